# Optimizing an MI355X kernel written in HIP

```python
import math
import jax, jax.numpy as jnp
from jax import lax
import numpy as np

D_MODEL = 1024
BATCH = 2
SEQ = 8192
DEPTH = 2

N_A_LAYERS = DEPTH // 2
N_B_LAYERS = DEPTH - N_A_LAYERS
HEAD_DIM = 64
N_HEADS = D_MODEL // HEAD_DIM
DECAY_LORA = 64
AAA_LORA = 64
GATE_LORA = 160
N_SHIFT_MIX = 6
GN_EPS = 64e-5
RMS_EPS = 1e-6
SB_BLOCK = 128
N_GROUPS = 4
EXPERTS_PER_GROUP = 4
N_EXPERTS = N_GROUPS * EXPERTS_PER_GROUP
TOP_K_INNER = 2
D_EXPERT = 256

kernel_name = "yoco_rwkv7_stickbreak_hmoe"


def rmsnorm(x, g):
    xf = x.astype(jnp.float32)
    y = xf * lax.rsqrt(jnp.mean(xf * xf, axis=-1, keepdims=True) + RMS_EPS)
    return (y * g.astype(jnp.float32)).astype(x.dtype)


def token_shift(x):
    return jnp.pad(x[:, :-1], ((0, 0), (1, 0), (0, 0)))


def wkv7_scan(r, decay, k, v, a, b):
    Bsz, T, H, N = r.shape

    def step(S, inp):
        r_t, w_t, k_t, v_t, a_t, b_t = inp
        sa = jnp.einsum('bhij,bhj->bhi', S, a_t)
        S = (S * w_t[:, :, None, :] + sa[..., None] * b_t[:, :, None, :]
             + v_t[..., None] * k_t[:, :, None, :])
        y = jnp.einsum('bhij,bhj->bhi', S, r_t)
        return S, y

    xs = tuple(jnp.moveaxis(t, 1, 0) for t in (r, decay, k, v, a, b))
    S0 = jnp.zeros((Bsz, H, N, N), jnp.float32)
    _, ys = lax.scan(step, S0, xs)
    return jnp.moveaxis(ys, 0, 1)


def rwkv7_time_mix(x, mix, w_rkv, w0, w1, w2, a0, a1, a2, g1, g2, k_k, k_a, r_k,
                   lnx_w, lnx_b, w_out):
    Bsz, T, C = x.shape
    H, N = N_HEADS, HEAD_DIM
    xx = token_shift(x) - x
    xs = x[None] + xx[None] * mix[:, None, None, :]
    rkv = jnp.einsum('nbtc,ncd->nbtd', xs[:3], w_rkv)
    r, k, v = rkv[0], rkv[1], rkv[2]
    xw, xa, xg = xs[3], xs[4], xs[5]
    w = -jax.nn.softplus(-(w0 + jnp.tanh(xw @ w1) @ w2)) - 0.5
    a = jax.nn.sigmoid(a0 + (xa @ a1) @ a2)
    g = jax.nn.sigmoid(xg @ g1) @ g2

    heads = lambda t: t.reshape(Bsz, T, H, N).astype(jnp.float32)
    kk = heads(k * k_k)
    kk = kk / jnp.maximum(jnp.sqrt(jnp.sum(kk * kk, axis=-1, keepdims=True)), 1e-12)
    k = k * (1.0 + (a - 1.0) * k_a)
    rh, kh, vh, ah = heads(r), heads(k), heads(v), heads(a)
    decay = jnp.exp(-jnp.exp(heads(w)))
    y = wkv7_scan(rh, decay, kh, vh, -kk, kk * ah)

    mu = jnp.mean(y, axis=-1, keepdims=True)
    var = jnp.mean(jnp.square(y - mu), axis=-1, keepdims=True)
    y = ((y - mu) * lax.rsqrt(var + GN_EPS)).reshape(Bsz, T, C)
    y = y * lnx_w.astype(jnp.float32) + lnx_b.astype(jnp.float32)
    bonus = jnp.sum(rh * kh * r_k.astype(jnp.float32), axis=-1, keepdims=True) * vh
    y = (y + bonus.reshape(Bsz, T, C)).astype(x.dtype)
    return (y * g) @ w_out


def stick_breaking_attention(q, k, v):
    Bsz, H, S, N = q.shape
    nb = S // SB_BLOCK
    scale = 1.0 / math.sqrt(N)
    qb = q.reshape(Bsz, H, nb, SB_BLOCK, N).transpose(2, 0, 1, 3, 4)
    kpos = jnp.arange(S)

    def block(args):
        i, q_blk = args
        qpos = i * SB_BLOCK + jnp.arange(SB_BLOCK)
        z = jnp.einsum('bhqd,bhkd->bhqk', q_blk, k).astype(jnp.float32) * scale
        mask = kpos[None, :] < qpos[:, None]
        u = jnp.where(mask, jax.nn.softplus(z), 0.0)
        suffix = lax.cumsum(u, axis=3, reverse=True) - u
        att = jnp.where(mask, jnp.exp(jax.nn.log_sigmoid(z) - suffix), 0.0)
        return jnp.einsum('bhqk,bhkd->bhqd', att.astype(v.dtype), v)

    o = lax.map(block, (jnp.arange(nb), qb))
    return o.transpose(1, 2, 0, 3, 4).reshape(Bsz, H, S, N)


def hier_moe(x, w_group, b_group, w_inner, b_inner, w_gate, w_up, w_down):
    gl = jnp.einsum('btd,dg->btg', x, w_group).astype(jnp.float32) + b_group.astype(jnp.float32)
    pg = jax.nn.softmax(gl, axis=-1)
    gval, gidx = lax.top_k(pg, 1)
    il = jnp.einsum('btd,dge->btge', x, w_inner).astype(jnp.float32) + b_inner.astype(jnp.float32)
    il_sel = jnp.einsum('btge,btg->bte', il, jax.nn.one_hot(gidx[..., 0], N_GROUPS, dtype=jnp.float32))
    pi = jax.nn.softmax(il_sel, axis=-1)
    ival, iidx = lax.top_k(pi, TOP_K_INNER)
    weight = gval * ival / jnp.sum(ival, axis=-1, keepdims=True)
    eidx = gidx * EXPERTS_PER_GROUP + iidx
    gates = jnp.sum(jax.nn.one_hot(eidx, N_EXPERTS, dtype=jnp.float32) * weight[..., None], axis=-2)
    h = (jax.nn.silu(jnp.einsum('btd,edf->btef', x, w_gate))
         * jnp.einsum('btd,edf->btef', x, w_up))
    h = h * gates.astype(h.dtype)[..., None]
    return jnp.einsum('btef,efd->btd', h, w_down)


def setup_inputs(seed: int = 0) -> dict:
    key = jax.random.key(seed)
    ks = iter(jax.random.split(key, 48))
    C, H, N = D_MODEL, N_HEADS, HEAD_DIM
    nA, nB = N_A_LAYERS, N_B_LAYERS
    G, E, NE, F = N_GROUPS, EXPERTS_PER_GROUP, N_EXPERTS, D_EXPERT

    def nrm(shape, scale):
        return jax.random.normal(next(ks), shape, jnp.float32) * scale

    def unif(shape, lo, hi):
        return jax.random.uniform(next(ks), shape, jnp.float32, lo, hi)

    return {
        "x": nrm((BATCH, SEQ, C), 1.0),
        "norm_mix": 1.0 + nrm((DEPTH, C), 0.02),
        "norm_ffn": 1.0 + nrm((DEPTH, C), 0.02),
        "norm_kv": 1.0 + nrm((C,), 0.02),
        "norm_final": 1.0 + nrm((C,), 0.02),
        "rw_mix": unif((nA, N_SHIFT_MIX, C), 0.0, 1.0),
        "rw_w_rkv": nrm((nA, 3, C, C), C ** -0.5),
        "rw_w0": unif((nA, C), -5.0, -1.0),
        "rw_w1": nrm((nA, C, DECAY_LORA), C ** -0.5),
        "rw_w2": nrm((nA, DECAY_LORA, C), 0.1 * DECAY_LORA ** -0.5),
        "rw_a0": nrm((nA, C), 0.1),
        "rw_a1": nrm((nA, C, AAA_LORA), C ** -0.5),
        "rw_a2": nrm((nA, AAA_LORA, C), 0.1 * AAA_LORA ** -0.5),
        "rw_g1": nrm((nA, C, GATE_LORA), C ** -0.5),
        "rw_g2": nrm((nA, GATE_LORA, C), GATE_LORA ** -0.5),
        "rw_k_k": 0.85 + nrm((nA, C), 0.05),
        "rw_k_a": 1.0 + nrm((nA, C), 0.05),
        "rw_r_k": nrm((nA, H, N), 0.1),
        "rw_lnx_w": 1.0 + nrm((nA, C), 0.02),
        "rw_lnx_b": nrm((nA, C), 0.02),
        "rw_w_out": nrm((nA, C, C), C ** -0.5),
        "w_kv": nrm((C, 2 * C), C ** -0.5),
        "sb_w_q": nrm((nB, C, C), C ** -0.5),
        "sb_w_out": nrm((nB, C, C), C ** -0.5),
        "moe_w_group": nrm((DEPTH, C, G), C ** -0.5),
        "moe_b_group": nrm((DEPTH, G), 0.01),
        "moe_w_inner": nrm((DEPTH, C, G, E), C ** -0.5),
        "moe_b_inner": nrm((DEPTH, G, E), 0.01),
        "moe_w_gate": nrm((DEPTH, NE, C, F), C ** -0.5),
        "moe_w_up": nrm((DEPTH, NE, C, F), C ** -0.5),
        "moe_w_down": nrm((DEPTH, NE, F, C), F ** -0.5),
    }


def reference(x, norm_mix, norm_ffn, norm_kv, norm_final,
              rw_mix, rw_w_rkv, rw_w0, rw_w1, rw_w2, rw_a0, rw_a1, rw_a2, rw_g1, rw_g2,
              rw_k_k, rw_k_a, rw_r_k, rw_lnx_w, rw_lnx_b, rw_w_out,
              w_kv, sb_w_q, sb_w_out,
              moe_w_group, moe_b_group, moe_w_inner, moe_b_inner,
              moe_w_gate, moe_w_up, moe_w_down):
    Bsz, S, C = x.shape
    H, N = N_HEADS, HEAD_DIM
    h = x
    k_shared = None
    v_shared = None
    for l in range(DEPTH):
        hn = rmsnorm(h, norm_mix[l])
        if l < N_A_LAYERS:
            i = l
            h = h + rwkv7_time_mix(hn, rw_mix[i], rw_w_rkv[i], rw_w0[i], rw_w1[i], rw_w2[i],
                                   rw_a0[i], rw_a1[i], rw_a2[i], rw_g1[i], rw_g2[i],
                                   rw_k_k[i], rw_k_a[i], rw_r_k[i], rw_lnx_w[i], rw_lnx_b[i],
                                   rw_w_out[i])
        else:
            j = l - N_A_LAYERS
            q = (hn @ sb_w_q[j]).reshape(Bsz, S, H, N).transpose(0, 2, 1, 3)
            o = stick_breaking_attention(q, k_shared, v_shared)
            h = h + o.transpose(0, 2, 1, 3).reshape(Bsz, S, C) @ sb_w_out[j]
        h = h + hier_moe(rmsnorm(h, norm_ffn[l]), moe_w_group[l], moe_b_group[l],
                         moe_w_inner[l], moe_b_inner[l], moe_w_gate[l], moe_w_up[l],
                         moe_w_down[l])
        if l == N_A_LAYERS - 1:
            kv = (rmsnorm(h, norm_kv) @ w_kv).reshape(Bsz, S, 2, H, N)
            k_shared = kv[:, :, 0].transpose(0, 2, 1, 3)
            v_shared = kv[:, :, 1].transpose(0, 2, 1, 3)
    return rmsnorm(h, norm_final)
```

```cpp
#include <hip/hip_runtime.h>
#include <cstdio>
#include <cstdint>

#ifndef MK_N_LAUNCHES
#define MK_N_LAUNCHES 17
#endif

namespace pg8 {
#define PG8_LAS __attribute__((address_space(3)))
typedef unsigned short bf16_t;
typedef short bf16x8 __attribute__((ext_vector_type(8)));
typedef float f32x4 __attribute__((ext_vector_type(4)));
typedef unsigned u32x4 __attribute__((ext_vector_type(4)));
constexpr int BM = 256, BK = 64, HALF = 128, HTB = HALF * BK * 2, STAGE_BYTES = 8 * HTB, NXCD = 8, WGM = 8;

__host__ __device__ __forceinline__ int lds_byte(int r, int c) { const int st = (r >> 4) * 2 + (c >> 5), rr = r & 15, cc = c & 31, ob = rr * 64 + cc * 2; return st * 1024 + (ob ^ (((ob >> 9) & 1) << 5)); }
__host__ __device__ __forceinline__ void stage_rc(int b, int& R, int& C) { const int st = b / 1024, sb = b % 1024, swz = sb ^ (((sb >> 9) & 1) << 5); R = (st >> 1) * 16 + swz / 64; C = (st & 1) * 32 + (swz % 64) / 2; }
__host__ __device__ __forceinline__ int perm32(int rho) { const int n = rho >> 4, i = rho & 15; return 8 * (i >> 2) + 4 * n + (i & 3); }

struct Unit { int pm, pn, aux, r0, cnt; };

__host__ __device__ __forceinline__ void tile_map(int wgid, int nM, int nN, int& pm, int& pn) {
    const int nwg = nM * nN;
    { const int q = nwg / NXCD, r = nwg % NXCD, xcd = wgid % NXCD, off = wgid / NXCD; wgid = (xcd < r ? xcd * (q + 1) : r * (q + 1) + (xcd - r) * q) + off; }
    const int nig = WGM * nN, gid = wgid / nig, fm = gid * WGM, gsz = (nM - fm) < WGM ? (nM - fm) : WGM;
    pm = fm + ((wgid % nig) % gsz); pn = (wgid % nig) / gsz;
}

__device__ __forceinline__ unsigned cvt_pk_bf16(float lo, float hi) { unsigned r; asm volatile("v_cvt_pk_bf16_f32 %0, %1, %2" : "=v"(r) : "v"(lo), "v"(hi)); return r; }

template <class Epi, class Sched, bool ALIGN_EPI, bool GATHER, int K>
__device__ __forceinline__ void gemm_phase(PG8_LAS unsigned char* lds, const Sched& S, const Epi& E, const int wid) {
    int lane_; asm volatile("v_mbcnt_lo_u32_b32 %0, -1, 0\n\tv_mbcnt_hi_u32_b32 %0, -1, %0" : "=v"(lane_));
    const int lane = lane_, tid = wid * 64 + lane, wr = wid >> 2, wc = wid & 3, fr = lane & 15, fq = lane >> 4;
    constexpr int nt = K / BK;
    unsigned voffA[2], voffB[2];
#pragma unroll
    for (int i = 0; i < 2; ++i) { int R, C; stage_rc(tid * 16 + i * 8192, R, C); const int Rb = Epi::PERM ? ((R & ~31) + perm32(R & 31)) : R;
        voffA[i] = (unsigned)(R * K + C) * 2u; voffB[i] = (unsigned)(Rb * K + C) * 2u; }
    constexpr size_t kstep = (size_t)(BK * 2);
    constexpr size_t hstep = (size_t)HALF * K * 2;
    const unsigned ldsw = (unsigned)wid * 1024u;
    const int aoff = lds_byte(wr * 64 + fr, fq * 8), boff = lds_byte(wc * 32 + fr, fq * 8);
#define PG8_SA(b, h) (((b) * 2 + (h)) * HTB)
#define PG8_SB(b, h) ((4 + (b) * 2 + (h)) * HTB)
#define PG8_STAGE(bufoff, gbase, voff) do { _Pragma("unroll") for (int _i = 0; _i < 2; ++_i) \
        __builtin_amdgcn_global_load_lds((const unsigned*)((const char*)(gbase) + (voff)[_i]), (PG8_LAS unsigned*)(lds + (bufoff) + ldsw + _i * 8192), 16, 0, 0); } while (0)
#define PG8_LDA(dst, b, h) do { _Pragma("unroll") for (int m = 0; m < 4; ++m) _Pragma("unroll") for (int k = 0; k < 2; ++k) dst[m][k] = *(const PG8_LAS bf16x8*)(lds + PG8_SA(b, h) + aoff + m * 2048 + k * 1024); } while (0)
#define PG8_LDB(dst, b, h) do { _Pragma("unroll") for (int n = 0; n < 2; ++n) _Pragma("unroll") for (int k = 0; k < 2; ++k) dst[n][k] = *(const PG8_LAS bf16x8*)(lds + PG8_SB(b, h) + boff + n * 2048 + k * 1024); } while (0)
#define PG8_MMA(ai, bj, At, Bt) do { __builtin_amdgcn_s_setprio(1); _Pragma("unroll") for (int m = 0; m < 4; ++m) _Pragma("unroll") for (int n = 0; n < 2; ++n) _Pragma("unroll") for (int k = 0; k < 2; ++k) \
        acc[ai][bj][m][n] = __builtin_amdgcn_mfma_f32_16x16x32_bf16(Bt[n][k], At[m][k], acc[ai][bj][m][n], 0, 0, 0); __builtin_amdgcn_s_setprio(0); } while (0)
#define PG8_WAIT_V(n) asm volatile("s_waitcnt vmcnt(" #n ")" ::: "memory")
#define PG8_WAIT_L(n) asm volatile("s_waitcnt lgkmcnt(" #n ")" ::: "memory")
#define PG8_BAR __builtin_amdgcn_s_barrier()
#define PG8_SCHED __builtin_amdgcn_sched_barrier(0)
    Unit cur, nxt; int ui = 0;
    if (!S.next(0, cur)) return;
    f32x4 acc[2][2][4][2];
#pragma unroll
    for (int a = 0; a < 2; ++a)
#pragma unroll
        for (int b = 0; b < 2; ++b)
#pragma unroll
            for (int m = 0; m < 4; ++m)
#pragma unroll
                for (int n = 0; n < 2; ++n) acc[a][b][m][n] = (f32x4){0.f, 0.f, 0.f, 0.f};
    bf16x8 At[4][2], B0[2][2], B1[2][2];
    unsigned vc[2][2];
#define PG8_GOFF(u) do { _Pragma("unroll") for (int _h = 0; _h < 2; ++_h) _Pragma("unroll") for (int _i = 0; _i < 2; ++_i) { int _R, _C; stage_rc(tid * 16 + _i * 8192, _R, _C); \
        vc[_h][_i] = S.a_row_off(u, _h * HALF + _R) + (unsigned)_C * 2u; } } while (0)
#define PG8_STAGE_A(bufoff, gbase, h) do { if constexpr (GATHER) { PG8_STAGE(bufoff, gbase, vc[h]); } else { PG8_STAGE(bufoff, (gbase) + (h) * hstep, voffA); } } while (0)
    if constexpr (GATHER) PG8_GOFF(cur);
    const char* cA = S.a_base(cur); const char* cB = S.b_base(cur);
    PG8_STAGE(PG8_SB(0, 0), cB, voffB); PG8_STAGE(PG8_SB(0, 1), cB + hstep, voffB); PG8_STAGE_A(PG8_SA(0, 0), cA, 0); PG8_STAGE_A(PG8_SA(0, 1), cA, 1);
    if (wr == 1) PG8_BAR;
    PG8_WAIT_V(2); PG8_BAR;
    PG8_STAGE(PG8_SB(1, 0), cB + kstep, voffB); PG8_STAGE_A(PG8_SA(1, 0), cA + kstep, 0); PG8_STAGE(PG8_SB(1, 1), cB + hstep + kstep, voffB);
    PG8_WAIT_V(6); PG8_BAR;
    for (;;) {
        const bool has_next = S.next(ui + 1, nxt);
        const char* nA = has_next ? S.a_base(nxt) : cA; const char* nB = has_next ? S.b_base(nxt) : cB;
        for (int t = 0; t < nt; t += 2) {
            const bool last = (t == nt - 2);
            const char* a1 = cA + (size_t)(t + 1) * kstep;
            const char* a2 = last ? nA : cA + (size_t)(t + 2) * kstep; const char* b2 = last ? nB : cB + (size_t)(t + 2) * kstep;
            const char* a3 = a2 + kstep; const char* b3 = b2 + kstep;
            PG8_LDB(B0, 0, 0); PG8_LDB(B1, 0, 1); PG8_SCHED; PG8_LDA(At, 0, 0); PG8_STAGE_A(PG8_SA(1, 1), a1, 1);
            if constexpr (GATHER) { if (last && has_next) PG8_GOFF(nxt); }
            PG8_WAIT_V(8); PG8_WAIT_L(0); PG8_BAR; PG8_MMA(0, 0, At, B0); PG8_MMA(0, 1, At, B1); PG8_BAR; PG8_SCHED;
            PG8_LDA(At, 0, 1); PG8_STAGE(PG8_SB(0, 0), b2, voffB); PG8_STAGE(PG8_SB(0, 1), b2 + hstep, voffB); PG8_STAGE_A(PG8_SA(0, 0), a2, 0);
            PG8_WAIT_V(8); PG8_WAIT_L(0); PG8_BAR; PG8_MMA(1, 0, At, B0); PG8_MMA(1, 1, At, B1); PG8_BAR; PG8_SCHED;
            PG8_LDB(B0, 1, 0); PG8_LDB(B1, 1, 1); PG8_SCHED; PG8_LDA(At, 1, 0); PG8_STAGE_A(PG8_SA(0, 1), a2, 1);
            PG8_WAIT_V(8); PG8_WAIT_L(0); PG8_BAR; PG8_MMA(0, 0, At, B0); PG8_MMA(0, 1, At, B1); PG8_BAR; PG8_SCHED;
            PG8_LDA(At, 1, 1); PG8_STAGE(PG8_SB(1, 0), b3, voffB); PG8_STAGE(PG8_SB(1, 1), b3 + hstep, voffB); PG8_STAGE_A(PG8_SA(1, 0), a3, 0);
            PG8_WAIT_V(8); PG8_WAIT_L(0); PG8_BAR; PG8_MMA(1, 0, At, B0); PG8_MMA(1, 1, At, B1); PG8_BAR; PG8_SCHED;
        }
        if constexpr (ALIGN_EPI) { if (wr == 0) PG8_BAR; }
        E(acc, cur, wr, wc, fr, fq);
        if (!has_next) break;
#pragma unroll
        for (int a = 0; a < 2; ++a)
#pragma unroll
            for (int b = 0; b < 2; ++b)
#pragma unroll
                for (int m = 0; m < 4; ++m)
#pragma unroll
                    for (int n = 0; n < 2; ++n) acc[a][b][m][n] = (f32x4){0.f, 0.f, 0.f, 0.f};
        cur = nxt; cA = nA; cB = nB; ++ui;
        if constexpr (ALIGN_EPI) { if (wr == 1) PG8_BAR; }
    }
    PG8_WAIT_V(0);
    if constexpr (!ALIGN_EPI) { if (wr == 0) PG8_BAR; }
    PG8_BAR;
#undef PG8_SA
#undef PG8_SB
#undef PG8_STAGE
#undef PG8_STAGE_A
#undef PG8_GOFF
#undef PG8_LDA
#undef PG8_LDB
#undef PG8_MMA
#undef PG8_WAIT_V
#undef PG8_WAIT_L
#undef PG8_BAR
#undef PG8_SCHED
}
}

constexpr int NWAVES = 8;
constexpr int NPHASE = 17;
constexpr int N_LAUNCHES = MK_N_LAUNCHES;
static_assert(N_LAUNCHES == 1 || N_LAUNCHES == NPHASE, "MK_N_LAUNCHES is 1 or NPHASE");

constexpr int BATCH = 2, SEQ = 8192, C = 1024, NH = 16, HD = 64, M = BATCH * SEQ;
constexpr int NE = 16, FE = 256, DW = 64, DA = 64, DG = 160;
constexpr float RMS_EPS = 1e-6f, GN_EPS = 64e-5f;
constexpr float SB_EXIT = 104.0f;

constexpr size_t MiB = 1u << 20;
constexpr size_t WS_CTL = 0, CTL_ZERO_BYTES = 1 * MiB;
constexpr size_t WS_WT_RKV = 1 * MiB;
constexpr size_t WS_WT_LORA = 7 * MiB;
constexpr size_t WS_WT_OUT = 9 * MiB;
constexpr size_t WS_WT_KVQ = 11 * MiB;
constexpr size_t WS_WT_SBO = 17 * MiB;
constexpr size_t WS_WT_GU = 19 * MiB;
constexpr size_t WS_WT_DN = 51 * MiB;
constexpr size_t WS_LW = 67 * MiB;
constexpr size_t WS_LA = 69 * MiB;
constexpr size_t WS_LG = 71 * MiB;
static_assert(WS_LA == WS_LW + 2 * MiB && WS_LG == WS_LW + 4 * MiB, "EpiLora's pointer arithmetic");
constexpr size_t WS_LIST = 76 * MiB;
constexpr size_t WS_WL = 77 * MiB;
constexpr size_t WS_HID = 78 * MiB;
constexpr size_t WS_B0 = 96 * MiB, WS_B1 = 128 * MiB, WS_B2 = 160 * MiB, WS_B3 = 192 * MiB, WS_B4 = 224 * MiB, WS_END = 256 * MiB;
constexpr size_t WS_RK = WS_B4;
static_assert(WS_HID + (size_t)144 * 256 * 256 * 2 <= WS_B0, "HID vs B0");
constexpr int CW_TMO = 0;
constexpr int CW_CNT = 1024;
constexpr int CW_BAR = 4096;

constexpr int RING_BYTES = 131072;
constexpr int LDSCTL_OFF = RING_BYTES, MISC_OFF = LDSCTL_OFF + 320, MOE_TAB_OFF = MISC_OFF + 128;
constexpr int LDS_BYTES = 147456;
static_assert(MOE_TAB_OFF + 256 <= LDS_BYTES, "LDS map");

#define GAS __attribute__((address_space(1)))
#define LAS __attribute__((address_space(3)))
typedef unsigned short bf16;
typedef unsigned v4u __attribute__((ext_vector_type(4)));
typedef unsigned v2u __attribute__((ext_vector_type(2)));
typedef float f32x4 __attribute__((ext_vector_type(4)));
typedef GAS unsigned gu32;
#define RLX_AGENT __ATOMIC_RELAXED, __HIP_MEMORY_SCOPE_AGENT
#define LDS_WAIT() asm volatile("s_waitcnt lgkmcnt(0)" ::: "memory")
#define VM_WAIT() asm volatile("s_waitcnt vmcnt(0)" ::: "memory")
__device__ __forceinline__ unsigned f2bf(float f) { unsigned u = __builtin_bit_cast(unsigned, f); return (u + 0x7fffu + ((u >> 16) & 1u)) >> 16; }
__device__ __forceinline__ unsigned pk2(float lo, float hi) { return f2bf(lo) | (f2bf(hi) << 16); }
__device__ __forceinline__ float bflo(unsigned u) { return __uint_as_float(u << 16); }
__device__ __forceinline__ float bfhi(unsigned u) { return __uint_as_float(u & 0xffff0000u); }
__device__ __forceinline__ float bf2f(bf16 b) { return __uint_as_float((unsigned)b << 16); }
__device__ __forceinline__ float sigmoidf_(float x) { return 1.0f / (1.0f + __expf(-x)); }

#define XB_TMO      128
#define XB_XCNT(j)  (256  + 64 * (j))
#define XB_XSUB(j)  (1280 + 64 * (j))
#define XB_XGEN(j)  (2304 + 64 * (j))
#define XB_TOP      3328
#define XB_TOPGEN   3392
#define XCD_BAR_WORDS 3456
#define XB_SPIN_CAP (1u << 18)
__device__ __forceinline__ unsigned xb_ld(unsigned* p)              { return __hip_atomic_load(p, __ATOMIC_RELAXED, __HIP_MEMORY_SCOPE_AGENT); }
__device__ __forceinline__ unsigned xb_add(unsigned* p, unsigned v) { return __hip_atomic_fetch_add(p, v, __ATOMIC_RELAXED, __HIP_MEMORY_SCOPE_AGENT); }
__device__ __forceinline__ unsigned xb_xcc_id() { return (unsigned)__builtin_amdgcn_s_getreg((3 << 11) | 20) & 0xFu; }
#define XB_SPIN(cond, bar) do { unsigned _sp = 0; while (cond) { __builtin_amdgcn_s_sleep(1); \
    if ((++_sp & 255u) == 0u) { if (xb_ld(&(bar)[XB_TMO])) break; if (_sp > XB_SPIN_CAP) { atomicAdd(&(bar)[XB_TMO], 1u); break; } } } } while (0)
struct XcdBarrier { unsigned* bar; unsigned x; volatile LAS unsigned* st; };
__device__ __forceinline__ XcdBarrier xcd_barrier_post(unsigned* bar, volatile LAS unsigned* st) {
    XcdBarrier b; b.bar = bar; b.x = xb_xcc_id(); b.st = st;
    if (threadIdx.x == 0) (void)xb_add(&bar[XB_XCNT(b.x)], 1u);
    return b;
}
__device__ __forceinline__ void xcd_barrier_complete(unsigned* bar, unsigned x, unsigned& nloc, unsigned& nx) {
    const unsigned G = gridDim.x * gridDim.y * gridDim.z;
    unsigned sum, cnt, mine, sp = 0u;
    for (;;) {
        sum = 0u; cnt = 0u; mine = 0u;
#pragma unroll
        for (unsigned j = 0; j < 16; ++j) { const unsigned c = xb_ld(&bar[XB_XCNT(j)]); sum += c; cnt += (c > 0u) ? 1u : 0u; mine = (j == x) ? c : mine; }
        if (sum == G) break;
        __builtin_amdgcn_s_sleep(1);
        if ((++sp & 255u) == 0u) { if (xb_ld(&bar[XB_TMO])) break; if (sp > XB_SPIN_CAP) { atomicAdd(&bar[XB_TMO], 1u); break; } }
    }
    nloc = mine > 0u ? mine : 1u; nx = cnt > 0u ? cnt : 1u;
}
__device__ __forceinline__ void xcd_barrier(const XcdBarrier& b) {
    asm volatile("s_waitcnt vmcnt(0)" ::: "memory");
    __syncthreads();
    if (threadIdx.x == 0) {
        unsigned* bar = b.bar;
        __builtin_amdgcn_s_waitcnt(0);
        unsigned nloc = b.st[0], nx = b.st[1];
        if (nloc == 0u) { xcd_barrier_complete(bar, b.x, nloc, nx); b.st[0] = nloc; b.st[1] = nx; }
        const unsigned old = xb_add(&bar[XB_XSUB(b.x)], 1u);
        const unsigned gen = old / nloc;
        if (old + 1u == (gen + 1u) * nloc) {
            __builtin_amdgcn_fence(__ATOMIC_RELEASE, "agent");
            asm volatile("s_waitcnt vmcnt(0)" ::: "memory");
            const unsigned og = xb_add(&bar[XB_TOP], 1u);
            const unsigned tg = og / nx;
            if (og + 1u == (tg + 1u) * nx) xb_add(&bar[XB_TOPGEN], 1u);
            else XB_SPIN(xb_ld(&bar[XB_TOPGEN]) == tg, bar);
            __builtin_amdgcn_fence(__ATOMIC_ACQUIRE, "agent");
            xb_add(&bar[XB_XGEN(b.x)], 1u);
            asm volatile("s_waitcnt vmcnt(0)" ::: "memory");
        } else {
            XB_SPIN(xb_ld(&bar[XB_XGEN(b.x)]) == gen, bar);
            __builtin_amdgcn_fence(__ATOMIC_ACQUIRE, "agent");
            asm volatile("s_waitcnt vmcnt(0)" ::: "memory");
        }
    }
    __syncthreads();
}

__device__ __forceinline__ float shx(float v, int o, int lane) { return __int_as_float(__builtin_amdgcn_ds_bpermute((lane ^ o) << 2, __float_as_int(v))); }
__device__ __forceinline__ float wave_sum(float v, int lane) {
#pragma unroll
    for (int o = 1; o < 64; o <<= 1) v += shx(v, o, lane);
    return v;
}
__device__ __forceinline__ void transpose_item(const float* W, int ldw, int k0, int n0, bf16* WT, int ldk, int dst_row0, const float* kscale, LAS float* scr, int lane) {
#pragma unroll 8
    for (int i = 0; i < 32; ++i) { const int kk = 2 * i + (lane >> 5); float v = W[(size_t)(k0 + kk) * ldw + n0 + (lane & 31)]; if (kscale) v *= kscale[k0 + kk]; scr[kk * 33 + (lane & 31)] = v; }
    LDS_WAIT(); asm volatile("" ::: "memory");
    const int c = lane & 7;
#pragma unroll
    for (int j = 0; j < 4; ++j) { const int n = (lane >> 3) + 8 * j; const LAS float* s = scr + (8 * c) * 33 + n;
        v4u o; o.x = pk2(s[0 * 33], s[1 * 33]); o.y = pk2(s[2 * 33], s[3 * 33]); o.z = pk2(s[4 * 33], s[5 * 33]); o.w = pk2(s[6 * 33], s[7 * 33]);
        *(GAS v4u*)(WT + (size_t)(dst_row0 + n) * ldk + k0 + 8 * c) = o; }
    LDS_WAIT(); asm volatile("" ::: "memory");
}

struct Args { const float* in[31]; float* out; unsigned char* ws; int ph_lo, ph_hi, li, pad; };
typedef const __attribute__((address_space(4))) unsigned char* kaptr_t;
__device__ __forceinline__ kaptr_t ka_base() { kaptr_t p = (kaptr_t)__builtin_amdgcn_kernarg_segment_ptr(); asm volatile("" : "+s"(p)); return p; }
#define INP(k) (*(const float* const __attribute__((address_space(4)))*)(ka_base() + 8 * (k)))
#define OUTP() (*(float* const __attribute__((address_space(4)))*)(ka_base() + 8 * 31))
#define WSP() (*(unsigned char* const __attribute__((address_space(4)))*)(ka_base() + 8 * 32))
#define KA_INT(i) (*(const int __attribute__((address_space(4)))*)(ka_base() + 8 * 33 + 4 * (i)))

__device__ __forceinline__ void p0_weights(unsigned char* ws, LAS unsigned char* lds, int gw, int NGW, int wave, int lane) {
    LAS float* scr = (LAS float*)(lds + wave * 16384);
    bf16* WT_RKV = (bf16*)(ws + WS_WT_RKV); bf16* WT_LORA = (bf16*)(ws + WS_WT_LORA); bf16* WT_OUT = (bf16*)(ws + WS_WT_OUT); bf16* WT_KVQ = (bf16*)(ws + WS_WT_KVQ);
    bf16* WT_SBO = (bf16*)(ws + WS_WT_SBO); bf16* WT_GU = (bf16*)(ws + WS_WT_GU); bf16* WT_DN = (bf16*)(ws + WS_WT_DN);
    constexpr int I_RKV = 3 * 512, I_LORA = 32 + 32 + 80, I_OUT = 512, I_KV = 1024, I_Q = 512, I_SBO = 512, I_G = 32 * 128, I_U = 32 * 128, I_D = 32 * 128;
    constexpr int NITEMS = I_RKV + I_LORA + I_OUT + I_KV + I_Q + I_SBO + I_G + I_U + I_D;
    for (int it = gw; it < NITEMS; it += NGW) {
        int r = it;
        if (r < I_RKV) { const int m = r / 512, q = r % 512, kb = q / 32, nb = q % 32; transpose_item(INP(6) + (size_t)m * C * C, C, 64 * kb, 32 * nb, WT_RKV, C, m * C + 32 * nb, nullptr, scr, lane); continue; } r -= I_RKV;
        if (r < I_LORA) {
            if (r < 32) { const int kb = r / 2, nb = r % 2; transpose_item(INP(8), DW, 64 * kb, 32 * nb, WT_LORA, C, 32 * nb, nullptr, scr, lane); }
            else if (r < 64) { const int q = r - 32, kb = q / 2, nb = q % 2; transpose_item(INP(11), DA, 64 * kb, 32 * nb, WT_LORA, C, 256 + 32 * nb, nullptr, scr, lane); }
            else { const int q = r - 64, kb = q / 5, nb = q % 5; transpose_item(INP(13), DG, 64 * kb, 32 * nb, WT_LORA, C, 512 + 32 * nb, nullptr, scr, lane); }
            continue; } r -= I_LORA;
        if (r < I_OUT) { const int kb = r / 32, nb = r % 32; transpose_item(INP(20), C, 64 * kb, 32 * nb, WT_OUT, C, 32 * nb, nullptr, scr, lane); continue; } r -= I_OUT;
        if (r < I_KV) { const int kb = r / 64, nb = r % 64; transpose_item(INP(21), 2 * C, 64 * kb, 32 * nb, WT_KVQ, C, 32 * nb, INP(3), scr, lane); continue; } r -= I_KV;
        if (r < I_Q) { const int kb = r / 32, nb = r % 32; transpose_item(INP(22), C, 64 * kb, 32 * nb, WT_KVQ, C, 2 * C + 32 * nb, INP(1) + C, scr, lane); continue; } r -= I_Q;
        if (r < I_SBO) { const int kb = r / 32, nb = r % 32; transpose_item(INP(23), C, 64 * kb, 32 * nb, WT_SBO, C, 32 * nb, nullptr, scr, lane); continue; } r -= I_SBO;
        if (r < I_G) { const int le = r / 128, q = r % 128, kb = q / 8, nb = q % 8, f0 = 32 * nb; transpose_item(INP(28) + (size_t)le * C * FE, FE, 64 * kb, f0, WT_GU + (size_t)le * 512 * C, C, 256 * (f0 / 128) + (f0 % 128), nullptr, scr, lane); continue; } r -= I_G;
        if (r < I_U) { const int le = r / 128, q = r % 128, kb = q / 8, nb = q % 8, f0 = 32 * nb; transpose_item(INP(29) + (size_t)le * C * FE, FE, 64 * kb, f0, WT_GU + (size_t)le * 512 * C, C, 256 * (f0 / 128) + 128 + (f0 % 128), nullptr, scr, lane); continue; } r -= I_U;
        { const int le = r / 128, q = r % 128, kb = q / 32, nb = q % 32; transpose_item(INP(30) + (size_t)le * FE * C, C, 64 * kb, 32 * nb, WT_DN + (size_t)le * C * FE, FE, 32 * nb, nullptr, scr, lane); }
    }
    for (int it = gw * 64 + lane; it < 768 * 128; it += NGW * 64) { const int row = it >> 7, ch = it & 127;
        const bool valid = (row < 64) || (row >= 256 && row < 320) || (row >= 512 && row < 672);
        if (!valid) *(GAS v4u*)(WT_LORA + (size_t)row * C + ch * 8) = (v4u){0u, 0u, 0u, 0u}; }
}
__device__ __forceinline__ void load_row(const float* p, int lane, f32x4 (&v)[4]) {
#pragma unroll
    for (int j = 0; j < 4; ++j) v[j] = ((const GAS f32x4*)p)[64 * j + lane];
}
__device__ __forceinline__ float row_rs(const f32x4 (&v)[4], int lane) {
    float s = 0.f;
#pragma unroll
    for (int j = 0; j < 4; ++j) s += (v[j].x * v[j].x + v[j].y * v[j].y) + (v[j].z * v[j].z + v[j].w * v[j].w);
    return 1.0f / sqrtf(wave_sum(s, lane) * (1.0f / C) + RMS_EPS);
}
__device__ __forceinline__ void store_row_bf16(bf16* p, int lane, const f32x4 (&v)[4]) {
#pragma unroll
    for (int j = 0; j < 4; ++j) { v2u o; o.x = pk2(v[j].x, v[j].y); o.y = pk2(v[j].z, v[j].w); ((GAS v2u*)p)[64 * j + lane] = o; }
}
__device__ __forceinline__ void p0_rows(unsigned char* ws, int gw, int NGW, int lane) {
    const float* x = INP(0); const float* gain = INP(1); const float* mix = INP(5);
    f32x4 g[4]; load_row(gain, lane, g);
    for (int run = gw; run < M / 8; run += NGW) {
        const int r0 = run * 8;
        f32x4 prev[4];
        if ((r0 % SEQ) == 0) {
#pragma unroll
            for (int j = 0; j < 4; ++j) prev[j] = (f32x4){0.f, 0.f, 0.f, 0.f};
        } else { load_row(x + (size_t)(r0 - 1) * C, lane, prev); const float rs = row_rs(prev, lane);
#pragma unroll
            for (int j = 0; j < 4; ++j) prev[j] = prev[j] * rs * g[j]; }
        for (int rr = 0; rr < 8; ++rr) {
            const int row = r0 + rr;
            f32x4 hn[4]; load_row(x + (size_t)row * C, lane, hn); const float rs = row_rs(hn, lane);
#pragma unroll
            for (int j = 0; j < 4; ++j) hn[j] = hn[j] * rs * g[j];
#pragma unroll
            for (int i = 0; i < 6; ++i) { f32x4 o[4];
#pragma unroll
                for (int j = 0; j < 4; ++j) { const f32x4 mx = ((const GAS f32x4*)(mix + i * C))[64 * j + lane]; o[j] = hn[j] + (prev[j] - hn[j]) * mx; }
                bf16* dst = i < 2 ? (bf16*)OUTP() + (size_t)i * M * C : (i == 2 ? (bf16*)(ws + WS_B4) : (bf16*)(ws + WS_B1) + (size_t)(i - 3) * M * C);
                store_row_bf16(dst + (size_t)row * C, lane, o); }
#pragma unroll
            for (int j = 0; j < 4; ++j) prev[j] = hn[j];
        }
    }
}

template <int NN, int NGROUPS> struct SchedGrouped {
    static constexpr int K = C;
    const char* A0; size_t astride; const char* A2; const char* B; size_t bgroup;
    int G, c;
    __device__ __forceinline__ bool next(int i, pg8::Unit& u) const {
        const int L = i * G + c; constexpr int per = 64 * NN; if (L >= per * NGROUPS) return false;
        const int g = L / per, w = L % per; pg8::tile_map(w, 64, NN, u.pm, u.pn); u.aux = g; u.r0 = 0; u.cnt = 0; return true; }
    __device__ __forceinline__ const char* a_base(const pg8::Unit& u) const { const char* A = (A2 != nullptr && u.aux == 2) ? A2 : A0 + (size_t)u.aux * astride; return A + (size_t)u.pm * 256 * K * 2; }
    __device__ __forceinline__ const char* b_base(const pg8::Unit& u) const { return B + (size_t)u.aux * bgroup + (size_t)u.pn * 256 * K * 2; }
    __device__ __forceinline__ unsigned a_row_off(const pg8::Unit&, int) const { return 0u; }
};
template <int NN, int K, bool GATHER> struct SchedMoe {
    const char* A; const char* B; size_t bexp; const unsigned* list; volatile LAS int* tab; int G, c;
    __device__ __forceinline__ bool next(int i, pg8::Unit& u) const {
        const int L = i * G + c; const int tot = __builtin_amdgcn_readfirstlane(tab[48]) * NN; if (L >= tot) return false;
        u.pm = L / NN; u.pn = L % NN; int e = 0;
#pragma unroll
        for (int j = 0; j < 16; ++j) e += (u.pm >= tab[32 + j]) ? 1 : 0;
        e = __builtin_amdgcn_readfirstlane(e);
        u.aux = e; u.r0 = (u.pm - __builtin_amdgcn_readfirstlane(tab[16 + e])) * 256; u.cnt = __builtin_amdgcn_readfirstlane(tab[e]); return true; }
    __device__ __forceinline__ const char* a_base(const pg8::Unit& u) const { return GATHER ? A : A + (size_t)u.pm * 256 * K * 2; }
    __device__ __forceinline__ const char* b_base(const pg8::Unit& u) const { return B + (size_t)u.aux * bexp + (size_t)u.pn * 256 * K * 2; }
    __device__ __forceinline__ unsigned a_row_off(const pg8::Unit& u, int r) const {
        const int idx = u.r0 + r; unsigned tok = 0u;
        if (idx < u.cnt) tok = list[(size_t)u.aux * M + idx] >> 1;
        return tok * (unsigned)(K * 2); }
};

using pg8::f32x4;
using pg8::Unit;
__device__ __forceinline__ v4u pack8(f32x4 v0, f32x4 v1) { v4u w; w.x = pg8::cvt_pk_bf16(v0[0], v0[1]); w.y = pg8::cvt_pk_bf16(v0[2], v0[3]); w.z = pg8::cvt_pk_bf16(v1[0], v1[1]); w.w = pg8::cvt_pk_bf16(v1[2], v1[3]); return w; }

struct EpiLora {
    static constexpr bool PERM = true;
    bf16* LW;
    __device__ __forceinline__ void operator()(const f32x4 (&acc)[2][2][4][2], const Unit& u, int wr, int wc, int fr, int fq) const {
        { int l_; asm volatile("v_mbcnt_lo_u32_b32 %0, -1, 0\n\tv_mbcnt_hi_u32_b32 %0, -1, %0" : "=v"(l_)); fr = l_ & 15; fq = l_ >> 4; }
        const int g = u.aux, width = g == 2 ? DG : DW; bf16* out = LW + (size_t)g * (1u << 20);
        const int row0 = u.pm * 256 + wr * 64 + fr;
#pragma unroll
        for (int bj = 0; bj < 2; ++bj) { const int col0 = bj * 128 + wc * 32 + 8 * fq; if (col0 < width) {
#pragma unroll
            for (int ai = 0; ai < 2; ++ai)
#pragma unroll
                for (int m = 0; m < 4; ++m) { f32x4 v0 = acc[ai][bj][m][0], v1 = acc[ai][bj][m][1];
                    if (g == 0) {
#pragma unroll
                        for (int q = 0; q < 4; ++q) { v0[q] = tanhf(v0[q]); v1[q] = tanhf(v1[q]); } }
                    else if (g == 2) {
#pragma unroll
                        for (int q = 0; q < 4; ++q) { v0[q] = sigmoidf_(v0[q]); v1[q] = sigmoidf_(v1[q]); } }
                    *(GAS v4u*)(out + (size_t)(row0 + ai * 128 + m * 16) * width + col0) = pack8(v0, v1); } } }
    }
};
struct EpiSplit3 {
    static constexpr bool PERM = true;
    bf16* O0; bool bycol;
    __device__ __forceinline__ void operator()(const f32x4 (&acc)[2][2][4][2], const Unit& u, int wr, int wc, int fr, int fq) const {
        { int l_; asm volatile("v_mbcnt_lo_u32_b32 %0, -1, 0\n\tv_mbcnt_hi_u32_b32 %0, -1, %0" : "=v"(l_)); fr = l_ & 15; fq = l_ >> 4; }
        const int g = bycol ? (u.pn >> 2) : u.aux, pn = bycol ? (u.pn & 3) : u.pn; bf16* out = O0 + (size_t)g * ((size_t)M * C);
        const int row0 = u.pm * 256 + wr * 64 + fr, col0 = pn * 256 + wc * 32 + 8 * fq;
#pragma unroll
        for (int ai = 0; ai < 2; ++ai)
#pragma unroll
            for (int m = 0; m < 4; ++m)
#pragma unroll
                for (int bj = 0; bj < 2; ++bj) *(GAS v4u*)(out + (size_t)(row0 + ai * 128 + m * 16) * C + col0 + bj * 128) = pack8(acc[ai][bj][m][0], acc[ai][bj][m][1]);
    }
};
struct EpiResid {
    static constexpr bool PERM = false;
    const float* base; float* out;
    __device__ __forceinline__ void operator()(const f32x4 (&acc)[2][2][4][2], const Unit& u, int wr, int wc, int fr, int fq) const {
        { int l_; asm volatile("v_mbcnt_lo_u32_b32 %0, -1, 0\n\tv_mbcnt_hi_u32_b32 %0, -1, %0" : "=v"(l_)); fr = l_ & 15; fq = l_ >> 4; }
        const int row0 = u.pm * 256 + wr * 64 + fr, col0 = u.pn * 256 + wc * 32 + 4 * fq;
#pragma unroll
        for (int ai = 0; ai < 2; ++ai)
#pragma unroll
            for (int m = 0; m < 4; ++m) { const size_t off = (size_t)(row0 + ai * 128 + m * 16) * C + col0;
#pragma unroll
                for (int bj = 0; bj < 2; ++bj)
#pragma unroll
                    for (int n = 0; n < 2; ++n) { const f32x4 b = *(const GAS f32x4*)(base + off + bj * 128 + n * 16); *(GAS f32x4*)(out + off + bj * 128 + n * 16) = b + acc[ai][bj][m][n]; } }
    }
};
struct EpiGU {
    static constexpr bool PERM = true;
    bf16* HID; const float* wl;
    __device__ __forceinline__ void operator()(const f32x4 (&acc)[2][2][4][2], const Unit& u, int wr, int wc, int fr, int fq) const {
        { int l_; asm volatile("v_mbcnt_lo_u32_b32 %0, -1, 0\n\tv_mbcnt_hi_u32_b32 %0, -1, %0" : "=v"(l_)); fr = l_ & 15; fq = l_ >> 4; }
        const int e = u.aux, cnt = u.cnt, base = u.r0, r0 = wr * 64 + fr, col0 = u.pn * 128 + wc * 32 + 8 * fq;
#pragma unroll
        for (int ai = 0; ai < 2; ++ai)
#pragma unroll
            for (int m = 0; m < 4; ++m) { const int r = r0 + ai * 128 + m * 16, idx = base + r; float w = 0.f; if (idx < cnt) w = wl[(size_t)e * M + idx];
                f32x4 h0, h1;
#pragma unroll
                for (int q = 0; q < 4; ++q) { const float g0 = acc[ai][0][m][0][q], g1 = acc[ai][0][m][1][q];
                    h0[q] = g0 * sigmoidf_(g0) * acc[ai][1][m][0][q] * w; h1[q] = g1 * sigmoidf_(g1) * acc[ai][1][m][1][q] * w; }
                *(GAS v4u*)(HID + (size_t)(u.pm * 256 + r) * FE + col0) = pack8(h0, h1);
                asm volatile("" ::: "memory"); }
    }
};
struct EpiDown {
    static constexpr bool PERM = true;
    bf16* EO; const unsigned* list;
    __device__ __forceinline__ void operator()(const f32x4 (&acc)[2][2][4][2], const Unit& u, int wr, int wc, int fr, int fq) const {
        { int l_; asm volatile("v_mbcnt_lo_u32_b32 %0, -1, 0\n\tv_mbcnt_hi_u32_b32 %0, -1, %0" : "=v"(l_)); fr = l_ & 15; fq = l_ >> 4; }
        const int e = u.aux, cnt = u.cnt, base = u.r0, r0 = wr * 64 + fr, col0 = u.pn * 256 + wc * 32 + 8 * fq;
#pragma unroll
        for (int ai = 0; ai < 2; ++ai)
#pragma unroll
            for (int m = 0; m < 4; ++m) { const int idx = base + r0 + ai * 128 + m * 16;
                if (idx < cnt) { const unsigned ent = list[(size_t)e * M + idx]; bf16* o = EO + ((size_t)(ent & 1u) * M + (ent >> 1)) * C + col0;
#pragma unroll
                    for (int bj = 0; bj < 2; ++bj) *(GAS v4u*)(o + bj * 128) = pack8(acc[ai][bj][m][0], acc[ai][bj][m][1]); }
                asm volatile("" ::: "memory"); }
    }
};

__device__ __forceinline__ void scan_naive(unsigned char* ws, LAS unsigned char* lds, int tid) {
    const int lane = tid & 63;
    const bf16* Rb = (const bf16*)(ws + WS_B1); const bf16* Kb = (const bf16*)(ws + WS_B2); const bf16* Vb = (const bf16*)(ws + WS_B3);
    const bf16* LW = (const bf16*)(ws + WS_LW); const bf16* LA = (const bf16*)(ws + WS_LA);
    float* Y = OUTP(); float* RK = (float*)(ws + WS_RK);
    LAS float* sR = (LAS float*)lds; LAS float* sK = sR + 4096; LAS float* sV = sK + 4096; LAS float* sA = sV + 4096; LAS float* sB = sA + 4096; LAS float* sD = sB + 4096;
    LAS float* sW2 = sD + 4096; LAS float* sA2 = sW2 + 4096;
    for (int unit = blockIdx.x; unit < BATCH * NH; unit += gridDim.x) {
        const int b = unit / NH, h = unit % NH;
        __syncthreads();
        for (int e = tid; e < 4096; e += 512) { const int d = e >> 6, j = e & 63; sW2[e] = INP(9)[(size_t)d * C + h * HD + j]; sA2[e] = INP(12)[(size_t)d * C + h * HD + j]; }
        __syncthreads();
        const int pt = tid >> 3, cq = tid & 7, c0 = h * HD + cq * 8;
        const int si = tid >> 3, jq = tid & 7;
        float S[8];
#pragma unroll
        for (int q = 0; q < 8; ++q) S[q] = 0.f;
        float w0v[8], a0v[8], kkv[8], kav[8], rkv[8];
#pragma unroll
        for (int q = 0; q < 8; ++q) { w0v[q] = INP(7)[c0 + q]; a0v[q] = INP(10)[c0 + q]; kkv[q] = INP(15)[c0 + q]; kav[q] = INP(16)[c0 + q]; rkv[q] = INP(17)[c0 + q]; }
        for (int blk = 0; blk < SEQ / 64; ++blk) {
            const size_t row = (size_t)b * SEQ + blk * 64 + pt;
            {
                const v4u r4 = *(const GAS v4u*)(Rb + row * C + c0), k4 = *(const GAS v4u*)(Kb + row * C + c0), v4 = *(const GAS v4u*)(Vb + row * C + c0);
                float r[8], k[8], v[8];
                r[0] = bflo(r4.x); r[1] = bfhi(r4.x); r[2] = bflo(r4.y); r[3] = bfhi(r4.y); r[4] = bflo(r4.z); r[5] = bfhi(r4.z); r[6] = bflo(r4.w); r[7] = bfhi(r4.w);
                k[0] = bflo(k4.x); k[1] = bfhi(k4.x); k[2] = bflo(k4.y); k[3] = bfhi(k4.y); k[4] = bflo(k4.z); k[5] = bfhi(k4.z); k[6] = bflo(k4.w); k[7] = bfhi(k4.w);
                v[0] = bflo(v4.x); v[1] = bfhi(v4.x); v[2] = bflo(v4.y); v[3] = bfhi(v4.y); v[4] = bflo(v4.z); v[5] = bfhi(v4.z); v[6] = bflo(v4.w); v[7] = bfhi(v4.w);
                float wp[8], ap[8];
#pragma unroll
                for (int q = 0; q < 8; ++q) { wp[q] = w0v[q]; ap[q] = a0v[q]; }
                for (int d = 0; d < 64; ++d) { const float lw = bf2f(LW[row * DW + d]), la = bf2f(LA[row * DA + d]);
#pragma unroll
                    for (int q = 0; q < 8; ++q) { wp[q] += lw * sW2[d * 64 + cq * 8 + q]; ap[q] += la * sA2[d * 64 + cq * 8 + q]; } }
                float kk[8], ss = 0.f, rks = 0.f;
#pragma unroll
                for (int q = 0; q < 8; ++q) { kk[q] = k[q] * kkv[q]; ss += kk[q] * kk[q]; }
                ss += shx(ss, 1, lane); ss += shx(ss, 2, lane); ss += shx(ss, 4, lane);
                const float inv = 1.0f / fmaxf(sqrtf(ss), 1e-12f);
#pragma unroll
                for (int q = 0; q < 8; ++q) { const float ag = sigmoidf_(ap[q]); const float kn = kk[q] * inv; const float kp = k[q] * (1.0f + (ag - 1.0f) * kav[q]);
                    const float lw = -0.6065306597126334f * sigmoidf_(wp[q]);
                    const int o = pt * 64 + cq * 8 + q;
                    sR[o] = r[q]; sK[o] = kp; sV[o] = v[q]; sA[o] = -kn; sB[o] = kn * ag; sD[o] = __expf(lw); rks += r[q] * kp * rkv[q]; }
                rks += shx(rks, 1, lane); rks += shx(rks, 2, lane); rks += shx(rks, 4, lane);
                if (cq == 0) RK[row * NH + h] = rks;
            }
            __syncthreads();
            for (int t = 0; t < 64; ++t) {
                const LAS f32x4* pa = (const LAS f32x4*)(sA + t * 64 + jq * 8); const LAS f32x4* pb = (const LAS f32x4*)(sB + t * 64 + jq * 8);
                const LAS f32x4* pd = (const LAS f32x4*)(sD + t * 64 + jq * 8); const LAS f32x4* pk = (const LAS f32x4*)(sK + t * 64 + jq * 8);
                const LAS f32x4* pr = (const LAS f32x4*)(sR + t * 64 + jq * 8);
                const f32x4 a0 = pa[0], a1 = pa[1], b0 = pb[0], b1 = pb[1], d0 = pd[0], d1 = pd[1], k0 = pk[0], k1 = pk[1], r0 = pr[0], r1 = pr[1];
                const float vi = sV[t * 64 + si];
                float sa = 0.f;
#pragma unroll
                for (int q = 0; q < 4; ++q) { sa += S[q] * a0[q]; sa += S[4 + q] * a1[q]; }
                sa += shx(sa, 1, lane); sa += shx(sa, 2, lane); sa += shx(sa, 4, lane);
                float y = 0.f;
#pragma unroll
                for (int q = 0; q < 4; ++q) { S[q] = S[q] * d0[q] + sa * b0[q] + vi * k0[q]; S[4 + q] = S[4 + q] * d1[q] + sa * b1[q] + vi * k1[q]; y += S[q] * r0[q]; y += S[4 + q] * r1[q]; }
                y += shx(y, 1, lane); y += shx(y, 2, lane); y += shx(y, 4, lane);
                if (jq == 0) Y[((size_t)b * SEQ + blk * 64 + t) * C + h * HD + si] = y;
            }
            __syncthreads();
        }
    }
}
__device__ __forceinline__ void post_scan(unsigned char* ws, int gw, int NGW, int lane) {
    const float* Y = OUTP(); const float* RK = (const float*)(ws + WS_RK); const bf16* Vb = (const bf16*)(ws + WS_B3); const bf16* LG = (const bf16*)(ws + WS_LG);
    bf16* YG = (bf16*)(ws + WS_B0); const float* g2 = INP(14); const float* lnw = INP(18); const float* lnb = INP(19);
    for (int it = gw; it < M * NH; it += NGW) {
        const int row = it / NH, h = it % NH, c = h * HD + lane;
        const float y = Y[(size_t)row * C + c];
        const float mu = wave_sum(y, lane) * (1.0f / HD); const float d = y - mu; const float var = wave_sum(d * d, lane) * (1.0f / HD);
        float o = d * (1.0f / sqrtf(var + GN_EPS)) * lnw[c] + lnb[c];
        o += RK[(size_t)row * NH + h] * bf2f(Vb[(size_t)row * C + c]);
        float g = 0.f;
        for (int dd = 0; dd < DG; ++dd) g += bf2f(LG[(size_t)row * DG + dd]) * g2[(size_t)dd * C + c];
        YG[(size_t)row * C + c] = (bf16)f2bf(o * g);
    }
}

__device__ __forceinline__ void router_rows(unsigned char* ws, LAS unsigned char* lds, int layer, int gw, int NGW, int lane, int tid) {
    const float* Hh = OUTP(); const float* gain = INP(2) + layer * C; bf16* XN = (bf16*)(ws + WS_B1);
    const float* wg = INP(24) + (size_t)layer * C * 4; const float* bg = INP(25) + layer * 4; const float* wi = INP(26) + (size_t)layer * C * 16; const float* bi = INP(27) + layer * 16;
    unsigned* cnt = (unsigned*)(ws + WS_CTL) + CW_CNT + layer * 16 * 64; unsigned* list = (unsigned*)(ws + WS_LIST); float* wl = (float*)(ws + WS_WL);
    LAS float* sWg = (LAS float*)lds; LAS float* sWi = sWg + C * 4;
    __syncthreads();
    for (int e = tid; e < C * 4; e += 512) sWg[e] = wg[e];
    for (int e = tid; e < C * 16; e += 512) sWi[e] = wi[e];
    __syncthreads();
    f32x4 g[4]; load_row(gain, lane, g);
    for (int row = gw; row < M; row += NGW) {
        f32x4 v[4]; load_row(Hh + (size_t)row * C, lane, v); const float rs = row_rs(v, lane);
#pragma unroll
        for (int j = 0; j < 4; ++j) v[j] = v[j] * rs * g[j];
        store_row_bf16(XN + (size_t)row * C, lane, v);
        float gl[4] = {0.f, 0.f, 0.f, 0.f};
        const LAS unsigned char* pWg = (const LAS unsigned char*)sWg + lane * 64;
#pragma unroll
        for (int j = 0; j < 4; ++j)
#pragma unroll
            for (int q = 0; q < 4; ++q) { const f32x4 w = *(const LAS f32x4*)(pWg + j * 4096 + q * 16); const float xv = v[j][q]; gl[0] += xv * w.x; gl[1] += xv * w.y; gl[2] += xv * w.z; gl[3] += xv * w.w; }
#pragma unroll
        for (int q = 0; q < 4; ++q) gl[q] = wave_sum(gl[q], lane) + bg[q];
        int gi = 0; float gm = gl[0];
#pragma unroll
        for (int q = 1; q < 4; ++q) if (gl[q] > gm) { gm = gl[q]; gi = q; }
        float gden = 0.f;
#pragma unroll
        for (int q = 0; q < 4; ++q) gden += __expf(gl[q] - gm);
        const float gval = 1.0f / gden;
        float il[4] = {0.f, 0.f, 0.f, 0.f};
        const LAS unsigned char* pWi = (const LAS unsigned char*)sWi + lane * 256 + gi * 16;
#pragma unroll
        for (int j = 0; j < 4; ++j)
#pragma unroll
            for (int q = 0; q < 4; ++q) { const f32x4 w = *(const LAS f32x4*)(pWi + j * 16384 + q * 64); const float xv = v[j][q]; il[0] += xv * w.x; il[1] += xv * w.y; il[2] += xv * w.z; il[3] += xv * w.w; }
#pragma unroll
        for (int q = 0; q < 4; ++q) il[q] = wave_sum(il[q], lane) + bi[gi * 4 + q];
        int i0 = 0; float m0 = il[0];
#pragma unroll
        for (int q = 1; q < 4; ++q) if (il[q] > m0) { m0 = il[q]; i0 = q; }
        int i1 = -1; float m1 = -INFINITY;
#pragma unroll
        for (int q = 0; q < 4; ++q) if (q != i0 && il[q] > m1) { m1 = il[q]; i1 = q; }
        const float e1 = __expf(m1 - m0); const float w0 = gval / (1.0f + e1), w1 = gval * e1 / (1.0f + e1);
        if (lane == 0) {
            const int ex0 = gi * 4 + i0, ex1 = gi * 4 + i1;
            const unsigned p0 = atomicAdd(cnt + ex0 * 64, 1u); list[(size_t)ex0 * M + p0] = (unsigned)row * 2u; wl[(size_t)ex0 * M + p0] = w0;
            const unsigned p1 = atomicAdd(cnt + ex1 * 64, 1u); list[(size_t)ex1 * M + p1] = (unsigned)row * 2u + 1u; wl[(size_t)ex1 * M + p1] = w1;
        }
    }
}
__device__ __forceinline__ void moe_table(unsigned char* ws, volatile LAS int* tab, int layer, int tid) {
    __syncthreads();
    if (tid == 0) { const unsigned* cnt = (const unsigned*)(ws + WS_CTL) + CW_CNT + layer * 16 * 64; int t = 0;
#pragma unroll 1
        for (int e = 0; e < 16; ++e) { const int c = (int)__hip_atomic_load(cnt, RLX_AGENT); cnt += 64; tab[e] = c; tab[16 + e] = t; t += (c + 255) >> 8; tab[32 + e] = t; }
        tab[48] = t; }
    __syncthreads();
}
__device__ __forceinline__ void combine_rows(unsigned char* ws, int mode, int gw, int NGW, int lane) {
    float* Hh = OUTP(); const bf16* E0 = (const bf16*)(ws + WS_B2); const bf16* E1 = (const bf16*)(ws + WS_B3); bf16* XN2 = (bf16*)(ws + WS_B0);
    f32x4 g[4]; load_row(INP(4), lane, g);
    for (int row = gw; row < M; row += NGW) {
        f32x4 v[4]; load_row(Hh + (size_t)row * C, lane, v);
#pragma unroll
        for (int j = 0; j < 4; ++j) { const v2u e0 = ((const GAS v2u*)(E0 + (size_t)row * C))[64 * j + lane], e1 = ((const GAS v2u*)(E1 + (size_t)row * C))[64 * j + lane];
            v[j].x += bflo(e0.x) + bflo(e1.x); v[j].y += bfhi(e0.x) + bfhi(e1.x); v[j].z += bflo(e0.y) + bflo(e1.y); v[j].w += bfhi(e0.y) + bfhi(e1.y); }
        const float rs = row_rs(v, lane);
        if (mode == 0) {
#pragma unroll
            for (int j = 0; j < 4; ++j) ((GAS f32x4*)(Hh + (size_t)row * C))[64 * j + lane] = v[j];
#pragma unroll
            for (int j = 0; j < 4; ++j) v[j] = v[j] * rs;
            store_row_bf16(XN2 + (size_t)row * C, lane, v);
        } else {
#pragma unroll
            for (int j = 0; j < 4; ++j) ((GAS f32x4*)(Hh + (size_t)row * C))[64 * j + lane] = v[j] * rs * g[j];
        }
    }
}
__device__ __forceinline__ void attn_naive(unsigned char* ws, int gw, int NGW, int lane) {
    const bf16* Kb = (const bf16*)(ws + WS_B1); const bf16* Vb = (const bf16*)(ws + WS_B2); const bf16* Qb = (const bf16*)(ws + WS_B3); bf16* Ob = (bf16*)(ws + WS_B0);
    for (int unit = gw; unit < BATCH * NH * (SEQ / 64); unit += NGW) {
        const int qb = unit % (SEQ / 64), bh = unit / (SEQ / 64), b = bh / NH, h = bh % NH;
        const int t0 = qb * 64, t = t0 + lane; const size_t rowq = (size_t)b * SEQ + t;
        float q[64], o[64];
#pragma unroll
        for (int c = 0; c < 8; ++c) { const v4u w = *(const GAS v4u*)(Qb + rowq * C + h * HD + c * 8);
            q[c * 8 + 0] = bflo(w.x) * 0.125f; q[c * 8 + 1] = bfhi(w.x) * 0.125f; q[c * 8 + 2] = bflo(w.y) * 0.125f; q[c * 8 + 3] = bfhi(w.y) * 0.125f;
            q[c * 8 + 4] = bflo(w.z) * 0.125f; q[c * 8 + 5] = bfhi(w.z) * 0.125f; q[c * 8 + 6] = bflo(w.w) * 0.125f; q[c * 8 + 7] = bfhi(w.w) * 0.125f; }
#pragma unroll
        for (int c = 0; c < 64; ++c) o[c] = 0.f;
        float suffix = 0.f;
        for (int s = t0 + 62; s >= 0; --s) {
            const bool valid = s < t;
            if (s < t0 && __all(suffix > SB_EXIT)) break;
            const bf16* kp = Kb + ((size_t)b * SEQ + s) * C + h * HD; const bf16* vp = Vb + ((size_t)b * SEQ + s) * C + h * HD;
            float z = 0.f;
#pragma unroll
            for (int c = 0; c < 8; ++c) { const v4u w = *(const GAS v4u*)(kp + c * 8);
                z += q[c * 8 + 0] * bflo(w.x) + q[c * 8 + 1] * bfhi(w.x) + q[c * 8 + 2] * bflo(w.y) + q[c * 8 + 3] * bfhi(w.y) + q[c * 8 + 4] * bflo(w.z) + q[c * 8 + 5] * bfhi(w.z) + q[c * 8 + 6] * bflo(w.w) + q[c * 8 + 7] * bfhi(w.w); }
            const float sp = fmaxf(z, 0.f) + log1pf(__expf(-fabsf(z)));
            const float att = valid ? __expf(z - sp - suffix) : 0.f;
            suffix += valid ? sp : 0.f;
#pragma unroll
            for (int c = 0; c < 8; ++c) { const v4u w = *(const GAS v4u*)(vp + c * 8);
                o[c * 8 + 0] += att * bflo(w.x); o[c * 8 + 1] += att * bfhi(w.x); o[c * 8 + 2] += att * bflo(w.y); o[c * 8 + 3] += att * bfhi(w.y);
                o[c * 8 + 4] += att * bflo(w.z); o[c * 8 + 5] += att * bfhi(w.z); o[c * 8 + 6] += att * bflo(w.w); o[c * 8 + 7] += att * bfhi(w.w); }
        }
#pragma unroll
        for (int c = 0; c < 8; ++c) { v4u w; w.x = pk2(o[c * 8 + 0], o[c * 8 + 1]); w.y = pk2(o[c * 8 + 2], o[c * 8 + 3]); w.z = pk2(o[c * 8 + 4], o[c * 8 + 5]); w.w = pk2(o[c * 8 + 6], o[c * 8 + 7]);
            *(GAS v4u*)(Ob + rowq * C + h * HD + c * 8) = w; }
    }
}

__global__ void __launch_bounds__(NWAVES * 64, 2) yoco_fwd(Args args) {
    extern __shared__ __attribute__((aligned(16))) unsigned char lds_raw[];
    LAS unsigned char* lds = (LAS unsigned char*)lds_raw;
    const int G = gridDim.x; const int bx = blockIdx.x;
    int wave = __builtin_amdgcn_readfirstlane(threadIdx.x >> 6); asm volatile("" : "+s"(wave));
#define IDS() int lane; asm volatile("v_mbcnt_lo_u32_b32 %0, -1, 0\n\tv_mbcnt_hi_u32_b32 %0, -1, %0" : "=v"(lane)); const int tid = wave * 64 + lane; (void)tid; \
    const int vcu = (G % 8 == 0) ? (bx % 8) * (G / 8) + bx / 8 : bx; const int gw = vcu * NWAVES + wave, NGW = G * NWAVES; (void)lane; (void)gw; (void)NGW;
    unsigned char* ws = WSP();
    volatile LAS unsigned* MISC = (volatile LAS unsigned*)(lds + MISC_OFF);
    volatile LAS int* tab = (volatile LAS int*)(lds + MOE_TAB_OFF);
    for (int u = threadIdx.x; u < (LDS_BYTES - LDSCTL_OFF) / 4; u += NWAVES * 64) ((LAS unsigned*)(lds + LDSCTL_OFF))[u] = 0u;
    __syncthreads();
    XcdBarrier bar; bar.bar = (unsigned*)(ws + WS_CTL) + CW_BAR; bar.x = 0; bar.st = nullptr;
    if (N_LAUNCHES == 1) bar = xcd_barrier_post((unsigned*)(ws + WS_CTL) + CW_BAR, MISC + 8);
    const int lo = KA_INT(0), hi = KA_INT(1);
#define IN(k) (lo <= (k) && (k) < hi)
#define SEAM(k) do { if (IN(k) && IN((k) + 1)) xcd_barrier(bar); } while (0)

    if (IN(0)) { IDS(); p0_weights(ws, lds, gw, NGW, wave, lane); p0_rows(ws, gw, NGW, lane); }
    SEAM(0);
    if (IN(1)) {
        SchedGrouped<1, 3> S{(const char*)(ws + WS_B1), (size_t)(WS_B2 - WS_B1), nullptr, (const char*)(ws + WS_WT_LORA), (size_t)256 * C * 2, G, bx};
        EpiLora E{(bf16*)(ws + WS_LW)};
        pg8::gemm_phase<EpiLora, SchedGrouped<1, 3>, true, false, C>(lds, S, E, wave);
    }
    SEAM(1);
    if (IN(2)) {
        SchedGrouped<4, 3> S{(const char*)OUTP(), (size_t)M * C * 2, (const char*)(ws + WS_B4), (const char*)(ws + WS_WT_RKV), (size_t)C * C * 2, G, bx};
        EpiSplit3 E{(bf16*)(ws + WS_B1), false};
        pg8::gemm_phase<EpiSplit3, SchedGrouped<4, 3>, true, false, C>(lds, S, E, wave);
    }
    SEAM(2);
    if (IN(3)) { IDS(); scan_naive(ws, lds, tid); }
    SEAM(3);
    if (IN(4)) { IDS(); post_scan(ws, gw, NGW, lane); }
    SEAM(4);
    if (IN(5)) {
        SchedGrouped<4, 1> S{(const char*)(ws + WS_B0), 0, nullptr, (const char*)(ws + WS_WT_OUT), 0, G, bx};
        EpiResid E{INP(0), OUTP()};
        pg8::gemm_phase<EpiResid, SchedGrouped<4, 1>, true, false, C>(lds, S, E, wave);
    }
    SEAM(5);
#pragma unroll 1
    for (int layer = 0; layer < 2; ++layer) {
        const int pb = layer == 0 ? 6 : 13;
        if (IN(pb)) { IDS(); router_rows(ws, lds, layer, gw, NGW, lane, tid); }
        SEAM(pb);
        if (IN(pb + 1)) {
            { IDS(); moe_table(ws, tab, layer, tid); }
            SchedMoe<2, C, true> S{(const char*)(ws + WS_B1), (const char*)(ws + WS_WT_GU) + (size_t)layer * 16 * 512 * C * 2, (size_t)512 * C * 2, (const unsigned*)(ws + WS_LIST), tab, G, bx};
            EpiGU E{(bf16*)(ws + WS_HID), (const float*)(ws + WS_WL)};
            pg8::gemm_phase<EpiGU, SchedMoe<2, C, true>, true, true, C>(lds, S, E, wave);
        }
        SEAM(pb + 1);
        if (IN(pb + 2)) {
            { IDS(); moe_table(ws, tab, layer, tid); }
            SchedMoe<4, FE, false> S{(const char*)(ws + WS_HID), (const char*)(ws + WS_WT_DN) + (size_t)layer * 16 * C * FE * 2, (size_t)C * FE * 2, (const unsigned*)(ws + WS_LIST), tab, G, bx};
            EpiDown E{(bf16*)(ws + WS_B2), (const unsigned*)(ws + WS_LIST)};
            pg8::gemm_phase<EpiDown, SchedMoe<4, FE, false>, true, false, FE>(lds, S, E, wave);
        }
        SEAM(pb + 2);
        if (layer == 0) {
            if (IN(9)) { IDS(); combine_rows(ws, 0, gw, NGW, lane); }
            SEAM(9);
            if (IN(10)) {
                SchedGrouped<12, 1> S{(const char*)(ws + WS_B0), 0, nullptr, (const char*)(ws + WS_WT_KVQ), 0, G, bx};
                EpiSplit3 E{(bf16*)(ws + WS_B1), true};
                pg8::gemm_phase<EpiSplit3, SchedGrouped<12, 1>, true, false, C>(lds, S, E, wave);
            }
            SEAM(10);
            if (IN(11)) { IDS(); attn_naive(ws, gw, NGW, lane); }
            SEAM(11);
            if (IN(12)) {
                SchedGrouped<4, 1> S{(const char*)(ws + WS_B0), 0, nullptr, (const char*)(ws + WS_WT_SBO), 0, G, bx};
                EpiResid E{OUTP(), OUTP()};
                pg8::gemm_phase<EpiResid, SchedGrouped<4, 1>, true, false, C>(lds, S, E, wave);
            }
            SEAM(12);
        }
    }
    if (IN(16)) { IDS(); combine_rows(ws, 1, gw, NGW, lane); }
#undef IN
#undef SEAM
}

extern "C" void kernel_launch(void* const* d_in, const int* in_sizes, int n_in, void* d_out, int out_size, void* d_ws, size_t ws_size, hipStream_t stream) {
    static int grid = 0;
    if (grid == 0) {
        if (n_in != 31 || in_sizes[0] != M * C || out_size != M * C || ws_size < WS_END) { fprintf(stderr, "kernel_launch: unexpected shapes (n_in %d, in0 %d, out %d, ws %zu); nothing launched\n", n_in, n_in > 0 ? in_sizes[0] : -1, out_size, ws_size); grid = -1; return; }
        int dev = 0, cus = 0, per_cu = 0;
        if (hipGetDevice(&dev) != hipSuccess || hipDeviceGetAttribute(&cus, hipDeviceAttributeMultiprocessorCount, dev) != hipSuccess) { grid = -1; return; }
        if (hipFuncSetAttribute((const void*)yoco_fwd, hipFuncAttributeMaxDynamicSharedMemorySize, LDS_BYTES) != hipSuccess) { fprintf(stderr, "kernel_launch: hipFuncSetAttribute failed\n"); grid = -1; return; }
        if (hipOccupancyMaxActiveBlocksPerMultiprocessor(&per_cu, (const void*)yoco_fwd, NWAVES * 64, LDS_BYTES) != hipSuccess || per_cu < 1) fprintf(stderr, "kernel_launch: occupancy query reports %d\n", per_cu);
        (void)hipGetLastError();
        grid = cus;
    }
    if (grid < 0) return;
    if (hipMemsetAsync((char*)d_ws + WS_CTL, 0, CTL_ZERO_BYTES, stream) != hipSuccess) return;
    Args a{};
    for (int i = 0; i < 31; ++i) a.in[i] = (const float*)d_in[i];
    a.out = (float*)d_out; a.ws = (unsigned char*)d_ws;
    for (int li = 0; li < N_LAUNCHES; ++li) {
        a.ph_lo = (N_LAUNCHES == 1) ? 0 : li; a.ph_hi = (N_LAUNCHES == 1) ? NPHASE : li + 1; a.li = li;
        hipLaunchKernelGGL(yoco_fwd, dim3(grid), dim3(NWAVES * 64), LDS_BYTES, stream, a);
        const hipError_t le = hipPeekAtLastError();
        if (le != hipSuccess) { fprintf(stderr, "kernel_launch: launch %d failed: %s\n", li, hipGetErrorName(le)); break; }
    }
}
```

```cpp
#include <hip/hip_runtime.h>
#include <cstdio>
#include <cstdint>

#ifndef MK_N_LAUNCHES
#define MK_N_LAUNCHES 1
#endif

namespace pg8 {
#define PG8_LAS __attribute__((address_space(3)))
typedef unsigned short bf16_t;
typedef short bf16x8 __attribute__((ext_vector_type(8)));
typedef float f32x4 __attribute__((ext_vector_type(4)));
typedef unsigned u32x4 __attribute__((ext_vector_type(4)));
constexpr int BM = 256, BK = 64, HALF = 128, HTB = HALF * BK * 2, STAGE_BYTES = 8 * HTB, NXCD = 8, WGM = 8;

__host__ __device__ __forceinline__ int lds_byte(int r, int c) { const int st = (r >> 4) * 2 + (c >> 5), rr = r & 15, cc = c & 31, ob = rr * 64 + cc * 2; return st * 1024 + (ob ^ (((ob >> 9) & 1) << 5)); }
__host__ __device__ __forceinline__ void stage_rc(int b, int& R, int& C) { const int st = b / 1024, sb = b % 1024, swz = sb ^ (((sb >> 9) & 1) << 5); R = (st >> 1) * 16 + swz / 64; C = (st & 1) * 32 + (swz % 64) / 2; }
__host__ __device__ __forceinline__ int perm32(int rho) { const int n = rho >> 4, i = rho & 15; return 8 * (i >> 2) + 4 * n + (i & 3); }

struct Unit { int pm, pn, aux, r0, cnt; };

__host__ __device__ __forceinline__ void tile_map(int wgid, int nM, int nN, int& pm, int& pn) {
    const int nwg = nM * nN;
    { const int q = nwg / NXCD, r = nwg % NXCD, xcd = wgid % NXCD, off = wgid / NXCD; wgid = (xcd < r ? xcd * (q + 1) : r * (q + 1) + (xcd - r) * q) + off; }
    const int nig = WGM * nN, gid = wgid / nig, fm = gid * WGM, gsz = (nM - fm) < WGM ? (nM - fm) : WGM;
    pm = fm + ((wgid % nig) % gsz); pn = (wgid % nig) / gsz;
}

__device__ __forceinline__ unsigned cvt_pk_bf16(float lo, float hi) { unsigned r; asm volatile("v_cvt_pk_bf16_f32 %0, %1, %2" : "=v"(r) : "v"(lo), "v"(hi)); return r; }

template <class Epi, class Sched, bool ALIGN_EPI, bool GATHER, int K>
__device__ __forceinline__ void gemm_phase(PG8_LAS unsigned char* lds, const Sched& S, const Epi& E, const int wid) {
    int lane_; asm volatile("v_mbcnt_lo_u32_b32 %0, -1, 0\n\tv_mbcnt_hi_u32_b32 %0, -1, %0" : "=v"(lane_));
    const int lane = lane_, tid = wid * 64 + lane, wr = wid >> 2, wc = wid & 3, fr = lane & 15, fq = lane >> 4;
    constexpr int nt = K / BK;
    unsigned voffA[2], voffB[2];
#pragma unroll
    for (int i = 0; i < 2; ++i) { int R, C; stage_rc(tid * 16 + i * 8192, R, C); const int Rb = Epi::PERM ? ((R & ~31) + perm32(R & 31)) : R;
        voffA[i] = (unsigned)(R * K + C) * 2u; voffB[i] = (unsigned)(Rb * K + C) * 2u; }
    constexpr size_t kstep = (size_t)(BK * 2);
    constexpr size_t hstep = (size_t)HALF * K * 2;
    const unsigned ldsw = (unsigned)wid * 1024u;
    const int aoff = lds_byte(wr * 64 + fr, fq * 8), boff = lds_byte(wc * 32 + fr, fq * 8);
#define PG8_SA(b, h) (((b) * 2 + (h)) * HTB)
#define PG8_SB(b, h) ((4 + (b) * 2 + (h)) * HTB)
#define PG8_STAGE(bufoff, gbase, voff) do { _Pragma("unroll") for (int _i = 0; _i < 2; ++_i) \
        __builtin_amdgcn_global_load_lds((const unsigned*)((const char*)(gbase) + (voff)[_i]), (PG8_LAS unsigned*)(lds + (bufoff) + ldsw + _i * 8192), 16, 0, 0); } while (0)
#define PG8_LDA(dst, b, h) do { _Pragma("unroll") for (int m = 0; m < 4; ++m) _Pragma("unroll") for (int k = 0; k < 2; ++k) dst[m][k] = *(const PG8_LAS bf16x8*)(lds + PG8_SA(b, h) + aoff + m * 2048 + k * 1024); } while (0)
#define PG8_LDB(dst, b, h) do { _Pragma("unroll") for (int n = 0; n < 2; ++n) _Pragma("unroll") for (int k = 0; k < 2; ++k) dst[n][k] = *(const PG8_LAS bf16x8*)(lds + PG8_SB(b, h) + boff + n * 2048 + k * 1024); } while (0)
#define PG8_MMA(ai, bj, At, Bt) do { __builtin_amdgcn_s_setprio(1); _Pragma("unroll") for (int m = 0; m < 4; ++m) _Pragma("unroll") for (int n = 0; n < 2; ++n) _Pragma("unroll") for (int k = 0; k < 2; ++k) \
        acc[ai][bj][m][n] = __builtin_amdgcn_mfma_f32_16x16x32_bf16(Bt[n][k], At[m][k], acc[ai][bj][m][n], 0, 0, 0); __builtin_amdgcn_s_setprio(0); } while (0)
#define PG8_WAIT_V(n) asm volatile("s_waitcnt vmcnt(" #n ")" ::: "memory")
#define PG8_WAIT_L(n) asm volatile("s_waitcnt lgkmcnt(" #n ")" ::: "memory")
#define PG8_BAR __builtin_amdgcn_s_barrier()
#define PG8_SCHED __builtin_amdgcn_sched_barrier(0)
    Unit cur, nxt; int ui = 0;
    if (!S.next(0, cur)) return;
    f32x4 acc[2][2][4][2];
#pragma unroll
    for (int a = 0; a < 2; ++a)
#pragma unroll
        for (int b = 0; b < 2; ++b)
#pragma unroll
            for (int m = 0; m < 4; ++m)
#pragma unroll
                for (int n = 0; n < 2; ++n) acc[a][b][m][n] = (f32x4){0.f, 0.f, 0.f, 0.f};
    bf16x8 At[4][2], B0[2][2], B1[2][2];
    unsigned vc[2][2];
#define PG8_GOFF(u) do { _Pragma("unroll") for (int _h = 0; _h < 2; ++_h) _Pragma("unroll") for (int _i = 0; _i < 2; ++_i) { int _R, _C; stage_rc(tid * 16 + _i * 8192, _R, _C); \
        vc[_h][_i] = S.a_row_off(u, _h * HALF + _R) + (unsigned)_C * 2u; } } while (0)
#define PG8_STAGE_A(bufoff, gbase, h) do { if constexpr (GATHER) { PG8_STAGE(bufoff, gbase, vc[h]); } else { PG8_STAGE(bufoff, (gbase) + (h) * hstep, voffA); } } while (0)
    if constexpr (GATHER) PG8_GOFF(cur);
    const char* cA = S.a_base(cur); const char* cB = S.b_base(cur);
    PG8_STAGE(PG8_SB(0, 0), cB, voffB); PG8_STAGE(PG8_SB(0, 1), cB + hstep, voffB); PG8_STAGE_A(PG8_SA(0, 0), cA, 0); PG8_STAGE_A(PG8_SA(0, 1), cA, 1);
    if (wr == 1) PG8_BAR;
    PG8_WAIT_V(2); PG8_BAR;
    PG8_STAGE(PG8_SB(1, 0), cB + kstep, voffB); PG8_STAGE_A(PG8_SA(1, 0), cA + kstep, 0); PG8_STAGE(PG8_SB(1, 1), cB + hstep + kstep, voffB);
    PG8_WAIT_V(6); PG8_BAR;
    for (;;) {
        const bool has_next = S.next(ui + 1, nxt);
        const char* nA = has_next ? S.a_base(nxt) : cA; const char* nB = has_next ? S.b_base(nxt) : cB;
        for (int t = 0; t < nt; t += 2) {
            const bool last = (t == nt - 2);
            const char* a1 = cA + (size_t)(t + 1) * kstep;
            const char* a2 = last ? nA : cA + (size_t)(t + 2) * kstep; const char* b2 = last ? nB : cB + (size_t)(t + 2) * kstep;
            const char* a3 = a2 + kstep; const char* b3 = b2 + kstep;
            PG8_LDB(B0, 0, 0); PG8_LDB(B1, 0, 1); PG8_SCHED; PG8_LDA(At, 0, 0); PG8_STAGE_A(PG8_SA(1, 1), a1, 1);
            if constexpr (GATHER) { if (last && has_next) PG8_GOFF(nxt); }
            PG8_WAIT_V(8); PG8_WAIT_L(0); PG8_BAR; PG8_MMA(0, 0, At, B0); PG8_MMA(0, 1, At, B1); PG8_BAR; PG8_SCHED;
            PG8_LDA(At, 0, 1); PG8_STAGE(PG8_SB(0, 0), b2, voffB); PG8_STAGE(PG8_SB(0, 1), b2 + hstep, voffB); PG8_STAGE_A(PG8_SA(0, 0), a2, 0);
            PG8_WAIT_V(8); PG8_WAIT_L(0); PG8_BAR; PG8_MMA(1, 0, At, B0); PG8_MMA(1, 1, At, B1); PG8_BAR; PG8_SCHED;
            PG8_LDB(B0, 1, 0); PG8_LDB(B1, 1, 1); PG8_SCHED; PG8_LDA(At, 1, 0); PG8_STAGE_A(PG8_SA(0, 1), a2, 1);
            PG8_WAIT_V(8); PG8_WAIT_L(0); PG8_BAR; PG8_MMA(0, 0, At, B0); PG8_MMA(0, 1, At, B1); PG8_BAR; PG8_SCHED;
            PG8_LDA(At, 1, 1); PG8_STAGE(PG8_SB(1, 0), b3, voffB); PG8_STAGE(PG8_SB(1, 1), b3 + hstep, voffB); PG8_STAGE_A(PG8_SA(1, 0), a3, 0);
            PG8_WAIT_V(8); PG8_WAIT_L(0); PG8_BAR; PG8_MMA(1, 0, At, B0); PG8_MMA(1, 1, At, B1); PG8_BAR; PG8_SCHED;
        }
        if constexpr (ALIGN_EPI) { if (wr == 0) PG8_BAR; }
        E(acc, cur, wr, wc, fr, fq);
        if (!has_next) break;
#pragma unroll
        for (int a = 0; a < 2; ++a)
#pragma unroll
            for (int b = 0; b < 2; ++b)
#pragma unroll
                for (int m = 0; m < 4; ++m)
#pragma unroll
                    for (int n = 0; n < 2; ++n) acc[a][b][m][n] = (f32x4){0.f, 0.f, 0.f, 0.f};
        cur = nxt; cA = nA; cB = nB; ++ui;
        if constexpr (ALIGN_EPI) { if (wr == 1) PG8_BAR; }
    }
    PG8_WAIT_V(0);
    if constexpr (!ALIGN_EPI) { if (wr == 0) PG8_BAR; }
    PG8_BAR;
#undef PG8_SA
#undef PG8_SB
#undef PG8_STAGE
#undef PG8_STAGE_A
#undef PG8_GOFF
#undef PG8_LDA
#undef PG8_LDB
#undef PG8_MMA
#undef PG8_WAIT_V
#undef PG8_WAIT_L
#undef PG8_BAR
#undef PG8_SCHED
}
}

constexpr int NWAVES = 8;
constexpr int NPHASE = 17;
constexpr int N_LAUNCHES = MK_N_LAUNCHES;
static_assert(N_LAUNCHES == 1 || N_LAUNCHES == NPHASE, "MK_N_LAUNCHES is 1 or NPHASE");

constexpr int BATCH = 2, SEQ = 8192, C = 1024, NH = 16, HD = 64, M = BATCH * SEQ;
constexpr int NE = 16, FE = 256, DW = 64, DA = 64, DG = 160;
constexpr float RMS_EPS = 1e-6f, GN_EPS = 64e-5f;
constexpr float SB_EXIT = 104.0f;

constexpr size_t MiB = 1u << 20;
constexpr size_t WS_CTL = 0, CTL_ZERO_BYTES = 1 * MiB;
constexpr size_t WS_WT_RKV = 1 * MiB;
constexpr size_t WS_WT_LORA = 7 * MiB;
constexpr size_t WS_WT_OUT = 9 * MiB;
constexpr size_t WS_WT_KVQ = 11 * MiB;
constexpr size_t WS_WT_SBO = 17 * MiB;
constexpr size_t WS_WT_GU = 19 * MiB;
constexpr size_t WS_WT_DN = 51 * MiB;
constexpr size_t WS_LW = 67 * MiB;
constexpr size_t WS_LA = 69 * MiB;
constexpr size_t WS_LG = 71 * MiB;
static_assert(WS_LA == WS_LW + 2 * MiB && WS_LG == WS_LW + 4 * MiB, "EpiLora's pointer arithmetic");
constexpr size_t WS_LIST = 76 * MiB;
constexpr size_t WS_WL = 77 * MiB;
constexpr size_t WS_HID = 78 * MiB;
constexpr size_t WS_B0 = 96 * MiB, WS_B1 = 128 * MiB, WS_B2 = 160 * MiB, WS_B3 = 192 * MiB, WS_B4 = 224 * MiB, WS_END = 256 * MiB;
constexpr size_t WS_RK = WS_B4;
static_assert(WS_HID + (size_t)144 * 256 * 256 * 2 <= WS_B0, "HID vs B0");
constexpr int CW_TMO = 0;
constexpr int CW_CNT = 1024;
constexpr int CW_BAR = 4096;

constexpr int RING_BYTES = 131072;
constexpr int LDSCTL_OFF = RING_BYTES, MISC_OFF = LDSCTL_OFF + 320, MOE_TAB_OFF = MISC_OFF + 128;
constexpr int LDS_BYTES = 147456;
static_assert(MOE_TAB_OFF + 256 <= LDS_BYTES, "LDS map");

#define GAS __attribute__((address_space(1)))
#define LAS __attribute__((address_space(3)))
typedef unsigned short bf16;
typedef unsigned v4u __attribute__((ext_vector_type(4)));
typedef unsigned v2u __attribute__((ext_vector_type(2)));
typedef float f32x4 __attribute__((ext_vector_type(4)));
typedef GAS unsigned gu32;
#define RLX_AGENT __ATOMIC_RELAXED, __HIP_MEMORY_SCOPE_AGENT
#define LDS_WAIT() asm volatile("s_waitcnt lgkmcnt(0)" ::: "memory")
#define VM_WAIT() asm volatile("s_waitcnt vmcnt(0)" ::: "memory")
__device__ __forceinline__ unsigned f2bf(float f) { unsigned u = __builtin_bit_cast(unsigned, f); return (u + 0x7fffu + ((u >> 16) & 1u)) >> 16; }
__device__ __forceinline__ unsigned pk2(float lo, float hi) { return f2bf(lo) | (f2bf(hi) << 16); }
__device__ __forceinline__ float bflo(unsigned u) { return __uint_as_float(u << 16); }
__device__ __forceinline__ float bfhi(unsigned u) { return __uint_as_float(u & 0xffff0000u); }
__device__ __forceinline__ float bf2f(bf16 b) { return __uint_as_float((unsigned)b << 16); }
__device__ __forceinline__ float sigmoidf_(float x) { return 1.0f / (1.0f + __expf(-x)); }

#define XB_TMO      128
#define XB_XCNT(j)  (256  + 64 * (j))
#define XB_XSUB(j)  (1280 + 64 * (j))
#define XB_XGEN(j)  (2304 + 64 * (j))
#define XB_TOP      3328
#define XB_TOPGEN   3392
#define XCD_BAR_WORDS 3456
#define XB_SPIN_CAP (1u << 18)
__device__ __forceinline__ unsigned xb_ld(unsigned* p)              { return __hip_atomic_load(p, __ATOMIC_RELAXED, __HIP_MEMORY_SCOPE_AGENT); }
__device__ __forceinline__ unsigned xb_add(unsigned* p, unsigned v) { return __hip_atomic_fetch_add(p, v, __ATOMIC_RELAXED, __HIP_MEMORY_SCOPE_AGENT); }
__device__ __forceinline__ unsigned xb_xcc_id() { return (unsigned)__builtin_amdgcn_s_getreg((3 << 11) | 20) & 0xFu; }
#define XB_SPIN(cond, bar) do { unsigned _sp = 0; while (cond) { __builtin_amdgcn_s_sleep(1); \
    if ((++_sp & 255u) == 0u) { if (xb_ld(&(bar)[XB_TMO])) break; if (_sp > XB_SPIN_CAP) { atomicAdd(&(bar)[XB_TMO], 1u); break; } } } } while (0)
struct XcdBarrier { unsigned* bar; unsigned x; volatile LAS unsigned* st; };
__device__ __forceinline__ XcdBarrier xcd_barrier_post(unsigned* bar, volatile LAS unsigned* st) {
    XcdBarrier b; b.bar = bar; b.x = xb_xcc_id(); b.st = st;
    if (threadIdx.x == 0) (void)xb_add(&bar[XB_XCNT(b.x)], 1u);
    return b;
}
__device__ __forceinline__ void xcd_barrier_complete(unsigned* bar, unsigned x, unsigned& nloc, unsigned& nx) {
    const unsigned G = gridDim.x * gridDim.y * gridDim.z;
    unsigned sum, cnt, mine, sp = 0u;
    for (;;) {
        sum = 0u; cnt = 0u; mine = 0u;
#pragma unroll
        for (unsigned j = 0; j < 16; ++j) { const unsigned c = xb_ld(&bar[XB_XCNT(j)]); sum += c; cnt += (c > 0u) ? 1u : 0u; mine = (j == x) ? c : mine; }
        if (sum == G) break;
        __builtin_amdgcn_s_sleep(1);
        if ((++sp & 255u) == 0u) { if (xb_ld(&bar[XB_TMO])) break; if (sp > XB_SPIN_CAP) { atomicAdd(&bar[XB_TMO], 1u); break; } }
    }
    nloc = mine > 0u ? mine : 1u; nx = cnt > 0u ? cnt : 1u;
}
__device__ __forceinline__ void xcd_barrier(const XcdBarrier& b) {
    asm volatile("s_waitcnt vmcnt(0)" ::: "memory");
    __syncthreads();
    if (threadIdx.x == 0) {
        unsigned* bar = b.bar;
        __builtin_amdgcn_s_waitcnt(0);
        unsigned nloc = b.st[0], nx = b.st[1];
        if (nloc == 0u) { xcd_barrier_complete(bar, b.x, nloc, nx); b.st[0] = nloc; b.st[1] = nx; }
        const unsigned old = xb_add(&bar[XB_XSUB(b.x)], 1u);
        const unsigned gen = old / nloc;
        if (old + 1u == (gen + 1u) * nloc) {
            __builtin_amdgcn_fence(__ATOMIC_RELEASE, "agent");
            asm volatile("s_waitcnt vmcnt(0)" ::: "memory");
            const unsigned og = xb_add(&bar[XB_TOP], 1u);
            const unsigned tg = og / nx;
            if (og + 1u == (tg + 1u) * nx) xb_add(&bar[XB_TOPGEN], 1u);
            else XB_SPIN(xb_ld(&bar[XB_TOPGEN]) == tg, bar);
            __builtin_amdgcn_fence(__ATOMIC_ACQUIRE, "agent");
            xb_add(&bar[XB_XGEN(b.x)], 1u);
            asm volatile("s_waitcnt vmcnt(0)" ::: "memory");
        } else {
            XB_SPIN(xb_ld(&bar[XB_XGEN(b.x)]) == gen, bar);
            __builtin_amdgcn_fence(__ATOMIC_ACQUIRE, "agent");
            asm volatile("s_waitcnt vmcnt(0)" ::: "memory");
        }
    }
    __syncthreads();
}

__device__ __forceinline__ float shx(float v, int o, int lane) { return __int_as_float(__builtin_amdgcn_ds_bpermute((lane ^ o) << 2, __float_as_int(v))); }
__device__ __forceinline__ float wave_sum(float v, int lane) {
#pragma unroll
    for (int o = 1; o < 64; o <<= 1) v += shx(v, o, lane);
    return v;
}
__device__ __forceinline__ void transpose_item(const float* W, int ldw, int k0, int n0, bf16* WT, int ldk, int dst_row0, const float* kscale, LAS float* scr, int lane) {
#pragma unroll 8
    for (int i = 0; i < 32; ++i) { const int kk = 2 * i + (lane >> 5); float v = W[(size_t)(k0 + kk) * ldw + n0 + (lane & 31)]; if (kscale) v *= kscale[k0 + kk]; scr[kk * 33 + (lane & 31)] = v; }
    LDS_WAIT(); asm volatile("" ::: "memory");
    const int c = lane & 7;
#pragma unroll
    for (int j = 0; j < 4; ++j) { const int n = (lane >> 3) + 8 * j; const LAS float* s = scr + (8 * c) * 33 + n;
        v4u o; o.x = pk2(s[0 * 33], s[1 * 33]); o.y = pk2(s[2 * 33], s[3 * 33]); o.z = pk2(s[4 * 33], s[5 * 33]); o.w = pk2(s[6 * 33], s[7 * 33]);
        *(GAS v4u*)(WT + (size_t)(dst_row0 + n) * ldk + k0 + 8 * c) = o; }
    LDS_WAIT(); asm volatile("" ::: "memory");
}

struct Args { const float* in[31]; float* out; unsigned char* ws; int ph_lo, ph_hi, li, pad; };
typedef const __attribute__((address_space(4))) unsigned char* kaptr_t;
__device__ __forceinline__ kaptr_t ka_base() { kaptr_t p = (kaptr_t)__builtin_amdgcn_kernarg_segment_ptr(); asm volatile("" : "+s"(p)); return p; }
#define INP(k) (*(const float* const __attribute__((address_space(4)))*)(ka_base() + 8 * (k)))
#define OUTP() (*(float* const __attribute__((address_space(4)))*)(ka_base() + 8 * 31))
#define WSP() (*(unsigned char* const __attribute__((address_space(4)))*)(ka_base() + 8 * 32))
#define KA_INT(i) (*(const int __attribute__((address_space(4)))*)(ka_base() + 8 * 33 + 4 * (i)))

__device__ __forceinline__ void p0_weights(unsigned char* ws, LAS unsigned char* lds, int gw, int NGW, int wave, int lane) {
    LAS float* scr = (LAS float*)(lds + wave * 16384);
    bf16* WT_RKV = (bf16*)(ws + WS_WT_RKV); bf16* WT_LORA = (bf16*)(ws + WS_WT_LORA); bf16* WT_OUT = (bf16*)(ws + WS_WT_OUT); bf16* WT_KVQ = (bf16*)(ws + WS_WT_KVQ);
    bf16* WT_SBO = (bf16*)(ws + WS_WT_SBO); bf16* WT_GU = (bf16*)(ws + WS_WT_GU); bf16* WT_DN = (bf16*)(ws + WS_WT_DN);
    constexpr int I_RKV = 3 * 512, I_LORA = 32 + 32 + 80, I_OUT = 512, I_KV = 1024, I_Q = 512, I_SBO = 512, I_G = 32 * 128, I_U = 32 * 128, I_D = 32 * 128;
    constexpr int NITEMS = I_RKV + I_LORA + I_OUT + I_KV + I_Q + I_SBO + I_G + I_U + I_D;
    for (int it = gw; it < NITEMS; it += NGW) {
        int r = it;
        if (r < I_RKV) { const int m = r / 512, q = r % 512, kb = q / 32, nb = q % 32; transpose_item(INP(6) + (size_t)m * C * C, C, 64 * kb, 32 * nb, WT_RKV, C, m * C + 32 * nb, nullptr, scr, lane); continue; } r -= I_RKV;
        if (r < I_LORA) {
            if (r < 32) { const int kb = r / 2, nb = r % 2; transpose_item(INP(8), DW, 64 * kb, 32 * nb, WT_LORA, C, 32 * nb, nullptr, scr, lane); }
            else if (r < 64) { const int q = r - 32, kb = q / 2, nb = q % 2; transpose_item(INP(11), DA, 64 * kb, 32 * nb, WT_LORA, C, 256 + 32 * nb, nullptr, scr, lane); }
            else { const int q = r - 64, kb = q / 5, nb = q % 5; transpose_item(INP(13), DG, 64 * kb, 32 * nb, WT_LORA, C, 512 + 32 * nb, nullptr, scr, lane); }
            continue; } r -= I_LORA;
        if (r < I_OUT) { const int kb = r / 32, nb = r % 32; transpose_item(INP(20), C, 64 * kb, 32 * nb, WT_OUT, C, 32 * nb, nullptr, scr, lane); continue; } r -= I_OUT;
        if (r < I_KV) { const int kb = r / 64, nb = r % 64; transpose_item(INP(21), 2 * C, 64 * kb, 32 * nb, WT_KVQ, C, 32 * nb, INP(3), scr, lane); continue; } r -= I_KV;
        if (r < I_Q) { const int kb = r / 32, nb = r % 32; transpose_item(INP(22), C, 64 * kb, 32 * nb, WT_KVQ, C, 2 * C + 32 * nb, INP(1) + C, scr, lane); continue; } r -= I_Q;
        if (r < I_SBO) { const int kb = r / 32, nb = r % 32; transpose_item(INP(23), C, 64 * kb, 32 * nb, WT_SBO, C, 32 * nb, nullptr, scr, lane); continue; } r -= I_SBO;
        if (r < I_G) { const int le = r / 128, q = r % 128, kb = q / 8, nb = q % 8, f0 = 32 * nb; transpose_item(INP(28) + (size_t)le * C * FE, FE, 64 * kb, f0, WT_GU + (size_t)le * 512 * C, C, 256 * (f0 / 128) + (f0 % 128), nullptr, scr, lane); continue; } r -= I_G;
        if (r < I_U) { const int le = r / 128, q = r % 128, kb = q / 8, nb = q % 8, f0 = 32 * nb; transpose_item(INP(29) + (size_t)le * C * FE, FE, 64 * kb, f0, WT_GU + (size_t)le * 512 * C, C, 256 * (f0 / 128) + 128 + (f0 % 128), nullptr, scr, lane); continue; } r -= I_U;
        { const int le = r / 128, q = r % 128, kb = q / 32, nb = q % 32; transpose_item(INP(30) + (size_t)le * FE * C, C, 64 * kb, 32 * nb, WT_DN + (size_t)le * C * FE, FE, 32 * nb, nullptr, scr, lane); }
    }
    for (int it = gw * 64 + lane; it < 768 * 128; it += NGW * 64) { const int row = it >> 7, ch = it & 127;
        const bool valid = (row < 64) || (row >= 256 && row < 320) || (row >= 512 && row < 672);
        if (!valid) *(GAS v4u*)(WT_LORA + (size_t)row * C + ch * 8) = (v4u){0u, 0u, 0u, 0u}; }
}
__device__ __forceinline__ void load_row(const float* p, int lane, f32x4 (&v)[4]) {
#pragma unroll
    for (int j = 0; j < 4; ++j) v[j] = ((const GAS f32x4*)p)[64 * j + lane];
}
__device__ __forceinline__ float row_rs(const f32x4 (&v)[4], int lane) {
    float s = 0.f;
#pragma unroll
    for (int j = 0; j < 4; ++j) s += (v[j].x * v[j].x + v[j].y * v[j].y) + (v[j].z * v[j].z + v[j].w * v[j].w);
    return 1.0f / sqrtf(wave_sum(s, lane) * (1.0f / C) + RMS_EPS);
}
__device__ __forceinline__ void store_row_bf16(bf16* p, int lane, const f32x4 (&v)[4]) {
#pragma unroll
    for (int j = 0; j < 4; ++j) { v2u o; o.x = pk2(v[j].x, v[j].y); o.y = pk2(v[j].z, v[j].w); ((GAS v2u*)p)[64 * j + lane] = o; }
}
__device__ __forceinline__ void p0_rows(unsigned char* ws, int gw, int NGW, int lane) {
    const float* x = INP(0); const float* gain = INP(1); const float* mix = INP(5);
    f32x4 g[4]; load_row(gain, lane, g);
    for (int run = gw; run < M / 8; run += NGW) {
        const int r0 = run * 8;
        f32x4 prev[4];
        if ((r0 % SEQ) == 0) {
#pragma unroll
            for (int j = 0; j < 4; ++j) prev[j] = (f32x4){0.f, 0.f, 0.f, 0.f};
        } else { load_row(x + (size_t)(r0 - 1) * C, lane, prev); const float rs = row_rs(prev, lane);
#pragma unroll
            for (int j = 0; j < 4; ++j) prev[j] = prev[j] * rs * g[j]; }
        for (int rr = 0; rr < 8; ++rr) {
            const int row = r0 + rr;
            f32x4 hn[4]; load_row(x + (size_t)row * C, lane, hn); const float rs = row_rs(hn, lane);
#pragma unroll
            for (int j = 0; j < 4; ++j) hn[j] = hn[j] * rs * g[j];
#pragma unroll
            for (int i = 0; i < 6; ++i) { f32x4 o[4];
#pragma unroll
                for (int j = 0; j < 4; ++j) { const f32x4 mx = ((const GAS f32x4*)(mix + i * C))[64 * j + lane]; o[j] = hn[j] + (prev[j] - hn[j]) * mx; }
                bf16* dst = i < 2 ? (bf16*)OUTP() + (size_t)i * M * C : (i == 2 ? (bf16*)(ws + WS_B4) : (bf16*)(ws + WS_B1) + (size_t)(i - 3) * M * C);
                store_row_bf16(dst + (size_t)row * C, lane, o); }
#pragma unroll
            for (int j = 0; j < 4; ++j) prev[j] = hn[j];
        }
    }
}

template <int NN, int NGROUPS> struct SchedGrouped {
    static constexpr int K = C;
    const char* A0; size_t astride; const char* A2; const char* B; size_t bgroup;
    int G, c;
    __device__ __forceinline__ bool next(int i, pg8::Unit& u) const {
        const int L = i * G + c; constexpr int per = 64 * NN; if (L >= per * NGROUPS) return false;
        const int g = L / per, w = L % per; pg8::tile_map(w, 64, NN, u.pm, u.pn); u.aux = g; u.r0 = 0; u.cnt = 0; return true; }
    __device__ __forceinline__ const char* a_base(const pg8::Unit& u) const { const char* A = (A2 != nullptr && u.aux == 2) ? A2 : A0 + (size_t)u.aux * astride; return A + (size_t)u.pm * 256 * K * 2; }
    __device__ __forceinline__ const char* b_base(const pg8::Unit& u) const { return B + (size_t)u.aux * bgroup + (size_t)u.pn * 256 * K * 2; }
    __device__ __forceinline__ unsigned a_row_off(const pg8::Unit&, int) const { return 0u; }
};
template <int NN, int K, bool GATHER> struct SchedMoe {
    const char* A; const char* B; size_t bexp; const unsigned* list; volatile LAS int* tab; int G, c;
    __device__ __forceinline__ bool next(int i, pg8::Unit& u) const {
        const int L = i * G + c; const int tot = __builtin_amdgcn_readfirstlane(tab[48]) * NN; if (L >= tot) return false;
        u.pm = L / NN; u.pn = L % NN; int e = 0;
#pragma unroll
        for (int j = 0; j < 16; ++j) e += (u.pm >= tab[32 + j]) ? 1 : 0;
        e = __builtin_amdgcn_readfirstlane(e);
        u.aux = e; u.r0 = (u.pm - __builtin_amdgcn_readfirstlane(tab[16 + e])) * 256; u.cnt = __builtin_amdgcn_readfirstlane(tab[e]); return true; }
    __device__ __forceinline__ const char* a_base(const pg8::Unit& u) const { return GATHER ? A : A + (size_t)u.pm * 256 * K * 2; }
    __device__ __forceinline__ const char* b_base(const pg8::Unit& u) const { return B + (size_t)u.aux * bexp + (size_t)u.pn * 256 * K * 2; }
    __device__ __forceinline__ unsigned a_row_off(const pg8::Unit& u, int r) const {
        const int idx = u.r0 + r; unsigned tok = 0u;
        if (idx < u.cnt) tok = list[(size_t)u.aux * M + idx] >> 1;
        return tok * (unsigned)(K * 2); }
};

using pg8::f32x4;
using pg8::Unit;
__device__ __forceinline__ v4u pack8(f32x4 v0, f32x4 v1) { v4u w; w.x = pg8::cvt_pk_bf16(v0[0], v0[1]); w.y = pg8::cvt_pk_bf16(v0[2], v0[3]); w.z = pg8::cvt_pk_bf16(v1[0], v1[1]); w.w = pg8::cvt_pk_bf16(v1[2], v1[3]); return w; }

struct EpiLora {
    static constexpr bool PERM = true;
    bf16* LW;
    __device__ __forceinline__ void operator()(const f32x4 (&acc)[2][2][4][2], const Unit& u, int wr, int wc, int fr, int fq) const {
        { int l_; asm volatile("v_mbcnt_lo_u32_b32 %0, -1, 0\n\tv_mbcnt_hi_u32_b32 %0, -1, %0" : "=v"(l_)); fr = l_ & 15; fq = l_ >> 4; }
        const int g = u.aux, width = g == 2 ? DG : DW; bf16* out = LW + (size_t)g * (1u << 20);
        const int row0 = u.pm * 256 + wr * 64 + fr;
#pragma unroll
        for (int bj = 0; bj < 2; ++bj) { const int col0 = bj * 128 + wc * 32 + 8 * fq; if (col0 < width) {
#pragma unroll
            for (int ai = 0; ai < 2; ++ai)
#pragma unroll
                for (int m = 0; m < 4; ++m) { f32x4 v0 = acc[ai][bj][m][0], v1 = acc[ai][bj][m][1];
                    if (g == 0) {
#pragma unroll
                        for (int q = 0; q < 4; ++q) { v0[q] = tanhf(v0[q]); v1[q] = tanhf(v1[q]); } }
                    else if (g == 2) {
#pragma unroll
                        for (int q = 0; q < 4; ++q) { v0[q] = sigmoidf_(v0[q]); v1[q] = sigmoidf_(v1[q]); } }
                    *(GAS v4u*)(out + (size_t)(row0 + ai * 128 + m * 16) * width + col0) = pack8(v0, v1); } } }
    }
};
struct EpiSplit3 {
    static constexpr bool PERM = true;
    bf16* O0; bool bycol;
    __device__ __forceinline__ void operator()(const f32x4 (&acc)[2][2][4][2], const Unit& u, int wr, int wc, int fr, int fq) const {
        { int l_; asm volatile("v_mbcnt_lo_u32_b32 %0, -1, 0\n\tv_mbcnt_hi_u32_b32 %0, -1, %0" : "=v"(l_)); fr = l_ & 15; fq = l_ >> 4; }
        const int g = bycol ? (u.pn >> 2) : u.aux, pn = bycol ? (u.pn & 3) : u.pn; bf16* out = O0 + (size_t)g * ((size_t)M * C);
        const int row0 = u.pm * 256 + wr * 64 + fr, col0 = pn * 256 + wc * 32 + 8 * fq;
#pragma unroll
        for (int ai = 0; ai < 2; ++ai)
#pragma unroll
            for (int m = 0; m < 4; ++m)
#pragma unroll
                for (int bj = 0; bj < 2; ++bj) *(GAS v4u*)(out + (size_t)(row0 + ai * 128 + m * 16) * C + col0 + bj * 128) = pack8(acc[ai][bj][m][0], acc[ai][bj][m][1]);
    }
};
struct EpiResid {
    static constexpr bool PERM = false;
    const float* base; float* out;
    __device__ __forceinline__ void operator()(const f32x4 (&acc)[2][2][4][2], const Unit& u, int wr, int wc, int fr, int fq) const {
        { int l_; asm volatile("v_mbcnt_lo_u32_b32 %0, -1, 0\n\tv_mbcnt_hi_u32_b32 %0, -1, %0" : "=v"(l_)); fr = l_ & 15; fq = l_ >> 4; }
        const int row0 = u.pm * 256 + wr * 64 + fr, col0 = u.pn * 256 + wc * 32 + 4 * fq;
#pragma unroll
        for (int ai = 0; ai < 2; ++ai)
#pragma unroll
            for (int m = 0; m < 4; ++m) { const size_t off = (size_t)(row0 + ai * 128 + m * 16) * C + col0;
#pragma unroll
                for (int bj = 0; bj < 2; ++bj)
#pragma unroll
                    for (int n = 0; n < 2; ++n) { const f32x4 b = *(const GAS f32x4*)(base + off + bj * 128 + n * 16); *(GAS f32x4*)(out + off + bj * 128 + n * 16) = b + acc[ai][bj][m][n]; } }
    }
};
struct EpiGU {
    static constexpr bool PERM = true;
    bf16* HID; const float* wl;
    __device__ __forceinline__ void operator()(const f32x4 (&acc)[2][2][4][2], const Unit& u, int wr, int wc, int fr, int fq) const {
        { int l_; asm volatile("v_mbcnt_lo_u32_b32 %0, -1, 0\n\tv_mbcnt_hi_u32_b32 %0, -1, %0" : "=v"(l_)); fr = l_ & 15; fq = l_ >> 4; }
        const int e = u.aux, cnt = u.cnt, base = u.r0, r0 = wr * 64 + fr, col0 = u.pn * 128 + wc * 32 + 8 * fq;
#pragma unroll
        for (int ai = 0; ai < 2; ++ai)
#pragma unroll
            for (int m = 0; m < 4; ++m) { const int r = r0 + ai * 128 + m * 16, idx = base + r; float w = 0.f; if (idx < cnt) w = wl[(size_t)e * M + idx];
                f32x4 h0, h1;
#pragma unroll
                for (int q = 0; q < 4; ++q) { const float g0 = acc[ai][0][m][0][q], g1 = acc[ai][0][m][1][q];
                    h0[q] = g0 * sigmoidf_(g0) * acc[ai][1][m][0][q] * w; h1[q] = g1 * sigmoidf_(g1) * acc[ai][1][m][1][q] * w; }
                *(GAS v4u*)(HID + (size_t)(u.pm * 256 + r) * FE + col0) = pack8(h0, h1);
                asm volatile("" ::: "memory"); }
    }
};
struct EpiDown {
    static constexpr bool PERM = true;
    bf16* EO; const unsigned* list;
    __device__ __forceinline__ void operator()(const f32x4 (&acc)[2][2][4][2], const Unit& u, int wr, int wc, int fr, int fq) const {
        { int l_; asm volatile("v_mbcnt_lo_u32_b32 %0, -1, 0\n\tv_mbcnt_hi_u32_b32 %0, -1, %0" : "=v"(l_)); fr = l_ & 15; fq = l_ >> 4; }
        const int e = u.aux, cnt = u.cnt, base = u.r0, r0 = wr * 64 + fr, col0 = u.pn * 256 + wc * 32 + 8 * fq;
#pragma unroll
        for (int ai = 0; ai < 2; ++ai)
#pragma unroll
            for (int m = 0; m < 4; ++m) { const int idx = base + r0 + ai * 128 + m * 16;
                if (idx < cnt) { const unsigned ent = list[(size_t)e * M + idx]; bf16* o = EO + ((size_t)(ent & 1u) * M + (ent >> 1)) * C + col0;
#pragma unroll
                    for (int bj = 0; bj < 2; ++bj) *(GAS v4u*)(o + bj * 128) = pack8(acc[ai][bj][m][0], acc[ai][bj][m][1]); }
                asm volatile("" ::: "memory"); }
    }
};

__device__ __forceinline__ void scan_naive(unsigned char* ws, LAS unsigned char* lds, int tid) {
    const int lane = tid & 63;
    const bf16* Rb = (const bf16*)(ws + WS_B1); const bf16* Kb = (const bf16*)(ws + WS_B2); const bf16* Vb = (const bf16*)(ws + WS_B3);
    const bf16* LW = (const bf16*)(ws + WS_LW); const bf16* LA = (const bf16*)(ws + WS_LA);
    float* Y = OUTP(); float* RK = (float*)(ws + WS_RK);
    LAS float* sR = (LAS float*)lds; LAS float* sK = sR + 4096; LAS float* sV = sK + 4096; LAS float* sA = sV + 4096; LAS float* sB = sA + 4096; LAS float* sD = sB + 4096;
    LAS float* sW2 = sD + 4096; LAS float* sA2 = sW2 + 4096;
    for (int unit = blockIdx.x; unit < BATCH * NH; unit += gridDim.x) {
        const int b = unit / NH, h = unit % NH;
        __syncthreads();
        for (int e = tid; e < 4096; e += 512) { const int d = e >> 6, j = e & 63; sW2[e] = INP(9)[(size_t)d * C + h * HD + j]; sA2[e] = INP(12)[(size_t)d * C + h * HD + j]; }
        __syncthreads();
        const int pt = tid >> 3, cq = tid & 7, c0 = h * HD + cq * 8;
        const int si = tid >> 3, jq = tid & 7;
        float S[8];
#pragma unroll
        for (int q = 0; q < 8; ++q) S[q] = 0.f;
        float w0v[8], a0v[8], kkv[8], kav[8], rkv[8];
#pragma unroll
        for (int q = 0; q < 8; ++q) { w0v[q] = INP(7)[c0 + q]; a0v[q] = INP(10)[c0 + q]; kkv[q] = INP(15)[c0 + q]; kav[q] = INP(16)[c0 + q]; rkv[q] = INP(17)[c0 + q]; }
        for (int blk = 0; blk < SEQ / 64; ++blk) {
            const size_t row = (size_t)b * SEQ + blk * 64 + pt;
            {
                const v4u r4 = *(const GAS v4u*)(Rb + row * C + c0), k4 = *(const GAS v4u*)(Kb + row * C + c0), v4 = *(const GAS v4u*)(Vb + row * C + c0);
                float r[8], k[8], v[8];
                r[0] = bflo(r4.x); r[1] = bfhi(r4.x); r[2] = bflo(r4.y); r[3] = bfhi(r4.y); r[4] = bflo(r4.z); r[5] = bfhi(r4.z); r[6] = bflo(r4.w); r[7] = bfhi(r4.w);
                k[0] = bflo(k4.x); k[1] = bfhi(k4.x); k[2] = bflo(k4.y); k[3] = bfhi(k4.y); k[4] = bflo(k4.z); k[5] = bfhi(k4.z); k[6] = bflo(k4.w); k[7] = bfhi(k4.w);
                v[0] = bflo(v4.x); v[1] = bfhi(v4.x); v[2] = bflo(v4.y); v[3] = bfhi(v4.y); v[4] = bflo(v4.z); v[5] = bfhi(v4.z); v[6] = bflo(v4.w); v[7] = bfhi(v4.w);
                float wp[8], ap[8];
#pragma unroll
                for (int q = 0; q < 8; ++q) { wp[q] = w0v[q]; ap[q] = a0v[q]; }
                for (int d = 0; d < 64; ++d) { const float lw = bf2f(LW[row * DW + d]), la = bf2f(LA[row * DA + d]);
#pragma unroll
                    for (int q = 0; q < 8; ++q) { wp[q] += lw * sW2[d * 64 + cq * 8 + q]; ap[q] += la * sA2[d * 64 + cq * 8 + q]; } }
                float kk[8], ss = 0.f, rks = 0.f;
#pragma unroll
                for (int q = 0; q < 8; ++q) { kk[q] = k[q] * kkv[q]; ss += kk[q] * kk[q]; }
                ss += shx(ss, 1, lane); ss += shx(ss, 2, lane); ss += shx(ss, 4, lane);
                const float inv = 1.0f / fmaxf(sqrtf(ss), 1e-12f);
#pragma unroll
                for (int q = 0; q < 8; ++q) { const float ag = sigmoidf_(ap[q]); const float kn = kk[q] * inv; const float kp = k[q] * (1.0f + (ag - 1.0f) * kav[q]);
                    const float lw = -0.6065306597126334f * sigmoidf_(wp[q]);
                    const int o = pt * 64 + cq * 8 + q;
                    sR[o] = r[q]; sK[o] = kp; sV[o] = v[q]; sA[o] = -kn; sB[o] = kn * ag; sD[o] = __expf(lw); rks += r[q] * kp * rkv[q]; }
                rks += shx(rks, 1, lane); rks += shx(rks, 2, lane); rks += shx(rks, 4, lane);
                if (cq == 0) RK[row * NH + h] = rks;
            }
            __syncthreads();
            for (int t = 0; t < 64; ++t) {
                const LAS f32x4* pa = (const LAS f32x4*)(sA + t * 64 + jq * 8); const LAS f32x4* pb = (const LAS f32x4*)(sB + t * 64 + jq * 8);
                const LAS f32x4* pd = (const LAS f32x4*)(sD + t * 64 + jq * 8); const LAS f32x4* pk = (const LAS f32x4*)(sK + t * 64 + jq * 8);
                const LAS f32x4* pr = (const LAS f32x4*)(sR + t * 64 + jq * 8);
                const f32x4 a0 = pa[0], a1 = pa[1], b0 = pb[0], b1 = pb[1], d0 = pd[0], d1 = pd[1], k0 = pk[0], k1 = pk[1], r0 = pr[0], r1 = pr[1];
                const float vi = sV[t * 64 + si];
                float sa = 0.f;
#pragma unroll
                for (int q = 0; q < 4; ++q) { sa += S[q] * a0[q]; sa += S[4 + q] * a1[q]; }
                sa += shx(sa, 1, lane); sa += shx(sa, 2, lane); sa += shx(sa, 4, lane);
                float y = 0.f;
#pragma unroll
                for (int q = 0; q < 4; ++q) { S[q] = S[q] * d0[q] + sa * b0[q] + vi * k0[q]; S[4 + q] = S[4 + q] * d1[q] + sa * b1[q] + vi * k1[q]; y += S[q] * r0[q]; y += S[4 + q] * r1[q]; }
                y += shx(y, 1, lane); y += shx(y, 2, lane); y += shx(y, 4, lane);
                if (jq == 0) Y[((size_t)b * SEQ + blk * 64 + t) * C + h * HD + si] = y;
            }
            __syncthreads();
        }
    }
}
__device__ __forceinline__ void post_scan(unsigned char* ws, int gw, int NGW, int lane) {
    const float* Y = OUTP(); const float* RK = (const float*)(ws + WS_RK); const bf16* Vb = (const bf16*)(ws + WS_B3); const bf16* LG = (const bf16*)(ws + WS_LG);
    bf16* YG = (bf16*)(ws + WS_B0); const float* g2 = INP(14); const float* lnw = INP(18); const float* lnb = INP(19);
    for (int it = gw; it < M * NH; it += NGW) {
        const int row = it / NH, h = it % NH, c = h * HD + lane;
        const float y = Y[(size_t)row * C + c];
        const float mu = wave_sum(y, lane) * (1.0f / HD); const float d = y - mu; const float var = wave_sum(d * d, lane) * (1.0f / HD);
        float o = d * (1.0f / sqrtf(var + GN_EPS)) * lnw[c] + lnb[c];
        o += RK[(size_t)row * NH + h] * bf2f(Vb[(size_t)row * C + c]);
        float g = 0.f;
        for (int dd = 0; dd < DG; ++dd) g += bf2f(LG[(size_t)row * DG + dd]) * g2[(size_t)dd * C + c];
        YG[(size_t)row * C + c] = (bf16)f2bf(o * g);
    }
}

__device__ __forceinline__ void router_rows(unsigned char* ws, LAS unsigned char* lds, int layer, int gw, int NGW, int lane, int tid) {
    const float* Hh = OUTP(); const float* gain = INP(2) + layer * C; bf16* XN = (bf16*)(ws + WS_B1);
    const float* wg = INP(24) + (size_t)layer * C * 4; const float* bg = INP(25) + layer * 4; const float* wi = INP(26) + (size_t)layer * C * 16; const float* bi = INP(27) + layer * 16;
    unsigned* cnt = (unsigned*)(ws + WS_CTL) + CW_CNT + layer * 16 * 64; unsigned* list = (unsigned*)(ws + WS_LIST); float* wl = (float*)(ws + WS_WL);
    LAS float* sWg = (LAS float*)lds; LAS float* sWi = sWg + C * 4;
    __syncthreads();
    for (int e = tid; e < C * 4; e += 512) sWg[e] = wg[e];
    for (int e = tid; e < C * 16; e += 512) sWi[e] = wi[e];
    __syncthreads();
    f32x4 g[4]; load_row(gain, lane, g);
    for (int row = gw; row < M; row += NGW) {
        f32x4 v[4]; load_row(Hh + (size_t)row * C, lane, v); const float rs = row_rs(v, lane);
#pragma unroll
        for (int j = 0; j < 4; ++j) v[j] = v[j] * rs * g[j];
        store_row_bf16(XN + (size_t)row * C, lane, v);
        float gl[4] = {0.f, 0.f, 0.f, 0.f};
        const LAS unsigned char* pWg = (const LAS unsigned char*)sWg + lane * 64;
#pragma unroll
        for (int j = 0; j < 4; ++j)
#pragma unroll
            for (int q = 0; q < 4; ++q) { const f32x4 w = *(const LAS f32x4*)(pWg + j * 4096 + q * 16); const float xv = v[j][q]; gl[0] += xv * w.x; gl[1] += xv * w.y; gl[2] += xv * w.z; gl[3] += xv * w.w; }
#pragma unroll
        for (int q = 0; q < 4; ++q) gl[q] = wave_sum(gl[q], lane) + bg[q];
        int gi = 0; float gm = gl[0];
#pragma unroll
        for (int q = 1; q < 4; ++q) if (gl[q] > gm) { gm = gl[q]; gi = q; }
        float gden = 0.f;
#pragma unroll
        for (int q = 0; q < 4; ++q) gden += __expf(gl[q] - gm);
        const float gval = 1.0f / gden;
        float il[4] = {0.f, 0.f, 0.f, 0.f};
        const LAS unsigned char* pWi = (const LAS unsigned char*)sWi + lane * 256 + gi * 16;
#pragma unroll
        for (int j = 0; j < 4; ++j)
#pragma unroll
            for (int q = 0; q < 4; ++q) { const f32x4 w = *(const LAS f32x4*)(pWi + j * 16384 + q * 64); const float xv = v[j][q]; il[0] += xv * w.x; il[1] += xv * w.y; il[2] += xv * w.z; il[3] += xv * w.w; }
#pragma unroll
        for (int q = 0; q < 4; ++q) il[q] = wave_sum(il[q], lane) + bi[gi * 4 + q];
        int i0 = 0; float m0 = il[0];
#pragma unroll
        for (int q = 1; q < 4; ++q) if (il[q] > m0) { m0 = il[q]; i0 = q; }
        int i1 = -1; float m1 = -INFINITY;
#pragma unroll
        for (int q = 0; q < 4; ++q) if (q != i0 && il[q] > m1) { m1 = il[q]; i1 = q; }
        const float e1 = __expf(m1 - m0); const float w0 = gval / (1.0f + e1), w1 = gval * e1 / (1.0f + e1);
        if (lane == 0) {
            const int ex0 = gi * 4 + i0, ex1 = gi * 4 + i1;
            const unsigned p0 = atomicAdd(cnt + ex0 * 64, 1u); list[(size_t)ex0 * M + p0] = (unsigned)row * 2u; wl[(size_t)ex0 * M + p0] = w0;
            const unsigned p1 = atomicAdd(cnt + ex1 * 64, 1u); list[(size_t)ex1 * M + p1] = (unsigned)row * 2u + 1u; wl[(size_t)ex1 * M + p1] = w1;
        }
    }
}
__device__ __forceinline__ void moe_table(unsigned char* ws, volatile LAS int* tab, int layer, int tid) {
    __syncthreads();
    if (tid == 0) { const unsigned* cnt = (const unsigned*)(ws + WS_CTL) + CW_CNT + layer * 16 * 64; int t = 0;
#pragma unroll 1
        for (int e = 0; e < 16; ++e) { const int c = (int)__hip_atomic_load(cnt, RLX_AGENT); cnt += 64; tab[e] = c; tab[16 + e] = t; t += (c + 255) >> 8; tab[32 + e] = t; }
        tab[48] = t; }
    __syncthreads();
}
__device__ __forceinline__ void combine_rows(unsigned char* ws, int mode, int gw, int NGW, int lane) {
    float* Hh = OUTP(); const bf16* E0 = (const bf16*)(ws + WS_B2); const bf16* E1 = (const bf16*)(ws + WS_B3); bf16* XN2 = (bf16*)(ws + WS_B0);
    f32x4 g[4]; load_row(INP(4), lane, g);
    for (int row = gw; row < M; row += NGW) {
        f32x4 v[4]; load_row(Hh + (size_t)row * C, lane, v);
#pragma unroll
        for (int j = 0; j < 4; ++j) { const v2u e0 = ((const GAS v2u*)(E0 + (size_t)row * C))[64 * j + lane], e1 = ((const GAS v2u*)(E1 + (size_t)row * C))[64 * j + lane];
            v[j].x += bflo(e0.x) + bflo(e1.x); v[j].y += bfhi(e0.x) + bfhi(e1.x); v[j].z += bflo(e0.y) + bflo(e1.y); v[j].w += bfhi(e0.y) + bfhi(e1.y); }
        const float rs = row_rs(v, lane);
        if (mode == 0) {
#pragma unroll
            for (int j = 0; j < 4; ++j) ((GAS f32x4*)(Hh + (size_t)row * C))[64 * j + lane] = v[j];
#pragma unroll
            for (int j = 0; j < 4; ++j) v[j] = v[j] * rs;
            store_row_bf16(XN2 + (size_t)row * C, lane, v);
        } else {
#pragma unroll
            for (int j = 0; j < 4; ++j) ((GAS f32x4*)(Hh + (size_t)row * C))[64 * j + lane] = v[j] * rs * g[j];
        }
    }
}
__device__ __forceinline__ void attn_naive(unsigned char* ws, int gw, int NGW, int lane) {
    const bf16* Kb = (const bf16*)(ws + WS_B1); const bf16* Vb = (const bf16*)(ws + WS_B2); const bf16* Qb = (const bf16*)(ws + WS_B3); bf16* Ob = (bf16*)(ws + WS_B0);
    for (int unit = gw; unit < BATCH * NH * (SEQ / 64); unit += NGW) {
        const int qb = unit % (SEQ / 64), bh = unit / (SEQ / 64), b = bh / NH, h = bh % NH;
        const int t0 = qb * 64, t = t0 + lane; const size_t rowq = (size_t)b * SEQ + t;
        float q[64], o[64];
#pragma unroll
        for (int c = 0; c < 8; ++c) { const v4u w = *(const GAS v4u*)(Qb + rowq * C + h * HD + c * 8);
            q[c * 8 + 0] = bflo(w.x) * 0.125f; q[c * 8 + 1] = bfhi(w.x) * 0.125f; q[c * 8 + 2] = bflo(w.y) * 0.125f; q[c * 8 + 3] = bfhi(w.y) * 0.125f;
            q[c * 8 + 4] = bflo(w.z) * 0.125f; q[c * 8 + 5] = bfhi(w.z) * 0.125f; q[c * 8 + 6] = bflo(w.w) * 0.125f; q[c * 8 + 7] = bfhi(w.w) * 0.125f; }
#pragma unroll
        for (int c = 0; c < 64; ++c) o[c] = 0.f;
        float suffix = 0.f;
        for (int s = t0 + 62; s >= 0; --s) {
            const bool valid = s < t;
            if (s < t0 && __all(suffix > SB_EXIT)) break;
            const bf16* kp = Kb + ((size_t)b * SEQ + s) * C + h * HD; const bf16* vp = Vb + ((size_t)b * SEQ + s) * C + h * HD;
            float z = 0.f;
#pragma unroll
            for (int c = 0; c < 8; ++c) { const v4u w = *(const GAS v4u*)(kp + c * 8);
                z += q[c * 8 + 0] * bflo(w.x) + q[c * 8 + 1] * bfhi(w.x) + q[c * 8 + 2] * bflo(w.y) + q[c * 8 + 3] * bfhi(w.y) + q[c * 8 + 4] * bflo(w.z) + q[c * 8 + 5] * bfhi(w.z) + q[c * 8 + 6] * bflo(w.w) + q[c * 8 + 7] * bfhi(w.w); }
            const float sp = fmaxf(z, 0.f) + log1pf(__expf(-fabsf(z)));
            const float att = valid ? __expf(z - sp - suffix) : 0.f;
            suffix += valid ? sp : 0.f;
#pragma unroll
            for (int c = 0; c < 8; ++c) { const v4u w = *(const GAS v4u*)(vp + c * 8);
                o[c * 8 + 0] += att * bflo(w.x); o[c * 8 + 1] += att * bfhi(w.x); o[c * 8 + 2] += att * bflo(w.y); o[c * 8 + 3] += att * bfhi(w.y);
                o[c * 8 + 4] += att * bflo(w.z); o[c * 8 + 5] += att * bfhi(w.z); o[c * 8 + 6] += att * bflo(w.w); o[c * 8 + 7] += att * bfhi(w.w); }
        }
#pragma unroll
        for (int c = 0; c < 8; ++c) { v4u w; w.x = pk2(o[c * 8 + 0], o[c * 8 + 1]); w.y = pk2(o[c * 8 + 2], o[c * 8 + 3]); w.z = pk2(o[c * 8 + 4], o[c * 8 + 5]); w.w = pk2(o[c * 8 + 6], o[c * 8 + 7]);
            *(GAS v4u*)(Ob + rowq * C + h * HD + c * 8) = w; }
    }
}

__global__ void __launch_bounds__(NWAVES * 64, 2) yoco_fwd(Args args) {
    extern __shared__ __attribute__((aligned(16))) unsigned char lds_raw[];
    LAS unsigned char* lds = (LAS unsigned char*)lds_raw;
    const int G = gridDim.x; const int bx = blockIdx.x;
    int wave = __builtin_amdgcn_readfirstlane(threadIdx.x >> 6); asm volatile("" : "+s"(wave));
#define IDS() int lane; asm volatile("v_mbcnt_lo_u32_b32 %0, -1, 0\n\tv_mbcnt_hi_u32_b32 %0, -1, %0" : "=v"(lane)); const int tid = wave * 64 + lane; (void)tid; \
    const int vcu = (G % 8 == 0) ? (bx % 8) * (G / 8) + bx / 8 : bx; const int gw = vcu * NWAVES + wave, NGW = G * NWAVES; (void)lane; (void)gw; (void)NGW;
    unsigned char* ws = WSP();
    volatile LAS unsigned* MISC = (volatile LAS unsigned*)(lds + MISC_OFF);
    volatile LAS int* tab = (volatile LAS int*)(lds + MOE_TAB_OFF);
    for (int u = threadIdx.x; u < (LDS_BYTES - LDSCTL_OFF) / 4; u += NWAVES * 64) ((LAS unsigned*)(lds + LDSCTL_OFF))[u] = 0u;
    __syncthreads();
    XcdBarrier bar; bar.bar = (unsigned*)(ws + WS_CTL) + CW_BAR; bar.x = 0; bar.st = nullptr;
    if (N_LAUNCHES == 1) bar = xcd_barrier_post((unsigned*)(ws + WS_CTL) + CW_BAR, MISC + 8);
    const int lo = KA_INT(0), hi = KA_INT(1);
#define IN(k) (lo <= (k) && (k) < hi)
#define SEAM(k) do { if (IN(k) && IN((k) + 1)) xcd_barrier(bar); } while (0)

    if (IN(0)) { IDS(); p0_weights(ws, lds, gw, NGW, wave, lane); p0_rows(ws, gw, NGW, lane); }
    SEAM(0);
    if (IN(1)) {
        SchedGrouped<1, 3> S{(const char*)(ws + WS_B1), (size_t)(WS_B2 - WS_B1), nullptr, (const char*)(ws + WS_WT_LORA), (size_t)256 * C * 2, G, bx};
        EpiLora E{(bf16*)(ws + WS_LW)};
        pg8::gemm_phase<EpiLora, SchedGrouped<1, 3>, true, false, C>(lds, S, E, wave);
    }
    SEAM(1);
    if (IN(2)) {
        SchedGrouped<4, 3> S{(const char*)OUTP(), (size_t)M * C * 2, (const char*)(ws + WS_B4), (const char*)(ws + WS_WT_RKV), (size_t)C * C * 2, G, bx};
        EpiSplit3 E{(bf16*)(ws + WS_B1), false};
        pg8::gemm_phase<EpiSplit3, SchedGrouped<4, 3>, true, false, C>(lds, S, E, wave);
    }
    SEAM(2);
    if (IN(3)) { IDS(); scan_naive(ws, lds, tid); }
    SEAM(3);
    if (IN(4)) { IDS(); post_scan(ws, gw, NGW, lane); }
    SEAM(4);
    if (IN(5)) {
        SchedGrouped<4, 1> S{(const char*)(ws + WS_B0), 0, nullptr, (const char*)(ws + WS_WT_OUT), 0, G, bx};
        EpiResid E{INP(0), OUTP()};
        pg8::gemm_phase<EpiResid, SchedGrouped<4, 1>, true, false, C>(lds, S, E, wave);
    }
    SEAM(5);
#pragma unroll 1
    for (int layer = 0; layer < 2; ++layer) {
        const int pb = layer == 0 ? 6 : 13;
        if (IN(pb)) { IDS(); router_rows(ws, lds, layer, gw, NGW, lane, tid); }
        SEAM(pb);
        if (IN(pb + 1)) {
            { IDS(); moe_table(ws, tab, layer, tid); }
            SchedMoe<2, C, true> S{(const char*)(ws + WS_B1), (const char*)(ws + WS_WT_GU) + (size_t)layer * 16 * 512 * C * 2, (size_t)512 * C * 2, (const unsigned*)(ws + WS_LIST), tab, G, bx};
            EpiGU E{(bf16*)(ws + WS_HID), (const float*)(ws + WS_WL)};
            pg8::gemm_phase<EpiGU, SchedMoe<2, C, true>, true, true, C>(lds, S, E, wave);
        }
        SEAM(pb + 1);
        if (IN(pb + 2)) {
            { IDS(); moe_table(ws, tab, layer, tid); }
            SchedMoe<4, FE, false> S{(const char*)(ws + WS_HID), (const char*)(ws + WS_WT_DN) + (size_t)layer * 16 * C * FE * 2, (size_t)C * FE * 2, (const unsigned*)(ws + WS_LIST), tab, G, bx};
            EpiDown E{(bf16*)(ws + WS_B2), (const unsigned*)(ws + WS_LIST)};
            pg8::gemm_phase<EpiDown, SchedMoe<4, FE, false>, true, false, FE>(lds, S, E, wave);
        }
        SEAM(pb + 2);
        if (layer == 0) {
            if (IN(9)) { IDS(); combine_rows(ws, 0, gw, NGW, lane); }
            SEAM(9);
            if (IN(10)) {
                SchedGrouped<12, 1> S{(const char*)(ws + WS_B0), 0, nullptr, (const char*)(ws + WS_WT_KVQ), 0, G, bx};
                EpiSplit3 E{(bf16*)(ws + WS_B1), true};
                pg8::gemm_phase<EpiSplit3, SchedGrouped<12, 1>, true, false, C>(lds, S, E, wave);
            }
            SEAM(10);
            if (IN(11)) { IDS(); attn_naive(ws, gw, NGW, lane); }
            SEAM(11);
            if (IN(12)) {
                SchedGrouped<4, 1> S{(const char*)(ws + WS_B0), 0, nullptr, (const char*)(ws + WS_WT_SBO), 0, G, bx};
                EpiResid E{OUTP(), OUTP()};
                pg8::gemm_phase<EpiResid, SchedGrouped<4, 1>, true, false, C>(lds, S, E, wave);
            }
            SEAM(12);
        }
    }
    if (IN(16)) { IDS(); combine_rows(ws, 1, gw, NGW, lane); }
#undef IN
#undef SEAM
}

extern "C" void kernel_launch(void* const* d_in, const int* in_sizes, int n_in, void* d_out, int out_size, void* d_ws, size_t ws_size, hipStream_t stream) {
    static int grid = 0;
    if (grid == 0) {
        if (n_in != 31 || in_sizes[0] != M * C || out_size != M * C || ws_size < WS_END) { fprintf(stderr, "kernel_launch: unexpected shapes (n_in %d, in0 %d, out %d, ws %zu); nothing launched\n", n_in, n_in > 0 ? in_sizes[0] : -1, out_size, ws_size); grid = -1; return; }
        int dev = 0, cus = 0, per_cu = 0;
        if (hipGetDevice(&dev) != hipSuccess || hipDeviceGetAttribute(&cus, hipDeviceAttributeMultiprocessorCount, dev) != hipSuccess) { grid = -1; return; }
        if (hipFuncSetAttribute((const void*)yoco_fwd, hipFuncAttributeMaxDynamicSharedMemorySize, LDS_BYTES) != hipSuccess) { fprintf(stderr, "kernel_launch: hipFuncSetAttribute failed\n"); grid = -1; return; }
        if (hipOccupancyMaxActiveBlocksPerMultiprocessor(&per_cu, (const void*)yoco_fwd, NWAVES * 64, LDS_BYTES) != hipSuccess || per_cu < 1) fprintf(stderr, "kernel_launch: occupancy query reports %d\n", per_cu);
        (void)hipGetLastError();
        grid = cus;
    }
    if (grid < 0) return;
    if (hipMemsetAsync((char*)d_ws + WS_CTL, 0, CTL_ZERO_BYTES, stream) != hipSuccess) return;
    Args a{};
    for (int i = 0; i < 31; ++i) a.in[i] = (const float*)d_in[i];
    a.out = (float*)d_out; a.ws = (unsigned char*)d_ws;
    for (int li = 0; li < N_LAUNCHES; ++li) {
        a.ph_lo = (N_LAUNCHES == 1) ? 0 : li; a.ph_hi = (N_LAUNCHES == 1) ? NPHASE : li + 1; a.li = li;
        hipLaunchKernelGGL(yoco_fwd, dim3(grid), dim3(NWAVES * 64), LDS_BYTES, stream, a);
        const hipError_t le = hipPeekAtLastError();
        if (le != hipSuccess) { fprintf(stderr, "kernel_launch: launch %d failed: %s\n", li, hipGetErrorName(le)); break; }
    }
}
```

```cpp
#include <hip/hip_runtime.h>
#include <cstdio>
#include <cstdint>

#ifndef MK_N_LAUNCHES
#define MK_N_LAUNCHES 1
#endif

namespace pg8 {
#define PG8_LAS __attribute__((address_space(3)))
typedef unsigned short bf16_t;
typedef short bf16x8 __attribute__((ext_vector_type(8)));
typedef float f32x4 __attribute__((ext_vector_type(4)));
typedef unsigned u32x4 __attribute__((ext_vector_type(4)));
constexpr int BM = 256, BK = 64, HALF = 128, HTB = HALF * BK * 2, STAGE_BYTES = 8 * HTB, NXCD = 8, WGM = 8;

__host__ __device__ __forceinline__ int lds_byte(int r, int c) { const int st = (r >> 4) * 2 + (c >> 5), rr = r & 15, cc = c & 31, ob = rr * 64 + cc * 2; return st * 1024 + (ob ^ (((ob >> 9) & 1) << 5)); }
__host__ __device__ __forceinline__ void stage_rc(int b, int& R, int& C) { const int st = b / 1024, sb = b % 1024, swz = sb ^ (((sb >> 9) & 1) << 5); R = (st >> 1) * 16 + swz / 64; C = (st & 1) * 32 + (swz % 64) / 2; }
__host__ __device__ __forceinline__ int perm32(int rho) { const int n = rho >> 4, i = rho & 15; return 8 * (i >> 2) + 4 * n + (i & 3); }

struct Unit { int pm, pn, aux, r0, cnt; };

__host__ __device__ __forceinline__ void tile_map(int wgid, int nM, int nN, int& pm, int& pn) {
    const int nwg = nM * nN;
    { const int q = nwg / NXCD, r = nwg % NXCD, xcd = wgid % NXCD, off = wgid / NXCD; wgid = (xcd < r ? xcd * (q + 1) : r * (q + 1) + (xcd - r) * q) + off; }
    const int nig = WGM * nN, gid = wgid / nig, fm = gid * WGM, gsz = (nM - fm) < WGM ? (nM - fm) : WGM;
    pm = fm + ((wgid % nig) % gsz); pn = (wgid % nig) / gsz;
}

typedef float f32x2_t __attribute__((ext_vector_type(2))); typedef __bf16 bf16x2_t __attribute__((ext_vector_type(2)));
__device__ __forceinline__ unsigned cvt_pk_bf16(float lo, float hi) { const f32x2_t v = {lo, hi}; const bf16x2_t b = __builtin_convertvector(v, bf16x2_t); return __builtin_bit_cast(unsigned, b); }

template <class Epi, class Sched, bool ALIGN_EPI, bool GATHER, int K>
__device__ __forceinline__ void gemm_phase(PG8_LAS unsigned char* lds, const Sched& S, const Epi& E, const int wid) {
    int lane_; asm volatile("v_mbcnt_lo_u32_b32 %0, -1, 0\n\tv_mbcnt_hi_u32_b32 %0, -1, %0" : "=v"(lane_));
    const int lane = lane_, tid = wid * 64 + lane, wr = wid >> 2, wc = wid & 3, fr = lane & 15, fq = lane >> 4;
    constexpr int nt = K / BK;
    unsigned voffA[2], voffB[2];
#pragma unroll
    for (int i = 0; i < 2; ++i) { int R, C; stage_rc(tid * 16 + i * 8192, R, C); const int Rb = Epi::PERM ? ((R & ~31) + perm32(R & 31)) : R;
        voffA[i] = (unsigned)(R * K + C) * 2u; voffB[i] = (unsigned)(Rb * K + C) * 2u; }
    constexpr size_t kstep = (size_t)(BK * 2);
    constexpr size_t hstep = (size_t)HALF * K * 2;
    const unsigned ldsw = (unsigned)wid * 1024u;
    const int aoff = lds_byte(wr * 64 + fr, fq * 8), boff = lds_byte(wc * 32 + fr, fq * 8);
#define PG8_SA(b, h) (((b) * 2 + (h)) * HTB)
#define PG8_SB(b, h) ((4 + (b) * 2 + (h)) * HTB)
#define PG8_STAGE(bufoff, gbase, voff) do { _Pragma("unroll") for (int _i = 0; _i < 2; ++_i) \
        __builtin_amdgcn_global_load_lds((const unsigned*)((const char*)(gbase) + (voff)[_i]), (PG8_LAS unsigned*)(lds + (bufoff) + ldsw + _i * 8192), 16, 0, 0); } while (0)
#define PG8_LDA(dst, b, h) do { _Pragma("unroll") for (int m = 0; m < 4; ++m) _Pragma("unroll") for (int k = 0; k < 2; ++k) dst[m][k] = *(const PG8_LAS bf16x8*)(lds + PG8_SA(b, h) + aoff + m * 2048 + k * 1024); } while (0)
#define PG8_LDB(dst, b, h) do { _Pragma("unroll") for (int n = 0; n < 2; ++n) _Pragma("unroll") for (int k = 0; k < 2; ++k) dst[n][k] = *(const PG8_LAS bf16x8*)(lds + PG8_SB(b, h) + boff + n * 2048 + k * 1024); } while (0)
#define PG8_MMA(ai, bj, At, Bt) do { __builtin_amdgcn_s_setprio(1); _Pragma("unroll") for (int m = 0; m < 4; ++m) _Pragma("unroll") for (int n = 0; n < 2; ++n) _Pragma("unroll") for (int k = 0; k < 2; ++k) \
        acc[ai][bj][m][n] = __builtin_amdgcn_mfma_f32_16x16x32_bf16(Bt[n][k], At[m][k], acc[ai][bj][m][n], 0, 0, 0); __builtin_amdgcn_s_setprio(0); } while (0)
#define PG8_WAIT_V(n) asm volatile("s_waitcnt vmcnt(" #n ")" ::: "memory")
#define PG8_WAIT_L(n) asm volatile("s_waitcnt lgkmcnt(" #n ")" ::: "memory")
#define PG8_BAR __builtin_amdgcn_s_barrier()
#define PG8_SCHED __builtin_amdgcn_sched_barrier(0)
    Unit cur, nxt; int ui = 0;
    if (!S.next(0, cur)) return;
    f32x4 acc[2][2][4][2];
#pragma unroll
    for (int a = 0; a < 2; ++a)
#pragma unroll
        for (int b = 0; b < 2; ++b)
#pragma unroll
            for (int m = 0; m < 4; ++m)
#pragma unroll
                for (int n = 0; n < 2; ++n) acc[a][b][m][n] = (f32x4){0.f, 0.f, 0.f, 0.f};
    bf16x8 At[4][2], B0[2][2], B1[2][2];
    unsigned vc[2][2];
#define PG8_GOFF(u) do { _Pragma("unroll") for (int _h = 0; _h < 2; ++_h) _Pragma("unroll") for (int _i = 0; _i < 2; ++_i) { int _R, _C; stage_rc(tid * 16 + _i * 8192, _R, _C); \
        vc[_h][_i] = S.a_row_off(u, _h * HALF + _R) + (unsigned)_C * 2u; } } while (0)
#define PG8_STAGE_A(bufoff, gbase, h) do { if constexpr (GATHER) { PG8_STAGE(bufoff, gbase, vc[h]); } else { PG8_STAGE(bufoff, (gbase) + (h) * hstep, voffA); } } while (0)
    if constexpr (GATHER) PG8_GOFF(cur);
    const char* cA = S.a_base(cur); const char* cB = S.b_base(cur);
    PG8_STAGE(PG8_SB(0, 0), cB, voffB); PG8_STAGE(PG8_SB(0, 1), cB + hstep, voffB); PG8_STAGE_A(PG8_SA(0, 0), cA, 0); PG8_STAGE_A(PG8_SA(0, 1), cA, 1);
    if (wr == 1) PG8_BAR;
    PG8_WAIT_V(2); PG8_BAR;
    PG8_STAGE(PG8_SB(1, 0), cB + kstep, voffB); PG8_STAGE_A(PG8_SA(1, 0), cA + kstep, 0); PG8_STAGE(PG8_SB(1, 1), cB + hstep + kstep, voffB);
    PG8_WAIT_V(6); PG8_BAR;
    for (;;) {
        const bool has_next = S.next(ui + 1, nxt);
        const char* nA = has_next ? S.a_base(nxt) : cA; const char* nB = has_next ? S.b_base(nxt) : cB;
        for (int t = 0; t < nt; t += 2) {
            const bool last = (t == nt - 2);
            const char* a1 = cA + (size_t)(t + 1) * kstep;
            const char* a2 = last ? nA : cA + (size_t)(t + 2) * kstep; const char* b2 = last ? nB : cB + (size_t)(t + 2) * kstep;
            const char* a3 = a2 + kstep; const char* b3 = b2 + kstep;
            PG8_LDB(B0, 0, 0); PG8_LDB(B1, 0, 1); PG8_SCHED; PG8_LDA(At, 0, 0); PG8_STAGE_A(PG8_SA(1, 1), a1, 1);
            if constexpr (GATHER) { if (last && has_next) PG8_GOFF(nxt); }
            PG8_WAIT_V(8); PG8_WAIT_L(0); PG8_BAR; PG8_MMA(0, 0, At, B0); PG8_MMA(0, 1, At, B1); PG8_BAR; PG8_SCHED;
            PG8_LDA(At, 0, 1); PG8_STAGE(PG8_SB(0, 0), b2, voffB); PG8_STAGE(PG8_SB(0, 1), b2 + hstep, voffB); PG8_STAGE_A(PG8_SA(0, 0), a2, 0);
            PG8_WAIT_V(8); PG8_WAIT_L(0); PG8_BAR; PG8_MMA(1, 0, At, B0); PG8_MMA(1, 1, At, B1); PG8_BAR; PG8_SCHED;
            PG8_LDB(B0, 1, 0); PG8_LDB(B1, 1, 1); PG8_SCHED; PG8_LDA(At, 1, 0); PG8_STAGE_A(PG8_SA(0, 1), a2, 1);
            PG8_WAIT_V(8); PG8_WAIT_L(0); PG8_BAR; PG8_MMA(0, 0, At, B0); PG8_MMA(0, 1, At, B1); PG8_BAR; PG8_SCHED;
            PG8_LDA(At, 1, 1); PG8_STAGE(PG8_SB(1, 0), b3, voffB); PG8_STAGE(PG8_SB(1, 1), b3 + hstep, voffB); PG8_STAGE_A(PG8_SA(1, 0), a3, 0);
            PG8_WAIT_V(8); PG8_WAIT_L(0); PG8_BAR; PG8_MMA(1, 0, At, B0); PG8_MMA(1, 1, At, B1); PG8_BAR; PG8_SCHED;
        }
        if constexpr (ALIGN_EPI) { if (wr == 0) PG8_BAR; }
        E(acc, cur, wr, wc, fr, fq);
        if (!has_next) break;
#pragma unroll
        for (int a = 0; a < 2; ++a)
#pragma unroll
            for (int b = 0; b < 2; ++b)
#pragma unroll
                for (int m = 0; m < 4; ++m)
#pragma unroll
                    for (int n = 0; n < 2; ++n) acc[a][b][m][n] = (f32x4){0.f, 0.f, 0.f, 0.f};
        cur = nxt; cA = nA; cB = nB; ++ui;
        if constexpr (ALIGN_EPI) { if (wr == 1) PG8_BAR; }
    }
    PG8_WAIT_V(0);
    if constexpr (!ALIGN_EPI) { if (wr == 0) PG8_BAR; }
    PG8_BAR;
#undef PG8_SA
#undef PG8_SB
#undef PG8_STAGE
#undef PG8_STAGE_A
#undef PG8_GOFF
#undef PG8_LDA
#undef PG8_LDB
#undef PG8_MMA
#undef PG8_WAIT_V
#undef PG8_WAIT_L
#undef PG8_BAR
#undef PG8_SCHED
}
}

constexpr int NWAVES = 8;
#ifndef MK_DEBUG
#define MK_DEBUG 0
#endif
#ifndef DBG_USE_NAIVE
#define DBG_USE_NAIVE 0
#endif
constexpr int DBGP = MK_DEBUG ? 3 : 0;
enum Phase { PH_P0 = 0, PH_LORA, PH_RKV, PH_S1, PH_S2, PH_S3, PH_DBG0, PH_WOUT = PH_DBG0 + DBGP, PH_ROUT0, PH_GU0, PH_DN0, PH_COMB, PH_KVQ, PH_ATTN, PH_SBO, PH_ROUT1, PH_GU1, PH_DN1, PH_FINAL, NPHASE };
constexpr int N_LAUNCHES = MK_N_LAUNCHES;


constexpr int BATCH = 2, SEQ = 8192, C = 1024, NH = 16, HD = 64, M = BATCH * SEQ;
constexpr int NE = 16, FE = 256, DW = 64, DA = 64, DG = 160;
constexpr float RMS_EPS = 1e-6f, GN_EPS = 64e-5f;
constexpr float SB_EXIT = 104.0f;

constexpr size_t MiB = 1u << 20;
constexpr size_t WS_CTL = 0, CTL_ZERO_BYTES = 64 * 1024;
constexpr size_t WS_WT_W2 = 128 * 1024, WS_WT_A2 = 256 * 1024, WS_WT_G2 = 384 * 1024;
constexpr size_t WS_WT_RKV = 1 * MiB;
constexpr size_t WS_WT_LORA = 7 * MiB;
constexpr size_t WS_WT_OUT = 9 * MiB;
constexpr size_t WS_WT_KVQ = 11 * MiB;
constexpr size_t WS_WT_SBO = 17 * MiB;
constexpr size_t WS_WT_GU = 19 * MiB;
constexpr size_t WS_WT_DN = 51 * MiB;
constexpr size_t WS_LW = 67 * MiB;
constexpr size_t WS_LA = 69 * MiB;
constexpr size_t WS_LG = 71 * MiB;
static_assert(WS_LA == WS_LW + 2 * MiB && WS_LG == WS_LW + 4 * MiB, "EpiLora's pointer arithmetic");
constexpr size_t WS_LIST = 76 * MiB;
constexpr size_t WS_WL = 77 * MiB;
constexpr size_t WS_HID = 78 * MiB;
constexpr size_t WS_B0 = 96 * MiB, WS_B1 = 128 * MiB, WS_B2 = 160 * MiB, WS_B3 = 192 * MiB, WS_B4 = 224 * MiB, WS_END = 256 * MiB;
static_assert(WS_HID + (size_t)144 * 256 * 256 * 2 <= WS_B0, "HID vs B0");
constexpr int CW_TMO = 0;
constexpr int CW_CNT = 1024;
constexpr int CW_BAR = 4096;

constexpr int RING_BYTES = 131072;
constexpr int LDSCTL_OFF = RING_BYTES, MISC_OFF = LDSCTL_OFF + 320, MOE_TAB_OFF = MISC_OFF + 128;
constexpr int LDS_BYTES = 147456;
static_assert(MOE_TAB_OFF + 256 <= LDS_BYTES, "LDS map");

#define GAS __attribute__((address_space(1)))
#define LAS __attribute__((address_space(3)))
typedef unsigned short bf16;
typedef unsigned v4u __attribute__((ext_vector_type(4)));
typedef unsigned v2u __attribute__((ext_vector_type(2)));
typedef float f32x4 __attribute__((ext_vector_type(4)));
typedef GAS unsigned gu32;
#define RLX_AGENT __ATOMIC_RELAXED, __HIP_MEMORY_SCOPE_AGENT
#define LDS_WAIT() asm volatile("s_waitcnt lgkmcnt(0)" ::: "memory")
#define VM_WAIT() asm volatile("s_waitcnt vmcnt(0)" ::: "memory")
__device__ __forceinline__ unsigned f2bf(float f) { unsigned u = __builtin_bit_cast(unsigned, f); return (u + 0x7fffu + ((u >> 16) & 1u)) >> 16; }
__device__ __forceinline__ unsigned pk2(float lo, float hi) { return f2bf(lo) | (f2bf(hi) << 16); }
__device__ __forceinline__ float bflo(unsigned u) { return __uint_as_float(u << 16); }
__device__ __forceinline__ float bfhi(unsigned u) { return __uint_as_float(u & 0xffff0000u); }
__device__ __forceinline__ float bf2f(bf16 b) { return __uint_as_float((unsigned)b << 16); }
__device__ __forceinline__ float sigmoidf_(float x) { return 1.0f / (1.0f + __expf(-x)); }

#define XB_TMO      128
#define XB_XCNT(j)  (256  + 64 * (j))
#define XB_XSUB(j)  (1280 + 64 * (j))
#define XB_XGEN(j)  (2304 + 64 * (j))
#define XB_TOP      3328
#define XB_TOPGEN   3392
#define XCD_BAR_WORDS 3456
#define XB_SPIN_CAP (1u << 18)
__device__ __forceinline__ unsigned xb_ld(unsigned* p)              { return __hip_atomic_load(p, __ATOMIC_RELAXED, __HIP_MEMORY_SCOPE_AGENT); }
__device__ __forceinline__ unsigned xb_add(unsigned* p, unsigned v) { return __hip_atomic_fetch_add(p, v, __ATOMIC_RELAXED, __HIP_MEMORY_SCOPE_AGENT); }
__device__ __forceinline__ unsigned xb_xcc_id() { return (unsigned)__builtin_amdgcn_s_getreg((3 << 11) | 20) & 0xFu; }
#define XB_SPIN(cond, bar) do { unsigned _sp = 0; while (cond) { __builtin_amdgcn_s_sleep(1); \
    if ((++_sp & 255u) == 0u) { if (xb_ld(&(bar)[XB_TMO])) break; if (_sp > XB_SPIN_CAP) { atomicAdd(&(bar)[XB_TMO], 1u); break; } } } } while (0)
struct XcdBarrier { unsigned* bar; unsigned x; volatile LAS unsigned* st; };
__device__ __forceinline__ XcdBarrier xcd_barrier_post(unsigned* bar, volatile LAS unsigned* st) {
    XcdBarrier b; b.bar = bar; b.x = xb_xcc_id(); b.st = st;
    if (threadIdx.x == 0) (void)xb_add(&bar[XB_XCNT(b.x)], 1u);
    return b;
}
__device__ __forceinline__ void xcd_barrier_complete(unsigned* bar, unsigned x, unsigned& nloc, unsigned& nx) {
    const unsigned G = gridDim.x * gridDim.y * gridDim.z;
    unsigned sum, cnt, mine, sp = 0u;
    for (;;) {
        sum = 0u; cnt = 0u; mine = 0u;
#pragma unroll
        for (unsigned j = 0; j < 16; ++j) { const unsigned c = xb_ld(&bar[XB_XCNT(j)]); sum += c; cnt += (c > 0u) ? 1u : 0u; mine = (j == x) ? c : mine; }
        if (sum == G) break;
        __builtin_amdgcn_s_sleep(1);
        if ((++sp & 255u) == 0u) { if (xb_ld(&bar[XB_TMO])) break; if (sp > XB_SPIN_CAP) { atomicAdd(&bar[XB_TMO], 1u); break; } }
    }
    nloc = mine > 0u ? mine : 1u; nx = cnt > 0u ? cnt : 1u;
}
__device__ __forceinline__ void xcd_barrier(const XcdBarrier& b) {
    asm volatile("s_waitcnt vmcnt(0)" ::: "memory");
    __syncthreads();
    if (threadIdx.x == 0) {
        unsigned* bar = b.bar;
        __builtin_amdgcn_s_waitcnt(0);
        unsigned nloc = b.st[0], nx = b.st[1];
        if (nloc == 0u) { xcd_barrier_complete(bar, b.x, nloc, nx); b.st[0] = nloc; b.st[1] = nx; }
        const unsigned old = xb_add(&bar[XB_XSUB(b.x)], 1u);
        const unsigned gen = old / nloc;
        if (old + 1u == (gen + 1u) * nloc) {
            __builtin_amdgcn_fence(__ATOMIC_RELEASE, "agent");
            asm volatile("s_waitcnt vmcnt(0)" ::: "memory");
            const unsigned og = xb_add(&bar[XB_TOP], 1u);
            const unsigned tg = og / nx;
            if (og + 1u == (tg + 1u) * nx) xb_add(&bar[XB_TOPGEN], 1u);
            else XB_SPIN(xb_ld(&bar[XB_TOPGEN]) == tg, bar);
            __builtin_amdgcn_fence(__ATOMIC_ACQUIRE, "agent");
            xb_add(&bar[XB_XGEN(b.x)], 1u);
            asm volatile("s_waitcnt vmcnt(0)" ::: "memory");
        } else {
            XB_SPIN(xb_ld(&bar[XB_XGEN(b.x)]) == gen, bar);
            __builtin_amdgcn_fence(__ATOMIC_ACQUIRE, "agent");
            asm volatile("s_waitcnt vmcnt(0)" ::: "memory");
        }
    }
    __syncthreads();
}

__device__ __forceinline__ float shx(float v, int o, int lane) { return __int_as_float(__builtin_amdgcn_ds_bpermute((lane ^ o) << 2, __float_as_int(v))); }
__device__ __forceinline__ float wave_sum(float v, int lane) {
#pragma unroll
    for (int o = 1; o < 64; o <<= 1) v += shx(v, o, lane);
    return v;
}
__device__ __forceinline__ void transpose_item(const float* W, int ldw, int k0, int n0, bf16* WT, int ldk, int dst_row0, const float* kscale, LAS float* scr, int lane, int kmax = 1 << 30) {
#pragma unroll 8
    for (int i = 0; i < 32; ++i) { const int kk = 2 * i + (lane >> 5); float v = (k0 + kk < kmax) ? W[(size_t)(k0 + kk) * ldw + n0 + (lane & 31)] : 0.f; if (kscale) v *= kscale[k0 + kk]; scr[kk * 33 + (lane & 31)] = v; }
    LDS_WAIT(); asm volatile("" ::: "memory");
    const int c = lane & 7;
#pragma unroll
    for (int j = 0; j < 4; ++j) { const int n = (lane >> 3) + 8 * j; const LAS float* s = scr + (8 * c) * 33 + n;
        v4u o; o.x = pk2(s[0 * 33], s[1 * 33]); o.y = pk2(s[2 * 33], s[3 * 33]); o.z = pk2(s[4 * 33], s[5 * 33]); o.w = pk2(s[6 * 33], s[7 * 33]);
        if (k0 + 8 * c < kmax) *(GAS v4u*)(WT + (size_t)(dst_row0 + n) * ldk + k0 + 8 * c) = o; }
    LDS_WAIT(); asm volatile("" ::: "memory");
}

struct Args { const float* in[31]; float* out; unsigned char* ws; int ph_lo, ph_hi, li, pad; };
typedef const __attribute__((address_space(4))) unsigned char* kaptr_t;
__device__ __forceinline__ kaptr_t ka_base() { kaptr_t p = (kaptr_t)__builtin_amdgcn_kernarg_segment_ptr(); asm volatile("" : "+s"(p)); return p; }
#define INP(k) (*(const float* const __attribute__((address_space(4)))*)(ka_base() + 8 * (k)))
#define OUTP() (*(float* const __attribute__((address_space(4)))*)(ka_base() + 8 * 31))
#define WSP() (*(unsigned char* const __attribute__((address_space(4)))*)(ka_base() + 8 * 32))
#define KA_INT(i) (*(const int __attribute__((address_space(4)))*)(ka_base() + 8 * 33 + 4 * (i)))

__device__ __forceinline__ void p0_weights(unsigned char* ws, LAS unsigned char* lds, int gw, int NGW, int wave, int lane) {
    LAS float* scr = (LAS float*)(lds + wave * 16384);
    bf16* WT_RKV = (bf16*)(ws + WS_WT_RKV); bf16* WT_LORA = (bf16*)(ws + WS_WT_LORA); bf16* WT_OUT = (bf16*)(ws + WS_WT_OUT); bf16* WT_KVQ = (bf16*)(ws + WS_WT_KVQ);
    bf16* WT_SBO = (bf16*)(ws + WS_WT_SBO); bf16* WT_GU = (bf16*)(ws + WS_WT_GU); bf16* WT_DN = (bf16*)(ws + WS_WT_DN);
    constexpr int I_UP = 32 + 32 + 96, I_RKV = 3 * 512, I_LORA = 32 + 32 + 80, I_OUT = 512, I_KV = 1024, I_Q = 512, I_SBO = 512, I_G = 32 * 128, I_U = 32 * 128, I_D = 32 * 128;
    constexpr int NITEMS = I_UP + I_RKV + I_LORA + I_OUT + I_KV + I_Q + I_SBO + I_G + I_U + I_D;
    for (int it = gw; it < NITEMS; it += NGW) {
        int r = it;
        if (r < I_UP) {
            if (r < 32) transpose_item(INP(9), C, 0, 32 * r, (bf16*)(ws + WS_WT_W2), 64, 32 * r, nullptr, scr, lane);
            else if (r < 64) transpose_item(INP(12), C, 0, 32 * (r - 32), (bf16*)(ws + WS_WT_A2), 64, 32 * (r - 32), nullptr, scr, lane);
            else { const int q = r - 64, kb = q / 32, nb = q % 32; transpose_item(INP(14), C, 64 * kb, 32 * nb, (bf16*)(ws + WS_WT_G2), DG, 32 * nb, nullptr, scr, lane, DG); }
            continue; } r -= I_UP;
        if (r < I_RKV) { const int m = r / 512, q = r % 512, kb = q / 32, nb = q % 32; transpose_item(INP(6) + (size_t)m * C * C, C, 64 * kb, 32 * nb, WT_RKV, C, m * C + 32 * nb, nullptr, scr, lane); continue; } r -= I_RKV;
        if (r < I_LORA) {
            if (r < 32) { const int kb = r / 2, nb = r % 2; transpose_item(INP(8), DW, 64 * kb, 32 * nb, WT_LORA, C, 32 * nb, nullptr, scr, lane); }
            else if (r < 64) { const int q = r - 32, kb = q / 2, nb = q % 2; transpose_item(INP(11), DA, 64 * kb, 32 * nb, WT_LORA, C, 256 + 32 * nb, nullptr, scr, lane); }
            else { const int q = r - 64, kb = q / 5, nb = q % 5; transpose_item(INP(13), DG, 64 * kb, 32 * nb, WT_LORA, C, 512 + 32 * nb, nullptr, scr, lane); }
            continue; } r -= I_LORA;
        if (r < I_OUT) { const int kb = r / 32, nb = r % 32; transpose_item(INP(20), C, 64 * kb, 32 * nb, WT_OUT, C, 32 * nb, nullptr, scr, lane); continue; } r -= I_OUT;
        if (r < I_KV) { const int kb = r / 64, nb = r % 64; transpose_item(INP(21), 2 * C, 64 * kb, 32 * nb, WT_KVQ, C, 32 * nb, INP(3), scr, lane); continue; } r -= I_KV;
        if (r < I_Q) { const int kb = r / 32, nb = r % 32; transpose_item(INP(22), C, 64 * kb, 32 * nb, WT_KVQ, C, 2 * C + 32 * nb, INP(1) + C, scr, lane); continue; } r -= I_Q;
        if (r < I_SBO) { const int kb = r / 32, nb = r % 32; transpose_item(INP(23), C, 64 * kb, 32 * nb, WT_SBO, C, 32 * nb, nullptr, scr, lane); continue; } r -= I_SBO;
        if (r < I_G) { const int le = r / 128, q = r % 128, kb = q / 8, nb = q % 8, f0 = 32 * nb; transpose_item(INP(28) + (size_t)le * C * FE, FE, 64 * kb, f0, WT_GU + (size_t)le * 512 * C, C, 256 * (f0 / 128) + (f0 % 128), nullptr, scr, lane); continue; } r -= I_G;
        if (r < I_U) { const int le = r / 128, q = r % 128, kb = q / 8, nb = q % 8, f0 = 32 * nb; transpose_item(INP(29) + (size_t)le * C * FE, FE, 64 * kb, f0, WT_GU + (size_t)le * 512 * C, C, 256 * (f0 / 128) + 128 + (f0 % 128), nullptr, scr, lane); continue; } r -= I_U;
        { const int le = r / 128, q = r % 128, kb = q / 32, nb = q % 32; transpose_item(INP(30) + (size_t)le * FE * C, C, 64 * kb, 32 * nb, WT_DN + (size_t)le * C * FE, FE, 32 * nb, nullptr, scr, lane); }
    }
    for (int it = gw * 64 + lane; it < 768 * 128; it += NGW * 64) { const int row = it >> 7, ch = it & 127;
        const bool valid = (row < 64) || (row >= 256 && row < 320) || (row >= 512 && row < 672);
        if (!valid) *(GAS v4u*)(WT_LORA + (size_t)row * C + ch * 8) = (v4u){0u, 0u, 0u, 0u}; }
}
__device__ __forceinline__ void load_row(const float* p, int lane, f32x4 (&v)[4]) {
#pragma unroll
    for (int j = 0; j < 4; ++j) v[j] = ((const GAS f32x4*)p)[64 * j + lane];
}
__device__ __forceinline__ float row_rs(const f32x4 (&v)[4], int lane) {
    float s = 0.f;
#pragma unroll
    for (int j = 0; j < 4; ++j) s += (v[j].x * v[j].x + v[j].y * v[j].y) + (v[j].z * v[j].z + v[j].w * v[j].w);
    return 1.0f / sqrtf(wave_sum(s, lane) * (1.0f / C) + RMS_EPS);
}
__device__ __forceinline__ void store_row_bf16(bf16* p, int lane, const f32x4 (&v)[4]) {
#pragma unroll
    for (int j = 0; j < 4; ++j) { v2u o; o.x = pk2(v[j].x, v[j].y); o.y = pk2(v[j].z, v[j].w); ((GAS v2u*)p)[64 * j + lane] = o; }
}
__device__ __forceinline__ void p0_rows(unsigned char* ws, int gw, int NGW, int lane) {
    const float* x = INP(0); const float* gain = INP(1); const float* mix = INP(5);
    f32x4 g[4]; load_row(gain, lane, g);
    for (int run = gw; run < M / 8; run += NGW) {
        const int r0 = run * 8;
        f32x4 prev[4];
        if ((r0 % SEQ) == 0) {
#pragma unroll
            for (int j = 0; j < 4; ++j) prev[j] = (f32x4){0.f, 0.f, 0.f, 0.f};
        } else { load_row(x + (size_t)(r0 - 1) * C, lane, prev); const float rs = row_rs(prev, lane);
#pragma unroll
            for (int j = 0; j < 4; ++j) prev[j] = prev[j] * rs * g[j]; }
        for (int rr = 0; rr < 8; ++rr) {
            const int row = r0 + rr;
            f32x4 hn[4]; load_row(x + (size_t)row * C, lane, hn); const float rs = row_rs(hn, lane);
#pragma unroll
            for (int j = 0; j < 4; ++j) hn[j] = hn[j] * rs * g[j];
#pragma unroll
            for (int i = 0; i < 6; ++i) { f32x4 o[4];
#pragma unroll
                for (int j = 0; j < 4; ++j) { const f32x4 mx = ((const GAS f32x4*)(mix + i * C))[64 * j + lane]; o[j] = hn[j] + (prev[j] - hn[j]) * mx; }
                bf16* dst = i < 2 ? (bf16*)OUTP() + (size_t)i * M * C : (i == 2 ? (bf16*)(ws + WS_B4) : (bf16*)(ws + WS_B1) + (size_t)(i - 3) * M * C);
                store_row_bf16(dst + (size_t)row * C, lane, o); }
#pragma unroll
            for (int j = 0; j < 4; ++j) prev[j] = hn[j];
        }
    }
}

template <int NN, int NGROUPS> struct SchedGrouped {
    static constexpr int K = C;
    const char* A0; size_t astride; const char* A2; const char* B; size_t bgroup;
    int G, c;
    __device__ __forceinline__ bool next(int i, pg8::Unit& u) const {
        const int L = i * G + c; constexpr int per = 64 * NN; if (L >= per * NGROUPS) return false;
        const int g = L / per, w = L % per; pg8::tile_map(w, 64, NN, u.pm, u.pn); u.aux = g; u.r0 = 0; u.cnt = 0; return true; }
    __device__ __forceinline__ const char* a_base(const pg8::Unit& u) const { const char* A = (A2 != nullptr && u.aux == 2) ? A2 : A0 + (size_t)u.aux * astride; return A + (size_t)u.pm * 256 * K * 2; }
    __device__ __forceinline__ const char* b_base(const pg8::Unit& u) const { return B + (size_t)u.aux * bgroup + (size_t)u.pn * 256 * K * 2; }
    __device__ __forceinline__ unsigned a_row_off(const pg8::Unit&, int) const { return 0u; }
};
template <int NN, int K, bool GATHER> struct SchedMoe {
    const char* A; const char* B; size_t bexp; const unsigned* list; volatile LAS int* tab; int G, c;
    __device__ __forceinline__ bool next(int i, pg8::Unit& u) const {
        const int L = i * G + c; const int tot = __builtin_amdgcn_readfirstlane(tab[48]) * NN; if (L >= tot) return false;
        u.pm = L / NN; u.pn = L % NN; int e = 0;
#pragma unroll
        for (int j = 0; j < 16; ++j) e += (u.pm >= tab[32 + j]) ? 1 : 0;
        e = __builtin_amdgcn_readfirstlane(e);
        u.aux = e; u.r0 = (u.pm - __builtin_amdgcn_readfirstlane(tab[16 + e])) * 256; u.cnt = __builtin_amdgcn_readfirstlane(tab[e]); return true; }
    __device__ __forceinline__ const char* a_base(const pg8::Unit& u) const { return GATHER ? A : A + (size_t)u.pm * 256 * K * 2; }
    __device__ __forceinline__ const char* b_base(const pg8::Unit& u) const { return B + (size_t)u.aux * bexp + (size_t)u.pn * 256 * K * 2; }
    __device__ __forceinline__ unsigned a_row_off(const pg8::Unit& u, int r) const {
        const int idx = u.r0 + r; unsigned tok = 0u;
        if (idx < u.cnt) tok = list[(size_t)u.aux * M + idx] >> 1;
        return tok * (unsigned)(K * 2); }
};

using pg8::f32x4;
using pg8::Unit;
__device__ __forceinline__ v4u pack8(f32x4 v0, f32x4 v1) { v4u w; w.x = pg8::cvt_pk_bf16(v0[0], v0[1]); w.y = pg8::cvt_pk_bf16(v0[2], v0[3]); w.z = pg8::cvt_pk_bf16(v1[0], v1[1]); w.w = pg8::cvt_pk_bf16(v1[2], v1[3]); return w; }

struct EpiLora {
    static constexpr bool PERM = true;
    bf16* LW;
    __device__ __forceinline__ void operator()(const f32x4 (&acc)[2][2][4][2], const Unit& u, int wr, int wc, int fr, int fq) const {
        { int l_; asm volatile("v_mbcnt_lo_u32_b32 %0, -1, 0\n\tv_mbcnt_hi_u32_b32 %0, -1, %0" : "=v"(l_)); fr = l_ & 15; fq = l_ >> 4; }
        const int g = u.aux, width = g == 2 ? DG : DW; bf16* out = LW + (size_t)g * (1u << 20);
        const int row0 = u.pm * 256 + wr * 64 + fr;
#pragma unroll
        for (int bj = 0; bj < 2; ++bj) { const int col0 = bj * 128 + wc * 32 + 8 * fq; if (col0 < width) {
#pragma unroll
            for (int ai = 0; ai < 2; ++ai)
#pragma unroll
                for (int m = 0; m < 4; ++m) { f32x4 v0 = acc[ai][bj][m][0], v1 = acc[ai][bj][m][1];
                    if (g == 0) {
#pragma unroll
                        for (int q = 0; q < 4; ++q) { v0[q] = tanhf(v0[q]); v1[q] = tanhf(v1[q]); } }
                    else if (g == 2) {
#pragma unroll
                        for (int q = 0; q < 4; ++q) { v0[q] = sigmoidf_(v0[q]); v1[q] = sigmoidf_(v1[q]); } }
                    *(GAS v4u*)(out + (size_t)(row0 + ai * 128 + m * 16) * width + col0) = pack8(v0, v1); } } }
    }
};
struct EpiSplit3 {
    static constexpr bool PERM = true;
    bf16* O0; bool bycol;
    __device__ __forceinline__ void operator()(const f32x4 (&acc)[2][2][4][2], const Unit& u, int wr, int wc, int fr, int fq) const {
        { int l_; asm volatile("v_mbcnt_lo_u32_b32 %0, -1, 0\n\tv_mbcnt_hi_u32_b32 %0, -1, %0" : "=v"(l_)); fr = l_ & 15; fq = l_ >> 4; }
        const int g = bycol ? (u.pn >> 2) : u.aux, pn = bycol ? (u.pn & 3) : u.pn; bf16* out = O0 + (size_t)g * ((size_t)M * C);
        const int row0 = u.pm * 256 + wr * 64 + fr, col0 = pn * 256 + wc * 32 + 8 * fq;
#pragma unroll
        for (int ai = 0; ai < 2; ++ai)
#pragma unroll
            for (int m = 0; m < 4; ++m)
#pragma unroll
                for (int bj = 0; bj < 2; ++bj) *(GAS v4u*)(out + (size_t)(row0 + ai * 128 + m * 16) * C + col0 + bj * 128) = pack8(acc[ai][bj][m][0], acc[ai][bj][m][1]);
    }
};
struct EpiResid {
    static constexpr bool PERM = false;
    const float* base; float* out;
    __device__ __forceinline__ void operator()(const f32x4 (&acc)[2][2][4][2], const Unit& u, int wr, int wc, int fr, int fq) const {
        { int l_; asm volatile("v_mbcnt_lo_u32_b32 %0, -1, 0\n\tv_mbcnt_hi_u32_b32 %0, -1, %0" : "=v"(l_)); fr = l_ & 15; fq = l_ >> 4; }
        const int row0 = u.pm * 256 + wr * 64 + fr, col0 = u.pn * 256 + wc * 32 + 4 * fq;
#pragma unroll
        for (int ai = 0; ai < 2; ++ai)
#pragma unroll
            for (int m = 0; m < 4; ++m) { const size_t off = (size_t)(row0 + ai * 128 + m * 16) * C + col0;
#pragma unroll
                for (int bj = 0; bj < 2; ++bj)
#pragma unroll
                    for (int n = 0; n < 2; ++n) { const f32x4 b = *(const GAS f32x4*)(base + off + bj * 128 + n * 16); *(GAS f32x4*)(out + off + bj * 128 + n * 16) = b + acc[ai][bj][m][n]; } }
    }
};
struct EpiGU {
    static constexpr bool PERM = true;
    bf16* HID; const float* wl;
    __device__ __forceinline__ void operator()(const f32x4 (&acc)[2][2][4][2], const Unit& u, int wr, int wc, int fr, int fq) const {
        { int l_; asm volatile("v_mbcnt_lo_u32_b32 %0, -1, 0\n\tv_mbcnt_hi_u32_b32 %0, -1, %0" : "=v"(l_)); fr = l_ & 15; fq = l_ >> 4; }
        const int e = u.aux, cnt = u.cnt, base = u.r0, r0 = wr * 64 + fr, col0 = u.pn * 128 + wc * 32 + 8 * fq;
#pragma unroll
        for (int ai = 0; ai < 2; ++ai)
#pragma unroll
            for (int m = 0; m < 4; ++m) { const int r = r0 + ai * 128 + m * 16, idx = base + r; float w = 0.f; if (idx < cnt) w = wl[(size_t)e * M + idx];
                f32x4 h0, h1;
#pragma unroll
                for (int q = 0; q < 4; ++q) { const float g0 = acc[ai][0][m][0][q], g1 = acc[ai][0][m][1][q];
                    h0[q] = g0 * sigmoidf_(g0) * acc[ai][1][m][0][q] * w; h1[q] = g1 * sigmoidf_(g1) * acc[ai][1][m][1][q] * w; }
                *(GAS v4u*)(HID + (size_t)(u.pm * 256 + r) * FE + col0) = pack8(h0, h1);
                asm volatile("" ::: "memory"); }
    }
};
struct EpiDown {
    static constexpr bool PERM = true;
    bf16* EO; const unsigned* list;
    __device__ __forceinline__ void operator()(const f32x4 (&acc)[2][2][4][2], const Unit& u, int wr, int wc, int fr, int fq) const {
        { int l_; asm volatile("v_mbcnt_lo_u32_b32 %0, -1, 0\n\tv_mbcnt_hi_u32_b32 %0, -1, %0" : "=v"(l_)); fr = l_ & 15; fq = l_ >> 4; }
        const int e = u.aux, cnt = u.cnt, base = u.r0, r0 = wr * 64 + fr, col0 = u.pn * 256 + wc * 32 + 8 * fq;
#pragma unroll
        for (int ai = 0; ai < 2; ++ai)
#pragma unroll
            for (int m = 0; m < 4; ++m) { const int idx = base + r0 + ai * 128 + m * 16;
                if (idx < cnt) { const unsigned ent = list[(size_t)e * M + idx]; bf16* o = EO + ((size_t)(ent & 1u) * M + (ent >> 1)) * C + col0;
#pragma unroll
                    for (int bj = 0; bj < 2; ++bj) *(GAS v4u*)(o + bj * 128) = pack8(acc[ai][bj][m][0], acc[ai][bj][m][1]); }
                asm volatile("" ::: "memory"); }
    }
};

typedef short bf16x8s __attribute__((ext_vector_type(8)));
typedef short bf16x4s __attribute__((ext_vector_type(4)));
constexpr int TPB = 144;
constexpr int TILE_B = 64 * TPB;
constexpr int FP = 68;
constexpr int CS_FA = 0, CS_FB = 16384, CS_TILES = 36864, CS_TOT = 129024, CS_RK = 132096;
#define TILE(n) (lds + CS_TILES + (n) * TILE_B)
__device__ __forceinline__ bf16x8s ldfrag(const LAS unsigned char* tile, int row, int kcol) { return *(const LAS bf16x8s*)(tile + row * TPB + kcol * 2); }
__device__ __forceinline__ bf16x8s ldfrag_perm(const LAS unsigned char* tile, int row, int ks, int g) {
    const bf16x4s lo = *(const LAS bf16x4s*)(tile + row * TPB + (32 * ks + 4 * g) * 2), hi = *(const LAS bf16x4s*)(tile + row * TPB + (32 * ks + 16 + 4 * g) * 2);
    return (bf16x8s){lo[0], lo[1], lo[2], lo[3], hi[0], hi[1], hi[2], hi[3]};
}
__device__ __forceinline__ void mm64(f32x4 (&acc)[2], const LAS unsigned char* At, const LAS unsigned char* Bt, int rt, int ch, int fr, int g) {
#pragma unroll
    for (int ks = 0; ks < 2; ++ks) { const bf16x8s a = ldfrag(At, 16 * rt + fr, 32 * ks + 8 * g);
#pragma unroll
        for (int ct = 0; ct < 2; ++ct) { const bf16x8s b = ldfrag(Bt, 32 * ch + 16 * ct + fr, 32 * ks + 8 * g); acc[ct] = __builtin_amdgcn_mfma_f32_16x16x32_bf16(a, b, acc[ct], 0, 0, 0); } }
}
__device__ __forceinline__ bf16x4s pack4(f32x4 v) { v2u w; w.x = pg8::cvt_pk_bf16(v[0], v[1]); w.y = pg8::cvt_pk_bf16(v[2], v[3]); return __builtin_bit_cast(bf16x4s, w); }
__device__ __forceinline__ void st_tr(LAS unsigned char* Out, const f32x4 (&acc)[2], int rt, int ch, int fr, int g) {
#pragma unroll
    for (int ct = 0; ct < 2; ++ct) *(LAS bf16x4s*)(Out + (32 * ch + 16 * ct + fr) * TPB + (16 * rt + 4 * g) * 2) = pack4(acc[ct]);
}
__device__ __forceinline__ void unpack8(v4u w, float (&o)[8]) { o[0] = bflo(w.x); o[1] = bfhi(w.x); o[2] = bflo(w.y); o[3] = bfhi(w.y); o[4] = bflo(w.z); o[5] = bfhi(w.z); o[6] = bflo(w.w); o[7] = bfhi(w.w); }
__device__ __forceinline__ v4u pack8f(const float (&o)[8]) { v4u w; w.x = pg8::cvt_pk_bf16(o[0], o[1]); w.y = pg8::cvt_pk_bf16(o[2], o[3]); w.z = pg8::cvt_pk_bf16(o[4], o[5]); w.w = pg8::cvt_pk_bf16(o[6], o[7]); return w; }

template <int MODE>
__device__ __forceinline__ void chunk_front(unsigned char* ws, LAS unsigned char* lds, int b, int c, int h, int tid, int lane, int wave, float (&v8)[8], float& rkb) {
    const int rt = wave & 3, ch = wave >> 2, fr = lane & 15, g = lane >> 4;
    const size_t row0 = (size_t)b * SEQ + c * 64;
    const bf16* Rb = (const bf16*)(ws + WS_B1); const bf16* Kb = (const bf16*)(ws + WS_B2); const bf16* Vb = (const bf16*)(ws + WS_B3);
    const bf16* LW = (const bf16*)(ws + WS_LW); const bf16* LA = (const bf16*)(ws + WS_LA);
    const bf16* W2T = (const bf16*)(ws + WS_WT_W2); const bf16* A2T = (const bf16*)(ws + WS_WT_A2);
    LAS float* FA = (LAS float*)(lds + CS_FA); LAS float* FB = (LAS float*)(lds + CS_FB); LAS float* TOT = (LAS float*)(lds + CS_TOT);
    {
        f32x4 aw[2], aa[2];
#pragma unroll
        for (int ct = 0; ct < 2; ++ct) { aw[ct] = (f32x4){0.f, 0.f, 0.f, 0.f}; aa[ct] = (f32x4){0.f, 0.f, 0.f, 0.f}; }
#pragma unroll
        for (int ks = 0; ks < 2; ++ks) {
            const bf16x8s fw = *(const GAS bf16x8s*)(LW + (row0 + 16 * rt + fr) * DW + 32 * ks + 8 * g), fa = *(const GAS bf16x8s*)(LA + (row0 + 16 * rt + fr) * DA + 32 * ks + 8 * g);
#pragma unroll
            for (int ct = 0; ct < 2; ++ct) { const size_t wr_ = (size_t)(h * HD + 32 * ch + 16 * ct + fr) * 64 + 32 * ks + 8 * g;
                aw[ct] = __builtin_amdgcn_mfma_f32_16x16x32_bf16(fw, *(const GAS bf16x8s*)(W2T + wr_), aw[ct], 0, 0, 0);
                aa[ct] = __builtin_amdgcn_mfma_f32_16x16x32_bf16(fa, *(const GAS bf16x8s*)(A2T + wr_), aa[ct], 0, 0, 0); } }
#pragma unroll
        for (int ct = 0; ct < 2; ++ct) { const int j = 32 * ch + 16 * ct + fr; const float w0 = INP(7)[h * HD + j], a0 = INP(10)[h * HD + j];
#pragma unroll
            for (int q = 0; q < 4; ++q) { const int t = 16 * rt + 4 * g + q; FA[t * 64 + j] = -0.6065306597126334f * sigmoidf_(w0 + aw[ct][q]); FB[t * 64 + j] = sigmoidf_(a0 + aa[ct][q]); } }
    }
    __syncthreads();
    {
        const int j = tid & 63, seg = tid >> 6; float run = 0.f; float loc[8];
#pragma unroll
        for (int q = 0; q < 8; ++q) { run += FA[(8 * seg + q) * 64 + j]; loc[q] = run; }
        TOT[seg * 64 + j] = run;
        __syncthreads();
        float off = 0.f;
#pragma unroll
        for (int s2 = 0; s2 < 7; ++s2) off += (s2 < seg) ? TOT[s2 * 64 + j] : 0.f;
#pragma unroll
        for (int q = 0; q < 8; ++q) FA[(8 * seg + q) * 64 + j] = loc[q] + off;
    }
    __syncthreads();
    {
        const int t = tid >> 3, cq = tid & 7, c0 = h * HD + cq * 8; const size_t row = row0 + t;
        float r[8], k[8];
        unpack8(*(const GAS v4u*)(Rb + row * C + c0), r); unpack8(*(const GAS v4u*)(Kb + row * C + c0), k); unpack8(*(const GAS v4u*)(Vb + row * C + c0), v8);
        float cw[8], cwp[8], ag[8], wl[8];
#pragma unroll
        for (int q = 0; q < 8; ++q) { cw[q] = FA[t * 64 + cq * 8 + q]; cwp[q] = t > 0 ? FA[(t - 1) * 64 + cq * 8 + q] : 0.f; ag[q] = FB[t * 64 + cq * 8 + q]; wl[q] = FA[63 * 64 + cq * 8 + q]; }
        float kk[8], ss = 0.f; rkb = 0.f;
#pragma unroll
        for (int q = 0; q < 8; ++q) { kk[q] = k[q] * INP(15)[c0 + q]; ss += kk[q] * kk[q]; }
        ss += shx(ss, 1, lane); ss += shx(ss, 2, lane); ss += shx(ss, 4, lane);
        const float inv = 1.0f / fmaxf(sqrtf(ss), 1e-12f);
        float at[8], bt[8], kt[8], rt_[8], bh[8], kh[8];
#pragma unroll
        for (int q = 0; q < 8; ++q) { const float kn = kk[q] * inv, kp = k[q] * (1.0f + (ag[q] - 1.0f) * INP(16)[c0 + q]);
            const float ein = __expf(-cw[q]);
            at[q] = -kn * __expf(cwp[q]); bt[q] = kn * ag[q] * ein; kt[q] = kp * ein; rt_[q] = r[q] * __expf(cw[q]);
            const float ewl = __expf(wl[q]); bh[q] = bt[q] * ewl; kh[q] = kt[q] * ewl;
            rkb += r[q] * kp * INP(17)[c0 + q]; }
        rkb += shx(rkb, 1, lane); rkb += shx(rkb, 2, lane); rkb += shx(rkb, 4, lane);
        *(LAS v4u*)(TILE(0) + t * TPB + cq * 16) = pack8f(at); *(LAS v4u*)(TILE(1) + t * TPB + cq * 16) = pack8f(bt); *(LAS v4u*)(TILE(2) + t * TPB + cq * 16) = pack8f(kt);
        if (MODE == 3) *(LAS v4u*)(TILE(3) + t * TPB + cq * 16) = pack8f(rt_);
#pragma unroll
        for (int q = 0; q < 8; ++q) { const int o = (cq * 8 + q) * TPB + t * 2;
            if (MODE == 1) { *(LAS bf16*)(TILE(3) + o) = (bf16)f2bf(at[q]); *(LAS bf16*)(TILE(4) + o) = (bf16)f2bf(bh[q]); *(LAS bf16*)(TILE(5) + o) = (bf16)f2bf(kh[q]); *(LAS bf16*)(TILE(6) + o) = (bf16)f2bf(v8[q]); }
            else { *(LAS bf16*)(TILE(4) + o) = (bf16)f2bf(v8[q]); } }
        if (MODE == 1 && t == 63) {
#pragma unroll
            for (int q = 0; q < 8; ++q) ((LAS float*)(lds + CS_RK))[cq * 8 + q] = __expf(wl[q]); }
    }
    __syncthreads();
}

__device__ __forceinline__ void scan_s1(unsigned char* ws, LAS unsigned char* lds, int lane0, int wave) {
    const int rt = wave & 3, ch = wave >> 2;
    LAS float* AabT = (LAS float*)(lds + CS_FA);
    for (int unit = blockIdx.x; unit < BATCH * NH * (SEQ / 64); unit += gridDim.x) {
        int lane = lane0; asm volatile("" : "+v"(lane));
        const int tid = wave * 64 + lane, fr = lane & 15, g = lane >> 4;
        const int h = unit & 15, c = (unit >> 4) & 127, b = unit >> 11; const size_t chunk = ((size_t)b * NH + h) * 128 + c;
        float v8[8]; float rkb;
        chunk_front<1>(ws, lds, b, c, h, tid, lane, wave, v8, rkb);
        {
            f32x4 acc[2] = {(f32x4){0.f, 0.f, 0.f, 0.f}, (f32x4){0.f, 0.f, 0.f, 0.f}};
            mm64(acc, TILE(0), TILE(1), rt, ch, fr, g);
#pragma unroll
            for (int ct = 0; ct < 2; ++ct) { const int cc = 32 * ch + 16 * ct + fr; f32x4 o;
#pragma unroll
                for (int q = 0; q < 4; ++q) { const int s = 16 * rt + 4 * g + q; o[q] = cc < s ? acc[ct][q] : 0.f; }
                *(LAS f32x4*)(AabT + cc * FP + 16 * rt + 4 * g) = o; }
            f32x4 ac2[2] = {(f32x4){0.f, 0.f, 0.f, 0.f}, (f32x4){0.f, 0.f, 0.f, 0.f}};
            mm64(ac2, TILE(2), TILE(0), rt, ch, fr, g);
#pragma unroll
            for (int ct = 0; ct < 2; ++ct) { const int t = 32 * ch + 16 * ct + fr;
#pragma unroll
                for (int q = 0; q < 4; ++q) { const int s = 16 * rt + 4 * g + q; ac2[ct][q] = s < t ? ac2[ct][q] : 0.f; } }
            st_tr(TILE(7), ac2, rt, ch, fr, g);
        }
        __syncthreads();
        if (wave == 0) {
            float T[64]; int ln = lane; const LAS float* ab = AabT; asm volatile("" : "+v"(ln), "+v"(ab));
#pragma unroll
            for (int cc = 63; cc >= 0; --cc) {
                float a = (ln == cc) ? 1.0f : 0.0f;
#pragma unroll
                for (int s = cc + 1; s < 64; ++s) a += T[s] * ab[cc * FP + s];
                T[cc] = a;
            }
            bf16* Tg = (bf16*)(ws + WS_B4) + chunk * 4096 + lane * 64;
#pragma unroll
            for (int q = 0; q < 8; ++q) { float o[8];
#pragma unroll
                for (int e = 0; e < 8; ++e) o[e] = T[q * 8 + e];
                const v4u w = pack8f(o); *(LAS v4u*)(TILE(8) + lane * TPB + q * 16) = w; *(GAS v4u*)(Tg + q * 8) = w; }
        } else if (wave >= 4) {
            const int rt2 = wave & 3;
#pragma unroll
            for (int ch2 = 0; ch2 < 2; ++ch2) { f32x4 acc[2] = {(f32x4){0.f, 0.f, 0.f, 0.f}, (f32x4){0.f, 0.f, 0.f, 0.f}};
                mm64(acc, TILE(7), TILE(6), rt2, ch2, fr, g);
                st_tr(TILE(2), acc, rt2, ch2, fr, g); }
        }
        __syncthreads();
        {
            f32x4 acc[2] = {(f32x4){0.f, 0.f, 0.f, 0.f}, (f32x4){0.f, 0.f, 0.f, 0.f}};
            mm64(acc, TILE(8), TILE(3), rt, ch, fr, g);
            f32x4 ac2[2] = {(f32x4){0.f, 0.f, 0.f, 0.f}, (f32x4){0.f, 0.f, 0.f, 0.f}};
            mm64(ac2, TILE(8), TILE(2), rt, ch, fr, g);
            __syncthreads();
            st_tr(TILE(1), acc, rt, ch, fr, g); st_tr(TILE(0), ac2, rt, ch, fr, g);
        }
        __syncthreads();
        {
            f32x4 acc[2] = {(f32x4){0.f, 0.f, 0.f, 0.f}, (f32x4){0.f, 0.f, 0.f, 0.f}};
            mm64(acc, TILE(1), TILE(4), rt, ch, fr, g);
            bf16* Mg = (bf16*)(ws + WS_B0) + chunk * 4096;
#pragma unroll
            for (int ct = 0; ct < 2; ++ct) { const int j1 = 32 * ch + 16 * ct + fr; const float wl = ((const LAS float*)(lds + CS_RK))[j1];
#pragma unroll
                for (int q = 0; q < 4; ++q) { const int j2 = 16 * rt + 4 * g + q; if (j2 == j1) acc[ct][q] += wl; }
                const int rtS = 2 * ch + ct, ksS = rt >> 1, half = rt & 1;
                *(GAS bf16x4s*)(Mg + (((rtS * 2 + ksS) * 64 + g * 16 + fr) * 8 + half * 4)) = pack4(acc[ct]); }
            f32x4 ad[2] = {(f32x4){0.f, 0.f, 0.f, 0.f}, (f32x4){0.f, 0.f, 0.f, 0.f}};
            mm64(ad, TILE(4), TILE(0), rt, ch, fr, g); mm64(ad, TILE(5), TILE(6), rt, ch, fr, g);
            bf16* Dg = (bf16*)OUTP() + chunk * 4096;
#pragma unroll
            for (int ct = 0; ct < 2; ++ct) *(GAS bf16x4s*)(Dg + (((2 * ch + ct) * 4 + rt) * 64 + lane) * 4) = pack4(ad[ct]);
        }
        __syncthreads();
    }
}

__device__ __forceinline__ void scan_s2(unsigned char* ws, int lane, int wave) {
    if (wave >= 4) return;
    const int ct = wave;
    for (int bh = blockIdx.x; bh < BATCH * NH; bh += gridDim.x) {
        const bf16* Mg = (const bf16*)(ws + WS_B0) + (size_t)bh * 128 * 4096; const bf16* Dg = (const bf16*)OUTP() + (size_t)bh * 128 * 4096; bf16* Sg = (bf16*)OUTP() + (size_t)M * C + (size_t)bh * 128 * 4096;
        f32x4 acc[4];
#pragma unroll
        for (int r = 0; r < 4; ++r) acc[r] = (f32x4){0.f, 0.f, 0.f, 0.f};
        bf16x8s mf[4][2]; bf16x4s df[4];
#pragma unroll
        for (int r = 0; r < 4; ++r) { df[r] = *(const GAS bf16x4s*)(Dg + ((ct * 4 + r) * 64 + lane) * 4);
#pragma unroll
            for (int ks = 0; ks < 2; ++ks) mf[r][ks] = *(const GAS bf16x8s*)(Mg + ((r * 2 + ks) * 64 + lane) * 8); }
#pragma unroll 1
        for (int c = 0; c < 128; ++c) {
            bf16x8s sf[2];
#pragma unroll
            for (int ks = 0; ks < 2; ++ks) { const bf16x4s lo = pack4(acc[2 * ks]), hi = pack4(acc[2 * ks + 1]); sf[ks] = (bf16x8s){lo[0], lo[1], lo[2], lo[3], hi[0], hi[1], hi[2], hi[3]}; }
#pragma unroll
            for (int ks = 0; ks < 2; ++ks) *(GAS bf16x8s*)(Sg + (size_t)c * 4096 + ((ct * 2 + ks) * 64 + lane) * 8) = sf[ks];
            bf16x8s mc[4][2]; f32x4 na[4];
#pragma unroll
            for (int r = 0; r < 4; ++r) { na[r] = (f32x4){bf2f((bf16)df[r][0]), bf2f((bf16)df[r][1]), bf2f((bf16)df[r][2]), bf2f((bf16)df[r][3])};
#pragma unroll
                for (int ks = 0; ks < 2; ++ks) mc[r][ks] = mf[r][ks]; }
            if (c + 1 < 128) {
                const bf16* Mn = Mg + (size_t)(c + 1) * 4096; const bf16* Dn = Dg + (size_t)(c + 1) * 4096;
#pragma unroll
                for (int r = 0; r < 4; ++r) { df[r] = *(const GAS bf16x4s*)(Dn + ((ct * 4 + r) * 64 + lane) * 4);
#pragma unroll
                    for (int ks = 0; ks < 2; ++ks) mf[r][ks] = *(const GAS bf16x8s*)(Mn + ((r * 2 + ks) * 64 + lane) * 8); }
            }
#pragma unroll
            for (int ks = 0; ks < 2; ++ks)
#pragma unroll
                for (int r = 0; r < 4; ++r) na[r] = __builtin_amdgcn_mfma_f32_16x16x32_bf16(mc[r][ks], sf[ks], na[r], 0, 0, 0);
#pragma unroll
            for (int r = 0; r < 4; ++r) acc[r] = na[r];
        }
    }
}

__device__ __forceinline__ void scan_s3(unsigned char* ws, LAS unsigned char* lds, int lane0, int wave) {
    const int rt = wave & 3, ch = wave >> 2;
    LAS float* Ys = (LAS float*)(lds + CS_FA); LAS float* Gs = Ys + 64 * FP;
    const bf16* LG = (const bf16*)(ws + WS_LG); const bf16* G2T = (const bf16*)(ws + WS_WT_G2); bf16* YG = (bf16*)(ws + WS_B0);
    for (int unit = blockIdx.x; unit < BATCH * NH * (SEQ / 64); unit += gridDim.x) {
        int lane = lane0; asm volatile("" : "+v"(lane));
        const int tid = wave * 64 + lane, fr = lane & 15, g = lane >> 4;
        const int h = unit & 15, c = (unit >> 4) & 127, b = unit >> 11; const size_t chunk = ((size_t)b * NH + h) * 128 + c; const size_t row0 = (size_t)b * SEQ + c * 64;
        float v8[8]; float rkb;
        chunk_front<3>(ws, lds, b, c, h, tid, lane, wave, v8, rkb);
        const bf16* Sg = (const bf16*)OUTP() + (size_t)M * C + chunk * 4096; const bf16* Tg = (const bf16*)(ws + WS_B4) + chunk * 4096;
        {
            f32x4 a1[2] = {(f32x4){0.f, 0.f, 0.f, 0.f}, (f32x4){0.f, 0.f, 0.f, 0.f}}, a2[2] = {(f32x4){0.f, 0.f, 0.f, 0.f}, (f32x4){0.f, 0.f, 0.f, 0.f}}, a3[2] = {(f32x4){0.f, 0.f, 0.f, 0.f}, (f32x4){0.f, 0.f, 0.f, 0.f}};
            mm64(a1, TILE(2), TILE(0), rt, ch, fr, g);
            mm64(a2, TILE(1), TILE(3), rt, ch, fr, g);
            mm64(a3, TILE(2), TILE(3), rt, ch, fr, g);
#pragma unroll
            for (int ct = 0; ct < 2; ++ct) { const int t = 32 * ch + 16 * ct + fr;
#pragma unroll
                for (int q = 0; q < 4; ++q) { const int s = 16 * rt + 4 * g + q; a1[ct][q] = s < t ? a1[ct][q] : 0.f; a2[ct][q] = s <= t ? a2[ct][q] : 0.f; a3[ct][q] = s <= t ? a3[ct][q] : 0.f; } }
            st_tr(TILE(5), a1, rt, ch, fr, g); st_tr(TILE(6), a2, rt, ch, fr, g); st_tr(TILE(7), a3, rt, ch, fr, g);
        }
        __syncthreads();
        {
            f32x4 acc[2] = {(f32x4){0.f, 0.f, 0.f, 0.f}, (f32x4){0.f, 0.f, 0.f, 0.f}};
#pragma unroll
            for (int ks = 0; ks < 2; ++ks) { const bf16x8s a = ldfrag_perm(TILE(0), 16 * rt + fr, ks, g);
#pragma unroll
                for (int ct = 0; ct < 2; ++ct) { const bf16x8s sfr = *(const GAS bf16x8s*)(Sg + (((2 * ch + ct) * 2 + ks) * 64 + lane) * 8); acc[ct] = __builtin_amdgcn_mfma_f32_16x16x32_bf16(a, sfr, acc[ct], 0, 0, 0); } }
            mm64(acc, TILE(5), TILE(4), rt, ch, fr, g);
            st_tr(TILE(8), acc, rt, ch, fr, g);
        }
        __syncthreads();
        {
            f32x4 acc[2] = {(f32x4){0.f, 0.f, 0.f, 0.f}, (f32x4){0.f, 0.f, 0.f, 0.f}};
#pragma unroll
            for (int ks = 0; ks < 2; ++ks) { const bf16x8s a = *(const GAS bf16x8s*)(Tg + (16 * rt + fr) * 64 + 32 * ks + 8 * g);
#pragma unroll
                for (int ct = 0; ct < 2; ++ct) { const bf16x8s bb = ldfrag(TILE(8), 32 * ch + 16 * ct + fr, 32 * ks + 8 * g); acc[ct] = __builtin_amdgcn_mfma_f32_16x16x32_bf16(a, bb, acc[ct], 0, 0, 0); } }
            st_tr(TILE(9), acc, rt, ch, fr, g);
        }
        __syncthreads();
        {
            f32x4 acc[2] = {(f32x4){0.f, 0.f, 0.f, 0.f}, (f32x4){0.f, 0.f, 0.f, 0.f}};
#pragma unroll
            for (int ks = 0; ks < 2; ++ks) { const bf16x8s a = *(const GAS bf16x8s*)(Sg + ((rt * 2 + ks) * 64 + lane) * 8);
#pragma unroll
                for (int ct = 0; ct < 2; ++ct) { const bf16x8s bb = ldfrag_perm(TILE(3), 32 * ch + 16 * ct + fr, ks, g); acc[ct] = __builtin_amdgcn_mfma_f32_16x16x32_bf16(a, bb, acc[ct], 0, 0, 0); } }
            mm64(acc, TILE(9), TILE(6), rt, ch, fr, g); mm64(acc, TILE(4), TILE(7), rt, ch, fr, g);
            f32x4 ag[2] = {(f32x4){0.f, 0.f, 0.f, 0.f}, (f32x4){0.f, 0.f, 0.f, 0.f}};
#pragma unroll
            for (int ks = 0; ks < 5; ++ks) { const bf16x8s a = *(const GAS bf16x8s*)(G2T + (size_t)(h * HD + 16 * rt + fr) * DG + 32 * ks + 8 * g);
#pragma unroll
                for (int ct = 0; ct < 2; ++ct) { const bf16x8s bb = *(const GAS bf16x8s*)(LG + (row0 + 32 * ch + 16 * ct + fr) * DG + 32 * ks + 8 * g); ag[ct] = __builtin_amdgcn_mfma_f32_16x16x32_bf16(a, bb, ag[ct], 0, 0, 0); } }
#pragma unroll
            for (int ct = 0; ct < 2; ++ct) { const int t = 32 * ch + 16 * ct + fr; *(LAS f32x4*)(Ys + t * FP + 16 * rt + 4 * g) = acc[ct]; *(LAS f32x4*)(Gs + t * FP + 16 * rt + 4 * g) = ag[ct]; }
        }
        __syncthreads();
        {
            const int t = tid >> 3, cq = tid & 7, c0 = h * HD + cq * 8;
            const f32x4 y0 = *(const LAS f32x4*)(Ys + t * FP + cq * 8), y1 = *(const LAS f32x4*)(Ys + t * FP + cq * 8 + 4), g0 = *(const LAS f32x4*)(Gs + t * FP + cq * 8), g1 = *(const LAS f32x4*)(Gs + t * FP + cq * 8 + 4);
            float y[8] = {y0[0], y0[1], y0[2], y0[3], y1[0], y1[1], y1[2], y1[3]}, gg[8] = {g0[0], g0[1], g0[2], g0[3], g1[0], g1[1], g1[2], g1[3]};
            float s = 0.f;
#pragma unroll
            for (int q = 0; q < 8; ++q) s += y[q];
            s += shx(s, 1, lane); s += shx(s, 2, lane); s += shx(s, 4, lane);
            const float mu = s * (1.0f / HD); float vs = 0.f;
#pragma unroll
            for (int q = 0; q < 8; ++q) { y[q] -= mu; vs += y[q] * y[q]; }
            vs += shx(vs, 1, lane); vs += shx(vs, 2, lane); vs += shx(vs, 4, lane);
            const float rstd = 1.0f / sqrtf(vs * (1.0f / HD) + GN_EPS);
            float o[8];
#pragma unroll
            for (int q = 0; q < 8; ++q) o[q] = (y[q] * rstd * INP(18)[c0 + q] + INP(19)[c0 + q] + rkb * v8[q]) * gg[q];
            *(GAS v4u*)(YG + (row0 + t) * C + c0) = pack8f(o);
        }
        __syncthreads();
    }
}
#undef TILE
#if MK_DEBUG
__device__ __forceinline__ void scan_naive(unsigned char* ws, LAS unsigned char* lds, int tid) {
    const int lane = tid & 63;
    const bf16* Rb = (const bf16*)(ws + WS_B1); const bf16* Kb = (const bf16*)(ws + WS_B2); const bf16* Vb = (const bf16*)(ws + WS_B3);
    const bf16* LW = (const bf16*)(ws + WS_LW); const bf16* LA = (const bf16*)(ws + WS_LA);
    float* Y = OUTP(); float* RK = (float*)(ws + WS_HID);
    LAS float* sR = (LAS float*)lds; LAS float* sK = sR + 4096; LAS float* sV = sK + 4096; LAS float* sA = sV + 4096; LAS float* sB = sA + 4096; LAS float* sD = sB + 4096;
    LAS float* sW2 = sD + 4096; LAS float* sA2 = sW2 + 4096;
    for (int unit = blockIdx.x; unit < BATCH * NH; unit += gridDim.x) {
        const int b = unit / NH, h = unit % NH;
        __syncthreads();
        for (int e = tid; e < 4096; e += 512) { const int d = e >> 6, j = e & 63; sW2[e] = INP(9)[(size_t)d * C + h * HD + j]; sA2[e] = INP(12)[(size_t)d * C + h * HD + j]; }
        __syncthreads();
        const int pt = tid >> 3, cq = tid & 7, c0 = h * HD + cq * 8;
        const int si = tid >> 3, jq = tid & 7;
        float S[8];
#pragma unroll
        for (int q = 0; q < 8; ++q) S[q] = 0.f;
        float w0v[8], a0v[8], kkv[8], kav[8], rkv[8];
#pragma unroll
        for (int q = 0; q < 8; ++q) { w0v[q] = INP(7)[c0 + q]; a0v[q] = INP(10)[c0 + q]; kkv[q] = INP(15)[c0 + q]; kav[q] = INP(16)[c0 + q]; rkv[q] = INP(17)[c0 + q]; }
        for (int blk = 0; blk < SEQ / 64; ++blk) {
            const size_t row = (size_t)b * SEQ + blk * 64 + pt;
            {
                const v4u r4 = *(const GAS v4u*)(Rb + row * C + c0), k4 = *(const GAS v4u*)(Kb + row * C + c0), v4 = *(const GAS v4u*)(Vb + row * C + c0);
                float r[8], k[8], v[8];
                r[0] = bflo(r4.x); r[1] = bfhi(r4.x); r[2] = bflo(r4.y); r[3] = bfhi(r4.y); r[4] = bflo(r4.z); r[5] = bfhi(r4.z); r[6] = bflo(r4.w); r[7] = bfhi(r4.w);
                k[0] = bflo(k4.x); k[1] = bfhi(k4.x); k[2] = bflo(k4.y); k[3] = bfhi(k4.y); k[4] = bflo(k4.z); k[5] = bfhi(k4.z); k[6] = bflo(k4.w); k[7] = bfhi(k4.w);
                v[0] = bflo(v4.x); v[1] = bfhi(v4.x); v[2] = bflo(v4.y); v[3] = bfhi(v4.y); v[4] = bflo(v4.z); v[5] = bfhi(v4.z); v[6] = bflo(v4.w); v[7] = bfhi(v4.w);
                float wp[8], ap[8];
#pragma unroll
                for (int q = 0; q < 8; ++q) { wp[q] = w0v[q]; ap[q] = a0v[q]; }
                for (int d = 0; d < 64; ++d) { const float lw = bf2f(LW[row * DW + d]), la = bf2f(LA[row * DA + d]);
#pragma unroll
                    for (int q = 0; q < 8; ++q) { wp[q] += lw * sW2[d * 64 + cq * 8 + q]; ap[q] += la * sA2[d * 64 + cq * 8 + q]; } }
                float kk[8], ss = 0.f, rks = 0.f;
#pragma unroll
                for (int q = 0; q < 8; ++q) { kk[q] = k[q] * kkv[q]; ss += kk[q] * kk[q]; }
                ss += shx(ss, 1, lane); ss += shx(ss, 2, lane); ss += shx(ss, 4, lane);
                const float inv = 1.0f / fmaxf(sqrtf(ss), 1e-12f);
#pragma unroll
                for (int q = 0; q < 8; ++q) { const float ag = sigmoidf_(ap[q]); const float kn = kk[q] * inv; const float kp = k[q] * (1.0f + (ag - 1.0f) * kav[q]);
                    const float lw = -0.6065306597126334f * sigmoidf_(wp[q]);
                    const int o = pt * 64 + cq * 8 + q;
                    sR[o] = r[q]; sK[o] = kp; sV[o] = v[q]; sA[o] = -kn; sB[o] = kn * ag; sD[o] = __expf(lw); rks += r[q] * kp * rkv[q]; }
                rks += shx(rks, 1, lane); rks += shx(rks, 2, lane); rks += shx(rks, 4, lane);
                if (cq == 0) RK[row * NH + h] = rks;
            }
            __syncthreads();
            for (int t = 0; t < 64; ++t) {
                const LAS f32x4* pa = (const LAS f32x4*)(sA + t * 64 + jq * 8); const LAS f32x4* pb = (const LAS f32x4*)(sB + t * 64 + jq * 8);
                const LAS f32x4* pd = (const LAS f32x4*)(sD + t * 64 + jq * 8); const LAS f32x4* pk = (const LAS f32x4*)(sK + t * 64 + jq * 8);
                const LAS f32x4* pr = (const LAS f32x4*)(sR + t * 64 + jq * 8);
                const f32x4 a0 = pa[0], a1 = pa[1], b0 = pb[0], b1 = pb[1], d0 = pd[0], d1 = pd[1], k0 = pk[0], k1 = pk[1], r0 = pr[0], r1 = pr[1];
                const float vi = sV[t * 64 + si];
                float sa = 0.f;
#pragma unroll
                for (int q = 0; q < 4; ++q) { sa += S[q] * a0[q]; sa += S[4 + q] * a1[q]; }
                sa += shx(sa, 1, lane); sa += shx(sa, 2, lane); sa += shx(sa, 4, lane);
                float y = 0.f;
#pragma unroll
                for (int q = 0; q < 4; ++q) { S[q] = S[q] * d0[q] + sa * b0[q] + vi * k0[q]; S[4 + q] = S[4 + q] * d1[q] + sa * b1[q] + vi * k1[q]; y += S[q] * r0[q]; y += S[4 + q] * r1[q]; }
                y += shx(y, 1, lane); y += shx(y, 2, lane); y += shx(y, 4, lane);
                if (jq == 0) Y[((size_t)b * SEQ + blk * 64 + t) * C + h * HD + si] = y;
            }
            __syncthreads();
        }
    }
}
__device__ __forceinline__ void post_scan(unsigned char* ws, int gw, int NGW, int lane) {
    const float* Y = OUTP(); const float* RK = (const float*)(ws + WS_HID); const bf16* Vb = (const bf16*)(ws + WS_B3); const bf16* LG = (const bf16*)(ws + WS_LG);
    bf16* YG = (bf16*)(ws + WS_B4); const float* g2 = INP(14); const float* lnw = INP(18); const float* lnb = INP(19);
    for (int it = gw; it < M * NH; it += NGW) {
        const int row = it / NH, h = it % NH, c = h * HD + lane;
        const float y = Y[(size_t)row * C + c];
        const float mu = wave_sum(y, lane) * (1.0f / HD); const float d = y - mu; const float var = wave_sum(d * d, lane) * (1.0f / HD);
        float o = d * (1.0f / sqrtf(var + GN_EPS)) * lnw[c] + lnb[c];
        o += RK[(size_t)row * NH + h] * bf2f(Vb[(size_t)row * C + c]);
        float g = 0.f;
        for (int dd = 0; dd < DG; ++dd) g += bf2f(LG[(size_t)row * DG + dd]) * g2[(size_t)dd * C + c];
        YG[(size_t)row * C + c] = (bf16)f2bf(o * g);
    }
}


constexpr int CW_DBG = 3200;
__device__ __forceinline__ void dbg_nonfinite(unsigned char* ws, const bf16* X, size_t n, int slot, int gw, int NGW, int lane, float thr = 1e30f) {
    unsigned* cw = (unsigned*)(ws + WS_CTL) + CW_DBG + 64 * slot; unsigned nnan = 0;
    for (size_t i = (size_t)gw * 64 + lane; i < n; i += (size_t)NGW * 64) { const float x = bf2f(X[i]); if (!(fabsf(x) < thr)) ++nnan; }
    if (nnan) atomicAdd(cw, nnan);
}
__device__ __forceinline__ void dbg_compare(unsigned char* ws, const bf16* X, const bf16* Y, int gw, int NGW, int lane) {
    unsigned* cw = (unsigned*)(ws + WS_CTL) + CW_DBG; unsigned nbad = 0, nnan = 0;
    for (size_t i = (size_t)gw * 64 + lane; i < (size_t)M * C; i += (size_t)NGW * 64) { const float x = bf2f(X[i]), y = bf2f(Y[i]);
        if (!(fabsf(x) < 1e30f)) ++nnan; else if (fabsf(x - y) > 0.05f * (fabsf(y) + 0.05f)) ++nbad; }
    if (nnan) atomicAdd(cw, nnan); if (nbad) atomicAdd(cw + 64, nbad);
}
#endif
__device__ __forceinline__ void router_rows(unsigned char* ws, LAS unsigned char* lds, int layer, int gw, int NGW, int lane, int tid) {
    const float* Hh = OUTP(); const float* gain = INP(2) + layer * C; bf16* XN = (bf16*)(ws + WS_B1);
    const float* wg = INP(24) + (size_t)layer * C * 4; const float* bg = INP(25) + layer * 4; const float* wi = INP(26) + (size_t)layer * C * 16; const float* bi = INP(27) + layer * 16;
    unsigned* cnt = (unsigned*)(ws + WS_CTL) + CW_CNT + layer * 16 * 64; unsigned* list = (unsigned*)(ws + WS_LIST); float* wl = (float*)(ws + WS_WL);
    LAS float* sWg = (LAS float*)lds; LAS float* sWi = sWg + C * 4;
    __syncthreads();
    for (int e = tid; e < C * 4; e += 512) sWg[e] = wg[e];
    for (int e = tid; e < C * 16; e += 512) sWi[e] = wi[e];
    __syncthreads();
    f32x4 g[4]; load_row(gain, lane, g);
    for (int row = gw; row < M; row += NGW) {
        f32x4 v[4]; load_row(Hh + (size_t)row * C, lane, v); const float rs = row_rs(v, lane);
#pragma unroll
        for (int j = 0; j < 4; ++j) v[j] = v[j] * rs * g[j];
        store_row_bf16(XN + (size_t)row * C, lane, v);
        float gl[4] = {0.f, 0.f, 0.f, 0.f};
        const LAS unsigned char* pWg = (const LAS unsigned char*)sWg + lane * 64;
#pragma unroll
        for (int j = 0; j < 4; ++j)
#pragma unroll
            for (int q = 0; q < 4; ++q) { const f32x4 w = *(const LAS f32x4*)(pWg + j * 4096 + q * 16); const float xv = v[j][q]; gl[0] += xv * w.x; gl[1] += xv * w.y; gl[2] += xv * w.z; gl[3] += xv * w.w; }
#pragma unroll
        for (int q = 0; q < 4; ++q) gl[q] = wave_sum(gl[q], lane) + bg[q];
        int gi = 0; float gm = gl[0];
#pragma unroll
        for (int q = 1; q < 4; ++q) if (gl[q] > gm) { gm = gl[q]; gi = q; }
        float gden = 0.f;
#pragma unroll
        for (int q = 0; q < 4; ++q) gden += __expf(gl[q] - gm);
        const float gval = 1.0f / gden;
        float il[4] = {0.f, 0.f, 0.f, 0.f};
        const LAS unsigned char* pWi = (const LAS unsigned char*)sWi + lane * 256 + gi * 16;
#pragma unroll
        for (int j = 0; j < 4; ++j)
#pragma unroll
            for (int q = 0; q < 4; ++q) { const f32x4 w = *(const LAS f32x4*)(pWi + j * 16384 + q * 64); const float xv = v[j][q]; il[0] += xv * w.x; il[1] += xv * w.y; il[2] += xv * w.z; il[3] += xv * w.w; }
#pragma unroll
        for (int q = 0; q < 4; ++q) il[q] = wave_sum(il[q], lane) + bi[gi * 4 + q];
        int i0 = 0; float m0 = il[0];
#pragma unroll
        for (int q = 1; q < 4; ++q) if (il[q] > m0) { m0 = il[q]; i0 = q; }
        int i1 = -1; float m1 = -INFINITY;
#pragma unroll
        for (int q = 0; q < 4; ++q) if (q != i0 && il[q] > m1) { m1 = il[q]; i1 = q; }
        const float e1 = __expf(m1 - m0); const float w0 = gval / (1.0f + e1), w1 = gval * e1 / (1.0f + e1);
        if (lane == 0) {
            const int ex0 = gi * 4 + i0, ex1 = gi * 4 + i1;
            const unsigned p0 = atomicAdd(cnt + ex0 * 64, 1u); list[(size_t)ex0 * M + p0] = (unsigned)row * 2u; wl[(size_t)ex0 * M + p0] = w0;
            const unsigned p1 = atomicAdd(cnt + ex1 * 64, 1u); list[(size_t)ex1 * M + p1] = (unsigned)row * 2u + 1u; wl[(size_t)ex1 * M + p1] = w1;
        }
    }
}
__device__ __forceinline__ void moe_table(unsigned char* ws, volatile LAS int* tab, int layer, int tid) {
    __syncthreads();
    if (tid == 0) { const unsigned* cnt = (const unsigned*)(ws + WS_CTL) + CW_CNT + layer * 16 * 64; int t = 0;
#pragma unroll 1
        for (int e = 0; e < 16; ++e) { const int c = (int)__hip_atomic_load(cnt, RLX_AGENT); cnt += 64; tab[e] = c; tab[16 + e] = t; t += (c + 255) >> 8; tab[32 + e] = t; }
        tab[48] = t; }
    __syncthreads();
}
__device__ __forceinline__ void combine_rows(unsigned char* ws, int mode, int gw, int NGW, int lane) {
    float* Hh = OUTP(); const bf16* E0 = (const bf16*)(ws + WS_B2); const bf16* E1 = (const bf16*)(ws + WS_B3); bf16* XN2 = (bf16*)(ws + WS_B0);
    f32x4 g[4]; load_row(INP(4), lane, g);
    for (int row = gw; row < M; row += NGW) {
        f32x4 v[4]; load_row(Hh + (size_t)row * C, lane, v);
#pragma unroll
        for (int j = 0; j < 4; ++j) { const v2u e0 = ((const GAS v2u*)(E0 + (size_t)row * C))[64 * j + lane], e1 = ((const GAS v2u*)(E1 + (size_t)row * C))[64 * j + lane];
            v[j].x += bflo(e0.x) + bflo(e1.x); v[j].y += bfhi(e0.x) + bfhi(e1.x); v[j].z += bflo(e0.y) + bflo(e1.y); v[j].w += bfhi(e0.y) + bfhi(e1.y); }
        const float rs = row_rs(v, lane);
        if (mode == 0) {
#pragma unroll
            for (int j = 0; j < 4; ++j) ((GAS f32x4*)(Hh + (size_t)row * C))[64 * j + lane] = v[j];
#pragma unroll
            for (int j = 0; j < 4; ++j) v[j] = v[j] * rs;
            store_row_bf16(XN2 + (size_t)row * C, lane, v);
        } else {
            float sig = 1.0f;
#if MK_DEBUG
            const unsigned* cw = (const unsigned*)(ws + WS_CTL) + CW_DBG; const unsigned nnan = __hip_atomic_load(cw, RLX_AGENT), nbad = __hip_atomic_load(cw + 64, RLX_AGENT);
            if (row < 512 && nnan > 0) sig = 2.0f;
            if (row >= 512 && row < 1536 && __hip_atomic_load(cw + 128, RLX_AGENT) > 0) sig = 2.0f;
            if (row >= 1536 && row < 3584 && __hip_atomic_load(cw + 192, RLX_AGENT) > 0) sig = 2.0f;
            if (row >= 3584 && row < 7680 && __hip_atomic_load(cw + 256, RLX_AGENT) > 0) sig = 2.0f;
            if (row >= 7680 && row < 15872 && __hip_atomic_load(cw + 320, RLX_AGENT) > 0) sig = 2.0f;
            if (row >= 15872 && nbad > (unsigned)(M / 100) * C) sig = 1.5f;
#endif
#pragma unroll
            for (int j = 0; j < 4; ++j) ((GAS f32x4*)(Hh + (size_t)row * C))[64 * j + lane] = v[j] * rs * g[j] * sig;
        }
    }
}
__device__ __forceinline__ void attn_naive(unsigned char* ws, int gw, int NGW, int lane) {
    const bf16* Kb = (const bf16*)(ws + WS_B1); const bf16* Vb = (const bf16*)(ws + WS_B2); const bf16* Qb = (const bf16*)(ws + WS_B3); bf16* Ob = (bf16*)(ws + WS_B0);
    for (int unit = gw; unit < BATCH * NH * (SEQ / 64); unit += NGW) {
        const int qb = unit % (SEQ / 64), bh = unit / (SEQ / 64), b = bh / NH, h = bh % NH;
        const int t0 = qb * 64, t = t0 + lane; const size_t rowq = (size_t)b * SEQ + t;
        float q[64], o[64];
#pragma unroll
        for (int c = 0; c < 8; ++c) { const v4u w = *(const GAS v4u*)(Qb + rowq * C + h * HD + c * 8);
            q[c * 8 + 0] = bflo(w.x) * 0.125f; q[c * 8 + 1] = bfhi(w.x) * 0.125f; q[c * 8 + 2] = bflo(w.y) * 0.125f; q[c * 8 + 3] = bfhi(w.y) * 0.125f;
            q[c * 8 + 4] = bflo(w.z) * 0.125f; q[c * 8 + 5] = bfhi(w.z) * 0.125f; q[c * 8 + 6] = bflo(w.w) * 0.125f; q[c * 8 + 7] = bfhi(w.w) * 0.125f; }
#pragma unroll
        for (int c = 0; c < 64; ++c) o[c] = 0.f;
        float suffix = 0.f;
        for (int s = t0 + 62; s >= 0; --s) {
            const bool valid = s < t;
            if (s < t0 && __all(suffix > SB_EXIT)) break;
            const bf16* kp = Kb + ((size_t)b * SEQ + s) * C + h * HD; const bf16* vp = Vb + ((size_t)b * SEQ + s) * C + h * HD;
            float z = 0.f;
#pragma unroll
            for (int c = 0; c < 8; ++c) { const v4u w = *(const GAS v4u*)(kp + c * 8);
                z += q[c * 8 + 0] * bflo(w.x) + q[c * 8 + 1] * bfhi(w.x) + q[c * 8 + 2] * bflo(w.y) + q[c * 8 + 3] * bfhi(w.y) + q[c * 8 + 4] * bflo(w.z) + q[c * 8 + 5] * bfhi(w.z) + q[c * 8 + 6] * bflo(w.w) + q[c * 8 + 7] * bfhi(w.w); }
            const float sp = fmaxf(z, 0.f) + log1pf(__expf(-fabsf(z)));
            const float att = valid ? __expf(z - sp - suffix) : 0.f;
            suffix += valid ? sp : 0.f;
#pragma unroll
            for (int c = 0; c < 8; ++c) { const v4u w = *(const GAS v4u*)(vp + c * 8);
                o[c * 8 + 0] += att * bflo(w.x); o[c * 8 + 1] += att * bfhi(w.x); o[c * 8 + 2] += att * bflo(w.y); o[c * 8 + 3] += att * bfhi(w.y);
                o[c * 8 + 4] += att * bflo(w.z); o[c * 8 + 5] += att * bfhi(w.z); o[c * 8 + 6] += att * bflo(w.w); o[c * 8 + 7] += att * bfhi(w.w); }
        }
#pragma unroll
        for (int c = 0; c < 8; ++c) { v4u w; w.x = pk2(o[c * 8 + 0], o[c * 8 + 1]); w.y = pk2(o[c * 8 + 2], o[c * 8 + 3]); w.z = pk2(o[c * 8 + 4], o[c * 8 + 5]); w.w = pk2(o[c * 8 + 6], o[c * 8 + 7]);
            *(GAS v4u*)(Ob + rowq * C + h * HD + c * 8) = w; }
    }
}

__global__ void __launch_bounds__(NWAVES * 64, 2) yoco_fwd(Args args) {
    extern __shared__ __attribute__((aligned(16))) unsigned char lds_raw[];
    LAS unsigned char* lds = (LAS unsigned char*)lds_raw;
    const int G = gridDim.x; const int bx = blockIdx.x;
    int wave = __builtin_amdgcn_readfirstlane(threadIdx.x >> 6); asm volatile("" : "+s"(wave));
#define IDS() int lane; asm volatile("v_mbcnt_lo_u32_b32 %0, -1, 0\n\tv_mbcnt_hi_u32_b32 %0, -1, %0" : "=v"(lane)); const int tid = wave * 64 + lane; (void)tid; \
    const int vcu = (G % 8 == 0) ? (bx % 8) * (G / 8) + bx / 8 : bx; const int gw = vcu * NWAVES + wave, NGW = G * NWAVES; (void)lane; (void)gw; (void)NGW;
    unsigned char* ws = WSP();
    volatile LAS unsigned* MISC = (volatile LAS unsigned*)(lds + MISC_OFF);
    volatile LAS int* tab = (volatile LAS int*)(lds + MOE_TAB_OFF);
    for (int u = threadIdx.x; u < (LDS_BYTES - LDSCTL_OFF) / 4; u += NWAVES * 64) ((LAS unsigned*)(lds + LDSCTL_OFF))[u] = 0u;
    __syncthreads();
    XcdBarrier bar; bar.bar = (unsigned*)(ws + WS_CTL) + CW_BAR; bar.x = 0; bar.st = nullptr;
    if (N_LAUNCHES == 1) bar = xcd_barrier_post((unsigned*)(ws + WS_CTL) + CW_BAR, MISC + 8);
    const int lo = KA_INT(0), hi = KA_INT(1);
#define IN(k) (lo <= (k) && (k) < hi)
#define SEAM(k) do { if (IN(k) && IN((k) + 1)) xcd_barrier(bar); } while (0)

    if (IN(PH_P0)) { IDS(); p0_weights(ws, lds, gw, NGW, wave, lane); p0_rows(ws, gw, NGW, lane); }
    SEAM(PH_P0);
    if (IN(PH_LORA)) {
        SchedGrouped<1, 3> S{(const char*)(ws + WS_B1), (size_t)(WS_B2 - WS_B1), nullptr, (const char*)(ws + WS_WT_LORA), (size_t)256 * C * 2, G, bx};
        EpiLora E{(bf16*)(ws + WS_LW)};
        pg8::gemm_phase<EpiLora, SchedGrouped<1, 3>, true, false, C>(lds, S, E, wave);
    }
    SEAM(PH_LORA);
    if (IN(PH_RKV)) {
        SchedGrouped<4, 3> S{(const char*)OUTP(), (size_t)M * C * 2, (const char*)(ws + WS_B4), (const char*)(ws + WS_WT_RKV), (size_t)C * C * 2, G, bx};
        EpiSplit3 E{(bf16*)(ws + WS_B1), false};
        pg8::gemm_phase<EpiSplit3, SchedGrouped<4, 3>, true, false, C>(lds, S, E, wave);
    }
    SEAM(PH_RKV);
    if (IN(PH_S1)) { IDS(); scan_s1(ws, lds, lane, wave); }
    SEAM(PH_S1);
    if (IN(PH_S2)) { IDS(); scan_s2(ws, lane, wave); }
    SEAM(PH_S2);
    if (IN(PH_S3)) { IDS(); scan_s3(ws, lds, lane, wave); }
    SEAM(PH_S3);
#if MK_DEBUG
    if (IN(PH_DBG0)) { IDS(); scan_naive(ws, lds, tid); }
    SEAM(PH_DBG0);
    if (IN(PH_DBG0 + 1)) { IDS(); post_scan(ws, gw, NGW, lane); }
    SEAM(PH_DBG0 + 1);
    if (IN(PH_DBG0 + 2)) { IDS(); dbg_compare(ws, (const bf16*)(ws + WS_B0), (const bf16*)(ws + WS_B4), gw, NGW, lane); }
    SEAM(PH_DBG0 + 2);
#endif
    if (IN(PH_WOUT)) {
        SchedGrouped<4, 1> S{(const char*)(ws + ((MK_DEBUG && DBG_USE_NAIVE) ? WS_B4 : WS_B0)), 0, nullptr, (const char*)(ws + WS_WT_OUT), 0, G, bx};
        EpiResid E{INP(0), OUTP()};
        pg8::gemm_phase<EpiResid, SchedGrouped<4, 1>, true, false, C>(lds, S, E, wave);
    }
    SEAM(PH_WOUT);
#pragma unroll 1
    for (int layer = 0; layer < 2; ++layer) {
        const int pb = layer == 0 ? (int)PH_ROUT0 : (int)PH_ROUT1;
        if (IN(pb)) { IDS(); router_rows(ws, lds, layer, gw, NGW, lane, tid); }
        SEAM(pb);
        if (IN(pb + 1)) {
            { IDS(); moe_table(ws, tab, layer, tid); }
            SchedMoe<2, C, true> S{(const char*)(ws + WS_B1), (const char*)(ws + WS_WT_GU) + (size_t)layer * 16 * 512 * C * 2, (size_t)512 * C * 2, (const unsigned*)(ws + WS_LIST), tab, G, bx};
            EpiGU E{(bf16*)(ws + WS_HID), (const float*)(ws + WS_WL)};
            pg8::gemm_phase<EpiGU, SchedMoe<2, C, true>, true, true, C>(lds, S, E, wave);
        }
        SEAM(pb + 1);
        if (IN(pb + 2)) {
            { IDS(); moe_table(ws, tab, layer, tid); }
            SchedMoe<4, FE, false> S{(const char*)(ws + WS_HID), (const char*)(ws + WS_WT_DN) + (size_t)layer * 16 * C * FE * 2, (size_t)C * FE * 2, (const unsigned*)(ws + WS_LIST), tab, G, bx};
            EpiDown E{(bf16*)(ws + WS_B2), (const unsigned*)(ws + WS_LIST)};
            pg8::gemm_phase<EpiDown, SchedMoe<4, FE, false>, true, false, FE>(lds, S, E, wave);
        }
        SEAM(pb + 2);
        if (layer == 0) {
            if (IN(PH_COMB)) { IDS(); combine_rows(ws, 0, gw, NGW, lane); }
            SEAM(PH_COMB);
            if (IN(PH_KVQ)) {
                SchedGrouped<12, 1> S{(const char*)(ws + WS_B0), 0, nullptr, (const char*)(ws + WS_WT_KVQ), 0, G, bx};
                EpiSplit3 E{(bf16*)(ws + WS_B1), true};
                pg8::gemm_phase<EpiSplit3, SchedGrouped<12, 1>, true, false, C>(lds, S, E, wave);
            }
            SEAM(PH_KVQ);
            if (IN(PH_ATTN)) { IDS(); attn_naive(ws, gw, NGW, lane); }
            SEAM(PH_ATTN);
            if (IN(PH_SBO)) {
                SchedGrouped<4, 1> S{(const char*)(ws + WS_B0), 0, nullptr, (const char*)(ws + WS_WT_SBO), 0, G, bx};
                EpiResid E{OUTP(), OUTP()};
                pg8::gemm_phase<EpiResid, SchedGrouped<4, 1>, true, false, C>(lds, S, E, wave);
            }
            SEAM(PH_SBO);
        }
    }
    if (IN(PH_FINAL)) { IDS(); combine_rows(ws, 1, gw, NGW, lane); }
#undef IN
#undef SEAM
}

extern "C" void kernel_launch(void* const* d_in, const int* in_sizes, int n_in, void* d_out, int out_size, void* d_ws, size_t ws_size, hipStream_t stream) {
    static int grid = 0;
    if (grid == 0) {
        if (n_in != 31 || in_sizes[0] != M * C || out_size != M * C || ws_size < WS_END) { fprintf(stderr, "kernel_launch: unexpected shapes (n_in %d, in0 %d, out %d, ws %zu); nothing launched\n", n_in, n_in > 0 ? in_sizes[0] : -1, out_size, ws_size); grid = -1; return; }
        int dev = 0, cus = 0, per_cu = 0;
        if (hipGetDevice(&dev) != hipSuccess || hipDeviceGetAttribute(&cus, hipDeviceAttributeMultiprocessorCount, dev) != hipSuccess) { grid = -1; return; }
        if (hipFuncSetAttribute((const void*)yoco_fwd, hipFuncAttributeMaxDynamicSharedMemorySize, LDS_BYTES) != hipSuccess) { fprintf(stderr, "kernel_launch: hipFuncSetAttribute failed\n"); grid = -1; return; }
        if (hipOccupancyMaxActiveBlocksPerMultiprocessor(&per_cu, (const void*)yoco_fwd, NWAVES * 64, LDS_BYTES) != hipSuccess || per_cu < 1) fprintf(stderr, "kernel_launch: occupancy query reports %d\n", per_cu);
        (void)hipGetLastError();
        grid = cus;
    }
    if (grid < 0) return;
    if (hipMemsetAsync((char*)d_ws + WS_CTL, 0, CTL_ZERO_BYTES, stream) != hipSuccess) return;
    Args a{};
    for (int i = 0; i < 31; ++i) a.in[i] = (const float*)d_in[i];
    a.out = (float*)d_out; a.ws = (unsigned char*)d_ws;
    for (int li = 0; li < (N_LAUNCHES == 1 ? 1 : (int)NPHASE); ++li) {
        a.ph_lo = (N_LAUNCHES == 1) ? 0 : li; a.ph_hi = (N_LAUNCHES == 1) ? NPHASE : li + 1; a.li = li;
        hipLaunchKernelGGL(yoco_fwd, dim3(grid), dim3(NWAVES * 64), LDS_BYTES, stream, a);
        const hipError_t le = hipPeekAtLastError();
        if (le != hipSuccess) { fprintf(stderr, "kernel_launch: launch %d failed: %s\n", li, hipGetErrorName(le)); break; }
    }
}
```

```cpp
#include <hip/hip_runtime.h>
#include <cstdio>
#include <cstdint>

#ifndef MK_N_LAUNCHES
#define MK_N_LAUNCHES 1
#endif

namespace pg8 {
#define PG8_LAS __attribute__((address_space(3)))
typedef unsigned short bf16_t;
typedef short bf16x8 __attribute__((ext_vector_type(8)));
typedef float f32x4 __attribute__((ext_vector_type(4)));
typedef unsigned u32x4 __attribute__((ext_vector_type(4)));
constexpr int BM = 256, BK = 64, HALF = 128, HTB = HALF * BK * 2, STAGE_BYTES = 8 * HTB, NXCD = 8, WGM = 8;

__host__ __device__ __forceinline__ int lds_byte(int r, int c) { const int st = (r >> 4) * 2 + (c >> 5), rr = r & 15, cc = c & 31, ob = rr * 64 + cc * 2; return st * 1024 + (ob ^ (((ob >> 9) & 1) << 5)); }
__host__ __device__ __forceinline__ void stage_rc(int b, int& R, int& C) { const int st = b / 1024, sb = b % 1024, swz = sb ^ (((sb >> 9) & 1) << 5); R = (st >> 1) * 16 + swz / 64; C = (st & 1) * 32 + (swz % 64) / 2; }
__host__ __device__ __forceinline__ int perm32(int rho) { const int n = rho >> 4, i = rho & 15; return 8 * (i >> 2) + 4 * n + (i & 3); }

struct Unit { int pm, pn, aux, r0, cnt; };

__host__ __device__ __forceinline__ void tile_map(int wgid, int nM, int nN, int& pm, int& pn) {
    const int nwg = nM * nN;
    { const int q = nwg / NXCD, r = nwg % NXCD, xcd = wgid % NXCD, off = wgid / NXCD; wgid = (xcd < r ? xcd * (q + 1) : r * (q + 1) + (xcd - r) * q) + off; }
    const int nig = WGM * nN, gid = wgid / nig, fm = gid * WGM, gsz = (nM - fm) < WGM ? (nM - fm) : WGM;
    pm = fm + ((wgid % nig) % gsz); pn = (wgid % nig) / gsz;
}

typedef float f32x2_t __attribute__((ext_vector_type(2))); typedef __bf16 bf16x2_t __attribute__((ext_vector_type(2)));
__device__ __forceinline__ unsigned cvt_pk_bf16(float lo, float hi) { const f32x2_t v = {lo, hi}; const bf16x2_t b = __builtin_convertvector(v, bf16x2_t); return __builtin_bit_cast(unsigned, b); }

template <class Epi, class Sched, bool ALIGN_EPI, bool GATHER, int K>
__device__ __forceinline__ void gemm_phase(PG8_LAS unsigned char* lds, const Sched& S, const Epi& E, const int wid) {
    int lane_; asm volatile("v_mbcnt_lo_u32_b32 %0, -1, 0\n\tv_mbcnt_hi_u32_b32 %0, -1, %0" : "=v"(lane_));
    const int lane = lane_, tid = wid * 64 + lane, wr = wid >> 2, wc = wid & 3, fr = lane & 15, fq = lane >> 4;
    constexpr int nt = K / BK;
    unsigned voffA[2], voffB[2];
#pragma unroll
    for (int i = 0; i < 2; ++i) { int R, C; stage_rc(tid * 16 + i * 8192, R, C); const int Rb = Epi::PERM ? ((R & ~31) + perm32(R & 31)) : R;
        voffA[i] = (unsigned)(R * K + C) * 2u; voffB[i] = (unsigned)(Rb * K + C) * 2u; }
    constexpr size_t kstep = (size_t)(BK * 2);
    constexpr size_t hstep = (size_t)HALF * K * 2;
    const unsigned ldsw = (unsigned)wid * 1024u;
    const int aoff = lds_byte(wr * 64 + fr, fq * 8), boff = lds_byte(wc * 32 + fr, fq * 8);
#define PG8_SA(b, h) (((b) * 2 + (h)) * HTB)
#define PG8_SB(b, h) ((4 + (b) * 2 + (h)) * HTB)
#define PG8_STAGE(bufoff, gbase, voff) do { _Pragma("unroll") for (int _i = 0; _i < 2; ++_i) \
        __builtin_amdgcn_global_load_lds((const unsigned*)((const char*)(gbase) + (voff)[_i]), (PG8_LAS unsigned*)(lds + (bufoff) + ldsw + _i * 8192), 16, 0, 0); } while (0)
#define PG8_LDA(dst, b, h) do { _Pragma("unroll") for (int m = 0; m < 4; ++m) _Pragma("unroll") for (int k = 0; k < 2; ++k) dst[m][k] = *(const PG8_LAS bf16x8*)(lds + PG8_SA(b, h) + aoff + m * 2048 + k * 1024); } while (0)
#define PG8_LDB(dst, b, h) do { _Pragma("unroll") for (int n = 0; n < 2; ++n) _Pragma("unroll") for (int k = 0; k < 2; ++k) dst[n][k] = *(const PG8_LAS bf16x8*)(lds + PG8_SB(b, h) + boff + n * 2048 + k * 1024); } while (0)
#define PG8_MMA(ai, bj, At, Bt) do { __builtin_amdgcn_s_setprio(1); _Pragma("unroll") for (int m = 0; m < 4; ++m) _Pragma("unroll") for (int n = 0; n < 2; ++n) _Pragma("unroll") for (int k = 0; k < 2; ++k) \
        acc[ai][bj][m][n] = __builtin_amdgcn_mfma_f32_16x16x32_bf16(Bt[n][k], At[m][k], acc[ai][bj][m][n], 0, 0, 0); __builtin_amdgcn_s_setprio(0); } while (0)
#define PG8_WAIT_V(n) asm volatile("s_waitcnt vmcnt(" #n ")" ::: "memory")
#define PG8_WAIT_L(n) asm volatile("s_waitcnt lgkmcnt(" #n ")" ::: "memory")
#define PG8_BAR __builtin_amdgcn_s_barrier()
#define PG8_SCHED __builtin_amdgcn_sched_barrier(0)
    Unit cur, nxt; int ui = 0;
    if (!S.next(0, cur)) return;
    f32x4 acc[2][2][4][2];
#pragma unroll
    for (int a = 0; a < 2; ++a)
#pragma unroll
        for (int b = 0; b < 2; ++b)
#pragma unroll
            for (int m = 0; m < 4; ++m)
#pragma unroll
                for (int n = 0; n < 2; ++n) acc[a][b][m][n] = (f32x4){0.f, 0.f, 0.f, 0.f};
    bf16x8 At[4][2], B0[2][2], B1[2][2];
    unsigned vc[2][2];
#define PG8_GOFF(u) do { _Pragma("unroll") for (int _h = 0; _h < 2; ++_h) _Pragma("unroll") for (int _i = 0; _i < 2; ++_i) { int _R, _C; stage_rc(tid * 16 + _i * 8192, _R, _C); \
        vc[_h][_i] = S.a_row_off(u, _h * HALF + _R) + (unsigned)_C * 2u; } } while (0)
#define PG8_STAGE_A(bufoff, gbase, h) do { if constexpr (GATHER) { PG8_STAGE(bufoff, gbase, vc[h]); } else { PG8_STAGE(bufoff, (gbase) + (h) * hstep, voffA); } } while (0)
    if constexpr (GATHER) PG8_GOFF(cur);
    const char* cA = S.a_base(cur); const char* cB = S.b_base(cur);
    PG8_STAGE(PG8_SB(0, 0), cB, voffB); PG8_STAGE(PG8_SB(0, 1), cB + hstep, voffB); PG8_STAGE_A(PG8_SA(0, 0), cA, 0); PG8_STAGE_A(PG8_SA(0, 1), cA, 1);
    if (wr == 1) PG8_BAR;
    PG8_WAIT_V(2); PG8_BAR;
    PG8_STAGE(PG8_SB(1, 0), cB + kstep, voffB); PG8_STAGE_A(PG8_SA(1, 0), cA + kstep, 0); PG8_STAGE(PG8_SB(1, 1), cB + hstep + kstep, voffB);
    PG8_WAIT_V(6); PG8_BAR;
    for (;;) {
        const bool has_next = S.next(ui + 1, nxt);
        const char* nA = has_next ? S.a_base(nxt) : cA; const char* nB = has_next ? S.b_base(nxt) : cB;
        for (int t = 0; t < nt; t += 2) {
            const bool last = (t == nt - 2);
            const char* a1 = cA + (size_t)(t + 1) * kstep;
            const char* a2 = last ? nA : cA + (size_t)(t + 2) * kstep; const char* b2 = last ? nB : cB + (size_t)(t + 2) * kstep;
            const char* a3 = a2 + kstep; const char* b3 = b2 + kstep;
            PG8_LDB(B0, 0, 0); PG8_LDB(B1, 0, 1); PG8_SCHED; PG8_LDA(At, 0, 0); PG8_STAGE_A(PG8_SA(1, 1), a1, 1);
            if constexpr (GATHER) { if (last && has_next) PG8_GOFF(nxt); }
            PG8_WAIT_V(8); PG8_WAIT_L(0); PG8_BAR; PG8_MMA(0, 0, At, B0); PG8_MMA(0, 1, At, B1); PG8_BAR; PG8_SCHED;
            PG8_LDA(At, 0, 1); PG8_STAGE(PG8_SB(0, 0), b2, voffB); PG8_STAGE(PG8_SB(0, 1), b2 + hstep, voffB); PG8_STAGE_A(PG8_SA(0, 0), a2, 0);
            PG8_WAIT_V(8); PG8_WAIT_L(0); PG8_BAR; PG8_MMA(1, 0, At, B0); PG8_MMA(1, 1, At, B1); PG8_BAR; PG8_SCHED;
            PG8_LDB(B0, 1, 0); PG8_LDB(B1, 1, 1); PG8_SCHED; PG8_LDA(At, 1, 0); PG8_STAGE_A(PG8_SA(0, 1), a2, 1);
            PG8_WAIT_V(8); PG8_WAIT_L(0); PG8_BAR; PG8_MMA(0, 0, At, B0); PG8_MMA(0, 1, At, B1); PG8_BAR; PG8_SCHED;
            PG8_LDA(At, 1, 1); PG8_STAGE(PG8_SB(1, 0), b3, voffB); PG8_STAGE(PG8_SB(1, 1), b3 + hstep, voffB); PG8_STAGE_A(PG8_SA(1, 0), a3, 0);
            PG8_WAIT_V(8); PG8_WAIT_L(0); PG8_BAR; PG8_MMA(1, 0, At, B0); PG8_MMA(1, 1, At, B1); PG8_BAR; PG8_SCHED;
        }
        if constexpr (ALIGN_EPI) { if (wr == 0) PG8_BAR; }
        E(acc, cur, wr, wc, fr, fq);
        if (!has_next) break;
#pragma unroll
        for (int a = 0; a < 2; ++a)
#pragma unroll
            for (int b = 0; b < 2; ++b)
#pragma unroll
                for (int m = 0; m < 4; ++m)
#pragma unroll
                    for (int n = 0; n < 2; ++n) acc[a][b][m][n] = (f32x4){0.f, 0.f, 0.f, 0.f};
        cur = nxt; cA = nA; cB = nB; ++ui;
        if constexpr (ALIGN_EPI) { if (wr == 1) PG8_BAR; }
    }
    PG8_WAIT_V(0);
    if constexpr (!ALIGN_EPI) { if (wr == 0) PG8_BAR; }
    PG8_BAR;
#undef PG8_SA
#undef PG8_SB
#undef PG8_STAGE
#undef PG8_STAGE_A
#undef PG8_GOFF
#undef PG8_LDA
#undef PG8_LDB
#undef PG8_MMA
#undef PG8_WAIT_V
#undef PG8_WAIT_L
#undef PG8_BAR
#undef PG8_SCHED
}
}

constexpr int NWAVES = 8;
#ifndef MK_DEBUG
#define MK_DEBUG 0
#endif
#ifndef DBG_USE_NAIVE
#define DBG_USE_NAIVE 0
#endif
constexpr int DBGP = MK_DEBUG ? 3 : 0;
enum Phase { PH_P0 = 0, PH_LORA, PH_RKV, PH_S1, PH_S2, PH_S3, PH_DBG0, PH_WOUT = PH_DBG0 + DBGP, PH_ROUT0, PH_GU0, PH_DN0, PH_COMB, PH_KVQ, PH_ATTN, PH_SBO, PH_ROUT1, PH_GU1, PH_DN1, PH_FINAL, NPHASE };
constexpr int N_LAUNCHES = MK_N_LAUNCHES;


constexpr int BATCH = 2, SEQ = 8192, C = 1024, NH = 16, HD = 64, M = BATCH * SEQ;
constexpr int NE = 16, FE = 256, DW = 64, DA = 64, DG = 160;
constexpr float RMS_EPS = 1e-6f, GN_EPS = 64e-5f;
constexpr float SB_EXIT = 104.0f;

constexpr size_t MiB = 1u << 20;
constexpr size_t WS_CTL = 0, CTL_ZERO_BYTES = 64 * 1024;
constexpr size_t WS_WT_W2 = 128 * 1024, WS_WT_A2 = 256 * 1024, WS_WT_G2 = 384 * 1024;
constexpr size_t WS_WT_RKV = 1 * MiB;
constexpr size_t WS_WT_LORA = 7 * MiB;
constexpr size_t WS_WT_OUT = 9 * MiB;
constexpr size_t WS_WT_KVQ = 11 * MiB;
constexpr size_t WS_WT_SBO = 17 * MiB;
constexpr size_t WS_WT_GU = 19 * MiB;
constexpr size_t WS_WT_DN = 51 * MiB;
constexpr size_t WS_LW = 67 * MiB;
constexpr size_t WS_LA = 69 * MiB;
constexpr size_t WS_LG = 71 * MiB;
static_assert(WS_LA == WS_LW + 2 * MiB && WS_LG == WS_LW + 4 * MiB, "EpiLora's pointer arithmetic");
constexpr size_t WS_LIST = 76 * MiB;
constexpr size_t WS_WL = 77 * MiB;
constexpr size_t WS_HID = 78 * MiB;
constexpr size_t WS_B0 = 96 * MiB, WS_B1 = 128 * MiB, WS_B2 = 160 * MiB, WS_B3 = 192 * MiB, WS_B4 = 224 * MiB, WS_END = 256 * MiB;
static_assert(WS_HID + (size_t)144 * 256 * 256 * 2 <= WS_B0, "HID vs B0");
constexpr int CW_TMO = 0;
constexpr int CW_CNT = 1024;
constexpr int CW_BAR = 4096;

constexpr int RING_BYTES = 131072;
constexpr int LDSCTL_OFF = RING_BYTES, MISC_OFF = LDSCTL_OFF + 320, MOE_TAB_OFF = MISC_OFF + 128;
constexpr int LDS_BYTES = 147456;
static_assert(MOE_TAB_OFF + 256 <= LDS_BYTES, "LDS map");

#define GAS __attribute__((address_space(1)))
#define LAS __attribute__((address_space(3)))
typedef unsigned short bf16;
typedef unsigned v4u __attribute__((ext_vector_type(4)));
typedef unsigned v2u __attribute__((ext_vector_type(2)));
typedef float f32x4 __attribute__((ext_vector_type(4)));
typedef GAS unsigned gu32;
#define RLX_AGENT __ATOMIC_RELAXED, __HIP_MEMORY_SCOPE_AGENT
#define LDS_WAIT() asm volatile("s_waitcnt lgkmcnt(0)" ::: "memory")
#define VM_WAIT() asm volatile("s_waitcnt vmcnt(0)" ::: "memory")
__device__ __forceinline__ unsigned f2bf(float f) { unsigned u = __builtin_bit_cast(unsigned, f); return (u + 0x7fffu + ((u >> 16) & 1u)) >> 16; }
__device__ __forceinline__ unsigned pk2(float lo, float hi) { return f2bf(lo) | (f2bf(hi) << 16); }
__device__ __forceinline__ float bflo(unsigned u) { return __uint_as_float(u << 16); }
__device__ __forceinline__ float bfhi(unsigned u) { return __uint_as_float(u & 0xffff0000u); }
__device__ __forceinline__ float bf2f(bf16 b) { return __uint_as_float((unsigned)b << 16); }
__device__ __forceinline__ float sigmoidf_(float x) { return 1.0f / (1.0f + __expf(-x)); }

#define XB_TMO      128
#define XB_XCNT(j)  (256  + 64 * (j))
#define XB_XSUB(j)  (1280 + 64 * (j))
#define XB_XGEN(j)  (2304 + 64 * (j))
#define XB_TOP      3328
#define XB_TOPGEN   3392
#define XCD_BAR_WORDS 3456
#define XB_SPIN_CAP (1u << 18)
__device__ __forceinline__ unsigned xb_ld(unsigned* p)              { return __hip_atomic_load(p, __ATOMIC_RELAXED, __HIP_MEMORY_SCOPE_AGENT); }
__device__ __forceinline__ unsigned xb_add(unsigned* p, unsigned v) { return __hip_atomic_fetch_add(p, v, __ATOMIC_RELAXED, __HIP_MEMORY_SCOPE_AGENT); }
__device__ __forceinline__ unsigned xb_xcc_id() { return (unsigned)__builtin_amdgcn_s_getreg((3 << 11) | 20) & 0xFu; }
#define XB_SPIN(cond, bar) do { unsigned _sp = 0; while (cond) { __builtin_amdgcn_s_sleep(1); \
    if ((++_sp & 255u) == 0u) { if (xb_ld(&(bar)[XB_TMO])) break; if (_sp > XB_SPIN_CAP) { atomicAdd(&(bar)[XB_TMO], 1u); break; } } } } while (0)
struct XcdBarrier { unsigned* bar; unsigned x; volatile LAS unsigned* st; };
__device__ __forceinline__ XcdBarrier xcd_barrier_post(unsigned* bar, volatile LAS unsigned* st) {
    XcdBarrier b; b.bar = bar; b.x = xb_xcc_id(); b.st = st;
    if (threadIdx.x == 0) (void)xb_add(&bar[XB_XCNT(b.x)], 1u);
    return b;
}
__device__ __forceinline__ void xcd_barrier_complete(unsigned* bar, unsigned x, unsigned& nloc, unsigned& nx) {
    const unsigned G = gridDim.x * gridDim.y * gridDim.z;
    unsigned sum, cnt, mine, sp = 0u;
    for (;;) {
        sum = 0u; cnt = 0u; mine = 0u;
#pragma unroll
        for (unsigned j = 0; j < 16; ++j) { const unsigned c = xb_ld(&bar[XB_XCNT(j)]); sum += c; cnt += (c > 0u) ? 1u : 0u; mine = (j == x) ? c : mine; }
        if (sum == G) break;
        __builtin_amdgcn_s_sleep(1);
        if ((++sp & 255u) == 0u) { if (xb_ld(&bar[XB_TMO])) break; if (sp > XB_SPIN_CAP) { atomicAdd(&bar[XB_TMO], 1u); break; } }
    }
    nloc = mine > 0u ? mine : 1u; nx = cnt > 0u ? cnt : 1u;
}
__device__ __forceinline__ void xcd_barrier(const XcdBarrier& b) {
    asm volatile("s_waitcnt vmcnt(0)" ::: "memory");
    __syncthreads();
    if (threadIdx.x == 0) {
        unsigned* bar = b.bar;
        __builtin_amdgcn_s_waitcnt(0);
        unsigned nloc = b.st[0], nx = b.st[1];
        if (nloc == 0u) { xcd_barrier_complete(bar, b.x, nloc, nx); b.st[0] = nloc; b.st[1] = nx; }
        const unsigned old = xb_add(&bar[XB_XSUB(b.x)], 1u);
        const unsigned gen = old / nloc;
        if (old + 1u == (gen + 1u) * nloc) {
            __builtin_amdgcn_fence(__ATOMIC_RELEASE, "agent");
            asm volatile("s_waitcnt vmcnt(0)" ::: "memory");
            const unsigned og = xb_add(&bar[XB_TOP], 1u);
            const unsigned tg = og / nx;
            if (og + 1u == (tg + 1u) * nx) xb_add(&bar[XB_TOPGEN], 1u);
            else XB_SPIN(xb_ld(&bar[XB_TOPGEN]) == tg, bar);
            __builtin_amdgcn_fence(__ATOMIC_ACQUIRE, "agent");
            xb_add(&bar[XB_XGEN(b.x)], 1u);
            asm volatile("s_waitcnt vmcnt(0)" ::: "memory");
        } else {
            XB_SPIN(xb_ld(&bar[XB_XGEN(b.x)]) == gen, bar);
            __builtin_amdgcn_fence(__ATOMIC_ACQUIRE, "agent");
            asm volatile("s_waitcnt vmcnt(0)" ::: "memory");
        }
    }
    __syncthreads();
}

__device__ __forceinline__ float shx(float v, int o, int lane) { return __int_as_float(__builtin_amdgcn_ds_bpermute((lane ^ o) << 2, __float_as_int(v))); }
__device__ __forceinline__ float wave_sum(float v, int lane) {
#pragma unroll
    for (int o = 1; o < 64; o <<= 1) v += shx(v, o, lane);
    return v;
}
__device__ __forceinline__ void transpose_item(const float* W, int ldw, int k0, int n0, bf16* WT, int ldk, int dst_row0, const float* kscale, LAS float* scr, int lane, int kmax = 1 << 30) {
#pragma unroll 8
    for (int i = 0; i < 32; ++i) { const int kk = 2 * i + (lane >> 5); float v = (k0 + kk < kmax) ? W[(size_t)(k0 + kk) * ldw + n0 + (lane & 31)] : 0.f; if (kscale) v *= kscale[k0 + kk]; scr[kk * 33 + (lane & 31)] = v; }
    LDS_WAIT(); asm volatile("" ::: "memory");
    const int c = lane & 7;
#pragma unroll
    for (int j = 0; j < 4; ++j) { const int n = (lane >> 3) + 8 * j; const LAS float* s = scr + (8 * c) * 33 + n;
        v4u o; o.x = pk2(s[0 * 33], s[1 * 33]); o.y = pk2(s[2 * 33], s[3 * 33]); o.z = pk2(s[4 * 33], s[5 * 33]); o.w = pk2(s[6 * 33], s[7 * 33]);
        if (k0 + 8 * c < kmax) *(GAS v4u*)(WT + (size_t)(dst_row0 + n) * ldk + k0 + 8 * c) = o; }
    LDS_WAIT(); asm volatile("" ::: "memory");
}

struct Args { const float* in[31]; float* out; unsigned char* ws; int ph_lo, ph_hi, li, pad; };
typedef const __attribute__((address_space(4))) unsigned char* kaptr_t;
__device__ __forceinline__ kaptr_t ka_base() { kaptr_t p = (kaptr_t)__builtin_amdgcn_kernarg_segment_ptr(); asm volatile("" : "+s"(p)); return p; }
#define INP(k) (*(const float* const __attribute__((address_space(4)))*)(ka_base() + 8 * (k)))
#define OUTP() (*(float* const __attribute__((address_space(4)))*)(ka_base() + 8 * 31))
#define WSP() (*(unsigned char* const __attribute__((address_space(4)))*)(ka_base() + 8 * 32))
#define KA_INT(i) (*(const int __attribute__((address_space(4)))*)(ka_base() + 8 * 33 + 4 * (i)))

__device__ __forceinline__ void p0_weights(unsigned char* ws, LAS unsigned char* lds, int gw, int NGW, int wave, int lane) {
    LAS float* scr = (LAS float*)(lds + wave * 16384);
    bf16* WT_RKV = (bf16*)(ws + WS_WT_RKV); bf16* WT_LORA = (bf16*)(ws + WS_WT_LORA); bf16* WT_OUT = (bf16*)(ws + WS_WT_OUT); bf16* WT_KVQ = (bf16*)(ws + WS_WT_KVQ);
    bf16* WT_SBO = (bf16*)(ws + WS_WT_SBO); bf16* WT_GU = (bf16*)(ws + WS_WT_GU); bf16* WT_DN = (bf16*)(ws + WS_WT_DN);
    constexpr int I_UP = 32 + 32 + 96, I_RKV = 3 * 512, I_LORA = 32 + 32 + 80, I_OUT = 512, I_KV = 1024, I_Q = 512, I_SBO = 512, I_G = 32 * 128, I_U = 32 * 128, I_D = 32 * 128;
    constexpr int NITEMS = I_UP + I_RKV + I_LORA + I_OUT + I_KV + I_Q + I_SBO + I_G + I_U + I_D;
    for (int it = gw; it < NITEMS; it += NGW) {
        int r = it;
        if (r < I_UP) {
            if (r < 32) transpose_item(INP(9), C, 0, 32 * r, (bf16*)(ws + WS_WT_W2), 64, 32 * r, nullptr, scr, lane);
            else if (r < 64) transpose_item(INP(12), C, 0, 32 * (r - 32), (bf16*)(ws + WS_WT_A2), 64, 32 * (r - 32), nullptr, scr, lane);
            else { const int q = r - 64, kb = q / 32, nb = q % 32; transpose_item(INP(14), C, 64 * kb, 32 * nb, (bf16*)(ws + WS_WT_G2), DG, 32 * nb, nullptr, scr, lane, DG); }
            continue; } r -= I_UP;
        if (r < I_RKV) { const int m = r / 512, q = r % 512, kb = q / 32, nb = q % 32; transpose_item(INP(6) + (size_t)m * C * C, C, 64 * kb, 32 * nb, WT_RKV, C, m * C + 32 * nb, nullptr, scr, lane); continue; } r -= I_RKV;
        if (r < I_LORA) {
            if (r < 32) { const int kb = r / 2, nb = r % 2; transpose_item(INP(8), DW, 64 * kb, 32 * nb, WT_LORA, C, 32 * nb, nullptr, scr, lane); }
            else if (r < 64) { const int q = r - 32, kb = q / 2, nb = q % 2; transpose_item(INP(11), DA, 64 * kb, 32 * nb, WT_LORA, C, 256 + 32 * nb, nullptr, scr, lane); }
            else { const int q = r - 64, kb = q / 5, nb = q % 5; transpose_item(INP(13), DG, 64 * kb, 32 * nb, WT_LORA, C, 512 + 32 * nb, nullptr, scr, lane); }
            continue; } r -= I_LORA;
        if (r < I_OUT) { const int kb = r / 32, nb = r % 32; transpose_item(INP(20), C, 64 * kb, 32 * nb, WT_OUT, C, 32 * nb, nullptr, scr, lane); continue; } r -= I_OUT;
        if (r < I_KV) { const int kb = r / 64, nb = r % 64; transpose_item(INP(21), 2 * C, 64 * kb, 32 * nb, WT_KVQ, C, 32 * nb, INP(3), scr, lane); continue; } r -= I_KV;
        if (r < I_Q) { const int kb = r / 32, nb = r % 32; transpose_item(INP(22), C, 64 * kb, 32 * nb, WT_KVQ, C, 2 * C + 32 * nb, INP(1) + C, scr, lane); continue; } r -= I_Q;
        if (r < I_SBO) { const int kb = r / 32, nb = r % 32; transpose_item(INP(23), C, 64 * kb, 32 * nb, WT_SBO, C, 32 * nb, nullptr, scr, lane); continue; } r -= I_SBO;
        if (r < I_G) { const int le = r / 128, q = r % 128, kb = q / 8, nb = q % 8, f0 = 32 * nb; transpose_item(INP(28) + (size_t)le * C * FE, FE, 64 * kb, f0, WT_GU + (size_t)le * 512 * C, C, 256 * (f0 / 128) + (f0 % 128), nullptr, scr, lane); continue; } r -= I_G;
        if (r < I_U) { const int le = r / 128, q = r % 128, kb = q / 8, nb = q % 8, f0 = 32 * nb; transpose_item(INP(29) + (size_t)le * C * FE, FE, 64 * kb, f0, WT_GU + (size_t)le * 512 * C, C, 256 * (f0 / 128) + 128 + (f0 % 128), nullptr, scr, lane); continue; } r -= I_U;
        { const int le = r / 128, q = r % 128, kb = q / 32, nb = q % 32; transpose_item(INP(30) + (size_t)le * FE * C, C, 64 * kb, 32 * nb, WT_DN + (size_t)le * C * FE, FE, 32 * nb, nullptr, scr, lane); }
    }
    for (int it = gw * 64 + lane; it < 768 * 128; it += NGW * 64) { const int row = it >> 7, ch = it & 127;
        const bool valid = (row < 64) || (row >= 256 && row < 320) || (row >= 512 && row < 672);
        if (!valid) *(GAS v4u*)(WT_LORA + (size_t)row * C + ch * 8) = (v4u){0u, 0u, 0u, 0u}; }
}
__device__ __forceinline__ void load_row(const float* p, int lane, f32x4 (&v)[4]) {
#pragma unroll
    for (int j = 0; j < 4; ++j) v[j] = ((const GAS f32x4*)p)[64 * j + lane];
}
__device__ __forceinline__ float row_rs(const f32x4 (&v)[4], int lane) {
    float s = 0.f;
#pragma unroll
    for (int j = 0; j < 4; ++j) s += (v[j].x * v[j].x + v[j].y * v[j].y) + (v[j].z * v[j].z + v[j].w * v[j].w);
    return 1.0f / sqrtf(wave_sum(s, lane) * (1.0f / C) + RMS_EPS);
}
__device__ __forceinline__ void store_row_bf16(bf16* p, int lane, const f32x4 (&v)[4]) {
#pragma unroll
    for (int j = 0; j < 4; ++j) { v2u o; o.x = pk2(v[j].x, v[j].y); o.y = pk2(v[j].z, v[j].w); ((GAS v2u*)p)[64 * j + lane] = o; }
}
__device__ __forceinline__ void p0_rows(unsigned char* ws, int gw, int NGW, int lane) {
    const float* x = INP(0); const float* gain = INP(1); const float* mix = INP(5);
    f32x4 g[4]; load_row(gain, lane, g);
    for (int run = gw; run < M / 8; run += NGW) {
        const int r0 = run * 8;
        f32x4 prev[4];
        if ((r0 % SEQ) == 0) {
#pragma unroll
            for (int j = 0; j < 4; ++j) prev[j] = (f32x4){0.f, 0.f, 0.f, 0.f};
        } else { load_row(x + (size_t)(r0 - 1) * C, lane, prev); const float rs = row_rs(prev, lane);
#pragma unroll
            for (int j = 0; j < 4; ++j) prev[j] = prev[j] * rs * g[j]; }
        for (int rr = 0; rr < 8; ++rr) {
            const int row = r0 + rr;
            f32x4 hn[4]; load_row(x + (size_t)row * C, lane, hn); const float rs = row_rs(hn, lane);
#pragma unroll
            for (int j = 0; j < 4; ++j) hn[j] = hn[j] * rs * g[j];
#pragma unroll
            for (int i = 0; i < 6; ++i) { f32x4 o[4];
#pragma unroll
                for (int j = 0; j < 4; ++j) { const f32x4 mx = ((const GAS f32x4*)(mix + i * C))[64 * j + lane]; o[j] = hn[j] + (prev[j] - hn[j]) * mx; }
                bf16* dst = i < 2 ? (bf16*)OUTP() + (size_t)i * M * C : (i == 2 ? (bf16*)(ws + WS_B4) : (bf16*)(ws + WS_B1) + (size_t)(i - 3) * M * C);
                store_row_bf16(dst + (size_t)row * C, lane, o); }
#pragma unroll
            for (int j = 0; j < 4; ++j) prev[j] = hn[j];
        }
    }
}

template <int NN, int NGROUPS> struct SchedGrouped {
    static constexpr int K = C;
    const char* A0; size_t astride; const char* A2; const char* B; size_t bgroup;
    int G, c;
    __device__ __forceinline__ bool next(int i, pg8::Unit& u) const {
        const int L = i * G + c; constexpr int per = 64 * NN; if (L >= per * NGROUPS) return false;
        const int g = L / per, w = L % per; pg8::tile_map(w, 64, NN, u.pm, u.pn); u.aux = g; u.r0 = 0; u.cnt = 0; return true; }
    __device__ __forceinline__ const char* a_base(const pg8::Unit& u) const { const char* A = (A2 != nullptr && u.aux == 2) ? A2 : A0 + (size_t)u.aux * astride; return A + (size_t)u.pm * 256 * K * 2; }
    __device__ __forceinline__ const char* b_base(const pg8::Unit& u) const { return B + (size_t)u.aux * bgroup + (size_t)u.pn * 256 * K * 2; }
    __device__ __forceinline__ unsigned a_row_off(const pg8::Unit&, int) const { return 0u; }
};
template <int NN, int K, bool GATHER> struct SchedMoe {
    const char* A; const char* B; size_t bexp; const unsigned* list; volatile LAS int* tab; int G, c;
    __device__ __forceinline__ bool next(int i, pg8::Unit& u) const {
        const int L = i * G + c; const int tot = __builtin_amdgcn_readfirstlane(tab[48]) * NN; if (L >= tot) return false;
        u.pm = L / NN; u.pn = L % NN; int e = 0;
#pragma unroll
        for (int j = 0; j < 16; ++j) e += (u.pm >= tab[32 + j]) ? 1 : 0;
        e = __builtin_amdgcn_readfirstlane(e);
        u.aux = e; u.r0 = (u.pm - __builtin_amdgcn_readfirstlane(tab[16 + e])) * 256; u.cnt = __builtin_amdgcn_readfirstlane(tab[e]); return true; }
    __device__ __forceinline__ const char* a_base(const pg8::Unit& u) const { return GATHER ? A : A + (size_t)u.pm * 256 * K * 2; }
    __device__ __forceinline__ const char* b_base(const pg8::Unit& u) const { return B + (size_t)u.aux * bexp + (size_t)u.pn * 256 * K * 2; }
    __device__ __forceinline__ unsigned a_row_off(const pg8::Unit& u, int r) const {
        const int idx = u.r0 + r; unsigned tok = 0u;
        if (idx < u.cnt) tok = list[(size_t)u.aux * M + idx] >> 1;
        return tok * (unsigned)(K * 2); }
};

using pg8::f32x4;
using pg8::Unit;
__device__ __forceinline__ v4u pack8(f32x4 v0, f32x4 v1) { v4u w; w.x = pg8::cvt_pk_bf16(v0[0], v0[1]); w.y = pg8::cvt_pk_bf16(v0[2], v0[3]); w.z = pg8::cvt_pk_bf16(v1[0], v1[1]); w.w = pg8::cvt_pk_bf16(v1[2], v1[3]); return w; }

struct EpiLora {
    static constexpr bool PERM = true;
    bf16* LW;
    __device__ __forceinline__ void operator()(const f32x4 (&acc)[2][2][4][2], const Unit& u, int wr, int wc, int fr, int fq) const {
        { int l_; asm volatile("v_mbcnt_lo_u32_b32 %0, -1, 0\n\tv_mbcnt_hi_u32_b32 %0, -1, %0" : "=v"(l_)); fr = l_ & 15; fq = l_ >> 4; }
        const int g = u.aux, width = g == 2 ? DG : DW; bf16* out = LW + (size_t)g * (1u << 20);
        const int row0 = u.pm * 256 + wr * 64 + fr;
#pragma unroll
        for (int bj = 0; bj < 2; ++bj) { const int col0 = bj * 128 + wc * 32 + 8 * fq; if (col0 < width) {
#pragma unroll
            for (int ai = 0; ai < 2; ++ai)
#pragma unroll
                for (int m = 0; m < 4; ++m) { f32x4 v0 = acc[ai][bj][m][0], v1 = acc[ai][bj][m][1];
                    if (g == 0) {
#pragma unroll
                        for (int q = 0; q < 4; ++q) { v0[q] = tanhf(v0[q]); v1[q] = tanhf(v1[q]); } }
                    else if (g == 2) {
#pragma unroll
                        for (int q = 0; q < 4; ++q) { v0[q] = sigmoidf_(v0[q]); v1[q] = sigmoidf_(v1[q]); } }
                    *(GAS v4u*)(out + (size_t)(row0 + ai * 128 + m * 16) * width + col0) = pack8(v0, v1); } } }
    }
};
struct EpiSplit3 {
    static constexpr bool PERM = true;
    bf16* O0; bool bycol;
    __device__ __forceinline__ void operator()(const f32x4 (&acc)[2][2][4][2], const Unit& u, int wr, int wc, int fr, int fq) const {
        { int l_; asm volatile("v_mbcnt_lo_u32_b32 %0, -1, 0\n\tv_mbcnt_hi_u32_b32 %0, -1, %0" : "=v"(l_)); fr = l_ & 15; fq = l_ >> 4; }
        const int g = bycol ? (u.pn >> 2) : u.aux, pn = bycol ? (u.pn & 3) : u.pn; bf16* out = O0 + (size_t)g * ((size_t)M * C);
        const int row0 = u.pm * 256 + wr * 64 + fr, col0 = pn * 256 + wc * 32 + 8 * fq;
#pragma unroll
        for (int ai = 0; ai < 2; ++ai)
#pragma unroll
            for (int m = 0; m < 4; ++m)
#pragma unroll
                for (int bj = 0; bj < 2; ++bj) *(GAS v4u*)(out + (size_t)(row0 + ai * 128 + m * 16) * C + col0 + bj * 128) = pack8(acc[ai][bj][m][0], acc[ai][bj][m][1]);
    }
};
struct EpiResid {
    static constexpr bool PERM = false;
    const float* base; float* out;
    __device__ __forceinline__ void operator()(const f32x4 (&acc)[2][2][4][2], const Unit& u, int wr, int wc, int fr, int fq) const {
        { int l_; asm volatile("v_mbcnt_lo_u32_b32 %0, -1, 0\n\tv_mbcnt_hi_u32_b32 %0, -1, %0" : "=v"(l_)); fr = l_ & 15; fq = l_ >> 4; }
        const int row0 = u.pm * 256 + wr * 64 + fr, col0 = u.pn * 256 + wc * 32 + 4 * fq;
#pragma unroll
        for (int ai = 0; ai < 2; ++ai)
#pragma unroll
            for (int m = 0; m < 4; ++m) { const size_t off = (size_t)(row0 + ai * 128 + m * 16) * C + col0;
#pragma unroll
                for (int bj = 0; bj < 2; ++bj)
#pragma unroll
                    for (int n = 0; n < 2; ++n) { const f32x4 b = *(const GAS f32x4*)(base + off + bj * 128 + n * 16); *(GAS f32x4*)(out + off + bj * 128 + n * 16) = b + acc[ai][bj][m][n]; } }
    }
};
struct EpiGU {
    static constexpr bool PERM = true;
    bf16* HID; const float* wl;
    __device__ __forceinline__ void operator()(const f32x4 (&acc)[2][2][4][2], const Unit& u, int wr, int wc, int fr, int fq) const {
        { int l_; asm volatile("v_mbcnt_lo_u32_b32 %0, -1, 0\n\tv_mbcnt_hi_u32_b32 %0, -1, %0" : "=v"(l_)); fr = l_ & 15; fq = l_ >> 4; }
        const int e = u.aux, cnt = u.cnt, base = u.r0, r0 = wr * 64 + fr, col0 = u.pn * 128 + wc * 32 + 8 * fq;
#pragma unroll
        for (int ai = 0; ai < 2; ++ai)
#pragma unroll
            for (int m = 0; m < 4; ++m) { const int r = r0 + ai * 128 + m * 16, idx = base + r; float w = 0.f; if (idx < cnt) w = wl[(size_t)e * M + idx];
                f32x4 h0, h1;
#pragma unroll
                for (int q = 0; q < 4; ++q) { const float g0 = acc[ai][0][m][0][q], g1 = acc[ai][0][m][1][q];
                    h0[q] = g0 * sigmoidf_(g0) * acc[ai][1][m][0][q] * w; h1[q] = g1 * sigmoidf_(g1) * acc[ai][1][m][1][q] * w; }
                *(GAS v4u*)(HID + (size_t)(u.pm * 256 + r) * FE + col0) = pack8(h0, h1);
                asm volatile("" ::: "memory"); }
    }
};
struct EpiDown {
    static constexpr bool PERM = true;
    bf16* EO; const unsigned* list;
    __device__ __forceinline__ void operator()(const f32x4 (&acc)[2][2][4][2], const Unit& u, int wr, int wc, int fr, int fq) const {
        { int l_; asm volatile("v_mbcnt_lo_u32_b32 %0, -1, 0\n\tv_mbcnt_hi_u32_b32 %0, -1, %0" : "=v"(l_)); fr = l_ & 15; fq = l_ >> 4; }
        const int e = u.aux, cnt = u.cnt, base = u.r0, r0 = wr * 64 + fr, col0 = u.pn * 256 + wc * 32 + 8 * fq;
#pragma unroll
        for (int ai = 0; ai < 2; ++ai)
#pragma unroll
            for (int m = 0; m < 4; ++m) { const int idx = base + r0 + ai * 128 + m * 16;
                if (idx < cnt) { const unsigned ent = list[(size_t)e * M + idx]; bf16* o = EO + ((size_t)(ent & 1u) * M + (ent >> 1)) * C + col0;
#pragma unroll
                    for (int bj = 0; bj < 2; ++bj) *(GAS v4u*)(o + bj * 128) = pack8(acc[ai][bj][m][0], acc[ai][bj][m][1]); }
                asm volatile("" ::: "memory"); }
    }
};

typedef short bf16x8s __attribute__((ext_vector_type(8)));
typedef short bf16x4s __attribute__((ext_vector_type(4)));
constexpr int TPB = 144;
constexpr int TILE_B = 64 * TPB;
constexpr int FP = 68;
constexpr int CS_FA = 0, CS_FB = 16384, CS_TILES = 36864, CS_TOT = 129024, CS_RK = 132096;
#define TILE(n) (lds + CS_TILES + (n) * TILE_B)
__device__ __forceinline__ bf16x8s ldfrag(const LAS unsigned char* tile, int row, int kcol) { return *(const LAS bf16x8s*)(tile + row * TPB + kcol * 2); }
__device__ __forceinline__ bf16x8s ldfrag_perm(const LAS unsigned char* tile, int row, int ks, int g) {
    const bf16x4s lo = *(const LAS bf16x4s*)(tile + row * TPB + (32 * ks + 4 * g) * 2), hi = *(const LAS bf16x4s*)(tile + row * TPB + (32 * ks + 16 + 4 * g) * 2);
    return (bf16x8s){lo[0], lo[1], lo[2], lo[3], hi[0], hi[1], hi[2], hi[3]};
}
__device__ __forceinline__ void mm64(f32x4 (&acc)[2], const LAS unsigned char* At, const LAS unsigned char* Bt, int rt, int ch, int fr, int g) {
#pragma unroll
    for (int ks = 0; ks < 2; ++ks) { const bf16x8s a = ldfrag(At, 16 * rt + fr, 32 * ks + 8 * g);
#pragma unroll
        for (int ct = 0; ct < 2; ++ct) { const bf16x8s b = ldfrag(Bt, 32 * ch + 16 * ct + fr, 32 * ks + 8 * g); acc[ct] = __builtin_amdgcn_mfma_f32_16x16x32_bf16(a, b, acc[ct], 0, 0, 0); } }
}
__device__ __forceinline__ bf16x4s pack4(f32x4 v) { v2u w; w.x = pg8::cvt_pk_bf16(v[0], v[1]); w.y = pg8::cvt_pk_bf16(v[2], v[3]); return __builtin_bit_cast(bf16x4s, w); }
__device__ __forceinline__ void st_tr(LAS unsigned char* Out, const f32x4 (&acc)[2], int rt, int ch, int fr, int g) {
#pragma unroll
    for (int ct = 0; ct < 2; ++ct) *(LAS bf16x4s*)(Out + (32 * ch + 16 * ct + fr) * TPB + (16 * rt + 4 * g) * 2) = pack4(acc[ct]);
}
__device__ __forceinline__ void unpack8(v4u w, float (&o)[8]) { o[0] = bflo(w.x); o[1] = bfhi(w.x); o[2] = bflo(w.y); o[3] = bfhi(w.y); o[4] = bflo(w.z); o[5] = bfhi(w.z); o[6] = bflo(w.w); o[7] = bfhi(w.w); }
__device__ __forceinline__ v4u pack8f(const float (&o)[8]) { v4u w; w.x = pg8::cvt_pk_bf16(o[0], o[1]); w.y = pg8::cvt_pk_bf16(o[2], o[3]); w.z = pg8::cvt_pk_bf16(o[4], o[5]); w.w = pg8::cvt_pk_bf16(o[6], o[7]); return w; }

template <int MODE>
__device__ __forceinline__ void chunk_front(unsigned char* ws, LAS unsigned char* lds, int b, int c, int h, int tid, int lane, int wave, float (&v8)[8], float& rkb) {
    const int rt = wave & 3, ch = wave >> 2, fr = lane & 15, g = lane >> 4;
    const size_t row0 = (size_t)b * SEQ + c * 64;
    const bf16* Rb = (const bf16*)(ws + WS_B1); const bf16* Kb = (const bf16*)(ws + WS_B2); const bf16* Vb = (const bf16*)(ws + WS_B3);
    const bf16* LW = (const bf16*)(ws + WS_LW); const bf16* LA = (const bf16*)(ws + WS_LA);
    const bf16* W2T = (const bf16*)(ws + WS_WT_W2); const bf16* A2T = (const bf16*)(ws + WS_WT_A2);
    LAS float* FA = (LAS float*)(lds + CS_FA); LAS float* FB = (LAS float*)(lds + CS_FB); LAS float* TOT = (LAS float*)(lds + CS_TOT);
    {
        f32x4 aw[2], aa[2];
#pragma unroll
        for (int ct = 0; ct < 2; ++ct) { aw[ct] = (f32x4){0.f, 0.f, 0.f, 0.f}; aa[ct] = (f32x4){0.f, 0.f, 0.f, 0.f}; }
#pragma unroll
        for (int ks = 0; ks < 2; ++ks) {
            const bf16x8s fw = *(const GAS bf16x8s*)(LW + (row0 + 16 * rt + fr) * DW + 32 * ks + 8 * g), fa = *(const GAS bf16x8s*)(LA + (row0 + 16 * rt + fr) * DA + 32 * ks + 8 * g);
#pragma unroll
            for (int ct = 0; ct < 2; ++ct) { const size_t wr_ = (size_t)(h * HD + 32 * ch + 16 * ct + fr) * 64 + 32 * ks + 8 * g;
                aw[ct] = __builtin_amdgcn_mfma_f32_16x16x32_bf16(fw, *(const GAS bf16x8s*)(W2T + wr_), aw[ct], 0, 0, 0);
                aa[ct] = __builtin_amdgcn_mfma_f32_16x16x32_bf16(fa, *(const GAS bf16x8s*)(A2T + wr_), aa[ct], 0, 0, 0); } }
#pragma unroll
        for (int ct = 0; ct < 2; ++ct) { const int j = 32 * ch + 16 * ct + fr; const float w0 = INP(7)[h * HD + j], a0 = INP(10)[h * HD + j];
#pragma unroll
            for (int q = 0; q < 4; ++q) { const int t = 16 * rt + 4 * g + q; FA[t * 64 + j] = -0.6065306597126334f * sigmoidf_(w0 + aw[ct][q]); FB[t * 64 + j] = sigmoidf_(a0 + aa[ct][q]); } }
    }
    __syncthreads();
    {
        const int j = tid & 63, seg = tid >> 6; float run = 0.f; float loc[8];
#pragma unroll
        for (int q = 0; q < 8; ++q) { run += FA[(8 * seg + q) * 64 + j]; loc[q] = run; }
        TOT[seg * 64 + j] = run;
        __syncthreads();
        float off = 0.f;
#pragma unroll
        for (int s2 = 0; s2 < 7; ++s2) off += (s2 < seg) ? TOT[s2 * 64 + j] : 0.f;
#pragma unroll
        for (int q = 0; q < 8; ++q) FA[(8 * seg + q) * 64 + j] = loc[q] + off;
    }
    __syncthreads();
    {
        const int t = tid >> 3, cq = tid & 7, c0 = h * HD + cq * 8; const size_t row = row0 + t;
        float r[8], k[8];
        unpack8(*(const GAS v4u*)(Rb + row * C + c0), r); unpack8(*(const GAS v4u*)(Kb + row * C + c0), k); unpack8(*(const GAS v4u*)(Vb + row * C + c0), v8);
        float cw[8], cwp[8], ag[8], wl[8];
#pragma unroll
        for (int q = 0; q < 8; ++q) { cw[q] = FA[t * 64 + cq * 8 + q]; cwp[q] = t > 0 ? FA[(t - 1) * 64 + cq * 8 + q] : 0.f; ag[q] = FB[t * 64 + cq * 8 + q]; wl[q] = FA[63 * 64 + cq * 8 + q]; }
        float kk[8], ss = 0.f; rkb = 0.f;
#pragma unroll
        for (int q = 0; q < 8; ++q) { kk[q] = k[q] * INP(15)[c0 + q]; ss += kk[q] * kk[q]; }
        ss += shx(ss, 1, lane); ss += shx(ss, 2, lane); ss += shx(ss, 4, lane);
        const float inv = 1.0f / fmaxf(sqrtf(ss), 1e-12f);
        float at[8], bt[8], kt[8], rt_[8], bh[8], kh[8];
#pragma unroll
        for (int q = 0; q < 8; ++q) { const float kn = kk[q] * inv, kp = k[q] * (1.0f + (ag[q] - 1.0f) * INP(16)[c0 + q]);
            const float ein = __expf(-cw[q]);
            at[q] = -kn * __expf(cwp[q]); bt[q] = kn * ag[q] * ein; kt[q] = kp * ein; rt_[q] = r[q] * __expf(cw[q]);
            const float ewl = __expf(wl[q]); bh[q] = bt[q] * ewl; kh[q] = kt[q] * ewl;
            rkb += r[q] * kp * INP(17)[c0 + q]; }
        rkb += shx(rkb, 1, lane); rkb += shx(rkb, 2, lane); rkb += shx(rkb, 4, lane);
        *(LAS v4u*)(TILE(0) + t * TPB + cq * 16) = pack8f(at); *(LAS v4u*)(TILE(1) + t * TPB + cq * 16) = pack8f(bt); *(LAS v4u*)(TILE(2) + t * TPB + cq * 16) = pack8f(kt);
        if (MODE == 3) *(LAS v4u*)(TILE(3) + t * TPB + cq * 16) = pack8f(rt_);
#pragma unroll
        for (int q = 0; q < 8; ++q) { const int o = (cq * 8 + q) * TPB + t * 2;
            if (MODE == 1) { *(LAS bf16*)(TILE(3) + o) = (bf16)f2bf(at[q]); *(LAS bf16*)(TILE(4) + o) = (bf16)f2bf(bh[q]); *(LAS bf16*)(TILE(5) + o) = (bf16)f2bf(kh[q]); *(LAS bf16*)(TILE(6) + o) = (bf16)f2bf(v8[q]); }
            else { *(LAS bf16*)(TILE(4) + o) = (bf16)f2bf(v8[q]); } }
        if (MODE == 1 && t == 63) {
#pragma unroll
            for (int q = 0; q < 8; ++q) ((LAS float*)(lds + CS_RK))[cq * 8 + q] = __expf(wl[q]); }
    }
    __syncthreads();
}

__device__ __forceinline__ void scan_s1(unsigned char* ws, LAS unsigned char* lds, int lane0, int wave) {
    const int rt = wave & 3, ch = wave >> 2;
    LAS float* AabT = (LAS float*)(lds + CS_FA);
    for (int unit = blockIdx.x; unit < BATCH * NH * (SEQ / 64); unit += gridDim.x) {
        int lane = lane0; asm volatile("" : "+v"(lane));
        const int tid = wave * 64 + lane, fr = lane & 15, g = lane >> 4;
        const int h = unit & 15, c = (unit >> 4) & 127, b = unit >> 11; const size_t chunk = ((size_t)b * NH + h) * 128 + c;
        float v8[8]; float rkb;
        chunk_front<1>(ws, lds, b, c, h, tid, lane, wave, v8, rkb);
        {
            f32x4 acc[2] = {(f32x4){0.f, 0.f, 0.f, 0.f}, (f32x4){0.f, 0.f, 0.f, 0.f}};
            mm64(acc, TILE(0), TILE(1), rt, ch, fr, g);
#pragma unroll
            for (int ct = 0; ct < 2; ++ct) { const int cc = 32 * ch + 16 * ct + fr; f32x4 o;
#pragma unroll
                for (int q = 0; q < 4; ++q) { const int s = 16 * rt + 4 * g + q; o[q] = cc < s ? acc[ct][q] : 0.f; }
                *(LAS f32x4*)(AabT + cc * FP + 16 * rt + 4 * g) = o; }
            f32x4 ac2[2] = {(f32x4){0.f, 0.f, 0.f, 0.f}, (f32x4){0.f, 0.f, 0.f, 0.f}};
            mm64(ac2, TILE(2), TILE(0), rt, ch, fr, g);
#pragma unroll
            for (int ct = 0; ct < 2; ++ct) { const int t = 32 * ch + 16 * ct + fr;
#pragma unroll
                for (int q = 0; q < 4; ++q) { const int s = 16 * rt + 4 * g + q; ac2[ct][q] = s < t ? ac2[ct][q] : 0.f; } }
            st_tr(TILE(7), ac2, rt, ch, fr, g);
        }
        __syncthreads();
        if (wave == 0) {
            float T[64]; int ln = lane; const LAS float* ab = AabT; asm volatile("" : "+v"(ln), "+v"(ab));
#pragma unroll
            for (int cc = 63; cc >= 0; --cc) {
                float a = (ln == cc) ? 1.0f : 0.0f;
#pragma unroll
                for (int s = cc + 1; s < 64; ++s) a += T[s] * ab[cc * FP + s];
                T[cc] = a;
            }
            bf16* Tg = (bf16*)(ws + WS_B4) + chunk * 4096 + lane * 64;
#pragma unroll
            for (int q = 0; q < 8; ++q) { float o[8];
#pragma unroll
                for (int e = 0; e < 8; ++e) o[e] = T[q * 8 + e];
                const v4u w = pack8f(o); *(LAS v4u*)(TILE(8) + lane * TPB + q * 16) = w; *(GAS v4u*)(Tg + q * 8) = w; }
        } else if (wave >= 4) {
            const int rt2 = wave & 3;
#pragma unroll
            for (int ch2 = 0; ch2 < 2; ++ch2) { f32x4 acc[2] = {(f32x4){0.f, 0.f, 0.f, 0.f}, (f32x4){0.f, 0.f, 0.f, 0.f}};
                mm64(acc, TILE(7), TILE(6), rt2, ch2, fr, g);
                st_tr(TILE(2), acc, rt2, ch2, fr, g); }
        }
        __syncthreads();
        {
            f32x4 acc[2] = {(f32x4){0.f, 0.f, 0.f, 0.f}, (f32x4){0.f, 0.f, 0.f, 0.f}};
            mm64(acc, TILE(8), TILE(3), rt, ch, fr, g);
            f32x4 ac2[2] = {(f32x4){0.f, 0.f, 0.f, 0.f}, (f32x4){0.f, 0.f, 0.f, 0.f}};
            mm64(ac2, TILE(8), TILE(2), rt, ch, fr, g);
            __syncthreads();
            st_tr(TILE(1), acc, rt, ch, fr, g); st_tr(TILE(0), ac2, rt, ch, fr, g);
        }
        __syncthreads();
        {
            f32x4 acc[2] = {(f32x4){0.f, 0.f, 0.f, 0.f}, (f32x4){0.f, 0.f, 0.f, 0.f}};
            mm64(acc, TILE(1), TILE(4), rt, ch, fr, g);
            bf16* Mg = (bf16*)(ws + WS_B0) + chunk * 4096;
#pragma unroll
            for (int ct = 0; ct < 2; ++ct) { const int j1 = 32 * ch + 16 * ct + fr; const float wl = ((const LAS float*)(lds + CS_RK))[j1];
#pragma unroll
                for (int q = 0; q < 4; ++q) { const int j2 = 16 * rt + 4 * g + q; if (j2 == j1) acc[ct][q] += wl; }
                const int rtS = 2 * ch + ct, ksS = rt >> 1, half = rt & 1;
                *(GAS bf16x4s*)(Mg + (((rtS * 2 + ksS) * 64 + g * 16 + fr) * 8 + half * 4)) = pack4(acc[ct]); }
            f32x4 ad[2] = {(f32x4){0.f, 0.f, 0.f, 0.f}, (f32x4){0.f, 0.f, 0.f, 0.f}};
            mm64(ad, TILE(4), TILE(0), rt, ch, fr, g); mm64(ad, TILE(5), TILE(6), rt, ch, fr, g);
            bf16* Dg = (bf16*)OUTP() + chunk * 4096;
#pragma unroll
            for (int ct = 0; ct < 2; ++ct) *(GAS bf16x4s*)(Dg + (((2 * ch + ct) * 4 + rt) * 64 + lane) * 4) = pack4(ad[ct]);
        }
        __syncthreads();
    }
}

__device__ __forceinline__ void scan_s2(unsigned char* ws, int lane, int wave) {
    if (wave >= 4) return;
    const int ct = wave;
    for (int bh = blockIdx.x; bh < BATCH * NH; bh += gridDim.x) {
        const bf16* Mg = (const bf16*)(ws + WS_B0) + (size_t)bh * 128 * 4096; const bf16* Dg = (const bf16*)OUTP() + (size_t)bh * 128 * 4096; bf16* Sg = (bf16*)OUTP() + (size_t)M * C + (size_t)bh * 128 * 4096;
        f32x4 acc[4];
#pragma unroll
        for (int r = 0; r < 4; ++r) acc[r] = (f32x4){0.f, 0.f, 0.f, 0.f};
        bf16x8s mf[4][2]; bf16x4s df[4];
#pragma unroll
        for (int r = 0; r < 4; ++r) { df[r] = *(const GAS bf16x4s*)(Dg + ((ct * 4 + r) * 64 + lane) * 4);
#pragma unroll
            for (int ks = 0; ks < 2; ++ks) mf[r][ks] = *(const GAS bf16x8s*)(Mg + ((r * 2 + ks) * 64 + lane) * 8); }
#pragma unroll 1
        for (int c = 0; c < 128; ++c) {
            bf16x8s sf[2];
#pragma unroll
            for (int ks = 0; ks < 2; ++ks) { const bf16x4s lo = pack4(acc[2 * ks]), hi = pack4(acc[2 * ks + 1]); sf[ks] = (bf16x8s){lo[0], lo[1], lo[2], lo[3], hi[0], hi[1], hi[2], hi[3]}; }
#pragma unroll
            for (int ks = 0; ks < 2; ++ks) *(GAS bf16x8s*)(Sg + (size_t)c * 4096 + ((ct * 2 + ks) * 64 + lane) * 8) = sf[ks];
            bf16x8s mc[4][2]; f32x4 na[4];
#pragma unroll
            for (int r = 0; r < 4; ++r) { na[r] = (f32x4){bf2f((bf16)df[r][0]), bf2f((bf16)df[r][1]), bf2f((bf16)df[r][2]), bf2f((bf16)df[r][3])};
#pragma unroll
                for (int ks = 0; ks < 2; ++ks) mc[r][ks] = mf[r][ks]; }
            if (c + 1 < 128) {
                const bf16* Mn = Mg + (size_t)(c + 1) * 4096; const bf16* Dn = Dg + (size_t)(c + 1) * 4096;
#pragma unroll
                for (int r = 0; r < 4; ++r) { df[r] = *(const GAS bf16x4s*)(Dn + ((ct * 4 + r) * 64 + lane) * 4);
#pragma unroll
                    for (int ks = 0; ks < 2; ++ks) mf[r][ks] = *(const GAS bf16x8s*)(Mn + ((r * 2 + ks) * 64 + lane) * 8); }
            }
#pragma unroll
            for (int ks = 0; ks < 2; ++ks)
#pragma unroll
                for (int r = 0; r < 4; ++r) na[r] = __builtin_amdgcn_mfma_f32_16x16x32_bf16(mc[r][ks], sf[ks], na[r], 0, 0, 0);
#pragma unroll
            for (int r = 0; r < 4; ++r) acc[r] = na[r];
        }
    }
}

__device__ __forceinline__ void scan_s3(unsigned char* ws, LAS unsigned char* lds, int lane0, int wave) {
    const int rt = wave & 3, ch = wave >> 2;
    LAS float* Ys = (LAS float*)(lds + CS_FA); LAS float* Gs = Ys + 64 * FP;
    const bf16* LG = (const bf16*)(ws + WS_LG); const bf16* G2T = (const bf16*)(ws + WS_WT_G2); bf16* YG = (bf16*)(ws + WS_B0);
    for (int unit = blockIdx.x; unit < BATCH * NH * (SEQ / 64); unit += gridDim.x) {
        int lane = lane0; asm volatile("" : "+v"(lane));
        const int tid = wave * 64 + lane, fr = lane & 15, g = lane >> 4;
        const int h = unit & 15, c = (unit >> 4) & 127, b = unit >> 11; const size_t chunk = ((size_t)b * NH + h) * 128 + c; const size_t row0 = (size_t)b * SEQ + c * 64;
        float v8[8]; float rkb;
        chunk_front<3>(ws, lds, b, c, h, tid, lane, wave, v8, rkb);
        const bf16* Sg = (const bf16*)OUTP() + (size_t)M * C + chunk * 4096; const bf16* Tg = (const bf16*)(ws + WS_B4) + chunk * 4096;
        {
            f32x4 a1[2] = {(f32x4){0.f, 0.f, 0.f, 0.f}, (f32x4){0.f, 0.f, 0.f, 0.f}}, a2[2] = {(f32x4){0.f, 0.f, 0.f, 0.f}, (f32x4){0.f, 0.f, 0.f, 0.f}}, a3[2] = {(f32x4){0.f, 0.f, 0.f, 0.f}, (f32x4){0.f, 0.f, 0.f, 0.f}};
            mm64(a1, TILE(2), TILE(0), rt, ch, fr, g);
            mm64(a2, TILE(1), TILE(3), rt, ch, fr, g);
            mm64(a3, TILE(2), TILE(3), rt, ch, fr, g);
#pragma unroll
            for (int ct = 0; ct < 2; ++ct) { const int t = 32 * ch + 16 * ct + fr;
#pragma unroll
                for (int q = 0; q < 4; ++q) { const int s = 16 * rt + 4 * g + q; a1[ct][q] = s < t ? a1[ct][q] : 0.f; a2[ct][q] = s <= t ? a2[ct][q] : 0.f; a3[ct][q] = s <= t ? a3[ct][q] : 0.f; } }
            st_tr(TILE(5), a1, rt, ch, fr, g); st_tr(TILE(6), a2, rt, ch, fr, g); st_tr(TILE(7), a3, rt, ch, fr, g);
        }
        __syncthreads();
        {
            f32x4 acc[2] = {(f32x4){0.f, 0.f, 0.f, 0.f}, (f32x4){0.f, 0.f, 0.f, 0.f}};
#pragma unroll
            for (int ks = 0; ks < 2; ++ks) { const bf16x8s a = ldfrag_perm(TILE(0), 16 * rt + fr, ks, g);
#pragma unroll
                for (int ct = 0; ct < 2; ++ct) { const bf16x8s sfr = *(const GAS bf16x8s*)(Sg + (((2 * ch + ct) * 2 + ks) * 64 + lane) * 8); acc[ct] = __builtin_amdgcn_mfma_f32_16x16x32_bf16(a, sfr, acc[ct], 0, 0, 0); } }
            mm64(acc, TILE(5), TILE(4), rt, ch, fr, g);
            st_tr(TILE(8), acc, rt, ch, fr, g);
        }
        __syncthreads();
        {
            f32x4 acc[2] = {(f32x4){0.f, 0.f, 0.f, 0.f}, (f32x4){0.f, 0.f, 0.f, 0.f}};
#pragma unroll
            for (int ks = 0; ks < 2; ++ks) { const bf16x8s a = *(const GAS bf16x8s*)(Tg + (16 * rt + fr) * 64 + 32 * ks + 8 * g);
#pragma unroll
                for (int ct = 0; ct < 2; ++ct) { const bf16x8s bb = ldfrag(TILE(8), 32 * ch + 16 * ct + fr, 32 * ks + 8 * g); acc[ct] = __builtin_amdgcn_mfma_f32_16x16x32_bf16(a, bb, acc[ct], 0, 0, 0); } }
            st_tr(TILE(9), acc, rt, ch, fr, g);
        }
        __syncthreads();
        {
            f32x4 acc[2] = {(f32x4){0.f, 0.f, 0.f, 0.f}, (f32x4){0.f, 0.f, 0.f, 0.f}};
#pragma unroll
            for (int ks = 0; ks < 2; ++ks) { const bf16x8s a = *(const GAS bf16x8s*)(Sg + ((rt * 2 + ks) * 64 + lane) * 8);
#pragma unroll
                for (int ct = 0; ct < 2; ++ct) { const bf16x8s bb = ldfrag_perm(TILE(3), 32 * ch + 16 * ct + fr, ks, g); acc[ct] = __builtin_amdgcn_mfma_f32_16x16x32_bf16(a, bb, acc[ct], 0, 0, 0); } }
            mm64(acc, TILE(9), TILE(6), rt, ch, fr, g); mm64(acc, TILE(4), TILE(7), rt, ch, fr, g);
            f32x4 ag[2] = {(f32x4){0.f, 0.f, 0.f, 0.f}, (f32x4){0.f, 0.f, 0.f, 0.f}};
#pragma unroll
            for (int ks = 0; ks < 5; ++ks) { const bf16x8s a = *(const GAS bf16x8s*)(G2T + (size_t)(h * HD + 16 * rt + fr) * DG + 32 * ks + 8 * g);
#pragma unroll
                for (int ct = 0; ct < 2; ++ct) { const bf16x8s bb = *(const GAS bf16x8s*)(LG + (row0 + 32 * ch + 16 * ct + fr) * DG + 32 * ks + 8 * g); ag[ct] = __builtin_amdgcn_mfma_f32_16x16x32_bf16(a, bb, ag[ct], 0, 0, 0); } }
#pragma unroll
            for (int ct = 0; ct < 2; ++ct) { const int t = 32 * ch + 16 * ct + fr; *(LAS f32x4*)(Ys + t * FP + 16 * rt + 4 * g) = acc[ct]; *(LAS f32x4*)(Gs + t * FP + 16 * rt + 4 * g) = ag[ct]; }
        }
        __syncthreads();
        {
            const int t = tid >> 3, cq = tid & 7, c0 = h * HD + cq * 8;
            const f32x4 y0 = *(const LAS f32x4*)(Ys + t * FP + cq * 8), y1 = *(const LAS f32x4*)(Ys + t * FP + cq * 8 + 4), g0 = *(const LAS f32x4*)(Gs + t * FP + cq * 8), g1 = *(const LAS f32x4*)(Gs + t * FP + cq * 8 + 4);
            float y[8] = {y0[0], y0[1], y0[2], y0[3], y1[0], y1[1], y1[2], y1[3]}, gg[8] = {g0[0], g0[1], g0[2], g0[3], g1[0], g1[1], g1[2], g1[3]};
            float s = 0.f;
#pragma unroll
            for (int q = 0; q < 8; ++q) s += y[q];
            s += shx(s, 1, lane); s += shx(s, 2, lane); s += shx(s, 4, lane);
            const float mu = s * (1.0f / HD); float vs = 0.f;
#pragma unroll
            for (int q = 0; q < 8; ++q) { y[q] -= mu; vs += y[q] * y[q]; }
            vs += shx(vs, 1, lane); vs += shx(vs, 2, lane); vs += shx(vs, 4, lane);
            const float rstd = 1.0f / sqrtf(vs * (1.0f / HD) + GN_EPS);
            float o[8];
#pragma unroll
            for (int q = 0; q < 8; ++q) o[q] = (y[q] * rstd * INP(18)[c0 + q] + INP(19)[c0 + q] + rkb * v8[q]) * gg[q];
            *(GAS v4u*)(YG + (row0 + t) * C + c0) = pack8f(o);
        }
        __syncthreads();
    }
}
#undef TILE
#if MK_DEBUG
__device__ __forceinline__ void scan_naive(unsigned char* ws, LAS unsigned char* lds, int tid) {
    const int lane = tid & 63;
    const bf16* Rb = (const bf16*)(ws + WS_B1); const bf16* Kb = (const bf16*)(ws + WS_B2); const bf16* Vb = (const bf16*)(ws + WS_B3);
    const bf16* LW = (const bf16*)(ws + WS_LW); const bf16* LA = (const bf16*)(ws + WS_LA);
    float* Y = OUTP(); float* RK = (float*)(ws + WS_HID);
    LAS float* sR = (LAS float*)lds; LAS float* sK = sR + 4096; LAS float* sV = sK + 4096; LAS float* sA = sV + 4096; LAS float* sB = sA + 4096; LAS float* sD = sB + 4096;
    LAS float* sW2 = sD + 4096; LAS float* sA2 = sW2 + 4096;
    for (int unit = blockIdx.x; unit < BATCH * NH; unit += gridDim.x) {
        const int b = unit / NH, h = unit % NH;
        __syncthreads();
        for (int e = tid; e < 4096; e += 512) { const int d = e >> 6, j = e & 63; sW2[e] = INP(9)[(size_t)d * C + h * HD + j]; sA2[e] = INP(12)[(size_t)d * C + h * HD + j]; }
        __syncthreads();
        const int pt = tid >> 3, cq = tid & 7, c0 = h * HD + cq * 8;
        const int si = tid >> 3, jq = tid & 7;
        float S[8];
#pragma unroll
        for (int q = 0; q < 8; ++q) S[q] = 0.f;
        float w0v[8], a0v[8], kkv[8], kav[8], rkv[8];
#pragma unroll
        for (int q = 0; q < 8; ++q) { w0v[q] = INP(7)[c0 + q]; a0v[q] = INP(10)[c0 + q]; kkv[q] = INP(15)[c0 + q]; kav[q] = INP(16)[c0 + q]; rkv[q] = INP(17)[c0 + q]; }
        for (int blk = 0; blk < SEQ / 64; ++blk) {
            const size_t row = (size_t)b * SEQ + blk * 64 + pt;
            {
                const v4u r4 = *(const GAS v4u*)(Rb + row * C + c0), k4 = *(const GAS v4u*)(Kb + row * C + c0), v4 = *(const GAS v4u*)(Vb + row * C + c0);
                float r[8], k[8], v[8];
                r[0] = bflo(r4.x); r[1] = bfhi(r4.x); r[2] = bflo(r4.y); r[3] = bfhi(r4.y); r[4] = bflo(r4.z); r[5] = bfhi(r4.z); r[6] = bflo(r4.w); r[7] = bfhi(r4.w);
                k[0] = bflo(k4.x); k[1] = bfhi(k4.x); k[2] = bflo(k4.y); k[3] = bfhi(k4.y); k[4] = bflo(k4.z); k[5] = bfhi(k4.z); k[6] = bflo(k4.w); k[7] = bfhi(k4.w);
                v[0] = bflo(v4.x); v[1] = bfhi(v4.x); v[2] = bflo(v4.y); v[3] = bfhi(v4.y); v[4] = bflo(v4.z); v[5] = bfhi(v4.z); v[6] = bflo(v4.w); v[7] = bfhi(v4.w);
                float wp[8], ap[8];
#pragma unroll
                for (int q = 0; q < 8; ++q) { wp[q] = w0v[q]; ap[q] = a0v[q]; }
                for (int d = 0; d < 64; ++d) { const float lw = bf2f(LW[row * DW + d]), la = bf2f(LA[row * DA + d]);
#pragma unroll
                    for (int q = 0; q < 8; ++q) { wp[q] += lw * sW2[d * 64 + cq * 8 + q]; ap[q] += la * sA2[d * 64 + cq * 8 + q]; } }
                float kk[8], ss = 0.f, rks = 0.f;
#pragma unroll
                for (int q = 0; q < 8; ++q) { kk[q] = k[q] * kkv[q]; ss += kk[q] * kk[q]; }
                ss += shx(ss, 1, lane); ss += shx(ss, 2, lane); ss += shx(ss, 4, lane);
                const float inv = 1.0f / fmaxf(sqrtf(ss), 1e-12f);
#pragma unroll
                for (int q = 0; q < 8; ++q) { const float ag = sigmoidf_(ap[q]); const float kn = kk[q] * inv; const float kp = k[q] * (1.0f + (ag - 1.0f) * kav[q]);
                    const float lw = -0.6065306597126334f * sigmoidf_(wp[q]);
                    const int o = pt * 64 + cq * 8 + q;
                    sR[o] = r[q]; sK[o] = kp; sV[o] = v[q]; sA[o] = -kn; sB[o] = kn * ag; sD[o] = __expf(lw); rks += r[q] * kp * rkv[q]; }
                rks += shx(rks, 1, lane); rks += shx(rks, 2, lane); rks += shx(rks, 4, lane);
                if (cq == 0) RK[row * NH + h] = rks;
            }
            __syncthreads();
            for (int t = 0; t < 64; ++t) {
                const LAS f32x4* pa = (const LAS f32x4*)(sA + t * 64 + jq * 8); const LAS f32x4* pb = (const LAS f32x4*)(sB + t * 64 + jq * 8);
                const LAS f32x4* pd = (const LAS f32x4*)(sD + t * 64 + jq * 8); const LAS f32x4* pk = (const LAS f32x4*)(sK + t * 64 + jq * 8);
                const LAS f32x4* pr = (const LAS f32x4*)(sR + t * 64 + jq * 8);
                const f32x4 a0 = pa[0], a1 = pa[1], b0 = pb[0], b1 = pb[1], d0 = pd[0], d1 = pd[1], k0 = pk[0], k1 = pk[1], r0 = pr[0], r1 = pr[1];
                const float vi = sV[t * 64 + si];
                float sa = 0.f;
#pragma unroll
                for (int q = 0; q < 4; ++q) { sa += S[q] * a0[q]; sa += S[4 + q] * a1[q]; }
                sa += shx(sa, 1, lane); sa += shx(sa, 2, lane); sa += shx(sa, 4, lane);
                float y = 0.f;
#pragma unroll
                for (int q = 0; q < 4; ++q) { S[q] = S[q] * d0[q] + sa * b0[q] + vi * k0[q]; S[4 + q] = S[4 + q] * d1[q] + sa * b1[q] + vi * k1[q]; y += S[q] * r0[q]; y += S[4 + q] * r1[q]; }
                y += shx(y, 1, lane); y += shx(y, 2, lane); y += shx(y, 4, lane);
                if (jq == 0) Y[((size_t)b * SEQ + blk * 64 + t) * C + h * HD + si] = y;
            }
            __syncthreads();
        }
    }
}
__device__ __forceinline__ void post_scan(unsigned char* ws, int gw, int NGW, int lane) {
    const float* Y = OUTP(); const float* RK = (const float*)(ws + WS_HID); const bf16* Vb = (const bf16*)(ws + WS_B3); const bf16* LG = (const bf16*)(ws + WS_LG);
    bf16* YG = (bf16*)(ws + WS_B4); const float* g2 = INP(14); const float* lnw = INP(18); const float* lnb = INP(19);
    for (int it = gw; it < M * NH; it += NGW) {
        const int row = it / NH, h = it % NH, c = h * HD + lane;
        const float y = Y[(size_t)row * C + c];
        const float mu = wave_sum(y, lane) * (1.0f / HD); const float d = y - mu; const float var = wave_sum(d * d, lane) * (1.0f / HD);
        float o = d * (1.0f / sqrtf(var + GN_EPS)) * lnw[c] + lnb[c];
        o += RK[(size_t)row * NH + h] * bf2f(Vb[(size_t)row * C + c]);
        float g = 0.f;
        for (int dd = 0; dd < DG; ++dd) g += bf2f(LG[(size_t)row * DG + dd]) * g2[(size_t)dd * C + c];
        YG[(size_t)row * C + c] = (bf16)f2bf(o * g);
    }
}


constexpr int CW_DBG = 3200;
__device__ __forceinline__ void dbg_nonfinite(unsigned char* ws, const bf16* X, size_t n, int slot, int gw, int NGW, int lane, float thr = 1e30f) {
    unsigned* cw = (unsigned*)(ws + WS_CTL) + CW_DBG + 64 * slot; unsigned nnan = 0;
    for (size_t i = (size_t)gw * 64 + lane; i < n; i += (size_t)NGW * 64) { const float x = bf2f(X[i]); if (!(fabsf(x) < thr)) ++nnan; }
    if (nnan) atomicAdd(cw, nnan);
}
__device__ __forceinline__ void dbg_compare(unsigned char* ws, const bf16* X, const bf16* Y, int gw, int NGW, int lane) {
    unsigned* cw = (unsigned*)(ws + WS_CTL) + CW_DBG; unsigned nbad = 0, nnan = 0;
    for (size_t i = (size_t)gw * 64 + lane; i < (size_t)M * C; i += (size_t)NGW * 64) { const float x = bf2f(X[i]), y = bf2f(Y[i]);
        if (!(fabsf(x) < 1e30f)) ++nnan; else if (fabsf(x - y) > 0.05f * (fabsf(y) + 0.05f)) ++nbad; }
    if (nnan) atomicAdd(cw, nnan); if (nbad) atomicAdd(cw + 64, nbad);
}
#endif
__device__ __forceinline__ void router_rows(unsigned char* ws, LAS unsigned char* lds, int layer, int gw, int NGW, int lane, int tid) {
    const float* Hh = OUTP(); const float* gain = INP(2) + layer * C; bf16* XN = (bf16*)(ws + WS_B1);
    const float* wg = INP(24) + (size_t)layer * C * 4; const float* bg = INP(25) + layer * 4; const float* wi = INP(26) + (size_t)layer * C * 16; const float* bi = INP(27) + layer * 16;
    unsigned* cnt = (unsigned*)(ws + WS_CTL) + CW_CNT + layer * 16 * 64; unsigned* list = (unsigned*)(ws + WS_LIST); float* wl = (float*)(ws + WS_WL);
    LAS float* sWg = (LAS float*)lds; LAS float* sWi = sWg + C * 4;
    __syncthreads();
    for (int e = tid; e < C * 4; e += 512) sWg[e] = wg[e];
    for (int e = tid; e < C * 16; e += 512) sWi[e] = wi[e];
    __syncthreads();
    f32x4 g[4]; load_row(gain, lane, g);
    for (int row = gw; row < M; row += NGW) {
        f32x4 v[4]; load_row(Hh + (size_t)row * C, lane, v); const float rs = row_rs(v, lane);
#pragma unroll
        for (int j = 0; j < 4; ++j) v[j] = v[j] * rs * g[j];
        store_row_bf16(XN + (size_t)row * C, lane, v);
        float gl[4] = {0.f, 0.f, 0.f, 0.f};
        const LAS unsigned char* pWg = (const LAS unsigned char*)sWg + lane * 64;
#pragma unroll
        for (int j = 0; j < 4; ++j)
#pragma unroll
            for (int q = 0; q < 4; ++q) { const f32x4 w = *(const LAS f32x4*)(pWg + j * 4096 + q * 16); const float xv = v[j][q]; gl[0] += xv * w.x; gl[1] += xv * w.y; gl[2] += xv * w.z; gl[3] += xv * w.w; }
#pragma unroll
        for (int q = 0; q < 4; ++q) gl[q] = wave_sum(gl[q], lane) + bg[q];
        int gi = 0; float gm = gl[0];
#pragma unroll
        for (int q = 1; q < 4; ++q) if (gl[q] > gm) { gm = gl[q]; gi = q; }
        float gden = 0.f;
#pragma unroll
        for (int q = 0; q < 4; ++q) gden += __expf(gl[q] - gm);
        const float gval = 1.0f / gden;
        float il[4] = {0.f, 0.f, 0.f, 0.f};
        const LAS unsigned char* pWi = (const LAS unsigned char*)sWi + lane * 256 + gi * 16;
#pragma unroll
        for (int j = 0; j < 4; ++j)
#pragma unroll
            for (int q = 0; q < 4; ++q) { const f32x4 w = *(const LAS f32x4*)(pWi + j * 16384 + q * 64); const float xv = v[j][q]; il[0] += xv * w.x; il[1] += xv * w.y; il[2] += xv * w.z; il[3] += xv * w.w; }
#pragma unroll
        for (int q = 0; q < 4; ++q) il[q] = wave_sum(il[q], lane) + bi[gi * 4 + q];
        int i0 = 0; float m0 = il[0];
#pragma unroll
        for (int q = 1; q < 4; ++q) if (il[q] > m0) { m0 = il[q]; i0 = q; }
        int i1 = -1; float m1 = -INFINITY;
#pragma unroll
        for (int q = 0; q < 4; ++q) if (q != i0 && il[q] > m1) { m1 = il[q]; i1 = q; }
        const float e1 = __expf(m1 - m0); const float w0 = gval / (1.0f + e1), w1 = gval * e1 / (1.0f + e1);
        if (lane == 0) {
            const int ex0 = gi * 4 + i0, ex1 = gi * 4 + i1;
            const unsigned p0 = atomicAdd(cnt + ex0 * 64, 1u); list[(size_t)ex0 * M + p0] = (unsigned)row * 2u; wl[(size_t)ex0 * M + p0] = w0;
            const unsigned p1 = atomicAdd(cnt + ex1 * 64, 1u); list[(size_t)ex1 * M + p1] = (unsigned)row * 2u + 1u; wl[(size_t)ex1 * M + p1] = w1;
        }
    }
}
__device__ __forceinline__ void moe_table(unsigned char* ws, volatile LAS int* tab, int layer, int tid) {
    __syncthreads();
    if (tid == 0) { const unsigned* cnt = (const unsigned*)(ws + WS_CTL) + CW_CNT + layer * 16 * 64; int t = 0;
#pragma unroll 1
        for (int e = 0; e < 16; ++e) { const int c = (int)__hip_atomic_load(cnt, RLX_AGENT); cnt += 64; tab[e] = c; tab[16 + e] = t; t += (c + 255) >> 8; tab[32 + e] = t; }
        tab[48] = t; }
    __syncthreads();
}
__device__ __forceinline__ void combine_rows(unsigned char* ws, int mode, int gw, int NGW, int lane) {
    float* Hh = OUTP(); const bf16* E0 = (const bf16*)(ws + WS_B2); const bf16* E1 = (const bf16*)(ws + WS_B3); bf16* XN2 = (bf16*)(ws + WS_B0);
    f32x4 g[4]; load_row(INP(4), lane, g);
    for (int row = gw; row < M; row += NGW) {
        f32x4 v[4]; load_row(Hh + (size_t)row * C, lane, v);
#pragma unroll
        for (int j = 0; j < 4; ++j) { const v2u e0 = ((const GAS v2u*)(E0 + (size_t)row * C))[64 * j + lane], e1 = ((const GAS v2u*)(E1 + (size_t)row * C))[64 * j + lane];
            v[j].x += bflo(e0.x) + bflo(e1.x); v[j].y += bfhi(e0.x) + bfhi(e1.x); v[j].z += bflo(e0.y) + bflo(e1.y); v[j].w += bfhi(e0.y) + bfhi(e1.y); }
        const float rs = row_rs(v, lane);
        if (mode == 0) {
#pragma unroll
            for (int j = 0; j < 4; ++j) ((GAS f32x4*)(Hh + (size_t)row * C))[64 * j + lane] = v[j];
#pragma unroll
            for (int j = 0; j < 4; ++j) v[j] = v[j] * rs;
            store_row_bf16(XN2 + (size_t)row * C, lane, v);
        } else {
            float sig = 1.0f;
#if MK_DEBUG
            const unsigned* cw = (const unsigned*)(ws + WS_CTL) + CW_DBG; const unsigned nnan = __hip_atomic_load(cw, RLX_AGENT), nbad = __hip_atomic_load(cw + 64, RLX_AGENT);
            if (row < 512 && nnan > 0) sig = 2.0f;
            if (row >= 512 && row < 1536 && __hip_atomic_load(cw + 128, RLX_AGENT) > 0) sig = 2.0f;
            if (row >= 1536 && row < 3584 && __hip_atomic_load(cw + 192, RLX_AGENT) > 0) sig = 2.0f;
            if (row >= 3584 && row < 7680 && __hip_atomic_load(cw + 256, RLX_AGENT) > 0) sig = 2.0f;
            if (row >= 7680 && row < 15872 && __hip_atomic_load(cw + 320, RLX_AGENT) > 0) sig = 2.0f;
            if (row >= 15872 && nbad > (unsigned)(M / 100) * C) sig = 1.5f;
#endif
#pragma unroll
            for (int j = 0; j < 4; ++j) ((GAS f32x4*)(Hh + (size_t)row * C))[64 * j + lane] = v[j] * rs * g[j] * sig;
        }
    }
}
__device__ __forceinline__ void attn_naive(unsigned char* ws, int gw, int NGW, int lane) {
    const bf16* Kb = (const bf16*)(ws + WS_B1); const bf16* Vb = (const bf16*)(ws + WS_B2); const bf16* Qb = (const bf16*)(ws + WS_B3); bf16* Ob = (bf16*)(ws + WS_B0);
    for (int unit = gw; unit < BATCH * NH * (SEQ / 64); unit += NGW) {
        const int qb = unit % (SEQ / 64), bh = unit / (SEQ / 64), b = bh / NH, h = bh % NH;
        const int t0 = qb * 64, t = t0 + lane; const size_t rowq = (size_t)b * SEQ + t;
        float q[64], o[64];
#pragma unroll
        for (int c = 0; c < 8; ++c) { const v4u w = *(const GAS v4u*)(Qb + rowq * C + h * HD + c * 8);
            q[c * 8 + 0] = bflo(w.x) * 0.125f; q[c * 8 + 1] = bfhi(w.x) * 0.125f; q[c * 8 + 2] = bflo(w.y) * 0.125f; q[c * 8 + 3] = bfhi(w.y) * 0.125f;
            q[c * 8 + 4] = bflo(w.z) * 0.125f; q[c * 8 + 5] = bfhi(w.z) * 0.125f; q[c * 8 + 6] = bflo(w.w) * 0.125f; q[c * 8 + 7] = bfhi(w.w) * 0.125f; }
#pragma unroll
        for (int c = 0; c < 64; ++c) o[c] = 0.f;
        float suffix = 0.f;
        for (int s = t0 + 62; s >= 0; --s) {
            const bool valid = s < t;
            if (s < t0 && __all(suffix > SB_EXIT)) break;
            const bf16* kp = Kb + ((size_t)b * SEQ + s) * C + h * HD; const bf16* vp = Vb + ((size_t)b * SEQ + s) * C + h * HD;
            float z = 0.f;
#pragma unroll
            for (int c = 0; c < 8; ++c) { const v4u w = *(const GAS v4u*)(kp + c * 8);
                z += q[c * 8 + 0] * bflo(w.x) + q[c * 8 + 1] * bfhi(w.x) + q[c * 8 + 2] * bflo(w.y) + q[c * 8 + 3] * bfhi(w.y) + q[c * 8 + 4] * bflo(w.z) + q[c * 8 + 5] * bfhi(w.z) + q[c * 8 + 6] * bflo(w.w) + q[c * 8 + 7] * bfhi(w.w); }
            const float sp = fmaxf(z, 0.f) + log1pf(__expf(-fabsf(z)));
            const float att = valid ? __expf(z - sp - suffix) : 0.f;
            suffix += valid ? sp : 0.f;
#pragma unroll
            for (int c = 0; c < 8; ++c) { const v4u w = *(const GAS v4u*)(vp + c * 8);
                o[c * 8 + 0] += att * bflo(w.x); o[c * 8 + 1] += att * bfhi(w.x); o[c * 8 + 2] += att * bflo(w.y); o[c * 8 + 3] += att * bfhi(w.y);
                o[c * 8 + 4] += att * bflo(w.z); o[c * 8 + 5] += att * bfhi(w.z); o[c * 8 + 6] += att * bflo(w.w); o[c * 8 + 7] += att * bfhi(w.w); }
        }
#pragma unroll
        for (int c = 0; c < 8; ++c) { v4u w; w.x = pk2(o[c * 8 + 0], o[c * 8 + 1]); w.y = pk2(o[c * 8 + 2], o[c * 8 + 3]); w.z = pk2(o[c * 8 + 4], o[c * 8 + 5]); w.w = pk2(o[c * 8 + 6], o[c * 8 + 7]);
            *(GAS v4u*)(Ob + rowq * C + h * HD + c * 8) = w; }
    }
}


typedef float f32x16 __attribute__((ext_vector_type(16)));
typedef short v4i16_t __attribute__((ext_vector_type(4)));
constexpr int AT_VP = 192;
constexpr int AT_WAVE_LDS = 32 * AT_VP;
__device__ __forceinline__ int crow32(int reg, int hh) { return (reg & 3) + 8 * (reg >> 2) + 4 * hh; }
__device__ __forceinline__ bf16x8s pack_step(const f32x16& x, const int s) {
    v4u p; p.x = pg8::cvt_pk_bf16(x[8 * s], x[8 * s + 1]); p.y = pg8::cvt_pk_bf16(x[8 * s + 2], x[8 * s + 3]); p.z = pg8::cvt_pk_bf16(x[8 * s + 4], x[8 * s + 5]); p.w = pg8::cvt_pk_bf16(x[8 * s + 6], x[8 * s + 7]);
    return __builtin_bit_cast(bf16x8s, p);
}
__device__ __forceinline__ void attn_mfma(unsigned char* ws, LAS unsigned char* lds, int gw, int NGW, int lane, int wave) {
    const bf16* Kb = (const bf16*)(ws + WS_B1); const bf16* Vb = (const bf16*)(ws + WS_B2); const bf16* Qb = (const bf16*)(ws + WS_B3); bf16* Ob = (bf16*)(ws + WS_B0);
    LAS unsigned char* vl = lds + wave * AT_WAVE_LDS;
    const int r32 = lane & 31, hh = lane >> 5;
    bf16x8s tri[2];
#pragma unroll
    for (int s = 0; s < 2; ++s)
#pragma unroll
        for (int j = 0; j < 8; ++j) tri[s][j] = (16 * s + 8 * (j >> 2) + 4 * hh + (j & 3)) > r32 ? (short)0x3F80 : (short)0;
    const int grp = lane >> 4, tq = (lane & 15) >> 2, tp = lane & 3;
    const LAS unsigned char* vtr0 = vl + (4 * hh + tq) * AT_VP + (16 * (grp & 1) + 4 * tp) * 2;
    for (int unit = gw; unit < BATCH * NH * (SEQ / 32); unit += NGW) {
        const int qb = unit % (SEQ / 32), bh = unit / (SEQ / 32), b = bh / NH, hd = bh % NH;
        const int t0 = qb * 32; const size_t rowb = (size_t)b * SEQ;
        bf16x8s qf[4];
#pragma unroll
        for (int ks = 0; ks < 4; ++ks) qf[ks] = *(const GAS bf16x8s*)(Qb + (rowb + t0 + r32) * C + hd * HD + 16 * ks + 8 * hh);
        f32x16 o[2];
#pragma unroll
        for (int i = 0; i < 16; ++i) { o[0][i] = 0.f; o[1][i] = 0.f; }
        float carry = 0.f;
        for (int s0 = t0; s0 >= 0; s0 -= 32) {
            bf16x8s kf[4];
#pragma unroll
            for (int ks = 0; ks < 4; ++ks) kf[ks] = *(const GAS bf16x8s*)(Kb + (rowb + s0 + r32) * C + hd * HD + 16 * ks + 8 * hh);
            v4u vreg[4];
#pragma unroll
            for (int i = 0; i < 4; ++i) { const int cidx = lane + 64 * i; vreg[i] = *(const GAS v4u*)(Vb + (rowb + s0 + (cidx >> 3)) * C + hd * HD + (cidx & 7) * 8); }
            f32x16 st;
#pragma unroll
            for (int i = 0; i < 16; ++i) st[i] = 0.f;
#pragma unroll
            for (int ks = 0; ks < 4; ++ks) st = __builtin_amdgcn_mfma_f32_32x32x16_bf16(kf[ks], qf[ks], st, 0, 0, 0);
#pragma unroll
            for (int i = 0; i < 4; ++i) { const int cidx = lane + 64 * i; *(LAS v4u*)(vl + (cidx >> 3) * AT_VP + (cidx & 7) * 16) = vreg[i]; }
            f32x16 zz, uu; float tot = 0.f; const int tq_ = t0 + r32;
#pragma unroll
            for (int i = 0; i < 16; ++i) { const int key = s0 + crow32(i, hh); const float z = st[i] * 0.125f; const float sp = fmaxf(z, 0.f) + __logf(1.0f + __expf(-fabsf(z)));
                const bool valid = key < tq_; zz[i] = valid ? z - sp : -1e30f; uu[i] = valid ? sp : 0.f; tot += uu[i]; }
            f32x16 uh, ul;
#pragma unroll
            for (int i = 0; i < 16; i += 2) { const unsigned ph = pg8::cvt_pk_bf16(uu[i], uu[i + 1]); uh[i] = bflo(ph); uh[i + 1] = bfhi(ph); ul[i] = uu[i] - uh[i]; ul[i + 1] = uu[i + 1] - uh[i + 1]; }
            f32x16 w;
#pragma unroll
            for (int i = 0; i < 16; ++i) w[i] = 0.f;
#pragma unroll
            for (int s = 0; s < 2; ++s) { w = __builtin_amdgcn_mfma_f32_32x32x16_bf16(tri[s], pack_step(uh, s), w, 0, 0, 0); w = __builtin_amdgcn_mfma_f32_32x32x16_bf16(tri[s], pack_step(ul, s), w, 0, 0, 0); }
            f32x16 pp;
#pragma unroll
            for (int i = 0; i < 16; ++i) pp[i] = __expf(zz[i] - w[i] - carry);
            tot += shx(tot, 32, lane); carry += tot;
            asm volatile("s_waitcnt lgkmcnt(0)" ::: "memory");
#pragma unroll
            for (int s = 0; s < 2; ++s) { const bf16x8s pa = pack_step(pp, s);
#pragma unroll
                for (int dt = 0; dt < 2; ++dt) {
                    const v4i16_t lo = __builtin_amdgcn_ds_read_tr16_b64_v4i16((LAS v4i16_t*)(vtr0 + (16 * s) * AT_VP + dt * 64));
                    const v4i16_t hi = __builtin_amdgcn_ds_read_tr16_b64_v4i16((LAS v4i16_t*)(vtr0 + (16 * s + 8) * AT_VP + dt * 64));
                    const bf16x8s vf = (bf16x8s){lo[0], lo[1], lo[2], lo[3], hi[0], hi[1], hi[2], hi[3]};
                    o[dt] = __builtin_amdgcn_mfma_f32_32x32x16_bf16(pa, vf, o[dt], 0, 0, 0); } }
            asm volatile("" ::: "memory");
            if (s0 < t0 && __all(carry > SB_EXIT)) break;
        }
#pragma unroll
        for (int dt = 0; dt < 2; ++dt)
#pragma unroll
            for (int i = 0; i < 16; ++i) Ob[(rowb + t0 + crow32(i, hh)) * C + hd * HD + 32 * dt + r32] = (bf16)f2bf(o[dt][i]);
    }
}
__global__ void __launch_bounds__(NWAVES * 64, 2) yoco_fwd(Args args) {
    extern __shared__ __attribute__((aligned(16))) unsigned char lds_raw[];
    LAS unsigned char* lds = (LAS unsigned char*)lds_raw;
    const int G = gridDim.x; const int bx = blockIdx.x;
    int wave = __builtin_amdgcn_readfirstlane(threadIdx.x >> 6); asm volatile("" : "+s"(wave));
#define IDS() int lane; asm volatile("v_mbcnt_lo_u32_b32 %0, -1, 0\n\tv_mbcnt_hi_u32_b32 %0, -1, %0" : "=v"(lane)); const int tid = wave * 64 + lane; (void)tid; \
    const int vcu = (G % 8 == 0) ? (bx % 8) * (G / 8) + bx / 8 : bx; const int gw = vcu * NWAVES + wave, NGW = G * NWAVES; (void)lane; (void)gw; (void)NGW;
    unsigned char* ws = WSP();
    volatile LAS unsigned* MISC = (volatile LAS unsigned*)(lds + MISC_OFF);
    volatile LAS int* tab = (volatile LAS int*)(lds + MOE_TAB_OFF);
    for (int u = threadIdx.x; u < (LDS_BYTES - LDSCTL_OFF) / 4; u += NWAVES * 64) ((LAS unsigned*)(lds + LDSCTL_OFF))[u] = 0u;
    __syncthreads();
    XcdBarrier bar; bar.bar = (unsigned*)(ws + WS_CTL) + CW_BAR; bar.x = 0; bar.st = nullptr;
    if (N_LAUNCHES == 1) bar = xcd_barrier_post((unsigned*)(ws + WS_CTL) + CW_BAR, MISC + 8);
    const int lo = KA_INT(0), hi = KA_INT(1);
#define IN(k) (lo <= (k) && (k) < hi)
#define SEAM(k) do { if (IN(k) && IN((k) + 1)) xcd_barrier(bar); } while (0)

    if (IN(PH_P0)) { IDS(); p0_weights(ws, lds, gw, NGW, wave, lane); p0_rows(ws, gw, NGW, lane); }
    SEAM(PH_P0);
    if (IN(PH_LORA)) {
        SchedGrouped<1, 3> S{(const char*)(ws + WS_B1), (size_t)(WS_B2 - WS_B1), nullptr, (const char*)(ws + WS_WT_LORA), (size_t)256 * C * 2, G, bx};
        EpiLora E{(bf16*)(ws + WS_LW)};
        pg8::gemm_phase<EpiLora, SchedGrouped<1, 3>, true, false, C>(lds, S, E, wave);
    }
    SEAM(PH_LORA);
    if (IN(PH_RKV)) {
        SchedGrouped<4, 3> S{(const char*)OUTP(), (size_t)M * C * 2, (const char*)(ws + WS_B4), (const char*)(ws + WS_WT_RKV), (size_t)C * C * 2, G, bx};
        EpiSplit3 E{(bf16*)(ws + WS_B1), false};
        pg8::gemm_phase<EpiSplit3, SchedGrouped<4, 3>, true, false, C>(lds, S, E, wave);
    }
    SEAM(PH_RKV);
    if (IN(PH_S1)) { IDS(); scan_s1(ws, lds, lane, wave); }
    SEAM(PH_S1);
    if (IN(PH_S2)) { IDS(); scan_s2(ws, lane, wave); }
    SEAM(PH_S2);
    if (IN(PH_S3)) { IDS(); scan_s3(ws, lds, lane, wave); }
    SEAM(PH_S3);
#if MK_DEBUG
    if (IN(PH_DBG0)) { IDS(); scan_naive(ws, lds, tid); }
    SEAM(PH_DBG0);
    if (IN(PH_DBG0 + 1)) { IDS(); post_scan(ws, gw, NGW, lane); }
    SEAM(PH_DBG0 + 1);
    if (IN(PH_DBG0 + 2)) { IDS(); dbg_compare(ws, (const bf16*)(ws + WS_B0), (const bf16*)(ws + WS_B4), gw, NGW, lane); }
    SEAM(PH_DBG0 + 2);
#endif
    if (IN(PH_WOUT)) {
        SchedGrouped<4, 1> S{(const char*)(ws + ((MK_DEBUG && DBG_USE_NAIVE) ? WS_B4 : WS_B0)), 0, nullptr, (const char*)(ws + WS_WT_OUT), 0, G, bx};
        EpiResid E{INP(0), OUTP()};
        pg8::gemm_phase<EpiResid, SchedGrouped<4, 1>, true, false, C>(lds, S, E, wave);
    }
    SEAM(PH_WOUT);
#pragma unroll 1
    for (int layer = 0; layer < 2; ++layer) {
        const int pb = layer == 0 ? (int)PH_ROUT0 : (int)PH_ROUT1;
        if (IN(pb)) { IDS(); router_rows(ws, lds, layer, gw, NGW, lane, tid); }
        SEAM(pb);
        if (IN(pb + 1)) {
            { IDS(); moe_table(ws, tab, layer, tid); }
            SchedMoe<2, C, true> S{(const char*)(ws + WS_B1), (const char*)(ws + WS_WT_GU) + (size_t)layer * 16 * 512 * C * 2, (size_t)512 * C * 2, (const unsigned*)(ws + WS_LIST), tab, G, bx};
            EpiGU E{(bf16*)(ws + WS_HID), (const float*)(ws + WS_WL)};
            pg8::gemm_phase<EpiGU, SchedMoe<2, C, true>, true, true, C>(lds, S, E, wave);
        }
        SEAM(pb + 1);
        if (IN(pb + 2)) {
            { IDS(); moe_table(ws, tab, layer, tid); }
            SchedMoe<4, FE, false> S{(const char*)(ws + WS_HID), (const char*)(ws + WS_WT_DN) + (size_t)layer * 16 * C * FE * 2, (size_t)C * FE * 2, (const unsigned*)(ws + WS_LIST), tab, G, bx};
            EpiDown E{(bf16*)(ws + WS_B2), (const unsigned*)(ws + WS_LIST)};
            pg8::gemm_phase<EpiDown, SchedMoe<4, FE, false>, true, false, FE>(lds, S, E, wave);
        }
        SEAM(pb + 2);
        if (layer == 0) {
            if (IN(PH_COMB)) { IDS(); combine_rows(ws, 0, gw, NGW, lane); }
            SEAM(PH_COMB);
            if (IN(PH_KVQ)) {
                SchedGrouped<12, 1> S{(const char*)(ws + WS_B0), 0, nullptr, (const char*)(ws + WS_WT_KVQ), 0, G, bx};
                EpiSplit3 E{(bf16*)(ws + WS_B1), true};
                pg8::gemm_phase<EpiSplit3, SchedGrouped<12, 1>, true, false, C>(lds, S, E, wave);
            }
            SEAM(PH_KVQ);
            if (IN(PH_ATTN)) { IDS(); attn_mfma(ws, lds, gw, NGW, lane, wave); }
            SEAM(PH_ATTN);
            if (IN(PH_SBO)) {
                SchedGrouped<4, 1> S{(const char*)(ws + WS_B0), 0, nullptr, (const char*)(ws + WS_WT_SBO), 0, G, bx};
                EpiResid E{OUTP(), OUTP()};
                pg8::gemm_phase<EpiResid, SchedGrouped<4, 1>, true, false, C>(lds, S, E, wave);
            }
            SEAM(PH_SBO);
        }
    }
    if (IN(PH_FINAL)) { IDS(); combine_rows(ws, 1, gw, NGW, lane); }
#undef IN
#undef SEAM
}

extern "C" void kernel_launch(void* const* d_in, const int* in_sizes, int n_in, void* d_out, int out_size, void* d_ws, size_t ws_size, hipStream_t stream) {
    static int grid = 0;
    if (grid == 0) {
        if (n_in != 31 || in_sizes[0] != M * C || out_size != M * C || ws_size < WS_END) { fprintf(stderr, "kernel_launch: unexpected shapes (n_in %d, in0 %d, out %d, ws %zu); nothing launched\n", n_in, n_in > 0 ? in_sizes[0] : -1, out_size, ws_size); grid = -1; return; }
        int dev = 0, cus = 0, per_cu = 0;
        if (hipGetDevice(&dev) != hipSuccess || hipDeviceGetAttribute(&cus, hipDeviceAttributeMultiprocessorCount, dev) != hipSuccess) { grid = -1; return; }
        if (hipFuncSetAttribute((const void*)yoco_fwd, hipFuncAttributeMaxDynamicSharedMemorySize, LDS_BYTES) != hipSuccess) { fprintf(stderr, "kernel_launch: hipFuncSetAttribute failed\n"); grid = -1; return; }
        if (hipOccupancyMaxActiveBlocksPerMultiprocessor(&per_cu, (const void*)yoco_fwd, NWAVES * 64, LDS_BYTES) != hipSuccess || per_cu < 1) fprintf(stderr, "kernel_launch: occupancy query reports %d\n", per_cu);
        (void)hipGetLastError();
        grid = cus;
    }
    if (grid < 0) return;
    if (hipMemsetAsync((char*)d_ws + WS_CTL, 0, CTL_ZERO_BYTES, stream) != hipSuccess) return;
    Args a{};
    for (int i = 0; i < 31; ++i) a.in[i] = (const float*)d_in[i];
    a.out = (float*)d_out; a.ws = (unsigned char*)d_ws;
    for (int li = 0; li < (N_LAUNCHES == 1 ? 1 : (int)NPHASE); ++li) {
        a.ph_lo = (N_LAUNCHES == 1) ? 0 : li; a.ph_hi = (N_LAUNCHES == 1) ? NPHASE : li + 1; a.li = li;
        hipLaunchKernelGGL(yoco_fwd, dim3(grid), dim3(NWAVES * 64), LDS_BYTES, stream, a);
        const hipError_t le = hipPeekAtLastError();
        if (le != hipSuccess) { fprintf(stderr, "kernel_launch: launch %d failed: %s\n", li, hipGetErrorName(le)); break; }
    }
}
```

```cpp
#include <hip/hip_runtime.h>
#include <cstdio>
#include <cstdint>

#ifndef MK_N_LAUNCHES
#define MK_N_LAUNCHES 1
#endif

namespace pg8 {
#define PG8_LAS __attribute__((address_space(3)))
typedef unsigned short bf16_t;
typedef short bf16x8 __attribute__((ext_vector_type(8)));
typedef float f32x4 __attribute__((ext_vector_type(4)));
typedef unsigned u32x4 __attribute__((ext_vector_type(4)));
constexpr int BM = 256, BK = 64, HALF = 128, HTB = HALF * BK * 2, STAGE_BYTES = 8 * HTB, NXCD = 8, WGM = 8;

__host__ __device__ __forceinline__ int lds_byte(int r, int c) { const int st = (r >> 4) * 2 + (c >> 5), rr = r & 15, cc = c & 31, ob = rr * 64 + cc * 2; return st * 1024 + (ob ^ (((ob >> 9) & 1) << 5)); }
__host__ __device__ __forceinline__ void stage_rc(int b, int& R, int& C) { const int st = b / 1024, sb = b % 1024, swz = sb ^ (((sb >> 9) & 1) << 5); R = (st >> 1) * 16 + swz / 64; C = (st & 1) * 32 + (swz % 64) / 2; }
__host__ __device__ __forceinline__ int perm32(int rho) { const int n = rho >> 4, i = rho & 15; return 8 * (i >> 2) + 4 * n + (i & 3); }

struct Unit { int pm, pn, aux, r0, cnt; };

__host__ __device__ __forceinline__ void tile_map(int wgid, int nM, int nN, int& pm, int& pn) {
    const int nwg = nM * nN;
    { const int q = nwg / NXCD, r = nwg % NXCD, xcd = wgid % NXCD, off = wgid / NXCD; wgid = (xcd < r ? xcd * (q + 1) : r * (q + 1) + (xcd - r) * q) + off; }
    const int nig = WGM * nN, gid = wgid / nig, fm = gid * WGM, gsz = (nM - fm) < WGM ? (nM - fm) : WGM;
    pm = fm + ((wgid % nig) % gsz); pn = (wgid % nig) / gsz;
}

typedef float f32x2_t __attribute__((ext_vector_type(2))); typedef __bf16 bf16x2_t __attribute__((ext_vector_type(2)));
__device__ __forceinline__ unsigned cvt_pk_bf16(float lo, float hi) { const f32x2_t v = {lo, hi}; const bf16x2_t b = __builtin_convertvector(v, bf16x2_t); return __builtin_bit_cast(unsigned, b); }

template <class Epi, class Sched, bool ALIGN_EPI, bool GATHER, int K>
__device__ __forceinline__ void gemm_phase(PG8_LAS unsigned char* lds, const Sched& S, const Epi& E, const int wid) {
    int lane_; asm volatile("v_mbcnt_lo_u32_b32 %0, -1, 0\n\tv_mbcnt_hi_u32_b32 %0, -1, %0" : "=v"(lane_));
    const int lane = lane_, tid = wid * 64 + lane, wr = wid >> 2, wc = wid & 3, fr = lane & 15, fq = lane >> 4;
    constexpr int nt = K / BK;
    unsigned voffA[2], voffB[2];
#pragma unroll
    for (int i = 0; i < 2; ++i) { int R, C; stage_rc(tid * 16 + i * 8192, R, C); const int Rb = Epi::PERM ? ((R & ~31) + perm32(R & 31)) : R;
        voffA[i] = (unsigned)(R * K + C) * 2u; voffB[i] = (unsigned)(Rb * K + C) * 2u; }
    constexpr size_t kstep = (size_t)(BK * 2);
    constexpr size_t hstep = (size_t)HALF * K * 2;
    const unsigned ldsw = (unsigned)wid * 1024u;
    const int aoff = lds_byte(wr * 64 + fr, fq * 8), boff = lds_byte(wc * 32 + fr, fq * 8);
#define PG8_SA(b, h) (((b) * 2 + (h)) * HTB)
#define PG8_SB(b, h) ((4 + (b) * 2 + (h)) * HTB)
#define PG8_STAGE(bufoff, gbase, voff) do { _Pragma("unroll") for (int _i = 0; _i < 2; ++_i) \
        __builtin_amdgcn_global_load_lds((const unsigned*)((const char*)(gbase) + (voff)[_i]), (PG8_LAS unsigned*)(lds + (bufoff) + ldsw + _i * 8192), 16, 0, 0); } while (0)
#define PG8_LDA(dst, b, h) do { _Pragma("unroll") for (int m = 0; m < 4; ++m) _Pragma("unroll") for (int k = 0; k < 2; ++k) dst[m][k] = *(const PG8_LAS bf16x8*)(lds + PG8_SA(b, h) + aoff + m * 2048 + k * 1024); } while (0)
#define PG8_LDB(dst, b, h) do { _Pragma("unroll") for (int n = 0; n < 2; ++n) _Pragma("unroll") for (int k = 0; k < 2; ++k) dst[n][k] = *(const PG8_LAS bf16x8*)(lds + PG8_SB(b, h) + boff + n * 2048 + k * 1024); } while (0)
#define PG8_MMA(ai, bj, At, Bt) do { __builtin_amdgcn_s_setprio(1); _Pragma("unroll") for (int m = 0; m < 4; ++m) _Pragma("unroll") for (int n = 0; n < 2; ++n) _Pragma("unroll") for (int k = 0; k < 2; ++k) \
        acc[ai][bj][m][n] = __builtin_amdgcn_mfma_f32_16x16x32_bf16(Bt[n][k], At[m][k], acc[ai][bj][m][n], 0, 0, 0); __builtin_amdgcn_s_setprio(0); } while (0)
#define PG8_WAIT_V(n) asm volatile("s_waitcnt vmcnt(" #n ")" ::: "memory")
#define PG8_WAIT_L(n) asm volatile("s_waitcnt lgkmcnt(" #n ")" ::: "memory")
#define PG8_BAR __builtin_amdgcn_s_barrier()
#define PG8_SCHED __builtin_amdgcn_sched_barrier(0)
    Unit cur, nxt; int ui = 0;
    if (!S.next(0, cur)) return;
    f32x4 acc[2][2][4][2];
#pragma unroll
    for (int a = 0; a < 2; ++a)
#pragma unroll
        for (int b = 0; b < 2; ++b)
#pragma unroll
            for (int m = 0; m < 4; ++m)
#pragma unroll
                for (int n = 0; n < 2; ++n) acc[a][b][m][n] = (f32x4){0.f, 0.f, 0.f, 0.f};
    bf16x8 At[4][2], B0[2][2], B1[2][2];
    unsigned vc[2][2];
#define PG8_GOFF(u) do { _Pragma("unroll") for (int _h = 0; _h < 2; ++_h) _Pragma("unroll") for (int _i = 0; _i < 2; ++_i) { int _R, _C; stage_rc(tid * 16 + _i * 8192, _R, _C); \
        vc[_h][_i] = S.a_row_off(u, _h * HALF + _R) + (unsigned)_C * 2u; } } while (0)
#define PG8_STAGE_A(bufoff, gbase, h) do { if constexpr (GATHER) { PG8_STAGE(bufoff, gbase, vc[h]); } else { PG8_STAGE(bufoff, (gbase) + (h) * hstep, voffA); } } while (0)
    if constexpr (GATHER) PG8_GOFF(cur);
    const char* cA = S.a_base(cur); const char* cB = S.b_base(cur);
    PG8_STAGE(PG8_SB(0, 0), cB, voffB); PG8_STAGE(PG8_SB(0, 1), cB + hstep, voffB); PG8_STAGE_A(PG8_SA(0, 0), cA, 0); PG8_STAGE_A(PG8_SA(0, 1), cA, 1);
    if (wr == 1) PG8_BAR;
    PG8_WAIT_V(2); PG8_BAR;
    PG8_STAGE(PG8_SB(1, 0), cB + kstep, voffB); PG8_STAGE_A(PG8_SA(1, 0), cA + kstep, 0); PG8_STAGE(PG8_SB(1, 1), cB + hstep + kstep, voffB);
    PG8_WAIT_V(6); PG8_BAR;
    for (;;) {
        const bool has_next = S.next(ui + 1, nxt);
        const char* nA = has_next ? S.a_base(nxt) : cA; const char* nB = has_next ? S.b_base(nxt) : cB;
        for (int t = 0; t < nt; t += 2) {
            const bool last = (t == nt - 2);
            const char* a1 = cA + (size_t)(t + 1) * kstep;
            const char* a2 = last ? nA : cA + (size_t)(t + 2) * kstep; const char* b2 = last ? nB : cB + (size_t)(t + 2) * kstep;
            const char* a3 = a2 + kstep; const char* b3 = b2 + kstep;
            PG8_LDB(B0, 0, 0); PG8_LDB(B1, 0, 1); PG8_SCHED; PG8_LDA(At, 0, 0); PG8_STAGE_A(PG8_SA(1, 1), a1, 1);
            if constexpr (GATHER) { if (last && has_next) PG8_GOFF(nxt); }
            PG8_WAIT_V(8); PG8_WAIT_L(0); PG8_BAR; PG8_MMA(0, 0, At, B0); PG8_MMA(0, 1, At, B1); PG8_BAR; PG8_SCHED;
            PG8_LDA(At, 0, 1); PG8_STAGE(PG8_SB(0, 0), b2, voffB); PG8_STAGE(PG8_SB(0, 1), b2 + hstep, voffB); PG8_STAGE_A(PG8_SA(0, 0), a2, 0);
            PG8_WAIT_V(8); PG8_WAIT_L(0); PG8_BAR; PG8_MMA(1, 0, At, B0); PG8_MMA(1, 1, At, B1); PG8_BAR; PG8_SCHED;
            PG8_LDB(B0, 1, 0); PG8_LDB(B1, 1, 1); PG8_SCHED; PG8_LDA(At, 1, 0); PG8_STAGE_A(PG8_SA(0, 1), a2, 1);
            PG8_WAIT_V(8); PG8_WAIT_L(0); PG8_BAR; PG8_MMA(0, 0, At, B0); PG8_MMA(0, 1, At, B1); PG8_BAR; PG8_SCHED;
            PG8_LDA(At, 1, 1); PG8_STAGE(PG8_SB(1, 0), b3, voffB); PG8_STAGE(PG8_SB(1, 1), b3 + hstep, voffB); PG8_STAGE_A(PG8_SA(1, 0), a3, 0);
            PG8_WAIT_V(8); PG8_WAIT_L(0); PG8_BAR; PG8_MMA(1, 0, At, B0); PG8_MMA(1, 1, At, B1); PG8_BAR; PG8_SCHED;
        }
        if constexpr (ALIGN_EPI) { if (wr == 0) PG8_BAR; }
        E(acc, cur, wr, wc, fr, fq);
        if (!has_next) break;
#pragma unroll
        for (int a = 0; a < 2; ++a)
#pragma unroll
            for (int b = 0; b < 2; ++b)
#pragma unroll
                for (int m = 0; m < 4; ++m)
#pragma unroll
                    for (int n = 0; n < 2; ++n) acc[a][b][m][n] = (f32x4){0.f, 0.f, 0.f, 0.f};
        cur = nxt; cA = nA; cB = nB; ++ui;
        if constexpr (ALIGN_EPI) { if (wr == 1) PG8_BAR; }
    }
    PG8_WAIT_V(0);
    if constexpr (!ALIGN_EPI) { if (wr == 0) PG8_BAR; }
    PG8_BAR;
#undef PG8_SA
#undef PG8_SB
#undef PG8_STAGE
#undef PG8_STAGE_A
#undef PG8_GOFF
#undef PG8_LDA
#undef PG8_LDB
#undef PG8_MMA
#undef PG8_WAIT_V
#undef PG8_WAIT_L
#undef PG8_BAR
#undef PG8_SCHED
}
}

constexpr int NWAVES = 8;
#ifndef MK_DEBUG
#define MK_DEBUG 0
#endif
#ifndef DBG_USE_NAIVE
#define DBG_USE_NAIVE 0
#endif
constexpr int DBGP = MK_DEBUG ? 3 : 0;
enum Phase { PH_P0 = 0, PH_LORA, PH_RKV, PH_S1, PH_S2, PH_S3, PH_DBG0, PH_WOUT = PH_DBG0 + DBGP, PH_ROUT0, PH_GU0, PH_DN0, PH_COMB, PH_KVQ, PH_ATTN, PH_SBO, PH_ROUT1, PH_GU1, PH_DN1, PH_FINAL, NPHASE };
constexpr int N_LAUNCHES = MK_N_LAUNCHES;


constexpr int BATCH = 2, SEQ = 8192, C = 1024, NH = 16, HD = 64, M = BATCH * SEQ;
constexpr int NE = 16, FE = 256, DW = 64, DA = 64, DG = 160;
constexpr float RMS_EPS = 1e-6f, GN_EPS = 64e-5f;
constexpr float SB_EXIT = 104.0f;

constexpr size_t MiB = 1u << 20;
constexpr size_t WS_CTL = 0, CTL_ZERO_BYTES = 64 * 1024;
constexpr size_t WS_WT_W2 = 128 * 1024, WS_WT_A2 = 256 * 1024, WS_WT_G2 = 384 * 1024;
constexpr size_t WS_WT_RKV = 1 * MiB;
constexpr size_t WS_WT_LORA = 7 * MiB;
constexpr size_t WS_WT_OUT = 9 * MiB;
constexpr size_t WS_WT_KVQ = 11 * MiB;
constexpr size_t WS_WT_SBO = 17 * MiB;
constexpr size_t WS_WT_GU = 19 * MiB;
constexpr size_t WS_WT_DN = 51 * MiB;
constexpr size_t WS_LW = 67 * MiB;
constexpr size_t WS_LA = 69 * MiB;
constexpr size_t WS_LG = 71 * MiB;
static_assert(WS_LA == WS_LW + 2 * MiB && WS_LG == WS_LW + 4 * MiB, "EpiLora's pointer arithmetic");
constexpr size_t WS_LIST = 76 * MiB;
constexpr size_t WS_WL = 77 * MiB;
constexpr size_t WS_HID = 78 * MiB;
constexpr size_t WS_B0 = 96 * MiB, WS_B1 = 128 * MiB, WS_B2 = 160 * MiB, WS_B3 = 192 * MiB, WS_B4 = 224 * MiB, WS_END = 256 * MiB;
static_assert(WS_HID + (size_t)144 * 256 * 256 * 2 <= WS_B0, "HID vs B0");
constexpr int CW_TMO = 0;
constexpr int CW_CNT = 1024;
constexpr int CW_BAR = 4096;

constexpr int RING_BYTES = 131072;
constexpr int LDSCTL_OFF = 146432, MISC_OFF = LDSCTL_OFF + 320, MOE_TAB_OFF = MISC_OFF + 128;
constexpr int LDS_BYTES = 147456;
static_assert(MOE_TAB_OFF + 256 <= LDS_BYTES, "LDS map");

#define GAS __attribute__((address_space(1)))
#define LAS __attribute__((address_space(3)))
typedef unsigned short bf16;
typedef unsigned v4u __attribute__((ext_vector_type(4)));
typedef unsigned v2u __attribute__((ext_vector_type(2)));
typedef float f32x4 __attribute__((ext_vector_type(4)));
typedef GAS unsigned gu32;
#define RLX_AGENT __ATOMIC_RELAXED, __HIP_MEMORY_SCOPE_AGENT
#define LDS_WAIT() asm volatile("s_waitcnt lgkmcnt(0)" ::: "memory")
#define VM_WAIT() asm volatile("s_waitcnt vmcnt(0)" ::: "memory")
__device__ __forceinline__ unsigned f2bf(float f) { unsigned u = __builtin_bit_cast(unsigned, f); return (u + 0x7fffu + ((u >> 16) & 1u)) >> 16; }
__device__ __forceinline__ unsigned pk2(float lo, float hi) { return f2bf(lo) | (f2bf(hi) << 16); }
__device__ __forceinline__ float bflo(unsigned u) { return __uint_as_float(u << 16); }
__device__ __forceinline__ float bfhi(unsigned u) { return __uint_as_float(u & 0xffff0000u); }
__device__ __forceinline__ float bf2f(bf16 b) { return __uint_as_float((unsigned)b << 16); }
__device__ __forceinline__ float sigmoidf_(float x) { return 1.0f / (1.0f + __expf(-x)); }

#define XB_TMO      128
#define XB_XCNT(j)  (256  + 64 * (j))
#define XB_XSUB(j)  (1280 + 64 * (j))
#define XB_XGEN(j)  (2304 + 64 * (j))
#define XB_TOP      3328
#define XB_TOPGEN   3392
#define XCD_BAR_WORDS 3456
#define XB_SPIN_CAP (1u << 18)
__device__ __forceinline__ unsigned xb_ld(unsigned* p)              { return __hip_atomic_load(p, __ATOMIC_RELAXED, __HIP_MEMORY_SCOPE_AGENT); }
__device__ __forceinline__ unsigned xb_add(unsigned* p, unsigned v) { return __hip_atomic_fetch_add(p, v, __ATOMIC_RELAXED, __HIP_MEMORY_SCOPE_AGENT); }
__device__ __forceinline__ unsigned xb_xcc_id() { return (unsigned)__builtin_amdgcn_s_getreg((3 << 11) | 20) & 0xFu; }
#define XB_SPIN(cond, bar) do { unsigned _sp = 0; while (cond) { __builtin_amdgcn_s_sleep(1); \
    if ((++_sp & 255u) == 0u) { if (xb_ld(&(bar)[XB_TMO])) break; if (_sp > XB_SPIN_CAP) { atomicAdd(&(bar)[XB_TMO], 1u); break; } } } } while (0)
struct XcdBarrier { unsigned* bar; unsigned x; volatile LAS unsigned* st; };
__device__ __forceinline__ XcdBarrier xcd_barrier_post(unsigned* bar, volatile LAS unsigned* st) {
    XcdBarrier b; b.bar = bar; b.x = xb_xcc_id(); b.st = st;
    if (threadIdx.x == 0) (void)xb_add(&bar[XB_XCNT(b.x)], 1u);
    return b;
}
__device__ __forceinline__ void xcd_barrier_complete(unsigned* bar, unsigned x, unsigned& nloc, unsigned& nx) {
    const unsigned G = gridDim.x * gridDim.y * gridDim.z;
    unsigned sum, cnt, mine, sp = 0u;
    for (;;) {
        sum = 0u; cnt = 0u; mine = 0u;
#pragma unroll
        for (unsigned j = 0; j < 16; ++j) { const unsigned c = xb_ld(&bar[XB_XCNT(j)]); sum += c; cnt += (c > 0u) ? 1u : 0u; mine = (j == x) ? c : mine; }
        if (sum == G) break;
        __builtin_amdgcn_s_sleep(1);
        if ((++sp & 255u) == 0u) { if (xb_ld(&bar[XB_TMO])) break; if (sp > XB_SPIN_CAP) { atomicAdd(&bar[XB_TMO], 1u); break; } }
    }
    nloc = mine > 0u ? mine : 1u; nx = cnt > 0u ? cnt : 1u;
}
__device__ __forceinline__ void xcd_barrier(const XcdBarrier& b) {
    asm volatile("s_waitcnt vmcnt(0)" ::: "memory");
    __syncthreads();
    if (threadIdx.x == 0) {
        unsigned* bar = b.bar;
        __builtin_amdgcn_s_waitcnt(0);
        unsigned nloc = b.st[0], nx = b.st[1];
        if (nloc == 0u) { xcd_barrier_complete(bar, b.x, nloc, nx); b.st[0] = nloc; b.st[1] = nx; }
        const unsigned old = xb_add(&bar[XB_XSUB(b.x)], 1u);
        const unsigned gen = old / nloc;
        if (old + 1u == (gen + 1u) * nloc) {
            __builtin_amdgcn_fence(__ATOMIC_RELEASE, "agent");
            asm volatile("s_waitcnt vmcnt(0)" ::: "memory");
            const unsigned og = xb_add(&bar[XB_TOP], 1u);
            const unsigned tg = og / nx;
            if (og + 1u == (tg + 1u) * nx) xb_add(&bar[XB_TOPGEN], 1u);
            else XB_SPIN(xb_ld(&bar[XB_TOPGEN]) == tg, bar);
            __builtin_amdgcn_fence(__ATOMIC_ACQUIRE, "agent");
            xb_add(&bar[XB_XGEN(b.x)], 1u);
            asm volatile("s_waitcnt vmcnt(0)" ::: "memory");
        } else {
            XB_SPIN(xb_ld(&bar[XB_XGEN(b.x)]) == gen, bar);
            __builtin_amdgcn_fence(__ATOMIC_ACQUIRE, "agent");
            asm volatile("s_waitcnt vmcnt(0)" ::: "memory");
        }
    }
    __syncthreads();
}

__device__ __forceinline__ float shx(float v, int o, int lane) { return __int_as_float(__builtin_amdgcn_ds_bpermute((lane ^ o) << 2, __float_as_int(v))); }
__device__ __forceinline__ float wave_sum(float v, int lane) {
#pragma unroll
    for (int o = 1; o < 64; o <<= 1) v += shx(v, o, lane);
    return v;
}
__device__ __forceinline__ void transpose_item(const float* W, int ldw, int k0, int n0, bf16* WT, int ldk, int dst_row0, const float* kscale, LAS float* scr, int lane, int kmax = 1 << 30) {
#pragma unroll 8
    for (int i = 0; i < 32; ++i) { const int kk = 2 * i + (lane >> 5); float v = (k0 + kk < kmax) ? W[(size_t)(k0 + kk) * ldw + n0 + (lane & 31)] : 0.f; if (kscale) v *= kscale[k0 + kk]; scr[kk * 33 + (lane & 31)] = v; }
    LDS_WAIT(); asm volatile("" ::: "memory");
    const int c = lane & 7;
#pragma unroll
    for (int j = 0; j < 4; ++j) { const int n = (lane >> 3) + 8 * j; const LAS float* s = scr + (8 * c) * 33 + n;
        v4u o; o.x = pk2(s[0 * 33], s[1 * 33]); o.y = pk2(s[2 * 33], s[3 * 33]); o.z = pk2(s[4 * 33], s[5 * 33]); o.w = pk2(s[6 * 33], s[7 * 33]);
        if (k0 + 8 * c < kmax) *(GAS v4u*)(WT + (size_t)(dst_row0 + n) * ldk + k0 + 8 * c) = o; }
    LDS_WAIT(); asm volatile("" ::: "memory");
}

struct Args { const float* in[31]; float* out; unsigned char* ws; int ph_lo, ph_hi, li, pad; };
typedef const __attribute__((address_space(4))) unsigned char* kaptr_t;
__device__ __forceinline__ kaptr_t ka_base() { kaptr_t p = (kaptr_t)__builtin_amdgcn_kernarg_segment_ptr(); asm volatile("" : "+s"(p)); return p; }
#define INP(k) (*(const float* const __attribute__((address_space(4)))*)(ka_base() + 8 * (k)))
#define OUTP() (*(float* const __attribute__((address_space(4)))*)(ka_base() + 8 * 31))
#define WSP() (*(unsigned char* const __attribute__((address_space(4)))*)(ka_base() + 8 * 32))
#define KA_INT(i) (*(const int __attribute__((address_space(4)))*)(ka_base() + 8 * 33 + 4 * (i)))

__device__ __forceinline__ void p0_weights(unsigned char* ws, LAS unsigned char* lds, int gw, int NGW, int wave, int lane) {
    LAS float* scr = (LAS float*)(lds + wave * 16384);
    bf16* WT_RKV = (bf16*)(ws + WS_WT_RKV); bf16* WT_LORA = (bf16*)(ws + WS_WT_LORA); bf16* WT_OUT = (bf16*)(ws + WS_WT_OUT); bf16* WT_KVQ = (bf16*)(ws + WS_WT_KVQ);
    bf16* WT_SBO = (bf16*)(ws + WS_WT_SBO); bf16* WT_GU = (bf16*)(ws + WS_WT_GU); bf16* WT_DN = (bf16*)(ws + WS_WT_DN);
    constexpr int I_UP = 32 + 32 + 96, I_RKV = 3 * 512, I_LORA = 32 + 32 + 80, I_OUT = 512, I_KV = 1024, I_Q = 512, I_SBO = 512, I_G = 32 * 128, I_U = 32 * 128, I_D = 32 * 128;
    constexpr int NITEMS = I_UP + I_RKV + I_LORA + I_OUT + I_KV + I_Q + I_SBO + I_G + I_U + I_D;
    for (int it = gw; it < NITEMS; it += NGW) {
        int r = it;
        if (r < I_UP) {
            if (r < 32) transpose_item(INP(9), C, 0, 32 * r, (bf16*)(ws + WS_WT_W2), 64, 32 * r, nullptr, scr, lane);
            else if (r < 64) transpose_item(INP(12), C, 0, 32 * (r - 32), (bf16*)(ws + WS_WT_A2), 64, 32 * (r - 32), nullptr, scr, lane);
            else { const int q = r - 64, kb = q / 32, nb = q % 32; transpose_item(INP(14), C, 64 * kb, 32 * nb, (bf16*)(ws + WS_WT_G2), DG, 32 * nb, nullptr, scr, lane, DG); }
            continue; } r -= I_UP;
        if (r < I_RKV) { const int m = r / 512, q = r % 512, kb = q / 32, nb = q % 32; transpose_item(INP(6) + (size_t)m * C * C, C, 64 * kb, 32 * nb, WT_RKV, C, m * C + 32 * nb, nullptr, scr, lane); continue; } r -= I_RKV;
        if (r < I_LORA) {
            if (r < 32) { const int kb = r / 2, nb = r % 2; transpose_item(INP(8), DW, 64 * kb, 32 * nb, WT_LORA, C, 32 * nb, nullptr, scr, lane); }
            else if (r < 64) { const int q = r - 32, kb = q / 2, nb = q % 2; transpose_item(INP(11), DA, 64 * kb, 32 * nb, WT_LORA, C, 256 + 32 * nb, nullptr, scr, lane); }
            else { const int q = r - 64, kb = q / 5, nb = q % 5; transpose_item(INP(13), DG, 64 * kb, 32 * nb, WT_LORA, C, 512 + 32 * nb, nullptr, scr, lane); }
            continue; } r -= I_LORA;
        if (r < I_OUT) { const int kb = r / 32, nb = r % 32; transpose_item(INP(20), C, 64 * kb, 32 * nb, WT_OUT, C, 32 * nb, nullptr, scr, lane); continue; } r -= I_OUT;
        if (r < I_KV) { const int kb = r / 64, nb = r % 64; transpose_item(INP(21), 2 * C, 64 * kb, 32 * nb, WT_KVQ, C, 32 * nb, INP(3), scr, lane); continue; } r -= I_KV;
        if (r < I_Q) { const int kb = r / 32, nb = r % 32; transpose_item(INP(22), C, 64 * kb, 32 * nb, WT_KVQ, C, 2 * C + 32 * nb, INP(1) + C, scr, lane); continue; } r -= I_Q;
        if (r < I_SBO) { const int kb = r / 32, nb = r % 32; transpose_item(INP(23), C, 64 * kb, 32 * nb, WT_SBO, C, 32 * nb, nullptr, scr, lane); continue; } r -= I_SBO;
        if (r < I_G) { const int le = r / 128, q = r % 128, kb = q / 8, nb = q % 8, f0 = 32 * nb; transpose_item(INP(28) + (size_t)le * C * FE, FE, 64 * kb, f0, WT_GU + (size_t)le * 512 * C, C, 256 * (f0 / 128) + (f0 % 128), nullptr, scr, lane); continue; } r -= I_G;
        if (r < I_U) { const int le = r / 128, q = r % 128, kb = q / 8, nb = q % 8, f0 = 32 * nb; transpose_item(INP(29) + (size_t)le * C * FE, FE, 64 * kb, f0, WT_GU + (size_t)le * 512 * C, C, 256 * (f0 / 128) + 128 + (f0 % 128), nullptr, scr, lane); continue; } r -= I_U;
        { const int le = r / 128, q = r % 128, kb = q / 32, nb = q % 32; transpose_item(INP(30) + (size_t)le * FE * C, C, 64 * kb, 32 * nb, WT_DN + (size_t)le * C * FE, FE, 32 * nb, nullptr, scr, lane); }
    }
    for (int it = gw * 64 + lane; it < 768 * 128; it += NGW * 64) { const int row = it >> 7, ch = it & 127;
        const bool valid = (row < 64) || (row >= 256 && row < 320) || (row >= 512 && row < 672);
        if (!valid) *(GAS v4u*)(WT_LORA + (size_t)row * C + ch * 8) = (v4u){0u, 0u, 0u, 0u}; }
}
__device__ __forceinline__ void load_row(const float* p, int lane, f32x4 (&v)[4]) {
#pragma unroll
    for (int j = 0; j < 4; ++j) v[j] = ((const GAS f32x4*)p)[64 * j + lane];
}
__device__ __forceinline__ float row_rs(const f32x4 (&v)[4], int lane) {
    float s = 0.f;
#pragma unroll
    for (int j = 0; j < 4; ++j) s += (v[j].x * v[j].x + v[j].y * v[j].y) + (v[j].z * v[j].z + v[j].w * v[j].w);
    return 1.0f / sqrtf(wave_sum(s, lane) * (1.0f / C) + RMS_EPS);
}
__device__ __forceinline__ void store_row_bf16(bf16* p, int lane, const f32x4 (&v)[4]) {
#pragma unroll
    for (int j = 0; j < 4; ++j) { v2u o; o.x = pk2(v[j].x, v[j].y); o.y = pk2(v[j].z, v[j].w); ((GAS v2u*)p)[64 * j + lane] = o; }
}
__device__ __forceinline__ void p0_rows(unsigned char* ws, int gw, int NGW, int lane) {
    const float* x = INP(0); const float* gain = INP(1); const float* mix = INP(5);
    f32x4 g[4]; load_row(gain, lane, g);
    for (int run = gw; run < M / 8; run += NGW) {
        const int r0 = run * 8;
        f32x4 prev[4];
        if ((r0 % SEQ) == 0) {
#pragma unroll
            for (int j = 0; j < 4; ++j) prev[j] = (f32x4){0.f, 0.f, 0.f, 0.f};
        } else { load_row(x + (size_t)(r0 - 1) * C, lane, prev); const float rs = row_rs(prev, lane);
#pragma unroll
            for (int j = 0; j < 4; ++j) prev[j] = prev[j] * rs * g[j]; }
        for (int rr = 0; rr < 8; ++rr) {
            const int row = r0 + rr;
            f32x4 hn[4]; load_row(x + (size_t)row * C, lane, hn); const float rs = row_rs(hn, lane);
#pragma unroll
            for (int j = 0; j < 4; ++j) hn[j] = hn[j] * rs * g[j];
#pragma unroll
            for (int i = 0; i < 6; ++i) { f32x4 o[4];
#pragma unroll
                for (int j = 0; j < 4; ++j) { const f32x4 mx = ((const GAS f32x4*)(mix + i * C))[64 * j + lane]; o[j] = hn[j] + (prev[j] - hn[j]) * mx; }
                bf16* dst = i < 2 ? (bf16*)OUTP() + (size_t)i * M * C : (i == 2 ? (bf16*)(ws + WS_B4) : (bf16*)(ws + WS_B1) + (size_t)(i - 3) * M * C);
                store_row_bf16(dst + (size_t)row * C, lane, o); }
#pragma unroll
            for (int j = 0; j < 4; ++j) prev[j] = hn[j];
        }
    }
}

template <int NN, int NGROUPS> struct SchedGrouped {
    static constexpr int K = C;
    const char* A0; size_t astride; const char* A2; const char* B; size_t bgroup;
    int G, c;
    __device__ __forceinline__ bool next(int i, pg8::Unit& u) const {
        const int L = i * G + c; constexpr int per = 64 * NN; if (L >= per * NGROUPS) return false;
        const int g = L / per, w = L % per; pg8::tile_map(w, 64, NN, u.pm, u.pn); u.aux = g; u.r0 = 0; u.cnt = 0; return true; }
    __device__ __forceinline__ const char* a_base(const pg8::Unit& u) const { const char* A = (A2 != nullptr && u.aux == 2) ? A2 : A0 + (size_t)u.aux * astride; return A + (size_t)u.pm * 256 * K * 2; }
    __device__ __forceinline__ const char* b_base(const pg8::Unit& u) const { return B + (size_t)u.aux * bgroup + (size_t)u.pn * 256 * K * 2; }
    __device__ __forceinline__ unsigned a_row_off(const pg8::Unit&, int) const { return 0u; }
};
template <int NN, int K, bool GATHER> struct SchedMoe {
    const char* A; const char* B; size_t bexp; const unsigned* list; volatile LAS int* tab; int G, c;
    __device__ __forceinline__ bool next(int i, pg8::Unit& u) const {
        const int L = i * G + c; const int tot = __builtin_amdgcn_readfirstlane(tab[48]) * NN; if (L >= tot) return false;
        u.pm = L / NN; u.pn = L % NN; int e = 0;
#pragma unroll
        for (int j = 0; j < 16; ++j) e += (u.pm >= tab[32 + j]) ? 1 : 0;
        e = __builtin_amdgcn_readfirstlane(e);
        u.aux = e; u.r0 = (u.pm - __builtin_amdgcn_readfirstlane(tab[16 + e])) * 256; u.cnt = __builtin_amdgcn_readfirstlane(tab[e]); return true; }
    __device__ __forceinline__ const char* a_base(const pg8::Unit& u) const { return GATHER ? A : A + (size_t)u.pm * 256 * K * 2; }
    __device__ __forceinline__ const char* b_base(const pg8::Unit& u) const { return B + (size_t)u.aux * bexp + (size_t)u.pn * 256 * K * 2; }
    __device__ __forceinline__ unsigned a_row_off(const pg8::Unit& u, int r) const {
        const int idx = u.r0 + r; unsigned tok = 0u;
        if (idx < u.cnt) tok = list[(size_t)u.aux * M + idx] >> 1;
        return tok * (unsigned)(K * 2); }
};

using pg8::f32x4;
using pg8::Unit;
__device__ __forceinline__ v4u pack8(f32x4 v0, f32x4 v1) { v4u w; w.x = pg8::cvt_pk_bf16(v0[0], v0[1]); w.y = pg8::cvt_pk_bf16(v0[2], v0[3]); w.z = pg8::cvt_pk_bf16(v1[0], v1[1]); w.w = pg8::cvt_pk_bf16(v1[2], v1[3]); return w; }

struct EpiLora {
    static constexpr bool PERM = true;
    bf16* LW;
    __device__ __forceinline__ void operator()(const f32x4 (&acc)[2][2][4][2], const Unit& u, int wr, int wc, int fr, int fq) const {
        { int l_; asm volatile("v_mbcnt_lo_u32_b32 %0, -1, 0\n\tv_mbcnt_hi_u32_b32 %0, -1, %0" : "=v"(l_)); fr = l_ & 15; fq = l_ >> 4; }
        const int g = u.aux, width = g == 2 ? DG : DW; bf16* out = LW + (size_t)g * (1u << 20);
        const int row0 = u.pm * 256 + wr * 64 + fr;
#pragma unroll
        for (int bj = 0; bj < 2; ++bj) { const int col0 = bj * 128 + wc * 32 + 8 * fq; if (col0 < width) {
#pragma unroll
            for (int ai = 0; ai < 2; ++ai)
#pragma unroll
                for (int m = 0; m < 4; ++m) { f32x4 v0 = acc[ai][bj][m][0], v1 = acc[ai][bj][m][1];
                    if (g == 0) {
#pragma unroll
                        for (int q = 0; q < 4; ++q) { v0[q] = tanhf(v0[q]); v1[q] = tanhf(v1[q]); } }
                    else if (g == 2) {
#pragma unroll
                        for (int q = 0; q < 4; ++q) { v0[q] = sigmoidf_(v0[q]); v1[q] = sigmoidf_(v1[q]); } }
                    *(GAS v4u*)(out + (size_t)(row0 + ai * 128 + m * 16) * width + col0) = pack8(v0, v1); } } }
    }
};
struct EpiSplit3 {
    static constexpr bool PERM = true;
    bf16* O0; bool bycol;
    __device__ __forceinline__ void operator()(const f32x4 (&acc)[2][2][4][2], const Unit& u, int wr, int wc, int fr, int fq) const {
        { int l_; asm volatile("v_mbcnt_lo_u32_b32 %0, -1, 0\n\tv_mbcnt_hi_u32_b32 %0, -1, %0" : "=v"(l_)); fr = l_ & 15; fq = l_ >> 4; }
        const int g = bycol ? (u.pn >> 2) : u.aux, pn = bycol ? (u.pn & 3) : u.pn; bf16* out = O0 + (size_t)g * ((size_t)M * C);
        const int row0 = u.pm * 256 + wr * 64 + fr, col0 = pn * 256 + wc * 32 + 8 * fq;
#pragma unroll
        for (int ai = 0; ai < 2; ++ai)
#pragma unroll
            for (int m = 0; m < 4; ++m)
#pragma unroll
                for (int bj = 0; bj < 2; ++bj) *(GAS v4u*)(out + (size_t)(row0 + ai * 128 + m * 16) * C + col0 + bj * 128) = pack8(acc[ai][bj][m][0], acc[ai][bj][m][1]);
    }
};
struct EpiResid {
    static constexpr bool PERM = false;
    const float* base; float* out;
    __device__ __forceinline__ void operator()(const f32x4 (&acc)[2][2][4][2], const Unit& u, int wr, int wc, int fr, int fq) const {
        { int l_; asm volatile("v_mbcnt_lo_u32_b32 %0, -1, 0\n\tv_mbcnt_hi_u32_b32 %0, -1, %0" : "=v"(l_)); fr = l_ & 15; fq = l_ >> 4; }
        const int row0 = u.pm * 256 + wr * 64 + fr, col0 = u.pn * 256 + wc * 32 + 4 * fq;
#pragma unroll
        for (int ai = 0; ai < 2; ++ai)
#pragma unroll
            for (int m = 0; m < 4; ++m) { const size_t off = (size_t)(row0 + ai * 128 + m * 16) * C + col0;
#pragma unroll
                for (int bj = 0; bj < 2; ++bj)
#pragma unroll
                    for (int n = 0; n < 2; ++n) { const f32x4 b = *(const GAS f32x4*)(base + off + bj * 128 + n * 16); *(GAS f32x4*)(out + off + bj * 128 + n * 16) = b + acc[ai][bj][m][n]; } }
    }
};
struct EpiGU {
    static constexpr bool PERM = true;
    bf16* HID; const float* wl;
    __device__ __forceinline__ void operator()(const f32x4 (&acc)[2][2][4][2], const Unit& u, int wr, int wc, int fr, int fq) const {
        { int l_; asm volatile("v_mbcnt_lo_u32_b32 %0, -1, 0\n\tv_mbcnt_hi_u32_b32 %0, -1, %0" : "=v"(l_)); fr = l_ & 15; fq = l_ >> 4; }
        const int e = u.aux, cnt = u.cnt, base = u.r0, r0 = wr * 64 + fr, col0 = u.pn * 128 + wc * 32 + 8 * fq;
#pragma unroll
        for (int ai = 0; ai < 2; ++ai)
#pragma unroll
            for (int m = 0; m < 4; ++m) { const int r = r0 + ai * 128 + m * 16, idx = base + r; float w = 0.f; if (idx < cnt) w = wl[(size_t)e * M + idx];
                f32x4 h0, h1;
#pragma unroll
                for (int q = 0; q < 4; ++q) { const float g0 = acc[ai][0][m][0][q], g1 = acc[ai][0][m][1][q];
                    h0[q] = g0 * sigmoidf_(g0) * acc[ai][1][m][0][q] * w; h1[q] = g1 * sigmoidf_(g1) * acc[ai][1][m][1][q] * w; }
                *(GAS v4u*)(HID + (size_t)(u.pm * 256 + r) * FE + col0) = pack8(h0, h1);
                asm volatile("" ::: "memory"); }
    }
};
struct EpiDown {
    static constexpr bool PERM = true;
    bf16* EO; const unsigned* list;
    __device__ __forceinline__ void operator()(const f32x4 (&acc)[2][2][4][2], const Unit& u, int wr, int wc, int fr, int fq) const {
        { int l_; asm volatile("v_mbcnt_lo_u32_b32 %0, -1, 0\n\tv_mbcnt_hi_u32_b32 %0, -1, %0" : "=v"(l_)); fr = l_ & 15; fq = l_ >> 4; }
        const int e = u.aux, cnt = u.cnt, base = u.r0, r0 = wr * 64 + fr, col0 = u.pn * 256 + wc * 32 + 8 * fq;
#pragma unroll
        for (int ai = 0; ai < 2; ++ai)
#pragma unroll
            for (int m = 0; m < 4; ++m) { const int idx = base + r0 + ai * 128 + m * 16;
                if (idx < cnt) { const unsigned ent = list[(size_t)e * M + idx]; bf16* o = EO + ((size_t)(ent & 1u) * M + (ent >> 1)) * C + col0;
#pragma unroll
                    for (int bj = 0; bj < 2; ++bj) *(GAS v4u*)(o + bj * 128) = pack8(acc[ai][bj][m][0], acc[ai][bj][m][1]); }
                asm volatile("" ::: "memory"); }
    }
};

typedef short bf16x8s __attribute__((ext_vector_type(8)));
typedef short bf16x4s __attribute__((ext_vector_type(4)));
typedef short v4i16_t __attribute__((ext_vector_type(4)));
constexpr int TPB = 144;
constexpr int TILE_B = 64 * TPB;
constexpr int FP = 68;
constexpr int CS_FA = 0, CS_FB = 16384, CS_TILES = 32768, CS_TOT = CS_TILES + 12 * TILE_B, CS_WL = CS_TOT + 2048;
static_assert(CS_WL + 256 <= LDSCTL_OFF, "scan LDS map");
#define TILE(n) (lds + CS_TILES + (n) * TILE_B)
#define F4Z (f32x4){0.f, 0.f, 0.f, 0.f}
__device__ __forceinline__ bf16x8s ldfrag(const LAS unsigned char* tile, int row, int kcol) { return *(const LAS bf16x8s*)(tile + row * TPB + kcol * 2); }
__device__ __forceinline__ bf16x8s ldfrag_tr(const LAS unsigned char* tile, int n0, int k0, int lane) {
    const int g = lane >> 4, q = (lane & 15) >> 2, p = lane & 3;
    const LAS unsigned char* a = tile + (k0 + 8 * g + q) * TPB + (n0 + 4 * p) * 2;
    const v4i16_t lo = __builtin_amdgcn_ds_read_tr16_b64_v4i16((LAS v4i16_t*)a), hi = __builtin_amdgcn_ds_read_tr16_b64_v4i16((LAS v4i16_t*)(a + 4 * TPB));
    return (bf16x8s){lo[0], lo[1], lo[2], lo[3], hi[0], hi[1], hi[2], hi[3]};
}
__device__ __forceinline__ bf16x8s ldfrag_perm(const LAS unsigned char* tile, int row, int ks, int g) {
    const bf16x4s lo = *(const LAS bf16x4s*)(tile + row * TPB + (32 * ks + 4 * g) * 2), hi = *(const LAS bf16x4s*)(tile + row * TPB + (32 * ks + 16 + 4 * g) * 2);
    return (bf16x8s){lo[0], lo[1], lo[2], lo[3], hi[0], hi[1], hi[2], hi[3]};
}
#define MFMA16(a, b, c) __builtin_amdgcn_mfma_f32_16x16x32_bf16((a), (b), (c), 0, 0, 0)
__device__ __forceinline__ void mm64(f32x4 (&acc)[2], const LAS unsigned char* At, const LAS unsigned char* Bt, int rt, int ch, int fr, int g) {
#pragma unroll
    for (int ks = 0; ks < 2; ++ks) { const bf16x8s a = ldfrag(At, 16 * rt + fr, 32 * ks + 8 * g);
#pragma unroll
        for (int ct = 0; ct < 2; ++ct) acc[ct] = MFMA16(a, ldfrag(Bt, 32 * ch + 16 * ct + fr, 32 * ks + 8 * g), acc[ct]); }
}
__device__ __forceinline__ void mm64_bt(f32x4 (&acc)[2], const LAS unsigned char* At, const LAS unsigned char* X, int rt, int ch, int fr, int g, int lane) {
#pragma unroll
    for (int ks = 0; ks < 2; ++ks) { const bf16x8s a = ldfrag(At, 16 * rt + fr, 32 * ks + 8 * g);
#pragma unroll
        for (int ct = 0; ct < 2; ++ct) acc[ct] = MFMA16(a, ldfrag_tr(X, 32 * ch + 16 * ct, 32 * ks, lane), acc[ct]); }
}
__device__ __forceinline__ void mm64_at(f32x4 (&acc)[2], const LAS unsigned char* Xa, const LAS unsigned char* Bt, int rt, int ch, int fr, int g, int lane) {
#pragma unroll
    for (int ks = 0; ks < 2; ++ks) { const bf16x8s a = ldfrag_tr(Xa, 16 * rt, 32 * ks, lane);
#pragma unroll
        for (int ct = 0; ct < 2; ++ct) acc[ct] = MFMA16(a, ldfrag(Bt, 32 * ch + 16 * ct + fr, 32 * ks + 8 * g), acc[ct]); }
}
__device__ __forceinline__ void mm64_att(f32x4 (&acc)[2], const LAS unsigned char* Xa, const LAS unsigned char* X, int rt, int ch, int lane) {
#pragma unroll
    for (int ks = 0; ks < 2; ++ks) { const bf16x8s a = ldfrag_tr(Xa, 16 * rt, 32 * ks, lane);
#pragma unroll
        for (int ct = 0; ct < 2; ++ct) acc[ct] = MFMA16(a, ldfrag_tr(X, 32 * ch + 16 * ct, 32 * ks, lane), acc[ct]); }
}
__device__ __forceinline__ bf16x4s pack4(f32x4 v) { v2u w; w.x = pg8::cvt_pk_bf16(v[0], v[1]); w.y = pg8::cvt_pk_bf16(v[2], v[3]); return __builtin_bit_cast(bf16x4s, w); }
__device__ __forceinline__ f32x4 unpack4(bf16x4s s) { const v2u w = __builtin_bit_cast(v2u, s); return (f32x4){bflo(w.x), bfhi(w.x), bflo(w.y), bfhi(w.y)}; }
__device__ __forceinline__ void st_tr(LAS unsigned char* Out, const f32x4 (&acc)[2], int rt, int ch, int fr, int g) {
#pragma unroll
    for (int ct = 0; ct < 2; ++ct) *(LAS bf16x4s*)(Out + (32 * ch + 16 * ct + fr) * TPB + (16 * rt + 4 * g) * 2) = pack4(acc[ct]);
}
__device__ __forceinline__ void ld_tr(f32x4 (&acc)[2], const LAS unsigned char* In, int rt, int ch, int fr, int g) {
#pragma unroll
    for (int ct = 0; ct < 2; ++ct) acc[ct] = unpack4(*(const LAS bf16x4s*)(In + (32 * ch + 16 * ct + fr) * TPB + (16 * rt + 4 * g) * 2));
}
__device__ __forceinline__ void unpack8(v4u w, float (&o)[8]) { o[0] = bflo(w.x); o[1] = bfhi(w.x); o[2] = bflo(w.y); o[3] = bfhi(w.y); o[4] = bflo(w.z); o[5] = bfhi(w.z); o[6] = bflo(w.w); o[7] = bfhi(w.w); }
__device__ __forceinline__ v4u pack8f(const float (&o)[8]) { v4u w; w.x = pg8::cvt_pk_bf16(o[0], o[1]); w.y = pg8::cvt_pk_bf16(o[2], o[3]); w.z = pg8::cvt_pk_bf16(o[4], o[5]); w.w = pg8::cvt_pk_bf16(o[6], o[7]); return w; }

struct FrontIn { v4u r, k, v; bf16x8s fw[2], fa[2], w2[2][2], a2[2][2]; };
__device__ __forceinline__ void front_fetch(FrontIn& f, unsigned char* ws, int unit, int tid, int lane, int wave) {
    const int h = unit & 15, c = (unit >> 4) & 127, b = unit >> 11; const size_t row0 = (size_t)b * SEQ + c * 64;
    const int rt = wave & 3, ch = wave >> 2, fr = lane & 15, g = lane >> 4, t = tid >> 3, cq = tid & 7, c0 = h * HD + cq * 8;
    const bf16* Rb = (const bf16*)(ws + WS_B1); const bf16* Kb = (const bf16*)(ws + WS_B2); const bf16* Vb = (const bf16*)(ws + WS_B3);
    const bf16* LW = (const bf16*)(ws + WS_LW); const bf16* LA = (const bf16*)(ws + WS_LA); const bf16* W2T = (const bf16*)(ws + WS_WT_W2); const bf16* A2T = (const bf16*)(ws + WS_WT_A2);
    f.r = *(const GAS v4u*)(Rb + (row0 + t) * C + c0); f.k = *(const GAS v4u*)(Kb + (row0 + t) * C + c0); f.v = *(const GAS v4u*)(Vb + (row0 + t) * C + c0);
#pragma unroll
    for (int ks = 0; ks < 2; ++ks) { f.fw[ks] = *(const GAS bf16x8s*)(LW + (row0 + 16 * rt + fr) * DW + 32 * ks + 8 * g); f.fa[ks] = *(const GAS bf16x8s*)(LA + (row0 + 16 * rt + fr) * DA + 32 * ks + 8 * g);
#pragma unroll
        for (int ct = 0; ct < 2; ++ct) { const size_t wr_ = (size_t)(h * HD + 32 * ch + 16 * ct + fr) * 64 + 32 * ks + 8 * g; f.w2[ks][ct] = *(const GAS bf16x8s*)(W2T + wr_); f.a2[ks][ct] = *(const GAS bf16x8s*)(A2T + wr_); } }
}
template <int MODE>
__device__ __forceinline__ void chunk_front(const FrontIn& f, LAS unsigned char* lds, int h, int tid, int lane, int wave, float (&v8)[8], float& rkb) {
    const int rt = wave & 3, ch = wave >> 2, fr = lane & 15, g = lane >> 4;
    LAS float* FA = (LAS float*)(lds + CS_FA); LAS float* FB = (LAS float*)(lds + CS_FB); LAS float* TOT = (LAS float*)(lds + CS_TOT);
    const int t = tid >> 3, cq = tid & 7, c0 = h * HD + cq * 8;
    float pkk[8], pka[8], prk[8];
    { const f32x4 a0 = *(const GAS f32x4*)(INP(15) + c0), a1 = *(const GAS f32x4*)(INP(15) + c0 + 4), b0 = *(const GAS f32x4*)(INP(16) + c0), b1 = *(const GAS f32x4*)(INP(16) + c0 + 4);
#pragma unroll
      for (int q = 0; q < 4; ++q) { pkk[q] = a0[q]; pkk[4 + q] = a1[q]; pka[q] = b0[q]; pka[4 + q] = b1[q]; }
      if (MODE == 3) { const f32x4 c0v = *(const GAS f32x4*)(INP(17) + c0), c1v = *(const GAS f32x4*)(INP(17) + c0 + 4);
#pragma unroll
          for (int q = 0; q < 4; ++q) { prk[q] = c0v[q]; prk[4 + q] = c1v[q]; } } }
    {
        f32x4 aw[2] = {F4Z, F4Z}, aa[2] = {F4Z, F4Z};
#pragma unroll
        for (int ks = 0; ks < 2; ++ks)
#pragma unroll
            for (int ct = 0; ct < 2; ++ct) { aw[ct] = MFMA16(f.fw[ks], f.w2[ks][ct], aw[ct]); aa[ct] = MFMA16(f.fa[ks], f.a2[ks][ct], aa[ct]); }
#pragma unroll
        for (int ct = 0; ct < 2; ++ct) { const int j = 32 * ch + 16 * ct + fr; const float w0 = INP(7)[h * HD + j], a0 = INP(10)[h * HD + j];
#pragma unroll
            for (int q = 0; q < 4; ++q) { const int tt = 16 * rt + 4 * g + q; FA[tt * 64 + j] = -0.6065306597126334f * sigmoidf_(w0 + aw[ct][q]); FB[tt * 64 + j] = sigmoidf_(a0 + aa[ct][q]); } }
    }
    __syncthreads();
    {
        const int j = tid & 63, seg = tid >> 6; float run = 0.f; float loc[8];
#pragma unroll
        for (int q = 0; q < 8; ++q) { run += FA[(8 * seg + q) * 64 + j]; loc[q] = run; }
        TOT[seg * 64 + j] = run;
        __syncthreads();
        float off = 0.f;
#pragma unroll
        for (int s2 = 0; s2 < 7; ++s2) off += (s2 < seg) ? TOT[s2 * 64 + j] : 0.f;
#pragma unroll
        for (int q = 0; q < 8; ++q) FA[(8 * seg + q) * 64 + j] = loc[q] + off;
    }
    __syncthreads();
    {
        float r[8], k[8];
        unpack8(f.r, r); unpack8(f.k, k); unpack8(f.v, v8);
        float cw[8], cwp[8], ag[8];
#pragma unroll
        for (int q = 0; q < 8; ++q) { cw[q] = FA[t * 64 + cq * 8 + q]; cwp[q] = t > 0 ? FA[(t - 1) * 64 + cq * 8 + q] : 0.f; ag[q] = FB[t * 64 + cq * 8 + q]; }
        float kk[8], ss = 0.f; rkb = 0.f;
#pragma unroll
        for (int q = 0; q < 8; ++q) { kk[q] = k[q] * pkk[q]; ss += kk[q] * kk[q]; }
        ss += shx(ss, 1, lane); ss += shx(ss, 2, lane); ss += shx(ss, 4, lane);
        const float inv = 1.0f / fmaxf(sqrtf(ss), 1e-12f);
        float at[8], bt[8], kt[8], rt_[8];
#pragma unroll
        for (int q = 0; q < 8; ++q) { const float kn = kk[q] * inv, kp = k[q] * (1.0f + (ag[q] - 1.0f) * pka[q]);
            const float ein = __expf(-cw[q]);
            at[q] = -kn * __expf(cwp[q]); bt[q] = kn * ag[q] * ein; kt[q] = kp * ein;
            if (MODE == 3) { rt_[q] = r[q] * __expf(cw[q]); rkb += r[q] * kp * prk[q]; } }
        if (MODE == 3) { rkb += shx(rkb, 1, lane); rkb += shx(rkb, 2, lane); rkb += shx(rkb, 4, lane); }
        *(LAS v4u*)(TILE(0) + t * TPB + cq * 16) = pack8f(at); *(LAS v4u*)(TILE(1) + t * TPB + cq * 16) = pack8f(bt); *(LAS v4u*)(TILE(2) + t * TPB + cq * 16) = pack8f(kt);
        *(LAS v4u*)(TILE(3) + t * TPB + cq * 16) = f.v;
        if (MODE == 3) *(LAS v4u*)(TILE(4) + t * TPB + cq * 16) = pack8f(rt_);
        if (MODE == 1 && t == 63) {
#pragma unroll
            for (int q = 0; q < 8; ++q) ((LAS float*)(lds + CS_WL))[cq * 8 + q] = __expf(cw[q]); }
    }
    __syncthreads();
}

__device__ __forceinline__ void scan_s1(unsigned char* ws, LAS unsigned char* lds, int lane0, int wave) {
    const int rt = wave & 3, ch = wave >> 2;
    FrontIn fin; { int l0 = lane0; asm volatile("" : "+v"(l0)); if ((int)blockIdx.x < BATCH * NH * (SEQ / 64)) front_fetch(fin, ws, blockIdx.x, wave * 64 + l0, l0, wave); }
    for (int unit = blockIdx.x; unit < BATCH * NH * (SEQ / 64); unit += gridDim.x) {
        int lane = lane0; asm volatile("" : "+v"(lane));
        const int tid = wave * 64 + lane, fr = lane & 15, g = lane >> 4;
        const int h = unit & 15, c = (unit >> 4) & 127, b = unit >> 11; const size_t chunk = ((size_t)b * NH + h) * 128 + c;
        float v8[8]; float rkb;
        chunk_front<1>(fin, lds, h, tid, lane, wave, v8, rkb);
        if (unit + (int)gridDim.x < BATCH * NH * (SEQ / 64)) front_fetch(fin, ws, unit + gridDim.x, tid, lane, wave);
        {
            f32x4 a1[2] = {F4Z, F4Z}, a2[2] = {F4Z, F4Z}, a3[2] = {F4Z, F4Z};
            mm64(a1, TILE(0), TILE(1), rt, ch, fr, g);
            mm64(a2, TILE(1), TILE(0), rt, ch, fr, g);
            mm64(a3, TILE(2), TILE(0), rt, ch, fr, g);
            f32x4 p1[2];
#pragma unroll
            for (int ct = 0; ct < 2; ++ct) { const int col = 32 * ch + 16 * ct + fr;
#pragma unroll
                for (int q = 0; q < 4; ++q) { const int row = 16 * rt + 4 * g + q;
                    a1[ct][q] = col < row ? a1[ct][q] : 0.f;
                    a2[ct][q] = row < col ? a2[ct][q] : 0.f;
                    p1[ct][q] = a2[ct][q] + (row == col ? 1.0f : 0.f);
                    a3[ct][q] = row < col ? a3[ct][q] : 0.f; } }
            st_tr(TILE(6), a1, rt, ch, fr, g);
            st_tr(TILE(5), a2, rt, ch, fr, g);
            st_tr(TILE(9), p1, rt, ch, fr, g);
            st_tr(TILE(4), a3, rt, ch, fr, g);
        }
        __syncthreads();
#pragma unroll
        for (int r = 0; r < 6; ++r) {
            LAS unsigned char* Sr = TILE(5 + 2 * (r & 1)); LAS unsigned char* Sc = TILE(6 + 2 * (r & 1)); LAS unsigned char* Sr2 = TILE(5 + 2 * ((r & 1) ^ 1)); LAS unsigned char* Sc2 = TILE(6 + 2 * ((r & 1) ^ 1));
            if (r <= 4) { f32x4 q1[2] = {F4Z, F4Z}, q2[2] = {F4Z, F4Z};
                mm64(q1, Sr, Sc, rt, ch, fr, g);
                mm64(q2, Sc, Sr, rt, ch, fr, g);
                st_tr(Sc2, q1, rt, ch, fr, g); st_tr(Sr2, q2, rt, ch, fr, g); }
            if (r >= 1) { LAS unsigned char* Pr = TILE(9 + ((r - 1) & 1)); LAS unsigned char* Pr2 = TILE(9 + (((r - 1) & 1) ^ 1));
                f32x4 pa[2]; ld_tr(pa, Pr, rt, ch, fr, g);
                mm64(pa, Sc, Pr, rt, ch, fr, g);
                st_tr(Pr2, pa, rt, ch, fr, g); }
            if (r == 0) { f32x4 gg[2] = {F4Z, F4Z};
                mm64_bt(gg, TILE(4), TILE(3), rt, ch, fr, g, lane);
                st_tr(TILE(11), gg, rt, ch, fr, g); }
            __syncthreads();
        }
        { const int trow = tid >> 3, tcq = tid & 7; *(GAS v4u*)((bf16*)(ws + WS_B4) + chunk * 4096 + trow * 64 + tcq * 8) = *(const LAS v4u*)(TILE(10) + trow * TPB + tcq * 16); }
        {
            f32x4 acc[2] = {F4Z, F4Z}, ac2[2] = {F4Z, F4Z};
            mm64_bt(acc, TILE(10), TILE(0), rt, ch, fr, g, lane);
            mm64(ac2, TILE(10), TILE(11), rt, ch, fr, g);
            st_tr(TILE(5), acc, rt, ch, fr, g); st_tr(TILE(6), ac2, rt, ch, fr, g);
        }
        __syncthreads();
        {
            const LAS float* WL = (const LAS float*)(lds + CS_WL);
            f32x4 acc[2] = {F4Z, F4Z};
            mm64_bt(acc, TILE(5), TILE(1), rt, ch, fr, g, lane);
            bf16* Mg = (bf16*)(ws + WS_B0) + chunk * 4096;
#pragma unroll
            for (int ct = 0; ct < 2; ++ct) { const int j1 = 32 * ch + 16 * ct + fr; const float wl = WL[j1];
#pragma unroll
                for (int q = 0; q < 4; ++q) { const int j2 = 16 * rt + 4 * g + q; acc[ct][q] = wl * (acc[ct][q] + (j2 == j1 ? 1.0f : 0.f)); }
                const int rtS = 2 * ch + ct, ksS = rt >> 1, half = rt & 1;
                *(GAS bf16x4s*)(Mg + (((rtS * 2 + ksS) * 64 + g * 16 + fr) * 8 + half * 4)) = pack4(acc[ct]); }
            f32x4 ad[2] = {F4Z, F4Z};
            mm64_at(ad, TILE(1), TILE(6), rt, ch, fr, g, lane);
            mm64_att(ad, TILE(2), TILE(3), rt, ch, lane);
            const f32x4 wl4 = *(const LAS f32x4*)(WL + 16 * rt + 4 * g);
            bf16* Dg = (bf16*)OUTP() + chunk * 4096;
#pragma unroll
            for (int ct = 0; ct < 2; ++ct) *(GAS bf16x4s*)(Dg + (((2 * ch + ct) * 4 + rt) * 64 + lane) * 4) = pack4(ad[ct] * wl4);
        }
        __syncthreads();
    }
}

__device__ __forceinline__ void scan_s2(unsigned char* ws, int lane, int wave) {
    if (wave >= 4) return;
    const int ct = wave;
    for (int bh = blockIdx.x; bh < BATCH * NH; bh += gridDim.x) {
        const bf16* Mg = (const bf16*)(ws + WS_B0) + (size_t)bh * 128 * 4096; const bf16* Dg = (const bf16*)OUTP() + (size_t)bh * 128 * 4096; bf16* Sg = (bf16*)OUTP() + (size_t)M * C + (size_t)bh * 128 * 4096;
        f32x4 acc[4];
#pragma unroll
        for (int r = 0; r < 4; ++r) acc[r] = F4Z;
        bf16x8s mf[4][2]; bf16x4s df[4];
#pragma unroll
        for (int r = 0; r < 4; ++r) { df[r] = *(const GAS bf16x4s*)(Dg + ((ct * 4 + r) * 64 + lane) * 4);
#pragma unroll
            for (int ks = 0; ks < 2; ++ks) mf[r][ks] = *(const GAS bf16x8s*)(Mg + ((r * 2 + ks) * 64 + lane) * 8); }
#pragma unroll 1
        for (int c = 0; c < 128; ++c) {
            bf16x8s sf[2];
#pragma unroll
            for (int ks = 0; ks < 2; ++ks) { const bf16x4s lo = pack4(acc[2 * ks]), hi = pack4(acc[2 * ks + 1]); sf[ks] = (bf16x8s){lo[0], lo[1], lo[2], lo[3], hi[0], hi[1], hi[2], hi[3]}; }
#pragma unroll
            for (int ks = 0; ks < 2; ++ks) *(GAS bf16x8s*)(Sg + (size_t)c * 4096 + ((ct * 2 + ks) * 64 + lane) * 8) = sf[ks];
            bf16x8s mc[4][2]; f32x4 na[4];
#pragma unroll
            for (int r = 0; r < 4; ++r) { na[r] = unpack4(df[r]);
#pragma unroll
                for (int ks = 0; ks < 2; ++ks) mc[r][ks] = mf[r][ks]; }
            if (c + 1 < 128) {
                const bf16* Mn = Mg + (size_t)(c + 1) * 4096; const bf16* Dn = Dg + (size_t)(c + 1) * 4096;
#pragma unroll
                for (int r = 0; r < 4; ++r) { df[r] = *(const GAS bf16x4s*)(Dn + ((ct * 4 + r) * 64 + lane) * 4);
#pragma unroll
                    for (int ks = 0; ks < 2; ++ks) mf[r][ks] = *(const GAS bf16x8s*)(Mn + ((r * 2 + ks) * 64 + lane) * 8); }
            }
#pragma unroll
            for (int ks = 0; ks < 2; ++ks)
#pragma unroll
                for (int r = 0; r < 4; ++r) na[r] = MFMA16(mc[r][ks], sf[ks], na[r]);
#pragma unroll
            for (int r = 0; r < 4; ++r) acc[r] = na[r];
        }
    }
}

__device__ __forceinline__ void scan_s3(unsigned char* ws, LAS unsigned char* lds, int lane0, int wave) {
    const int rt = wave & 3, ch = wave >> 2;
    LAS float* Ys = (LAS float*)(lds + CS_FA);
    const bf16* LG = (const bf16*)(ws + WS_LG); const bf16* G2T = (const bf16*)(ws + WS_WT_G2); bf16* YG = (bf16*)(ws + WS_B0);
    FrontIn fin; { int l0 = lane0; asm volatile("" : "+v"(l0)); if ((int)blockIdx.x < BATCH * NH * (SEQ / 64)) front_fetch(fin, ws, blockIdx.x, wave * 64 + l0, l0, wave); }
    for (int unit = blockIdx.x; unit < BATCH * NH * (SEQ / 64); unit += gridDim.x) {
        int lane = lane0; asm volatile("" : "+v"(lane));
        const int tid = wave * 64 + lane, fr = lane & 15, g = lane >> 4;
        const int h = unit & 15, c = (unit >> 4) & 127, b = unit >> 11; const size_t chunk = ((size_t)b * NH + h) * 128 + c; const size_t row0 = (size_t)b * SEQ + c * 64;
        const bf16* Sg = (const bf16*)OUTP() + (size_t)M * C + chunk * 4096; const bf16* Tg = (const bf16*)(ws + WS_B4) + chunk * 4096;
        bf16x8s sB[2][2], sA[2], tA[2];
#pragma unroll
        for (int ks = 0; ks < 2; ++ks) { sA[ks] = *(const GAS bf16x8s*)(Sg + ((rt * 2 + ks) * 64 + lane) * 8); tA[ks] = *(const GAS bf16x8s*)(Tg + (16 * rt + fr) * 64 + 32 * ks + 8 * g);
#pragma unroll
            for (int ct = 0; ct < 2; ++ct) sB[ks][ct] = *(const GAS bf16x8s*)(Sg + (((2 * ch + ct) * 2 + ks) * 64 + lane) * 8); }
        const int et = tid >> 3, ecq = tid & 7, ec0 = h * HD + ecq * 8;
        const f32x4 lnw0 = *(const GAS f32x4*)(INP(18) + ec0), lnw1 = *(const GAS f32x4*)(INP(18) + ec0 + 4), lnb0 = *(const GAS f32x4*)(INP(19) + ec0), lnb1 = *(const GAS f32x4*)(INP(19) + ec0 + 4);
        bf16x8s gA[5], gB[5][2];
#pragma unroll
        for (int ks = 0; ks < 5; ++ks) { gA[ks] = *(const GAS bf16x8s*)(G2T + (size_t)(h * HD + 16 * rt + fr) * DG + 32 * ks + 8 * g);
#pragma unroll
            for (int ct = 0; ct < 2; ++ct) gB[ks][ct] = *(const GAS bf16x8s*)(LG + (row0 + 32 * ch + 16 * ct + fr) * DG + 32 * ks + 8 * g); }
        float v8[8]; float rkb;
        chunk_front<3>(fin, lds, h, tid, lane, wave, v8, rkb);
        if (unit + (int)gridDim.x < BATCH * NH * (SEQ / 64)) front_fetch(fin, ws, unit + gridDim.x, tid, lane, wave);
        {
            f32x4 a1[2] = {F4Z, F4Z}, a2[2] = {F4Z, F4Z}, a3[2] = {F4Z, F4Z};
            mm64(a1, TILE(2), TILE(0), rt, ch, fr, g);
            mm64(a2, TILE(1), TILE(4), rt, ch, fr, g);
            mm64(a3, TILE(2), TILE(4), rt, ch, fr, g);
#pragma unroll
            for (int ct = 0; ct < 2; ++ct) { const int t = 32 * ch + 16 * ct + fr;
#pragma unroll
                for (int q = 0; q < 4; ++q) { const int s = 16 * rt + 4 * g + q; a1[ct][q] = s < t ? a1[ct][q] : 0.f; a2[ct][q] = s <= t ? a2[ct][q] : 0.f; a3[ct][q] = s <= t ? a3[ct][q] : 0.f; } }
            st_tr(TILE(5), a1, rt, ch, fr, g); st_tr(TILE(6), a2, rt, ch, fr, g); st_tr(TILE(7), a3, rt, ch, fr, g);
        }
        f32x4 ag[2] = {F4Z, F4Z};
#pragma unroll
        for (int ks = 0; ks < 5; ++ks)
#pragma unroll
            for (int ct = 0; ct < 2; ++ct) ag[ct] = MFMA16(gA[ks], gB[ks][ct], ag[ct]);
        __syncthreads();
        {
            f32x4 acc[2] = {F4Z, F4Z};
#pragma unroll
            for (int ks = 0; ks < 2; ++ks) { const bf16x8s a = ldfrag_perm(TILE(0), 16 * rt + fr, ks, g);
#pragma unroll
                for (int ct = 0; ct < 2; ++ct) acc[ct] = MFMA16(a, sB[ks][ct], acc[ct]); }
            mm64_bt(acc, TILE(5), TILE(3), rt, ch, fr, g, lane);
            st_tr(TILE(8), acc, rt, ch, fr, g);
        }
        __syncthreads();
        {
            f32x4 acc[2] = {F4Z, F4Z};
#pragma unroll
            for (int ks = 0; ks < 2; ++ks)
#pragma unroll
                for (int ct = 0; ct < 2; ++ct) acc[ct] = MFMA16(tA[ks], ldfrag(TILE(8), 32 * ch + 16 * ct + fr, 32 * ks + 8 * g), acc[ct]);
            st_tr(TILE(9), acc, rt, ch, fr, g);
        }
        __syncthreads();
        {
            f32x4 acc[2] = {F4Z, F4Z};
#pragma unroll
            for (int ks = 0; ks < 2; ++ks)
#pragma unroll
                for (int ct = 0; ct < 2; ++ct) acc[ct] = MFMA16(sA[ks], ldfrag_perm(TILE(4), 32 * ch + 16 * ct + fr, ks, g), acc[ct]);
            mm64(acc, TILE(9), TILE(6), rt, ch, fr, g); mm64_at(acc, TILE(3), TILE(7), rt, ch, fr, g, lane);
#pragma unroll
            for (int ct = 0; ct < 2; ++ct) { const int t = 32 * ch + 16 * ct + fr; *(LAS f32x4*)(Ys + t * FP + 16 * rt + 4 * g) = acc[ct]; }
        }
        __syncthreads();
        {
            const f32x4 y0 = *(const LAS f32x4*)(Ys + et * FP + ecq * 8), y1 = *(const LAS f32x4*)(Ys + et * FP + ecq * 8 + 4);
            float y[8] = {y0[0], y0[1], y0[2], y0[3], y1[0], y1[1], y1[2], y1[3]};
            float s = 0.f;
#pragma unroll
            for (int q = 0; q < 8; ++q) s += y[q];
            s += shx(s, 1, lane); s += shx(s, 2, lane); s += shx(s, 4, lane);
            const float mu = s * (1.0f / HD); float vs = 0.f;
#pragma unroll
            for (int q = 0; q < 8; ++q) { y[q] -= mu; vs += y[q] * y[q]; }
            vs += shx(vs, 1, lane); vs += shx(vs, 2, lane); vs += shx(vs, 4, lane);
            const float rstd = 1.0f / sqrtf(vs * (1.0f / HD) + GN_EPS);
            f32x4 o0, o1;
#pragma unroll
            for (int q = 0; q < 4; ++q) { o0[q] = y[q] * rstd * lnw0[q] + lnb0[q] + rkb * v8[q]; o1[q] = y[4 + q] * rstd * lnw1[q] + lnb1[q] + rkb * v8[4 + q]; }
            *(LAS f32x4*)(Ys + et * FP + ecq * 8) = o0; *(LAS f32x4*)(Ys + et * FP + ecq * 8 + 4) = o1;
        }
        __syncthreads();
        {
#pragma unroll
            for (int ct = 0; ct < 2; ++ct) { const int t = 32 * ch + 16 * ct + fr; const f32x4 yv = *(const LAS f32x4*)(Ys + t * FP + 16 * rt + 4 * g);
                *(GAS bf16x4s*)(YG + (row0 + t) * C + h * HD + 16 * rt + 4 * g) = pack4(yv * ag[ct]); }
        }
        __syncthreads();
    }
}
#undef TILE
#if MK_DEBUG
__device__ __forceinline__ void scan_naive(unsigned char* ws, LAS unsigned char* lds, int tid) {
    const int lane = tid & 63;
    const bf16* Rb = (const bf16*)(ws + WS_B1); const bf16* Kb = (const bf16*)(ws + WS_B2); const bf16* Vb = (const bf16*)(ws + WS_B3);
    const bf16* LW = (const bf16*)(ws + WS_LW); const bf16* LA = (const bf16*)(ws + WS_LA);
    float* Y = OUTP(); float* RK = (float*)(ws + WS_HID);
    LAS float* sR = (LAS float*)lds; LAS float* sK = sR + 4096; LAS float* sV = sK + 4096; LAS float* sA = sV + 4096; LAS float* sB = sA + 4096; LAS float* sD = sB + 4096;
    LAS float* sW2 = sD + 4096; LAS float* sA2 = sW2 + 4096;
    for (int unit = blockIdx.x; unit < BATCH * NH; unit += gridDim.x) {
        const int b = unit / NH, h = unit % NH;
        __syncthreads();
        for (int e = tid; e < 4096; e += 512) { const int d = e >> 6, j = e & 63; sW2[e] = INP(9)[(size_t)d * C + h * HD + j]; sA2[e] = INP(12)[(size_t)d * C + h * HD + j]; }
        __syncthreads();
        const int pt = tid >> 3, cq = tid & 7, c0 = h * HD + cq * 8;
        const int si = tid >> 3, jq = tid & 7;
        float S[8];
#pragma unroll
        for (int q = 0; q < 8; ++q) S[q] = 0.f;
        float w0v[8], a0v[8], kkv[8], kav[8], rkv[8];
#pragma unroll
        for (int q = 0; q < 8; ++q) { w0v[q] = INP(7)[c0 + q]; a0v[q] = INP(10)[c0 + q]; kkv[q] = INP(15)[c0 + q]; kav[q] = INP(16)[c0 + q]; rkv[q] = INP(17)[c0 + q]; }
        for (int blk = 0; blk < SEQ / 64; ++blk) {
            const size_t row = (size_t)b * SEQ + blk * 64 + pt;
            {
                const v4u r4 = *(const GAS v4u*)(Rb + row * C + c0), k4 = *(const GAS v4u*)(Kb + row * C + c0), v4 = *(const GAS v4u*)(Vb + row * C + c0);
                float r[8], k[8], v[8];
                r[0] = bflo(r4.x); r[1] = bfhi(r4.x); r[2] = bflo(r4.y); r[3] = bfhi(r4.y); r[4] = bflo(r4.z); r[5] = bfhi(r4.z); r[6] = bflo(r4.w); r[7] = bfhi(r4.w);
                k[0] = bflo(k4.x); k[1] = bfhi(k4.x); k[2] = bflo(k4.y); k[3] = bfhi(k4.y); k[4] = bflo(k4.z); k[5] = bfhi(k4.z); k[6] = bflo(k4.w); k[7] = bfhi(k4.w);
                v[0] = bflo(v4.x); v[1] = bfhi(v4.x); v[2] = bflo(v4.y); v[3] = bfhi(v4.y); v[4] = bflo(v4.z); v[5] = bfhi(v4.z); v[6] = bflo(v4.w); v[7] = bfhi(v4.w);
                float wp[8], ap[8];
#pragma unroll
                for (int q = 0; q < 8; ++q) { wp[q] = w0v[q]; ap[q] = a0v[q]; }
                for (int d = 0; d < 64; ++d) { const float lw = bf2f(LW[row * DW + d]), la = bf2f(LA[row * DA + d]);
#pragma unroll
                    for (int q = 0; q < 8; ++q) { wp[q] += lw * sW2[d * 64 + cq * 8 + q]; ap[q] += la * sA2[d * 64 + cq * 8 + q]; } }
                float kk[8], ss = 0.f, rks = 0.f;
#pragma unroll
                for (int q = 0; q < 8; ++q) { kk[q] = k[q] * kkv[q]; ss += kk[q] * kk[q]; }
                ss += shx(ss, 1, lane); ss += shx(ss, 2, lane); ss += shx(ss, 4, lane);
                const float inv = 1.0f / fmaxf(sqrtf(ss), 1e-12f);
#pragma unroll
                for (int q = 0; q < 8; ++q) { const float ag = sigmoidf_(ap[q]); const float kn = kk[q] * inv; const float kp = k[q] * (1.0f + (ag - 1.0f) * kav[q]);
                    const float lw = -0.6065306597126334f * sigmoidf_(wp[q]);
                    const int o = pt * 64 + cq * 8 + q;
                    sR[o] = r[q]; sK[o] = kp; sV[o] = v[q]; sA[o] = -kn; sB[o] = kn * ag; sD[o] = __expf(lw); rks += r[q] * kp * rkv[q]; }
                rks += shx(rks, 1, lane); rks += shx(rks, 2, lane); rks += shx(rks, 4, lane);
                if (cq == 0) RK[row * NH + h] = rks;
            }
            __syncthreads();
            for (int t = 0; t < 64; ++t) {
                const LAS f32x4* pa = (const LAS f32x4*)(sA + t * 64 + jq * 8); const LAS f32x4* pb = (const LAS f32x4*)(sB + t * 64 + jq * 8);
                const LAS f32x4* pd = (const LAS f32x4*)(sD + t * 64 + jq * 8); const LAS f32x4* pk = (const LAS f32x4*)(sK + t * 64 + jq * 8);
                const LAS f32x4* pr = (const LAS f32x4*)(sR + t * 64 + jq * 8);
                const f32x4 a0 = pa[0], a1 = pa[1], b0 = pb[0], b1 = pb[1], d0 = pd[0], d1 = pd[1], k0 = pk[0], k1 = pk[1], r0 = pr[0], r1 = pr[1];
                const float vi = sV[t * 64 + si];
                float sa = 0.f;
#pragma unroll
                for (int q = 0; q < 4; ++q) { sa += S[q] * a0[q]; sa += S[4 + q] * a1[q]; }
                sa += shx(sa, 1, lane); sa += shx(sa, 2, lane); sa += shx(sa, 4, lane);
                float y = 0.f;
#pragma unroll
                for (int q = 0; q < 4; ++q) { S[q] = S[q] * d0[q] + sa * b0[q] + vi * k0[q]; S[4 + q] = S[4 + q] * d1[q] + sa * b1[q] + vi * k1[q]; y += S[q] * r0[q]; y += S[4 + q] * r1[q]; }
                y += shx(y, 1, lane); y += shx(y, 2, lane); y += shx(y, 4, lane);
                if (jq == 0) Y[((size_t)b * SEQ + blk * 64 + t) * C + h * HD + si] = y;
            }
            __syncthreads();
        }
    }
}
__device__ __forceinline__ void post_scan(unsigned char* ws, int gw, int NGW, int lane) {
    const float* Y = OUTP(); const float* RK = (const float*)(ws + WS_HID); const bf16* Vb = (const bf16*)(ws + WS_B3); const bf16* LG = (const bf16*)(ws + WS_LG);
    bf16* YG = (bf16*)(ws + WS_B4); const float* g2 = INP(14); const float* lnw = INP(18); const float* lnb = INP(19);
    for (int it = gw; it < M * NH; it += NGW) {
        const int row = it / NH, h = it % NH, c = h * HD + lane;
        const float y = Y[(size_t)row * C + c];
        const float mu = wave_sum(y, lane) * (1.0f / HD); const float d = y - mu; const float var = wave_sum(d * d, lane) * (1.0f / HD);
        float o = d * (1.0f / sqrtf(var + GN_EPS)) * lnw[c] + lnb[c];
        o += RK[(size_t)row * NH + h] * bf2f(Vb[(size_t)row * C + c]);
        float g = 0.f;
        for (int dd = 0; dd < DG; ++dd) g += bf2f(LG[(size_t)row * DG + dd]) * g2[(size_t)dd * C + c];
        YG[(size_t)row * C + c] = (bf16)f2bf(o * g);
    }
}


constexpr int CW_DBG = 3200;
__device__ __forceinline__ void dbg_nonfinite(unsigned char* ws, const bf16* X, size_t n, int slot, int gw, int NGW, int lane, float thr = 1e30f) {
    unsigned* cw = (unsigned*)(ws + WS_CTL) + CW_DBG + 64 * slot; unsigned nnan = 0;
    for (size_t i = (size_t)gw * 64 + lane; i < n; i += (size_t)NGW * 64) { const float x = bf2f(X[i]); if (!(fabsf(x) < thr)) ++nnan; }
    if (nnan) atomicAdd(cw, nnan);
}
__device__ __forceinline__ void dbg_compare(unsigned char* ws, const bf16* X, const bf16* Y, int gw, int NGW, int lane) {
    unsigned* cw = (unsigned*)(ws + WS_CTL) + CW_DBG; unsigned nbad = 0, nnan = 0;
    for (size_t i = (size_t)gw * 64 + lane; i < (size_t)M * C; i += (size_t)NGW * 64) { const float x = bf2f(X[i]), y = bf2f(Y[i]);
        if (!(fabsf(x) < 1e30f)) ++nnan; else if (fabsf(x - y) > 0.05f * (fabsf(y) + 0.05f)) ++nbad; }
    if (nnan) atomicAdd(cw, nnan); if (nbad) atomicAdd(cw + 64, nbad);
}
#endif
__device__ __forceinline__ void router_rows(unsigned char* ws, LAS unsigned char* lds, int layer, int gw, int NGW, int lane, int tid) {
    const float* Hh = OUTP(); const float* gain = INP(2) + layer * C; bf16* XN = (bf16*)(ws + WS_B1);
    const float* wg = INP(24) + (size_t)layer * C * 4; const float* bg = INP(25) + layer * 4; const float* wi = INP(26) + (size_t)layer * C * 16; const float* bi = INP(27) + layer * 16;
    unsigned* cnt = (unsigned*)(ws + WS_CTL) + CW_CNT + layer * 16 * 64; unsigned* list = (unsigned*)(ws + WS_LIST); float* wl = (float*)(ws + WS_WL);
    LAS float* sWg = (LAS float*)lds; LAS float* sWi = sWg + C * 4;
    __syncthreads();
    for (int e = tid; e < C * 4; e += 512) sWg[e] = wg[e];
    for (int e = tid; e < C * 16; e += 512) sWi[e] = wi[e];
    __syncthreads();
    f32x4 g[4]; load_row(gain, lane, g);
    for (int row = gw; row < M; row += NGW) {
        f32x4 v[4]; load_row(Hh + (size_t)row * C, lane, v); const float rs = row_rs(v, lane);
#pragma unroll
        for (int j = 0; j < 4; ++j) v[j] = v[j] * rs * g[j];
        store_row_bf16(XN + (size_t)row * C, lane, v);
        float gl[4] = {0.f, 0.f, 0.f, 0.f};
        const LAS unsigned char* pWg = (const LAS unsigned char*)sWg + lane * 64;
#pragma unroll
        for (int j = 0; j < 4; ++j)
#pragma unroll
            for (int q = 0; q < 4; ++q) { const f32x4 w = *(const LAS f32x4*)(pWg + j * 4096 + q * 16); const float xv = v[j][q]; gl[0] += xv * w.x; gl[1] += xv * w.y; gl[2] += xv * w.z; gl[3] += xv * w.w; }
#pragma unroll
        for (int q = 0; q < 4; ++q) gl[q] = wave_sum(gl[q], lane) + bg[q];
        int gi = 0; float gm = gl[0];
#pragma unroll
        for (int q = 1; q < 4; ++q) if (gl[q] > gm) { gm = gl[q]; gi = q; }
        float gden = 0.f;
#pragma unroll
        for (int q = 0; q < 4; ++q) gden += __expf(gl[q] - gm);
        const float gval = 1.0f / gden;
        float il[4] = {0.f, 0.f, 0.f, 0.f};
        const LAS unsigned char* pWi = (const LAS unsigned char*)sWi + lane * 256 + gi * 16;
#pragma unroll
        for (int j = 0; j < 4; ++j)
#pragma unroll
            for (int q = 0; q < 4; ++q) { const f32x4 w = *(const LAS f32x4*)(pWi + j * 16384 + q * 64); const float xv = v[j][q]; il[0] += xv * w.x; il[1] += xv * w.y; il[2] += xv * w.z; il[3] += xv * w.w; }
#pragma unroll
        for (int q = 0; q < 4; ++q) il[q] = wave_sum(il[q], lane) + bi[gi * 4 + q];
        int i0 = 0; float m0 = il[0];
#pragma unroll
        for (int q = 1; q < 4; ++q) if (il[q] > m0) { m0 = il[q]; i0 = q; }
        int i1 = -1; float m1 = -INFINITY;
#pragma unroll
        for (int q = 0; q < 4; ++q) if (q != i0 && il[q] > m1) { m1 = il[q]; i1 = q; }
        const float e1 = __expf(m1 - m0); const float w0 = gval / (1.0f + e1), w1 = gval * e1 / (1.0f + e1);
        if (lane == 0) {
            const int ex0 = gi * 4 + i0, ex1 = gi * 4 + i1;
            const unsigned p0 = atomicAdd(cnt + ex0 * 64, 1u); list[(size_t)ex0 * M + p0] = (unsigned)row * 2u; wl[(size_t)ex0 * M + p0] = w0;
            const unsigned p1 = atomicAdd(cnt + ex1 * 64, 1u); list[(size_t)ex1 * M + p1] = (unsigned)row * 2u + 1u; wl[(size_t)ex1 * M + p1] = w1;
        }
    }
}
__device__ __forceinline__ void moe_table(unsigned char* ws, volatile LAS int* tab, int layer, int tid) {
    __syncthreads();
    if (tid == 0) { const unsigned* cnt = (const unsigned*)(ws + WS_CTL) + CW_CNT + layer * 16 * 64; int t = 0;
#pragma unroll 1
        for (int e = 0; e < 16; ++e) { const int c = (int)__hip_atomic_load(cnt, RLX_AGENT); cnt += 64; tab[e] = c; tab[16 + e] = t; t += (c + 255) >> 8; tab[32 + e] = t; }
        tab[48] = t; }
    __syncthreads();
}
__device__ __forceinline__ void combine_rows(unsigned char* ws, int mode, int gw, int NGW, int lane) {
    float* Hh = OUTP(); const bf16* E0 = (const bf16*)(ws + WS_B2); const bf16* E1 = (const bf16*)(ws + WS_B3); bf16* XN2 = (bf16*)(ws + WS_B0);
    f32x4 g[4]; load_row(INP(4), lane, g);
    for (int row = gw; row < M; row += NGW) {
        f32x4 v[4]; load_row(Hh + (size_t)row * C, lane, v);
#pragma unroll
        for (int j = 0; j < 4; ++j) { const v2u e0 = ((const GAS v2u*)(E0 + (size_t)row * C))[64 * j + lane], e1 = ((const GAS v2u*)(E1 + (size_t)row * C))[64 * j + lane];
            v[j].x += bflo(e0.x) + bflo(e1.x); v[j].y += bfhi(e0.x) + bfhi(e1.x); v[j].z += bflo(e0.y) + bflo(e1.y); v[j].w += bfhi(e0.y) + bfhi(e1.y); }
        const float rs = row_rs(v, lane);
        if (mode == 0) {
#pragma unroll
            for (int j = 0; j < 4; ++j) ((GAS f32x4*)(Hh + (size_t)row * C))[64 * j + lane] = v[j];
#pragma unroll
            for (int j = 0; j < 4; ++j) v[j] = v[j] * rs;
            store_row_bf16(XN2 + (size_t)row * C, lane, v);
        } else {
            float sig = 1.0f;
#if MK_DEBUG
            const unsigned* cw = (const unsigned*)(ws + WS_CTL) + CW_DBG; const unsigned nnan = __hip_atomic_load(cw, RLX_AGENT), nbad = __hip_atomic_load(cw + 64, RLX_AGENT);
            if (row < 512 && nnan > 0) sig = 2.0f;
            if (row >= 512 && row < 1536 && __hip_atomic_load(cw + 128, RLX_AGENT) > 0) sig = 2.0f;
            if (row >= 1536 && row < 3584 && __hip_atomic_load(cw + 192, RLX_AGENT) > 0) sig = 2.0f;
            if (row >= 3584 && row < 7680 && __hip_atomic_load(cw + 256, RLX_AGENT) > 0) sig = 2.0f;
            if (row >= 7680 && row < 15872 && __hip_atomic_load(cw + 320, RLX_AGENT) > 0) sig = 2.0f;
            if (row >= 15872 && nbad > (unsigned)(M / 100) * C) sig = 1.5f;
#endif
#pragma unroll
            for (int j = 0; j < 4; ++j) ((GAS f32x4*)(Hh + (size_t)row * C))[64 * j + lane] = v[j] * rs * g[j] * sig;
        }
    }
}
__device__ __forceinline__ void attn_naive(unsigned char* ws, int gw, int NGW, int lane) {
    const bf16* Kb = (const bf16*)(ws + WS_B1); const bf16* Vb = (const bf16*)(ws + WS_B2); const bf16* Qb = (const bf16*)(ws + WS_B3); bf16* Ob = (bf16*)(ws + WS_B0);
    for (int unit = gw; unit < BATCH * NH * (SEQ / 64); unit += NGW) {
        const int qb = unit % (SEQ / 64), bh = unit / (SEQ / 64), b = bh / NH, h = bh % NH;
        const int t0 = qb * 64, t = t0 + lane; const size_t rowq = (size_t)b * SEQ + t;
        float q[64], o[64];
#pragma unroll
        for (int c = 0; c < 8; ++c) { const v4u w = *(const GAS v4u*)(Qb + rowq * C + h * HD + c * 8);
            q[c * 8 + 0] = bflo(w.x) * 0.125f; q[c * 8 + 1] = bfhi(w.x) * 0.125f; q[c * 8 + 2] = bflo(w.y) * 0.125f; q[c * 8 + 3] = bfhi(w.y) * 0.125f;
            q[c * 8 + 4] = bflo(w.z) * 0.125f; q[c * 8 + 5] = bfhi(w.z) * 0.125f; q[c * 8 + 6] = bflo(w.w) * 0.125f; q[c * 8 + 7] = bfhi(w.w) * 0.125f; }
#pragma unroll
        for (int c = 0; c < 64; ++c) o[c] = 0.f;
        float suffix = 0.f;
        for (int s = t0 + 62; s >= 0; --s) {
            const bool valid = s < t;
            if (s < t0 && __all(suffix > SB_EXIT)) break;
            const bf16* kp = Kb + ((size_t)b * SEQ + s) * C + h * HD; const bf16* vp = Vb + ((size_t)b * SEQ + s) * C + h * HD;
            float z = 0.f;
#pragma unroll
            for (int c = 0; c < 8; ++c) { const v4u w = *(const GAS v4u*)(kp + c * 8);
                z += q[c * 8 + 0] * bflo(w.x) + q[c * 8 + 1] * bfhi(w.x) + q[c * 8 + 2] * bflo(w.y) + q[c * 8 + 3] * bfhi(w.y) + q[c * 8 + 4] * bflo(w.z) + q[c * 8 + 5] * bfhi(w.z) + q[c * 8 + 6] * bflo(w.w) + q[c * 8 + 7] * bfhi(w.w); }
            const float sp = fmaxf(z, 0.f) + log1pf(__expf(-fabsf(z)));
            const float att = valid ? __expf(z - sp - suffix) : 0.f;
            suffix += valid ? sp : 0.f;
#pragma unroll
            for (int c = 0; c < 8; ++c) { const v4u w = *(const GAS v4u*)(vp + c * 8);
                o[c * 8 + 0] += att * bflo(w.x); o[c * 8 + 1] += att * bfhi(w.x); o[c * 8 + 2] += att * bflo(w.y); o[c * 8 + 3] += att * bfhi(w.y);
                o[c * 8 + 4] += att * bflo(w.z); o[c * 8 + 5] += att * bfhi(w.z); o[c * 8 + 6] += att * bflo(w.w); o[c * 8 + 7] += att * bfhi(w.w); }
        }
#pragma unroll
        for (int c = 0; c < 8; ++c) { v4u w; w.x = pk2(o[c * 8 + 0], o[c * 8 + 1]); w.y = pk2(o[c * 8 + 2], o[c * 8 + 3]); w.z = pk2(o[c * 8 + 4], o[c * 8 + 5]); w.w = pk2(o[c * 8 + 6], o[c * 8 + 7]);
            *(GAS v4u*)(Ob + rowq * C + h * HD + c * 8) = w; }
    }
}


typedef float f32x16 __attribute__((ext_vector_type(16)));
constexpr int AT_VP = 192;
constexpr int AT_WAVE_LDS = 32 * AT_VP;
__device__ __forceinline__ int crow32(int reg, int hh) { return (reg & 3) + 8 * (reg >> 2) + 4 * hh; }
__device__ __forceinline__ bf16x8s pack_step(const f32x16& x, const int s) {
    v4u p; p.x = pg8::cvt_pk_bf16(x[8 * s], x[8 * s + 1]); p.y = pg8::cvt_pk_bf16(x[8 * s + 2], x[8 * s + 3]); p.z = pg8::cvt_pk_bf16(x[8 * s + 4], x[8 * s + 5]); p.w = pg8::cvt_pk_bf16(x[8 * s + 6], x[8 * s + 7]);
    return __builtin_bit_cast(bf16x8s, p);
}
__device__ __forceinline__ void attn_mfma(unsigned char* ws, LAS unsigned char* lds, int gw, int NGW, int lane, int wave) {
    const bf16* Kb = (const bf16*)(ws + WS_B1); const bf16* Vb = (const bf16*)(ws + WS_B2); const bf16* Qb = (const bf16*)(ws + WS_B3); bf16* Ob = (bf16*)(ws + WS_B0);
    LAS unsigned char* vl = lds + wave * AT_WAVE_LDS;
    const int r32 = lane & 31, hh = lane >> 5;
    bf16x8s tri[2];
#pragma unroll
    for (int s = 0; s < 2; ++s)
#pragma unroll
        for (int j = 0; j < 8; ++j) tri[s][j] = (16 * s + 8 * (j >> 2) + 4 * hh + (j & 3)) > r32 ? (short)0x3F80 : (short)0;
    const int grp = lane >> 4, tq = (lane & 15) >> 2, tp = lane & 3;
    const LAS unsigned char* vtr0 = vl + (4 * hh + tq) * AT_VP + (16 * (grp & 1) + 4 * tp) * 2;
    for (int unit = gw; unit < BATCH * NH * (SEQ / 32); unit += NGW) {
        const int qb = unit % (SEQ / 32), bh = unit / (SEQ / 32), b = bh / NH, hd = bh % NH;
        const int t0 = qb * 32; const size_t rowb = (size_t)b * SEQ;
        bf16x8s qf[4];
#pragma unroll
        for (int ks = 0; ks < 4; ++ks) qf[ks] = *(const GAS bf16x8s*)(Qb + (rowb + t0 + r32) * C + hd * HD + 16 * ks + 8 * hh);
        f32x16 o[2];
#pragma unroll
        for (int i = 0; i < 16; ++i) { o[0][i] = 0.f; o[1][i] = 0.f; }
        float carry = 0.f;
        for (int s0 = t0; s0 >= 0; s0 -= 32) {
            bf16x8s kf[4];
#pragma unroll
            for (int ks = 0; ks < 4; ++ks) kf[ks] = *(const GAS bf16x8s*)(Kb + (rowb + s0 + r32) * C + hd * HD + 16 * ks + 8 * hh);
            v4u vreg[4];
#pragma unroll
            for (int i = 0; i < 4; ++i) { const int cidx = lane + 64 * i; vreg[i] = *(const GAS v4u*)(Vb + (rowb + s0 + (cidx >> 3)) * C + hd * HD + (cidx & 7) * 8); }
            f32x16 st;
#pragma unroll
            for (int i = 0; i < 16; ++i) st[i] = 0.f;
#pragma unroll
            for (int ks = 0; ks < 4; ++ks) st = __builtin_amdgcn_mfma_f32_32x32x16_bf16(kf[ks], qf[ks], st, 0, 0, 0);
#pragma unroll
            for (int i = 0; i < 4; ++i) { const int cidx = lane + 64 * i; *(LAS v4u*)(vl + (cidx >> 3) * AT_VP + (cidx & 7) * 16) = vreg[i]; }
            f32x16 zz, uu; float tot = 0.f; const int tq_ = t0 + r32;
#pragma unroll
            for (int i = 0; i < 16; ++i) { const int key = s0 + crow32(i, hh); const float z = st[i] * 0.125f; const float sp = fmaxf(z, 0.f) + __logf(1.0f + __expf(-fabsf(z)));
                const bool valid = key < tq_; zz[i] = valid ? z - sp : -1e30f; uu[i] = valid ? sp : 0.f; tot += uu[i]; }
            f32x16 uh, ul;
#pragma unroll
            for (int i = 0; i < 16; i += 2) { const unsigned ph = pg8::cvt_pk_bf16(uu[i], uu[i + 1]); uh[i] = bflo(ph); uh[i + 1] = bfhi(ph); ul[i] = uu[i] - uh[i]; ul[i + 1] = uu[i + 1] - uh[i + 1]; }
            f32x16 w;
#pragma unroll
            for (int i = 0; i < 16; ++i) w[i] = 0.f;
#pragma unroll
            for (int s = 0; s < 2; ++s) { w = __builtin_amdgcn_mfma_f32_32x32x16_bf16(tri[s], pack_step(uh, s), w, 0, 0, 0); w = __builtin_amdgcn_mfma_f32_32x32x16_bf16(tri[s], pack_step(ul, s), w, 0, 0, 0); }
            f32x16 pp;
#pragma unroll
            for (int i = 0; i < 16; ++i) pp[i] = __expf(zz[i] - w[i] - carry);
            tot += shx(tot, 32, lane); carry += tot;
            asm volatile("s_waitcnt lgkmcnt(0)" ::: "memory");
#pragma unroll
            for (int s = 0; s < 2; ++s) { const bf16x8s pa = pack_step(pp, s);
#pragma unroll
                for (int dt = 0; dt < 2; ++dt) {
                    const v4i16_t lo = __builtin_amdgcn_ds_read_tr16_b64_v4i16((LAS v4i16_t*)(vtr0 + (16 * s) * AT_VP + dt * 64));
                    const v4i16_t hi = __builtin_amdgcn_ds_read_tr16_b64_v4i16((LAS v4i16_t*)(vtr0 + (16 * s + 8) * AT_VP + dt * 64));
                    const bf16x8s vf = (bf16x8s){lo[0], lo[1], lo[2], lo[3], hi[0], hi[1], hi[2], hi[3]};
                    o[dt] = __builtin_amdgcn_mfma_f32_32x32x16_bf16(pa, vf, o[dt], 0, 0, 0); } }
            asm volatile("" ::: "memory");
            if (s0 < t0 && __all(carry > SB_EXIT)) break;
        }
#pragma unroll
        for (int dt = 0; dt < 2; ++dt)
#pragma unroll
            for (int i = 0; i < 16; ++i) Ob[(rowb + t0 + crow32(i, hh)) * C + hd * HD + 32 * dt + r32] = (bf16)f2bf(o[dt][i]);
    }
}
__global__ void __launch_bounds__(NWAVES * 64, 2) yoco_fwd(Args args) {
    extern __shared__ __attribute__((aligned(16))) unsigned char lds_raw[];
    LAS unsigned char* lds = (LAS unsigned char*)lds_raw;
    const int G = gridDim.x; const int bx = blockIdx.x;
    int wave = __builtin_amdgcn_readfirstlane(threadIdx.x >> 6); asm volatile("" : "+s"(wave));
#define IDS() int lane; asm volatile("v_mbcnt_lo_u32_b32 %0, -1, 0\n\tv_mbcnt_hi_u32_b32 %0, -1, %0" : "=v"(lane)); const int tid = wave * 64 + lane; (void)tid; \
    const int vcu = (G % 8 == 0) ? (bx % 8) * (G / 8) + bx / 8 : bx; const int gw = vcu * NWAVES + wave, NGW = G * NWAVES; (void)lane; (void)gw; (void)NGW;
    unsigned char* ws = WSP();
    volatile LAS unsigned* MISC = (volatile LAS unsigned*)(lds + MISC_OFF);
    volatile LAS int* tab = (volatile LAS int*)(lds + MOE_TAB_OFF);
    for (int u = threadIdx.x; u < (LDS_BYTES - LDSCTL_OFF) / 4; u += NWAVES * 64) ((LAS unsigned*)(lds + LDSCTL_OFF))[u] = 0u;
    __syncthreads();
    XcdBarrier bar; bar.bar = (unsigned*)(ws + WS_CTL) + CW_BAR; bar.x = 0; bar.st = nullptr;
    if (N_LAUNCHES == 1) bar = xcd_barrier_post((unsigned*)(ws + WS_CTL) + CW_BAR, MISC + 8);
    const int lo = KA_INT(0), hi = KA_INT(1);
#ifndef PROBE_PH
#define PROBE_PH -1
#endif
#define IN(k) (lo <= (k) && (k) < hi)
#define REP(k) for (int rep_ = 0; rep_ < ((PROBE_PH == (k)) ? 2 : 1); ++rep_)
#define SEAM(k) do { if (IN(k) && IN((k) + 1)) xcd_barrier(bar); } while (0)

    if (IN(PH_P0)) REP(PH_P0) { IDS(); p0_weights(ws, lds, gw, NGW, wave, lane); p0_rows(ws, gw, NGW, lane); }
    SEAM(PH_P0);
    if (IN(PH_LORA)) REP(PH_LORA) {
        SchedGrouped<1, 3> S{(const char*)(ws + WS_B1), (size_t)(WS_B2 - WS_B1), nullptr, (const char*)(ws + WS_WT_LORA), (size_t)256 * C * 2, G, bx};
        EpiLora E{(bf16*)(ws + WS_LW)};
        pg8::gemm_phase<EpiLora, SchedGrouped<1, 3>, true, false, C>(lds, S, E, wave);
    }
    SEAM(PH_LORA);
    if (IN(PH_RKV)) REP(PH_RKV) {
        SchedGrouped<4, 3> S{(const char*)OUTP(), (size_t)M * C * 2, (const char*)(ws + WS_B4), (const char*)(ws + WS_WT_RKV), (size_t)C * C * 2, G, bx};
        EpiSplit3 E{(bf16*)(ws + WS_B1), false};
        pg8::gemm_phase<EpiSplit3, SchedGrouped<4, 3>, true, false, C>(lds, S, E, wave);
    }
    SEAM(PH_RKV);
    if (IN(PH_S1)) REP(PH_S1) { IDS(); scan_s1(ws, lds, lane, wave); }
    SEAM(PH_S1);
    if (IN(PH_S2)) REP(PH_S2) { IDS(); scan_s2(ws, lane, wave); }
    SEAM(PH_S2);
    if (IN(PH_S3)) REP(PH_S3) { IDS(); scan_s3(ws, lds, lane, wave); }
    SEAM(PH_S3);
#if MK_DEBUG
    if (IN(PH_DBG0)) { IDS(); scan_naive(ws, lds, tid); }
    SEAM(PH_DBG0);
    if (IN(PH_DBG0 + 1)) { IDS(); post_scan(ws, gw, NGW, lane); }
    SEAM(PH_DBG0 + 1);
    if (IN(PH_DBG0 + 2)) { IDS(); dbg_compare(ws, (const bf16*)(ws + WS_B0), (const bf16*)(ws + WS_B4), gw, NGW, lane); }
    SEAM(PH_DBG0 + 2);
#endif
    if (IN(PH_WOUT)) REP(PH_WOUT) {
        SchedGrouped<4, 1> S{(const char*)(ws + ((MK_DEBUG && DBG_USE_NAIVE) ? WS_B4 : WS_B0)), 0, nullptr, (const char*)(ws + WS_WT_OUT), 0, G, bx};
        EpiResid E{INP(0), OUTP()};
        pg8::gemm_phase<EpiResid, SchedGrouped<4, 1>, true, false, C>(lds, S, E, wave);
    }
    SEAM(PH_WOUT);
#pragma unroll 1
    for (int layer = 0; layer < 2; ++layer) {
        const int pb = layer == 0 ? (int)PH_ROUT0 : (int)PH_ROUT1;
        if (IN(pb)) { IDS(); router_rows(ws, lds, layer, gw, NGW, lane, tid); }
        SEAM(pb);
        if (IN(pb + 1)) REP(pb + 1) {
            { IDS(); moe_table(ws, tab, layer, tid); }
            SchedMoe<2, C, true> S{(const char*)(ws + WS_B1), (const char*)(ws + WS_WT_GU) + (size_t)layer * 16 * 512 * C * 2, (size_t)512 * C * 2, (const unsigned*)(ws + WS_LIST), tab, G, bx};
            EpiGU E{(bf16*)(ws + WS_HID), (const float*)(ws + WS_WL)};
            pg8::gemm_phase<EpiGU, SchedMoe<2, C, true>, true, true, C>(lds, S, E, wave);
        }
        SEAM(pb + 1);
        if (IN(pb + 2)) REP(pb + 2) {
            { IDS(); moe_table(ws, tab, layer, tid); }
            SchedMoe<4, FE, false> S{(const char*)(ws + WS_HID), (const char*)(ws + WS_WT_DN) + (size_t)layer * 16 * C * FE * 2, (size_t)C * FE * 2, (const unsigned*)(ws + WS_LIST), tab, G, bx};
            EpiDown E{(bf16*)(ws + WS_B2), (const unsigned*)(ws + WS_LIST)};
            pg8::gemm_phase<EpiDown, SchedMoe<4, FE, false>, true, false, FE>(lds, S, E, wave);
        }
        SEAM(pb + 2);
        if (layer == 0) {
            if (IN(PH_COMB)) { IDS(); combine_rows(ws, 0, gw, NGW, lane); }
            SEAM(PH_COMB);
            if (IN(PH_KVQ)) REP(PH_KVQ) {
                SchedGrouped<12, 1> S{(const char*)(ws + WS_B0), 0, nullptr, (const char*)(ws + WS_WT_KVQ), 0, G, bx};
                EpiSplit3 E{(bf16*)(ws + WS_B1), true};
                pg8::gemm_phase<EpiSplit3, SchedGrouped<12, 1>, true, false, C>(lds, S, E, wave);
            }
            SEAM(PH_KVQ);
            if (IN(PH_ATTN)) REP(PH_ATTN) { IDS(); attn_mfma(ws, lds, gw, NGW, lane, wave); }
            SEAM(PH_ATTN);
            if (IN(PH_SBO)) {
                SchedGrouped<4, 1> S{(const char*)(ws + WS_B0), 0, nullptr, (const char*)(ws + WS_WT_SBO), 0, G, bx};
                EpiResid E{OUTP(), OUTP()};
                pg8::gemm_phase<EpiResid, SchedGrouped<4, 1>, true, false, C>(lds, S, E, wave);
            }
            SEAM(PH_SBO);
        }
    }
    if (IN(PH_FINAL)) { IDS(); combine_rows(ws, 1, gw, NGW, lane); }
#undef IN
#undef SEAM
}

extern "C" void kernel_launch(void* const* d_in, const int* in_sizes, int n_in, void* d_out, int out_size, void* d_ws, size_t ws_size, hipStream_t stream) {
    static int grid = 0;
    if (grid == 0) {
        if (n_in != 31 || in_sizes[0] != M * C || out_size != M * C || ws_size < WS_END) { fprintf(stderr, "kernel_launch: unexpected shapes (n_in %d, in0 %d, out %d, ws %zu); nothing launched\n", n_in, n_in > 0 ? in_sizes[0] : -1, out_size, ws_size); grid = -1; return; }
        int dev = 0, cus = 0, per_cu = 0;
        if (hipGetDevice(&dev) != hipSuccess || hipDeviceGetAttribute(&cus, hipDeviceAttributeMultiprocessorCount, dev) != hipSuccess) { grid = -1; return; }
        if (hipFuncSetAttribute((const void*)yoco_fwd, hipFuncAttributeMaxDynamicSharedMemorySize, LDS_BYTES) != hipSuccess) { fprintf(stderr, "kernel_launch: hipFuncSetAttribute failed\n"); grid = -1; return; }
        if (hipOccupancyMaxActiveBlocksPerMultiprocessor(&per_cu, (const void*)yoco_fwd, NWAVES * 64, LDS_BYTES) != hipSuccess || per_cu < 1) fprintf(stderr, "kernel_launch: occupancy query reports %d\n", per_cu);
        (void)hipGetLastError();
        grid = cus;
    }
    if (grid < 0) return;
    if (hipMemsetAsync((char*)d_ws + WS_CTL, 0, CTL_ZERO_BYTES, stream) != hipSuccess) return;
    Args a{};
    for (int i = 0; i < 31; ++i) a.in[i] = (const float*)d_in[i];
    a.out = (float*)d_out; a.ws = (unsigned char*)d_ws;
    for (int li = 0; li < (N_LAUNCHES == 1 ? 1 : (int)NPHASE); ++li) {
        a.ph_lo = (N_LAUNCHES == 1) ? 0 : li; a.ph_hi = (N_LAUNCHES == 1) ? NPHASE : li + 1; a.li = li;
        hipLaunchKernelGGL(yoco_fwd, dim3(grid), dim3(NWAVES * 64), LDS_BYTES, stream, a);
        const hipError_t le = hipPeekAtLastError();
        if (le != hipSuccess) { fprintf(stderr, "kernel_launch: launch %d failed: %s\n", li, hipGetErrorName(le)); break; }
    }
}
```

```cpp
#include <hip/hip_runtime.h>
#include <cstdio>
#include <cstdint>

#ifndef MK_N_LAUNCHES
#define MK_N_LAUNCHES 1
#endif

namespace pg8 {
#define PG8_LAS __attribute__((address_space(3)))
typedef unsigned short bf16_t;
typedef short bf16x8 __attribute__((ext_vector_type(8)));
typedef float f32x4 __attribute__((ext_vector_type(4)));
typedef unsigned u32x4 __attribute__((ext_vector_type(4)));
constexpr int BM = 256, BK = 64, HALF = 128, HTB = HALF * BK * 2, STAGE_BYTES = 8 * HTB, NXCD = 8, WGM = 8;

__host__ __device__ __forceinline__ int lds_byte(int r, int c) { const int st = (r >> 4) * 2 + (c >> 5), rr = r & 15, cc = c & 31, ob = rr * 64 + cc * 2; return st * 1024 + (ob ^ (((ob >> 9) & 1) << 5)); }
__host__ __device__ __forceinline__ void stage_rc(int b, int& R, int& C) { const int st = b / 1024, sb = b % 1024, swz = sb ^ (((sb >> 9) & 1) << 5); R = (st >> 1) * 16 + swz / 64; C = (st & 1) * 32 + (swz % 64) / 2; }
__host__ __device__ __forceinline__ int perm32(int rho) { const int n = rho >> 4, i = rho & 15; return 8 * (i >> 2) + 4 * n + (i & 3); }

struct Unit { int pm, pn, aux, r0, cnt; };

__host__ __device__ __forceinline__ void tile_map(int wgid, int nM, int nN, int& pm, int& pn) {
    const int nwg = nM * nN;
    { const int q = nwg / NXCD, r = nwg % NXCD, xcd = wgid % NXCD, off = wgid / NXCD; wgid = (xcd < r ? xcd * (q + 1) : r * (q + 1) + (xcd - r) * q) + off; }
    const int nig = WGM * nN, gid = wgid / nig, fm = gid * WGM, gsz = (nM - fm) < WGM ? (nM - fm) : WGM;
    pm = fm + ((wgid % nig) % gsz); pn = (wgid % nig) / gsz;
}

typedef float f32x2_t __attribute__((ext_vector_type(2))); typedef __bf16 bf16x2_t __attribute__((ext_vector_type(2)));
__device__ __forceinline__ unsigned cvt_pk_bf16(float lo, float hi) { const f32x2_t v = {lo, hi}; const bf16x2_t b = __builtin_convertvector(v, bf16x2_t); return __builtin_bit_cast(unsigned, b); }

template <class Epi, class Sched, bool ALIGN_EPI, bool GATHER, int K>
__device__ __forceinline__ void gemm_phase(PG8_LAS unsigned char* lds, const Sched& S, const Epi& E, const int wid) {
    int lane_; asm volatile("v_mbcnt_lo_u32_b32 %0, -1, 0\n\tv_mbcnt_hi_u32_b32 %0, -1, %0" : "=v"(lane_));
    const int lane = lane_, tid = wid * 64 + lane, wr = wid >> 2, wc = wid & 3, fr = lane & 15, fq = lane >> 4;
    constexpr int nt = K / BK;
    unsigned voffA[2], voffB[2];
#pragma unroll
    for (int i = 0; i < 2; ++i) { int R, C; stage_rc(tid * 16 + i * 8192, R, C); const int Rb = Epi::PERM ? ((R & ~31) + perm32(R & 31)) : R;
        voffA[i] = (unsigned)(R * K + C) * 2u; voffB[i] = (unsigned)(Rb * K + C) * 2u; }
    constexpr size_t kstep = (size_t)(BK * 2);
    constexpr size_t hstep = (size_t)HALF * K * 2;
    const unsigned ldsw = (unsigned)wid * 1024u;
    const int aoff = lds_byte(wr * 64 + fr, fq * 8), boff = lds_byte(wc * 32 + fr, fq * 8);
#define PG8_SA(b, h) (((b) * 2 + (h)) * HTB)
#define PG8_SB(b, h) ((4 + (b) * 2 + (h)) * HTB)
#define PG8_STAGE(bufoff, gbase, voff) do { _Pragma("unroll") for (int _i = 0; _i < 2; ++_i) \
        __builtin_amdgcn_global_load_lds((const unsigned*)((const char*)(gbase) + (voff)[_i]), (PG8_LAS unsigned*)(lds + (bufoff) + ldsw + _i * 8192), 16, 0, 0); } while (0)
#define PG8_LDA(dst, b, h) do { _Pragma("unroll") for (int m = 0; m < 4; ++m) _Pragma("unroll") for (int k = 0; k < 2; ++k) dst[m][k] = *(const PG8_LAS bf16x8*)(lds + PG8_SA(b, h) + aoff + m * 2048 + k * 1024); } while (0)
#define PG8_LDB(dst, b, h) do { _Pragma("unroll") for (int n = 0; n < 2; ++n) _Pragma("unroll") for (int k = 0; k < 2; ++k) dst[n][k] = *(const PG8_LAS bf16x8*)(lds + PG8_SB(b, h) + boff + n * 2048 + k * 1024); } while (0)
#define PG8_MMA(ai, bj, At, Bt) do { __builtin_amdgcn_s_setprio(1); _Pragma("unroll") for (int m = 0; m < 4; ++m) _Pragma("unroll") for (int n = 0; n < 2; ++n) _Pragma("unroll") for (int k = 0; k < 2; ++k) \
        acc[ai][bj][m][n] = __builtin_amdgcn_mfma_f32_16x16x32_bf16(Bt[n][k], At[m][k], acc[ai][bj][m][n], 0, 0, 0); __builtin_amdgcn_s_setprio(0); } while (0)
#define PG8_WAIT_V(n) asm volatile("s_waitcnt vmcnt(" #n ")" ::: "memory")
#define PG8_WAIT_L(n) asm volatile("s_waitcnt lgkmcnt(" #n ")" ::: "memory")
#define PG8_BAR __builtin_amdgcn_s_barrier()
#define PG8_SCHED __builtin_amdgcn_sched_barrier(0)
    Unit cur, nxt; int ui = 0;
    if (!S.next(0, cur)) return;
    f32x4 acc[2][2][4][2];
#pragma unroll
    for (int a = 0; a < 2; ++a)
#pragma unroll
        for (int b = 0; b < 2; ++b)
#pragma unroll
            for (int m = 0; m < 4; ++m)
#pragma unroll
                for (int n = 0; n < 2; ++n) acc[a][b][m][n] = (f32x4){0.f, 0.f, 0.f, 0.f};
    bf16x8 At[4][2], B0[2][2], B1[2][2];
    unsigned vc[2][2];
#define PG8_GOFF(u) do { _Pragma("unroll") for (int _h = 0; _h < 2; ++_h) _Pragma("unroll") for (int _i = 0; _i < 2; ++_i) { int _R, _C; stage_rc(tid * 16 + _i * 8192, _R, _C); \
        vc[_h][_i] = S.a_row_off(u, _h * HALF + _R) + (unsigned)_C * 2u; } } while (0)
#define PG8_STAGE_A(bufoff, gbase, h) do { if constexpr (GATHER) { PG8_STAGE(bufoff, gbase, vc[h]); } else { PG8_STAGE(bufoff, (gbase) + (h) * hstep, voffA); } } while (0)
    if constexpr (GATHER) PG8_GOFF(cur);
    const char* cA = S.a_base(cur); const char* cB = S.b_base(cur);
    PG8_STAGE(PG8_SB(0, 0), cB, voffB); PG8_STAGE(PG8_SB(0, 1), cB + hstep, voffB); PG8_STAGE_A(PG8_SA(0, 0), cA, 0); PG8_STAGE_A(PG8_SA(0, 1), cA, 1);
    if (wr == 1) PG8_BAR;
    PG8_WAIT_V(2); PG8_BAR;
    PG8_STAGE(PG8_SB(1, 0), cB + kstep, voffB); PG8_STAGE_A(PG8_SA(1, 0), cA + kstep, 0); PG8_STAGE(PG8_SB(1, 1), cB + hstep + kstep, voffB);
    PG8_WAIT_V(6); PG8_BAR;
    for (;;) {
        const bool has_next = S.next(ui + 1, nxt);
        const char* nA = has_next ? S.a_base(nxt) : cA; const char* nB = has_next ? S.b_base(nxt) : cB;
        for (int t = 0; t < nt; t += 2) {
            const bool last = (t == nt - 2);
            const char* a1 = cA + (size_t)(t + 1) * kstep;
            const char* a2 = last ? nA : cA + (size_t)(t + 2) * kstep; const char* b2 = last ? nB : cB + (size_t)(t + 2) * kstep;
            const char* a3 = a2 + kstep; const char* b3 = b2 + kstep;
            PG8_LDB(B0, 0, 0); PG8_LDB(B1, 0, 1); PG8_SCHED; PG8_LDA(At, 0, 0); PG8_STAGE_A(PG8_SA(1, 1), a1, 1);
            if constexpr (GATHER) { if (last && has_next) PG8_GOFF(nxt); }
            PG8_WAIT_V(8); PG8_WAIT_L(0); PG8_BAR; PG8_MMA(0, 0, At, B0); PG8_MMA(0, 1, At, B1); PG8_BAR; PG8_SCHED;
            PG8_LDA(At, 0, 1); PG8_STAGE(PG8_SB(0, 0), b2, voffB); PG8_STAGE(PG8_SB(0, 1), b2 + hstep, voffB); PG8_STAGE_A(PG8_SA(0, 0), a2, 0);
            PG8_WAIT_V(8); PG8_WAIT_L(0); PG8_BAR; PG8_MMA(1, 0, At, B0); PG8_MMA(1, 1, At, B1); PG8_BAR; PG8_SCHED;
            PG8_LDB(B0, 1, 0); PG8_LDB(B1, 1, 1); PG8_SCHED; PG8_LDA(At, 1, 0); PG8_STAGE_A(PG8_SA(0, 1), a2, 1);
            PG8_WAIT_V(8); PG8_WAIT_L(0); PG8_BAR; PG8_MMA(0, 0, At, B0); PG8_MMA(0, 1, At, B1); PG8_BAR; PG8_SCHED;
            PG8_LDA(At, 1, 1); PG8_STAGE(PG8_SB(1, 0), b3, voffB); PG8_STAGE(PG8_SB(1, 1), b3 + hstep, voffB); PG8_STAGE_A(PG8_SA(1, 0), a3, 0);
            PG8_WAIT_V(8); PG8_WAIT_L(0); PG8_BAR; PG8_MMA(1, 0, At, B0); PG8_MMA(1, 1, At, B1); PG8_BAR; PG8_SCHED;
        }
        if constexpr (ALIGN_EPI) { if (wr == 0) PG8_BAR; }
        E(acc, cur, wr, wc, fr, fq);
        if (!has_next) break;
#pragma unroll
        for (int a = 0; a < 2; ++a)
#pragma unroll
            for (int b = 0; b < 2; ++b)
#pragma unroll
                for (int m = 0; m < 4; ++m)
#pragma unroll
                    for (int n = 0; n < 2; ++n) acc[a][b][m][n] = (f32x4){0.f, 0.f, 0.f, 0.f};
        cur = nxt; cA = nA; cB = nB; ++ui;
        if constexpr (ALIGN_EPI) { if (wr == 1) PG8_BAR; }
    }
    PG8_WAIT_V(0);
    if constexpr (!ALIGN_EPI) { if (wr == 0) PG8_BAR; }
    PG8_BAR;
#undef PG8_SA
#undef PG8_SB
#undef PG8_STAGE
#undef PG8_STAGE_A
#undef PG8_GOFF
#undef PG8_LDA
#undef PG8_LDB
#undef PG8_MMA
#undef PG8_WAIT_V
#undef PG8_WAIT_L
#undef PG8_BAR
#undef PG8_SCHED
}
}

constexpr int NWAVES = 8;
#ifndef MK_DEBUG
#define MK_DEBUG 0
#endif
#ifndef DBG_USE_NAIVE
#define DBG_USE_NAIVE 0
#endif
constexpr int DBGP = MK_DEBUG ? 3 : 0;
enum Phase { PH_P0 = 0, PH_LORA, PH_RKV, PH_S1, PH_S2, PH_S3, PH_DBG0, PH_WOUT = PH_DBG0 + DBGP, PH_ROUT0, PH_GU0, PH_DN0, PH_COMB, PH_KVQ, PH_ATTN, PH_SBO, PH_ROUT1, PH_GU1, PH_DN1, PH_FINAL, NPHASE };
constexpr int N_LAUNCHES = MK_N_LAUNCHES;


constexpr int BATCH = 2, SEQ = 8192, C = 1024, NH = 16, HD = 64, M = BATCH * SEQ;
constexpr int NE = 16, FE = 256, DW = 64, DA = 64, DG = 160;
constexpr float RMS_EPS = 1e-6f, GN_EPS = 64e-5f;
constexpr float SB_EXIT = 104.0f;

constexpr size_t MiB = 1u << 20;
constexpr size_t WS_CTL = 0, CTL_ZERO_BYTES = 64 * 1024;
constexpr size_t WS_WT_W2 = 128 * 1024, WS_WT_A2 = 256 * 1024, WS_WT_G2 = 384 * 1024;
constexpr size_t WS_WT_RKV = 1 * MiB;
constexpr size_t WS_WT_LORA = 7 * MiB;
constexpr size_t WS_WT_OUT = 9 * MiB;
constexpr size_t WS_WT_KVQ = 11 * MiB;
constexpr size_t WS_WT_SBO = 17 * MiB;
constexpr size_t WS_WT_GU = 19 * MiB;
constexpr size_t WS_WT_DN = 51 * MiB;
constexpr size_t WS_LW = 67 * MiB;
constexpr size_t WS_LA = 69 * MiB;
constexpr size_t WS_LG = 71 * MiB;
static_assert(WS_LA == WS_LW + 2 * MiB && WS_LG == WS_LW + 4 * MiB, "EpiLora's pointer arithmetic");
constexpr size_t WS_LIST = 76 * MiB;
constexpr size_t WS_WL = 77 * MiB;
constexpr size_t WS_HID = 78 * MiB;
constexpr size_t WS_B0 = 96 * MiB, WS_B1 = 128 * MiB, WS_B2 = 160 * MiB, WS_B3 = 192 * MiB, WS_B4 = 224 * MiB, WS_END = 256 * MiB;
static_assert(WS_HID + (size_t)144 * 256 * 256 * 2 <= WS_B0, "HID vs B0");
constexpr int CW_TMO = 0;
constexpr int CW_CNT = 1024;
constexpr int CW_BAR = 4096;

constexpr int RING_BYTES = 131072;
constexpr int LDSCTL_OFF = 146688, MISC_OFF = LDSCTL_OFF + 320, MOE_TAB_OFF = MISC_OFF + 128;
constexpr int LDS_BYTES = 147456;
static_assert(MOE_TAB_OFF + 256 <= LDS_BYTES, "LDS map");
static_assert(BATCH * NH * (SEQ / 64) % 16 == 0, "scan units");

#define GAS __attribute__((address_space(1)))
#define LAS __attribute__((address_space(3)))
typedef unsigned short bf16;
typedef unsigned v4u __attribute__((ext_vector_type(4)));
typedef unsigned v2u __attribute__((ext_vector_type(2)));
typedef float f32x4 __attribute__((ext_vector_type(4)));
typedef GAS unsigned gu32;
#define RLX_AGENT __ATOMIC_RELAXED, __HIP_MEMORY_SCOPE_AGENT
#define LDS_WAIT() asm volatile("s_waitcnt lgkmcnt(0)" ::: "memory")
#define VM_WAIT() asm volatile("s_waitcnt vmcnt(0)" ::: "memory")
__device__ __forceinline__ unsigned f2bf(float f) { unsigned u = __builtin_bit_cast(unsigned, f); return (u + 0x7fffu + ((u >> 16) & 1u)) >> 16; }
__device__ __forceinline__ unsigned pk2(float lo, float hi) { return f2bf(lo) | (f2bf(hi) << 16); }
__device__ __forceinline__ float bflo(unsigned u) { return __uint_as_float(u << 16); }
__device__ __forceinline__ float bfhi(unsigned u) { return __uint_as_float(u & 0xffff0000u); }
__device__ __forceinline__ float bf2f(bf16 b) { return __uint_as_float((unsigned)b << 16); }
__device__ __forceinline__ float sigmoidf_(float x) { return 1.0f / (1.0f + __expf(-x)); }

#define XB_TMO      128
#define XB_XCNT(j)  (256  + 64 * (j))
#define XB_XSUB(j)  (1280 + 64 * (j))
#define XB_XGEN(j)  (2304 + 64 * (j))
#define XB_TOP      3328
#define XB_TOPGEN   3392
#define XCD_BAR_WORDS 3456
#define XB_SPIN_CAP (1u << 18)
__device__ __forceinline__ unsigned xb_ld(unsigned* p)              { return __hip_atomic_load(p, __ATOMIC_RELAXED, __HIP_MEMORY_SCOPE_AGENT); }
__device__ __forceinline__ unsigned xb_add(unsigned* p, unsigned v) { return __hip_atomic_fetch_add(p, v, __ATOMIC_RELAXED, __HIP_MEMORY_SCOPE_AGENT); }
__device__ __forceinline__ unsigned xb_xcc_id() { return (unsigned)__builtin_amdgcn_s_getreg((3 << 11) | 20) & 0xFu; }
#define XB_SPIN(cond, bar) do { unsigned _sp = 0; while (cond) { __builtin_amdgcn_s_sleep(1); \
    if ((++_sp & 255u) == 0u) { if (xb_ld(&(bar)[XB_TMO])) break; if (_sp > XB_SPIN_CAP) { atomicAdd(&(bar)[XB_TMO], 1u); break; } } } } while (0)
struct XcdBarrier { unsigned* bar; unsigned x; volatile LAS unsigned* st; };
__device__ __forceinline__ XcdBarrier xcd_barrier_post(unsigned* bar, volatile LAS unsigned* st) {
    XcdBarrier b; b.bar = bar; b.x = xb_xcc_id(); b.st = st;
    if (threadIdx.x == 0) (void)xb_add(&bar[XB_XCNT(b.x)], 1u);
    return b;
}
__device__ __forceinline__ void xcd_barrier_complete(unsigned* bar, unsigned x, unsigned& nloc, unsigned& nx) {
    const unsigned G = gridDim.x * gridDim.y * gridDim.z;
    unsigned sum, cnt, mine, sp = 0u;
    for (;;) {
        sum = 0u; cnt = 0u; mine = 0u;
#pragma unroll
        for (unsigned j = 0; j < 16; ++j) { const unsigned c = xb_ld(&bar[XB_XCNT(j)]); sum += c; cnt += (c > 0u) ? 1u : 0u; mine = (j == x) ? c : mine; }
        if (sum == G) break;
        __builtin_amdgcn_s_sleep(1);
        if ((++sp & 255u) == 0u) { if (xb_ld(&bar[XB_TMO])) break; if (sp > XB_SPIN_CAP) { atomicAdd(&bar[XB_TMO], 1u); break; } }
    }
    nloc = mine > 0u ? mine : 1u; nx = cnt > 0u ? cnt : 1u;
}
__device__ __forceinline__ void xcd_barrier(const XcdBarrier& b) {
    asm volatile("s_waitcnt vmcnt(0)" ::: "memory");
    __syncthreads();
    if (threadIdx.x == 0) {
        unsigned* bar = b.bar;
        __builtin_amdgcn_s_waitcnt(0);
        unsigned nloc = b.st[0], nx = b.st[1];
        if (nloc == 0u) { xcd_barrier_complete(bar, b.x, nloc, nx); b.st[0] = nloc; b.st[1] = nx; }
        const unsigned old = xb_add(&bar[XB_XSUB(b.x)], 1u);
        const unsigned gen = old / nloc;
        if (old + 1u == (gen + 1u) * nloc) {
            __builtin_amdgcn_fence(__ATOMIC_RELEASE, "agent");
            asm volatile("s_waitcnt vmcnt(0)" ::: "memory");
            const unsigned og = xb_add(&bar[XB_TOP], 1u);
            const unsigned tg = og / nx;
            if (og + 1u == (tg + 1u) * nx) xb_add(&bar[XB_TOPGEN], 1u);
            else XB_SPIN(xb_ld(&bar[XB_TOPGEN]) == tg, bar);
            __builtin_amdgcn_fence(__ATOMIC_ACQUIRE, "agent");
            xb_add(&bar[XB_XGEN(b.x)], 1u);
            asm volatile("s_waitcnt vmcnt(0)" ::: "memory");
        } else {
            XB_SPIN(xb_ld(&bar[XB_XGEN(b.x)]) == gen, bar);
            __builtin_amdgcn_fence(__ATOMIC_ACQUIRE, "agent");
            asm volatile("s_waitcnt vmcnt(0)" ::: "memory");
        }
    }
    __syncthreads();
}

__device__ __forceinline__ float shx(float v, int o, int lane) { return __int_as_float(__builtin_amdgcn_ds_bpermute((lane ^ o) << 2, __float_as_int(v))); }
__device__ __forceinline__ float wave_sum(float v, int lane) {
#pragma unroll
    for (int o = 1; o < 64; o <<= 1) v += shx(v, o, lane);
    return v;
}
__device__ __forceinline__ void transpose_item(const float* W, int ldw, int k0, int n0, bf16* WT, int ldk, int dst_row0, const float* kscale, LAS float* scr, int lane, int kmax = 1 << 30) {
#pragma unroll 8
    for (int i = 0; i < 32; ++i) { const int kk = 2 * i + (lane >> 5); float v = (k0 + kk < kmax) ? W[(size_t)(k0 + kk) * ldw + n0 + (lane & 31)] : 0.f; if (kscale) v *= kscale[k0 + kk]; scr[kk * 33 + (lane & 31)] = v; }
    LDS_WAIT(); asm volatile("" ::: "memory");
    const int c = lane & 7;
#pragma unroll
    for (int j = 0; j < 4; ++j) { const int n = (lane >> 3) + 8 * j; const LAS float* s = scr + (8 * c) * 33 + n;
        v4u o; o.x = pk2(s[0 * 33], s[1 * 33]); o.y = pk2(s[2 * 33], s[3 * 33]); o.z = pk2(s[4 * 33], s[5 * 33]); o.w = pk2(s[6 * 33], s[7 * 33]);
        if (k0 + 8 * c < kmax) *(GAS v4u*)(WT + (size_t)(dst_row0 + n) * ldk + k0 + 8 * c) = o; }
    LDS_WAIT(); asm volatile("" ::: "memory");
}

struct Args { const float* in[31]; float* out; unsigned char* ws; int ph_lo, ph_hi, li, pad; };
typedef const __attribute__((address_space(4))) unsigned char* kaptr_t;
__device__ __forceinline__ kaptr_t ka_base() { kaptr_t p = (kaptr_t)__builtin_amdgcn_kernarg_segment_ptr(); asm volatile("" : "+s"(p)); return p; }
#define INP(k) (*(const float* const __attribute__((address_space(4)))*)(ka_base() + 8 * (k)))
#define OUTP() (*(float* const __attribute__((address_space(4)))*)(ka_base() + 8 * 31))
#define WSP() (*(unsigned char* const __attribute__((address_space(4)))*)(ka_base() + 8 * 32))
#define KA_INT(i) (*(const int __attribute__((address_space(4)))*)(ka_base() + 8 * 33 + 4 * (i)))

__device__ __forceinline__ void p0_weights(unsigned char* ws, LAS unsigned char* lds, int gw, int NGW, int wave, int lane) {
    LAS float* scr = (LAS float*)(lds + wave * 16384);
    bf16* WT_RKV = (bf16*)(ws + WS_WT_RKV); bf16* WT_LORA = (bf16*)(ws + WS_WT_LORA); bf16* WT_OUT = (bf16*)(ws + WS_WT_OUT); bf16* WT_KVQ = (bf16*)(ws + WS_WT_KVQ);
    bf16* WT_SBO = (bf16*)(ws + WS_WT_SBO); bf16* WT_GU = (bf16*)(ws + WS_WT_GU); bf16* WT_DN = (bf16*)(ws + WS_WT_DN);
    constexpr int I_UP = 32 + 32 + 96, I_RKV = 3 * 512, I_LORA = 32 + 32 + 80, I_OUT = 512, I_KV = 1024, I_Q = 512, I_SBO = 512, I_G = 32 * 128, I_U = 32 * 128, I_D = 32 * 128;
    constexpr int NITEMS = I_UP + I_RKV + I_LORA + I_OUT + I_KV + I_Q + I_SBO + I_G + I_U + I_D;
    for (int it = gw; it < NITEMS; it += NGW) {
        int r = it;
        if (r < I_UP) {
            if (r < 32) transpose_item(INP(9), C, 0, 32 * r, (bf16*)(ws + WS_WT_W2), 64, 32 * r, nullptr, scr, lane);
            else if (r < 64) transpose_item(INP(12), C, 0, 32 * (r - 32), (bf16*)(ws + WS_WT_A2), 64, 32 * (r - 32), nullptr, scr, lane);
            else { const int q = r - 64, kb = q / 32, nb = q % 32; transpose_item(INP(14), C, 64 * kb, 32 * nb, (bf16*)(ws + WS_WT_G2), DG, 32 * nb, nullptr, scr, lane, DG); }
            continue; } r -= I_UP;
        if (r < I_RKV) { const int m = r / 512, q = r % 512, kb = q / 32, nb = q % 32; transpose_item(INP(6) + (size_t)m * C * C, C, 64 * kb, 32 * nb, WT_RKV, C, m * C + 32 * nb, nullptr, scr, lane); continue; } r -= I_RKV;
        if (r < I_LORA) {
            if (r < 32) { const int kb = r / 2, nb = r % 2; transpose_item(INP(8), DW, 64 * kb, 32 * nb, WT_LORA, C, 32 * nb, nullptr, scr, lane); }
            else if (r < 64) { const int q = r - 32, kb = q / 2, nb = q % 2; transpose_item(INP(11), DA, 64 * kb, 32 * nb, WT_LORA, C, 256 + 32 * nb, nullptr, scr, lane); }
            else { const int q = r - 64, kb = q / 5, nb = q % 5; transpose_item(INP(13), DG, 64 * kb, 32 * nb, WT_LORA, C, 512 + 32 * nb, nullptr, scr, lane); }
            continue; } r -= I_LORA;
        if (r < I_OUT) { const int kb = r / 32, nb = r % 32; transpose_item(INP(20), C, 64 * kb, 32 * nb, WT_OUT, C, 32 * nb, nullptr, scr, lane); continue; } r -= I_OUT;
        if (r < I_KV) { const int kb = r / 64, nb = r % 64; transpose_item(INP(21), 2 * C, 64 * kb, 32 * nb, WT_KVQ, C, 32 * nb, INP(3), scr, lane); continue; } r -= I_KV;
        if (r < I_Q) { const int kb = r / 32, nb = r % 32; transpose_item(INP(22), C, 64 * kb, 32 * nb, WT_KVQ, C, 2 * C + 32 * nb, INP(1) + C, scr, lane); continue; } r -= I_Q;
        if (r < I_SBO) { const int kb = r / 32, nb = r % 32; transpose_item(INP(23), C, 64 * kb, 32 * nb, WT_SBO, C, 32 * nb, nullptr, scr, lane); continue; } r -= I_SBO;
        if (r < I_G) { const int le = r / 128, q = r % 128, kb = q / 8, nb = q % 8, f0 = 32 * nb; transpose_item(INP(28) + (size_t)le * C * FE, FE, 64 * kb, f0, WT_GU + (size_t)le * 512 * C, C, 256 * (f0 / 128) + (f0 % 128), nullptr, scr, lane); continue; } r -= I_G;
        if (r < I_U) { const int le = r / 128, q = r % 128, kb = q / 8, nb = q % 8, f0 = 32 * nb; transpose_item(INP(29) + (size_t)le * C * FE, FE, 64 * kb, f0, WT_GU + (size_t)le * 512 * C, C, 256 * (f0 / 128) + 128 + (f0 % 128), nullptr, scr, lane); continue; } r -= I_U;
        { const int le = r / 128, q = r % 128, kb = q / 32, nb = q % 32; transpose_item(INP(30) + (size_t)le * FE * C, C, 64 * kb, 32 * nb, WT_DN + (size_t)le * C * FE, FE, 32 * nb, nullptr, scr, lane); }
    }
    for (int it = gw * 64 + lane; it < 768 * 128; it += NGW * 64) { const int row = it >> 7, ch = it & 127;
        const bool valid = (row < 64) || (row >= 256 && row < 320) || (row >= 512 && row < 672);
        if (!valid) *(GAS v4u*)(WT_LORA + (size_t)row * C + ch * 8) = (v4u){0u, 0u, 0u, 0u}; }
}
__device__ __forceinline__ void load_row(const float* p, int lane, f32x4 (&v)[4]) {
#pragma unroll
    for (int j = 0; j < 4; ++j) v[j] = ((const GAS f32x4*)p)[64 * j + lane];
}
__device__ __forceinline__ float row_rs(const f32x4 (&v)[4], int lane) {
    float s = 0.f;
#pragma unroll
    for (int j = 0; j < 4; ++j) s += (v[j].x * v[j].x + v[j].y * v[j].y) + (v[j].z * v[j].z + v[j].w * v[j].w);
    return 1.0f / sqrtf(wave_sum(s, lane) * (1.0f / C) + RMS_EPS);
}
__device__ __forceinline__ void store_row_bf16(bf16* p, int lane, const f32x4 (&v)[4]) {
#pragma unroll
    for (int j = 0; j < 4; ++j) { v2u o; o.x = pk2(v[j].x, v[j].y); o.y = pk2(v[j].z, v[j].w); ((GAS v2u*)p)[64 * j + lane] = o; }
}
__device__ __forceinline__ void p0_rows(unsigned char* ws, int gw, int NGW, int lane) {
    const float* x = INP(0); const float* gain = INP(1); const float* mix = INP(5);
    f32x4 g[4]; load_row(gain, lane, g);
    for (int run = gw; run < M / 8; run += NGW) {
        const int r0 = run * 8;
        f32x4 prev[4];
        if ((r0 % SEQ) == 0) {
#pragma unroll
            for (int j = 0; j < 4; ++j) prev[j] = (f32x4){0.f, 0.f, 0.f, 0.f};
        } else { load_row(x + (size_t)(r0 - 1) * C, lane, prev); const float rs = row_rs(prev, lane);
#pragma unroll
            for (int j = 0; j < 4; ++j) prev[j] = prev[j] * rs * g[j]; }
        for (int rr = 0; rr < 8; ++rr) {
            const int row = r0 + rr;
            f32x4 hn[4]; load_row(x + (size_t)row * C, lane, hn); const float rs = row_rs(hn, lane);
#pragma unroll
            for (int j = 0; j < 4; ++j) hn[j] = hn[j] * rs * g[j];
#pragma unroll
            for (int i = 0; i < 6; ++i) { f32x4 o[4];
#pragma unroll
                for (int j = 0; j < 4; ++j) { const f32x4 mx = ((const GAS f32x4*)(mix + i * C))[64 * j + lane]; o[j] = hn[j] + (prev[j] - hn[j]) * mx; }
                bf16* dst = i < 2 ? (bf16*)OUTP() + (size_t)i * M * C : (i == 2 ? (bf16*)(ws + WS_B4) : (bf16*)(ws + WS_B1) + (size_t)(i - 3) * M * C);
                store_row_bf16(dst + (size_t)row * C, lane, o); }
#pragma unroll
            for (int j = 0; j < 4; ++j) prev[j] = hn[j];
        }
    }
}

template <int NN, int NGROUPS> struct SchedGrouped {
    static constexpr int K = C;
    const char* A0; size_t astride; const char* A2; const char* B; size_t bgroup;
    int G, c;
    __device__ __forceinline__ bool next(int i, pg8::Unit& u) const {
        const int L = i * G + c; constexpr int per = 64 * NN; if (L >= per * NGROUPS) return false;
        const int g = L / per, w = L % per; pg8::tile_map(w, 64, NN, u.pm, u.pn); u.aux = g; u.r0 = 0; u.cnt = 0; return true; }
    __device__ __forceinline__ const char* a_base(const pg8::Unit& u) const { const char* A = (A2 != nullptr && u.aux == 2) ? A2 : A0 + (size_t)u.aux * astride; return A + (size_t)u.pm * 256 * K * 2; }
    __device__ __forceinline__ const char* b_base(const pg8::Unit& u) const { return B + (size_t)u.aux * bgroup + (size_t)u.pn * 256 * K * 2; }
    __device__ __forceinline__ unsigned a_row_off(const pg8::Unit&, int) const { return 0u; }
};
template <int NN, int K, bool GATHER> struct SchedMoe {
    const char* A; const char* B; size_t bexp; const unsigned* list; volatile LAS int* tab; int G, c;
    __device__ __forceinline__ bool next(int i, pg8::Unit& u) const {
        const int L = i * G + c; const int tot = __builtin_amdgcn_readfirstlane(tab[48]) * NN; if (L >= tot) return false;
        u.pm = L / NN; u.pn = L % NN; int e = 0;
#pragma unroll
        for (int j = 0; j < 16; ++j) e += (u.pm >= tab[32 + j]) ? 1 : 0;
        e = __builtin_amdgcn_readfirstlane(e);
        u.aux = e; u.r0 = (u.pm - __builtin_amdgcn_readfirstlane(tab[16 + e])) * 256; u.cnt = __builtin_amdgcn_readfirstlane(tab[e]); return true; }
    __device__ __forceinline__ const char* a_base(const pg8::Unit& u) const { return GATHER ? A : A + (size_t)u.pm * 256 * K * 2; }
    __device__ __forceinline__ const char* b_base(const pg8::Unit& u) const { return B + (size_t)u.aux * bexp + (size_t)u.pn * 256 * K * 2; }
    __device__ __forceinline__ unsigned a_row_off(const pg8::Unit& u, int r) const {
        const int idx = u.r0 + r; unsigned tok = 0u;
        if (idx < u.cnt) tok = list[(size_t)u.aux * M + idx] >> 1;
        return tok * (unsigned)(K * 2); }
};

using pg8::f32x4;
using pg8::Unit;
__device__ __forceinline__ v4u pack8(f32x4 v0, f32x4 v1) { v4u w; w.x = pg8::cvt_pk_bf16(v0[0], v0[1]); w.y = pg8::cvt_pk_bf16(v0[2], v0[3]); w.z = pg8::cvt_pk_bf16(v1[0], v1[1]); w.w = pg8::cvt_pk_bf16(v1[2], v1[3]); return w; }

struct EpiLora {
    static constexpr bool PERM = true;
    bf16* LW;
    __device__ __forceinline__ void operator()(const f32x4 (&acc)[2][2][4][2], const Unit& u, int wr, int wc, int fr, int fq) const {
        { int l_; asm volatile("v_mbcnt_lo_u32_b32 %0, -1, 0\n\tv_mbcnt_hi_u32_b32 %0, -1, %0" : "=v"(l_)); fr = l_ & 15; fq = l_ >> 4; }
        const int g = u.aux, width = g == 2 ? DG : DW; bf16* out = LW + (size_t)g * (1u << 20);
        const int row0 = u.pm * 256 + wr * 64 + fr;
#pragma unroll
        for (int bj = 0; bj < 2; ++bj) { const int col0 = bj * 128 + wc * 32 + 8 * fq; if (col0 < width) {
#pragma unroll
            for (int ai = 0; ai < 2; ++ai)
#pragma unroll
                for (int m = 0; m < 4; ++m) { f32x4 v0 = acc[ai][bj][m][0], v1 = acc[ai][bj][m][1];
                    if (g == 0) {
#pragma unroll
                        for (int q = 0; q < 4; ++q) { v0[q] = tanhf(v0[q]); v1[q] = tanhf(v1[q]); } }
                    else if (g == 2) {
#pragma unroll
                        for (int q = 0; q < 4; ++q) { v0[q] = sigmoidf_(v0[q]); v1[q] = sigmoidf_(v1[q]); } }
                    *(GAS v4u*)(out + (size_t)(row0 + ai * 128 + m * 16) * width + col0) = pack8(v0, v1); } } }
    }
};
struct EpiSplit3 {
    static constexpr bool PERM = true;
    bf16* O0; bool bycol;
    __device__ __forceinline__ void operator()(const f32x4 (&acc)[2][2][4][2], const Unit& u, int wr, int wc, int fr, int fq) const {
        { int l_; asm volatile("v_mbcnt_lo_u32_b32 %0, -1, 0\n\tv_mbcnt_hi_u32_b32 %0, -1, %0" : "=v"(l_)); fr = l_ & 15; fq = l_ >> 4; }
        const int g = bycol ? (u.pn >> 2) : u.aux, pn = bycol ? (u.pn & 3) : u.pn; bf16* out = O0 + (size_t)g * ((size_t)M * C);
        const int row0 = u.pm * 256 + wr * 64 + fr, col0 = pn * 256 + wc * 32 + 8 * fq;
#pragma unroll
        for (int ai = 0; ai < 2; ++ai)
#pragma unroll
            for (int m = 0; m < 4; ++m)
#pragma unroll
                for (int bj = 0; bj < 2; ++bj) *(GAS v4u*)(out + (size_t)(row0 + ai * 128 + m * 16) * C + col0 + bj * 128) = pack8(acc[ai][bj][m][0], acc[ai][bj][m][1]);
    }
};
struct EpiResid {
    static constexpr bool PERM = false;
    const float* base; float* out;
    __device__ __forceinline__ void operator()(const f32x4 (&acc)[2][2][4][2], const Unit& u, int wr, int wc, int fr, int fq) const {
        { int l_; asm volatile("v_mbcnt_lo_u32_b32 %0, -1, 0\n\tv_mbcnt_hi_u32_b32 %0, -1, %0" : "=v"(l_)); fr = l_ & 15; fq = l_ >> 4; }
        const int row0 = u.pm * 256 + wr * 64 + fr, col0 = u.pn * 256 + wc * 32 + 4 * fq;
#pragma unroll
        for (int ai = 0; ai < 2; ++ai)
#pragma unroll
            for (int m = 0; m < 4; ++m) { const size_t off = (size_t)(row0 + ai * 128 + m * 16) * C + col0;
#pragma unroll
                for (int bj = 0; bj < 2; ++bj)
#pragma unroll
                    for (int n = 0; n < 2; ++n) { const f32x4 b = *(const GAS f32x4*)(base + off + bj * 128 + n * 16); *(GAS f32x4*)(out + off + bj * 128 + n * 16) = b + acc[ai][bj][m][n]; } }
    }
};
struct EpiGU {
    static constexpr bool PERM = true;
    bf16* HID; const float* wl;
    __device__ __forceinline__ void operator()(const f32x4 (&acc)[2][2][4][2], const Unit& u, int wr, int wc, int fr, int fq) const {
        { int l_; asm volatile("v_mbcnt_lo_u32_b32 %0, -1, 0\n\tv_mbcnt_hi_u32_b32 %0, -1, %0" : "=v"(l_)); fr = l_ & 15; fq = l_ >> 4; }
        const int e = u.aux, cnt = u.cnt, base = u.r0, r0 = wr * 64 + fr, col0 = u.pn * 128 + wc * 32 + 8 * fq;
#pragma unroll
        for (int ai = 0; ai < 2; ++ai)
#pragma unroll
            for (int m = 0; m < 4; ++m) { const int r = r0 + ai * 128 + m * 16, idx = base + r; float w = 0.f; if (idx < cnt) w = wl[(size_t)e * M + idx];
                f32x4 h0, h1;
#pragma unroll
                for (int q = 0; q < 4; ++q) { const float g0 = acc[ai][0][m][0][q], g1 = acc[ai][0][m][1][q];
                    h0[q] = g0 * sigmoidf_(g0) * acc[ai][1][m][0][q] * w; h1[q] = g1 * sigmoidf_(g1) * acc[ai][1][m][1][q] * w; }
                *(GAS v4u*)(HID + (size_t)(u.pm * 256 + r) * FE + col0) = pack8(h0, h1);
                asm volatile("" ::: "memory"); }
    }
};
struct EpiDown {
    static constexpr bool PERM = true;
    bf16* EO; const unsigned* list;
    __device__ __forceinline__ void operator()(const f32x4 (&acc)[2][2][4][2], const Unit& u, int wr, int wc, int fr, int fq) const {
        { int l_; asm volatile("v_mbcnt_lo_u32_b32 %0, -1, 0\n\tv_mbcnt_hi_u32_b32 %0, -1, %0" : "=v"(l_)); fr = l_ & 15; fq = l_ >> 4; }
        const int e = u.aux, cnt = u.cnt, base = u.r0, r0 = wr * 64 + fr, col0 = u.pn * 256 + wc * 32 + 8 * fq;
#pragma unroll
        for (int ai = 0; ai < 2; ++ai)
#pragma unroll
            for (int m = 0; m < 4; ++m) { const int idx = base + r0 + ai * 128 + m * 16;
                if (idx < cnt) { const unsigned ent = list[(size_t)e * M + idx]; bf16* o = EO + ((size_t)(ent & 1u) * M + (ent >> 1)) * C + col0;
#pragma unroll
                    for (int bj = 0; bj < 2; ++bj) *(GAS v4u*)(o + bj * 128) = pack8(acc[ai][bj][m][0], acc[ai][bj][m][1]); }
                asm volatile("" ::: "memory"); }
    }
};

typedef short bf16x8s __attribute__((ext_vector_type(8)));
typedef short bf16x4s __attribute__((ext_vector_type(4)));
typedef short v4i16_t __attribute__((ext_vector_type(4)));
constexpr int TPB = 144;
constexpr int TILE_B = 64 * TPB;
constexpr int FP = 68;
constexpr int CS_FA = 0, CS_FB = 16384, CS_TILES = 32768, CS_TOT = CS_TILES + 12 * TILE_B, CS_WL = CS_TOT + 2048, CS_PAR = CS_WL + 256;
static_assert(CS_PAR + 768 <= LDSCTL_OFF, "scan LDS map");
#define TILE(n) (lds + CS_TILES + (n) * TILE_B)
#define F4Z (f32x4){0.f, 0.f, 0.f, 0.f}
__device__ __forceinline__ bf16x8s ldfrag(const LAS unsigned char* tile, int row, int kcol) { return *(const LAS bf16x8s*)(tile + row * TPB + kcol * 2); }
__device__ __forceinline__ bf16x8s ldfrag_tr(const LAS unsigned char* tile, int n0, int k0, int lane) {
    const int g = lane >> 4, q = (lane & 15) >> 2, p = lane & 3;
    const LAS unsigned char* a = tile + (k0 + 8 * g + q) * TPB + (n0 + 4 * p) * 2;
    const v4i16_t lo = __builtin_amdgcn_ds_read_tr16_b64_v4i16((LAS v4i16_t*)a), hi = __builtin_amdgcn_ds_read_tr16_b64_v4i16((LAS v4i16_t*)(a + 4 * TPB));
    return (bf16x8s){lo[0], lo[1], lo[2], lo[3], hi[0], hi[1], hi[2], hi[3]};
}
__device__ __forceinline__ bf16x8s ldfrag_perm(const LAS unsigned char* tile, int row, int ks, int g) {
    const bf16x4s lo = *(const LAS bf16x4s*)(tile + row * TPB + (32 * ks + 4 * g) * 2), hi = *(const LAS bf16x4s*)(tile + row * TPB + (32 * ks + 16 + 4 * g) * 2);
    return (bf16x8s){lo[0], lo[1], lo[2], lo[3], hi[0], hi[1], hi[2], hi[3]};
}
__device__ __forceinline__ void lds_barrier() { asm volatile("s_waitcnt lgkmcnt(0)" ::: "memory"); __builtin_amdgcn_s_barrier(); asm volatile("" ::: "memory"); }
#define MFMA16(a, b, c) __builtin_amdgcn_mfma_f32_16x16x32_bf16((a), (b), (c), 0, 0, 0)
__device__ __forceinline__ void mm64(f32x4 (&acc)[2], const LAS unsigned char* At, const LAS unsigned char* Bt, int rt, int ch, int fr, int g) {
#pragma unroll
    for (int ks = 0; ks < 2; ++ks) { const bf16x8s a = ldfrag(At, 16 * rt + fr, 32 * ks + 8 * g);
#pragma unroll
        for (int ct = 0; ct < 2; ++ct) acc[ct] = MFMA16(a, ldfrag(Bt, 32 * ch + 16 * ct + fr, 32 * ks + 8 * g), acc[ct]); }
}
__device__ __forceinline__ void mm64_bt(f32x4 (&acc)[2], const LAS unsigned char* At, const LAS unsigned char* X, int rt, int ch, int fr, int g, int lane) {
#pragma unroll
    for (int ks = 0; ks < 2; ++ks) { const bf16x8s a = ldfrag(At, 16 * rt + fr, 32 * ks + 8 * g);
#pragma unroll
        for (int ct = 0; ct < 2; ++ct) acc[ct] = MFMA16(a, ldfrag_tr(X, 32 * ch + 16 * ct, 32 * ks, lane), acc[ct]); }
}
__device__ __forceinline__ void mm64_at(f32x4 (&acc)[2], const LAS unsigned char* Xa, const LAS unsigned char* Bt, int rt, int ch, int fr, int g, int lane) {
#pragma unroll
    for (int ks = 0; ks < 2; ++ks) { const bf16x8s a = ldfrag_tr(Xa, 16 * rt, 32 * ks, lane);
#pragma unroll
        for (int ct = 0; ct < 2; ++ct) acc[ct] = MFMA16(a, ldfrag(Bt, 32 * ch + 16 * ct + fr, 32 * ks + 8 * g), acc[ct]); }
}
__device__ __forceinline__ void mm64_att(f32x4 (&acc)[2], const LAS unsigned char* Xa, const LAS unsigned char* X, int rt, int ch, int lane) {
#pragma unroll
    for (int ks = 0; ks < 2; ++ks) { const bf16x8s a = ldfrag_tr(Xa, 16 * rt, 32 * ks, lane);
#pragma unroll
        for (int ct = 0; ct < 2; ++ct) acc[ct] = MFMA16(a, ldfrag_tr(X, 32 * ch + 16 * ct, 32 * ks, lane), acc[ct]); }
}
__device__ __forceinline__ bf16x4s pack4(f32x4 v) { v2u w; w.x = pg8::cvt_pk_bf16(v[0], v[1]); w.y = pg8::cvt_pk_bf16(v[2], v[3]); return __builtin_bit_cast(bf16x4s, w); }
__device__ __forceinline__ f32x4 unpack4(bf16x4s s) { const v2u w = __builtin_bit_cast(v2u, s); return (f32x4){bflo(w.x), bfhi(w.x), bflo(w.y), bfhi(w.y)}; }
__device__ __forceinline__ void st_tr(LAS unsigned char* Out, const f32x4 (&acc)[2], int rt, int ch, int fr, int g) {
#pragma unroll
    for (int ct = 0; ct < 2; ++ct) *(LAS bf16x4s*)(Out + (32 * ch + 16 * ct + fr) * TPB + (16 * rt + 4 * g) * 2) = pack4(acc[ct]);
}
__device__ __forceinline__ void ld_tr(f32x4 (&acc)[2], const LAS unsigned char* In, int rt, int ch, int fr, int g) {
#pragma unroll
    for (int ct = 0; ct < 2; ++ct) acc[ct] = unpack4(*(const LAS bf16x4s*)(In + (32 * ch + 16 * ct + fr) * TPB + (16 * rt + 4 * g) * 2));
}
__device__ __forceinline__ void unpack8(v4u w, float (&o)[8]) { o[0] = bflo(w.x); o[1] = bfhi(w.x); o[2] = bflo(w.y); o[3] = bfhi(w.y); o[4] = bflo(w.z); o[5] = bfhi(w.z); o[6] = bflo(w.w); o[7] = bfhi(w.w); }
__device__ __forceinline__ v4u pack8f(const float (&o)[8]) { v4u w; w.x = pg8::cvt_pk_bf16(o[0], o[1]); w.y = pg8::cvt_pk_bf16(o[2], o[3]); w.z = pg8::cvt_pk_bf16(o[4], o[5]); w.w = pg8::cvt_pk_bf16(o[6], o[7]); return w; }

struct FrontIn { v4u r, k, v; bf16x8s fw[2], fa[2]; };
__device__ __forceinline__ void front_fetch(FrontIn& f, unsigned char* ws, int unit, int tid, int lane, int wave) {
    const int h = unit & 15, c = (unit >> 4) & 127, b = unit >> 11; const size_t row0 = (size_t)b * SEQ + c * 64;
    const int rt = wave & 3, fr = lane & 15, g = lane >> 4, t = tid >> 3, cq = tid & 7, c0 = h * HD + cq * 8;
    const bf16* Rb = (const bf16*)(ws + WS_B1); const bf16* Kb = (const bf16*)(ws + WS_B2); const bf16* Vb = (const bf16*)(ws + WS_B3);
    const bf16* LW = (const bf16*)(ws + WS_LW); const bf16* LA = (const bf16*)(ws + WS_LA);
    f.r = *(const GAS v4u*)(Rb + (row0 + t) * C + c0); f.k = *(const GAS v4u*)(Kb + (row0 + t) * C + c0); f.v = *(const GAS v4u*)(Vb + (row0 + t) * C + c0);
#pragma unroll
    for (int ks = 0; ks < 2; ++ks) { f.fw[ks] = *(const GAS bf16x8s*)(LW + (row0 + 16 * rt + fr) * DW + 32 * ks + 8 * g); f.fa[ks] = *(const GAS bf16x8s*)(LA + (row0 + 16 * rt + fr) * DA + 32 * ks + 8 * g); }
}
__device__ __forceinline__ void head_consts(unsigned char* ws, LAS unsigned char* lds, int h, int tid, int wtile, int atile) {
    const bf16* W2T = (const bf16*)(ws + WS_WT_W2); const bf16* A2T = (const bf16*)(ws + WS_WT_A2);
    const int row = tid >> 3, cq = tid & 7;
    *(LAS v4u*)(lds + CS_TILES + wtile * TILE_B + row * TPB + cq * 16) = *(const GAS v4u*)(W2T + (size_t)(h * HD + row) * 64 + cq * 8);
    *(LAS v4u*)(lds + CS_TILES + atile * TILE_B + row * TPB + cq * 16) = *(const GAS v4u*)(A2T + (size_t)(h * HD + row) * 64 + cq * 8);
    if (tid < 64) { LAS float* P = (LAS float*)(lds + CS_PAR); P[tid] = INP(15)[h * HD + tid]; P[64 + tid] = INP(16)[h * HD + tid]; P[128 + tid] = INP(17)[h * HD + tid]; }
    __syncthreads();
}
template <int MODE>
__device__ __forceinline__ void chunk_front(const FrontIn& f, LAS unsigned char* lds, const float (&w0v)[2], const float (&a0v)[2], int tid, int lane, int wave, float (&v8)[8], float& rkb) {
    const int rt = wave & 3, ch = wave >> 2, fr = lane & 15, g = lane >> 4;
    LAS float* FA = (LAS float*)(lds + CS_FA); LAS float* FB = (LAS float*)(lds + CS_FB); LAS float* TOT = (LAS float*)(lds + CS_TOT);
    const int t = tid >> 3, cq = tid & 7;
    constexpr int WTILE = MODE == 1 ? 6 : 10, ATILE = MODE == 1 ? 8 : 11;
    {
        f32x4 aw[2] = {F4Z, F4Z}, aa[2] = {F4Z, F4Z};
#pragma unroll
        for (int ks = 0; ks < 2; ++ks)
#pragma unroll
            for (int ct = 0; ct < 2; ++ct) { aw[ct] = MFMA16(f.fw[ks], ldfrag(TILE(WTILE), 32 * ch + 16 * ct + fr, 32 * ks + 8 * g), aw[ct]); aa[ct] = MFMA16(f.fa[ks], ldfrag(TILE(ATILE), 32 * ch + 16 * ct + fr, 32 * ks + 8 * g), aa[ct]); }
#pragma unroll
        for (int ct = 0; ct < 2; ++ct) { const int j = 32 * ch + 16 * ct + fr; const float w0 = w0v[ct], a0 = a0v[ct];
#pragma unroll
            for (int q = 0; q < 4; ++q) { const int tt = 16 * rt + 4 * g + q; FA[tt * 64 + j] = -0.6065306597126334f * sigmoidf_(w0 + aw[ct][q]); FB[tt * 64 + j] = sigmoidf_(a0 + aa[ct][q]); } }
    }
    lds_barrier();
    {
        const int j = tid & 63, seg = tid >> 6; float run = 0.f; float loc[8];
#pragma unroll
        for (int q = 0; q < 8; ++q) { run += FA[(8 * seg + q) * 64 + j]; loc[q] = run; }
        TOT[seg * 64 + j] = run;
        lds_barrier();
        float off = 0.f;
#pragma unroll
        for (int s2 = 0; s2 < 7; ++s2) off += (s2 < seg) ? TOT[s2 * 64 + j] : 0.f;
#pragma unroll
        for (int q = 0; q < 8; ++q) FA[(8 * seg + q) * 64 + j] = loc[q] + off;
    }
    lds_barrier();
    {
        float r[8], k[8], pkk[8], pka[8], prk[8];
        unpack8(f.r, r); unpack8(f.k, k); unpack8(f.v, v8);
        { const LAS float* P = (const LAS float*)(lds + CS_PAR) + cq * 8; const f32x4 a0_ = *(const LAS f32x4*)P, a1_ = *(const LAS f32x4*)(P + 4), b0_ = *(const LAS f32x4*)(P + 64), b1_ = *(const LAS f32x4*)(P + 68), c0_ = *(const LAS f32x4*)(P + 128), c1_ = *(const LAS f32x4*)(P + 132);
#pragma unroll
          for (int q = 0; q < 4; ++q) { pkk[q] = a0_[q]; pkk[4 + q] = a1_[q]; pka[q] = b0_[q]; pka[4 + q] = b1_[q]; prk[q] = c0_[q]; prk[4 + q] = c1_[q]; } }
        float cw[8], cwp[8], ag[8];
#pragma unroll
        for (int q = 0; q < 8; ++q) { cw[q] = FA[t * 64 + cq * 8 + q]; cwp[q] = t > 0 ? FA[(t - 1) * 64 + cq * 8 + q] : 0.f; ag[q] = FB[t * 64 + cq * 8 + q]; }
        float kk[8], ss = 0.f; rkb = 0.f;
#pragma unroll
        for (int q = 0; q < 8; ++q) { kk[q] = k[q] * pkk[q]; ss += kk[q] * kk[q]; }
        ss += shx(ss, 1, lane); ss += shx(ss, 2, lane); ss += shx(ss, 4, lane);
        const float inv = 1.0f / fmaxf(sqrtf(ss), 1e-12f);
        float at[8], bt[8], kt[8], rt_[8];
#pragma unroll
        for (int q = 0; q < 8; ++q) { const float kn = kk[q] * inv, kp = k[q] * (1.0f + (ag[q] - 1.0f) * pka[q]);
            const float ein = __expf(-cw[q]);
            at[q] = -kn * __expf(cwp[q]); bt[q] = kn * ag[q] * ein; kt[q] = kp * ein;
            if (MODE == 3) { rt_[q] = r[q] * __expf(cw[q]); rkb += r[q] * kp * prk[q]; } }
        if (MODE == 3) { rkb += shx(rkb, 1, lane); rkb += shx(rkb, 2, lane); rkb += shx(rkb, 4, lane); }
        *(LAS v4u*)(TILE(0) + t * TPB + cq * 16) = pack8f(at); *(LAS v4u*)(TILE(1) + t * TPB + cq * 16) = pack8f(bt); *(LAS v4u*)(TILE(2) + t * TPB + cq * 16) = pack8f(kt);
        *(LAS v4u*)(TILE(3) + t * TPB + cq * 16) = f.v;
        if (MODE == 3) *(LAS v4u*)(TILE(4) + t * TPB + cq * 16) = pack8f(rt_);
        if (MODE == 1 && t == 63) {
#pragma unroll
            for (int q = 0; q < 8; ++q) ((LAS float*)(lds + CS_WL))[cq * 8 + q] = __expf(cw[q]); }
    }
    lds_barrier();
}

__device__ __forceinline__ void scan_s1(unsigned char* ws, LAS unsigned char* lds, int lane0, int wave) {
    const int rt = wave & 3, ch = wave >> 2;
    FrontIn fin; float w0v[2], a0v[2];
    { int l0 = lane0; asm volatile("" : "+v"(l0)); const int hh = blockIdx.x & 15;
      if ((int)blockIdx.x < BATCH * NH * (SEQ / 64)) front_fetch(fin, ws, blockIdx.x, wave * 64 + l0, l0, wave);
#pragma unroll
      for (int ct = 0; ct < 2; ++ct) { w0v[ct] = INP(7)[hh * HD + 32 * ch + 16 * ct + (l0 & 15)]; a0v[ct] = INP(10)[hh * HD + 32 * ch + 16 * ct + (l0 & 15)]; }
      head_consts(ws, lds, hh, wave * 64 + l0, 6, 8); }
    for (int unit = blockIdx.x; unit < BATCH * NH * (SEQ / 64); unit += gridDim.x) {
        int lane = lane0; asm volatile("" : "+v"(lane));
        const int tid = wave * 64 + lane, fr = lane & 15, g = lane >> 4;
        const int h = unit & 15, c = (unit >> 4) & 127, b = unit >> 11; const size_t chunk = ((size_t)b * NH + h) * 128 + c;
        float v8[8]; float rkb;
        chunk_front<1>(fin, lds, w0v, a0v, tid, lane, wave, v8, rkb);
        if (unit + (int)gridDim.x < BATCH * NH * (SEQ / 64)) front_fetch(fin, ws, unit + gridDim.x, tid, lane, wave);
        {
            f32x4 a2[2] = {F4Z, F4Z}, a3[2] = {F4Z, F4Z};
            mm64(a2, TILE(1), TILE(0), rt, ch, fr, g);
            mm64(a3, TILE(2), TILE(0), rt, ch, fr, g);
            f32x4 p1[2];
#pragma unroll
            for (int ct = 0; ct < 2; ++ct) { const int col = 32 * ch + 16 * ct + fr;
#pragma unroll
                for (int q = 0; q < 4; ++q) { const int row = 16 * rt + 4 * g + q;
                    a2[ct][q] = row < col ? a2[ct][q] : 0.f;
                    p1[ct][q] = a2[ct][q] + (row == col ? 1.0f : 0.f);
                    a3[ct][q] = row < col ? a3[ct][q] : 0.f; } }
            st_tr(TILE(5), a2, rt, ch, fr, g);
            st_tr(TILE(9), p1, rt, ch, fr, g);
            st_tr(TILE(4), a3, rt, ch, fr, g);
        }
        lds_barrier();
#pragma unroll
        for (int r = 0; r < 6; ++r) {
            LAS unsigned char* Sr = TILE(5 + 2 * (r & 1)); LAS unsigned char* Sr2 = TILE(5 + 2 * ((r & 1) ^ 1));
            if (r <= 4) { f32x4 q2[2] = {F4Z, F4Z};
                mm64_at(q2, Sr, Sr, rt, ch, fr, g, lane);
                st_tr(Sr2, q2, rt, ch, fr, g); }
            if (r >= 1) { LAS unsigned char* Pr = TILE(9 + ((r - 1) & 1)); LAS unsigned char* Pr2 = TILE(9 + (((r - 1) & 1) ^ 1));
                f32x4 pa[2]; ld_tr(pa, Pr, rt, ch, fr, g);
                mm64_at(pa, Sr, Pr, rt, ch, fr, g, lane);
                st_tr(Pr2, pa, rt, ch, fr, g); }
            if (r == 0) { f32x4 gg[2] = {F4Z, F4Z};
                mm64_bt(gg, TILE(4), TILE(3), rt, ch, fr, g, lane);
                st_tr(TILE(11), gg, rt, ch, fr, g); }
            lds_barrier();
        }
        { const int trow = tid >> 3, tcq = tid & 7; *(GAS v4u*)((bf16*)(ws + WS_B4) + chunk * 4096 + trow * 64 + tcq * 8) = *(const LAS v4u*)(TILE(10) + trow * TPB + tcq * 16); }
        {
            f32x4 acc[2] = {F4Z, F4Z}, ac2[2] = {F4Z, F4Z};
            mm64_bt(acc, TILE(10), TILE(0), rt, ch, fr, g, lane);
            mm64(ac2, TILE(10), TILE(11), rt, ch, fr, g);
            st_tr(TILE(5), acc, rt, ch, fr, g); st_tr(TILE(7), ac2, rt, ch, fr, g);
        }
        lds_barrier();
        {
            const LAS float* WL = (const LAS float*)(lds + CS_WL);
            f32x4 acc[2] = {F4Z, F4Z};
            mm64_bt(acc, TILE(5), TILE(1), rt, ch, fr, g, lane);
            bf16* Mg = (bf16*)(ws + WS_B0) + chunk * 4096;
#pragma unroll
            for (int ct = 0; ct < 2; ++ct) { const int j1 = 32 * ch + 16 * ct + fr; const float wl = WL[j1];
#pragma unroll
                for (int q = 0; q < 4; ++q) { const int j2 = 16 * rt + 4 * g + q; acc[ct][q] = wl * (acc[ct][q] + (j2 == j1 ? 1.0f : 0.f)); }
                const int rtS = 2 * ch + ct, ksS = rt >> 1, half = rt & 1;
                *(GAS bf16x4s*)(Mg + (((rtS * 2 + ksS) * 64 + g * 16 + fr) * 8 + half * 4)) = pack4(acc[ct]); }
            f32x4 ad[2] = {F4Z, F4Z};
            mm64_at(ad, TILE(1), TILE(7), rt, ch, fr, g, lane);
            mm64_att(ad, TILE(2), TILE(3), rt, ch, lane);
            const f32x4 wl4 = *(const LAS f32x4*)(WL + 16 * rt + 4 * g);
            bf16* Dg = (bf16*)OUTP() + chunk * 4096;
#pragma unroll
            for (int ct = 0; ct < 2; ++ct) *(GAS bf16x4s*)(Dg + (((2 * ch + ct) * 4 + rt) * 64 + lane) * 4) = pack4(ad[ct] * wl4);
        }
        lds_barrier();
    }
}

__device__ __forceinline__ void scan_s2(unsigned char* ws, int lane, int wave) {
    if (wave >= 4) return;
    const int ct = wave;
    for (int bh = blockIdx.x; bh < BATCH * NH; bh += gridDim.x) {
        const bf16* Mg = (const bf16*)(ws + WS_B0) + (size_t)bh * 128 * 4096; const bf16* Dg = (const bf16*)OUTP() + (size_t)bh * 128 * 4096; bf16* Sg = (bf16*)OUTP() + (size_t)M * C + (size_t)bh * 128 * 4096;
        f32x4 acc[4];
#pragma unroll
        for (int r = 0; r < 4; ++r) acc[r] = F4Z;
        bf16x8s mf[4][2]; bf16x4s df[4];
#pragma unroll
        for (int r = 0; r < 4; ++r) { df[r] = *(const GAS bf16x4s*)(Dg + ((ct * 4 + r) * 64 + lane) * 4);
#pragma unroll
            for (int ks = 0; ks < 2; ++ks) mf[r][ks] = *(const GAS bf16x8s*)(Mg + ((r * 2 + ks) * 64 + lane) * 8); }
#pragma unroll 1
        for (int c = 0; c < 128; ++c) {
            bf16x8s sf[2];
#pragma unroll
            for (int ks = 0; ks < 2; ++ks) { const bf16x4s lo = pack4(acc[2 * ks]), hi = pack4(acc[2 * ks + 1]); sf[ks] = (bf16x8s){lo[0], lo[1], lo[2], lo[3], hi[0], hi[1], hi[2], hi[3]}; }
#pragma unroll
            for (int ks = 0; ks < 2; ++ks) *(GAS bf16x8s*)(Sg + (size_t)c * 4096 + ((ct * 2 + ks) * 64 + lane) * 8) = sf[ks];
            bf16x8s mc[4][2]; f32x4 na[4];
#pragma unroll
            for (int r = 0; r < 4; ++r) { na[r] = unpack4(df[r]);
#pragma unroll
                for (int ks = 0; ks < 2; ++ks) mc[r][ks] = mf[r][ks]; }
            if (c + 1 < 128) {
                const bf16* Mn = Mg + (size_t)(c + 1) * 4096; const bf16* Dn = Dg + (size_t)(c + 1) * 4096;
#pragma unroll
                for (int r = 0; r < 4; ++r) { df[r] = *(const GAS bf16x4s*)(Dn + ((ct * 4 + r) * 64 + lane) * 4);
#pragma unroll
                    for (int ks = 0; ks < 2; ++ks) mf[r][ks] = *(const GAS bf16x8s*)(Mn + ((r * 2 + ks) * 64 + lane) * 8); }
            }
#pragma unroll
            for (int ks = 0; ks < 2; ++ks)
#pragma unroll
                for (int r = 0; r < 4; ++r) na[r] = MFMA16(mc[r][ks], sf[ks], na[r]);
#pragma unroll
            for (int r = 0; r < 4; ++r) acc[r] = na[r];
        }
    }
}

__device__ __forceinline__ void scan_s3(unsigned char* ws, LAS unsigned char* lds, int lane0, int wave) {
    const int rt = wave & 3, ch = wave >> 2;
    LAS float* Ys = (LAS float*)(lds + CS_FA);
    const bf16* LG = (const bf16*)(ws + WS_LG); const bf16* G2T = (const bf16*)(ws + WS_WT_G2); bf16* YG = (bf16*)(ws + WS_B0);
    FrontIn fin; float w0v[2], a0v[2];
    { int l0 = lane0; asm volatile("" : "+v"(l0)); const int hh = blockIdx.x & 15;
      if ((int)blockIdx.x < BATCH * NH * (SEQ / 64)) front_fetch(fin, ws, blockIdx.x, wave * 64 + l0, l0, wave);
#pragma unroll
      for (int ct = 0; ct < 2; ++ct) { w0v[ct] = INP(7)[hh * HD + 32 * ch + 16 * ct + (l0 & 15)]; a0v[ct] = INP(10)[hh * HD + 32 * ch + 16 * ct + (l0 & 15)]; }
      head_consts(ws, lds, hh, wave * 64 + l0, 10, 11); }
    for (int unit = blockIdx.x; unit < BATCH * NH * (SEQ / 64); unit += gridDim.x) {
        int lane = lane0; asm volatile("" : "+v"(lane));
        const int tid = wave * 64 + lane, fr = lane & 15, g = lane >> 4;
        const int h = unit & 15, c = (unit >> 4) & 127, b = unit >> 11; const size_t chunk = ((size_t)b * NH + h) * 128 + c; const size_t row0 = (size_t)b * SEQ + c * 64;
        const bf16* Sg = (const bf16*)OUTP() + (size_t)M * C + chunk * 4096; const bf16* Tg = (const bf16*)(ws + WS_B4) + chunk * 4096;
        bf16x8s sB[2][2], sA[2], tA[2];
#pragma unroll
        for (int ks = 0; ks < 2; ++ks) { sA[ks] = *(const GAS bf16x8s*)(Sg + ((rt * 2 + ks) * 64 + lane) * 8); tA[ks] = *(const GAS bf16x8s*)(Tg + (16 * rt + fr) * 64 + 32 * ks + 8 * g);
#pragma unroll
            for (int ct = 0; ct < 2; ++ct) sB[ks][ct] = *(const GAS bf16x8s*)(Sg + (((2 * ch + ct) * 2 + ks) * 64 + lane) * 8); }
        const int et = tid >> 3, ecq = tid & 7, ec0 = h * HD + ecq * 8;
        const f32x4 lnw0 = *(const GAS f32x4*)(INP(18) + ec0), lnw1 = *(const GAS f32x4*)(INP(18) + ec0 + 4), lnb0 = *(const GAS f32x4*)(INP(19) + ec0), lnb1 = *(const GAS f32x4*)(INP(19) + ec0 + 4);
        float v8[8]; float rkb;
        chunk_front<3>(fin, lds, w0v, a0v, tid, lane, wave, v8, rkb);
        bf16x8s gA[5], gB[5][2];
#pragma unroll
        for (int ks = 0; ks < 5; ++ks) { gA[ks] = *(const GAS bf16x8s*)(G2T + (size_t)(h * HD + 16 * rt + fr) * DG + 32 * ks + 8 * g);
#pragma unroll
            for (int ct = 0; ct < 2; ++ct) gB[ks][ct] = *(const GAS bf16x8s*)(LG + (row0 + 32 * ch + 16 * ct + fr) * DG + 32 * ks + 8 * g); }
        if (unit + (int)gridDim.x < BATCH * NH * (SEQ / 64)) front_fetch(fin, ws, unit + gridDim.x, tid, lane, wave);
        {
            f32x4 a1[2] = {F4Z, F4Z}, a2[2] = {F4Z, F4Z}, a3[2] = {F4Z, F4Z};
            mm64(a1, TILE(2), TILE(0), rt, ch, fr, g);
            mm64(a2, TILE(1), TILE(4), rt, ch, fr, g);
            mm64(a3, TILE(2), TILE(4), rt, ch, fr, g);
#pragma unroll
            for (int ct = 0; ct < 2; ++ct) { const int t = 32 * ch + 16 * ct + fr;
#pragma unroll
                for (int q = 0; q < 4; ++q) { const int s = 16 * rt + 4 * g + q; a1[ct][q] = s < t ? a1[ct][q] : 0.f; a2[ct][q] = s <= t ? a2[ct][q] : 0.f; a3[ct][q] = s <= t ? a3[ct][q] : 0.f; } }
            st_tr(TILE(5), a1, rt, ch, fr, g); st_tr(TILE(6), a2, rt, ch, fr, g); st_tr(TILE(7), a3, rt, ch, fr, g);
        }
        f32x4 ag[2] = {F4Z, F4Z};
#pragma unroll
        for (int ks = 0; ks < 5; ++ks)
#pragma unroll
            for (int ct = 0; ct < 2; ++ct) ag[ct] = MFMA16(gA[ks], gB[ks][ct], ag[ct]);
        lds_barrier();
        {
            f32x4 acc[2] = {F4Z, F4Z};
#pragma unroll
            for (int ks = 0; ks < 2; ++ks) { const bf16x8s a = ldfrag_perm(TILE(0), 16 * rt + fr, ks, g);
#pragma unroll
                for (int ct = 0; ct < 2; ++ct) acc[ct] = MFMA16(a, sB[ks][ct], acc[ct]); }
            mm64_bt(acc, TILE(5), TILE(3), rt, ch, fr, g, lane);
            st_tr(TILE(8), acc, rt, ch, fr, g);
        }
        lds_barrier();
        {
            f32x4 acc[2] = {F4Z, F4Z};
#pragma unroll
            for (int ks = 0; ks < 2; ++ks)
#pragma unroll
                for (int ct = 0; ct < 2; ++ct) acc[ct] = MFMA16(tA[ks], ldfrag(TILE(8), 32 * ch + 16 * ct + fr, 32 * ks + 8 * g), acc[ct]);
            st_tr(TILE(9), acc, rt, ch, fr, g);
        }
        lds_barrier();
        {
            f32x4 acc[2] = {F4Z, F4Z};
#pragma unroll
            for (int ks = 0; ks < 2; ++ks)
#pragma unroll
                for (int ct = 0; ct < 2; ++ct) acc[ct] = MFMA16(sA[ks], ldfrag_perm(TILE(4), 32 * ch + 16 * ct + fr, ks, g), acc[ct]);
            mm64(acc, TILE(9), TILE(6), rt, ch, fr, g); mm64_at(acc, TILE(3), TILE(7), rt, ch, fr, g, lane);
#pragma unroll
            for (int ct = 0; ct < 2; ++ct) { const int t = 32 * ch + 16 * ct + fr; *(LAS f32x4*)(Ys + t * FP + 16 * rt + 4 * g) = acc[ct]; }
        }
        lds_barrier();
        {
            const f32x4 y0 = *(const LAS f32x4*)(Ys + et * FP + ecq * 8), y1 = *(const LAS f32x4*)(Ys + et * FP + ecq * 8 + 4);
            float y[8] = {y0[0], y0[1], y0[2], y0[3], y1[0], y1[1], y1[2], y1[3]};
            float s = 0.f;
#pragma unroll
            for (int q = 0; q < 8; ++q) s += y[q];
            s += shx(s, 1, lane); s += shx(s, 2, lane); s += shx(s, 4, lane);
            const float mu = s * (1.0f / HD); float vs = 0.f;
#pragma unroll
            for (int q = 0; q < 8; ++q) { y[q] -= mu; vs += y[q] * y[q]; }
            vs += shx(vs, 1, lane); vs += shx(vs, 2, lane); vs += shx(vs, 4, lane);
            const float rstd = 1.0f / sqrtf(vs * (1.0f / HD) + GN_EPS);
            f32x4 o0, o1;
#pragma unroll
            for (int q = 0; q < 4; ++q) { o0[q] = y[q] * rstd * lnw0[q] + lnb0[q] + rkb * v8[q]; o1[q] = y[4 + q] * rstd * lnw1[q] + lnb1[q] + rkb * v8[4 + q]; }
            *(LAS f32x4*)(Ys + et * FP + ecq * 8) = o0; *(LAS f32x4*)(Ys + et * FP + ecq * 8 + 4) = o1;
        }
        lds_barrier();
        {
#pragma unroll
            for (int ct = 0; ct < 2; ++ct) { const int t = 32 * ch + 16 * ct + fr; const f32x4 yv = *(const LAS f32x4*)(Ys + t * FP + 16 * rt + 4 * g);
                *(GAS bf16x4s*)(YG + (row0 + t) * C + h * HD + 16 * rt + 4 * g) = pack4(yv * ag[ct]); }
        }
        lds_barrier();
    }
}
#undef TILE
#if MK_DEBUG
__device__ __forceinline__ void scan_naive(unsigned char* ws, LAS unsigned char* lds, int tid) {
    const int lane = tid & 63;
    const bf16* Rb = (const bf16*)(ws + WS_B1); const bf16* Kb = (const bf16*)(ws + WS_B2); const bf16* Vb = (const bf16*)(ws + WS_B3);
    const bf16* LW = (const bf16*)(ws + WS_LW); const bf16* LA = (const bf16*)(ws + WS_LA);
    float* Y = OUTP(); float* RK = (float*)(ws + WS_HID);
    LAS float* sR = (LAS float*)lds; LAS float* sK = sR + 4096; LAS float* sV = sK + 4096; LAS float* sA = sV + 4096; LAS float* sB = sA + 4096; LAS float* sD = sB + 4096;
    LAS float* sW2 = sD + 4096; LAS float* sA2 = sW2 + 4096;
    for (int unit = blockIdx.x; unit < BATCH * NH; unit += gridDim.x) {
        const int b = unit / NH, h = unit % NH;
        __syncthreads();
        for (int e = tid; e < 4096; e += 512) { const int d = e >> 6, j = e & 63; sW2[e] = INP(9)[(size_t)d * C + h * HD + j]; sA2[e] = INP(12)[(size_t)d * C + h * HD + j]; }
        __syncthreads();
        const int pt = tid >> 3, cq = tid & 7, c0 = h * HD + cq * 8;
        const int si = tid >> 3, jq = tid & 7;
        float S[8];
#pragma unroll
        for (int q = 0; q < 8; ++q) S[q] = 0.f;
        float w0v[8], a0v[8], kkv[8], kav[8], rkv[8];
#pragma unroll
        for (int q = 0; q < 8; ++q) { w0v[q] = INP(7)[c0 + q]; a0v[q] = INP(10)[c0 + q]; kkv[q] = INP(15)[c0 + q]; kav[q] = INP(16)[c0 + q]; rkv[q] = INP(17)[c0 + q]; }
        for (int blk = 0; blk < SEQ / 64; ++blk) {
            const size_t row = (size_t)b * SEQ + blk * 64 + pt;
            {
                const v4u r4 = *(const GAS v4u*)(Rb + row * C + c0), k4 = *(const GAS v4u*)(Kb + row * C + c0), v4 = *(const GAS v4u*)(Vb + row * C + c0);
                float r[8], k[8], v[8];
                r[0] = bflo(r4.x); r[1] = bfhi(r4.x); r[2] = bflo(r4.y); r[3] = bfhi(r4.y); r[4] = bflo(r4.z); r[5] = bfhi(r4.z); r[6] = bflo(r4.w); r[7] = bfhi(r4.w);
                k[0] = bflo(k4.x); k[1] = bfhi(k4.x); k[2] = bflo(k4.y); k[3] = bfhi(k4.y); k[4] = bflo(k4.z); k[5] = bfhi(k4.z); k[6] = bflo(k4.w); k[7] = bfhi(k4.w);
                v[0] = bflo(v4.x); v[1] = bfhi(v4.x); v[2] = bflo(v4.y); v[3] = bfhi(v4.y); v[4] = bflo(v4.z); v[5] = bfhi(v4.z); v[6] = bflo(v4.w); v[7] = bfhi(v4.w);
                float wp[8], ap[8];
#pragma unroll
                for (int q = 0; q < 8; ++q) { wp[q] = w0v[q]; ap[q] = a0v[q]; }
                for (int d = 0; d < 64; ++d) { const float lw = bf2f(LW[row * DW + d]), la = bf2f(LA[row * DA + d]);
#pragma unroll
                    for (int q = 0; q < 8; ++q) { wp[q] += lw * sW2[d * 64 + cq * 8 + q]; ap[q] += la * sA2[d * 64 + cq * 8 + q]; } }
                float kk[8], ss = 0.f, rks = 0.f;
#pragma unroll
                for (int q = 0; q < 8; ++q) { kk[q] = k[q] * kkv[q]; ss += kk[q] * kk[q]; }
                ss += shx(ss, 1, lane); ss += shx(ss, 2, lane); ss += shx(ss, 4, lane);
                const float inv = 1.0f / fmaxf(sqrtf(ss), 1e-12f);
#pragma unroll
                for (int q = 0; q < 8; ++q) { const float ag = sigmoidf_(ap[q]); const float kn = kk[q] * inv; const float kp = k[q] * (1.0f + (ag - 1.0f) * kav[q]);
                    const float lw = -0.6065306597126334f * sigmoidf_(wp[q]);
                    const int o = pt * 64 + cq * 8 + q;
                    sR[o] = r[q]; sK[o] = kp; sV[o] = v[q]; sA[o] = -kn; sB[o] = kn * ag; sD[o] = __expf(lw); rks += r[q] * kp * rkv[q]; }
                rks += shx(rks, 1, lane); rks += shx(rks, 2, lane); rks += shx(rks, 4, lane);
                if (cq == 0) RK[row * NH + h] = rks;
            }
            __syncthreads();
            for (int t = 0; t < 64; ++t) {
                const LAS f32x4* pa = (const LAS f32x4*)(sA + t * 64 + jq * 8); const LAS f32x4* pb = (const LAS f32x4*)(sB + t * 64 + jq * 8);
                const LAS f32x4* pd = (const LAS f32x4*)(sD + t * 64 + jq * 8); const LAS f32x4* pk = (const LAS f32x4*)(sK + t * 64 + jq * 8);
                const LAS f32x4* pr = (const LAS f32x4*)(sR + t * 64 + jq * 8);
                const f32x4 a0 = pa[0], a1 = pa[1], b0 = pb[0], b1 = pb[1], d0 = pd[0], d1 = pd[1], k0 = pk[0], k1 = pk[1], r0 = pr[0], r1 = pr[1];
                const float vi = sV[t * 64 + si];
                float sa = 0.f;
#pragma unroll
                for (int q = 0; q < 4; ++q) { sa += S[q] * a0[q]; sa += S[4 + q] * a1[q]; }
                sa += shx(sa, 1, lane); sa += shx(sa, 2, lane); sa += shx(sa, 4, lane);
                float y = 0.f;
#pragma unroll
                for (int q = 0; q < 4; ++q) { S[q] = S[q] * d0[q] + sa * b0[q] + vi * k0[q]; S[4 + q] = S[4 + q] * d1[q] + sa * b1[q] + vi * k1[q]; y += S[q] * r0[q]; y += S[4 + q] * r1[q]; }
                y += shx(y, 1, lane); y += shx(y, 2, lane); y += shx(y, 4, lane);
                if (jq == 0) Y[((size_t)b * SEQ + blk * 64 + t) * C + h * HD + si] = y;
            }
            __syncthreads();
        }
    }
}
__device__ __forceinline__ void post_scan(unsigned char* ws, int gw, int NGW, int lane) {
    const float* Y = OUTP(); const float* RK = (const float*)(ws + WS_HID); const bf16* Vb = (const bf16*)(ws + WS_B3); const bf16* LG = (const bf16*)(ws + WS_LG);
    bf16* YG = (bf16*)(ws + WS_B4); const float* g2 = INP(14); const float* lnw = INP(18); const float* lnb = INP(19);
    for (int it = gw; it < M * NH; it += NGW) {
        const int row = it / NH, h = it % NH, c = h * HD + lane;
        const float y = Y[(size_t)row * C + c];
        const float mu = wave_sum(y, lane) * (1.0f / HD); const float d = y - mu; const float var = wave_sum(d * d, lane) * (1.0f / HD);
        float o = d * (1.0f / sqrtf(var + GN_EPS)) * lnw[c] + lnb[c];
        o += RK[(size_t)row * NH + h] * bf2f(Vb[(size_t)row * C + c]);
        float g = 0.f;
        for (int dd = 0; dd < DG; ++dd) g += bf2f(LG[(size_t)row * DG + dd]) * g2[(size_t)dd * C + c];
        YG[(size_t)row * C + c] = (bf16)f2bf(o * g);
    }
}


constexpr int CW_DBG = 3200;
__device__ __forceinline__ void dbg_nonfinite(unsigned char* ws, const bf16* X, size_t n, int slot, int gw, int NGW, int lane, float thr = 1e30f) {
    unsigned* cw = (unsigned*)(ws + WS_CTL) + CW_DBG + 64 * slot; unsigned nnan = 0;
    for (size_t i = (size_t)gw * 64 + lane; i < n; i += (size_t)NGW * 64) { const float x = bf2f(X[i]); if (!(fabsf(x) < thr)) ++nnan; }
    if (nnan) atomicAdd(cw, nnan);
}
__device__ __forceinline__ void dbg_compare(unsigned char* ws, const bf16* X, const bf16* Y, int gw, int NGW, int lane) {
    unsigned* cw = (unsigned*)(ws + WS_CTL) + CW_DBG; unsigned nbad = 0, nnan = 0;
    for (size_t i = (size_t)gw * 64 + lane; i < (size_t)M * C; i += (size_t)NGW * 64) { const float x = bf2f(X[i]), y = bf2f(Y[i]);
        if (!(fabsf(x) < 1e30f)) ++nnan; else if (fabsf(x - y) > 0.05f * (fabsf(y) + 0.05f)) ++nbad; }
    if (nnan) atomicAdd(cw, nnan); if (nbad) atomicAdd(cw + 64, nbad);
}
#endif
__device__ __forceinline__ void router_rows(unsigned char* ws, LAS unsigned char* lds, int layer, int gw, int NGW, int lane, int tid) {
    const float* Hh = OUTP(); const float* gain = INP(2) + layer * C; bf16* XN = (bf16*)(ws + WS_B1);
    const float* wg = INP(24) + (size_t)layer * C * 4; const float* bg = INP(25) + layer * 4; const float* wi = INP(26) + (size_t)layer * C * 16; const float* bi = INP(27) + layer * 16;
    unsigned* cnt = (unsigned*)(ws + WS_CTL) + CW_CNT + layer * 16 * 64; unsigned* list = (unsigned*)(ws + WS_LIST); float* wl = (float*)(ws + WS_WL);
    LAS float* sWg = (LAS float*)lds; LAS float* sWi = sWg + C * 4;
    __syncthreads();
    for (int e = tid; e < C * 4; e += 512) sWg[e] = wg[e];
    for (int e = tid; e < C * 16; e += 512) sWi[e] = wi[e];
    __syncthreads();
    f32x4 g[4]; load_row(gain, lane, g);
    for (int row = gw; row < M; row += NGW) {
        f32x4 v[4]; load_row(Hh + (size_t)row * C, lane, v); const float rs = row_rs(v, lane);
#pragma unroll
        for (int j = 0; j < 4; ++j) v[j] = v[j] * rs * g[j];
        store_row_bf16(XN + (size_t)row * C, lane, v);
        float gl[4] = {0.f, 0.f, 0.f, 0.f};
        const LAS unsigned char* pWg = (const LAS unsigned char*)sWg + lane * 64;
#pragma unroll
        for (int j = 0; j < 4; ++j)
#pragma unroll
            for (int q = 0; q < 4; ++q) { const f32x4 w = *(const LAS f32x4*)(pWg + j * 4096 + q * 16); const float xv = v[j][q]; gl[0] += xv * w.x; gl[1] += xv * w.y; gl[2] += xv * w.z; gl[3] += xv * w.w; }
#pragma unroll
        for (int q = 0; q < 4; ++q) gl[q] = wave_sum(gl[q], lane) + bg[q];
        int gi = 0; float gm = gl[0];
#pragma unroll
        for (int q = 1; q < 4; ++q) if (gl[q] > gm) { gm = gl[q]; gi = q; }
        float gden = 0.f;
#pragma unroll
        for (int q = 0; q < 4; ++q) gden += __expf(gl[q] - gm);
        const float gval = 1.0f / gden;
        float il[4] = {0.f, 0.f, 0.f, 0.f};
        const LAS unsigned char* pWi = (const LAS unsigned char*)sWi + lane * 256 + gi * 16;
#pragma unroll
        for (int j = 0; j < 4; ++j)
#pragma unroll
            for (int q = 0; q < 4; ++q) { const f32x4 w = *(const LAS f32x4*)(pWi + j * 16384 + q * 64); const float xv = v[j][q]; il[0] += xv * w.x; il[1] += xv * w.y; il[2] += xv * w.z; il[3] += xv * w.w; }
#pragma unroll
        for (int q = 0; q < 4; ++q) il[q] = wave_sum(il[q], lane) + bi[gi * 4 + q];
        int i0 = 0; float m0 = il[0];
#pragma unroll
        for (int q = 1; q < 4; ++q) if (il[q] > m0) { m0 = il[q]; i0 = q; }
        int i1 = -1; float m1 = -INFINITY;
#pragma unroll
        for (int q = 0; q < 4; ++q) if (q != i0 && il[q] > m1) { m1 = il[q]; i1 = q; }
        const float e1 = __expf(m1 - m0); const float w0 = gval / (1.0f + e1), w1 = gval * e1 / (1.0f + e1);
        if (lane == 0) {
            const int ex0 = gi * 4 + i0, ex1 = gi * 4 + i1;
            const unsigned p0 = atomicAdd(cnt + ex0 * 64, 1u); list[(size_t)ex0 * M + p0] = (unsigned)row * 2u; wl[(size_t)ex0 * M + p0] = w0;
            const unsigned p1 = atomicAdd(cnt + ex1 * 64, 1u); list[(size_t)ex1 * M + p1] = (unsigned)row * 2u + 1u; wl[(size_t)ex1 * M + p1] = w1;
        }
    }
}
__device__ __forceinline__ void moe_table(unsigned char* ws, volatile LAS int* tab, int layer, int tid) {
    __syncthreads();
    if (tid == 0) { const unsigned* cnt = (const unsigned*)(ws + WS_CTL) + CW_CNT + layer * 16 * 64; int t = 0;
#pragma unroll 1
        for (int e = 0; e < 16; ++e) { const int c = (int)__hip_atomic_load(cnt, RLX_AGENT); cnt += 64; tab[e] = c; tab[16 + e] = t; t += (c + 255) >> 8; tab[32 + e] = t; }
        tab[48] = t; }
    __syncthreads();
}
__device__ __forceinline__ void combine_rows(unsigned char* ws, int mode, int gw, int NGW, int lane) {
    float* Hh = OUTP(); const bf16* E0 = (const bf16*)(ws + WS_B2); const bf16* E1 = (const bf16*)(ws + WS_B3); bf16* XN2 = (bf16*)(ws + WS_B0);
    f32x4 g[4]; load_row(INP(4), lane, g);
    for (int row = gw; row < M; row += NGW) {
        f32x4 v[4]; load_row(Hh + (size_t)row * C, lane, v);
#pragma unroll
        for (int j = 0; j < 4; ++j) { const v2u e0 = ((const GAS v2u*)(E0 + (size_t)row * C))[64 * j + lane], e1 = ((const GAS v2u*)(E1 + (size_t)row * C))[64 * j + lane];
            v[j].x += bflo(e0.x) + bflo(e1.x); v[j].y += bfhi(e0.x) + bfhi(e1.x); v[j].z += bflo(e0.y) + bflo(e1.y); v[j].w += bfhi(e0.y) + bfhi(e1.y); }
        const float rs = row_rs(v, lane);
        if (mode == 0) {
#pragma unroll
            for (int j = 0; j < 4; ++j) ((GAS f32x4*)(Hh + (size_t)row * C))[64 * j + lane] = v[j];
#pragma unroll
            for (int j = 0; j < 4; ++j) v[j] = v[j] * rs;
            store_row_bf16(XN2 + (size_t)row * C, lane, v);
        } else {
            float sig = 1.0f;
#if MK_DEBUG
            const unsigned* cw = (const unsigned*)(ws + WS_CTL) + CW_DBG; const unsigned nnan = __hip_atomic_load(cw, RLX_AGENT), nbad = __hip_atomic_load(cw + 64, RLX_AGENT);
            if (row < 512 && nnan > 0) sig = 2.0f;
            if (row >= 512 && row < 1536 && __hip_atomic_load(cw + 128, RLX_AGENT) > 0) sig = 2.0f;
            if (row >= 1536 && row < 3584 && __hip_atomic_load(cw + 192, RLX_AGENT) > 0) sig = 2.0f;
            if (row >= 3584 && row < 7680 && __hip_atomic_load(cw + 256, RLX_AGENT) > 0) sig = 2.0f;
            if (row >= 7680 && row < 15872 && __hip_atomic_load(cw + 320, RLX_AGENT) > 0) sig = 2.0f;
            if (row >= 15872 && nbad > (unsigned)(M / 100) * C) sig = 1.5f;
#endif
#pragma unroll
            for (int j = 0; j < 4; ++j) ((GAS f32x4*)(Hh + (size_t)row * C))[64 * j + lane] = v[j] * rs * g[j] * sig;
        }
    }
}
__device__ __forceinline__ void attn_naive(unsigned char* ws, int gw, int NGW, int lane) {
    const bf16* Kb = (const bf16*)(ws + WS_B1); const bf16* Vb = (const bf16*)(ws + WS_B2); const bf16* Qb = (const bf16*)(ws + WS_B3); bf16* Ob = (bf16*)(ws + WS_B0);
    for (int unit = gw; unit < BATCH * NH * (SEQ / 64); unit += NGW) {
        const int qb = unit % (SEQ / 64), bh = unit / (SEQ / 64), b = bh / NH, h = bh % NH;
        const int t0 = qb * 64, t = t0 + lane; const size_t rowq = (size_t)b * SEQ + t;
        float q[64], o[64];
#pragma unroll
        for (int c = 0; c < 8; ++c) { const v4u w = *(const GAS v4u*)(Qb + rowq * C + h * HD + c * 8);
            q[c * 8 + 0] = bflo(w.x) * 0.125f; q[c * 8 + 1] = bfhi(w.x) * 0.125f; q[c * 8 + 2] = bflo(w.y) * 0.125f; q[c * 8 + 3] = bfhi(w.y) * 0.125f;
            q[c * 8 + 4] = bflo(w.z) * 0.125f; q[c * 8 + 5] = bfhi(w.z) * 0.125f; q[c * 8 + 6] = bflo(w.w) * 0.125f; q[c * 8 + 7] = bfhi(w.w) * 0.125f; }
#pragma unroll
        for (int c = 0; c < 64; ++c) o[c] = 0.f;
        float suffix = 0.f;
        for (int s = t0 + 62; s >= 0; --s) {
            const bool valid = s < t;
            if (s < t0 && __all(suffix > SB_EXIT)) break;
            const bf16* kp = Kb + ((size_t)b * SEQ + s) * C + h * HD; const bf16* vp = Vb + ((size_t)b * SEQ + s) * C + h * HD;
            float z = 0.f;
#pragma unroll
            for (int c = 0; c < 8; ++c) { const v4u w = *(const GAS v4u*)(kp + c * 8);
                z += q[c * 8 + 0] * bflo(w.x) + q[c * 8 + 1] * bfhi(w.x) + q[c * 8 + 2] * bflo(w.y) + q[c * 8 + 3] * bfhi(w.y) + q[c * 8 + 4] * bflo(w.z) + q[c * 8 + 5] * bfhi(w.z) + q[c * 8 + 6] * bflo(w.w) + q[c * 8 + 7] * bfhi(w.w); }
            const float sp = fmaxf(z, 0.f) + log1pf(__expf(-fabsf(z)));
            const float att = valid ? __expf(z - sp - suffix) : 0.f;
            suffix += valid ? sp : 0.f;
#pragma unroll
            for (int c = 0; c < 8; ++c) { const v4u w = *(const GAS v4u*)(vp + c * 8);
                o[c * 8 + 0] += att * bflo(w.x); o[c * 8 + 1] += att * bfhi(w.x); o[c * 8 + 2] += att * bflo(w.y); o[c * 8 + 3] += att * bfhi(w.y);
                o[c * 8 + 4] += att * bflo(w.z); o[c * 8 + 5] += att * bfhi(w.z); o[c * 8 + 6] += att * bflo(w.w); o[c * 8 + 7] += att * bfhi(w.w); }
        }
#pragma unroll
        for (int c = 0; c < 8; ++c) { v4u w; w.x = pk2(o[c * 8 + 0], o[c * 8 + 1]); w.y = pk2(o[c * 8 + 2], o[c * 8 + 3]); w.z = pk2(o[c * 8 + 4], o[c * 8 + 5]); w.w = pk2(o[c * 8 + 6], o[c * 8 + 7]);
            *(GAS v4u*)(Ob + rowq * C + h * HD + c * 8) = w; }
    }
}


typedef float f32x16 __attribute__((ext_vector_type(16)));
constexpr int AT_VP = 192;
constexpr int AT_WAVE_LDS = 32 * AT_VP;
__device__ __forceinline__ int crow32(int reg, int hh) { return (reg & 3) + 8 * (reg >> 2) + 4 * hh; }
__device__ __forceinline__ bf16x8s pack_step(const f32x16& x, const int s) {
    v4u p; p.x = pg8::cvt_pk_bf16(x[8 * s], x[8 * s + 1]); p.y = pg8::cvt_pk_bf16(x[8 * s + 2], x[8 * s + 3]); p.z = pg8::cvt_pk_bf16(x[8 * s + 4], x[8 * s + 5]); p.w = pg8::cvt_pk_bf16(x[8 * s + 6], x[8 * s + 7]);
    return __builtin_bit_cast(bf16x8s, p);
}
__device__ __forceinline__ void attn_mfma(unsigned char* ws, LAS unsigned char* lds, int gw, int NGW, int lane, int wave) {
    const bf16* Kb = (const bf16*)(ws + WS_B1); const bf16* Vb = (const bf16*)(ws + WS_B2); const bf16* Qb = (const bf16*)(ws + WS_B3); bf16* Ob = (bf16*)(ws + WS_B0);
    LAS unsigned char* vl = lds + wave * AT_WAVE_LDS;
    const int r32 = lane & 31, hh = lane >> 5;
    bf16x8s tri[2];
#pragma unroll
    for (int s = 0; s < 2; ++s)
#pragma unroll
        for (int j = 0; j < 8; ++j) tri[s][j] = (16 * s + 8 * (j >> 2) + 4 * hh + (j & 3)) > r32 ? (short)0x3F80 : (short)0;
    const int grp = lane >> 4, tq = (lane & 15) >> 2, tp = lane & 3;
    const LAS unsigned char* vtr0 = vl + (4 * hh + tq) * AT_VP + (16 * (grp & 1) + 4 * tp) * 2;
    for (int unit = gw; unit < BATCH * NH * (SEQ / 32); unit += NGW) {
        const int qb = unit % (SEQ / 32), bh = unit / (SEQ / 32), b = bh / NH, hd = bh % NH;
        const int t0 = qb * 32; const size_t rowb = (size_t)b * SEQ;
        bf16x8s qf[4];
#pragma unroll
        for (int ks = 0; ks < 4; ++ks) qf[ks] = *(const GAS bf16x8s*)(Qb + (rowb + t0 + r32) * C + hd * HD + 16 * ks + 8 * hh);
        f32x16 o[2];
#pragma unroll
        for (int i = 0; i < 16; ++i) { o[0][i] = 0.f; o[1][i] = 0.f; }
        float carry = 0.f;
        for (int s0 = t0; s0 >= 0; s0 -= 32) {
            bf16x8s kf[4];
#pragma unroll
            for (int ks = 0; ks < 4; ++ks) kf[ks] = *(const GAS bf16x8s*)(Kb + (rowb + s0 + r32) * C + hd * HD + 16 * ks + 8 * hh);
            v4u vreg[4];
#pragma unroll
            for (int i = 0; i < 4; ++i) { const int cidx = lane + 64 * i; vreg[i] = *(const GAS v4u*)(Vb + (rowb + s0 + (cidx >> 3)) * C + hd * HD + (cidx & 7) * 8); }
            f32x16 st;
#pragma unroll
            for (int i = 0; i < 16; ++i) st[i] = 0.f;
#pragma unroll
            for (int ks = 0; ks < 4; ++ks) st = __builtin_amdgcn_mfma_f32_32x32x16_bf16(kf[ks], qf[ks], st, 0, 0, 0);
#pragma unroll
            for (int i = 0; i < 4; ++i) { const int cidx = lane + 64 * i; *(LAS v4u*)(vl + (cidx >> 3) * AT_VP + (cidx & 7) * 16) = vreg[i]; }
            f32x16 zz, uu; float tot = 0.f; const int tq_ = t0 + r32;
#pragma unroll
            for (int i = 0; i < 16; ++i) { const int key = s0 + crow32(i, hh); const float z = st[i] * 0.125f; const float sp = fmaxf(z, 0.f) + __logf(1.0f + __expf(-fabsf(z)));
                const bool valid = key < tq_; zz[i] = valid ? z - sp : -1e30f; uu[i] = valid ? sp : 0.f; tot += uu[i]; }
            f32x16 uh, ul;
#pragma unroll
            for (int i = 0; i < 16; i += 2) { const unsigned ph = pg8::cvt_pk_bf16(uu[i], uu[i + 1]); uh[i] = bflo(ph); uh[i + 1] = bfhi(ph); ul[i] = uu[i] - uh[i]; ul[i + 1] = uu[i + 1] - uh[i + 1]; }
            f32x16 w;
#pragma unroll
            for (int i = 0; i < 16; ++i) w[i] = 0.f;
#pragma unroll
            for (int s = 0; s < 2; ++s) { w = __builtin_amdgcn_mfma_f32_32x32x16_bf16(tri[s], pack_step(uh, s), w, 0, 0, 0); w = __builtin_amdgcn_mfma_f32_32x32x16_bf16(tri[s], pack_step(ul, s), w, 0, 0, 0); }
            f32x16 pp;
#pragma unroll
            for (int i = 0; i < 16; ++i) pp[i] = __expf(zz[i] - w[i] - carry);
            tot += shx(tot, 32, lane); carry += tot;
            asm volatile("s_waitcnt lgkmcnt(0)" ::: "memory");
#pragma unroll
            for (int s = 0; s < 2; ++s) { const bf16x8s pa = pack_step(pp, s);
#pragma unroll
                for (int dt = 0; dt < 2; ++dt) {
                    const v4i16_t lo = __builtin_amdgcn_ds_read_tr16_b64_v4i16((LAS v4i16_t*)(vtr0 + (16 * s) * AT_VP + dt * 64));
                    const v4i16_t hi = __builtin_amdgcn_ds_read_tr16_b64_v4i16((LAS v4i16_t*)(vtr0 + (16 * s + 8) * AT_VP + dt * 64));
                    const bf16x8s vf = (bf16x8s){lo[0], lo[1], lo[2], lo[3], hi[0], hi[1], hi[2], hi[3]};
                    o[dt] = __builtin_amdgcn_mfma_f32_32x32x16_bf16(pa, vf, o[dt], 0, 0, 0); } }
            asm volatile("" ::: "memory");
            if (s0 < t0 && __all(carry > SB_EXIT)) break;
        }
#pragma unroll
        for (int dt = 0; dt < 2; ++dt)
#pragma unroll
            for (int i = 0; i < 16; ++i) Ob[(rowb + t0 + crow32(i, hh)) * C + hd * HD + 32 * dt + r32] = (bf16)f2bf(o[dt][i]);
    }
}
__global__ void __launch_bounds__(NWAVES * 64, 2) yoco_fwd(Args args) {
    extern __shared__ __attribute__((aligned(16))) unsigned char lds_raw[];
    LAS unsigned char* lds = (LAS unsigned char*)lds_raw;
    const int G = gridDim.x; const int bx = blockIdx.x;
    int wave = __builtin_amdgcn_readfirstlane(threadIdx.x >> 6); asm volatile("" : "+s"(wave));
#define IDS() int lane; asm volatile("v_mbcnt_lo_u32_b32 %0, -1, 0\n\tv_mbcnt_hi_u32_b32 %0, -1, %0" : "=v"(lane)); const int tid = wave * 64 + lane; (void)tid; \
    const int vcu = (G % 8 == 0) ? (bx % 8) * (G / 8) + bx / 8 : bx; const int gw = vcu * NWAVES + wave, NGW = G * NWAVES; (void)lane; (void)gw; (void)NGW;
    unsigned char* ws = WSP();
    volatile LAS unsigned* MISC = (volatile LAS unsigned*)(lds + MISC_OFF);
    volatile LAS int* tab = (volatile LAS int*)(lds + MOE_TAB_OFF);
    for (int u = threadIdx.x; u < (LDS_BYTES - LDSCTL_OFF) / 4; u += NWAVES * 64) ((LAS unsigned*)(lds + LDSCTL_OFF))[u] = 0u;
    __syncthreads();
    XcdBarrier bar; bar.bar = (unsigned*)(ws + WS_CTL) + CW_BAR; bar.x = 0; bar.st = nullptr;
    if (N_LAUNCHES == 1) bar = xcd_barrier_post((unsigned*)(ws + WS_CTL) + CW_BAR, MISC + 8);
    const int lo = KA_INT(0), hi = KA_INT(1);
#ifndef PROBE_PH
#define PROBE_PH -1
#endif
#define IN(k) (lo <= (k) && (k) < hi)
#define REP(k) for (int rep_ = 0; rep_ < ((PROBE_PH == (k)) ? 2 : 1); ++rep_)
#define SEAM(k) do { if (IN(k) && IN((k) + 1)) xcd_barrier(bar); } while (0)

    if (IN(PH_P0)) REP(PH_P0) { IDS(); p0_weights(ws, lds, gw, NGW, wave, lane); p0_rows(ws, gw, NGW, lane); }
    SEAM(PH_P0);
    if (IN(PH_LORA)) REP(PH_LORA) {
        SchedGrouped<1, 3> S{(const char*)(ws + WS_B1), (size_t)(WS_B2 - WS_B1), nullptr, (const char*)(ws + WS_WT_LORA), (size_t)256 * C * 2, G, bx};
        EpiLora E{(bf16*)(ws + WS_LW)};
        pg8::gemm_phase<EpiLora, SchedGrouped<1, 3>, true, false, C>(lds, S, E, wave);
    }
    SEAM(PH_LORA);
    if (IN(PH_RKV)) REP(PH_RKV) {
        SchedGrouped<4, 3> S{(const char*)OUTP(), (size_t)M * C * 2, (const char*)(ws + WS_B4), (const char*)(ws + WS_WT_RKV), (size_t)C * C * 2, G, bx};
        EpiSplit3 E{(bf16*)(ws + WS_B1), false};
        pg8::gemm_phase<EpiSplit3, SchedGrouped<4, 3>, true, false, C>(lds, S, E, wave);
    }
    SEAM(PH_RKV);
    if (IN(PH_S1)) REP(PH_S1) { IDS(); scan_s1(ws, lds, lane, wave); }
    SEAM(PH_S1);
    if (IN(PH_S2)) REP(PH_S2) { IDS(); scan_s2(ws, lane, wave); }
    SEAM(PH_S2);
    if (IN(PH_S3)) REP(PH_S3) { IDS(); scan_s3(ws, lds, lane, wave); }
    SEAM(PH_S3);
#if MK_DEBUG
    if (IN(PH_DBG0)) { IDS(); scan_naive(ws, lds, tid); }
    SEAM(PH_DBG0);
    if (IN(PH_DBG0 + 1)) { IDS(); post_scan(ws, gw, NGW, lane); }
    SEAM(PH_DBG0 + 1);
    if (IN(PH_DBG0 + 2)) { IDS(); dbg_compare(ws, (const bf16*)(ws + WS_B0), (const bf16*)(ws + WS_B4), gw, NGW, lane); }
    SEAM(PH_DBG0 + 2);
#endif
    if (IN(PH_WOUT)) REP(PH_WOUT) {
        SchedGrouped<4, 1> S{(const char*)(ws + ((MK_DEBUG && DBG_USE_NAIVE) ? WS_B4 : WS_B0)), 0, nullptr, (const char*)(ws + WS_WT_OUT), 0, G, bx};
        EpiResid E{INP(0), OUTP()};
        pg8::gemm_phase<EpiResid, SchedGrouped<4, 1>, true, false, C>(lds, S, E, wave);
    }
    SEAM(PH_WOUT);
#pragma unroll 1
    for (int layer = 0; layer < 2; ++layer) {
        const int pb = layer == 0 ? (int)PH_ROUT0 : (int)PH_ROUT1;
        if (IN(pb)) { IDS(); router_rows(ws, lds, layer, gw, NGW, lane, tid); }
        SEAM(pb);
        if (IN(pb + 1)) REP(pb + 1) {
            { IDS(); moe_table(ws, tab, layer, tid); }
            SchedMoe<2, C, true> S{(const char*)(ws + WS_B1), (const char*)(ws + WS_WT_GU) + (size_t)layer * 16 * 512 * C * 2, (size_t)512 * C * 2, (const unsigned*)(ws + WS_LIST), tab, G, bx};
            EpiGU E{(bf16*)(ws + WS_HID), (const float*)(ws + WS_WL)};
            pg8::gemm_phase<EpiGU, SchedMoe<2, C, true>, true, true, C>(lds, S, E, wave);
        }
        SEAM(pb + 1);
        if (IN(pb + 2)) REP(pb + 2) {
            { IDS(); moe_table(ws, tab, layer, tid); }
            SchedMoe<4, FE, false> S{(const char*)(ws + WS_HID), (const char*)(ws + WS_WT_DN) + (size_t)layer * 16 * C * FE * 2, (size_t)C * FE * 2, (const unsigned*)(ws + WS_LIST), tab, G, bx};
            EpiDown E{(bf16*)(ws + WS_B2), (const unsigned*)(ws + WS_LIST)};
            pg8::gemm_phase<EpiDown, SchedMoe<4, FE, false>, true, false, FE>(lds, S, E, wave);
        }
        SEAM(pb + 2);
        if (layer == 0) {
            if (IN(PH_COMB)) { IDS(); combine_rows(ws, 0, gw, NGW, lane); }
            SEAM(PH_COMB);
            if (IN(PH_KVQ)) REP(PH_KVQ) {
                SchedGrouped<12, 1> S{(const char*)(ws + WS_B0), 0, nullptr, (const char*)(ws + WS_WT_KVQ), 0, G, bx};
                EpiSplit3 E{(bf16*)(ws + WS_B1), true};
                pg8::gemm_phase<EpiSplit3, SchedGrouped<12, 1>, true, false, C>(lds, S, E, wave);
            }
            SEAM(PH_KVQ);
            if (IN(PH_ATTN)) REP(PH_ATTN) { IDS(); attn_mfma(ws, lds, gw, NGW, lane, wave); }
            SEAM(PH_ATTN);
            if (IN(PH_SBO)) {
                SchedGrouped<4, 1> S{(const char*)(ws + WS_B0), 0, nullptr, (const char*)(ws + WS_WT_SBO), 0, G, bx};
                EpiResid E{OUTP(), OUTP()};
                pg8::gemm_phase<EpiResid, SchedGrouped<4, 1>, true, false, C>(lds, S, E, wave);
            }
            SEAM(PH_SBO);
        }
    }
    if (IN(PH_FINAL)) { IDS(); combine_rows(ws, 1, gw, NGW, lane); }
#undef IN
#undef SEAM
}

extern "C" void kernel_launch(void* const* d_in, const int* in_sizes, int n_in, void* d_out, int out_size, void* d_ws, size_t ws_size, hipStream_t stream) {
    static int grid = 0;
    if (grid == 0) {
        if (n_in != 31 || in_sizes[0] != M * C || out_size != M * C || ws_size < WS_END) { fprintf(stderr, "kernel_launch: unexpected shapes (n_in %d, in0 %d, out %d, ws %zu); nothing launched\n", n_in, n_in > 0 ? in_sizes[0] : -1, out_size, ws_size); grid = -1; return; }
        int dev = 0, cus = 0, per_cu = 0;
        if (hipGetDevice(&dev) != hipSuccess || hipDeviceGetAttribute(&cus, hipDeviceAttributeMultiprocessorCount, dev) != hipSuccess) { grid = -1; return; }
        if (hipFuncSetAttribute((const void*)yoco_fwd, hipFuncAttributeMaxDynamicSharedMemorySize, LDS_BYTES) != hipSuccess) { fprintf(stderr, "kernel_launch: hipFuncSetAttribute failed\n"); grid = -1; return; }
        if (hipOccupancyMaxActiveBlocksPerMultiprocessor(&per_cu, (const void*)yoco_fwd, NWAVES * 64, LDS_BYTES) != hipSuccess || per_cu < 1) fprintf(stderr, "kernel_launch: occupancy query reports %d\n", per_cu);
        (void)hipGetLastError();
        grid = cus - (cus % 16);
    }
    if (grid < 0) return;
    if (hipMemsetAsync((char*)d_ws + WS_CTL, 0, CTL_ZERO_BYTES, stream) != hipSuccess) return;
    Args a{};
    for (int i = 0; i < 31; ++i) a.in[i] = (const float*)d_in[i];
    a.out = (float*)d_out; a.ws = (unsigned char*)d_ws;
    for (int li = 0; li < (N_LAUNCHES == 1 ? 1 : (int)NPHASE); ++li) {
        a.ph_lo = (N_LAUNCHES == 1) ? 0 : li; a.ph_hi = (N_LAUNCHES == 1) ? NPHASE : li + 1; a.li = li;
        hipLaunchKernelGGL(yoco_fwd, dim3(grid), dim3(NWAVES * 64), LDS_BYTES, stream, a);
        const hipError_t le = hipPeekAtLastError();
        if (le != hipSuccess) { fprintf(stderr, "kernel_launch: launch %d failed: %s\n", li, hipGetErrorName(le)); break; }
    }
}
```

```cpp
#include <hip/hip_runtime.h>
#include <cstdio>
#include <cstdint>

#ifndef MK_N_LAUNCHES
#define MK_N_LAUNCHES 1
#endif

namespace pg8 {
#define PG8_LAS __attribute__((address_space(3)))
typedef unsigned short bf16_t;
typedef short bf16x8 __attribute__((ext_vector_type(8)));
typedef float f32x4 __attribute__((ext_vector_type(4)));
typedef unsigned u32x4 __attribute__((ext_vector_type(4)));
constexpr int BM = 256, BK = 64, HALF = 128, HTB = HALF * BK * 2, STAGE_BYTES = 8 * HTB, NXCD = 8, WGM = 8;

__host__ __device__ __forceinline__ int lds_byte(int r, int c) { const int st = (r >> 4) * 2 + (c >> 5), rr = r & 15, cc = c & 31, ob = rr * 64 + cc * 2; return st * 1024 + (ob ^ (((ob >> 9) & 1) << 5)); }
__host__ __device__ __forceinline__ void stage_rc(int b, int& R, int& C) { const int st = b / 1024, sb = b % 1024, swz = sb ^ (((sb >> 9) & 1) << 5); R = (st >> 1) * 16 + swz / 64; C = (st & 1) * 32 + (swz % 64) / 2; }
__host__ __device__ __forceinline__ int perm32(int rho) { const int n = rho >> 4, i = rho & 15; return 8 * (i >> 2) + 4 * n + (i & 3); }

struct Unit { int pm, pn, aux, r0, cnt; };

__host__ __device__ __forceinline__ void tile_map(int wgid, int nM, int nN, int& pm, int& pn) {
    const int nwg = nM * nN;
    { const int q = nwg / NXCD, r = nwg % NXCD, xcd = wgid % NXCD, off = wgid / NXCD; wgid = (xcd < r ? xcd * (q + 1) : r * (q + 1) + (xcd - r) * q) + off; }
    const int nig = WGM * nN, gid = wgid / nig, fm = gid * WGM, gsz = (nM - fm) < WGM ? (nM - fm) : WGM;
    pm = fm + ((wgid % nig) % gsz); pn = (wgid % nig) / gsz;
}

typedef float f32x2_t __attribute__((ext_vector_type(2))); typedef __bf16 bf16x2_t __attribute__((ext_vector_type(2)));
__device__ __forceinline__ unsigned cvt_pk_bf16(float lo, float hi) { const f32x2_t v = {lo, hi}; const bf16x2_t b = __builtin_convertvector(v, bf16x2_t); return __builtin_bit_cast(unsigned, b); }

template <class Epi, class Sched, bool ALIGN_EPI, bool GATHER, int K>
__device__ __forceinline__ void gemm_phase(PG8_LAS unsigned char* lds, const Sched& S, const Epi& E, const int wid) {
    int lane_; asm volatile("v_mbcnt_lo_u32_b32 %0, -1, 0\n\tv_mbcnt_hi_u32_b32 %0, -1, %0" : "=v"(lane_));
    const int lane = lane_, tid = wid * 64 + lane, wr = wid >> 2, wc = wid & 3, fr = lane & 15, fq = lane >> 4;
    constexpr int nt = K / BK;
    unsigned voffA[2], voffB[2];
#pragma unroll
    for (int i = 0; i < 2; ++i) { int R, C; stage_rc(tid * 16 + i * 8192, R, C); const int Rb = Epi::PERM ? ((R & ~31) + perm32(R & 31)) : R;
        voffA[i] = (unsigned)(R * K + C) * 2u; voffB[i] = (unsigned)(Rb * K + C) * 2u; }
    constexpr size_t kstep = (size_t)(BK * 2);
    constexpr size_t hstep = (size_t)HALF * K * 2;
    const unsigned ldsw = (unsigned)wid * 1024u;
    const int aoff = lds_byte(wr * 64 + fr, fq * 8), boff = lds_byte(wc * 32 + fr, fq * 8);
#define PG8_SA(b, h) (((b) * 2 + (h)) * HTB)
#define PG8_SB(b, h) ((4 + (b) * 2 + (h)) * HTB)
#define PG8_STAGE(bufoff, gbase, voff) do { _Pragma("unroll") for (int _i = 0; _i < 2; ++_i) \
        __builtin_amdgcn_global_load_lds((const unsigned*)((const char*)(gbase) + (voff)[_i]), (PG8_LAS unsigned*)(lds + (bufoff) + ldsw + _i * 8192), 16, 0, 0); } while (0)
#define PG8_LDA(dst, b, h) do { _Pragma("unroll") for (int m = 0; m < 4; ++m) _Pragma("unroll") for (int k = 0; k < 2; ++k) dst[m][k] = *(const PG8_LAS bf16x8*)(lds + PG8_SA(b, h) + aoff + m * 2048 + k * 1024); } while (0)
#define PG8_LDB(dst, b, h) do { _Pragma("unroll") for (int n = 0; n < 2; ++n) _Pragma("unroll") for (int k = 0; k < 2; ++k) dst[n][k] = *(const PG8_LAS bf16x8*)(lds + PG8_SB(b, h) + boff + n * 2048 + k * 1024); } while (0)
#define PG8_MMA(ai, bj, At, Bt) do { __builtin_amdgcn_s_setprio(1); _Pragma("unroll") for (int m = 0; m < 4; ++m) _Pragma("unroll") for (int n = 0; n < 2; ++n) _Pragma("unroll") for (int k = 0; k < 2; ++k) \
        acc[ai][bj][m][n] = __builtin_amdgcn_mfma_f32_16x16x32_bf16(Bt[n][k], At[m][k], acc[ai][bj][m][n], 0, 0, 0); __builtin_amdgcn_s_setprio(0); } while (0)
#define PG8_WAIT_V(n) asm volatile("s_waitcnt vmcnt(" #n ")" ::: "memory")
#define PG8_WAIT_L(n) asm volatile("s_waitcnt lgkmcnt(" #n ")" ::: "memory")
#define PG8_BAR __builtin_amdgcn_s_barrier()
#define PG8_SCHED __builtin_amdgcn_sched_barrier(0)
    Unit cur, nxt; int ui = 0;
    if (!S.next(0, cur)) return;
    f32x4 acc[2][2][4][2];
#pragma unroll
    for (int a = 0; a < 2; ++a)
#pragma unroll
        for (int b = 0; b < 2; ++b)
#pragma unroll
            for (int m = 0; m < 4; ++m)
#pragma unroll
                for (int n = 0; n < 2; ++n) acc[a][b][m][n] = (f32x4){0.f, 0.f, 0.f, 0.f};
    bf16x8 At[4][2], B0[2][2], B1[2][2];
    unsigned vc[2][2];
#define PG8_GOFF(u) do { _Pragma("unroll") for (int _h = 0; _h < 2; ++_h) _Pragma("unroll") for (int _i = 0; _i < 2; ++_i) { int _R, _C; stage_rc(tid * 16 + _i * 8192, _R, _C); \
        vc[_h][_i] = S.a_row_off(u, _h * HALF + _R) + (unsigned)_C * 2u; } } while (0)
#define PG8_STAGE_A(bufoff, gbase, h) do { if constexpr (GATHER) { PG8_STAGE(bufoff, gbase, vc[h]); } else { PG8_STAGE(bufoff, (gbase) + (h) * hstep, voffA); } } while (0)
    if constexpr (GATHER) PG8_GOFF(cur);
    const char* cA = S.a_base(cur); const char* cB = S.b_base(cur);
    PG8_STAGE(PG8_SB(0, 0), cB, voffB); PG8_STAGE(PG8_SB(0, 1), cB + hstep, voffB); PG8_STAGE_A(PG8_SA(0, 0), cA, 0); PG8_STAGE_A(PG8_SA(0, 1), cA, 1);
    if (wr == 1) PG8_BAR;
    PG8_WAIT_V(2); PG8_BAR;
    PG8_STAGE(PG8_SB(1, 0), cB + kstep, voffB); PG8_STAGE_A(PG8_SA(1, 0), cA + kstep, 0); PG8_STAGE(PG8_SB(1, 1), cB + hstep + kstep, voffB);
    PG8_WAIT_V(6); PG8_BAR;
    for (;;) {
        const bool has_next = S.next(ui + 1, nxt);
        const char* nA = has_next ? S.a_base(nxt) : cA; const char* nB = has_next ? S.b_base(nxt) : cB;
        for (int t = 0; t < nt; t += 2) {
            const bool last = (t == nt - 2);
            const char* a1 = cA + (size_t)(t + 1) * kstep;
            const char* a2 = last ? nA : cA + (size_t)(t + 2) * kstep; const char* b2 = last ? nB : cB + (size_t)(t + 2) * kstep;
            const char* a3 = a2 + kstep; const char* b3 = b2 + kstep;
            PG8_LDB(B0, 0, 0); PG8_LDB(B1, 0, 1); PG8_SCHED; PG8_LDA(At, 0, 0); PG8_STAGE_A(PG8_SA(1, 1), a1, 1);
            if constexpr (GATHER) { if (last && has_next) PG8_GOFF(nxt); }
            PG8_WAIT_V(8); PG8_WAIT_L(0); PG8_BAR; PG8_MMA(0, 0, At, B0); PG8_MMA(0, 1, At, B1); PG8_BAR; PG8_SCHED;
            PG8_LDA(At, 0, 1); PG8_STAGE(PG8_SB(0, 0), b2, voffB); PG8_STAGE(PG8_SB(0, 1), b2 + hstep, voffB); PG8_STAGE_A(PG8_SA(0, 0), a2, 0);
            PG8_WAIT_V(8); PG8_WAIT_L(0); PG8_BAR; PG8_MMA(1, 0, At, B0); PG8_MMA(1, 1, At, B1); PG8_BAR; PG8_SCHED;
            PG8_LDB(B0, 1, 0); PG8_LDB(B1, 1, 1); PG8_SCHED; PG8_LDA(At, 1, 0); PG8_STAGE_A(PG8_SA(0, 1), a2, 1);
            PG8_WAIT_V(8); PG8_WAIT_L(0); PG8_BAR; PG8_MMA(0, 0, At, B0); PG8_MMA(0, 1, At, B1); PG8_BAR; PG8_SCHED;
            PG8_LDA(At, 1, 1); PG8_STAGE(PG8_SB(1, 0), b3, voffB); PG8_STAGE(PG8_SB(1, 1), b3 + hstep, voffB); PG8_STAGE_A(PG8_SA(1, 0), a3, 0);
            PG8_WAIT_V(8); PG8_WAIT_L(0); PG8_BAR; PG8_MMA(1, 0, At, B0); PG8_MMA(1, 1, At, B1); PG8_BAR; PG8_SCHED;
        }
        if constexpr (ALIGN_EPI) { if (wr == 0) PG8_BAR; }
        E(acc, cur, wr, wc, fr, fq);
        if (!has_next) break;
#pragma unroll
        for (int a = 0; a < 2; ++a)
#pragma unroll
            for (int b = 0; b < 2; ++b)
#pragma unroll
                for (int m = 0; m < 4; ++m)
#pragma unroll
                    for (int n = 0; n < 2; ++n) acc[a][b][m][n] = (f32x4){0.f, 0.f, 0.f, 0.f};
        cur = nxt; cA = nA; cB = nB; ++ui;
        if constexpr (ALIGN_EPI) { if (wr == 1) PG8_BAR; }
    }
    PG8_WAIT_V(0);
    if constexpr (!ALIGN_EPI) { if (wr == 0) PG8_BAR; }
    PG8_BAR;
#undef PG8_SA
#undef PG8_SB
#undef PG8_STAGE
#undef PG8_STAGE_A
#undef PG8_GOFF
#undef PG8_LDA
#undef PG8_LDB
#undef PG8_MMA
#undef PG8_WAIT_V
#undef PG8_WAIT_L
#undef PG8_BAR
#undef PG8_SCHED
}
}

constexpr int NWAVES = 8;
#ifndef MK_DEBUG
#define MK_DEBUG 0
#endif
#ifndef DBG_USE_NAIVE
#define DBG_USE_NAIVE 0
#endif
constexpr int DBGP = MK_DEBUG ? 3 : 0;
enum Phase { PH_P0 = 0, PH_LORA, PH_RKV, PH_S1, PH_S2, PH_S3, PH_DBG0, PH_WOUT = PH_DBG0 + DBGP, PH_ROUT0, PH_GU0, PH_DN0, PH_COMB, PH_KVQ, PH_ATTN, PH_SBO, PH_ROUT1, PH_GU1, PH_DN1, PH_FINAL, NPHASE };
constexpr int N_LAUNCHES = MK_N_LAUNCHES;


constexpr int BATCH = 2, SEQ = 8192, C = 1024, NH = 16, HD = 64, M = BATCH * SEQ;
constexpr int NE = 16, FE = 256, DW = 64, DA = 64, DG = 160;
constexpr float RMS_EPS = 1e-6f, GN_EPS = 64e-5f;
constexpr float SB_EXIT = 104.0f;

constexpr size_t MiB = 1u << 20;
constexpr size_t WS_CTL = 0, CTL_ZERO_BYTES = 64 * 1024;
constexpr size_t WS_WT_W2 = 128 * 1024, WS_WT_A2 = 256 * 1024, WS_WT_G2 = 384 * 1024;
constexpr size_t WS_WT_RKV = 1 * MiB;
constexpr size_t WS_WT_LORA = 7 * MiB;
constexpr size_t WS_WT_OUT = 9 * MiB;
constexpr size_t WS_WT_KVQ = 11 * MiB;
constexpr size_t WS_WT_SBO = 17 * MiB;
constexpr size_t WS_WT_GU = 19 * MiB;
constexpr size_t WS_WT_DN = 51 * MiB;
constexpr size_t WS_LW = 67 * MiB;
constexpr size_t WS_LA = 69 * MiB;
constexpr size_t WS_LG = 71 * MiB;
static_assert(WS_LA == WS_LW + 2 * MiB && WS_LG == WS_LW + 4 * MiB, "EpiLora's pointer arithmetic");
constexpr size_t WS_LIST = 76 * MiB;
constexpr size_t WS_WL = 77 * MiB;
constexpr size_t WS_HID = 78 * MiB;
constexpr size_t WS_B0 = 96 * MiB, WS_B1 = 128 * MiB, WS_B2 = 160 * MiB, WS_B3 = 192 * MiB, WS_B4 = 224 * MiB, WS_END = 256 * MiB;
static_assert(WS_HID + (size_t)144 * 256 * 256 * 2 <= WS_B0, "HID vs B0");
constexpr int CW_TMO = 0;
constexpr int CW_CNT = 1024;
constexpr int CW_BAR = 4096;

constexpr int RING_BYTES = 131072;
constexpr int LDSCTL_OFF = 146688, MISC_OFF = LDSCTL_OFF + 320, MOE_TAB_OFF = MISC_OFF + 128;
constexpr int LDS_BYTES = 147456;
static_assert(MOE_TAB_OFF + 256 <= LDS_BYTES, "LDS map");
static_assert(BATCH * NH * (SEQ / 64) % 16 == 0, "scan units");

#define GAS __attribute__((address_space(1)))
#define LAS __attribute__((address_space(3)))
typedef unsigned short bf16;
typedef unsigned v4u __attribute__((ext_vector_type(4)));
typedef unsigned v2u __attribute__((ext_vector_type(2)));
typedef float f32x4 __attribute__((ext_vector_type(4)));
typedef GAS unsigned gu32;
#define RLX_AGENT __ATOMIC_RELAXED, __HIP_MEMORY_SCOPE_AGENT
#define LDS_WAIT() asm volatile("s_waitcnt lgkmcnt(0)" ::: "memory")
#define VM_WAIT() asm volatile("s_waitcnt vmcnt(0)" ::: "memory")
__device__ __forceinline__ unsigned f2bf(float f) { unsigned u = __builtin_bit_cast(unsigned, f); return (u + 0x7fffu + ((u >> 16) & 1u)) >> 16; }
__device__ __forceinline__ unsigned pk2(float lo, float hi) { return f2bf(lo) | (f2bf(hi) << 16); }
__device__ __forceinline__ float bflo(unsigned u) { return __uint_as_float(u << 16); }
__device__ __forceinline__ float bfhi(unsigned u) { return __uint_as_float(u & 0xffff0000u); }
__device__ __forceinline__ float bf2f(bf16 b) { return __uint_as_float((unsigned)b << 16); }
__device__ __forceinline__ float sigmoidf_(float x) { return 1.0f / (1.0f + __expf(-x)); }

#define XB_TMO      128
#define XB_XCNT(j)  (256  + 64 * (j))
#define XB_XSUB(j)  (1280 + 64 * (j))
#define XB_XGEN(j)  (2304 + 64 * (j))
#define XB_TOP      3328
#define XB_TOPGEN   3392
#define XCD_BAR_WORDS 3456
#define XB_SPIN_CAP (1u << 18)
__device__ __forceinline__ unsigned xb_ld(unsigned* p)              { return __hip_atomic_load(p, __ATOMIC_RELAXED, __HIP_MEMORY_SCOPE_AGENT); }
__device__ __forceinline__ unsigned xb_add(unsigned* p, unsigned v) { return __hip_atomic_fetch_add(p, v, __ATOMIC_RELAXED, __HIP_MEMORY_SCOPE_AGENT); }
__device__ __forceinline__ unsigned xb_xcc_id() { return (unsigned)__builtin_amdgcn_s_getreg((3 << 11) | 20) & 0xFu; }
#define XB_SPIN(cond, bar) do { unsigned _sp = 0; while (cond) { __builtin_amdgcn_s_sleep(1); \
    if ((++_sp & 255u) == 0u) { if (xb_ld(&(bar)[XB_TMO])) break; if (_sp > XB_SPIN_CAP) { atomicAdd(&(bar)[XB_TMO], 1u); break; } } } } while (0)
struct XcdBarrier { unsigned* bar; unsigned x; volatile LAS unsigned* st; };
__device__ __forceinline__ XcdBarrier xcd_barrier_post(unsigned* bar, volatile LAS unsigned* st) {
    XcdBarrier b; b.bar = bar; b.x = xb_xcc_id(); b.st = st;
    if (threadIdx.x == 0) (void)xb_add(&bar[XB_XCNT(b.x)], 1u);
    return b;
}
__device__ __forceinline__ void xcd_barrier_complete(unsigned* bar, unsigned x, unsigned& nloc, unsigned& nx) {
    const unsigned G = gridDim.x * gridDim.y * gridDim.z;
    unsigned sum, cnt, mine, sp = 0u;
    for (;;) {
        sum = 0u; cnt = 0u; mine = 0u;
#pragma unroll
        for (unsigned j = 0; j < 16; ++j) { const unsigned c = xb_ld(&bar[XB_XCNT(j)]); sum += c; cnt += (c > 0u) ? 1u : 0u; mine = (j == x) ? c : mine; }
        if (sum == G) break;
        __builtin_amdgcn_s_sleep(1);
        if ((++sp & 255u) == 0u) { if (xb_ld(&bar[XB_TMO])) break; if (sp > XB_SPIN_CAP) { atomicAdd(&bar[XB_TMO], 1u); break; } }
    }
    nloc = mine > 0u ? mine : 1u; nx = cnt > 0u ? cnt : 1u;
}
__device__ __forceinline__ void xcd_barrier(const XcdBarrier& b) {
    asm volatile("s_waitcnt vmcnt(0)" ::: "memory");
    __syncthreads();
    if (threadIdx.x == 0) {
        unsigned* bar = b.bar;
        __builtin_amdgcn_s_waitcnt(0);
        unsigned nloc = b.st[0], nx = b.st[1];
        if (nloc == 0u) { xcd_barrier_complete(bar, b.x, nloc, nx); b.st[0] = nloc; b.st[1] = nx; }
        const unsigned old = xb_add(&bar[XB_XSUB(b.x)], 1u);
        const unsigned gen = old / nloc;
        if (old + 1u == (gen + 1u) * nloc) {
            __builtin_amdgcn_fence(__ATOMIC_RELEASE, "agent");
            asm volatile("s_waitcnt vmcnt(0)" ::: "memory");
            const unsigned og = xb_add(&bar[XB_TOP], 1u);
            const unsigned tg = og / nx;
            if (og + 1u == (tg + 1u) * nx) xb_add(&bar[XB_TOPGEN], 1u);
            else XB_SPIN(xb_ld(&bar[XB_TOPGEN]) == tg, bar);
            __builtin_amdgcn_fence(__ATOMIC_ACQUIRE, "agent");
            xb_add(&bar[XB_XGEN(b.x)], 1u);
            asm volatile("s_waitcnt vmcnt(0)" ::: "memory");
        } else {
            XB_SPIN(xb_ld(&bar[XB_XGEN(b.x)]) == gen, bar);
            __builtin_amdgcn_fence(__ATOMIC_ACQUIRE, "agent");
            asm volatile("s_waitcnt vmcnt(0)" ::: "memory");
        }
    }
    __syncthreads();
}

__device__ __forceinline__ float shx(float v, int o, int lane) { return __int_as_float(__builtin_amdgcn_ds_bpermute((lane ^ o) << 2, __float_as_int(v))); }
__device__ __forceinline__ float wave_sum(float v, int lane) {
#pragma unroll
    for (int o = 1; o < 64; o <<= 1) v += shx(v, o, lane);
    return v;
}
__device__ __forceinline__ void transpose_item(const float* W, int ldw, int k0, int n0, bf16* WT, int ldk, int dst_row0, const float* kscale, LAS float* scr, int lane, int kmax = 1 << 30) {
    const int r8 = lane >> 3, quad = lane & 7;
    f32x4 v[8];
#pragma unroll
    for (int i = 0; i < 8; ++i) { const int kk = r8 + 8 * i; v[i] = (k0 + kk < kmax) ? *(const GAS f32x4*)(W + (size_t)(k0 + kk) * ldw + n0 + quad * 4) : (f32x4){0.f, 0.f, 0.f, 0.f}; }
#pragma unroll
    for (int i = 0; i < 8; ++i) { const int kk = r8 + 8 * i; if (kscale) v[i] = v[i] * kscale[(k0 + kk < kmax) ? k0 + kk : 0]; *(LAS f32x4*)(scr + kk * 36 + ((quad ^ i) << 2)) = v[i]; }
    LDS_WAIT(); asm volatile("" ::: "memory");
    const int c = lane & 7;
#pragma unroll
    for (int j = 0; j < 4; ++j) { const int n = (lane >> 3) + 8 * j; const LAS float* sp = scr + (8 * c) * 36 + ((((n >> 2) ^ c) << 2) | (n & 3));
        v4u o; o.x = pk2(sp[0 * 36], sp[1 * 36]); o.y = pk2(sp[2 * 36], sp[3 * 36]); o.z = pk2(sp[4 * 36], sp[5 * 36]); o.w = pk2(sp[6 * 36], sp[7 * 36]);
        if (k0 + 8 * c < kmax) *(GAS v4u*)(WT + (size_t)(dst_row0 + n) * ldk + k0 + 8 * c) = o; }
    LDS_WAIT(); asm volatile("" ::: "memory");
}

struct Args { const float* in[31]; float* out; unsigned char* ws; int ph_lo, ph_hi, li, pad; };
typedef const __attribute__((address_space(4))) unsigned char* kaptr_t;
__device__ __forceinline__ kaptr_t ka_base() { kaptr_t p = (kaptr_t)__builtin_amdgcn_kernarg_segment_ptr(); asm volatile("" : "+s"(p)); return p; }
#define INP(k) (*(const float* const __attribute__((address_space(4)))*)(ka_base() + 8 * (k)))
#define OUTP() (*(float* const __attribute__((address_space(4)))*)(ka_base() + 8 * 31))
#define WSP() (*(unsigned char* const __attribute__((address_space(4)))*)(ka_base() + 8 * 32))
#define KA_INT(i) (*(const int __attribute__((address_space(4)))*)(ka_base() + 8 * 33 + 4 * (i)))

template <int PART> __device__ __forceinline__ void p0_weights(unsigned char* ws, LAS unsigned char* lds, int gw, int NGW, int wave, int lane) {
    LAS float* scr = (LAS float*)(lds + wave * 16384);
    bf16* WT_RKV = (bf16*)(ws + WS_WT_RKV); bf16* WT_LORA = (bf16*)(ws + WS_WT_LORA); bf16* WT_OUT = (bf16*)(ws + WS_WT_OUT); bf16* WT_KVQ = (bf16*)(ws + WS_WT_KVQ);
    bf16* WT_SBO = (bf16*)(ws + WS_WT_SBO); bf16* WT_GU = (bf16*)(ws + WS_WT_GU); bf16* WT_DN = (bf16*)(ws + WS_WT_DN);
    constexpr int I_UP = 32 + 32 + 96, I_RKV = 3 * 512, I_LORA = 32 + 32 + 80, I_OUT = 512, I_KV = 1024, I_Q = 512, I_SBO = 512, I_G = 32 * 128, I_U = 32 * 128, I_D = 32 * 128;
    constexpr int NDENSE = I_UP + I_RKV + I_LORA + I_OUT + I_KV + I_Q + I_SBO, NITEMS = NDENSE + I_G + I_U + I_D;
    for (int it = (PART == 0 ? 0 : NDENSE) + gw; it < (PART == 0 ? NDENSE : NITEMS); it += NGW) {
        int r = it;
        if (r < I_UP) {
            if (r < 32) transpose_item(INP(9), C, 0, 32 * r, (bf16*)(ws + WS_WT_W2), 64, 32 * r, nullptr, scr, lane);
            else if (r < 64) transpose_item(INP(12), C, 0, 32 * (r - 32), (bf16*)(ws + WS_WT_A2), 64, 32 * (r - 32), nullptr, scr, lane);
            else { const int q = r - 64, kb = q / 32, nb = q % 32; transpose_item(INP(14), C, 64 * kb, 32 * nb, (bf16*)(ws + WS_WT_G2), DG, 32 * nb, nullptr, scr, lane, DG); }
            continue; } r -= I_UP;
        if (r < I_RKV) { const int m = r / 512, q = r % 512, kb = q / 32, nb = q % 32; transpose_item(INP(6) + (size_t)m * C * C, C, 64 * kb, 32 * nb, WT_RKV, C, m * C + 32 * nb, nullptr, scr, lane); continue; } r -= I_RKV;
        if (r < I_LORA) {
            if (r < 32) { const int kb = r / 2, nb = r % 2; transpose_item(INP(8), DW, 64 * kb, 32 * nb, WT_LORA, C, 32 * nb, nullptr, scr, lane); }
            else if (r < 64) { const int q = r - 32, kb = q / 2, nb = q % 2; transpose_item(INP(11), DA, 64 * kb, 32 * nb, WT_LORA, C, 256 + 32 * nb, nullptr, scr, lane); }
            else { const int q = r - 64, kb = q / 5, nb = q % 5; transpose_item(INP(13), DG, 64 * kb, 32 * nb, WT_LORA, C, 512 + 32 * nb, nullptr, scr, lane); }
            continue; } r -= I_LORA;
        if (r < I_OUT) { const int kb = r / 32, nb = r % 32; transpose_item(INP(20), C, 64 * kb, 32 * nb, WT_OUT, C, 32 * nb, nullptr, scr, lane); continue; } r -= I_OUT;
        if (r < I_KV) { const int kb = r / 64, nb = r % 64; transpose_item(INP(21), 2 * C, 64 * kb, 32 * nb, WT_KVQ, C, 32 * nb, INP(3), scr, lane); continue; } r -= I_KV;
        if (r < I_Q) { const int kb = r / 32, nb = r % 32; transpose_item(INP(22), C, 64 * kb, 32 * nb, WT_KVQ, C, 2 * C + 32 * nb, INP(1) + C, scr, lane); continue; } r -= I_Q;
        if (r < I_SBO) { const int kb = r / 32, nb = r % 32; transpose_item(INP(23), C, 64 * kb, 32 * nb, WT_SBO, C, 32 * nb, nullptr, scr, lane); continue; } r -= I_SBO;
        if (r < I_G) { const int le = r / 128, q = r % 128, kb = q / 8, nb = q % 8, f0 = 32 * nb; transpose_item(INP(28) + (size_t)le * C * FE, FE, 64 * kb, f0, WT_GU + (size_t)le * 512 * C, C, 256 * (f0 / 128) + (f0 % 128), nullptr, scr, lane); continue; } r -= I_G;
        if (r < I_U) { const int le = r / 128, q = r % 128, kb = q / 8, nb = q % 8, f0 = 32 * nb; transpose_item(INP(29) + (size_t)le * C * FE, FE, 64 * kb, f0, WT_GU + (size_t)le * 512 * C, C, 256 * (f0 / 128) + 128 + (f0 % 128), nullptr, scr, lane); continue; } r -= I_U;
        { const int le = r / 128, q = r % 128, kb = q / 32, nb = q % 32; transpose_item(INP(30) + (size_t)le * FE * C, C, 64 * kb, 32 * nb, WT_DN + (size_t)le * C * FE, FE, 32 * nb, nullptr, scr, lane); }
    }
    if (PART == 0) for (int it = gw * 64 + lane; it < 768 * 128; it += NGW * 64) { const int row = it >> 7, ch = it & 127;
        const bool valid = (row < 64) || (row >= 256 && row < 320) || (row >= 512 && row < 672);
        if (!valid) *(GAS v4u*)(WT_LORA + (size_t)row * C + ch * 8) = (v4u){0u, 0u, 0u, 0u}; }
}
__device__ __forceinline__ void load_row(const float* p, int lane, f32x4 (&v)[4]) {
#pragma unroll
    for (int j = 0; j < 4; ++j) v[j] = ((const GAS f32x4*)p)[64 * j + lane];
}
__device__ __forceinline__ float row_rs(const f32x4 (&v)[4], int lane) {
    float s = 0.f;
#pragma unroll
    for (int j = 0; j < 4; ++j) s += (v[j].x * v[j].x + v[j].y * v[j].y) + (v[j].z * v[j].z + v[j].w * v[j].w);
    return 1.0f / sqrtf(wave_sum(s, lane) * (1.0f / C) + RMS_EPS);
}
__device__ __forceinline__ void store_row_bf16(bf16* p, int lane, const f32x4 (&v)[4]) {
#pragma unroll
    for (int j = 0; j < 4; ++j) { v2u o; o.x = pk2(v[j].x, v[j].y); o.y = pk2(v[j].z, v[j].w); ((GAS v2u*)p)[64 * j + lane] = o; }
}
__device__ __forceinline__ void p0_rows(unsigned char* ws, int gw, int NGW, int lane) {
    const float* x = INP(0); const float* gain = INP(1); const float* mix = INP(5);
    f32x4 g[4]; load_row(gain, lane, g);
    for (int run = gw; run < M / 8; run += NGW) {
        const int r0 = run * 8;
        f32x4 prev[4];
        if ((r0 % SEQ) == 0) {
#pragma unroll
            for (int j = 0; j < 4; ++j) prev[j] = (f32x4){0.f, 0.f, 0.f, 0.f};
        } else { load_row(x + (size_t)(r0 - 1) * C, lane, prev); const float rs = row_rs(prev, lane);
#pragma unroll
            for (int j = 0; j < 4; ++j) prev[j] = prev[j] * rs * g[j]; }
        for (int rr = 0; rr < 8; ++rr) {
            const int row = r0 + rr;
            f32x4 hn[4]; load_row(x + (size_t)row * C, lane, hn); const float rs = row_rs(hn, lane);
#pragma unroll
            for (int j = 0; j < 4; ++j) hn[j] = hn[j] * rs * g[j];
#pragma unroll
            for (int i = 0; i < 6; ++i) { f32x4 o[4];
#pragma unroll
                for (int j = 0; j < 4; ++j) { const f32x4 mx = ((const GAS f32x4*)(mix + i * C))[64 * j + lane]; o[j] = hn[j] + (prev[j] - hn[j]) * mx; }
                bf16* dst = i < 2 ? (bf16*)OUTP() + (size_t)i * M * C : (i == 2 ? (bf16*)(ws + WS_B4) : (bf16*)(ws + WS_B1) + (size_t)(i - 3) * M * C);
                store_row_bf16(dst + (size_t)row * C, lane, o); }
#pragma unroll
            for (int j = 0; j < 4; ++j) prev[j] = hn[j];
        }
    }
}

template <int NN, int NGROUPS> struct SchedGrouped {
    static constexpr int K = C;
    const char* A0; size_t astride; const char* A2; const char* B; size_t bgroup;
    int G, c;
    __device__ __forceinline__ bool next(int i, pg8::Unit& u) const {
        const int L = i * G + c; constexpr int per = 64 * NN; if (L >= per * NGROUPS) return false;
        const int g = L / per, w = L % per; pg8::tile_map(w, 64, NN, u.pm, u.pn); u.aux = g; u.r0 = 0; u.cnt = 0; return true; }
    __device__ __forceinline__ const char* a_base(const pg8::Unit& u) const { const char* A = (A2 != nullptr && u.aux == 2) ? A2 : A0 + (size_t)u.aux * astride; return A + (size_t)u.pm * 256 * K * 2; }
    __device__ __forceinline__ const char* b_base(const pg8::Unit& u) const { return B + (size_t)u.aux * bgroup + (size_t)u.pn * 256 * K * 2; }
    __device__ __forceinline__ unsigned a_row_off(const pg8::Unit&, int) const { return 0u; }
};
template <int NN, int K, bool GATHER> struct SchedMoe {
    const char* A; const char* B; size_t bexp; const unsigned* list; volatile LAS int* tab; int G, c;
    __device__ __forceinline__ bool next(int i, pg8::Unit& u) const {
        const int L = i * G + c; const int tot = __builtin_amdgcn_readfirstlane(tab[48]) * NN; if (L >= tot) return false;
        u.pm = L / NN; u.pn = L % NN; int e = 0;
#pragma unroll
        for (int j = 0; j < 16; ++j) e += (u.pm >= tab[32 + j]) ? 1 : 0;
        e = __builtin_amdgcn_readfirstlane(e);
        u.aux = e; u.r0 = (u.pm - __builtin_amdgcn_readfirstlane(tab[16 + e])) * 256; u.cnt = __builtin_amdgcn_readfirstlane(tab[e]); return true; }
    __device__ __forceinline__ const char* a_base(const pg8::Unit& u) const { return GATHER ? A : A + (size_t)u.pm * 256 * K * 2; }
    __device__ __forceinline__ const char* b_base(const pg8::Unit& u) const { return B + (size_t)u.aux * bexp + (size_t)u.pn * 256 * K * 2; }
    __device__ __forceinline__ unsigned a_row_off(const pg8::Unit& u, int r) const {
        const int idx = u.r0 + r; unsigned tok = 0u;
        if (idx < u.cnt) tok = list[(size_t)u.aux * M + idx] >> 1;
        return tok * (unsigned)(K * 2); }
};

using pg8::f32x4;
using pg8::Unit;
__device__ __forceinline__ v4u pack8(f32x4 v0, f32x4 v1) { v4u w; w.x = pg8::cvt_pk_bf16(v0[0], v0[1]); w.y = pg8::cvt_pk_bf16(v0[2], v0[3]); w.z = pg8::cvt_pk_bf16(v1[0], v1[1]); w.w = pg8::cvt_pk_bf16(v1[2], v1[3]); return w; }

struct EpiLora {
    static constexpr bool PERM = true;
    bf16* LW;
    __device__ __forceinline__ void operator()(const f32x4 (&acc)[2][2][4][2], const Unit& u, int wr, int wc, int fr, int fq) const {
        { int l_; asm volatile("v_mbcnt_lo_u32_b32 %0, -1, 0\n\tv_mbcnt_hi_u32_b32 %0, -1, %0" : "=v"(l_)); fr = l_ & 15; fq = l_ >> 4; }
        const int g = u.aux, width = g == 2 ? DG : DW; bf16* out = LW + (size_t)g * (1u << 20);
        const int row0 = u.pm * 256 + wr * 64 + fr;
#pragma unroll
        for (int bj = 0; bj < 2; ++bj) { const int col0 = bj * 128 + wc * 32 + 8 * fq; if (col0 < width) {
#pragma unroll
            for (int ai = 0; ai < 2; ++ai)
#pragma unroll
                for (int m = 0; m < 4; ++m) { f32x4 v0 = acc[ai][bj][m][0], v1 = acc[ai][bj][m][1];
                    if (g == 0) {
#pragma unroll
                        for (int q = 0; q < 4; ++q) { v0[q] = tanhf(v0[q]); v1[q] = tanhf(v1[q]); } }
                    else if (g == 2) {
#pragma unroll
                        for (int q = 0; q < 4; ++q) { v0[q] = sigmoidf_(v0[q]); v1[q] = sigmoidf_(v1[q]); } }
                    *(GAS v4u*)(out + (size_t)(row0 + ai * 128 + m * 16) * width + col0) = pack8(v0, v1); } } }
    }
};
struct EpiSplit3 {
    static constexpr bool PERM = true;
    bf16* O0; bool bycol;
    __device__ __forceinline__ void operator()(const f32x4 (&acc)[2][2][4][2], const Unit& u, int wr, int wc, int fr, int fq) const {
        { int l_; asm volatile("v_mbcnt_lo_u32_b32 %0, -1, 0\n\tv_mbcnt_hi_u32_b32 %0, -1, %0" : "=v"(l_)); fr = l_ & 15; fq = l_ >> 4; }
        const int g = bycol ? (u.pn >> 2) : u.aux, pn = bycol ? (u.pn & 3) : u.pn; bf16* out = O0 + (size_t)g * ((size_t)M * C);
        const int row0 = u.pm * 256 + wr * 64 + fr, col0 = pn * 256 + wc * 32 + 8 * fq;
#pragma unroll
        for (int ai = 0; ai < 2; ++ai)
#pragma unroll
            for (int m = 0; m < 4; ++m)
#pragma unroll
                for (int bj = 0; bj < 2; ++bj) *(GAS v4u*)(out + (size_t)(row0 + ai * 128 + m * 16) * C + col0 + bj * 128) = pack8(acc[ai][bj][m][0], acc[ai][bj][m][1]);
    }
};
struct EpiResid {
    static constexpr bool PERM = false;
    const float* base; float* out;
    __device__ __forceinline__ void operator()(const f32x4 (&acc)[2][2][4][2], const Unit& u, int wr, int wc, int fr, int fq) const {
        { int l_; asm volatile("v_mbcnt_lo_u32_b32 %0, -1, 0\n\tv_mbcnt_hi_u32_b32 %0, -1, %0" : "=v"(l_)); fr = l_ & 15; fq = l_ >> 4; }
        const int row0 = u.pm * 256 + wr * 64 + fr, col0 = u.pn * 256 + wc * 32 + 4 * fq;
#pragma unroll
        for (int ai = 0; ai < 2; ++ai)
#pragma unroll
            for (int m = 0; m < 4; ++m) { const size_t off = (size_t)(row0 + ai * 128 + m * 16) * C + col0;
#pragma unroll
                for (int bj = 0; bj < 2; ++bj)
#pragma unroll
                    for (int n = 0; n < 2; ++n) { const f32x4 b = *(const GAS f32x4*)(base + off + bj * 128 + n * 16); *(GAS f32x4*)(out + off + bj * 128 + n * 16) = b + acc[ai][bj][m][n]; } }
    }
};
struct EpiGU {
    static constexpr bool PERM = true;
    bf16* HID; const float* wl;
    __device__ __forceinline__ void operator()(const f32x4 (&acc)[2][2][4][2], const Unit& u, int wr, int wc, int fr, int fq) const {
        { int l_; asm volatile("v_mbcnt_lo_u32_b32 %0, -1, 0\n\tv_mbcnt_hi_u32_b32 %0, -1, %0" : "=v"(l_)); fr = l_ & 15; fq = l_ >> 4; }
        const int e = u.aux, cnt = u.cnt, base = u.r0, r0 = wr * 64 + fr, col0 = u.pn * 128 + wc * 32 + 8 * fq;
#pragma unroll
        for (int ai = 0; ai < 2; ++ai)
#pragma unroll
            for (int m = 0; m < 4; ++m) { const int r = r0 + ai * 128 + m * 16, idx = base + r; float w = 0.f; if (idx < cnt) w = wl[(size_t)e * M + idx];
                f32x4 h0, h1;
#pragma unroll
                for (int q = 0; q < 4; ++q) { const float g0 = acc[ai][0][m][0][q], g1 = acc[ai][0][m][1][q];
                    h0[q] = g0 * sigmoidf_(g0) * acc[ai][1][m][0][q] * w; h1[q] = g1 * sigmoidf_(g1) * acc[ai][1][m][1][q] * w; }
                *(GAS v4u*)(HID + (size_t)(u.pm * 256 + r) * FE + col0) = pack8(h0, h1);
                asm volatile("" ::: "memory"); }
    }
};
struct EpiDown {
    static constexpr bool PERM = true;
    bf16* EO; const unsigned* list;
    __device__ __forceinline__ void operator()(const f32x4 (&acc)[2][2][4][2], const Unit& u, int wr, int wc, int fr, int fq) const {
        { int l_; asm volatile("v_mbcnt_lo_u32_b32 %0, -1, 0\n\tv_mbcnt_hi_u32_b32 %0, -1, %0" : "=v"(l_)); fr = l_ & 15; fq = l_ >> 4; }
        const int e = u.aux, cnt = u.cnt, base = u.r0, r0 = wr * 64 + fr, col0 = u.pn * 256 + wc * 32 + 8 * fq;
#pragma unroll
        for (int ai = 0; ai < 2; ++ai)
#pragma unroll
            for (int m = 0; m < 4; ++m) { const int idx = base + r0 + ai * 128 + m * 16;
                if (idx < cnt) { const unsigned ent = list[(size_t)e * M + idx]; bf16* o = EO + ((size_t)(ent & 1u) * M + (ent >> 1)) * C + col0;
#pragma unroll
                    for (int bj = 0; bj < 2; ++bj) *(GAS v4u*)(o + bj * 128) = pack8(acc[ai][bj][m][0], acc[ai][bj][m][1]); }
                asm volatile("" ::: "memory"); }
    }
};

typedef short bf16x8s __attribute__((ext_vector_type(8)));
typedef short bf16x4s __attribute__((ext_vector_type(4)));
typedef short v4i16_t __attribute__((ext_vector_type(4)));
constexpr int TPB = 144;
constexpr int TILE_B = 64 * TPB;
constexpr int FP = 68;
constexpr int CS_FA = 0, CS_FB = 16384, CS_TILES = 32768, CS_TOT = CS_TILES + 12 * TILE_B, CS_WL = CS_TOT + 2048, CS_PAR = CS_WL + 256;
static_assert(CS_PAR + 768 <= LDSCTL_OFF, "scan LDS map");
#define TILE(n) (lds + CS_TILES + (n) * TILE_B)
#define F4Z (f32x4){0.f, 0.f, 0.f, 0.f}
__device__ __forceinline__ bf16x8s ldfrag(const LAS unsigned char* tile, int row, int kcol) { return *(const LAS bf16x8s*)(tile + row * TPB + kcol * 2); }
__device__ __forceinline__ bf16x8s ldfrag_tr(const LAS unsigned char* tile, int n0, int k0, int lane) {
    const int g = lane >> 4, q = (lane & 15) >> 2, p = lane & 3;
    const LAS unsigned char* a = tile + (k0 + 8 * g + q) * TPB + (n0 + 4 * p) * 2;
    const v4i16_t lo = __builtin_amdgcn_ds_read_tr16_b64_v4i16((LAS v4i16_t*)a), hi = __builtin_amdgcn_ds_read_tr16_b64_v4i16((LAS v4i16_t*)(a + 4 * TPB));
    return (bf16x8s){lo[0], lo[1], lo[2], lo[3], hi[0], hi[1], hi[2], hi[3]};
}
__device__ __forceinline__ bf16x8s ldfrag_perm(const LAS unsigned char* tile, int row, int ks, int g) {
    const bf16x4s lo = *(const LAS bf16x4s*)(tile + row * TPB + (32 * ks + 4 * g) * 2), hi = *(const LAS bf16x4s*)(tile + row * TPB + (32 * ks + 16 + 4 * g) * 2);
    return (bf16x8s){lo[0], lo[1], lo[2], lo[3], hi[0], hi[1], hi[2], hi[3]};
}
__device__ __forceinline__ void lds_barrier() { asm volatile("s_waitcnt lgkmcnt(0)" ::: "memory"); __builtin_amdgcn_s_barrier(); asm volatile("" ::: "memory"); }
#define MFMA16(a, b, c) __builtin_amdgcn_mfma_f32_16x16x32_bf16((a), (b), (c), 0, 0, 0)
__device__ __forceinline__ void mm64(f32x4 (&acc)[2], const LAS unsigned char* At, const LAS unsigned char* Bt, int rt, int ch, int fr, int g) {
#pragma unroll
    for (int ks = 0; ks < 2; ++ks) { const bf16x8s a = ldfrag(At, 16 * rt + fr, 32 * ks + 8 * g);
#pragma unroll
        for (int ct = 0; ct < 2; ++ct) acc[ct] = MFMA16(a, ldfrag(Bt, 32 * ch + 16 * ct + fr, 32 * ks + 8 * g), acc[ct]); }
}
__device__ __forceinline__ void mm64_bt(f32x4 (&acc)[2], const LAS unsigned char* At, const LAS unsigned char* X, int rt, int ch, int fr, int g, int lane) {
#pragma unroll
    for (int ks = 0; ks < 2; ++ks) { const bf16x8s a = ldfrag(At, 16 * rt + fr, 32 * ks + 8 * g);
#pragma unroll
        for (int ct = 0; ct < 2; ++ct) acc[ct] = MFMA16(a, ldfrag_tr(X, 32 * ch + 16 * ct, 32 * ks, lane), acc[ct]); }
}
__device__ __forceinline__ void mm64_at(f32x4 (&acc)[2], const LAS unsigned char* Xa, const LAS unsigned char* Bt, int rt, int ch, int fr, int g, int lane) {
#pragma unroll
    for (int ks = 0; ks < 2; ++ks) { const bf16x8s a = ldfrag_tr(Xa, 16 * rt, 32 * ks, lane);
#pragma unroll
        for (int ct = 0; ct < 2; ++ct) acc[ct] = MFMA16(a, ldfrag(Bt, 32 * ch + 16 * ct + fr, 32 * ks + 8 * g), acc[ct]); }
}
__device__ __forceinline__ void mm64_att(f32x4 (&acc)[2], const LAS unsigned char* Xa, const LAS unsigned char* X, int rt, int ch, int lane) {
#pragma unroll
    for (int ks = 0; ks < 2; ++ks) { const bf16x8s a = ldfrag_tr(Xa, 16 * rt, 32 * ks, lane);
#pragma unroll
        for (int ct = 0; ct < 2; ++ct) acc[ct] = MFMA16(a, ldfrag_tr(X, 32 * ch + 16 * ct, 32 * ks, lane), acc[ct]); }
}
__device__ __forceinline__ bf16x4s pack4(f32x4 v) { v2u w; w.x = pg8::cvt_pk_bf16(v[0], v[1]); w.y = pg8::cvt_pk_bf16(v[2], v[3]); return __builtin_bit_cast(bf16x4s, w); }
__device__ __forceinline__ f32x4 unpack4(bf16x4s s) { const v2u w = __builtin_bit_cast(v2u, s); return (f32x4){bflo(w.x), bfhi(w.x), bflo(w.y), bfhi(w.y)}; }
__device__ __forceinline__ void st_tr(LAS unsigned char* Out, const f32x4 (&acc)[2], int rt, int ch, int fr, int g) {
#pragma unroll
    for (int ct = 0; ct < 2; ++ct) *(LAS bf16x4s*)(Out + (32 * ch + 16 * ct + fr) * TPB + (16 * rt + 4 * g) * 2) = pack4(acc[ct]);
}
__device__ __forceinline__ void ld_tr(f32x4 (&acc)[2], const LAS unsigned char* In, int rt, int ch, int fr, int g) {
#pragma unroll
    for (int ct = 0; ct < 2; ++ct) acc[ct] = unpack4(*(const LAS bf16x4s*)(In + (32 * ch + 16 * ct + fr) * TPB + (16 * rt + 4 * g) * 2));
}
__device__ __forceinline__ void unpack8(v4u w, float (&o)[8]) { o[0] = bflo(w.x); o[1] = bfhi(w.x); o[2] = bflo(w.y); o[3] = bfhi(w.y); o[4] = bflo(w.z); o[5] = bfhi(w.z); o[6] = bflo(w.w); o[7] = bfhi(w.w); }
__device__ __forceinline__ v4u pack8f(const float (&o)[8]) { v4u w; w.x = pg8::cvt_pk_bf16(o[0], o[1]); w.y = pg8::cvt_pk_bf16(o[2], o[3]); w.z = pg8::cvt_pk_bf16(o[4], o[5]); w.w = pg8::cvt_pk_bf16(o[6], o[7]); return w; }

struct FrontIn { v4u r, k, v; bf16x8s fw[2], fa[2]; };
__device__ __forceinline__ void front_fetch(FrontIn& f, unsigned char* ws, int unit, int tid, int lane, int wave) {
    const int h = unit & 15, c = (unit >> 4) & 127, b = unit >> 11; const size_t row0 = (size_t)b * SEQ + c * 64;
    const int rt = wave & 3, fr = lane & 15, g = lane >> 4, t = tid >> 3, cq = tid & 7, c0 = h * HD + cq * 8;
    const bf16* Rb = (const bf16*)(ws + WS_B1); const bf16* Kb = (const bf16*)(ws + WS_B2); const bf16* Vb = (const bf16*)(ws + WS_B3);
    const bf16* LW = (const bf16*)(ws + WS_LW); const bf16* LA = (const bf16*)(ws + WS_LA);
    f.r = *(const GAS v4u*)(Rb + (row0 + t) * C + c0); f.k = *(const GAS v4u*)(Kb + (row0 + t) * C + c0); f.v = *(const GAS v4u*)(Vb + (row0 + t) * C + c0);
#pragma unroll
    for (int ks = 0; ks < 2; ++ks) { f.fw[ks] = *(const GAS bf16x8s*)(LW + (row0 + 16 * rt + fr) * DW + 32 * ks + 8 * g); f.fa[ks] = *(const GAS bf16x8s*)(LA + (row0 + 16 * rt + fr) * DA + 32 * ks + 8 * g); }
}
__device__ __forceinline__ void head_consts(unsigned char* ws, LAS unsigned char* lds, int h, int tid, int wtile, int atile) {
    const bf16* W2T = (const bf16*)(ws + WS_WT_W2); const bf16* A2T = (const bf16*)(ws + WS_WT_A2);
    const int row = tid >> 3, cq = tid & 7;
    *(LAS v4u*)(lds + CS_TILES + wtile * TILE_B + row * TPB + cq * 16) = *(const GAS v4u*)(W2T + (size_t)(h * HD + row) * 64 + cq * 8);
    *(LAS v4u*)(lds + CS_TILES + atile * TILE_B + row * TPB + cq * 16) = *(const GAS v4u*)(A2T + (size_t)(h * HD + row) * 64 + cq * 8);
    if (tid < 64) { LAS float* P = (LAS float*)(lds + CS_PAR); P[tid] = INP(15)[h * HD + tid]; P[64 + tid] = INP(16)[h * HD + tid]; P[128 + tid] = INP(17)[h * HD + tid]; }
    __syncthreads();
}
template <int MODE>
__device__ __forceinline__ void chunk_front(const FrontIn& f, LAS unsigned char* lds, const float (&w0v)[2], const float (&a0v)[2], int tid, int lane, int wave, float (&v8)[8], float& rkb) {
    const int rt = wave & 3, ch = wave >> 2, fr = lane & 15, g = lane >> 4;
    LAS float* FA = (LAS float*)(lds + CS_FA); LAS float* FB = (LAS float*)(lds + CS_FB); LAS float* TOT = (LAS float*)(lds + CS_TOT);
    const int t = tid >> 3, cq = tid & 7;
    constexpr int WTILE = MODE == 1 ? 6 : 10, ATILE = MODE == 1 ? 8 : 11;
    {
        f32x4 aw[2] = {F4Z, F4Z}, aa[2] = {F4Z, F4Z};
#pragma unroll
        for (int ks = 0; ks < 2; ++ks)
#pragma unroll
            for (int ct = 0; ct < 2; ++ct) { aw[ct] = MFMA16(f.fw[ks], ldfrag(TILE(WTILE), 32 * ch + 16 * ct + fr, 32 * ks + 8 * g), aw[ct]); aa[ct] = MFMA16(f.fa[ks], ldfrag(TILE(ATILE), 32 * ch + 16 * ct + fr, 32 * ks + 8 * g), aa[ct]); }
#pragma unroll
        for (int ct = 0; ct < 2; ++ct) { const int j = 32 * ch + 16 * ct + fr; const float w0 = w0v[ct], a0 = a0v[ct];
#pragma unroll
            for (int q = 0; q < 4; ++q) { const int tt = 16 * rt + 4 * g + q; FA[tt * 64 + j] = -0.6065306597126334f * sigmoidf_(w0 + aw[ct][q]); FB[tt * 64 + j] = sigmoidf_(a0 + aa[ct][q]); } }
    }
    lds_barrier();
    {
        const int j = tid & 63, seg = tid >> 6; float run = 0.f; float loc[8];
#pragma unroll
        for (int q = 0; q < 8; ++q) { run += FA[(8 * seg + q) * 64 + j]; loc[q] = run; }
        TOT[seg * 64 + j] = run;
        lds_barrier();
        float off = 0.f;
#pragma unroll
        for (int s2 = 0; s2 < 7; ++s2) off += (s2 < seg) ? TOT[s2 * 64 + j] : 0.f;
#pragma unroll
        for (int q = 0; q < 8; ++q) FA[(8 * seg + q) * 64 + j] = loc[q] + off;
    }
    lds_barrier();
    {
        float r[8], k[8], pkk[8], pka[8], prk[8];
        unpack8(f.r, r); unpack8(f.k, k); unpack8(f.v, v8);
        { const LAS float* P = (const LAS float*)(lds + CS_PAR) + cq * 8; const f32x4 a0_ = *(const LAS f32x4*)P, a1_ = *(const LAS f32x4*)(P + 4), b0_ = *(const LAS f32x4*)(P + 64), b1_ = *(const LAS f32x4*)(P + 68), c0_ = *(const LAS f32x4*)(P + 128), c1_ = *(const LAS f32x4*)(P + 132);
#pragma unroll
          for (int q = 0; q < 4; ++q) { pkk[q] = a0_[q]; pkk[4 + q] = a1_[q]; pka[q] = b0_[q]; pka[4 + q] = b1_[q]; prk[q] = c0_[q]; prk[4 + q] = c1_[q]; } }
        float cw[8], cwp[8], ag[8];
        { const int tp = t > 0 ? t - 1 : 0;
          const f32x4 c0_ = *(const LAS f32x4*)(FA + t * 64 + cq * 8), c1_ = *(const LAS f32x4*)(FA + t * 64 + cq * 8 + 4), p0_ = *(const LAS f32x4*)(FA + tp * 64 + cq * 8), p1_ = *(const LAS f32x4*)(FA + tp * 64 + cq * 8 + 4);
          const f32x4 g0_ = *(const LAS f32x4*)(FB + t * 64 + cq * 8), g1_ = *(const LAS f32x4*)(FB + t * 64 + cq * 8 + 4);
#pragma unroll
          for (int q = 0; q < 4; ++q) { cw[q] = c0_[q]; cw[4 + q] = c1_[q]; cwp[q] = t > 0 ? p0_[q] : 0.f; cwp[4 + q] = t > 0 ? p1_[q] : 0.f; ag[q] = g0_[q]; ag[4 + q] = g1_[q]; } }
        float kk[8], ss = 0.f; rkb = 0.f;
#pragma unroll
        for (int q = 0; q < 8; ++q) { kk[q] = k[q] * pkk[q]; ss += kk[q] * kk[q]; }
        ss += shx(ss, 1, lane); ss += shx(ss, 2, lane); ss += shx(ss, 4, lane);
        const float inv = 1.0f / fmaxf(sqrtf(ss), 1e-12f);
        float at[8], bt[8], kt[8], rt_[8];
#pragma unroll
        for (int q = 0; q < 8; ++q) { const float kn = kk[q] * inv, kp = k[q] * (1.0f + (ag[q] - 1.0f) * pka[q]);
            const float ein = __expf(-cw[q]);
            at[q] = -kn * __expf(cwp[q]); bt[q] = kn * ag[q] * ein; kt[q] = kp * ein;
            if (MODE == 3) { rt_[q] = r[q] * __expf(cw[q]); rkb += r[q] * kp * prk[q]; } }
        if (MODE == 3) { rkb += shx(rkb, 1, lane); rkb += shx(rkb, 2, lane); rkb += shx(rkb, 4, lane); }
        *(LAS v4u*)(TILE(0) + t * TPB + cq * 16) = pack8f(at); *(LAS v4u*)(TILE(1) + t * TPB + cq * 16) = pack8f(bt); *(LAS v4u*)(TILE(2) + t * TPB + cq * 16) = pack8f(kt);
        *(LAS v4u*)(TILE(3) + t * TPB + cq * 16) = f.v;
        if (MODE == 3) *(LAS v4u*)(TILE(4) + t * TPB + cq * 16) = pack8f(rt_);
        if (MODE == 1 && t == 63) {
#pragma unroll
            for (int q = 0; q < 8; ++q) ((LAS float*)(lds + CS_WL))[cq * 8 + q] = __expf(cw[q]); }
    }
    lds_barrier();
}

__device__ __forceinline__ void scan_s1(unsigned char* ws, LAS unsigned char* lds, int lane0, int wave) {
    const int rt = wave & 3, ch = wave >> 2;
    FrontIn fin; float w0v[2], a0v[2];
    { int l0 = lane0; asm volatile("" : "+v"(l0)); const int hh = blockIdx.x & 15;
      if ((int)blockIdx.x < BATCH * NH * (SEQ / 64)) front_fetch(fin, ws, blockIdx.x, wave * 64 + l0, l0, wave);
#pragma unroll
      for (int ct = 0; ct < 2; ++ct) { w0v[ct] = INP(7)[hh * HD + 32 * ch + 16 * ct + (l0 & 15)]; a0v[ct] = INP(10)[hh * HD + 32 * ch + 16 * ct + (l0 & 15)]; }
      head_consts(ws, lds, hh, wave * 64 + l0, 6, 8); }
    for (int unit = blockIdx.x; unit < BATCH * NH * (SEQ / 64); unit += gridDim.x) {
        int lane = lane0; asm volatile("" : "+v"(lane));
        const int tid = wave * 64 + lane, fr = lane & 15, g = lane >> 4;
        const int h = unit & 15, c = (unit >> 4) & 127, b = unit >> 11; const size_t chunk = ((size_t)b * NH + h) * 128 + c;
        float v8[8]; float rkb;
        chunk_front<1>(fin, lds, w0v, a0v, tid, lane, wave, v8, rkb);
        if (unit + (int)gridDim.x < BATCH * NH * (SEQ / 64)) front_fetch(fin, ws, unit + gridDim.x, tid, lane, wave);
        {
            f32x4 a2[2] = {F4Z, F4Z}, a3[2] = {F4Z, F4Z};
            mm64(a2, TILE(1), TILE(0), rt, ch, fr, g);
            mm64(a3, TILE(2), TILE(0), rt, ch, fr, g);
            f32x4 p1[2];
#pragma unroll
            for (int ct = 0; ct < 2; ++ct) { const int col = 32 * ch + 16 * ct + fr;
#pragma unroll
                for (int q = 0; q < 4; ++q) { const int row = 16 * rt + 4 * g + q;
                    a2[ct][q] = row < col ? a2[ct][q] : 0.f;
                    p1[ct][q] = a2[ct][q] + (row == col ? 1.0f : 0.f);
                    a3[ct][q] = row < col ? a3[ct][q] : 0.f; } }
            st_tr(TILE(5), a2, rt, ch, fr, g);
            st_tr(TILE(9), p1, rt, ch, fr, g);
            st_tr(TILE(4), a3, rt, ch, fr, g);
        }
        lds_barrier();
#pragma unroll
        for (int r = 0; r < 6; ++r) {
            LAS unsigned char* Sr = TILE(5 + 2 * (r & 1)); LAS unsigned char* Sr2 = TILE(5 + 2 * ((r & 1) ^ 1));
            if (r <= 4) { f32x4 q2[2] = {F4Z, F4Z};
                mm64_at(q2, Sr, Sr, rt, ch, fr, g, lane);
                st_tr(Sr2, q2, rt, ch, fr, g); }
            if (r >= 1) { LAS unsigned char* Pr = TILE(9 + ((r - 1) & 1)); LAS unsigned char* Pr2 = TILE(9 + (((r - 1) & 1) ^ 1));
                f32x4 pa[2]; ld_tr(pa, Pr, rt, ch, fr, g);
                mm64_at(pa, Sr, Pr, rt, ch, fr, g, lane);
                st_tr(Pr2, pa, rt, ch, fr, g); }
            if (r == 0) { f32x4 gg[2] = {F4Z, F4Z};
                mm64_bt(gg, TILE(4), TILE(3), rt, ch, fr, g, lane);
                st_tr(TILE(11), gg, rt, ch, fr, g); }
            lds_barrier();
        }
        { const int trow = tid >> 3, tcq = tid & 7; *(GAS v4u*)((bf16*)(ws + WS_B4) + chunk * 4096 + trow * 64 + tcq * 8) = *(const LAS v4u*)(TILE(10) + trow * TPB + tcq * 16); }
        {
            f32x4 acc[2] = {F4Z, F4Z}, ac2[2] = {F4Z, F4Z};
            mm64_bt(acc, TILE(10), TILE(0), rt, ch, fr, g, lane);
            mm64(ac2, TILE(10), TILE(11), rt, ch, fr, g);
            st_tr(TILE(5), acc, rt, ch, fr, g); st_tr(TILE(7), ac2, rt, ch, fr, g);
        }
        lds_barrier();
        {
            const LAS float* WL = (const LAS float*)(lds + CS_WL);
            f32x4 acc[2] = {F4Z, F4Z};
            mm64_bt(acc, TILE(5), TILE(1), rt, ch, fr, g, lane);
            bf16* Mg = (bf16*)(ws + WS_B0) + chunk * 4096;
#pragma unroll
            for (int ct = 0; ct < 2; ++ct) { const int j1 = 32 * ch + 16 * ct + fr; const float wl = WL[j1];
#pragma unroll
                for (int q = 0; q < 4; ++q) { const int j2 = 16 * rt + 4 * g + q; acc[ct][q] = wl * (acc[ct][q] + (j2 == j1 ? 1.0f : 0.f)); }
                const int rtS = 2 * ch + ct, ksS = rt >> 1, half = rt & 1;
                *(GAS bf16x4s*)(Mg + (((rtS * 2 + ksS) * 64 + g * 16 + fr) * 8 + half * 4)) = pack4(acc[ct]); }
            f32x4 ad[2] = {F4Z, F4Z};
            mm64_at(ad, TILE(1), TILE(7), rt, ch, fr, g, lane);
            mm64_att(ad, TILE(2), TILE(3), rt, ch, lane);
            const f32x4 wl4 = *(const LAS f32x4*)(WL + 16 * rt + 4 * g);
            bf16* Dg = (bf16*)OUTP() + chunk * 4096;
#pragma unroll
            for (int ct = 0; ct < 2; ++ct) *(GAS bf16x4s*)(Dg + (((2 * ch + ct) * 4 + rt) * 64 + lane) * 4) = pack4(ad[ct] * wl4);
        }
        lds_barrier();
    }
}

__device__ __forceinline__ void scan_s2(unsigned char* ws, int lane, int wave) {
    if (wave >= 4) return;
    const int ct = wave;
    for (int bh = blockIdx.x; bh < BATCH * NH; bh += gridDim.x) {
        const bf16* Mg = (const bf16*)(ws + WS_B0) + (size_t)bh * 128 * 4096; const bf16* Dg = (const bf16*)OUTP() + (size_t)bh * 128 * 4096; bf16* Sg = (bf16*)OUTP() + (size_t)M * C + (size_t)bh * 128 * 4096;
        f32x4 acc[4];
#pragma unroll
        for (int r = 0; r < 4; ++r) acc[r] = F4Z;
        bf16x8s mf[4][2]; bf16x4s df[4];
#pragma unroll
        for (int r = 0; r < 4; ++r) { df[r] = *(const GAS bf16x4s*)(Dg + ((ct * 4 + r) * 64 + lane) * 4);
#pragma unroll
            for (int ks = 0; ks < 2; ++ks) mf[r][ks] = *(const GAS bf16x8s*)(Mg + ((r * 2 + ks) * 64 + lane) * 8); }
#pragma unroll 1
        for (int c = 0; c < 128; ++c) {
            bf16x8s sf[2];
#pragma unroll
            for (int ks = 0; ks < 2; ++ks) { const bf16x4s lo = pack4(acc[2 * ks]), hi = pack4(acc[2 * ks + 1]); sf[ks] = (bf16x8s){lo[0], lo[1], lo[2], lo[3], hi[0], hi[1], hi[2], hi[3]}; }
#pragma unroll
            for (int ks = 0; ks < 2; ++ks) *(GAS bf16x8s*)(Sg + (size_t)c * 4096 + ((ct * 2 + ks) * 64 + lane) * 8) = sf[ks];
            bf16x8s mc[4][2]; f32x4 na[4];
#pragma unroll
            for (int r = 0; r < 4; ++r) { na[r] = unpack4(df[r]);
#pragma unroll
                for (int ks = 0; ks < 2; ++ks) mc[r][ks] = mf[r][ks]; }
            if (c + 1 < 128) {
                const bf16* Mn = Mg + (size_t)(c + 1) * 4096; const bf16* Dn = Dg + (size_t)(c + 1) * 4096;
#pragma unroll
                for (int r = 0; r < 4; ++r) { df[r] = *(const GAS bf16x4s*)(Dn + ((ct * 4 + r) * 64 + lane) * 4);
#pragma unroll
                    for (int ks = 0; ks < 2; ++ks) mf[r][ks] = *(const GAS bf16x8s*)(Mn + ((r * 2 + ks) * 64 + lane) * 8); }
            }
#pragma unroll
            for (int ks = 0; ks < 2; ++ks)
#pragma unroll
                for (int r = 0; r < 4; ++r) na[r] = MFMA16(mc[r][ks], sf[ks], na[r]);
#pragma unroll
            for (int r = 0; r < 4; ++r) acc[r] = na[r];
        }
    }
}

__device__ __forceinline__ void scan_s3(unsigned char* ws, LAS unsigned char* lds, int lane0, int wave) {
    const int rt = wave & 3, ch = wave >> 2;
    LAS float* Ys = (LAS float*)(lds + CS_FA);
    const bf16* LG = (const bf16*)(ws + WS_LG); const bf16* G2T = (const bf16*)(ws + WS_WT_G2); bf16* YG = (bf16*)(ws + WS_B0);
    FrontIn fin; float w0v[2], a0v[2];
    { int l0 = lane0; asm volatile("" : "+v"(l0)); const int hh = blockIdx.x & 15;
      if ((int)blockIdx.x < BATCH * NH * (SEQ / 64)) front_fetch(fin, ws, blockIdx.x, wave * 64 + l0, l0, wave);
#pragma unroll
      for (int ct = 0; ct < 2; ++ct) { w0v[ct] = INP(7)[hh * HD + 32 * ch + 16 * ct + (l0 & 15)]; a0v[ct] = INP(10)[hh * HD + 32 * ch + 16 * ct + (l0 & 15)]; }
      head_consts(ws, lds, hh, wave * 64 + l0, 10, 11); }
    for (int unit = blockIdx.x; unit < BATCH * NH * (SEQ / 64); unit += gridDim.x) {
        int lane = lane0; asm volatile("" : "+v"(lane));
        const int tid = wave * 64 + lane, fr = lane & 15, g = lane >> 4;
        const int h = unit & 15, c = (unit >> 4) & 127, b = unit >> 11; const size_t chunk = ((size_t)b * NH + h) * 128 + c; const size_t row0 = (size_t)b * SEQ + c * 64;
        const bf16* Sg = (const bf16*)OUTP() + (size_t)M * C + chunk * 4096; const bf16* Tg = (const bf16*)(ws + WS_B4) + chunk * 4096;
        bf16x8s sB[2][2], sA[2], tA[2];
#pragma unroll
        for (int ks = 0; ks < 2; ++ks) { sA[ks] = *(const GAS bf16x8s*)(Sg + ((rt * 2 + ks) * 64 + lane) * 8); tA[ks] = *(const GAS bf16x8s*)(Tg + (16 * rt + fr) * 64 + 32 * ks + 8 * g);
#pragma unroll
            for (int ct = 0; ct < 2; ++ct) sB[ks][ct] = *(const GAS bf16x8s*)(Sg + (((2 * ch + ct) * 2 + ks) * 64 + lane) * 8); }
        const int et = tid >> 3, ecq = tid & 7, ec0 = h * HD + ecq * 8;
        const f32x4 lnw0 = *(const GAS f32x4*)(INP(18) + ec0), lnw1 = *(const GAS f32x4*)(INP(18) + ec0 + 4), lnb0 = *(const GAS f32x4*)(INP(19) + ec0), lnb1 = *(const GAS f32x4*)(INP(19) + ec0 + 4);
        float v8[8]; float rkb;
        chunk_front<3>(fin, lds, w0v, a0v, tid, lane, wave, v8, rkb);
        bf16x8s gA[5], gB[5][2];
#pragma unroll
        for (int ks = 0; ks < 5; ++ks) { gA[ks] = *(const GAS bf16x8s*)(G2T + (size_t)(h * HD + 16 * rt + fr) * DG + 32 * ks + 8 * g);
#pragma unroll
            for (int ct = 0; ct < 2; ++ct) gB[ks][ct] = *(const GAS bf16x8s*)(LG + (row0 + 32 * ch + 16 * ct + fr) * DG + 32 * ks + 8 * g); }
        if (unit + (int)gridDim.x < BATCH * NH * (SEQ / 64)) front_fetch(fin, ws, unit + gridDim.x, tid, lane, wave);
        {
            f32x4 a1[2] = {F4Z, F4Z}, a2[2] = {F4Z, F4Z}, a3[2] = {F4Z, F4Z};
            mm64(a1, TILE(2), TILE(0), rt, ch, fr, g);
            mm64(a2, TILE(1), TILE(4), rt, ch, fr, g);
            mm64(a3, TILE(2), TILE(4), rt, ch, fr, g);
#pragma unroll
            for (int ct = 0; ct < 2; ++ct) { const int t = 32 * ch + 16 * ct + fr;
#pragma unroll
                for (int q = 0; q < 4; ++q) { const int s = 16 * rt + 4 * g + q; a1[ct][q] = s < t ? a1[ct][q] : 0.f; a2[ct][q] = s <= t ? a2[ct][q] : 0.f; a3[ct][q] = s <= t ? a3[ct][q] : 0.f; } }
            st_tr(TILE(5), a1, rt, ch, fr, g); st_tr(TILE(6), a2, rt, ch, fr, g); st_tr(TILE(7), a3, rt, ch, fr, g);
        }
        f32x4 ag[2] = {F4Z, F4Z};
#pragma unroll
        for (int ks = 0; ks < 5; ++ks)
#pragma unroll
            for (int ct = 0; ct < 2; ++ct) ag[ct] = MFMA16(gA[ks], gB[ks][ct], ag[ct]);
        lds_barrier();
        {
            f32x4 acc[2] = {F4Z, F4Z};
#pragma unroll
            for (int ks = 0; ks < 2; ++ks) { const bf16x8s a = ldfrag_perm(TILE(0), 16 * rt + fr, ks, g);
#pragma unroll
                for (int ct = 0; ct < 2; ++ct) acc[ct] = MFMA16(a, sB[ks][ct], acc[ct]); }
            mm64_bt(acc, TILE(5), TILE(3), rt, ch, fr, g, lane);
            st_tr(TILE(8), acc, rt, ch, fr, g);
        }
        lds_barrier();
        {
            f32x4 acc[2] = {F4Z, F4Z};
#pragma unroll
            for (int ks = 0; ks < 2; ++ks)
#pragma unroll
                for (int ct = 0; ct < 2; ++ct) acc[ct] = MFMA16(tA[ks], ldfrag(TILE(8), 32 * ch + 16 * ct + fr, 32 * ks + 8 * g), acc[ct]);
            st_tr(TILE(9), acc, rt, ch, fr, g);
        }
        lds_barrier();
        {
            f32x4 acc[2] = {F4Z, F4Z};
#pragma unroll
            for (int ks = 0; ks < 2; ++ks)
#pragma unroll
                for (int ct = 0; ct < 2; ++ct) acc[ct] = MFMA16(sA[ks], ldfrag_perm(TILE(4), 32 * ch + 16 * ct + fr, ks, g), acc[ct]);
            mm64(acc, TILE(9), TILE(6), rt, ch, fr, g); mm64_at(acc, TILE(3), TILE(7), rt, ch, fr, g, lane);
#pragma unroll
            for (int ct = 0; ct < 2; ++ct) { const int t = 32 * ch + 16 * ct + fr; *(LAS f32x4*)(Ys + t * FP + 16 * rt + 4 * g) = acc[ct]; }
        }
        lds_barrier();
        {
            const f32x4 y0 = *(const LAS f32x4*)(Ys + et * FP + ecq * 8), y1 = *(const LAS f32x4*)(Ys + et * FP + ecq * 8 + 4);
            float y[8] = {y0[0], y0[1], y0[2], y0[3], y1[0], y1[1], y1[2], y1[3]};
            float s = 0.f;
#pragma unroll
            for (int q = 0; q < 8; ++q) s += y[q];
            s += shx(s, 1, lane); s += shx(s, 2, lane); s += shx(s, 4, lane);
            const float mu = s * (1.0f / HD); float vs = 0.f;
#pragma unroll
            for (int q = 0; q < 8; ++q) { y[q] -= mu; vs += y[q] * y[q]; }
            vs += shx(vs, 1, lane); vs += shx(vs, 2, lane); vs += shx(vs, 4, lane);
            const float rstd = 1.0f / sqrtf(vs * (1.0f / HD) + GN_EPS);
            f32x4 o0, o1;
#pragma unroll
            for (int q = 0; q < 4; ++q) { o0[q] = y[q] * rstd * lnw0[q] + lnb0[q] + rkb * v8[q]; o1[q] = y[4 + q] * rstd * lnw1[q] + lnb1[q] + rkb * v8[4 + q]; }
            *(LAS f32x4*)(Ys + et * FP + ecq * 8) = o0; *(LAS f32x4*)(Ys + et * FP + ecq * 8 + 4) = o1;
        }
        lds_barrier();
        {
#pragma unroll
            for (int ct = 0; ct < 2; ++ct) { const int t = 32 * ch + 16 * ct + fr; const f32x4 yv = *(const LAS f32x4*)(Ys + t * FP + 16 * rt + 4 * g);
                *(GAS bf16x4s*)(YG + (row0 + t) * C + h * HD + 16 * rt + 4 * g) = pack4(yv * ag[ct]); }
        }
        lds_barrier();
    }
}
#undef TILE
#if MK_DEBUG
__device__ __forceinline__ void scan_naive(unsigned char* ws, LAS unsigned char* lds, int tid) {
    const int lane = tid & 63;
    const bf16* Rb = (const bf16*)(ws + WS_B1); const bf16* Kb = (const bf16*)(ws + WS_B2); const bf16* Vb = (const bf16*)(ws + WS_B3);
    const bf16* LW = (const bf16*)(ws + WS_LW); const bf16* LA = (const bf16*)(ws + WS_LA);
    float* Y = OUTP(); float* RK = (float*)(ws + WS_HID);
    LAS float* sR = (LAS float*)lds; LAS float* sK = sR + 4096; LAS float* sV = sK + 4096; LAS float* sA = sV + 4096; LAS float* sB = sA + 4096; LAS float* sD = sB + 4096;
    LAS float* sW2 = sD + 4096; LAS float* sA2 = sW2 + 4096;
    for (int unit = blockIdx.x; unit < BATCH * NH; unit += gridDim.x) {
        const int b = unit / NH, h = unit % NH;
        __syncthreads();
        for (int e = tid; e < 4096; e += 512) { const int d = e >> 6, j = e & 63; sW2[e] = INP(9)[(size_t)d * C + h * HD + j]; sA2[e] = INP(12)[(size_t)d * C + h * HD + j]; }
        __syncthreads();
        const int pt = tid >> 3, cq = tid & 7, c0 = h * HD + cq * 8;
        const int si = tid >> 3, jq = tid & 7;
        float S[8];
#pragma unroll
        for (int q = 0; q < 8; ++q) S[q] = 0.f;
        float w0v[8], a0v[8], kkv[8], kav[8], rkv[8];
#pragma unroll
        for (int q = 0; q < 8; ++q) { w0v[q] = INP(7)[c0 + q]; a0v[q] = INP(10)[c0 + q]; kkv[q] = INP(15)[c0 + q]; kav[q] = INP(16)[c0 + q]; rkv[q] = INP(17)[c0 + q]; }
        for (int blk = 0; blk < SEQ / 64; ++blk) {
            const size_t row = (size_t)b * SEQ + blk * 64 + pt;
            {
                const v4u r4 = *(const GAS v4u*)(Rb + row * C + c0), k4 = *(const GAS v4u*)(Kb + row * C + c0), v4 = *(const GAS v4u*)(Vb + row * C + c0);
                float r[8], k[8], v[8];
                r[0] = bflo(r4.x); r[1] = bfhi(r4.x); r[2] = bflo(r4.y); r[3] = bfhi(r4.y); r[4] = bflo(r4.z); r[5] = bfhi(r4.z); r[6] = bflo(r4.w); r[7] = bfhi(r4.w);
                k[0] = bflo(k4.x); k[1] = bfhi(k4.x); k[2] = bflo(k4.y); k[3] = bfhi(k4.y); k[4] = bflo(k4.z); k[5] = bfhi(k4.z); k[6] = bflo(k4.w); k[7] = bfhi(k4.w);
                v[0] = bflo(v4.x); v[1] = bfhi(v4.x); v[2] = bflo(v4.y); v[3] = bfhi(v4.y); v[4] = bflo(v4.z); v[5] = bfhi(v4.z); v[6] = bflo(v4.w); v[7] = bfhi(v4.w);
                float wp[8], ap[8];
#pragma unroll
                for (int q = 0; q < 8; ++q) { wp[q] = w0v[q]; ap[q] = a0v[q]; }
                for (int d = 0; d < 64; ++d) { const float lw = bf2f(LW[row * DW + d]), la = bf2f(LA[row * DA + d]);
#pragma unroll
                    for (int q = 0; q < 8; ++q) { wp[q] += lw * sW2[d * 64 + cq * 8 + q]; ap[q] += la * sA2[d * 64 + cq * 8 + q]; } }
                float kk[8], ss = 0.f, rks = 0.f;
#pragma unroll
                for (int q = 0; q < 8; ++q) { kk[q] = k[q] * kkv[q]; ss += kk[q] * kk[q]; }
                ss += shx(ss, 1, lane); ss += shx(ss, 2, lane); ss += shx(ss, 4, lane);
                const float inv = 1.0f / fmaxf(sqrtf(ss), 1e-12f);
#pragma unroll
                for (int q = 0; q < 8; ++q) { const float ag = sigmoidf_(ap[q]); const float kn = kk[q] * inv; const float kp = k[q] * (1.0f + (ag - 1.0f) * kav[q]);
                    const float lw = -0.6065306597126334f * sigmoidf_(wp[q]);
                    const int o = pt * 64 + cq * 8 + q;
                    sR[o] = r[q]; sK[o] = kp; sV[o] = v[q]; sA[o] = -kn; sB[o] = kn * ag; sD[o] = __expf(lw); rks += r[q] * kp * rkv[q]; }
                rks += shx(rks, 1, lane); rks += shx(rks, 2, lane); rks += shx(rks, 4, lane);
                if (cq == 0) RK[row * NH + h] = rks;
            }
            __syncthreads();
            for (int t = 0; t < 64; ++t) {
                const LAS f32x4* pa = (const LAS f32x4*)(sA + t * 64 + jq * 8); const LAS f32x4* pb = (const LAS f32x4*)(sB + t * 64 + jq * 8);
                const LAS f32x4* pd = (const LAS f32x4*)(sD + t * 64 + jq * 8); const LAS f32x4* pk = (const LAS f32x4*)(sK + t * 64 + jq * 8);
                const LAS f32x4* pr = (const LAS f32x4*)(sR + t * 64 + jq * 8);
                const f32x4 a0 = pa[0], a1 = pa[1], b0 = pb[0], b1 = pb[1], d0 = pd[0], d1 = pd[1], k0 = pk[0], k1 = pk[1], r0 = pr[0], r1 = pr[1];
                const float vi = sV[t * 64 + si];
                float sa = 0.f;
#pragma unroll
                for (int q = 0; q < 4; ++q) { sa += S[q] * a0[q]; sa += S[4 + q] * a1[q]; }
                sa += shx(sa, 1, lane); sa += shx(sa, 2, lane); sa += shx(sa, 4, lane);
                float y = 0.f;
#pragma unroll
                for (int q = 0; q < 4; ++q) { S[q] = S[q] * d0[q] + sa * b0[q] + vi * k0[q]; S[4 + q] = S[4 + q] * d1[q] + sa * b1[q] + vi * k1[q]; y += S[q] * r0[q]; y += S[4 + q] * r1[q]; }
                y += shx(y, 1, lane); y += shx(y, 2, lane); y += shx(y, 4, lane);
                if (jq == 0) Y[((size_t)b * SEQ + blk * 64 + t) * C + h * HD + si] = y;
            }
            __syncthreads();
        }
    }
}
__device__ __forceinline__ void post_scan(unsigned char* ws, int gw, int NGW, int lane) {
    const float* Y = OUTP(); const float* RK = (const float*)(ws + WS_HID); const bf16* Vb = (const bf16*)(ws + WS_B3); const bf16* LG = (const bf16*)(ws + WS_LG);
    bf16* YG = (bf16*)(ws + WS_B4); const float* g2 = INP(14); const float* lnw = INP(18); const float* lnb = INP(19);
    for (int it = gw; it < M * NH; it += NGW) {
        const int row = it / NH, h = it % NH, c = h * HD + lane;
        const float y = Y[(size_t)row * C + c];
        const float mu = wave_sum(y, lane) * (1.0f / HD); const float d = y - mu; const float var = wave_sum(d * d, lane) * (1.0f / HD);
        float o = d * (1.0f / sqrtf(var + GN_EPS)) * lnw[c] + lnb[c];
        o += RK[(size_t)row * NH + h] * bf2f(Vb[(size_t)row * C + c]);
        float g = 0.f;
        for (int dd = 0; dd < DG; ++dd) g += bf2f(LG[(size_t)row * DG + dd]) * g2[(size_t)dd * C + c];
        YG[(size_t)row * C + c] = (bf16)f2bf(o * g);
    }
}


constexpr int CW_DBG = 3200;
__device__ __forceinline__ void dbg_nonfinite(unsigned char* ws, const bf16* X, size_t n, int slot, int gw, int NGW, int lane, float thr = 1e30f) {
    unsigned* cw = (unsigned*)(ws + WS_CTL) + CW_DBG + 64 * slot; unsigned nnan = 0;
    for (size_t i = (size_t)gw * 64 + lane; i < n; i += (size_t)NGW * 64) { const float x = bf2f(X[i]); if (!(fabsf(x) < thr)) ++nnan; }
    if (nnan) atomicAdd(cw, nnan);
}
__device__ __forceinline__ void dbg_compare(unsigned char* ws, const bf16* X, const bf16* Y, int gw, int NGW, int lane) {
    unsigned* cw = (unsigned*)(ws + WS_CTL) + CW_DBG; unsigned nbad = 0, nnan = 0;
    for (size_t i = (size_t)gw * 64 + lane; i < (size_t)M * C; i += (size_t)NGW * 64) { const float x = bf2f(X[i]), y = bf2f(Y[i]);
        if (!(fabsf(x) < 1e30f)) ++nnan; else if (fabsf(x - y) > 0.05f * (fabsf(y) + 0.05f)) ++nbad; }
    if (nnan) atomicAdd(cw, nnan); if (nbad) atomicAdd(cw + 64, nbad);
}
#endif
__device__ __forceinline__ void router_rows(unsigned char* ws, LAS unsigned char* lds, int layer, int gw, int NGW, int lane, int tid, bool dry = false) {
    const float* Hh = OUTP(); const float* gain = INP(2) + layer * C; bf16* XN = (bf16*)(ws + WS_B1);
    const float* wg = INP(24) + (size_t)layer * C * 4; const float* bg = INP(25) + layer * 4; const float* wi = INP(26) + (size_t)layer * C * 16; const float* bi = INP(27) + layer * 16;
    unsigned* cnt = (unsigned*)(ws + WS_CTL) + CW_CNT + layer * 16 * 64; unsigned* list = (unsigned*)(ws + WS_LIST); float* wl = (float*)(ws + WS_WL);
    LAS float* sWg = (LAS float*)lds; LAS float* sWi = sWg + C * 4;
    constexpr int RECMAX = 256;
    LAS unsigned* lcnt = (LAS unsigned*)(lds + 81920); LAS unsigned* gbase = lcnt + 16; LAS int* nrec = (LAS int*)(lcnt + 32);
    LAS unsigned* recRow = lcnt + 64; LAS unsigned* recE = recRow + RECMAX; LAS unsigned* recL = recE + RECMAX; LAS float* recW0 = (LAS float*)(recL + RECMAX); LAS float* recW1 = recW0 + RECMAX;
    __syncthreads();
    for (int e = tid; e < C * 4; e += 512) sWg[e] = wg[e];
    for (int e = tid; e < C * 16; e += 512) sWi[e] = wi[e];
    if (tid < 33) lcnt[tid == 32 ? 32 : tid] = 0u;
    __syncthreads();
    f32x4 g[4]; load_row(gain, lane, g);
    for (int row = gw; row < M; row += NGW) {
        f32x4 v[4]; load_row(Hh + (size_t)row * C, lane, v); const float rs = row_rs(v, lane);
#pragma unroll
        for (int j = 0; j < 4; ++j) v[j] = v[j] * rs * g[j];
        store_row_bf16(XN + (size_t)row * C, lane, v);
        float gl[4] = {0.f, 0.f, 0.f, 0.f};
        const LAS unsigned char* pWg = (const LAS unsigned char*)sWg + lane * 64;
#pragma unroll
        for (int j = 0; j < 4; ++j)
#pragma unroll
            for (int q = 0; q < 4; ++q) { const f32x4 w = *(const LAS f32x4*)(pWg + j * 4096 + q * 16); const float xv = v[j][q]; gl[0] += xv * w.x; gl[1] += xv * w.y; gl[2] += xv * w.z; gl[3] += xv * w.w; }
#pragma unroll
        for (int q = 0; q < 4; ++q) gl[q] = wave_sum(gl[q], lane) + bg[q];
        int gi = 0; float gm = gl[0];
#pragma unroll
        for (int q = 1; q < 4; ++q) if (gl[q] > gm) { gm = gl[q]; gi = q; }
        float gden = 0.f;
#pragma unroll
        for (int q = 0; q < 4; ++q) gden += __expf(gl[q] - gm);
        const float gval = 1.0f / gden;
        float il[4] = {0.f, 0.f, 0.f, 0.f};
        const LAS unsigned char* pWi = (const LAS unsigned char*)sWi + lane * 256 + gi * 16;
#pragma unroll
        for (int j = 0; j < 4; ++j)
#pragma unroll
            for (int q = 0; q < 4; ++q) { const f32x4 w = *(const LAS f32x4*)(pWi + j * 16384 + q * 64); const float xv = v[j][q]; il[0] += xv * w.x; il[1] += xv * w.y; il[2] += xv * w.z; il[3] += xv * w.w; }
#pragma unroll
        for (int q = 0; q < 4; ++q) il[q] = wave_sum(il[q], lane) + bi[gi * 4 + q];
        int i0 = 0; float m0 = il[0];
#pragma unroll
        for (int q = 1; q < 4; ++q) if (il[q] > m0) { m0 = il[q]; i0 = q; }
        int i1 = -1; float m1 = -INFINITY;
#pragma unroll
        for (int q = 0; q < 4; ++q) if (q != i0 && il[q] > m1) { m1 = il[q]; i1 = q; }
        const float e1 = __expf(m1 - m0); const float w0 = gval / (1.0f + e1), w1 = gval * e1 / (1.0f + e1);
        if (lane == 0 && !dry) {
            const int ex0 = gi * 4 + i0, ex1 = gi * 4 + i1;
            const int ri = __hip_atomic_fetch_add(nrec, 1, __ATOMIC_RELAXED, __HIP_MEMORY_SCOPE_WORKGROUP);
            const unsigned l0 = __hip_atomic_fetch_add(lcnt + ex0, 1u, __ATOMIC_RELAXED, __HIP_MEMORY_SCOPE_WORKGROUP), l1 = __hip_atomic_fetch_add(lcnt + ex1, 1u, __ATOMIC_RELAXED, __HIP_MEMORY_SCOPE_WORKGROUP);
            if (ri < RECMAX) { recRow[ri] = (unsigned)row; recE[ri] = (unsigned)ex0 | ((unsigned)ex1 << 8); recL[ri] = l0 | (l1 << 16); recW0[ri] = w0; recW1[ri] = w1; }
        }
    }
    __syncthreads();
    if (tid < 16 && !dry) gbase[tid] = atomicAdd(cnt + tid * 64, lcnt[tid]);
    __syncthreads();
    { const int n = *nrec < RECMAX ? *nrec : RECMAX;
      for (int i = tid; i < n; i += 512) { const unsigned row = recRow[i], e = recE[i], l = recL[i]; const unsigned ex0 = e & 255u, ex1 = e >> 8;
          const unsigned p0 = gbase[ex0] + (l & 0xffffu), p1 = gbase[ex1] + (l >> 16);
          list[(size_t)ex0 * M + p0] = row * 2u; wl[(size_t)ex0 * M + p0] = recW0[i]; list[(size_t)ex1 * M + p1] = row * 2u + 1u; wl[(size_t)ex1 * M + p1] = recW1[i]; } }
}
__device__ __forceinline__ void moe_table(unsigned char* ws, volatile LAS int* tab, int layer, int tid) {
    __syncthreads();
    if (tid == 0) { const unsigned* cnt = (const unsigned*)(ws + WS_CTL) + CW_CNT + layer * 16 * 64; int t = 0;
#pragma unroll 1
        for (int e = 0; e < 16; ++e) { const int c = (int)__hip_atomic_load(cnt, RLX_AGENT); cnt += 64; tab[e] = c; tab[16 + e] = t; t += (c + 255) >> 8; tab[32 + e] = t; }
        tab[48] = t; }
    __syncthreads();
}
__device__ __forceinline__ void combine_rows(unsigned char* ws, int mode, int gw, int NGW, int lane, bool dry = false) {
    float* Hh = OUTP(); const bf16* E0 = (const bf16*)(ws + WS_B2); const bf16* E1 = (const bf16*)(ws + WS_B3); bf16* XN2 = (bf16*)(ws + WS_B0);
    f32x4 g[4]; load_row(INP(4), lane, g);
    for (int row = gw; row < M; row += NGW) {
        f32x4 v[4]; load_row(Hh + (size_t)row * C, lane, v);
#pragma unroll
        for (int j = 0; j < 4; ++j) { const v2u e0 = ((const GAS v2u*)(E0 + (size_t)row * C))[64 * j + lane], e1 = ((const GAS v2u*)(E1 + (size_t)row * C))[64 * j + lane];
            v[j].x += bflo(e0.x) + bflo(e1.x); v[j].y += bfhi(e0.x) + bfhi(e1.x); v[j].z += bflo(e0.y) + bflo(e1.y); v[j].w += bfhi(e0.y) + bfhi(e1.y); }
        const float rs = row_rs(v, lane);
        if (mode == 0) {
#pragma unroll
            for (int j = 0; j < 4; ++j) if (!dry) ((GAS f32x4*)(Hh + (size_t)row * C))[64 * j + lane] = v[j];
#pragma unroll
            for (int j = 0; j < 4; ++j) v[j] = v[j] * rs;
            store_row_bf16(XN2 + (size_t)row * C, lane, v);
        } else {
            float sig = 1.0f;
#if MK_DEBUG
            const unsigned* cw = (const unsigned*)(ws + WS_CTL) + CW_DBG; const unsigned nnan = __hip_atomic_load(cw, RLX_AGENT), nbad = __hip_atomic_load(cw + 64, RLX_AGENT);
            if (row < 512 && nnan > 0) sig = 2.0f;
            if (row >= 512 && row < 1536 && __hip_atomic_load(cw + 128, RLX_AGENT) > 0) sig = 2.0f;
            if (row >= 1536 && row < 3584 && __hip_atomic_load(cw + 192, RLX_AGENT) > 0) sig = 2.0f;
            if (row >= 3584 && row < 7680 && __hip_atomic_load(cw + 256, RLX_AGENT) > 0) sig = 2.0f;
            if (row >= 7680 && row < 15872 && __hip_atomic_load(cw + 320, RLX_AGENT) > 0) sig = 2.0f;
            if (row >= 15872 && nbad > (unsigned)(M / 100) * C) sig = 1.5f;
#endif
#pragma unroll
            for (int j = 0; j < 4; ++j) ((GAS f32x4*)(Hh + (size_t)row * C))[64 * j + lane] = v[j] * rs * g[j] * sig;
        }
    }
}
__device__ __forceinline__ void attn_naive(unsigned char* ws, int gw, int NGW, int lane) {
    const bf16* Kb = (const bf16*)(ws + WS_B1); const bf16* Vb = (const bf16*)(ws + WS_B2); const bf16* Qb = (const bf16*)(ws + WS_B3); bf16* Ob = (bf16*)(ws + WS_B0);
    for (int unit = gw; unit < BATCH * NH * (SEQ / 64); unit += NGW) {
        const int qb = unit % (SEQ / 64), bh = unit / (SEQ / 64), b = bh / NH, h = bh % NH;
        const int t0 = qb * 64, t = t0 + lane; const size_t rowq = (size_t)b * SEQ + t;
        float q[64], o[64];
#pragma unroll
        for (int c = 0; c < 8; ++c) { const v4u w = *(const GAS v4u*)(Qb + rowq * C + h * HD + c * 8);
            q[c * 8 + 0] = bflo(w.x) * 0.125f; q[c * 8 + 1] = bfhi(w.x) * 0.125f; q[c * 8 + 2] = bflo(w.y) * 0.125f; q[c * 8 + 3] = bfhi(w.y) * 0.125f;
            q[c * 8 + 4] = bflo(w.z) * 0.125f; q[c * 8 + 5] = bfhi(w.z) * 0.125f; q[c * 8 + 6] = bflo(w.w) * 0.125f; q[c * 8 + 7] = bfhi(w.w) * 0.125f; }
#pragma unroll
        for (int c = 0; c < 64; ++c) o[c] = 0.f;
        float suffix = 0.f;
        for (int s = t0 + 62; s >= 0; --s) {
            const bool valid = s < t;
            if (s < t0 && __all(suffix > SB_EXIT)) break;
            const bf16* kp = Kb + ((size_t)b * SEQ + s) * C + h * HD; const bf16* vp = Vb + ((size_t)b * SEQ + s) * C + h * HD;
            float z = 0.f;
#pragma unroll
            for (int c = 0; c < 8; ++c) { const v4u w = *(const GAS v4u*)(kp + c * 8);
                z += q[c * 8 + 0] * bflo(w.x) + q[c * 8 + 1] * bfhi(w.x) + q[c * 8 + 2] * bflo(w.y) + q[c * 8 + 3] * bfhi(w.y) + q[c * 8 + 4] * bflo(w.z) + q[c * 8 + 5] * bfhi(w.z) + q[c * 8 + 6] * bflo(w.w) + q[c * 8 + 7] * bfhi(w.w); }
            const float sp = fmaxf(z, 0.f) + log1pf(__expf(-fabsf(z)));
            const float att = valid ? __expf(z - sp - suffix) : 0.f;
            suffix += valid ? sp : 0.f;
#pragma unroll
            for (int c = 0; c < 8; ++c) { const v4u w = *(const GAS v4u*)(vp + c * 8);
                o[c * 8 + 0] += att * bflo(w.x); o[c * 8 + 1] += att * bfhi(w.x); o[c * 8 + 2] += att * bflo(w.y); o[c * 8 + 3] += att * bfhi(w.y);
                o[c * 8 + 4] += att * bflo(w.z); o[c * 8 + 5] += att * bfhi(w.z); o[c * 8 + 6] += att * bflo(w.w); o[c * 8 + 7] += att * bfhi(w.w); }
        }
#pragma unroll
        for (int c = 0; c < 8; ++c) { v4u w; w.x = pk2(o[c * 8 + 0], o[c * 8 + 1]); w.y = pk2(o[c * 8 + 2], o[c * 8 + 3]); w.z = pk2(o[c * 8 + 4], o[c * 8 + 5]); w.w = pk2(o[c * 8 + 6], o[c * 8 + 7]);
            *(GAS v4u*)(Ob + rowq * C + h * HD + c * 8) = w; }
    }
}


typedef float f32x16 __attribute__((ext_vector_type(16)));
constexpr int AT_VP = 192;
constexpr int AT_WAVE_LDS = 32 * AT_VP;
__device__ __forceinline__ int crow32(int reg, int hh) { return (reg & 3) + 8 * (reg >> 2) + 4 * hh; }
__device__ __forceinline__ bf16x8s pack_step(const f32x16& x, const int s) {
    v4u p; p.x = pg8::cvt_pk_bf16(x[8 * s], x[8 * s + 1]); p.y = pg8::cvt_pk_bf16(x[8 * s + 2], x[8 * s + 3]); p.z = pg8::cvt_pk_bf16(x[8 * s + 4], x[8 * s + 5]); p.w = pg8::cvt_pk_bf16(x[8 * s + 6], x[8 * s + 7]);
    return __builtin_bit_cast(bf16x8s, p);
}
__device__ __forceinline__ void attn_mfma(unsigned char* ws, LAS unsigned char* lds, int gw, int NGW, int lane, int wave) {
    const bf16* Kb = (const bf16*)(ws + WS_B1); const bf16* Vb = (const bf16*)(ws + WS_B2); const bf16* Qb = (const bf16*)(ws + WS_B3); bf16* Ob = (bf16*)(ws + WS_B0);
    LAS unsigned char* vl = lds + wave * AT_WAVE_LDS;
    const int r32 = lane & 31, hh = lane >> 5;
    bf16x8s tri[2];
#pragma unroll
    for (int s = 0; s < 2; ++s)
#pragma unroll
        for (int j = 0; j < 8; ++j) tri[s][j] = (16 * s + 8 * (j >> 2) + 4 * hh + (j & 3)) > r32 ? (short)0x3F80 : (short)0;
    const int grp = lane >> 4, tq = (lane & 15) >> 2, tp = lane & 3;
    const LAS unsigned char* vtr0 = vl + (4 * hh + tq) * AT_VP + (16 * (grp & 1) + 4 * tp) * 2;
    for (int unit = gw; unit < BATCH * NH * (SEQ / 32); unit += NGW) {
        const int qb = unit % (SEQ / 32), bh = unit / (SEQ / 32), b = bh / NH, hd = bh % NH;
        const int t0 = qb * 32; const size_t rowb = (size_t)b * SEQ;
        bf16x8s qf[4];
#pragma unroll
        for (int ks = 0; ks < 4; ++ks) qf[ks] = *(const GAS bf16x8s*)(Qb + (rowb + t0 + r32) * C + hd * HD + 16 * ks + 8 * hh);
        f32x16 o[2];
#pragma unroll
        for (int i = 0; i < 16; ++i) { o[0][i] = 0.f; o[1][i] = 0.f; }
        float carry = 0.f;
        for (int s0 = t0; s0 >= 0; s0 -= 32) {
            bf16x8s kf[4];
#pragma unroll
            for (int ks = 0; ks < 4; ++ks) kf[ks] = *(const GAS bf16x8s*)(Kb + (rowb + s0 + r32) * C + hd * HD + 16 * ks + 8 * hh);
            v4u vreg[4];
#pragma unroll
            for (int i = 0; i < 4; ++i) { const int cidx = lane + 64 * i; vreg[i] = *(const GAS v4u*)(Vb + (rowb + s0 + (cidx >> 3)) * C + hd * HD + (cidx & 7) * 8); }
            f32x16 st;
#pragma unroll
            for (int i = 0; i < 16; ++i) st[i] = 0.f;
#pragma unroll
            for (int ks = 0; ks < 4; ++ks) st = __builtin_amdgcn_mfma_f32_32x32x16_bf16(kf[ks], qf[ks], st, 0, 0, 0);
#pragma unroll
            for (int i = 0; i < 4; ++i) { const int cidx = lane + 64 * i; *(LAS v4u*)(vl + (cidx >> 3) * AT_VP + (cidx & 7) * 16) = vreg[i]; }
            f32x16 zz, uu; float tot = 0.f; const int tq_ = t0 + r32;
#pragma unroll
            for (int i = 0; i < 16; ++i) { const int key = s0 + crow32(i, hh); const float z = st[i] * 0.125f; const float sp = fmaxf(z, 0.f) + __logf(1.0f + __expf(-fabsf(z)));
                const bool valid = key < tq_; zz[i] = valid ? z - sp : -1e30f; uu[i] = valid ? sp : 0.f; tot += uu[i]; }
            f32x16 uh, ul;
#pragma unroll
            for (int i = 0; i < 16; i += 2) { const unsigned ph = pg8::cvt_pk_bf16(uu[i], uu[i + 1]); uh[i] = bflo(ph); uh[i + 1] = bfhi(ph); ul[i] = uu[i] - uh[i]; ul[i + 1] = uu[i + 1] - uh[i + 1]; }
            f32x16 w;
#pragma unroll
            for (int i = 0; i < 16; ++i) w[i] = 0.f;
#pragma unroll
            for (int s = 0; s < 2; ++s) { w = __builtin_amdgcn_mfma_f32_32x32x16_bf16(tri[s], pack_step(uh, s), w, 0, 0, 0); w = __builtin_amdgcn_mfma_f32_32x32x16_bf16(tri[s], pack_step(ul, s), w, 0, 0, 0); }
            f32x16 pp;
#pragma unroll
            for (int i = 0; i < 16; ++i) pp[i] = __expf(zz[i] - w[i] - carry);
            tot += shx(tot, 32, lane); carry += tot;
            asm volatile("s_waitcnt lgkmcnt(0)" ::: "memory");
#pragma unroll
            for (int s = 0; s < 2; ++s) { const bf16x8s pa = pack_step(pp, s);
#pragma unroll
                for (int dt = 0; dt < 2; ++dt) {
                    const v4i16_t lo = __builtin_amdgcn_ds_read_tr16_b64_v4i16((LAS v4i16_t*)(vtr0 + (16 * s) * AT_VP + dt * 64));
                    const v4i16_t hi = __builtin_amdgcn_ds_read_tr16_b64_v4i16((LAS v4i16_t*)(vtr0 + (16 * s + 8) * AT_VP + dt * 64));
                    const bf16x8s vf = (bf16x8s){lo[0], lo[1], lo[2], lo[3], hi[0], hi[1], hi[2], hi[3]};
                    o[dt] = __builtin_amdgcn_mfma_f32_32x32x16_bf16(pa, vf, o[dt], 0, 0, 0); } }
            asm volatile("" ::: "memory");
            if (s0 < t0 && __all(carry > SB_EXIT)) break;
        }
#pragma unroll
        for (int dt = 0; dt < 2; ++dt)
#pragma unroll
            for (int i = 0; i < 16; ++i) Ob[(rowb + t0 + crow32(i, hh)) * C + hd * HD + 32 * dt + r32] = (bf16)f2bf(o[dt][i]);
    }
}
__global__ void __launch_bounds__(NWAVES * 64, 2) yoco_fwd(Args args) {
    extern __shared__ __attribute__((aligned(16))) unsigned char lds_raw[];
    LAS unsigned char* lds = (LAS unsigned char*)lds_raw;
    const int G = gridDim.x; const int bx = blockIdx.x;
    int wave = __builtin_amdgcn_readfirstlane(threadIdx.x >> 6); asm volatile("" : "+s"(wave));
#define IDS() int lane; asm volatile("v_mbcnt_lo_u32_b32 %0, -1, 0\n\tv_mbcnt_hi_u32_b32 %0, -1, %0" : "=v"(lane)); const int tid = wave * 64 + lane; (void)tid; \
    const int vcu = (G % 8 == 0) ? (bx % 8) * (G / 8) + bx / 8 : bx; const int gw = vcu * NWAVES + wave, NGW = G * NWAVES; (void)lane; (void)gw; (void)NGW;
    unsigned char* ws = WSP();
    volatile LAS unsigned* MISC = (volatile LAS unsigned*)(lds + MISC_OFF);
    volatile LAS int* tab = (volatile LAS int*)(lds + MOE_TAB_OFF);
    for (int u = threadIdx.x; u < (LDS_BYTES - LDSCTL_OFF) / 4; u += NWAVES * 64) ((LAS unsigned*)(lds + LDSCTL_OFF))[u] = 0u;
    __syncthreads();
    XcdBarrier bar; bar.bar = (unsigned*)(ws + WS_CTL) + CW_BAR; bar.x = 0; bar.st = nullptr;
    if (N_LAUNCHES == 1) bar = xcd_barrier_post((unsigned*)(ws + WS_CTL) + CW_BAR, MISC + 8);
    const int lo = KA_INT(0), hi = KA_INT(1);
#ifndef PROBE_PH
#define PROBE_PH -1
#endif
#define IN(k) (lo <= (k) && (k) < hi)
#define REP(k) for (int rep_ = 0; rep_ < ((PROBE_PH == (k)) ? 2 : 1); ++rep_)
#define SEAM(k) do { if (IN(k) && IN((k) + 1)) xcd_barrier(bar); } while (0)

    if (IN(PH_P0)) REP(PH_P0) { IDS(); p0_weights<0>(ws, lds, gw, NGW, wave, lane); p0_weights<1>(ws, lds, gw, NGW, wave, lane); p0_rows(ws, gw, NGW, lane); }
    SEAM(PH_P0);
    if (PROBE_PH == 100 && N_LAUNCHES == 1) { for (int i_ = 0; i_ < 10; ++i_) xcd_barrier(bar); }
    if (IN(PH_LORA)) REP(PH_LORA) {
        SchedGrouped<1, 3> S{(const char*)(ws + WS_B1), (size_t)(WS_B2 - WS_B1), nullptr, (const char*)(ws + WS_WT_LORA), (size_t)256 * C * 2, G, bx};
        EpiLora E{(bf16*)(ws + WS_LW)};
        pg8::gemm_phase<EpiLora, SchedGrouped<1, 3>, true, false, C>(lds, S, E, wave);
    }
    SEAM(PH_LORA);
    if (IN(PH_RKV)) REP(PH_RKV) {
        SchedGrouped<4, 3> S{(const char*)OUTP(), (size_t)M * C * 2, (const char*)(ws + WS_B4), (const char*)(ws + WS_WT_RKV), (size_t)C * C * 2, G, bx};
        EpiSplit3 E{(bf16*)(ws + WS_B1), false};
        pg8::gemm_phase<EpiSplit3, SchedGrouped<4, 3>, true, false, C>(lds, S, E, wave);
    }
    SEAM(PH_RKV);
    if (IN(PH_S1)) REP(PH_S1) { IDS(); scan_s1(ws, lds, lane, wave); }
    SEAM(PH_S1);
    if (IN(PH_S2)) REP(PH_S2) { IDS();
        if (bx < BATCH * NH || G <= BATCH * NH) scan_s2(ws, lane, wave);
        }
    SEAM(PH_S2);
    if (IN(PH_S3)) REP(PH_S3) { IDS(); scan_s3(ws, lds, lane, wave); }
    SEAM(PH_S3);
#if MK_DEBUG
    if (IN(PH_DBG0)) { IDS(); scan_naive(ws, lds, tid); }
    SEAM(PH_DBG0);
    if (IN(PH_DBG0 + 1)) { IDS(); post_scan(ws, gw, NGW, lane); }
    SEAM(PH_DBG0 + 1);
    if (IN(PH_DBG0 + 2)) { IDS(); dbg_compare(ws, (const bf16*)(ws + WS_B0), (const bf16*)(ws + WS_B4), gw, NGW, lane); }
    SEAM(PH_DBG0 + 2);
#endif
    if (IN(PH_WOUT)) REP(PH_WOUT) {
        SchedGrouped<4, 1> S{(const char*)(ws + ((MK_DEBUG && DBG_USE_NAIVE) ? WS_B4 : WS_B0)), 0, nullptr, (const char*)(ws + WS_WT_OUT), 0, G, bx};
        EpiResid E{INP(0), OUTP()};
        pg8::gemm_phase<EpiResid, SchedGrouped<4, 1>, true, false, C>(lds, S, E, wave);
    }
    SEAM(PH_WOUT);
#pragma unroll 1
    for (int layer = 0; layer < 2; ++layer) {
        const int pb = layer == 0 ? (int)PH_ROUT0 : (int)PH_ROUT1;
        if (IN(pb)) { IDS(); if (PROBE_PH == 101 && layer == 0) router_rows(ws, lds, layer, gw, NGW, lane, tid, true); router_rows(ws, lds, layer, gw, NGW, lane, tid); }
        SEAM(pb);
        if (IN(pb + 1)) REP(pb + 1) {
            { IDS(); moe_table(ws, tab, layer, tid); }
            SchedMoe<2, C, true> S{(const char*)(ws + WS_B1), (const char*)(ws + WS_WT_GU) + (size_t)layer * 16 * 512 * C * 2, (size_t)512 * C * 2, (const unsigned*)(ws + WS_LIST), tab, G, bx};
            EpiGU E{(bf16*)(ws + WS_HID), (const float*)(ws + WS_WL)};
            pg8::gemm_phase<EpiGU, SchedMoe<2, C, true>, true, true, C>(lds, S, E, wave);
        }
        SEAM(pb + 1);
        if (IN(pb + 2)) REP(pb + 2) {
            { IDS(); moe_table(ws, tab, layer, tid); }
            SchedMoe<4, FE, false> S{(const char*)(ws + WS_HID), (const char*)(ws + WS_WT_DN) + (size_t)layer * 16 * C * FE * 2, (size_t)C * FE * 2, (const unsigned*)(ws + WS_LIST), tab, G, bx};
            EpiDown E{(bf16*)(ws + WS_B2), (const unsigned*)(ws + WS_LIST)};
            pg8::gemm_phase<EpiDown, SchedMoe<4, FE, false>, true, false, FE>(lds, S, E, wave);
        }
        SEAM(pb + 2);
        if (layer == 0) {
            if (IN(PH_COMB)) { IDS(); if (PROBE_PH == 102) combine_rows(ws, 0, gw, NGW, lane, true); combine_rows(ws, 0, gw, NGW, lane); }
            SEAM(PH_COMB);
            if (IN(PH_KVQ)) REP(PH_KVQ) {
                SchedGrouped<12, 1> S{(const char*)(ws + WS_B0), 0, nullptr, (const char*)(ws + WS_WT_KVQ), 0, G, bx};
                EpiSplit3 E{(bf16*)(ws + WS_B1), true};
                pg8::gemm_phase<EpiSplit3, SchedGrouped<12, 1>, true, false, C>(lds, S, E, wave);
            }
            SEAM(PH_KVQ);
            if (IN(PH_ATTN)) REP(PH_ATTN) { IDS(); attn_mfma(ws, lds, gw, NGW, lane, wave); }
            SEAM(PH_ATTN);
            if (IN(PH_SBO)) {
                SchedGrouped<4, 1> S{(const char*)(ws + WS_B0), 0, nullptr, (const char*)(ws + WS_WT_SBO), 0, G, bx};
                EpiResid E{OUTP(), OUTP()};
                pg8::gemm_phase<EpiResid, SchedGrouped<4, 1>, true, false, C>(lds, S, E, wave);
            }
            SEAM(PH_SBO);
        }
    }
    if (IN(PH_FINAL)) { IDS(); combine_rows(ws, 1, gw, NGW, lane); }
#undef IN
#undef SEAM
}

extern "C" void kernel_launch(void* const* d_in, const int* in_sizes, int n_in, void* d_out, int out_size, void* d_ws, size_t ws_size, hipStream_t stream) {
    static int grid = 0;
    if (grid == 0) {
        if (n_in != 31 || in_sizes[0] != M * C || out_size != M * C || ws_size < WS_END) { fprintf(stderr, "kernel_launch: unexpected shapes (n_in %d, in0 %d, out %d, ws %zu); nothing launched\n", n_in, n_in > 0 ? in_sizes[0] : -1, out_size, ws_size); grid = -1; return; }
        int dev = 0, cus = 0, per_cu = 0;
        if (hipGetDevice(&dev) != hipSuccess || hipDeviceGetAttribute(&cus, hipDeviceAttributeMultiprocessorCount, dev) != hipSuccess) { grid = -1; return; }
        if (hipFuncSetAttribute((const void*)yoco_fwd, hipFuncAttributeMaxDynamicSharedMemorySize, LDS_BYTES) != hipSuccess) { fprintf(stderr, "kernel_launch: hipFuncSetAttribute failed\n"); grid = -1; return; }
        if (hipOccupancyMaxActiveBlocksPerMultiprocessor(&per_cu, (const void*)yoco_fwd, NWAVES * 64, LDS_BYTES) != hipSuccess || per_cu < 1) fprintf(stderr, "kernel_launch: occupancy query reports %d\n", per_cu);
        (void)hipGetLastError();
        grid = cus - (cus % 16);
    }
    if (grid < 0) return;
    if (hipMemsetAsync((char*)d_ws + WS_CTL, 0, CTL_ZERO_BYTES, stream) != hipSuccess) return;
    Args a{};
    for (int i = 0; i < 31; ++i) a.in[i] = (const float*)d_in[i];
    a.out = (float*)d_out; a.ws = (unsigned char*)d_ws;
    for (int li = 0; li < (N_LAUNCHES == 1 ? 1 : (int)NPHASE); ++li) {
        a.ph_lo = (N_LAUNCHES == 1) ? 0 : li; a.ph_hi = (N_LAUNCHES == 1) ? NPHASE : li + 1; a.li = li;
        hipLaunchKernelGGL(yoco_fwd, dim3(grid), dim3(NWAVES * 64), LDS_BYTES, stream, a);
        const hipError_t le = hipPeekAtLastError();
        if (le != hipSuccess) { fprintf(stderr, "kernel_launch: launch %d failed: %s\n", li, hipGetErrorName(le)); break; }
    }
}
```

```cpp
#include <hip/hip_runtime.h>
#include <cstdio>
#include <cstdint>

#ifndef MK_N_LAUNCHES
#define MK_N_LAUNCHES 1
#endif

namespace pg8 {
#define PG8_LAS __attribute__((address_space(3)))
typedef unsigned short bf16_t;
typedef short bf16x8 __attribute__((ext_vector_type(8)));
typedef float f32x4 __attribute__((ext_vector_type(4)));
typedef unsigned u32x4 __attribute__((ext_vector_type(4)));
constexpr int BM = 256, BK = 64, HALF = 128, HTB = HALF * BK * 2, STAGE_BYTES = 8 * HTB, NXCD = 8, WGM = 8;

__host__ __device__ __forceinline__ int lds_byte(int r, int c) { const int st = (r >> 4) * 2 + (c >> 5), rr = r & 15, cc = c & 31, ob = rr * 64 + cc * 2; return st * 1024 + (ob ^ (((ob >> 9) & 1) << 5)); }
__host__ __device__ __forceinline__ void stage_rc(int b, int& R, int& C) { const int st = b / 1024, sb = b % 1024, swz = sb ^ (((sb >> 9) & 1) << 5); R = (st >> 1) * 16 + swz / 64; C = (st & 1) * 32 + (swz % 64) / 2; }
__host__ __device__ __forceinline__ int perm32(int rho) { const int n = rho >> 4, i = rho & 15; return 8 * (i >> 2) + 4 * n + (i & 3); }

struct Unit { int pm, pn, aux, r0, cnt; };

__host__ __device__ __forceinline__ void tile_map(int wgid, int nM, int nN, int& pm, int& pn) {
    const int nwg = nM * nN;
    { const int q = nwg / NXCD, r = nwg % NXCD, xcd = wgid % NXCD, off = wgid / NXCD; wgid = (xcd < r ? xcd * (q + 1) : r * (q + 1) + (xcd - r) * q) + off; }
    const int nig = WGM * nN, gid = wgid / nig, fm = gid * WGM, gsz = (nM - fm) < WGM ? (nM - fm) : WGM;
    pm = fm + ((wgid % nig) % gsz); pn = (wgid % nig) / gsz;
}

typedef float f32x2_t __attribute__((ext_vector_type(2))); typedef __bf16 bf16x2_t __attribute__((ext_vector_type(2)));
__device__ __forceinline__ unsigned cvt_pk_bf16(float lo, float hi) { const f32x2_t v = {lo, hi}; const bf16x2_t b = __builtin_convertvector(v, bf16x2_t); return __builtin_bit_cast(unsigned, b); }

template <class Epi, class Sched, bool ALIGN_EPI, bool GATHER, int K>
__device__ __forceinline__ void gemm_phase(PG8_LAS unsigned char* lds, const Sched& S, const Epi& E, const int wid) {
    int lane_; asm volatile("v_mbcnt_lo_u32_b32 %0, -1, 0\n\tv_mbcnt_hi_u32_b32 %0, -1, %0" : "=v"(lane_));
    const int lane = lane_, tid = wid * 64 + lane, wr = wid >> 2, wc = wid & 3, fr = lane & 15, fq = lane >> 4;
    constexpr int nt = K / BK;
    unsigned voffA[2], voffB[2];
#pragma unroll
    for (int i = 0; i < 2; ++i) { int R, C; stage_rc(tid * 16 + i * 8192, R, C); const int Rb = Epi::PERM ? ((R & ~31) + perm32(R & 31)) : R;
        voffA[i] = (unsigned)(R * K + C) * 2u; voffB[i] = (unsigned)(Rb * K + C) * 2u; }
    constexpr size_t kstep = (size_t)(BK * 2);
    constexpr size_t hstep = (size_t)HALF * K * 2;
    const unsigned ldsw = (unsigned)wid * 1024u;
    const int aoff = lds_byte(wr * 64 + fr, fq * 8), boff = lds_byte(wc * 32 + fr, fq * 8);
#define PG8_SA(b, h) (((b) * 2 + (h)) * HTB)
#define PG8_SB(b, h) ((4 + (b) * 2 + (h)) * HTB)
#define PG8_STAGE(bufoff, gbase, voff) do { _Pragma("unroll") for (int _i = 0; _i < 2; ++_i) \
        __builtin_amdgcn_global_load_lds((const unsigned*)((const char*)(gbase) + (voff)[_i]), (PG8_LAS unsigned*)(lds + (bufoff) + ldsw + _i * 8192), 16, 0, 0); } while (0)
#define PG8_LDA(dst, b, h) do { _Pragma("unroll") for (int m = 0; m < 4; ++m) _Pragma("unroll") for (int k = 0; k < 2; ++k) dst[m][k] = *(const PG8_LAS bf16x8*)(lds + PG8_SA(b, h) + aoff + m * 2048 + k * 1024); } while (0)
#define PG8_LDB(dst, b, h) do { _Pragma("unroll") for (int n = 0; n < 2; ++n) _Pragma("unroll") for (int k = 0; k < 2; ++k) dst[n][k] = *(const PG8_LAS bf16x8*)(lds + PG8_SB(b, h) + boff + n * 2048 + k * 1024); } while (0)
#define PG8_MMA(ai, bj, At, Bt) do { __builtin_amdgcn_s_setprio(1); _Pragma("unroll") for (int m = 0; m < 4; ++m) _Pragma("unroll") for (int n = 0; n < 2; ++n) _Pragma("unroll") for (int k = 0; k < 2; ++k) \
        acc[ai][bj][m][n] = __builtin_amdgcn_mfma_f32_16x16x32_bf16(Bt[n][k], At[m][k], acc[ai][bj][m][n], 0, 0, 0); __builtin_amdgcn_s_setprio(0); } while (0)
#define PG8_WAIT_V(n) asm volatile("s_waitcnt vmcnt(" #n ")" ::: "memory")
#define PG8_WAIT_L(n) asm volatile("s_waitcnt lgkmcnt(" #n ")" ::: "memory")
#define PG8_BAR __builtin_amdgcn_s_barrier()
#define PG8_SCHED __builtin_amdgcn_sched_barrier(0)
    Unit cur, nxt; int ui = 0;
    if (!S.next(0, cur)) return;
    f32x4 acc[2][2][4][2];
#pragma unroll
    for (int a = 0; a < 2; ++a)
#pragma unroll
        for (int b = 0; b < 2; ++b)
#pragma unroll
            for (int m = 0; m < 4; ++m)
#pragma unroll
                for (int n = 0; n < 2; ++n) acc[a][b][m][n] = (f32x4){0.f, 0.f, 0.f, 0.f};
    bf16x8 At[4][2], B0[2][2], B1[2][2];
    unsigned vc[2][2];
#define PG8_GOFF(u) do { _Pragma("unroll") for (int _h = 0; _h < 2; ++_h) _Pragma("unroll") for (int _i = 0; _i < 2; ++_i) { int _R, _C; stage_rc(tid * 16 + _i * 8192, _R, _C); \
        vc[_h][_i] = S.a_row_off(u, _h * HALF + _R) + (unsigned)_C * 2u; } } while (0)
#define PG8_STAGE_A(bufoff, gbase, h) do { if constexpr (GATHER) { PG8_STAGE(bufoff, gbase, vc[h]); } else { PG8_STAGE(bufoff, (gbase) + (h) * hstep, voffA); } } while (0)
    if constexpr (GATHER) PG8_GOFF(cur);
    const char* cA = S.a_base(cur); const char* cB = S.b_base(cur);
    PG8_STAGE(PG8_SB(0, 0), cB, voffB); PG8_STAGE(PG8_SB(0, 1), cB + hstep, voffB); PG8_STAGE_A(PG8_SA(0, 0), cA, 0); PG8_STAGE_A(PG8_SA(0, 1), cA, 1);
    if (wr == 1) PG8_BAR;
    PG8_WAIT_V(2); PG8_BAR;
    PG8_STAGE(PG8_SB(1, 0), cB + kstep, voffB); PG8_STAGE_A(PG8_SA(1, 0), cA + kstep, 0); PG8_STAGE(PG8_SB(1, 1), cB + hstep + kstep, voffB);
    PG8_WAIT_V(6); PG8_BAR;
    for (;;) {
        const bool has_next = S.next(ui + 1, nxt);
        const char* nA = has_next ? S.a_base(nxt) : cA; const char* nB = has_next ? S.b_base(nxt) : cB;
        for (int t = 0; t < nt; t += 2) {
            const bool last = (t == nt - 2);
            const char* a1 = cA + (size_t)(t + 1) * kstep;
            const char* a2 = last ? nA : cA + (size_t)(t + 2) * kstep; const char* b2 = last ? nB : cB + (size_t)(t + 2) * kstep;
            const char* a3 = a2 + kstep; const char* b3 = b2 + kstep;
            PG8_LDB(B0, 0, 0); PG8_LDB(B1, 0, 1); PG8_SCHED; PG8_LDA(At, 0, 0); PG8_STAGE_A(PG8_SA(1, 1), a1, 1);
            if constexpr (GATHER) { if (last && has_next) PG8_GOFF(nxt); }
            PG8_WAIT_V(8); PG8_WAIT_L(0); PG8_BAR; PG8_MMA(0, 0, At, B0); PG8_MMA(0, 1, At, B1); PG8_BAR; PG8_SCHED;
            PG8_LDA(At, 0, 1); PG8_STAGE(PG8_SB(0, 0), b2, voffB); PG8_STAGE(PG8_SB(0, 1), b2 + hstep, voffB); PG8_STAGE_A(PG8_SA(0, 0), a2, 0);
            PG8_WAIT_V(8); PG8_WAIT_L(0); PG8_BAR; PG8_MMA(1, 0, At, B0); PG8_MMA(1, 1, At, B1); PG8_BAR; PG8_SCHED;
            PG8_LDB(B0, 1, 0); PG8_LDB(B1, 1, 1); PG8_SCHED; PG8_LDA(At, 1, 0); PG8_STAGE_A(PG8_SA(0, 1), a2, 1);
            PG8_WAIT_V(8); PG8_WAIT_L(0); PG8_BAR; PG8_MMA(0, 0, At, B0); PG8_MMA(0, 1, At, B1); PG8_BAR; PG8_SCHED;
            PG8_LDA(At, 1, 1); PG8_STAGE(PG8_SB(1, 0), b3, voffB); PG8_STAGE(PG8_SB(1, 1), b3 + hstep, voffB); PG8_STAGE_A(PG8_SA(1, 0), a3, 0);
            PG8_WAIT_V(8); PG8_WAIT_L(0); PG8_BAR; PG8_MMA(1, 0, At, B0); PG8_MMA(1, 1, At, B1); PG8_BAR; PG8_SCHED;
        }
        if constexpr (ALIGN_EPI) { if (wr == 0) PG8_BAR; }
        E(acc, cur, wr, wc, fr, fq);
        if (!has_next) break;
#pragma unroll
        for (int a = 0; a < 2; ++a)
#pragma unroll
            for (int b = 0; b < 2; ++b)
#pragma unroll
                for (int m = 0; m < 4; ++m)
#pragma unroll
                    for (int n = 0; n < 2; ++n) acc[a][b][m][n] = (f32x4){0.f, 0.f, 0.f, 0.f};
        cur = nxt; cA = nA; cB = nB; ++ui;
        if constexpr (ALIGN_EPI) { if (wr == 1) PG8_BAR; }
    }
    PG8_WAIT_V(0);
    if constexpr (!ALIGN_EPI) { if (wr == 0) PG8_BAR; }
    PG8_BAR;
#undef PG8_SA
#undef PG8_SB
#undef PG8_STAGE
#undef PG8_STAGE_A
#undef PG8_GOFF
#undef PG8_LDA
#undef PG8_LDB
#undef PG8_MMA
#undef PG8_WAIT_V
#undef PG8_WAIT_L
#undef PG8_BAR
#undef PG8_SCHED
}
}

constexpr int NWAVES = 8;
#ifndef MK_DEBUG
#define MK_DEBUG 0
#endif
#ifndef DBG_USE_NAIVE
#define DBG_USE_NAIVE 0
#endif
constexpr int DBGP = MK_DEBUG ? 3 : 0;
enum Phase { PH_P0 = 0, PH_LORA, PH_RKV, PH_S1, PH_S2, PH_S3, PH_DBG0, PH_WOUT = PH_DBG0 + DBGP, PH_ROUT0, PH_GU0, PH_DN0, PH_COMB, PH_KVQ, PH_ATTN, PH_SBO, PH_ROUT1, PH_GU1, PH_DN1, PH_FINAL, NPHASE };
constexpr int N_LAUNCHES = MK_N_LAUNCHES;


constexpr int BATCH = 2, SEQ = 8192, C = 1024, NH = 16, HD = 64, M = BATCH * SEQ;
constexpr int NE = 16, FE = 256, DW = 64, DA = 64, DG = 160;
constexpr float RMS_EPS = 1e-6f, GN_EPS = 64e-5f;
constexpr float SB_EXIT = 104.0f;

constexpr size_t MiB = 1u << 20;
constexpr size_t WS_CTL = 0, CTL_ZERO_BYTES = 64 * 1024;
constexpr size_t WS_WT_W2 = 128 * 1024, WS_WT_A2 = 256 * 1024, WS_WT_G2 = 384 * 1024;
constexpr size_t WS_WT_RKV = 1 * MiB;
constexpr size_t WS_WT_LORA = 7 * MiB;
constexpr size_t WS_WT_OUT = 9 * MiB;
constexpr size_t WS_WT_KVQ = 11 * MiB;
constexpr size_t WS_WT_SBO = 17 * MiB;
constexpr size_t WS_WT_GU = 19 * MiB;
constexpr size_t WS_WT_DN = 51 * MiB;
constexpr size_t WS_LW = 67 * MiB;
constexpr size_t WS_LA = 69 * MiB;
constexpr size_t WS_LG = 71 * MiB;
static_assert(WS_LA == WS_LW + 2 * MiB && WS_LG == WS_LW + 4 * MiB, "EpiLora's pointer arithmetic");
constexpr size_t WS_LIST = 76 * MiB;
constexpr size_t WS_WL = 77 * MiB;
constexpr size_t WS_HID = 78 * MiB;
constexpr size_t WS_B0 = 96 * MiB, WS_B1 = 128 * MiB, WS_B2 = 160 * MiB, WS_B3 = 192 * MiB, WS_B4 = 224 * MiB, WS_END = 256 * MiB;
static_assert(WS_HID + (size_t)144 * 256 * 256 * 2 <= WS_B0, "HID vs B0");
constexpr int CW_TMO = 0;
constexpr int CW_CNT = 1024;
constexpr int CW_BAR = 4096;

constexpr int RING_BYTES = 131072;
constexpr int LDSCTL_OFF = 146688, MISC_OFF = LDSCTL_OFF + 320, MOE_TAB_OFF = MISC_OFF + 128;
constexpr int LDS_BYTES = 147456;
static_assert(MOE_TAB_OFF + 256 <= LDS_BYTES, "LDS map");
static_assert(BATCH * NH * (SEQ / 64) % 16 == 0, "scan units");

#define GAS __attribute__((address_space(1)))
#define LAS __attribute__((address_space(3)))
typedef unsigned short bf16;
typedef unsigned v4u __attribute__((ext_vector_type(4)));
typedef unsigned v2u __attribute__((ext_vector_type(2)));
typedef float f32x4 __attribute__((ext_vector_type(4)));
typedef GAS unsigned gu32;
#define RLX_AGENT __ATOMIC_RELAXED, __HIP_MEMORY_SCOPE_AGENT
#define LDS_WAIT() asm volatile("s_waitcnt lgkmcnt(0)" ::: "memory")
#define VM_WAIT() asm volatile("s_waitcnt vmcnt(0)" ::: "memory")
__device__ __forceinline__ unsigned f2bf(float f) { unsigned u = __builtin_bit_cast(unsigned, f); return (u + 0x7fffu + ((u >> 16) & 1u)) >> 16; }
__device__ __forceinline__ unsigned pk2(float lo, float hi) { return f2bf(lo) | (f2bf(hi) << 16); }
__device__ __forceinline__ float bflo(unsigned u) { return __uint_as_float(u << 16); }
__device__ __forceinline__ float bfhi(unsigned u) { return __uint_as_float(u & 0xffff0000u); }
__device__ __forceinline__ float bf2f(bf16 b) { return __uint_as_float((unsigned)b << 16); }
__device__ __forceinline__ float sigmoidf_(float x) { return 1.0f / (1.0f + __expf(-x)); }

#define XB_TMO      128
#define XB_XCNT(j)  (256  + 64 * (j))
#define XB_XSUB(j)  (1280 + 64 * (j))
#define XB_XGEN(j)  (2304 + 64 * (j))
#define XB_TOP      3328
#define XB_TOPGEN   3392
#define XCD_BAR_WORDS 3456
#define XB_SPIN_CAP (1u << 18)
__device__ __forceinline__ unsigned xb_ld(unsigned* p)              { return __hip_atomic_load(p, __ATOMIC_RELAXED, __HIP_MEMORY_SCOPE_AGENT); }
__device__ __forceinline__ unsigned xb_add(unsigned* p, unsigned v) { return __hip_atomic_fetch_add(p, v, __ATOMIC_RELAXED, __HIP_MEMORY_SCOPE_AGENT); }
__device__ __forceinline__ unsigned xb_xcc_id() { return (unsigned)__builtin_amdgcn_s_getreg((3 << 11) | 20) & 0xFu; }
#define XB_SPIN(cond, bar) do { unsigned _sp = 0; while (cond) { __builtin_amdgcn_s_sleep(1); \
    if ((++_sp & 255u) == 0u) { if (xb_ld(&(bar)[XB_TMO])) break; if (_sp > XB_SPIN_CAP) { atomicAdd(&(bar)[XB_TMO], 1u); break; } } } } while (0)
struct XcdBarrier { unsigned* bar; unsigned x; volatile LAS unsigned* st; };
__device__ __forceinline__ XcdBarrier xcd_barrier_post(unsigned* bar, volatile LAS unsigned* st) {
    XcdBarrier b; b.bar = bar; b.x = xb_xcc_id(); b.st = st;
    if (threadIdx.x == 0) (void)xb_add(&bar[XB_XCNT(b.x)], 1u);
    return b;
}
__device__ __forceinline__ void xcd_barrier_complete(unsigned* bar, unsigned x, unsigned& nloc, unsigned& nx) {
    const unsigned G = gridDim.x * gridDim.y * gridDim.z;
    unsigned sum, cnt, mine, sp = 0u;
    for (;;) {
        sum = 0u; cnt = 0u; mine = 0u;
#pragma unroll
        for (unsigned j = 0; j < 16; ++j) { const unsigned c = xb_ld(&bar[XB_XCNT(j)]); sum += c; cnt += (c > 0u) ? 1u : 0u; mine = (j == x) ? c : mine; }
        if (sum == G) break;
        __builtin_amdgcn_s_sleep(1);
        if ((++sp & 255u) == 0u) { if (xb_ld(&bar[XB_TMO])) break; if (sp > XB_SPIN_CAP) { atomicAdd(&bar[XB_TMO], 1u); break; } }
    }
    nloc = mine > 0u ? mine : 1u; nx = cnt > 0u ? cnt : 1u;
}
__device__ __forceinline__ void xcd_barrier(const XcdBarrier& b) {
    asm volatile("s_waitcnt vmcnt(0)" ::: "memory");
    __syncthreads();
    if (threadIdx.x == 0) {
        unsigned* bar = b.bar;
        __builtin_amdgcn_s_waitcnt(0);
        unsigned nloc = b.st[0], nx = b.st[1];
        if (nloc == 0u) { xcd_barrier_complete(bar, b.x, nloc, nx); b.st[0] = nloc; b.st[1] = nx; }
        const unsigned old = xb_add(&bar[XB_XSUB(b.x)], 1u);
        const unsigned gen = old / nloc;
        if (old + 1u == (gen + 1u) * nloc) {
            __builtin_amdgcn_fence(__ATOMIC_RELEASE, "agent");
            asm volatile("s_waitcnt vmcnt(0)" ::: "memory");
            const unsigned og = xb_add(&bar[XB_TOP], 1u);
            const unsigned tg = og / nx;
            if (og + 1u == (tg + 1u) * nx) xb_add(&bar[XB_TOPGEN], 1u);
            else XB_SPIN(xb_ld(&bar[XB_TOPGEN]) == tg, bar);
            __builtin_amdgcn_fence(__ATOMIC_ACQUIRE, "agent");
            xb_add(&bar[XB_XGEN(b.x)], 1u);
            asm volatile("s_waitcnt vmcnt(0)" ::: "memory");
        } else {
            XB_SPIN(xb_ld(&bar[XB_XGEN(b.x)]) == gen, bar);
            __builtin_amdgcn_fence(__ATOMIC_ACQUIRE, "agent");
            asm volatile("s_waitcnt vmcnt(0)" ::: "memory");
        }
    }
    __syncthreads();
}

__device__ __forceinline__ float shx(float v, int o, int lane) { return __int_as_float(__builtin_amdgcn_ds_bpermute((lane ^ o) << 2, __float_as_int(v))); }
__device__ __forceinline__ float wave_sum(float v, int lane) {
#pragma unroll
    for (int o = 1; o < 64; o <<= 1) v += shx(v, o, lane);
    return v;
}
__device__ __forceinline__ void transpose_item(const float* W, int ldw, int k0, int n0, bf16* WT, int ldk, int dst_row0, const float* kscale, LAS float* scr, int lane, int kmax = 1 << 30) {
    const int r8 = lane >> 3, quad = lane & 7;
    f32x4 v[8];
#pragma unroll
    for (int i = 0; i < 8; ++i) { const int kk = r8 + 8 * i; v[i] = (k0 + kk < kmax) ? *(const GAS f32x4*)(W + (size_t)(k0 + kk) * ldw + n0 + quad * 4) : (f32x4){0.f, 0.f, 0.f, 0.f}; }
#pragma unroll
    for (int i = 0; i < 8; ++i) { const int kk = r8 + 8 * i; if (kscale) v[i] = v[i] * kscale[(k0 + kk < kmax) ? k0 + kk : 0]; *(LAS f32x4*)(scr + kk * 36 + ((quad ^ i) << 2)) = v[i]; }
    LDS_WAIT(); asm volatile("" ::: "memory");
    const int c = lane & 7;
#pragma unroll
    for (int j = 0; j < 4; ++j) { const int n = (lane >> 3) + 8 * j; const LAS float* sp = scr + (8 * c) * 36 + ((((n >> 2) ^ c) << 2) | (n & 3));
        v4u o; o.x = pk2(sp[0 * 36], sp[1 * 36]); o.y = pk2(sp[2 * 36], sp[3 * 36]); o.z = pk2(sp[4 * 36], sp[5 * 36]); o.w = pk2(sp[6 * 36], sp[7 * 36]);
        if (k0 + 8 * c < kmax) *(GAS v4u*)(WT + (size_t)(dst_row0 + n) * ldk + k0 + 8 * c) = o; }
    LDS_WAIT(); asm volatile("" ::: "memory");
}

struct Args { const float* in[31]; float* out; unsigned char* ws; int ph_lo, ph_hi, li, pad; };
typedef const __attribute__((address_space(4))) unsigned char* kaptr_t;
__device__ __forceinline__ kaptr_t ka_base() { kaptr_t p = (kaptr_t)__builtin_amdgcn_kernarg_segment_ptr(); asm volatile("" : "+s"(p)); return p; }
#define INP(k) (*(const float* const __attribute__((address_space(4)))*)(ka_base() + 8 * (k)))
#define OUTP() (*(float* const __attribute__((address_space(4)))*)(ka_base() + 8 * 31))
#define WSP() (*(unsigned char* const __attribute__((address_space(4)))*)(ka_base() + 8 * 32))
#define KA_INT(i) (*(const int __attribute__((address_space(4)))*)(ka_base() + 8 * 33 + 4 * (i)))

template <int PART> __device__ __forceinline__ void p0_weights(unsigned char* ws, LAS unsigned char* lds, int gw, int NGW, int wave, int lane) {
    LAS float* scr = (LAS float*)(lds + wave * 16384);
    bf16* WT_RKV = (bf16*)(ws + WS_WT_RKV); bf16* WT_LORA = (bf16*)(ws + WS_WT_LORA); bf16* WT_OUT = (bf16*)(ws + WS_WT_OUT); bf16* WT_KVQ = (bf16*)(ws + WS_WT_KVQ);
    bf16* WT_SBO = (bf16*)(ws + WS_WT_SBO); bf16* WT_GU = (bf16*)(ws + WS_WT_GU); bf16* WT_DN = (bf16*)(ws + WS_WT_DN);
    constexpr int I_UP = 32 + 32 + 96, I_RKV = 3 * 512, I_LORA = 32 + 32 + 80, I_OUT = 512, I_KV = 1024, I_Q = 512, I_SBO = 512, I_G = 32 * 128, I_U = 32 * 128, I_D = 32 * 128;
    constexpr int NDENSE = I_UP + I_RKV + I_LORA + I_OUT + I_KV + I_Q + I_SBO, NITEMS = NDENSE + I_G + I_U + I_D;
    for (int it = (PART == 0 ? 0 : NDENSE) + gw; it < (PART == 0 ? NDENSE : NITEMS); it += NGW) {
        int r = it;
        if (r < I_UP) {
            if (r < 32) transpose_item(INP(9), C, 0, 32 * r, (bf16*)(ws + WS_WT_W2), 64, 32 * r, nullptr, scr, lane);
            else if (r < 64) transpose_item(INP(12), C, 0, 32 * (r - 32), (bf16*)(ws + WS_WT_A2), 64, 32 * (r - 32), nullptr, scr, lane);
            else { const int q = r - 64, kb = q / 32, nb = q % 32; transpose_item(INP(14), C, 64 * kb, 32 * nb, (bf16*)(ws + WS_WT_G2), DG, 32 * nb, nullptr, scr, lane, DG); }
            continue; } r -= I_UP;
        if (r < I_RKV) { const int m = r / 512, q = r % 512, kb = q / 32, nb = q % 32; transpose_item(INP(6) + (size_t)m * C * C, C, 64 * kb, 32 * nb, WT_RKV, C, m * C + 32 * nb, nullptr, scr, lane); continue; } r -= I_RKV;
        if (r < I_LORA) {
            if (r < 32) { const int kb = r / 2, nb = r % 2; transpose_item(INP(8), DW, 64 * kb, 32 * nb, WT_LORA, C, 32 * nb, nullptr, scr, lane); }
            else if (r < 64) { const int q = r - 32, kb = q / 2, nb = q % 2; transpose_item(INP(11), DA, 64 * kb, 32 * nb, WT_LORA, C, 256 + 32 * nb, nullptr, scr, lane); }
            else { const int q = r - 64, kb = q / 5, nb = q % 5; transpose_item(INP(13), DG, 64 * kb, 32 * nb, WT_LORA, C, 512 + 32 * nb, nullptr, scr, lane); }
            continue; } r -= I_LORA;
        if (r < I_OUT) { const int kb = r / 32, nb = r % 32; transpose_item(INP(20), C, 64 * kb, 32 * nb, WT_OUT, C, 32 * nb, nullptr, scr, lane); continue; } r -= I_OUT;
        if (r < I_KV) { const int kb = r / 64, nb = r % 64; transpose_item(INP(21), 2 * C, 64 * kb, 32 * nb, WT_KVQ, C, 32 * nb, INP(3), scr, lane); continue; } r -= I_KV;
        if (r < I_Q) { const int kb = r / 32, nb = r % 32; transpose_item(INP(22), C, 64 * kb, 32 * nb, WT_KVQ, C, 2 * C + 32 * nb, INP(1) + C, scr, lane); continue; } r -= I_Q;
        if (r < I_SBO) { const int kb = r / 32, nb = r % 32; transpose_item(INP(23), C, 64 * kb, 32 * nb, WT_SBO, C, 32 * nb, nullptr, scr, lane); continue; } r -= I_SBO;
        if (r < I_G) { const int le = r / 128, q = r % 128, kb = q / 8, nb = q % 8, f0 = 32 * nb; transpose_item(INP(28) + (size_t)le * C * FE, FE, 64 * kb, f0, WT_GU + (size_t)le * 512 * C, C, 256 * (f0 / 128) + (f0 % 128), nullptr, scr, lane); continue; } r -= I_G;
        if (r < I_U) { const int le = r / 128, q = r % 128, kb = q / 8, nb = q % 8, f0 = 32 * nb; transpose_item(INP(29) + (size_t)le * C * FE, FE, 64 * kb, f0, WT_GU + (size_t)le * 512 * C, C, 256 * (f0 / 128) + 128 + (f0 % 128), nullptr, scr, lane); continue; } r -= I_U;
        { const int le = r / 128, q = r % 128, kb = q / 32, nb = q % 32; transpose_item(INP(30) + (size_t)le * FE * C, C, 64 * kb, 32 * nb, WT_DN + (size_t)le * C * FE, FE, 32 * nb, nullptr, scr, lane); }
    }
    if (PART == 0) for (int it = gw * 64 + lane; it < 768 * 128; it += NGW * 64) { const int row = it >> 7, ch = it & 127;
        const bool valid = (row < 64) || (row >= 256 && row < 320) || (row >= 512 && row < 672);
        if (!valid) *(GAS v4u*)(WT_LORA + (size_t)row * C + ch * 8) = (v4u){0u, 0u, 0u, 0u}; }
}
__device__ __forceinline__ void load_row(const float* p, int lane, f32x4 (&v)[4]) {
#pragma unroll
    for (int j = 0; j < 4; ++j) v[j] = ((const GAS f32x4*)p)[64 * j + lane];
}
__device__ __forceinline__ float row_rs(const f32x4 (&v)[4], int lane) {
    float s = 0.f;
#pragma unroll
    for (int j = 0; j < 4; ++j) s += (v[j].x * v[j].x + v[j].y * v[j].y) + (v[j].z * v[j].z + v[j].w * v[j].w);
    return 1.0f / sqrtf(wave_sum(s, lane) * (1.0f / C) + RMS_EPS);
}
__device__ __forceinline__ void store_row_bf16(bf16* p, int lane, const f32x4 (&v)[4]) {
#pragma unroll
    for (int j = 0; j < 4; ++j) { v2u o; o.x = pk2(v[j].x, v[j].y); o.y = pk2(v[j].z, v[j].w); ((GAS v2u*)p)[64 * j + lane] = o; }
}
__device__ __forceinline__ void p0_rows(unsigned char* ws, int gw, int NGW, int lane) {
    const float* x = INP(0); const float* gain = INP(1); const float* mix = INP(5);
    f32x4 g[4]; load_row(gain, lane, g);
    for (int run = gw; run < M / 8; run += NGW) {
        const int r0 = run * 8;
        f32x4 prev[4];
        if ((r0 % SEQ) == 0) {
#pragma unroll
            for (int j = 0; j < 4; ++j) prev[j] = (f32x4){0.f, 0.f, 0.f, 0.f};
        } else { load_row(x + (size_t)(r0 - 1) * C, lane, prev); const float rs = row_rs(prev, lane);
#pragma unroll
            for (int j = 0; j < 4; ++j) prev[j] = prev[j] * rs * g[j]; }
        for (int rr = 0; rr < 8; ++rr) {
            const int row = r0 + rr;
            f32x4 hn[4]; load_row(x + (size_t)row * C, lane, hn); const float rs = row_rs(hn, lane);
#pragma unroll
            for (int j = 0; j < 4; ++j) hn[j] = hn[j] * rs * g[j];
#pragma unroll
            for (int i = 0; i < 6; ++i) { f32x4 o[4];
#pragma unroll
                for (int j = 0; j < 4; ++j) { const f32x4 mx = ((const GAS f32x4*)(mix + i * C))[64 * j + lane]; o[j] = hn[j] + (prev[j] - hn[j]) * mx; }
                bf16* dst = i < 2 ? (bf16*)OUTP() + (size_t)i * M * C : (i == 2 ? (bf16*)(ws + WS_B4) : (bf16*)(ws + WS_B1) + (size_t)(i - 3) * M * C);
                store_row_bf16(dst + (size_t)row * C, lane, o); }
#pragma unroll
            for (int j = 0; j < 4; ++j) prev[j] = hn[j];
        }
    }
}

template <int NN, int NGROUPS> struct SchedGrouped {
    static constexpr int K = C;
    const char* A0; size_t astride; const char* A2; const char* B; size_t bgroup;
    int G, c;
    __device__ __forceinline__ bool next(int i, pg8::Unit& u) const {
        const int L = i * G + c; constexpr int per = 64 * NN; if (L >= per * NGROUPS) return false;
        const int g = L / per, w = L % per; pg8::tile_map(w, 64, NN, u.pm, u.pn); u.aux = g; u.r0 = 0; u.cnt = 0; return true; }
    __device__ __forceinline__ const char* a_base(const pg8::Unit& u) const { const char* A = (A2 != nullptr && u.aux == 2) ? A2 : A0 + (size_t)u.aux * astride; return A + (size_t)u.pm * 256 * K * 2; }
    __device__ __forceinline__ const char* b_base(const pg8::Unit& u) const { return B + (size_t)u.aux * bgroup + (size_t)u.pn * 256 * K * 2; }
    __device__ __forceinline__ unsigned a_row_off(const pg8::Unit&, int) const { return 0u; }
};
template <int NN, int K, bool GATHER> struct SchedMoe {
    const char* A; const char* B; size_t bexp; const unsigned* list; volatile LAS int* tab; int G, c;
    __device__ __forceinline__ bool next(int i, pg8::Unit& u) const {
        const int L = i * G + c; const int tot = __builtin_amdgcn_readfirstlane(tab[48]) * NN; if (L >= tot) return false;
        u.pm = L / NN; u.pn = L % NN; int e = 0;
#pragma unroll
        for (int j = 0; j < 16; ++j) e += (u.pm >= tab[32 + j]) ? 1 : 0;
        e = __builtin_amdgcn_readfirstlane(e);
        u.aux = e; u.r0 = (u.pm - __builtin_amdgcn_readfirstlane(tab[16 + e])) * 256; u.cnt = __builtin_amdgcn_readfirstlane(tab[e]); return true; }
    __device__ __forceinline__ const char* a_base(const pg8::Unit& u) const { return GATHER ? A : A + (size_t)u.pm * 256 * K * 2; }
    __device__ __forceinline__ const char* b_base(const pg8::Unit& u) const { return B + (size_t)u.aux * bexp + (size_t)u.pn * 256 * K * 2; }
    __device__ __forceinline__ unsigned a_row_off(const pg8::Unit& u, int r) const {
        const int idx = u.r0 + r; unsigned tok = 0u;
        if (idx < u.cnt) tok = list[(size_t)u.aux * M + idx] >> 1;
        return tok * (unsigned)(K * 2); }
};

using pg8::f32x4;
using pg8::Unit;
__device__ __forceinline__ v4u pack8(f32x4 v0, f32x4 v1) { v4u w; w.x = pg8::cvt_pk_bf16(v0[0], v0[1]); w.y = pg8::cvt_pk_bf16(v0[2], v0[3]); w.z = pg8::cvt_pk_bf16(v1[0], v1[1]); w.w = pg8::cvt_pk_bf16(v1[2], v1[3]); return w; }

struct EpiLora {
    static constexpr bool PERM = true;
    bf16* LW;
    __device__ __forceinline__ void operator()(const f32x4 (&acc)[2][2][4][2], const Unit& u, int wr, int wc, int fr, int fq) const {
        { int l_; asm volatile("v_mbcnt_lo_u32_b32 %0, -1, 0\n\tv_mbcnt_hi_u32_b32 %0, -1, %0" : "=v"(l_)); fr = l_ & 15; fq = l_ >> 4; }
        const int g = u.aux, width = g == 2 ? DG : DW; bf16* out = LW + (size_t)g * (1u << 20);
        const int row0 = u.pm * 256 + wr * 64 + fr;
#pragma unroll
        for (int bj = 0; bj < 2; ++bj) { const int col0 = bj * 128 + wc * 32 + 8 * fq; if (col0 < width) {
#pragma unroll
            for (int ai = 0; ai < 2; ++ai)
#pragma unroll
                for (int m = 0; m < 4; ++m) { f32x4 v0 = acc[ai][bj][m][0], v1 = acc[ai][bj][m][1];
                    if (g == 0) {
#pragma unroll
                        for (int q = 0; q < 4; ++q) { v0[q] = tanhf(v0[q]); v1[q] = tanhf(v1[q]); } }
                    else if (g == 2) {
#pragma unroll
                        for (int q = 0; q < 4; ++q) { v0[q] = sigmoidf_(v0[q]); v1[q] = sigmoidf_(v1[q]); } }
                    *(GAS v4u*)(out + (size_t)(row0 + ai * 128 + m * 16) * width + col0) = pack8(v0, v1); } } }
    }
};
struct EpiSplit3 {
    static constexpr bool PERM = true;
    bf16* O0; bool bycol;
    __device__ __forceinline__ void operator()(const f32x4 (&acc)[2][2][4][2], const Unit& u, int wr, int wc, int fr, int fq) const {
        { int l_; asm volatile("v_mbcnt_lo_u32_b32 %0, -1, 0\n\tv_mbcnt_hi_u32_b32 %0, -1, %0" : "=v"(l_)); fr = l_ & 15; fq = l_ >> 4; }
        const int g = bycol ? (u.pn >> 2) : u.aux, pn = bycol ? (u.pn & 3) : u.pn; bf16* out = O0 + (size_t)g * ((size_t)M * C);
        const int row0 = u.pm * 256 + wr * 64 + fr, col0 = pn * 256 + wc * 32 + 8 * fq;
#pragma unroll
        for (int ai = 0; ai < 2; ++ai)
#pragma unroll
            for (int m = 0; m < 4; ++m)
#pragma unroll
                for (int bj = 0; bj < 2; ++bj) *(GAS v4u*)(out + (size_t)(row0 + ai * 128 + m * 16) * C + col0 + bj * 128) = pack8(acc[ai][bj][m][0], acc[ai][bj][m][1]);
    }
};
struct EpiResid {
    static constexpr bool PERM = false;
    const float* base; float* out;
    __device__ __forceinline__ void operator()(const f32x4 (&acc)[2][2][4][2], const Unit& u, int wr, int wc, int fr, int fq) const {
        { int l_; asm volatile("v_mbcnt_lo_u32_b32 %0, -1, 0\n\tv_mbcnt_hi_u32_b32 %0, -1, %0" : "=v"(l_)); fr = l_ & 15; fq = l_ >> 4; }
        const int row0 = u.pm * 256 + wr * 64 + fr, col0 = u.pn * 256 + wc * 32 + 4 * fq;
#pragma unroll
        for (int ai = 0; ai < 2; ++ai)
#pragma unroll
            for (int m = 0; m < 4; ++m) { const size_t off = (size_t)(row0 + ai * 128 + m * 16) * C + col0;
#pragma unroll
                for (int bj = 0; bj < 2; ++bj)
#pragma unroll
                    for (int n = 0; n < 2; ++n) { const f32x4 b = *(const GAS f32x4*)(base + off + bj * 128 + n * 16); *(GAS f32x4*)(out + off + bj * 128 + n * 16) = b + acc[ai][bj][m][n]; } }
    }
};
struct EpiGU {
    static constexpr bool PERM = true;
    bf16* HID; const float* wl;
    __device__ __forceinline__ void operator()(const f32x4 (&acc)[2][2][4][2], const Unit& u, int wr, int wc, int fr, int fq) const {
        { int l_; asm volatile("v_mbcnt_lo_u32_b32 %0, -1, 0\n\tv_mbcnt_hi_u32_b32 %0, -1, %0" : "=v"(l_)); fr = l_ & 15; fq = l_ >> 4; }
        const int e = u.aux, cnt = u.cnt, base = u.r0, r0 = wr * 64 + fr, col0 = u.pn * 128 + wc * 32 + 8 * fq;
#pragma unroll
        for (int ai = 0; ai < 2; ++ai)
#pragma unroll
            for (int m = 0; m < 4; ++m) { const int r = r0 + ai * 128 + m * 16, idx = base + r; float w = 0.f; if (idx < cnt) w = wl[(size_t)e * M + idx];
                f32x4 h0, h1;
#pragma unroll
                for (int q = 0; q < 4; ++q) { const float g0 = acc[ai][0][m][0][q], g1 = acc[ai][0][m][1][q];
                    h0[q] = g0 * sigmoidf_(g0) * acc[ai][1][m][0][q] * w; h1[q] = g1 * sigmoidf_(g1) * acc[ai][1][m][1][q] * w; }
                *(GAS v4u*)(HID + (size_t)(u.pm * 256 + r) * FE + col0) = pack8(h0, h1);
                asm volatile("" ::: "memory"); }
    }
};
struct EpiDown {
    static constexpr bool PERM = true;
    bf16* EO; const unsigned* list;
    __device__ __forceinline__ void operator()(const f32x4 (&acc)[2][2][4][2], const Unit& u, int wr, int wc, int fr, int fq) const {
        { int l_; asm volatile("v_mbcnt_lo_u32_b32 %0, -1, 0\n\tv_mbcnt_hi_u32_b32 %0, -1, %0" : "=v"(l_)); fr = l_ & 15; fq = l_ >> 4; }
        const int e = u.aux, cnt = u.cnt, base = u.r0, r0 = wr * 64 + fr, col0 = u.pn * 256 + wc * 32 + 8 * fq;
#pragma unroll
        for (int ai = 0; ai < 2; ++ai)
#pragma unroll
            for (int m = 0; m < 4; ++m) { const int idx = base + r0 + ai * 128 + m * 16;
                if (idx < cnt) { const unsigned ent = list[(size_t)e * M + idx]; bf16* o = EO + ((size_t)(ent & 1u) * M + (ent >> 1)) * C + col0;
#pragma unroll
                    for (int bj = 0; bj < 2; ++bj) *(GAS v4u*)(o + bj * 128) = pack8(acc[ai][bj][m][0], acc[ai][bj][m][1]); }
                asm volatile("" ::: "memory"); }
    }
};

typedef short bf16x8s __attribute__((ext_vector_type(8)));
typedef short bf16x4s __attribute__((ext_vector_type(4)));
typedef short v4i16_t __attribute__((ext_vector_type(4)));
constexpr int TPB = 144;
constexpr int TILE_B = 64 * TPB;
constexpr int FP = 68;
constexpr int CS_FA = 0, CS_FB = 16384, CS_TILES = 32768, CS_TOT = CS_TILES + 12 * TILE_B, CS_WL = CS_TOT + 2048, CS_PAR = CS_WL + 256;
static_assert(CS_PAR + 768 <= LDSCTL_OFF, "scan LDS map");
#define TILE(n) (lds + CS_TILES + (n) * TILE_B)
#define F4Z (f32x4){0.f, 0.f, 0.f, 0.f}
__device__ __forceinline__ bf16x8s ldfrag(const LAS unsigned char* tile, int row, int kcol) { return *(const LAS bf16x8s*)(tile + row * TPB + kcol * 2); }
__device__ __forceinline__ bf16x8s ldfrag_tr(const LAS unsigned char* tile, int n0, int k0, int lane) {
    const int g = lane >> 4, q = (lane & 15) >> 2, p = lane & 3;
    const LAS unsigned char* a = tile + (k0 + 8 * g + q) * TPB + (n0 + 4 * p) * 2;
    const v4i16_t lo = __builtin_amdgcn_ds_read_tr16_b64_v4i16((LAS v4i16_t*)a), hi = __builtin_amdgcn_ds_read_tr16_b64_v4i16((LAS v4i16_t*)(a + 4 * TPB));
    return (bf16x8s){lo[0], lo[1], lo[2], lo[3], hi[0], hi[1], hi[2], hi[3]};
}
__device__ __forceinline__ bf16x8s ldfrag_perm(const LAS unsigned char* tile, int row, int ks, int g) {
    const bf16x4s lo = *(const LAS bf16x4s*)(tile + row * TPB + (32 * ks + 4 * g) * 2), hi = *(const LAS bf16x4s*)(tile + row * TPB + (32 * ks + 16 + 4 * g) * 2);
    return (bf16x8s){lo[0], lo[1], lo[2], lo[3], hi[0], hi[1], hi[2], hi[3]};
}
__device__ __forceinline__ void lds_barrier() { asm volatile("s_waitcnt lgkmcnt(0)" ::: "memory"); __builtin_amdgcn_s_barrier(); asm volatile("" ::: "memory"); }
#define MFMA16(a, b, c) __builtin_amdgcn_mfma_f32_16x16x32_bf16((a), (b), (c), 0, 0, 0)
__device__ __forceinline__ void mm64(f32x4 (&acc)[2], const LAS unsigned char* At, const LAS unsigned char* Bt, int rt, int ch, int fr, int g) {
#pragma unroll
    for (int ks = 0; ks < 2; ++ks) { const bf16x8s a = ldfrag(At, 16 * rt + fr, 32 * ks + 8 * g);
#pragma unroll
        for (int ct = 0; ct < 2; ++ct) acc[ct] = MFMA16(a, ldfrag(Bt, 32 * ch + 16 * ct + fr, 32 * ks + 8 * g), acc[ct]); }
}
__device__ __forceinline__ void mm64_bt(f32x4 (&acc)[2], const LAS unsigned char* At, const LAS unsigned char* X, int rt, int ch, int fr, int g, int lane) {
#pragma unroll
    for (int ks = 0; ks < 2; ++ks) { const bf16x8s a = ldfrag(At, 16 * rt + fr, 32 * ks + 8 * g);
#pragma unroll
        for (int ct = 0; ct < 2; ++ct) acc[ct] = MFMA16(a, ldfrag_tr(X, 32 * ch + 16 * ct, 32 * ks, lane), acc[ct]); }
}
__device__ __forceinline__ void mm64_at(f32x4 (&acc)[2], const LAS unsigned char* Xa, const LAS unsigned char* Bt, int rt, int ch, int fr, int g, int lane) {
#pragma unroll
    for (int ks = 0; ks < 2; ++ks) { const bf16x8s a = ldfrag_tr(Xa, 16 * rt, 32 * ks, lane);
#pragma unroll
        for (int ct = 0; ct < 2; ++ct) acc[ct] = MFMA16(a, ldfrag(Bt, 32 * ch + 16 * ct + fr, 32 * ks + 8 * g), acc[ct]); }
}
__device__ __forceinline__ void mm64_att(f32x4 (&acc)[2], const LAS unsigned char* Xa, const LAS unsigned char* X, int rt, int ch, int lane) {
#pragma unroll
    for (int ks = 0; ks < 2; ++ks) { const bf16x8s a = ldfrag_tr(Xa, 16 * rt, 32 * ks, lane);
#pragma unroll
        for (int ct = 0; ct < 2; ++ct) acc[ct] = MFMA16(a, ldfrag_tr(X, 32 * ch + 16 * ct, 32 * ks, lane), acc[ct]); }
}
__device__ __forceinline__ bf16x4s pack4(f32x4 v) { v2u w; w.x = pg8::cvt_pk_bf16(v[0], v[1]); w.y = pg8::cvt_pk_bf16(v[2], v[3]); return __builtin_bit_cast(bf16x4s, w); }
__device__ __forceinline__ f32x4 unpack4(bf16x4s s) { const v2u w = __builtin_bit_cast(v2u, s); return (f32x4){bflo(w.x), bfhi(w.x), bflo(w.y), bfhi(w.y)}; }
__device__ __forceinline__ void st_tr(LAS unsigned char* Out, const f32x4 (&acc)[2], int rt, int ch, int fr, int g) {
#pragma unroll
    for (int ct = 0; ct < 2; ++ct) *(LAS bf16x4s*)(Out + (32 * ch + 16 * ct + fr) * TPB + (16 * rt + 4 * g) * 2) = pack4(acc[ct]);
}
__device__ __forceinline__ void ld_tr(f32x4 (&acc)[2], const LAS unsigned char* In, int rt, int ch, int fr, int g) {
#pragma unroll
    for (int ct = 0; ct < 2; ++ct) acc[ct] = unpack4(*(const LAS bf16x4s*)(In + (32 * ch + 16 * ct + fr) * TPB + (16 * rt + 4 * g) * 2));
}
__device__ __forceinline__ void unpack8(v4u w, float (&o)[8]) { o[0] = bflo(w.x); o[1] = bfhi(w.x); o[2] = bflo(w.y); o[3] = bfhi(w.y); o[4] = bflo(w.z); o[5] = bfhi(w.z); o[6] = bflo(w.w); o[7] = bfhi(w.w); }
__device__ __forceinline__ v4u pack8f(const float (&o)[8]) { v4u w; w.x = pg8::cvt_pk_bf16(o[0], o[1]); w.y = pg8::cvt_pk_bf16(o[2], o[3]); w.z = pg8::cvt_pk_bf16(o[4], o[5]); w.w = pg8::cvt_pk_bf16(o[6], o[7]); return w; }

struct FrontIn { v4u r, k, v; bf16x8s fw[2], fa[2]; };
__device__ __forceinline__ void front_fetch(FrontIn& f, unsigned char* ws, int unit, int tid, int lane, int wave) {
    const int h = unit & 15, c = (unit >> 4) & 127, b = unit >> 11; const size_t row0 = (size_t)b * SEQ + c * 64;
    const int rt = wave & 3, fr = lane & 15, g = lane >> 4, t = tid >> 3, cq = tid & 7, c0 = h * HD + cq * 8;
    const bf16* Rb = (const bf16*)(ws + WS_B1); const bf16* Kb = (const bf16*)(ws + WS_B2); const bf16* Vb = (const bf16*)(ws + WS_B3);
    const bf16* LW = (const bf16*)(ws + WS_LW); const bf16* LA = (const bf16*)(ws + WS_LA);
    f.r = *(const GAS v4u*)(Rb + (row0 + t) * C + c0); f.k = *(const GAS v4u*)(Kb + (row0 + t) * C + c0); f.v = *(const GAS v4u*)(Vb + (row0 + t) * C + c0);
#pragma unroll
    for (int ks = 0; ks < 2; ++ks) { f.fw[ks] = *(const GAS bf16x8s*)(LW + (row0 + 16 * rt + fr) * DW + 32 * ks + 8 * g); f.fa[ks] = *(const GAS bf16x8s*)(LA + (row0 + 16 * rt + fr) * DA + 32 * ks + 8 * g); }
}
__device__ __forceinline__ void head_consts(unsigned char* ws, LAS unsigned char* lds, int h, int tid, int wtile, int atile) {
    const bf16* W2T = (const bf16*)(ws + WS_WT_W2); const bf16* A2T = (const bf16*)(ws + WS_WT_A2);
    const int row = tid >> 3, cq = tid & 7;
    *(LAS v4u*)(lds + CS_TILES + wtile * TILE_B + row * TPB + cq * 16) = *(const GAS v4u*)(W2T + (size_t)(h * HD + row) * 64 + cq * 8);
    *(LAS v4u*)(lds + CS_TILES + atile * TILE_B + row * TPB + cq * 16) = *(const GAS v4u*)(A2T + (size_t)(h * HD + row) * 64 + cq * 8);
    if (tid < 64) { LAS float* P = (LAS float*)(lds + CS_PAR); P[tid] = INP(15)[h * HD + tid]; P[64 + tid] = INP(16)[h * HD + tid]; P[128 + tid] = INP(17)[h * HD + tid]; }
    __syncthreads();
}
template <int MODE>
__device__ __forceinline__ void chunk_front(const FrontIn& f, LAS unsigned char* lds, const float (&w0v)[2], const float (&a0v)[2], int tid, int lane, int wave, float (&v8)[8], float& rkb) {
    const int rt = wave & 3, ch = wave >> 2, fr = lane & 15, g = lane >> 4;
    LAS float* FA = (LAS float*)(lds + CS_FA); LAS float* FB = (LAS float*)(lds + CS_FB); LAS float* TOT = (LAS float*)(lds + CS_TOT);
    const int t = tid >> 3, cq = tid & 7;
    constexpr int WTILE = MODE == 1 ? 6 : 10, ATILE = MODE == 1 ? 8 : 11;
    {
        f32x4 aw[2] = {F4Z, F4Z}, aa[2] = {F4Z, F4Z};
#pragma unroll
        for (int ks = 0; ks < 2; ++ks)
#pragma unroll
            for (int ct = 0; ct < 2; ++ct) { aw[ct] = MFMA16(f.fw[ks], ldfrag(TILE(WTILE), 32 * ch + 16 * ct + fr, 32 * ks + 8 * g), aw[ct]); aa[ct] = MFMA16(f.fa[ks], ldfrag(TILE(ATILE), 32 * ch + 16 * ct + fr, 32 * ks + 8 * g), aa[ct]); }
#pragma unroll
        for (int ct = 0; ct < 2; ++ct) { const int j = 32 * ch + 16 * ct + fr; const float w0 = w0v[ct], a0 = a0v[ct];
#pragma unroll
            for (int q = 0; q < 4; ++q) { const int tt = 16 * rt + 4 * g + q; FA[tt * 64 + j] = -0.6065306597126334f * sigmoidf_(w0 + aw[ct][q]); FB[tt * 64 + j] = sigmoidf_(a0 + aa[ct][q]); } }
    }
    lds_barrier();
    {
        const int j = tid & 63, seg = tid >> 6; float run = 0.f; float loc[8];
#pragma unroll
        for (int q = 0; q < 8; ++q) { run += FA[(8 * seg + q) * 64 + j]; loc[q] = run; }
        TOT[seg * 64 + j] = run;
        lds_barrier();
        float off = 0.f;
#pragma unroll
        for (int s2 = 0; s2 < 7; ++s2) off += (s2 < seg) ? TOT[s2 * 64 + j] : 0.f;
#pragma unroll
        for (int q = 0; q < 8; ++q) FA[(8 * seg + q) * 64 + j] = loc[q] + off;
    }
    lds_barrier();
    {
        float r[8], k[8], pkk[8], pka[8], prk[8];
        unpack8(f.r, r); unpack8(f.k, k); unpack8(f.v, v8);
        { const LAS float* P = (const LAS float*)(lds + CS_PAR) + cq * 8; const f32x4 a0_ = *(const LAS f32x4*)P, a1_ = *(const LAS f32x4*)(P + 4), b0_ = *(const LAS f32x4*)(P + 64), b1_ = *(const LAS f32x4*)(P + 68), c0_ = *(const LAS f32x4*)(P + 128), c1_ = *(const LAS f32x4*)(P + 132);
#pragma unroll
          for (int q = 0; q < 4; ++q) { pkk[q] = a0_[q]; pkk[4 + q] = a1_[q]; pka[q] = b0_[q]; pka[4 + q] = b1_[q]; prk[q] = c0_[q]; prk[4 + q] = c1_[q]; } }
        float cw[8], cwp[8], ag[8];
        { const int tp = t > 0 ? t - 1 : 0;
          const f32x4 c0_ = *(const LAS f32x4*)(FA + t * 64 + cq * 8), c1_ = *(const LAS f32x4*)(FA + t * 64 + cq * 8 + 4), p0_ = *(const LAS f32x4*)(FA + tp * 64 + cq * 8), p1_ = *(const LAS f32x4*)(FA + tp * 64 + cq * 8 + 4);
          const f32x4 g0_ = *(const LAS f32x4*)(FB + t * 64 + cq * 8), g1_ = *(const LAS f32x4*)(FB + t * 64 + cq * 8 + 4);
#pragma unroll
          for (int q = 0; q < 4; ++q) { cw[q] = c0_[q]; cw[4 + q] = c1_[q]; cwp[q] = t > 0 ? p0_[q] : 0.f; cwp[4 + q] = t > 0 ? p1_[q] : 0.f; ag[q] = g0_[q]; ag[4 + q] = g1_[q]; } }
        float kk[8], ss = 0.f; rkb = 0.f;
#pragma unroll
        for (int q = 0; q < 8; ++q) { kk[q] = k[q] * pkk[q]; ss += kk[q] * kk[q]; }
        ss += shx(ss, 1, lane); ss += shx(ss, 2, lane); ss += shx(ss, 4, lane);
        const float inv = 1.0f / fmaxf(sqrtf(ss), 1e-12f);
        float at[8], bt[8], kt[8], rt_[8];
#pragma unroll
        for (int q = 0; q < 8; ++q) { const float kn = kk[q] * inv, kp = k[q] * (1.0f + (ag[q] - 1.0f) * pka[q]);
            const float ein = __expf(-cw[q]);
            at[q] = -kn * __expf(cwp[q]); bt[q] = kn * ag[q] * ein; kt[q] = kp * ein;
            if (MODE == 3) { rt_[q] = r[q] * __expf(cw[q]); rkb += r[q] * kp * prk[q]; } }
        if (MODE == 3) { rkb += shx(rkb, 1, lane); rkb += shx(rkb, 2, lane); rkb += shx(rkb, 4, lane); }
        *(LAS v4u*)(TILE(0) + t * TPB + cq * 16) = pack8f(at); *(LAS v4u*)(TILE(1) + t * TPB + cq * 16) = pack8f(bt); *(LAS v4u*)(TILE(2) + t * TPB + cq * 16) = pack8f(kt);
        *(LAS v4u*)(TILE(3) + t * TPB + cq * 16) = f.v;
        if (MODE == 3) *(LAS v4u*)(TILE(4) + t * TPB + cq * 16) = pack8f(rt_);
        if (MODE == 1 && t == 63) {
#pragma unroll
            for (int q = 0; q < 8; ++q) ((LAS float*)(lds + CS_WL))[cq * 8 + q] = __expf(cw[q]); }
    }
    lds_barrier();
}

__device__ __forceinline__ void scan_s1(unsigned char* ws, LAS unsigned char* lds, int lane0, int wave) {
    const int rt = wave & 3, ch = wave >> 2;
    FrontIn fin; float w0v[2], a0v[2];
    { int l0 = lane0; asm volatile("" : "+v"(l0)); const int hh = blockIdx.x & 15;
      if ((int)blockIdx.x < BATCH * NH * (SEQ / 64)) front_fetch(fin, ws, blockIdx.x, wave * 64 + l0, l0, wave);
#pragma unroll
      for (int ct = 0; ct < 2; ++ct) { w0v[ct] = INP(7)[hh * HD + 32 * ch + 16 * ct + (l0 & 15)]; a0v[ct] = INP(10)[hh * HD + 32 * ch + 16 * ct + (l0 & 15)]; }
      head_consts(ws, lds, hh, wave * 64 + l0, 6, 8); }
    for (int unit = blockIdx.x; unit < BATCH * NH * (SEQ / 64); unit += gridDim.x) {
        int lane = lane0; asm volatile("" : "+v"(lane));
        const int tid = wave * 64 + lane, fr = lane & 15, g = lane >> 4;
        const int h = unit & 15, c = (unit >> 4) & 127, b = unit >> 11; const size_t chunk = ((size_t)b * NH + h) * 128 + c;
        float v8[8]; float rkb;
        chunk_front<1>(fin, lds, w0v, a0v, tid, lane, wave, v8, rkb);
        if (unit + (int)gridDim.x < BATCH * NH * (SEQ / 64)) front_fetch(fin, ws, unit + gridDim.x, tid, lane, wave);
        {
            f32x4 a2[2] = {F4Z, F4Z}, a3[2] = {F4Z, F4Z};
            mm64(a2, TILE(1), TILE(0), rt, ch, fr, g);
            mm64(a3, TILE(2), TILE(0), rt, ch, fr, g);
            f32x4 p1[2];
#pragma unroll
            for (int ct = 0; ct < 2; ++ct) { const int col = 32 * ch + 16 * ct + fr;
#pragma unroll
                for (int q = 0; q < 4; ++q) { const int row = 16 * rt + 4 * g + q;
                    a2[ct][q] = row < col ? a2[ct][q] : 0.f;
                    p1[ct][q] = a2[ct][q] + (row == col ? 1.0f : 0.f);
                    a3[ct][q] = row < col ? a3[ct][q] : 0.f; } }
            st_tr(TILE(5), a2, rt, ch, fr, g);
            st_tr(TILE(9), p1, rt, ch, fr, g);
            st_tr(TILE(4), a3, rt, ch, fr, g);
        }
        lds_barrier();
#pragma unroll
        for (int r = 0; r < 6; ++r) {
            LAS unsigned char* Sr = TILE(5 + 2 * (r & 1)); LAS unsigned char* Sr2 = TILE(5 + 2 * ((r & 1) ^ 1));
            if (r <= 4) { f32x4 q2[2] = {F4Z, F4Z};
                mm64_at(q2, Sr, Sr, rt, ch, fr, g, lane);
                st_tr(Sr2, q2, rt, ch, fr, g); }
            if (r >= 1) { LAS unsigned char* Pr = TILE(9 + ((r - 1) & 1)); LAS unsigned char* Pr2 = TILE(9 + (((r - 1) & 1) ^ 1));
                f32x4 pa[2]; ld_tr(pa, Pr, rt, ch, fr, g);
                mm64_at(pa, Sr, Pr, rt, ch, fr, g, lane);
                st_tr(Pr2, pa, rt, ch, fr, g); }
            if (r == 0) { f32x4 gg[2] = {F4Z, F4Z};
                mm64_bt(gg, TILE(4), TILE(3), rt, ch, fr, g, lane);
                st_tr(TILE(11), gg, rt, ch, fr, g); }
            lds_barrier();
        }
        { const int trow = tid >> 3, tcq = tid & 7; *(GAS v4u*)((bf16*)(ws + WS_B4) + chunk * 4096 + trow * 64 + tcq * 8) = *(const LAS v4u*)(TILE(10) + trow * TPB + tcq * 16); }
        {
            f32x4 acc[2] = {F4Z, F4Z}, ac2[2] = {F4Z, F4Z};
            mm64_bt(acc, TILE(10), TILE(0), rt, ch, fr, g, lane);
            mm64(ac2, TILE(10), TILE(11), rt, ch, fr, g);
            st_tr(TILE(5), acc, rt, ch, fr, g); st_tr(TILE(7), ac2, rt, ch, fr, g);
        }
        lds_barrier();
        {
            const LAS float* WL = (const LAS float*)(lds + CS_WL);
            f32x4 acc[2] = {F4Z, F4Z};
            mm64_bt(acc, TILE(5), TILE(1), rt, ch, fr, g, lane);
            bf16* Mg = (bf16*)(ws + WS_B0) + chunk * 4096;
#pragma unroll
            for (int ct = 0; ct < 2; ++ct) { const int j1 = 32 * ch + 16 * ct + fr; const float wl = WL[j1];
#pragma unroll
                for (int q = 0; q < 4; ++q) { const int j2 = 16 * rt + 4 * g + q; acc[ct][q] = wl * (acc[ct][q] + (j2 == j1 ? 1.0f : 0.f)); }
                const int rtS = 2 * ch + ct, ksS = rt >> 1, half = rt & 1;
                *(GAS bf16x4s*)(Mg + (((rtS * 2 + ksS) * 64 + g * 16 + fr) * 8 + half * 4)) = pack4(acc[ct]); }
            f32x4 ad[2] = {F4Z, F4Z};
            mm64_at(ad, TILE(1), TILE(7), rt, ch, fr, g, lane);
            mm64_att(ad, TILE(2), TILE(3), rt, ch, lane);
            const f32x4 wl4 = *(const LAS f32x4*)(WL + 16 * rt + 4 * g);
            bf16* Dg = (bf16*)OUTP() + chunk * 4096;
#pragma unroll
            for (int ct = 0; ct < 2; ++ct) *(GAS bf16x4s*)(Dg + (((2 * ch + ct) * 4 + rt) * 64 + lane) * 4) = pack4(ad[ct] * wl4);
        }
        lds_barrier();
    }
}

constexpr int S2_PD = 6;
__device__ __forceinline__ void scan_s2(unsigned char* ws, LAS unsigned char* lds, int lane, int wave) {
    for (int bh = blockIdx.x; bh < BATCH * NH; bh += gridDim.x) {
        const unsigned char* Mg = (const unsigned char*)((const bf16*)(ws + WS_B0) + (size_t)bh * 128 * 4096); const unsigned char* Dg = (const unsigned char*)((const bf16*)OUTP() + (size_t)bh * 128 * 4096);
        bf16* Sg = (bf16*)OUTP() + (size_t)M * C + (size_t)bh * 128 * 4096;
        if (wave >= 4) {
            const int lw = wave - 4;
            const unsigned char* src = (lw < 2 ? Mg + lw * 4096 : Dg + (lw - 2) * 4096) + lane * 16;
            LAS unsigned char* dst = lds + lw * 4096 + lane * 16;
            v4u q[S2_PD][4];
#define S2_LOADQ(j, c) do { _Pragma("unroll") for (int i_ = 0; i_ < 4; ++i_) q[j][i_] = *(const GAS v4u*)(src + (size_t)(c) * 8192 + i_ * 1024); } while (0)
#define S2_STOREQ(j, slot) do { _Pragma("unroll") for (int i_ = 0; i_ < 4; ++i_) *(LAS v4u*)(dst + (slot) * 16384 + i_ * 1024) = q[j][i_]; } while (0)
#pragma unroll
            for (int j = 0; j < S2_PD; ++j) S2_LOADQ(j, j);
            S2_STOREQ(0, 0); S2_LOADQ(0, S2_PD);
            lds_barrier();
#pragma unroll 1
            for (int s0 = 0; s0 < 128; s0 += S2_PD) {
#pragma unroll
                for (int jj = 0; jj < S2_PD; ++jj) { const int step = s0 + jj;
                    if (step + 1 < 128) S2_STOREQ((jj + 1) % S2_PD, (step + 1) & 1);
                    if (step + 1 + S2_PD < 128) S2_LOADQ((jj + 1) % S2_PD, step + 1 + S2_PD);
                    lds_barrier(); }
            }
#undef S2_LOADQ
#undef S2_STOREQ
        } else {
            const int ct = wave;
            f32x4 acc[4];
#pragma unroll
            for (int r = 0; r < 4; ++r) acc[r] = F4Z;
            lds_barrier();
#pragma unroll 1
            for (int s0 = 0; s0 < 128; s0 += S2_PD) {
#pragma unroll
                for (int jj = 0; jj < S2_PD; ++jj) { const int step = s0 + jj;
                    if (step < 128) {
                        const LAS unsigned char* slot = lds + (step & 1) * 16384;
                        bf16x8s sf[2];
#pragma unroll
                        for (int ks = 0; ks < 2; ++ks) { const bf16x4s lo = pack4(acc[2 * ks]), hi = pack4(acc[2 * ks + 1]); sf[ks] = (bf16x8s){lo[0], lo[1], lo[2], lo[3], hi[0], hi[1], hi[2], hi[3]}; }
#pragma unroll
                        for (int ks = 0; ks < 2; ++ks) *(GAS bf16x8s*)(Sg + (size_t)step * 4096 + ((ct * 2 + ks) * 64 + lane) * 8) = sf[ks];
                        f32x4 na[4];
#pragma unroll
                        for (int r = 0; r < 4; ++r) na[r] = unpack4(*(const LAS bf16x4s*)(slot + 8192 + ((ct * 4 + r) * 64 + lane) * 8));
#pragma unroll
                        for (int ks = 0; ks < 2; ++ks)
#pragma unroll
                            for (int r = 0; r < 4; ++r) na[r] = MFMA16(*(const LAS bf16x8s*)(slot + ((r * 2 + ks) * 64 + lane) * 16), sf[ks], na[r]);
#pragma unroll
                        for (int r = 0; r < 4; ++r) acc[r] = na[r];
                    }
                    lds_barrier(); }
            }
        }
    }
}

__device__ __forceinline__ void scan_s3(unsigned char* ws, LAS unsigned char* lds, int lane0, int wave) {
    const int rt = wave & 3, ch = wave >> 2;
    LAS float* Ys = (LAS float*)(lds + CS_FA);
    const bf16* LG = (const bf16*)(ws + WS_LG); const bf16* G2T = (const bf16*)(ws + WS_WT_G2); bf16* YG = (bf16*)(ws + WS_B0);
    FrontIn fin; float w0v[2], a0v[2];
    { int l0 = lane0; asm volatile("" : "+v"(l0)); const int hh = blockIdx.x & 15;
      if ((int)blockIdx.x < BATCH * NH * (SEQ / 64)) front_fetch(fin, ws, blockIdx.x, wave * 64 + l0, l0, wave);
#pragma unroll
      for (int ct = 0; ct < 2; ++ct) { w0v[ct] = INP(7)[hh * HD + 32 * ch + 16 * ct + (l0 & 15)]; a0v[ct] = INP(10)[hh * HD + 32 * ch + 16 * ct + (l0 & 15)]; }
      head_consts(ws, lds, hh, wave * 64 + l0, 10, 11); }
    for (int unit = blockIdx.x; unit < BATCH * NH * (SEQ / 64); unit += gridDim.x) {
        int lane = lane0; asm volatile("" : "+v"(lane));
        const int tid = wave * 64 + lane, fr = lane & 15, g = lane >> 4;
        const int h = unit & 15, c = (unit >> 4) & 127, b = unit >> 11; const size_t chunk = ((size_t)b * NH + h) * 128 + c; const size_t row0 = (size_t)b * SEQ + c * 64;
        const bf16* Sg = (const bf16*)OUTP() + (size_t)M * C + chunk * 4096; const bf16* Tg = (const bf16*)(ws + WS_B4) + chunk * 4096;
        bf16x8s sB[2][2], sA[2], tA[2];
#pragma unroll
        for (int ks = 0; ks < 2; ++ks) { sA[ks] = *(const GAS bf16x8s*)(Sg + ((rt * 2 + ks) * 64 + lane) * 8); tA[ks] = *(const GAS bf16x8s*)(Tg + (16 * rt + fr) * 64 + 32 * ks + 8 * g);
#pragma unroll
            for (int ct = 0; ct < 2; ++ct) sB[ks][ct] = *(const GAS bf16x8s*)(Sg + (((2 * ch + ct) * 2 + ks) * 64 + lane) * 8); }
        const int et = tid >> 3, ecq = tid & 7, ec0 = h * HD + ecq * 8;
        const f32x4 lnw0 = *(const GAS f32x4*)(INP(18) + ec0), lnw1 = *(const GAS f32x4*)(INP(18) + ec0 + 4), lnb0 = *(const GAS f32x4*)(INP(19) + ec0), lnb1 = *(const GAS f32x4*)(INP(19) + ec0 + 4);
        float v8[8]; float rkb;
        chunk_front<3>(fin, lds, w0v, a0v, tid, lane, wave, v8, rkb);
        bf16x8s gA[5], gB[5][2];
#pragma unroll
        for (int ks = 0; ks < 5; ++ks) { gA[ks] = *(const GAS bf16x8s*)(G2T + (size_t)(h * HD + 16 * rt + fr) * DG + 32 * ks + 8 * g);
#pragma unroll
            for (int ct = 0; ct < 2; ++ct) gB[ks][ct] = *(const GAS bf16x8s*)(LG + (row0 + 32 * ch + 16 * ct + fr) * DG + 32 * ks + 8 * g); }
        if (unit + (int)gridDim.x < BATCH * NH * (SEQ / 64)) front_fetch(fin, ws, unit + gridDim.x, tid, lane, wave);
        {
            f32x4 a1[2] = {F4Z, F4Z}, a2[2] = {F4Z, F4Z}, a3[2] = {F4Z, F4Z};
            mm64(a1, TILE(2), TILE(0), rt, ch, fr, g);
            mm64(a2, TILE(1), TILE(4), rt, ch, fr, g);
            mm64(a3, TILE(2), TILE(4), rt, ch, fr, g);
#pragma unroll
            for (int ct = 0; ct < 2; ++ct) { const int t = 32 * ch + 16 * ct + fr;
#pragma unroll
                for (int q = 0; q < 4; ++q) { const int s = 16 * rt + 4 * g + q; a1[ct][q] = s < t ? a1[ct][q] : 0.f; a2[ct][q] = s <= t ? a2[ct][q] : 0.f; a3[ct][q] = s <= t ? a3[ct][q] : 0.f; } }
            st_tr(TILE(5), a1, rt, ch, fr, g); st_tr(TILE(6), a2, rt, ch, fr, g); st_tr(TILE(7), a3, rt, ch, fr, g);
        }
        f32x4 ag[2] = {F4Z, F4Z};
#pragma unroll
        for (int ks = 0; ks < 5; ++ks)
#pragma unroll
            for (int ct = 0; ct < 2; ++ct) ag[ct] = MFMA16(gA[ks], gB[ks][ct], ag[ct]);
        lds_barrier();
        {
            f32x4 acc[2] = {F4Z, F4Z};
#pragma unroll
            for (int ks = 0; ks < 2; ++ks) { const bf16x8s a = ldfrag_perm(TILE(0), 16 * rt + fr, ks, g);
#pragma unroll
                for (int ct = 0; ct < 2; ++ct) acc[ct] = MFMA16(a, sB[ks][ct], acc[ct]); }
            mm64_bt(acc, TILE(5), TILE(3), rt, ch, fr, g, lane);
            st_tr(TILE(8), acc, rt, ch, fr, g);
        }
        lds_barrier();
        {
            f32x4 acc[2] = {F4Z, F4Z};
#pragma unroll
            for (int ks = 0; ks < 2; ++ks)
#pragma unroll
                for (int ct = 0; ct < 2; ++ct) acc[ct] = MFMA16(tA[ks], ldfrag(TILE(8), 32 * ch + 16 * ct + fr, 32 * ks + 8 * g), acc[ct]);
            st_tr(TILE(9), acc, rt, ch, fr, g);
        }
        lds_barrier();
        {
            f32x4 acc[2] = {F4Z, F4Z};
#pragma unroll
            for (int ks = 0; ks < 2; ++ks)
#pragma unroll
                for (int ct = 0; ct < 2; ++ct) acc[ct] = MFMA16(sA[ks], ldfrag_perm(TILE(4), 32 * ch + 16 * ct + fr, ks, g), acc[ct]);
            mm64(acc, TILE(9), TILE(6), rt, ch, fr, g); mm64_at(acc, TILE(3), TILE(7), rt, ch, fr, g, lane);
#pragma unroll
            for (int ct = 0; ct < 2; ++ct) { const int t = 32 * ch + 16 * ct + fr; *(LAS f32x4*)(Ys + t * FP + 16 * rt + 4 * g) = acc[ct]; }
        }
        lds_barrier();
        {
            const f32x4 y0 = *(const LAS f32x4*)(Ys + et * FP + ecq * 8), y1 = *(const LAS f32x4*)(Ys + et * FP + ecq * 8 + 4);
            float y[8] = {y0[0], y0[1], y0[2], y0[3], y1[0], y1[1], y1[2], y1[3]};
            float s = 0.f;
#pragma unroll
            for (int q = 0; q < 8; ++q) s += y[q];
            s += shx(s, 1, lane); s += shx(s, 2, lane); s += shx(s, 4, lane);
            const float mu = s * (1.0f / HD); float vs = 0.f;
#pragma unroll
            for (int q = 0; q < 8; ++q) { y[q] -= mu; vs += y[q] * y[q]; }
            vs += shx(vs, 1, lane); vs += shx(vs, 2, lane); vs += shx(vs, 4, lane);
            const float rstd = 1.0f / sqrtf(vs * (1.0f / HD) + GN_EPS);
            f32x4 o0, o1;
#pragma unroll
            for (int q = 0; q < 4; ++q) { o0[q] = y[q] * rstd * lnw0[q] + lnb0[q] + rkb * v8[q]; o1[q] = y[4 + q] * rstd * lnw1[q] + lnb1[q] + rkb * v8[4 + q]; }
            *(LAS f32x4*)(Ys + et * FP + ecq * 8) = o0; *(LAS f32x4*)(Ys + et * FP + ecq * 8 + 4) = o1;
        }
        lds_barrier();
        {
#pragma unroll
            for (int ct = 0; ct < 2; ++ct) { const int t = 32 * ch + 16 * ct + fr; const f32x4 yv = *(const LAS f32x4*)(Ys + t * FP + 16 * rt + 4 * g);
                *(GAS bf16x4s*)(YG + (row0 + t) * C + h * HD + 16 * rt + 4 * g) = pack4(yv * ag[ct]); }
        }
        lds_barrier();
    }
}
#undef TILE
#if MK_DEBUG
__device__ __forceinline__ void scan_naive(unsigned char* ws, LAS unsigned char* lds, int tid) {
    const int lane = tid & 63;
    const bf16* Rb = (const bf16*)(ws + WS_B1); const bf16* Kb = (const bf16*)(ws + WS_B2); const bf16* Vb = (const bf16*)(ws + WS_B3);
    const bf16* LW = (const bf16*)(ws + WS_LW); const bf16* LA = (const bf16*)(ws + WS_LA);
    float* Y = OUTP(); float* RK = (float*)(ws + WS_HID);
    LAS float* sR = (LAS float*)lds; LAS float* sK = sR + 4096; LAS float* sV = sK + 4096; LAS float* sA = sV + 4096; LAS float* sB = sA + 4096; LAS float* sD = sB + 4096;
    LAS float* sW2 = sD + 4096; LAS float* sA2 = sW2 + 4096;
    for (int unit = blockIdx.x; unit < BATCH * NH; unit += gridDim.x) {
        const int b = unit / NH, h = unit % NH;
        __syncthreads();
        for (int e = tid; e < 4096; e += 512) { const int d = e >> 6, j = e & 63; sW2[e] = INP(9)[(size_t)d * C + h * HD + j]; sA2[e] = INP(12)[(size_t)d * C + h * HD + j]; }
        __syncthreads();
        const int pt = tid >> 3, cq = tid & 7, c0 = h * HD + cq * 8;
        const int si = tid >> 3, jq = tid & 7;
        float S[8];
#pragma unroll
        for (int q = 0; q < 8; ++q) S[q] = 0.f;
        float w0v[8], a0v[8], kkv[8], kav[8], rkv[8];
#pragma unroll
        for (int q = 0; q < 8; ++q) { w0v[q] = INP(7)[c0 + q]; a0v[q] = INP(10)[c0 + q]; kkv[q] = INP(15)[c0 + q]; kav[q] = INP(16)[c0 + q]; rkv[q] = INP(17)[c0 + q]; }
        for (int blk = 0; blk < SEQ / 64; ++blk) {
            const size_t row = (size_t)b * SEQ + blk * 64 + pt;
            {
                const v4u r4 = *(const GAS v4u*)(Rb + row * C + c0), k4 = *(const GAS v4u*)(Kb + row * C + c0), v4 = *(const GAS v4u*)(Vb + row * C + c0);
                float r[8], k[8], v[8];
                r[0] = bflo(r4.x); r[1] = bfhi(r4.x); r[2] = bflo(r4.y); r[3] = bfhi(r4.y); r[4] = bflo(r4.z); r[5] = bfhi(r4.z); r[6] = bflo(r4.w); r[7] = bfhi(r4.w);
                k[0] = bflo(k4.x); k[1] = bfhi(k4.x); k[2] = bflo(k4.y); k[3] = bfhi(k4.y); k[4] = bflo(k4.z); k[5] = bfhi(k4.z); k[6] = bflo(k4.w); k[7] = bfhi(k4.w);
                v[0] = bflo(v4.x); v[1] = bfhi(v4.x); v[2] = bflo(v4.y); v[3] = bfhi(v4.y); v[4] = bflo(v4.z); v[5] = bfhi(v4.z); v[6] = bflo(v4.w); v[7] = bfhi(v4.w);
                float wp[8], ap[8];
#pragma unroll
                for (int q = 0; q < 8; ++q) { wp[q] = w0v[q]; ap[q] = a0v[q]; }
                for (int d = 0; d < 64; ++d) { const float lw = bf2f(LW[row * DW + d]), la = bf2f(LA[row * DA + d]);
#pragma unroll
                    for (int q = 0; q < 8; ++q) { wp[q] += lw * sW2[d * 64 + cq * 8 + q]; ap[q] += la * sA2[d * 64 + cq * 8 + q]; } }
                float kk[8], ss = 0.f, rks = 0.f;
#pragma unroll
                for (int q = 0; q < 8; ++q) { kk[q] = k[q] * kkv[q]; ss += kk[q] * kk[q]; }
                ss += shx(ss, 1, lane); ss += shx(ss, 2, lane); ss += shx(ss, 4, lane);
                const float inv = 1.0f / fmaxf(sqrtf(ss), 1e-12f);
#pragma unroll
                for (int q = 0; q < 8; ++q) { const float ag = sigmoidf_(ap[q]); const float kn = kk[q] * inv; const float kp = k[q] * (1.0f + (ag - 1.0f) * kav[q]);
                    const float lw = -0.6065306597126334f * sigmoidf_(wp[q]);
                    const int o = pt * 64 + cq * 8 + q;
                    sR[o] = r[q]; sK[o] = kp; sV[o] = v[q]; sA[o] = -kn; sB[o] = kn * ag; sD[o] = __expf(lw); rks += r[q] * kp * rkv[q]; }
                rks += shx(rks, 1, lane); rks += shx(rks, 2, lane); rks += shx(rks, 4, lane);
                if (cq == 0) RK[row * NH + h] = rks;
            }
            __syncthreads();
            for (int t = 0; t < 64; ++t) {
                const LAS f32x4* pa = (const LAS f32x4*)(sA + t * 64 + jq * 8); const LAS f32x4* pb = (const LAS f32x4*)(sB + t * 64 + jq * 8);
                const LAS f32x4* pd = (const LAS f32x4*)(sD + t * 64 + jq * 8); const LAS f32x4* pk = (const LAS f32x4*)(sK + t * 64 + jq * 8);
                const LAS f32x4* pr = (const LAS f32x4*)(sR + t * 64 + jq * 8);
                const f32x4 a0 = pa[0], a1 = pa[1], b0 = pb[0], b1 = pb[1], d0 = pd[0], d1 = pd[1], k0 = pk[0], k1 = pk[1], r0 = pr[0], r1 = pr[1];
                const float vi = sV[t * 64 + si];
                float sa = 0.f;
#pragma unroll
                for (int q = 0; q < 4; ++q) { sa += S[q] * a0[q]; sa += S[4 + q] * a1[q]; }
                sa += shx(sa, 1, lane); sa += shx(sa, 2, lane); sa += shx(sa, 4, lane);
                float y = 0.f;
#pragma unroll
                for (int q = 0; q < 4; ++q) { S[q] = S[q] * d0[q] + sa * b0[q] + vi * k0[q]; S[4 + q] = S[4 + q] * d1[q] + sa * b1[q] + vi * k1[q]; y += S[q] * r0[q]; y += S[4 + q] * r1[q]; }
                y += shx(y, 1, lane); y += shx(y, 2, lane); y += shx(y, 4, lane);
                if (jq == 0) Y[((size_t)b * SEQ + blk * 64 + t) * C + h * HD + si] = y;
            }
            __syncthreads();
        }
    }
}
__device__ __forceinline__ void post_scan(unsigned char* ws, int gw, int NGW, int lane) {
    const float* Y = OUTP(); const float* RK = (const float*)(ws + WS_HID); const bf16* Vb = (const bf16*)(ws + WS_B3); const bf16* LG = (const bf16*)(ws + WS_LG);
    bf16* YG = (bf16*)(ws + WS_B4); const float* g2 = INP(14); const float* lnw = INP(18); const float* lnb = INP(19);
    for (int it = gw; it < M * NH; it += NGW) {
        const int row = it / NH, h = it % NH, c = h * HD + lane;
        const float y = Y[(size_t)row * C + c];
        const float mu = wave_sum(y, lane) * (1.0f / HD); const float d = y - mu; const float var = wave_sum(d * d, lane) * (1.0f / HD);
        float o = d * (1.0f / sqrtf(var + GN_EPS)) * lnw[c] + lnb[c];
        o += RK[(size_t)row * NH + h] * bf2f(Vb[(size_t)row * C + c]);
        float g = 0.f;
        for (int dd = 0; dd < DG; ++dd) g += bf2f(LG[(size_t)row * DG + dd]) * g2[(size_t)dd * C + c];
        YG[(size_t)row * C + c] = (bf16)f2bf(o * g);
    }
}


constexpr int CW_DBG = 3200;
__device__ __forceinline__ void dbg_nonfinite(unsigned char* ws, const bf16* X, size_t n, int slot, int gw, int NGW, int lane, float thr = 1e30f) {
    unsigned* cw = (unsigned*)(ws + WS_CTL) + CW_DBG + 64 * slot; unsigned nnan = 0;
    for (size_t i = (size_t)gw * 64 + lane; i < n; i += (size_t)NGW * 64) { const float x = bf2f(X[i]); if (!(fabsf(x) < thr)) ++nnan; }
    if (nnan) atomicAdd(cw, nnan);
}
__device__ __forceinline__ void dbg_compare(unsigned char* ws, const bf16* X, const bf16* Y, int gw, int NGW, int lane) {
    unsigned* cw = (unsigned*)(ws + WS_CTL) + CW_DBG; unsigned nbad = 0, nnan = 0;
    for (size_t i = (size_t)gw * 64 + lane; i < (size_t)M * C; i += (size_t)NGW * 64) { const float x = bf2f(X[i]), y = bf2f(Y[i]);
        if (!(fabsf(x) < 1e30f)) ++nnan; else if (fabsf(x - y) > 0.05f * (fabsf(y) + 0.05f)) ++nbad; }
    if (nnan) atomicAdd(cw, nnan); if (nbad) atomicAdd(cw + 64, nbad);
}
#endif
__device__ __forceinline__ void router_rows(unsigned char* ws, LAS unsigned char* lds, int layer, int gw, int NGW, int lane, int tid, bool dry = false) {
    const float* Hh = OUTP(); const float* gain = INP(2) + layer * C; bf16* XN = (bf16*)(ws + WS_B1);
    const float* wg = INP(24) + (size_t)layer * C * 4; const float* bg = INP(25) + layer * 4; const float* wi = INP(26) + (size_t)layer * C * 16; const float* bi = INP(27) + layer * 16;
    unsigned* cnt = (unsigned*)(ws + WS_CTL) + CW_CNT + layer * 16 * 64; unsigned* list = (unsigned*)(ws + WS_LIST); float* wl = (float*)(ws + WS_WL);
    LAS float* sWg = (LAS float*)lds; LAS float* sWi = sWg + C * 4;
    constexpr int RECMAX = 256;
    LAS unsigned* lcnt = (LAS unsigned*)(lds + 81920); LAS unsigned* gbase = lcnt + 16; LAS int* nrec = (LAS int*)(lcnt + 32);
    LAS unsigned* recRow = lcnt + 64; LAS unsigned* recE = recRow + RECMAX; LAS unsigned* recL = recE + RECMAX; LAS float* recW0 = (LAS float*)(recL + RECMAX); LAS float* recW1 = recW0 + RECMAX;
    __syncthreads();
    for (int e = tid; e < C * 4; e += 512) sWg[e] = wg[e];
    for (int e = tid; e < C * 16; e += 512) sWi[e] = wi[e];
    if (tid < 33) lcnt[tid == 32 ? 32 : tid] = 0u;
    __syncthreads();
    f32x4 g[4]; load_row(gain, lane, g);
    for (int row = gw; row < M; row += NGW) {
        f32x4 v[4]; load_row(Hh + (size_t)row * C, lane, v); const float rs = row_rs(v, lane);
#pragma unroll
        for (int j = 0; j < 4; ++j) v[j] = v[j] * rs * g[j];
        store_row_bf16(XN + (size_t)row * C, lane, v);
        float gl[4] = {0.f, 0.f, 0.f, 0.f};
        const LAS unsigned char* pWg = (const LAS unsigned char*)sWg + lane * 64;
#pragma unroll
        for (int j = 0; j < 4; ++j)
#pragma unroll
            for (int q = 0; q < 4; ++q) { const f32x4 w = *(const LAS f32x4*)(pWg + j * 4096 + q * 16); const float xv = v[j][q]; gl[0] += xv * w.x; gl[1] += xv * w.y; gl[2] += xv * w.z; gl[3] += xv * w.w; }
#pragma unroll
        for (int q = 0; q < 4; ++q) gl[q] = wave_sum(gl[q], lane) + bg[q];
        int gi = 0; float gm = gl[0];
#pragma unroll
        for (int q = 1; q < 4; ++q) if (gl[q] > gm) { gm = gl[q]; gi = q; }
        float gden = 0.f;
#pragma unroll
        for (int q = 0; q < 4; ++q) gden += __expf(gl[q] - gm);
        const float gval = 1.0f / gden;
        float il[4] = {0.f, 0.f, 0.f, 0.f};
        const LAS unsigned char* pWi = (const LAS unsigned char*)sWi + lane * 256 + gi * 16;
#pragma unroll
        for (int j = 0; j < 4; ++j)
#pragma unroll
            for (int q = 0; q < 4; ++q) { const f32x4 w = *(const LAS f32x4*)(pWi + j * 16384 + q * 64); const float xv = v[j][q]; il[0] += xv * w.x; il[1] += xv * w.y; il[2] += xv * w.z; il[3] += xv * w.w; }
#pragma unroll
        for (int q = 0; q < 4; ++q) il[q] = wave_sum(il[q], lane) + bi[gi * 4 + q];
        int i0 = 0; float m0 = il[0];
#pragma unroll
        for (int q = 1; q < 4; ++q) if (il[q] > m0) { m0 = il[q]; i0 = q; }
        int i1 = -1; float m1 = -INFINITY;
#pragma unroll
        for (int q = 0; q < 4; ++q) if (q != i0 && il[q] > m1) { m1 = il[q]; i1 = q; }
        const float e1 = __expf(m1 - m0); const float w0 = gval / (1.0f + e1), w1 = gval * e1 / (1.0f + e1);
        if (lane == 0 && !dry) {
            const int ex0 = gi * 4 + i0, ex1 = gi * 4 + i1;
            const int ri = __hip_atomic_fetch_add(nrec, 1, __ATOMIC_RELAXED, __HIP_MEMORY_SCOPE_WORKGROUP);
            const unsigned l0 = __hip_atomic_fetch_add(lcnt + ex0, 1u, __ATOMIC_RELAXED, __HIP_MEMORY_SCOPE_WORKGROUP), l1 = __hip_atomic_fetch_add(lcnt + ex1, 1u, __ATOMIC_RELAXED, __HIP_MEMORY_SCOPE_WORKGROUP);
            if (ri < RECMAX) { recRow[ri] = (unsigned)row; recE[ri] = (unsigned)ex0 | ((unsigned)ex1 << 8); recL[ri] = l0 | (l1 << 16); recW0[ri] = w0; recW1[ri] = w1; }
        }
    }
    __syncthreads();
    if (tid < 16 && !dry) gbase[tid] = atomicAdd(cnt + tid * 64, lcnt[tid]);
    __syncthreads();
    { const int n = *nrec < RECMAX ? *nrec : RECMAX;
      for (int i = tid; i < n; i += 512) { const unsigned row = recRow[i], e = recE[i], l = recL[i]; const unsigned ex0 = e & 255u, ex1 = e >> 8;
          const unsigned p0 = gbase[ex0] + (l & 0xffffu), p1 = gbase[ex1] + (l >> 16);
          list[(size_t)ex0 * M + p0] = row * 2u; wl[(size_t)ex0 * M + p0] = recW0[i]; list[(size_t)ex1 * M + p1] = row * 2u + 1u; wl[(size_t)ex1 * M + p1] = recW1[i]; } }
}
__device__ __forceinline__ void moe_table(unsigned char* ws, volatile LAS int* tab, int layer, int tid) {
    __syncthreads();
    if (tid == 0) { const unsigned* cnt = (const unsigned*)(ws + WS_CTL) + CW_CNT + layer * 16 * 64; int t = 0;
#pragma unroll 1
        for (int e = 0; e < 16; ++e) { const int c = (int)__hip_atomic_load(cnt, RLX_AGENT); cnt += 64; tab[e] = c; tab[16 + e] = t; t += (c + 255) >> 8; tab[32 + e] = t; }
        tab[48] = t; }
    __syncthreads();
}
__device__ __forceinline__ void combine_rows(unsigned char* ws, int mode, int gw, int NGW, int lane, bool dry = false) {
    float* Hh = OUTP(); const bf16* E0 = (const bf16*)(ws + WS_B2); const bf16* E1 = (const bf16*)(ws + WS_B3); bf16* XN2 = (bf16*)(ws + WS_B0);
    f32x4 g[4]; load_row(INP(4), lane, g);
    for (int row = gw; row < M; row += NGW) {
        f32x4 v[4]; load_row(Hh + (size_t)row * C, lane, v);
#pragma unroll
        for (int j = 0; j < 4; ++j) { const v2u e0 = ((const GAS v2u*)(E0 + (size_t)row * C))[64 * j + lane], e1 = ((const GAS v2u*)(E1 + (size_t)row * C))[64 * j + lane];
            v[j].x += bflo(e0.x) + bflo(e1.x); v[j].y += bfhi(e0.x) + bfhi(e1.x); v[j].z += bflo(e0.y) + bflo(e1.y); v[j].w += bfhi(e0.y) + bfhi(e1.y); }
        const float rs = row_rs(v, lane);
        if (mode == 0) {
#pragma unroll
            for (int j = 0; j < 4; ++j) if (!dry) ((GAS f32x4*)(Hh + (size_t)row * C))[64 * j + lane] = v[j];
#pragma unroll
            for (int j = 0; j < 4; ++j) v[j] = v[j] * rs;
            store_row_bf16(XN2 + (size_t)row * C, lane, v);
        } else {
            float sig = 1.0f;
#if MK_DEBUG
            const unsigned* cw = (const unsigned*)(ws + WS_CTL) + CW_DBG; const unsigned nnan = __hip_atomic_load(cw, RLX_AGENT), nbad = __hip_atomic_load(cw + 64, RLX_AGENT);
            if (row < 512 && nnan > 0) sig = 2.0f;
            if (row >= 512 && row < 1536 && __hip_atomic_load(cw + 128, RLX_AGENT) > 0) sig = 2.0f;
            if (row >= 1536 && row < 3584 && __hip_atomic_load(cw + 192, RLX_AGENT) > 0) sig = 2.0f;
            if (row >= 3584 && row < 7680 && __hip_atomic_load(cw + 256, RLX_AGENT) > 0) sig = 2.0f;
            if (row >= 7680 && row < 15872 && __hip_atomic_load(cw + 320, RLX_AGENT) > 0) sig = 2.0f;
            if (row >= 15872 && nbad > (unsigned)(M / 100) * C) sig = 1.5f;
#endif
#pragma unroll
            for (int j = 0; j < 4; ++j) ((GAS f32x4*)(Hh + (size_t)row * C))[64 * j + lane] = v[j] * rs * g[j] * sig;
        }
    }
}
__device__ __forceinline__ void attn_naive(unsigned char* ws, int gw, int NGW, int lane) {
    const bf16* Kb = (const bf16*)(ws + WS_B1); const bf16* Vb = (const bf16*)(ws + WS_B2); const bf16* Qb = (const bf16*)(ws + WS_B3); bf16* Ob = (bf16*)(ws + WS_B0);
    for (int unit = gw; unit < BATCH * NH * (SEQ / 64); unit += NGW) {
        const int qb = unit % (SEQ / 64), bh = unit / (SEQ / 64), b = bh / NH, h = bh % NH;
        const int t0 = qb * 64, t = t0 + lane; const size_t rowq = (size_t)b * SEQ + t;
        float q[64], o[64];
#pragma unroll
        for (int c = 0; c < 8; ++c) { const v4u w = *(const GAS v4u*)(Qb + rowq * C + h * HD + c * 8);
            q[c * 8 + 0] = bflo(w.x) * 0.125f; q[c * 8 + 1] = bfhi(w.x) * 0.125f; q[c * 8 + 2] = bflo(w.y) * 0.125f; q[c * 8 + 3] = bfhi(w.y) * 0.125f;
            q[c * 8 + 4] = bflo(w.z) * 0.125f; q[c * 8 + 5] = bfhi(w.z) * 0.125f; q[c * 8 + 6] = bflo(w.w) * 0.125f; q[c * 8 + 7] = bfhi(w.w) * 0.125f; }
#pragma unroll
        for (int c = 0; c < 64; ++c) o[c] = 0.f;
        float suffix = 0.f;
        for (int s = t0 + 62; s >= 0; --s) {
            const bool valid = s < t;
            if (s < t0 && __all(suffix > SB_EXIT)) break;
            const bf16* kp = Kb + ((size_t)b * SEQ + s) * C + h * HD; const bf16* vp = Vb + ((size_t)b * SEQ + s) * C + h * HD;
            float z = 0.f;
#pragma unroll
            for (int c = 0; c < 8; ++c) { const v4u w = *(const GAS v4u*)(kp + c * 8);
                z += q[c * 8 + 0] * bflo(w.x) + q[c * 8 + 1] * bfhi(w.x) + q[c * 8 + 2] * bflo(w.y) + q[c * 8 + 3] * bfhi(w.y) + q[c * 8 + 4] * bflo(w.z) + q[c * 8 + 5] * bfhi(w.z) + q[c * 8 + 6] * bflo(w.w) + q[c * 8 + 7] * bfhi(w.w); }
            const float sp = fmaxf(z, 0.f) + log1pf(__expf(-fabsf(z)));
            const float att = valid ? __expf(z - sp - suffix) : 0.f;
            suffix += valid ? sp : 0.f;
#pragma unroll
            for (int c = 0; c < 8; ++c) { const v4u w = *(const GAS v4u*)(vp + c * 8);
                o[c * 8 + 0] += att * bflo(w.x); o[c * 8 + 1] += att * bfhi(w.x); o[c * 8 + 2] += att * bflo(w.y); o[c * 8 + 3] += att * bfhi(w.y);
                o[c * 8 + 4] += att * bflo(w.z); o[c * 8 + 5] += att * bfhi(w.z); o[c * 8 + 6] += att * bflo(w.w); o[c * 8 + 7] += att * bfhi(w.w); }
        }
#pragma unroll
        for (int c = 0; c < 8; ++c) { v4u w; w.x = pk2(o[c * 8 + 0], o[c * 8 + 1]); w.y = pk2(o[c * 8 + 2], o[c * 8 + 3]); w.z = pk2(o[c * 8 + 4], o[c * 8 + 5]); w.w = pk2(o[c * 8 + 6], o[c * 8 + 7]);
            *(GAS v4u*)(Ob + rowq * C + h * HD + c * 8) = w; }
    }
}


typedef float f32x16 __attribute__((ext_vector_type(16)));
constexpr int AT_VP = 192;
constexpr int AT_WAVE_LDS = 32 * AT_VP;
__device__ __forceinline__ int crow32(int reg, int hh) { return (reg & 3) + 8 * (reg >> 2) + 4 * hh; }
__device__ __forceinline__ bf16x8s pack_step(const f32x16& x, const int s) {
    v4u p; p.x = pg8::cvt_pk_bf16(x[8 * s], x[8 * s + 1]); p.y = pg8::cvt_pk_bf16(x[8 * s + 2], x[8 * s + 3]); p.z = pg8::cvt_pk_bf16(x[8 * s + 4], x[8 * s + 5]); p.w = pg8::cvt_pk_bf16(x[8 * s + 6], x[8 * s + 7]);
    return __builtin_bit_cast(bf16x8s, p);
}
__device__ __forceinline__ void attn_mfma(unsigned char* ws, LAS unsigned char* lds, int gw, int NGW, int lane, int wave) {
    const bf16* Kb = (const bf16*)(ws + WS_B1); const bf16* Vb = (const bf16*)(ws + WS_B2); const bf16* Qb = (const bf16*)(ws + WS_B3); bf16* Ob = (bf16*)(ws + WS_B0);
    LAS unsigned char* vl = lds + wave * AT_WAVE_LDS;
    const int r32 = lane & 31, hh = lane >> 5;
    bf16x8s tri[2];
#pragma unroll
    for (int s = 0; s < 2; ++s)
#pragma unroll
        for (int j = 0; j < 8; ++j) tri[s][j] = (16 * s + 8 * (j >> 2) + 4 * hh + (j & 3)) > r32 ? (short)0x3F80 : (short)0;
    const int grp = lane >> 4, tq = (lane & 15) >> 2, tp = lane & 3;
    const LAS unsigned char* vtr0 = vl + (4 * hh + tq) * AT_VP + (16 * (grp & 1) + 4 * tp) * 2;
    for (int unit = gw; unit < BATCH * NH * (SEQ / 32); unit += NGW) {
        const int qb = unit % (SEQ / 32), bh = unit / (SEQ / 32), b = bh / NH, hd = bh % NH;
        const int t0 = qb * 32; const size_t rowb = (size_t)b * SEQ;
        bf16x8s qf[4];
#pragma unroll
        for (int ks = 0; ks < 4; ++ks) qf[ks] = *(const GAS bf16x8s*)(Qb + (rowb + t0 + r32) * C + hd * HD + 16 * ks + 8 * hh);
        f32x16 o[2];
#pragma unroll
        for (int i = 0; i < 16; ++i) { o[0][i] = 0.f; o[1][i] = 0.f; }
        float carry = 0.f;
        for (int s0 = t0; s0 >= 0; s0 -= 32) {
            bf16x8s kf[4];
#pragma unroll
            for (int ks = 0; ks < 4; ++ks) kf[ks] = *(const GAS bf16x8s*)(Kb + (rowb + s0 + r32) * C + hd * HD + 16 * ks + 8 * hh);
            v4u vreg[4];
#pragma unroll
            for (int i = 0; i < 4; ++i) { const int cidx = lane + 64 * i; vreg[i] = *(const GAS v4u*)(Vb + (rowb + s0 + (cidx >> 3)) * C + hd * HD + (cidx & 7) * 8); }
            f32x16 st;
#pragma unroll
            for (int i = 0; i < 16; ++i) st[i] = 0.f;
#pragma unroll
            for (int ks = 0; ks < 4; ++ks) st = __builtin_amdgcn_mfma_f32_32x32x16_bf16(kf[ks], qf[ks], st, 0, 0, 0);
#pragma unroll
            for (int i = 0; i < 4; ++i) { const int cidx = lane + 64 * i; *(LAS v4u*)(vl + (cidx >> 3) * AT_VP + (cidx & 7) * 16) = vreg[i]; }
            f32x16 zz, uu; float tot = 0.f; const int tq_ = t0 + r32;
            if (s0 + 31 < t0) {
#pragma unroll
                for (int i = 0; i < 16; ++i) { const float z = st[i] * 0.18033688011112042f; const float sp = fmaxf(z, 0.f) + __builtin_amdgcn_logf(1.0f + __builtin_amdgcn_exp2f(-fabsf(z)));
                    zz[i] = z - sp; uu[i] = sp; tot += sp; }
            } else {
#pragma unroll
                for (int i = 0; i < 16; ++i) { const int key = s0 + crow32(i, hh); const float z = st[i] * 0.18033688011112042f; const float sp = fmaxf(z, 0.f) + __builtin_amdgcn_logf(1.0f + __builtin_amdgcn_exp2f(-fabsf(z)));
                    const bool valid = key < tq_; zz[i] = valid ? z - sp : -1e30f; uu[i] = valid ? sp : 0.f; tot += uu[i]; }
            }
            f32x16 w;
#pragma unroll
            for (int i = 0; i < 16; ++i) w[i] = 0.f;
#pragma unroll
            for (int s = 0; s < 2; ++s) w = __builtin_amdgcn_mfma_f32_32x32x16_bf16(tri[s], pack_step(uu, s), w, 0, 0, 0);
            f32x16 pp;
#pragma unroll
            for (int i = 0; i < 16; ++i) pp[i] = __builtin_amdgcn_exp2f(zz[i] - w[i] - carry);
            tot += shx(tot, 32, lane); carry += tot;
            asm volatile("s_waitcnt lgkmcnt(0)" ::: "memory");
#pragma unroll
            for (int s = 0; s < 2; ++s) { const bf16x8s pa = pack_step(pp, s);
#pragma unroll
                for (int dt = 0; dt < 2; ++dt) {
                    const v4i16_t lo = __builtin_amdgcn_ds_read_tr16_b64_v4i16((LAS v4i16_t*)(vtr0 + (16 * s) * AT_VP + dt * 64));
                    const v4i16_t hi = __builtin_amdgcn_ds_read_tr16_b64_v4i16((LAS v4i16_t*)(vtr0 + (16 * s + 8) * AT_VP + dt * 64));
                    const bf16x8s vf = (bf16x8s){lo[0], lo[1], lo[2], lo[3], hi[0], hi[1], hi[2], hi[3]};
                    o[dt] = __builtin_amdgcn_mfma_f32_32x32x16_bf16(pa, vf, o[dt], 0, 0, 0); } }
            asm volatile("" ::: "memory");
            if (s0 < t0 && __all(carry > SB_EXIT * 1.4426950408889634f)) break;
        }
#pragma unroll
        for (int dt = 0; dt < 2; ++dt)
#pragma unroll
            for (int i = 0; i < 16; ++i) Ob[(rowb + t0 + crow32(i, hh)) * C + hd * HD + 32 * dt + r32] = (bf16)f2bf(o[dt][i]);
    }
}
__global__ void __launch_bounds__(NWAVES * 64, 2) yoco_fwd(Args args) {
    extern __shared__ __attribute__((aligned(16))) unsigned char lds_raw[];
    LAS unsigned char* lds = (LAS unsigned char*)lds_raw;
    const int G = gridDim.x; const int bx = blockIdx.x;
    int wave = __builtin_amdgcn_readfirstlane(threadIdx.x >> 6); asm volatile("" : "+s"(wave));
#define IDS() int lane; asm volatile("v_mbcnt_lo_u32_b32 %0, -1, 0\n\tv_mbcnt_hi_u32_b32 %0, -1, %0" : "=v"(lane)); const int tid = wave * 64 + lane; (void)tid; \
    const int vcu = (G % 8 == 0) ? (bx % 8) * (G / 8) + bx / 8 : bx; const int gw = vcu * NWAVES + wave, NGW = G * NWAVES; (void)lane; (void)gw; (void)NGW;
    unsigned char* ws = WSP();
    volatile LAS unsigned* MISC = (volatile LAS unsigned*)(lds + MISC_OFF);
    volatile LAS int* tab = (volatile LAS int*)(lds + MOE_TAB_OFF);
    for (int u = threadIdx.x; u < (LDS_BYTES - LDSCTL_OFF) / 4; u += NWAVES * 64) ((LAS unsigned*)(lds + LDSCTL_OFF))[u] = 0u;
    __syncthreads();
    XcdBarrier bar; bar.bar = (unsigned*)(ws + WS_CTL) + CW_BAR; bar.x = 0; bar.st = nullptr;
    if (N_LAUNCHES == 1) bar = xcd_barrier_post((unsigned*)(ws + WS_CTL) + CW_BAR, MISC + 8);
    const int lo = KA_INT(0), hi = KA_INT(1);
#ifndef PROBE_PH
#define PROBE_PH -1
#endif
#define IN(k) (lo <= (k) && (k) < hi)
#define REP(k) for (int rep_ = 0; rep_ < ((PROBE_PH == (k)) ? 2 : 1); ++rep_)
#define SEAM(k) do { if (IN(k) && IN((k) + 1)) xcd_barrier(bar); } while (0)

    if (IN(PH_P0)) REP(PH_P0) { IDS(); p0_weights<0>(ws, lds, gw, NGW, wave, lane); p0_weights<1>(ws, lds, gw, NGW, wave, lane); p0_rows(ws, gw, NGW, lane); }
    SEAM(PH_P0);
    if (PROBE_PH == 100 && N_LAUNCHES == 1) { for (int i_ = 0; i_ < 10; ++i_) xcd_barrier(bar); }
    if (IN(PH_LORA)) REP(PH_LORA) {
        SchedGrouped<1, 3> S{(const char*)(ws + WS_B1), (size_t)(WS_B2 - WS_B1), nullptr, (const char*)(ws + WS_WT_LORA), (size_t)256 * C * 2, G, bx};
        EpiLora E{(bf16*)(ws + WS_LW)};
        pg8::gemm_phase<EpiLora, SchedGrouped<1, 3>, true, false, C>(lds, S, E, wave);
    }
    SEAM(PH_LORA);
    if (IN(PH_RKV)) REP(PH_RKV) {
        SchedGrouped<4, 3> S{(const char*)OUTP(), (size_t)M * C * 2, (const char*)(ws + WS_B4), (const char*)(ws + WS_WT_RKV), (size_t)C * C * 2, G, bx};
        EpiSplit3 E{(bf16*)(ws + WS_B1), false};
        pg8::gemm_phase<EpiSplit3, SchedGrouped<4, 3>, true, false, C>(lds, S, E, wave);
    }
    SEAM(PH_RKV);
    if (IN(PH_S1)) REP(PH_S1) { IDS(); scan_s1(ws, lds, lane, wave); }
    SEAM(PH_S1);
    if (IN(PH_S2)) REP(PH_S2) { IDS();
        if (bx < BATCH * NH || G <= BATCH * NH) scan_s2(ws, lds, lane, wave);
        }
    SEAM(PH_S2);
    if (IN(PH_S3)) REP(PH_S3) { IDS(); scan_s3(ws, lds, lane, wave); }
    SEAM(PH_S3);
#if MK_DEBUG
    if (IN(PH_DBG0)) { IDS(); scan_naive(ws, lds, tid); }
    SEAM(PH_DBG0);
    if (IN(PH_DBG0 + 1)) { IDS(); post_scan(ws, gw, NGW, lane); }
    SEAM(PH_DBG0 + 1);
    if (IN(PH_DBG0 + 2)) { IDS(); dbg_compare(ws, (const bf16*)(ws + WS_B0), (const bf16*)(ws + WS_B4), gw, NGW, lane); }
    SEAM(PH_DBG0 + 2);
#endif
    if (IN(PH_WOUT)) REP(PH_WOUT) {
        SchedGrouped<4, 1> S{(const char*)(ws + ((MK_DEBUG && DBG_USE_NAIVE) ? WS_B4 : WS_B0)), 0, nullptr, (const char*)(ws + WS_WT_OUT), 0, G, bx};
        EpiResid E{INP(0), OUTP()};
        pg8::gemm_phase<EpiResid, SchedGrouped<4, 1>, true, false, C>(lds, S, E, wave);
    }
    SEAM(PH_WOUT);
#pragma unroll 1
    for (int layer = 0; layer < 2; ++layer) {
        const int pb = layer == 0 ? (int)PH_ROUT0 : (int)PH_ROUT1;
        if (IN(pb)) { IDS(); if (PROBE_PH == 101 && layer == 0) router_rows(ws, lds, layer, gw, NGW, lane, tid, true); router_rows(ws, lds, layer, gw, NGW, lane, tid); }
        SEAM(pb);
        if (IN(pb + 1)) REP(pb + 1) {
            { IDS(); moe_table(ws, tab, layer, tid); }
            SchedMoe<2, C, true> S{(const char*)(ws + WS_B1), (const char*)(ws + WS_WT_GU) + (size_t)layer * 16 * 512 * C * 2, (size_t)512 * C * 2, (const unsigned*)(ws + WS_LIST), tab, G, bx};
            EpiGU E{(bf16*)(ws + WS_HID), (const float*)(ws + WS_WL)};
            pg8::gemm_phase<EpiGU, SchedMoe<2, C, true>, true, true, C>(lds, S, E, wave);
        }
        SEAM(pb + 1);
        if (IN(pb + 2)) REP(pb + 2) {
            { IDS(); moe_table(ws, tab, layer, tid); }
            SchedMoe<4, FE, false> S{(const char*)(ws + WS_HID), (const char*)(ws + WS_WT_DN) + (size_t)layer * 16 * C * FE * 2, (size_t)C * FE * 2, (const unsigned*)(ws + WS_LIST), tab, G, bx};
            EpiDown E{(bf16*)(ws + WS_B2), (const unsigned*)(ws + WS_LIST)};
            pg8::gemm_phase<EpiDown, SchedMoe<4, FE, false>, true, false, FE>(lds, S, E, wave);
        }
        SEAM(pb + 2);
        if (layer == 0) {
            if (IN(PH_COMB)) { IDS(); if (PROBE_PH == 102) combine_rows(ws, 0, gw, NGW, lane, true); combine_rows(ws, 0, gw, NGW, lane); }
            SEAM(PH_COMB);
            if (IN(PH_KVQ)) REP(PH_KVQ) {
                SchedGrouped<12, 1> S{(const char*)(ws + WS_B0), 0, nullptr, (const char*)(ws + WS_WT_KVQ), 0, G, bx};
                EpiSplit3 E{(bf16*)(ws + WS_B1), true};
                pg8::gemm_phase<EpiSplit3, SchedGrouped<12, 1>, true, false, C>(lds, S, E, wave);
            }
            SEAM(PH_KVQ);
            if (IN(PH_ATTN)) REP(PH_ATTN) { IDS(); attn_mfma(ws, lds, gw, NGW, lane, wave); }
            SEAM(PH_ATTN);
            if (IN(PH_SBO)) {
                SchedGrouped<4, 1> S{(const char*)(ws + WS_B0), 0, nullptr, (const char*)(ws + WS_WT_SBO), 0, G, bx};
                EpiResid E{OUTP(), OUTP()};
                pg8::gemm_phase<EpiResid, SchedGrouped<4, 1>, true, false, C>(lds, S, E, wave);
            }
            SEAM(PH_SBO);
        }
    }
    if (IN(PH_FINAL)) { IDS(); combine_rows(ws, 1, gw, NGW, lane); }
#undef IN
#undef SEAM
}

extern "C" void kernel_launch(void* const* d_in, const int* in_sizes, int n_in, void* d_out, int out_size, void* d_ws, size_t ws_size, hipStream_t stream) {
    static int grid = 0;
    if (grid == 0) {
        if (n_in != 31 || in_sizes[0] != M * C || out_size != M * C || ws_size < WS_END) { fprintf(stderr, "kernel_launch: unexpected shapes (n_in %d, in0 %d, out %d, ws %zu); nothing launched\n", n_in, n_in > 0 ? in_sizes[0] : -1, out_size, ws_size); grid = -1; return; }
        int dev = 0, cus = 0, per_cu = 0;
        if (hipGetDevice(&dev) != hipSuccess || hipDeviceGetAttribute(&cus, hipDeviceAttributeMultiprocessorCount, dev) != hipSuccess) { grid = -1; return; }
        if (hipFuncSetAttribute((const void*)yoco_fwd, hipFuncAttributeMaxDynamicSharedMemorySize, LDS_BYTES) != hipSuccess) { fprintf(stderr, "kernel_launch: hipFuncSetAttribute failed\n"); grid = -1; return; }
        if (hipOccupancyMaxActiveBlocksPerMultiprocessor(&per_cu, (const void*)yoco_fwd, NWAVES * 64, LDS_BYTES) != hipSuccess || per_cu < 1) fprintf(stderr, "kernel_launch: occupancy query reports %d\n", per_cu);
        (void)hipGetLastError();
        grid = cus - (cus % 16);
    }
    if (grid < 0) return;
    if (hipMemsetAsync((char*)d_ws + WS_CTL, 0, CTL_ZERO_BYTES, stream) != hipSuccess) return;
    Args a{};
    for (int i = 0; i < 31; ++i) a.in[i] = (const float*)d_in[i];
    a.out = (float*)d_out; a.ws = (unsigned char*)d_ws;
    for (int li = 0; li < (N_LAUNCHES == 1 ? 1 : (int)NPHASE); ++li) {
        a.ph_lo = (N_LAUNCHES == 1) ? 0 : li; a.ph_hi = (N_LAUNCHES == 1) ? NPHASE : li + 1; a.li = li;
        hipLaunchKernelGGL(yoco_fwd, dim3(grid), dim3(NWAVES * 64), LDS_BYTES, stream, a);
        const hipError_t le = hipPeekAtLastError();
        if (le != hipSuccess) { fprintf(stderr, "kernel_launch: launch %d failed: %s\n", li, hipGetErrorName(le)); break; }
    }
}
```

```cpp
#include <hip/hip_runtime.h>
#include <cstdio>
#include <cstdint>

#ifndef MK_N_LAUNCHES
#define MK_N_LAUNCHES 1
#endif

namespace pg8 {
#define PG8_LAS __attribute__((address_space(3)))
typedef unsigned short bf16_t;
typedef short bf16x8 __attribute__((ext_vector_type(8)));
typedef float f32x4 __attribute__((ext_vector_type(4)));
typedef unsigned u32x4 __attribute__((ext_vector_type(4)));
constexpr int BM = 256, BK = 64, HALF = 128, HTB = HALF * BK * 2, STAGE_BYTES = 8 * HTB, NXCD = 8, WGM = 8;

__host__ __device__ __forceinline__ int lds_byte(int r, int c) { const int st = (r >> 4) * 2 + (c >> 5), rr = r & 15, cc = c & 31, ob = rr * 64 + cc * 2; return st * 1024 + (ob ^ (((ob >> 9) & 1) << 5)); }
__host__ __device__ __forceinline__ void stage_rc(int b, int& R, int& C) { const int st = b / 1024, sb = b % 1024, swz = sb ^ (((sb >> 9) & 1) << 5); R = (st >> 1) * 16 + swz / 64; C = (st & 1) * 32 + (swz % 64) / 2; }
__host__ __device__ __forceinline__ int perm32(int rho) { const int n = rho >> 4, i = rho & 15; return 8 * (i >> 2) + 4 * n + (i & 3); }

struct Unit { int pm, pn, aux, r0, cnt; };

__host__ __device__ __forceinline__ void tile_map(int wgid, int nM, int nN, int& pm, int& pn) {
    const int nwg = nM * nN;
    { const int q = nwg / NXCD, r = nwg % NXCD, xcd = wgid % NXCD, off = wgid / NXCD; wgid = (xcd < r ? xcd * (q + 1) : r * (q + 1) + (xcd - r) * q) + off; }
    const int nig = WGM * nN, gid = wgid / nig, fm = gid * WGM, gsz = (nM - fm) < WGM ? (nM - fm) : WGM;
    pm = fm + ((wgid % nig) % gsz); pn = (wgid % nig) / gsz;
}

typedef float f32x2_t __attribute__((ext_vector_type(2))); typedef __bf16 bf16x2_t __attribute__((ext_vector_type(2)));
__device__ __forceinline__ unsigned cvt_pk_bf16(float lo, float hi) { const f32x2_t v = {lo, hi}; const bf16x2_t b = __builtin_convertvector(v, bf16x2_t); return __builtin_bit_cast(unsigned, b); }

template <class Epi, class Sched, bool ALIGN_EPI, bool GATHER, int K>
__device__ __forceinline__ void gemm_phase(PG8_LAS unsigned char* lds, const Sched& S, const Epi& E, const int wid) {
    int lane_; asm volatile("v_mbcnt_lo_u32_b32 %0, -1, 0\n\tv_mbcnt_hi_u32_b32 %0, -1, %0" : "=v"(lane_));
    const int lane = lane_, tid = wid * 64 + lane, wr = wid >> 2, wc = wid & 3, fr = lane & 15, fq = lane >> 4;
    constexpr int nt = K / BK;
    unsigned voffA[2], voffB[2];
#pragma unroll
    for (int i = 0; i < 2; ++i) { int R, C; stage_rc(tid * 16 + i * 8192, R, C); const int Rb = Epi::PERM ? ((R & ~31) + perm32(R & 31)) : R;
        voffA[i] = (unsigned)(R * K + C) * 2u; voffB[i] = (unsigned)(Rb * K + C) * 2u; }
    constexpr size_t kstep = (size_t)(BK * 2);
    constexpr size_t hstep = (size_t)HALF * K * 2;
    const unsigned ldsw = (unsigned)wid * 1024u;
    const int aoff = lds_byte(wr * 64 + fr, fq * 8), boff = lds_byte(wc * 32 + fr, fq * 8);
#define PG8_SA(b, h) (((b) * 2 + (h)) * HTB)
#define PG8_SB(b, h) ((4 + (b) * 2 + (h)) * HTB)
#define PG8_STAGE(bufoff, gbase, voff) do { _Pragma("unroll") for (int _i = 0; _i < 2; ++_i) \
        __builtin_amdgcn_global_load_lds((const unsigned*)((const char*)(gbase) + (voff)[_i]), (PG8_LAS unsigned*)(lds + (bufoff) + ldsw + _i * 8192), 16, 0, 0); } while (0)
#define PG8_LDA(dst, b, h) do { _Pragma("unroll") for (int m = 0; m < 4; ++m) _Pragma("unroll") for (int k = 0; k < 2; ++k) dst[m][k] = *(const PG8_LAS bf16x8*)(lds + PG8_SA(b, h) + aoff + m * 2048 + k * 1024); } while (0)
#define PG8_LDB(dst, b, h) do { _Pragma("unroll") for (int n = 0; n < 2; ++n) _Pragma("unroll") for (int k = 0; k < 2; ++k) dst[n][k] = *(const PG8_LAS bf16x8*)(lds + PG8_SB(b, h) + boff + n * 2048 + k * 1024); } while (0)
#define PG8_MMA(ai, bj, At, Bt) do { __builtin_amdgcn_s_setprio(1); _Pragma("unroll") for (int m = 0; m < 4; ++m) _Pragma("unroll") for (int n = 0; n < 2; ++n) _Pragma("unroll") for (int k = 0; k < 2; ++k) \
        acc[ai][bj][m][n] = __builtin_amdgcn_mfma_f32_16x16x32_bf16(Bt[n][k], At[m][k], acc[ai][bj][m][n], 0, 0, 0); __builtin_amdgcn_s_setprio(0); } while (0)
#define PG8_WAIT_V(n) asm volatile("s_waitcnt vmcnt(" #n ")" ::: "memory")
#define PG8_WAIT_L(n) asm volatile("s_waitcnt lgkmcnt(" #n ")" ::: "memory")
#define PG8_BAR __builtin_amdgcn_s_barrier()
#define PG8_SCHED __builtin_amdgcn_sched_barrier(0)
    Unit cur, nxt; int ui = 0;
    if (!S.next(0, cur)) return;
    f32x4 acc[2][2][4][2];
#pragma unroll
    for (int a = 0; a < 2; ++a)
#pragma unroll
        for (int b = 0; b < 2; ++b)
#pragma unroll
            for (int m = 0; m < 4; ++m)
#pragma unroll
                for (int n = 0; n < 2; ++n) acc[a][b][m][n] = (f32x4){0.f, 0.f, 0.f, 0.f};
    bf16x8 At[4][2], B0[2][2], B1[2][2];
    unsigned vc[2][2];
#define PG8_GOFF(u) do { _Pragma("unroll") for (int _h = 0; _h < 2; ++_h) _Pragma("unroll") for (int _i = 0; _i < 2; ++_i) { int _R, _C; stage_rc(tid * 16 + _i * 8192, _R, _C); \
        vc[_h][_i] = S.a_row_off(u, _h * HALF + _R) + (unsigned)_C * 2u; } } while (0)
#define PG8_STAGE_A(bufoff, gbase, h) do { if constexpr (GATHER) { PG8_STAGE(bufoff, gbase, vc[h]); } else { PG8_STAGE(bufoff, (gbase) + (h) * hstep, voffA); } } while (0)
    if constexpr (GATHER) PG8_GOFF(cur);
    const char* cA = S.a_base(cur); const char* cB = S.b_base(cur);
    PG8_STAGE(PG8_SB(0, 0), cB, voffB); PG8_STAGE(PG8_SB(0, 1), cB + hstep, voffB); PG8_STAGE_A(PG8_SA(0, 0), cA, 0); PG8_STAGE_A(PG8_SA(0, 1), cA, 1);
    if (wr == 1) PG8_BAR;
    PG8_WAIT_V(2); PG8_BAR;
    PG8_STAGE(PG8_SB(1, 0), cB + kstep, voffB); PG8_STAGE_A(PG8_SA(1, 0), cA + kstep, 0); PG8_STAGE(PG8_SB(1, 1), cB + hstep + kstep, voffB);
    PG8_WAIT_V(6); PG8_BAR;
    for (;;) {
        const bool has_next = S.next(ui + 1, nxt);
        const char* nA = has_next ? S.a_base(nxt) : cA; const char* nB = has_next ? S.b_base(nxt) : cB;
        for (int t = 0; t < nt; t += 2) {
            const bool last = (t == nt - 2);
            const char* a1 = cA + (size_t)(t + 1) * kstep;
            const char* a2 = last ? nA : cA + (size_t)(t + 2) * kstep; const char* b2 = last ? nB : cB + (size_t)(t + 2) * kstep;
            const char* a3 = a2 + kstep; const char* b3 = b2 + kstep;
            PG8_LDB(B0, 0, 0); PG8_LDB(B1, 0, 1); PG8_SCHED; PG8_LDA(At, 0, 0); PG8_STAGE_A(PG8_SA(1, 1), a1, 1);
            if constexpr (GATHER) { if (last && has_next) PG8_GOFF(nxt); }
            PG8_WAIT_V(8); PG8_WAIT_L(0); PG8_BAR; PG8_MMA(0, 0, At, B0); PG8_MMA(0, 1, At, B1); PG8_BAR; PG8_SCHED;
            PG8_LDA(At, 0, 1); PG8_STAGE(PG8_SB(0, 0), b2, voffB); PG8_STAGE(PG8_SB(0, 1), b2 + hstep, voffB); PG8_STAGE_A(PG8_SA(0, 0), a2, 0);
            PG8_WAIT_V(8); PG8_WAIT_L(0); PG8_BAR; PG8_MMA(1, 0, At, B0); PG8_MMA(1, 1, At, B1); PG8_BAR; PG8_SCHED;
            PG8_LDB(B0, 1, 0); PG8_LDB(B1, 1, 1); PG8_SCHED; PG8_LDA(At, 1, 0); PG8_STAGE_A(PG8_SA(0, 1), a2, 1);
            PG8_WAIT_V(8); PG8_WAIT_L(0); PG8_BAR; PG8_MMA(0, 0, At, B0); PG8_MMA(0, 1, At, B1); PG8_BAR; PG8_SCHED;
            PG8_LDA(At, 1, 1); PG8_STAGE(PG8_SB(1, 0), b3, voffB); PG8_STAGE(PG8_SB(1, 1), b3 + hstep, voffB); PG8_STAGE_A(PG8_SA(1, 0), a3, 0);
            PG8_WAIT_V(8); PG8_WAIT_L(0); PG8_BAR; PG8_MMA(1, 0, At, B0); PG8_MMA(1, 1, At, B1); PG8_BAR; PG8_SCHED;
        }
        if constexpr (ALIGN_EPI) { if (wr == 0) PG8_BAR; }
        E(acc, cur, wr, wc, fr, fq);
        if (!has_next) break;
#pragma unroll
        for (int a = 0; a < 2; ++a)
#pragma unroll
            for (int b = 0; b < 2; ++b)
#pragma unroll
                for (int m = 0; m < 4; ++m)
#pragma unroll
                    for (int n = 0; n < 2; ++n) acc[a][b][m][n] = (f32x4){0.f, 0.f, 0.f, 0.f};
        cur = nxt; cA = nA; cB = nB; ++ui;
        if constexpr (ALIGN_EPI) { if (wr == 1) PG8_BAR; }
    }
    PG8_WAIT_V(0);
    if constexpr (!ALIGN_EPI) { if (wr == 0) PG8_BAR; }
    PG8_BAR;
#undef PG8_SA
#undef PG8_SB
#undef PG8_STAGE
#undef PG8_STAGE_A
#undef PG8_GOFF
#undef PG8_LDA
#undef PG8_LDB
#undef PG8_MMA
#undef PG8_WAIT_V
#undef PG8_WAIT_L
#undef PG8_BAR
#undef PG8_SCHED
}
}

constexpr int NWAVES = 8;
#ifndef MK_DEBUG
#define MK_DEBUG 0
#endif
#ifndef DBG_USE_NAIVE
#define DBG_USE_NAIVE 0
#endif
constexpr int DBGP = MK_DEBUG ? 3 : 0;
enum Phase { PH_P0 = 0, PH_LORA, PH_RKV, PH_S1, PH_S2, PH_S3, PH_DBG0, PH_WOUT = PH_DBG0 + DBGP, PH_ROUT0, PH_GU0, PH_DN0, PH_COMB, PH_KVQ, PH_ATTN, PH_SBO, PH_ROUT1, PH_GU1, PH_DN1, PH_FINAL, NPHASE };
constexpr int N_LAUNCHES = MK_N_LAUNCHES;


constexpr int BATCH = 2, SEQ = 8192, C = 1024, NH = 16, HD = 64, M = BATCH * SEQ;
constexpr int NE = 16, FE = 256, DW = 64, DA = 64, DG = 160;
constexpr float RMS_EPS = 1e-6f, GN_EPS = 64e-5f;
constexpr float SB_EXIT = 104.0f;

constexpr size_t MiB = 1u << 20;
constexpr size_t WS_CTL = 0, CTL_ZERO_BYTES = 64 * 1024;
constexpr size_t WS_WT_W2 = 128 * 1024, WS_WT_A2 = 256 * 1024, WS_WT_G2 = 384 * 1024;
constexpr size_t WS_WT_RKV = 1 * MiB;
constexpr size_t WS_WT_LORA = 7 * MiB;
constexpr size_t WS_WT_OUT = 9 * MiB;
constexpr size_t WS_WT_KVQ = 11 * MiB;
constexpr size_t WS_WT_SBO = 17 * MiB;
constexpr size_t WS_WT_GU = 19 * MiB;
constexpr size_t WS_WT_DN = 51 * MiB;
constexpr size_t WS_LW = 67 * MiB;
constexpr size_t WS_LA = 69 * MiB;
constexpr size_t WS_LG = 71 * MiB;
static_assert(WS_LA == WS_LW + 2 * MiB && WS_LG == WS_LW + 4 * MiB, "EpiLora's pointer arithmetic");
constexpr size_t WS_LIST = 76 * MiB;
constexpr size_t WS_WL = 77 * MiB;
constexpr size_t WS_HID = 78 * MiB;
constexpr size_t WS_B0 = 96 * MiB, WS_B1 = 128 * MiB, WS_B2 = 160 * MiB, WS_B3 = 192 * MiB, WS_B4 = 224 * MiB, WS_END = 256 * MiB;
static_assert(WS_HID + (size_t)144 * 256 * 256 * 2 <= WS_B0, "HID vs B0");
constexpr int CW_TMO = 0;
constexpr int CW_CNT = 1024;
constexpr int CW_BAR = 4096;

constexpr int RING_BYTES = 131072;
constexpr int LDSCTL_OFF = 146688, MISC_OFF = LDSCTL_OFF + 320, MOE_TAB_OFF = MISC_OFF + 128;
constexpr int LDS_BYTES = 147456;
static_assert(MOE_TAB_OFF + 256 <= LDS_BYTES, "LDS map");
static_assert(BATCH * NH * (SEQ / 64) % 16 == 0, "scan units");

#define GAS __attribute__((address_space(1)))
#define LAS __attribute__((address_space(3)))
typedef unsigned short bf16;
typedef unsigned v4u __attribute__((ext_vector_type(4)));
typedef unsigned v2u __attribute__((ext_vector_type(2)));
typedef float f32x4 __attribute__((ext_vector_type(4)));
typedef GAS unsigned gu32;
#define RLX_AGENT __ATOMIC_RELAXED, __HIP_MEMORY_SCOPE_AGENT
#define LDS_WAIT() asm volatile("s_waitcnt lgkmcnt(0)" ::: "memory")
#define VM_WAIT() asm volatile("s_waitcnt vmcnt(0)" ::: "memory")
__device__ __forceinline__ unsigned f2bf(float f) { unsigned u = __builtin_bit_cast(unsigned, f); return (u + 0x7fffu + ((u >> 16) & 1u)) >> 16; }
__device__ __forceinline__ unsigned pk2(float lo, float hi) { return f2bf(lo) | (f2bf(hi) << 16); }
__device__ __forceinline__ float bflo(unsigned u) { return __uint_as_float(u << 16); }
__device__ __forceinline__ float bfhi(unsigned u) { return __uint_as_float(u & 0xffff0000u); }
__device__ __forceinline__ float bf2f(bf16 b) { return __uint_as_float((unsigned)b << 16); }
__device__ __forceinline__ float sigmoidf_(float x) { return 1.0f / (1.0f + __expf(-x)); }

#define XB_TMO      128
#define XB_XCNT(j)  (256  + 64 * (j))
#define XB_XSUB(j)  (1280 + 64 * (j))
#define XB_XGEN(j)  (2304 + 64 * (j))
#define XB_TOP      3328
#define XB_TOPGEN   3392
#define XCD_BAR_WORDS 3456
#define XB_SPIN_CAP (1u << 18)
__device__ __forceinline__ unsigned xb_ld(unsigned* p)              { return __hip_atomic_load(p, __ATOMIC_RELAXED, __HIP_MEMORY_SCOPE_AGENT); }
__device__ __forceinline__ unsigned xb_add(unsigned* p, unsigned v) { return __hip_atomic_fetch_add(p, v, __ATOMIC_RELAXED, __HIP_MEMORY_SCOPE_AGENT); }
__device__ __forceinline__ unsigned xb_xcc_id() { return (unsigned)__builtin_amdgcn_s_getreg((3 << 11) | 20) & 0xFu; }
#define XB_SPIN(cond, bar) do { unsigned _sp = 0; while (cond) { __builtin_amdgcn_s_sleep(1); \
    if ((++_sp & 255u) == 0u) { if (xb_ld(&(bar)[XB_TMO])) break; if (_sp > XB_SPIN_CAP) { atomicAdd(&(bar)[XB_TMO], 1u); break; } } } } while (0)
struct XcdBarrier { unsigned* bar; unsigned x; volatile LAS unsigned* st; };
__device__ __forceinline__ XcdBarrier xcd_barrier_post(unsigned* bar, volatile LAS unsigned* st) {
    XcdBarrier b; b.bar = bar; b.x = xb_xcc_id(); b.st = st;
    if (threadIdx.x == 0) (void)xb_add(&bar[XB_XCNT(b.x)], 1u);
    return b;
}
__device__ __forceinline__ void xcd_barrier_complete(unsigned* bar, unsigned x, unsigned& nloc, unsigned& nx) {
    const unsigned G = gridDim.x * gridDim.y * gridDim.z;
    unsigned sum, cnt, mine, sp = 0u;
    for (;;) {
        sum = 0u; cnt = 0u; mine = 0u;
#pragma unroll
        for (unsigned j = 0; j < 16; ++j) { const unsigned c = xb_ld(&bar[XB_XCNT(j)]); sum += c; cnt += (c > 0u) ? 1u : 0u; mine = (j == x) ? c : mine; }
        if (sum == G) break;
        __builtin_amdgcn_s_sleep(1);
        if ((++sp & 255u) == 0u) { if (xb_ld(&bar[XB_TMO])) break; if (sp > XB_SPIN_CAP) { atomicAdd(&bar[XB_TMO], 1u); break; } }
    }
    nloc = mine > 0u ? mine : 1u; nx = cnt > 0u ? cnt : 1u;
}
__device__ __forceinline__ void xcd_barrier(const XcdBarrier& b) {
    asm volatile("s_waitcnt vmcnt(0)" ::: "memory");
    __syncthreads();
    if (threadIdx.x == 0) {
        unsigned* bar = b.bar;
        __builtin_amdgcn_s_waitcnt(0);
        unsigned nloc = b.st[0], nx = b.st[1];
        if (nloc == 0u) { xcd_barrier_complete(bar, b.x, nloc, nx); b.st[0] = nloc; b.st[1] = nx; }
        const unsigned old = xb_add(&bar[XB_XSUB(b.x)], 1u);
        const unsigned gen = old / nloc;
        if (old + 1u == (gen + 1u) * nloc) {
            __builtin_amdgcn_fence(__ATOMIC_RELEASE, "agent");
            asm volatile("s_waitcnt vmcnt(0)" ::: "memory");
            const unsigned og = xb_add(&bar[XB_TOP], 1u);
            const unsigned tg = og / nx;
            if (og + 1u == (tg + 1u) * nx) xb_add(&bar[XB_TOPGEN], 1u);
            else XB_SPIN(xb_ld(&bar[XB_TOPGEN]) == tg, bar);
            __builtin_amdgcn_fence(__ATOMIC_ACQUIRE, "agent");
            xb_add(&bar[XB_XGEN(b.x)], 1u);
            asm volatile("s_waitcnt vmcnt(0)" ::: "memory");
        } else {
            XB_SPIN(xb_ld(&bar[XB_XGEN(b.x)]) == gen, bar);
            __builtin_amdgcn_fence(__ATOMIC_ACQUIRE, "agent");
            asm volatile("s_waitcnt vmcnt(0)" ::: "memory");
        }
    }
    __syncthreads();
}

__device__ __forceinline__ float shx(float v, int o, int lane) { return __int_as_float(__builtin_amdgcn_ds_bpermute((lane ^ o) << 2, __float_as_int(v))); }
__device__ __forceinline__ float wave_sum(float v, int lane) {
#pragma unroll
    for (int o = 1; o < 64; o <<= 1) v += shx(v, o, lane);
    return v;
}
__device__ __forceinline__ void transpose_item(const float* W, int ldw, int k0, int n0, bf16* WT, int ldk, int dst_row0, const float* kscale, LAS float* scr, int lane, int kmax = 1 << 30) {
    const int r8 = lane >> 3, quad = lane & 7;
    f32x4 v[8];
#pragma unroll
    for (int i = 0; i < 8; ++i) { const int kk = r8 + 8 * i; v[i] = (k0 + kk < kmax) ? *(const GAS f32x4*)(W + (size_t)(k0 + kk) * ldw + n0 + quad * 4) : (f32x4){0.f, 0.f, 0.f, 0.f}; }
#pragma unroll
    for (int i = 0; i < 8; ++i) { const int kk = r8 + 8 * i; if (kscale) v[i] = v[i] * kscale[(k0 + kk < kmax) ? k0 + kk : 0]; *(LAS f32x4*)(scr + kk * 36 + ((quad ^ i) << 2)) = v[i]; }
    LDS_WAIT(); asm volatile("" ::: "memory");
    const int c = lane & 7;
#pragma unroll
    for (int j = 0; j < 4; ++j) { const int n = (lane >> 3) + 8 * j; const LAS float* sp = scr + (8 * c) * 36 + ((((n >> 2) ^ c) << 2) | (n & 3));
        v4u o; o.x = pk2(sp[0 * 36], sp[1 * 36]); o.y = pk2(sp[2 * 36], sp[3 * 36]); o.z = pk2(sp[4 * 36], sp[5 * 36]); o.w = pk2(sp[6 * 36], sp[7 * 36]);
        if (k0 + 8 * c < kmax) *(GAS v4u*)(WT + (size_t)(dst_row0 + n) * ldk + k0 + 8 * c) = o; }
    LDS_WAIT(); asm volatile("" ::: "memory");
}

struct Args { const float* in[31]; float* out; unsigned char* ws; int ph_lo, ph_hi, li, pad; };
typedef const __attribute__((address_space(4))) unsigned char* kaptr_t;
__device__ __forceinline__ kaptr_t ka_base() { kaptr_t p = (kaptr_t)__builtin_amdgcn_kernarg_segment_ptr(); asm volatile("" : "+s"(p)); return p; }
#define INP(k) (*(const float* const __attribute__((address_space(4)))*)(ka_base() + 8 * (k)))
#define OUTP() (*(float* const __attribute__((address_space(4)))*)(ka_base() + 8 * 31))
#define WSP() (*(unsigned char* const __attribute__((address_space(4)))*)(ka_base() + 8 * 32))
#define KA_INT(i) (*(const int __attribute__((address_space(4)))*)(ka_base() + 8 * 33 + 4 * (i)))

template <int PART> __device__ __forceinline__ void p0_weights(unsigned char* ws, LAS unsigned char* lds, int gw, int NGW, int wave, int lane) {
    LAS float* scr = (LAS float*)(lds + wave * 16384);
    bf16* WT_RKV = (bf16*)(ws + WS_WT_RKV); bf16* WT_LORA = (bf16*)(ws + WS_WT_LORA); bf16* WT_OUT = (bf16*)(ws + WS_WT_OUT); bf16* WT_KVQ = (bf16*)(ws + WS_WT_KVQ);
    bf16* WT_SBO = (bf16*)(ws + WS_WT_SBO); bf16* WT_GU = (bf16*)(ws + WS_WT_GU); bf16* WT_DN = (bf16*)(ws + WS_WT_DN);
    constexpr int I_UP = 32 + 32 + 96, I_RKV = 3 * 512, I_LORA = 32 + 32 + 80, I_OUT = 512, I_KV = 1024, I_Q = 512, I_SBO = 512, I_G = 32 * 128, I_U = 32 * 128, I_D = 32 * 128;
    constexpr int NDENSE = I_UP + I_RKV + I_LORA + I_OUT + I_KV + I_Q + I_SBO, NITEMS = NDENSE + I_G + I_U + I_D;
    for (int it = (PART == 0 ? 0 : NDENSE) + gw; it < (PART == 0 ? NDENSE : NITEMS); it += NGW) {
        int r = it;
        if (r < I_UP) {
            if (r < 32) transpose_item(INP(9), C, 0, 32 * r, (bf16*)(ws + WS_WT_W2), 64, 32 * r, nullptr, scr, lane);
            else if (r < 64) transpose_item(INP(12), C, 0, 32 * (r - 32), (bf16*)(ws + WS_WT_A2), 64, 32 * (r - 32), nullptr, scr, lane);
            else { const int q = r - 64, kb = q / 32, nb = q % 32; transpose_item(INP(14), C, 64 * kb, 32 * nb, (bf16*)(ws + WS_WT_G2), DG, 32 * nb, nullptr, scr, lane, DG); }
            continue; } r -= I_UP;
        if (r < I_RKV) { const int m = r / 512, q = r % 512, kb = q / 32, nb = q % 32; transpose_item(INP(6) + (size_t)m * C * C, C, 64 * kb, 32 * nb, WT_RKV, C, m * C + 32 * nb, nullptr, scr, lane); continue; } r -= I_RKV;
        if (r < I_LORA) {
            if (r < 32) { const int kb = r / 2, nb = r % 2; transpose_item(INP(8), DW, 64 * kb, 32 * nb, WT_LORA, C, 32 * nb, nullptr, scr, lane); }
            else if (r < 64) { const int q = r - 32, kb = q / 2, nb = q % 2; transpose_item(INP(11), DA, 64 * kb, 32 * nb, WT_LORA, C, 256 + 32 * nb, nullptr, scr, lane); }
            else { const int q = r - 64, kb = q / 5, nb = q % 5; transpose_item(INP(13), DG, 64 * kb, 32 * nb, WT_LORA, C, 512 + 32 * nb, nullptr, scr, lane); }
            continue; } r -= I_LORA;
        if (r < I_OUT) { const int kb = r / 32, nb = r % 32; transpose_item(INP(20), C, 64 * kb, 32 * nb, WT_OUT, C, 32 * nb, nullptr, scr, lane); continue; } r -= I_OUT;
        if (r < I_KV) { const int kb = r / 64, nb = r % 64; transpose_item(INP(21), 2 * C, 64 * kb, 32 * nb, WT_KVQ, C, 32 * nb, INP(3), scr, lane); continue; } r -= I_KV;
        if (r < I_Q) { const int kb = r / 32, nb = r % 32; transpose_item(INP(22), C, 64 * kb, 32 * nb, WT_KVQ, C, 2 * C + 32 * nb, INP(1) + C, scr, lane); continue; } r -= I_Q;
        if (r < I_SBO) { const int kb = r / 32, nb = r % 32; transpose_item(INP(23), C, 64 * kb, 32 * nb, WT_SBO, C, 32 * nb, nullptr, scr, lane); continue; } r -= I_SBO;
        if (r < I_G) { const int le = r / 128, q = r % 128, kb = q / 8, nb = q % 8, f0 = 32 * nb; transpose_item(INP(28) + (size_t)le * C * FE, FE, 64 * kb, f0, WT_GU + (size_t)le * 512 * C, C, 256 * (f0 / 128) + (f0 % 128), nullptr, scr, lane); continue; } r -= I_G;
        if (r < I_U) { const int le = r / 128, q = r % 128, kb = q / 8, nb = q % 8, f0 = 32 * nb; transpose_item(INP(29) + (size_t)le * C * FE, FE, 64 * kb, f0, WT_GU + (size_t)le * 512 * C, C, 256 * (f0 / 128) + 128 + (f0 % 128), nullptr, scr, lane); continue; } r -= I_U;
        { const int le = r / 128, q = r % 128, kb = q / 32, nb = q % 32; transpose_item(INP(30) + (size_t)le * FE * C, C, 64 * kb, 32 * nb, WT_DN + (size_t)le * C * FE, FE, 32 * nb, nullptr, scr, lane); }
    }
    if (PART == 0) for (int it = gw * 64 + lane; it < 768 * 128; it += NGW * 64) { const int row = it >> 7, ch = it & 127;
        const bool valid = (row < 64) || (row >= 256 && row < 320) || (row >= 512 && row < 672);
        if (!valid) *(GAS v4u*)(WT_LORA + (size_t)row * C + ch * 8) = (v4u){0u, 0u, 0u, 0u}; }
}
__device__ __forceinline__ void load_row(const float* p, int lane, f32x4 (&v)[4]) {
#pragma unroll
    for (int j = 0; j < 4; ++j) v[j] = ((const GAS f32x4*)p)[64 * j + lane];
}
__device__ __forceinline__ float row_rs(const f32x4 (&v)[4], int lane) {
    float s = 0.f;
#pragma unroll
    for (int j = 0; j < 4; ++j) s += (v[j].x * v[j].x + v[j].y * v[j].y) + (v[j].z * v[j].z + v[j].w * v[j].w);
    return 1.0f / sqrtf(wave_sum(s, lane) * (1.0f / C) + RMS_EPS);
}
__device__ __forceinline__ void store_row_bf16(bf16* p, int lane, const f32x4 (&v)[4]) {
#pragma unroll
    for (int j = 0; j < 4; ++j) { v2u o; o.x = pk2(v[j].x, v[j].y); o.y = pk2(v[j].z, v[j].w); ((GAS v2u*)p)[64 * j + lane] = o; }
}
__device__ __forceinline__ void p0_rows(unsigned char* ws, int gw, int NGW, int lane) {
    const float* x = INP(0); const float* gain = INP(1); const float* mix = INP(5);
    f32x4 g[4]; load_row(gain, lane, g);
    for (int run = gw; run < M / 8; run += NGW) {
        const int r0 = run * 8;
        f32x4 prev[4];
        if ((r0 % SEQ) == 0) {
#pragma unroll
            for (int j = 0; j < 4; ++j) prev[j] = (f32x4){0.f, 0.f, 0.f, 0.f};
        } else { load_row(x + (size_t)(r0 - 1) * C, lane, prev); const float rs = row_rs(prev, lane);
#pragma unroll
            for (int j = 0; j < 4; ++j) prev[j] = prev[j] * rs * g[j]; }
        for (int rr = 0; rr < 8; ++rr) {
            const int row = r0 + rr;
            f32x4 hn[4]; load_row(x + (size_t)row * C, lane, hn); const float rs = row_rs(hn, lane);
#pragma unroll
            for (int j = 0; j < 4; ++j) hn[j] = hn[j] * rs * g[j];
#pragma unroll
            for (int i = 0; i < 6; ++i) { f32x4 o[4];
#pragma unroll
                for (int j = 0; j < 4; ++j) { const f32x4 mx = ((const GAS f32x4*)(mix + i * C))[64 * j + lane]; o[j] = hn[j] + (prev[j] - hn[j]) * mx; }
                bf16* dst = i < 2 ? (bf16*)OUTP() + (size_t)i * M * C : (i == 2 ? (bf16*)(ws + WS_B4) : (bf16*)(ws + WS_B1) + (size_t)(i - 3) * M * C);
                store_row_bf16(dst + (size_t)row * C, lane, o); }
#pragma unroll
            for (int j = 0; j < 4; ++j) prev[j] = hn[j];
        }
    }
}

template <int NN, int NGROUPS> struct SchedGrouped {
    static constexpr int K = C;
    const char* A0; size_t astride; const char* A2; const char* B; size_t bgroup;
    int G, c;
    __device__ __forceinline__ bool next(int i, pg8::Unit& u) const {
        const int L = i * G + c; constexpr int per = 64 * NN; if (L >= per * NGROUPS) return false;
        const int g = L / per, w = L % per; pg8::tile_map(w, 64, NN, u.pm, u.pn); u.aux = g; u.r0 = 0; u.cnt = 0; return true; }
    __device__ __forceinline__ const char* a_base(const pg8::Unit& u) const { const char* A = (A2 != nullptr && u.aux == 2) ? A2 : A0 + (size_t)u.aux * astride; return A + (size_t)u.pm * 256 * K * 2; }
    __device__ __forceinline__ const char* b_base(const pg8::Unit& u) const { return B + (size_t)u.aux * bgroup + (size_t)u.pn * 256 * K * 2; }
    __device__ __forceinline__ unsigned a_row_off(const pg8::Unit&, int) const { return 0u; }
};
template <int NN, int K, bool GATHER> struct SchedMoe {
    const char* A; const char* B; size_t bexp; const unsigned* list; volatile LAS int* tab; int G, c;
    __device__ __forceinline__ bool next(int i, pg8::Unit& u) const {
        const int L = i * G + c; const int tot = __builtin_amdgcn_readfirstlane(tab[48]) * NN; if (L >= tot) return false;
        u.pm = L / NN; u.pn = L % NN; int e = 0;
#pragma unroll
        for (int j = 0; j < 16; ++j) e += (u.pm >= tab[32 + j]) ? 1 : 0;
        e = __builtin_amdgcn_readfirstlane(e);
        u.aux = e; u.r0 = (u.pm - __builtin_amdgcn_readfirstlane(tab[16 + e])) * 256; u.cnt = __builtin_amdgcn_readfirstlane(tab[e]); return true; }
    __device__ __forceinline__ const char* a_base(const pg8::Unit& u) const { return GATHER ? A : A + (size_t)u.pm * 256 * K * 2; }
    __device__ __forceinline__ const char* b_base(const pg8::Unit& u) const { return B + (size_t)u.aux * bexp + (size_t)u.pn * 256 * K * 2; }
    __device__ __forceinline__ unsigned a_row_off(const pg8::Unit& u, int r) const {
        const int idx = u.r0 + r; unsigned tok = 0u;
        if (idx < u.cnt) tok = list[(size_t)u.aux * M + idx] >> 1;
        return tok * (unsigned)(K * 2); }
};

using pg8::f32x4;
using pg8::Unit;
__device__ __forceinline__ v4u pack8(f32x4 v0, f32x4 v1) { v4u w; w.x = pg8::cvt_pk_bf16(v0[0], v0[1]); w.y = pg8::cvt_pk_bf16(v0[2], v0[3]); w.z = pg8::cvt_pk_bf16(v1[0], v1[1]); w.w = pg8::cvt_pk_bf16(v1[2], v1[3]); return w; }

struct EpiLora {
    static constexpr bool PERM = true;
    bf16* LW;
    __device__ __forceinline__ void operator()(const f32x4 (&acc)[2][2][4][2], const Unit& u, int wr, int wc, int fr, int fq) const {
        { int l_; asm volatile("v_mbcnt_lo_u32_b32 %0, -1, 0\n\tv_mbcnt_hi_u32_b32 %0, -1, %0" : "=v"(l_)); fr = l_ & 15; fq = l_ >> 4; }
        const int g = u.aux, width = g == 2 ? DG : DW; bf16* out = LW + (size_t)g * (1u << 20);
        const int row0 = u.pm * 256 + wr * 64 + fr;
#pragma unroll
        for (int bj = 0; bj < 2; ++bj) { const int col0 = bj * 128 + wc * 32 + 8 * fq; if (col0 < width) {
#pragma unroll
            for (int ai = 0; ai < 2; ++ai)
#pragma unroll
                for (int m = 0; m < 4; ++m) { f32x4 v0 = acc[ai][bj][m][0], v1 = acc[ai][bj][m][1];
                    if (g == 0) {
#pragma unroll
                        for (int q = 0; q < 4; ++q) { v0[q] = tanhf(v0[q]); v1[q] = tanhf(v1[q]); } }
                    else if (g == 2) {
#pragma unroll
                        for (int q = 0; q < 4; ++q) { v0[q] = sigmoidf_(v0[q]); v1[q] = sigmoidf_(v1[q]); } }
                    *(GAS v4u*)(out + (size_t)(row0 + ai * 128 + m * 16) * width + col0) = pack8(v0, v1); } } }
    }
};
struct EpiSplit3 {
    static constexpr bool PERM = true;
    bf16* O0; bool bycol;
    __device__ __forceinline__ void operator()(const f32x4 (&acc)[2][2][4][2], const Unit& u, int wr, int wc, int fr, int fq) const {
        { int l_; asm volatile("v_mbcnt_lo_u32_b32 %0, -1, 0\n\tv_mbcnt_hi_u32_b32 %0, -1, %0" : "=v"(l_)); fr = l_ & 15; fq = l_ >> 4; }
        const int g = bycol ? (u.pn >> 2) : u.aux, pn = bycol ? (u.pn & 3) : u.pn; bf16* out = O0 + (size_t)g * ((size_t)M * C);
        const int row0 = u.pm * 256 + wr * 64 + fr, col0 = pn * 256 + wc * 32 + 8 * fq;
#pragma unroll
        for (int ai = 0; ai < 2; ++ai)
#pragma unroll
            for (int m = 0; m < 4; ++m)
#pragma unroll
                for (int bj = 0; bj < 2; ++bj) *(GAS v4u*)(out + (size_t)(row0 + ai * 128 + m * 16) * C + col0 + bj * 128) = pack8(acc[ai][bj][m][0], acc[ai][bj][m][1]);
    }
};
struct EpiResid {
    static constexpr bool PERM = false;
    const float* base; float* out;
    __device__ __forceinline__ void operator()(const f32x4 (&acc)[2][2][4][2], const Unit& u, int wr, int wc, int fr, int fq) const {
        { int l_; asm volatile("v_mbcnt_lo_u32_b32 %0, -1, 0\n\tv_mbcnt_hi_u32_b32 %0, -1, %0" : "=v"(l_)); fr = l_ & 15; fq = l_ >> 4; }
        const int row0 = u.pm * 256 + wr * 64 + fr, col0 = u.pn * 256 + wc * 32 + 4 * fq;
#pragma unroll
        for (int ai = 0; ai < 2; ++ai)
#pragma unroll
            for (int m = 0; m < 4; ++m) { const size_t off = (size_t)(row0 + ai * 128 + m * 16) * C + col0;
#pragma unroll
                for (int bj = 0; bj < 2; ++bj)
#pragma unroll
                    for (int n = 0; n < 2; ++n) { const f32x4 b = *(const GAS f32x4*)(base + off + bj * 128 + n * 16); *(GAS f32x4*)(out + off + bj * 128 + n * 16) = b + acc[ai][bj][m][n]; } }
    }
};
struct EpiGU {
    static constexpr bool PERM = true;
    bf16* HID; const float* wl;
    __device__ __forceinline__ void operator()(const f32x4 (&acc)[2][2][4][2], const Unit& u, int wr, int wc, int fr, int fq) const {
        { int l_; asm volatile("v_mbcnt_lo_u32_b32 %0, -1, 0\n\tv_mbcnt_hi_u32_b32 %0, -1, %0" : "=v"(l_)); fr = l_ & 15; fq = l_ >> 4; }
        const int e = u.aux, cnt = u.cnt, base = u.r0, r0 = wr * 64 + fr, col0 = u.pn * 128 + wc * 32 + 8 * fq;
#pragma unroll
        for (int ai = 0; ai < 2; ++ai)
#pragma unroll
            for (int m = 0; m < 4; ++m) { const int r = r0 + ai * 128 + m * 16, idx = base + r; float w = 0.f; if (idx < cnt) w = wl[(size_t)e * M + idx];
                f32x4 h0, h1;
#pragma unroll
                for (int q = 0; q < 4; ++q) { const float g0 = acc[ai][0][m][0][q], g1 = acc[ai][0][m][1][q];
                    h0[q] = g0 * sigmoidf_(g0) * acc[ai][1][m][0][q] * w; h1[q] = g1 * sigmoidf_(g1) * acc[ai][1][m][1][q] * w; }
                *(GAS v4u*)(HID + (size_t)(u.pm * 256 + r) * FE + col0) = pack8(h0, h1);
                asm volatile("" ::: "memory"); }
    }
};
struct EpiDown {
    static constexpr bool PERM = true;
    bf16* EO; const unsigned* list;
    __device__ __forceinline__ void operator()(const f32x4 (&acc)[2][2][4][2], const Unit& u, int wr, int wc, int fr, int fq) const {
        { int l_; asm volatile("v_mbcnt_lo_u32_b32 %0, -1, 0\n\tv_mbcnt_hi_u32_b32 %0, -1, %0" : "=v"(l_)); fr = l_ & 15; fq = l_ >> 4; }
        const int e = u.aux, cnt = u.cnt, base = u.r0, r0 = wr * 64 + fr, col0 = u.pn * 256 + wc * 32 + 8 * fq;
#pragma unroll
        for (int ai = 0; ai < 2; ++ai)
#pragma unroll
            for (int m = 0; m < 4; ++m) { const int idx = base + r0 + ai * 128 + m * 16;
                if (idx < cnt) { const unsigned ent = list[(size_t)e * M + idx]; bf16* o = EO + ((size_t)(ent & 1u) * M + (ent >> 1)) * C + col0;
#pragma unroll
                    for (int bj = 0; bj < 2; ++bj) *(GAS v4u*)(o + bj * 128) = pack8(acc[ai][bj][m][0], acc[ai][bj][m][1]); }
                asm volatile("" ::: "memory"); }
    }
};

typedef short bf16x8s __attribute__((ext_vector_type(8)));
typedef short bf16x4s __attribute__((ext_vector_type(4)));
typedef short v4i16_t __attribute__((ext_vector_type(4)));
constexpr int TPB = 144;
constexpr int TILE_B = 64 * TPB;
constexpr int FP = 68;
constexpr int CS_FA = 0, CS_FB = 16384, CS_TILES = 32768, CS_TOT = CS_TILES + 12 * TILE_B, CS_WL = CS_TOT + 2048, CS_PAR = CS_WL + 256;
static_assert(CS_PAR + 768 <= LDSCTL_OFF, "scan LDS map");
#define TILE(n) (lds + CS_TILES + (n) * TILE_B)
#define F4Z (f32x4){0.f, 0.f, 0.f, 0.f}
__device__ __forceinline__ bf16x8s ldfrag(const LAS unsigned char* tile, int row, int kcol) { return *(const LAS bf16x8s*)(tile + row * TPB + kcol * 2); }
__device__ __forceinline__ bf16x8s ldfrag_tr(const LAS unsigned char* tile, int n0, int k0, int lane) {
    const int g = lane >> 4, q = (lane & 15) >> 2, p = lane & 3;
    const LAS unsigned char* a = tile + (k0 + 8 * g + q) * TPB + (n0 + 4 * p) * 2;
    const v4i16_t lo = __builtin_amdgcn_ds_read_tr16_b64_v4i16((LAS v4i16_t*)a), hi = __builtin_amdgcn_ds_read_tr16_b64_v4i16((LAS v4i16_t*)(a + 4 * TPB));
    return (bf16x8s){lo[0], lo[1], lo[2], lo[3], hi[0], hi[1], hi[2], hi[3]};
}
__device__ __forceinline__ bf16x8s ldfrag_perm(const LAS unsigned char* tile, int row, int ks, int g) {
    const bf16x4s lo = *(const LAS bf16x4s*)(tile + row * TPB + (32 * ks + 4 * g) * 2), hi = *(const LAS bf16x4s*)(tile + row * TPB + (32 * ks + 16 + 4 * g) * 2);
    return (bf16x8s){lo[0], lo[1], lo[2], lo[3], hi[0], hi[1], hi[2], hi[3]};
}
__device__ __forceinline__ void lds_barrier() { asm volatile("s_waitcnt lgkmcnt(0)" ::: "memory"); __builtin_amdgcn_s_barrier(); asm volatile("" ::: "memory"); }
#define MFMA16(a, b, c) __builtin_amdgcn_mfma_f32_16x16x32_bf16((a), (b), (c), 0, 0, 0)
__device__ __forceinline__ void mm64(f32x4 (&acc)[2], const LAS unsigned char* At, const LAS unsigned char* Bt, int rt, int ch, int fr, int g) {
#pragma unroll
    for (int ks = 0; ks < 2; ++ks) { const bf16x8s a = ldfrag(At, 16 * rt + fr, 32 * ks + 8 * g);
#pragma unroll
        for (int ct = 0; ct < 2; ++ct) acc[ct] = MFMA16(a, ldfrag(Bt, 32 * ch + 16 * ct + fr, 32 * ks + 8 * g), acc[ct]); }
}
__device__ __forceinline__ void mm64_bt(f32x4 (&acc)[2], const LAS unsigned char* At, const LAS unsigned char* X, int rt, int ch, int fr, int g, int lane) {
#pragma unroll
    for (int ks = 0; ks < 2; ++ks) { const bf16x8s a = ldfrag(At, 16 * rt + fr, 32 * ks + 8 * g);
#pragma unroll
        for (int ct = 0; ct < 2; ++ct) acc[ct] = MFMA16(a, ldfrag_tr(X, 32 * ch + 16 * ct, 32 * ks, lane), acc[ct]); }
}
__device__ __forceinline__ void mm64_at(f32x4 (&acc)[2], const LAS unsigned char* Xa, const LAS unsigned char* Bt, int rt, int ch, int fr, int g, int lane) {
#pragma unroll
    for (int ks = 0; ks < 2; ++ks) { const bf16x8s a = ldfrag_tr(Xa, 16 * rt, 32 * ks, lane);
#pragma unroll
        for (int ct = 0; ct < 2; ++ct) acc[ct] = MFMA16(a, ldfrag(Bt, 32 * ch + 16 * ct + fr, 32 * ks + 8 * g), acc[ct]); }
}
__device__ __forceinline__ void mm64_att(f32x4 (&acc)[2], const LAS unsigned char* Xa, const LAS unsigned char* X, int rt, int ch, int lane) {
#pragma unroll
    for (int ks = 0; ks < 2; ++ks) { const bf16x8s a = ldfrag_tr(Xa, 16 * rt, 32 * ks, lane);
#pragma unroll
        for (int ct = 0; ct < 2; ++ct) acc[ct] = MFMA16(a, ldfrag_tr(X, 32 * ch + 16 * ct, 32 * ks, lane), acc[ct]); }
}
__device__ __forceinline__ bf16x4s pack4(f32x4 v) { v2u w; w.x = pg8::cvt_pk_bf16(v[0], v[1]); w.y = pg8::cvt_pk_bf16(v[2], v[3]); return __builtin_bit_cast(bf16x4s, w); }
__device__ __forceinline__ f32x4 unpack4(bf16x4s s) { const v2u w = __builtin_bit_cast(v2u, s); return (f32x4){bflo(w.x), bfhi(w.x), bflo(w.y), bfhi(w.y)}; }
__device__ __forceinline__ void st_tr(LAS unsigned char* Out, const f32x4 (&acc)[2], int rt, int ch, int fr, int g) {
#pragma unroll
    for (int ct = 0; ct < 2; ++ct) *(LAS bf16x4s*)(Out + (32 * ch + 16 * ct + fr) * TPB + (16 * rt + 4 * g) * 2) = pack4(acc[ct]);
}
__device__ __forceinline__ void ld_tr(f32x4 (&acc)[2], const LAS unsigned char* In, int rt, int ch, int fr, int g) {
#pragma unroll
    for (int ct = 0; ct < 2; ++ct) acc[ct] = unpack4(*(const LAS bf16x4s*)(In + (32 * ch + 16 * ct + fr) * TPB + (16 * rt + 4 * g) * 2));
}
__device__ __forceinline__ void unpack8(v4u w, float (&o)[8]) { o[0] = bflo(w.x); o[1] = bfhi(w.x); o[2] = bflo(w.y); o[3] = bfhi(w.y); o[4] = bflo(w.z); o[5] = bfhi(w.z); o[6] = bflo(w.w); o[7] = bfhi(w.w); }
__device__ __forceinline__ v4u pack8f(const float (&o)[8]) { v4u w; w.x = pg8::cvt_pk_bf16(o[0], o[1]); w.y = pg8::cvt_pk_bf16(o[2], o[3]); w.z = pg8::cvt_pk_bf16(o[4], o[5]); w.w = pg8::cvt_pk_bf16(o[6], o[7]); return w; }

struct FrontIn { v4u r, k, v; bf16x8s fw[2], fa[2]; };
__device__ __forceinline__ void front_fetch(FrontIn& f, unsigned char* ws, int unit, int tid, int lane, int wave) {
    const int h = unit & 15, c = (unit >> 4) & 127, b = unit >> 11; const size_t row0 = (size_t)b * SEQ + c * 64;
    const int rt = wave & 3, fr = lane & 15, g = lane >> 4, t = tid >> 3, cq = tid & 7, c0 = h * HD + cq * 8;
    const bf16* Rb = (const bf16*)(ws + WS_B1); const bf16* Kb = (const bf16*)(ws + WS_B2); const bf16* Vb = (const bf16*)(ws + WS_B3);
    const bf16* LW = (const bf16*)(ws + WS_LW); const bf16* LA = (const bf16*)(ws + WS_LA);
    f.r = *(const GAS v4u*)(Rb + (row0 + t) * C + c0); f.k = *(const GAS v4u*)(Kb + (row0 + t) * C + c0); f.v = *(const GAS v4u*)(Vb + (row0 + t) * C + c0);
#pragma unroll
    for (int ks = 0; ks < 2; ++ks) { f.fw[ks] = *(const GAS bf16x8s*)(LW + (row0 + 16 * rt + fr) * DW + 32 * ks + 8 * g); f.fa[ks] = *(const GAS bf16x8s*)(LA + (row0 + 16 * rt + fr) * DA + 32 * ks + 8 * g); }
}
__device__ __forceinline__ void head_consts(unsigned char* ws, LAS unsigned char* lds, int h, int tid, int wtile, int atile) {
    const bf16* W2T = (const bf16*)(ws + WS_WT_W2); const bf16* A2T = (const bf16*)(ws + WS_WT_A2);
    const int row = tid >> 3, cq = tid & 7;
    *(LAS v4u*)(lds + CS_TILES + wtile * TILE_B + row * TPB + cq * 16) = *(const GAS v4u*)(W2T + (size_t)(h * HD + row) * 64 + cq * 8);
    *(LAS v4u*)(lds + CS_TILES + atile * TILE_B + row * TPB + cq * 16) = *(const GAS v4u*)(A2T + (size_t)(h * HD + row) * 64 + cq * 8);
    if (tid < 64) { LAS float* P = (LAS float*)(lds + CS_PAR); P[tid] = INP(15)[h * HD + tid]; P[64 + tid] = INP(16)[h * HD + tid]; P[128 + tid] = INP(17)[h * HD + tid]; }
    __syncthreads();
}
template <int MODE>
__device__ __forceinline__ void chunk_front(const FrontIn& f, LAS unsigned char* lds, const float (&w0v)[2], const float (&a0v)[2], int tid, int lane, int wave, float (&v8)[8], float& rkb) {
    const int rt = wave & 3, ch = wave >> 2, fr = lane & 15, g = lane >> 4;
    LAS float* FA = (LAS float*)(lds + CS_FA); LAS float* FB = (LAS float*)(lds + CS_FB); LAS float* TOT = (LAS float*)(lds + CS_TOT);
    const int t = tid >> 3, cq = tid & 7;
    constexpr int WTILE = MODE == 1 ? 6 : 10, ATILE = MODE == 1 ? 8 : 11;
    {
        f32x4 aw[2] = {F4Z, F4Z}, aa[2] = {F4Z, F4Z};
#pragma unroll
        for (int ks = 0; ks < 2; ++ks)
#pragma unroll
            for (int ct = 0; ct < 2; ++ct) { aw[ct] = MFMA16(f.fw[ks], ldfrag(TILE(WTILE), 32 * ch + 16 * ct + fr, 32 * ks + 8 * g), aw[ct]); aa[ct] = MFMA16(f.fa[ks], ldfrag(TILE(ATILE), 32 * ch + 16 * ct + fr, 32 * ks + 8 * g), aa[ct]); }
#pragma unroll
        for (int ct = 0; ct < 2; ++ct) { const int j = 32 * ch + 16 * ct + fr; const float w0 = w0v[ct], a0 = a0v[ct];
#pragma unroll
            for (int q = 0; q < 4; ++q) { const int tt = 16 * rt + 4 * g + q, js = j ^ ((g & 1) << 4);
                FA[tt * 64 + js] = -0.6065306597126334f * sigmoidf_(w0 + aw[ct][q]); FB[tt * 64 + js] = sigmoidf_(a0 + aa[ct][q]); } }
    }
    lds_barrier();
    {
        const int j = tid & 63, seg = tid >> 6; float run = 0.f; float loc[8];
#pragma unroll
        for (int q = 0; q < 8; ++q) { run += FA[(8 * seg + q) * 64 + (j ^ (((q >> 2) & 1) << 4))]; loc[q] = run; }
        TOT[seg * 64 + j] = run;
        lds_barrier();
        float off = 0.f;
#pragma unroll
        for (int s2 = 0; s2 < 7; ++s2) off += (s2 < seg) ? TOT[s2 * 64 + j] : 0.f;
#pragma unroll
        for (int q = 0; q < 8; ++q) FA[(8 * seg + q) * 64 + (j ^ (((q >> 2) & 1) << 4))] = loc[q] + off;
    }
    lds_barrier();
    {
        float r[8], k[8], pkk[8], pka[8], prk[8];
        unpack8(f.r, r); unpack8(f.k, k); unpack8(f.v, v8);
        { const LAS float* P = (const LAS float*)(lds + CS_PAR) + cq * 8; const f32x4 a0_ = *(const LAS f32x4*)P, a1_ = *(const LAS f32x4*)(P + 4), b0_ = *(const LAS f32x4*)(P + 64), b1_ = *(const LAS f32x4*)(P + 68), c0_ = *(const LAS f32x4*)(P + 128), c1_ = *(const LAS f32x4*)(P + 132);
#pragma unroll
          for (int q = 0; q < 4; ++q) { pkk[q] = a0_[q]; pkk[4 + q] = a1_[q]; pka[q] = b0_[q]; pka[4 + q] = b1_[q]; prk[q] = c0_[q]; prk[4 + q] = c1_[q]; } }
        float cw[8], cwp[8], ag[8];
        { const int tp = t > 0 ? t - 1 : 0;
          const int ct_ = (cq ^ (((t >> 2) & 1) << 1)) * 8, cp_ = (cq ^ (((tp >> 2) & 1) << 1)) * 8;
          const f32x4 c0_ = *(const LAS f32x4*)(FA + t * 64 + ct_), c1_ = *(const LAS f32x4*)(FA + t * 64 + ct_ + 4), p0_ = *(const LAS f32x4*)(FA + tp * 64 + cp_), p1_ = *(const LAS f32x4*)(FA + tp * 64 + cp_ + 4);
          const f32x4 g0_ = *(const LAS f32x4*)(FB + t * 64 + ct_), g1_ = *(const LAS f32x4*)(FB + t * 64 + ct_ + 4);
#pragma unroll
          for (int q = 0; q < 4; ++q) { cw[q] = c0_[q]; cw[4 + q] = c1_[q]; cwp[q] = t > 0 ? p0_[q] : 0.f; cwp[4 + q] = t > 0 ? p1_[q] : 0.f; ag[q] = g0_[q]; ag[4 + q] = g1_[q]; } }
        float kk[8], ss = 0.f; rkb = 0.f;
#pragma unroll
        for (int q = 0; q < 8; ++q) { kk[q] = k[q] * pkk[q]; ss += kk[q] * kk[q]; }
        ss += shx(ss, 1, lane); ss += shx(ss, 2, lane); ss += shx(ss, 4, lane);
        const float inv = 1.0f / fmaxf(sqrtf(ss), 1e-12f);
        float at[8], bt[8], kt[8], rt_[8];
#pragma unroll
        for (int q = 0; q < 8; ++q) { const float kn = kk[q] * inv, kp = k[q] * (1.0f + (ag[q] - 1.0f) * pka[q]);
            const float ein = __expf(-cw[q]);
            at[q] = -kn * __expf(cwp[q]); bt[q] = kn * ag[q] * ein; kt[q] = kp * ein;
            if (MODE == 3) { rt_[q] = r[q] * __expf(cw[q]); rkb += r[q] * kp * prk[q]; } }
        if (MODE == 3) { rkb += shx(rkb, 1, lane); rkb += shx(rkb, 2, lane); rkb += shx(rkb, 4, lane); }
        *(LAS v4u*)(TILE(0) + t * TPB + cq * 16) = pack8f(at); *(LAS v4u*)(TILE(1) + t * TPB + cq * 16) = pack8f(bt); *(LAS v4u*)(TILE(2) + t * TPB + cq * 16) = pack8f(kt);
        *(LAS v4u*)(TILE(3) + t * TPB + cq * 16) = f.v;
        if (MODE == 3) *(LAS v4u*)(TILE(4) + t * TPB + cq * 16) = pack8f(rt_);
        if (MODE == 1 && t == 63) {
#pragma unroll
            for (int q = 0; q < 8; ++q) ((LAS float*)(lds + CS_WL))[cq * 8 + q] = __expf(cw[q]); }
    }
    lds_barrier();
}

__device__ __forceinline__ void scan_s1(unsigned char* ws, LAS unsigned char* lds, int lane0, int wave) {
    const int rt = wave & 3, ch = wave >> 2;
    FrontIn fin; float w0v[2], a0v[2];
    { int l0 = lane0; asm volatile("" : "+v"(l0)); const int hh = blockIdx.x & 15;
      if ((int)blockIdx.x < BATCH * NH * (SEQ / 64)) front_fetch(fin, ws, blockIdx.x, wave * 64 + l0, l0, wave);
#pragma unroll
      for (int ct = 0; ct < 2; ++ct) { w0v[ct] = INP(7)[hh * HD + 32 * ch + 16 * ct + (l0 & 15)]; a0v[ct] = INP(10)[hh * HD + 32 * ch + 16 * ct + (l0 & 15)]; }
      head_consts(ws, lds, hh, wave * 64 + l0, 6, 8); }
    for (int unit = blockIdx.x; unit < BATCH * NH * (SEQ / 64); unit += gridDim.x) {
        int lane = lane0; asm volatile("" : "+v"(lane));
        const int tid = wave * 64 + lane, fr = lane & 15, g = lane >> 4;
        const int h = unit & 15, c = (unit >> 4) & 127, b = unit >> 11; const size_t chunk = ((size_t)b * NH + h) * 128 + c;
        float v8[8]; float rkb;
        chunk_front<1>(fin, lds, w0v, a0v, tid, lane, wave, v8, rkb);
        if (unit + (int)gridDim.x < BATCH * NH * (SEQ / 64)) front_fetch(fin, ws, unit + gridDim.x, tid, lane, wave);
        {
            f32x4 a2[2] = {F4Z, F4Z}, a3[2] = {F4Z, F4Z};
            mm64(a2, TILE(1), TILE(0), rt, ch, fr, g);
            mm64(a3, TILE(2), TILE(0), rt, ch, fr, g);
            f32x4 p1[2];
#pragma unroll
            for (int ct = 0; ct < 2; ++ct) { const int col = 32 * ch + 16 * ct + fr;
#pragma unroll
                for (int q = 0; q < 4; ++q) { const int row = 16 * rt + 4 * g + q;
                    a2[ct][q] = row < col ? a2[ct][q] : 0.f;
                    p1[ct][q] = a2[ct][q] + (row == col ? 1.0f : 0.f);
                    a3[ct][q] = row < col ? a3[ct][q] : 0.f; } }
            st_tr(TILE(5), a2, rt, ch, fr, g);
            st_tr(TILE(9), p1, rt, ch, fr, g);
            st_tr(TILE(4), a3, rt, ch, fr, g);
        }
        lds_barrier();
#pragma unroll
        for (int r = 0; r < 6; ++r) {
            LAS unsigned char* Sr = TILE(5 + 2 * (r & 1)); LAS unsigned char* Sr2 = TILE(5 + 2 * ((r & 1) ^ 1));
            if (r <= 4) { f32x4 q2[2] = {F4Z, F4Z};
                mm64_at(q2, Sr, Sr, rt, ch, fr, g, lane);
                st_tr(Sr2, q2, rt, ch, fr, g); }
            if (r >= 1) { LAS unsigned char* Pr = TILE(9 + ((r - 1) & 1)); LAS unsigned char* Pr2 = TILE(9 + (((r - 1) & 1) ^ 1));
                f32x4 pa[2]; ld_tr(pa, Pr, rt, ch, fr, g);
                mm64_at(pa, Sr, Pr, rt, ch, fr, g, lane);
                st_tr(Pr2, pa, rt, ch, fr, g); }
            if (r == 0) { f32x4 gg[2] = {F4Z, F4Z};
                mm64_bt(gg, TILE(4), TILE(3), rt, ch, fr, g, lane);
                st_tr(TILE(11), gg, rt, ch, fr, g); }
            lds_barrier();
        }
        { const int trow = tid >> 3, tcq = tid & 7; *(GAS v4u*)((bf16*)(ws + WS_B4) + chunk * 4096 + trow * 64 + tcq * 8) = *(const LAS v4u*)(TILE(10) + trow * TPB + tcq * 16); }
        {
            f32x4 acc[2] = {F4Z, F4Z}, ac2[2] = {F4Z, F4Z};
            mm64_bt(acc, TILE(10), TILE(0), rt, ch, fr, g, lane);
            mm64(ac2, TILE(10), TILE(11), rt, ch, fr, g);
            st_tr(TILE(5), acc, rt, ch, fr, g); st_tr(TILE(7), ac2, rt, ch, fr, g);
        }
        lds_barrier();
        {
            const LAS float* WL = (const LAS float*)(lds + CS_WL);
            f32x4 acc[2] = {F4Z, F4Z};
            mm64_bt(acc, TILE(5), TILE(1), rt, ch, fr, g, lane);
            bf16* Mg = (bf16*)(ws + WS_B0) + chunk * 4096;
#pragma unroll
            for (int ct = 0; ct < 2; ++ct) { const int j1 = 32 * ch + 16 * ct + fr; const float wl = WL[j1];
#pragma unroll
                for (int q = 0; q < 4; ++q) { const int j2 = 16 * rt + 4 * g + q; acc[ct][q] = wl * (acc[ct][q] + (j2 == j1 ? 1.0f : 0.f)); }
                const int rtS = 2 * ch + ct, ksS = rt >> 1, half = rt & 1;
                *(GAS bf16x4s*)(Mg + (((rtS * 2 + ksS) * 64 + g * 16 + fr) * 8 + half * 4)) = pack4(acc[ct]); }
            f32x4 ad[2] = {F4Z, F4Z};
            mm64_at(ad, TILE(1), TILE(7), rt, ch, fr, g, lane);
            mm64_att(ad, TILE(2), TILE(3), rt, ch, lane);
            const f32x4 wl4 = *(const LAS f32x4*)(WL + 16 * rt + 4 * g);
            bf16* Dg = (bf16*)OUTP() + chunk * 4096;
#pragma unroll
            for (int ct = 0; ct < 2; ++ct) *(GAS bf16x4s*)(Dg + (((2 * ch + ct) * 4 + rt) * 64 + lane) * 4) = pack4(ad[ct] * wl4);
        }
        lds_barrier();
    }
}

constexpr int S2_PD = 6;
__device__ __forceinline__ void scan_s2(unsigned char* ws, LAS unsigned char* lds, int lane, int wave) {
    for (int bh = blockIdx.x; bh < BATCH * NH; bh += gridDim.x) {
        const unsigned char* Mg = (const unsigned char*)((const bf16*)(ws + WS_B0) + (size_t)bh * 128 * 4096); const unsigned char* Dg = (const unsigned char*)((const bf16*)OUTP() + (size_t)bh * 128 * 4096);
        bf16* Sg = (bf16*)OUTP() + (size_t)M * C + (size_t)bh * 128 * 4096;
        if (wave >= 4) {
            const int lw = wave - 4;
            const unsigned char* src = (lw < 2 ? Mg + lw * 4096 : Dg + (lw - 2) * 4096) + lane * 16;
            LAS unsigned char* dst = lds + lw * 4096 + lane * 16;
            v4u q[S2_PD][4];
#define S2_LOADQ(j, c) do { _Pragma("unroll") for (int i_ = 0; i_ < 4; ++i_) q[j][i_] = *(const GAS v4u*)(src + (size_t)(c) * 8192 + i_ * 1024); } while (0)
#define S2_STOREQ(j, slot) do { _Pragma("unroll") for (int i_ = 0; i_ < 4; ++i_) *(LAS v4u*)(dst + (slot) * 16384 + i_ * 1024) = q[j][i_]; } while (0)
#pragma unroll
            for (int j = 0; j < S2_PD; ++j) S2_LOADQ(j, j);
            S2_STOREQ(0, 0); S2_LOADQ(0, S2_PD);
            lds_barrier();
#pragma unroll 1
            for (int s0 = 0; s0 < 128; s0 += S2_PD) {
#pragma unroll
                for (int jj = 0; jj < S2_PD; ++jj) { const int step = s0 + jj;
                    if (step + 1 < 128) S2_STOREQ((jj + 1) % S2_PD, (step + 1) & 1);
                    if (step + 1 + S2_PD < 128) S2_LOADQ((jj + 1) % S2_PD, step + 1 + S2_PD);
                    lds_barrier(); }
            }
#undef S2_LOADQ
#undef S2_STOREQ
        } else {
            const int ct = wave;
            f32x4 acc[4];
#pragma unroll
            for (int r = 0; r < 4; ++r) acc[r] = F4Z;
            lds_barrier();
#pragma unroll 1
            for (int s0 = 0; s0 < 128; s0 += S2_PD) {
#pragma unroll
                for (int jj = 0; jj < S2_PD; ++jj) { const int step = s0 + jj;
                    if (step < 128) {
                        const LAS unsigned char* slot = lds + (step & 1) * 16384;
                        bf16x8s sf[2];
#pragma unroll
                        for (int ks = 0; ks < 2; ++ks) { const bf16x4s lo = pack4(acc[2 * ks]), hi = pack4(acc[2 * ks + 1]); sf[ks] = (bf16x8s){lo[0], lo[1], lo[2], lo[3], hi[0], hi[1], hi[2], hi[3]}; }
#pragma unroll
                        for (int ks = 0; ks < 2; ++ks) *(GAS bf16x8s*)(Sg + (size_t)step * 4096 + ((ct * 2 + ks) * 64 + lane) * 8) = sf[ks];
                        f32x4 na[4];
#pragma unroll
                        for (int r = 0; r < 4; ++r) na[r] = unpack4(*(const LAS bf16x4s*)(slot + 8192 + ((ct * 4 + r) * 64 + lane) * 8));
#pragma unroll
                        for (int ks = 0; ks < 2; ++ks)
#pragma unroll
                            for (int r = 0; r < 4; ++r) na[r] = MFMA16(*(const LAS bf16x8s*)(slot + ((r * 2 + ks) * 64 + lane) * 16), sf[ks], na[r]);
#pragma unroll
                        for (int r = 0; r < 4; ++r) acc[r] = na[r];
                    }
                    lds_barrier(); }
            }
        }
    }
}

__device__ __forceinline__ void scan_s3(unsigned char* ws, LAS unsigned char* lds, int lane0, int wave) {
    const int rt = wave & 3, ch = wave >> 2;
    LAS float* Ys = (LAS float*)(lds + CS_FA);
    const bf16* LG = (const bf16*)(ws + WS_LG); const bf16* G2T = (const bf16*)(ws + WS_WT_G2); bf16* YG = (bf16*)(ws + WS_B0);
    FrontIn fin; float w0v[2], a0v[2];
    { int l0 = lane0; asm volatile("" : "+v"(l0)); const int hh = blockIdx.x & 15;
      if ((int)blockIdx.x < BATCH * NH * (SEQ / 64)) front_fetch(fin, ws, blockIdx.x, wave * 64 + l0, l0, wave);
#pragma unroll
      for (int ct = 0; ct < 2; ++ct) { w0v[ct] = INP(7)[hh * HD + 32 * ch + 16 * ct + (l0 & 15)]; a0v[ct] = INP(10)[hh * HD + 32 * ch + 16 * ct + (l0 & 15)]; }
      head_consts(ws, lds, hh, wave * 64 + l0, 10, 11); }
    bf16x8s gA[5], gB[5][2];
    { int l0 = lane0; asm volatile("" : "+v"(l0)); const int hh = blockIdx.x & 15, fr0 = l0 & 15, g0 = l0 >> 4;
      const int u0 = blockIdx.x < BATCH * NH * (SEQ / 64) ? blockIdx.x : 0; const size_t row00 = (size_t)(u0 >> 11) * SEQ + ((u0 >> 4) & 127) * 64;
#pragma unroll
      for (int ks = 0; ks < 5; ++ks) { gA[ks] = *(const GAS bf16x8s*)(G2T + (size_t)(hh * HD + 16 * rt + fr0) * DG + 32 * ks + 8 * g0);
#pragma unroll
          for (int ct = 0; ct < 2; ++ct) gB[ks][ct] = *(const GAS bf16x8s*)(LG + (row00 + 32 * ch + 16 * ct + fr0) * DG + 32 * ks + 8 * g0); } }
    for (int unit = blockIdx.x; unit < BATCH * NH * (SEQ / 64); unit += gridDim.x) {
        int lane = lane0; asm volatile("" : "+v"(lane));
        const int tid = wave * 64 + lane, fr = lane & 15, g = lane >> 4;
        const int h = unit & 15, c = (unit >> 4) & 127, b = unit >> 11; const size_t chunk = ((size_t)b * NH + h) * 128 + c; const size_t row0 = (size_t)b * SEQ + c * 64;
        const bf16* Sg = (const bf16*)OUTP() + (size_t)M * C + chunk * 4096; const bf16* Tg = (const bf16*)(ws + WS_B4) + chunk * 4096;
        bf16x8s sB[2][2], sA[2], tA[2];
#pragma unroll
        for (int ks = 0; ks < 2; ++ks) { sA[ks] = *(const GAS bf16x8s*)(Sg + ((rt * 2 + ks) * 64 + lane) * 8); tA[ks] = *(const GAS bf16x8s*)(Tg + (16 * rt + fr) * 64 + 32 * ks + 8 * g);
#pragma unroll
            for (int ct = 0; ct < 2; ++ct) sB[ks][ct] = *(const GAS bf16x8s*)(Sg + (((2 * ch + ct) * 2 + ks) * 64 + lane) * 8); }
        const int et = tid >> 3, ecq = tid & 7, ec0 = h * HD + ecq * 8;
        const f32x4 lnw0 = *(const GAS f32x4*)(INP(18) + ec0), lnw1 = *(const GAS f32x4*)(INP(18) + ec0 + 4), lnb0 = *(const GAS f32x4*)(INP(19) + ec0), lnb1 = *(const GAS f32x4*)(INP(19) + ec0 + 4);
        float v8[8]; float rkb;
        chunk_front<3>(fin, lds, w0v, a0v, tid, lane, wave, v8, rkb);
        f32x4 ag[2] = {F4Z, F4Z};
#pragma unroll
        for (int ks = 0; ks < 5; ++ks)
#pragma unroll
            for (int ct = 0; ct < 2; ++ct) ag[ct] = MFMA16(gA[ks], gB[ks][ct], ag[ct]);
        if (unit + (int)gridDim.x < BATCH * NH * (SEQ / 64)) { const int un = unit + gridDim.x; const size_t rown = (size_t)(un >> 11) * SEQ + ((un >> 4) & 127) * 64;
#pragma unroll
            for (int ks = 0; ks < 5; ++ks)
#pragma unroll
                for (int ct = 0; ct < 2; ++ct) gB[ks][ct] = *(const GAS bf16x8s*)(LG + (rown + 32 * ch + 16 * ct + fr) * DG + 32 * ks + 8 * g); }
        if (unit + (int)gridDim.x < BATCH * NH * (SEQ / 64)) front_fetch(fin, ws, unit + gridDim.x, tid, lane, wave);
        {
            f32x4 a1[2] = {F4Z, F4Z}, a2[2] = {F4Z, F4Z}, a3[2] = {F4Z, F4Z};
            mm64(a1, TILE(2), TILE(0), rt, ch, fr, g);
            mm64(a2, TILE(1), TILE(4), rt, ch, fr, g);
            mm64(a3, TILE(2), TILE(4), rt, ch, fr, g);
#pragma unroll
            for (int ct = 0; ct < 2; ++ct) { const int t = 32 * ch + 16 * ct + fr;
#pragma unroll
                for (int q = 0; q < 4; ++q) { const int s = 16 * rt + 4 * g + q; a1[ct][q] = s < t ? a1[ct][q] : 0.f; a2[ct][q] = s <= t ? a2[ct][q] : 0.f; a3[ct][q] = s <= t ? a3[ct][q] : 0.f; } }
            st_tr(TILE(5), a1, rt, ch, fr, g); st_tr(TILE(6), a2, rt, ch, fr, g); st_tr(TILE(7), a3, rt, ch, fr, g);
        }
        lds_barrier();
        {
            f32x4 acc[2] = {F4Z, F4Z};
#pragma unroll
            for (int ks = 0; ks < 2; ++ks) { const bf16x8s a = ldfrag_perm(TILE(0), 16 * rt + fr, ks, g);
#pragma unroll
                for (int ct = 0; ct < 2; ++ct) acc[ct] = MFMA16(a, sB[ks][ct], acc[ct]); }
            mm64_bt(acc, TILE(5), TILE(3), rt, ch, fr, g, lane);
            st_tr(TILE(8), acc, rt, ch, fr, g);
        }
        lds_barrier();
        {
            f32x4 acc[2] = {F4Z, F4Z};
#pragma unroll
            for (int ks = 0; ks < 2; ++ks)
#pragma unroll
                for (int ct = 0; ct < 2; ++ct) acc[ct] = MFMA16(tA[ks], ldfrag(TILE(8), 32 * ch + 16 * ct + fr, 32 * ks + 8 * g), acc[ct]);
            st_tr(TILE(9), acc, rt, ch, fr, g);
        }
        lds_barrier();
        {
            f32x4 acc[2] = {F4Z, F4Z};
#pragma unroll
            for (int ks = 0; ks < 2; ++ks)
#pragma unroll
                for (int ct = 0; ct < 2; ++ct) acc[ct] = MFMA16(sA[ks], ldfrag_perm(TILE(4), 32 * ch + 16 * ct + fr, ks, g), acc[ct]);
            mm64(acc, TILE(9), TILE(6), rt, ch, fr, g); mm64_at(acc, TILE(3), TILE(7), rt, ch, fr, g, lane);
#pragma unroll
            for (int ct = 0; ct < 2; ++ct) { const int t = 32 * ch + 16 * ct + fr; *(LAS f32x4*)(Ys + t * FP + 16 * rt + 4 * g) = acc[ct]; }
        }
        lds_barrier();
        {
            const f32x4 y0 = *(const LAS f32x4*)(Ys + et * FP + ecq * 8), y1 = *(const LAS f32x4*)(Ys + et * FP + ecq * 8 + 4);
            float y[8] = {y0[0], y0[1], y0[2], y0[3], y1[0], y1[1], y1[2], y1[3]};
            float s = 0.f;
#pragma unroll
            for (int q = 0; q < 8; ++q) s += y[q];
            s += shx(s, 1, lane); s += shx(s, 2, lane); s += shx(s, 4, lane);
            const float mu = s * (1.0f / HD); float vs = 0.f;
#pragma unroll
            for (int q = 0; q < 8; ++q) { y[q] -= mu; vs += y[q] * y[q]; }
            vs += shx(vs, 1, lane); vs += shx(vs, 2, lane); vs += shx(vs, 4, lane);
            const float rstd = 1.0f / sqrtf(vs * (1.0f / HD) + GN_EPS);
            f32x4 o0, o1;
#pragma unroll
            for (int q = 0; q < 4; ++q) { o0[q] = y[q] * rstd * lnw0[q] + lnb0[q] + rkb * v8[q]; o1[q] = y[4 + q] * rstd * lnw1[q] + lnb1[q] + rkb * v8[4 + q]; }
            *(LAS f32x4*)(Ys + et * FP + ecq * 8) = o0; *(LAS f32x4*)(Ys + et * FP + ecq * 8 + 4) = o1;
        }
        lds_barrier();
        {
#pragma unroll
            for (int ct = 0; ct < 2; ++ct) { const int t = 32 * ch + 16 * ct + fr; const f32x4 yv = *(const LAS f32x4*)(Ys + t * FP + 16 * rt + 4 * g);
                *(GAS bf16x4s*)(YG + (row0 + t) * C + h * HD + 16 * rt + 4 * g) = pack4(yv * ag[ct]); }
        }
        lds_barrier();
    }
}
#undef TILE
#if MK_DEBUG
__device__ __forceinline__ void scan_naive(unsigned char* ws, LAS unsigned char* lds, int tid) {
    const int lane = tid & 63;
    const bf16* Rb = (const bf16*)(ws + WS_B1); const bf16* Kb = (const bf16*)(ws + WS_B2); const bf16* Vb = (const bf16*)(ws + WS_B3);
    const bf16* LW = (const bf16*)(ws + WS_LW); const bf16* LA = (const bf16*)(ws + WS_LA);
    float* Y = OUTP(); float* RK = (float*)(ws + WS_HID);
    LAS float* sR = (LAS float*)lds; LAS float* sK = sR + 4096; LAS float* sV = sK + 4096; LAS float* sA = sV + 4096; LAS float* sB = sA + 4096; LAS float* sD = sB + 4096;
    LAS float* sW2 = sD + 4096; LAS float* sA2 = sW2 + 4096;
    for (int unit = blockIdx.x; unit < BATCH * NH; unit += gridDim.x) {
        const int b = unit / NH, h = unit % NH;
        __syncthreads();
        for (int e = tid; e < 4096; e += 512) { const int d = e >> 6, j = e & 63; sW2[e] = INP(9)[(size_t)d * C + h * HD + j]; sA2[e] = INP(12)[(size_t)d * C + h * HD + j]; }
        __syncthreads();
        const int pt = tid >> 3, cq = tid & 7, c0 = h * HD + cq * 8;
        const int si = tid >> 3, jq = tid & 7;
        float S[8];
#pragma unroll
        for (int q = 0; q < 8; ++q) S[q] = 0.f;
        float w0v[8], a0v[8], kkv[8], kav[8], rkv[8];
#pragma unroll
        for (int q = 0; q < 8; ++q) { w0v[q] = INP(7)[c0 + q]; a0v[q] = INP(10)[c0 + q]; kkv[q] = INP(15)[c0 + q]; kav[q] = INP(16)[c0 + q]; rkv[q] = INP(17)[c0 + q]; }
        for (int blk = 0; blk < SEQ / 64; ++blk) {
            const size_t row = (size_t)b * SEQ + blk * 64 + pt;
            {
                const v4u r4 = *(const GAS v4u*)(Rb + row * C + c0), k4 = *(const GAS v4u*)(Kb + row * C + c0), v4 = *(const GAS v4u*)(Vb + row * C + c0);
                float r[8], k[8], v[8];
                r[0] = bflo(r4.x); r[1] = bfhi(r4.x); r[2] = bflo(r4.y); r[3] = bfhi(r4.y); r[4] = bflo(r4.z); r[5] = bfhi(r4.z); r[6] = bflo(r4.w); r[7] = bfhi(r4.w);
                k[0] = bflo(k4.x); k[1] = bfhi(k4.x); k[2] = bflo(k4.y); k[3] = bfhi(k4.y); k[4] = bflo(k4.z); k[5] = bfhi(k4.z); k[6] = bflo(k4.w); k[7] = bfhi(k4.w);
                v[0] = bflo(v4.x); v[1] = bfhi(v4.x); v[2] = bflo(v4.y); v[3] = bfhi(v4.y); v[4] = bflo(v4.z); v[5] = bfhi(v4.z); v[6] = bflo(v4.w); v[7] = bfhi(v4.w);
                float wp[8], ap[8];
#pragma unroll
                for (int q = 0; q < 8; ++q) { wp[q] = w0v[q]; ap[q] = a0v[q]; }
                for (int d = 0; d < 64; ++d) { const float lw = bf2f(LW[row * DW + d]), la = bf2f(LA[row * DA + d]);
#pragma unroll
                    for (int q = 0; q < 8; ++q) { wp[q] += lw * sW2[d * 64 + cq * 8 + q]; ap[q] += la * sA2[d * 64 + cq * 8 + q]; } }
                float kk[8], ss = 0.f, rks = 0.f;
#pragma unroll
                for (int q = 0; q < 8; ++q) { kk[q] = k[q] * kkv[q]; ss += kk[q] * kk[q]; }
                ss += shx(ss, 1, lane); ss += shx(ss, 2, lane); ss += shx(ss, 4, lane);
                const float inv = 1.0f / fmaxf(sqrtf(ss), 1e-12f);
#pragma unroll
                for (int q = 0; q < 8; ++q) { const float ag = sigmoidf_(ap[q]); const float kn = kk[q] * inv; const float kp = k[q] * (1.0f + (ag - 1.0f) * kav[q]);
                    const float lw = -0.6065306597126334f * sigmoidf_(wp[q]);
                    const int o = pt * 64 + cq * 8 + q;
                    sR[o] = r[q]; sK[o] = kp; sV[o] = v[q]; sA[o] = -kn; sB[o] = kn * ag; sD[o] = __expf(lw); rks += r[q] * kp * rkv[q]; }
                rks += shx(rks, 1, lane); rks += shx(rks, 2, lane); rks += shx(rks, 4, lane);
                if (cq == 0) RK[row * NH + h] = rks;
            }
            __syncthreads();
            for (int t = 0; t < 64; ++t) {
                const LAS f32x4* pa = (const LAS f32x4*)(sA + t * 64 + jq * 8); const LAS f32x4* pb = (const LAS f32x4*)(sB + t * 64 + jq * 8);
                const LAS f32x4* pd = (const LAS f32x4*)(sD + t * 64 + jq * 8); const LAS f32x4* pk = (const LAS f32x4*)(sK + t * 64 + jq * 8);
                const LAS f32x4* pr = (const LAS f32x4*)(sR + t * 64 + jq * 8);
                const f32x4 a0 = pa[0], a1 = pa[1], b0 = pb[0], b1 = pb[1], d0 = pd[0], d1 = pd[1], k0 = pk[0], k1 = pk[1], r0 = pr[0], r1 = pr[1];
                const float vi = sV[t * 64 + si];
                float sa = 0.f;
#pragma unroll
                for (int q = 0; q < 4; ++q) { sa += S[q] * a0[q]; sa += S[4 + q] * a1[q]; }
                sa += shx(sa, 1, lane); sa += shx(sa, 2, lane); sa += shx(sa, 4, lane);
                float y = 0.f;
#pragma unroll
                for (int q = 0; q < 4; ++q) { S[q] = S[q] * d0[q] + sa * b0[q] + vi * k0[q]; S[4 + q] = S[4 + q] * d1[q] + sa * b1[q] + vi * k1[q]; y += S[q] * r0[q]; y += S[4 + q] * r1[q]; }
                y += shx(y, 1, lane); y += shx(y, 2, lane); y += shx(y, 4, lane);
                if (jq == 0) Y[((size_t)b * SEQ + blk * 64 + t) * C + h * HD + si] = y;
            }
            __syncthreads();
        }
    }
}
__device__ __forceinline__ void post_scan(unsigned char* ws, int gw, int NGW, int lane) {
    const float* Y = OUTP(); const float* RK = (const float*)(ws + WS_HID); const bf16* Vb = (const bf16*)(ws + WS_B3); const bf16* LG = (const bf16*)(ws + WS_LG);
    bf16* YG = (bf16*)(ws + WS_B4); const float* g2 = INP(14); const float* lnw = INP(18); const float* lnb = INP(19);
    for (int it = gw; it < M * NH; it += NGW) {
        const int row = it / NH, h = it % NH, c = h * HD + lane;
        const float y = Y[(size_t)row * C + c];
        const float mu = wave_sum(y, lane) * (1.0f / HD); const float d = y - mu; const float var = wave_sum(d * d, lane) * (1.0f / HD);
        float o = d * (1.0f / sqrtf(var + GN_EPS)) * lnw[c] + lnb[c];
        o += RK[(size_t)row * NH + h] * bf2f(Vb[(size_t)row * C + c]);
        float g = 0.f;
        for (int dd = 0; dd < DG; ++dd) g += bf2f(LG[(size_t)row * DG + dd]) * g2[(size_t)dd * C + c];
        YG[(size_t)row * C + c] = (bf16)f2bf(o * g);
    }
}


constexpr int CW_DBG = 3200;
__device__ __forceinline__ void dbg_nonfinite(unsigned char* ws, const bf16* X, size_t n, int slot, int gw, int NGW, int lane, float thr = 1e30f) {
    unsigned* cw = (unsigned*)(ws + WS_CTL) + CW_DBG + 64 * slot; unsigned nnan = 0;
    for (size_t i = (size_t)gw * 64 + lane; i < n; i += (size_t)NGW * 64) { const float x = bf2f(X[i]); if (!(fabsf(x) < thr)) ++nnan; }
    if (nnan) atomicAdd(cw, nnan);
}
__device__ __forceinline__ void dbg_compare(unsigned char* ws, const bf16* X, const bf16* Y, int gw, int NGW, int lane) {
    unsigned* cw = (unsigned*)(ws + WS_CTL) + CW_DBG; unsigned nbad = 0, nnan = 0;
    for (size_t i = (size_t)gw * 64 + lane; i < (size_t)M * C; i += (size_t)NGW * 64) { const float x = bf2f(X[i]), y = bf2f(Y[i]);
        if (!(fabsf(x) < 1e30f)) ++nnan; else if (fabsf(x - y) > 0.05f * (fabsf(y) + 0.05f)) ++nbad; }
    if (nnan) atomicAdd(cw, nnan); if (nbad) atomicAdd(cw + 64, nbad);
}
#endif
__device__ __forceinline__ void router_rows(unsigned char* ws, LAS unsigned char* lds, int layer, int gw, int NGW, int lane, int tid, bool dry = false) {
    const float* Hh = OUTP(); const float* gain = INP(2) + layer * C; bf16* XN = (bf16*)(ws + WS_B1);
    const float* wg = INP(24) + (size_t)layer * C * 4; const float* bg = INP(25) + layer * 4; const float* wi = INP(26) + (size_t)layer * C * 16; const float* bi = INP(27) + layer * 16;
    unsigned* cnt = (unsigned*)(ws + WS_CTL) + CW_CNT + layer * 16 * 64; unsigned* list = (unsigned*)(ws + WS_LIST); float* wl = (float*)(ws + WS_WL);
    LAS float* sWg = (LAS float*)lds; LAS float* sWi = sWg + C * 4;
    constexpr int RECMAX = 256;
    LAS unsigned* lcnt = (LAS unsigned*)(lds + 81920); LAS unsigned* gbase = lcnt + 16; LAS int* nrec = (LAS int*)(lcnt + 32);
    LAS unsigned* recRow = lcnt + 64; LAS unsigned* recE = recRow + RECMAX; LAS unsigned* recL = recE + RECMAX; LAS float* recW0 = (LAS float*)(recL + RECMAX); LAS float* recW1 = recW0 + RECMAX;
    __syncthreads();
    for (int e = tid; e < C * 4; e += 512) sWg[e] = wg[e];
    for (int e = tid; e < C * 16; e += 512) sWi[e] = wi[e];
    if (tid < 33) lcnt[tid == 32 ? 32 : tid] = 0u;
    __syncthreads();
    f32x4 g[4]; load_row(gain, lane, g);
    for (int row = gw; row < M; row += NGW) {
        f32x4 v[4]; load_row(Hh + (size_t)row * C, lane, v); const float rs = row_rs(v, lane);
#pragma unroll
        for (int j = 0; j < 4; ++j) v[j] = v[j] * rs * g[j];
        store_row_bf16(XN + (size_t)row * C, lane, v);
        float gl[4] = {0.f, 0.f, 0.f, 0.f};
        const LAS unsigned char* pWg = (const LAS unsigned char*)sWg + lane * 64;
#pragma unroll
        for (int j = 0; j < 4; ++j)
#pragma unroll
            for (int q = 0; q < 4; ++q) { const f32x4 w = *(const LAS f32x4*)(pWg + j * 4096 + q * 16); const float xv = v[j][q]; gl[0] += xv * w.x; gl[1] += xv * w.y; gl[2] += xv * w.z; gl[3] += xv * w.w; }
#pragma unroll
        for (int q = 0; q < 4; ++q) gl[q] = wave_sum(gl[q], lane) + bg[q];
        int gi = 0; float gm = gl[0];
#pragma unroll
        for (int q = 1; q < 4; ++q) if (gl[q] > gm) { gm = gl[q]; gi = q; }
        float gden = 0.f;
#pragma unroll
        for (int q = 0; q < 4; ++q) gden += __expf(gl[q] - gm);
        const float gval = 1.0f / gden;
        float il[4] = {0.f, 0.f, 0.f, 0.f};
        const LAS unsigned char* pWi = (const LAS unsigned char*)sWi + lane * 256 + gi * 16;
#pragma unroll
        for (int j = 0; j < 4; ++j)
#pragma unroll
            for (int q = 0; q < 4; ++q) { const f32x4 w = *(const LAS f32x4*)(pWi + j * 16384 + q * 64); const float xv = v[j][q]; il[0] += xv * w.x; il[1] += xv * w.y; il[2] += xv * w.z; il[3] += xv * w.w; }
#pragma unroll
        for (int q = 0; q < 4; ++q) il[q] = wave_sum(il[q], lane) + bi[gi * 4 + q];
        int i0 = 0; float m0 = il[0];
#pragma unroll
        for (int q = 1; q < 4; ++q) if (il[q] > m0) { m0 = il[q]; i0 = q; }
        int i1 = -1; float m1 = -INFINITY;
#pragma unroll
        for (int q = 0; q < 4; ++q) if (q != i0 && il[q] > m1) { m1 = il[q]; i1 = q; }
        const float e1 = __expf(m1 - m0); const float w0 = gval / (1.0f + e1), w1 = gval * e1 / (1.0f + e1);
        if (lane == 0 && !dry) {
            const int ex0 = gi * 4 + i0, ex1 = gi * 4 + i1;
            const int ri = __hip_atomic_fetch_add(nrec, 1, __ATOMIC_RELAXED, __HIP_MEMORY_SCOPE_WORKGROUP);
            const unsigned l0 = __hip_atomic_fetch_add(lcnt + ex0, 1u, __ATOMIC_RELAXED, __HIP_MEMORY_SCOPE_WORKGROUP), l1 = __hip_atomic_fetch_add(lcnt + ex1, 1u, __ATOMIC_RELAXED, __HIP_MEMORY_SCOPE_WORKGROUP);
            if (ri < RECMAX) { recRow[ri] = (unsigned)row; recE[ri] = (unsigned)ex0 | ((unsigned)ex1 << 8); recL[ri] = l0 | (l1 << 16); recW0[ri] = w0; recW1[ri] = w1; }
        }
    }
    __syncthreads();
    if (tid < 16 && !dry) gbase[tid] = atomicAdd(cnt + tid * 64, lcnt[tid]);
    __syncthreads();
    { const int n = *nrec < RECMAX ? *nrec : RECMAX;
      for (int i = tid; i < n; i += 512) { const unsigned row = recRow[i], e = recE[i], l = recL[i]; const unsigned ex0 = e & 255u, ex1 = e >> 8;
          const unsigned p0 = gbase[ex0] + (l & 0xffffu), p1 = gbase[ex1] + (l >> 16);
          list[(size_t)ex0 * M + p0] = row * 2u; wl[(size_t)ex0 * M + p0] = recW0[i]; list[(size_t)ex1 * M + p1] = row * 2u + 1u; wl[(size_t)ex1 * M + p1] = recW1[i]; } }
}
__device__ __forceinline__ void moe_table(unsigned char* ws, volatile LAS int* tab, int layer, int tid) {
    __syncthreads();
    if (tid == 0) { const unsigned* cnt = (const unsigned*)(ws + WS_CTL) + CW_CNT + layer * 16 * 64; int t = 0;
#pragma unroll 1
        for (int e = 0; e < 16; ++e) { const int c = (int)__hip_atomic_load(cnt, RLX_AGENT); cnt += 64; tab[e] = c; tab[16 + e] = t; t += (c + 255) >> 8; tab[32 + e] = t; }
        tab[48] = t; }
    __syncthreads();
}
__device__ __forceinline__ void combine_rows(unsigned char* ws, int mode, int gw, int NGW, int lane, bool dry = false) {
    float* Hh = OUTP(); const bf16* E0 = (const bf16*)(ws + WS_B2); const bf16* E1 = (const bf16*)(ws + WS_B3); bf16* XN2 = (bf16*)(ws + WS_B0);
    f32x4 g[4]; load_row(INP(4), lane, g);
    for (int row = gw; row < M; row += NGW) {
        f32x4 v[4]; load_row(Hh + (size_t)row * C, lane, v);
#pragma unroll
        for (int j = 0; j < 4; ++j) { const v2u e0 = ((const GAS v2u*)(E0 + (size_t)row * C))[64 * j + lane], e1 = ((const GAS v2u*)(E1 + (size_t)row * C))[64 * j + lane];
            v[j].x += bflo(e0.x) + bflo(e1.x); v[j].y += bfhi(e0.x) + bfhi(e1.x); v[j].z += bflo(e0.y) + bflo(e1.y); v[j].w += bfhi(e0.y) + bfhi(e1.y); }
        const float rs = row_rs(v, lane);
        if (mode == 0) {
#pragma unroll
            for (int j = 0; j < 4; ++j) if (!dry) ((GAS f32x4*)(Hh + (size_t)row * C))[64 * j + lane] = v[j];
#pragma unroll
            for (int j = 0; j < 4; ++j) v[j] = v[j] * rs;
            store_row_bf16(XN2 + (size_t)row * C, lane, v);
        } else {
            float sig = 1.0f;
#if MK_DEBUG
            const unsigned* cw = (const unsigned*)(ws + WS_CTL) + CW_DBG; const unsigned nnan = __hip_atomic_load(cw, RLX_AGENT), nbad = __hip_atomic_load(cw + 64, RLX_AGENT);
            if (row < 512 && nnan > 0) sig = 2.0f;
            if (row >= 512 && row < 1536 && __hip_atomic_load(cw + 128, RLX_AGENT) > 0) sig = 2.0f;
            if (row >= 1536 && row < 3584 && __hip_atomic_load(cw + 192, RLX_AGENT) > 0) sig = 2.0f;
            if (row >= 3584 && row < 7680 && __hip_atomic_load(cw + 256, RLX_AGENT) > 0) sig = 2.0f;
            if (row >= 7680 && row < 15872 && __hip_atomic_load(cw + 320, RLX_AGENT) > 0) sig = 2.0f;
            if (row >= 15872 && nbad > (unsigned)(M / 100) * C) sig = 1.5f;
#endif
#pragma unroll
            for (int j = 0; j < 4; ++j) ((GAS f32x4*)(Hh + (size_t)row * C))[64 * j + lane] = v[j] * rs * g[j] * sig;
        }
    }
}
__device__ __forceinline__ void attn_naive(unsigned char* ws, int gw, int NGW, int lane) {
    const bf16* Kb = (const bf16*)(ws + WS_B1); const bf16* Vb = (const bf16*)(ws + WS_B2); const bf16* Qb = (const bf16*)(ws + WS_B3); bf16* Ob = (bf16*)(ws + WS_B0);
    for (int unit = gw; unit < BATCH * NH * (SEQ / 64); unit += NGW) {
        const int qb = unit % (SEQ / 64), bh = unit / (SEQ / 64), b = bh / NH, h = bh % NH;
        const int t0 = qb * 64, t = t0 + lane; const size_t rowq = (size_t)b * SEQ + t;
        float q[64], o[64];
#pragma unroll
        for (int c = 0; c < 8; ++c) { const v4u w = *(const GAS v4u*)(Qb + rowq * C + h * HD + c * 8);
            q[c * 8 + 0] = bflo(w.x) * 0.125f; q[c * 8 + 1] = bfhi(w.x) * 0.125f; q[c * 8 + 2] = bflo(w.y) * 0.125f; q[c * 8 + 3] = bfhi(w.y) * 0.125f;
            q[c * 8 + 4] = bflo(w.z) * 0.125f; q[c * 8 + 5] = bfhi(w.z) * 0.125f; q[c * 8 + 6] = bflo(w.w) * 0.125f; q[c * 8 + 7] = bfhi(w.w) * 0.125f; }
#pragma unroll
        for (int c = 0; c < 64; ++c) o[c] = 0.f;
        float suffix = 0.f;
        for (int s = t0 + 62; s >= 0; --s) {
            const bool valid = s < t;
            if (s < t0 && __all(suffix > SB_EXIT)) break;
            const bf16* kp = Kb + ((size_t)b * SEQ + s) * C + h * HD; const bf16* vp = Vb + ((size_t)b * SEQ + s) * C + h * HD;
            float z = 0.f;
#pragma unroll
            for (int c = 0; c < 8; ++c) { const v4u w = *(const GAS v4u*)(kp + c * 8);
                z += q[c * 8 + 0] * bflo(w.x) + q[c * 8 + 1] * bfhi(w.x) + q[c * 8 + 2] * bflo(w.y) + q[c * 8 + 3] * bfhi(w.y) + q[c * 8 + 4] * bflo(w.z) + q[c * 8 + 5] * bfhi(w.z) + q[c * 8 + 6] * bflo(w.w) + q[c * 8 + 7] * bfhi(w.w); }
            const float sp = fmaxf(z, 0.f) + log1pf(__expf(-fabsf(z)));
            const float att = valid ? __expf(z - sp - suffix) : 0.f;
            suffix += valid ? sp : 0.f;
#pragma unroll
            for (int c = 0; c < 8; ++c) { const v4u w = *(const GAS v4u*)(vp + c * 8);
                o[c * 8 + 0] += att * bflo(w.x); o[c * 8 + 1] += att * bfhi(w.x); o[c * 8 + 2] += att * bflo(w.y); o[c * 8 + 3] += att * bfhi(w.y);
                o[c * 8 + 4] += att * bflo(w.z); o[c * 8 + 5] += att * bfhi(w.z); o[c * 8 + 6] += att * bflo(w.w); o[c * 8 + 7] += att * bfhi(w.w); }
        }
#pragma unroll
        for (int c = 0; c < 8; ++c) { v4u w; w.x = pk2(o[c * 8 + 0], o[c * 8 + 1]); w.y = pk2(o[c * 8 + 2], o[c * 8 + 3]); w.z = pk2(o[c * 8 + 4], o[c * 8 + 5]); w.w = pk2(o[c * 8 + 6], o[c * 8 + 7]);
            *(GAS v4u*)(Ob + rowq * C + h * HD + c * 8) = w; }
    }
}


typedef float f32x16 __attribute__((ext_vector_type(16)));
constexpr int AT_VP = 192;
constexpr int AT_WAVE_LDS = 32 * AT_VP;
__device__ __forceinline__ int crow32(int reg, int hh) { return (reg & 3) + 8 * (reg >> 2) + 4 * hh; }
__device__ __forceinline__ bf16x8s pack_step(const f32x16& x, const int s) {
    v4u p; p.x = pg8::cvt_pk_bf16(x[8 * s], x[8 * s + 1]); p.y = pg8::cvt_pk_bf16(x[8 * s + 2], x[8 * s + 3]); p.z = pg8::cvt_pk_bf16(x[8 * s + 4], x[8 * s + 5]); p.w = pg8::cvt_pk_bf16(x[8 * s + 6], x[8 * s + 7]);
    return __builtin_bit_cast(bf16x8s, p);
}
__device__ __forceinline__ void attn_mfma(unsigned char* ws, LAS unsigned char* lds, int gw, int NGW, int lane, int wave) {
    const bf16* Kb = (const bf16*)(ws + WS_B1); const bf16* Vb = (const bf16*)(ws + WS_B2); const bf16* Qb = (const bf16*)(ws + WS_B3); bf16* Ob = (bf16*)(ws + WS_B0);
    LAS unsigned char* vl = lds + wave * AT_WAVE_LDS;
    const int r32 = lane & 31, hh = lane >> 5;
    bf16x8s tri[2];
#pragma unroll
    for (int s = 0; s < 2; ++s)
#pragma unroll
        for (int j = 0; j < 8; ++j) tri[s][j] = (16 * s + 8 * (j >> 2) + 4 * hh + (j & 3)) > r32 ? (short)0x3F80 : (short)0;
    const int grp = lane >> 4, tq = (lane & 15) >> 2, tp = lane & 3;
    const LAS unsigned char* vtr0 = vl + (4 * hh + tq) * AT_VP + (16 * (grp & 1) + 4 * tp) * 2;
    for (int unit = gw; unit < BATCH * NH * (SEQ / 32); unit += NGW) {
        const int qb = unit % (SEQ / 32), bh = unit / (SEQ / 32), b = bh / NH, hd = bh % NH;
        const int t0 = qb * 32; const size_t rowb = (size_t)b * SEQ;
        bf16x8s qf[4];
#pragma unroll
        for (int ks = 0; ks < 4; ++ks) qf[ks] = *(const GAS bf16x8s*)(Qb + (rowb + t0 + r32) * C + hd * HD + 16 * ks + 8 * hh);
        f32x16 o[2];
#pragma unroll
        for (int i = 0; i < 16; ++i) { o[0][i] = 0.f; o[1][i] = 0.f; }
        float carry = 0.f;
        for (int s0 = t0; s0 >= 0; s0 -= 32) {
            bf16x8s kf[4];
#pragma unroll
            for (int ks = 0; ks < 4; ++ks) kf[ks] = *(const GAS bf16x8s*)(Kb + (rowb + s0 + r32) * C + hd * HD + 16 * ks + 8 * hh);
            v4u vreg[4];
#pragma unroll
            for (int i = 0; i < 4; ++i) { const int cidx = lane + 64 * i; vreg[i] = *(const GAS v4u*)(Vb + (rowb + s0 + (cidx >> 3)) * C + hd * HD + (cidx & 7) * 8); }
            f32x16 st;
#pragma unroll
            for (int i = 0; i < 16; ++i) st[i] = 0.f;
#pragma unroll
            for (int ks = 0; ks < 4; ++ks) st = __builtin_amdgcn_mfma_f32_32x32x16_bf16(kf[ks], qf[ks], st, 0, 0, 0);
#pragma unroll
            for (int i = 0; i < 4; ++i) { const int cidx = lane + 64 * i; *(LAS v4u*)(vl + (cidx >> 3) * AT_VP + (cidx & 7) * 16) = vreg[i]; }
            f32x16 zz, uu; float tot = 0.f; const int tq_ = t0 + r32;
            if (s0 + 31 < t0) {
#pragma unroll
                for (int i = 0; i < 16; ++i) { const float z = st[i] * 0.18033688011112042f; const float sp = fmaxf(z, 0.f) + __builtin_amdgcn_logf(1.0f + __builtin_amdgcn_exp2f(-fabsf(z)));
                    zz[i] = z - sp; uu[i] = sp; tot += sp; }
            } else {
#pragma unroll
                for (int i = 0; i < 16; ++i) { const int key = s0 + crow32(i, hh); const float z = st[i] * 0.18033688011112042f; const float sp = fmaxf(z, 0.f) + __builtin_amdgcn_logf(1.0f + __builtin_amdgcn_exp2f(-fabsf(z)));
                    const bool valid = key < tq_; zz[i] = valid ? z - sp : -1e30f; uu[i] = valid ? sp : 0.f; tot += uu[i]; }
            }
            f32x16 w;
#pragma unroll
            for (int i = 0; i < 16; ++i) w[i] = 0.f;
#pragma unroll
            for (int s = 0; s < 2; ++s) w = __builtin_amdgcn_mfma_f32_32x32x16_bf16(tri[s], pack_step(uu, s), w, 0, 0, 0);
            f32x16 pp;
#pragma unroll
            for (int i = 0; i < 16; ++i) pp[i] = __builtin_amdgcn_exp2f(zz[i] - w[i] - carry);
            tot += shx(tot, 32, lane); carry += tot;
            asm volatile("s_waitcnt lgkmcnt(0)" ::: "memory");
#pragma unroll
            for (int s = 0; s < 2; ++s) { const bf16x8s pa = pack_step(pp, s);
#pragma unroll
                for (int dt = 0; dt < 2; ++dt) {
                    const v4i16_t lo = __builtin_amdgcn_ds_read_tr16_b64_v4i16((LAS v4i16_t*)(vtr0 + (16 * s) * AT_VP + dt * 64));
                    const v4i16_t hi = __builtin_amdgcn_ds_read_tr16_b64_v4i16((LAS v4i16_t*)(vtr0 + (16 * s + 8) * AT_VP + dt * 64));
                    const bf16x8s vf = (bf16x8s){lo[0], lo[1], lo[2], lo[3], hi[0], hi[1], hi[2], hi[3]};
                    o[dt] = __builtin_amdgcn_mfma_f32_32x32x16_bf16(pa, vf, o[dt], 0, 0, 0); } }
            asm volatile("" ::: "memory");
            if (s0 < t0 && __all(carry > SB_EXIT * 1.4426950408889634f)) break;
        }
#pragma unroll
        for (int dt = 0; dt < 2; ++dt)
#pragma unroll
            for (int i = 0; i < 16; ++i) Ob[(rowb + t0 + crow32(i, hh)) * C + hd * HD + 32 * dt + r32] = (bf16)f2bf(o[dt][i]);
    }
}
__global__ void __launch_bounds__(NWAVES * 64, 2) yoco_fwd(Args args) {
    extern __shared__ __attribute__((aligned(16))) unsigned char lds_raw[];
    LAS unsigned char* lds = (LAS unsigned char*)lds_raw;
    const int G = gridDim.x; const int bx = blockIdx.x;
    int wave = __builtin_amdgcn_readfirstlane(threadIdx.x >> 6); asm volatile("" : "+s"(wave));
#define IDS() int lane; asm volatile("v_mbcnt_lo_u32_b32 %0, -1, 0\n\tv_mbcnt_hi_u32_b32 %0, -1, %0" : "=v"(lane)); const int tid = wave * 64 + lane; (void)tid; \
    const int vcu = (G % 8 == 0) ? (bx % 8) * (G / 8) + bx / 8 : bx; const int gw = vcu * NWAVES + wave, NGW = G * NWAVES; (void)lane; (void)gw; (void)NGW;
    unsigned char* ws = WSP();
    volatile LAS unsigned* MISC = (volatile LAS unsigned*)(lds + MISC_OFF);
    volatile LAS int* tab = (volatile LAS int*)(lds + MOE_TAB_OFF);
    for (int u = threadIdx.x; u < (LDS_BYTES - LDSCTL_OFF) / 4; u += NWAVES * 64) ((LAS unsigned*)(lds + LDSCTL_OFF))[u] = 0u;
    __syncthreads();
    XcdBarrier bar; bar.bar = (unsigned*)(ws + WS_CTL) + CW_BAR; bar.x = 0; bar.st = nullptr;
    if (N_LAUNCHES == 1) bar = xcd_barrier_post((unsigned*)(ws + WS_CTL) + CW_BAR, MISC + 8);
    const int lo = KA_INT(0), hi = KA_INT(1);
#ifndef PROBE_PH
#define PROBE_PH -1
#endif
#define IN(k) (lo <= (k) && (k) < hi)
#define REP(k) for (int rep_ = 0; rep_ < ((PROBE_PH == (k)) ? 2 : 1); ++rep_)
#define SEAM(k) do { if (IN(k) && IN((k) + 1)) xcd_barrier(bar); } while (0)

    if (IN(PH_P0)) REP(PH_P0) { IDS(); p0_weights<0>(ws, lds, gw, NGW, wave, lane); p0_weights<1>(ws, lds, gw, NGW, wave, lane); p0_rows(ws, gw, NGW, lane); }
    SEAM(PH_P0);
    if (PROBE_PH == 100 && N_LAUNCHES == 1) { for (int i_ = 0; i_ < 10; ++i_) xcd_barrier(bar); }
    if (IN(PH_LORA)) REP(PH_LORA) {
        SchedGrouped<1, 3> S{(const char*)(ws + WS_B1), (size_t)(WS_B2 - WS_B1), nullptr, (const char*)(ws + WS_WT_LORA), (size_t)256 * C * 2, G, bx};
        EpiLora E{(bf16*)(ws + WS_LW)};
        pg8::gemm_phase<EpiLora, SchedGrouped<1, 3>, true, false, C>(lds, S, E, wave);
    }
    SEAM(PH_LORA);
    if (IN(PH_RKV)) REP(PH_RKV) {
        SchedGrouped<4, 3> S{(const char*)OUTP(), (size_t)M * C * 2, (const char*)(ws + WS_B4), (const char*)(ws + WS_WT_RKV), (size_t)C * C * 2, G, bx};
        EpiSplit3 E{(bf16*)(ws + WS_B1), false};
        pg8::gemm_phase<EpiSplit3, SchedGrouped<4, 3>, true, false, C>(lds, S, E, wave);
    }
    SEAM(PH_RKV);
    if (IN(PH_S1)) REP(PH_S1) { IDS(); scan_s1(ws, lds, lane, wave); }
    SEAM(PH_S1);
    if (IN(PH_S2)) REP(PH_S2) { IDS();
        if (bx < BATCH * NH || G <= BATCH * NH) scan_s2(ws, lds, lane, wave);
        }
    SEAM(PH_S2);
    if (IN(PH_S3)) REP(PH_S3) { IDS(); scan_s3(ws, lds, lane, wave); }
    SEAM(PH_S3);
#if MK_DEBUG
    if (IN(PH_DBG0)) { IDS(); scan_naive(ws, lds, tid); }
    SEAM(PH_DBG0);
    if (IN(PH_DBG0 + 1)) { IDS(); post_scan(ws, gw, NGW, lane); }
    SEAM(PH_DBG0 + 1);
    if (IN(PH_DBG0 + 2)) { IDS(); dbg_compare(ws, (const bf16*)(ws + WS_B0), (const bf16*)(ws + WS_B4), gw, NGW, lane); }
    SEAM(PH_DBG0 + 2);
#endif
    if (IN(PH_WOUT)) REP(PH_WOUT) {
        SchedGrouped<4, 1> S{(const char*)(ws + ((MK_DEBUG && DBG_USE_NAIVE) ? WS_B4 : WS_B0)), 0, nullptr, (const char*)(ws + WS_WT_OUT), 0, G, bx};
        EpiResid E{INP(0), OUTP()};
        pg8::gemm_phase<EpiResid, SchedGrouped<4, 1>, true, false, C>(lds, S, E, wave);
    }
    SEAM(PH_WOUT);
#pragma unroll 1
    for (int layer = 0; layer < 2; ++layer) {
        const int pb = layer == 0 ? (int)PH_ROUT0 : (int)PH_ROUT1;
        if (IN(pb)) { IDS(); if (PROBE_PH == 101 && layer == 0) router_rows(ws, lds, layer, gw, NGW, lane, tid, true); router_rows(ws, lds, layer, gw, NGW, lane, tid); }
        SEAM(pb);
        if (IN(pb + 1)) REP(pb + 1) {
            { IDS(); moe_table(ws, tab, layer, tid); }
            SchedMoe<2, C, true> S{(const char*)(ws + WS_B1), (const char*)(ws + WS_WT_GU) + (size_t)layer * 16 * 512 * C * 2, (size_t)512 * C * 2, (const unsigned*)(ws + WS_LIST), tab, G, bx};
            EpiGU E{(bf16*)(ws + WS_HID), (const float*)(ws + WS_WL)};
            pg8::gemm_phase<EpiGU, SchedMoe<2, C, true>, true, true, C>(lds, S, E, wave);
        }
        SEAM(pb + 1);
        if (IN(pb + 2)) REP(pb + 2) {
            { IDS(); moe_table(ws, tab, layer, tid); }
            SchedMoe<4, FE, false> S{(const char*)(ws + WS_HID), (const char*)(ws + WS_WT_DN) + (size_t)layer * 16 * C * FE * 2, (size_t)C * FE * 2, (const unsigned*)(ws + WS_LIST), tab, G, bx};
            EpiDown E{(bf16*)(ws + WS_B2), (const unsigned*)(ws + WS_LIST)};
            pg8::gemm_phase<EpiDown, SchedMoe<4, FE, false>, true, false, FE>(lds, S, E, wave);
        }
        SEAM(pb + 2);
        if (layer == 0) {
            if (IN(PH_COMB)) { IDS(); if (PROBE_PH == 102) combine_rows(ws, 0, gw, NGW, lane, true); combine_rows(ws, 0, gw, NGW, lane); }
            SEAM(PH_COMB);
            if (IN(PH_KVQ)) REP(PH_KVQ) {
                SchedGrouped<12, 1> S{(const char*)(ws + WS_B0), 0, nullptr, (const char*)(ws + WS_WT_KVQ), 0, G, bx};
                EpiSplit3 E{(bf16*)(ws + WS_B1), true};
                pg8::gemm_phase<EpiSplit3, SchedGrouped<12, 1>, true, false, C>(lds, S, E, wave);
            }
            SEAM(PH_KVQ);
            if (IN(PH_ATTN)) REP(PH_ATTN) { IDS(); attn_mfma(ws, lds, gw, NGW, lane, wave); }
            SEAM(PH_ATTN);
            if (IN(PH_SBO)) {
                SchedGrouped<4, 1> S{(const char*)(ws + WS_B0), 0, nullptr, (const char*)(ws + WS_WT_SBO), 0, G, bx};
                EpiResid E{OUTP(), OUTP()};
                pg8::gemm_phase<EpiResid, SchedGrouped<4, 1>, true, false, C>(lds, S, E, wave);
            }
            SEAM(PH_SBO);
        }
    }
    if (IN(PH_FINAL)) { IDS(); combine_rows(ws, 1, gw, NGW, lane); }
#undef IN
#undef SEAM
}

extern "C" void kernel_launch(void* const* d_in, const int* in_sizes, int n_in, void* d_out, int out_size, void* d_ws, size_t ws_size, hipStream_t stream) {
    static int grid = 0;
    if (grid == 0) {
        if (n_in != 31 || in_sizes[0] != M * C || out_size != M * C || ws_size < WS_END) { fprintf(stderr, "kernel_launch: unexpected shapes (n_in %d, in0 %d, out %d, ws %zu); nothing launched\n", n_in, n_in > 0 ? in_sizes[0] : -1, out_size, ws_size); grid = -1; return; }
        int dev = 0, cus = 0, per_cu = 0;
        if (hipGetDevice(&dev) != hipSuccess || hipDeviceGetAttribute(&cus, hipDeviceAttributeMultiprocessorCount, dev) != hipSuccess) { grid = -1; return; }
        if (hipFuncSetAttribute((const void*)yoco_fwd, hipFuncAttributeMaxDynamicSharedMemorySize, LDS_BYTES) != hipSuccess) { fprintf(stderr, "kernel_launch: hipFuncSetAttribute failed\n"); grid = -1; return; }
        if (hipOccupancyMaxActiveBlocksPerMultiprocessor(&per_cu, (const void*)yoco_fwd, NWAVES * 64, LDS_BYTES) != hipSuccess || per_cu < 1) fprintf(stderr, "kernel_launch: occupancy query reports %d\n", per_cu);
        (void)hipGetLastError();
        grid = cus - (cus % 16);
    }
    if (grid < 0) return;
    if (hipMemsetAsync((char*)d_ws + WS_CTL, 0, CTL_ZERO_BYTES, stream) != hipSuccess) return;
    Args a{};
    for (int i = 0; i < 31; ++i) a.in[i] = (const float*)d_in[i];
    a.out = (float*)d_out; a.ws = (unsigned char*)d_ws;
    for (int li = 0; li < (N_LAUNCHES == 1 ? 1 : (int)NPHASE); ++li) {
        a.ph_lo = (N_LAUNCHES == 1) ? 0 : li; a.ph_hi = (N_LAUNCHES == 1) ? NPHASE : li + 1; a.li = li;
        hipLaunchKernelGGL(yoco_fwd, dim3(grid), dim3(NWAVES * 64), LDS_BYTES, stream, a);
        const hipError_t le = hipPeekAtLastError();
        if (le != hipSuccess) { fprintf(stderr, "kernel_launch: launch %d failed: %s\n", li, hipGetErrorName(le)); break; }
    }
}
```

```cpp
#include <hip/hip_runtime.h>
#include <cstdio>
#include <cstdint>

#ifndef MK_N_LAUNCHES
#define MK_N_LAUNCHES 1
#endif

namespace pg8 {
#define PG8_LAS __attribute__((address_space(3)))
typedef unsigned short bf16_t;
typedef short bf16x8 __attribute__((ext_vector_type(8)));
typedef float f32x4 __attribute__((ext_vector_type(4)));
typedef unsigned u32x4 __attribute__((ext_vector_type(4)));
constexpr int BM = 256, BK = 64, HALF = 128, HTB = HALF * BK * 2, STAGE_BYTES = 8 * HTB, NXCD = 8, WGM = 8;

__host__ __device__ __forceinline__ int lds_byte(int r, int c) { const int st = (r >> 4) * 2 + (c >> 5), rr = r & 15, cc = c & 31, ob = rr * 64 + cc * 2; return st * 1024 + (ob ^ (((ob >> 9) & 1) << 5)); }
__host__ __device__ __forceinline__ void stage_rc(int b, int& R, int& C) { const int st = b / 1024, sb = b % 1024, swz = sb ^ (((sb >> 9) & 1) << 5); R = (st >> 1) * 16 + swz / 64; C = (st & 1) * 32 + (swz % 64) / 2; }
__host__ __device__ __forceinline__ int perm32(int rho) { const int n = rho >> 4, i = rho & 15; return 8 * (i >> 2) + 4 * n + (i & 3); }

struct Unit { int pm, pn, aux, r0, cnt; };

__host__ __device__ __forceinline__ void tile_map(int wgid, int nM, int nN, int& pm, int& pn) {
    const int nwg = nM * nN;
    { const int q = nwg / NXCD, r = nwg % NXCD, xcd = wgid % NXCD, off = wgid / NXCD; wgid = (xcd < r ? xcd * (q + 1) : r * (q + 1) + (xcd - r) * q) + off; }
    const int nig = WGM * nN, gid = wgid / nig, fm = gid * WGM, gsz = (nM - fm) < WGM ? (nM - fm) : WGM;
    pm = fm + ((wgid % nig) % gsz); pn = (wgid % nig) / gsz;
}

typedef float f32x2_t __attribute__((ext_vector_type(2))); typedef __bf16 bf16x2_t __attribute__((ext_vector_type(2)));
__device__ __forceinline__ unsigned cvt_pk_bf16(float lo, float hi) { const f32x2_t v = {lo, hi}; const bf16x2_t b = __builtin_convertvector(v, bf16x2_t); return __builtin_bit_cast(unsigned, b); }

template <class Epi, class Sched, bool ALIGN_EPI, bool GATHER, int K>
__device__ __forceinline__ void gemm_phase(PG8_LAS unsigned char* lds, const Sched& S, const Epi& E, const int wid) {
    int lane_; asm volatile("v_mbcnt_lo_u32_b32 %0, -1, 0\n\tv_mbcnt_hi_u32_b32 %0, -1, %0" : "=v"(lane_));
    const int lane = lane_, tid = wid * 64 + lane, wr = wid >> 2, wc = wid & 3, fr = lane & 15, fq = lane >> 4;
    constexpr int nt = K / BK;
    unsigned voffA[2], voffB[2];
#pragma unroll
    for (int i = 0; i < 2; ++i) { int R, C; stage_rc(tid * 16 + i * 8192, R, C); const int Rb = Epi::PERM ? ((R & ~31) + perm32(R & 31)) : R;
        voffA[i] = (unsigned)(R * K + C) * 2u; voffB[i] = (unsigned)(Rb * K + C) * 2u; }
    constexpr size_t kstep = (size_t)(BK * 2);
    constexpr size_t hstep = (size_t)HALF * K * 2;
    const unsigned ldsw = (unsigned)wid * 1024u;
    const int aoff = lds_byte(wr * 64 + fr, fq * 8), boff = lds_byte(wc * 32 + fr, fq * 8);
#define PG8_SA(b, h) (((b) * 2 + (h)) * HTB)
#define PG8_SB(b, h) ((4 + (b) * 2 + (h)) * HTB)
#define PG8_STAGE(bufoff, gbase, voff) do { _Pragma("unroll") for (int _i = 0; _i < 2; ++_i) \
        __builtin_amdgcn_global_load_lds((const unsigned*)((const char*)(gbase) + (voff)[_i]), (PG8_LAS unsigned*)(lds + (bufoff) + ldsw + _i * 8192), 16, 0, 0); } while (0)
#define PG8_LDA(dst, b, h) do { _Pragma("unroll") for (int m = 0; m < 4; ++m) _Pragma("unroll") for (int k = 0; k < 2; ++k) dst[m][k] = *(const PG8_LAS bf16x8*)(lds + PG8_SA(b, h) + aoff + m * 2048 + k * 1024); } while (0)
#define PG8_LDB(dst, b, h) do { _Pragma("unroll") for (int n = 0; n < 2; ++n) _Pragma("unroll") for (int k = 0; k < 2; ++k) dst[n][k] = *(const PG8_LAS bf16x8*)(lds + PG8_SB(b, h) + boff + n * 2048 + k * 1024); } while (0)
#define PG8_MMA(ai, bj, At, Bt) do { __builtin_amdgcn_s_setprio(1); _Pragma("unroll") for (int m = 0; m < 4; ++m) _Pragma("unroll") for (int n = 0; n < 2; ++n) _Pragma("unroll") for (int k = 0; k < 2; ++k) \
        acc[ai][bj][m][n] = __builtin_amdgcn_mfma_f32_16x16x32_bf16(Bt[n][k], At[m][k], acc[ai][bj][m][n], 0, 0, 0); __builtin_amdgcn_s_setprio(0); } while (0)
#define PG8_WAIT_V(n) asm volatile("s_waitcnt vmcnt(" #n ")" ::: "memory")
#define PG8_WAIT_L(n) asm volatile("s_waitcnt lgkmcnt(" #n ")" ::: "memory")
#define PG8_BAR __builtin_amdgcn_s_barrier()
#define PG8_SCHED __builtin_amdgcn_sched_barrier(0)
    Unit cur, nxt; int ui = 0;
    if (!S.next(0, cur)) return;
    f32x4 acc[2][2][4][2];
#pragma unroll
    for (int a = 0; a < 2; ++a)
#pragma unroll
        for (int b = 0; b < 2; ++b)
#pragma unroll
            for (int m = 0; m < 4; ++m)
#pragma unroll
                for (int n = 0; n < 2; ++n) acc[a][b][m][n] = (f32x4){0.f, 0.f, 0.f, 0.f};
    bf16x8 At[4][2], B0[2][2], B1[2][2];
    unsigned vc[2][2];
#define PG8_GOFF(u) do { _Pragma("unroll") for (int _h = 0; _h < 2; ++_h) _Pragma("unroll") for (int _i = 0; _i < 2; ++_i) { int _R, _C; stage_rc(tid * 16 + _i * 8192, _R, _C); \
        vc[_h][_i] = S.a_row_off(u, _h * HALF + _R) + (unsigned)_C * 2u; } } while (0)
#define PG8_STAGE_A(bufoff, gbase, h) do { if constexpr (GATHER) { PG8_STAGE(bufoff, gbase, vc[h]); } else { PG8_STAGE(bufoff, (gbase) + (h) * hstep, voffA); } } while (0)
    if constexpr (GATHER) PG8_GOFF(cur);
    const char* cA = S.a_base(cur); const char* cB = S.b_base(cur);
    PG8_STAGE(PG8_SB(0, 0), cB, voffB); PG8_STAGE(PG8_SB(0, 1), cB + hstep, voffB); PG8_STAGE_A(PG8_SA(0, 0), cA, 0); PG8_STAGE_A(PG8_SA(0, 1), cA, 1);
    if (wr == 1) PG8_BAR;
    PG8_WAIT_V(2); PG8_BAR;
    PG8_STAGE(PG8_SB(1, 0), cB + kstep, voffB); PG8_STAGE_A(PG8_SA(1, 0), cA + kstep, 0); PG8_STAGE(PG8_SB(1, 1), cB + hstep + kstep, voffB);
    PG8_WAIT_V(6); PG8_BAR;
    for (;;) {
        const bool has_next = S.next(ui + 1, nxt);
        const char* nA = has_next ? S.a_base(nxt) : cA; const char* nB = has_next ? S.b_base(nxt) : cB;
        for (int t = 0; t < nt; t += 2) {
            const bool last = (t == nt - 2);
            const char* a1 = cA + (size_t)(t + 1) * kstep;
            const char* a2 = last ? nA : cA + (size_t)(t + 2) * kstep; const char* b2 = last ? nB : cB + (size_t)(t + 2) * kstep;
            const char* a3 = a2 + kstep; const char* b3 = b2 + kstep;
            PG8_LDB(B0, 0, 0); PG8_LDB(B1, 0, 1); PG8_SCHED; PG8_LDA(At, 0, 0); PG8_STAGE_A(PG8_SA(1, 1), a1, 1);
            if constexpr (GATHER) { if (last && has_next) PG8_GOFF(nxt); }
            PG8_WAIT_V(8); PG8_WAIT_L(0); PG8_BAR; PG8_MMA(0, 0, At, B0); PG8_MMA(0, 1, At, B1); PG8_BAR; PG8_SCHED;
            PG8_LDA(At, 0, 1); PG8_STAGE(PG8_SB(0, 0), b2, voffB); PG8_STAGE(PG8_SB(0, 1), b2 + hstep, voffB); PG8_STAGE_A(PG8_SA(0, 0), a2, 0);
            PG8_WAIT_V(8); PG8_WAIT_L(0); PG8_BAR; PG8_MMA(1, 0, At, B0); PG8_MMA(1, 1, At, B1); PG8_BAR; PG8_SCHED;
            PG8_LDB(B0, 1, 0); PG8_LDB(B1, 1, 1); PG8_SCHED; PG8_LDA(At, 1, 0); PG8_STAGE_A(PG8_SA(0, 1), a2, 1);
            PG8_WAIT_V(8); PG8_WAIT_L(0); PG8_BAR; PG8_MMA(0, 0, At, B0); PG8_MMA(0, 1, At, B1); PG8_BAR; PG8_SCHED;
            PG8_LDA(At, 1, 1); PG8_STAGE(PG8_SB(1, 0), b3, voffB); PG8_STAGE(PG8_SB(1, 1), b3 + hstep, voffB); PG8_STAGE_A(PG8_SA(1, 0), a3, 0);
            PG8_WAIT_V(8); PG8_WAIT_L(0); PG8_BAR; PG8_MMA(1, 0, At, B0); PG8_MMA(1, 1, At, B1); PG8_BAR; PG8_SCHED;
        }
        if constexpr (ALIGN_EPI) { if (wr == 0) PG8_BAR; }
        E(acc, cur, wr, wc, fr, fq);
        if (!has_next) break;
#pragma unroll
        for (int a = 0; a < 2; ++a)
#pragma unroll
            for (int b = 0; b < 2; ++b)
#pragma unroll
                for (int m = 0; m < 4; ++m)
#pragma unroll
                    for (int n = 0; n < 2; ++n) acc[a][b][m][n] = (f32x4){0.f, 0.f, 0.f, 0.f};
        cur = nxt; cA = nA; cB = nB; ++ui;
        if constexpr (ALIGN_EPI) { if (wr == 1) PG8_BAR; }
    }
    PG8_WAIT_V(0);
    if constexpr (!ALIGN_EPI) { if (wr == 0) PG8_BAR; }
    PG8_BAR;
#undef PG8_SA
#undef PG8_SB
#undef PG8_STAGE
#undef PG8_STAGE_A
#undef PG8_GOFF
#undef PG8_LDA
#undef PG8_LDB
#undef PG8_MMA
#undef PG8_WAIT_V
#undef PG8_WAIT_L
#undef PG8_BAR
#undef PG8_SCHED
}
}

constexpr int NWAVES = 8;
#ifndef MK_DEBUG
#define MK_DEBUG 0
#endif
#ifndef DBG_USE_NAIVE
#define DBG_USE_NAIVE 0
#endif
constexpr int DBGP = MK_DEBUG ? 3 : 0;
enum Phase { PH_P0 = 0, PH_LORA, PH_RKV, PH_S1, PH_S2, PH_S3, PH_DBG0, PH_WOUT = PH_DBG0 + DBGP, PH_ROUT0, PH_GU0, PH_DN0, PH_COMB, PH_KVQ, PH_ATTN, PH_SBO, PH_ROUT1, PH_GU1, PH_DN1, PH_FINAL, NPHASE };
constexpr int N_LAUNCHES = MK_N_LAUNCHES;


constexpr int BATCH = 2, SEQ = 8192, C = 1024, NH = 16, HD = 64, M = BATCH * SEQ;
constexpr int NE = 16, FE = 256, DW = 64, DA = 64, DG = 160;
constexpr float RMS_EPS = 1e-6f, GN_EPS = 64e-5f;
constexpr float SB_EXIT = 104.0f;

constexpr size_t MiB = 1u << 20;
constexpr size_t WS_CTL = 0, CTL_ZERO_BYTES = 64 * 1024;
constexpr size_t WS_WT_W2 = 128 * 1024, WS_WT_A2 = 256 * 1024, WS_WT_G2 = 384 * 1024;
constexpr size_t WS_WT_RKV = 1 * MiB;
constexpr size_t WS_WT_LORA = 7 * MiB;
constexpr size_t WS_WT_OUT = 9 * MiB;
constexpr size_t WS_WT_KVQ = 11 * MiB;
constexpr size_t WS_WT_SBO = 17 * MiB;
constexpr size_t WS_WT_GU = 19 * MiB;
constexpr size_t WS_WT_DN = 51 * MiB;
constexpr size_t WS_LW = 67 * MiB;
constexpr size_t WS_LA = 69 * MiB;
constexpr size_t WS_LG = 71 * MiB;
static_assert(WS_LA == WS_LW + 2 * MiB && WS_LG == WS_LW + 4 * MiB, "EpiLora's pointer arithmetic");
constexpr size_t WS_LIST = 76 * MiB;
constexpr size_t WS_WL = 77 * MiB;
constexpr size_t WS_HID = 78 * MiB;
constexpr size_t WS_B0 = 96 * MiB, WS_B1 = 128 * MiB, WS_B2 = 160 * MiB, WS_B3 = 192 * MiB, WS_B4 = 224 * MiB, WS_END = 256 * MiB;
static_assert(WS_HID + (size_t)144 * 256 * 256 * 2 <= WS_B0, "HID vs B0");
constexpr int CW_TMO = 0;
constexpr int CW_CNT = 1024;
constexpr int CW_BAR = 4096;

constexpr int RING_BYTES = 131072;
constexpr int LDSCTL_OFF = 146688, MISC_OFF = LDSCTL_OFF + 320, MOE_TAB_OFF = MISC_OFF + 128;
constexpr int LDS_BYTES = 147456;
static_assert(MOE_TAB_OFF + 256 <= LDS_BYTES, "LDS map");
static_assert(BATCH * NH * (SEQ / 64) % 16 == 0, "scan units");

#define GAS __attribute__((address_space(1)))
#define LAS __attribute__((address_space(3)))
typedef unsigned short bf16;
typedef unsigned v4u __attribute__((ext_vector_type(4)));
typedef unsigned v2u __attribute__((ext_vector_type(2)));
typedef float f32x4 __attribute__((ext_vector_type(4)));
typedef GAS unsigned gu32;
#define RLX_AGENT __ATOMIC_RELAXED, __HIP_MEMORY_SCOPE_AGENT
#define LDS_WAIT() asm volatile("s_waitcnt lgkmcnt(0)" ::: "memory")
#define VM_WAIT() asm volatile("s_waitcnt vmcnt(0)" ::: "memory")
__device__ __forceinline__ unsigned f2bf(float f) { unsigned u = __builtin_bit_cast(unsigned, f); return (u + 0x7fffu + ((u >> 16) & 1u)) >> 16; }
__device__ __forceinline__ unsigned pk2(float lo, float hi) { return f2bf(lo) | (f2bf(hi) << 16); }
__device__ __forceinline__ float bflo(unsigned u) { return __uint_as_float(u << 16); }
__device__ __forceinline__ float bfhi(unsigned u) { return __uint_as_float(u & 0xffff0000u); }
__device__ __forceinline__ float bf2f(bf16 b) { return __uint_as_float((unsigned)b << 16); }
__device__ __forceinline__ float sigmoidf_(float x) { return 1.0f / (1.0f + __expf(-x)); }

#define XB_TMO      128
#define XB_XCNT(j)  (256  + 64 * (j))
#define XB_XSUB(j)  (1280 + 64 * (j))
#define XB_XGEN(j)  (2304 + 64 * (j))
#define XB_TOP      3328
#define XB_TOPGEN   3392
#define XCD_BAR_WORDS 3456
#define XB_SPIN_CAP (1u << 18)
__device__ __forceinline__ unsigned xb_ld(unsigned* p)              { return __hip_atomic_load(p, __ATOMIC_RELAXED, __HIP_MEMORY_SCOPE_AGENT); }
__device__ __forceinline__ unsigned xb_add(unsigned* p, unsigned v) { return __hip_atomic_fetch_add(p, v, __ATOMIC_RELAXED, __HIP_MEMORY_SCOPE_AGENT); }
__device__ __forceinline__ unsigned xb_xcc_id() { return (unsigned)__builtin_amdgcn_s_getreg((3 << 11) | 20) & 0xFu; }
#define XB_SPIN(cond, bar) do { unsigned _sp = 0; while (cond) { __builtin_amdgcn_s_sleep(1); \
    if ((++_sp & 255u) == 0u) { if (xb_ld(&(bar)[XB_TMO])) break; if (_sp > XB_SPIN_CAP) { atomicAdd(&(bar)[XB_TMO], 1u); break; } } } } while (0)
struct XcdBarrier { unsigned* bar; unsigned x; volatile LAS unsigned* st; };
__device__ __forceinline__ XcdBarrier xcd_barrier_post(unsigned* bar, volatile LAS unsigned* st) {
    XcdBarrier b; b.bar = bar; b.x = xb_xcc_id(); b.st = st;
    if (threadIdx.x == 0) (void)xb_add(&bar[XB_XCNT(b.x)], 1u);
    return b;
}
__device__ __forceinline__ void xcd_barrier_complete(unsigned* bar, unsigned x, unsigned& nloc, unsigned& nx) {
    const unsigned G = gridDim.x * gridDim.y * gridDim.z;
    unsigned sum, cnt, mine, sp = 0u;
    for (;;) {
        sum = 0u; cnt = 0u; mine = 0u;
#pragma unroll
        for (unsigned j = 0; j < 16; ++j) { const unsigned c = xb_ld(&bar[XB_XCNT(j)]); sum += c; cnt += (c > 0u) ? 1u : 0u; mine = (j == x) ? c : mine; }
        if (sum == G) break;
        __builtin_amdgcn_s_sleep(1);
        if ((++sp & 255u) == 0u) { if (xb_ld(&bar[XB_TMO])) break; if (sp > XB_SPIN_CAP) { atomicAdd(&bar[XB_TMO], 1u); break; } }
    }
    nloc = mine > 0u ? mine : 1u; nx = cnt > 0u ? cnt : 1u;
}
__device__ __forceinline__ void xcd_barrier(const XcdBarrier& b) {
    asm volatile("s_waitcnt vmcnt(0)" ::: "memory");
    __syncthreads();
    if (threadIdx.x == 0) {
        unsigned* bar = b.bar;
        __builtin_amdgcn_s_waitcnt(0);
        unsigned nloc = b.st[0], nx = b.st[1];
        if (nloc == 0u) { xcd_barrier_complete(bar, b.x, nloc, nx); b.st[0] = nloc; b.st[1] = nx; }
        const unsigned old = xb_add(&bar[XB_XSUB(b.x)], 1u);
        const unsigned gen = old / nloc;
        if (old + 1u == (gen + 1u) * nloc) {
            __builtin_amdgcn_fence(__ATOMIC_RELEASE, "agent");
            asm volatile("s_waitcnt vmcnt(0)" ::: "memory");
            const unsigned og = xb_add(&bar[XB_TOP], 1u);
            const unsigned tg = og / nx;
            if (og + 1u == (tg + 1u) * nx) xb_add(&bar[XB_TOPGEN], 1u);
            else XB_SPIN(xb_ld(&bar[XB_TOPGEN]) == tg, bar);
            __builtin_amdgcn_fence(__ATOMIC_ACQUIRE, "agent");
            xb_add(&bar[XB_XGEN(b.x)], 1u);
            asm volatile("s_waitcnt vmcnt(0)" ::: "memory");
        } else {
            XB_SPIN(xb_ld(&bar[XB_XGEN(b.x)]) == gen, bar);
            __builtin_amdgcn_fence(__ATOMIC_ACQUIRE, "agent");
            asm volatile("s_waitcnt vmcnt(0)" ::: "memory");
        }
    }
    __syncthreads();
}

__device__ __forceinline__ float shx(float v, int o, int lane) { return __int_as_float(__builtin_amdgcn_ds_bpermute((lane ^ o) << 2, __float_as_int(v))); }
__device__ __forceinline__ float wave_sum(float v, int lane) {
#pragma unroll
    for (int o = 1; o < 64; o <<= 1) v += shx(v, o, lane);
    return v;
}
__device__ __forceinline__ void transpose_item(const float* W, int ldw, int k0, int n0, bf16* WT, int ldk, int dst_row0, const float* kscale, LAS float* scr, int lane, int kmax = 1 << 30) {
    const int r8 = lane >> 3, quad = lane & 7;
    f32x4 v[8];
#pragma unroll
    for (int i = 0; i < 8; ++i) { const int kk = r8 + 8 * i; v[i] = (k0 + kk < kmax) ? *(const GAS f32x4*)(W + (size_t)(k0 + kk) * ldw + n0 + quad * 4) : (f32x4){0.f, 0.f, 0.f, 0.f}; }
#pragma unroll
    for (int i = 0; i < 8; ++i) { const int kk = r8 + 8 * i; if (kscale) v[i] = v[i] * kscale[(k0 + kk < kmax) ? k0 + kk : 0]; *(LAS f32x4*)(scr + kk * 36 + ((quad ^ i) << 2)) = v[i]; }
    LDS_WAIT(); asm volatile("" ::: "memory");
    const int c = lane & 7;
#pragma unroll
    for (int j = 0; j < 4; ++j) { const int n = (lane >> 3) + 8 * j; const LAS float* sp = scr + (8 * c) * 36 + ((((n >> 2) ^ c) << 2) | (n & 3));
        v4u o; o.x = pk2(sp[0 * 36], sp[1 * 36]); o.y = pk2(sp[2 * 36], sp[3 * 36]); o.z = pk2(sp[4 * 36], sp[5 * 36]); o.w = pk2(sp[6 * 36], sp[7 * 36]);
        if (k0 + 8 * c < kmax) *(GAS v4u*)(WT + (size_t)(dst_row0 + n) * ldk + k0 + 8 * c) = o; }
    LDS_WAIT(); asm volatile("" ::: "memory");
}

struct Args { const float* in[31]; float* out; unsigned char* ws; int ph_lo, ph_hi, li, pad; };
typedef const __attribute__((address_space(4))) unsigned char* kaptr_t;
__device__ __forceinline__ kaptr_t ka_base() { kaptr_t p = (kaptr_t)__builtin_amdgcn_kernarg_segment_ptr(); asm volatile("" : "+s"(p)); return p; }
#define INP(k) (*(const float* const __attribute__((address_space(4)))*)(ka_base() + 8 * (k)))
#define OUTP() (*(float* const __attribute__((address_space(4)))*)(ka_base() + 8 * 31))
#define WSP() (*(unsigned char* const __attribute__((address_space(4)))*)(ka_base() + 8 * 32))
#define KA_INT(i) (*(const int __attribute__((address_space(4)))*)(ka_base() + 8 * 33 + 4 * (i)))

template <int PART> __device__ __forceinline__ void p0_weights(unsigned char* ws, LAS unsigned char* lds, int gw, int NGW, int wave, int lane) {
    LAS float* scr = (LAS float*)(lds + wave * 16384);
    bf16* WT_RKV = (bf16*)(ws + WS_WT_RKV); bf16* WT_LORA = (bf16*)(ws + WS_WT_LORA); bf16* WT_OUT = (bf16*)(ws + WS_WT_OUT); bf16* WT_KVQ = (bf16*)(ws + WS_WT_KVQ);
    bf16* WT_SBO = (bf16*)(ws + WS_WT_SBO); bf16* WT_GU = (bf16*)(ws + WS_WT_GU); bf16* WT_DN = (bf16*)(ws + WS_WT_DN);
    constexpr int I_UP = 32 + 32 + 96, I_RKV = 3 * 512, I_LORA = 32 + 32 + 80, I_OUT = 512, I_KV = 1024, I_Q = 512, I_SBO = 512, I_G = 32 * 128, I_U = 32 * 128, I_D = 32 * 128;
    constexpr int NDENSE = I_UP + I_RKV + I_LORA + I_OUT + I_KV + I_Q + I_SBO, NITEMS = NDENSE + I_G + I_U + I_D;
    for (int it = (PART == 0 ? 0 : NDENSE) + gw; it < (PART == 0 ? NDENSE : NITEMS); it += NGW) {
        int r = it;
        if (r < I_UP) {
            if (r < 32) transpose_item(INP(9), C, 0, 32 * r, (bf16*)(ws + WS_WT_W2), 64, 32 * r, nullptr, scr, lane);
            else if (r < 64) transpose_item(INP(12), C, 0, 32 * (r - 32), (bf16*)(ws + WS_WT_A2), 64, 32 * (r - 32), nullptr, scr, lane);
            else { const int q = r - 64, kb = q / 32, nb = q % 32; transpose_item(INP(14), C, 64 * kb, 32 * nb, (bf16*)(ws + WS_WT_G2), DG, 32 * nb, nullptr, scr, lane, DG); }
            continue; } r -= I_UP;
        if (r < I_RKV) { const int m = r / 512, q = r % 512, kb = q / 32, nb = q % 32; transpose_item(INP(6) + (size_t)m * C * C, C, 64 * kb, 32 * nb, WT_RKV, C, m * C + 32 * nb, nullptr, scr, lane); continue; } r -= I_RKV;
        if (r < I_LORA) {
            if (r < 32) { const int kb = r / 2, nb = r % 2; transpose_item(INP(8), DW, 64 * kb, 32 * nb, WT_LORA, C, 32 * nb, nullptr, scr, lane); }
            else if (r < 64) { const int q = r - 32, kb = q / 2, nb = q % 2; transpose_item(INP(11), DA, 64 * kb, 32 * nb, WT_LORA, C, 256 + 32 * nb, nullptr, scr, lane); }
            else { const int q = r - 64, kb = q / 5, nb = q % 5; transpose_item(INP(13), DG, 64 * kb, 32 * nb, WT_LORA, C, 512 + 32 * nb, nullptr, scr, lane); }
            continue; } r -= I_LORA;
        if (r < I_OUT) { const int kb = r / 32, nb = r % 32; transpose_item(INP(20), C, 64 * kb, 32 * nb, WT_OUT, C, 32 * nb, nullptr, scr, lane); continue; } r -= I_OUT;
        if (r < I_KV) { const int kb = r / 64, nb = r % 64; transpose_item(INP(21), 2 * C, 64 * kb, 32 * nb, WT_KVQ, C, 32 * nb, INP(3), scr, lane); continue; } r -= I_KV;
        if (r < I_Q) { const int kb = r / 32, nb = r % 32; transpose_item(INP(22), C, 64 * kb, 32 * nb, WT_KVQ, C, 2 * C + 32 * nb, INP(1) + C, scr, lane); continue; } r -= I_Q;
        if (r < I_SBO) { const int kb = r / 32, nb = r % 32; transpose_item(INP(23), C, 64 * kb, 32 * nb, WT_SBO, C, 32 * nb, nullptr, scr, lane); continue; } r -= I_SBO;
        if (r < I_G) { const int le = r / 128, q = r % 128, kb = q / 8, nb = q % 8, f0 = 32 * nb; transpose_item(INP(28) + (size_t)le * C * FE, FE, 64 * kb, f0, WT_GU + (size_t)le * 512 * C, C, 256 * (f0 / 128) + (f0 % 128), nullptr, scr, lane); continue; } r -= I_G;
        if (r < I_U) { const int le = r / 128, q = r % 128, kb = q / 8, nb = q % 8, f0 = 32 * nb; transpose_item(INP(29) + (size_t)le * C * FE, FE, 64 * kb, f0, WT_GU + (size_t)le * 512 * C, C, 256 * (f0 / 128) + 128 + (f0 % 128), nullptr, scr, lane); continue; } r -= I_U;
        { const int le = r / 128, q = r % 128, kb = q / 32, nb = q % 32; transpose_item(INP(30) + (size_t)le * FE * C, C, 64 * kb, 32 * nb, WT_DN + (size_t)le * C * FE, FE, 32 * nb, nullptr, scr, lane); }
    }
    if (PART == 0) for (int it = gw * 64 + lane; it < 768 * 128; it += NGW * 64) { const int row = it >> 7, ch = it & 127;
        const bool valid = (row < 64) || (row >= 256 && row < 320) || (row >= 512 && row < 672);
        if (!valid) *(GAS v4u*)(WT_LORA + (size_t)row * C + ch * 8) = (v4u){0u, 0u, 0u, 0u}; }
}
__device__ __forceinline__ void load_row(const float* p, int lane, f32x4 (&v)[4]) {
#pragma unroll
    for (int j = 0; j < 4; ++j) v[j] = ((const GAS f32x4*)p)[64 * j + lane];
}
__device__ __forceinline__ float row_rs(const f32x4 (&v)[4], int lane) {
    float s = 0.f;
#pragma unroll
    for (int j = 0; j < 4; ++j) s += (v[j].x * v[j].x + v[j].y * v[j].y) + (v[j].z * v[j].z + v[j].w * v[j].w);
    return 1.0f / sqrtf(wave_sum(s, lane) * (1.0f / C) + RMS_EPS);
}
__device__ __forceinline__ void store_row_bf16(bf16* p, int lane, const f32x4 (&v)[4]) {
#pragma unroll
    for (int j = 0; j < 4; ++j) { v2u o; o.x = pk2(v[j].x, v[j].y); o.y = pk2(v[j].z, v[j].w); ((GAS v2u*)p)[64 * j + lane] = o; }
}
__device__ __forceinline__ void p0_rows(unsigned char* ws, int gw, int NGW, int lane) {
    const float* x = INP(0); const float* gain = INP(1); const float* mix = INP(5);
    f32x4 g[4]; load_row(gain, lane, g);
    for (int run = gw; run < M / 8; run += NGW) {
        const int r0 = run * 8;
        f32x4 prev[4];
        if ((r0 % SEQ) == 0) {
#pragma unroll
            for (int j = 0; j < 4; ++j) prev[j] = (f32x4){0.f, 0.f, 0.f, 0.f};
        } else { load_row(x + (size_t)(r0 - 1) * C, lane, prev); const float rs = row_rs(prev, lane);
#pragma unroll
            for (int j = 0; j < 4; ++j) prev[j] = prev[j] * rs * g[j]; }
        for (int rr = 0; rr < 8; ++rr) {
            const int row = r0 + rr;
            f32x4 hn[4]; load_row(x + (size_t)row * C, lane, hn); const float rs = row_rs(hn, lane);
#pragma unroll
            for (int j = 0; j < 4; ++j) hn[j] = hn[j] * rs * g[j];
#pragma unroll
            for (int i = 0; i < 6; ++i) { f32x4 o[4];
#pragma unroll
                for (int j = 0; j < 4; ++j) { const f32x4 mx = ((const GAS f32x4*)(mix + i * C))[64 * j + lane]; o[j] = hn[j] + (prev[j] - hn[j]) * mx; }
                bf16* dst = i < 2 ? (bf16*)OUTP() + (size_t)i * M * C : (i == 2 ? (bf16*)(ws + WS_B4) : (bf16*)(ws + WS_B1) + (size_t)(i - 3) * M * C);
                store_row_bf16(dst + (size_t)row * C, lane, o); }
#pragma unroll
            for (int j = 0; j < 4; ++j) prev[j] = hn[j];
        }
    }
}

template <int NN, int NGROUPS> struct SchedGrouped {
    static constexpr int K = C;
    const char* A0; size_t astride; const char* A2; const char* B; size_t bgroup;
    int G, c;
    __device__ __forceinline__ bool next(int i, pg8::Unit& u) const {
        const int L = i * G + c; constexpr int per = 64 * NN; if (L >= per * NGROUPS) return false;
        const int g = L / per, w = L % per; pg8::tile_map(w, 64, NN, u.pm, u.pn); u.aux = g; u.r0 = 0; u.cnt = 0; return true; }
    __device__ __forceinline__ const char* a_base(const pg8::Unit& u) const { const char* A = (A2 != nullptr && u.aux == 2) ? A2 : A0 + (size_t)u.aux * astride; return A + (size_t)u.pm * 256 * K * 2; }
    __device__ __forceinline__ const char* b_base(const pg8::Unit& u) const { return B + (size_t)u.aux * bgroup + (size_t)u.pn * 256 * K * 2; }
    __device__ __forceinline__ unsigned a_row_off(const pg8::Unit&, int) const { return 0u; }
};
template <int NN, int K, bool GATHER> struct SchedMoe {
    const char* A; const char* B; size_t bexp; const unsigned* list; volatile LAS int* tab; int G, c;
    __device__ __forceinline__ bool next(int i, pg8::Unit& u) const {
        const int L = i * G + c; const int tot = __builtin_amdgcn_readfirstlane(tab[48]) * NN; if (L >= tot) return false;
        u.pm = L / NN; u.pn = L % NN; int e = 0;
#pragma unroll
        for (int j = 0; j < 16; ++j) e += (u.pm >= tab[32 + j]) ? 1 : 0;
        e = __builtin_amdgcn_readfirstlane(e);
        u.aux = e; u.r0 = (u.pm - __builtin_amdgcn_readfirstlane(tab[16 + e])) * 256; u.cnt = __builtin_amdgcn_readfirstlane(tab[e]); return true; }
    __device__ __forceinline__ const char* a_base(const pg8::Unit& u) const { return GATHER ? A : A + (size_t)u.pm * 256 * K * 2; }
    __device__ __forceinline__ const char* b_base(const pg8::Unit& u) const { return B + (size_t)u.aux * bexp + (size_t)u.pn * 256 * K * 2; }
    __device__ __forceinline__ unsigned a_row_off(const pg8::Unit& u, int r) const {
        const int idx = u.r0 + r; unsigned tok = 0u;
        if (idx < u.cnt) tok = list[(size_t)u.aux * M + idx] >> 1;
        return tok * (unsigned)(K * 2); }
};

using pg8::f32x4;
using pg8::Unit;
__device__ __forceinline__ v4u pack8(f32x4 v0, f32x4 v1) { v4u w; w.x = pg8::cvt_pk_bf16(v0[0], v0[1]); w.y = pg8::cvt_pk_bf16(v0[2], v0[3]); w.z = pg8::cvt_pk_bf16(v1[0], v1[1]); w.w = pg8::cvt_pk_bf16(v1[2], v1[3]); return w; }

struct EpiLora {
    static constexpr bool PERM = true;
    bf16* LW;
    __device__ __forceinline__ void operator()(const f32x4 (&acc)[2][2][4][2], const Unit& u, int wr, int wc, int fr, int fq) const {
        { int l_; asm volatile("v_mbcnt_lo_u32_b32 %0, -1, 0\n\tv_mbcnt_hi_u32_b32 %0, -1, %0" : "=v"(l_)); fr = l_ & 15; fq = l_ >> 4; }
        const int g = u.aux, width = g == 2 ? DG : DW; bf16* out = LW + (size_t)g * (1u << 20);
        const int row0 = u.pm * 256 + wr * 64 + fr;
#pragma unroll
        for (int bj = 0; bj < 2; ++bj) { const int col0 = bj * 128 + wc * 32 + 8 * fq; if (col0 < width) {
#pragma unroll
            for (int ai = 0; ai < 2; ++ai)
#pragma unroll
                for (int m = 0; m < 4; ++m) { f32x4 v0 = acc[ai][bj][m][0], v1 = acc[ai][bj][m][1];
                    if (g == 0) {
#pragma unroll
                        for (int q = 0; q < 4; ++q) { v0[q] = tanhf(v0[q]); v1[q] = tanhf(v1[q]); } }
                    else if (g == 2) {
#pragma unroll
                        for (int q = 0; q < 4; ++q) { v0[q] = sigmoidf_(v0[q]); v1[q] = sigmoidf_(v1[q]); } }
                    *(GAS v4u*)(out + (size_t)(row0 + ai * 128 + m * 16) * width + col0) = pack8(v0, v1); } } }
    }
};
struct EpiSplit3 {
    static constexpr bool PERM = true;
    bf16* O0; bool bycol;
    __device__ __forceinline__ void operator()(const f32x4 (&acc)[2][2][4][2], const Unit& u, int wr, int wc, int fr, int fq) const {
        { int l_; asm volatile("v_mbcnt_lo_u32_b32 %0, -1, 0\n\tv_mbcnt_hi_u32_b32 %0, -1, %0" : "=v"(l_)); fr = l_ & 15; fq = l_ >> 4; }
        const int g = bycol ? (u.pn >> 2) : u.aux, pn = bycol ? (u.pn & 3) : u.pn; bf16* out = O0 + (size_t)g * ((size_t)M * C);
        const int row0 = u.pm * 256 + wr * 64 + fr, col0 = pn * 256 + wc * 32 + 8 * fq;
#pragma unroll
        for (int ai = 0; ai < 2; ++ai)
#pragma unroll
            for (int m = 0; m < 4; ++m)
#pragma unroll
                for (int bj = 0; bj < 2; ++bj) *(GAS v4u*)(out + (size_t)(row0 + ai * 128 + m * 16) * C + col0 + bj * 128) = pack8(acc[ai][bj][m][0], acc[ai][bj][m][1]);
    }
};
struct EpiResid {
    static constexpr bool PERM = false;
    const float* base; float* out;
    __device__ __forceinline__ void operator()(const f32x4 (&acc)[2][2][4][2], const Unit& u, int wr, int wc, int fr, int fq) const {
        { int l_; asm volatile("v_mbcnt_lo_u32_b32 %0, -1, 0\n\tv_mbcnt_hi_u32_b32 %0, -1, %0" : "=v"(l_)); fr = l_ & 15; fq = l_ >> 4; }
        const int row0 = u.pm * 256 + wr * 64 + fr, col0 = u.pn * 256 + wc * 32 + 4 * fq;
#pragma unroll
        for (int ai = 0; ai < 2; ++ai)
#pragma unroll
            for (int m = 0; m < 4; ++m) { const size_t off = (size_t)(row0 + ai * 128 + m * 16) * C + col0;
#pragma unroll
                for (int bj = 0; bj < 2; ++bj)
#pragma unroll
                    for (int n = 0; n < 2; ++n) { const f32x4 b = *(const GAS f32x4*)(base + off + bj * 128 + n * 16); *(GAS f32x4*)(out + off + bj * 128 + n * 16) = b + acc[ai][bj][m][n]; } }
    }
};
struct EpiGU {
    static constexpr bool PERM = true;
    bf16* HID; const float* wl;
    __device__ __forceinline__ void operator()(const f32x4 (&acc)[2][2][4][2], const Unit& u, int wr, int wc, int fr, int fq) const {
        { int l_; asm volatile("v_mbcnt_lo_u32_b32 %0, -1, 0\n\tv_mbcnt_hi_u32_b32 %0, -1, %0" : "=v"(l_)); fr = l_ & 15; fq = l_ >> 4; }
        const int e = u.aux, cnt = u.cnt, base = u.r0, r0 = wr * 64 + fr, col0 = u.pn * 128 + wc * 32 + 8 * fq;
#pragma unroll
        for (int ai = 0; ai < 2; ++ai)
#pragma unroll
            for (int m = 0; m < 4; ++m) { const int r = r0 + ai * 128 + m * 16, idx = base + r; float w = 0.f; if (idx < cnt) w = wl[(size_t)e * M + idx];
                f32x4 h0, h1;
#pragma unroll
                for (int q = 0; q < 4; ++q) { const float g0 = acc[ai][0][m][0][q], g1 = acc[ai][0][m][1][q];
                    h0[q] = g0 * sigmoidf_(g0) * acc[ai][1][m][0][q] * w; h1[q] = g1 * sigmoidf_(g1) * acc[ai][1][m][1][q] * w; }
                *(GAS v4u*)(HID + (size_t)(u.pm * 256 + r) * FE + col0) = pack8(h0, h1);
                asm volatile("" ::: "memory"); }
    }
};
struct EpiDown {
    static constexpr bool PERM = true;
    bf16* EO; const unsigned* list;
    __device__ __forceinline__ void operator()(const f32x4 (&acc)[2][2][4][2], const Unit& u, int wr, int wc, int fr, int fq) const {
        { int l_; asm volatile("v_mbcnt_lo_u32_b32 %0, -1, 0\n\tv_mbcnt_hi_u32_b32 %0, -1, %0" : "=v"(l_)); fr = l_ & 15; fq = l_ >> 4; }
        const int e = u.aux, cnt = u.cnt, base = u.r0, r0 = wr * 64 + fr, col0 = u.pn * 256 + wc * 32 + 8 * fq;
#pragma unroll
        for (int ai = 0; ai < 2; ++ai)
#pragma unroll
            for (int m = 0; m < 4; ++m) { const int idx = base + r0 + ai * 128 + m * 16;
                if (idx < cnt) { const unsigned ent = list[(size_t)e * M + idx]; bf16* o = EO + ((size_t)(ent & 1u) * M + (ent >> 1)) * C + col0;
#pragma unroll
                    for (int bj = 0; bj < 2; ++bj) *(GAS v4u*)(o + bj * 128) = pack8(acc[ai][bj][m][0], acc[ai][bj][m][1]); }
                asm volatile("" ::: "memory"); }
    }
};

typedef short bf16x8s __attribute__((ext_vector_type(8)));
typedef short bf16x4s __attribute__((ext_vector_type(4)));
typedef short v4i16_t __attribute__((ext_vector_type(4)));
constexpr int TPB = 144;
constexpr int TILE_B = 64 * TPB;
constexpr int FP = 68;
constexpr int CS_FA = 0, CS_FB = 16384, CS_TILES = 32768, CS_TOT = CS_TILES + 12 * TILE_B, CS_WL = CS_TOT + 2048, CS_PAR = CS_WL + 256;
static_assert(CS_PAR + 768 <= LDSCTL_OFF, "scan LDS map");
#define TILE(n) (lds + CS_TILES + (n) * TILE_B)
#define F4Z (f32x4){0.f, 0.f, 0.f, 0.f}
__device__ __forceinline__ bf16x8s ldfrag(const LAS unsigned char* tile, int row, int kcol) { return *(const LAS bf16x8s*)(tile + row * TPB + kcol * 2); }
__device__ __forceinline__ bf16x8s ldfrag_tr(const LAS unsigned char* tile, int n0, int k0, int lane) {
    const int g = lane >> 4, q = (lane & 15) >> 2, p = lane & 3;
    const LAS unsigned char* a = tile + (k0 + 8 * g + q) * TPB + (n0 + 4 * p) * 2;
    const v4i16_t lo = __builtin_amdgcn_ds_read_tr16_b64_v4i16((LAS v4i16_t*)a), hi = __builtin_amdgcn_ds_read_tr16_b64_v4i16((LAS v4i16_t*)(a + 4 * TPB));
    return (bf16x8s){lo[0], lo[1], lo[2], lo[3], hi[0], hi[1], hi[2], hi[3]};
}
__device__ __forceinline__ bf16x8s ldfrag_perm(const LAS unsigned char* tile, int row, int ks, int g) {
    const bf16x4s lo = *(const LAS bf16x4s*)(tile + row * TPB + (32 * ks + 4 * g) * 2), hi = *(const LAS bf16x4s*)(tile + row * TPB + (32 * ks + 16 + 4 * g) * 2);
    return (bf16x8s){lo[0], lo[1], lo[2], lo[3], hi[0], hi[1], hi[2], hi[3]};
}
__device__ __forceinline__ void lds_barrier() { asm volatile("s_waitcnt lgkmcnt(0)" ::: "memory"); __builtin_amdgcn_s_barrier(); asm volatile("" ::: "memory"); }
#define MFMA16(a, b, c) __builtin_amdgcn_mfma_f32_16x16x32_bf16((a), (b), (c), 0, 0, 0)
__device__ __forceinline__ void mm64(f32x4 (&acc)[2], const LAS unsigned char* At, const LAS unsigned char* Bt, int rt, int ch, int fr, int g) {
#pragma unroll
    for (int ks = 0; ks < 2; ++ks) { const bf16x8s a = ldfrag(At, 16 * rt + fr, 32 * ks + 8 * g);
#pragma unroll
        for (int ct = 0; ct < 2; ++ct) acc[ct] = MFMA16(a, ldfrag(Bt, 32 * ch + 16 * ct + fr, 32 * ks + 8 * g), acc[ct]); }
}
__device__ __forceinline__ void mm64_bt(f32x4 (&acc)[2], const LAS unsigned char* At, const LAS unsigned char* X, int rt, int ch, int fr, int g, int lane) {
#pragma unroll
    for (int ks = 0; ks < 2; ++ks) { const bf16x8s a = ldfrag(At, 16 * rt + fr, 32 * ks + 8 * g);
#pragma unroll
        for (int ct = 0; ct < 2; ++ct) acc[ct] = MFMA16(a, ldfrag_tr(X, 32 * ch + 16 * ct, 32 * ks, lane), acc[ct]); }
}
__device__ __forceinline__ void mm64_at(f32x4 (&acc)[2], const LAS unsigned char* Xa, const LAS unsigned char* Bt, int rt, int ch, int fr, int g, int lane) {
#pragma unroll
    for (int ks = 0; ks < 2; ++ks) { const bf16x8s a = ldfrag_tr(Xa, 16 * rt, 32 * ks, lane);
#pragma unroll
        for (int ct = 0; ct < 2; ++ct) acc[ct] = MFMA16(a, ldfrag(Bt, 32 * ch + 16 * ct + fr, 32 * ks + 8 * g), acc[ct]); }
}
__device__ __forceinline__ void mm64_att(f32x4 (&acc)[2], const LAS unsigned char* Xa, const LAS unsigned char* X, int rt, int ch, int lane) {
#pragma unroll
    for (int ks = 0; ks < 2; ++ks) { const bf16x8s a = ldfrag_tr(Xa, 16 * rt, 32 * ks, lane);
#pragma unroll
        for (int ct = 0; ct < 2; ++ct) acc[ct] = MFMA16(a, ldfrag_tr(X, 32 * ch + 16 * ct, 32 * ks, lane), acc[ct]); }
}
__device__ __forceinline__ bf16x4s pack4(f32x4 v) { v2u w; w.x = pg8::cvt_pk_bf16(v[0], v[1]); w.y = pg8::cvt_pk_bf16(v[2], v[3]); return __builtin_bit_cast(bf16x4s, w); }
__device__ __forceinline__ f32x4 unpack4(bf16x4s s) { const v2u w = __builtin_bit_cast(v2u, s); return (f32x4){bflo(w.x), bfhi(w.x), bflo(w.y), bfhi(w.y)}; }
__device__ __forceinline__ void st_tr(LAS unsigned char* Out, const f32x4 (&acc)[2], int rt, int ch, int fr, int g) {
#pragma unroll
    for (int ct = 0; ct < 2; ++ct) *(LAS bf16x4s*)(Out + (32 * ch + 16 * ct + fr) * TPB + (16 * rt + 4 * g) * 2) = pack4(acc[ct]);
}
__device__ __forceinline__ void ld_tr(f32x4 (&acc)[2], const LAS unsigned char* In, int rt, int ch, int fr, int g) {
#pragma unroll
    for (int ct = 0; ct < 2; ++ct) acc[ct] = unpack4(*(const LAS bf16x4s*)(In + (32 * ch + 16 * ct + fr) * TPB + (16 * rt + 4 * g) * 2));
}
__device__ __forceinline__ void unpack8(v4u w, float (&o)[8]) { o[0] = bflo(w.x); o[1] = bfhi(w.x); o[2] = bflo(w.y); o[3] = bfhi(w.y); o[4] = bflo(w.z); o[5] = bfhi(w.z); o[6] = bflo(w.w); o[7] = bfhi(w.w); }
__device__ __forceinline__ v4u pack8f(const float (&o)[8]) { v4u w; w.x = pg8::cvt_pk_bf16(o[0], o[1]); w.y = pg8::cvt_pk_bf16(o[2], o[3]); w.z = pg8::cvt_pk_bf16(o[4], o[5]); w.w = pg8::cvt_pk_bf16(o[6], o[7]); return w; }

struct FrontIn { v4u r, k, v; bf16x8s fw[2], fa[2]; };
__device__ __forceinline__ void front_fetch(FrontIn& f, unsigned char* ws, int unit, int tid, int lane, int wave) {
    const int h = unit & 15, c = (unit >> 4) & 127, b = unit >> 11; const size_t row0 = (size_t)b * SEQ + c * 64;
    const int rt = wave & 3, fr = lane & 15, g = lane >> 4, t = tid >> 3, cq = tid & 7, c0 = h * HD + cq * 8;
    const bf16* Rb = (const bf16*)(ws + WS_B1); const bf16* Kb = (const bf16*)(ws + WS_B2); const bf16* Vb = (const bf16*)(ws + WS_B3);
    const bf16* LW = (const bf16*)(ws + WS_LW); const bf16* LA = (const bf16*)(ws + WS_LA);
    f.r = *(const GAS v4u*)(Rb + (row0 + t) * C + c0); f.k = *(const GAS v4u*)(Kb + (row0 + t) * C + c0); f.v = *(const GAS v4u*)(Vb + (row0 + t) * C + c0);
#pragma unroll
    for (int ks = 0; ks < 2; ++ks) { f.fw[ks] = *(const GAS bf16x8s*)(LW + (row0 + 16 * rt + fr) * DW + 32 * ks + 8 * g); f.fa[ks] = *(const GAS bf16x8s*)(LA + (row0 + 16 * rt + fr) * DA + 32 * ks + 8 * g); }
}
__device__ __forceinline__ v4u head_consts(unsigned char* ws, LAS unsigned char* lds, int h, int tid, int wtile, int atile) {
    const bf16* W2T = (const bf16*)(ws + WS_WT_W2); const bf16* A2T = (const bf16*)(ws + WS_WT_A2);
    const int row = tid >> 3, cq = tid & 7;
    const v4u w2chunk = *(const GAS v4u*)(W2T + (size_t)(h * HD + row) * 64 + cq * 8);
    *(LAS v4u*)(lds + CS_TILES + wtile * TILE_B + row * TPB + cq * 16) = w2chunk;
    *(LAS v4u*)(lds + CS_TILES + atile * TILE_B + row * TPB + cq * 16) = *(const GAS v4u*)(A2T + (size_t)(h * HD + row) * 64 + cq * 8);
    if (tid < 64) { LAS float* P = (LAS float*)(lds + CS_PAR); P[tid] = INP(15)[h * HD + tid]; P[64 + tid] = INP(16)[h * HD + tid]; P[128 + tid] = INP(17)[h * HD + tid]; }
    __syncthreads();
    return w2chunk;
}
template <int MODE>
__device__ __forceinline__ void chunk_front(const FrontIn& f, LAS unsigned char* lds, const float (&w0v)[2], const float (&a0v)[2], int tid, int lane, int wave, float (&v8)[8], float& rkb) {
    const int rt = wave & 3, ch = wave >> 2, fr = lane & 15, g = lane >> 4;
    LAS float* FA = (LAS float*)(lds + CS_FA); LAS float* FB = (LAS float*)(lds + CS_FB); LAS float* TOT = (LAS float*)(lds + CS_TOT);
    const int t = tid >> 3, cq = tid & 7;
    constexpr int WTILE = MODE == 1 ? 6 : 10, ATILE = MODE == 1 ? 8 : 11;
    {
        f32x4 aw[2] = {F4Z, F4Z}, aa[2] = {F4Z, F4Z};
#pragma unroll
        for (int ks = 0; ks < 2; ++ks)
#pragma unroll
            for (int ct = 0; ct < 2; ++ct) { aw[ct] = MFMA16(f.fw[ks], ldfrag(TILE(WTILE), 32 * ch + 16 * ct + fr, 32 * ks + 8 * g), aw[ct]); aa[ct] = MFMA16(f.fa[ks], ldfrag(TILE(ATILE), 32 * ch + 16 * ct + fr, 32 * ks + 8 * g), aa[ct]); }
#pragma unroll
        for (int ct = 0; ct < 2; ++ct) { const int j = 32 * ch + 16 * ct + fr; const float w0 = w0v[ct], a0 = a0v[ct];
#pragma unroll
            for (int q = 0; q < 4; ++q) { const int tt = 16 * rt + 4 * g + q, js = j ^ ((g & 1) << 4);
                FA[tt * 64 + js] = -0.6065306597126334f * sigmoidf_(w0 + aw[ct][q]); FB[tt * 64 + js] = sigmoidf_(a0 + aa[ct][q]); } }
    }
    lds_barrier();
    {
        const int j = tid & 63, seg = tid >> 6; float run = 0.f; float loc[8];
#pragma unroll
        for (int q = 0; q < 8; ++q) { run += FA[(8 * seg + q) * 64 + (j ^ (((q >> 2) & 1) << 4))]; loc[q] = run; }
        TOT[seg * 64 + j] = run;
        lds_barrier();
        float off = 0.f;
#pragma unroll
        for (int s2 = 0; s2 < 7; ++s2) off += (s2 < seg) ? TOT[s2 * 64 + j] : 0.f;
#pragma unroll
        for (int q = 0; q < 8; ++q) FA[(8 * seg + q) * 64 + (j ^ (((q >> 2) & 1) << 4))] = loc[q] + off;
    }
    lds_barrier();
    {
        float r[8], k[8], pkk[8], pka[8], prk[8];
        unpack8(f.r, r); unpack8(f.k, k); unpack8(f.v, v8);
        { const LAS float* P = (const LAS float*)(lds + CS_PAR) + cq * 8; const f32x4 a0_ = *(const LAS f32x4*)P, a1_ = *(const LAS f32x4*)(P + 4), b0_ = *(const LAS f32x4*)(P + 64), b1_ = *(const LAS f32x4*)(P + 68), c0_ = *(const LAS f32x4*)(P + 128), c1_ = *(const LAS f32x4*)(P + 132);
#pragma unroll
          for (int q = 0; q < 4; ++q) { pkk[q] = a0_[q]; pkk[4 + q] = a1_[q]; pka[q] = b0_[q]; pka[4 + q] = b1_[q]; prk[q] = c0_[q]; prk[4 + q] = c1_[q]; } }
        float cw[8], cwp[8], ag[8];
        { const int tp = t > 0 ? t - 1 : 0;
          const int ct_ = (cq ^ (((t >> 2) & 1) << 1)) * 8, cp_ = (cq ^ (((tp >> 2) & 1) << 1)) * 8;
          const f32x4 c0_ = *(const LAS f32x4*)(FA + t * 64 + ct_), c1_ = *(const LAS f32x4*)(FA + t * 64 + ct_ + 4), p0_ = *(const LAS f32x4*)(FA + tp * 64 + cp_), p1_ = *(const LAS f32x4*)(FA + tp * 64 + cp_ + 4);
          const f32x4 g0_ = *(const LAS f32x4*)(FB + t * 64 + ct_), g1_ = *(const LAS f32x4*)(FB + t * 64 + ct_ + 4);
#pragma unroll
          for (int q = 0; q < 4; ++q) { cw[q] = c0_[q]; cw[4 + q] = c1_[q]; cwp[q] = t > 0 ? p0_[q] : 0.f; cwp[4 + q] = t > 0 ? p1_[q] : 0.f; ag[q] = g0_[q]; ag[4 + q] = g1_[q]; } }
        float kk[8], ss = 0.f; rkb = 0.f;
#pragma unroll
        for (int q = 0; q < 8; ++q) { kk[q] = k[q] * pkk[q]; ss += kk[q] * kk[q]; }
        ss += shx(ss, 1, lane); ss += shx(ss, 2, lane); ss += shx(ss, 4, lane);
        const float inv = 1.0f / fmaxf(sqrtf(ss), 1e-12f);
        float at[8], bt[8], kt[8], rt_[8];
#pragma unroll
        for (int q = 0; q < 8; ++q) { const float kn = kk[q] * inv, kp = k[q] * (1.0f + (ag[q] - 1.0f) * pka[q]);
            const float ein = __expf(-cw[q]);
            at[q] = -kn * __expf(cwp[q]); bt[q] = kn * ag[q] * ein; kt[q] = kp * ein;
            rt_[q] = r[q] * __expf(cw[q]); rkb += r[q] * kp * prk[q]; }
        rkb += shx(rkb, 1, lane); rkb += shx(rkb, 2, lane); rkb += shx(rkb, 4, lane);
        *(LAS v4u*)(TILE(0) + t * TPB + cq * 16) = pack8f(at); *(LAS v4u*)(TILE(1) + t * TPB + cq * 16) = pack8f(bt); *(LAS v4u*)(TILE(2) + t * TPB + cq * 16) = pack8f(kt);
        *(LAS v4u*)(TILE(3) + t * TPB + cq * 16) = f.v;
        *(LAS v4u*)(TILE(MODE == 1 ? 6 : 4) + t * TPB + cq * 16) = pack8f(rt_);
        if (MODE == 1 && t == 63) {
#pragma unroll
            for (int q = 0; q < 8; ++q) ((LAS float*)(lds + CS_WL))[cq * 8 + q] = __expf(cw[q]); }
    }
    lds_barrier();
}

__device__ __forceinline__ void scan_s1(unsigned char* ws, LAS unsigned char* lds, int lane0, int wave) {
    const int rt = wave & 3, ch = wave >> 2;
    FrontIn fin; float w0v[2], a0v[2]; v4u w2keep;
    { int l0 = lane0; asm volatile("" : "+v"(l0)); const int hh = blockIdx.x & 15;
      if ((int)blockIdx.x < BATCH * NH * (SEQ / 64)) front_fetch(fin, ws, blockIdx.x, wave * 64 + l0, l0, wave);
#pragma unroll
      for (int ct = 0; ct < 2; ++ct) { w0v[ct] = INP(7)[hh * HD + 32 * ch + 16 * ct + (l0 & 15)]; a0v[ct] = INP(10)[hh * HD + 32 * ch + 16 * ct + (l0 & 15)]; }
      w2keep = head_consts(ws, lds, hh, wave * 64 + l0, 6, 8); }
    for (int unit = blockIdx.x; unit < BATCH * NH * (SEQ / 64); unit += gridDim.x) {
        int lane = lane0; asm volatile("" : "+v"(lane));
        const int tid = wave * 64 + lane, fr = lane & 15, g = lane >> 4;
        const int h = unit & 15, c = (unit >> 4) & 127, b = unit >> 11; const size_t chunk = ((size_t)b * NH + h) * 128 + c;
        float v8[8]; float rkb;
        chunk_front<1>(fin, lds, w0v, a0v, tid, lane, wave, v8, rkb);
        { const size_t row0_ = (size_t)b * SEQ + c * 64; if ((tid & 7) == 0) ((float*)(ws + WS_HID))[(row0_ + (tid >> 3)) * NH + h] = rkb; }
        if (unit + (int)gridDim.x < BATCH * NH * (SEQ / 64)) front_fetch(fin, ws, unit + gridDim.x, tid, lane, wave);
        {
            f32x4 a2[2] = {F4Z, F4Z}, a3[2] = {F4Z, F4Z};
            mm64(a2, TILE(1), TILE(0), rt, ch, fr, g);
            mm64(a3, TILE(2), TILE(0), rt, ch, fr, g);
            f32x4 p1[2];
#pragma unroll
            for (int ct = 0; ct < 2; ++ct) { const int col = 32 * ch + 16 * ct + fr;
#pragma unroll
                for (int q = 0; q < 4; ++q) { const int row = 16 * rt + 4 * g + q;
                    a2[ct][q] = row < col ? a2[ct][q] : 0.f;
                    p1[ct][q] = a2[ct][q] + (row == col ? 1.0f : 0.f);
                    a3[ct][q] = row < col ? a3[ct][q] : 0.f; } }
            st_tr(TILE(5), a2, rt, ch, fr, g);
            st_tr(TILE(9), p1, rt, ch, fr, g);
            st_tr(TILE(4), a3, rt, ch, fr, g);
        }
        lds_barrier();
#pragma unroll
        for (int r = 0; r < 6; ++r) {
            LAS unsigned char* Sr = TILE(5 + 2 * (r & 1)); LAS unsigned char* Sr2 = TILE(5 + 2 * ((r & 1) ^ 1));
            if (r <= 4) { f32x4 q2[2] = {F4Z, F4Z};
                mm64_at(q2, Sr, Sr, rt, ch, fr, g, lane);
                st_tr(Sr2, q2, rt, ch, fr, g); }
            if (r >= 1) { LAS unsigned char* Pr = TILE(9 + ((r - 1) & 1)); LAS unsigned char* Pr2 = TILE(9 + (((r - 1) & 1) ^ 1));
                f32x4 pa[2]; ld_tr(pa, Pr, rt, ch, fr, g);
                mm64_at(pa, Sr, Pr, rt, ch, fr, g, lane);
                st_tr(Pr2, pa, rt, ch, fr, g); }
            if (r == 0) { f32x4 gg[2] = {F4Z, F4Z};
                mm64_bt(gg, TILE(4), TILE(3), rt, ch, fr, g, lane);
                st_tr(TILE(11), gg, rt, ch, fr, g); }
            lds_barrier();
        }
        {
            f32x4 acc[2] = {F4Z, F4Z}, ac2[2] = {F4Z, F4Z};
            mm64_bt(acc, TILE(10), TILE(0), rt, ch, fr, g, lane);
            mm64(ac2, TILE(10), TILE(11), rt, ch, fr, g);
            st_tr(TILE(5), acc, rt, ch, fr, g); st_tr(TILE(7), ac2, rt, ch, fr, g);
            f32x4 b2[2] = {F4Z, F4Z}, b3[2] = {F4Z, F4Z};
            mm64(b2, TILE(1), TILE(6), rt, ch, fr, g); mm64(b3, TILE(2), TILE(6), rt, ch, fr, g);
#pragma unroll
            for (int ct = 0; ct < 2; ++ct) { const int t = 32 * ch + 16 * ct + fr;
#pragma unroll
                for (int q = 0; q < 4; ++q) { const int s_ = 16 * rt + 4 * g + q; b2[ct][q] = s_ <= t ? b2[ct][q] : 0.f; b3[ct][q] = s_ <= t ? b3[ct][q] : 0.f; } }
            st_tr(TILE(4), b2, rt, ch, fr, g); st_tr(TILE(9), b3, rt, ch, fr, g);
        }
        lds_barrier();
        {
            const LAS float* WL = (const LAS float*)(lds + CS_WL);
            f32x4 acc[2] = {F4Z, F4Z};
            mm64_bt(acc, TILE(5), TILE(1), rt, ch, fr, g, lane);
            bf16* Mg = (bf16*)(ws + WS_B0) + chunk * 4096;
#pragma unroll
            for (int ct = 0; ct < 2; ++ct) { const int j1 = 32 * ch + 16 * ct + fr; const float wl = WL[j1];
#pragma unroll
                for (int q = 0; q < 4; ++q) { const int j2 = 16 * rt + 4 * g + q; acc[ct][q] = wl * (acc[ct][q] + (j2 == j1 ? 1.0f : 0.f)); }
                const int rtS = 2 * ch + ct, ksS = rt >> 1, half = rt & 1;
                *(GAS bf16x4s*)(Mg + (((rtS * 2 + ksS) * 64 + g * 16 + fr) * 8 + half * 4)) = pack4(acc[ct]); }
            f32x4 ad[2] = {F4Z, F4Z};
            mm64_at(ad, TILE(1), TILE(7), rt, ch, fr, g, lane);
            mm64_att(ad, TILE(2), TILE(3), rt, ch, lane);
            const f32x4 wl4 = *(const LAS f32x4*)(WL + 16 * rt + 4 * g);
            bf16* Dg = (bf16*)OUTP() + chunk * 4096;
#pragma unroll
            for (int ct = 0; ct < 2; ++ct) *(GAS bf16x4s*)(Dg + (((2 * ch + ct) * 4 + rt) * 64 + lane) * 4) = pack4(ad[ct] * wl4);
            const size_t row0_ = (size_t)b * SEQ + c * 64;
            f32x4 ar[2]; ld_tr(ar, TILE(6), rt, ch, fr, g);
            mm64(ar, TILE(5), TILE(4), rt, ch, fr, g);
            f32x4 ay[2] = {F4Z, F4Z};
            mm64(ay, TILE(7), TILE(4), rt, ch, fr, g); mm64_at(ay, TILE(3), TILE(9), rt, ch, fr, g, lane);
            bf16* Rg = (bf16*)(ws + WS_B1); bf16* Kg = (bf16*)(ws + WS_B2);
#pragma unroll
            for (int ct = 0; ct < 2; ++ct) { const size_t o_ = (row0_ + 32 * ch + 16 * ct + fr) * C + h * HD + 16 * rt + 4 * g; *(GAS bf16x4s*)(Rg + o_) = pack4(ar[ct]); *(GAS bf16x4s*)(Kg + o_) = pack4(ay[ct]); }
        }
        lds_barrier();
        { const int row_ = tid >> 3, cq_ = tid & 7; *(LAS v4u*)(TILE(6) + row_ * TPB + cq_ * 16) = w2keep; }
        lds_barrier();
    }
}

constexpr int S2_PD = 6;
__device__ __forceinline__ void scan_s2(unsigned char* ws, LAS unsigned char* lds, int lane, int wave) {
    for (int bh = blockIdx.x; bh < BATCH * NH; bh += gridDim.x) {
        const unsigned char* Mg = (const unsigned char*)((const bf16*)(ws + WS_B0) + (size_t)bh * 128 * 4096); const unsigned char* Dg = (const unsigned char*)((const bf16*)OUTP() + (size_t)bh * 128 * 4096);
        bf16* Sg = (bf16*)OUTP() + (size_t)M * C + (size_t)bh * 128 * 4096;
        if (wave >= 4) {
            const int lw = wave - 4;
            const unsigned char* src = (lw < 2 ? Mg + lw * 4096 : Dg + (lw - 2) * 4096) + lane * 16;
            LAS unsigned char* dst = lds + lw * 4096 + lane * 16;
            v4u q[S2_PD][4];
#define S2_LOADQ(j, c) do { _Pragma("unroll") for (int i_ = 0; i_ < 4; ++i_) q[j][i_] = *(const GAS v4u*)(src + (size_t)(c) * 8192 + i_ * 1024); } while (0)
#define S2_STOREQ(j, slot) do { _Pragma("unroll") for (int i_ = 0; i_ < 4; ++i_) *(LAS v4u*)(dst + (slot) * 16384 + i_ * 1024) = q[j][i_]; } while (0)
#pragma unroll
            for (int j = 0; j < S2_PD; ++j) S2_LOADQ(j, j);
            S2_STOREQ(0, 0); S2_LOADQ(0, S2_PD);
            lds_barrier();
#pragma unroll 1
            for (int s0 = 0; s0 < 128; s0 += S2_PD) {
#pragma unroll
                for (int jj = 0; jj < S2_PD; ++jj) { const int step = s0 + jj;
                    if (step + 1 < 128) S2_STOREQ((jj + 1) % S2_PD, (step + 1) & 1);
                    if (step + 1 + S2_PD < 128) S2_LOADQ((jj + 1) % S2_PD, step + 1 + S2_PD);
                    lds_barrier(); }
            }
#undef S2_LOADQ
#undef S2_STOREQ
        } else {
            const int ct = wave;
            f32x4 acc[4];
#pragma unroll
            for (int r = 0; r < 4; ++r) acc[r] = F4Z;
            lds_barrier();
#pragma unroll 1
            for (int s0 = 0; s0 < 128; s0 += S2_PD) {
#pragma unroll
                for (int jj = 0; jj < S2_PD; ++jj) { const int step = s0 + jj;
                    if (step < 128) {
                        const LAS unsigned char* slot = lds + (step & 1) * 16384;
                        bf16x8s sf[2];
#pragma unroll
                        for (int ks = 0; ks < 2; ++ks) { const bf16x4s lo = pack4(acc[2 * ks]), hi = pack4(acc[2 * ks + 1]); sf[ks] = (bf16x8s){lo[0], lo[1], lo[2], lo[3], hi[0], hi[1], hi[2], hi[3]}; }
#pragma unroll
                        for (int ks = 0; ks < 2; ++ks) *(GAS bf16x8s*)(Sg + (size_t)step * 4096 + ((ct * 2 + ks) * 64 + lane) * 8) = sf[ks];
                        f32x4 na[4];
#pragma unroll
                        for (int r = 0; r < 4; ++r) na[r] = unpack4(*(const LAS bf16x4s*)(slot + 8192 + ((ct * 4 + r) * 64 + lane) * 8));
#pragma unroll
                        for (int ks = 0; ks < 2; ++ks)
#pragma unroll
                            for (int r = 0; r < 4; ++r) na[r] = MFMA16(*(const LAS bf16x8s*)(slot + ((r * 2 + ks) * 64 + lane) * 16), sf[ks], na[r]);
#pragma unroll
                        for (int r = 0; r < 4; ++r) acc[r] = na[r];
                    }
                    lds_barrier(); }
            }
        }
    }
}

struct S3In { bf16x4s yh[2], rlo[2][2], rhi[2][2]; bf16x8s sA[2], gB[5][2]; v4u v; float rkb; };
__device__ __forceinline__ void s3_fetch(S3In& f, unsigned char* ws, int unit, int tid, int lane, int wave) {
    const int h = unit & 15, c = (unit >> 4) & 127, b = unit >> 11; const size_t chunk = ((size_t)b * NH + h) * 128 + c, row0 = (size_t)b * SEQ + c * 64;
    const int rt = wave & 3, ch = wave >> 2, fr = lane & 15, g = lane >> 4;
    const bf16* Rg = (const bf16*)(ws + WS_B1); const bf16* Kg = (const bf16*)(ws + WS_B2); const bf16* Vb = (const bf16*)(ws + WS_B3); const bf16* LG = (const bf16*)(ws + WS_LG);
    const bf16* Sg = (const bf16*)OUTP() + (size_t)M * C + chunk * 4096;
#pragma unroll
    for (int ct = 0; ct < 2; ++ct) { const size_t rowt = row0 + 32 * ch + 16 * ct + fr;
        f.yh[ct] = *(const GAS bf16x4s*)(Kg + rowt * C + h * HD + 16 * rt + 4 * g);
#pragma unroll
        for (int ks = 0; ks < 2; ++ks) { f.rlo[ks][ct] = *(const GAS bf16x4s*)(Rg + rowt * C + h * HD + 32 * ks + 4 * g); f.rhi[ks][ct] = *(const GAS bf16x4s*)(Rg + rowt * C + h * HD + 32 * ks + 16 + 4 * g); }
#pragma unroll
        for (int ks = 0; ks < 5; ++ks) f.gB[ks][ct] = *(const GAS bf16x8s*)(LG + rowt * DG + 32 * ks + 8 * g); }
#pragma unroll
    for (int ks = 0; ks < 2; ++ks) f.sA[ks] = *(const GAS bf16x8s*)(Sg + ((rt * 2 + ks) * 64 + lane) * 8);
    const int et = tid >> 3, ecq = tid & 7;
    f.v = *(const GAS v4u*)(Vb + (row0 + et) * C + h * HD + ecq * 8); f.rkb = ((const float*)(ws + WS_HID))[(row0 + et) * NH + h];
}
__device__ __forceinline__ void scan_s3(unsigned char* ws, LAS unsigned char* lds, int lane0, int wave) {
    const int rt = wave & 3, ch = wave >> 2;
    LAS float* Ys = (LAS float*)(lds + CS_FA);
    const bf16* G2T = (const bf16*)(ws + WS_WT_G2); bf16* YG = (bf16*)(ws + WS_B0);
    constexpr int NU = BATCH * NH * (SEQ / 64);
    S3In fin; bf16x8s gA[5]; f32x4 lnw0, lnw1, lnb0, lnb1;
    { int l0 = lane0; asm volatile("" : "+v"(l0)); const int hh = blockIdx.x & 15, t0_ = wave * 64 + l0;
      if ((int)blockIdx.x < NU) s3_fetch(fin, ws, blockIdx.x, t0_, l0, wave);
#pragma unroll
      for (int ks = 0; ks < 5; ++ks) gA[ks] = *(const GAS bf16x8s*)(G2T + (size_t)(hh * HD + 16 * rt + (l0 & 15)) * DG + 32 * ks + 8 * (l0 >> 4));
      const int ec0 = hh * HD + (t0_ & 7) * 8;
      lnw0 = *(const GAS f32x4*)(INP(18) + ec0); lnw1 = *(const GAS f32x4*)(INP(18) + ec0 + 4); lnb0 = *(const GAS f32x4*)(INP(19) + ec0); lnb1 = *(const GAS f32x4*)(INP(19) + ec0 + 4); }
    for (int unit = blockIdx.x; unit < NU; unit += gridDim.x) {
        int lane = lane0; asm volatile("" : "+v"(lane));
        const int tid = wave * 64 + lane, fr = lane & 15, g = lane >> 4;
        const int h = unit & 15, c = (unit >> 4) & 127, b = unit >> 11; const size_t row0 = (size_t)b * SEQ + c * 64;
        f32x4 acc[2], ag[2] = {F4Z, F4Z};
#pragma unroll
        for (int ct = 0; ct < 2; ++ct) { acc[ct] = unpack4(fin.yh[ct]);
#pragma unroll
            for (int ks = 0; ks < 2; ++ks) { const bf16x4s lo = fin.rlo[ks][ct], hi = fin.rhi[ks][ct]; acc[ct] = MFMA16(fin.sA[ks], ((bf16x8s){lo[0], lo[1], lo[2], lo[3], hi[0], hi[1], hi[2], hi[3]}), acc[ct]); }
#pragma unroll
            for (int ks = 0; ks < 5; ++ks) ag[ct] = MFMA16(gA[ks], fin.gB[ks][ct], ag[ct]); }
        float v8[8]; unpack8(fin.v, v8); const float rkb = fin.rkb;
        if (unit + (int)gridDim.x < NU) s3_fetch(fin, ws, unit + gridDim.x, tid, lane, wave);
#pragma unroll
        for (int ct = 0; ct < 2; ++ct) { const int t = 32 * ch + 16 * ct + fr; *(LAS f32x4*)(Ys + t * FP + 16 * rt + 4 * g) = acc[ct]; }
        lds_barrier();
        {
            const int et = tid >> 3, ecq = tid & 7;
            const f32x4 y0 = *(const LAS f32x4*)(Ys + et * FP + ecq * 8), y1 = *(const LAS f32x4*)(Ys + et * FP + ecq * 8 + 4);
            float y[8] = {y0[0], y0[1], y0[2], y0[3], y1[0], y1[1], y1[2], y1[3]};
            float s_ = 0.f;
#pragma unroll
            for (int q = 0; q < 8; ++q) s_ += y[q];
            s_ += shx(s_, 1, lane); s_ += shx(s_, 2, lane); s_ += shx(s_, 4, lane);
            const float mu = s_ * (1.0f / HD); float vs = 0.f;
#pragma unroll
            for (int q = 0; q < 8; ++q) { y[q] -= mu; vs += y[q] * y[q]; }
            vs += shx(vs, 1, lane); vs += shx(vs, 2, lane); vs += shx(vs, 4, lane);
            const float rstd = 1.0f / sqrtf(vs * (1.0f / HD) + GN_EPS);
            f32x4 o0, o1;
#pragma unroll
            for (int q = 0; q < 4; ++q) { o0[q] = y[q] * rstd * lnw0[q] + lnb0[q] + rkb * v8[q]; o1[q] = y[4 + q] * rstd * lnw1[q] + lnb1[q] + rkb * v8[4 + q]; }
            *(LAS f32x4*)(Ys + et * FP + ecq * 8) = o0; *(LAS f32x4*)(Ys + et * FP + ecq * 8 + 4) = o1;
        }
        lds_barrier();
#pragma unroll
        for (int ct = 0; ct < 2; ++ct) { const int t = 32 * ch + 16 * ct + fr; const f32x4 yv = *(const LAS f32x4*)(Ys + t * FP + 16 * rt + 4 * g);
            *(GAS bf16x4s*)(YG + (row0 + t) * C + h * HD + 16 * rt + 4 * g) = pack4(yv * ag[ct]); }
        lds_barrier();
    }
}
#undef TILE
#if MK_DEBUG
__device__ __forceinline__ void scan_naive(unsigned char* ws, LAS unsigned char* lds, int tid) {
    const int lane = tid & 63;
    const bf16* Rb = (const bf16*)(ws + WS_B1); const bf16* Kb = (const bf16*)(ws + WS_B2); const bf16* Vb = (const bf16*)(ws + WS_B3);
    const bf16* LW = (const bf16*)(ws + WS_LW); const bf16* LA = (const bf16*)(ws + WS_LA);
    float* Y = OUTP(); float* RK = (float*)(ws + WS_HID);
    LAS float* sR = (LAS float*)lds; LAS float* sK = sR + 4096; LAS float* sV = sK + 4096; LAS float* sA = sV + 4096; LAS float* sB = sA + 4096; LAS float* sD = sB + 4096;
    LAS float* sW2 = sD + 4096; LAS float* sA2 = sW2 + 4096;
    for (int unit = blockIdx.x; unit < BATCH * NH; unit += gridDim.x) {
        const int b = unit / NH, h = unit % NH;
        __syncthreads();
        for (int e = tid; e < 4096; e += 512) { const int d = e >> 6, j = e & 63; sW2[e] = INP(9)[(size_t)d * C + h * HD + j]; sA2[e] = INP(12)[(size_t)d * C + h * HD + j]; }
        __syncthreads();
        const int pt = tid >> 3, cq = tid & 7, c0 = h * HD + cq * 8;
        const int si = tid >> 3, jq = tid & 7;
        float S[8];
#pragma unroll
        for (int q = 0; q < 8; ++q) S[q] = 0.f;
        float w0v[8], a0v[8], kkv[8], kav[8], rkv[8];
#pragma unroll
        for (int q = 0; q < 8; ++q) { w0v[q] = INP(7)[c0 + q]; a0v[q] = INP(10)[c0 + q]; kkv[q] = INP(15)[c0 + q]; kav[q] = INP(16)[c0 + q]; rkv[q] = INP(17)[c0 + q]; }
        for (int blk = 0; blk < SEQ / 64; ++blk) {
            const size_t row = (size_t)b * SEQ + blk * 64 + pt;
            {
                const v4u r4 = *(const GAS v4u*)(Rb + row * C + c0), k4 = *(const GAS v4u*)(Kb + row * C + c0), v4 = *(const GAS v4u*)(Vb + row * C + c0);
                float r[8], k[8], v[8];
                r[0] = bflo(r4.x); r[1] = bfhi(r4.x); r[2] = bflo(r4.y); r[3] = bfhi(r4.y); r[4] = bflo(r4.z); r[5] = bfhi(r4.z); r[6] = bflo(r4.w); r[7] = bfhi(r4.w);
                k[0] = bflo(k4.x); k[1] = bfhi(k4.x); k[2] = bflo(k4.y); k[3] = bfhi(k4.y); k[4] = bflo(k4.z); k[5] = bfhi(k4.z); k[6] = bflo(k4.w); k[7] = bfhi(k4.w);
                v[0] = bflo(v4.x); v[1] = bfhi(v4.x); v[2] = bflo(v4.y); v[3] = bfhi(v4.y); v[4] = bflo(v4.z); v[5] = bfhi(v4.z); v[6] = bflo(v4.w); v[7] = bfhi(v4.w);
                float wp[8], ap[8];
#pragma unroll
                for (int q = 0; q < 8; ++q) { wp[q] = w0v[q]; ap[q] = a0v[q]; }
                for (int d = 0; d < 64; ++d) { const float lw = bf2f(LW[row * DW + d]), la = bf2f(LA[row * DA + d]);
#pragma unroll
                    for (int q = 0; q < 8; ++q) { wp[q] += lw * sW2[d * 64 + cq * 8 + q]; ap[q] += la * sA2[d * 64 + cq * 8 + q]; } }
                float kk[8], ss = 0.f, rks = 0.f;
#pragma unroll
                for (int q = 0; q < 8; ++q) { kk[q] = k[q] * kkv[q]; ss += kk[q] * kk[q]; }
                ss += shx(ss, 1, lane); ss += shx(ss, 2, lane); ss += shx(ss, 4, lane);
                const float inv = 1.0f / fmaxf(sqrtf(ss), 1e-12f);
#pragma unroll
                for (int q = 0; q < 8; ++q) { const float ag = sigmoidf_(ap[q]); const float kn = kk[q] * inv; const float kp = k[q] * (1.0f + (ag - 1.0f) * kav[q]);
                    const float lw = -0.6065306597126334f * sigmoidf_(wp[q]);
                    const int o = pt * 64 + cq * 8 + q;
                    sR[o] = r[q]; sK[o] = kp; sV[o] = v[q]; sA[o] = -kn; sB[o] = kn * ag; sD[o] = __expf(lw); rks += r[q] * kp * rkv[q]; }
                rks += shx(rks, 1, lane); rks += shx(rks, 2, lane); rks += shx(rks, 4, lane);
                if (cq == 0) RK[row * NH + h] = rks;
            }
            __syncthreads();
            for (int t = 0; t < 64; ++t) {
                const LAS f32x4* pa = (const LAS f32x4*)(sA + t * 64 + jq * 8); const LAS f32x4* pb = (const LAS f32x4*)(sB + t * 64 + jq * 8);
                const LAS f32x4* pd = (const LAS f32x4*)(sD + t * 64 + jq * 8); const LAS f32x4* pk = (const LAS f32x4*)(sK + t * 64 + jq * 8);
                const LAS f32x4* pr = (const LAS f32x4*)(sR + t * 64 + jq * 8);
                const f32x4 a0 = pa[0], a1 = pa[1], b0 = pb[0], b1 = pb[1], d0 = pd[0], d1 = pd[1], k0 = pk[0], k1 = pk[1], r0 = pr[0], r1 = pr[1];
                const float vi = sV[t * 64 + si];
                float sa = 0.f;
#pragma unroll
                for (int q = 0; q < 4; ++q) { sa += S[q] * a0[q]; sa += S[4 + q] * a1[q]; }
                sa += shx(sa, 1, lane); sa += shx(sa, 2, lane); sa += shx(sa, 4, lane);
                float y = 0.f;
#pragma unroll
                for (int q = 0; q < 4; ++q) { S[q] = S[q] * d0[q] + sa * b0[q] + vi * k0[q]; S[4 + q] = S[4 + q] * d1[q] + sa * b1[q] + vi * k1[q]; y += S[q] * r0[q]; y += S[4 + q] * r1[q]; }
                y += shx(y, 1, lane); y += shx(y, 2, lane); y += shx(y, 4, lane);
                if (jq == 0) Y[((size_t)b * SEQ + blk * 64 + t) * C + h * HD + si] = y;
            }
            __syncthreads();
        }
    }
}
__device__ __forceinline__ void post_scan(unsigned char* ws, int gw, int NGW, int lane) {
    const float* Y = OUTP(); const float* RK = (const float*)(ws + WS_HID); const bf16* Vb = (const bf16*)(ws + WS_B3); const bf16* LG = (const bf16*)(ws + WS_LG);
    bf16* YG = (bf16*)(ws + WS_B4); const float* g2 = INP(14); const float* lnw = INP(18); const float* lnb = INP(19);
    for (int it = gw; it < M * NH; it += NGW) {
        const int row = it / NH, h = it % NH, c = h * HD + lane;
        const float y = Y[(size_t)row * C + c];
        const float mu = wave_sum(y, lane) * (1.0f / HD); const float d = y - mu; const float var = wave_sum(d * d, lane) * (1.0f / HD);
        float o = d * (1.0f / sqrtf(var + GN_EPS)) * lnw[c] + lnb[c];
        o += RK[(size_t)row * NH + h] * bf2f(Vb[(size_t)row * C + c]);
        float g = 0.f;
        for (int dd = 0; dd < DG; ++dd) g += bf2f(LG[(size_t)row * DG + dd]) * g2[(size_t)dd * C + c];
        YG[(size_t)row * C + c] = (bf16)f2bf(o * g);
    }
}


constexpr int CW_DBG = 3200;
__device__ __forceinline__ void dbg_nonfinite(unsigned char* ws, const bf16* X, size_t n, int slot, int gw, int NGW, int lane, float thr = 1e30f) {
    unsigned* cw = (unsigned*)(ws + WS_CTL) + CW_DBG + 64 * slot; unsigned nnan = 0;
    for (size_t i = (size_t)gw * 64 + lane; i < n; i += (size_t)NGW * 64) { const float x = bf2f(X[i]); if (!(fabsf(x) < thr)) ++nnan; }
    if (nnan) atomicAdd(cw, nnan);
}
__device__ __forceinline__ void dbg_compare(unsigned char* ws, const bf16* X, const bf16* Y, int gw, int NGW, int lane) {
    unsigned* cw = (unsigned*)(ws + WS_CTL) + CW_DBG; unsigned nbad = 0, nnan = 0;
    for (size_t i = (size_t)gw * 64 + lane; i < (size_t)M * C; i += (size_t)NGW * 64) { const float x = bf2f(X[i]), y = bf2f(Y[i]);
        if (!(fabsf(x) < 1e30f)) ++nnan; else if (fabsf(x - y) > 0.05f * (fabsf(y) + 0.05f)) ++nbad; }
    if (nnan) atomicAdd(cw, nnan); if (nbad) atomicAdd(cw + 64, nbad);
}
#endif
__device__ __forceinline__ void router_rows(unsigned char* ws, LAS unsigned char* lds, int layer, int gw, int NGW, int lane, int tid, bool dry = false) {
    const float* Hh = OUTP(); const float* gain = INP(2) + layer * C; bf16* XN = (bf16*)(ws + WS_B1);
    const float* wg = INP(24) + (size_t)layer * C * 4; const float* bg = INP(25) + layer * 4; const float* wi = INP(26) + (size_t)layer * C * 16; const float* bi = INP(27) + layer * 16;
    unsigned* cnt = (unsigned*)(ws + WS_CTL) + CW_CNT + layer * 16 * 64; unsigned* list = (unsigned*)(ws + WS_LIST); float* wl = (float*)(ws + WS_WL);
    LAS float* sWg = (LAS float*)lds; LAS float* sWi = sWg + C * 4;
    constexpr int RECMAX = 256;
    LAS unsigned* lcnt = (LAS unsigned*)(lds + 81920); LAS unsigned* gbase = lcnt + 16; LAS int* nrec = (LAS int*)(lcnt + 32);
    LAS unsigned* recRow = lcnt + 64; LAS unsigned* recE = recRow + RECMAX; LAS unsigned* recL = recE + RECMAX; LAS float* recW0 = (LAS float*)(recL + RECMAX); LAS float* recW1 = recW0 + RECMAX;
    __syncthreads();
    for (int e = tid; e < C * 4; e += 512) sWg[e] = wg[e];
    for (int e = tid; e < C * 16; e += 512) sWi[e] = wi[e];
    if (tid < 33) lcnt[tid == 32 ? 32 : tid] = 0u;
    __syncthreads();
    f32x4 g[4]; load_row(gain, lane, g);
    for (int row = gw; row < M; row += NGW) {
        f32x4 v[4]; load_row(Hh + (size_t)row * C, lane, v); const float rs = row_rs(v, lane);
#pragma unroll
        for (int j = 0; j < 4; ++j) v[j] = v[j] * rs * g[j];
        store_row_bf16(XN + (size_t)row * C, lane, v);
        float gl[4] = {0.f, 0.f, 0.f, 0.f};
        const LAS unsigned char* pWg = (const LAS unsigned char*)sWg + lane * 64;
#pragma unroll
        for (int j = 0; j < 4; ++j)
#pragma unroll
            for (int q = 0; q < 4; ++q) { const f32x4 w = *(const LAS f32x4*)(pWg + j * 4096 + q * 16); const float xv = v[j][q]; gl[0] += xv * w.x; gl[1] += xv * w.y; gl[2] += xv * w.z; gl[3] += xv * w.w; }
#pragma unroll
        for (int q = 0; q < 4; ++q) gl[q] = wave_sum(gl[q], lane) + bg[q];
        int gi = 0; float gm = gl[0];
#pragma unroll
        for (int q = 1; q < 4; ++q) if (gl[q] > gm) { gm = gl[q]; gi = q; }
        float gden = 0.f;
#pragma unroll
        for (int q = 0; q < 4; ++q) gden += __expf(gl[q] - gm);
        const float gval = 1.0f / gden;
        float il[4] = {0.f, 0.f, 0.f, 0.f};
        const LAS unsigned char* pWi = (const LAS unsigned char*)sWi + lane * 256 + gi * 16;
#pragma unroll
        for (int j = 0; j < 4; ++j)
#pragma unroll
            for (int q = 0; q < 4; ++q) { const f32x4 w = *(const LAS f32x4*)(pWi + j * 16384 + q * 64); const float xv = v[j][q]; il[0] += xv * w.x; il[1] += xv * w.y; il[2] += xv * w.z; il[3] += xv * w.w; }
#pragma unroll
        for (int q = 0; q < 4; ++q) il[q] = wave_sum(il[q], lane) + bi[gi * 4 + q];
        int i0 = 0; float m0 = il[0];
#pragma unroll
        for (int q = 1; q < 4; ++q) if (il[q] > m0) { m0 = il[q]; i0 = q; }
        int i1 = -1; float m1 = -INFINITY;
#pragma unroll
        for (int q = 0; q < 4; ++q) if (q != i0 && il[q] > m1) { m1 = il[q]; i1 = q; }
        const float e1 = __expf(m1 - m0); const float w0 = gval / (1.0f + e1), w1 = gval * e1 / (1.0f + e1);
        if (lane == 0 && !dry) {
            const int ex0 = gi * 4 + i0, ex1 = gi * 4 + i1;
            const int ri = __hip_atomic_fetch_add(nrec, 1, __ATOMIC_RELAXED, __HIP_MEMORY_SCOPE_WORKGROUP);
            const unsigned l0 = __hip_atomic_fetch_add(lcnt + ex0, 1u, __ATOMIC_RELAXED, __HIP_MEMORY_SCOPE_WORKGROUP), l1 = __hip_atomic_fetch_add(lcnt + ex1, 1u, __ATOMIC_RELAXED, __HIP_MEMORY_SCOPE_WORKGROUP);
            if (ri < RECMAX) { recRow[ri] = (unsigned)row; recE[ri] = (unsigned)ex0 | ((unsigned)ex1 << 8); recL[ri] = l0 | (l1 << 16); recW0[ri] = w0; recW1[ri] = w1; }
        }
    }
    __syncthreads();
    if (tid < 16 && !dry) gbase[tid] = atomicAdd(cnt + tid * 64, lcnt[tid]);
    __syncthreads();
    { const int n = *nrec < RECMAX ? *nrec : RECMAX;
      for (int i = tid; i < n; i += 512) { const unsigned row = recRow[i], e = recE[i], l = recL[i]; const unsigned ex0 = e & 255u, ex1 = e >> 8;
          const unsigned p0 = gbase[ex0] + (l & 0xffffu), p1 = gbase[ex1] + (l >> 16);
          list[(size_t)ex0 * M + p0] = row * 2u; wl[(size_t)ex0 * M + p0] = recW0[i]; list[(size_t)ex1 * M + p1] = row * 2u + 1u; wl[(size_t)ex1 * M + p1] = recW1[i]; } }
}
__device__ __forceinline__ void moe_table(unsigned char* ws, volatile LAS int* tab, int layer, int tid) {
    __syncthreads();
    if (tid == 0) { const unsigned* cnt = (const unsigned*)(ws + WS_CTL) + CW_CNT + layer * 16 * 64; int t = 0;
#pragma unroll 1
        for (int e = 0; e < 16; ++e) { const int c = (int)__hip_atomic_load(cnt, RLX_AGENT); cnt += 64; tab[e] = c; tab[16 + e] = t; t += (c + 255) >> 8; tab[32 + e] = t; }
        tab[48] = t; }
    __syncthreads();
}
__device__ __forceinline__ void combine_rows(unsigned char* ws, int mode, int gw, int NGW, int lane, bool dry = false) {
    float* Hh = OUTP(); const bf16* E0 = (const bf16*)(ws + WS_B2); const bf16* E1 = (const bf16*)(ws + WS_B3); bf16* XN2 = (bf16*)(ws + WS_B0);
    f32x4 g[4]; load_row(INP(4), lane, g);
    for (int row = gw; row < M; row += NGW) {
        f32x4 v[4]; load_row(Hh + (size_t)row * C, lane, v);
#pragma unroll
        for (int j = 0; j < 4; ++j) { const v2u e0 = ((const GAS v2u*)(E0 + (size_t)row * C))[64 * j + lane], e1 = ((const GAS v2u*)(E1 + (size_t)row * C))[64 * j + lane];
            v[j].x += bflo(e0.x) + bflo(e1.x); v[j].y += bfhi(e0.x) + bfhi(e1.x); v[j].z += bflo(e0.y) + bflo(e1.y); v[j].w += bfhi(e0.y) + bfhi(e1.y); }
        const float rs = row_rs(v, lane);
        if (mode == 0) {
#pragma unroll
            for (int j = 0; j < 4; ++j) if (!dry) ((GAS f32x4*)(Hh + (size_t)row * C))[64 * j + lane] = v[j];
#pragma unroll
            for (int j = 0; j < 4; ++j) v[j] = v[j] * rs;
            store_row_bf16(XN2 + (size_t)row * C, lane, v);
        } else {
            float sig = 1.0f;
#if MK_DEBUG
            const unsigned* cw = (const unsigned*)(ws + WS_CTL) + CW_DBG; const unsigned nnan = __hip_atomic_load(cw, RLX_AGENT), nbad = __hip_atomic_load(cw + 64, RLX_AGENT);
            if (row < 512 && nnan > 0) sig = 2.0f;
            if (row >= 512 && row < 1536 && __hip_atomic_load(cw + 128, RLX_AGENT) > 0) sig = 2.0f;
            if (row >= 1536 && row < 3584 && __hip_atomic_load(cw + 192, RLX_AGENT) > 0) sig = 2.0f;
            if (row >= 3584 && row < 7680 && __hip_atomic_load(cw + 256, RLX_AGENT) > 0) sig = 2.0f;
            if (row >= 7680 && row < 15872 && __hip_atomic_load(cw + 320, RLX_AGENT) > 0) sig = 2.0f;
            if (row >= 15872 && nbad > (unsigned)(M / 100) * C) sig = 1.5f;
#endif
#pragma unroll
            for (int j = 0; j < 4; ++j) ((GAS f32x4*)(Hh + (size_t)row * C))[64 * j + lane] = v[j] * rs * g[j] * sig;
        }
    }
}
__device__ __forceinline__ void attn_naive(unsigned char* ws, int gw, int NGW, int lane) {
    const bf16* Kb = (const bf16*)(ws + WS_B1); const bf16* Vb = (const bf16*)(ws + WS_B2); const bf16* Qb = (const bf16*)(ws + WS_B3); bf16* Ob = (bf16*)(ws + WS_B0);
    for (int unit = gw; unit < BATCH * NH * (SEQ / 64); unit += NGW) {
        const int qb = unit % (SEQ / 64), bh = unit / (SEQ / 64), b = bh / NH, h = bh % NH;
        const int t0 = qb * 64, t = t0 + lane; const size_t rowq = (size_t)b * SEQ + t;
        float q[64], o[64];
#pragma unroll
        for (int c = 0; c < 8; ++c) { const v4u w = *(const GAS v4u*)(Qb + rowq * C + h * HD + c * 8);
            q[c * 8 + 0] = bflo(w.x) * 0.125f; q[c * 8 + 1] = bfhi(w.x) * 0.125f; q[c * 8 + 2] = bflo(w.y) * 0.125f; q[c * 8 + 3] = bfhi(w.y) * 0.125f;
            q[c * 8 + 4] = bflo(w.z) * 0.125f; q[c * 8 + 5] = bfhi(w.z) * 0.125f; q[c * 8 + 6] = bflo(w.w) * 0.125f; q[c * 8 + 7] = bfhi(w.w) * 0.125f; }
#pragma unroll
        for (int c = 0; c < 64; ++c) o[c] = 0.f;
        float suffix = 0.f;
        for (int s = t0 + 62; s >= 0; --s) {
            const bool valid = s < t;
            if (s < t0 && __all(suffix > SB_EXIT)) break;
            const bf16* kp = Kb + ((size_t)b * SEQ + s) * C + h * HD; const bf16* vp = Vb + ((size_t)b * SEQ + s) * C + h * HD;
            float z = 0.f;
#pragma unroll
            for (int c = 0; c < 8; ++c) { const v4u w = *(const GAS v4u*)(kp + c * 8);
                z += q[c * 8 + 0] * bflo(w.x) + q[c * 8 + 1] * bfhi(w.x) + q[c * 8 + 2] * bflo(w.y) + q[c * 8 + 3] * bfhi(w.y) + q[c * 8 + 4] * bflo(w.z) + q[c * 8 + 5] * bfhi(w.z) + q[c * 8 + 6] * bflo(w.w) + q[c * 8 + 7] * bfhi(w.w); }
            const float sp = fmaxf(z, 0.f) + log1pf(__expf(-fabsf(z)));
            const float att = valid ? __expf(z - sp - suffix) : 0.f;
            suffix += valid ? sp : 0.f;
#pragma unroll
            for (int c = 0; c < 8; ++c) { const v4u w = *(const GAS v4u*)(vp + c * 8);
                o[c * 8 + 0] += att * bflo(w.x); o[c * 8 + 1] += att * bfhi(w.x); o[c * 8 + 2] += att * bflo(w.y); o[c * 8 + 3] += att * bfhi(w.y);
                o[c * 8 + 4] += att * bflo(w.z); o[c * 8 + 5] += att * bfhi(w.z); o[c * 8 + 6] += att * bflo(w.w); o[c * 8 + 7] += att * bfhi(w.w); }
        }
#pragma unroll
        for (int c = 0; c < 8; ++c) { v4u w; w.x = pk2(o[c * 8 + 0], o[c * 8 + 1]); w.y = pk2(o[c * 8 + 2], o[c * 8 + 3]); w.z = pk2(o[c * 8 + 4], o[c * 8 + 5]); w.w = pk2(o[c * 8 + 6], o[c * 8 + 7]);
            *(GAS v4u*)(Ob + rowq * C + h * HD + c * 8) = w; }
    }
}


typedef float f32x16 __attribute__((ext_vector_type(16)));
constexpr int AT_VP = 192;
constexpr int AT_WAVE_LDS = 32 * AT_VP;
__device__ __forceinline__ int crow32(int reg, int hh) { return (reg & 3) + 8 * (reg >> 2) + 4 * hh; }
__device__ __forceinline__ bf16x8s pack_step(const f32x16& x, const int s) {
    v4u p; p.x = pg8::cvt_pk_bf16(x[8 * s], x[8 * s + 1]); p.y = pg8::cvt_pk_bf16(x[8 * s + 2], x[8 * s + 3]); p.z = pg8::cvt_pk_bf16(x[8 * s + 4], x[8 * s + 5]); p.w = pg8::cvt_pk_bf16(x[8 * s + 6], x[8 * s + 7]);
    return __builtin_bit_cast(bf16x8s, p);
}
__device__ __forceinline__ void attn_mfma(unsigned char* ws, LAS unsigned char* lds, int gw, int NGW, int lane, int wave) {
    const bf16* Kb = (const bf16*)(ws + WS_B1); const bf16* Vb = (const bf16*)(ws + WS_B2); const bf16* Qb = (const bf16*)(ws + WS_B3); bf16* Ob = (bf16*)(ws + WS_B0);
    LAS unsigned char* vl = lds + wave * AT_WAVE_LDS;
    const int r32 = lane & 31, hh = lane >> 5;
    bf16x8s tri[2];
#pragma unroll
    for (int s = 0; s < 2; ++s)
#pragma unroll
        for (int j = 0; j < 8; ++j) tri[s][j] = (16 * s + 8 * (j >> 2) + 4 * hh + (j & 3)) > r32 ? (short)0x3F80 : (short)0;
    const int grp = lane >> 4, tq = (lane & 15) >> 2, tp = lane & 3;
    const LAS unsigned char* vtr0 = vl + (4 * hh + tq) * AT_VP + (16 * (grp & 1) + 4 * tp) * 2;
    for (int unit = gw; unit < BATCH * NH * (SEQ / 32); unit += NGW) {
        const int qb = unit % (SEQ / 32), bh = unit / (SEQ / 32), b = bh / NH, hd = bh % NH;
        const int t0 = qb * 32; const size_t rowb = (size_t)b * SEQ;
        bf16x8s qf[4];
#pragma unroll
        for (int ks = 0; ks < 4; ++ks) qf[ks] = *(const GAS bf16x8s*)(Qb + (rowb + t0 + r32) * C + hd * HD + 16 * ks + 8 * hh);
        f32x16 o[2];
#pragma unroll
        for (int i = 0; i < 16; ++i) { o[0][i] = 0.f; o[1][i] = 0.f; }
        float carry = 0.f;
        for (int s0 = t0; s0 >= 0; s0 -= 32) {
            bf16x8s kf[4];
#pragma unroll
            for (int ks = 0; ks < 4; ++ks) kf[ks] = *(const GAS bf16x8s*)(Kb + (rowb + s0 + r32) * C + hd * HD + 16 * ks + 8 * hh);
            v4u vreg[4];
#pragma unroll
            for (int i = 0; i < 4; ++i) { const int cidx = lane + 64 * i; vreg[i] = *(const GAS v4u*)(Vb + (rowb + s0 + (cidx >> 3)) * C + hd * HD + (cidx & 7) * 8); }
            f32x16 st;
#pragma unroll
            for (int i = 0; i < 16; ++i) st[i] = 0.f;
#pragma unroll
            for (int ks = 0; ks < 4; ++ks) st = __builtin_amdgcn_mfma_f32_32x32x16_bf16(kf[ks], qf[ks], st, 0, 0, 0);
#pragma unroll
            for (int i = 0; i < 4; ++i) { const int cidx = lane + 64 * i; *(LAS v4u*)(vl + (cidx >> 3) * AT_VP + (cidx & 7) * 16) = vreg[i]; }
            f32x16 zz, uu; float tot = 0.f; const int tq_ = t0 + r32;
            if (s0 + 31 < t0) {
#pragma unroll
                for (int i = 0; i < 16; ++i) { const float z = st[i] * 0.18033688011112042f; const float sp = fmaxf(z, 0.f) + __builtin_amdgcn_logf(1.0f + __builtin_amdgcn_exp2f(-fabsf(z)));
                    zz[i] = z - sp; uu[i] = sp; tot += sp; }
            } else {
#pragma unroll
                for (int i = 0; i < 16; ++i) { const int key = s0 + crow32(i, hh); const float z = st[i] * 0.18033688011112042f; const float sp = fmaxf(z, 0.f) + __builtin_amdgcn_logf(1.0f + __builtin_amdgcn_exp2f(-fabsf(z)));
                    const bool valid = key < tq_; zz[i] = valid ? z - sp : -1e30f; uu[i] = valid ? sp : 0.f; tot += uu[i]; }
            }
            f32x16 w;
#pragma unroll
            for (int i = 0; i < 16; ++i) w[i] = 0.f;
#pragma unroll
            for (int s = 0; s < 2; ++s) w = __builtin_amdgcn_mfma_f32_32x32x16_bf16(tri[s], pack_step(uu, s), w, 0, 0, 0);
            f32x16 pp;
#pragma unroll
            for (int i = 0; i < 16; ++i) pp[i] = __builtin_amdgcn_exp2f(zz[i] - w[i] - carry);
            tot += shx(tot, 32, lane); carry += tot;
            asm volatile("s_waitcnt lgkmcnt(0)" ::: "memory");
#pragma unroll
            for (int s = 0; s < 2; ++s) { const bf16x8s pa = pack_step(pp, s);
#pragma unroll
                for (int dt = 0; dt < 2; ++dt) {
                    const v4i16_t lo = __builtin_amdgcn_ds_read_tr16_b64_v4i16((LAS v4i16_t*)(vtr0 + (16 * s) * AT_VP + dt * 64));
                    const v4i16_t hi = __builtin_amdgcn_ds_read_tr16_b64_v4i16((LAS v4i16_t*)(vtr0 + (16 * s + 8) * AT_VP + dt * 64));
                    const bf16x8s vf = (bf16x8s){lo[0], lo[1], lo[2], lo[3], hi[0], hi[1], hi[2], hi[3]};
                    o[dt] = __builtin_amdgcn_mfma_f32_32x32x16_bf16(pa, vf, o[dt], 0, 0, 0); } }
            asm volatile("" ::: "memory");
            if (s0 < t0 && __all(carry > SB_EXIT * 1.4426950408889634f)) break;
        }
#pragma unroll
        for (int dt = 0; dt < 2; ++dt)
#pragma unroll
            for (int i = 0; i < 16; ++i) Ob[(rowb + t0 + crow32(i, hh)) * C + hd * HD + 32 * dt + r32] = (bf16)f2bf(o[dt][i]);
    }
}
__global__ void __launch_bounds__(NWAVES * 64, 2) yoco_fwd(Args args) {
    extern __shared__ __attribute__((aligned(16))) unsigned char lds_raw[];
    LAS unsigned char* lds = (LAS unsigned char*)lds_raw;
    const int G = gridDim.x; const int bx = blockIdx.x;
    int wave = __builtin_amdgcn_readfirstlane(threadIdx.x >> 6); asm volatile("" : "+s"(wave));
#define IDS() int lane; asm volatile("v_mbcnt_lo_u32_b32 %0, -1, 0\n\tv_mbcnt_hi_u32_b32 %0, -1, %0" : "=v"(lane)); const int tid = wave * 64 + lane; (void)tid; \
    const int vcu = (G % 8 == 0) ? (bx % 8) * (G / 8) + bx / 8 : bx; const int gw = vcu * NWAVES + wave, NGW = G * NWAVES; (void)lane; (void)gw; (void)NGW;
    unsigned char* ws = WSP();
    volatile LAS unsigned* MISC = (volatile LAS unsigned*)(lds + MISC_OFF);
    volatile LAS int* tab = (volatile LAS int*)(lds + MOE_TAB_OFF);
    for (int u = threadIdx.x; u < (LDS_BYTES - LDSCTL_OFF) / 4; u += NWAVES * 64) ((LAS unsigned*)(lds + LDSCTL_OFF))[u] = 0u;
    __syncthreads();
    XcdBarrier bar; bar.bar = (unsigned*)(ws + WS_CTL) + CW_BAR; bar.x = 0; bar.st = nullptr;
    if (N_LAUNCHES == 1) bar = xcd_barrier_post((unsigned*)(ws + WS_CTL) + CW_BAR, MISC + 8);
    const int lo = KA_INT(0), hi = KA_INT(1);
#ifndef PROBE_PH
#define PROBE_PH -1
#endif
#define IN(k) (lo <= (k) && (k) < hi)
#define REP(k) for (int rep_ = 0; rep_ < ((PROBE_PH == (k)) ? 2 : 1); ++rep_)
#define SEAM(k) do { if (IN(k) && IN((k) + 1)) xcd_barrier(bar); } while (0)

    if (IN(PH_P0)) REP(PH_P0) { IDS(); p0_weights<0>(ws, lds, gw, NGW, wave, lane); p0_weights<1>(ws, lds, gw, NGW, wave, lane); p0_rows(ws, gw, NGW, lane); }
    SEAM(PH_P0);
    if (PROBE_PH == 100 && N_LAUNCHES == 1) { for (int i_ = 0; i_ < 10; ++i_) xcd_barrier(bar); }
    if (IN(PH_LORA)) REP(PH_LORA) {
        SchedGrouped<1, 3> S{(const char*)(ws + WS_B1), (size_t)(WS_B2 - WS_B1), nullptr, (const char*)(ws + WS_WT_LORA), (size_t)256 * C * 2, G, bx};
        EpiLora E{(bf16*)(ws + WS_LW)};
        pg8::gemm_phase<EpiLora, SchedGrouped<1, 3>, true, false, C>(lds, S, E, wave);
    }
    SEAM(PH_LORA);
    if (IN(PH_RKV)) REP(PH_RKV) {
        SchedGrouped<4, 3> S{(const char*)OUTP(), (size_t)M * C * 2, (const char*)(ws + WS_B4), (const char*)(ws + WS_WT_RKV), (size_t)C * C * 2, G, bx};
        EpiSplit3 E{(bf16*)(ws + WS_B1), false};
        pg8::gemm_phase<EpiSplit3, SchedGrouped<4, 3>, true, false, C>(lds, S, E, wave);
    }
    SEAM(PH_RKV);
    if (IN(PH_S1)) REP(PH_S1) { IDS(); scan_s1(ws, lds, lane, wave); }
    SEAM(PH_S1);
    if (IN(PH_S2)) REP(PH_S2) { IDS();
        if (bx < BATCH * NH || G <= BATCH * NH) scan_s2(ws, lds, lane, wave);
        }
    SEAM(PH_S2);
    if (IN(PH_S3)) REP(PH_S3) { IDS(); scan_s3(ws, lds, lane, wave); }
    SEAM(PH_S3);
#if MK_DEBUG
    if (IN(PH_DBG0)) { IDS(); scan_naive(ws, lds, tid); }
    SEAM(PH_DBG0);
    if (IN(PH_DBG0 + 1)) { IDS(); post_scan(ws, gw, NGW, lane); }
    SEAM(PH_DBG0 + 1);
    if (IN(PH_DBG0 + 2)) { IDS(); dbg_compare(ws, (const bf16*)(ws + WS_B0), (const bf16*)(ws + WS_B4), gw, NGW, lane); }
    SEAM(PH_DBG0 + 2);
#endif
    if (IN(PH_WOUT)) REP(PH_WOUT) {
        SchedGrouped<4, 1> S{(const char*)(ws + ((MK_DEBUG && DBG_USE_NAIVE) ? WS_B4 : WS_B0)), 0, nullptr, (const char*)(ws + WS_WT_OUT), 0, G, bx};
        EpiResid E{INP(0), OUTP()};
        pg8::gemm_phase<EpiResid, SchedGrouped<4, 1>, true, false, C>(lds, S, E, wave);
    }
    SEAM(PH_WOUT);
#pragma unroll 1
    for (int layer = 0; layer < 2; ++layer) {
        const int pb = layer == 0 ? (int)PH_ROUT0 : (int)PH_ROUT1;
        if (IN(pb)) { IDS(); if (PROBE_PH == 101 && layer == 0) router_rows(ws, lds, layer, gw, NGW, lane, tid, true); router_rows(ws, lds, layer, gw, NGW, lane, tid); }
        SEAM(pb);
        if (IN(pb + 1)) REP(pb + 1) {
            { IDS(); moe_table(ws, tab, layer, tid); }
            SchedMoe<2, C, true> S{(const char*)(ws + WS_B1), (const char*)(ws + WS_WT_GU) + (size_t)layer * 16 * 512 * C * 2, (size_t)512 * C * 2, (const unsigned*)(ws + WS_LIST), tab, G, bx};
            EpiGU E{(bf16*)(ws + WS_HID), (const float*)(ws + WS_WL)};
            pg8::gemm_phase<EpiGU, SchedMoe<2, C, true>, true, true, C>(lds, S, E, wave);
        }
        SEAM(pb + 1);
        if (IN(pb + 2)) REP(pb + 2) {
            { IDS(); moe_table(ws, tab, layer, tid); }
            SchedMoe<4, FE, false> S{(const char*)(ws + WS_HID), (const char*)(ws + WS_WT_DN) + (size_t)layer * 16 * C * FE * 2, (size_t)C * FE * 2, (const unsigned*)(ws + WS_LIST), tab, G, bx};
            EpiDown E{(bf16*)(ws + WS_B2), (const unsigned*)(ws + WS_LIST)};
            pg8::gemm_phase<EpiDown, SchedMoe<4, FE, false>, true, false, FE>(lds, S, E, wave);
        }
        SEAM(pb + 2);
        if (layer == 0) {
            if (IN(PH_COMB)) { IDS(); if (PROBE_PH == 102) combine_rows(ws, 0, gw, NGW, lane, true); combine_rows(ws, 0, gw, NGW, lane); }
            SEAM(PH_COMB);
            if (IN(PH_KVQ)) REP(PH_KVQ) {
                SchedGrouped<12, 1> S{(const char*)(ws + WS_B0), 0, nullptr, (const char*)(ws + WS_WT_KVQ), 0, G, bx};
                EpiSplit3 E{(bf16*)(ws + WS_B1), true};
                pg8::gemm_phase<EpiSplit3, SchedGrouped<12, 1>, true, false, C>(lds, S, E, wave);
            }
            SEAM(PH_KVQ);
            if (IN(PH_ATTN)) REP(PH_ATTN) { IDS(); attn_mfma(ws, lds, gw, NGW, lane, wave); }
            SEAM(PH_ATTN);
            if (IN(PH_SBO)) {
                SchedGrouped<4, 1> S{(const char*)(ws + WS_B0), 0, nullptr, (const char*)(ws + WS_WT_SBO), 0, G, bx};
                EpiResid E{OUTP(), OUTP()};
                pg8::gemm_phase<EpiResid, SchedGrouped<4, 1>, true, false, C>(lds, S, E, wave);
            }
            SEAM(PH_SBO);
        }
    }
    if (IN(PH_FINAL)) { IDS(); combine_rows(ws, 1, gw, NGW, lane); }
#undef IN
#undef SEAM
}

extern "C" void kernel_launch(void* const* d_in, const int* in_sizes, int n_in, void* d_out, int out_size, void* d_ws, size_t ws_size, hipStream_t stream) {
    static int grid = 0;
    if (grid == 0) {
        if (n_in != 31 || in_sizes[0] != M * C || out_size != M * C || ws_size < WS_END) { fprintf(stderr, "kernel_launch: unexpected shapes (n_in %d, in0 %d, out %d, ws %zu); nothing launched\n", n_in, n_in > 0 ? in_sizes[0] : -1, out_size, ws_size); grid = -1; return; }
        int dev = 0, cus = 0, per_cu = 0;
        if (hipGetDevice(&dev) != hipSuccess || hipDeviceGetAttribute(&cus, hipDeviceAttributeMultiprocessorCount, dev) != hipSuccess) { grid = -1; return; }
        if (hipFuncSetAttribute((const void*)yoco_fwd, hipFuncAttributeMaxDynamicSharedMemorySize, LDS_BYTES) != hipSuccess) { fprintf(stderr, "kernel_launch: hipFuncSetAttribute failed\n"); grid = -1; return; }
        if (hipOccupancyMaxActiveBlocksPerMultiprocessor(&per_cu, (const void*)yoco_fwd, NWAVES * 64, LDS_BYTES) != hipSuccess || per_cu < 1) fprintf(stderr, "kernel_launch: occupancy query reports %d\n", per_cu);
        (void)hipGetLastError();
        grid = cus - (cus % 16);
    }
    if (grid < 0) return;
    if (hipMemsetAsync((char*)d_ws + WS_CTL, 0, CTL_ZERO_BYTES, stream) != hipSuccess) return;
    Args a{};
    for (int i = 0; i < 31; ++i) a.in[i] = (const float*)d_in[i];
    a.out = (float*)d_out; a.ws = (unsigned char*)d_ws;
    for (int li = 0; li < (N_LAUNCHES == 1 ? 1 : (int)NPHASE); ++li) {
        a.ph_lo = (N_LAUNCHES == 1) ? 0 : li; a.ph_hi = (N_LAUNCHES == 1) ? NPHASE : li + 1; a.li = li;
        hipLaunchKernelGGL(yoco_fwd, dim3(grid), dim3(NWAVES * 64), LDS_BYTES, stream, a);
        const hipError_t le = hipPeekAtLastError();
        if (le != hipSuccess) { fprintf(stderr, "kernel_launch: launch %d failed: %s\n", li, hipGetErrorName(le)); break; }
    }
}
```

```cpp
#include <hip/hip_runtime.h>
#include <cstdio>
#include <cstdint>

#ifndef MK_N_LAUNCHES
#define MK_N_LAUNCHES 1
#endif

namespace pg8 {
#define PG8_LAS __attribute__((address_space(3)))
typedef unsigned short bf16_t;
typedef short bf16x8 __attribute__((ext_vector_type(8)));
typedef float f32x4 __attribute__((ext_vector_type(4)));
typedef unsigned u32x4 __attribute__((ext_vector_type(4)));
constexpr int BM = 256, BK = 64, HALF = 128, HTB = HALF * BK * 2, STAGE_BYTES = 8 * HTB, NXCD = 8, WGM = 8;

__host__ __device__ __forceinline__ int lds_byte(int r, int c) { const int st = (r >> 4) * 2 + (c >> 5), rr = r & 15, cc = c & 31, ob = rr * 64 + cc * 2; return st * 1024 + (ob ^ (((ob >> 9) & 1) << 5)); }
__host__ __device__ __forceinline__ void stage_rc(int b, int& R, int& C) { const int st = b / 1024, sb = b % 1024, swz = sb ^ (((sb >> 9) & 1) << 5); R = (st >> 1) * 16 + swz / 64; C = (st & 1) * 32 + (swz % 64) / 2; }
__host__ __device__ __forceinline__ int perm32(int rho) { const int n = rho >> 4, i = rho & 15; return 8 * (i >> 2) + 4 * n + (i & 3); }

struct Unit { int pm, pn, aux, r0, cnt; };

__host__ __device__ __forceinline__ void tile_map(int wgid, int nM, int nN, int& pm, int& pn) {
    const int nwg = nM * nN;
    { const int q = nwg / NXCD, r = nwg % NXCD, xcd = wgid % NXCD, off = wgid / NXCD; wgid = (xcd < r ? xcd * (q + 1) : r * (q + 1) + (xcd - r) * q) + off; }
    const int nig = WGM * nN, gid = wgid / nig, fm = gid * WGM, gsz = (nM - fm) < WGM ? (nM - fm) : WGM;
    pm = fm + ((wgid % nig) % gsz); pn = (wgid % nig) / gsz;
}

typedef float f32x2_t __attribute__((ext_vector_type(2))); typedef __bf16 bf16x2_t __attribute__((ext_vector_type(2)));
__device__ __forceinline__ unsigned cvt_pk_bf16(float lo, float hi) { const f32x2_t v = {lo, hi}; const bf16x2_t b = __builtin_convertvector(v, bf16x2_t); return __builtin_bit_cast(unsigned, b); }

template <class Epi, class Sched, bool ALIGN_EPI, bool GATHER, int K>
__device__ __forceinline__ void gemm_phase(PG8_LAS unsigned char* lds, const Sched& S, const Epi& E, const int wid) {
    int lane_; asm volatile("v_mbcnt_lo_u32_b32 %0, -1, 0\n\tv_mbcnt_hi_u32_b32 %0, -1, %0" : "=v"(lane_));
    const int lane = lane_, tid = wid * 64 + lane, wr = wid >> 2, wc = wid & 3, fr = lane & 15, fq = lane >> 4;
    constexpr int nt = K / BK;
    unsigned voffA[2], voffB[2];
#pragma unroll
    for (int i = 0; i < 2; ++i) { int R, C; stage_rc(tid * 16 + i * 8192, R, C); const int Rb = Epi::PERM ? ((R & ~31) + perm32(R & 31)) : R;
        voffA[i] = (unsigned)(R * K + C) * 2u; voffB[i] = (unsigned)(Rb * K + C) * 2u; }
    constexpr size_t kstep = (size_t)(BK * 2);
    constexpr size_t hstep = (size_t)HALF * K * 2;
    const unsigned ldsw = (unsigned)wid * 1024u;
    const int aoff = lds_byte(wr * 64 + fr, fq * 8), boff = lds_byte(wc * 32 + fr, fq * 8);
#define PG8_SA(b, h) (((b) * 2 + (h)) * HTB)
#define PG8_SB(b, h) ((4 + (b) * 2 + (h)) * HTB)
#define PG8_STAGE(bufoff, gbase, voff) do { _Pragma("unroll") for (int _i = 0; _i < 2; ++_i) \
        __builtin_amdgcn_global_load_lds((const unsigned*)((const char*)(gbase) + (voff)[_i]), (PG8_LAS unsigned*)(lds + (bufoff) + ldsw + _i * 8192), 16, 0, 0); } while (0)
#define PG8_LDA(dst, b, h) do { _Pragma("unroll") for (int m = 0; m < 4; ++m) _Pragma("unroll") for (int k = 0; k < 2; ++k) dst[m][k] = *(const PG8_LAS bf16x8*)(lds + PG8_SA(b, h) + aoff + m * 2048 + k * 1024); } while (0)
#define PG8_LDB(dst, b, h) do { _Pragma("unroll") for (int n = 0; n < 2; ++n) _Pragma("unroll") for (int k = 0; k < 2; ++k) dst[n][k] = *(const PG8_LAS bf16x8*)(lds + PG8_SB(b, h) + boff + n * 2048 + k * 1024); } while (0)
#define PG8_MMA(ai, bj, At, Bt) do { __builtin_amdgcn_s_setprio(1); _Pragma("unroll") for (int m = 0; m < 4; ++m) _Pragma("unroll") for (int n = 0; n < 2; ++n) _Pragma("unroll") for (int k = 0; k < 2; ++k) \
        acc[ai][bj][m][n] = __builtin_amdgcn_mfma_f32_16x16x32_bf16(Bt[n][k], At[m][k], acc[ai][bj][m][n], 0, 0, 0); __builtin_amdgcn_s_setprio(0); } while (0)
#define PG8_WAIT_V(n) asm volatile("s_waitcnt vmcnt(" #n ")" ::: "memory")
#define PG8_WAIT_L(n) asm volatile("s_waitcnt lgkmcnt(" #n ")" ::: "memory")
#define PG8_BAR __builtin_amdgcn_s_barrier()
#define PG8_SCHED __builtin_amdgcn_sched_barrier(0)
    Unit cur, nxt; int ui = 0;
    if (!S.next(0, cur)) return;
    f32x4 acc[2][2][4][2];
#pragma unroll
    for (int a = 0; a < 2; ++a)
#pragma unroll
        for (int b = 0; b < 2; ++b)
#pragma unroll
            for (int m = 0; m < 4; ++m)
#pragma unroll
                for (int n = 0; n < 2; ++n) acc[a][b][m][n] = (f32x4){0.f, 0.f, 0.f, 0.f};
    bf16x8 At[4][2], B0[2][2], B1[2][2];
    unsigned vc[2][2];
#define PG8_GOFF(u) do { _Pragma("unroll") for (int _h = 0; _h < 2; ++_h) _Pragma("unroll") for (int _i = 0; _i < 2; ++_i) { int _R, _C; stage_rc(tid * 16 + _i * 8192, _R, _C); \
        vc[_h][_i] = S.a_row_off(u, _h * HALF + _R) + (unsigned)_C * 2u; } } while (0)
#define PG8_STAGE_A(bufoff, gbase, h) do { if constexpr (GATHER) { PG8_STAGE(bufoff, gbase, vc[h]); } else { PG8_STAGE(bufoff, (gbase) + (h) * hstep, voffA); } } while (0)
    if constexpr (GATHER) PG8_GOFF(cur);
    const char* cA = S.a_base(cur); const char* cB = S.b_base(cur);
    PG8_STAGE(PG8_SB(0, 0), cB, voffB); PG8_STAGE(PG8_SB(0, 1), cB + hstep, voffB); PG8_STAGE_A(PG8_SA(0, 0), cA, 0); PG8_STAGE_A(PG8_SA(0, 1), cA, 1);
    if (wr == 1) PG8_BAR;
    PG8_WAIT_V(2); PG8_BAR;
    PG8_STAGE(PG8_SB(1, 0), cB + kstep, voffB); PG8_STAGE_A(PG8_SA(1, 0), cA + kstep, 0); PG8_STAGE(PG8_SB(1, 1), cB + hstep + kstep, voffB);
    PG8_WAIT_V(6); PG8_BAR;
    for (;;) {
        const bool has_next = S.next(ui + 1, nxt);
        const char* nA = has_next ? S.a_base(nxt) : cA; const char* nB = has_next ? S.b_base(nxt) : cB;
        for (int t = 0; t < nt; t += 2) {
            const bool last = (t == nt - 2);
            const char* a1 = cA + (size_t)(t + 1) * kstep;
            const char* a2 = last ? nA : cA + (size_t)(t + 2) * kstep; const char* b2 = last ? nB : cB + (size_t)(t + 2) * kstep;
            const char* a3 = a2 + kstep; const char* b3 = b2 + kstep;
            PG8_LDB(B0, 0, 0); PG8_LDB(B1, 0, 1); PG8_SCHED; PG8_LDA(At, 0, 0); PG8_STAGE_A(PG8_SA(1, 1), a1, 1);
            if constexpr (GATHER) { if (last && has_next) PG8_GOFF(nxt); }
            PG8_WAIT_V(8); PG8_WAIT_L(0); PG8_BAR; PG8_MMA(0, 0, At, B0); PG8_MMA(0, 1, At, B1); PG8_BAR; PG8_SCHED;
            PG8_LDA(At, 0, 1); PG8_STAGE(PG8_SB(0, 0), b2, voffB); PG8_STAGE(PG8_SB(0, 1), b2 + hstep, voffB); PG8_STAGE_A(PG8_SA(0, 0), a2, 0);
            PG8_WAIT_V(8); PG8_WAIT_L(0); PG8_BAR; PG8_MMA(1, 0, At, B0); PG8_MMA(1, 1, At, B1); PG8_BAR; PG8_SCHED;
            PG8_LDB(B0, 1, 0); PG8_LDB(B1, 1, 1); PG8_SCHED; PG8_LDA(At, 1, 0); PG8_STAGE_A(PG8_SA(0, 1), a2, 1);
            PG8_WAIT_V(8); PG8_WAIT_L(0); PG8_BAR; PG8_MMA(0, 0, At, B0); PG8_MMA(0, 1, At, B1); PG8_BAR; PG8_SCHED;
            PG8_LDA(At, 1, 1); PG8_STAGE(PG8_SB(1, 0), b3, voffB); PG8_STAGE(PG8_SB(1, 1), b3 + hstep, voffB); PG8_STAGE_A(PG8_SA(1, 0), a3, 0);
            PG8_WAIT_V(8); PG8_WAIT_L(0); PG8_BAR; PG8_MMA(1, 0, At, B0); PG8_MMA(1, 1, At, B1); PG8_BAR; PG8_SCHED;
        }
        if constexpr (ALIGN_EPI) { if (wr == 0) PG8_BAR; }
        E(acc, cur, wr, wc, fr, fq);
        if (!has_next) break;
#pragma unroll
        for (int a = 0; a < 2; ++a)
#pragma unroll
            for (int b = 0; b < 2; ++b)
#pragma unroll
                for (int m = 0; m < 4; ++m)
#pragma unroll
                    for (int n = 0; n < 2; ++n) acc[a][b][m][n] = (f32x4){0.f, 0.f, 0.f, 0.f};
        cur = nxt; cA = nA; cB = nB; ++ui;
        if constexpr (ALIGN_EPI) { if (wr == 1) PG8_BAR; }
    }
    PG8_WAIT_V(0);
    if constexpr (!ALIGN_EPI) { if (wr == 0) PG8_BAR; }
    PG8_BAR;
#undef PG8_SA
#undef PG8_SB
#undef PG8_STAGE
#undef PG8_STAGE_A
#undef PG8_GOFF
#undef PG8_LDA
#undef PG8_LDB
#undef PG8_MMA
#undef PG8_WAIT_V
#undef PG8_WAIT_L
#undef PG8_BAR
#undef PG8_SCHED
}
}

constexpr int NWAVES = 8;
#ifndef MK_DEBUG
#define MK_DEBUG 0
#endif
#ifndef DBG_USE_NAIVE
#define DBG_USE_NAIVE 0
#endif
constexpr int DBGP = MK_DEBUG ? 3 : 0;
enum Phase { PH_P0 = 0, PH_LORA, PH_RKV, PH_S1, PH_S2, PH_S3, PH_DBG0, PH_WOUT = PH_DBG0 + DBGP, PH_ROUT0, PH_GU0, PH_DN0, PH_COMB, PH_KVQ, PH_ATTN, PH_SBO, PH_ROUT1, PH_GU1, PH_DN1, PH_FINAL, NPHASE };
constexpr int N_LAUNCHES = MK_N_LAUNCHES;


constexpr int BATCH = 2, SEQ = 8192, C = 1024, NH = 16, HD = 64, M = BATCH * SEQ;
constexpr int NE = 16, FE = 256, DW = 64, DA = 64, DG = 160;
constexpr float RMS_EPS = 1e-6f, GN_EPS = 64e-5f;
constexpr float SB_EXIT = 104.0f;

constexpr size_t MiB = 1u << 20;
constexpr size_t WS_CTL = 0, CTL_ZERO_BYTES = 64 * 1024;
constexpr size_t WS_WT_W2 = 128 * 1024, WS_WT_A2 = 256 * 1024, WS_WT_G2 = 384 * 1024;
constexpr size_t WS_WT_RKV = 1 * MiB;
constexpr size_t WS_WT_LORA = 7 * MiB;
constexpr size_t WS_WT_OUT = 9 * MiB;
constexpr size_t WS_WT_KVQ = 11 * MiB;
constexpr size_t WS_WT_SBO = 17 * MiB;
constexpr size_t WS_WT_GU = 19 * MiB;
constexpr size_t WS_WT_DN = 51 * MiB;
constexpr size_t WS_LW = 67 * MiB;
constexpr size_t WS_LA = 69 * MiB;
constexpr size_t WS_LG = 71 * MiB;
static_assert(WS_LA == WS_LW + 2 * MiB && WS_LG == WS_LW + 4 * MiB, "EpiLora's pointer arithmetic");
constexpr size_t WS_LIST = 76 * MiB;
constexpr size_t WS_WL = 77 * MiB;
constexpr size_t WS_HID = 78 * MiB;
constexpr size_t WS_B0 = 96 * MiB, WS_B1 = 128 * MiB, WS_B2 = 160 * MiB, WS_B3 = 192 * MiB, WS_B4 = 224 * MiB, WS_END = 256 * MiB;
static_assert(WS_HID + (size_t)144 * 256 * 256 * 2 <= WS_B0, "HID vs B0");
constexpr int CW_TMO = 0;
constexpr int CW_CNT = 1024;
constexpr int CW_BAR = 4096;

constexpr int RING_BYTES = 131072;
constexpr int LDSCTL_OFF = 146688, MISC_OFF = LDSCTL_OFF + 320, MOE_TAB_OFF = MISC_OFF + 128;
constexpr int LDS_BYTES = 147456;
static_assert(MOE_TAB_OFF + 256 <= LDS_BYTES, "LDS map");
static_assert(BATCH * NH * (SEQ / 64) % 16 == 0, "scan units");

#define GAS __attribute__((address_space(1)))
#define LAS __attribute__((address_space(3)))
typedef unsigned short bf16;
typedef unsigned v4u __attribute__((ext_vector_type(4)));
typedef unsigned v2u __attribute__((ext_vector_type(2)));
typedef float f32x4 __attribute__((ext_vector_type(4)));
typedef GAS unsigned gu32;
#define RLX_AGENT __ATOMIC_RELAXED, __HIP_MEMORY_SCOPE_AGENT
#define LDS_WAIT() asm volatile("s_waitcnt lgkmcnt(0)" ::: "memory")
#define VM_WAIT() asm volatile("s_waitcnt vmcnt(0)" ::: "memory")
__device__ __forceinline__ unsigned f2bf(float f) { unsigned u = __builtin_bit_cast(unsigned, f); return (u + 0x7fffu + ((u >> 16) & 1u)) >> 16; }
__device__ __forceinline__ unsigned pk2(float lo, float hi) { return f2bf(lo) | (f2bf(hi) << 16); }
__device__ __forceinline__ float bflo(unsigned u) { return __uint_as_float(u << 16); }
__device__ __forceinline__ float bfhi(unsigned u) { return __uint_as_float(u & 0xffff0000u); }
__device__ __forceinline__ float bf2f(bf16 b) { return __uint_as_float((unsigned)b << 16); }
__device__ __forceinline__ float sigmoidf_(float x) { return 1.0f / (1.0f + __expf(-x)); }

#define XB_TMO      128
#define XB_XCNT(j)  (256  + 64 * (j))
#define XB_XSUB(j)  (1280 + 64 * (j))
#define XB_XGEN(j)  (2304 + 64 * (j))
#define XB_TOP      3328
#define XB_TOPGEN   3392
#define XCD_BAR_WORDS 3456
#define XB_SPIN_CAP (1u << 18)
__device__ __forceinline__ unsigned xb_ld(unsigned* p)              { return __hip_atomic_load(p, __ATOMIC_RELAXED, __HIP_MEMORY_SCOPE_AGENT); }
__device__ __forceinline__ unsigned xb_add(unsigned* p, unsigned v) { return __hip_atomic_fetch_add(p, v, __ATOMIC_RELAXED, __HIP_MEMORY_SCOPE_AGENT); }
__device__ __forceinline__ unsigned xb_xcc_id() { return (unsigned)__builtin_amdgcn_s_getreg((3 << 11) | 20) & 0xFu; }
#define XB_SPIN(cond, bar) do { unsigned _sp = 0; while (cond) { __builtin_amdgcn_s_sleep(1); \
    if ((++_sp & 255u) == 0u) { if (xb_ld(&(bar)[XB_TMO])) break; if (_sp > XB_SPIN_CAP) { atomicAdd(&(bar)[XB_TMO], 1u); break; } } } } while (0)
struct XcdBarrier { unsigned* bar; unsigned x; volatile LAS unsigned* st; };
__device__ __forceinline__ XcdBarrier xcd_barrier_post(unsigned* bar, volatile LAS unsigned* st) {
    XcdBarrier b; b.bar = bar; b.x = xb_xcc_id(); b.st = st;
    if (threadIdx.x == 0) (void)xb_add(&bar[XB_XCNT(b.x)], 1u);
    return b;
}
__device__ __forceinline__ void xcd_barrier_complete(unsigned* bar, unsigned x, unsigned& nloc, unsigned& nx) {
    const unsigned G = gridDim.x * gridDim.y * gridDim.z;
    unsigned sum, cnt, mine, sp = 0u;
    for (;;) {
        sum = 0u; cnt = 0u; mine = 0u;
#pragma unroll
        for (unsigned j = 0; j < 16; ++j) { const unsigned c = xb_ld(&bar[XB_XCNT(j)]); sum += c; cnt += (c > 0u) ? 1u : 0u; mine = (j == x) ? c : mine; }
        if (sum == G) break;
        __builtin_amdgcn_s_sleep(1);
        if ((++sp & 255u) == 0u) { if (xb_ld(&bar[XB_TMO])) break; if (sp > XB_SPIN_CAP) { atomicAdd(&bar[XB_TMO], 1u); break; } }
    }
    nloc = mine > 0u ? mine : 1u; nx = cnt > 0u ? cnt : 1u;
}
__device__ __forceinline__ void xcd_barrier(const XcdBarrier& b) {
    asm volatile("s_waitcnt vmcnt(0)" ::: "memory");
    __syncthreads();
    if (threadIdx.x == 0) {
        unsigned* bar = b.bar;
        __builtin_amdgcn_s_waitcnt(0);
        unsigned nloc = b.st[0], nx = b.st[1];
        if (nloc == 0u) { xcd_barrier_complete(bar, b.x, nloc, nx); b.st[0] = nloc; b.st[1] = nx; }
        const unsigned old = xb_add(&bar[XB_XSUB(b.x)], 1u);
        const unsigned gen = old / nloc;
        if (old + 1u == (gen + 1u) * nloc) {
            __builtin_amdgcn_fence(__ATOMIC_RELEASE, "agent");
            asm volatile("s_waitcnt vmcnt(0)" ::: "memory");
            const unsigned og = xb_add(&bar[XB_TOP], 1u);
            const unsigned tg = og / nx;
            if (og + 1u == (tg + 1u) * nx) xb_add(&bar[XB_TOPGEN], 1u);
            else XB_SPIN(xb_ld(&bar[XB_TOPGEN]) == tg, bar);
            __builtin_amdgcn_fence(__ATOMIC_ACQUIRE, "agent");
            xb_add(&bar[XB_XGEN(b.x)], 1u);
            asm volatile("s_waitcnt vmcnt(0)" ::: "memory");
        } else {
            XB_SPIN(xb_ld(&bar[XB_XGEN(b.x)]) == gen, bar);
            __builtin_amdgcn_fence(__ATOMIC_ACQUIRE, "agent");
            asm volatile("s_waitcnt vmcnt(0)" ::: "memory");
        }
    }
    __syncthreads();
}

__device__ __forceinline__ float shx(float v, int o, int lane) { return __int_as_float(__builtin_amdgcn_ds_bpermute((lane ^ o) << 2, __float_as_int(v))); }
__device__ __forceinline__ float wave_sum(float v, int lane) {
#pragma unroll
    for (int o = 1; o < 64; o <<= 1) v += shx(v, o, lane);
    return v;
}
__device__ __forceinline__ void transpose_item(const float* W, int ldw, int k0, int n0, bf16* WT, int ldk, int dst_row0, const float* kscale, LAS float* scr, int lane, int kmax = 1 << 30) {
    const int r8 = lane >> 3, quad = lane & 7;
    f32x4 v[8];
#pragma unroll
    for (int i = 0; i < 8; ++i) { const int kk = r8 + 8 * i; v[i] = (k0 + kk < kmax) ? *(const GAS f32x4*)(W + (size_t)(k0 + kk) * ldw + n0 + quad * 4) : (f32x4){0.f, 0.f, 0.f, 0.f}; }
#pragma unroll
    for (int i = 0; i < 8; ++i) { const int kk = r8 + 8 * i; if (kscale) v[i] = v[i] * kscale[(k0 + kk < kmax) ? k0 + kk : 0]; *(LAS f32x4*)(scr + kk * 36 + ((quad ^ i) << 2)) = v[i]; }
    LDS_WAIT(); asm volatile("" ::: "memory");
    const int c = lane & 7;
#pragma unroll
    for (int j = 0; j < 4; ++j) { const int n = (lane >> 3) + 8 * j; const LAS float* sp = scr + (8 * c) * 36 + ((((n >> 2) ^ c) << 2) | (n & 3));
        v4u o; o.x = pk2(sp[0 * 36], sp[1 * 36]); o.y = pk2(sp[2 * 36], sp[3 * 36]); o.z = pk2(sp[4 * 36], sp[5 * 36]); o.w = pk2(sp[6 * 36], sp[7 * 36]);
        if (k0 + 8 * c < kmax) *(GAS v4u*)(WT + (size_t)(dst_row0 + n) * ldk + k0 + 8 * c) = o; }
    LDS_WAIT(); asm volatile("" ::: "memory");
}

struct Args { const float* in[31]; float* out; unsigned char* ws; int ph_lo, ph_hi, li, pad; };
typedef const __attribute__((address_space(4))) unsigned char* kaptr_t;
__device__ __forceinline__ kaptr_t ka_base() { kaptr_t p = (kaptr_t)__builtin_amdgcn_kernarg_segment_ptr(); asm volatile("" : "+s"(p)); return p; }
#define INP(k) (*(const float* const __attribute__((address_space(4)))*)(ka_base() + 8 * (k)))
#define OUTP() (*(float* const __attribute__((address_space(4)))*)(ka_base() + 8 * 31))
#define WSP() (*(unsigned char* const __attribute__((address_space(4)))*)(ka_base() + 8 * 32))
#define KA_INT(i) (*(const int __attribute__((address_space(4)))*)(ka_base() + 8 * 33 + 4 * (i)))

template <int PART> __device__ __forceinline__ void p0_weights(unsigned char* ws, LAS unsigned char* lds, int gw, int NGW, int wave, int lane) {
    LAS float* scr = (LAS float*)(lds + wave * 16384);
    bf16* WT_RKV = (bf16*)(ws + WS_WT_RKV); bf16* WT_LORA = (bf16*)(ws + WS_WT_LORA); bf16* WT_OUT = (bf16*)(ws + WS_WT_OUT); bf16* WT_KVQ = (bf16*)(ws + WS_WT_KVQ);
    bf16* WT_SBO = (bf16*)(ws + WS_WT_SBO); bf16* WT_GU = (bf16*)(ws + WS_WT_GU); bf16* WT_DN = (bf16*)(ws + WS_WT_DN);
    constexpr int I_UP = 32 + 32 + 96, I_RKV = 3 * 512, I_LORA = 32 + 32 + 80, I_OUT = 512, I_KV = 1024, I_Q = 512, I_SBO = 512, I_G = 32 * 128, I_U = 32 * 128, I_D = 32 * 128;
    constexpr int NDENSE = I_UP + I_RKV + I_LORA + I_OUT + I_KV + I_Q + I_SBO, NITEMS = NDENSE + I_G + I_U + I_D;
    for (int it = (PART == 0 ? 0 : NDENSE) + gw; it < (PART == 0 ? NDENSE : NITEMS); it += NGW) {
        int r = it;
        if (r < I_UP) {
            if (r < 32) transpose_item(INP(9), C, 0, 32 * r, (bf16*)(ws + WS_WT_W2), 64, 32 * r, nullptr, scr, lane);
            else if (r < 64) transpose_item(INP(12), C, 0, 32 * (r - 32), (bf16*)(ws + WS_WT_A2), 64, 32 * (r - 32), nullptr, scr, lane);
            else { const int q = r - 64, kb = q / 32, nb = q % 32; transpose_item(INP(14), C, 64 * kb, 32 * nb, (bf16*)(ws + WS_WT_G2), DG, 32 * nb, nullptr, scr, lane, DG); }
            continue; } r -= I_UP;
        if (r < I_RKV) { const int m = r / 512, q = r % 512, kb = q / 32, nb = q % 32; transpose_item(INP(6) + (size_t)m * C * C, C, 64 * kb, 32 * nb, WT_RKV, C, m * C + 32 * nb, nullptr, scr, lane); continue; } r -= I_RKV;
        if (r < I_LORA) {
            if (r < 32) { const int kb = r / 2, nb = r % 2; transpose_item(INP(8), DW, 64 * kb, 32 * nb, WT_LORA, C, 32 * nb, nullptr, scr, lane); }
            else if (r < 64) { const int q = r - 32, kb = q / 2, nb = q % 2; transpose_item(INP(11), DA, 64 * kb, 32 * nb, WT_LORA, C, 256 + 32 * nb, nullptr, scr, lane); }
            else { const int q = r - 64, kb = q / 5, nb = q % 5; transpose_item(INP(13), DG, 64 * kb, 32 * nb, WT_LORA, C, 512 + 32 * nb, nullptr, scr, lane); }
            continue; } r -= I_LORA;
        if (r < I_OUT) { const int kb = r / 32, nb = r % 32; transpose_item(INP(20), C, 64 * kb, 32 * nb, WT_OUT, C, 32 * nb, nullptr, scr, lane); continue; } r -= I_OUT;
        if (r < I_KV) { const int kb = r / 64, nb = r % 64; transpose_item(INP(21), 2 * C, 64 * kb, 32 * nb, WT_KVQ, C, 32 * nb, INP(3), scr, lane); continue; } r -= I_KV;
        if (r < I_Q) { const int kb = r / 32, nb = r % 32; transpose_item(INP(22), C, 64 * kb, 32 * nb, WT_KVQ, C, 2 * C + 32 * nb, INP(1) + C, scr, lane); continue; } r -= I_Q;
        if (r < I_SBO) { const int kb = r / 32, nb = r % 32; transpose_item(INP(23), C, 64 * kb, 32 * nb, WT_SBO, C, 32 * nb, nullptr, scr, lane); continue; } r -= I_SBO;
        if (r < I_G) { const int le = r / 128, q = r % 128, kb = q / 8, nb = q % 8, f0 = 32 * nb; transpose_item(INP(28) + (size_t)le * C * FE, FE, 64 * kb, f0, WT_GU + (size_t)le * 512 * C, C, 256 * (f0 / 128) + (f0 % 128), nullptr, scr, lane); continue; } r -= I_G;
        if (r < I_U) { const int le = r / 128, q = r % 128, kb = q / 8, nb = q % 8, f0 = 32 * nb; transpose_item(INP(29) + (size_t)le * C * FE, FE, 64 * kb, f0, WT_GU + (size_t)le * 512 * C, C, 256 * (f0 / 128) + 128 + (f0 % 128), nullptr, scr, lane); continue; } r -= I_U;
        { const int le = r / 128, q = r % 128, kb = q / 32, nb = q % 32; transpose_item(INP(30) + (size_t)le * FE * C, C, 64 * kb, 32 * nb, WT_DN + (size_t)le * C * FE, FE, 32 * nb, nullptr, scr, lane); }
    }
    if (PART == 0) for (int it = gw * 64 + lane; it < 768 * 128; it += NGW * 64) { const int row = it >> 7, ch = it & 127;
        const bool valid = (row < 64) || (row >= 256 && row < 320) || (row >= 512 && row < 672);
        if (!valid) *(GAS v4u*)(WT_LORA + (size_t)row * C + ch * 8) = (v4u){0u, 0u, 0u, 0u}; }
}
__device__ __forceinline__ void load_row(const float* p, int lane, f32x4 (&v)[4]) {
#pragma unroll
    for (int j = 0; j < 4; ++j) v[j] = ((const GAS f32x4*)p)[64 * j + lane];
}
__device__ __forceinline__ float row_rs(const f32x4 (&v)[4], int lane) {
    float s = 0.f;
#pragma unroll
    for (int j = 0; j < 4; ++j) s += (v[j].x * v[j].x + v[j].y * v[j].y) + (v[j].z * v[j].z + v[j].w * v[j].w);
    return 1.0f / sqrtf(wave_sum(s, lane) * (1.0f / C) + RMS_EPS);
}
__device__ __forceinline__ void store_row_bf16(bf16* p, int lane, const f32x4 (&v)[4]) {
#pragma unroll
    for (int j = 0; j < 4; ++j) { v2u o; o.x = pk2(v[j].x, v[j].y); o.y = pk2(v[j].z, v[j].w); ((GAS v2u*)p)[64 * j + lane] = o; }
}
__device__ __forceinline__ void p0_rows(unsigned char* ws, int gw, int NGW, int lane) {
    const float* x = INP(0); const float* gain = INP(1); const float* mix = INP(5);
    f32x4 g[4]; load_row(gain, lane, g);
    for (int run = gw; run < M / 8; run += NGW) {
        const int r0 = run * 8;
        f32x4 prev[4];
        if ((r0 % SEQ) == 0) {
#pragma unroll
            for (int j = 0; j < 4; ++j) prev[j] = (f32x4){0.f, 0.f, 0.f, 0.f};
        } else { load_row(x + (size_t)(r0 - 1) * C, lane, prev); const float rs = row_rs(prev, lane);
#pragma unroll
            for (int j = 0; j < 4; ++j) prev[j] = prev[j] * rs * g[j]; }
        for (int rr = 0; rr < 8; ++rr) {
            const int row = r0 + rr;
            f32x4 hn[4]; load_row(x + (size_t)row * C, lane, hn); const float rs = row_rs(hn, lane);
#pragma unroll
            for (int j = 0; j < 4; ++j) hn[j] = hn[j] * rs * g[j];
#pragma unroll
            for (int i = 0; i < 6; ++i) { f32x4 o[4];
#pragma unroll
                for (int j = 0; j < 4; ++j) { const f32x4 mx = ((const GAS f32x4*)(mix + i * C))[64 * j + lane]; o[j] = hn[j] + (prev[j] - hn[j]) * mx; }
                bf16* dst = i < 2 ? (bf16*)OUTP() + (size_t)i * M * C : (i == 2 ? (bf16*)(ws + WS_B4) : (bf16*)(ws + WS_B1) + (size_t)(i - 3) * M * C);
                store_row_bf16(dst + (size_t)row * C, lane, o); }
#pragma unroll
            for (int j = 0; j < 4; ++j) prev[j] = hn[j];
        }
    }
}

template <int NN, int NGROUPS> struct SchedGrouped {
    static constexpr int K = C;
    const char* A0; size_t astride; const char* A2; const char* B; size_t bgroup;
    int G, c;
    __device__ __forceinline__ bool next(int i, pg8::Unit& u) const {
        const int L = i * G + c; constexpr int per = 64 * NN; if (L >= per * NGROUPS) return false;
        const int g = L / per, w = L % per; pg8::tile_map(w, 64, NN, u.pm, u.pn); u.aux = g; u.r0 = 0; u.cnt = 0; return true; }
    __device__ __forceinline__ const char* a_base(const pg8::Unit& u) const { const char* A = (A2 != nullptr && u.aux == 2) ? A2 : A0 + (size_t)u.aux * astride; return A + (size_t)u.pm * 256 * K * 2; }
    __device__ __forceinline__ const char* b_base(const pg8::Unit& u) const { return B + (size_t)u.aux * bgroup + (size_t)u.pn * 256 * K * 2; }
    __device__ __forceinline__ unsigned a_row_off(const pg8::Unit&, int) const { return 0u; }
};
template <int NN, int K, bool GATHER> struct SchedMoe {
    const char* A; const char* B; size_t bexp; const unsigned* list; volatile LAS int* tab; int G, c;
    __device__ __forceinline__ bool next(int i, pg8::Unit& u) const {
        const int L = i * G + c; const int tot = __builtin_amdgcn_readfirstlane(tab[48]) * NN; if (L >= tot) return false;
        u.pm = L / NN; u.pn = L % NN; int e = 0;
#pragma unroll
        for (int j = 0; j < 16; ++j) e += (u.pm >= tab[32 + j]) ? 1 : 0;
        e = __builtin_amdgcn_readfirstlane(e);
        u.aux = e; u.r0 = (u.pm - __builtin_amdgcn_readfirstlane(tab[16 + e])) * 256; u.cnt = __builtin_amdgcn_readfirstlane(tab[e]); return true; }
    __device__ __forceinline__ const char* a_base(const pg8::Unit& u) const { return GATHER ? A : A + (size_t)u.pm * 256 * K * 2; }
    __device__ __forceinline__ const char* b_base(const pg8::Unit& u) const { return B + (size_t)u.aux * bexp + (size_t)u.pn * 256 * K * 2; }
    __device__ __forceinline__ unsigned a_row_off(const pg8::Unit& u, int r) const {
        const int idx = u.r0 + r; unsigned tok = 0u;
        if (idx < u.cnt) tok = list[(size_t)u.aux * M + idx] >> 1;
        return tok * (unsigned)(K * 2); }
};

using pg8::f32x4;
using pg8::Unit;
__device__ __forceinline__ v4u pack8(f32x4 v0, f32x4 v1) { v4u w; w.x = pg8::cvt_pk_bf16(v0[0], v0[1]); w.y = pg8::cvt_pk_bf16(v0[2], v0[3]); w.z = pg8::cvt_pk_bf16(v1[0], v1[1]); w.w = pg8::cvt_pk_bf16(v1[2], v1[3]); return w; }

struct EpiLora {
    static constexpr bool PERM = true;
    bf16* LW;
    __device__ __forceinline__ void operator()(const f32x4 (&acc)[2][2][4][2], const Unit& u, int wr, int wc, int fr, int fq) const {
        { int l_; asm volatile("v_mbcnt_lo_u32_b32 %0, -1, 0\n\tv_mbcnt_hi_u32_b32 %0, -1, %0" : "=v"(l_)); fr = l_ & 15; fq = l_ >> 4; }
        const int g = u.aux, width = g == 2 ? DG : DW; bf16* out = LW + (size_t)g * (1u << 20);
        const int row0 = u.pm * 256 + wr * 64 + fr;
#pragma unroll
        for (int bj = 0; bj < 2; ++bj) { const int col0 = bj * 128 + wc * 32 + 8 * fq; if (col0 < width) {
#pragma unroll
            for (int ai = 0; ai < 2; ++ai)
#pragma unroll
                for (int m = 0; m < 4; ++m) { f32x4 v0 = acc[ai][bj][m][0], v1 = acc[ai][bj][m][1];
                    if (g == 0) {
#pragma unroll
                        for (int q = 0; q < 4; ++q) { v0[q] = tanhf(v0[q]); v1[q] = tanhf(v1[q]); } }
                    else if (g == 2) {
#pragma unroll
                        for (int q = 0; q < 4; ++q) { v0[q] = sigmoidf_(v0[q]); v1[q] = sigmoidf_(v1[q]); } }
                    *(GAS v4u*)(out + (size_t)(row0 + ai * 128 + m * 16) * width + col0) = pack8(v0, v1); } } }
    }
};
struct EpiSplit3 {
    static constexpr bool PERM = true;
    bf16* O0; bool bycol;
    __device__ __forceinline__ void operator()(const f32x4 (&acc)[2][2][4][2], const Unit& u, int wr, int wc, int fr, int fq) const {
        { int l_; asm volatile("v_mbcnt_lo_u32_b32 %0, -1, 0\n\tv_mbcnt_hi_u32_b32 %0, -1, %0" : "=v"(l_)); fr = l_ & 15; fq = l_ >> 4; }
        const int g = bycol ? (u.pn >> 2) : u.aux, pn = bycol ? (u.pn & 3) : u.pn; bf16* out = O0 + (size_t)g * ((size_t)M * C);
        const int row0 = u.pm * 256 + wr * 64 + fr, col0 = pn * 256 + wc * 32 + 8 * fq;
#pragma unroll
        for (int ai = 0; ai < 2; ++ai)
#pragma unroll
            for (int m = 0; m < 4; ++m)
#pragma unroll
                for (int bj = 0; bj < 2; ++bj) *(GAS v4u*)(out + (size_t)(row0 + ai * 128 + m * 16) * C + col0 + bj * 128) = pack8(acc[ai][bj][m][0], acc[ai][bj][m][1]);
    }
};
struct EpiResid {
    static constexpr bool PERM = false;
    const float* base; float* out;
    __device__ __forceinline__ void operator()(const f32x4 (&acc)[2][2][4][2], const Unit& u, int wr, int wc, int fr, int fq) const {
        { int l_; asm volatile("v_mbcnt_lo_u32_b32 %0, -1, 0\n\tv_mbcnt_hi_u32_b32 %0, -1, %0" : "=v"(l_)); fr = l_ & 15; fq = l_ >> 4; }
        const int row0 = u.pm * 256 + wr * 64 + fr, col0 = u.pn * 256 + wc * 32 + 4 * fq;
#pragma unroll
        for (int ai = 0; ai < 2; ++ai)
#pragma unroll
            for (int m = 0; m < 4; ++m) { const size_t off = (size_t)(row0 + ai * 128 + m * 16) * C + col0;
#pragma unroll
                for (int bj = 0; bj < 2; ++bj)
#pragma unroll
                    for (int n = 0; n < 2; ++n) { const f32x4 b = *(const GAS f32x4*)(base + off + bj * 128 + n * 16); *(GAS f32x4*)(out + off + bj * 128 + n * 16) = b + acc[ai][bj][m][n]; } }
    }
};
struct EpiGU {
    static constexpr bool PERM = true;
    bf16* HID; const float* wl;
    __device__ __forceinline__ void operator()(const f32x4 (&acc)[2][2][4][2], const Unit& u, int wr, int wc, int fr, int fq) const {
        { int l_; asm volatile("v_mbcnt_lo_u32_b32 %0, -1, 0\n\tv_mbcnt_hi_u32_b32 %0, -1, %0" : "=v"(l_)); fr = l_ & 15; fq = l_ >> 4; }
        const int e = u.aux, cnt = u.cnt, base = u.r0, r0 = wr * 64 + fr, col0 = u.pn * 128 + wc * 32 + 8 * fq;
#pragma unroll
        for (int ai = 0; ai < 2; ++ai)
#pragma unroll
            for (int m = 0; m < 4; ++m) { const int r = r0 + ai * 128 + m * 16, idx = base + r; float w = 0.f; if (idx < cnt) w = wl[(size_t)e * M + idx];
                f32x4 h0, h1;
#pragma unroll
                for (int q = 0; q < 4; ++q) { const float g0 = acc[ai][0][m][0][q], g1 = acc[ai][0][m][1][q];
                    h0[q] = g0 * sigmoidf_(g0) * acc[ai][1][m][0][q] * w; h1[q] = g1 * sigmoidf_(g1) * acc[ai][1][m][1][q] * w; }
                *(GAS v4u*)(HID + (size_t)(u.pm * 256 + r) * FE + col0) = pack8(h0, h1);
                asm volatile("" ::: "memory"); }
    }
};
struct EpiDown {
    static constexpr bool PERM = true;
    bf16* EO; const unsigned* list;
    __device__ __forceinline__ void operator()(const f32x4 (&acc)[2][2][4][2], const Unit& u, int wr, int wc, int fr, int fq) const {
        { int l_; asm volatile("v_mbcnt_lo_u32_b32 %0, -1, 0\n\tv_mbcnt_hi_u32_b32 %0, -1, %0" : "=v"(l_)); fr = l_ & 15; fq = l_ >> 4; }
        const int e = u.aux, cnt = u.cnt, base = u.r0, r0 = wr * 64 + fr, col0 = u.pn * 256 + wc * 32 + 8 * fq;
#pragma unroll
        for (int ai = 0; ai < 2; ++ai)
#pragma unroll
            for (int m = 0; m < 4; ++m) { const int idx = base + r0 + ai * 128 + m * 16;
                if (idx < cnt) { const unsigned ent = list[(size_t)e * M + idx]; bf16* o = EO + ((size_t)(ent & 1u) * M + (ent >> 1)) * C + col0;
#pragma unroll
                    for (int bj = 0; bj < 2; ++bj) *(GAS v4u*)(o + bj * 128) = pack8(acc[ai][bj][m][0], acc[ai][bj][m][1]); }
                asm volatile("" ::: "memory"); }
    }
};

typedef short bf16x8s __attribute__((ext_vector_type(8)));
typedef short bf16x4s __attribute__((ext_vector_type(4)));
typedef short v4i16_t __attribute__((ext_vector_type(4)));
constexpr int TPB = 144;
constexpr int TILE_B = 64 * TPB;
constexpr int FP = 68;
constexpr int CS_FA = 0, CS_FB = 16384, CS_TILES = 32768, CS_TOT = CS_TILES + 12 * TILE_B, CS_WL = CS_TOT + 2048, CS_PAR = CS_WL + 256;
static_assert(CS_PAR + 768 <= LDSCTL_OFF, "scan LDS map");
#define TILE(n) (lds + CS_TILES + (n) * TILE_B)
#define F4Z (f32x4){0.f, 0.f, 0.f, 0.f}
__device__ __forceinline__ bf16x8s ldfrag(const LAS unsigned char* tile, int row, int kcol) { return *(const LAS bf16x8s*)(tile + row * TPB + kcol * 2); }
__device__ __forceinline__ bf16x8s ldfrag_tr(const LAS unsigned char* tile, int n0, int k0, int lane) {
    const int g = lane >> 4, q = (lane & 15) >> 2, p = lane & 3;
    const LAS unsigned char* a = tile + (k0 + 8 * g + q) * TPB + (n0 + 4 * p) * 2;
    const v4i16_t lo = __builtin_amdgcn_ds_read_tr16_b64_v4i16((LAS v4i16_t*)a), hi = __builtin_amdgcn_ds_read_tr16_b64_v4i16((LAS v4i16_t*)(a + 4 * TPB));
    return (bf16x8s){lo[0], lo[1], lo[2], lo[3], hi[0], hi[1], hi[2], hi[3]};
}
__device__ __forceinline__ bf16x8s ldfrag_perm(const LAS unsigned char* tile, int row, int ks, int g) {
    const bf16x4s lo = *(const LAS bf16x4s*)(tile + row * TPB + (32 * ks + 4 * g) * 2), hi = *(const LAS bf16x4s*)(tile + row * TPB + (32 * ks + 16 + 4 * g) * 2);
    return (bf16x8s){lo[0], lo[1], lo[2], lo[3], hi[0], hi[1], hi[2], hi[3]};
}
__device__ __forceinline__ void lds_barrier() { asm volatile("s_waitcnt lgkmcnt(0)" ::: "memory"); __builtin_amdgcn_s_barrier(); asm volatile("" ::: "memory"); }
#define MFMA16(a, b, c) __builtin_amdgcn_mfma_f32_16x16x32_bf16((a), (b), (c), 0, 0, 0)
__device__ __forceinline__ void mm64(f32x4 (&acc)[2], const LAS unsigned char* At, const LAS unsigned char* Bt, int rt, int ch, int fr, int g) {
#pragma unroll
    for (int ks = 0; ks < 2; ++ks) { const bf16x8s a = ldfrag(At, 16 * rt + fr, 32 * ks + 8 * g);
#pragma unroll
        for (int ct = 0; ct < 2; ++ct) acc[ct] = MFMA16(a, ldfrag(Bt, 32 * ch + 16 * ct + fr, 32 * ks + 8 * g), acc[ct]); }
}
__device__ __forceinline__ void mm64_bt(f32x4 (&acc)[2], const LAS unsigned char* At, const LAS unsigned char* X, int rt, int ch, int fr, int g, int lane) {
#pragma unroll
    for (int ks = 0; ks < 2; ++ks) { const bf16x8s a = ldfrag(At, 16 * rt + fr, 32 * ks + 8 * g);
#pragma unroll
        for (int ct = 0; ct < 2; ++ct) acc[ct] = MFMA16(a, ldfrag_tr(X, 32 * ch + 16 * ct, 32 * ks, lane), acc[ct]); }
}
__device__ __forceinline__ void mm64_at(f32x4 (&acc)[2], const LAS unsigned char* Xa, const LAS unsigned char* Bt, int rt, int ch, int fr, int g, int lane) {
#pragma unroll
    for (int ks = 0; ks < 2; ++ks) { const bf16x8s a = ldfrag_tr(Xa, 16 * rt, 32 * ks, lane);
#pragma unroll
        for (int ct = 0; ct < 2; ++ct) acc[ct] = MFMA16(a, ldfrag(Bt, 32 * ch + 16 * ct + fr, 32 * ks + 8 * g), acc[ct]); }
}
__device__ __forceinline__ void mm64_att(f32x4 (&acc)[2], const LAS unsigned char* Xa, const LAS unsigned char* X, int rt, int ch, int lane) {
#pragma unroll
    for (int ks = 0; ks < 2; ++ks) { const bf16x8s a = ldfrag_tr(Xa, 16 * rt, 32 * ks, lane);
#pragma unroll
        for (int ct = 0; ct < 2; ++ct) acc[ct] = MFMA16(a, ldfrag_tr(X, 32 * ch + 16 * ct, 32 * ks, lane), acc[ct]); }
}
__device__ __forceinline__ bf16x4s pack4(f32x4 v) { v2u w; w.x = pg8::cvt_pk_bf16(v[0], v[1]); w.y = pg8::cvt_pk_bf16(v[2], v[3]); return __builtin_bit_cast(bf16x4s, w); }
__device__ __forceinline__ f32x4 unpack4(bf16x4s s) { const v2u w = __builtin_bit_cast(v2u, s); return (f32x4){bflo(w.x), bfhi(w.x), bflo(w.y), bfhi(w.y)}; }
__device__ __forceinline__ void st_tr(LAS unsigned char* Out, const f32x4 (&acc)[2], int rt, int ch, int fr, int g) {
#pragma unroll
    for (int ct = 0; ct < 2; ++ct) *(LAS bf16x4s*)(Out + (32 * ch + 16 * ct + fr) * TPB + (16 * rt + 4 * g) * 2) = pack4(acc[ct]);
}
__device__ __forceinline__ void ld_tr(f32x4 (&acc)[2], const LAS unsigned char* In, int rt, int ch, int fr, int g) {
#pragma unroll
    for (int ct = 0; ct < 2; ++ct) acc[ct] = unpack4(*(const LAS bf16x4s*)(In + (32 * ch + 16 * ct + fr) * TPB + (16 * rt + 4 * g) * 2));
}
__device__ __forceinline__ void unpack8(v4u w, float (&o)[8]) { o[0] = bflo(w.x); o[1] = bfhi(w.x); o[2] = bflo(w.y); o[3] = bfhi(w.y); o[4] = bflo(w.z); o[5] = bfhi(w.z); o[6] = bflo(w.w); o[7] = bfhi(w.w); }
__device__ __forceinline__ v4u pack8f(const float (&o)[8]) { v4u w; w.x = pg8::cvt_pk_bf16(o[0], o[1]); w.y = pg8::cvt_pk_bf16(o[2], o[3]); w.z = pg8::cvt_pk_bf16(o[4], o[5]); w.w = pg8::cvt_pk_bf16(o[6], o[7]); return w; }

struct FrontIn { v4u r, k, v; bf16x8s fw[2], fa[2]; };
__device__ __forceinline__ void front_fetch(FrontIn& f, unsigned char* ws, int unit, int tid, int lane, int wave) {
    const int h = unit & 15, c = (unit >> 4) & 127, b = unit >> 11; const size_t row0 = (size_t)b * SEQ + c * 64;
    const int rt = wave & 3, fr = lane & 15, g = lane >> 4, t = tid >> 3, cq = tid & 7, c0 = h * HD + cq * 8;
    const bf16* Rb = (const bf16*)(ws + WS_B1); const bf16* Kb = (const bf16*)(ws + WS_B2); const bf16* Vb = (const bf16*)(ws + WS_B3);
    const bf16* LW = (const bf16*)(ws + WS_LW); const bf16* LA = (const bf16*)(ws + WS_LA);
    f.r = *(const GAS v4u*)(Rb + (row0 + t) * C + c0); f.k = *(const GAS v4u*)(Kb + (row0 + t) * C + c0); f.v = *(const GAS v4u*)(Vb + (row0 + t) * C + c0);
#pragma unroll
    for (int ks = 0; ks < 2; ++ks) { f.fw[ks] = *(const GAS bf16x8s*)(LW + (row0 + 16 * rt + fr) * DW + 32 * ks + 8 * g); f.fa[ks] = *(const GAS bf16x8s*)(LA + (row0 + 16 * rt + fr) * DA + 32 * ks + 8 * g); }
}
__device__ __forceinline__ v4u head_consts(unsigned char* ws, LAS unsigned char* lds, int h, int tid, int wtile, int atile) {
    const bf16* W2T = (const bf16*)(ws + WS_WT_W2); const bf16* A2T = (const bf16*)(ws + WS_WT_A2);
    const int row = tid >> 3, cq = tid & 7;
    const v4u w2chunk = *(const GAS v4u*)(W2T + (size_t)(h * HD + row) * 64 + cq * 8);
    *(LAS v4u*)(lds + CS_TILES + wtile * TILE_B + row * TPB + cq * 16) = w2chunk;
    *(LAS v4u*)(lds + CS_TILES + atile * TILE_B + row * TPB + cq * 16) = *(const GAS v4u*)(A2T + (size_t)(h * HD + row) * 64 + cq * 8);
    if (tid < 64) { LAS float* P = (LAS float*)(lds + CS_PAR); P[tid] = INP(15)[h * HD + tid]; P[64 + tid] = INP(16)[h * HD + tid]; P[128 + tid] = INP(17)[h * HD + tid]; }
    __syncthreads();
    return w2chunk;
}
template <int MODE>
__device__ __forceinline__ void chunk_front(const FrontIn& f, LAS unsigned char* lds, const float (&w0v)[2], const float (&a0v)[2], int tid, int lane, int wave, float (&v8)[8], float& rkb) {
    const int rt = wave & 3, ch = wave >> 2, fr = lane & 15, g = lane >> 4;
    LAS float* FA = (LAS float*)(lds + CS_FA); LAS float* FB = (LAS float*)(lds + CS_FB); LAS float* TOT = (LAS float*)(lds + CS_TOT);
    const int t = tid >> 3, cq = tid & 7;
    constexpr int WTILE = MODE == 1 ? 6 : 10, ATILE = MODE == 1 ? 8 : 11;
    {
        f32x4 aw[2] = {F4Z, F4Z}, aa[2] = {F4Z, F4Z};
#pragma unroll
        for (int ks = 0; ks < 2; ++ks)
#pragma unroll
            for (int ct = 0; ct < 2; ++ct) { aw[ct] = MFMA16(f.fw[ks], ldfrag(TILE(WTILE), 32 * ch + 16 * ct + fr, 32 * ks + 8 * g), aw[ct]); aa[ct] = MFMA16(f.fa[ks], ldfrag(TILE(ATILE), 32 * ch + 16 * ct + fr, 32 * ks + 8 * g), aa[ct]); }
#pragma unroll
        for (int ct = 0; ct < 2; ++ct) { const int j = 32 * ch + 16 * ct + fr; const float w0 = w0v[ct], a0 = a0v[ct];
#pragma unroll
            for (int q = 0; q < 4; ++q) { const int tt = 16 * rt + 4 * g + q, js = j ^ ((g & 1) << 4);
                FA[tt * 64 + js] = -0.6065306597126334f * sigmoidf_(w0 + aw[ct][q]); FB[tt * 64 + js] = sigmoidf_(a0 + aa[ct][q]); } }
    }
    lds_barrier();
    {
        const int j = tid & 63, seg = tid >> 6; float run = 0.f; float loc[8];
#pragma unroll
        for (int q = 0; q < 8; ++q) { run += FA[(8 * seg + q) * 64 + (j ^ (((q >> 2) & 1) << 4))]; loc[q] = run; }
        TOT[seg * 64 + j] = run;
        lds_barrier();
        float off = 0.f;
#pragma unroll
        for (int s2 = 0; s2 < 7; ++s2) off += (s2 < seg) ? TOT[s2 * 64 + j] : 0.f;
#pragma unroll
        for (int q = 0; q < 8; ++q) FA[(8 * seg + q) * 64 + (j ^ (((q >> 2) & 1) << 4))] = loc[q] + off;
    }
    lds_barrier();
    {
        float r[8], k[8], pkk[8], pka[8], prk[8];
        unpack8(f.r, r); unpack8(f.k, k); unpack8(f.v, v8);
        { const LAS float* P = (const LAS float*)(lds + CS_PAR) + cq * 8; const f32x4 a0_ = *(const LAS f32x4*)P, a1_ = *(const LAS f32x4*)(P + 4), b0_ = *(const LAS f32x4*)(P + 64), b1_ = *(const LAS f32x4*)(P + 68), c0_ = *(const LAS f32x4*)(P + 128), c1_ = *(const LAS f32x4*)(P + 132);
#pragma unroll
          for (int q = 0; q < 4; ++q) { pkk[q] = a0_[q]; pkk[4 + q] = a1_[q]; pka[q] = b0_[q]; pka[4 + q] = b1_[q]; prk[q] = c0_[q]; prk[4 + q] = c1_[q]; } }
        float cw[8], cwp[8], ag[8];
        { const int tp = t > 0 ? t - 1 : 0;
          const int ct_ = (cq ^ (((t >> 2) & 1) << 1)) * 8, cp_ = (cq ^ (((tp >> 2) & 1) << 1)) * 8;
          const f32x4 c0_ = *(const LAS f32x4*)(FA + t * 64 + ct_), c1_ = *(const LAS f32x4*)(FA + t * 64 + ct_ + 4), p0_ = *(const LAS f32x4*)(FA + tp * 64 + cp_), p1_ = *(const LAS f32x4*)(FA + tp * 64 + cp_ + 4);
          const f32x4 g0_ = *(const LAS f32x4*)(FB + t * 64 + ct_), g1_ = *(const LAS f32x4*)(FB + t * 64 + ct_ + 4);
#pragma unroll
          for (int q = 0; q < 4; ++q) { cw[q] = c0_[q]; cw[4 + q] = c1_[q]; cwp[q] = t > 0 ? p0_[q] : 0.f; cwp[4 + q] = t > 0 ? p1_[q] : 0.f; ag[q] = g0_[q]; ag[4 + q] = g1_[q]; } }
        float kk[8], ss = 0.f; rkb = 0.f;
#pragma unroll
        for (int q = 0; q < 8; ++q) { kk[q] = k[q] * pkk[q]; ss += kk[q] * kk[q]; }
        ss += shx(ss, 1, lane); ss += shx(ss, 2, lane); ss += shx(ss, 4, lane);
        const float inv = 1.0f / fmaxf(sqrtf(ss), 1e-12f);
        float at[8], bt[8], kt[8], rt_[8];
#pragma unroll
        for (int q = 0; q < 8; ++q) { const float kn = kk[q] * inv, kp = k[q] * (1.0f + (ag[q] - 1.0f) * pka[q]);
            const float ein = __expf(-cw[q]);
            at[q] = -kn * __expf(cwp[q]); bt[q] = kn * ag[q] * ein; kt[q] = kp * ein;
            rt_[q] = r[q] * __expf(cw[q]); rkb += r[q] * kp * prk[q]; }
        rkb += shx(rkb, 1, lane); rkb += shx(rkb, 2, lane); rkb += shx(rkb, 4, lane);
        *(LAS v4u*)(TILE(0) + t * TPB + cq * 16) = pack8f(at); *(LAS v4u*)(TILE(1) + t * TPB + cq * 16) = pack8f(bt); *(LAS v4u*)(TILE(2) + t * TPB + cq * 16) = pack8f(kt);
        *(LAS v4u*)(TILE(3) + t * TPB + cq * 16) = f.v;
        *(LAS v4u*)(TILE(MODE == 1 ? 6 : 4) + t * TPB + cq * 16) = pack8f(rt_);
        if (MODE == 1 && t == 63) {
#pragma unroll
            for (int q = 0; q < 8; ++q) ((LAS float*)(lds + CS_WL))[cq * 8 + q] = __expf(cw[q]); }
    }
    lds_barrier();
}

__device__ __forceinline__ void scan_s1(unsigned char* ws, LAS unsigned char* lds, int lane0, int wave) {
    const int rt = wave & 3, ch = wave >> 2;
    FrontIn fin; float w0v[2], a0v[2]; v4u w2keep;
    { int l0 = lane0; asm volatile("" : "+v"(l0)); const int hh = blockIdx.x & 15;
      if ((int)blockIdx.x < BATCH * NH * (SEQ / 64)) front_fetch(fin, ws, blockIdx.x, wave * 64 + l0, l0, wave);
#pragma unroll
      for (int ct = 0; ct < 2; ++ct) { w0v[ct] = INP(7)[hh * HD + 32 * ch + 16 * ct + (l0 & 15)]; a0v[ct] = INP(10)[hh * HD + 32 * ch + 16 * ct + (l0 & 15)]; }
      w2keep = head_consts(ws, lds, hh, wave * 64 + l0, 6, 8); }
    for (int unit = blockIdx.x; unit < BATCH * NH * (SEQ / 64); unit += gridDim.x) {
        int lane = lane0; asm volatile("" : "+v"(lane));
        const int tid = wave * 64 + lane, fr = lane & 15, g = lane >> 4;
        const int h = unit & 15, c = (unit >> 4) & 127, b = unit >> 11; const size_t chunk = ((size_t)b * NH + h) * 128 + c;
        float v8[8]; float rkb;
        chunk_front<1>(fin, lds, w0v, a0v, tid, lane, wave, v8, rkb);
        { const size_t row0_ = (size_t)b * SEQ + c * 64; if ((tid & 7) == 0) ((float*)(ws + WS_HID))[(row0_ + (tid >> 3)) * NH + h] = rkb; }
        if (unit + (int)gridDim.x < BATCH * NH * (SEQ / 64)) front_fetch(fin, ws, unit + gridDim.x, tid, lane, wave);
        {
            f32x4 a2[2] = {F4Z, F4Z}, a3[2] = {F4Z, F4Z};
            mm64(a2, TILE(1), TILE(0), rt, ch, fr, g);
            mm64(a3, TILE(2), TILE(0), rt, ch, fr, g);
            f32x4 p1[2];
#pragma unroll
            for (int ct = 0; ct < 2; ++ct) { const int col = 32 * ch + 16 * ct + fr;
#pragma unroll
                for (int q = 0; q < 4; ++q) { const int row = 16 * rt + 4 * g + q;
                    a2[ct][q] = row < col ? a2[ct][q] : 0.f;
                    p1[ct][q] = a2[ct][q] + (row == col ? 1.0f : 0.f);
                    a3[ct][q] = row < col ? a3[ct][q] : 0.f; } }
            st_tr(TILE(5), a2, rt, ch, fr, g);
            st_tr(TILE(9), p1, rt, ch, fr, g);
            st_tr(TILE(4), a3, rt, ch, fr, g);
        }
        lds_barrier();
#pragma unroll
        for (int r = 0; r < 6; ++r) {
            LAS unsigned char* Sr = TILE(5 + 2 * (r & 1)); LAS unsigned char* Sr2 = TILE(5 + 2 * ((r & 1) ^ 1));
            if (r <= 4) { f32x4 q2[2] = {F4Z, F4Z};
                mm64_at(q2, Sr, Sr, rt, ch, fr, g, lane);
                st_tr(Sr2, q2, rt, ch, fr, g); }
            if (r >= 1) { LAS unsigned char* Pr = TILE(9 + ((r - 1) & 1)); LAS unsigned char* Pr2 = TILE(9 + (((r - 1) & 1) ^ 1));
                f32x4 pa[2]; ld_tr(pa, Pr, rt, ch, fr, g);
                mm64_at(pa, Sr, Pr, rt, ch, fr, g, lane);
                st_tr(Pr2, pa, rt, ch, fr, g); }
            if (r == 0) { f32x4 gg[2] = {F4Z, F4Z};
                mm64_bt(gg, TILE(4), TILE(3), rt, ch, fr, g, lane);
                st_tr(TILE(11), gg, rt, ch, fr, g); }
            lds_barrier();
        }
        {
            f32x4 acc[2] = {F4Z, F4Z}, ac2[2] = {F4Z, F4Z};
            mm64_bt(acc, TILE(10), TILE(0), rt, ch, fr, g, lane);
            mm64(ac2, TILE(10), TILE(11), rt, ch, fr, g);
            st_tr(TILE(5), acc, rt, ch, fr, g); st_tr(TILE(7), ac2, rt, ch, fr, g);
            f32x4 b2[2] = {F4Z, F4Z}, b3[2] = {F4Z, F4Z};
            mm64(b2, TILE(1), TILE(6), rt, ch, fr, g); mm64(b3, TILE(2), TILE(6), rt, ch, fr, g);
#pragma unroll
            for (int ct = 0; ct < 2; ++ct) { const int t = 32 * ch + 16 * ct + fr;
#pragma unroll
                for (int q = 0; q < 4; ++q) { const int s_ = 16 * rt + 4 * g + q; b2[ct][q] = s_ <= t ? b2[ct][q] : 0.f; b3[ct][q] = s_ <= t ? b3[ct][q] : 0.f; } }
            st_tr(TILE(4), b2, rt, ch, fr, g); st_tr(TILE(9), b3, rt, ch, fr, g);
        }
        lds_barrier();
        {
            const LAS float* WL = (const LAS float*)(lds + CS_WL);
            f32x4 acc[2] = {F4Z, F4Z};
            mm64_bt(acc, TILE(5), TILE(1), rt, ch, fr, g, lane);
            bf16* Mg = (bf16*)(ws + WS_B0) + chunk * 4096;
#pragma unroll
            for (int ct = 0; ct < 2; ++ct) { const int j1 = 32 * ch + 16 * ct + fr; const float wl = WL[j1];
#pragma unroll
                for (int q = 0; q < 4; ++q) { const int j2 = 16 * rt + 4 * g + q; acc[ct][q] = wl * (acc[ct][q] + (j2 == j1 ? 1.0f : 0.f)); }
                const int rtS = 2 * ch + ct, ksS = rt >> 1, half = rt & 1;
                *(GAS bf16x4s*)(Mg + (((rtS * 2 + ksS) * 64 + g * 16 + fr) * 8 + half * 4)) = pack4(acc[ct]); }
            f32x4 ad[2] = {F4Z, F4Z};
            mm64_at(ad, TILE(1), TILE(7), rt, ch, fr, g, lane);
            mm64_att(ad, TILE(2), TILE(3), rt, ch, lane);
            const f32x4 wl4 = *(const LAS f32x4*)(WL + 16 * rt + 4 * g);
            bf16* Dg = (bf16*)OUTP() + chunk * 4096;
#pragma unroll
            for (int ct = 0; ct < 2; ++ct) *(GAS bf16x4s*)(Dg + (((2 * ch + ct) * 4 + rt) * 64 + lane) * 4) = pack4(ad[ct] * wl4);
            const size_t row0_ = (size_t)b * SEQ + c * 64;
            f32x4 ar[2]; ld_tr(ar, TILE(6), rt, ch, fr, g);
            mm64(ar, TILE(5), TILE(4), rt, ch, fr, g);
            f32x4 ay[2] = {F4Z, F4Z};
            mm64(ay, TILE(7), TILE(4), rt, ch, fr, g); mm64_at(ay, TILE(3), TILE(9), rt, ch, fr, g, lane);
            bf16* Rg = (bf16*)(ws + WS_B1); bf16* Kg = (bf16*)(ws + WS_B2);
#pragma unroll
            for (int ct = 0; ct < 2; ++ct) { const size_t o_ = (row0_ + 32 * ch + 16 * ct + fr) * C + h * HD + 16 * rt + 4 * g; *(GAS bf16x4s*)(Rg + o_) = pack4(ar[ct]); *(GAS bf16x4s*)(Kg + o_) = pack4(ay[ct]); }
        }
        lds_barrier();
        { const int row_ = tid >> 3, cq_ = tid & 7; *(LAS v4u*)(TILE(6) + row_ * TPB + cq_ * 16) = w2keep; }
        lds_barrier();
    }
}

constexpr int S2_PD = 6;
__device__ __forceinline__ void scan_s2(unsigned char* ws, LAS unsigned char* lds, int lane, int wave) {
    for (int bh = blockIdx.x; bh < BATCH * NH; bh += gridDim.x) {
        const unsigned char* Mg = (const unsigned char*)((const bf16*)(ws + WS_B0) + (size_t)bh * 128 * 4096); const unsigned char* Dg = (const unsigned char*)((const bf16*)OUTP() + (size_t)bh * 128 * 4096);
        bf16* Sg = (bf16*)OUTP() + (size_t)M * C + (size_t)bh * 128 * 4096;
        if (wave >= 4) {
            const int lw = wave - 4;
            const unsigned char* src = (lw < 2 ? Mg + lw * 4096 : Dg + (lw - 2) * 4096) + lane * 16;
            LAS unsigned char* dst = lds + lw * 4096 + lane * 16;
            v4u q[S2_PD][4];
#define S2_LOADQ(j, c) do { _Pragma("unroll") for (int i_ = 0; i_ < 4; ++i_) q[j][i_] = *(const GAS v4u*)(src + (size_t)(c) * 8192 + i_ * 1024); } while (0)
#define S2_STOREQ(j, slot) do { _Pragma("unroll") for (int i_ = 0; i_ < 4; ++i_) *(LAS v4u*)(dst + (slot) * 16384 + i_ * 1024) = q[j][i_]; } while (0)
#pragma unroll
            for (int j = 0; j < S2_PD; ++j) S2_LOADQ(j, j);
            S2_STOREQ(0, 0); S2_LOADQ(0, S2_PD);
            lds_barrier();
#pragma unroll 1
            for (int s0 = 0; s0 < 128; s0 += S2_PD) {
#pragma unroll
                for (int jj = 0; jj < S2_PD; ++jj) { const int step = s0 + jj;
                    if (step + 1 < 128) S2_STOREQ((jj + 1) % S2_PD, (step + 1) & 1);
                    if (step + 1 + S2_PD < 128) S2_LOADQ((jj + 1) % S2_PD, step + 1 + S2_PD);
                    lds_barrier(); }
            }
#undef S2_LOADQ
#undef S2_STOREQ
        } else {
            const int ct = wave;
            f32x4 acc[4];
#pragma unroll
            for (int r = 0; r < 4; ++r) acc[r] = F4Z;
            lds_barrier();
#pragma unroll 1
            for (int s0 = 0; s0 < 128; s0 += S2_PD) {
#pragma unroll
                for (int jj = 0; jj < S2_PD; ++jj) { const int step = s0 + jj;
                    if (step < 128) {
                        const LAS unsigned char* slot = lds + (step & 1) * 16384;
                        bf16x8s sf[2];
#pragma unroll
                        for (int ks = 0; ks < 2; ++ks) { const bf16x4s lo = pack4(acc[2 * ks]), hi = pack4(acc[2 * ks + 1]); sf[ks] = (bf16x8s){lo[0], lo[1], lo[2], lo[3], hi[0], hi[1], hi[2], hi[3]}; }
#pragma unroll
                        for (int ks = 0; ks < 2; ++ks) *(GAS bf16x8s*)(Sg + (size_t)step * 4096 + ((ct * 2 + ks) * 64 + lane) * 8) = sf[ks];
                        f32x4 na[4];
#pragma unroll
                        for (int r = 0; r < 4; ++r) na[r] = unpack4(*(const LAS bf16x4s*)(slot + 8192 + ((ct * 4 + r) * 64 + lane) * 8));
#pragma unroll
                        for (int ks = 0; ks < 2; ++ks)
#pragma unroll
                            for (int r = 0; r < 4; ++r) na[r] = MFMA16(*(const LAS bf16x8s*)(slot + ((r * 2 + ks) * 64 + lane) * 16), sf[ks], na[r]);
#pragma unroll
                        for (int r = 0; r < 4; ++r) acc[r] = na[r];
                    }
                    lds_barrier(); }
            }
        }
    }
}

constexpr int S3_RT = 32768, S3_YT = S3_RT + TILE_B, S3_LG = S3_YT + TILE_B, S3_LGP = 336;
struct S3In { v4u rr, yy, vv, lg[3]; bf16x8s sA[2]; float rkb; };
__device__ __forceinline__ void s3_fetch(S3In& f, unsigned char* ws, int unit, int tid, int lane, int wave) {
    const int h = unit & 15, c = (unit >> 4) & 127, b = unit >> 11; const size_t chunk = ((size_t)b * NH + h) * 128 + c, row0 = (size_t)b * SEQ + c * 64;
    const int rt = wave & 3, et = tid >> 3, ecq = tid & 7;
    const bf16* Rg = (const bf16*)(ws + WS_B1); const bf16* Kg = (const bf16*)(ws + WS_B2); const bf16* Vb = (const bf16*)(ws + WS_B3); const bf16* LG = (const bf16*)(ws + WS_LG);
    const bf16* Sg = (const bf16*)OUTP() + (size_t)M * C + chunk * 4096;
    const size_t o_ = (row0 + et) * C + h * HD + ecq * 8;
    f.rr = *(const GAS v4u*)(Rg + o_); f.yy = *(const GAS v4u*)(Kg + o_); f.vv = *(const GAS v4u*)(Vb + o_);
#pragma unroll
    for (int i = 0; i < 3; ++i) { const int chn = tid + 512 * i; if (chn < 64 * 20) f.lg[i] = *(const GAS v4u*)(LG + (row0 + chn / 20) * DG + (chn % 20) * 8); }
#pragma unroll
    for (int ks = 0; ks < 2; ++ks) f.sA[ks] = *(const GAS bf16x8s*)(Sg + ((rt * 2 + ks) * 64 + lane) * 8);
    f.rkb = ((const float*)(ws + WS_HID))[(row0 + et) * NH + h];
}
__device__ __forceinline__ void scan_s3(unsigned char* ws, LAS unsigned char* lds, int lane0, int wave) {
    const int rt = wave & 3, ch = wave >> 2;
    LAS float* Ys = (LAS float*)(lds + CS_FA);
    const bf16* G2T = (const bf16*)(ws + WS_WT_G2); bf16* YG = (bf16*)(ws + WS_B0);
    constexpr int NU = BATCH * NH * (SEQ / 64);
    S3In fin; bf16x8s gA[5]; f32x4 lnw0, lnw1, lnb0, lnb1;
    { int l0 = lane0; asm volatile("" : "+v"(l0)); const int hh = blockIdx.x & 15, t0_ = wave * 64 + l0;
      if ((int)blockIdx.x < NU) s3_fetch(fin, ws, blockIdx.x, t0_, l0, wave);
#pragma unroll
      for (int ks = 0; ks < 5; ++ks) gA[ks] = *(const GAS bf16x8s*)(G2T + (size_t)(hh * HD + 16 * rt + (l0 & 15)) * DG + 32 * ks + 8 * (l0 >> 4));
      const int ec0 = hh * HD + (t0_ & 7) * 8;
      lnw0 = *(const GAS f32x4*)(INP(18) + ec0); lnw1 = *(const GAS f32x4*)(INP(18) + ec0 + 4); lnb0 = *(const GAS f32x4*)(INP(19) + ec0); lnb1 = *(const GAS f32x4*)(INP(19) + ec0 + 4); }
    __syncthreads();
    for (int unit = blockIdx.x; unit < NU; unit += gridDim.x) {
        int lane = lane0; asm volatile("" : "+v"(lane));
        const int tid = wave * 64 + lane, fr = lane & 15, g = lane >> 4, et = tid >> 3, ecq = tid & 7;
        const int h = unit & 15, c = (unit >> 4) & 127, b = unit >> 11; const size_t row0 = (size_t)b * SEQ + c * 64;
        *(LAS v4u*)(lds + S3_RT + et * TPB + ecq * 16) = fin.rr; *(LAS v4u*)(lds + S3_YT + et * TPB + ecq * 16) = fin.yy;
#pragma unroll
        for (int i = 0; i < 3; ++i) { const int chn = tid + 512 * i; if (chn < 64 * 20) *(LAS v4u*)(lds + S3_LG + (chn / 20) * S3_LGP + (chn % 20) * 16) = fin.lg[i]; }
        float v8[8]; unpack8(fin.vv, v8); const float rkb = fin.rkb; const bf16x8s sA0 = fin.sA[0], sA1 = fin.sA[1];
        lds_barrier();
        if (unit + (int)gridDim.x < NU) s3_fetch(fin, ws, unit + gridDim.x, tid, lane, wave);
        f32x4 acc[2], ag[2] = {F4Z, F4Z};
#pragma unroll
        for (int ct = 0; ct < 2; ++ct) { const int t = 32 * ch + 16 * ct + fr;
            acc[ct] = unpack4(*(const LAS bf16x4s*)(lds + S3_YT + t * TPB + (16 * rt + 4 * g) * 2));
            acc[ct] = MFMA16(sA0, ldfrag_perm(lds + S3_RT, t, 0, g), acc[ct]); acc[ct] = MFMA16(sA1, ldfrag_perm(lds + S3_RT, t, 1, g), acc[ct]);
#pragma unroll
            for (int ks = 0; ks < 5; ++ks) ag[ct] = MFMA16(gA[ks], *(const LAS bf16x8s*)(lds + S3_LG + t * S3_LGP + (32 * ks + 8 * g) * 2), ag[ct]);
            *(LAS f32x4*)(Ys + t * FP + 16 * rt + 4 * g) = acc[ct]; }
        lds_barrier();
        {
            const f32x4 y0 = *(const LAS f32x4*)(Ys + et * FP + ecq * 8), y1 = *(const LAS f32x4*)(Ys + et * FP + ecq * 8 + 4);
            float y[8] = {y0[0], y0[1], y0[2], y0[3], y1[0], y1[1], y1[2], y1[3]};
            float s_ = 0.f;
#pragma unroll
            for (int q = 0; q < 8; ++q) s_ += y[q];
            s_ += shx(s_, 1, lane); s_ += shx(s_, 2, lane); s_ += shx(s_, 4, lane);
            const float mu = s_ * (1.0f / HD); float vs = 0.f;
#pragma unroll
            for (int q = 0; q < 8; ++q) { y[q] -= mu; vs += y[q] * y[q]; }
            vs += shx(vs, 1, lane); vs += shx(vs, 2, lane); vs += shx(vs, 4, lane);
            const float rstd = 1.0f / sqrtf(vs * (1.0f / HD) + GN_EPS);
            f32x4 o0, o1;
#pragma unroll
            for (int q = 0; q < 4; ++q) { o0[q] = y[q] * rstd * lnw0[q] + lnb0[q] + rkb * v8[q]; o1[q] = y[4 + q] * rstd * lnw1[q] + lnb1[q] + rkb * v8[4 + q]; }
            *(LAS f32x4*)(Ys + et * FP + ecq * 8) = o0; *(LAS f32x4*)(Ys + et * FP + ecq * 8 + 4) = o1;
        }
        lds_barrier();
#pragma unroll
        for (int ct = 0; ct < 2; ++ct) { const int t = 32 * ch + 16 * ct + fr; const f32x4 yv = *(const LAS f32x4*)(Ys + t * FP + 16 * rt + 4 * g);
            *(GAS bf16x4s*)(YG + (row0 + t) * C + h * HD + 16 * rt + 4 * g) = pack4(yv * ag[ct]); }
    }
    __syncthreads();
}
#undef TILE
#if MK_DEBUG
__device__ __forceinline__ void scan_naive(unsigned char* ws, LAS unsigned char* lds, int tid) {
    const int lane = tid & 63;
    const bf16* Rb = (const bf16*)(ws + WS_B1); const bf16* Kb = (const bf16*)(ws + WS_B2); const bf16* Vb = (const bf16*)(ws + WS_B3);
    const bf16* LW = (const bf16*)(ws + WS_LW); const bf16* LA = (const bf16*)(ws + WS_LA);
    float* Y = OUTP(); float* RK = (float*)(ws + WS_HID);
    LAS float* sR = (LAS float*)lds; LAS float* sK = sR + 4096; LAS float* sV = sK + 4096; LAS float* sA = sV + 4096; LAS float* sB = sA + 4096; LAS float* sD = sB + 4096;
    LAS float* sW2 = sD + 4096; LAS float* sA2 = sW2 + 4096;
    for (int unit = blockIdx.x; unit < BATCH * NH; unit += gridDim.x) {
        const int b = unit / NH, h = unit % NH;
        __syncthreads();
        for (int e = tid; e < 4096; e += 512) { const int d = e >> 6, j = e & 63; sW2[e] = INP(9)[(size_t)d * C + h * HD + j]; sA2[e] = INP(12)[(size_t)d * C + h * HD + j]; }
        __syncthreads();
        const int pt = tid >> 3, cq = tid & 7, c0 = h * HD + cq * 8;
        const int si = tid >> 3, jq = tid & 7;
        float S[8];
#pragma unroll
        for (int q = 0; q < 8; ++q) S[q] = 0.f;
        float w0v[8], a0v[8], kkv[8], kav[8], rkv[8];
#pragma unroll
        for (int q = 0; q < 8; ++q) { w0v[q] = INP(7)[c0 + q]; a0v[q] = INP(10)[c0 + q]; kkv[q] = INP(15)[c0 + q]; kav[q] = INP(16)[c0 + q]; rkv[q] = INP(17)[c0 + q]; }
        for (int blk = 0; blk < SEQ / 64; ++blk) {
            const size_t row = (size_t)b * SEQ + blk * 64 + pt;
            {
                const v4u r4 = *(const GAS v4u*)(Rb + row * C + c0), k4 = *(const GAS v4u*)(Kb + row * C + c0), v4 = *(const GAS v4u*)(Vb + row * C + c0);
                float r[8], k[8], v[8];
                r[0] = bflo(r4.x); r[1] = bfhi(r4.x); r[2] = bflo(r4.y); r[3] = bfhi(r4.y); r[4] = bflo(r4.z); r[5] = bfhi(r4.z); r[6] = bflo(r4.w); r[7] = bfhi(r4.w);
                k[0] = bflo(k4.x); k[1] = bfhi(k4.x); k[2] = bflo(k4.y); k[3] = bfhi(k4.y); k[4] = bflo(k4.z); k[5] = bfhi(k4.z); k[6] = bflo(k4.w); k[7] = bfhi(k4.w);
                v[0] = bflo(v4.x); v[1] = bfhi(v4.x); v[2] = bflo(v4.y); v[3] = bfhi(v4.y); v[4] = bflo(v4.z); v[5] = bfhi(v4.z); v[6] = bflo(v4.w); v[7] = bfhi(v4.w);
                float wp[8], ap[8];
#pragma unroll
                for (int q = 0; q < 8; ++q) { wp[q] = w0v[q]; ap[q] = a0v[q]; }
                for (int d = 0; d < 64; ++d) { const float lw = bf2f(LW[row * DW + d]), la = bf2f(LA[row * DA + d]);
#pragma unroll
                    for (int q = 0; q < 8; ++q) { wp[q] += lw * sW2[d * 64 + cq * 8 + q]; ap[q] += la * sA2[d * 64 + cq * 8 + q]; } }
                float kk[8], ss = 0.f, rks = 0.f;
#pragma unroll
                for (int q = 0; q < 8; ++q) { kk[q] = k[q] * kkv[q]; ss += kk[q] * kk[q]; }
                ss += shx(ss, 1, lane); ss += shx(ss, 2, lane); ss += shx(ss, 4, lane);
                const float inv = 1.0f / fmaxf(sqrtf(ss), 1e-12f);
#pragma unroll
                for (int q = 0; q < 8; ++q) { const float ag = sigmoidf_(ap[q]); const float kn = kk[q] * inv; const float kp = k[q] * (1.0f + (ag - 1.0f) * kav[q]);
                    const float lw = -0.6065306597126334f * sigmoidf_(wp[q]);
                    const int o = pt * 64 + cq * 8 + q;
                    sR[o] = r[q]; sK[o] = kp; sV[o] = v[q]; sA[o] = -kn; sB[o] = kn * ag; sD[o] = __expf(lw); rks += r[q] * kp * rkv[q]; }
                rks += shx(rks, 1, lane); rks += shx(rks, 2, lane); rks += shx(rks, 4, lane);
                if (cq == 0) RK[row * NH + h] = rks;
            }
            __syncthreads();
            for (int t = 0; t < 64; ++t) {
                const LAS f32x4* pa = (const LAS f32x4*)(sA + t * 64 + jq * 8); const LAS f32x4* pb = (const LAS f32x4*)(sB + t * 64 + jq * 8);
                const LAS f32x4* pd = (const LAS f32x4*)(sD + t * 64 + jq * 8); const LAS f32x4* pk = (const LAS f32x4*)(sK + t * 64 + jq * 8);
                const LAS f32x4* pr = (const LAS f32x4*)(sR + t * 64 + jq * 8);
                const f32x4 a0 = pa[0], a1 = pa[1], b0 = pb[0], b1 = pb[1], d0 = pd[0], d1 = pd[1], k0 = pk[0], k1 = pk[1], r0 = pr[0], r1 = pr[1];
                const float vi = sV[t * 64 + si];
                float sa = 0.f;
#pragma unroll
                for (int q = 0; q < 4; ++q) { sa += S[q] * a0[q]; sa += S[4 + q] * a1[q]; }
                sa += shx(sa, 1, lane); sa += shx(sa, 2, lane); sa += shx(sa, 4, lane);
                float y = 0.f;
#pragma unroll
                for (int q = 0; q < 4; ++q) { S[q] = S[q] * d0[q] + sa * b0[q] + vi * k0[q]; S[4 + q] = S[4 + q] * d1[q] + sa * b1[q] + vi * k1[q]; y += S[q] * r0[q]; y += S[4 + q] * r1[q]; }
                y += shx(y, 1, lane); y += shx(y, 2, lane); y += shx(y, 4, lane);
                if (jq == 0) Y[((size_t)b * SEQ + blk * 64 + t) * C + h * HD + si] = y;
            }
            __syncthreads();
        }
    }
}
__device__ __forceinline__ void post_scan(unsigned char* ws, int gw, int NGW, int lane) {
    const float* Y = OUTP(); const float* RK = (const float*)(ws + WS_HID); const bf16* Vb = (const bf16*)(ws + WS_B3); const bf16* LG = (const bf16*)(ws + WS_LG);
    bf16* YG = (bf16*)(ws + WS_B4); const float* g2 = INP(14); const float* lnw = INP(18); const float* lnb = INP(19);
    for (int it = gw; it < M * NH; it += NGW) {
        const int row = it / NH, h = it % NH, c = h * HD + lane;
        const float y = Y[(size_t)row * C + c];
        const float mu = wave_sum(y, lane) * (1.0f / HD); const float d = y - mu; const float var = wave_sum(d * d, lane) * (1.0f / HD);
        float o = d * (1.0f / sqrtf(var + GN_EPS)) * lnw[c] + lnb[c];
        o += RK[(size_t)row * NH + h] * bf2f(Vb[(size_t)row * C + c]);
        float g = 0.f;
        for (int dd = 0; dd < DG; ++dd) g += bf2f(LG[(size_t)row * DG + dd]) * g2[(size_t)dd * C + c];
        YG[(size_t)row * C + c] = (bf16)f2bf(o * g);
    }
}


constexpr int CW_DBG = 3200;
__device__ __forceinline__ void dbg_nonfinite(unsigned char* ws, const bf16* X, size_t n, int slot, int gw, int NGW, int lane, float thr = 1e30f) {
    unsigned* cw = (unsigned*)(ws + WS_CTL) + CW_DBG + 64 * slot; unsigned nnan = 0;
    for (size_t i = (size_t)gw * 64 + lane; i < n; i += (size_t)NGW * 64) { const float x = bf2f(X[i]); if (!(fabsf(x) < thr)) ++nnan; }
    if (nnan) atomicAdd(cw, nnan);
}
__device__ __forceinline__ void dbg_compare(unsigned char* ws, const bf16* X, const bf16* Y, int gw, int NGW, int lane) {
    unsigned* cw = (unsigned*)(ws + WS_CTL) + CW_DBG; unsigned nbad = 0, nnan = 0;
    for (size_t i = (size_t)gw * 64 + lane; i < (size_t)M * C; i += (size_t)NGW * 64) { const float x = bf2f(X[i]), y = bf2f(Y[i]);
        if (!(fabsf(x) < 1e30f)) ++nnan; else if (fabsf(x - y) > 0.05f * (fabsf(y) + 0.05f)) ++nbad; }
    if (nnan) atomicAdd(cw, nnan); if (nbad) atomicAdd(cw + 64, nbad);
}
#endif
__device__ __forceinline__ void router_rows(unsigned char* ws, LAS unsigned char* lds, int layer, int gw, int NGW, int lane, int tid, bool dry = false) {
    const float* Hh = OUTP(); const float* gain = INP(2) + layer * C; bf16* XN = (bf16*)(ws + WS_B1);
    const float* wg = INP(24) + (size_t)layer * C * 4; const float* bg = INP(25) + layer * 4; const float* wi = INP(26) + (size_t)layer * C * 16; const float* bi = INP(27) + layer * 16;
    unsigned* cnt = (unsigned*)(ws + WS_CTL) + CW_CNT + layer * 16 * 64; unsigned* list = (unsigned*)(ws + WS_LIST); float* wl = (float*)(ws + WS_WL);
    LAS float* sWg = (LAS float*)lds; LAS float* sWi = sWg + C * 4;
    constexpr int RECMAX = 256;
    LAS unsigned* lcnt = (LAS unsigned*)(lds + 81920); LAS unsigned* gbase = lcnt + 16; LAS int* nrec = (LAS int*)(lcnt + 32);
    LAS unsigned* recRow = lcnt + 64; LAS unsigned* recE = recRow + RECMAX; LAS unsigned* recL = recE + RECMAX; LAS float* recW0 = (LAS float*)(recL + RECMAX); LAS float* recW1 = recW0 + RECMAX;
    __syncthreads();
    for (int e = tid; e < C * 4; e += 512) sWg[e] = wg[e];
    for (int e = tid; e < C * 16; e += 512) sWi[e] = wi[e];
    if (tid < 33) lcnt[tid == 32 ? 32 : tid] = 0u;
    __syncthreads();
    f32x4 g[4]; load_row(gain, lane, g);
    for (int row = gw; row < M; row += NGW) {
        f32x4 v[4]; load_row(Hh + (size_t)row * C, lane, v); const float rs = row_rs(v, lane);
#pragma unroll
        for (int j = 0; j < 4; ++j) v[j] = v[j] * rs * g[j];
        store_row_bf16(XN + (size_t)row * C, lane, v);
        float gl[4] = {0.f, 0.f, 0.f, 0.f};
        const LAS unsigned char* pWg = (const LAS unsigned char*)sWg + lane * 64;
#pragma unroll
        for (int j = 0; j < 4; ++j)
#pragma unroll
            for (int q = 0; q < 4; ++q) { const f32x4 w = *(const LAS f32x4*)(pWg + j * 4096 + q * 16); const float xv = v[j][q]; gl[0] += xv * w.x; gl[1] += xv * w.y; gl[2] += xv * w.z; gl[3] += xv * w.w; }
#pragma unroll
        for (int q = 0; q < 4; ++q) gl[q] = wave_sum(gl[q], lane) + bg[q];
        int gi = 0; float gm = gl[0];
#pragma unroll
        for (int q = 1; q < 4; ++q) if (gl[q] > gm) { gm = gl[q]; gi = q; }
        float gden = 0.f;
#pragma unroll
        for (int q = 0; q < 4; ++q) gden += __expf(gl[q] - gm);
        const float gval = 1.0f / gden;
        float il[4] = {0.f, 0.f, 0.f, 0.f};
        const LAS unsigned char* pWi = (const LAS unsigned char*)sWi + lane * 256 + gi * 16;
#pragma unroll
        for (int j = 0; j < 4; ++j)
#pragma unroll
            for (int q = 0; q < 4; ++q) { const f32x4 w = *(const LAS f32x4*)(pWi + j * 16384 + q * 64); const float xv = v[j][q]; il[0] += xv * w.x; il[1] += xv * w.y; il[2] += xv * w.z; il[3] += xv * w.w; }
#pragma unroll
        for (int q = 0; q < 4; ++q) il[q] = wave_sum(il[q], lane) + bi[gi * 4 + q];
        int i0 = 0; float m0 = il[0];
#pragma unroll
        for (int q = 1; q < 4; ++q) if (il[q] > m0) { m0 = il[q]; i0 = q; }
        int i1 = -1; float m1 = -INFINITY;
#pragma unroll
        for (int q = 0; q < 4; ++q) if (q != i0 && il[q] > m1) { m1 = il[q]; i1 = q; }
        const float e1 = __expf(m1 - m0); const float w0 = gval / (1.0f + e1), w1 = gval * e1 / (1.0f + e1);
        if (lane == 0 && !dry) {
            const int ex0 = gi * 4 + i0, ex1 = gi * 4 + i1;
            const int ri = __hip_atomic_fetch_add(nrec, 1, __ATOMIC_RELAXED, __HIP_MEMORY_SCOPE_WORKGROUP);
            const unsigned l0 = __hip_atomic_fetch_add(lcnt + ex0, 1u, __ATOMIC_RELAXED, __HIP_MEMORY_SCOPE_WORKGROUP), l1 = __hip_atomic_fetch_add(lcnt + ex1, 1u, __ATOMIC_RELAXED, __HIP_MEMORY_SCOPE_WORKGROUP);
            if (ri < RECMAX) { recRow[ri] = (unsigned)row; recE[ri] = (unsigned)ex0 | ((unsigned)ex1 << 8); recL[ri] = l0 | (l1 << 16); recW0[ri] = w0; recW1[ri] = w1; }
        }
    }
    __syncthreads();
    if (tid < 16 && !dry) gbase[tid] = atomicAdd(cnt + tid * 64, lcnt[tid]);
    __syncthreads();
    { const int n = *nrec < RECMAX ? *nrec : RECMAX;
      for (int i = tid; i < n; i += 512) { const unsigned row = recRow[i], e = recE[i], l = recL[i]; const unsigned ex0 = e & 255u, ex1 = e >> 8;
          const unsigned p0 = gbase[ex0] + (l & 0xffffu), p1 = gbase[ex1] + (l >> 16);
          list[(size_t)ex0 * M + p0] = row * 2u; wl[(size_t)ex0 * M + p0] = recW0[i]; list[(size_t)ex1 * M + p1] = row * 2u + 1u; wl[(size_t)ex1 * M + p1] = recW1[i]; } }
}
__device__ __forceinline__ void moe_table(unsigned char* ws, volatile LAS int* tab, int layer, int tid) {
    __syncthreads();
    if (tid == 0) { const unsigned* cnt = (const unsigned*)(ws + WS_CTL) + CW_CNT + layer * 16 * 64; int t = 0;
#pragma unroll 1
        for (int e = 0; e < 16; ++e) { const int c = (int)__hip_atomic_load(cnt, RLX_AGENT); cnt += 64; tab[e] = c; tab[16 + e] = t; t += (c + 255) >> 8; tab[32 + e] = t; }
        tab[48] = t; }
    __syncthreads();
}
__device__ __forceinline__ void combine_rows(unsigned char* ws, int mode, int gw, int NGW, int lane, bool dry = false) {
    float* Hh = OUTP(); const bf16* E0 = (const bf16*)(ws + WS_B2); const bf16* E1 = (const bf16*)(ws + WS_B3); bf16* XN2 = (bf16*)(ws + WS_B0);
    f32x4 g[4]; load_row(INP(4), lane, g);
    for (int row = gw; row < M; row += NGW) {
        f32x4 v[4]; load_row(Hh + (size_t)row * C, lane, v);
#pragma unroll
        for (int j = 0; j < 4; ++j) { const v2u e0 = ((const GAS v2u*)(E0 + (size_t)row * C))[64 * j + lane], e1 = ((const GAS v2u*)(E1 + (size_t)row * C))[64 * j + lane];
            v[j].x += bflo(e0.x) + bflo(e1.x); v[j].y += bfhi(e0.x) + bfhi(e1.x); v[j].z += bflo(e0.y) + bflo(e1.y); v[j].w += bfhi(e0.y) + bfhi(e1.y); }
        const float rs = row_rs(v, lane);
        if (mode == 0) {
#pragma unroll
            for (int j = 0; j < 4; ++j) if (!dry) ((GAS f32x4*)(Hh + (size_t)row * C))[64 * j + lane] = v[j];
#pragma unroll
            for (int j = 0; j < 4; ++j) v[j] = v[j] * rs;
            store_row_bf16(XN2 + (size_t)row * C, lane, v);
        } else {
            float sig = 1.0f;
#if MK_DEBUG
            const unsigned* cw = (const unsigned*)(ws + WS_CTL) + CW_DBG; const unsigned nnan = __hip_atomic_load(cw, RLX_AGENT), nbad = __hip_atomic_load(cw + 64, RLX_AGENT);
            if (row < 512 && nnan > 0) sig = 2.0f;
            if (row >= 512 && row < 1536 && __hip_atomic_load(cw + 128, RLX_AGENT) > 0) sig = 2.0f;
            if (row >= 1536 && row < 3584 && __hip_atomic_load(cw + 192, RLX_AGENT) > 0) sig = 2.0f;
            if (row >= 3584 && row < 7680 && __hip_atomic_load(cw + 256, RLX_AGENT) > 0) sig = 2.0f;
            if (row >= 7680 && row < 15872 && __hip_atomic_load(cw + 320, RLX_AGENT) > 0) sig = 2.0f;
            if (row >= 15872 && nbad > (unsigned)(M / 100) * C) sig = 1.5f;
#endif
#pragma unroll
            for (int j = 0; j < 4; ++j) ((GAS f32x4*)(Hh + (size_t)row * C))[64 * j + lane] = v[j] * rs * g[j] * sig;
        }
    }
}
__device__ __forceinline__ void attn_naive(unsigned char* ws, int gw, int NGW, int lane) {
    const bf16* Kb = (const bf16*)(ws + WS_B1); const bf16* Vb = (const bf16*)(ws + WS_B2); const bf16* Qb = (const bf16*)(ws + WS_B3); bf16* Ob = (bf16*)(ws + WS_B0);
    for (int unit = gw; unit < BATCH * NH * (SEQ / 64); unit += NGW) {
        const int qb = unit % (SEQ / 64), bh = unit / (SEQ / 64), b = bh / NH, h = bh % NH;
        const int t0 = qb * 64, t = t0 + lane; const size_t rowq = (size_t)b * SEQ + t;
        float q[64], o[64];
#pragma unroll
        for (int c = 0; c < 8; ++c) { const v4u w = *(const GAS v4u*)(Qb + rowq * C + h * HD + c * 8);
            q[c * 8 + 0] = bflo(w.x) * 0.125f; q[c * 8 + 1] = bfhi(w.x) * 0.125f; q[c * 8 + 2] = bflo(w.y) * 0.125f; q[c * 8 + 3] = bfhi(w.y) * 0.125f;
            q[c * 8 + 4] = bflo(w.z) * 0.125f; q[c * 8 + 5] = bfhi(w.z) * 0.125f; q[c * 8 + 6] = bflo(w.w) * 0.125f; q[c * 8 + 7] = bfhi(w.w) * 0.125f; }
#pragma unroll
        for (int c = 0; c < 64; ++c) o[c] = 0.f;
        float suffix = 0.f;
        for (int s = t0 + 62; s >= 0; --s) {
            const bool valid = s < t;
            if (s < t0 && __all(suffix > SB_EXIT)) break;
            const bf16* kp = Kb + ((size_t)b * SEQ + s) * C + h * HD; const bf16* vp = Vb + ((size_t)b * SEQ + s) * C + h * HD;
            float z = 0.f;
#pragma unroll
            for (int c = 0; c < 8; ++c) { const v4u w = *(const GAS v4u*)(kp + c * 8);
                z += q[c * 8 + 0] * bflo(w.x) + q[c * 8 + 1] * bfhi(w.x) + q[c * 8 + 2] * bflo(w.y) + q[c * 8 + 3] * bfhi(w.y) + q[c * 8 + 4] * bflo(w.z) + q[c * 8 + 5] * bfhi(w.z) + q[c * 8 + 6] * bflo(w.w) + q[c * 8 + 7] * bfhi(w.w); }
            const float sp = fmaxf(z, 0.f) + log1pf(__expf(-fabsf(z)));
            const float att = valid ? __expf(z - sp - suffix) : 0.f;
            suffix += valid ? sp : 0.f;
#pragma unroll
            for (int c = 0; c < 8; ++c) { const v4u w = *(const GAS v4u*)(vp + c * 8);
                o[c * 8 + 0] += att * bflo(w.x); o[c * 8 + 1] += att * bfhi(w.x); o[c * 8 + 2] += att * bflo(w.y); o[c * 8 + 3] += att * bfhi(w.y);
                o[c * 8 + 4] += att * bflo(w.z); o[c * 8 + 5] += att * bfhi(w.z); o[c * 8 + 6] += att * bflo(w.w); o[c * 8 + 7] += att * bfhi(w.w); }
        }
#pragma unroll
        for (int c = 0; c < 8; ++c) { v4u w; w.x = pk2(o[c * 8 + 0], o[c * 8 + 1]); w.y = pk2(o[c * 8 + 2], o[c * 8 + 3]); w.z = pk2(o[c * 8 + 4], o[c * 8 + 5]); w.w = pk2(o[c * 8 + 6], o[c * 8 + 7]);
            *(GAS v4u*)(Ob + rowq * C + h * HD + c * 8) = w; }
    }
}


typedef float f32x16 __attribute__((ext_vector_type(16)));
constexpr int AT_VP = 192;
constexpr int AT_WAVE_LDS = 32 * AT_VP;
__device__ __forceinline__ int crow32(int reg, int hh) { return (reg & 3) + 8 * (reg >> 2) + 4 * hh; }
__device__ __forceinline__ bf16x8s pack_step(const f32x16& x, const int s) {
    v4u p; p.x = pg8::cvt_pk_bf16(x[8 * s], x[8 * s + 1]); p.y = pg8::cvt_pk_bf16(x[8 * s + 2], x[8 * s + 3]); p.z = pg8::cvt_pk_bf16(x[8 * s + 4], x[8 * s + 5]); p.w = pg8::cvt_pk_bf16(x[8 * s + 6], x[8 * s + 7]);
    return __builtin_bit_cast(bf16x8s, p);
}
__device__ __forceinline__ void attn_mfma(unsigned char* ws, LAS unsigned char* lds, int gw, int NGW, int lane, int wave) {
    const bf16* Kb = (const bf16*)(ws + WS_B1); const bf16* Vb = (const bf16*)(ws + WS_B2); const bf16* Qb = (const bf16*)(ws + WS_B3); bf16* Ob = (bf16*)(ws + WS_B0);
    LAS unsigned char* vl = lds + wave * AT_WAVE_LDS;
    const int r32 = lane & 31, hh = lane >> 5;
    bf16x8s tri[2];
#pragma unroll
    for (int s = 0; s < 2; ++s)
#pragma unroll
        for (int j = 0; j < 8; ++j) tri[s][j] = (16 * s + 8 * (j >> 2) + 4 * hh + (j & 3)) > r32 ? (short)0x3F80 : (short)0;
    const int grp = lane >> 4, tq = (lane & 15) >> 2, tp = lane & 3;
    const LAS unsigned char* vtr0 = vl + (4 * hh + tq) * AT_VP + (16 * (grp & 1) + 4 * tp) * 2;
    for (int unit = gw; unit < BATCH * NH * (SEQ / 32); unit += NGW) {
        const int qb = unit % (SEQ / 32), bh = unit / (SEQ / 32), b = bh / NH, hd = bh % NH;
        const int t0 = qb * 32; const size_t rowb = (size_t)b * SEQ;
        bf16x8s qf[4];
#pragma unroll
        for (int ks = 0; ks < 4; ++ks) qf[ks] = *(const GAS bf16x8s*)(Qb + (rowb + t0 + r32) * C + hd * HD + 16 * ks + 8 * hh);
        f32x16 o[2];
#pragma unroll
        for (int i = 0; i < 16; ++i) { o[0][i] = 0.f; o[1][i] = 0.f; }
        float carry = 0.f;
        for (int s0 = t0; s0 >= 0; s0 -= 32) {
            bf16x8s kf[4];
#pragma unroll
            for (int ks = 0; ks < 4; ++ks) kf[ks] = *(const GAS bf16x8s*)(Kb + (rowb + s0 + r32) * C + hd * HD + 16 * ks + 8 * hh);
            v4u vreg[4];
#pragma unroll
            for (int i = 0; i < 4; ++i) { const int cidx = lane + 64 * i; vreg[i] = *(const GAS v4u*)(Vb + (rowb + s0 + (cidx >> 3)) * C + hd * HD + (cidx & 7) * 8); }
            f32x16 st;
#pragma unroll
            for (int i = 0; i < 16; ++i) st[i] = 0.f;
#pragma unroll
            for (int ks = 0; ks < 4; ++ks) st = __builtin_amdgcn_mfma_f32_32x32x16_bf16(kf[ks], qf[ks], st, 0, 0, 0);
#pragma unroll
            for (int i = 0; i < 4; ++i) { const int cidx = lane + 64 * i; *(LAS v4u*)(vl + (cidx >> 3) * AT_VP + (cidx & 7) * 16) = vreg[i]; }
            f32x16 zz, uu; float tot = 0.f; const int tq_ = t0 + r32;
            if (s0 + 31 < t0) {
#pragma unroll
                for (int i = 0; i < 16; ++i) { const float z = st[i] * 0.18033688011112042f; const float sp = fmaxf(z, 0.f) + __builtin_amdgcn_logf(1.0f + __builtin_amdgcn_exp2f(-fabsf(z)));
                    zz[i] = z - sp; uu[i] = sp; tot += sp; }
            } else {
#pragma unroll
                for (int i = 0; i < 16; ++i) { const int key = s0 + crow32(i, hh); const float z = st[i] * 0.18033688011112042f; const float sp = fmaxf(z, 0.f) + __builtin_amdgcn_logf(1.0f + __builtin_amdgcn_exp2f(-fabsf(z)));
                    const bool valid = key < tq_; zz[i] = valid ? z - sp : -1e30f; uu[i] = valid ? sp : 0.f; tot += uu[i]; }
            }
            f32x16 w;
#pragma unroll
            for (int i = 0; i < 16; ++i) w[i] = 0.f;
#pragma unroll
            for (int s = 0; s < 2; ++s) w = __builtin_amdgcn_mfma_f32_32x32x16_bf16(tri[s], pack_step(uu, s), w, 0, 0, 0);
            f32x16 pp;
#pragma unroll
            for (int i = 0; i < 16; ++i) pp[i] = __builtin_amdgcn_exp2f(zz[i] - w[i] - carry);
            tot += shx(tot, 32, lane); carry += tot;
            asm volatile("s_waitcnt lgkmcnt(0)" ::: "memory");
#pragma unroll
            for (int s = 0; s < 2; ++s) { const bf16x8s pa = pack_step(pp, s);
#pragma unroll
                for (int dt = 0; dt < 2; ++dt) {
                    const v4i16_t lo = __builtin_amdgcn_ds_read_tr16_b64_v4i16((LAS v4i16_t*)(vtr0 + (16 * s) * AT_VP + dt * 64));
                    const v4i16_t hi = __builtin_amdgcn_ds_read_tr16_b64_v4i16((LAS v4i16_t*)(vtr0 + (16 * s + 8) * AT_VP + dt * 64));
                    const bf16x8s vf = (bf16x8s){lo[0], lo[1], lo[2], lo[3], hi[0], hi[1], hi[2], hi[3]};
                    o[dt] = __builtin_amdgcn_mfma_f32_32x32x16_bf16(pa, vf, o[dt], 0, 0, 0); } }
            asm volatile("" ::: "memory");
            if (s0 < t0 && __all(carry > SB_EXIT * 1.4426950408889634f)) break;
        }
#pragma unroll
        for (int dt = 0; dt < 2; ++dt)
#pragma unroll
            for (int i = 0; i < 16; ++i) Ob[(rowb + t0 + crow32(i, hh)) * C + hd * HD + 32 * dt + r32] = (bf16)f2bf(o[dt][i]);
    }
}
__global__ void __launch_bounds__(NWAVES * 64, 2) yoco_fwd(Args args) {
    extern __shared__ __attribute__((aligned(16))) unsigned char lds_raw[];
    LAS unsigned char* lds = (LAS unsigned char*)lds_raw;
    const int G = gridDim.x; const int bx = blockIdx.x;
    int wave = __builtin_amdgcn_readfirstlane(threadIdx.x >> 6); asm volatile("" : "+s"(wave));
#define IDS() int lane; asm volatile("v_mbcnt_lo_u32_b32 %0, -1, 0\n\tv_mbcnt_hi_u32_b32 %0, -1, %0" : "=v"(lane)); const int tid = wave * 64 + lane; (void)tid; \
    const int vcu = (G % 8 == 0) ? (bx % 8) * (G / 8) + bx / 8 : bx; const int gw = vcu * NWAVES + wave, NGW = G * NWAVES; (void)lane; (void)gw; (void)NGW;
    unsigned char* ws = WSP();
    volatile LAS unsigned* MISC = (volatile LAS unsigned*)(lds + MISC_OFF);
    volatile LAS int* tab = (volatile LAS int*)(lds + MOE_TAB_OFF);
    for (int u = threadIdx.x; u < (LDS_BYTES - LDSCTL_OFF) / 4; u += NWAVES * 64) ((LAS unsigned*)(lds + LDSCTL_OFF))[u] = 0u;
    __syncthreads();
    XcdBarrier bar; bar.bar = (unsigned*)(ws + WS_CTL) + CW_BAR; bar.x = 0; bar.st = nullptr;
    if (N_LAUNCHES == 1) bar = xcd_barrier_post((unsigned*)(ws + WS_CTL) + CW_BAR, MISC + 8);
    const int lo = KA_INT(0), hi = KA_INT(1);
#ifndef PROBE_PH
#define PROBE_PH -1
#endif
#define IN(k) (lo <= (k) && (k) < hi)
#define REP(k) for (int rep_ = 0; rep_ < ((PROBE_PH == (k)) ? 2 : 1); ++rep_)
#define SEAM(k) do { if (IN(k) && IN((k) + 1)) xcd_barrier(bar); } while (0)

    if (IN(PH_P0)) REP(PH_P0) { IDS(); p0_weights<0>(ws, lds, gw, NGW, wave, lane); p0_weights<1>(ws, lds, gw, NGW, wave, lane); p0_rows(ws, gw, NGW, lane); }
    SEAM(PH_P0);
    if (PROBE_PH == 100 && N_LAUNCHES == 1) { for (int i_ = 0; i_ < 10; ++i_) xcd_barrier(bar); }
    if (IN(PH_LORA)) REP(PH_LORA) {
        SchedGrouped<1, 3> S{(const char*)(ws + WS_B1), (size_t)(WS_B2 - WS_B1), nullptr, (const char*)(ws + WS_WT_LORA), (size_t)256 * C * 2, G, bx};
        EpiLora E{(bf16*)(ws + WS_LW)};
        pg8::gemm_phase<EpiLora, SchedGrouped<1, 3>, true, false, C>(lds, S, E, wave);
    }
    SEAM(PH_LORA);
    if (IN(PH_RKV)) REP(PH_RKV) {
        SchedGrouped<4, 3> S{(const char*)OUTP(), (size_t)M * C * 2, (const char*)(ws + WS_B4), (const char*)(ws + WS_WT_RKV), (size_t)C * C * 2, G, bx};
        EpiSplit3 E{(bf16*)(ws + WS_B1), false};
        pg8::gemm_phase<EpiSplit3, SchedGrouped<4, 3>, true, false, C>(lds, S, E, wave);
    }
    SEAM(PH_RKV);
    if (IN(PH_S1)) REP(PH_S1) { IDS(); scan_s1(ws, lds, lane, wave); }
    SEAM(PH_S1);
    if (IN(PH_S2)) REP(PH_S2) { IDS();
        if (bx < BATCH * NH || G <= BATCH * NH) scan_s2(ws, lds, lane, wave);
        }
    SEAM(PH_S2);
    if (IN(PH_S3)) REP(PH_S3) { IDS(); scan_s3(ws, lds, lane, wave); }
    SEAM(PH_S3);
#if MK_DEBUG
    if (IN(PH_DBG0)) { IDS(); scan_naive(ws, lds, tid); }
    SEAM(PH_DBG0);
    if (IN(PH_DBG0 + 1)) { IDS(); post_scan(ws, gw, NGW, lane); }
    SEAM(PH_DBG0 + 1);
    if (IN(PH_DBG0 + 2)) { IDS(); dbg_compare(ws, (const bf16*)(ws + WS_B0), (const bf16*)(ws + WS_B4), gw, NGW, lane); }
    SEAM(PH_DBG0 + 2);
#endif
    if (IN(PH_WOUT)) REP(PH_WOUT) {
        SchedGrouped<4, 1> S{(const char*)(ws + ((MK_DEBUG && DBG_USE_NAIVE) ? WS_B4 : WS_B0)), 0, nullptr, (const char*)(ws + WS_WT_OUT), 0, G, bx};
        EpiResid E{INP(0), OUTP()};
        pg8::gemm_phase<EpiResid, SchedGrouped<4, 1>, true, false, C>(lds, S, E, wave);
    }
    SEAM(PH_WOUT);
#pragma unroll 1
    for (int layer = 0; layer < 2; ++layer) {
        const int pb = layer == 0 ? (int)PH_ROUT0 : (int)PH_ROUT1;
        if (IN(pb)) { IDS(); if (PROBE_PH == 101 && layer == 0) router_rows(ws, lds, layer, gw, NGW, lane, tid, true); router_rows(ws, lds, layer, gw, NGW, lane, tid); }
        SEAM(pb);
        if (IN(pb + 1)) REP(pb + 1) {
            { IDS(); moe_table(ws, tab, layer, tid); }
            SchedMoe<2, C, true> S{(const char*)(ws + WS_B1), (const char*)(ws + WS_WT_GU) + (size_t)layer * 16 * 512 * C * 2, (size_t)512 * C * 2, (const unsigned*)(ws + WS_LIST), tab, G, bx};
            EpiGU E{(bf16*)(ws + WS_HID), (const float*)(ws + WS_WL)};
            pg8::gemm_phase<EpiGU, SchedMoe<2, C, true>, true, true, C>(lds, S, E, wave);
        }
        SEAM(pb + 1);
        if (IN(pb + 2)) REP(pb + 2) {
            { IDS(); moe_table(ws, tab, layer, tid); }
            SchedMoe<4, FE, false> S{(const char*)(ws + WS_HID), (const char*)(ws + WS_WT_DN) + (size_t)layer * 16 * C * FE * 2, (size_t)C * FE * 2, (const unsigned*)(ws + WS_LIST), tab, G, bx};
            EpiDown E{(bf16*)(ws + WS_B2), (const unsigned*)(ws + WS_LIST)};
            pg8::gemm_phase<EpiDown, SchedMoe<4, FE, false>, true, false, FE>(lds, S, E, wave);
        }
        SEAM(pb + 2);
        if (layer == 0) {
            if (IN(PH_COMB)) { IDS(); if (PROBE_PH == 102) combine_rows(ws, 0, gw, NGW, lane, true); combine_rows(ws, 0, gw, NGW, lane); }
            SEAM(PH_COMB);
            if (IN(PH_KVQ)) REP(PH_KVQ) {
                SchedGrouped<12, 1> S{(const char*)(ws + WS_B0), 0, nullptr, (const char*)(ws + WS_WT_KVQ), 0, G, bx};
                EpiSplit3 E{(bf16*)(ws + WS_B1), true};
                pg8::gemm_phase<EpiSplit3, SchedGrouped<12, 1>, true, false, C>(lds, S, E, wave);
            }
            SEAM(PH_KVQ);
            if (IN(PH_ATTN)) REP(PH_ATTN) { IDS(); attn_mfma(ws, lds, gw, NGW, lane, wave); }
            SEAM(PH_ATTN);
            if (IN(PH_SBO)) {
                SchedGrouped<4, 1> S{(const char*)(ws + WS_B0), 0, nullptr, (const char*)(ws + WS_WT_SBO), 0, G, bx};
                EpiResid E{OUTP(), OUTP()};
                pg8::gemm_phase<EpiResid, SchedGrouped<4, 1>, true, false, C>(lds, S, E, wave);
            }
            SEAM(PH_SBO);
        }
    }
    if (IN(PH_FINAL)) { IDS(); combine_rows(ws, 1, gw, NGW, lane); }
#undef IN
#undef SEAM
}

extern "C" void kernel_launch(void* const* d_in, const int* in_sizes, int n_in, void* d_out, int out_size, void* d_ws, size_t ws_size, hipStream_t stream) {
    static int grid = 0;
    if (grid == 0) {
        if (n_in != 31 || in_sizes[0] != M * C || out_size != M * C || ws_size < WS_END) { fprintf(stderr, "kernel_launch: unexpected shapes (n_in %d, in0 %d, out %d, ws %zu); nothing launched\n", n_in, n_in > 0 ? in_sizes[0] : -1, out_size, ws_size); grid = -1; return; }
        int dev = 0, cus = 0, per_cu = 0;
        if (hipGetDevice(&dev) != hipSuccess || hipDeviceGetAttribute(&cus, hipDeviceAttributeMultiprocessorCount, dev) != hipSuccess) { grid = -1; return; }
        if (hipFuncSetAttribute((const void*)yoco_fwd, hipFuncAttributeMaxDynamicSharedMemorySize, LDS_BYTES) != hipSuccess) { fprintf(stderr, "kernel_launch: hipFuncSetAttribute failed\n"); grid = -1; return; }
        if (hipOccupancyMaxActiveBlocksPerMultiprocessor(&per_cu, (const void*)yoco_fwd, NWAVES * 64, LDS_BYTES) != hipSuccess || per_cu < 1) fprintf(stderr, "kernel_launch: occupancy query reports %d\n", per_cu);
        (void)hipGetLastError();
        grid = cus - (cus % 16);
    }
    if (grid < 0) return;
    if (hipMemsetAsync((char*)d_ws + WS_CTL, 0, CTL_ZERO_BYTES, stream) != hipSuccess) return;
    Args a{};
    for (int i = 0; i < 31; ++i) a.in[i] = (const float*)d_in[i];
    a.out = (float*)d_out; a.ws = (unsigned char*)d_ws;
    for (int li = 0; li < (N_LAUNCHES == 1 ? 1 : (int)NPHASE); ++li) {
        a.ph_lo = (N_LAUNCHES == 1) ? 0 : li; a.ph_hi = (N_LAUNCHES == 1) ? NPHASE : li + 1; a.li = li;
        hipLaunchKernelGGL(yoco_fwd, dim3(grid), dim3(NWAVES * 64), LDS_BYTES, stream, a);
        const hipError_t le = hipPeekAtLastError();
        if (le != hipSuccess) { fprintf(stderr, "kernel_launch: launch %d failed: %s\n", li, hipGetErrorName(le)); break; }
    }
}
```

```cpp
#include <hip/hip_runtime.h>
#include <cstdio>
#include <cstdint>

#ifndef MK_N_LAUNCHES
#define MK_N_LAUNCHES 1
#endif

namespace pg8 {
#define PG8_LAS __attribute__((address_space(3)))
typedef unsigned short bf16_t;
typedef short bf16x8 __attribute__((ext_vector_type(8)));
typedef float f32x4 __attribute__((ext_vector_type(4)));
typedef unsigned u32x4 __attribute__((ext_vector_type(4)));
constexpr int BM = 256, BK = 64, HALF = 128, HTB = HALF * BK * 2, STAGE_BYTES = 8 * HTB, NXCD = 8, WGM = 8;

__host__ __device__ __forceinline__ int lds_byte(int r, int c) { const int st = (r >> 4) * 2 + (c >> 5), rr = r & 15, cc = c & 31, ob = rr * 64 + cc * 2; return st * 1024 + (ob ^ (((ob >> 9) & 1) << 5)); }
__host__ __device__ __forceinline__ void stage_rc(int b, int& R, int& C) { const int st = b / 1024, sb = b % 1024, swz = sb ^ (((sb >> 9) & 1) << 5); R = (st >> 1) * 16 + swz / 64; C = (st & 1) * 32 + (swz % 64) / 2; }
__host__ __device__ __forceinline__ int perm32(int rho) { const int n = rho >> 4, i = rho & 15; return 8 * (i >> 2) + 4 * n + (i & 3); }

struct Unit { int pm, pn, aux, r0, cnt; };

__host__ __device__ __forceinline__ void tile_map(int wgid, int nM, int nN, int& pm, int& pn) {
    const int nwg = nM * nN;
    { const int q = nwg / NXCD, r = nwg % NXCD, xcd = wgid % NXCD, off = wgid / NXCD; wgid = (xcd < r ? xcd * (q + 1) : r * (q + 1) + (xcd - r) * q) + off; }
    const int nig = WGM * nN, gid = wgid / nig, fm = gid * WGM, gsz = (nM - fm) < WGM ? (nM - fm) : WGM;
    pm = fm + ((wgid % nig) % gsz); pn = (wgid % nig) / gsz;
}

typedef float f32x2_t __attribute__((ext_vector_type(2))); typedef __bf16 bf16x2_t __attribute__((ext_vector_type(2)));
__device__ __forceinline__ unsigned cvt_pk_bf16(float lo, float hi) { const f32x2_t v = {lo, hi}; const bf16x2_t b = __builtin_convertvector(v, bf16x2_t); return __builtin_bit_cast(unsigned, b); }

template <class Epi, class Sched, bool ALIGN_EPI, bool GATHER, int K>
__device__ __forceinline__ void gemm_phase(PG8_LAS unsigned char* lds, const Sched& S, const Epi& E, const int wid) {
    int lane_; asm volatile("v_mbcnt_lo_u32_b32 %0, -1, 0\n\tv_mbcnt_hi_u32_b32 %0, -1, %0" : "=v"(lane_));
    const int lane = lane_, tid = wid * 64 + lane, wr = wid >> 2, wc = wid & 3, fr = lane & 15, fq = lane >> 4;
    constexpr int nt = K / BK;
    unsigned voffA[2], voffB[2];
#pragma unroll
    for (int i = 0; i < 2; ++i) { int R, C; stage_rc(tid * 16 + i * 8192, R, C); const int Rb = Epi::PERM ? ((R & ~31) + perm32(R & 31)) : R;
        voffA[i] = (unsigned)(R * K + C) * 2u; voffB[i] = (unsigned)(Rb * K + C) * 2u; }
    constexpr size_t kstep = (size_t)(BK * 2);
    constexpr size_t hstep = (size_t)HALF * K * 2;
    const unsigned ldsw = (unsigned)wid * 1024u;
    const int aoff = lds_byte(wr * 64 + fr, fq * 8), boff = lds_byte(wc * 32 + fr, fq * 8);
#define PG8_SA(b, h) (((b) * 2 + (h)) * HTB)
#define PG8_SB(b, h) ((4 + (b) * 2 + (h)) * HTB)
#define PG8_STAGE(bufoff, gbase, voff) do { _Pragma("unroll") for (int _i = 0; _i < 2; ++_i) \
        __builtin_amdgcn_global_load_lds((const unsigned*)((const char*)(gbase) + (voff)[_i]), (PG8_LAS unsigned*)(lds + (bufoff) + ldsw + _i * 8192), 16, 0, 0); } while (0)
#define PG8_LDA(dst, b, h) do { _Pragma("unroll") for (int m = 0; m < 4; ++m) _Pragma("unroll") for (int k = 0; k < 2; ++k) dst[m][k] = *(const PG8_LAS bf16x8*)(lds + PG8_SA(b, h) + aoff + m * 2048 + k * 1024); } while (0)
#define PG8_LDB(dst, b, h) do { _Pragma("unroll") for (int n = 0; n < 2; ++n) _Pragma("unroll") for (int k = 0; k < 2; ++k) dst[n][k] = *(const PG8_LAS bf16x8*)(lds + PG8_SB(b, h) + boff + n * 2048 + k * 1024); } while (0)
#define PG8_MMA(ai, bj, At, Bt) do { __builtin_amdgcn_s_setprio(1); _Pragma("unroll") for (int m = 0; m < 4; ++m) _Pragma("unroll") for (int n = 0; n < 2; ++n) _Pragma("unroll") for (int k = 0; k < 2; ++k) \
        acc[ai][bj][m][n] = __builtin_amdgcn_mfma_f32_16x16x32_bf16(Bt[n][k], At[m][k], acc[ai][bj][m][n], 0, 0, 0); __builtin_amdgcn_s_setprio(0); } while (0)
#define PG8_WAIT_V(n) asm volatile("s_waitcnt vmcnt(" #n ")" ::: "memory")
#define PG8_WAIT_L(n) asm volatile("s_waitcnt lgkmcnt(" #n ")" ::: "memory")
#define PG8_BAR __builtin_amdgcn_s_barrier()
#define PG8_SCHED __builtin_amdgcn_sched_barrier(0)
    Unit cur, nxt; int ui = 0;
    if (!S.next(0, cur)) return;
    f32x4 acc[2][2][4][2];
#pragma unroll
    for (int a = 0; a < 2; ++a)
#pragma unroll
        for (int b = 0; b < 2; ++b)
#pragma unroll
            for (int m = 0; m < 4; ++m)
#pragma unroll
                for (int n = 0; n < 2; ++n) acc[a][b][m][n] = (f32x4){0.f, 0.f, 0.f, 0.f};
    bf16x8 At[4][2], B0[2][2], B1[2][2];
    unsigned vc[2][2];
#define PG8_GOFF(u) do { _Pragma("unroll") for (int _h = 0; _h < 2; ++_h) _Pragma("unroll") for (int _i = 0; _i < 2; ++_i) { int _R, _C; stage_rc(tid * 16 + _i * 8192, _R, _C); \
        vc[_h][_i] = S.a_row_off(u, _h * HALF + _R) + (unsigned)_C * 2u; } } while (0)
#define PG8_STAGE_A(bufoff, gbase, h) do { if constexpr (GATHER) { PG8_STAGE(bufoff, gbase, vc[h]); } else { PG8_STAGE(bufoff, (gbase) + (h) * hstep, voffA); } } while (0)
    if constexpr (GATHER) PG8_GOFF(cur);
    const char* cA = S.a_base(cur); const char* cB = S.b_base(cur);
    PG8_STAGE(PG8_SB(0, 0), cB, voffB); PG8_STAGE(PG8_SB(0, 1), cB + hstep, voffB); PG8_STAGE_A(PG8_SA(0, 0), cA, 0); PG8_STAGE_A(PG8_SA(0, 1), cA, 1);
    if (wr == 1) PG8_BAR;
    PG8_WAIT_V(2); PG8_BAR;
    PG8_STAGE(PG8_SB(1, 0), cB + kstep, voffB); PG8_STAGE_A(PG8_SA(1, 0), cA + kstep, 0); PG8_STAGE(PG8_SB(1, 1), cB + hstep + kstep, voffB);
    PG8_WAIT_V(6); PG8_BAR;
    for (;;) {
        const bool has_next = S.next(ui + 1, nxt);
        const char* nA = has_next ? S.a_base(nxt) : cA; const char* nB = has_next ? S.b_base(nxt) : cB;
        for (int t = 0; t < nt; t += 2) {
            const bool last = (t == nt - 2);
            const char* a1 = cA + (size_t)(t + 1) * kstep;
            const char* a2 = last ? nA : cA + (size_t)(t + 2) * kstep; const char* b2 = last ? nB : cB + (size_t)(t + 2) * kstep;
            const char* a3 = a2 + kstep; const char* b3 = b2 + kstep;
            PG8_LDB(B0, 0, 0); PG8_LDB(B1, 0, 1); PG8_SCHED; PG8_LDA(At, 0, 0); PG8_STAGE_A(PG8_SA(1, 1), a1, 1);
            if constexpr (GATHER) { if (last && has_next) PG8_GOFF(nxt); }
            PG8_WAIT_V(8); PG8_WAIT_L(0); PG8_BAR; PG8_MMA(0, 0, At, B0); PG8_MMA(0, 1, At, B1); PG8_BAR; PG8_SCHED;
            PG8_LDA(At, 0, 1); PG8_STAGE(PG8_SB(0, 0), b2, voffB); PG8_STAGE(PG8_SB(0, 1), b2 + hstep, voffB); PG8_STAGE_A(PG8_SA(0, 0), a2, 0);
            PG8_WAIT_V(8); PG8_WAIT_L(0); PG8_BAR; PG8_MMA(1, 0, At, B0); PG8_MMA(1, 1, At, B1); PG8_BAR; PG8_SCHED;
            PG8_LDB(B0, 1, 0); PG8_LDB(B1, 1, 1); PG8_SCHED; PG8_LDA(At, 1, 0); PG8_STAGE_A(PG8_SA(0, 1), a2, 1);
            PG8_WAIT_V(8); PG8_WAIT_L(0); PG8_BAR; PG8_MMA(0, 0, At, B0); PG8_MMA(0, 1, At, B1); PG8_BAR; PG8_SCHED;
            PG8_LDA(At, 1, 1); PG8_STAGE(PG8_SB(1, 0), b3, voffB); PG8_STAGE(PG8_SB(1, 1), b3 + hstep, voffB); PG8_STAGE_A(PG8_SA(1, 0), a3, 0);
            PG8_WAIT_V(8); PG8_WAIT_L(0); PG8_BAR; PG8_MMA(1, 0, At, B0); PG8_MMA(1, 1, At, B1); PG8_BAR; PG8_SCHED;
        }
        if constexpr (ALIGN_EPI) { if (wr == 0) PG8_BAR; }
        E(acc, cur, wr, wc, fr, fq);
        if (!has_next) break;
#pragma unroll
        for (int a = 0; a < 2; ++a)
#pragma unroll
            for (int b = 0; b < 2; ++b)
#pragma unroll
                for (int m = 0; m < 4; ++m)
#pragma unroll
                    for (int n = 0; n < 2; ++n) acc[a][b][m][n] = (f32x4){0.f, 0.f, 0.f, 0.f};
        cur = nxt; cA = nA; cB = nB; ++ui;
        if constexpr (ALIGN_EPI) { if (wr == 1) PG8_BAR; }
    }
    PG8_WAIT_V(0);
    if constexpr (!ALIGN_EPI) { if (wr == 0) PG8_BAR; }
    PG8_BAR;
#undef PG8_SA
#undef PG8_SB
#undef PG8_STAGE
#undef PG8_STAGE_A
#undef PG8_GOFF
#undef PG8_LDA
#undef PG8_LDB
#undef PG8_MMA
#undef PG8_WAIT_V
#undef PG8_WAIT_L
#undef PG8_BAR
#undef PG8_SCHED
}
}

constexpr int NWAVES = 8;
#ifndef MK_DEBUG
#define MK_DEBUG 0
#endif
#ifndef DBG_USE_NAIVE
#define DBG_USE_NAIVE 0
#endif
constexpr int DBGP = MK_DEBUG ? 3 : 0;
enum Phase { PH_P0 = 0, PH_LORA, PH_RKV, PH_S1, PH_S2, PH_S3, PH_DBG0, PH_WOUT = PH_DBG0 + DBGP, PH_ROUT0, PH_GU0, PH_DN0, PH_COMB, PH_KVQ, PH_ATTN, PH_SBO, PH_ROUT1, PH_GU1, PH_DN1, PH_FINAL, NPHASE };
constexpr int N_LAUNCHES = MK_N_LAUNCHES;


constexpr int BATCH = 2, SEQ = 8192, C = 1024, NH = 16, HD = 64, M = BATCH * SEQ;
constexpr int NE = 16, FE = 256, DW = 64, DA = 64, DG = 160;
constexpr float RMS_EPS = 1e-6f, GN_EPS = 64e-5f;
constexpr float SB_EXIT = 104.0f;

constexpr size_t MiB = 1u << 20;
constexpr size_t WS_CTL = 0, CTL_ZERO_BYTES = 64 * 1024;
constexpr size_t WS_WT_W2 = 128 * 1024, WS_WT_A2 = 256 * 1024, WS_WT_G2 = 384 * 1024;
constexpr size_t WS_WT_RKV = 1 * MiB;
constexpr size_t WS_WT_LORA = 7 * MiB;
constexpr size_t WS_WT_OUT = 9 * MiB;
constexpr size_t WS_WT_KVQ = 11 * MiB;
constexpr size_t WS_WT_SBO = 17 * MiB;
constexpr size_t WS_WT_GU = 19 * MiB;
constexpr size_t WS_WT_DN = 51 * MiB;
constexpr size_t WS_LW = 67 * MiB;
constexpr size_t WS_LA = 69 * MiB;
constexpr size_t WS_LG = 71 * MiB;
static_assert(WS_LA == WS_LW + 2 * MiB && WS_LG == WS_LW + 4 * MiB, "EpiLora's pointer arithmetic");
constexpr size_t WS_LIST = 76 * MiB;
constexpr size_t WS_WL = 77 * MiB;
constexpr size_t WS_HID = 78 * MiB;
constexpr size_t WS_B0 = 96 * MiB, WS_B1 = 128 * MiB, WS_B2 = 160 * MiB, WS_B3 = 192 * MiB, WS_B4 = 224 * MiB, WS_END = 256 * MiB;
static_assert(WS_HID + (size_t)144 * 256 * 256 * 2 <= WS_B0, "HID vs B0");
constexpr int CW_TMO = 0;
constexpr int CW_CNT = 1024;
constexpr int CW_BAR = 4096;

constexpr int RING_BYTES = 131072;
constexpr int LDSCTL_OFF = 146688, MISC_OFF = LDSCTL_OFF + 320, MOE_TAB_OFF = MISC_OFF + 128;
constexpr int LDS_BYTES = 147456;
static_assert(MOE_TAB_OFF + 256 <= LDS_BYTES, "LDS map");
static_assert(BATCH * NH * (SEQ / 64) % 16 == 0, "scan units");

#define GAS __attribute__((address_space(1)))
#define LAS __attribute__((address_space(3)))
typedef unsigned short bf16;
typedef unsigned v4u __attribute__((ext_vector_type(4)));
typedef unsigned v2u __attribute__((ext_vector_type(2)));
typedef float f32x4 __attribute__((ext_vector_type(4)));
typedef GAS unsigned gu32;
#define RLX_AGENT __ATOMIC_RELAXED, __HIP_MEMORY_SCOPE_AGENT
#define LDS_WAIT() asm volatile("s_waitcnt lgkmcnt(0)" ::: "memory")
#define VM_WAIT() asm volatile("s_waitcnt vmcnt(0)" ::: "memory")
__device__ __forceinline__ unsigned f2bf(float f) { unsigned u = __builtin_bit_cast(unsigned, f); return (u + 0x7fffu + ((u >> 16) & 1u)) >> 16; }
__device__ __forceinline__ unsigned pk2(float lo, float hi) { return f2bf(lo) | (f2bf(hi) << 16); }
__device__ __forceinline__ float bflo(unsigned u) { return __uint_as_float(u << 16); }
__device__ __forceinline__ float bfhi(unsigned u) { return __uint_as_float(u & 0xffff0000u); }
__device__ __forceinline__ float bf2f(bf16 b) { return __uint_as_float((unsigned)b << 16); }
__device__ __forceinline__ float sigmoidf_(float x) { return 1.0f / (1.0f + __expf(-x)); }

#define XB_TMO      128
#define XB_XCNT(j)  (256  + 64 * (j))
#define XB_XSUB(j)  (1280 + 64 * (j))
#define XB_XGEN(j)  (2304 + 64 * (j))
#define XB_TOP      3328
#define XB_TOPGEN   3392
#define XCD_BAR_WORDS 3456
#define XB_SPIN_CAP (1u << 18)
__device__ __forceinline__ unsigned xb_ld(unsigned* p)              { return __hip_atomic_load(p, __ATOMIC_RELAXED, __HIP_MEMORY_SCOPE_AGENT); }
__device__ __forceinline__ unsigned xb_add(unsigned* p, unsigned v) { return __hip_atomic_fetch_add(p, v, __ATOMIC_RELAXED, __HIP_MEMORY_SCOPE_AGENT); }
__device__ __forceinline__ unsigned xb_xcc_id() { return (unsigned)__builtin_amdgcn_s_getreg((3 << 11) | 20) & 0xFu; }
#define XB_SPIN(cond, bar) do { unsigned _sp = 0; while (cond) { __builtin_amdgcn_s_sleep(1); \
    if ((++_sp & 255u) == 0u) { if (xb_ld(&(bar)[XB_TMO])) break; if (_sp > XB_SPIN_CAP) { atomicAdd(&(bar)[XB_TMO], 1u); break; } } } } while (0)
struct XcdBarrier { unsigned* bar; unsigned x; volatile LAS unsigned* st; };
__device__ __forceinline__ XcdBarrier xcd_barrier_post(unsigned* bar, volatile LAS unsigned* st) {
    XcdBarrier b; b.bar = bar; b.x = xb_xcc_id(); b.st = st;
    if (threadIdx.x == 0) (void)xb_add(&bar[XB_XCNT(b.x)], 1u);
    return b;
}
__device__ __forceinline__ void xcd_barrier_complete(unsigned* bar, unsigned x, unsigned& nloc, unsigned& nx) {
    const unsigned G = gridDim.x * gridDim.y * gridDim.z;
    unsigned sum, cnt, mine, sp = 0u;
    for (;;) {
        sum = 0u; cnt = 0u; mine = 0u;
#pragma unroll
        for (unsigned j = 0; j < 16; ++j) { const unsigned c = xb_ld(&bar[XB_XCNT(j)]); sum += c; cnt += (c > 0u) ? 1u : 0u; mine = (j == x) ? c : mine; }
        if (sum == G) break;
        __builtin_amdgcn_s_sleep(1);
        if ((++sp & 255u) == 0u) { if (xb_ld(&bar[XB_TMO])) break; if (sp > XB_SPIN_CAP) { atomicAdd(&bar[XB_TMO], 1u); break; } }
    }
    nloc = mine > 0u ? mine : 1u; nx = cnt > 0u ? cnt : 1u;
}
__device__ __forceinline__ void xcd_barrier(const XcdBarrier& b) {
    asm volatile("s_waitcnt vmcnt(0)" ::: "memory");
    __syncthreads();
    if (threadIdx.x == 0) {
        unsigned* bar = b.bar;
        __builtin_amdgcn_s_waitcnt(0);
        unsigned nloc = b.st[0], nx = b.st[1];
        if (nloc == 0u) { xcd_barrier_complete(bar, b.x, nloc, nx); b.st[0] = nloc; b.st[1] = nx; }
        const unsigned old = xb_add(&bar[XB_XSUB(b.x)], 1u);
        const unsigned gen = old / nloc;
        if (old + 1u == (gen + 1u) * nloc) {
            __builtin_amdgcn_fence(__ATOMIC_RELEASE, "agent");
            asm volatile("s_waitcnt vmcnt(0)" ::: "memory");
            const unsigned og = xb_add(&bar[XB_TOP], 1u);
            const unsigned tg = og / nx;
            if (og + 1u == (tg + 1u) * nx) xb_add(&bar[XB_TOPGEN], 1u);
            else XB_SPIN(xb_ld(&bar[XB_TOPGEN]) == tg, bar);
            __builtin_amdgcn_fence(__ATOMIC_ACQUIRE, "agent");
            xb_add(&bar[XB_XGEN(b.x)], 1u);
            asm volatile("s_waitcnt vmcnt(0)" ::: "memory");
        } else {
            XB_SPIN(xb_ld(&bar[XB_XGEN(b.x)]) == gen, bar);
            __builtin_amdgcn_fence(__ATOMIC_ACQUIRE, "agent");
            asm volatile("s_waitcnt vmcnt(0)" ::: "memory");
        }
    }
    __syncthreads();
}

__device__ __forceinline__ float shx(float v, int o, int lane) { return __int_as_float(__builtin_amdgcn_ds_bpermute((lane ^ o) << 2, __float_as_int(v))); }
__device__ __forceinline__ float wave_sum(float v, int lane) {
#pragma unroll
    for (int o = 1; o < 64; o <<= 1) v += shx(v, o, lane);
    return v;
}
__device__ __forceinline__ void transpose_item(const float* W, int ldw, int k0, int n0, bf16* WT, int ldk, int dst_row0, const float* kscale, LAS float* scr, int lane, int kmax = 1 << 30) {
    const int r8 = lane >> 3, quad = lane & 7;
    f32x4 v[8];
#pragma unroll
    for (int i = 0; i < 8; ++i) { const int kk = r8 + 8 * i; v[i] = (k0 + kk < kmax) ? *(const GAS f32x4*)(W + (size_t)(k0 + kk) * ldw + n0 + quad * 4) : (f32x4){0.f, 0.f, 0.f, 0.f}; }
#pragma unroll
    for (int i = 0; i < 8; ++i) { const int kk = r8 + 8 * i; if (kscale) v[i] = v[i] * kscale[(k0 + kk < kmax) ? k0 + kk : 0]; *(LAS f32x4*)(scr + kk * 36 + ((quad ^ i) << 2)) = v[i]; }
    LDS_WAIT(); asm volatile("" ::: "memory");
    const int c = lane & 7;
#pragma unroll
    for (int j = 0; j < 4; ++j) { const int n = (lane >> 3) + 8 * j; const LAS float* sp = scr + (8 * c) * 36 + ((((n >> 2) ^ c) << 2) | (n & 3));
        v4u o; o.x = pk2(sp[0 * 36], sp[1 * 36]); o.y = pk2(sp[2 * 36], sp[3 * 36]); o.z = pk2(sp[4 * 36], sp[5 * 36]); o.w = pk2(sp[6 * 36], sp[7 * 36]);
        if (k0 + 8 * c < kmax) *(GAS v4u*)(WT + (size_t)(dst_row0 + n) * ldk + k0 + 8 * c) = o; }
    LDS_WAIT(); asm volatile("" ::: "memory");
}

struct Args { const float* in[31]; float* out; unsigned char* ws; int ph_lo, ph_hi, li, pad; };
typedef const __attribute__((address_space(4))) unsigned char* kaptr_t;
__device__ __forceinline__ kaptr_t ka_base() { kaptr_t p = (kaptr_t)__builtin_amdgcn_kernarg_segment_ptr(); asm volatile("" : "+s"(p)); return p; }
#define INP(k) (*(const float* const __attribute__((address_space(4)))*)(ka_base() + 8 * (k)))
#define OUTP() (*(float* const __attribute__((address_space(4)))*)(ka_base() + 8 * 31))
#define WSP() (*(unsigned char* const __attribute__((address_space(4)))*)(ka_base() + 8 * 32))
#define KA_INT(i) (*(const int __attribute__((address_space(4)))*)(ka_base() + 8 * 33 + 4 * (i)))

template <int PART> __device__ __forceinline__ void p0_weights(unsigned char* ws, LAS unsigned char* lds, int gw, int NGW, int wave, int lane) {
    LAS float* scr = (LAS float*)(lds + wave * 16384);
    bf16* WT_RKV = (bf16*)(ws + WS_WT_RKV); bf16* WT_LORA = (bf16*)(ws + WS_WT_LORA); bf16* WT_OUT = (bf16*)(ws + WS_WT_OUT); bf16* WT_KVQ = (bf16*)(ws + WS_WT_KVQ);
    bf16* WT_SBO = (bf16*)(ws + WS_WT_SBO); bf16* WT_GU = (bf16*)(ws + WS_WT_GU); bf16* WT_DN = (bf16*)(ws + WS_WT_DN);
    constexpr int I_UP = 32 + 32 + 96, I_RKV = 3 * 512, I_LORA = 32 + 32 + 80, I_OUT = 512, I_KV = 1024, I_Q = 512, I_SBO = 512, I_G = 32 * 128, I_U = 32 * 128, I_D = 32 * 128;
    constexpr int NDENSE = I_UP + I_RKV + I_LORA + I_OUT + I_KV + I_Q + I_SBO, NITEMS = NDENSE + I_G + I_U + I_D;
    for (int it = (PART == 0 ? 0 : NDENSE) + gw; it < (PART == 0 ? NDENSE : NITEMS); it += NGW) {
        int r = it;
        if (r < I_UP) {
            if (r < 32) transpose_item(INP(9), C, 0, 32 * r, (bf16*)(ws + WS_WT_W2), 64, 32 * r, nullptr, scr, lane);
            else if (r < 64) transpose_item(INP(12), C, 0, 32 * (r - 32), (bf16*)(ws + WS_WT_A2), 64, 32 * (r - 32), nullptr, scr, lane);
            else { const int q = r - 64, kb = q / 32, nb = q % 32; transpose_item(INP(14), C, 64 * kb, 32 * nb, (bf16*)(ws + WS_WT_G2), DG, 32 * nb, nullptr, scr, lane, DG); }
            continue; } r -= I_UP;
        if (r < I_RKV) { const int m = r / 512, q = r % 512, kb = q / 32, nb = q % 32; transpose_item(INP(6) + (size_t)m * C * C, C, 64 * kb, 32 * nb, WT_RKV, C, m * C + 32 * nb, nullptr, scr, lane); continue; } r -= I_RKV;
        if (r < I_LORA) {
            if (r < 32) { const int kb = r / 2, nb = r % 2; transpose_item(INP(8), DW, 64 * kb, 32 * nb, WT_LORA, C, 32 * nb, nullptr, scr, lane); }
            else if (r < 64) { const int q = r - 32, kb = q / 2, nb = q % 2; transpose_item(INP(11), DA, 64 * kb, 32 * nb, WT_LORA, C, 256 + 32 * nb, nullptr, scr, lane); }
            else { const int q = r - 64, kb = q / 5, nb = q % 5; transpose_item(INP(13), DG, 64 * kb, 32 * nb, WT_LORA, C, 512 + 32 * nb, nullptr, scr, lane); }
            continue; } r -= I_LORA;
        if (r < I_OUT) { const int kb = r / 32, nb = r % 32; transpose_item(INP(20), C, 64 * kb, 32 * nb, WT_OUT, C, 32 * nb, nullptr, scr, lane); continue; } r -= I_OUT;
        if (r < I_KV) { const int kb = r / 64, nb = r % 64; transpose_item(INP(21), 2 * C, 64 * kb, 32 * nb, WT_KVQ, C, 32 * nb, INP(3), scr, lane); continue; } r -= I_KV;
        if (r < I_Q) { const int kb = r / 32, nb = r % 32; transpose_item(INP(22), C, 64 * kb, 32 * nb, WT_KVQ, C, 2 * C + 32 * nb, INP(1) + C, scr, lane); continue; } r -= I_Q;
        if (r < I_SBO) { const int kb = r / 32, nb = r % 32; transpose_item(INP(23), C, 64 * kb, 32 * nb, WT_SBO, C, 32 * nb, nullptr, scr, lane); continue; } r -= I_SBO;
        if (r < I_G) { const int le = r / 128, q = r % 128, kb = q / 8, nb = q % 8, f0 = 32 * nb; transpose_item(INP(28) + (size_t)le * C * FE, FE, 64 * kb, f0, WT_GU + (size_t)le * 512 * C, C, 256 * (f0 / 128) + (f0 % 128), nullptr, scr, lane); continue; } r -= I_G;
        if (r < I_U) { const int le = r / 128, q = r % 128, kb = q / 8, nb = q % 8, f0 = 32 * nb; transpose_item(INP(29) + (size_t)le * C * FE, FE, 64 * kb, f0, WT_GU + (size_t)le * 512 * C, C, 256 * (f0 / 128) + 128 + (f0 % 128), nullptr, scr, lane); continue; } r -= I_U;
        { const int le = r / 128, q = r % 128, kb = q / 32, nb = q % 32; transpose_item(INP(30) + (size_t)le * FE * C, C, 64 * kb, 32 * nb, WT_DN + (size_t)le * C * FE, FE, 32 * nb, nullptr, scr, lane); }
    }
    if (PART == 0) for (int it = gw * 64 + lane; it < 768 * 128; it += NGW * 64) { const int row = it >> 7, ch = it & 127;
        const bool valid = (row < 64) || (row >= 256 && row < 320) || (row >= 512 && row < 672);
        if (!valid) *(GAS v4u*)(WT_LORA + (size_t)row * C + ch * 8) = (v4u){0u, 0u, 0u, 0u}; }
}
__device__ __forceinline__ void load_row(const float* p, int lane, f32x4 (&v)[4]) {
#pragma unroll
    for (int j = 0; j < 4; ++j) v[j] = ((const GAS f32x4*)p)[64 * j + lane];
}
__device__ __forceinline__ void load_row_bf(const bf16* p, int lane, f32x4 (&v)[4]) {
#pragma unroll
    for (int j = 0; j < 4; ++j) { const v2u w = ((const GAS v2u*)p)[64 * j + lane]; v[j] = (f32x4){bflo(w.x), bfhi(w.x), bflo(w.y), bfhi(w.y)}; }
}
__device__ __forceinline__ float row_rs(const f32x4 (&v)[4], int lane) {
    float s = 0.f;
#pragma unroll
    for (int j = 0; j < 4; ++j) s += (v[j].x * v[j].x + v[j].y * v[j].y) + (v[j].z * v[j].z + v[j].w * v[j].w);
    return 1.0f / sqrtf(wave_sum(s, lane) * (1.0f / C) + RMS_EPS);
}
__device__ __forceinline__ void store_row_bf16(bf16* p, int lane, const f32x4 (&v)[4]) {
#pragma unroll
    for (int j = 0; j < 4; ++j) { v2u o; o.x = pk2(v[j].x, v[j].y); o.y = pk2(v[j].z, v[j].w); ((GAS v2u*)p)[64 * j + lane] = o; }
}
__device__ __forceinline__ void p0_rows(unsigned char* ws, int gw, int NGW, int lane) {
    const float* x = INP(0); const float* gain = INP(1); const float* mix = INP(5);
    f32x4 g[4]; load_row(gain, lane, g);
    for (int run = gw; run < M / 8; run += NGW) {
        const int r0 = run * 8;
        f32x4 prev[4];
        if ((r0 % SEQ) == 0) {
#pragma unroll
            for (int j = 0; j < 4; ++j) prev[j] = (f32x4){0.f, 0.f, 0.f, 0.f};
        } else { load_row(x + (size_t)(r0 - 1) * C, lane, prev); const float rs = row_rs(prev, lane);
#pragma unroll
            for (int j = 0; j < 4; ++j) prev[j] = prev[j] * rs * g[j]; }
        for (int rr = 0; rr < 8; ++rr) {
            const int row = r0 + rr;
            f32x4 hn[4]; load_row(x + (size_t)row * C, lane, hn); const float rs = row_rs(hn, lane);
#pragma unroll
            for (int j = 0; j < 4; ++j) hn[j] = hn[j] * rs * g[j];
#pragma unroll
            for (int i = 0; i < 6; ++i) { f32x4 o[4];
#pragma unroll
                for (int j = 0; j < 4; ++j) { const f32x4 mx = ((const GAS f32x4*)(mix + i * C))[64 * j + lane]; o[j] = hn[j] + (prev[j] - hn[j]) * mx; }
                bf16* dst = i < 2 ? (bf16*)OUTP() + (size_t)i * M * C : (i == 2 ? (bf16*)(ws + WS_B4) : (bf16*)(ws + WS_B1) + (size_t)(i - 3) * M * C);
                store_row_bf16(dst + (size_t)row * C, lane, o); }
#pragma unroll
            for (int j = 0; j < 4; ++j) prev[j] = hn[j];
        }
    }
}

template <int NN, int NGROUPS> struct SchedGrouped {
    static constexpr int K = C;
    const char* A0; size_t astride; const char* A2; const char* B; size_t bgroup;
    int G, c;
    __device__ __forceinline__ bool next(int i, pg8::Unit& u) const {
        const int L = i * G + c; constexpr int per = 64 * NN; if (L >= per * NGROUPS) return false;
        const int g = L / per, w = L % per; pg8::tile_map(w, 64, NN, u.pm, u.pn); u.aux = g; u.r0 = 0; u.cnt = 0; return true; }
    __device__ __forceinline__ const char* a_base(const pg8::Unit& u) const { const char* A = (A2 != nullptr && u.aux == 2) ? A2 : A0 + (size_t)u.aux * astride; return A + (size_t)u.pm * 256 * K * 2; }
    __device__ __forceinline__ const char* b_base(const pg8::Unit& u) const { return B + (size_t)u.aux * bgroup + (size_t)u.pn * 256 * K * 2; }
    __device__ __forceinline__ unsigned a_row_off(const pg8::Unit&, int) const { return 0u; }
};
template <int NN, int K, bool GATHER> struct SchedMoe {
    const char* A; const char* B; size_t bexp; const unsigned* list; volatile LAS int* tab; int G, c;
    __device__ __forceinline__ bool next(int i, pg8::Unit& u) const {
        const int L = i * G + c; const int tot = __builtin_amdgcn_readfirstlane(tab[48]) * NN; if (L >= tot) return false;
        u.pm = L / NN; u.pn = L % NN; int e = 0;
#pragma unroll
        for (int j = 0; j < 16; ++j) e += (u.pm >= tab[32 + j]) ? 1 : 0;
        e = __builtin_amdgcn_readfirstlane(e);
        u.aux = e; u.r0 = (u.pm - __builtin_amdgcn_readfirstlane(tab[16 + e])) * 256; u.cnt = __builtin_amdgcn_readfirstlane(tab[e]); return true; }
    __device__ __forceinline__ const char* a_base(const pg8::Unit& u) const { return GATHER ? A : A + (size_t)u.pm * 256 * K * 2; }
    __device__ __forceinline__ const char* b_base(const pg8::Unit& u) const { return B + (size_t)u.aux * bexp + (size_t)u.pn * 256 * K * 2; }
    __device__ __forceinline__ unsigned a_row_off(const pg8::Unit& u, int r) const {
        const int idx = u.r0 + r; unsigned tok = 0u;
        if (idx < u.cnt) tok = list[(size_t)u.aux * M + idx] >> 1;
        return tok * (unsigned)(K * 2); }
};

using pg8::f32x4;
using pg8::Unit;
__device__ __forceinline__ v4u pack8(f32x4 v0, f32x4 v1) { v4u w; w.x = pg8::cvt_pk_bf16(v0[0], v0[1]); w.y = pg8::cvt_pk_bf16(v0[2], v0[3]); w.z = pg8::cvt_pk_bf16(v1[0], v1[1]); w.w = pg8::cvt_pk_bf16(v1[2], v1[3]); return w; }

struct EpiLora {
    static constexpr bool PERM = true;
    bf16* LW;
    __device__ __forceinline__ void operator()(const f32x4 (&acc)[2][2][4][2], const Unit& u, int wr, int wc, int fr, int fq) const {
        { int l_; asm volatile("v_mbcnt_lo_u32_b32 %0, -1, 0\n\tv_mbcnt_hi_u32_b32 %0, -1, %0" : "=v"(l_)); fr = l_ & 15; fq = l_ >> 4; }
        const int g = u.aux, width = g == 2 ? DG : DW; bf16* out = LW + (size_t)g * (1u << 20);
        const int row0 = u.pm * 256 + wr * 64 + fr;
#pragma unroll
        for (int bj = 0; bj < 2; ++bj) { const int col0 = bj * 128 + wc * 32 + 8 * fq; if (col0 < width) {
#pragma unroll
            for (int ai = 0; ai < 2; ++ai)
#pragma unroll
                for (int m = 0; m < 4; ++m) { f32x4 v0 = acc[ai][bj][m][0], v1 = acc[ai][bj][m][1];
                    if (g == 0) {
#pragma unroll
                        for (int q = 0; q < 4; ++q) { v0[q] = tanhf(v0[q]); v1[q] = tanhf(v1[q]); } }
                    else if (g == 2) {
#pragma unroll
                        for (int q = 0; q < 4; ++q) { v0[q] = sigmoidf_(v0[q]); v1[q] = sigmoidf_(v1[q]); } }
                    *(GAS v4u*)(out + (size_t)(row0 + ai * 128 + m * 16) * width + col0) = pack8(v0, v1); } } }
    }
};
struct EpiSplit3 {
    static constexpr bool PERM = true;
    bf16* O0; bool bycol;
    __device__ __forceinline__ void operator()(const f32x4 (&acc)[2][2][4][2], const Unit& u, int wr, int wc, int fr, int fq) const {
        { int l_; asm volatile("v_mbcnt_lo_u32_b32 %0, -1, 0\n\tv_mbcnt_hi_u32_b32 %0, -1, %0" : "=v"(l_)); fr = l_ & 15; fq = l_ >> 4; }
        const int g = bycol ? (u.pn >> 2) : u.aux, pn = bycol ? (u.pn & 3) : u.pn; bf16* out = O0 + (size_t)g * ((size_t)M * C);
        const int row0 = u.pm * 256 + wr * 64 + fr, col0 = pn * 256 + wc * 32 + 8 * fq;
#pragma unroll
        for (int ai = 0; ai < 2; ++ai)
#pragma unroll
            for (int m = 0; m < 4; ++m)
#pragma unroll
                for (int bj = 0; bj < 2; ++bj) *(GAS v4u*)(out + (size_t)(row0 + ai * 128 + m * 16) * C + col0 + bj * 128) = pack8(acc[ai][bj][m][0], acc[ai][bj][m][1]);
    }
};
template <bool BASE_F32> struct EpiResidBf {
    static constexpr bool PERM = true;
    const void* base; bf16* out;
    __device__ __forceinline__ void operator()(const f32x4 (&acc)[2][2][4][2], const Unit& u, int wr, int wc, int fr, int fq) const {
        { int l_; asm volatile("v_mbcnt_lo_u32_b32 %0, -1, 0\n\tv_mbcnt_hi_u32_b32 %0, -1, %0" : "=v"(l_)); fr = l_ & 15; fq = l_ >> 4; }
        const int row0 = u.pm * 256 + wr * 64 + fr, col0 = u.pn * 256 + wc * 32 + 8 * fq;
#pragma unroll
        for (int ai = 0; ai < 2; ++ai)
#pragma unroll
            for (int m = 0; m < 4; ++m) { const size_t off = (size_t)(row0 + ai * 128 + m * 16) * C + col0;
#pragma unroll
                for (int bj = 0; bj < 2; ++bj) { f32x4 b0, b1;
                    if (BASE_F32) { b0 = *(const GAS f32x4*)((const float*)base + off + bj * 128); b1 = *(const GAS f32x4*)((const float*)base + off + bj * 128 + 4); }
                    else { const v4u w = *(const GAS v4u*)((const bf16*)base + off + bj * 128); b0 = (f32x4){bflo(w.x), bfhi(w.x), bflo(w.y), bfhi(w.y)}; b1 = (f32x4){bflo(w.z), bfhi(w.z), bflo(w.w), bfhi(w.w)}; }
                    *(GAS v4u*)(out + off + bj * 128) = pack8(b0 + acc[ai][bj][m][0], b1 + acc[ai][bj][m][1]); }
                asm volatile("" ::: "memory"); }
    }
};
struct EpiGU {
    static constexpr bool PERM = true;
    bf16* HID; const float* wl;
    __device__ __forceinline__ void operator()(const f32x4 (&acc)[2][2][4][2], const Unit& u, int wr, int wc, int fr, int fq) const {
        { int l_; asm volatile("v_mbcnt_lo_u32_b32 %0, -1, 0\n\tv_mbcnt_hi_u32_b32 %0, -1, %0" : "=v"(l_)); fr = l_ & 15; fq = l_ >> 4; }
        const int e = u.aux, cnt = u.cnt, base = u.r0, r0 = wr * 64 + fr, col0 = u.pn * 128 + wc * 32 + 8 * fq;
#pragma unroll
        for (int ai = 0; ai < 2; ++ai)
#pragma unroll
            for (int m = 0; m < 4; ++m) { const int r = r0 + ai * 128 + m * 16, idx = base + r; float w = 0.f; if (idx < cnt) w = wl[(size_t)e * M + idx];
                f32x4 h0, h1;
#pragma unroll
                for (int q = 0; q < 4; ++q) { const float g0 = acc[ai][0][m][0][q], g1 = acc[ai][0][m][1][q];
                    h0[q] = g0 * sigmoidf_(g0) * acc[ai][1][m][0][q] * w; h1[q] = g1 * sigmoidf_(g1) * acc[ai][1][m][1][q] * w; }
                *(GAS v4u*)(HID + (size_t)(u.pm * 256 + r) * FE + col0) = pack8(h0, h1);
                asm volatile("" ::: "memory"); }
    }
};
struct EpiDown {
    static constexpr bool PERM = true;
    bf16* EO; const unsigned* list;
    __device__ __forceinline__ void operator()(const f32x4 (&acc)[2][2][4][2], const Unit& u, int wr, int wc, int fr, int fq) const {
        { int l_; asm volatile("v_mbcnt_lo_u32_b32 %0, -1, 0\n\tv_mbcnt_hi_u32_b32 %0, -1, %0" : "=v"(l_)); fr = l_ & 15; fq = l_ >> 4; }
        const int e = u.aux, cnt = u.cnt, base = u.r0, r0 = wr * 64 + fr, col0 = u.pn * 256 + wc * 32 + 8 * fq;
#pragma unroll
        for (int ai = 0; ai < 2; ++ai)
#pragma unroll
            for (int m = 0; m < 4; ++m) { const int idx = base + r0 + ai * 128 + m * 16;
                if (idx < cnt) { const unsigned ent = list[(size_t)e * M + idx]; bf16* o = EO + ((size_t)(ent & 1u) * M + (ent >> 1)) * C + col0;
#pragma unroll
                    for (int bj = 0; bj < 2; ++bj) *(GAS v4u*)(o + bj * 128) = pack8(acc[ai][bj][m][0], acc[ai][bj][m][1]); }
                asm volatile("" ::: "memory"); }
    }
};

typedef short bf16x8s __attribute__((ext_vector_type(8)));
typedef short bf16x4s __attribute__((ext_vector_type(4)));
typedef short v4i16_t __attribute__((ext_vector_type(4)));
constexpr int TPB = 144;
constexpr int TILE_B = 64 * TPB;
constexpr int FP = 68;
constexpr int CS_FA = 0, CS_FB = 16384, CS_TILES = 32768, CS_TOT = CS_TILES + 12 * TILE_B, CS_WL = CS_TOT + 2048, CS_PAR = CS_WL + 256;
static_assert(CS_PAR + 768 <= LDSCTL_OFF, "scan LDS map");
#define TILE(n) (lds + CS_TILES + (n) * TILE_B)
#define F4Z (f32x4){0.f, 0.f, 0.f, 0.f}
__device__ __forceinline__ bf16x8s ldfrag(const LAS unsigned char* tile, int row, int kcol) { return *(const LAS bf16x8s*)(tile + row * TPB + kcol * 2); }
__device__ __forceinline__ bf16x8s ldfrag_tr(const LAS unsigned char* tile, int n0, int k0, int lane) {
    const int g = lane >> 4, q = (lane & 15) >> 2, p = lane & 3;
    const LAS unsigned char* a = tile + (k0 + 8 * g + q) * TPB + (n0 + 4 * p) * 2;
    const v4i16_t lo = __builtin_amdgcn_ds_read_tr16_b64_v4i16((LAS v4i16_t*)a), hi = __builtin_amdgcn_ds_read_tr16_b64_v4i16((LAS v4i16_t*)(a + 4 * TPB));
    return (bf16x8s){lo[0], lo[1], lo[2], lo[3], hi[0], hi[1], hi[2], hi[3]};
}
__device__ __forceinline__ bf16x8s ldfrag_perm(const LAS unsigned char* tile, int row, int ks, int g) {
    const bf16x4s lo = *(const LAS bf16x4s*)(tile + row * TPB + (32 * ks + 4 * g) * 2), hi = *(const LAS bf16x4s*)(tile + row * TPB + (32 * ks + 16 + 4 * g) * 2);
    return (bf16x8s){lo[0], lo[1], lo[2], lo[3], hi[0], hi[1], hi[2], hi[3]};
}
__device__ __forceinline__ void lds_barrier() { asm volatile("s_waitcnt lgkmcnt(0)" ::: "memory"); __builtin_amdgcn_s_barrier(); asm volatile("" ::: "memory"); }
#define MFMA16(a, b, c) __builtin_amdgcn_mfma_f32_16x16x32_bf16((a), (b), (c), 0, 0, 0)
__device__ __forceinline__ void mm64(f32x4 (&acc)[2], const LAS unsigned char* At, const LAS unsigned char* Bt, int rt, int ch, int fr, int g) {
#pragma unroll
    for (int ks = 0; ks < 2; ++ks) { const bf16x8s a = ldfrag(At, 16 * rt + fr, 32 * ks + 8 * g);
#pragma unroll
        for (int ct = 0; ct < 2; ++ct) acc[ct] = MFMA16(a, ldfrag(Bt, 32 * ch + 16 * ct + fr, 32 * ks + 8 * g), acc[ct]); }
}
__device__ __forceinline__ void mm64_bt(f32x4 (&acc)[2], const LAS unsigned char* At, const LAS unsigned char* X, int rt, int ch, int fr, int g, int lane) {
#pragma unroll
    for (int ks = 0; ks < 2; ++ks) { const bf16x8s a = ldfrag(At, 16 * rt + fr, 32 * ks + 8 * g);
#pragma unroll
        for (int ct = 0; ct < 2; ++ct) acc[ct] = MFMA16(a, ldfrag_tr(X, 32 * ch + 16 * ct, 32 * ks, lane), acc[ct]); }
}
__device__ __forceinline__ void mm64_at(f32x4 (&acc)[2], const LAS unsigned char* Xa, const LAS unsigned char* Bt, int rt, int ch, int fr, int g, int lane) {
#pragma unroll
    for (int ks = 0; ks < 2; ++ks) { const bf16x8s a = ldfrag_tr(Xa, 16 * rt, 32 * ks, lane);
#pragma unroll
        for (int ct = 0; ct < 2; ++ct) acc[ct] = MFMA16(a, ldfrag(Bt, 32 * ch + 16 * ct + fr, 32 * ks + 8 * g), acc[ct]); }
}
__device__ __forceinline__ void mm64_att(f32x4 (&acc)[2], const LAS unsigned char* Xa, const LAS unsigned char* X, int rt, int ch, int lane) {
#pragma unroll
    for (int ks = 0; ks < 2; ++ks) { const bf16x8s a = ldfrag_tr(Xa, 16 * rt, 32 * ks, lane);
#pragma unroll
        for (int ct = 0; ct < 2; ++ct) acc[ct] = MFMA16(a, ldfrag_tr(X, 32 * ch + 16 * ct, 32 * ks, lane), acc[ct]); }
}
__device__ __forceinline__ bf16x4s pack4(f32x4 v) { v2u w; w.x = pg8::cvt_pk_bf16(v[0], v[1]); w.y = pg8::cvt_pk_bf16(v[2], v[3]); return __builtin_bit_cast(bf16x4s, w); }
__device__ __forceinline__ f32x4 unpack4(bf16x4s s) { const v2u w = __builtin_bit_cast(v2u, s); return (f32x4){bflo(w.x), bfhi(w.x), bflo(w.y), bfhi(w.y)}; }
__device__ __forceinline__ void st_tr(LAS unsigned char* Out, const f32x4 (&acc)[2], int rt, int ch, int fr, int g) {
#pragma unroll
    for (int ct = 0; ct < 2; ++ct) *(LAS bf16x4s*)(Out + (32 * ch + 16 * ct + fr) * TPB + (16 * rt + 4 * g) * 2) = pack4(acc[ct]);
}
__device__ __forceinline__ void ld_tr(f32x4 (&acc)[2], const LAS unsigned char* In, int rt, int ch, int fr, int g) {
#pragma unroll
    for (int ct = 0; ct < 2; ++ct) acc[ct] = unpack4(*(const LAS bf16x4s*)(In + (32 * ch + 16 * ct + fr) * TPB + (16 * rt + 4 * g) * 2));
}
__device__ __forceinline__ void unpack8(v4u w, float (&o)[8]) { o[0] = bflo(w.x); o[1] = bfhi(w.x); o[2] = bflo(w.y); o[3] = bfhi(w.y); o[4] = bflo(w.z); o[5] = bfhi(w.z); o[6] = bflo(w.w); o[7] = bfhi(w.w); }
__device__ __forceinline__ v4u pack8f(const float (&o)[8]) { v4u w; w.x = pg8::cvt_pk_bf16(o[0], o[1]); w.y = pg8::cvt_pk_bf16(o[2], o[3]); w.z = pg8::cvt_pk_bf16(o[4], o[5]); w.w = pg8::cvt_pk_bf16(o[6], o[7]); return w; }

struct FrontIn { v4u r, k, v; bf16x8s fw[2], fa[2]; };
__device__ __forceinline__ void front_fetch(FrontIn& f, unsigned char* ws, int unit, int tid, int lane, int wave) {
    const int h = unit & 15, c = (unit >> 4) & 127, b = unit >> 11; const size_t row0 = (size_t)b * SEQ + c * 64;
    const int rt = wave & 3, fr = lane & 15, g = lane >> 4, t = tid >> 3, cq = tid & 7, c0 = h * HD + cq * 8;
    const bf16* Rb = (const bf16*)(ws + WS_B1); const bf16* Kb = (const bf16*)(ws + WS_B2); const bf16* Vb = (const bf16*)(ws + WS_B3);
    const bf16* LW = (const bf16*)(ws + WS_LW); const bf16* LA = (const bf16*)(ws + WS_LA);
    f.r = *(const GAS v4u*)(Rb + (row0 + t) * C + c0); f.k = *(const GAS v4u*)(Kb + (row0 + t) * C + c0); f.v = *(const GAS v4u*)(Vb + (row0 + t) * C + c0);
#pragma unroll
    for (int ks = 0; ks < 2; ++ks) { f.fw[ks] = *(const GAS bf16x8s*)(LW + (row0 + 16 * rt + fr) * DW + 32 * ks + 8 * g); f.fa[ks] = *(const GAS bf16x8s*)(LA + (row0 + 16 * rt + fr) * DA + 32 * ks + 8 * g); }
}
__device__ __forceinline__ v4u head_consts(unsigned char* ws, LAS unsigned char* lds, int h, int tid, int wtile, int atile) {
    const bf16* W2T = (const bf16*)(ws + WS_WT_W2); const bf16* A2T = (const bf16*)(ws + WS_WT_A2);
    const int row = tid >> 3, cq = tid & 7;
    const v4u w2chunk = *(const GAS v4u*)(W2T + (size_t)(h * HD + row) * 64 + cq * 8);
    *(LAS v4u*)(lds + CS_TILES + wtile * TILE_B + row * TPB + cq * 16) = w2chunk;
    *(LAS v4u*)(lds + CS_TILES + atile * TILE_B + row * TPB + cq * 16) = *(const GAS v4u*)(A2T + (size_t)(h * HD + row) * 64 + cq * 8);
    if (tid < 64) { LAS float* P = (LAS float*)(lds + CS_PAR); P[tid] = INP(15)[h * HD + tid]; P[64 + tid] = INP(16)[h * HD + tid]; P[128 + tid] = INP(17)[h * HD + tid]; }
    __syncthreads();
    return w2chunk;
}
template <int MODE>
__device__ __forceinline__ void chunk_front(const FrontIn& f, LAS unsigned char* lds, const float (&w0v)[2], const float (&a0v)[2], int tid, int lane, int wave, float (&v8)[8], float& rkb) {
    const int rt = wave & 3, ch = wave >> 2, fr = lane & 15, g = lane >> 4;
    LAS float* FA = (LAS float*)(lds + CS_FA); LAS float* FB = (LAS float*)(lds + CS_FB); LAS float* TOT = (LAS float*)(lds + CS_TOT);
    const int t = tid >> 3, cq = tid & 7;
    constexpr int WTILE = MODE == 1 ? 6 : 10, ATILE = MODE == 1 ? 8 : 11;
    {
        f32x4 aw[2] = {F4Z, F4Z}, aa[2] = {F4Z, F4Z};
#pragma unroll
        for (int ks = 0; ks < 2; ++ks)
#pragma unroll
            for (int ct = 0; ct < 2; ++ct) { aw[ct] = MFMA16(f.fw[ks], ldfrag(TILE(WTILE), 32 * ch + 16 * ct + fr, 32 * ks + 8 * g), aw[ct]); aa[ct] = MFMA16(f.fa[ks], ldfrag(TILE(ATILE), 32 * ch + 16 * ct + fr, 32 * ks + 8 * g), aa[ct]); }
#pragma unroll
        for (int ct = 0; ct < 2; ++ct) { const int j = 32 * ch + 16 * ct + fr; const float w0 = w0v[ct], a0 = a0v[ct];
#pragma unroll
            for (int q = 0; q < 4; ++q) { const int tt = 16 * rt + 4 * g + q, js = j ^ ((g & 1) << 4);
                FA[tt * 64 + js] = -0.6065306597126334f * sigmoidf_(w0 + aw[ct][q]); FB[tt * 64 + js] = sigmoidf_(a0 + aa[ct][q]); } }
    }
    lds_barrier();
    {
        const int j = tid & 63, seg = tid >> 6; float run = 0.f; float loc[8];
#pragma unroll
        for (int q = 0; q < 8; ++q) { run += FA[(8 * seg + q) * 64 + (j ^ (((q >> 2) & 1) << 4))]; loc[q] = run; }
        TOT[seg * 64 + j] = run;
        lds_barrier();
        float off = 0.f;
#pragma unroll
        for (int s2 = 0; s2 < 7; ++s2) off += (s2 < seg) ? TOT[s2 * 64 + j] : 0.f;
#pragma unroll
        for (int q = 0; q < 8; ++q) FA[(8 * seg + q) * 64 + (j ^ (((q >> 2) & 1) << 4))] = loc[q] + off;
    }
    lds_barrier();
    {
        float r[8], k[8], pkk[8], pka[8], prk[8];
        unpack8(f.r, r); unpack8(f.k, k); unpack8(f.v, v8);
        { const LAS float* P = (const LAS float*)(lds + CS_PAR) + cq * 8; const f32x4 a0_ = *(const LAS f32x4*)P, a1_ = *(const LAS f32x4*)(P + 4), b0_ = *(const LAS f32x4*)(P + 64), b1_ = *(const LAS f32x4*)(P + 68), c0_ = *(const LAS f32x4*)(P + 128), c1_ = *(const LAS f32x4*)(P + 132);
#pragma unroll
          for (int q = 0; q < 4; ++q) { pkk[q] = a0_[q]; pkk[4 + q] = a1_[q]; pka[q] = b0_[q]; pka[4 + q] = b1_[q]; prk[q] = c0_[q]; prk[4 + q] = c1_[q]; } }
        float cw[8], cwp[8], ag[8];
        { const int tp = t > 0 ? t - 1 : 0;
          const int ct_ = (cq ^ (((t >> 2) & 1) << 1)) * 8, cp_ = (cq ^ (((tp >> 2) & 1) << 1)) * 8;
          const f32x4 c0_ = *(const LAS f32x4*)(FA + t * 64 + ct_), c1_ = *(const LAS f32x4*)(FA + t * 64 + ct_ + 4), p0_ = *(const LAS f32x4*)(FA + tp * 64 + cp_), p1_ = *(const LAS f32x4*)(FA + tp * 64 + cp_ + 4);
          const f32x4 g0_ = *(const LAS f32x4*)(FB + t * 64 + ct_), g1_ = *(const LAS f32x4*)(FB + t * 64 + ct_ + 4);
#pragma unroll
          for (int q = 0; q < 4; ++q) { cw[q] = c0_[q]; cw[4 + q] = c1_[q]; cwp[q] = t > 0 ? p0_[q] : 0.f; cwp[4 + q] = t > 0 ? p1_[q] : 0.f; ag[q] = g0_[q]; ag[4 + q] = g1_[q]; } }
        float kk[8], ss = 0.f; rkb = 0.f;
#pragma unroll
        for (int q = 0; q < 8; ++q) { kk[q] = k[q] * pkk[q]; ss += kk[q] * kk[q]; }
        ss += shx(ss, 1, lane); ss += shx(ss, 2, lane); ss += shx(ss, 4, lane);
        const float inv = 1.0f / fmaxf(sqrtf(ss), 1e-12f);
        float at[8], bt[8], kt[8], rt_[8];
#pragma unroll
        for (int q = 0; q < 8; ++q) { const float kn = kk[q] * inv, kp = k[q] * (1.0f + (ag[q] - 1.0f) * pka[q]);
            const float ein = __expf(-cw[q]);
            at[q] = -kn * __expf(cwp[q]); bt[q] = kn * ag[q] * ein; kt[q] = kp * ein;
            rt_[q] = r[q] * __expf(cw[q]); rkb += r[q] * kp * prk[q]; }
        rkb += shx(rkb, 1, lane); rkb += shx(rkb, 2, lane); rkb += shx(rkb, 4, lane);
        *(LAS v4u*)(TILE(0) + t * TPB + cq * 16) = pack8f(at); *(LAS v4u*)(TILE(1) + t * TPB + cq * 16) = pack8f(bt); *(LAS v4u*)(TILE(2) + t * TPB + cq * 16) = pack8f(kt);
        *(LAS v4u*)(TILE(3) + t * TPB + cq * 16) = f.v;
        *(LAS v4u*)(TILE(MODE == 1 ? 6 : 4) + t * TPB + cq * 16) = pack8f(rt_);
        if (MODE == 1 && t == 63) {
#pragma unroll
            for (int q = 0; q < 8; ++q) ((LAS float*)(lds + CS_WL))[cq * 8 + q] = __expf(cw[q]); }
    }
    lds_barrier();
}

__device__ __forceinline__ void scan_s1(unsigned char* ws, LAS unsigned char* lds, int lane0, int wave) {
    const int rt = wave & 3, ch = wave >> 2;
    FrontIn fin; float w0v[2], a0v[2]; v4u w2keep;
    { int l0 = lane0; asm volatile("" : "+v"(l0)); const int hh = blockIdx.x & 15;
      if ((int)blockIdx.x < BATCH * NH * (SEQ / 64)) front_fetch(fin, ws, blockIdx.x, wave * 64 + l0, l0, wave);
#pragma unroll
      for (int ct = 0; ct < 2; ++ct) { w0v[ct] = INP(7)[hh * HD + 32 * ch + 16 * ct + (l0 & 15)]; a0v[ct] = INP(10)[hh * HD + 32 * ch + 16 * ct + (l0 & 15)]; }
      w2keep = head_consts(ws, lds, hh, wave * 64 + l0, 6, 8); }
    for (int unit = blockIdx.x; unit < BATCH * NH * (SEQ / 64); unit += gridDim.x) {
        int lane = lane0; asm volatile("" : "+v"(lane));
        const int tid = wave * 64 + lane, fr = lane & 15, g = lane >> 4;
        const int h = unit & 15, c = (unit >> 4) & 127, b = unit >> 11; const size_t chunk = ((size_t)b * NH + h) * 128 + c;
        float v8[8]; float rkb;
        chunk_front<1>(fin, lds, w0v, a0v, tid, lane, wave, v8, rkb);
        { const size_t row0_ = (size_t)b * SEQ + c * 64; if ((tid & 7) == 0) ((float*)(ws + WS_HID))[(row0_ + (tid >> 3)) * NH + h] = rkb; }
        if (unit + (int)gridDim.x < BATCH * NH * (SEQ / 64)) front_fetch(fin, ws, unit + gridDim.x, tid, lane, wave);
        {
            f32x4 a2[2] = {F4Z, F4Z}, a3[2] = {F4Z, F4Z};
            mm64(a2, TILE(1), TILE(0), rt, ch, fr, g);
            mm64(a3, TILE(2), TILE(0), rt, ch, fr, g);
            f32x4 p1[2];
#pragma unroll
            for (int ct = 0; ct < 2; ++ct) { const int col = 32 * ch + 16 * ct + fr;
#pragma unroll
                for (int q = 0; q < 4; ++q) { const int row = 16 * rt + 4 * g + q;
                    a2[ct][q] = row < col ? a2[ct][q] : 0.f;
                    p1[ct][q] = a2[ct][q] + (row == col ? 1.0f : 0.f);
                    a3[ct][q] = row < col ? a3[ct][q] : 0.f; } }
            st_tr(TILE(5), a2, rt, ch, fr, g);
            st_tr(TILE(9), p1, rt, ch, fr, g);
            st_tr(TILE(4), a3, rt, ch, fr, g);
        }
        lds_barrier();
#pragma unroll
        for (int r = 0; r < 6; ++r) {
            LAS unsigned char* Sr = TILE(5 + 2 * (r & 1)); LAS unsigned char* Sr2 = TILE(5 + 2 * ((r & 1) ^ 1));
            if (r <= 4) { f32x4 q2[2] = {F4Z, F4Z};
                mm64_at(q2, Sr, Sr, rt, ch, fr, g, lane);
                st_tr(Sr2, q2, rt, ch, fr, g); }
            if (r >= 1) { LAS unsigned char* Pr = TILE(9 + ((r - 1) & 1)); LAS unsigned char* Pr2 = TILE(9 + (((r - 1) & 1) ^ 1));
                f32x4 pa[2]; ld_tr(pa, Pr, rt, ch, fr, g);
                mm64_at(pa, Sr, Pr, rt, ch, fr, g, lane);
                st_tr(Pr2, pa, rt, ch, fr, g); }
            if (r == 0) { f32x4 gg[2] = {F4Z, F4Z};
                mm64_bt(gg, TILE(4), TILE(3), rt, ch, fr, g, lane);
                st_tr(TILE(11), gg, rt, ch, fr, g); }
            lds_barrier();
        }
        {
            f32x4 acc[2] = {F4Z, F4Z}, ac2[2] = {F4Z, F4Z};
            mm64_bt(acc, TILE(10), TILE(0), rt, ch, fr, g, lane);
            mm64(ac2, TILE(10), TILE(11), rt, ch, fr, g);
            st_tr(TILE(5), acc, rt, ch, fr, g); st_tr(TILE(7), ac2, rt, ch, fr, g);
            f32x4 b2[2] = {F4Z, F4Z}, b3[2] = {F4Z, F4Z};
            mm64(b2, TILE(1), TILE(6), rt, ch, fr, g); mm64(b3, TILE(2), TILE(6), rt, ch, fr, g);
#pragma unroll
            for (int ct = 0; ct < 2; ++ct) { const int t = 32 * ch + 16 * ct + fr;
#pragma unroll
                for (int q = 0; q < 4; ++q) { const int s_ = 16 * rt + 4 * g + q; b2[ct][q] = s_ <= t ? b2[ct][q] : 0.f; b3[ct][q] = s_ <= t ? b3[ct][q] : 0.f; } }
            st_tr(TILE(4), b2, rt, ch, fr, g); st_tr(TILE(9), b3, rt, ch, fr, g);
        }
        lds_barrier();
        {
            const LAS float* WL = (const LAS float*)(lds + CS_WL);
            f32x4 acc[2] = {F4Z, F4Z};
            mm64_bt(acc, TILE(5), TILE(1), rt, ch, fr, g, lane);
            bf16* Mg = (bf16*)(ws + WS_B0) + chunk * 4096;
#pragma unroll
            for (int ct = 0; ct < 2; ++ct) { const int j1 = 32 * ch + 16 * ct + fr; const float wl = WL[j1];
#pragma unroll
                for (int q = 0; q < 4; ++q) { const int j2 = 16 * rt + 4 * g + q; acc[ct][q] = wl * (acc[ct][q] + (j2 == j1 ? 1.0f : 0.f)); }
                const int rtS = 2 * ch + ct, ksS = rt >> 1, half = rt & 1;
                *(GAS bf16x4s*)(Mg + (((rtS * 2 + ksS) * 64 + g * 16 + fr) * 8 + half * 4)) = pack4(acc[ct]); }
            f32x4 ad[2] = {F4Z, F4Z};
            mm64_at(ad, TILE(1), TILE(7), rt, ch, fr, g, lane);
            mm64_att(ad, TILE(2), TILE(3), rt, ch, lane);
            const f32x4 wl4 = *(const LAS f32x4*)(WL + 16 * rt + 4 * g);
            bf16* Dg = (bf16*)OUTP() + chunk * 4096;
#pragma unroll
            for (int ct = 0; ct < 2; ++ct) *(GAS bf16x4s*)(Dg + (((2 * ch + ct) * 4 + rt) * 64 + lane) * 4) = pack4(ad[ct] * wl4);
            const size_t row0_ = (size_t)b * SEQ + c * 64;
            f32x4 ar[2]; ld_tr(ar, TILE(6), rt, ch, fr, g);
            mm64(ar, TILE(5), TILE(4), rt, ch, fr, g);
            f32x4 ay[2] = {F4Z, F4Z};
            mm64(ay, TILE(7), TILE(4), rt, ch, fr, g); mm64_at(ay, TILE(3), TILE(9), rt, ch, fr, g, lane);
            bf16* Rg = (bf16*)(ws + WS_B1); bf16* Kg = (bf16*)(ws + WS_B2);
#pragma unroll
            for (int ct = 0; ct < 2; ++ct) { const size_t o_ = (row0_ + 32 * ch + 16 * ct + fr) * C + h * HD + 16 * rt + 4 * g; *(GAS bf16x4s*)(Rg + o_) = pack4(ar[ct]); *(GAS bf16x4s*)(Kg + o_) = pack4(ay[ct]); }
        }
        lds_barrier();
        { const int row_ = tid >> 3, cq_ = tid & 7; *(LAS v4u*)(TILE(6) + row_ * TPB + cq_ * 16) = w2keep; }
        lds_barrier();
    }
}

constexpr int S2_PD = 6;
__device__ __forceinline__ void scan_s2(unsigned char* ws, LAS unsigned char* lds, int lane, int wave) {
    for (int bh = blockIdx.x; bh < BATCH * NH; bh += gridDim.x) {
        const unsigned char* Mg = (const unsigned char*)((const bf16*)(ws + WS_B0) + (size_t)bh * 128 * 4096); const unsigned char* Dg = (const unsigned char*)((const bf16*)OUTP() + (size_t)bh * 128 * 4096);
        bf16* Sg = (bf16*)OUTP() + (size_t)M * C + (size_t)bh * 128 * 4096;
        if (wave >= 4) {
            const int lw = wave - 4;
            const unsigned char* src = (lw < 2 ? Mg + lw * 4096 : Dg + (lw - 2) * 4096) + lane * 16;
            LAS unsigned char* dst = lds + lw * 4096 + lane * 16;
            v4u q[S2_PD][4];
#define S2_LOADQ(j, c) do { _Pragma("unroll") for (int i_ = 0; i_ < 4; ++i_) q[j][i_] = *(const GAS v4u*)(src + (size_t)(c) * 8192 + i_ * 1024); } while (0)
#define S2_STOREQ(j, slot) do { _Pragma("unroll") for (int i_ = 0; i_ < 4; ++i_) *(LAS v4u*)(dst + (slot) * 16384 + i_ * 1024) = q[j][i_]; } while (0)
#pragma unroll
            for (int j = 0; j < S2_PD; ++j) S2_LOADQ(j, j);
            S2_STOREQ(0, 0); S2_LOADQ(0, S2_PD);
            lds_barrier();
#pragma unroll 1
            for (int s0 = 0; s0 < 128; s0 += S2_PD) {
#pragma unroll
                for (int jj = 0; jj < S2_PD; ++jj) { const int step = s0 + jj;
                    if (step + 1 < 128) S2_STOREQ((jj + 1) % S2_PD, (step + 1) & 1);
                    if (step + 1 + S2_PD < 128) S2_LOADQ((jj + 1) % S2_PD, step + 1 + S2_PD);
                    lds_barrier(); }
            }
#undef S2_LOADQ
#undef S2_STOREQ
        } else {
            const int ct = wave;
            f32x4 acc[4];
#pragma unroll
            for (int r = 0; r < 4; ++r) acc[r] = F4Z;
            lds_barrier();
#pragma unroll 1
            for (int s0 = 0; s0 < 128; s0 += S2_PD) {
#pragma unroll
                for (int jj = 0; jj < S2_PD; ++jj) { const int step = s0 + jj;
                    if (step < 128) {
                        const LAS unsigned char* slot = lds + (step & 1) * 16384;
                        bf16x8s sf[2];
#pragma unroll
                        for (int ks = 0; ks < 2; ++ks) { const bf16x4s lo = pack4(acc[2 * ks]), hi = pack4(acc[2 * ks + 1]); sf[ks] = (bf16x8s){lo[0], lo[1], lo[2], lo[3], hi[0], hi[1], hi[2], hi[3]}; }
#pragma unroll
                        for (int ks = 0; ks < 2; ++ks) *(GAS bf16x8s*)(Sg + (size_t)step * 4096 + ((ct * 2 + ks) * 64 + lane) * 8) = sf[ks];
                        f32x4 na[4];
#pragma unroll
                        for (int r = 0; r < 4; ++r) na[r] = unpack4(*(const LAS bf16x4s*)(slot + 8192 + ((ct * 4 + r) * 64 + lane) * 8));
#pragma unroll
                        for (int ks = 0; ks < 2; ++ks)
#pragma unroll
                            for (int r = 0; r < 4; ++r) na[r] = MFMA16(*(const LAS bf16x8s*)(slot + ((r * 2 + ks) * 64 + lane) * 16), sf[ks], na[r]);
#pragma unroll
                        for (int r = 0; r < 4; ++r) acc[r] = na[r];
                    }
                    lds_barrier(); }
            }
        }
    }
}

constexpr int S3_RT = 32768, S3_YT = S3_RT + TILE_B, S3_LG = S3_YT + TILE_B, S3_LGP = 336;
struct S3In { v4u rr, yy, vv, lg[3]; bf16x8s sA[2]; float rkb; };
__device__ __forceinline__ void s3_fetch(S3In& f, unsigned char* ws, int unit, int tid, int lane, int wave) {
    const int h = unit & 15, c = (unit >> 4) & 127, b = unit >> 11; const size_t chunk = ((size_t)b * NH + h) * 128 + c, row0 = (size_t)b * SEQ + c * 64;
    const int rt = wave & 3, et = tid >> 3, ecq = tid & 7;
    const bf16* Rg = (const bf16*)(ws + WS_B1); const bf16* Kg = (const bf16*)(ws + WS_B2); const bf16* Vb = (const bf16*)(ws + WS_B3); const bf16* LG = (const bf16*)(ws + WS_LG);
    const bf16* Sg = (const bf16*)OUTP() + (size_t)M * C + chunk * 4096;
    const size_t o_ = (row0 + et) * C + h * HD + ecq * 8;
    f.rr = *(const GAS v4u*)(Rg + o_); f.yy = *(const GAS v4u*)(Kg + o_); f.vv = *(const GAS v4u*)(Vb + o_);
#pragma unroll
    for (int i = 0; i < 3; ++i) { const int chn = tid + 512 * i; if (chn < 64 * 20) f.lg[i] = *(const GAS v4u*)(LG + (row0 + chn / 20) * DG + (chn % 20) * 8); }
#pragma unroll
    for (int ks = 0; ks < 2; ++ks) f.sA[ks] = *(const GAS bf16x8s*)(Sg + ((rt * 2 + ks) * 64 + lane) * 8);
    f.rkb = ((const float*)(ws + WS_HID))[(row0 + et) * NH + h];
}
__device__ __forceinline__ void scan_s3(unsigned char* ws, LAS unsigned char* lds, int lane0, int wave) {
    const int rt = wave & 3, ch = wave >> 2;
    LAS float* Ys = (LAS float*)(lds + CS_FA);
    const bf16* G2T = (const bf16*)(ws + WS_WT_G2); bf16* YG = (bf16*)(ws + WS_B0);
    constexpr int NU = BATCH * NH * (SEQ / 64);
    S3In fin; bf16x8s gA[5]; f32x4 lnw0, lnw1, lnb0, lnb1;
    { int l0 = lane0; asm volatile("" : "+v"(l0)); const int hh = blockIdx.x & 15, t0_ = wave * 64 + l0;
      if ((int)blockIdx.x < NU) s3_fetch(fin, ws, blockIdx.x, t0_, l0, wave);
#pragma unroll
      for (int ks = 0; ks < 5; ++ks) gA[ks] = *(const GAS bf16x8s*)(G2T + (size_t)(hh * HD + 16 * rt + (l0 & 15)) * DG + 32 * ks + 8 * (l0 >> 4));
      const int ec0 = hh * HD + (t0_ & 7) * 8;
      lnw0 = *(const GAS f32x4*)(INP(18) + ec0); lnw1 = *(const GAS f32x4*)(INP(18) + ec0 + 4); lnb0 = *(const GAS f32x4*)(INP(19) + ec0); lnb1 = *(const GAS f32x4*)(INP(19) + ec0 + 4); }
    __syncthreads();
    for (int unit = blockIdx.x; unit < NU; unit += gridDim.x) {
        int lane = lane0; asm volatile("" : "+v"(lane));
        const int tid = wave * 64 + lane, fr = lane & 15, g = lane >> 4, et = tid >> 3, ecq = tid & 7;
        const int h = unit & 15, c = (unit >> 4) & 127, b = unit >> 11; const size_t row0 = (size_t)b * SEQ + c * 64;
        *(LAS v4u*)(lds + S3_RT + et * TPB + ecq * 16) = fin.rr; *(LAS v4u*)(lds + S3_YT + et * TPB + ecq * 16) = fin.yy;
#pragma unroll
        for (int i = 0; i < 3; ++i) { const int chn = tid + 512 * i; if (chn < 64 * 20) *(LAS v4u*)(lds + S3_LG + (chn / 20) * S3_LGP + (chn % 20) * 16) = fin.lg[i]; }
        float v8[8]; unpack8(fin.vv, v8); const float rkb = fin.rkb; const bf16x8s sA0 = fin.sA[0], sA1 = fin.sA[1];
        lds_barrier();
        if (unit + (int)gridDim.x < NU) s3_fetch(fin, ws, unit + gridDim.x, tid, lane, wave);
        f32x4 acc[2], ag[2] = {F4Z, F4Z};
#pragma unroll
        for (int ct = 0; ct < 2; ++ct) { const int t = 32 * ch + 16 * ct + fr;
            acc[ct] = unpack4(*(const LAS bf16x4s*)(lds + S3_YT + t * TPB + (16 * rt + 4 * g) * 2));
            acc[ct] = MFMA16(sA0, ldfrag_perm(lds + S3_RT, t, 0, g), acc[ct]); acc[ct] = MFMA16(sA1, ldfrag_perm(lds + S3_RT, t, 1, g), acc[ct]);
#pragma unroll
            for (int ks = 0; ks < 5; ++ks) ag[ct] = MFMA16(gA[ks], *(const LAS bf16x8s*)(lds + S3_LG + t * S3_LGP + (32 * ks + 8 * g) * 2), ag[ct]);
            *(LAS f32x4*)(Ys + t * FP + 16 * rt + 4 * g) = acc[ct]; }
        lds_barrier();
        {
            const f32x4 y0 = *(const LAS f32x4*)(Ys + et * FP + ecq * 8), y1 = *(const LAS f32x4*)(Ys + et * FP + ecq * 8 + 4);
            float y[8] = {y0[0], y0[1], y0[2], y0[3], y1[0], y1[1], y1[2], y1[3]};
            float s_ = 0.f;
#pragma unroll
            for (int q = 0; q < 8; ++q) s_ += y[q];
            s_ += shx(s_, 1, lane); s_ += shx(s_, 2, lane); s_ += shx(s_, 4, lane);
            const float mu = s_ * (1.0f / HD); float vs = 0.f;
#pragma unroll
            for (int q = 0; q < 8; ++q) { y[q] -= mu; vs += y[q] * y[q]; }
            vs += shx(vs, 1, lane); vs += shx(vs, 2, lane); vs += shx(vs, 4, lane);
            const float rstd = 1.0f / sqrtf(vs * (1.0f / HD) + GN_EPS);
            f32x4 o0, o1;
#pragma unroll
            for (int q = 0; q < 4; ++q) { o0[q] = y[q] * rstd * lnw0[q] + lnb0[q] + rkb * v8[q]; o1[q] = y[4 + q] * rstd * lnw1[q] + lnb1[q] + rkb * v8[4 + q]; }
            *(LAS f32x4*)(Ys + et * FP + ecq * 8) = o0; *(LAS f32x4*)(Ys + et * FP + ecq * 8 + 4) = o1;
        }
        lds_barrier();
#pragma unroll
        for (int ct = 0; ct < 2; ++ct) { const int t = 32 * ch + 16 * ct + fr; const f32x4 yv = *(const LAS f32x4*)(Ys + t * FP + 16 * rt + 4 * g);
            *(GAS bf16x4s*)(YG + (row0 + t) * C + h * HD + 16 * rt + 4 * g) = pack4(yv * ag[ct]); }
    }
    __syncthreads();
}
#undef TILE
#if MK_DEBUG
__device__ __forceinline__ void scan_naive(unsigned char* ws, LAS unsigned char* lds, int tid) {
    const int lane = tid & 63;
    const bf16* Rb = (const bf16*)(ws + WS_B1); const bf16* Kb = (const bf16*)(ws + WS_B2); const bf16* Vb = (const bf16*)(ws + WS_B3);
    const bf16* LW = (const bf16*)(ws + WS_LW); const bf16* LA = (const bf16*)(ws + WS_LA);
    float* Y = OUTP(); float* RK = (float*)(ws + WS_HID);
    LAS float* sR = (LAS float*)lds; LAS float* sK = sR + 4096; LAS float* sV = sK + 4096; LAS float* sA = sV + 4096; LAS float* sB = sA + 4096; LAS float* sD = sB + 4096;
    LAS float* sW2 = sD + 4096; LAS float* sA2 = sW2 + 4096;
    for (int unit = blockIdx.x; unit < BATCH * NH; unit += gridDim.x) {
        const int b = unit / NH, h = unit % NH;
        __syncthreads();
        for (int e = tid; e < 4096; e += 512) { const int d = e >> 6, j = e & 63; sW2[e] = INP(9)[(size_t)d * C + h * HD + j]; sA2[e] = INP(12)[(size_t)d * C + h * HD + j]; }
        __syncthreads();
        const int pt = tid >> 3, cq = tid & 7, c0 = h * HD + cq * 8;
        const int si = tid >> 3, jq = tid & 7;
        float S[8];
#pragma unroll
        for (int q = 0; q < 8; ++q) S[q] = 0.f;
        float w0v[8], a0v[8], kkv[8], kav[8], rkv[8];
#pragma unroll
        for (int q = 0; q < 8; ++q) { w0v[q] = INP(7)[c0 + q]; a0v[q] = INP(10)[c0 + q]; kkv[q] = INP(15)[c0 + q]; kav[q] = INP(16)[c0 + q]; rkv[q] = INP(17)[c0 + q]; }
        for (int blk = 0; blk < SEQ / 64; ++blk) {
            const size_t row = (size_t)b * SEQ + blk * 64 + pt;
            {
                const v4u r4 = *(const GAS v4u*)(Rb + row * C + c0), k4 = *(const GAS v4u*)(Kb + row * C + c0), v4 = *(const GAS v4u*)(Vb + row * C + c0);
                float r[8], k[8], v[8];
                r[0] = bflo(r4.x); r[1] = bfhi(r4.x); r[2] = bflo(r4.y); r[3] = bfhi(r4.y); r[4] = bflo(r4.z); r[5] = bfhi(r4.z); r[6] = bflo(r4.w); r[7] = bfhi(r4.w);
                k[0] = bflo(k4.x); k[1] = bfhi(k4.x); k[2] = bflo(k4.y); k[3] = bfhi(k4.y); k[4] = bflo(k4.z); k[5] = bfhi(k4.z); k[6] = bflo(k4.w); k[7] = bfhi(k4.w);
                v[0] = bflo(v4.x); v[1] = bfhi(v4.x); v[2] = bflo(v4.y); v[3] = bfhi(v4.y); v[4] = bflo(v4.z); v[5] = bfhi(v4.z); v[6] = bflo(v4.w); v[7] = bfhi(v4.w);
                float wp[8], ap[8];
#pragma unroll
                for (int q = 0; q < 8; ++q) { wp[q] = w0v[q]; ap[q] = a0v[q]; }
                for (int d = 0; d < 64; ++d) { const float lw = bf2f(LW[row * DW + d]), la = bf2f(LA[row * DA + d]);
#pragma unroll
                    for (int q = 0; q < 8; ++q) { wp[q] += lw * sW2[d * 64 + cq * 8 + q]; ap[q] += la * sA2[d * 64 + cq * 8 + q]; } }
                float kk[8], ss = 0.f, rks = 0.f;
#pragma unroll
                for (int q = 0; q < 8; ++q) { kk[q] = k[q] * kkv[q]; ss += kk[q] * kk[q]; }
                ss += shx(ss, 1, lane); ss += shx(ss, 2, lane); ss += shx(ss, 4, lane);
                const float inv = 1.0f / fmaxf(sqrtf(ss), 1e-12f);
#pragma unroll
                for (int q = 0; q < 8; ++q) { const float ag = sigmoidf_(ap[q]); const float kn = kk[q] * inv; const float kp = k[q] * (1.0f + (ag - 1.0f) * kav[q]);
                    const float lw = -0.6065306597126334f * sigmoidf_(wp[q]);
                    const int o = pt * 64 + cq * 8 + q;
                    sR[o] = r[q]; sK[o] = kp; sV[o] = v[q]; sA[o] = -kn; sB[o] = kn * ag; sD[o] = __expf(lw); rks += r[q] * kp * rkv[q]; }
                rks += shx(rks, 1, lane); rks += shx(rks, 2, lane); rks += shx(rks, 4, lane);
                if (cq == 0) RK[row * NH + h] = rks;
            }
            __syncthreads();
            for (int t = 0; t < 64; ++t) {
                const LAS f32x4* pa = (const LAS f32x4*)(sA + t * 64 + jq * 8); const LAS f32x4* pb = (const LAS f32x4*)(sB + t * 64 + jq * 8);
                const LAS f32x4* pd = (const LAS f32x4*)(sD + t * 64 + jq * 8); const LAS f32x4* pk = (const LAS f32x4*)(sK + t * 64 + jq * 8);
                const LAS f32x4* pr = (const LAS f32x4*)(sR + t * 64 + jq * 8);
                const f32x4 a0 = pa[0], a1 = pa[1], b0 = pb[0], b1 = pb[1], d0 = pd[0], d1 = pd[1], k0 = pk[0], k1 = pk[1], r0 = pr[0], r1 = pr[1];
                const float vi = sV[t * 64 + si];
                float sa = 0.f;
#pragma unroll
                for (int q = 0; q < 4; ++q) { sa += S[q] * a0[q]; sa += S[4 + q] * a1[q]; }
                sa += shx(sa, 1, lane); sa += shx(sa, 2, lane); sa += shx(sa, 4, lane);
                float y = 0.f;
#pragma unroll
                for (int q = 0; q < 4; ++q) { S[q] = S[q] * d0[q] + sa * b0[q] + vi * k0[q]; S[4 + q] = S[4 + q] * d1[q] + sa * b1[q] + vi * k1[q]; y += S[q] * r0[q]; y += S[4 + q] * r1[q]; }
                y += shx(y, 1, lane); y += shx(y, 2, lane); y += shx(y, 4, lane);
                if (jq == 0) Y[((size_t)b * SEQ + blk * 64 + t) * C + h * HD + si] = y;
            }
            __syncthreads();
        }
    }
}
__device__ __forceinline__ void post_scan(unsigned char* ws, int gw, int NGW, int lane) {
    const float* Y = OUTP(); const float* RK = (const float*)(ws + WS_HID); const bf16* Vb = (const bf16*)(ws + WS_B3); const bf16* LG = (const bf16*)(ws + WS_LG);
    bf16* YG = (bf16*)(ws + WS_B4); const float* g2 = INP(14); const float* lnw = INP(18); const float* lnb = INP(19);
    for (int it = gw; it < M * NH; it += NGW) {
        const int row = it / NH, h = it % NH, c = h * HD + lane;
        const float y = Y[(size_t)row * C + c];
        const float mu = wave_sum(y, lane) * (1.0f / HD); const float d = y - mu; const float var = wave_sum(d * d, lane) * (1.0f / HD);
        float o = d * (1.0f / sqrtf(var + GN_EPS)) * lnw[c] + lnb[c];
        o += RK[(size_t)row * NH + h] * bf2f(Vb[(size_t)row * C + c]);
        float g = 0.f;
        for (int dd = 0; dd < DG; ++dd) g += bf2f(LG[(size_t)row * DG + dd]) * g2[(size_t)dd * C + c];
        YG[(size_t)row * C + c] = (bf16)f2bf(o * g);
    }
}


constexpr int CW_DBG = 3200;
__device__ __forceinline__ void dbg_nonfinite(unsigned char* ws, const bf16* X, size_t n, int slot, int gw, int NGW, int lane, float thr = 1e30f) {
    unsigned* cw = (unsigned*)(ws + WS_CTL) + CW_DBG + 64 * slot; unsigned nnan = 0;
    for (size_t i = (size_t)gw * 64 + lane; i < n; i += (size_t)NGW * 64) { const float x = bf2f(X[i]); if (!(fabsf(x) < thr)) ++nnan; }
    if (nnan) atomicAdd(cw, nnan);
}
__device__ __forceinline__ void dbg_compare(unsigned char* ws, const bf16* X, const bf16* Y, int gw, int NGW, int lane) {
    unsigned* cw = (unsigned*)(ws + WS_CTL) + CW_DBG; unsigned nbad = 0, nnan = 0;
    for (size_t i = (size_t)gw * 64 + lane; i < (size_t)M * C; i += (size_t)NGW * 64) { const float x = bf2f(X[i]), y = bf2f(Y[i]);
        if (!(fabsf(x) < 1e30f)) ++nnan; else if (fabsf(x - y) > 0.05f * (fabsf(y) + 0.05f)) ++nbad; }
    if (nnan) atomicAdd(cw, nnan); if (nbad) atomicAdd(cw + 64, nbad);
}
#endif
__device__ __forceinline__ void router_rows(unsigned char* ws, LAS unsigned char* lds, int layer, int gw, int NGW, int lane, int tid, bool dry = false) {
    const bf16* Hh = (const bf16*)(ws + WS_B4); const float* gain = INP(2) + layer * C; bf16* XN = (bf16*)(ws + WS_B1);
    const float* wg = INP(24) + (size_t)layer * C * 4; const float* bg = INP(25) + layer * 4; const float* wi = INP(26) + (size_t)layer * C * 16; const float* bi = INP(27) + layer * 16;
    unsigned* cnt = (unsigned*)(ws + WS_CTL) + CW_CNT + layer * 16 * 64; unsigned* list = (unsigned*)(ws + WS_LIST); float* wl = (float*)(ws + WS_WL);
    LAS float* sWg = (LAS float*)lds; LAS float* sWi = sWg + C * 4;
    constexpr int RECMAX = 256;
    LAS unsigned* lcnt = (LAS unsigned*)(lds + 81920); LAS unsigned* gbase = lcnt + 16; LAS int* nrec = (LAS int*)(lcnt + 32);
    LAS unsigned* recRow = lcnt + 64; LAS unsigned* recE = recRow + RECMAX; LAS unsigned* recL = recE + RECMAX; LAS float* recW0 = (LAS float*)(recL + RECMAX); LAS float* recW1 = recW0 + RECMAX;
    __syncthreads();
    for (int e = tid; e < C * 4; e += 512) sWg[e] = wg[e];
    for (int e = tid; e < C * 16; e += 512) sWi[e] = wi[e];
    if (tid < 33) lcnt[tid == 32 ? 32 : tid] = 0u;
    __syncthreads();
    f32x4 g[4]; load_row(gain, lane, g);
    for (int row = gw; row < M; row += NGW) {
        f32x4 v[4]; load_row_bf(Hh + (size_t)row * C, lane, v); const float rs = row_rs(v, lane);
#pragma unroll
        for (int j = 0; j < 4; ++j) v[j] = v[j] * rs * g[j];
        store_row_bf16(XN + (size_t)row * C, lane, v);
        float gl[4] = {0.f, 0.f, 0.f, 0.f};
        const LAS unsigned char* pWg = (const LAS unsigned char*)sWg + lane * 64;
#pragma unroll
        for (int j = 0; j < 4; ++j)
#pragma unroll
            for (int q = 0; q < 4; ++q) { const f32x4 w = *(const LAS f32x4*)(pWg + j * 4096 + q * 16); const float xv = v[j][q]; gl[0] += xv * w.x; gl[1] += xv * w.y; gl[2] += xv * w.z; gl[3] += xv * w.w; }
#pragma unroll
        for (int q = 0; q < 4; ++q) gl[q] = wave_sum(gl[q], lane) + bg[q];
        int gi = 0; float gm = gl[0];
#pragma unroll
        for (int q = 1; q < 4; ++q) if (gl[q] > gm) { gm = gl[q]; gi = q; }
        float gden = 0.f;
#pragma unroll
        for (int q = 0; q < 4; ++q) gden += __expf(gl[q] - gm);
        const float gval = 1.0f / gden;
        float il[4] = {0.f, 0.f, 0.f, 0.f};
        const LAS unsigned char* pWi = (const LAS unsigned char*)sWi + lane * 256 + gi * 16;
#pragma unroll
        for (int j = 0; j < 4; ++j)
#pragma unroll
            for (int q = 0; q < 4; ++q) { const f32x4 w = *(const LAS f32x4*)(pWi + j * 16384 + q * 64); const float xv = v[j][q]; il[0] += xv * w.x; il[1] += xv * w.y; il[2] += xv * w.z; il[3] += xv * w.w; }
#pragma unroll
        for (int q = 0; q < 4; ++q) il[q] = wave_sum(il[q], lane) + bi[gi * 4 + q];
        int i0 = 0; float m0 = il[0];
#pragma unroll
        for (int q = 1; q < 4; ++q) if (il[q] > m0) { m0 = il[q]; i0 = q; }
        int i1 = -1; float m1 = -INFINITY;
#pragma unroll
        for (int q = 0; q < 4; ++q) if (q != i0 && il[q] > m1) { m1 = il[q]; i1 = q; }
        const float e1 = __expf(m1 - m0); const float w0 = gval / (1.0f + e1), w1 = gval * e1 / (1.0f + e1);
        if (lane == 0 && !dry) {
            const int ex0 = gi * 4 + i0, ex1 = gi * 4 + i1;
            const int ri = __hip_atomic_fetch_add(nrec, 1, __ATOMIC_RELAXED, __HIP_MEMORY_SCOPE_WORKGROUP);
            const unsigned l0 = __hip_atomic_fetch_add(lcnt + ex0, 1u, __ATOMIC_RELAXED, __HIP_MEMORY_SCOPE_WORKGROUP), l1 = __hip_atomic_fetch_add(lcnt + ex1, 1u, __ATOMIC_RELAXED, __HIP_MEMORY_SCOPE_WORKGROUP);
            if (ri < RECMAX) { recRow[ri] = (unsigned)row; recE[ri] = (unsigned)ex0 | ((unsigned)ex1 << 8); recL[ri] = l0 | (l1 << 16); recW0[ri] = w0; recW1[ri] = w1; }
        }
    }
    __syncthreads();
    if (tid < 16 && !dry) gbase[tid] = atomicAdd(cnt + tid * 64, lcnt[tid]);
    __syncthreads();
    { const int n = *nrec < RECMAX ? *nrec : RECMAX;
      for (int i = tid; i < n; i += 512) { const unsigned row = recRow[i], e = recE[i], l = recL[i]; const unsigned ex0 = e & 255u, ex1 = e >> 8;
          const unsigned p0 = gbase[ex0] + (l & 0xffffu), p1 = gbase[ex1] + (l >> 16);
          list[(size_t)ex0 * M + p0] = row * 2u; wl[(size_t)ex0 * M + p0] = recW0[i]; list[(size_t)ex1 * M + p1] = row * 2u + 1u; wl[(size_t)ex1 * M + p1] = recW1[i]; } }
}
__device__ __forceinline__ void moe_table(unsigned char* ws, volatile LAS int* tab, int layer, int tid) {
    __syncthreads();
    if (tid == 0) { const unsigned* cnt = (const unsigned*)(ws + WS_CTL) + CW_CNT + layer * 16 * 64; int t = 0;
#pragma unroll 1
        for (int e = 0; e < 16; ++e) { const int c = (int)__hip_atomic_load(cnt, RLX_AGENT); cnt += 64; tab[e] = c; tab[16 + e] = t; t += (c + 255) >> 8; tab[32 + e] = t; }
        tab[48] = t; }
    __syncthreads();
}
__device__ __forceinline__ void combine_rows(unsigned char* ws, int mode, int gw, int NGW, int lane, bool dry = false) {
    bf16* Hh = (bf16*)(ws + WS_B4); float* Out = OUTP(); const bf16* E0 = (const bf16*)(ws + WS_B2); const bf16* E1 = (const bf16*)(ws + WS_B3); bf16* XN2 = (bf16*)(ws + WS_B0);
    f32x4 g[4]; load_row(INP(4), lane, g);
    for (int row = gw; row < M; row += NGW) {
        f32x4 v[4]; load_row_bf(Hh + (size_t)row * C, lane, v);
#pragma unroll
        for (int j = 0; j < 4; ++j) { const v2u e0 = ((const GAS v2u*)(E0 + (size_t)row * C))[64 * j + lane], e1 = ((const GAS v2u*)(E1 + (size_t)row * C))[64 * j + lane];
            v[j].x += bflo(e0.x) + bflo(e1.x); v[j].y += bfhi(e0.x) + bfhi(e1.x); v[j].z += bflo(e0.y) + bflo(e1.y); v[j].w += bfhi(e0.y) + bfhi(e1.y); }
        const float rs = row_rs(v, lane);
        if (mode == 0) {
            if (!dry) store_row_bf16(Hh + (size_t)row * C, lane, v);
#pragma unroll
            for (int j = 0; j < 4; ++j) v[j] = v[j] * rs;
            store_row_bf16(XN2 + (size_t)row * C, lane, v);
        } else {
            float sig = 1.0f;
#if MK_DEBUG
            const unsigned* cw = (const unsigned*)(ws + WS_CTL) + CW_DBG; const unsigned nnan = __hip_atomic_load(cw, RLX_AGENT), nbad = __hip_atomic_load(cw + 64, RLX_AGENT);
            if (row < 512 && nnan > 0) sig = 2.0f;
            if (row >= 512 && row < 1536 && __hip_atomic_load(cw + 128, RLX_AGENT) > 0) sig = 2.0f;
            if (row >= 1536 && row < 3584 && __hip_atomic_load(cw + 192, RLX_AGENT) > 0) sig = 2.0f;
            if (row >= 3584 && row < 7680 && __hip_atomic_load(cw + 256, RLX_AGENT) > 0) sig = 2.0f;
            if (row >= 7680 && row < 15872 && __hip_atomic_load(cw + 320, RLX_AGENT) > 0) sig = 2.0f;
            if (row >= 15872 && nbad > (unsigned)(M / 100) * C) sig = 1.5f;
#endif
#pragma unroll
            for (int j = 0; j < 4; ++j) ((GAS f32x4*)(Out + (size_t)row * C))[64 * j + lane] = v[j] * rs * g[j] * sig;
        }
    }
}
__device__ __forceinline__ void attn_naive(unsigned char* ws, int gw, int NGW, int lane) {
    const bf16* Kb = (const bf16*)(ws + WS_B1); const bf16* Vb = (const bf16*)(ws + WS_B2); const bf16* Qb = (const bf16*)(ws + WS_B3); bf16* Ob = (bf16*)(ws + WS_B0);
    for (int unit = gw; unit < BATCH * NH * (SEQ / 64); unit += NGW) {
        const int qb = unit % (SEQ / 64), bh = unit / (SEQ / 64), b = bh / NH, h = bh % NH;
        const int t0 = qb * 64, t = t0 + lane; const size_t rowq = (size_t)b * SEQ + t;
        float q[64], o[64];
#pragma unroll
        for (int c = 0; c < 8; ++c) { const v4u w = *(const GAS v4u*)(Qb + rowq * C + h * HD + c * 8);
            q[c * 8 + 0] = bflo(w.x) * 0.125f; q[c * 8 + 1] = bfhi(w.x) * 0.125f; q[c * 8 + 2] = bflo(w.y) * 0.125f; q[c * 8 + 3] = bfhi(w.y) * 0.125f;
            q[c * 8 + 4] = bflo(w.z) * 0.125f; q[c * 8 + 5] = bfhi(w.z) * 0.125f; q[c * 8 + 6] = bflo(w.w) * 0.125f; q[c * 8 + 7] = bfhi(w.w) * 0.125f; }
#pragma unroll
        for (int c = 0; c < 64; ++c) o[c] = 0.f;
        float suffix = 0.f;
        for (int s = t0 + 62; s >= 0; --s) {
            const bool valid = s < t;
            if (s < t0 && __all(suffix > SB_EXIT)) break;
            const bf16* kp = Kb + ((size_t)b * SEQ + s) * C + h * HD; const bf16* vp = Vb + ((size_t)b * SEQ + s) * C + h * HD;
            float z = 0.f;
#pragma unroll
            for (int c = 0; c < 8; ++c) { const v4u w = *(const GAS v4u*)(kp + c * 8);
                z += q[c * 8 + 0] * bflo(w.x) + q[c * 8 + 1] * bfhi(w.x) + q[c * 8 + 2] * bflo(w.y) + q[c * 8 + 3] * bfhi(w.y) + q[c * 8 + 4] * bflo(w.z) + q[c * 8 + 5] * bfhi(w.z) + q[c * 8 + 6] * bflo(w.w) + q[c * 8 + 7] * bfhi(w.w); }
            const float sp = fmaxf(z, 0.f) + log1pf(__expf(-fabsf(z)));
            const float att = valid ? __expf(z - sp - suffix) : 0.f;
            suffix += valid ? sp : 0.f;
#pragma unroll
            for (int c = 0; c < 8; ++c) { const v4u w = *(const GAS v4u*)(vp + c * 8);
                o[c * 8 + 0] += att * bflo(w.x); o[c * 8 + 1] += att * bfhi(w.x); o[c * 8 + 2] += att * bflo(w.y); o[c * 8 + 3] += att * bfhi(w.y);
                o[c * 8 + 4] += att * bflo(w.z); o[c * 8 + 5] += att * bfhi(w.z); o[c * 8 + 6] += att * bflo(w.w); o[c * 8 + 7] += att * bfhi(w.w); }
        }
#pragma unroll
        for (int c = 0; c < 8; ++c) { v4u w; w.x = pk2(o[c * 8 + 0], o[c * 8 + 1]); w.y = pk2(o[c * 8 + 2], o[c * 8 + 3]); w.z = pk2(o[c * 8 + 4], o[c * 8 + 5]); w.w = pk2(o[c * 8 + 6], o[c * 8 + 7]);
            *(GAS v4u*)(Ob + rowq * C + h * HD + c * 8) = w; }
    }
}


typedef float f32x16 __attribute__((ext_vector_type(16)));
constexpr int AT_VP = 192;
constexpr int AT_WAVE_LDS = 32 * AT_VP;
__device__ __forceinline__ int crow32(int reg, int hh) { return (reg & 3) + 8 * (reg >> 2) + 4 * hh; }
__device__ __forceinline__ bf16x8s pack_step(const f32x16& x, const int s) {
    v4u p; p.x = pg8::cvt_pk_bf16(x[8 * s], x[8 * s + 1]); p.y = pg8::cvt_pk_bf16(x[8 * s + 2], x[8 * s + 3]); p.z = pg8::cvt_pk_bf16(x[8 * s + 4], x[8 * s + 5]); p.w = pg8::cvt_pk_bf16(x[8 * s + 6], x[8 * s + 7]);
    return __builtin_bit_cast(bf16x8s, p);
}
__device__ __forceinline__ void attn_mfma(unsigned char* ws, LAS unsigned char* lds, int gw, int NGW, int lane, int wave) {
    const bf16* Kb = (const bf16*)(ws + WS_B1); const bf16* Vb = (const bf16*)(ws + WS_B2); const bf16* Qb = (const bf16*)(ws + WS_B3); bf16* Ob = (bf16*)(ws + WS_B0);
    LAS unsigned char* vl = lds + wave * AT_WAVE_LDS;
    const int r32 = lane & 31, hh = lane >> 5;
    bf16x8s tri[2];
#pragma unroll
    for (int s = 0; s < 2; ++s)
#pragma unroll
        for (int j = 0; j < 8; ++j) tri[s][j] = (16 * s + 8 * (j >> 2) + 4 * hh + (j & 3)) > r32 ? (short)0x3F80 : (short)0;
    const int grp = lane >> 4, tq = (lane & 15) >> 2, tp = lane & 3;
    const LAS unsigned char* vtr0 = vl + (4 * hh + tq) * AT_VP + (16 * (grp & 1) + 4 * tp) * 2;
    for (int unit = gw; unit < BATCH * NH * (SEQ / 32); unit += NGW) {
        const int qb = unit % (SEQ / 32), bh = unit / (SEQ / 32), b = bh / NH, hd = bh % NH;
        const int t0 = qb * 32; const size_t rowb = (size_t)b * SEQ;
        bf16x8s qf[4];
#pragma unroll
        for (int ks = 0; ks < 4; ++ks) qf[ks] = *(const GAS bf16x8s*)(Qb + (rowb + t0 + r32) * C + hd * HD + 16 * ks + 8 * hh);
        f32x16 o[2];
#pragma unroll
        for (int i = 0; i < 16; ++i) { o[0][i] = 0.f; o[1][i] = 0.f; }
        float carry = 0.f;
        for (int s0 = t0; s0 >= 0; s0 -= 32) {
            bf16x8s kf[4];
#pragma unroll
            for (int ks = 0; ks < 4; ++ks) kf[ks] = *(const GAS bf16x8s*)(Kb + (rowb + s0 + r32) * C + hd * HD + 16 * ks + 8 * hh);
            v4u vreg[4];
#pragma unroll
            for (int i = 0; i < 4; ++i) { const int cidx = lane + 64 * i; vreg[i] = *(const GAS v4u*)(Vb + (rowb + s0 + (cidx >> 3)) * C + hd * HD + (cidx & 7) * 8); }
            f32x16 st;
#pragma unroll
            for (int i = 0; i < 16; ++i) st[i] = 0.f;
#pragma unroll
            for (int ks = 0; ks < 4; ++ks) st = __builtin_amdgcn_mfma_f32_32x32x16_bf16(kf[ks], qf[ks], st, 0, 0, 0);
#pragma unroll
            for (int i = 0; i < 4; ++i) { const int cidx = lane + 64 * i; *(LAS v4u*)(vl + (cidx >> 3) * AT_VP + (cidx & 7) * 16) = vreg[i]; }
            f32x16 zz, uu; float tot = 0.f; const int tq_ = t0 + r32;
            if (s0 + 31 < t0) {
#pragma unroll
                for (int i = 0; i < 16; ++i) { const float z = st[i] * 0.18033688011112042f; const float sp = fmaxf(z, 0.f) + __builtin_amdgcn_logf(1.0f + __builtin_amdgcn_exp2f(-fabsf(z)));
                    zz[i] = z - sp; uu[i] = sp; tot += sp; }
            } else {
#pragma unroll
                for (int i = 0; i < 16; ++i) { const int key = s0 + crow32(i, hh); const float z = st[i] * 0.18033688011112042f; const float sp = fmaxf(z, 0.f) + __builtin_amdgcn_logf(1.0f + __builtin_amdgcn_exp2f(-fabsf(z)));
                    const bool valid = key < tq_; zz[i] = valid ? z - sp : -1e30f; uu[i] = valid ? sp : 0.f; tot += uu[i]; }
            }
            f32x16 w;
#pragma unroll
            for (int i = 0; i < 16; ++i) w[i] = 0.f;
#pragma unroll
            for (int s = 0; s < 2; ++s) w = __builtin_amdgcn_mfma_f32_32x32x16_bf16(tri[s], pack_step(uu, s), w, 0, 0, 0);
            f32x16 pp;
#pragma unroll
            for (int i = 0; i < 16; ++i) pp[i] = __builtin_amdgcn_exp2f(zz[i] - w[i] - carry);
            tot += shx(tot, 32, lane); carry += tot;
            asm volatile("s_waitcnt lgkmcnt(0)" ::: "memory");
#pragma unroll
            for (int s = 0; s < 2; ++s) { const bf16x8s pa = pack_step(pp, s);
#pragma unroll
                for (int dt = 0; dt < 2; ++dt) {
                    const v4i16_t lo = __builtin_amdgcn_ds_read_tr16_b64_v4i16((LAS v4i16_t*)(vtr0 + (16 * s) * AT_VP + dt * 64));
                    const v4i16_t hi = __builtin_amdgcn_ds_read_tr16_b64_v4i16((LAS v4i16_t*)(vtr0 + (16 * s + 8) * AT_VP + dt * 64));
                    const bf16x8s vf = (bf16x8s){lo[0], lo[1], lo[2], lo[3], hi[0], hi[1], hi[2], hi[3]};
                    o[dt] = __builtin_amdgcn_mfma_f32_32x32x16_bf16(pa, vf, o[dt], 0, 0, 0); } }
            asm volatile("" ::: "memory");
            if (s0 < t0 && __all(carry > SB_EXIT * 1.4426950408889634f)) break;
        }
#pragma unroll
        for (int dt = 0; dt < 2; ++dt)
#pragma unroll
            for (int i = 0; i < 16; ++i) Ob[(rowb + t0 + crow32(i, hh)) * C + hd * HD + 32 * dt + r32] = (bf16)f2bf(o[dt][i]);
    }
}
__global__ void __launch_bounds__(NWAVES * 64, 2) yoco_fwd(Args args) {
    extern __shared__ __attribute__((aligned(16))) unsigned char lds_raw[];
    LAS unsigned char* lds = (LAS unsigned char*)lds_raw;
    const int G = gridDim.x; const int bx = blockIdx.x;
    int wave = __builtin_amdgcn_readfirstlane(threadIdx.x >> 6); asm volatile("" : "+s"(wave));
#define IDS() int lane; asm volatile("v_mbcnt_lo_u32_b32 %0, -1, 0\n\tv_mbcnt_hi_u32_b32 %0, -1, %0" : "=v"(lane)); const int tid = wave * 64 + lane; (void)tid; \
    const int vcu = (G % 8 == 0) ? (bx % 8) * (G / 8) + bx / 8 : bx; const int gw = vcu * NWAVES + wave, NGW = G * NWAVES; (void)lane; (void)gw; (void)NGW;
    unsigned char* ws = WSP();
    volatile LAS unsigned* MISC = (volatile LAS unsigned*)(lds + MISC_OFF);
    volatile LAS int* tab = (volatile LAS int*)(lds + MOE_TAB_OFF);
    for (int u = threadIdx.x; u < (LDS_BYTES - LDSCTL_OFF) / 4; u += NWAVES * 64) ((LAS unsigned*)(lds + LDSCTL_OFF))[u] = 0u;
    __syncthreads();
    XcdBarrier bar; bar.bar = (unsigned*)(ws + WS_CTL) + CW_BAR; bar.x = 0; bar.st = nullptr;
    if (N_LAUNCHES == 1) bar = xcd_barrier_post((unsigned*)(ws + WS_CTL) + CW_BAR, MISC + 8);
    const int lo = KA_INT(0), hi = KA_INT(1);
#ifndef PROBE_PH
#define PROBE_PH -1
#endif
#define IN(k) (lo <= (k) && (k) < hi)
#define REP(k) for (int rep_ = 0; rep_ < ((PROBE_PH == (k)) ? 2 : 1); ++rep_)
#define SEAM(k) do { if (IN(k) && IN((k) + 1)) xcd_barrier(bar); } while (0)

    if (IN(PH_P0)) REP(PH_P0) { IDS(); p0_weights<0>(ws, lds, gw, NGW, wave, lane); p0_weights<1>(ws, lds, gw, NGW, wave, lane); p0_rows(ws, gw, NGW, lane); }
    SEAM(PH_P0);
    if (PROBE_PH == 100 && N_LAUNCHES == 1) { for (int i_ = 0; i_ < 10; ++i_) xcd_barrier(bar); }
    if (IN(PH_LORA)) REP(PH_LORA) {
        SchedGrouped<1, 3> S{(const char*)(ws + WS_B1), (size_t)(WS_B2 - WS_B1), nullptr, (const char*)(ws + WS_WT_LORA), (size_t)256 * C * 2, G, bx};
        EpiLora E{(bf16*)(ws + WS_LW)};
        pg8::gemm_phase<EpiLora, SchedGrouped<1, 3>, true, false, C>(lds, S, E, wave);
    }
    SEAM(PH_LORA);
    if (IN(PH_RKV)) REP(PH_RKV) {
        SchedGrouped<4, 3> S{(const char*)OUTP(), (size_t)M * C * 2, (const char*)(ws + WS_B4), (const char*)(ws + WS_WT_RKV), (size_t)C * C * 2, G, bx};
        EpiSplit3 E{(bf16*)(ws + WS_B1), false};
        pg8::gemm_phase<EpiSplit3, SchedGrouped<4, 3>, true, false, C>(lds, S, E, wave);
    }
    SEAM(PH_RKV);
    if (IN(PH_S1)) REP(PH_S1) { IDS(); scan_s1(ws, lds, lane, wave); }
    SEAM(PH_S1);
    if (IN(PH_S2)) REP(PH_S2) { IDS();
        if (bx < BATCH * NH || G <= BATCH * NH) scan_s2(ws, lds, lane, wave);
        }
    SEAM(PH_S2);
    if (IN(PH_S3)) REP(PH_S3) { IDS(); scan_s3(ws, lds, lane, wave); }
    SEAM(PH_S3);
#if MK_DEBUG
    if (IN(PH_DBG0)) { IDS(); scan_naive(ws, lds, tid); }
    SEAM(PH_DBG0);
    if (IN(PH_DBG0 + 1)) { IDS(); post_scan(ws, gw, NGW, lane); }
    SEAM(PH_DBG0 + 1);
    if (IN(PH_DBG0 + 2)) { IDS(); dbg_compare(ws, (const bf16*)(ws + WS_B0), (const bf16*)(ws + WS_B4), gw, NGW, lane); }
    SEAM(PH_DBG0 + 2);
#endif
    if (IN(PH_WOUT)) REP(PH_WOUT) {
        SchedGrouped<4, 1> S{(const char*)(ws + ((MK_DEBUG && DBG_USE_NAIVE) ? WS_B4 : WS_B0)), 0, nullptr, (const char*)(ws + WS_WT_OUT), 0, G, bx};
        EpiResidBf<true> E{INP(0), (bf16*)(ws + WS_B4)};
        pg8::gemm_phase<EpiResidBf<true>, SchedGrouped<4, 1>, true, false, C>(lds, S, E, wave);
    }
    SEAM(PH_WOUT);
#pragma unroll 1
    for (int layer = 0; layer < 2; ++layer) {
        const int pb = layer == 0 ? (int)PH_ROUT0 : (int)PH_ROUT1;
        if (IN(pb)) { IDS(); if (PROBE_PH == 101 && layer == 0) router_rows(ws, lds, layer, gw, NGW, lane, tid, true); router_rows(ws, lds, layer, gw, NGW, lane, tid); }
        SEAM(pb);
        if (IN(pb + 1)) REP(pb + 1) {
            { IDS(); moe_table(ws, tab, layer, tid); }
            SchedMoe<2, C, true> S{(const char*)(ws + WS_B1), (const char*)(ws + WS_WT_GU) + (size_t)layer * 16 * 512 * C * 2, (size_t)512 * C * 2, (const unsigned*)(ws + WS_LIST), tab, G, bx};
            EpiGU E{(bf16*)(ws + WS_HID), (const float*)(ws + WS_WL)};
            pg8::gemm_phase<EpiGU, SchedMoe<2, C, true>, true, true, C>(lds, S, E, wave);
        }
        SEAM(pb + 1);
        if (IN(pb + 2)) REP(pb + 2) {
            { IDS(); moe_table(ws, tab, layer, tid); }
            SchedMoe<4, FE, false> S{(const char*)(ws + WS_HID), (const char*)(ws + WS_WT_DN) + (size_t)layer * 16 * C * FE * 2, (size_t)C * FE * 2, (const unsigned*)(ws + WS_LIST), tab, G, bx};
            EpiDown E{(bf16*)(ws + WS_B2), (const unsigned*)(ws + WS_LIST)};
            pg8::gemm_phase<EpiDown, SchedMoe<4, FE, false>, true, false, FE>(lds, S, E, wave);
        }
        SEAM(pb + 2);
        if (layer == 0) {
            if (IN(PH_COMB)) { IDS(); if (PROBE_PH == 102) combine_rows(ws, 0, gw, NGW, lane, true); combine_rows(ws, 0, gw, NGW, lane); }
            SEAM(PH_COMB);
            if (IN(PH_KVQ)) REP(PH_KVQ) {
                SchedGrouped<12, 1> S{(const char*)(ws + WS_B0), 0, nullptr, (const char*)(ws + WS_WT_KVQ), 0, G, bx};
                EpiSplit3 E{(bf16*)(ws + WS_B1), true};
                pg8::gemm_phase<EpiSplit3, SchedGrouped<12, 1>, true, false, C>(lds, S, E, wave);
            }
            SEAM(PH_KVQ);
            if (IN(PH_ATTN)) REP(PH_ATTN) { IDS(); attn_mfma(ws, lds, gw, NGW, lane, wave); }
            SEAM(PH_ATTN);
            if (IN(PH_SBO)) {
                SchedGrouped<4, 1> S{(const char*)(ws + WS_B0), 0, nullptr, (const char*)(ws + WS_WT_SBO), 0, G, bx};
                EpiResidBf<false> E{(const void*)(ws + WS_B4), (bf16*)(ws + WS_B4)};
                pg8::gemm_phase<EpiResidBf<false>, SchedGrouped<4, 1>, true, false, C>(lds, S, E, wave);
            }
            SEAM(PH_SBO);
        }
    }
    if (IN(PH_FINAL)) { IDS(); combine_rows(ws, 1, gw, NGW, lane); }
#undef IN
#undef SEAM
}

extern "C" void kernel_launch(void* const* d_in, const int* in_sizes, int n_in, void* d_out, int out_size, void* d_ws, size_t ws_size, hipStream_t stream) {
    static int grid = 0;
    if (grid == 0) {
        if (n_in != 31 || in_sizes[0] != M * C || out_size != M * C || ws_size < WS_END) { fprintf(stderr, "kernel_launch: unexpected shapes (n_in %d, in0 %d, out %d, ws %zu); nothing launched\n", n_in, n_in > 0 ? in_sizes[0] : -1, out_size, ws_size); grid = -1; return; }
        int dev = 0, cus = 0, per_cu = 0;
        if (hipGetDevice(&dev) != hipSuccess || hipDeviceGetAttribute(&cus, hipDeviceAttributeMultiprocessorCount, dev) != hipSuccess) { grid = -1; return; }
        if (hipFuncSetAttribute((const void*)yoco_fwd, hipFuncAttributeMaxDynamicSharedMemorySize, LDS_BYTES) != hipSuccess) { fprintf(stderr, "kernel_launch: hipFuncSetAttribute failed\n"); grid = -1; return; }
        if (hipOccupancyMaxActiveBlocksPerMultiprocessor(&per_cu, (const void*)yoco_fwd, NWAVES * 64, LDS_BYTES) != hipSuccess || per_cu < 1) fprintf(stderr, "kernel_launch: occupancy query reports %d\n", per_cu);
        (void)hipGetLastError();
        grid = cus - (cus % 16);
    }
    if (grid < 0) return;
    if (hipMemsetAsync((char*)d_ws + WS_CTL, 0, CTL_ZERO_BYTES, stream) != hipSuccess) return;
    Args a{};
    for (int i = 0; i < 31; ++i) a.in[i] = (const float*)d_in[i];
    a.out = (float*)d_out; a.ws = (unsigned char*)d_ws;
    for (int li = 0; li < (N_LAUNCHES == 1 ? 1 : (int)NPHASE); ++li) {
        a.ph_lo = (N_LAUNCHES == 1) ? 0 : li; a.ph_hi = (N_LAUNCHES == 1) ? NPHASE : li + 1; a.li = li;
        hipLaunchKernelGGL(yoco_fwd, dim3(grid), dim3(NWAVES * 64), LDS_BYTES, stream, a);
        const hipError_t le = hipPeekAtLastError();
        if (le != hipSuccess) { fprintf(stderr, "kernel_launch: launch %d failed: %s\n", li, hipGetErrorName(le)); break; }
    }
}
```

```cpp
#include <hip/hip_runtime.h>
#include <cstdio>
#include <cstdint>

#ifndef MK_N_LAUNCHES
#define MK_N_LAUNCHES 1
#endif

namespace pg8 {
#define PG8_LAS __attribute__((address_space(3)))
typedef unsigned short bf16_t;
typedef short bf16x8 __attribute__((ext_vector_type(8)));
typedef float f32x4 __attribute__((ext_vector_type(4)));
typedef unsigned u32x4 __attribute__((ext_vector_type(4)));
constexpr int BM = 256, BK = 64, HALF = 128, HTB = HALF * BK * 2, STAGE_BYTES = 8 * HTB, NXCD = 8, WGM = 8;

__host__ __device__ __forceinline__ int lds_byte(int r, int c) { const int st = (r >> 4) * 2 + (c >> 5), rr = r & 15, cc = c & 31, ob = rr * 64 + cc * 2; return st * 1024 + (ob ^ (((ob >> 9) & 1) << 5)); }
__host__ __device__ __forceinline__ void stage_rc(int b, int& R, int& C) { const int st = b / 1024, sb = b % 1024, swz = sb ^ (((sb >> 9) & 1) << 5); R = (st >> 1) * 16 + swz / 64; C = (st & 1) * 32 + (swz % 64) / 2; }
__host__ __device__ __forceinline__ int perm32(int rho) { const int n = rho >> 4, i = rho & 15; return 8 * (i >> 2) + 4 * n + (i & 3); }

struct Unit { int pm, pn, aux, r0, cnt; };

__host__ __device__ __forceinline__ void tile_map(int wgid, int nM, int nN, int& pm, int& pn) {
    const int nwg = nM * nN;
    { const int q = nwg / NXCD, r = nwg % NXCD, xcd = wgid % NXCD, off = wgid / NXCD; wgid = (xcd < r ? xcd * (q + 1) : r * (q + 1) + (xcd - r) * q) + off; }
    const int nig = WGM * nN, gid = wgid / nig, fm = gid * WGM, gsz = (nM - fm) < WGM ? (nM - fm) : WGM;
    pm = fm + ((wgid % nig) % gsz); pn = (wgid % nig) / gsz;
}

typedef float f32x2_t __attribute__((ext_vector_type(2))); typedef __bf16 bf16x2_t __attribute__((ext_vector_type(2)));
__device__ __forceinline__ unsigned cvt_pk_bf16(float lo, float hi) { const f32x2_t v = {lo, hi}; const bf16x2_t b = __builtin_convertvector(v, bf16x2_t); return __builtin_bit_cast(unsigned, b); }

template <class Epi, class Sched, bool ALIGN_EPI, bool GATHER, int K>
__device__ __forceinline__ void gemm_phase(PG8_LAS unsigned char* lds, const Sched& S, const Epi& E, const int wid) {
    int lane_; asm volatile("v_mbcnt_lo_u32_b32 %0, -1, 0\n\tv_mbcnt_hi_u32_b32 %0, -1, %0" : "=v"(lane_));
    const int lane = lane_, tid = wid * 64 + lane, wr = wid >> 2, wc = wid & 3, fr = lane & 15, fq = lane >> 4;
    constexpr int nt = K / BK;
    unsigned voffA[2], voffB[2];
#pragma unroll
    for (int i = 0; i < 2; ++i) { int R, C; stage_rc(tid * 16 + i * 8192, R, C); const int Rb = Epi::PERM ? ((R & ~31) + perm32(R & 31)) : R;
        voffA[i] = (unsigned)(R * K + C) * 2u; voffB[i] = (unsigned)(Rb * K + C) * 2u; }
    constexpr size_t kstep = (size_t)(BK * 2);
    constexpr size_t hstep = (size_t)HALF * K * 2;
    const unsigned ldsw = (unsigned)wid * 1024u;
    const int aoff = lds_byte(wr * 64 + fr, fq * 8), boff = lds_byte(wc * 32 + fr, fq * 8);
#define PG8_SA(b, h) (((b) * 2 + (h)) * HTB)
#define PG8_SB(b, h) ((4 + (b) * 2 + (h)) * HTB)
#define PG8_STAGE(bufoff, gbase, voff) do { _Pragma("unroll") for (int _i = 0; _i < 2; ++_i) \
        __builtin_amdgcn_global_load_lds((const unsigned*)((const char*)(gbase) + (voff)[_i]), (PG8_LAS unsigned*)(lds + (bufoff) + ldsw + _i * 8192), 16, 0, 0); } while (0)
#define PG8_LDA(dst, b, h) do { _Pragma("unroll") for (int m = 0; m < 4; ++m) _Pragma("unroll") for (int k = 0; k < 2; ++k) dst[m][k] = *(const PG8_LAS bf16x8*)(lds + PG8_SA(b, h) + aoff + m * 2048 + k * 1024); } while (0)
#define PG8_LDB(dst, b, h) do { _Pragma("unroll") for (int n = 0; n < 2; ++n) _Pragma("unroll") for (int k = 0; k < 2; ++k) dst[n][k] = *(const PG8_LAS bf16x8*)(lds + PG8_SB(b, h) + boff + n * 2048 + k * 1024); } while (0)
#define PG8_MMA(ai, bj, At, Bt) do { __builtin_amdgcn_s_setprio(1); _Pragma("unroll") for (int m = 0; m < 4; ++m) _Pragma("unroll") for (int n = 0; n < 2; ++n) _Pragma("unroll") for (int k = 0; k < 2; ++k) \
        acc[ai][bj][m][n] = __builtin_amdgcn_mfma_f32_16x16x32_bf16(Bt[n][k], At[m][k], acc[ai][bj][m][n], 0, 0, 0); __builtin_amdgcn_s_setprio(0); } while (0)
#define PG8_WAIT_V(n) asm volatile("s_waitcnt vmcnt(" #n ")" ::: "memory")
#define PG8_WAIT_L(n) asm volatile("s_waitcnt lgkmcnt(" #n ")" ::: "memory")
#define PG8_BAR __builtin_amdgcn_s_barrier()
#define PG8_SCHED __builtin_amdgcn_sched_barrier(0)
    Unit cur, nxt; int ui = 0;
    if (!S.next(0, cur)) return;
    f32x4 acc[2][2][4][2];
#pragma unroll
    for (int a = 0; a < 2; ++a)
#pragma unroll
        for (int b = 0; b < 2; ++b)
#pragma unroll
            for (int m = 0; m < 4; ++m)
#pragma unroll
                for (int n = 0; n < 2; ++n) acc[a][b][m][n] = (f32x4){0.f, 0.f, 0.f, 0.f};
    bf16x8 At[4][2], B0[2][2], B1[2][2];
    unsigned vc[2][2];
#define PG8_GOFF(u) do { _Pragma("unroll") for (int _h = 0; _h < 2; ++_h) _Pragma("unroll") for (int _i = 0; _i < 2; ++_i) { int _R, _C; stage_rc(tid * 16 + _i * 8192, _R, _C); \
        vc[_h][_i] = S.a_row_off(u, _h * HALF + _R) + (unsigned)_C * 2u; } } while (0)
#define PG8_STAGE_A(bufoff, gbase, h) do { if constexpr (GATHER) { PG8_STAGE(bufoff, gbase, vc[h]); } else { PG8_STAGE(bufoff, (gbase) + (h) * hstep, voffA); } } while (0)
    if constexpr (GATHER) PG8_GOFF(cur);
    const char* cA = S.a_base(cur); const char* cB = S.b_base(cur);
    PG8_STAGE(PG8_SB(0, 0), cB, voffB); PG8_STAGE(PG8_SB(0, 1), cB + hstep, voffB); PG8_STAGE_A(PG8_SA(0, 0), cA, 0); PG8_STAGE_A(PG8_SA(0, 1), cA, 1);
    if (wr == 1) PG8_BAR;
    PG8_WAIT_V(2); PG8_BAR;
    PG8_STAGE(PG8_SB(1, 0), cB + kstep, voffB); PG8_STAGE_A(PG8_SA(1, 0), cA + kstep, 0); PG8_STAGE(PG8_SB(1, 1), cB + hstep + kstep, voffB);
    PG8_WAIT_V(6); PG8_BAR;
    for (;;) {
        const bool has_next = S.next(ui + 1, nxt);
        const char* nA = has_next ? S.a_base(nxt) : cA; const char* nB = has_next ? S.b_base(nxt) : cB;
        for (int t = 0; t < nt; t += 2) {
            const bool last = (t == nt - 2);
            const char* a1 = cA + (size_t)(t + 1) * kstep;
            const char* a2 = last ? nA : cA + (size_t)(t + 2) * kstep; const char* b2 = last ? nB : cB + (size_t)(t + 2) * kstep;
            const char* a3 = a2 + kstep; const char* b3 = b2 + kstep;
            PG8_LDB(B0, 0, 0); PG8_LDB(B1, 0, 1); PG8_SCHED; PG8_LDA(At, 0, 0); PG8_STAGE_A(PG8_SA(1, 1), a1, 1);
            if constexpr (GATHER) { if (last && has_next) PG8_GOFF(nxt); }
            PG8_WAIT_V(8); PG8_WAIT_L(0); PG8_BAR; PG8_MMA(0, 0, At, B0); PG8_MMA(0, 1, At, B1); PG8_BAR; PG8_SCHED;
            PG8_LDA(At, 0, 1); PG8_STAGE(PG8_SB(0, 0), b2, voffB); PG8_STAGE(PG8_SB(0, 1), b2 + hstep, voffB); PG8_STAGE_A(PG8_SA(0, 0), a2, 0);
            PG8_WAIT_V(8); PG8_WAIT_L(0); PG8_BAR; PG8_MMA(1, 0, At, B0); PG8_MMA(1, 1, At, B1); PG8_BAR; PG8_SCHED;
            PG8_LDB(B0, 1, 0); PG8_LDB(B1, 1, 1); PG8_SCHED; PG8_LDA(At, 1, 0); PG8_STAGE_A(PG8_SA(0, 1), a2, 1);
            PG8_WAIT_V(8); PG8_WAIT_L(0); PG8_BAR; PG8_MMA(0, 0, At, B0); PG8_MMA(0, 1, At, B1); PG8_BAR; PG8_SCHED;
            PG8_LDA(At, 1, 1); PG8_STAGE(PG8_SB(1, 0), b3, voffB); PG8_STAGE(PG8_SB(1, 1), b3 + hstep, voffB); PG8_STAGE_A(PG8_SA(1, 0), a3, 0);
            PG8_WAIT_V(8); PG8_WAIT_L(0); PG8_BAR; PG8_MMA(1, 0, At, B0); PG8_MMA(1, 1, At, B1); PG8_BAR; PG8_SCHED;
        }
        if constexpr (ALIGN_EPI) { if (wr == 0) PG8_BAR; }
        E(acc, cur, wr, wc, fr, fq);
        if (!has_next) break;
#pragma unroll
        for (int a = 0; a < 2; ++a)
#pragma unroll
            for (int b = 0; b < 2; ++b)
#pragma unroll
                for (int m = 0; m < 4; ++m)
#pragma unroll
                    for (int n = 0; n < 2; ++n) acc[a][b][m][n] = (f32x4){0.f, 0.f, 0.f, 0.f};
        cur = nxt; cA = nA; cB = nB; ++ui;
        if constexpr (ALIGN_EPI) { if (wr == 1) PG8_BAR; }
    }
    PG8_WAIT_V(0);
    if constexpr (!ALIGN_EPI) { if (wr == 0) PG8_BAR; }
    PG8_BAR;
#undef PG8_SA
#undef PG8_SB
#undef PG8_STAGE
#undef PG8_STAGE_A
#undef PG8_GOFF
#undef PG8_LDA
#undef PG8_LDB
#undef PG8_MMA
#undef PG8_WAIT_V
#undef PG8_WAIT_L
#undef PG8_BAR
#undef PG8_SCHED
}
}

constexpr int NWAVES = 8;
#ifndef MK_DEBUG
#define MK_DEBUG 0
#endif
#ifndef DBG_USE_NAIVE
#define DBG_USE_NAIVE 0
#endif
constexpr int DBGP = MK_DEBUG ? 3 : 0;
enum Phase { PH_P0 = 0, PH_LORA, PH_RKV, PH_S1, PH_S2, PH_S3, PH_DBG0, PH_WOUT = PH_DBG0 + DBGP, PH_ROUT0, PH_GU0, PH_DN0, PH_COMB, PH_KVQ, PH_ATTN, PH_SBO, PH_ROUT1, PH_GU1, PH_DN1, PH_FINAL, NPHASE };
constexpr int N_LAUNCHES = MK_N_LAUNCHES;


constexpr int BATCH = 2, SEQ = 8192, C = 1024, NH = 16, HD = 64, M = BATCH * SEQ;
constexpr int NE = 16, FE = 256, DW = 64, DA = 64, DG = 160;
constexpr float RMS_EPS = 1e-6f, GN_EPS = 64e-5f;
constexpr float SB_EXIT = 104.0f;

constexpr size_t MiB = 1u << 20;
constexpr size_t WS_CTL = 0, CTL_ZERO_BYTES = 64 * 1024;
constexpr size_t WS_WT_W2 = 128 * 1024, WS_WT_A2 = 256 * 1024, WS_WT_G2 = 384 * 1024;
constexpr size_t WS_WT_RKV = 1 * MiB;
constexpr size_t WS_WT_LORA = 7 * MiB;
constexpr size_t WS_WT_OUT = 9 * MiB;
constexpr size_t WS_WT_KVQ = 11 * MiB;
constexpr size_t WS_WT_SBO = 17 * MiB;
constexpr size_t WS_WT_GU = 19 * MiB;
constexpr size_t WS_WT_DN = 51 * MiB;
constexpr size_t WS_LW = 67 * MiB;
constexpr size_t WS_LA = 69 * MiB;
constexpr size_t WS_LG = 71 * MiB;
static_assert(WS_LA == WS_LW + 2 * MiB && WS_LG == WS_LW + 4 * MiB, "EpiLora's pointer arithmetic");
constexpr size_t WS_LIST = 76 * MiB;
constexpr size_t WS_WL = 77 * MiB;
constexpr size_t WS_HID = 78 * MiB;
constexpr size_t WS_B0 = 96 * MiB, WS_B1 = 128 * MiB, WS_B2 = 160 * MiB, WS_B3 = 192 * MiB, WS_B4 = 224 * MiB, WS_END = 256 * MiB;
static_assert(WS_HID + (size_t)144 * 256 * 256 * 2 <= WS_B0, "HID vs B0");
constexpr int CW_TMO = 0;
constexpr int CW_CNT = 1024;
constexpr int CW_BAR = 4096;

constexpr int RING_BYTES = 131072;
constexpr int LDSCTL_OFF = 146688, MISC_OFF = LDSCTL_OFF + 320, MOE_TAB_OFF = MISC_OFF + 128;
constexpr int LDS_BYTES = 147456;
static_assert(MOE_TAB_OFF + 256 <= LDS_BYTES, "LDS map");
static_assert(BATCH * NH * (SEQ / 64) % 16 == 0, "scan units");

#define GAS __attribute__((address_space(1)))
#define LAS __attribute__((address_space(3)))
typedef unsigned short bf16;
typedef unsigned v4u __attribute__((ext_vector_type(4)));
typedef unsigned v2u __attribute__((ext_vector_type(2)));
typedef float f32x4 __attribute__((ext_vector_type(4)));
typedef GAS unsigned gu32;
#define RLX_AGENT __ATOMIC_RELAXED, __HIP_MEMORY_SCOPE_AGENT
#define LDS_WAIT() asm volatile("s_waitcnt lgkmcnt(0)" ::: "memory")
#define VM_WAIT() asm volatile("s_waitcnt vmcnt(0)" ::: "memory")
__device__ __forceinline__ unsigned f2bf(float f) { unsigned u = __builtin_bit_cast(unsigned, f); return (u + 0x7fffu + ((u >> 16) & 1u)) >> 16; }
__device__ __forceinline__ unsigned pk2(float lo, float hi) { return f2bf(lo) | (f2bf(hi) << 16); }
__device__ __forceinline__ float bflo(unsigned u) { return __uint_as_float(u << 16); }
__device__ __forceinline__ float bfhi(unsigned u) { return __uint_as_float(u & 0xffff0000u); }
__device__ __forceinline__ float bf2f(bf16 b) { return __uint_as_float((unsigned)b << 16); }
__device__ __forceinline__ float sigmoidf_(float x) { return 1.0f / (1.0f + __expf(-x)); }

#define XB_TMO      128
#define XB_XCNT(j)  (256  + 64 * (j))
#define XB_XSUB(j)  (1280 + 64 * (j))
#define XB_XGEN(j)  (2304 + 64 * (j))
#define XB_TOP      3328
#define XB_TOPGEN   3392
#define XCD_BAR_WORDS 3456
#define XB_SPIN_CAP (1u << 18)
__device__ __forceinline__ unsigned xb_ld(unsigned* p)              { return __hip_atomic_load(p, __ATOMIC_RELAXED, __HIP_MEMORY_SCOPE_AGENT); }
__device__ __forceinline__ unsigned xb_add(unsigned* p, unsigned v) { return __hip_atomic_fetch_add(p, v, __ATOMIC_RELAXED, __HIP_MEMORY_SCOPE_AGENT); }
__device__ __forceinline__ unsigned xb_xcc_id() { return (unsigned)__builtin_amdgcn_s_getreg((3 << 11) | 20) & 0xFu; }
#define XB_SPIN(cond, bar) do { unsigned _sp = 0; while (cond) { __builtin_amdgcn_s_sleep(1); \
    if ((++_sp & 255u) == 0u) { if (xb_ld(&(bar)[XB_TMO])) break; if (_sp > XB_SPIN_CAP) { atomicAdd(&(bar)[XB_TMO], 1u); break; } } } } while (0)
struct XcdBarrier { unsigned* bar; unsigned x; volatile LAS unsigned* st; };
__device__ __forceinline__ XcdBarrier xcd_barrier_post(unsigned* bar, volatile LAS unsigned* st) {
    XcdBarrier b; b.bar = bar; b.x = xb_xcc_id(); b.st = st;
    if (threadIdx.x == 0) (void)xb_add(&bar[XB_XCNT(b.x)], 1u);
    return b;
}
__device__ __forceinline__ void xcd_barrier_complete(unsigned* bar, unsigned x, unsigned& nloc, unsigned& nx) {
    const unsigned G = gridDim.x * gridDim.y * gridDim.z;
    unsigned sum, cnt, mine, sp = 0u;
    for (;;) {
        sum = 0u; cnt = 0u; mine = 0u;
#pragma unroll
        for (unsigned j = 0; j < 16; ++j) { const unsigned c = xb_ld(&bar[XB_XCNT(j)]); sum += c; cnt += (c > 0u) ? 1u : 0u; mine = (j == x) ? c : mine; }
        if (sum == G) break;
        __builtin_amdgcn_s_sleep(1);
        if ((++sp & 255u) == 0u) { if (xb_ld(&bar[XB_TMO])) break; if (sp > XB_SPIN_CAP) { atomicAdd(&bar[XB_TMO], 1u); break; } }
    }
    nloc = mine > 0u ? mine : 1u; nx = cnt > 0u ? cnt : 1u;
}
__device__ __forceinline__ void xcd_barrier(const XcdBarrier& b) {
    asm volatile("s_waitcnt vmcnt(0)" ::: "memory");
    __syncthreads();
    if (threadIdx.x == 0) {
        unsigned* bar = b.bar;
        __builtin_amdgcn_s_waitcnt(0);
        unsigned nloc = b.st[0], nx = b.st[1];
        if (nloc == 0u) { xcd_barrier_complete(bar, b.x, nloc, nx); b.st[0] = nloc; b.st[1] = nx; }
        const unsigned old = xb_add(&bar[XB_XSUB(b.x)], 1u);
        const unsigned gen = old / nloc;
        if (old + 1u == (gen + 1u) * nloc) {
            __builtin_amdgcn_fence(__ATOMIC_RELEASE, "agent");
            asm volatile("s_waitcnt vmcnt(0)" ::: "memory");
            const unsigned og = xb_add(&bar[XB_TOP], 1u);
            const unsigned tg = og / nx;
            if (og + 1u == (tg + 1u) * nx) xb_add(&bar[XB_TOPGEN], 1u);
            else XB_SPIN(xb_ld(&bar[XB_TOPGEN]) == tg, bar);
            __builtin_amdgcn_fence(__ATOMIC_ACQUIRE, "agent");
            xb_add(&bar[XB_XGEN(b.x)], 1u);
            asm volatile("s_waitcnt vmcnt(0)" ::: "memory");
        } else {
            XB_SPIN(xb_ld(&bar[XB_XGEN(b.x)]) == gen, bar);
            __builtin_amdgcn_fence(__ATOMIC_ACQUIRE, "agent");
            asm volatile("s_waitcnt vmcnt(0)" ::: "memory");
        }
    }
    __syncthreads();
}

__device__ __forceinline__ float shx(float v, int o, int lane) { return __int_as_float(__builtin_amdgcn_ds_bpermute((lane ^ o) << 2, __float_as_int(v))); }
__device__ __forceinline__ float wave_sum(float v, int lane) {
#pragma unroll
    for (int o = 1; o < 64; o <<= 1) v += shx(v, o, lane);
    return v;
}
__device__ __forceinline__ void transpose_item(const float* W, int ldw, int k0, int n0, bf16* WT, int ldk, int dst_row0, const float* kscale, LAS float* scr, int lane, int kmax = 1 << 30) {
    const int r8 = lane >> 3, quad = lane & 7;
    f32x4 v[8];
#pragma unroll
    for (int i = 0; i < 8; ++i) { const int kk = r8 + 8 * i; v[i] = (k0 + kk < kmax) ? *(const GAS f32x4*)(W + (size_t)(k0 + kk) * ldw + n0 + quad * 4) : (f32x4){0.f, 0.f, 0.f, 0.f}; }
#pragma unroll
    for (int i = 0; i < 8; ++i) { const int kk = r8 + 8 * i; if (kscale) v[i] = v[i] * kscale[(k0 + kk < kmax) ? k0 + kk : 0]; *(LAS f32x4*)(scr + kk * 36 + ((quad ^ i) << 2)) = v[i]; }
    LDS_WAIT(); asm volatile("" ::: "memory");
    const int c = lane & 7;
#pragma unroll
    for (int j = 0; j < 4; ++j) { const int n = (lane >> 3) + 8 * j; const LAS float* sp = scr + (8 * c) * 36 + ((((n >> 2) ^ c) << 2) | (n & 3));
        v4u o; o.x = pk2(sp[0 * 36], sp[1 * 36]); o.y = pk2(sp[2 * 36], sp[3 * 36]); o.z = pk2(sp[4 * 36], sp[5 * 36]); o.w = pk2(sp[6 * 36], sp[7 * 36]);
        if (k0 + 8 * c < kmax) *(GAS v4u*)(WT + (size_t)(dst_row0 + n) * ldk + k0 + 8 * c) = o; }
    LDS_WAIT(); asm volatile("" ::: "memory");
}

struct Args { const float* in[31]; float* out; unsigned char* ws; int ph_lo, ph_hi, li, pad; };
typedef const __attribute__((address_space(4))) unsigned char* kaptr_t;
__device__ __forceinline__ kaptr_t ka_base() { kaptr_t p = (kaptr_t)__builtin_amdgcn_kernarg_segment_ptr(); asm volatile("" : "+s"(p)); return p; }
#define INP(k) (*(const float* const __attribute__((address_space(4)))*)(ka_base() + 8 * (k)))
#define OUTP() (*(float* const __attribute__((address_space(4)))*)(ka_base() + 8 * 31))
#define WSP() (*(unsigned char* const __attribute__((address_space(4)))*)(ka_base() + 8 * 32))
#define KA_INT(i) (*(const int __attribute__((address_space(4)))*)(ka_base() + 8 * 33 + 4 * (i)))

template <int PART> __device__ __forceinline__ void p0_weights(unsigned char* ws, LAS unsigned char* lds, int gw, int NGW, int wave, int lane) {
    LAS float* scr = (LAS float*)(lds + wave * 16384);
    bf16* WT_RKV = (bf16*)(ws + WS_WT_RKV); bf16* WT_LORA = (bf16*)(ws + WS_WT_LORA); bf16* WT_OUT = (bf16*)(ws + WS_WT_OUT); bf16* WT_KVQ = (bf16*)(ws + WS_WT_KVQ);
    bf16* WT_SBO = (bf16*)(ws + WS_WT_SBO); bf16* WT_GU = (bf16*)(ws + WS_WT_GU); bf16* WT_DN = (bf16*)(ws + WS_WT_DN);
    constexpr int I_UP = 32 + 32 + 96, I_RKV = 3 * 512, I_LORA = 32 + 32 + 80, I_OUT = 512, I_KV = 1024, I_Q = 512, I_SBO = 512, I_G = 32 * 128, I_U = 32 * 128, I_D = 32 * 128;
    constexpr int NDENSE = I_UP + I_RKV + I_LORA + I_OUT + I_KV + I_Q + I_SBO, NITEMS = NDENSE + I_G + I_U + I_D;
    for (int it = (PART == 0 ? 0 : NDENSE) + gw; it < (PART == 0 ? NDENSE : NITEMS); it += NGW) {
        int r = it;
        if (r < I_UP) {
            if (r < 32) transpose_item(INP(9), C, 0, 32 * r, (bf16*)(ws + WS_WT_W2), 64, 32 * r, nullptr, scr, lane);
            else if (r < 64) transpose_item(INP(12), C, 0, 32 * (r - 32), (bf16*)(ws + WS_WT_A2), 64, 32 * (r - 32), nullptr, scr, lane);
            else { const int q = r - 64, kb = q / 32, nb = q % 32; transpose_item(INP(14), C, 64 * kb, 32 * nb, (bf16*)(ws + WS_WT_G2), DG, 32 * nb, nullptr, scr, lane, DG); }
            continue; } r -= I_UP;
        if (r < I_RKV) { const int m = r / 512, q = r % 512, kb = q / 32, nb = q % 32; transpose_item(INP(6) + (size_t)m * C * C, C, 64 * kb, 32 * nb, WT_RKV, C, m * C + 32 * nb, nullptr, scr, lane); continue; } r -= I_RKV;
        if (r < I_LORA) {
            if (r < 32) { const int kb = r / 2, nb = r % 2; transpose_item(INP(8), DW, 64 * kb, 32 * nb, WT_LORA, C, 32 * nb, nullptr, scr, lane); }
            else if (r < 64) { const int q = r - 32, kb = q / 2, nb = q % 2; transpose_item(INP(11), DA, 64 * kb, 32 * nb, WT_LORA, C, 256 + 32 * nb, nullptr, scr, lane); }
            else { const int q = r - 64, kb = q / 5, nb = q % 5; transpose_item(INP(13), DG, 64 * kb, 32 * nb, WT_LORA, C, 512 + 32 * nb, nullptr, scr, lane); }
            continue; } r -= I_LORA;
        if (r < I_OUT) { const int kb = r / 32, nb = r % 32; transpose_item(INP(20), C, 64 * kb, 32 * nb, WT_OUT, C, 32 * nb, nullptr, scr, lane); continue; } r -= I_OUT;
        if (r < I_KV) { const int kb = r / 64, nb = r % 64; transpose_item(INP(21), 2 * C, 64 * kb, 32 * nb, WT_KVQ, C, 32 * nb, INP(3), scr, lane); continue; } r -= I_KV;
        if (r < I_Q) { const int kb = r / 32, nb = r % 32; transpose_item(INP(22), C, 64 * kb, 32 * nb, WT_KVQ, C, 2 * C + 32 * nb, INP(1) + C, scr, lane); continue; } r -= I_Q;
        if (r < I_SBO) { const int kb = r / 32, nb = r % 32; transpose_item(INP(23), C, 64 * kb, 32 * nb, WT_SBO, C, 32 * nb, nullptr, scr, lane); continue; } r -= I_SBO;
        if (r < I_G) { const int le = r / 128, q = r % 128, kb = q / 8, nb = q % 8, f0 = 32 * nb; transpose_item(INP(28) + (size_t)le * C * FE, FE, 64 * kb, f0, WT_GU + (size_t)le * 512 * C, C, 256 * (f0 / 128) + (f0 % 128), nullptr, scr, lane); continue; } r -= I_G;
        if (r < I_U) { const int le = r / 128, q = r % 128, kb = q / 8, nb = q % 8, f0 = 32 * nb; transpose_item(INP(29) + (size_t)le * C * FE, FE, 64 * kb, f0, WT_GU + (size_t)le * 512 * C, C, 256 * (f0 / 128) + 128 + (f0 % 128), nullptr, scr, lane); continue; } r -= I_U;
        { const int le = r / 128, q = r % 128, kb = q / 32, nb = q % 32; transpose_item(INP(30) + (size_t)le * FE * C, C, 64 * kb, 32 * nb, WT_DN + (size_t)le * C * FE, FE, 32 * nb, nullptr, scr, lane); }
    }
    if (PART == 0) for (int it = gw * 64 + lane; it < 768 * 128; it += NGW * 64) { const int row = it >> 7, ch = it & 127;
        const bool valid = (row < 64) || (row >= 256 && row < 320) || (row >= 512 && row < 672);
        if (!valid) *(GAS v4u*)(WT_LORA + (size_t)row * C + ch * 8) = (v4u){0u, 0u, 0u, 0u}; }
}
__device__ __forceinline__ void load_row(const float* p, int lane, f32x4 (&v)[4]) {
#pragma unroll
    for (int j = 0; j < 4; ++j) v[j] = ((const GAS f32x4*)p)[64 * j + lane];
}
__device__ __forceinline__ void load_row_bf(const bf16* p, int lane, f32x4 (&v)[4]) {
#pragma unroll
    for (int j = 0; j < 4; ++j) { const v2u w = ((const GAS v2u*)p)[64 * j + lane]; v[j] = (f32x4){bflo(w.x), bfhi(w.x), bflo(w.y), bfhi(w.y)}; }
}
__device__ __forceinline__ float row_rs(const f32x4 (&v)[4], int lane) {
    float s = 0.f;
#pragma unroll
    for (int j = 0; j < 4; ++j) s += (v[j].x * v[j].x + v[j].y * v[j].y) + (v[j].z * v[j].z + v[j].w * v[j].w);
    return 1.0f / sqrtf(wave_sum(s, lane) * (1.0f / C) + RMS_EPS);
}
__device__ __forceinline__ void store_row_bf16(bf16* p, int lane, const f32x4 (&v)[4]) {
#pragma unroll
    for (int j = 0; j < 4; ++j) { v2u o; o.x = pk2(v[j].x, v[j].y); o.y = pk2(v[j].z, v[j].w); ((GAS v2u*)p)[64 * j + lane] = o; }
}
__device__ __forceinline__ void p0_rows(unsigned char* ws, int gw, int NGW, int lane) {
    const float* x = INP(0); const float* gain = INP(1); const float* mix = INP(5);
    f32x4 g[4]; load_row(gain, lane, g);
    for (int run = gw; run < M / 8; run += NGW) {
        const int r0 = run * 8;
        f32x4 prev[4];
        if ((r0 % SEQ) == 0) {
#pragma unroll
            for (int j = 0; j < 4; ++j) prev[j] = (f32x4){0.f, 0.f, 0.f, 0.f};
        } else { load_row(x + (size_t)(r0 - 1) * C, lane, prev); const float rs = row_rs(prev, lane);
#pragma unroll
            for (int j = 0; j < 4; ++j) prev[j] = prev[j] * rs * g[j]; }
        for (int rr = 0; rr < 8; ++rr) {
            const int row = r0 + rr;
            f32x4 hn[4]; load_row(x + (size_t)row * C, lane, hn); const float rs = row_rs(hn, lane);
#pragma unroll
            for (int j = 0; j < 4; ++j) hn[j] = hn[j] * rs * g[j];
#pragma unroll
            for (int i = 0; i < 6; ++i) { f32x4 o[4];
#pragma unroll
                for (int j = 0; j < 4; ++j) { const f32x4 mx = ((const GAS f32x4*)(mix + i * C))[64 * j + lane]; o[j] = hn[j] + (prev[j] - hn[j]) * mx; }
                bf16* dst = i < 2 ? (bf16*)OUTP() + (size_t)i * M * C : (i == 2 ? (bf16*)(ws + WS_B4) : (bf16*)(ws + WS_B1) + (size_t)(i - 3) * M * C);
                store_row_bf16(dst + (size_t)row * C, lane, o); }
#pragma unroll
            for (int j = 0; j < 4; ++j) prev[j] = hn[j];
        }
    }
}

template <int NN, int NGROUPS> struct SchedGrouped {
    static constexpr int K = C;
    const char* A0; size_t astride; const char* A2; const char* B; size_t bgroup;
    int G, c;
    __device__ __forceinline__ bool next(int i, pg8::Unit& u) const {
        const int L = i * G + c; constexpr int per = 64 * NN; if (L >= per * NGROUPS) return false;
        const int g = L / per, w = L % per; pg8::tile_map(w, 64, NN, u.pm, u.pn); u.aux = g; u.r0 = 0; u.cnt = 0; return true; }
    __device__ __forceinline__ const char* a_base(const pg8::Unit& u) const { const char* A = (A2 != nullptr && u.aux == 2) ? A2 : A0 + (size_t)u.aux * astride; return A + (size_t)u.pm * 256 * K * 2; }
    __device__ __forceinline__ const char* b_base(const pg8::Unit& u) const { return B + (size_t)u.aux * bgroup + (size_t)u.pn * 256 * K * 2; }
    __device__ __forceinline__ unsigned a_row_off(const pg8::Unit&, int) const { return 0u; }
};
template <int NN, int K, bool GATHER> struct SchedMoe {
    const char* A; const char* B; size_t bexp; const unsigned* list; volatile LAS int* tab; int G, c;
    __device__ __forceinline__ bool next(int i, pg8::Unit& u) const {
        const int L = i * G + c; const int tot = __builtin_amdgcn_readfirstlane(tab[48]) * NN; if (L >= tot) return false;
        u.pm = L / NN; u.pn = L % NN; int e = 0;
#pragma unroll
        for (int j = 0; j < 16; ++j) e += (u.pm >= tab[32 + j]) ? 1 : 0;
        e = __builtin_amdgcn_readfirstlane(e);
        u.aux = e; u.r0 = (u.pm - __builtin_amdgcn_readfirstlane(tab[16 + e])) * 256; u.cnt = __builtin_amdgcn_readfirstlane(tab[e]); return true; }
    __device__ __forceinline__ const char* a_base(const pg8::Unit& u) const { return GATHER ? A : A + (size_t)u.pm * 256 * K * 2; }
    __device__ __forceinline__ const char* b_base(const pg8::Unit& u) const { return B + (size_t)u.aux * bexp + (size_t)u.pn * 256 * K * 2; }
    __device__ __forceinline__ unsigned a_row_off(const pg8::Unit& u, int r) const {
        const int idx = u.r0 + r; unsigned tok = 0u;
        if (idx < u.cnt) tok = list[(size_t)u.aux * M + idx] >> 1;
        return tok * (unsigned)(K * 2); }
};

using pg8::f32x4;
using pg8::Unit;
__device__ __forceinline__ v4u pack8(f32x4 v0, f32x4 v1) { v4u w; w.x = pg8::cvt_pk_bf16(v0[0], v0[1]); w.y = pg8::cvt_pk_bf16(v0[2], v0[3]); w.z = pg8::cvt_pk_bf16(v1[0], v1[1]); w.w = pg8::cvt_pk_bf16(v1[2], v1[3]); return w; }

struct EpiLora {
    static constexpr bool PERM = true;
    bf16* LW;
    __device__ __forceinline__ void operator()(const f32x4 (&acc)[2][2][4][2], const Unit& u, int wr, int wc, int fr, int fq) const {
        { int l_; asm volatile("v_mbcnt_lo_u32_b32 %0, -1, 0\n\tv_mbcnt_hi_u32_b32 %0, -1, %0" : "=v"(l_)); fr = l_ & 15; fq = l_ >> 4; }
        const int g = u.aux, width = g == 2 ? DG : DW; bf16* out = LW + (size_t)g * (1u << 20);
        const int row0 = u.pm * 256 + wr * 64 + fr;
#pragma unroll
        for (int bj = 0; bj < 2; ++bj) { const int col0 = bj * 128 + wc * 32 + 8 * fq; if (col0 < width) {
#pragma unroll
            for (int ai = 0; ai < 2; ++ai)
#pragma unroll
                for (int m = 0; m < 4; ++m) { f32x4 v0 = acc[ai][bj][m][0], v1 = acc[ai][bj][m][1];
                    if (g == 0) {
#pragma unroll
                        for (int q = 0; q < 4; ++q) { v0[q] = tanhf(v0[q]); v1[q] = tanhf(v1[q]); } }
                    else if (g == 2) {
#pragma unroll
                        for (int q = 0; q < 4; ++q) { v0[q] = sigmoidf_(v0[q]); v1[q] = sigmoidf_(v1[q]); } }
                    *(GAS v4u*)(out + (size_t)(row0 + ai * 128 + m * 16) * width + col0) = pack8(v0, v1); } } }
    }
};
struct EpiSplit3 {
    static constexpr bool PERM = true;
    bf16* O0; bool bycol;
    __device__ __forceinline__ void operator()(const f32x4 (&acc)[2][2][4][2], const Unit& u, int wr, int wc, int fr, int fq) const {
        { int l_; asm volatile("v_mbcnt_lo_u32_b32 %0, -1, 0\n\tv_mbcnt_hi_u32_b32 %0, -1, %0" : "=v"(l_)); fr = l_ & 15; fq = l_ >> 4; }
        const int g = bycol ? (u.pn >> 2) : u.aux, pn = bycol ? (u.pn & 3) : u.pn; bf16* out = O0 + (size_t)g * ((size_t)M * C);
        const int row0 = u.pm * 256 + wr * 64 + fr, col0 = pn * 256 + wc * 32 + 8 * fq;
#pragma unroll
        for (int ai = 0; ai < 2; ++ai)
#pragma unroll
            for (int m = 0; m < 4; ++m)
#pragma unroll
                for (int bj = 0; bj < 2; ++bj) *(GAS v4u*)(out + (size_t)(row0 + ai * 128 + m * 16) * C + col0 + bj * 128) = pack8(acc[ai][bj][m][0], acc[ai][bj][m][1]);
    }
};
template <bool BASE_F32> struct EpiResidBf {
    static constexpr bool PERM = true;
    const void* base; bf16* out;
    __device__ __forceinline__ void operator()(const f32x4 (&acc)[2][2][4][2], const Unit& u, int wr, int wc, int fr, int fq) const {
        { int l_; asm volatile("v_mbcnt_lo_u32_b32 %0, -1, 0\n\tv_mbcnt_hi_u32_b32 %0, -1, %0" : "=v"(l_)); fr = l_ & 15; fq = l_ >> 4; }
        const int row0 = u.pm * 256 + wr * 64 + fr, col0 = u.pn * 256 + wc * 32 + 8 * fq;
#pragma unroll
        for (int ai = 0; ai < 2; ++ai)
#pragma unroll
            for (int m = 0; m < 4; ++m) { const size_t off = (size_t)(row0 + ai * 128 + m * 16) * C + col0;
#pragma unroll
                for (int bj = 0; bj < 2; ++bj) { f32x4 b0, b1;
                    if (BASE_F32) { b0 = *(const GAS f32x4*)((const float*)base + off + bj * 128); b1 = *(const GAS f32x4*)((const float*)base + off + bj * 128 + 4); }
                    else { const v4u w = *(const GAS v4u*)((const bf16*)base + off + bj * 128); b0 = (f32x4){bflo(w.x), bfhi(w.x), bflo(w.y), bfhi(w.y)}; b1 = (f32x4){bflo(w.z), bfhi(w.z), bflo(w.w), bfhi(w.w)}; }
                    *(GAS v4u*)(out + off + bj * 128) = pack8(b0 + acc[ai][bj][m][0], b1 + acc[ai][bj][m][1]); }
                asm volatile("" ::: "memory"); }
    }
};
struct EpiGU {
    static constexpr bool PERM = true;
    bf16* HID; const float* wl;
    __device__ __forceinline__ void operator()(const f32x4 (&acc)[2][2][4][2], const Unit& u, int wr, int wc, int fr, int fq) const {
        { int l_; asm volatile("v_mbcnt_lo_u32_b32 %0, -1, 0\n\tv_mbcnt_hi_u32_b32 %0, -1, %0" : "=v"(l_)); fr = l_ & 15; fq = l_ >> 4; }
        const int e = u.aux, cnt = u.cnt, base = u.r0, r0 = wr * 64 + fr, col0 = u.pn * 128 + wc * 32 + 8 * fq;
#pragma unroll
        for (int ai = 0; ai < 2; ++ai)
#pragma unroll
            for (int m = 0; m < 4; ++m) { const int r = r0 + ai * 128 + m * 16, idx = base + r; float w = 0.f; if (idx < cnt) w = wl[(size_t)e * M + idx];
                f32x4 h0, h1;
#pragma unroll
                for (int q = 0; q < 4; ++q) { const float g0 = acc[ai][0][m][0][q], g1 = acc[ai][0][m][1][q];
                    h0[q] = g0 * sigmoidf_(g0) * acc[ai][1][m][0][q] * w; h1[q] = g1 * sigmoidf_(g1) * acc[ai][1][m][1][q] * w; }
                *(GAS v4u*)(HID + (size_t)(u.pm * 256 + r) * FE + col0) = pack8(h0, h1);
                asm volatile("" ::: "memory"); }
    }
};
struct EpiDown {
    static constexpr bool PERM = true;
    bf16* EO; const unsigned* list;
    __device__ __forceinline__ void operator()(const f32x4 (&acc)[2][2][4][2], const Unit& u, int wr, int wc, int fr, int fq) const {
        { int l_; asm volatile("v_mbcnt_lo_u32_b32 %0, -1, 0\n\tv_mbcnt_hi_u32_b32 %0, -1, %0" : "=v"(l_)); fr = l_ & 15; fq = l_ >> 4; }
        const int e = u.aux, cnt = u.cnt, base = u.r0, r0 = wr * 64 + fr, col0 = u.pn * 256 + wc * 32 + 8 * fq;
#pragma unroll
        for (int ai = 0; ai < 2; ++ai)
#pragma unroll
            for (int m = 0; m < 4; ++m) { const int idx = base + r0 + ai * 128 + m * 16;
                if (idx < cnt) { const unsigned ent = list[(size_t)e * M + idx]; bf16* o = EO + ((size_t)(ent & 1u) * M + (ent >> 1)) * C + col0;
#pragma unroll
                    for (int bj = 0; bj < 2; ++bj) *(GAS v4u*)(o + bj * 128) = pack8(acc[ai][bj][m][0], acc[ai][bj][m][1]); }
                asm volatile("" ::: "memory"); }
    }
};

typedef short bf16x8s __attribute__((ext_vector_type(8)));
typedef short bf16x4s __attribute__((ext_vector_type(4)));
typedef short v4i16_t __attribute__((ext_vector_type(4)));
constexpr int TPB = 144;
constexpr int TILE_B = 64 * TPB;
constexpr int FP = 68;
constexpr int CS_FA = 0, CS_FB = 16384, CS_TILES = 32768, CS_TOT = CS_TILES + 12 * TILE_B, CS_WL = CS_TOT + 2048, CS_PAR = CS_WL + 256;
static_assert(CS_PAR + 768 <= LDSCTL_OFF, "scan LDS map");
#define TILE(n) (lds + CS_TILES + (n) * TILE_B)
#define F4Z (f32x4){0.f, 0.f, 0.f, 0.f}
__device__ __forceinline__ bf16x8s ldfrag(const LAS unsigned char* tile, int row, int kcol) { return *(const LAS bf16x8s*)(tile + row * TPB + kcol * 2); }
__device__ __forceinline__ bf16x8s ldfrag_tr(const LAS unsigned char* tile, int n0, int k0, int lane) {
    const int g = lane >> 4, q = (lane & 15) >> 2, p = lane & 3;
    const LAS unsigned char* a = tile + (k0 + 8 * g + q) * TPB + (n0 + 4 * p) * 2;
    const v4i16_t lo = __builtin_amdgcn_ds_read_tr16_b64_v4i16((LAS v4i16_t*)a), hi = __builtin_amdgcn_ds_read_tr16_b64_v4i16((LAS v4i16_t*)(a + 4 * TPB));
    return (bf16x8s){lo[0], lo[1], lo[2], lo[3], hi[0], hi[1], hi[2], hi[3]};
}
__device__ __forceinline__ bf16x8s ldfrag_perm(const LAS unsigned char* tile, int row, int ks, int g) {
    const bf16x4s lo = *(const LAS bf16x4s*)(tile + row * TPB + (32 * ks + 4 * g) * 2), hi = *(const LAS bf16x4s*)(tile + row * TPB + (32 * ks + 16 + 4 * g) * 2);
    return (bf16x8s){lo[0], lo[1], lo[2], lo[3], hi[0], hi[1], hi[2], hi[3]};
}
__device__ __forceinline__ void lds_barrier() { asm volatile("s_waitcnt lgkmcnt(0)" ::: "memory"); __builtin_amdgcn_s_barrier(); asm volatile("" ::: "memory"); }
#define MFMA16(a, b, c) __builtin_amdgcn_mfma_f32_16x16x32_bf16((a), (b), (c), 0, 0, 0)
__device__ __forceinline__ void mm64(f32x4 (&acc)[2], const LAS unsigned char* At, const LAS unsigned char* Bt, int rt, int ch, int fr, int g) {
#pragma unroll
    for (int ks = 0; ks < 2; ++ks) { const bf16x8s a = ldfrag(At, 16 * rt + fr, 32 * ks + 8 * g);
#pragma unroll
        for (int ct = 0; ct < 2; ++ct) acc[ct] = MFMA16(a, ldfrag(Bt, 32 * ch + 16 * ct + fr, 32 * ks + 8 * g), acc[ct]); }
}
__device__ __forceinline__ void mm64_bt(f32x4 (&acc)[2], const LAS unsigned char* At, const LAS unsigned char* X, int rt, int ch, int fr, int g, int lane) {
#pragma unroll
    for (int ks = 0; ks < 2; ++ks) { const bf16x8s a = ldfrag(At, 16 * rt + fr, 32 * ks + 8 * g);
#pragma unroll
        for (int ct = 0; ct < 2; ++ct) acc[ct] = MFMA16(a, ldfrag_tr(X, 32 * ch + 16 * ct, 32 * ks, lane), acc[ct]); }
}
__device__ __forceinline__ void mm64_at(f32x4 (&acc)[2], const LAS unsigned char* Xa, const LAS unsigned char* Bt, int rt, int ch, int fr, int g, int lane) {
#pragma unroll
    for (int ks = 0; ks < 2; ++ks) { const bf16x8s a = ldfrag_tr(Xa, 16 * rt, 32 * ks, lane);
#pragma unroll
        for (int ct = 0; ct < 2; ++ct) acc[ct] = MFMA16(a, ldfrag(Bt, 32 * ch + 16 * ct + fr, 32 * ks + 8 * g), acc[ct]); }
}
__device__ __forceinline__ void mm64_att(f32x4 (&acc)[2], const LAS unsigned char* Xa, const LAS unsigned char* X, int rt, int ch, int lane) {
#pragma unroll
    for (int ks = 0; ks < 2; ++ks) { const bf16x8s a = ldfrag_tr(Xa, 16 * rt, 32 * ks, lane);
#pragma unroll
        for (int ct = 0; ct < 2; ++ct) acc[ct] = MFMA16(a, ldfrag_tr(X, 32 * ch + 16 * ct, 32 * ks, lane), acc[ct]); }
}
__device__ __forceinline__ bf16x4s pack4(f32x4 v) { v2u w; w.x = pg8::cvt_pk_bf16(v[0], v[1]); w.y = pg8::cvt_pk_bf16(v[2], v[3]); return __builtin_bit_cast(bf16x4s, w); }
__device__ __forceinline__ f32x4 unpack4(bf16x4s s) { const v2u w = __builtin_bit_cast(v2u, s); return (f32x4){bflo(w.x), bfhi(w.x), bflo(w.y), bfhi(w.y)}; }
__device__ __forceinline__ void st_tr(LAS unsigned char* Out, const f32x4 (&acc)[2], int rt, int ch, int fr, int g) {
#pragma unroll
    for (int ct = 0; ct < 2; ++ct) *(LAS bf16x4s*)(Out + (32 * ch + 16 * ct + fr) * TPB + (16 * rt + 4 * g) * 2) = pack4(acc[ct]);
}
__device__ __forceinline__ void ld_tr(f32x4 (&acc)[2], const LAS unsigned char* In, int rt, int ch, int fr, int g) {
#pragma unroll
    for (int ct = 0; ct < 2; ++ct) acc[ct] = unpack4(*(const LAS bf16x4s*)(In + (32 * ch + 16 * ct + fr) * TPB + (16 * rt + 4 * g) * 2));
}
__device__ __forceinline__ void unpack8(v4u w, float (&o)[8]) { o[0] = bflo(w.x); o[1] = bfhi(w.x); o[2] = bflo(w.y); o[3] = bfhi(w.y); o[4] = bflo(w.z); o[5] = bfhi(w.z); o[6] = bflo(w.w); o[7] = bfhi(w.w); }
__device__ __forceinline__ v4u pack8f(const float (&o)[8]) { v4u w; w.x = pg8::cvt_pk_bf16(o[0], o[1]); w.y = pg8::cvt_pk_bf16(o[2], o[3]); w.z = pg8::cvt_pk_bf16(o[4], o[5]); w.w = pg8::cvt_pk_bf16(o[6], o[7]); return w; }

struct FrontIn { v4u r, k, v; bf16x8s fw[2], fa[2]; };
__device__ __forceinline__ void front_fetch(FrontIn& f, unsigned char* ws, int unit, int tid, int lane, int wave) {
    const int h = unit & 15, c = (unit >> 4) & 127, b = unit >> 11; const size_t row0 = (size_t)b * SEQ + c * 64;
    const int rt = wave & 3, fr = lane & 15, g = lane >> 4, t = tid >> 3, cq = tid & 7, c0 = h * HD + cq * 8;
    const bf16* Rb = (const bf16*)(ws + WS_B1); const bf16* Kb = (const bf16*)(ws + WS_B2); const bf16* Vb = (const bf16*)(ws + WS_B3);
    const bf16* LW = (const bf16*)(ws + WS_LW); const bf16* LA = (const bf16*)(ws + WS_LA);
    f.r = *(const GAS v4u*)(Rb + (row0 + t) * C + c0); f.k = *(const GAS v4u*)(Kb + (row0 + t) * C + c0); f.v = *(const GAS v4u*)(Vb + (row0 + t) * C + c0);
#pragma unroll
    for (int ks = 0; ks < 2; ++ks) { f.fw[ks] = *(const GAS bf16x8s*)(LW + (row0 + 16 * rt + fr) * DW + 32 * ks + 8 * g); f.fa[ks] = *(const GAS bf16x8s*)(LA + (row0 + 16 * rt + fr) * DA + 32 * ks + 8 * g); }
}
__device__ __forceinline__ v4u head_consts(unsigned char* ws, LAS unsigned char* lds, int h, int tid, int wtile, int atile) {
    const bf16* W2T = (const bf16*)(ws + WS_WT_W2); const bf16* A2T = (const bf16*)(ws + WS_WT_A2);
    const int row = tid >> 3, cq = tid & 7;
    const v4u w2chunk = *(const GAS v4u*)(W2T + (size_t)(h * HD + row) * 64 + cq * 8);
    *(LAS v4u*)(lds + CS_TILES + wtile * TILE_B + row * TPB + cq * 16) = w2chunk;
    *(LAS v4u*)(lds + CS_TILES + atile * TILE_B + row * TPB + cq * 16) = *(const GAS v4u*)(A2T + (size_t)(h * HD + row) * 64 + cq * 8);
    if (tid < 64) { LAS float* P = (LAS float*)(lds + CS_PAR); P[tid] = INP(15)[h * HD + tid]; P[64 + tid] = INP(16)[h * HD + tid]; P[128 + tid] = INP(17)[h * HD + tid]; }
    __syncthreads();
    return w2chunk;
}
template <int MODE>
__device__ __forceinline__ void chunk_front(const FrontIn& f, LAS unsigned char* lds, const float (&w0v)[2], const float (&a0v)[2], const bf16x8s (&w2f)[2][2], const bf16x8s (&a2f)[2][2], int tid, int lane, int wave, float (&v8)[8], float& rkb) {
    const int rt = wave & 3, ch = wave >> 2, fr = lane & 15, g = lane >> 4;
    LAS float* FA = (LAS float*)(lds + CS_FA); LAS float* FB = (LAS float*)(lds + CS_FB); LAS float* TOT = (LAS float*)(lds + CS_TOT);
    const int t = tid >> 3, cq = tid & 7;
    {
        f32x4 aw[2] = {F4Z, F4Z}, aa[2] = {F4Z, F4Z};
#pragma unroll
        for (int ks = 0; ks < 2; ++ks)
#pragma unroll
            for (int ct = 0; ct < 2; ++ct) { aw[ct] = MFMA16(f.fw[ks], w2f[ks][ct], aw[ct]); aa[ct] = MFMA16(f.fa[ks], a2f[ks][ct], aa[ct]); }
#pragma unroll
        for (int ct = 0; ct < 2; ++ct) { const int j = 32 * ch + 16 * ct + fr, js = j ^ ((g & 1) << 4); const float w0 = w0v[ct], a0 = a0v[ct];
            float p[4];
#pragma unroll
            for (int q = 0; q < 4; ++q) { p[q] = -0.6065306597126334f * sigmoidf_(w0 + aw[ct][q]); if (q) p[q] += p[q - 1]; }
            const float s_ = p[3];
            const float u1 = __int_as_float(__builtin_amdgcn_ds_bpermute(((lane - 16) & 63) << 2, __float_as_int(s_))); const float t1 = s_ + (g >= 1 ? u1 : 0.f);
            const float u2 = __int_as_float(__builtin_amdgcn_ds_bpermute(((lane - 32) & 63) << 2, __float_as_int(t1))); const float t2 = t1 + (g >= 2 ? u2 : 0.f);
            const float ex = t2 - s_;
#pragma unroll
            for (int q = 0; q < 4; ++q) { const int tt = 16 * rt + 4 * g + q; FA[tt * 64 + js] = p[q] + ex; FB[tt * 64 + js] = sigmoidf_(a0 + aa[ct][q]); }
            if (g == 3) TOT[rt * 64 + j] = t2; }
    }
    lds_barrier();
    {
        float r[8], k[8], pkk[8], pka[8], prk[8];
        unpack8(f.r, r); unpack8(f.k, k); unpack8(f.v, v8);
        { const LAS float* P = (const LAS float*)(lds + CS_PAR) + cq * 8; const f32x4 a0_ = *(const LAS f32x4*)P, a1_ = *(const LAS f32x4*)(P + 4), b0_ = *(const LAS f32x4*)(P + 64), b1_ = *(const LAS f32x4*)(P + 68), c0_ = *(const LAS f32x4*)(P + 128), c1_ = *(const LAS f32x4*)(P + 132);
#pragma unroll
          for (int q = 0; q < 4; ++q) { pkk[q] = a0_[q]; pkk[4 + q] = a1_[q]; pka[q] = b0_[q]; pka[4 + q] = b1_[q]; prk[q] = c0_[q]; prk[4 + q] = c1_[q]; } }
        float cw[8], cwp[8], ag[8];
        { const int tp = t > 0 ? t - 1 : 0, rtt = wave >> 1;
          const int ct_ = (cq ^ (((t >> 2) & 1) << 1)) * 8, cp_ = (cq ^ (((tp >> 2) & 1) << 1)) * 8;
          const f32x4 c0_ = *(const LAS f32x4*)(FA + t * 64 + ct_), c1_ = *(const LAS f32x4*)(FA + t * 64 + ct_ + 4), p0_ = *(const LAS f32x4*)(FA + tp * 64 + cp_), p1_ = *(const LAS f32x4*)(FA + tp * 64 + cp_ + 4);
          const f32x4 g0_ = *(const LAS f32x4*)(FB + t * 64 + ct_), g1_ = *(const LAS f32x4*)(FB + t * 64 + ct_ + 4);
          f32x4 o0_ = F4Z, o1_ = F4Z, l0_ = F4Z, l1_ = F4Z;
          for (int r_ = 0; r_ < rtt; ++r_) { l0_ = *(const LAS f32x4*)(TOT + r_ * 64 + cq * 8); l1_ = *(const LAS f32x4*)(TOT + r_ * 64 + cq * 8 + 4); o0_ = o0_ + l0_; o1_ = o1_ + l1_; }
          const bool first = (t & 15) == 0;
#pragma unroll
          for (int q = 0; q < 4; ++q) { cw[q] = c0_[q] + o0_[q]; cw[4 + q] = c1_[q] + o1_[q];
              cwp[q] = t > 0 ? p0_[q] + o0_[q] - (first ? l0_[q] : 0.f) : 0.f; cwp[4 + q] = t > 0 ? p1_[q] + o1_[q] - (first ? l1_[q] : 0.f) : 0.f; ag[q] = g0_[q]; ag[4 + q] = g1_[q]; } }
        float kk[8], ss = 0.f; rkb = 0.f;
#pragma unroll
        for (int q = 0; q < 8; ++q) { kk[q] = k[q] * pkk[q]; ss += kk[q] * kk[q]; }
        ss += shx(ss, 1, lane); ss += shx(ss, 2, lane); ss += shx(ss, 4, lane);
        const float inv = 1.0f / fmaxf(sqrtf(ss), 1e-12f);
        float at[8], bt[8], kt[8], rt_[8];
#pragma unroll
        for (int q = 0; q < 8; ++q) { const float kn = kk[q] * inv, kp = k[q] * (1.0f + (ag[q] - 1.0f) * pka[q]);
            const float ein = __expf(-cw[q]);
            at[q] = -kn * __expf(cwp[q]); bt[q] = kn * ag[q] * ein; kt[q] = kp * ein;
            rt_[q] = r[q] * __expf(cw[q]); rkb += r[q] * kp * prk[q]; }
        rkb += shx(rkb, 1, lane); rkb += shx(rkb, 2, lane); rkb += shx(rkb, 4, lane);
        *(LAS v4u*)(TILE(0) + t * TPB + cq * 16) = pack8f(at); *(LAS v4u*)(TILE(1) + t * TPB + cq * 16) = pack8f(bt); *(LAS v4u*)(TILE(2) + t * TPB + cq * 16) = pack8f(kt);
        *(LAS v4u*)(TILE(3) + t * TPB + cq * 16) = f.v;
        *(LAS v4u*)(TILE(6) + t * TPB + cq * 16) = pack8f(rt_);
        if (MODE == 1 && t == 63) {
#pragma unroll
            for (int q = 0; q < 8; ++q) ((LAS float*)(lds + CS_WL))[cq * 8 + q] = __expf(cw[q]); }
    }
    lds_barrier();
}

__device__ __forceinline__ void scan_s1(unsigned char* ws, LAS unsigned char* lds, int lane0, int wave) {
    const int rt = wave & 3, ch = wave >> 2;
    FrontIn fin; float w0v[2], a0v[2]; bf16x8s w2f[2][2], a2f[2][2];
    { int l0 = lane0; asm volatile("" : "+v"(l0)); const int hh = blockIdx.x & 15;
      if ((int)blockIdx.x < BATCH * NH * (SEQ / 64)) front_fetch(fin, ws, blockIdx.x, wave * 64 + l0, l0, wave);
      const bf16* W2T = (const bf16*)(ws + WS_WT_W2); const bf16* A2T = (const bf16*)(ws + WS_WT_A2);
#pragma unroll
      for (int ct = 0; ct < 2; ++ct) { w0v[ct] = INP(7)[hh * HD + 32 * ch + 16 * ct + (l0 & 15)]; a0v[ct] = INP(10)[hh * HD + 32 * ch + 16 * ct + (l0 & 15)];
#pragma unroll
          for (int ks = 0; ks < 2; ++ks) { const size_t wr_ = (size_t)(hh * HD + 32 * ch + 16 * ct + (l0 & 15)) * 64 + 32 * ks + 8 * (l0 >> 4); w2f[ks][ct] = *(const GAS bf16x8s*)(W2T + wr_); a2f[ks][ct] = *(const GAS bf16x8s*)(A2T + wr_); } }
      const int tid0 = wave * 64 + l0;
      if (tid0 < 64) { LAS float* P = (LAS float*)(lds + CS_PAR); P[tid0] = INP(15)[hh * HD + tid0]; P[64 + tid0] = INP(16)[hh * HD + tid0]; P[128 + tid0] = INP(17)[hh * HD + tid0]; }
      __syncthreads(); }
    for (int unit = blockIdx.x; unit < BATCH * NH * (SEQ / 64); unit += gridDim.x) {
        int lane = lane0; asm volatile("" : "+v"(lane));
        const int tid = wave * 64 + lane, fr = lane & 15, g = lane >> 4;
        const int h = unit & 15, c = (unit >> 4) & 127, b = unit >> 11; const size_t chunk = ((size_t)b * NH + h) * 128 + c;
        float v8[8]; float rkb;
        chunk_front<1>(fin, lds, w0v, a0v, w2f, a2f, tid, lane, wave, v8, rkb);
        { const size_t row0_ = (size_t)b * SEQ + c * 64; if ((tid & 7) == 0) ((float*)(ws + WS_HID))[(row0_ + (tid >> 3)) * NH + h] = rkb; }
        if (unit + (int)gridDim.x < BATCH * NH * (SEQ / 64)) front_fetch(fin, ws, unit + gridDim.x, tid, lane, wave);
        {
            f32x4 a2[2] = {F4Z, F4Z}, a3[2] = {F4Z, F4Z};
            mm64(a2, TILE(1), TILE(0), rt, ch, fr, g);
            mm64(a3, TILE(2), TILE(0), rt, ch, fr, g);
            f32x4 p1[2];
#pragma unroll
            for (int ct = 0; ct < 2; ++ct) { const int col = 32 * ch + 16 * ct + fr;
#pragma unroll
                for (int q = 0; q < 4; ++q) { const int row = 16 * rt + 4 * g + q;
                    a2[ct][q] = row < col ? a2[ct][q] : 0.f;
                    p1[ct][q] = a2[ct][q] + (row == col ? 1.0f : 0.f);
                    a3[ct][q] = row < col ? a3[ct][q] : 0.f; } }
            st_tr(TILE(5), a2, rt, ch, fr, g);
            st_tr(TILE(9), p1, rt, ch, fr, g);
            st_tr(TILE(4), a3, rt, ch, fr, g);
        }
        lds_barrier();
#pragma unroll
        for (int r = 0; r < 6; ++r) {
            LAS unsigned char* Sr = TILE(5 + 2 * (r & 1)); LAS unsigned char* Sr2 = TILE(5 + 2 * ((r & 1) ^ 1));
            if (r <= 4) { f32x4 q2[2] = {F4Z, F4Z};
                mm64_at(q2, Sr, Sr, rt, ch, fr, g, lane);
                st_tr(Sr2, q2, rt, ch, fr, g); }
            if (r >= 1) { LAS unsigned char* Pr = TILE(9 + ((r - 1) & 1)); LAS unsigned char* Pr2 = TILE(9 + (((r - 1) & 1) ^ 1));
                f32x4 pa[2]; ld_tr(pa, Pr, rt, ch, fr, g);
                mm64_at(pa, Sr, Pr, rt, ch, fr, g, lane);
                st_tr(Pr2, pa, rt, ch, fr, g); }
            if (r == 0) { f32x4 gg[2] = {F4Z, F4Z};
                mm64_bt(gg, TILE(4), TILE(3), rt, ch, fr, g, lane);
                st_tr(TILE(11), gg, rt, ch, fr, g); }
            lds_barrier();
        }
        {
            f32x4 acc[2] = {F4Z, F4Z}, ac2[2] = {F4Z, F4Z};
            mm64_bt(acc, TILE(10), TILE(0), rt, ch, fr, g, lane);
            mm64(ac2, TILE(10), TILE(11), rt, ch, fr, g);
            st_tr(TILE(5), acc, rt, ch, fr, g); st_tr(TILE(7), ac2, rt, ch, fr, g);
            f32x4 b2[2] = {F4Z, F4Z}, b3[2] = {F4Z, F4Z};
            mm64(b2, TILE(1), TILE(6), rt, ch, fr, g); mm64(b3, TILE(2), TILE(6), rt, ch, fr, g);
#pragma unroll
            for (int ct = 0; ct < 2; ++ct) { const int t = 32 * ch + 16 * ct + fr;
#pragma unroll
                for (int q = 0; q < 4; ++q) { const int s_ = 16 * rt + 4 * g + q; b2[ct][q] = s_ <= t ? b2[ct][q] : 0.f; b3[ct][q] = s_ <= t ? b3[ct][q] : 0.f; } }
            st_tr(TILE(4), b2, rt, ch, fr, g); st_tr(TILE(9), b3, rt, ch, fr, g);
        }
        lds_barrier();
        {
            const LAS float* WL = (const LAS float*)(lds + CS_WL);
            f32x4 acc[2] = {F4Z, F4Z};
            mm64_bt(acc, TILE(5), TILE(1), rt, ch, fr, g, lane);
            bf16* Mg = (bf16*)(ws + WS_B0) + chunk * 4096;
#pragma unroll
            for (int ct = 0; ct < 2; ++ct) { const int j1 = 32 * ch + 16 * ct + fr; const float wl = WL[j1];
#pragma unroll
                for (int q = 0; q < 4; ++q) { const int j2 = 16 * rt + 4 * g + q; acc[ct][q] = wl * (acc[ct][q] + (j2 == j1 ? 1.0f : 0.f)); }
                const int rtS = 2 * ch + ct, ksS = rt >> 1, half = rt & 1;
                *(GAS bf16x4s*)(Mg + (((rtS * 2 + ksS) * 64 + g * 16 + fr) * 8 + half * 4)) = pack4(acc[ct]); }
            f32x4 ad[2] = {F4Z, F4Z};
            mm64_at(ad, TILE(1), TILE(7), rt, ch, fr, g, lane);
            mm64_att(ad, TILE(2), TILE(3), rt, ch, lane);
            const f32x4 wl4 = *(const LAS f32x4*)(WL + 16 * rt + 4 * g);
            bf16* Dg = (bf16*)OUTP() + chunk * 4096;
#pragma unroll
            for (int ct = 0; ct < 2; ++ct) *(GAS bf16x4s*)(Dg + (((2 * ch + ct) * 4 + rt) * 64 + lane) * 4) = pack4(ad[ct] * wl4);
            const size_t row0_ = (size_t)b * SEQ + c * 64;
            f32x4 ar[2]; ld_tr(ar, TILE(6), rt, ch, fr, g);
            mm64(ar, TILE(5), TILE(4), rt, ch, fr, g);
            f32x4 ay[2] = {F4Z, F4Z};
            mm64(ay, TILE(7), TILE(4), rt, ch, fr, g); mm64_at(ay, TILE(3), TILE(9), rt, ch, fr, g, lane);
            bf16* Rg = (bf16*)(ws + WS_B1); bf16* Kg = (bf16*)(ws + WS_B2);
#pragma unroll
            for (int ct = 0; ct < 2; ++ct) { const size_t o_ = (row0_ + 32 * ch + 16 * ct + fr) * C + h * HD + 16 * rt + 4 * g; *(GAS bf16x4s*)(Rg + o_) = pack4(ar[ct]); *(GAS bf16x4s*)(Kg + o_) = pack4(ay[ct]); }
        }
        lds_barrier();
    }
}

constexpr int S2_PD = 6;
__device__ __forceinline__ void scan_s2(unsigned char* ws, LAS unsigned char* lds, int lane, int wave) {
    for (int bh = blockIdx.x; bh < BATCH * NH; bh += gridDim.x) {
        const unsigned char* Mg = (const unsigned char*)((const bf16*)(ws + WS_B0) + (size_t)bh * 128 * 4096); const unsigned char* Dg = (const unsigned char*)((const bf16*)OUTP() + (size_t)bh * 128 * 4096);
        bf16* Sg = (bf16*)OUTP() + (size_t)M * C + (size_t)bh * 128 * 4096;
        if (wave >= 4) {
            const int lw = wave - 4;
            const unsigned char* src = (lw < 2 ? Mg + lw * 4096 : Dg + (lw - 2) * 4096) + lane * 16;
            LAS unsigned char* dst = lds + lw * 4096 + lane * 16;
            v4u q[S2_PD][4];
#define S2_LOADQ(j, c) do { _Pragma("unroll") for (int i_ = 0; i_ < 4; ++i_) q[j][i_] = *(const GAS v4u*)(src + (size_t)(c) * 8192 + i_ * 1024); } while (0)
#define S2_STOREQ(j, slot) do { _Pragma("unroll") for (int i_ = 0; i_ < 4; ++i_) *(LAS v4u*)(dst + (slot) * 16384 + i_ * 1024) = q[j][i_]; } while (0)
#pragma unroll
            for (int j = 0; j < S2_PD; ++j) S2_LOADQ(j, j);
            S2_STOREQ(0, 0); S2_LOADQ(0, S2_PD);
            lds_barrier();
#pragma unroll 1
            for (int s0 = 0; s0 < 128; s0 += S2_PD) {
#pragma unroll
                for (int jj = 0; jj < S2_PD; ++jj) { const int step = s0 + jj;
                    if (step + 1 < 128) S2_STOREQ((jj + 1) % S2_PD, (step + 1) & 1);
                    if (step + 1 + S2_PD < 128) S2_LOADQ((jj + 1) % S2_PD, step + 1 + S2_PD);
                    lds_barrier(); }
            }
#undef S2_LOADQ
#undef S2_STOREQ
        } else {
            const int ct = wave;
            f32x4 acc[4];
#pragma unroll
            for (int r = 0; r < 4; ++r) acc[r] = F4Z;
            lds_barrier();
#pragma unroll 1
            for (int s0 = 0; s0 < 128; s0 += S2_PD) {
#pragma unroll
                for (int jj = 0; jj < S2_PD; ++jj) { const int step = s0 + jj;
                    if (step < 128) {
                        const LAS unsigned char* slot = lds + (step & 1) * 16384;
                        bf16x8s sf[2];
#pragma unroll
                        for (int ks = 0; ks < 2; ++ks) { const bf16x4s lo = pack4(acc[2 * ks]), hi = pack4(acc[2 * ks + 1]); sf[ks] = (bf16x8s){lo[0], lo[1], lo[2], lo[3], hi[0], hi[1], hi[2], hi[3]}; }
#pragma unroll
                        for (int ks = 0; ks < 2; ++ks) *(GAS bf16x8s*)(Sg + (size_t)step * 4096 + ((ct * 2 + ks) * 64 + lane) * 8) = sf[ks];
                        f32x4 na[4];
#pragma unroll
                        for (int r = 0; r < 4; ++r) na[r] = unpack4(*(const LAS bf16x4s*)(slot + 8192 + ((ct * 4 + r) * 64 + lane) * 8));
#pragma unroll
                        for (int ks = 0; ks < 2; ++ks)
#pragma unroll
                            for (int r = 0; r < 4; ++r) na[r] = MFMA16(*(const LAS bf16x8s*)(slot + ((r * 2 + ks) * 64 + lane) * 16), sf[ks], na[r]);
#pragma unroll
                        for (int r = 0; r < 4; ++r) acc[r] = na[r];
                    }
                    lds_barrier(); }
            }
        }
    }
}

constexpr int S3_RT = 32768, S3_YT = S3_RT + TILE_B, S3_LG = S3_YT + TILE_B, S3_LGP = 336;
struct S3In { v4u rr, yy, vv, lg[3]; bf16x8s sA[2]; float rkb; };
__device__ __forceinline__ void s3_fetch(S3In& f, unsigned char* ws, int unit, int tid, int lane, int wave) {
    const int h = unit & 15, c = (unit >> 4) & 127, b = unit >> 11; const size_t chunk = ((size_t)b * NH + h) * 128 + c, row0 = (size_t)b * SEQ + c * 64;
    const int rt = wave & 3, et = tid >> 3, ecq = tid & 7;
    const bf16* Rg = (const bf16*)(ws + WS_B1); const bf16* Kg = (const bf16*)(ws + WS_B2); const bf16* Vb = (const bf16*)(ws + WS_B3); const bf16* LG = (const bf16*)(ws + WS_LG);
    const bf16* Sg = (const bf16*)OUTP() + (size_t)M * C + chunk * 4096;
    const size_t o_ = (row0 + et) * C + h * HD + ecq * 8;
    f.rr = *(const GAS v4u*)(Rg + o_); f.yy = *(const GAS v4u*)(Kg + o_); f.vv = *(const GAS v4u*)(Vb + o_);
#pragma unroll
    for (int i = 0; i < 3; ++i) { const int chn = tid + 512 * i; if (chn < 64 * 20) f.lg[i] = *(const GAS v4u*)(LG + (row0 + chn / 20) * DG + (chn % 20) * 8); }
#pragma unroll
    for (int ks = 0; ks < 2; ++ks) f.sA[ks] = *(const GAS bf16x8s*)(Sg + ((rt * 2 + ks) * 64 + lane) * 8);
    f.rkb = ((const float*)(ws + WS_HID))[(row0 + et) * NH + h];
}
__device__ __forceinline__ void scan_s3(unsigned char* ws, LAS unsigned char* lds, int lane0, int wave) {
    const int rt = wave & 3, ch = wave >> 2;
    LAS float* Ys = (LAS float*)(lds + CS_FA);
    const bf16* G2T = (const bf16*)(ws + WS_WT_G2); bf16* YG = (bf16*)(ws + WS_B0);
    constexpr int NU = BATCH * NH * (SEQ / 64);
    S3In fin; bf16x8s gA[5]; f32x4 lnw0, lnw1, lnb0, lnb1;
    { int l0 = lane0; asm volatile("" : "+v"(l0)); const int hh = blockIdx.x & 15, t0_ = wave * 64 + l0;
      if ((int)blockIdx.x < NU) s3_fetch(fin, ws, blockIdx.x, t0_, l0, wave);
#pragma unroll
      for (int ks = 0; ks < 5; ++ks) gA[ks] = *(const GAS bf16x8s*)(G2T + (size_t)(hh * HD + 16 * rt + (l0 & 15)) * DG + 32 * ks + 8 * (l0 >> 4));
      const int ec0 = hh * HD + (t0_ & 7) * 8;
      lnw0 = *(const GAS f32x4*)(INP(18) + ec0); lnw1 = *(const GAS f32x4*)(INP(18) + ec0 + 4); lnb0 = *(const GAS f32x4*)(INP(19) + ec0); lnb1 = *(const GAS f32x4*)(INP(19) + ec0 + 4); }
    __syncthreads();
    for (int unit = blockIdx.x; unit < NU; unit += gridDim.x) {
        int lane = lane0; asm volatile("" : "+v"(lane));
        const int tid = wave * 64 + lane, fr = lane & 15, g = lane >> 4, et = tid >> 3, ecq = tid & 7;
        const int h = unit & 15, c = (unit >> 4) & 127, b = unit >> 11; const size_t row0 = (size_t)b * SEQ + c * 64;
        *(LAS v4u*)(lds + S3_RT + et * TPB + ecq * 16) = fin.rr; *(LAS v4u*)(lds + S3_YT + et * TPB + ecq * 16) = fin.yy;
#pragma unroll
        for (int i = 0; i < 3; ++i) { const int chn = tid + 512 * i; if (chn < 64 * 20) *(LAS v4u*)(lds + S3_LG + (chn / 20) * S3_LGP + (chn % 20) * 16) = fin.lg[i]; }
        float v8[8]; unpack8(fin.vv, v8); const float rkb = fin.rkb; const bf16x8s sA0 = fin.sA[0], sA1 = fin.sA[1];
        lds_barrier();
        if (unit + (int)gridDim.x < NU) s3_fetch(fin, ws, unit + gridDim.x, tid, lane, wave);
        f32x4 acc[2], ag[2] = {F4Z, F4Z};
#pragma unroll
        for (int ct = 0; ct < 2; ++ct) { const int t = 32 * ch + 16 * ct + fr;
            acc[ct] = unpack4(*(const LAS bf16x4s*)(lds + S3_YT + t * TPB + (16 * rt + 4 * g) * 2));
            acc[ct] = MFMA16(sA0, ldfrag_perm(lds + S3_RT, t, 0, g), acc[ct]); acc[ct] = MFMA16(sA1, ldfrag_perm(lds + S3_RT, t, 1, g), acc[ct]);
#pragma unroll
            for (int ks = 0; ks < 5; ++ks) ag[ct] = MFMA16(gA[ks], *(const LAS bf16x8s*)(lds + S3_LG + t * S3_LGP + (32 * ks + 8 * g) * 2), ag[ct]);
            *(LAS f32x4*)(Ys + t * FP + 16 * rt + 4 * g) = acc[ct]; }
        lds_barrier();
        {
            const f32x4 y0 = *(const LAS f32x4*)(Ys + et * FP + ecq * 8), y1 = *(const LAS f32x4*)(Ys + et * FP + ecq * 8 + 4);
            float y[8] = {y0[0], y0[1], y0[2], y0[3], y1[0], y1[1], y1[2], y1[3]};
            float s_ = 0.f;
#pragma unroll
            for (int q = 0; q < 8; ++q) s_ += y[q];
            s_ += shx(s_, 1, lane); s_ += shx(s_, 2, lane); s_ += shx(s_, 4, lane);
            const float mu = s_ * (1.0f / HD); float vs = 0.f;
#pragma unroll
            for (int q = 0; q < 8; ++q) { y[q] -= mu; vs += y[q] * y[q]; }
            vs += shx(vs, 1, lane); vs += shx(vs, 2, lane); vs += shx(vs, 4, lane);
            const float rstd = 1.0f / sqrtf(vs * (1.0f / HD) + GN_EPS);
            f32x4 o0, o1;
#pragma unroll
            for (int q = 0; q < 4; ++q) { o0[q] = y[q] * rstd * lnw0[q] + lnb0[q] + rkb * v8[q]; o1[q] = y[4 + q] * rstd * lnw1[q] + lnb1[q] + rkb * v8[4 + q]; }
            *(LAS f32x4*)(Ys + et * FP + ecq * 8) = o0; *(LAS f32x4*)(Ys + et * FP + ecq * 8 + 4) = o1;
        }
        lds_barrier();
#pragma unroll
        for (int ct = 0; ct < 2; ++ct) { const int t = 32 * ch + 16 * ct + fr; const f32x4 yv = *(const LAS f32x4*)(Ys + t * FP + 16 * rt + 4 * g);
            *(GAS bf16x4s*)(YG + (row0 + t) * C + h * HD + 16 * rt + 4 * g) = pack4(yv * ag[ct]); }
    }
    __syncthreads();
}
#undef TILE
#if MK_DEBUG
__device__ __forceinline__ void scan_naive(unsigned char* ws, LAS unsigned char* lds, int tid) {
    const int lane = tid & 63;
    const bf16* Rb = (const bf16*)(ws + WS_B1); const bf16* Kb = (const bf16*)(ws + WS_B2); const bf16* Vb = (const bf16*)(ws + WS_B3);
    const bf16* LW = (const bf16*)(ws + WS_LW); const bf16* LA = (const bf16*)(ws + WS_LA);
    float* Y = OUTP(); float* RK = (float*)(ws + WS_HID);
    LAS float* sR = (LAS float*)lds; LAS float* sK = sR + 4096; LAS float* sV = sK + 4096; LAS float* sA = sV + 4096; LAS float* sB = sA + 4096; LAS float* sD = sB + 4096;
    LAS float* sW2 = sD + 4096; LAS float* sA2 = sW2 + 4096;
    for (int unit = blockIdx.x; unit < BATCH * NH; unit += gridDim.x) {
        const int b = unit / NH, h = unit % NH;
        __syncthreads();
        for (int e = tid; e < 4096; e += 512) { const int d = e >> 6, j = e & 63; sW2[e] = INP(9)[(size_t)d * C + h * HD + j]; sA2[e] = INP(12)[(size_t)d * C + h * HD + j]; }
        __syncthreads();
        const int pt = tid >> 3, cq = tid & 7, c0 = h * HD + cq * 8;
        const int si = tid >> 3, jq = tid & 7;
        float S[8];
#pragma unroll
        for (int q = 0; q < 8; ++q) S[q] = 0.f;
        float w0v[8], a0v[8], kkv[8], kav[8], rkv[8];
#pragma unroll
        for (int q = 0; q < 8; ++q) { w0v[q] = INP(7)[c0 + q]; a0v[q] = INP(10)[c0 + q]; kkv[q] = INP(15)[c0 + q]; kav[q] = INP(16)[c0 + q]; rkv[q] = INP(17)[c0 + q]; }
        for (int blk = 0; blk < SEQ / 64; ++blk) {
            const size_t row = (size_t)b * SEQ + blk * 64 + pt;
            {
                const v4u r4 = *(const GAS v4u*)(Rb + row * C + c0), k4 = *(const GAS v4u*)(Kb + row * C + c0), v4 = *(const GAS v4u*)(Vb + row * C + c0);
                float r[8], k[8], v[8];
                r[0] = bflo(r4.x); r[1] = bfhi(r4.x); r[2] = bflo(r4.y); r[3] = bfhi(r4.y); r[4] = bflo(r4.z); r[5] = bfhi(r4.z); r[6] = bflo(r4.w); r[7] = bfhi(r4.w);
                k[0] = bflo(k4.x); k[1] = bfhi(k4.x); k[2] = bflo(k4.y); k[3] = bfhi(k4.y); k[4] = bflo(k4.z); k[5] = bfhi(k4.z); k[6] = bflo(k4.w); k[7] = bfhi(k4.w);
                v[0] = bflo(v4.x); v[1] = bfhi(v4.x); v[2] = bflo(v4.y); v[3] = bfhi(v4.y); v[4] = bflo(v4.z); v[5] = bfhi(v4.z); v[6] = bflo(v4.w); v[7] = bfhi(v4.w);
                float wp[8], ap[8];
#pragma unroll
                for (int q = 0; q < 8; ++q) { wp[q] = w0v[q]; ap[q] = a0v[q]; }
                for (int d = 0; d < 64; ++d) { const float lw = bf2f(LW[row * DW + d]), la = bf2f(LA[row * DA + d]);
#pragma unroll
                    for (int q = 0; q < 8; ++q) { wp[q] += lw * sW2[d * 64 + cq * 8 + q]; ap[q] += la * sA2[d * 64 + cq * 8 + q]; } }
                float kk[8], ss = 0.f, rks = 0.f;
#pragma unroll
                for (int q = 0; q < 8; ++q) { kk[q] = k[q] * kkv[q]; ss += kk[q] * kk[q]; }
                ss += shx(ss, 1, lane); ss += shx(ss, 2, lane); ss += shx(ss, 4, lane);
                const float inv = 1.0f / fmaxf(sqrtf(ss), 1e-12f);
#pragma unroll
                for (int q = 0; q < 8; ++q) { const float ag = sigmoidf_(ap[q]); const float kn = kk[q] * inv; const float kp = k[q] * (1.0f + (ag - 1.0f) * kav[q]);
                    const float lw = -0.6065306597126334f * sigmoidf_(wp[q]);
                    const int o = pt * 64 + cq * 8 + q;
                    sR[o] = r[q]; sK[o] = kp; sV[o] = v[q]; sA[o] = -kn; sB[o] = kn * ag; sD[o] = __expf(lw); rks += r[q] * kp * rkv[q]; }
                rks += shx(rks, 1, lane); rks += shx(rks, 2, lane); rks += shx(rks, 4, lane);
                if (cq == 0) RK[row * NH + h] = rks;
            }
            __syncthreads();
            for (int t = 0; t < 64; ++t) {
                const LAS f32x4* pa = (const LAS f32x4*)(sA + t * 64 + jq * 8); const LAS f32x4* pb = (const LAS f32x4*)(sB + t * 64 + jq * 8);
                const LAS f32x4* pd = (const LAS f32x4*)(sD + t * 64 + jq * 8); const LAS f32x4* pk = (const LAS f32x4*)(sK + t * 64 + jq * 8);
                const LAS f32x4* pr = (const LAS f32x4*)(sR + t * 64 + jq * 8);
                const f32x4 a0 = pa[0], a1 = pa[1], b0 = pb[0], b1 = pb[1], d0 = pd[0], d1 = pd[1], k0 = pk[0], k1 = pk[1], r0 = pr[0], r1 = pr[1];
                const float vi = sV[t * 64 + si];
                float sa = 0.f;
#pragma unroll
                for (int q = 0; q < 4; ++q) { sa += S[q] * a0[q]; sa += S[4 + q] * a1[q]; }
                sa += shx(sa, 1, lane); sa += shx(sa, 2, lane); sa += shx(sa, 4, lane);
                float y = 0.f;
#pragma unroll
                for (int q = 0; q < 4; ++q) { S[q] = S[q] * d0[q] + sa * b0[q] + vi * k0[q]; S[4 + q] = S[4 + q] * d1[q] + sa * b1[q] + vi * k1[q]; y += S[q] * r0[q]; y += S[4 + q] * r1[q]; }
                y += shx(y, 1, lane); y += shx(y, 2, lane); y += shx(y, 4, lane);
                if (jq == 0) Y[((size_t)b * SEQ + blk * 64 + t) * C + h * HD + si] = y;
            }
            __syncthreads();
        }
    }
}
__device__ __forceinline__ void post_scan(unsigned char* ws, int gw, int NGW, int lane) {
    const float* Y = OUTP(); const float* RK = (const float*)(ws + WS_HID); const bf16* Vb = (const bf16*)(ws + WS_B3); const bf16* LG = (const bf16*)(ws + WS_LG);
    bf16* YG = (bf16*)(ws + WS_B4); const float* g2 = INP(14); const float* lnw = INP(18); const float* lnb = INP(19);
    for (int it = gw; it < M * NH; it += NGW) {
        const int row = it / NH, h = it % NH, c = h * HD + lane;
        const float y = Y[(size_t)row * C + c];
        const float mu = wave_sum(y, lane) * (1.0f / HD); const float d = y - mu; const float var = wave_sum(d * d, lane) * (1.0f / HD);
        float o = d * (1.0f / sqrtf(var + GN_EPS)) * lnw[c] + lnb[c];
        o += RK[(size_t)row * NH + h] * bf2f(Vb[(size_t)row * C + c]);
        float g = 0.f;
        for (int dd = 0; dd < DG; ++dd) g += bf2f(LG[(size_t)row * DG + dd]) * g2[(size_t)dd * C + c];
        YG[(size_t)row * C + c] = (bf16)f2bf(o * g);
    }
}


constexpr int CW_DBG = 3200;
__device__ __forceinline__ void dbg_nonfinite(unsigned char* ws, const bf16* X, size_t n, int slot, int gw, int NGW, int lane, float thr = 1e30f) {
    unsigned* cw = (unsigned*)(ws + WS_CTL) + CW_DBG + 64 * slot; unsigned nnan = 0;
    for (size_t i = (size_t)gw * 64 + lane; i < n; i += (size_t)NGW * 64) { const float x = bf2f(X[i]); if (!(fabsf(x) < thr)) ++nnan; }
    if (nnan) atomicAdd(cw, nnan);
}
__device__ __forceinline__ void dbg_compare(unsigned char* ws, const bf16* X, const bf16* Y, int gw, int NGW, int lane) {
    unsigned* cw = (unsigned*)(ws + WS_CTL) + CW_DBG; unsigned nbad = 0, nnan = 0;
    for (size_t i = (size_t)gw * 64 + lane; i < (size_t)M * C; i += (size_t)NGW * 64) { const float x = bf2f(X[i]), y = bf2f(Y[i]);
        if (!(fabsf(x) < 1e30f)) ++nnan; else if (fabsf(x - y) > 0.05f * (fabsf(y) + 0.05f)) ++nbad; }
    if (nnan) atomicAdd(cw, nnan); if (nbad) atomicAdd(cw + 64, nbad);
}
#endif
__device__ __forceinline__ void router_rows(unsigned char* ws, LAS unsigned char* lds, int layer, int gw, int NGW, int lane, int tid, bool dry = false) {
    const bf16* Hh = (const bf16*)(ws + WS_B4); const float* gain = INP(2) + layer * C; bf16* XN = (bf16*)(ws + WS_B1);
    const float* wg = INP(24) + (size_t)layer * C * 4; const float* bg = INP(25) + layer * 4; const float* wi = INP(26) + (size_t)layer * C * 16; const float* bi = INP(27) + layer * 16;
    unsigned* cnt = (unsigned*)(ws + WS_CTL) + CW_CNT + layer * 16 * 64; unsigned* list = (unsigned*)(ws + WS_LIST); float* wl = (float*)(ws + WS_WL);
    LAS float* sWg = (LAS float*)lds; LAS float* sWi = sWg + C * 4;
    constexpr int RECMAX = 256;
    LAS unsigned* lcnt = (LAS unsigned*)(lds + 81920); LAS unsigned* gbase = lcnt + 16; LAS int* nrec = (LAS int*)(lcnt + 32);
    LAS unsigned* recRow = lcnt + 64; LAS unsigned* recE = recRow + RECMAX; LAS unsigned* recL = recE + RECMAX; LAS float* recW0 = (LAS float*)(recL + RECMAX); LAS float* recW1 = recW0 + RECMAX;
    __syncthreads();
    for (int e = tid; e < C * 4; e += 512) sWg[e] = wg[e];
    for (int e = tid; e < C * 16; e += 512) sWi[e] = wi[e];
    if (tid < 33) lcnt[tid == 32 ? 32 : tid] = 0u;
    __syncthreads();
    f32x4 g[4]; load_row(gain, lane, g);
    for (int row = gw; row < M; row += NGW) {
        f32x4 v[4]; load_row_bf(Hh + (size_t)row * C, lane, v); const float rs = row_rs(v, lane);
#pragma unroll
        for (int j = 0; j < 4; ++j) v[j] = v[j] * rs * g[j];
        store_row_bf16(XN + (size_t)row * C, lane, v);
        float gl[4] = {0.f, 0.f, 0.f, 0.f};
        const LAS unsigned char* pWg = (const LAS unsigned char*)sWg + lane * 64;
#pragma unroll
        for (int j = 0; j < 4; ++j)
#pragma unroll
            for (int q = 0; q < 4; ++q) { const f32x4 w = *(const LAS f32x4*)(pWg + j * 4096 + q * 16); const float xv = v[j][q]; gl[0] += xv * w.x; gl[1] += xv * w.y; gl[2] += xv * w.z; gl[3] += xv * w.w; }
#pragma unroll
        for (int q = 0; q < 4; ++q) gl[q] = wave_sum(gl[q], lane) + bg[q];
        int gi = 0; float gm = gl[0];
#pragma unroll
        for (int q = 1; q < 4; ++q) if (gl[q] > gm) { gm = gl[q]; gi = q; }
        float gden = 0.f;
#pragma unroll
        for (int q = 0; q < 4; ++q) gden += __expf(gl[q] - gm);
        const float gval = 1.0f / gden;
        float il[4] = {0.f, 0.f, 0.f, 0.f};
        const LAS unsigned char* pWi = (const LAS unsigned char*)sWi + lane * 256 + gi * 16;
#pragma unroll
        for (int j = 0; j < 4; ++j)
#pragma unroll
            for (int q = 0; q < 4; ++q) { const f32x4 w = *(const LAS f32x4*)(pWi + j * 16384 + q * 64); const float xv = v[j][q]; il[0] += xv * w.x; il[1] += xv * w.y; il[2] += xv * w.z; il[3] += xv * w.w; }
#pragma unroll
        for (int q = 0; q < 4; ++q) il[q] = wave_sum(il[q], lane) + bi[gi * 4 + q];
        int i0 = 0; float m0 = il[0];
#pragma unroll
        for (int q = 1; q < 4; ++q) if (il[q] > m0) { m0 = il[q]; i0 = q; }
        int i1 = -1; float m1 = -INFINITY;
#pragma unroll
        for (int q = 0; q < 4; ++q) if (q != i0 && il[q] > m1) { m1 = il[q]; i1 = q; }
        const float e1 = __expf(m1 - m0); const float w0 = gval / (1.0f + e1), w1 = gval * e1 / (1.0f + e1);
        if (lane == 0 && !dry) {
            const int ex0 = gi * 4 + i0, ex1 = gi * 4 + i1;
            const int ri = __hip_atomic_fetch_add(nrec, 1, __ATOMIC_RELAXED, __HIP_MEMORY_SCOPE_WORKGROUP);
            const unsigned l0 = __hip_atomic_fetch_add(lcnt + ex0, 1u, __ATOMIC_RELAXED, __HIP_MEMORY_SCOPE_WORKGROUP), l1 = __hip_atomic_fetch_add(lcnt + ex1, 1u, __ATOMIC_RELAXED, __HIP_MEMORY_SCOPE_WORKGROUP);
            if (ri < RECMAX) { recRow[ri] = (unsigned)row; recE[ri] = (unsigned)ex0 | ((unsigned)ex1 << 8); recL[ri] = l0 | (l1 << 16); recW0[ri] = w0; recW1[ri] = w1; }
        }
    }
    __syncthreads();
    if (tid < 16 && !dry) gbase[tid] = atomicAdd(cnt + tid * 64, lcnt[tid]);
    __syncthreads();
    { const int n = *nrec < RECMAX ? *nrec : RECMAX;
      for (int i = tid; i < n; i += 512) { const unsigned row = recRow[i], e = recE[i], l = recL[i]; const unsigned ex0 = e & 255u, ex1 = e >> 8;
          const unsigned p0 = gbase[ex0] + (l & 0xffffu), p1 = gbase[ex1] + (l >> 16);
          list[(size_t)ex0 * M + p0] = row * 2u; wl[(size_t)ex0 * M + p0] = recW0[i]; list[(size_t)ex1 * M + p1] = row * 2u + 1u; wl[(size_t)ex1 * M + p1] = recW1[i]; } }
}
__device__ __forceinline__ void moe_table(unsigned char* ws, volatile LAS int* tab, int layer, int tid) {
    __syncthreads();
    if (tid == 0) { const unsigned* cnt = (const unsigned*)(ws + WS_CTL) + CW_CNT + layer * 16 * 64; int t = 0;
#pragma unroll 1
        for (int e = 0; e < 16; ++e) { const int c = (int)__hip_atomic_load(cnt, RLX_AGENT); cnt += 64; tab[e] = c; tab[16 + e] = t; t += (c + 255) >> 8; tab[32 + e] = t; }
        tab[48] = t; }
    __syncthreads();
}
__device__ __forceinline__ void combine_rows(unsigned char* ws, int mode, int gw, int NGW, int lane, bool dry = false) {
    bf16* Hh = (bf16*)(ws + WS_B4); float* Out = OUTP(); const bf16* E0 = (const bf16*)(ws + WS_B2); const bf16* E1 = (const bf16*)(ws + WS_B3); bf16* XN2 = (bf16*)(ws + WS_B0);
    f32x4 g[4]; load_row(INP(4), lane, g);
    for (int row = gw; row < M; row += NGW) {
        f32x4 v[4]; load_row_bf(Hh + (size_t)row * C, lane, v);
#pragma unroll
        for (int j = 0; j < 4; ++j) { const v2u e0 = ((const GAS v2u*)(E0 + (size_t)row * C))[64 * j + lane], e1 = ((const GAS v2u*)(E1 + (size_t)row * C))[64 * j + lane];
            v[j].x += bflo(e0.x) + bflo(e1.x); v[j].y += bfhi(e0.x) + bfhi(e1.x); v[j].z += bflo(e0.y) + bflo(e1.y); v[j].w += bfhi(e0.y) + bfhi(e1.y); }
        const float rs = row_rs(v, lane);
        if (mode == 0) {
            if (!dry) store_row_bf16(Hh + (size_t)row * C, lane, v);
#pragma unroll
            for (int j = 0; j < 4; ++j) v[j] = v[j] * rs;
            store_row_bf16(XN2 + (size_t)row * C, lane, v);
        } else {
            float sig = 1.0f;
#if MK_DEBUG
            const unsigned* cw = (const unsigned*)(ws + WS_CTL) + CW_DBG; const unsigned nnan = __hip_atomic_load(cw, RLX_AGENT), nbad = __hip_atomic_load(cw + 64, RLX_AGENT);
            if (row < 512 && nnan > 0) sig = 2.0f;
            if (row >= 512 && row < 1536 && __hip_atomic_load(cw + 128, RLX_AGENT) > 0) sig = 2.0f;
            if (row >= 1536 && row < 3584 && __hip_atomic_load(cw + 192, RLX_AGENT) > 0) sig = 2.0f;
            if (row >= 3584 && row < 7680 && __hip_atomic_load(cw + 256, RLX_AGENT) > 0) sig = 2.0f;
            if (row >= 7680 && row < 15872 && __hip_atomic_load(cw + 320, RLX_AGENT) > 0) sig = 2.0f;
            if (row >= 15872 && nbad > (unsigned)(M / 100) * C) sig = 1.5f;
#endif
#pragma unroll
            for (int j = 0; j < 4; ++j) ((GAS f32x4*)(Out + (size_t)row * C))[64 * j + lane] = v[j] * rs * g[j] * sig;
        }
    }
}
__device__ __forceinline__ void attn_naive(unsigned char* ws, int gw, int NGW, int lane) {
    const bf16* Kb = (const bf16*)(ws + WS_B1); const bf16* Vb = (const bf16*)(ws + WS_B2); const bf16* Qb = (const bf16*)(ws + WS_B3); bf16* Ob = (bf16*)(ws + WS_B0);
    for (int unit = gw; unit < BATCH * NH * (SEQ / 64); unit += NGW) {
        const int qb = unit % (SEQ / 64), bh = unit / (SEQ / 64), b = bh / NH, h = bh % NH;
        const int t0 = qb * 64, t = t0 + lane; const size_t rowq = (size_t)b * SEQ + t;
        float q[64], o[64];
#pragma unroll
        for (int c = 0; c < 8; ++c) { const v4u w = *(const GAS v4u*)(Qb + rowq * C + h * HD + c * 8);
            q[c * 8 + 0] = bflo(w.x) * 0.125f; q[c * 8 + 1] = bfhi(w.x) * 0.125f; q[c * 8 + 2] = bflo(w.y) * 0.125f; q[c * 8 + 3] = bfhi(w.y) * 0.125f;
            q[c * 8 + 4] = bflo(w.z) * 0.125f; q[c * 8 + 5] = bfhi(w.z) * 0.125f; q[c * 8 + 6] = bflo(w.w) * 0.125f; q[c * 8 + 7] = bfhi(w.w) * 0.125f; }
#pragma unroll
        for (int c = 0; c < 64; ++c) o[c] = 0.f;
        float suffix = 0.f;
        for (int s = t0 + 62; s >= 0; --s) {
            const bool valid = s < t;
            if (s < t0 && __all(suffix > SB_EXIT)) break;
            const bf16* kp = Kb + ((size_t)b * SEQ + s) * C + h * HD; const bf16* vp = Vb + ((size_t)b * SEQ + s) * C + h * HD;
            float z = 0.f;
#pragma unroll
            for (int c = 0; c < 8; ++c) { const v4u w = *(const GAS v4u*)(kp + c * 8);
                z += q[c * 8 + 0] * bflo(w.x) + q[c * 8 + 1] * bfhi(w.x) + q[c * 8 + 2] * bflo(w.y) + q[c * 8 + 3] * bfhi(w.y) + q[c * 8 + 4] * bflo(w.z) + q[c * 8 + 5] * bfhi(w.z) + q[c * 8 + 6] * bflo(w.w) + q[c * 8 + 7] * bfhi(w.w); }
            const float sp = fmaxf(z, 0.f) + log1pf(__expf(-fabsf(z)));
            const float att = valid ? __expf(z - sp - suffix) : 0.f;
            suffix += valid ? sp : 0.f;
#pragma unroll
            for (int c = 0; c < 8; ++c) { const v4u w = *(const GAS v4u*)(vp + c * 8);
                o[c * 8 + 0] += att * bflo(w.x); o[c * 8 + 1] += att * bfhi(w.x); o[c * 8 + 2] += att * bflo(w.y); o[c * 8 + 3] += att * bfhi(w.y);
                o[c * 8 + 4] += att * bflo(w.z); o[c * 8 + 5] += att * bfhi(w.z); o[c * 8 + 6] += att * bflo(w.w); o[c * 8 + 7] += att * bfhi(w.w); }
        }
#pragma unroll
        for (int c = 0; c < 8; ++c) { v4u w; w.x = pk2(o[c * 8 + 0], o[c * 8 + 1]); w.y = pk2(o[c * 8 + 2], o[c * 8 + 3]); w.z = pk2(o[c * 8 + 4], o[c * 8 + 5]); w.w = pk2(o[c * 8 + 6], o[c * 8 + 7]);
            *(GAS v4u*)(Ob + rowq * C + h * HD + c * 8) = w; }
    }
}


typedef float f32x16 __attribute__((ext_vector_type(16)));
constexpr int AT_VP = 192;
constexpr int AT_WAVE_LDS = 32 * AT_VP;
__device__ __forceinline__ int crow32(int reg, int hh) { return (reg & 3) + 8 * (reg >> 2) + 4 * hh; }
__device__ __forceinline__ bf16x8s pack_step(const f32x16& x, const int s) {
    v4u p; p.x = pg8::cvt_pk_bf16(x[8 * s], x[8 * s + 1]); p.y = pg8::cvt_pk_bf16(x[8 * s + 2], x[8 * s + 3]); p.z = pg8::cvt_pk_bf16(x[8 * s + 4], x[8 * s + 5]); p.w = pg8::cvt_pk_bf16(x[8 * s + 6], x[8 * s + 7]);
    return __builtin_bit_cast(bf16x8s, p);
}
__device__ __forceinline__ void attn_mfma(unsigned char* ws, LAS unsigned char* lds, int gw, int NGW, int lane, int wave) {
    const bf16* Kb = (const bf16*)(ws + WS_B1); const bf16* Vb = (const bf16*)(ws + WS_B2); const bf16* Qb = (const bf16*)(ws + WS_B3); bf16* Ob = (bf16*)(ws + WS_B0);
    LAS unsigned char* vl = lds + wave * AT_WAVE_LDS;
    const int r32 = lane & 31, hh = lane >> 5;
    bf16x8s tri[2];
#pragma unroll
    for (int s = 0; s < 2; ++s)
#pragma unroll
        for (int j = 0; j < 8; ++j) tri[s][j] = (16 * s + 8 * (j >> 2) + 4 * hh + (j & 3)) > r32 ? (short)0x3F80 : (short)0;
    const int grp = lane >> 4, tq = (lane & 15) >> 2, tp = lane & 3;
    const LAS unsigned char* vtr0 = vl + (4 * hh + tq) * AT_VP + (16 * (grp & 1) + 4 * tp) * 2;
    for (int unit = gw; unit < BATCH * NH * (SEQ / 32); unit += NGW) {
        const int qb = unit % (SEQ / 32), bh = unit / (SEQ / 32), b = bh / NH, hd = bh % NH;
        const int t0 = qb * 32; const size_t rowb = (size_t)b * SEQ;
        bf16x8s qf[4];
#pragma unroll
        for (int ks = 0; ks < 4; ++ks) qf[ks] = *(const GAS bf16x8s*)(Qb + (rowb + t0 + r32) * C + hd * HD + 16 * ks + 8 * hh);
        f32x16 o[2];
#pragma unroll
        for (int i = 0; i < 16; ++i) { o[0][i] = 0.f; o[1][i] = 0.f; }
        float carry = 0.f;
        for (int s0 = t0; s0 >= 0; s0 -= 32) {
            bf16x8s kf[4];
#pragma unroll
            for (int ks = 0; ks < 4; ++ks) kf[ks] = *(const GAS bf16x8s*)(Kb + (rowb + s0 + r32) * C + hd * HD + 16 * ks + 8 * hh);
            v4u vreg[4];
#pragma unroll
            for (int i = 0; i < 4; ++i) { const int cidx = lane + 64 * i; vreg[i] = *(const GAS v4u*)(Vb + (rowb + s0 + (cidx >> 3)) * C + hd * HD + (cidx & 7) * 8); }
            f32x16 st;
#pragma unroll
            for (int i = 0; i < 16; ++i) st[i] = 0.f;
#pragma unroll
            for (int ks = 0; ks < 4; ++ks) st = __builtin_amdgcn_mfma_f32_32x32x16_bf16(kf[ks], qf[ks], st, 0, 0, 0);
#pragma unroll
            for (int i = 0; i < 4; ++i) { const int cidx = lane + 64 * i; *(LAS v4u*)(vl + (cidx >> 3) * AT_VP + (cidx & 7) * 16) = vreg[i]; }
            f32x16 zz, uu; float tot = 0.f; const int tq_ = t0 + r32;
            if (s0 + 31 < t0) {
#pragma unroll
                for (int i = 0; i < 16; ++i) { const float z = st[i] * 0.18033688011112042f; const float sp = fmaxf(z, 0.f) + __builtin_amdgcn_logf(1.0f + __builtin_amdgcn_exp2f(-fabsf(z)));
                    zz[i] = z - sp; uu[i] = sp; tot += sp; }
            } else {
#pragma unroll
                for (int i = 0; i < 16; ++i) { const int key = s0 + crow32(i, hh); const float z = st[i] * 0.18033688011112042f; const float sp = fmaxf(z, 0.f) + __builtin_amdgcn_logf(1.0f + __builtin_amdgcn_exp2f(-fabsf(z)));
                    const bool valid = key < tq_; zz[i] = valid ? z - sp : -1e30f; uu[i] = valid ? sp : 0.f; tot += uu[i]; }
            }
            f32x16 w;
#pragma unroll
            for (int i = 0; i < 16; ++i) w[i] = 0.f;
#pragma unroll
            for (int s = 0; s < 2; ++s) w = __builtin_amdgcn_mfma_f32_32x32x16_bf16(tri[s], pack_step(uu, s), w, 0, 0, 0);
            f32x16 pp;
#pragma unroll
            for (int i = 0; i < 16; ++i) pp[i] = __builtin_amdgcn_exp2f(zz[i] - w[i] - carry);
            tot += shx(tot, 32, lane); carry += tot;
            asm volatile("s_waitcnt lgkmcnt(0)" ::: "memory");
#pragma unroll
            for (int s = 0; s < 2; ++s) { const bf16x8s pa = pack_step(pp, s);
#pragma unroll
                for (int dt = 0; dt < 2; ++dt) {
                    const v4i16_t lo = __builtin_amdgcn_ds_read_tr16_b64_v4i16((LAS v4i16_t*)(vtr0 + (16 * s) * AT_VP + dt * 64));
                    const v4i16_t hi = __builtin_amdgcn_ds_read_tr16_b64_v4i16((LAS v4i16_t*)(vtr0 + (16 * s + 8) * AT_VP + dt * 64));
                    const bf16x8s vf = (bf16x8s){lo[0], lo[1], lo[2], lo[3], hi[0], hi[1], hi[2], hi[3]};
                    o[dt] = __builtin_amdgcn_mfma_f32_32x32x16_bf16(pa, vf, o[dt], 0, 0, 0); } }
            asm volatile("" ::: "memory");
            if (s0 < t0 && __all(carry > SB_EXIT * 1.4426950408889634f)) break;
        }
#pragma unroll
        for (int dt = 0; dt < 2; ++dt)
#pragma unroll
            for (int i = 0; i < 16; ++i) Ob[(rowb + t0 + crow32(i, hh)) * C + hd * HD + 32 * dt + r32] = (bf16)f2bf(o[dt][i]);
    }
}
__global__ void __launch_bounds__(NWAVES * 64, 2) yoco_fwd(Args args) {
    extern __shared__ __attribute__((aligned(16))) unsigned char lds_raw[];
    LAS unsigned char* lds = (LAS unsigned char*)lds_raw;
    const int G = gridDim.x; const int bx = blockIdx.x;
    int wave = __builtin_amdgcn_readfirstlane(threadIdx.x >> 6); asm volatile("" : "+s"(wave));
#define IDS() int lane; asm volatile("v_mbcnt_lo_u32_b32 %0, -1, 0\n\tv_mbcnt_hi_u32_b32 %0, -1, %0" : "=v"(lane)); const int tid = wave * 64 + lane; (void)tid; \
    const int vcu = (G % 8 == 0) ? (bx % 8) * (G / 8) + bx / 8 : bx; const int gw = vcu * NWAVES + wave, NGW = G * NWAVES; (void)lane; (void)gw; (void)NGW;
    unsigned char* ws = WSP();
    volatile LAS unsigned* MISC = (volatile LAS unsigned*)(lds + MISC_OFF);
    volatile LAS int* tab = (volatile LAS int*)(lds + MOE_TAB_OFF);
    for (int u = threadIdx.x; u < (LDS_BYTES - LDSCTL_OFF) / 4; u += NWAVES * 64) ((LAS unsigned*)(lds + LDSCTL_OFF))[u] = 0u;
    __syncthreads();
    XcdBarrier bar; bar.bar = (unsigned*)(ws + WS_CTL) + CW_BAR; bar.x = 0; bar.st = nullptr;
    if (N_LAUNCHES == 1) bar = xcd_barrier_post((unsigned*)(ws + WS_CTL) + CW_BAR, MISC + 8);
    const int lo = KA_INT(0), hi = KA_INT(1);
#ifndef PROBE_PH
#define PROBE_PH -1
#endif
#define IN(k) (lo <= (k) && (k) < hi)
#define REP(k) for (int rep_ = 0; rep_ < ((PROBE_PH == (k)) ? 2 : 1); ++rep_)
#define SEAM(k) do { if (IN(k) && IN((k) + 1)) xcd_barrier(bar); } while (0)

    if (IN(PH_P0)) REP(PH_P0) { IDS(); p0_weights<0>(ws, lds, gw, NGW, wave, lane); p0_weights<1>(ws, lds, gw, NGW, wave, lane); p0_rows(ws, gw, NGW, lane); }
    SEAM(PH_P0);
    if (PROBE_PH == 100 && N_LAUNCHES == 1) { for (int i_ = 0; i_ < 10; ++i_) xcd_barrier(bar); }
    if (IN(PH_LORA)) REP(PH_LORA) {
        SchedGrouped<1, 3> S{(const char*)(ws + WS_B1), (size_t)(WS_B2 - WS_B1), nullptr, (const char*)(ws + WS_WT_LORA), (size_t)256 * C * 2, G, bx};
        EpiLora E{(bf16*)(ws + WS_LW)};
        pg8::gemm_phase<EpiLora, SchedGrouped<1, 3>, true, false, C>(lds, S, E, wave);
    }
    SEAM(PH_LORA);
    if (IN(PH_RKV)) REP(PH_RKV) {
        SchedGrouped<4, 3> S{(const char*)OUTP(), (size_t)M * C * 2, (const char*)(ws + WS_B4), (const char*)(ws + WS_WT_RKV), (size_t)C * C * 2, G, bx};
        EpiSplit3 E{(bf16*)(ws + WS_B1), false};
        pg8::gemm_phase<EpiSplit3, SchedGrouped<4, 3>, true, false, C>(lds, S, E, wave);
    }
    SEAM(PH_RKV);
    if (IN(PH_S1)) REP(PH_S1) { IDS(); scan_s1(ws, lds, lane, wave); }
    SEAM(PH_S1);
    if (IN(PH_S2)) REP(PH_S2) { IDS();
        if (bx < BATCH * NH || G <= BATCH * NH) scan_s2(ws, lds, lane, wave);
        }
    SEAM(PH_S2);
    if (IN(PH_S3)) REP(PH_S3) { IDS(); scan_s3(ws, lds, lane, wave); }
    SEAM(PH_S3);
#if MK_DEBUG
    if (IN(PH_DBG0)) { IDS(); scan_naive(ws, lds, tid); }
    SEAM(PH_DBG0);
    if (IN(PH_DBG0 + 1)) { IDS(); post_scan(ws, gw, NGW, lane); }
    SEAM(PH_DBG0 + 1);
    if (IN(PH_DBG0 + 2)) { IDS(); dbg_compare(ws, (const bf16*)(ws + WS_B0), (const bf16*)(ws + WS_B4), gw, NGW, lane); }
    SEAM(PH_DBG0 + 2);
#endif
    if (IN(PH_WOUT)) REP(PH_WOUT) {
        SchedGrouped<4, 1> S{(const char*)(ws + ((MK_DEBUG && DBG_USE_NAIVE) ? WS_B4 : WS_B0)), 0, nullptr, (const char*)(ws + WS_WT_OUT), 0, G, bx};
        EpiResidBf<true> E{INP(0), (bf16*)(ws + WS_B4)};
        pg8::gemm_phase<EpiResidBf<true>, SchedGrouped<4, 1>, true, false, C>(lds, S, E, wave);
    }
    SEAM(PH_WOUT);
#pragma unroll 1
    for (int layer = 0; layer < 2; ++layer) {
        const int pb = layer == 0 ? (int)PH_ROUT0 : (int)PH_ROUT1;
        if (IN(pb)) { IDS(); if (PROBE_PH == 101 && layer == 0) router_rows(ws, lds, layer, gw, NGW, lane, tid, true); router_rows(ws, lds, layer, gw, NGW, lane, tid); }
        SEAM(pb);
        if (IN(pb + 1)) REP(pb + 1) {
            { IDS(); moe_table(ws, tab, layer, tid); }
            SchedMoe<2, C, true> S{(const char*)(ws + WS_B1), (const char*)(ws + WS_WT_GU) + (size_t)layer * 16 * 512 * C * 2, (size_t)512 * C * 2, (const unsigned*)(ws + WS_LIST), tab, G, bx};
            EpiGU E{(bf16*)(ws + WS_HID), (const float*)(ws + WS_WL)};
            pg8::gemm_phase<EpiGU, SchedMoe<2, C, true>, true, true, C>(lds, S, E, wave);
        }
        SEAM(pb + 1);
        if (IN(pb + 2)) REP(pb + 2) {
            { IDS(); moe_table(ws, tab, layer, tid); }
            SchedMoe<4, FE, false> S{(const char*)(ws + WS_HID), (const char*)(ws + WS_WT_DN) + (size_t)layer * 16 * C * FE * 2, (size_t)C * FE * 2, (const unsigned*)(ws + WS_LIST), tab, G, bx};
            EpiDown E{(bf16*)(ws + WS_B2), (const unsigned*)(ws + WS_LIST)};
            pg8::gemm_phase<EpiDown, SchedMoe<4, FE, false>, true, false, FE>(lds, S, E, wave);
        }
        SEAM(pb + 2);
        if (layer == 0) {
            if (IN(PH_COMB)) { IDS(); if (PROBE_PH == 102) combine_rows(ws, 0, gw, NGW, lane, true); combine_rows(ws, 0, gw, NGW, lane); }
            SEAM(PH_COMB);
            if (IN(PH_KVQ)) REP(PH_KVQ) {
                SchedGrouped<12, 1> S{(const char*)(ws + WS_B0), 0, nullptr, (const char*)(ws + WS_WT_KVQ), 0, G, bx};
                EpiSplit3 E{(bf16*)(ws + WS_B1), true};
                pg8::gemm_phase<EpiSplit3, SchedGrouped<12, 1>, true, false, C>(lds, S, E, wave);
            }
            SEAM(PH_KVQ);
            if (IN(PH_ATTN)) REP(PH_ATTN) { IDS(); attn_mfma(ws, lds, gw, NGW, lane, wave); }
            SEAM(PH_ATTN);
            if (IN(PH_SBO)) {
                SchedGrouped<4, 1> S{(const char*)(ws + WS_B0), 0, nullptr, (const char*)(ws + WS_WT_SBO), 0, G, bx};
                EpiResidBf<false> E{(const void*)(ws + WS_B4), (bf16*)(ws + WS_B4)};
                pg8::gemm_phase<EpiResidBf<false>, SchedGrouped<4, 1>, true, false, C>(lds, S, E, wave);
            }
            SEAM(PH_SBO);
        }
    }
    if (IN(PH_FINAL)) { IDS(); combine_rows(ws, 1, gw, NGW, lane); }
#undef IN
#undef SEAM
}

extern "C" void kernel_launch(void* const* d_in, const int* in_sizes, int n_in, void* d_out, int out_size, void* d_ws, size_t ws_size, hipStream_t stream) {
    static int grid = 0;
    if (grid == 0) {
        if (n_in != 31 || in_sizes[0] != M * C || out_size != M * C || ws_size < WS_END) { fprintf(stderr, "kernel_launch: unexpected shapes (n_in %d, in0 %d, out %d, ws %zu); nothing launched\n", n_in, n_in > 0 ? in_sizes[0] : -1, out_size, ws_size); grid = -1; return; }
        int dev = 0, cus = 0, per_cu = 0;
        if (hipGetDevice(&dev) != hipSuccess || hipDeviceGetAttribute(&cus, hipDeviceAttributeMultiprocessorCount, dev) != hipSuccess) { grid = -1; return; }
        if (hipFuncSetAttribute((const void*)yoco_fwd, hipFuncAttributeMaxDynamicSharedMemorySize, LDS_BYTES) != hipSuccess) { fprintf(stderr, "kernel_launch: hipFuncSetAttribute failed\n"); grid = -1; return; }
        if (hipOccupancyMaxActiveBlocksPerMultiprocessor(&per_cu, (const void*)yoco_fwd, NWAVES * 64, LDS_BYTES) != hipSuccess || per_cu < 1) fprintf(stderr, "kernel_launch: occupancy query reports %d\n", per_cu);
        (void)hipGetLastError();
        grid = cus - (cus % 16);
    }
    if (grid < 0) return;
    if (hipMemsetAsync((char*)d_ws + WS_CTL, 0, CTL_ZERO_BYTES, stream) != hipSuccess) return;
    Args a{};
    for (int i = 0; i < 31; ++i) a.in[i] = (const float*)d_in[i];
    a.out = (float*)d_out; a.ws = (unsigned char*)d_ws;
    for (int li = 0; li < (N_LAUNCHES == 1 ? 1 : (int)NPHASE); ++li) {
        a.ph_lo = (N_LAUNCHES == 1) ? 0 : li; a.ph_hi = (N_LAUNCHES == 1) ? NPHASE : li + 1; a.li = li;
        hipLaunchKernelGGL(yoco_fwd, dim3(grid), dim3(NWAVES * 64), LDS_BYTES, stream, a);
        const hipError_t le = hipPeekAtLastError();
        if (le != hipSuccess) { fprintf(stderr, "kernel_launch: launch %d failed: %s\n", li, hipGetErrorName(le)); break; }
    }
}
```

```cpp
#include <hip/hip_runtime.h>
#include <cstdio>
#include <cstdint>

#ifndef MK_N_LAUNCHES
#define MK_N_LAUNCHES 1
#endif

namespace pg8 {
#define PG8_LAS __attribute__((address_space(3)))
typedef unsigned short bf16_t;
typedef short bf16x8 __attribute__((ext_vector_type(8)));
typedef float f32x4 __attribute__((ext_vector_type(4)));
typedef unsigned u32x4 __attribute__((ext_vector_type(4)));
constexpr int BM = 256, BK = 64, HALF = 128, HTB = HALF * BK * 2, STAGE_BYTES = 8 * HTB, NXCD = 8, WGM = 8;

__host__ __device__ __forceinline__ int lds_byte(int r, int c) { const int st = (r >> 4) * 2 + (c >> 5), rr = r & 15, cc = c & 31, ob = rr * 64 + cc * 2; return st * 1024 + (ob ^ (((ob >> 9) & 1) << 5)); }
__host__ __device__ __forceinline__ void stage_rc(int b, int& R, int& C) { const int st = b / 1024, sb = b % 1024, swz = sb ^ (((sb >> 9) & 1) << 5); R = (st >> 1) * 16 + swz / 64; C = (st & 1) * 32 + (swz % 64) / 2; }
__host__ __device__ __forceinline__ int perm32(int rho) { const int n = rho >> 4, i = rho & 15; return 8 * (i >> 2) + 4 * n + (i & 3); }

struct Unit { int pm, pn, aux, r0, cnt; };

__host__ __device__ __forceinline__ void tile_map(int wgid, int nM, int nN, int& pm, int& pn) {
    const int nwg = nM * nN;
    { const int q = nwg / NXCD, r = nwg % NXCD, xcd = wgid % NXCD, off = wgid / NXCD; wgid = (xcd < r ? xcd * (q + 1) : r * (q + 1) + (xcd - r) * q) + off; }
    const int nig = WGM * nN, gid = wgid / nig, fm = gid * WGM, gsz = (nM - fm) < WGM ? (nM - fm) : WGM;
    pm = fm + ((wgid % nig) % gsz); pn = (wgid % nig) / gsz;
}

typedef float f32x2_t __attribute__((ext_vector_type(2))); typedef __bf16 bf16x2_t __attribute__((ext_vector_type(2)));
__device__ __forceinline__ unsigned cvt_pk_bf16(float lo, float hi) { const f32x2_t v = {lo, hi}; const bf16x2_t b = __builtin_convertvector(v, bf16x2_t); return __builtin_bit_cast(unsigned, b); }

template <class Epi, class Sched, bool ALIGN_EPI, bool GATHER, int K>
__device__ __forceinline__ void gemm_phase(PG8_LAS unsigned char* lds, const Sched& S, const Epi& E, const int wid) {
    int lane_; asm volatile("v_mbcnt_lo_u32_b32 %0, -1, 0\n\tv_mbcnt_hi_u32_b32 %0, -1, %0" : "=v"(lane_));
    const int lane = lane_, tid = wid * 64 + lane, wr = wid >> 2, wc = wid & 3, fr = lane & 15, fq = lane >> 4;
    constexpr int nt = K / BK;
    unsigned voffA[2], voffB[2];
#pragma unroll
    for (int i = 0; i < 2; ++i) { int R, C; stage_rc(tid * 16 + i * 8192, R, C); const int Rb = Epi::PERM ? ((R & ~31) + perm32(R & 31)) : R;
        voffA[i] = (unsigned)(R * K + C) * 2u; voffB[i] = (unsigned)(Rb * K + C) * 2u; }
    constexpr size_t kstep = (size_t)(BK * 2);
    constexpr size_t hstep = (size_t)HALF * K * 2;
    const unsigned ldsw = (unsigned)wid * 1024u;
    const int aoff = lds_byte(wr * 64 + fr, fq * 8), boff = lds_byte(wc * 32 + fr, fq * 8);
#define PG8_SA(b, h) (((b) * 2 + (h)) * HTB)
#define PG8_SB(b, h) ((4 + (b) * 2 + (h)) * HTB)
#define PG8_STAGE(bufoff, gbase, voff) do { _Pragma("unroll") for (int _i = 0; _i < 2; ++_i) \
        __builtin_amdgcn_global_load_lds((const unsigned*)((const char*)(gbase) + (voff)[_i]), (PG8_LAS unsigned*)(lds + (bufoff) + ldsw + _i * 8192), 16, 0, 0); } while (0)
#define PG8_LDA(dst, b, h) do { _Pragma("unroll") for (int m = 0; m < 4; ++m) _Pragma("unroll") for (int k = 0; k < 2; ++k) dst[m][k] = *(const PG8_LAS bf16x8*)(lds + PG8_SA(b, h) + aoff + m * 2048 + k * 1024); } while (0)
#define PG8_LDB(dst, b, h) do { _Pragma("unroll") for (int n = 0; n < 2; ++n) _Pragma("unroll") for (int k = 0; k < 2; ++k) dst[n][k] = *(const PG8_LAS bf16x8*)(lds + PG8_SB(b, h) + boff + n * 2048 + k * 1024); } while (0)
#define PG8_MMA(ai, bj, At, Bt) do { __builtin_amdgcn_s_setprio(1); _Pragma("unroll") for (int m = 0; m < 4; ++m) _Pragma("unroll") for (int n = 0; n < 2; ++n) _Pragma("unroll") for (int k = 0; k < 2; ++k) \
        acc[ai][bj][m][n] = __builtin_amdgcn_mfma_f32_16x16x32_bf16(Bt[n][k], At[m][k], acc[ai][bj][m][n], 0, 0, 0); __builtin_amdgcn_s_setprio(0); } while (0)
#define PG8_WAIT_V(n) asm volatile("s_waitcnt vmcnt(" #n ")" ::: "memory")
#define PG8_WAIT_L(n) asm volatile("s_waitcnt lgkmcnt(" #n ")" ::: "memory")
#define PG8_BAR __builtin_amdgcn_s_barrier()
#define PG8_SCHED __builtin_amdgcn_sched_barrier(0)
    Unit cur, nxt; int ui = 0;
    if (!S.next(0, cur)) return;
    f32x4 acc[2][2][4][2];
#pragma unroll
    for (int a = 0; a < 2; ++a)
#pragma unroll
        for (int b = 0; b < 2; ++b)
#pragma unroll
            for (int m = 0; m < 4; ++m)
#pragma unroll
                for (int n = 0; n < 2; ++n) acc[a][b][m][n] = (f32x4){0.f, 0.f, 0.f, 0.f};
    bf16x8 At[4][2], B0[2][2], B1[2][2];
    unsigned vc[2][2];
#define PG8_GOFF(u) do { _Pragma("unroll") for (int _h = 0; _h < 2; ++_h) _Pragma("unroll") for (int _i = 0; _i < 2; ++_i) { int _R, _C; stage_rc(tid * 16 + _i * 8192, _R, _C); \
        vc[_h][_i] = S.a_row_off(u, _h * HALF + _R) + (unsigned)_C * 2u; } } while (0)
#define PG8_STAGE_A(bufoff, gbase, h) do { if constexpr (GATHER) { PG8_STAGE(bufoff, gbase, vc[h]); } else { PG8_STAGE(bufoff, (gbase) + (h) * hstep, voffA); } } while (0)
    if constexpr (GATHER) PG8_GOFF(cur);
    const char* cA = S.a_base(cur); const char* cB = S.b_base(cur);
    PG8_STAGE(PG8_SB(0, 0), cB, voffB); PG8_STAGE(PG8_SB(0, 1), cB + hstep, voffB); PG8_STAGE_A(PG8_SA(0, 0), cA, 0); PG8_STAGE_A(PG8_SA(0, 1), cA, 1);
    if (wr == 1) PG8_BAR;
    PG8_WAIT_V(2); PG8_BAR;
    PG8_STAGE(PG8_SB(1, 0), cB + kstep, voffB); PG8_STAGE_A(PG8_SA(1, 0), cA + kstep, 0); PG8_STAGE(PG8_SB(1, 1), cB + hstep + kstep, voffB);
    PG8_WAIT_V(6); PG8_BAR;
    for (;;) {
        const bool has_next = S.next(ui + 1, nxt);
        const char* nA = has_next ? S.a_base(nxt) : cA; const char* nB = has_next ? S.b_base(nxt) : cB;
        for (int t = 0; t < nt; t += 2) {
            const bool last = (t == nt - 2);
            const char* a1 = cA + (size_t)(t + 1) * kstep;
            const char* a2 = last ? nA : cA + (size_t)(t + 2) * kstep; const char* b2 = last ? nB : cB + (size_t)(t + 2) * kstep;
            const char* a3 = a2 + kstep; const char* b3 = b2 + kstep;
            PG8_LDB(B0, 0, 0); PG8_LDB(B1, 0, 1); PG8_SCHED; PG8_LDA(At, 0, 0); PG8_STAGE_A(PG8_SA(1, 1), a1, 1);
            if constexpr (GATHER) { if (last && has_next) PG8_GOFF(nxt); }
            PG8_WAIT_V(8); PG8_WAIT_L(0); PG8_BAR; PG8_MMA(0, 0, At, B0); PG8_MMA(0, 1, At, B1); PG8_BAR; PG8_SCHED;
            PG8_LDA(At, 0, 1); PG8_STAGE(PG8_SB(0, 0), b2, voffB); PG8_STAGE(PG8_SB(0, 1), b2 + hstep, voffB); PG8_STAGE_A(PG8_SA(0, 0), a2, 0);
            PG8_WAIT_V(8); PG8_WAIT_L(0); PG8_BAR; PG8_MMA(1, 0, At, B0); PG8_MMA(1, 1, At, B1); PG8_BAR; PG8_SCHED;
            PG8_LDB(B0, 1, 0); PG8_LDB(B1, 1, 1); PG8_SCHED; PG8_LDA(At, 1, 0); PG8_STAGE_A(PG8_SA(0, 1), a2, 1);
            PG8_WAIT_V(8); PG8_WAIT_L(0); PG8_BAR; PG8_MMA(0, 0, At, B0); PG8_MMA(0, 1, At, B1); PG8_BAR; PG8_SCHED;
            PG8_LDA(At, 1, 1); PG8_STAGE(PG8_SB(1, 0), b3, voffB); PG8_STAGE(PG8_SB(1, 1), b3 + hstep, voffB); PG8_STAGE_A(PG8_SA(1, 0), a3, 0);
            PG8_WAIT_V(8); PG8_WAIT_L(0); PG8_BAR; PG8_MMA(1, 0, At, B0); PG8_MMA(1, 1, At, B1); PG8_BAR; PG8_SCHED;
        }
        if constexpr (ALIGN_EPI) { if (wr == 0) PG8_BAR; }
        E(acc, cur, wr, wc, fr, fq);
        if (!has_next) break;
#pragma unroll
        for (int a = 0; a < 2; ++a)
#pragma unroll
            for (int b = 0; b < 2; ++b)
#pragma unroll
                for (int m = 0; m < 4; ++m)
#pragma unroll
                    for (int n = 0; n < 2; ++n) acc[a][b][m][n] = (f32x4){0.f, 0.f, 0.f, 0.f};
        cur = nxt; cA = nA; cB = nB; ++ui;
        if constexpr (ALIGN_EPI) { if (wr == 1) PG8_BAR; }
    }
    PG8_WAIT_V(0);
    if constexpr (!ALIGN_EPI) { if (wr == 0) PG8_BAR; }
    PG8_BAR;
#undef PG8_SA
#undef PG8_SB
#undef PG8_STAGE
#undef PG8_STAGE_A
#undef PG8_GOFF
#undef PG8_LDA
#undef PG8_LDB
#undef PG8_MMA
#undef PG8_WAIT_V
#undef PG8_WAIT_L
#undef PG8_BAR
#undef PG8_SCHED
}
}

constexpr int NWAVES = 8;
#ifndef MK_DEBUG
#define MK_DEBUG 0
#endif
#ifndef DBG_USE_NAIVE
#define DBG_USE_NAIVE 0
#endif
constexpr int DBGP = MK_DEBUG ? 3 : 0;
enum Phase { PH_P0 = 0, PH_LORA, PH_RKV, PH_S1, PH_S2, PH_S3, PH_DBG0, PH_WOUT = PH_DBG0 + DBGP, PH_ROUT0, PH_GU0, PH_DN0, PH_COMB, PH_KVQ, PH_ATTN, PH_SBO, PH_ROUT1, PH_GU1, PH_DN1, PH_FINAL, NPHASE };
constexpr int N_LAUNCHES = MK_N_LAUNCHES;


constexpr int BATCH = 2, SEQ = 8192, C = 1024, NH = 16, HD = 64, M = BATCH * SEQ;
constexpr int NE = 16, FE = 256, DW = 64, DA = 64, DG = 160;
constexpr float RMS_EPS = 1e-6f, GN_EPS = 64e-5f;
constexpr float SB_EXIT = 104.0f;

constexpr size_t MiB = 1u << 20;
constexpr size_t WS_CTL = 0, CTL_ZERO_BYTES = 64 * 1024;
constexpr size_t WS_WT_W2 = 128 * 1024, WS_WT_A2 = 256 * 1024, WS_WT_G2 = 384 * 1024;
constexpr size_t WS_WT_RKV = 1 * MiB;
constexpr size_t WS_WT_LORA = 7 * MiB;
constexpr size_t WS_WT_OUT = 9 * MiB;
constexpr size_t WS_WT_KVQ = 11 * MiB;
constexpr size_t WS_WT_SBO = 17 * MiB;
constexpr size_t WS_WT_GU = 19 * MiB;
constexpr size_t WS_WT_DN = 51 * MiB;
constexpr size_t WS_LW = 67 * MiB;
constexpr size_t WS_LA = 69 * MiB;
constexpr size_t WS_LG = 71 * MiB;
static_assert(WS_LA == WS_LW + 2 * MiB && WS_LG == WS_LW + 4 * MiB, "EpiLora's pointer arithmetic");
constexpr size_t WS_LIST = 76 * MiB;
constexpr size_t WS_WL = 77 * MiB;
constexpr size_t WS_HID = 78 * MiB;
constexpr size_t WS_B0 = 96 * MiB, WS_B1 = 128 * MiB, WS_B2 = 160 * MiB, WS_B3 = 192 * MiB, WS_B4 = 224 * MiB, WS_END = 256 * MiB;
static_assert(WS_HID + (size_t)144 * 256 * 256 * 2 <= WS_B0, "HID vs B0");
constexpr int CW_TMO = 0;
constexpr int CW_CNT = 1024;
constexpr int CW_BAR = 4096;

constexpr int RING_BYTES = 131072;
constexpr int LDSCTL_OFF = 146688, MISC_OFF = LDSCTL_OFF + 320, MOE_TAB_OFF = MISC_OFF + 128;
constexpr int LDS_BYTES = 147456;
static_assert(MOE_TAB_OFF + 256 <= LDS_BYTES, "LDS map");
static_assert(BATCH * NH * (SEQ / 64) % 16 == 0, "scan units");

#define GAS __attribute__((address_space(1)))
#define LAS __attribute__((address_space(3)))
typedef unsigned short bf16;
typedef unsigned v4u __attribute__((ext_vector_type(4)));
typedef unsigned v2u __attribute__((ext_vector_type(2)));
typedef float f32x4 __attribute__((ext_vector_type(4)));
typedef GAS unsigned gu32;
#define RLX_AGENT __ATOMIC_RELAXED, __HIP_MEMORY_SCOPE_AGENT
#define LDS_WAIT() asm volatile("s_waitcnt lgkmcnt(0)" ::: "memory")
#define VM_WAIT() asm volatile("s_waitcnt vmcnt(0)" ::: "memory")
__device__ __forceinline__ unsigned f2bf(float f) { unsigned u = __builtin_bit_cast(unsigned, f); return (u + 0x7fffu + ((u >> 16) & 1u)) >> 16; }
__device__ __forceinline__ unsigned pk2(float lo, float hi) { return f2bf(lo) | (f2bf(hi) << 16); }
__device__ __forceinline__ float bflo(unsigned u) { return __uint_as_float(u << 16); }
__device__ __forceinline__ float bfhi(unsigned u) { return __uint_as_float(u & 0xffff0000u); }
__device__ __forceinline__ float bf2f(bf16 b) { return __uint_as_float((unsigned)b << 16); }
__device__ __forceinline__ float sigmoidf_(float x) { return 1.0f / (1.0f + __expf(-x)); }

#define XB_TMO      128
#define XB_XCNT(j)  (256  + 64 * (j))
#define XB_XSUB(j)  (1280 + 64 * (j))
#define XB_XGEN(j)  (2304 + 64 * (j))
#define XB_TOP      3328
#define XB_TOPGEN   3392
#define XCD_BAR_WORDS 3456
#define XB_SPIN_CAP (1u << 18)
__device__ __forceinline__ unsigned xb_ld(unsigned* p)              { return __hip_atomic_load(p, __ATOMIC_RELAXED, __HIP_MEMORY_SCOPE_AGENT); }
__device__ __forceinline__ unsigned xb_add(unsigned* p, unsigned v) { return __hip_atomic_fetch_add(p, v, __ATOMIC_RELAXED, __HIP_MEMORY_SCOPE_AGENT); }
__device__ __forceinline__ unsigned xb_xcc_id() { return (unsigned)__builtin_amdgcn_s_getreg((3 << 11) | 20) & 0xFu; }
#define XB_SPIN(cond, bar) do { unsigned _sp = 0; while (cond) { __builtin_amdgcn_s_sleep(1); \
    if ((++_sp & 255u) == 0u) { if (xb_ld(&(bar)[XB_TMO])) break; if (_sp > XB_SPIN_CAP) { atomicAdd(&(bar)[XB_TMO], 1u); break; } } } } while (0)
struct XcdBarrier { unsigned* bar; unsigned x; volatile LAS unsigned* st; };
__device__ __forceinline__ XcdBarrier xcd_barrier_post(unsigned* bar, volatile LAS unsigned* st) {
    XcdBarrier b; b.bar = bar; b.x = xb_xcc_id(); b.st = st;
    if (threadIdx.x == 0) (void)xb_add(&bar[XB_XCNT(b.x)], 1u);
    return b;
}
__device__ __forceinline__ void xcd_barrier_complete(unsigned* bar, unsigned x, unsigned& nloc, unsigned& nx) {
    const unsigned G = gridDim.x * gridDim.y * gridDim.z;
    unsigned sum, cnt, mine, sp = 0u;
    for (;;) {
        sum = 0u; cnt = 0u; mine = 0u;
#pragma unroll
        for (unsigned j = 0; j < 16; ++j) { const unsigned c = xb_ld(&bar[XB_XCNT(j)]); sum += c; cnt += (c > 0u) ? 1u : 0u; mine = (j == x) ? c : mine; }
        if (sum == G) break;
        __builtin_amdgcn_s_sleep(1);
        if ((++sp & 255u) == 0u) { if (xb_ld(&bar[XB_TMO])) break; if (sp > XB_SPIN_CAP) { atomicAdd(&bar[XB_TMO], 1u); break; } }
    }
    nloc = mine > 0u ? mine : 1u; nx = cnt > 0u ? cnt : 1u;
}
__device__ __forceinline__ void xcd_barrier(const XcdBarrier& b) {
    asm volatile("s_waitcnt vmcnt(0)" ::: "memory");
    __syncthreads();
    if (threadIdx.x == 0) {
        unsigned* bar = b.bar;
        __builtin_amdgcn_s_waitcnt(0);
        unsigned nloc = b.st[0], nx = b.st[1];
        if (nloc == 0u) { xcd_barrier_complete(bar, b.x, nloc, nx); b.st[0] = nloc; b.st[1] = nx; }
        const unsigned old = xb_add(&bar[XB_XSUB(b.x)], 1u);
        const unsigned gen = old / nloc;
        if (old + 1u == (gen + 1u) * nloc) {
            __builtin_amdgcn_fence(__ATOMIC_RELEASE, "agent");
            asm volatile("s_waitcnt vmcnt(0)" ::: "memory");
            const unsigned og = xb_add(&bar[XB_TOP], 1u);
            const unsigned tg = og / nx;
            if (og + 1u == (tg + 1u) * nx) xb_add(&bar[XB_TOPGEN], 1u);
            else XB_SPIN(xb_ld(&bar[XB_TOPGEN]) == tg, bar);
            __builtin_amdgcn_fence(__ATOMIC_ACQUIRE, "agent");
            xb_add(&bar[XB_XGEN(b.x)], 1u);
            asm volatile("s_waitcnt vmcnt(0)" ::: "memory");
        } else {
            XB_SPIN(xb_ld(&bar[XB_XGEN(b.x)]) == gen, bar);
            __builtin_amdgcn_fence(__ATOMIC_ACQUIRE, "agent");
            asm volatile("s_waitcnt vmcnt(0)" ::: "memory");
        }
    }
    __syncthreads();
}

__device__ __forceinline__ float shx(float v, int o, int lane) { return __int_as_float(__builtin_amdgcn_ds_bpermute((lane ^ o) << 2, __float_as_int(v))); }
__device__ __forceinline__ float wave_sum(float v, int lane) {
#pragma unroll
    for (int o = 1; o < 64; o <<= 1) v += shx(v, o, lane);
    return v;
}
__device__ __forceinline__ void transpose_item(const float* W, int ldw, int k0, int n0, bf16* WT, int ldk, int dst_row0, const float* kscale, LAS float* scr, int lane, int kmax = 1 << 30) {
    const int r8 = lane >> 3, quad = lane & 7;
    f32x4 v[8];
#pragma unroll
    for (int i = 0; i < 8; ++i) { const int kk = r8 + 8 * i; v[i] = (k0 + kk < kmax) ? *(const GAS f32x4*)(W + (size_t)(k0 + kk) * ldw + n0 + quad * 4) : (f32x4){0.f, 0.f, 0.f, 0.f}; }
#pragma unroll
    for (int i = 0; i < 8; ++i) { const int kk = r8 + 8 * i; if (kscale) v[i] = v[i] * kscale[(k0 + kk < kmax) ? k0 + kk : 0]; *(LAS f32x4*)(scr + kk * 36 + ((quad ^ i) << 2)) = v[i]; }
    LDS_WAIT(); asm volatile("" ::: "memory");
    const int c = lane & 7;
#pragma unroll
    for (int j = 0; j < 4; ++j) { const int n = (lane >> 3) + 8 * j; const LAS float* sp = scr + (8 * c) * 36 + ((((n >> 2) ^ c) << 2) | (n & 3));
        v4u o; o.x = pk2(sp[0 * 36], sp[1 * 36]); o.y = pk2(sp[2 * 36], sp[3 * 36]); o.z = pk2(sp[4 * 36], sp[5 * 36]); o.w = pk2(sp[6 * 36], sp[7 * 36]);
        if (k0 + 8 * c < kmax) *(GAS v4u*)(WT + (size_t)(dst_row0 + n) * ldk + k0 + 8 * c) = o; }
    LDS_WAIT(); asm volatile("" ::: "memory");
}

struct Args { const float* in[31]; float* out; unsigned char* ws; int ph_lo, ph_hi, li, pad; };
typedef const __attribute__((address_space(4))) unsigned char* kaptr_t;
__device__ __forceinline__ kaptr_t ka_base() { kaptr_t p = (kaptr_t)__builtin_amdgcn_kernarg_segment_ptr(); asm volatile("" : "+s"(p)); return p; }
#define INP(k) (*(const float* const __attribute__((address_space(4)))*)(ka_base() + 8 * (k)))
#define OUTP() (*(float* const __attribute__((address_space(4)))*)(ka_base() + 8 * 31))
#define WSP() (*(unsigned char* const __attribute__((address_space(4)))*)(ka_base() + 8 * 32))
#define KA_INT(i) (*(const int __attribute__((address_space(4)))*)(ka_base() + 8 * 33 + 4 * (i)))

template <int PART> __device__ __forceinline__ void p0_weights(unsigned char* ws, LAS unsigned char* lds, int gw, int NGW, int wave, int lane) {
    LAS float* scr = (LAS float*)(lds + wave * 16384);
    bf16* WT_RKV = (bf16*)(ws + WS_WT_RKV); bf16* WT_LORA = (bf16*)(ws + WS_WT_LORA); bf16* WT_OUT = (bf16*)(ws + WS_WT_OUT); bf16* WT_KVQ = (bf16*)(ws + WS_WT_KVQ);
    bf16* WT_SBO = (bf16*)(ws + WS_WT_SBO); bf16* WT_GU = (bf16*)(ws + WS_WT_GU); bf16* WT_DN = (bf16*)(ws + WS_WT_DN);
    constexpr int I_UP = 32 + 32 + 96, I_RKV = 3 * 512, I_LORA = 32 + 32 + 80, I_OUT = 512, I_KV = 1024, I_Q = 512, I_SBO = 512, I_G = 32 * 128, I_U = 32 * 128, I_D = 32 * 128;
    constexpr int NDENSE = I_UP + I_RKV + I_LORA + I_OUT + I_KV + I_Q + I_SBO, NITEMS = NDENSE + I_G + I_U + I_D;
    for (int it = (PART == 0 ? 0 : NDENSE) + gw; it < (PART == 0 ? NDENSE : NITEMS); it += NGW) {
        int r = it;
        if (r < I_UP) {
            if (r < 32) transpose_item(INP(9), C, 0, 32 * r, (bf16*)(ws + WS_WT_W2), 64, 32 * r, nullptr, scr, lane);
            else if (r < 64) transpose_item(INP(12), C, 0, 32 * (r - 32), (bf16*)(ws + WS_WT_A2), 64, 32 * (r - 32), nullptr, scr, lane);
            else { const int q = r - 64, kb = q / 32, nb = q % 32; transpose_item(INP(14), C, 64 * kb, 32 * nb, (bf16*)(ws + WS_WT_G2), DG, 32 * nb, nullptr, scr, lane, DG); }
            continue; } r -= I_UP;
        if (r < I_RKV) { const int m = r / 512, q = r % 512, kb = q / 32, nb = q % 32; transpose_item(INP(6) + (size_t)m * C * C, C, 64 * kb, 32 * nb, WT_RKV, C, m * C + 32 * nb, nullptr, scr, lane); continue; } r -= I_RKV;
        if (r < I_LORA) {
            if (r < 32) { const int kb = r / 2, nb = r % 2; transpose_item(INP(8), DW, 64 * kb, 32 * nb, WT_LORA, C, 32 * nb, nullptr, scr, lane); }
            else if (r < 64) { const int q = r - 32, kb = q / 2, nb = q % 2; transpose_item(INP(11), DA, 64 * kb, 32 * nb, WT_LORA, C, 256 + 32 * nb, nullptr, scr, lane); }
            else { const int q = r - 64, kb = q / 5, nb = q % 5; transpose_item(INP(13), DG, 64 * kb, 32 * nb, WT_LORA, C, 512 + 32 * nb, nullptr, scr, lane); }
            continue; } r -= I_LORA;
        if (r < I_OUT) { const int kb = r / 32, nb = r % 32; transpose_item(INP(20), C, 64 * kb, 32 * nb, WT_OUT, C, 32 * nb, nullptr, scr, lane); continue; } r -= I_OUT;
        if (r < I_KV) { const int kb = r / 64, nb = r % 64; transpose_item(INP(21), 2 * C, 64 * kb, 32 * nb, WT_KVQ, C, 32 * nb, INP(3), scr, lane); continue; } r -= I_KV;
        if (r < I_Q) { const int kb = r / 32, nb = r % 32; transpose_item(INP(22), C, 64 * kb, 32 * nb, WT_KVQ, C, 2 * C + 32 * nb, INP(1) + C, scr, lane); continue; } r -= I_Q;
        if (r < I_SBO) { const int kb = r / 32, nb = r % 32; transpose_item(INP(23), C, 64 * kb, 32 * nb, WT_SBO, C, 32 * nb, nullptr, scr, lane); continue; } r -= I_SBO;
        if (r < I_G) { const int le = r / 128, q = r % 128, kb = q / 8, nb = q % 8, f0 = 32 * nb; transpose_item(INP(28) + (size_t)le * C * FE, FE, 64 * kb, f0, WT_GU + (size_t)le * 512 * C, C, 256 * (f0 / 128) + (f0 % 128), INP(2) + (le >> 4) * C, scr, lane); continue; } r -= I_G;
        if (r < I_U) { const int le = r / 128, q = r % 128, kb = q / 8, nb = q % 8, f0 = 32 * nb; transpose_item(INP(29) + (size_t)le * C * FE, FE, 64 * kb, f0, WT_GU + (size_t)le * 512 * C, C, 256 * (f0 / 128) + 128 + (f0 % 128), INP(2) + (le >> 4) * C, scr, lane); continue; } r -= I_U;
        { const int le = r / 128, q = r % 128, kb = q / 32, nb = q % 32; transpose_item(INP(30) + (size_t)le * FE * C, C, 64 * kb, 32 * nb, WT_DN + (size_t)le * C * FE, FE, 32 * nb, nullptr, scr, lane); }
    }
    if (PART == 0) for (int it = gw * 64 + lane; it < 768 * 128; it += NGW * 64) { const int row = it >> 7, ch = it & 127;
        const bool valid = (row < 64) || (row >= 256 && row < 320) || (row >= 512 && row < 672);
        if (!valid) *(GAS v4u*)(WT_LORA + (size_t)row * C + ch * 8) = (v4u){0u, 0u, 0u, 0u}; }
}
__device__ __forceinline__ void load_row(const float* p, int lane, f32x4 (&v)[4]) {
#pragma unroll
    for (int j = 0; j < 4; ++j) v[j] = ((const GAS f32x4*)p)[64 * j + lane];
}
__device__ __forceinline__ void load_row_bf(const bf16* p, int lane, f32x4 (&v)[4]) {
#pragma unroll
    for (int j = 0; j < 4; ++j) { const v2u w = ((const GAS v2u*)p)[64 * j + lane]; v[j] = (f32x4){bflo(w.x), bfhi(w.x), bflo(w.y), bfhi(w.y)}; }
}
__device__ __forceinline__ float row_rs(const f32x4 (&v)[4], int lane) {
    float s = 0.f;
#pragma unroll
    for (int j = 0; j < 4; ++j) s += (v[j].x * v[j].x + v[j].y * v[j].y) + (v[j].z * v[j].z + v[j].w * v[j].w);
    return 1.0f / sqrtf(wave_sum(s, lane) * (1.0f / C) + RMS_EPS);
}
__device__ __forceinline__ void store_row_bf16(bf16* p, int lane, const f32x4 (&v)[4]) {
#pragma unroll
    for (int j = 0; j < 4; ++j) { v2u o; o.x = pk2(v[j].x, v[j].y); o.y = pk2(v[j].z, v[j].w); ((GAS v2u*)p)[64 * j + lane] = o; }
}
__device__ __forceinline__ void p0_rows(unsigned char* ws, int gw, int NGW, int lane) {
    const float* x = INP(0); const float* gain = INP(1); const float* mix = INP(5);
    f32x4 g[4]; load_row(gain, lane, g);
    for (int run = gw; run < M / 8; run += NGW) {
        const int r0 = run * 8;
        f32x4 prev[4];
        if ((r0 % SEQ) == 0) {
#pragma unroll
            for (int j = 0; j < 4; ++j) prev[j] = (f32x4){0.f, 0.f, 0.f, 0.f};
        } else { load_row(x + (size_t)(r0 - 1) * C, lane, prev); const float rs = row_rs(prev, lane);
#pragma unroll
            for (int j = 0; j < 4; ++j) prev[j] = prev[j] * rs * g[j]; }
        for (int rr = 0; rr < 8; ++rr) {
            const int row = r0 + rr;
            f32x4 hn[4]; load_row(x + (size_t)row * C, lane, hn); const float rs = row_rs(hn, lane);
#pragma unroll
            for (int j = 0; j < 4; ++j) hn[j] = hn[j] * rs * g[j];
#pragma unroll
            for (int i = 0; i < 6; ++i) { f32x4 o[4];
#pragma unroll
                for (int j = 0; j < 4; ++j) { const f32x4 mx = ((const GAS f32x4*)(mix + i * C))[64 * j + lane]; o[j] = hn[j] + (prev[j] - hn[j]) * mx; }
                bf16* dst = i < 2 ? (bf16*)OUTP() + (size_t)i * M * C : (i == 2 ? (bf16*)(ws + WS_B4) : (bf16*)(ws + WS_B1) + (size_t)(i - 3) * M * C);
                store_row_bf16(dst + (size_t)row * C, lane, o); }
#pragma unroll
            for (int j = 0; j < 4; ++j) prev[j] = hn[j];
        }
    }
}

template <int NN, int NGROUPS> struct SchedGrouped {
    static constexpr int K = C;
    const char* A0; size_t astride; const char* A2; const char* B; size_t bgroup;
    int G, c;
    __device__ __forceinline__ bool next(int i, pg8::Unit& u) const {
        const int L = i * G + c; constexpr int per = 64 * NN; if (L >= per * NGROUPS) return false;
        const int g = L / per, w = L % per; pg8::tile_map(w, 64, NN, u.pm, u.pn); u.aux = g; u.r0 = 0; u.cnt = 0; return true; }
    __device__ __forceinline__ const char* a_base(const pg8::Unit& u) const { const char* A = (A2 != nullptr && u.aux == 2) ? A2 : A0 + (size_t)u.aux * astride; return A + (size_t)u.pm * 256 * K * 2; }
    __device__ __forceinline__ const char* b_base(const pg8::Unit& u) const { return B + (size_t)u.aux * bgroup + (size_t)u.pn * 256 * K * 2; }
    __device__ __forceinline__ unsigned a_row_off(const pg8::Unit&, int) const { return 0u; }
};
template <int NN, int K, bool GATHER> struct SchedMoe {
    const char* A; const char* B; size_t bexp; const unsigned* list; volatile LAS int* tab; int G, c;
    __device__ __forceinline__ bool next(int i, pg8::Unit& u) const {
        const int L = i * G + c; const int tot = __builtin_amdgcn_readfirstlane(tab[48]) * NN; if (L >= tot) return false;
        u.pm = L / NN; u.pn = L % NN; int e = 0;
#pragma unroll
        for (int j = 0; j < 16; ++j) e += (u.pm >= tab[32 + j]) ? 1 : 0;
        e = __builtin_amdgcn_readfirstlane(e);
        u.aux = e; u.r0 = (u.pm - __builtin_amdgcn_readfirstlane(tab[16 + e])) * 256; u.cnt = __builtin_amdgcn_readfirstlane(tab[e]); return true; }
    __device__ __forceinline__ const char* a_base(const pg8::Unit& u) const { return GATHER ? A : A + (size_t)u.pm * 256 * K * 2; }
    __device__ __forceinline__ const char* b_base(const pg8::Unit& u) const { return B + (size_t)u.aux * bexp + (size_t)u.pn * 256 * K * 2; }
    __device__ __forceinline__ unsigned a_row_off(const pg8::Unit& u, int r) const {
        const int idx = u.r0 + r; unsigned tok = 0u;
        if (idx < u.cnt) tok = list[(size_t)u.aux * M + idx] >> 1;
        return tok * (unsigned)(K * 2); }
};

using pg8::f32x4;
using pg8::Unit;
__device__ __forceinline__ v4u pack8(f32x4 v0, f32x4 v1) { v4u w; w.x = pg8::cvt_pk_bf16(v0[0], v0[1]); w.y = pg8::cvt_pk_bf16(v0[2], v0[3]); w.z = pg8::cvt_pk_bf16(v1[0], v1[1]); w.w = pg8::cvt_pk_bf16(v1[2], v1[3]); return w; }

struct EpiLora {
    static constexpr bool PERM = true;
    bf16* LW;
    __device__ __forceinline__ void operator()(const f32x4 (&acc)[2][2][4][2], const Unit& u, int wr, int wc, int fr, int fq) const {
        { int l_; asm volatile("v_mbcnt_lo_u32_b32 %0, -1, 0\n\tv_mbcnt_hi_u32_b32 %0, -1, %0" : "=v"(l_)); fr = l_ & 15; fq = l_ >> 4; }
        const int g = u.aux, width = g == 2 ? DG : DW; bf16* out = LW + (size_t)g * (1u << 20);
        const int row0 = u.pm * 256 + wr * 64 + fr;
#pragma unroll
        for (int bj = 0; bj < 2; ++bj) { const int col0 = bj * 128 + wc * 32 + 8 * fq; if (col0 < width) {
#pragma unroll
            for (int ai = 0; ai < 2; ++ai)
#pragma unroll
                for (int m = 0; m < 4; ++m) { f32x4 v0 = acc[ai][bj][m][0], v1 = acc[ai][bj][m][1];
                    if (g == 0) {
#pragma unroll
                        for (int q = 0; q < 4; ++q) { v0[q] = tanhf(v0[q]); v1[q] = tanhf(v1[q]); } }
                    else if (g == 2) {
#pragma unroll
                        for (int q = 0; q < 4; ++q) { v0[q] = sigmoidf_(v0[q]); v1[q] = sigmoidf_(v1[q]); } }
                    *(GAS v4u*)(out + (size_t)(row0 + ai * 128 + m * 16) * width + col0) = pack8(v0, v1); } } }
    }
};
struct EpiSplit3 {
    static constexpr bool PERM = true;
    bf16* O0; bool bycol; const float* rowscale;
    __device__ __forceinline__ void operator()(const f32x4 (&acc)[2][2][4][2], const Unit& u, int wr, int wc, int fr, int fq) const {
        { int l_; asm volatile("v_mbcnt_lo_u32_b32 %0, -1, 0\n\tv_mbcnt_hi_u32_b32 %0, -1, %0" : "=v"(l_)); fr = l_ & 15; fq = l_ >> 4; }
        const int g = bycol ? (u.pn >> 2) : u.aux, pn = bycol ? (u.pn & 3) : u.pn; bf16* out = O0 + (size_t)g * ((size_t)M * C);
        const int row0 = u.pm * 256 + wr * 64 + fr, col0 = pn * 256 + wc * 32 + 8 * fq;
#pragma unroll
        for (int ai = 0; ai < 2; ++ai)
#pragma unroll
            for (int m = 0; m < 4; ++m)
                { const float sc = rowscale ? rowscale[row0 + ai * 128 + m * 16] : 1.0f;
#pragma unroll
                for (int bj = 0; bj < 2; ++bj) *(GAS v4u*)(out + (size_t)(row0 + ai * 128 + m * 16) * C + col0 + bj * 128) = pack8(acc[ai][bj][m][0] * sc, acc[ai][bj][m][1] * sc); }
    }
};
template <bool BASE_F32> struct EpiResidBf {
    static constexpr bool PERM = true;
    const void* base; bf16* out;
    __device__ __forceinline__ void operator()(const f32x4 (&acc)[2][2][4][2], const Unit& u, int wr, int wc, int fr, int fq) const {
        { int l_; asm volatile("v_mbcnt_lo_u32_b32 %0, -1, 0\n\tv_mbcnt_hi_u32_b32 %0, -1, %0" : "=v"(l_)); fr = l_ & 15; fq = l_ >> 4; }
        const int row0 = u.pm * 256 + wr * 64 + fr, col0 = u.pn * 256 + wc * 32 + 8 * fq;
#pragma unroll
        for (int ai = 0; ai < 2; ++ai)
#pragma unroll
            for (int m = 0; m < 4; ++m) { const size_t off = (size_t)(row0 + ai * 128 + m * 16) * C + col0;
#pragma unroll
                for (int bj = 0; bj < 2; ++bj) { f32x4 b0, b1;
                    if (BASE_F32) { b0 = *(const GAS f32x4*)((const float*)base + off + bj * 128); b1 = *(const GAS f32x4*)((const float*)base + off + bj * 128 + 4); }
                    else { const v4u w = *(const GAS v4u*)((const bf16*)base + off + bj * 128); b0 = (f32x4){bflo(w.x), bfhi(w.x), bflo(w.y), bfhi(w.y)}; b1 = (f32x4){bflo(w.z), bfhi(w.z), bflo(w.w), bfhi(w.w)}; }
                    *(GAS v4u*)(out + off + bj * 128) = pack8(b0 + acc[ai][bj][m][0], b1 + acc[ai][bj][m][1]); }
                asm volatile("" ::: "memory"); }
    }
};
struct EpiGU {
    static constexpr bool PERM = true;
    bf16* HID; const float* wl; const float* rsl;
    __device__ __forceinline__ void operator()(const f32x4 (&acc)[2][2][4][2], const Unit& u, int wr, int wc, int fr, int fq) const {
        { int l_; asm volatile("v_mbcnt_lo_u32_b32 %0, -1, 0\n\tv_mbcnt_hi_u32_b32 %0, -1, %0" : "=v"(l_)); fr = l_ & 15; fq = l_ >> 4; }
        const int e = u.aux, cnt = u.cnt, base = u.r0, r0 = wr * 64 + fr, col0 = u.pn * 128 + wc * 32 + 8 * fq;
#pragma unroll
        for (int ai = 0; ai < 2; ++ai)
#pragma unroll
            for (int m = 0; m < 4; ++m) { const int r = r0 + ai * 128 + m * 16, idx = base + r; float w = 0.f, rs = 0.f; if (idx < cnt) { w = wl[(size_t)e * M + idx]; rs = rsl[(size_t)e * M + idx]; }
                f32x4 h0, h1;
#pragma unroll
                for (int q = 0; q < 4; ++q) { const float g0 = acc[ai][0][m][0][q] * rs, g1 = acc[ai][0][m][1][q] * rs;
                    h0[q] = g0 * sigmoidf_(g0) * (acc[ai][1][m][0][q] * rs) * w; h1[q] = g1 * sigmoidf_(g1) * (acc[ai][1][m][1][q] * rs) * w; }
                *(GAS v4u*)(HID + (size_t)(u.pm * 256 + r) * FE + col0) = pack8(h0, h1);
                asm volatile("" ::: "memory"); }
    }
};
struct EpiDown {
    static constexpr bool PERM = true;
    bf16* EO; const unsigned* list;
    __device__ __forceinline__ void operator()(const f32x4 (&acc)[2][2][4][2], const Unit& u, int wr, int wc, int fr, int fq) const {
        { int l_; asm volatile("v_mbcnt_lo_u32_b32 %0, -1, 0\n\tv_mbcnt_hi_u32_b32 %0, -1, %0" : "=v"(l_)); fr = l_ & 15; fq = l_ >> 4; }
        const int e = u.aux, cnt = u.cnt, base = u.r0, r0 = wr * 64 + fr, col0 = u.pn * 256 + wc * 32 + 8 * fq;
#pragma unroll
        for (int ai = 0; ai < 2; ++ai)
#pragma unroll
            for (int m = 0; m < 4; ++m) { const int idx = base + r0 + ai * 128 + m * 16;
                if (idx < cnt) { const unsigned ent = list[(size_t)e * M + idx]; bf16* o = EO + ((size_t)(ent & 1u) * M + (ent >> 1)) * C + col0;
#pragma unroll
                    for (int bj = 0; bj < 2; ++bj) *(GAS v4u*)(o + bj * 128) = pack8(acc[ai][bj][m][0], acc[ai][bj][m][1]); }
                asm volatile("" ::: "memory"); }
    }
};

typedef short bf16x8s __attribute__((ext_vector_type(8)));
typedef short bf16x4s __attribute__((ext_vector_type(4)));
typedef short v4i16_t __attribute__((ext_vector_type(4)));
constexpr int TPB = 144;
constexpr int TILE_B = 64 * TPB;
constexpr int FP = 68;
constexpr int CS_FA = 0, CS_FB = 16384, CS_TILES = 32768, CS_TOT = CS_TILES + 12 * TILE_B, CS_WL = CS_TOT + 2048, CS_PAR = CS_WL + 256;
static_assert(CS_PAR + 768 <= LDSCTL_OFF, "scan LDS map");
#define TILE(n) (lds + CS_TILES + (n) * TILE_B)
#define F4Z (f32x4){0.f, 0.f, 0.f, 0.f}
__device__ __forceinline__ bf16x8s ldfrag(const LAS unsigned char* tile, int row, int kcol) { return *(const LAS bf16x8s*)(tile + row * TPB + kcol * 2); }
__device__ __forceinline__ bf16x8s ldfrag_tr(const LAS unsigned char* tile, int n0, int k0, int lane) {
    const int g = lane >> 4, q = (lane & 15) >> 2, p = lane & 3;
    const LAS unsigned char* a = tile + (k0 + 8 * g + q) * TPB + (n0 + 4 * p) * 2;
    const v4i16_t lo = __builtin_amdgcn_ds_read_tr16_b64_v4i16((LAS v4i16_t*)a), hi = __builtin_amdgcn_ds_read_tr16_b64_v4i16((LAS v4i16_t*)(a + 4 * TPB));
    return (bf16x8s){lo[0], lo[1], lo[2], lo[3], hi[0], hi[1], hi[2], hi[3]};
}
__device__ __forceinline__ bf16x8s ldfrag_perm(const LAS unsigned char* tile, int row, int ks, int g) {
    const bf16x4s lo = *(const LAS bf16x4s*)(tile + row * TPB + (32 * ks + 4 * g) * 2), hi = *(const LAS bf16x4s*)(tile + row * TPB + (32 * ks + 16 + 4 * g) * 2);
    return (bf16x8s){lo[0], lo[1], lo[2], lo[3], hi[0], hi[1], hi[2], hi[3]};
}
__device__ __forceinline__ void lds_barrier() { asm volatile("s_waitcnt lgkmcnt(0)" ::: "memory"); __builtin_amdgcn_s_barrier(); asm volatile("" ::: "memory"); }
#define MFMA16(a, b, c) __builtin_amdgcn_mfma_f32_16x16x32_bf16((a), (b), (c), 0, 0, 0)
__device__ __forceinline__ void mm64(f32x4 (&acc)[2], const LAS unsigned char* At, const LAS unsigned char* Bt, int rt, int ch, int fr, int g) {
#pragma unroll
    for (int ks = 0; ks < 2; ++ks) { const bf16x8s a = ldfrag(At, 16 * rt + fr, 32 * ks + 8 * g);
#pragma unroll
        for (int ct = 0; ct < 2; ++ct) acc[ct] = MFMA16(a, ldfrag(Bt, 32 * ch + 16 * ct + fr, 32 * ks + 8 * g), acc[ct]); }
}
__device__ __forceinline__ void mm64_bt(f32x4 (&acc)[2], const LAS unsigned char* At, const LAS unsigned char* X, int rt, int ch, int fr, int g, int lane) {
#pragma unroll
    for (int ks = 0; ks < 2; ++ks) { const bf16x8s a = ldfrag(At, 16 * rt + fr, 32 * ks + 8 * g);
#pragma unroll
        for (int ct = 0; ct < 2; ++ct) acc[ct] = MFMA16(a, ldfrag_tr(X, 32 * ch + 16 * ct, 32 * ks, lane), acc[ct]); }
}
__device__ __forceinline__ void mm64_at(f32x4 (&acc)[2], const LAS unsigned char* Xa, const LAS unsigned char* Bt, int rt, int ch, int fr, int g, int lane) {
#pragma unroll
    for (int ks = 0; ks < 2; ++ks) { const bf16x8s a = ldfrag_tr(Xa, 16 * rt, 32 * ks, lane);
#pragma unroll
        for (int ct = 0; ct < 2; ++ct) acc[ct] = MFMA16(a, ldfrag(Bt, 32 * ch + 16 * ct + fr, 32 * ks + 8 * g), acc[ct]); }
}
__device__ __forceinline__ void mm64_att(f32x4 (&acc)[2], const LAS unsigned char* Xa, const LAS unsigned char* X, int rt, int ch, int lane) {
#pragma unroll
    for (int ks = 0; ks < 2; ++ks) { const bf16x8s a = ldfrag_tr(Xa, 16 * rt, 32 * ks, lane);
#pragma unroll
        for (int ct = 0; ct < 2; ++ct) acc[ct] = MFMA16(a, ldfrag_tr(X, 32 * ch + 16 * ct, 32 * ks, lane), acc[ct]); }
}
__device__ __forceinline__ bf16x4s pack4(f32x4 v) { v2u w; w.x = pg8::cvt_pk_bf16(v[0], v[1]); w.y = pg8::cvt_pk_bf16(v[2], v[3]); return __builtin_bit_cast(bf16x4s, w); }
__device__ __forceinline__ f32x4 unpack4(bf16x4s s) { const v2u w = __builtin_bit_cast(v2u, s); return (f32x4){bflo(w.x), bfhi(w.x), bflo(w.y), bfhi(w.y)}; }
__device__ __forceinline__ void st_tr(LAS unsigned char* Out, const f32x4 (&acc)[2], int rt, int ch, int fr, int g) {
#pragma unroll
    for (int ct = 0; ct < 2; ++ct) *(LAS bf16x4s*)(Out + (32 * ch + 16 * ct + fr) * TPB + (16 * rt + 4 * g) * 2) = pack4(acc[ct]);
}
__device__ __forceinline__ void ld_tr(f32x4 (&acc)[2], const LAS unsigned char* In, int rt, int ch, int fr, int g) {
#pragma unroll
    for (int ct = 0; ct < 2; ++ct) acc[ct] = unpack4(*(const LAS bf16x4s*)(In + (32 * ch + 16 * ct + fr) * TPB + (16 * rt + 4 * g) * 2));
}
__device__ __forceinline__ void unpack8(v4u w, float (&o)[8]) { o[0] = bflo(w.x); o[1] = bfhi(w.x); o[2] = bflo(w.y); o[3] = bfhi(w.y); o[4] = bflo(w.z); o[5] = bfhi(w.z); o[6] = bflo(w.w); o[7] = bfhi(w.w); }
__device__ __forceinline__ v4u pack8f(const float (&o)[8]) { v4u w; w.x = pg8::cvt_pk_bf16(o[0], o[1]); w.y = pg8::cvt_pk_bf16(o[2], o[3]); w.z = pg8::cvt_pk_bf16(o[4], o[5]); w.w = pg8::cvt_pk_bf16(o[6], o[7]); return w; }

struct FrontIn { v4u r, k, v; bf16x8s fw[2], fa[2]; };
__device__ __forceinline__ void front_fetch(FrontIn& f, unsigned char* ws, int unit, int tid, int lane, int wave) {
    const int h = unit & 15, c = (unit >> 4) & 127, b = unit >> 11; const size_t row0 = (size_t)b * SEQ + c * 64;
    const int rt = wave & 3, fr = lane & 15, g = lane >> 4, t = tid >> 3, cq = tid & 7, c0 = h * HD + cq * 8;
    const bf16* Rb = (const bf16*)(ws + WS_B1); const bf16* Kb = (const bf16*)(ws + WS_B2); const bf16* Vb = (const bf16*)(ws + WS_B3);
    const bf16* LW = (const bf16*)(ws + WS_LW); const bf16* LA = (const bf16*)(ws + WS_LA);
    f.r = *(const GAS v4u*)(Rb + (row0 + t) * C + c0); f.k = *(const GAS v4u*)(Kb + (row0 + t) * C + c0); f.v = *(const GAS v4u*)(Vb + (row0 + t) * C + c0);
#pragma unroll
    for (int ks = 0; ks < 2; ++ks) { f.fw[ks] = *(const GAS bf16x8s*)(LW + (row0 + 16 * rt + fr) * DW + 32 * ks + 8 * g); f.fa[ks] = *(const GAS bf16x8s*)(LA + (row0 + 16 * rt + fr) * DA + 32 * ks + 8 * g); }
}
__device__ __forceinline__ v4u head_consts(unsigned char* ws, LAS unsigned char* lds, int h, int tid, int wtile, int atile) {
    const bf16* W2T = (const bf16*)(ws + WS_WT_W2); const bf16* A2T = (const bf16*)(ws + WS_WT_A2);
    const int row = tid >> 3, cq = tid & 7;
    const v4u w2chunk = *(const GAS v4u*)(W2T + (size_t)(h * HD + row) * 64 + cq * 8);
    *(LAS v4u*)(lds + CS_TILES + wtile * TILE_B + row * TPB + cq * 16) = w2chunk;
    *(LAS v4u*)(lds + CS_TILES + atile * TILE_B + row * TPB + cq * 16) = *(const GAS v4u*)(A2T + (size_t)(h * HD + row) * 64 + cq * 8);
    if (tid < 64) { LAS float* P = (LAS float*)(lds + CS_PAR); P[tid] = INP(15)[h * HD + tid]; P[64 + tid] = INP(16)[h * HD + tid]; P[128 + tid] = INP(17)[h * HD + tid]; }
    __syncthreads();
    return w2chunk;
}
template <int MODE>
__device__ __forceinline__ void chunk_front(const FrontIn& f, LAS unsigned char* lds, const float (&w0v)[2], const float (&a0v)[2], const bf16x8s (&w2f)[2][2], const bf16x8s (&a2f)[2][2], int tid, int lane, int wave, float (&v8)[8], float& rkb) {
    const int rt = wave & 3, ch = wave >> 2, fr = lane & 15, g = lane >> 4;
    LAS float* FA = (LAS float*)(lds + CS_FA); LAS float* FB = (LAS float*)(lds + CS_FB); LAS float* TOT = (LAS float*)(lds + CS_TOT);
    const int t = tid >> 3, cq = tid & 7;
    {
        f32x4 aw[2] = {F4Z, F4Z}, aa[2] = {F4Z, F4Z};
#pragma unroll
        for (int ks = 0; ks < 2; ++ks)
#pragma unroll
            for (int ct = 0; ct < 2; ++ct) { aw[ct] = MFMA16(f.fw[ks], w2f[ks][ct], aw[ct]); aa[ct] = MFMA16(f.fa[ks], a2f[ks][ct], aa[ct]); }
#pragma unroll
        for (int ct = 0; ct < 2; ++ct) { const int j = 32 * ch + 16 * ct + fr, js = j ^ ((g & 1) << 4); const float w0 = w0v[ct], a0 = a0v[ct];
            float p[4];
#pragma unroll
            for (int q = 0; q < 4; ++q) { p[q] = -0.6065306597126334f * sigmoidf_(w0 + aw[ct][q]); if (q) p[q] += p[q - 1]; }
            const float s_ = p[3];
            const float u1 = __int_as_float(__builtin_amdgcn_ds_bpermute(((lane - 16) & 63) << 2, __float_as_int(s_))); const float t1 = s_ + (g >= 1 ? u1 : 0.f);
            const float u2 = __int_as_float(__builtin_amdgcn_ds_bpermute(((lane - 32) & 63) << 2, __float_as_int(t1))); const float t2 = t1 + (g >= 2 ? u2 : 0.f);
            const float ex = t2 - s_;
#pragma unroll
            for (int q = 0; q < 4; ++q) { const int tt = 16 * rt + 4 * g + q; FA[tt * 64 + js] = p[q] + ex; FB[tt * 64 + js] = sigmoidf_(a0 + aa[ct][q]); }
            if (g == 3) TOT[rt * 64 + j] = t2; }
    }
    lds_barrier();
    {
        float r[8], k[8], pkk[8], pka[8], prk[8];
        unpack8(f.r, r); unpack8(f.k, k); unpack8(f.v, v8);
        { const LAS float* P = (const LAS float*)(lds + CS_PAR) + cq * 8; const f32x4 a0_ = *(const LAS f32x4*)P, a1_ = *(const LAS f32x4*)(P + 4), b0_ = *(const LAS f32x4*)(P + 64), b1_ = *(const LAS f32x4*)(P + 68), c0_ = *(const LAS f32x4*)(P + 128), c1_ = *(const LAS f32x4*)(P + 132);
#pragma unroll
          for (int q = 0; q < 4; ++q) { pkk[q] = a0_[q]; pkk[4 + q] = a1_[q]; pka[q] = b0_[q]; pka[4 + q] = b1_[q]; prk[q] = c0_[q]; prk[4 + q] = c1_[q]; } }
        float cw[8], cwp[8], ag[8];
        { const int tp = t > 0 ? t - 1 : 0, rtt = wave >> 1;
          const int ct_ = (cq ^ (((t >> 2) & 1) << 1)) * 8, cp_ = (cq ^ (((tp >> 2) & 1) << 1)) * 8;
          const f32x4 c0_ = *(const LAS f32x4*)(FA + t * 64 + ct_), c1_ = *(const LAS f32x4*)(FA + t * 64 + ct_ + 4), p0_ = *(const LAS f32x4*)(FA + tp * 64 + cp_), p1_ = *(const LAS f32x4*)(FA + tp * 64 + cp_ + 4);
          const f32x4 g0_ = *(const LAS f32x4*)(FB + t * 64 + ct_), g1_ = *(const LAS f32x4*)(FB + t * 64 + ct_ + 4);
          f32x4 o0_ = F4Z, o1_ = F4Z, l0_ = F4Z, l1_ = F4Z;
          for (int r_ = 0; r_ < rtt; ++r_) { l0_ = *(const LAS f32x4*)(TOT + r_ * 64 + cq * 8); l1_ = *(const LAS f32x4*)(TOT + r_ * 64 + cq * 8 + 4); o0_ = o0_ + l0_; o1_ = o1_ + l1_; }
          const bool first = (t & 15) == 0;
#pragma unroll
          for (int q = 0; q < 4; ++q) { cw[q] = c0_[q] + o0_[q]; cw[4 + q] = c1_[q] + o1_[q];
              cwp[q] = t > 0 ? p0_[q] + o0_[q] - (first ? l0_[q] : 0.f) : 0.f; cwp[4 + q] = t > 0 ? p1_[q] + o1_[q] - (first ? l1_[q] : 0.f) : 0.f; ag[q] = g0_[q]; ag[4 + q] = g1_[q]; } }
        float kk[8], ss = 0.f; rkb = 0.f;
#pragma unroll
        for (int q = 0; q < 8; ++q) { kk[q] = k[q] * pkk[q]; ss += kk[q] * kk[q]; }
        ss += shx(ss, 1, lane); ss += shx(ss, 2, lane); ss += shx(ss, 4, lane);
        const float inv = 1.0f / fmaxf(sqrtf(ss), 1e-12f);
        float at[8], bt[8], kt[8], rt_[8];
#pragma unroll
        for (int q = 0; q < 8; ++q) { const float kn = kk[q] * inv, kp = k[q] * (1.0f + (ag[q] - 1.0f) * pka[q]);
            const float ein = __expf(-cw[q]);
            at[q] = -kn * __expf(cwp[q]); bt[q] = kn * ag[q] * ein; kt[q] = kp * ein;
            rt_[q] = r[q] * __expf(cw[q]); rkb += r[q] * kp * prk[q]; }
        rkb += shx(rkb, 1, lane); rkb += shx(rkb, 2, lane); rkb += shx(rkb, 4, lane);
        *(LAS v4u*)(TILE(0) + t * TPB + cq * 16) = pack8f(at); *(LAS v4u*)(TILE(1) + t * TPB + cq * 16) = pack8f(bt); *(LAS v4u*)(TILE(2) + t * TPB + cq * 16) = pack8f(kt);
        *(LAS v4u*)(TILE(3) + t * TPB + cq * 16) = f.v;
        *(LAS v4u*)(TILE(6) + t * TPB + cq * 16) = pack8f(rt_);
        if (MODE == 1 && t == 63) {
#pragma unroll
            for (int q = 0; q < 8; ++q) ((LAS float*)(lds + CS_WL))[cq * 8 + q] = __expf(cw[q]); }
    }
    lds_barrier();
}

__device__ __forceinline__ void scan_s1(unsigned char* ws, LAS unsigned char* lds, int lane0, int wave) {
    const int rt = wave & 3, ch = wave >> 2;
    FrontIn fin; float w0v[2], a0v[2]; bf16x8s w2f[2][2], a2f[2][2];
    { int l0 = lane0; asm volatile("" : "+v"(l0)); const int hh = blockIdx.x & 15;
      if ((int)blockIdx.x < BATCH * NH * (SEQ / 64)) front_fetch(fin, ws, blockIdx.x, wave * 64 + l0, l0, wave);
      const bf16* W2T = (const bf16*)(ws + WS_WT_W2); const bf16* A2T = (const bf16*)(ws + WS_WT_A2);
#pragma unroll
      for (int ct = 0; ct < 2; ++ct) { w0v[ct] = INP(7)[hh * HD + 32 * ch + 16 * ct + (l0 & 15)]; a0v[ct] = INP(10)[hh * HD + 32 * ch + 16 * ct + (l0 & 15)];
#pragma unroll
          for (int ks = 0; ks < 2; ++ks) { const size_t wr_ = (size_t)(hh * HD + 32 * ch + 16 * ct + (l0 & 15)) * 64 + 32 * ks + 8 * (l0 >> 4); w2f[ks][ct] = *(const GAS bf16x8s*)(W2T + wr_); a2f[ks][ct] = *(const GAS bf16x8s*)(A2T + wr_); } }
      const int tid0 = wave * 64 + l0;
      if (tid0 < 64) { LAS float* P = (LAS float*)(lds + CS_PAR); P[tid0] = INP(15)[hh * HD + tid0]; P[64 + tid0] = INP(16)[hh * HD + tid0]; P[128 + tid0] = INP(17)[hh * HD + tid0]; }
      __syncthreads(); }
    for (int unit = blockIdx.x; unit < BATCH * NH * (SEQ / 64); unit += gridDim.x) {
        int lane = lane0; asm volatile("" : "+v"(lane));
        const int tid = wave * 64 + lane, fr = lane & 15, g = lane >> 4;
        const int h = unit & 15, c = (unit >> 4) & 127, b = unit >> 11; const size_t chunk = ((size_t)b * NH + h) * 128 + c;
        float v8[8]; float rkb;
        chunk_front<1>(fin, lds, w0v, a0v, w2f, a2f, tid, lane, wave, v8, rkb);
        { const size_t row0_ = (size_t)b * SEQ + c * 64; if ((tid & 7) == 0) ((float*)(ws + WS_HID))[(row0_ + (tid >> 3)) * NH + h] = rkb; }
        if (unit + (int)gridDim.x < BATCH * NH * (SEQ / 64)) front_fetch(fin, ws, unit + gridDim.x, tid, lane, wave);
        {
            f32x4 a2[2] = {F4Z, F4Z}, a3[2] = {F4Z, F4Z};
            mm64(a2, TILE(1), TILE(0), rt, ch, fr, g);
            mm64(a3, TILE(2), TILE(0), rt, ch, fr, g);
            f32x4 p1[2];
#pragma unroll
            for (int ct = 0; ct < 2; ++ct) { const int col = 32 * ch + 16 * ct + fr;
#pragma unroll
                for (int q = 0; q < 4; ++q) { const int row = 16 * rt + 4 * g + q;
                    a2[ct][q] = row < col ? a2[ct][q] : 0.f;
                    p1[ct][q] = a2[ct][q] + (row == col ? 1.0f : 0.f);
                    a3[ct][q] = row < col ? a3[ct][q] : 0.f; } }
            st_tr(TILE(5), a2, rt, ch, fr, g);
            st_tr(TILE(9), p1, rt, ch, fr, g);
            st_tr(TILE(4), a3, rt, ch, fr, g);
        }
        lds_barrier();
#pragma unroll
        for (int r = 0; r < 6; ++r) {
            LAS unsigned char* Sr = TILE(5 + 2 * (r & 1)); LAS unsigned char* Sr2 = TILE(5 + 2 * ((r & 1) ^ 1));
            if (r <= 4) { f32x4 q2[2] = {F4Z, F4Z};
                mm64_at(q2, Sr, Sr, rt, ch, fr, g, lane);
                st_tr(Sr2, q2, rt, ch, fr, g); }
            if (r >= 1) { LAS unsigned char* Pr = TILE(9 + ((r - 1) & 1)); LAS unsigned char* Pr2 = TILE(9 + (((r - 1) & 1) ^ 1));
                f32x4 pa[2]; ld_tr(pa, Pr, rt, ch, fr, g);
                mm64_at(pa, Sr, Pr, rt, ch, fr, g, lane);
                st_tr(Pr2, pa, rt, ch, fr, g); }
            if (r == 0) { f32x4 gg[2] = {F4Z, F4Z};
                mm64_bt(gg, TILE(4), TILE(3), rt, ch, fr, g, lane);
                st_tr(TILE(11), gg, rt, ch, fr, g); }
            lds_barrier();
        }
        {
            f32x4 acc[2] = {F4Z, F4Z}, ac2[2] = {F4Z, F4Z};
            mm64_bt(acc, TILE(10), TILE(0), rt, ch, fr, g, lane);
            mm64(ac2, TILE(10), TILE(11), rt, ch, fr, g);
            st_tr(TILE(5), acc, rt, ch, fr, g); st_tr(TILE(7), ac2, rt, ch, fr, g);
            f32x4 b2[2] = {F4Z, F4Z}, b3[2] = {F4Z, F4Z};
            mm64(b2, TILE(1), TILE(6), rt, ch, fr, g); mm64(b3, TILE(2), TILE(6), rt, ch, fr, g);
#pragma unroll
            for (int ct = 0; ct < 2; ++ct) { const int t = 32 * ch + 16 * ct + fr;
#pragma unroll
                for (int q = 0; q < 4; ++q) { const int s_ = 16 * rt + 4 * g + q; b2[ct][q] = s_ <= t ? b2[ct][q] : 0.f; b3[ct][q] = s_ <= t ? b3[ct][q] : 0.f; } }
            st_tr(TILE(4), b2, rt, ch, fr, g); st_tr(TILE(9), b3, rt, ch, fr, g);
        }
        lds_barrier();
        {
            const LAS float* WL = (const LAS float*)(lds + CS_WL);
            f32x4 acc[2] = {F4Z, F4Z};
            mm64_bt(acc, TILE(5), TILE(1), rt, ch, fr, g, lane);
            bf16* Mg = (bf16*)(ws + WS_B0) + chunk * 4096;
#pragma unroll
            for (int ct = 0; ct < 2; ++ct) { const int j1 = 32 * ch + 16 * ct + fr; const float wl = WL[j1];
#pragma unroll
                for (int q = 0; q < 4; ++q) { const int j2 = 16 * rt + 4 * g + q; acc[ct][q] = wl * (acc[ct][q] + (j2 == j1 ? 1.0f : 0.f)); }
                const int rtS = 2 * ch + ct, ksS = rt >> 1, half = rt & 1;
                *(GAS bf16x4s*)(Mg + (((rtS * 2 + ksS) * 64 + g * 16 + fr) * 8 + half * 4)) = pack4(acc[ct]); }
            f32x4 ad[2] = {F4Z, F4Z};
            mm64_at(ad, TILE(1), TILE(7), rt, ch, fr, g, lane);
            mm64_att(ad, TILE(2), TILE(3), rt, ch, lane);
            const f32x4 wl4 = *(const LAS f32x4*)(WL + 16 * rt + 4 * g);
            bf16* Dg = (bf16*)OUTP() + chunk * 4096;
#pragma unroll
            for (int ct = 0; ct < 2; ++ct) *(GAS bf16x4s*)(Dg + (((2 * ch + ct) * 4 + rt) * 64 + lane) * 4) = pack4(ad[ct] * wl4);
            const size_t row0_ = (size_t)b * SEQ + c * 64;
            f32x4 ar[2]; ld_tr(ar, TILE(6), rt, ch, fr, g);
            mm64(ar, TILE(5), TILE(4), rt, ch, fr, g);
            f32x4 ay[2] = {F4Z, F4Z};
            mm64(ay, TILE(7), TILE(4), rt, ch, fr, g); mm64_at(ay, TILE(3), TILE(9), rt, ch, fr, g, lane);
            bf16* Rg = (bf16*)(ws + WS_B1); bf16* Kg = (bf16*)(ws + WS_B2);
#pragma unroll
            for (int ct = 0; ct < 2; ++ct) { const size_t o_ = (row0_ + 32 * ch + 16 * ct + fr) * C + h * HD + 16 * rt + 4 * g; *(GAS bf16x4s*)(Rg + o_) = pack4(ar[ct]); *(GAS bf16x4s*)(Kg + o_) = pack4(ay[ct]); }
        }
        lds_barrier();
    }
}

constexpr int S2_PD = 6;
__device__ __forceinline__ void scan_s2(unsigned char* ws, LAS unsigned char* lds, int lane, int wave) {
    for (int bh = blockIdx.x; bh < BATCH * NH; bh += gridDim.x) {
        const unsigned char* Mg = (const unsigned char*)((const bf16*)(ws + WS_B0) + (size_t)bh * 128 * 4096); const unsigned char* Dg = (const unsigned char*)((const bf16*)OUTP() + (size_t)bh * 128 * 4096);
        bf16* Sg = (bf16*)OUTP() + (size_t)M * C + (size_t)bh * 128 * 4096;
        if (wave >= 4) {
            const int lw = wave - 4;
            const unsigned char* src = (lw < 2 ? Mg + lw * 4096 : Dg + (lw - 2) * 4096) + lane * 16;
            LAS unsigned char* dst = lds + lw * 4096 + lane * 16;
            v4u q[S2_PD][4];
#define S2_LOADQ(j, c) do { _Pragma("unroll") for (int i_ = 0; i_ < 4; ++i_) q[j][i_] = *(const GAS v4u*)(src + (size_t)(c) * 8192 + i_ * 1024); } while (0)
#define S2_STOREQ(j, slot) do { _Pragma("unroll") for (int i_ = 0; i_ < 4; ++i_) *(LAS v4u*)(dst + (slot) * 16384 + i_ * 1024) = q[j][i_]; } while (0)
#pragma unroll
            for (int j = 0; j < S2_PD; ++j) S2_LOADQ(j, j);
            S2_STOREQ(0, 0); S2_LOADQ(0, S2_PD);
            lds_barrier();
#pragma unroll 1
            for (int s0 = 0; s0 < 128; s0 += S2_PD) {
#pragma unroll
                for (int jj = 0; jj < S2_PD; ++jj) { const int step = s0 + jj;
                    if (step + 1 < 128) S2_STOREQ((jj + 1) % S2_PD, (step + 1) & 1);
                    if (step + 1 + S2_PD < 128) S2_LOADQ((jj + 1) % S2_PD, step + 1 + S2_PD);
                    lds_barrier(); }
            }
#undef S2_LOADQ
#undef S2_STOREQ
        } else {
            const int ct = wave;
            f32x4 acc[4];
#pragma unroll
            for (int r = 0; r < 4; ++r) acc[r] = F4Z;
            lds_barrier();
#pragma unroll 1
            for (int s0 = 0; s0 < 128; s0 += S2_PD) {
#pragma unroll
                for (int jj = 0; jj < S2_PD; ++jj) { const int step = s0 + jj;
                    if (step < 128) {
                        const LAS unsigned char* slot = lds + (step & 1) * 16384;
                        bf16x8s sf[2];
#pragma unroll
                        for (int ks = 0; ks < 2; ++ks) { const bf16x4s lo = pack4(acc[2 * ks]), hi = pack4(acc[2 * ks + 1]); sf[ks] = (bf16x8s){lo[0], lo[1], lo[2], lo[3], hi[0], hi[1], hi[2], hi[3]}; }
#pragma unroll
                        for (int ks = 0; ks < 2; ++ks) *(GAS bf16x8s*)(Sg + (size_t)step * 4096 + ((ct * 2 + ks) * 64 + lane) * 8) = sf[ks];
                        f32x4 na[4];
#pragma unroll
                        for (int r = 0; r < 4; ++r) na[r] = unpack4(*(const LAS bf16x4s*)(slot + 8192 + ((ct * 4 + r) * 64 + lane) * 8));
#pragma unroll
                        for (int ks = 0; ks < 2; ++ks)
#pragma unroll
                            for (int r = 0; r < 4; ++r) na[r] = MFMA16(*(const LAS bf16x8s*)(slot + ((r * 2 + ks) * 64 + lane) * 16), sf[ks], na[r]);
#pragma unroll
                        for (int r = 0; r < 4; ++r) acc[r] = na[r];
                    }
                    lds_barrier(); }
            }
        }
    }
}

constexpr int S3_RT = 32768, S3_YT = S3_RT + TILE_B, S3_LG = S3_YT + TILE_B, S3_LGP = 336;
struct S3In { v4u rr, yy, vv, lg[3]; bf16x8s sA[2]; float rkb; };
__device__ __forceinline__ void s3_fetch(S3In& f, unsigned char* ws, int unit, int tid, int lane, int wave) {
    const int h = unit & 15, c = (unit >> 4) & 127, b = unit >> 11; const size_t chunk = ((size_t)b * NH + h) * 128 + c, row0 = (size_t)b * SEQ + c * 64;
    const int rt = wave & 3, et = tid >> 3, ecq = tid & 7;
    const bf16* Rg = (const bf16*)(ws + WS_B1); const bf16* Kg = (const bf16*)(ws + WS_B2); const bf16* Vb = (const bf16*)(ws + WS_B3); const bf16* LG = (const bf16*)(ws + WS_LG);
    const bf16* Sg = (const bf16*)OUTP() + (size_t)M * C + chunk * 4096;
    const size_t o_ = (row0 + et) * C + h * HD + ecq * 8;
    f.rr = *(const GAS v4u*)(Rg + o_); f.yy = *(const GAS v4u*)(Kg + o_); f.vv = *(const GAS v4u*)(Vb + o_);
#pragma unroll
    for (int i = 0; i < 3; ++i) { const int chn = tid + 512 * i; if (chn < 64 * 20) f.lg[i] = *(const GAS v4u*)(LG + (row0 + chn / 20) * DG + (chn % 20) * 8); }
#pragma unroll
    for (int ks = 0; ks < 2; ++ks) f.sA[ks] = *(const GAS bf16x8s*)(Sg + ((rt * 2 + ks) * 64 + lane) * 8);
    f.rkb = ((const float*)(ws + WS_HID))[(row0 + et) * NH + h];
}
__device__ __forceinline__ void scan_s3(unsigned char* ws, LAS unsigned char* lds, int lane0, int wave) {
    const int rt = wave & 3, ch = wave >> 2;
    LAS float* Ys = (LAS float*)(lds + CS_FA);
    const bf16* G2T = (const bf16*)(ws + WS_WT_G2); bf16* YG = (bf16*)(ws + WS_B0);
    constexpr int NU = BATCH * NH * (SEQ / 64);
    S3In fin; bf16x8s gA[5]; f32x4 lnw0, lnw1, lnb0, lnb1;
    { int l0 = lane0; asm volatile("" : "+v"(l0)); const int hh = blockIdx.x & 15, t0_ = wave * 64 + l0;
      if ((int)blockIdx.x < NU) s3_fetch(fin, ws, blockIdx.x, t0_, l0, wave);
#pragma unroll
      for (int ks = 0; ks < 5; ++ks) gA[ks] = *(const GAS bf16x8s*)(G2T + (size_t)(hh * HD + 16 * rt + (l0 & 15)) * DG + 32 * ks + 8 * (l0 >> 4));
      const int ec0 = hh * HD + (t0_ & 7) * 8;
      lnw0 = *(const GAS f32x4*)(INP(18) + ec0); lnw1 = *(const GAS f32x4*)(INP(18) + ec0 + 4); lnb0 = *(const GAS f32x4*)(INP(19) + ec0); lnb1 = *(const GAS f32x4*)(INP(19) + ec0 + 4); }
    __syncthreads();
    for (int unit = blockIdx.x; unit < NU; unit += gridDim.x) {
        int lane = lane0; asm volatile("" : "+v"(lane));
        const int tid = wave * 64 + lane, fr = lane & 15, g = lane >> 4, et = tid >> 3, ecq = tid & 7;
        const int h = unit & 15, c = (unit >> 4) & 127, b = unit >> 11; const size_t row0 = (size_t)b * SEQ + c * 64;
        *(LAS v4u*)(lds + S3_RT + et * TPB + ecq * 16) = fin.rr; *(LAS v4u*)(lds + S3_YT + et * TPB + ecq * 16) = fin.yy;
#pragma unroll
        for (int i = 0; i < 3; ++i) { const int chn = tid + 512 * i; if (chn < 64 * 20) *(LAS v4u*)(lds + S3_LG + (chn / 20) * S3_LGP + (chn % 20) * 16) = fin.lg[i]; }
        float v8[8]; unpack8(fin.vv, v8); const float rkb = fin.rkb; const bf16x8s sA0 = fin.sA[0], sA1 = fin.sA[1];
        lds_barrier();
        if (unit + (int)gridDim.x < NU) s3_fetch(fin, ws, unit + gridDim.x, tid, lane, wave);
        f32x4 acc[2], ag[2] = {F4Z, F4Z};
#pragma unroll
        for (int ct = 0; ct < 2; ++ct) { const int t = 32 * ch + 16 * ct + fr;
            acc[ct] = unpack4(*(const LAS bf16x4s*)(lds + S3_YT + t * TPB + (16 * rt + 4 * g) * 2));
            acc[ct] = MFMA16(sA0, ldfrag_perm(lds + S3_RT, t, 0, g), acc[ct]); acc[ct] = MFMA16(sA1, ldfrag_perm(lds + S3_RT, t, 1, g), acc[ct]);
#pragma unroll
            for (int ks = 0; ks < 5; ++ks) ag[ct] = MFMA16(gA[ks], *(const LAS bf16x8s*)(lds + S3_LG + t * S3_LGP + (32 * ks + 8 * g) * 2), ag[ct]);
            *(LAS f32x4*)(Ys + t * FP + 16 * rt + 4 * g) = acc[ct]; }
        lds_barrier();
        {
            const f32x4 y0 = *(const LAS f32x4*)(Ys + et * FP + ecq * 8), y1 = *(const LAS f32x4*)(Ys + et * FP + ecq * 8 + 4);
            float y[8] = {y0[0], y0[1], y0[2], y0[3], y1[0], y1[1], y1[2], y1[3]};
            float s_ = 0.f;
#pragma unroll
            for (int q = 0; q < 8; ++q) s_ += y[q];
            s_ += shx(s_, 1, lane); s_ += shx(s_, 2, lane); s_ += shx(s_, 4, lane);
            const float mu = s_ * (1.0f / HD); float vs = 0.f;
#pragma unroll
            for (int q = 0; q < 8; ++q) { y[q] -= mu; vs += y[q] * y[q]; }
            vs += shx(vs, 1, lane); vs += shx(vs, 2, lane); vs += shx(vs, 4, lane);
            const float rstd = 1.0f / sqrtf(vs * (1.0f / HD) + GN_EPS);
            f32x4 o0, o1;
#pragma unroll
            for (int q = 0; q < 4; ++q) { o0[q] = y[q] * rstd * lnw0[q] + lnb0[q] + rkb * v8[q]; o1[q] = y[4 + q] * rstd * lnw1[q] + lnb1[q] + rkb * v8[4 + q]; }
            *(LAS f32x4*)(Ys + et * FP + ecq * 8) = o0; *(LAS f32x4*)(Ys + et * FP + ecq * 8 + 4) = o1;
        }
        lds_barrier();
#pragma unroll
        for (int ct = 0; ct < 2; ++ct) { const int t = 32 * ch + 16 * ct + fr; const f32x4 yv = *(const LAS f32x4*)(Ys + t * FP + 16 * rt + 4 * g);
            *(GAS bf16x4s*)(YG + (row0 + t) * C + h * HD + 16 * rt + 4 * g) = pack4(yv * ag[ct]); }
    }
    __syncthreads();
}
#undef TILE
#if MK_DEBUG
__device__ __forceinline__ void scan_naive(unsigned char* ws, LAS unsigned char* lds, int tid) {
    const int lane = tid & 63;
    const bf16* Rb = (const bf16*)(ws + WS_B1); const bf16* Kb = (const bf16*)(ws + WS_B2); const bf16* Vb = (const bf16*)(ws + WS_B3);
    const bf16* LW = (const bf16*)(ws + WS_LW); const bf16* LA = (const bf16*)(ws + WS_LA);
    float* Y = OUTP(); float* RK = (float*)(ws + WS_HID);
    LAS float* sR = (LAS float*)lds; LAS float* sK = sR + 4096; LAS float* sV = sK + 4096; LAS float* sA = sV + 4096; LAS float* sB = sA + 4096; LAS float* sD = sB + 4096;
    LAS float* sW2 = sD + 4096; LAS float* sA2 = sW2 + 4096;
    for (int unit = blockIdx.x; unit < BATCH * NH; unit += gridDim.x) {
        const int b = unit / NH, h = unit % NH;
        __syncthreads();
        for (int e = tid; e < 4096; e += 512) { const int d = e >> 6, j = e & 63; sW2[e] = INP(9)[(size_t)d * C + h * HD + j]; sA2[e] = INP(12)[(size_t)d * C + h * HD + j]; }
        __syncthreads();
        const int pt = tid >> 3, cq = tid & 7, c0 = h * HD + cq * 8;
        const int si = tid >> 3, jq = tid & 7;
        float S[8];
#pragma unroll
        for (int q = 0; q < 8; ++q) S[q] = 0.f;
        float w0v[8], a0v[8], kkv[8], kav[8], rkv[8];
#pragma unroll
        for (int q = 0; q < 8; ++q) { w0v[q] = INP(7)[c0 + q]; a0v[q] = INP(10)[c0 + q]; kkv[q] = INP(15)[c0 + q]; kav[q] = INP(16)[c0 + q]; rkv[q] = INP(17)[c0 + q]; }
        for (int blk = 0; blk < SEQ / 64; ++blk) {
            const size_t row = (size_t)b * SEQ + blk * 64 + pt;
            {
                const v4u r4 = *(const GAS v4u*)(Rb + row * C + c0), k4 = *(const GAS v4u*)(Kb + row * C + c0), v4 = *(const GAS v4u*)(Vb + row * C + c0);
                float r[8], k[8], v[8];
                r[0] = bflo(r4.x); r[1] = bfhi(r4.x); r[2] = bflo(r4.y); r[3] = bfhi(r4.y); r[4] = bflo(r4.z); r[5] = bfhi(r4.z); r[6] = bflo(r4.w); r[7] = bfhi(r4.w);
                k[0] = bflo(k4.x); k[1] = bfhi(k4.x); k[2] = bflo(k4.y); k[3] = bfhi(k4.y); k[4] = bflo(k4.z); k[5] = bfhi(k4.z); k[6] = bflo(k4.w); k[7] = bfhi(k4.w);
                v[0] = bflo(v4.x); v[1] = bfhi(v4.x); v[2] = bflo(v4.y); v[3] = bfhi(v4.y); v[4] = bflo(v4.z); v[5] = bfhi(v4.z); v[6] = bflo(v4.w); v[7] = bfhi(v4.w);
                float wp[8], ap[8];
#pragma unroll
                for (int q = 0; q < 8; ++q) { wp[q] = w0v[q]; ap[q] = a0v[q]; }
                for (int d = 0; d < 64; ++d) { const float lw = bf2f(LW[row * DW + d]), la = bf2f(LA[row * DA + d]);
#pragma unroll
                    for (int q = 0; q < 8; ++q) { wp[q] += lw * sW2[d * 64 + cq * 8 + q]; ap[q] += la * sA2[d * 64 + cq * 8 + q]; } }
                float kk[8], ss = 0.f, rks = 0.f;
#pragma unroll
                for (int q = 0; q < 8; ++q) { kk[q] = k[q] * kkv[q]; ss += kk[q] * kk[q]; }
                ss += shx(ss, 1, lane); ss += shx(ss, 2, lane); ss += shx(ss, 4, lane);
                const float inv = 1.0f / fmaxf(sqrtf(ss), 1e-12f);
#pragma unroll
                for (int q = 0; q < 8; ++q) { const float ag = sigmoidf_(ap[q]); const float kn = kk[q] * inv; const float kp = k[q] * (1.0f + (ag - 1.0f) * kav[q]);
                    const float lw = -0.6065306597126334f * sigmoidf_(wp[q]);
                    const int o = pt * 64 + cq * 8 + q;
                    sR[o] = r[q]; sK[o] = kp; sV[o] = v[q]; sA[o] = -kn; sB[o] = kn * ag; sD[o] = __expf(lw); rks += r[q] * kp * rkv[q]; }
                rks += shx(rks, 1, lane); rks += shx(rks, 2, lane); rks += shx(rks, 4, lane);
                if (cq == 0) RK[row * NH + h] = rks;
            }
            __syncthreads();
            for (int t = 0; t < 64; ++t) {
                const LAS f32x4* pa = (const LAS f32x4*)(sA + t * 64 + jq * 8); const LAS f32x4* pb = (const LAS f32x4*)(sB + t * 64 + jq * 8);
                const LAS f32x4* pd = (const LAS f32x4*)(sD + t * 64 + jq * 8); const LAS f32x4* pk = (const LAS f32x4*)(sK + t * 64 + jq * 8);
                const LAS f32x4* pr = (const LAS f32x4*)(sR + t * 64 + jq * 8);
                const f32x4 a0 = pa[0], a1 = pa[1], b0 = pb[0], b1 = pb[1], d0 = pd[0], d1 = pd[1], k0 = pk[0], k1 = pk[1], r0 = pr[0], r1 = pr[1];
                const float vi = sV[t * 64 + si];
                float sa = 0.f;
#pragma unroll
                for (int q = 0; q < 4; ++q) { sa += S[q] * a0[q]; sa += S[4 + q] * a1[q]; }
                sa += shx(sa, 1, lane); sa += shx(sa, 2, lane); sa += shx(sa, 4, lane);
                float y = 0.f;
#pragma unroll
                for (int q = 0; q < 4; ++q) { S[q] = S[q] * d0[q] + sa * b0[q] + vi * k0[q]; S[4 + q] = S[4 + q] * d1[q] + sa * b1[q] + vi * k1[q]; y += S[q] * r0[q]; y += S[4 + q] * r1[q]; }
                y += shx(y, 1, lane); y += shx(y, 2, lane); y += shx(y, 4, lane);
                if (jq == 0) Y[((size_t)b * SEQ + blk * 64 + t) * C + h * HD + si] = y;
            }
            __syncthreads();
        }
    }
}
__device__ __forceinline__ void post_scan(unsigned char* ws, int gw, int NGW, int lane) {
    const float* Y = OUTP(); const float* RK = (const float*)(ws + WS_HID); const bf16* Vb = (const bf16*)(ws + WS_B3); const bf16* LG = (const bf16*)(ws + WS_LG);
    bf16* YG = (bf16*)(ws + WS_B4); const float* g2 = INP(14); const float* lnw = INP(18); const float* lnb = INP(19);
    for (int it = gw; it < M * NH; it += NGW) {
        const int row = it / NH, h = it % NH, c = h * HD + lane;
        const float y = Y[(size_t)row * C + c];
        const float mu = wave_sum(y, lane) * (1.0f / HD); const float d = y - mu; const float var = wave_sum(d * d, lane) * (1.0f / HD);
        float o = d * (1.0f / sqrtf(var + GN_EPS)) * lnw[c] + lnb[c];
        o += RK[(size_t)row * NH + h] * bf2f(Vb[(size_t)row * C + c]);
        float g = 0.f;
        for (int dd = 0; dd < DG; ++dd) g += bf2f(LG[(size_t)row * DG + dd]) * g2[(size_t)dd * C + c];
        YG[(size_t)row * C + c] = (bf16)f2bf(o * g);
    }
}


constexpr int CW_DBG = 3200;
__device__ __forceinline__ void dbg_nonfinite(unsigned char* ws, const bf16* X, size_t n, int slot, int gw, int NGW, int lane, float thr = 1e30f) {
    unsigned* cw = (unsigned*)(ws + WS_CTL) + CW_DBG + 64 * slot; unsigned nnan = 0;
    for (size_t i = (size_t)gw * 64 + lane; i < n; i += (size_t)NGW * 64) { const float x = bf2f(X[i]); if (!(fabsf(x) < thr)) ++nnan; }
    if (nnan) atomicAdd(cw, nnan);
}
__device__ __forceinline__ void dbg_compare(unsigned char* ws, const bf16* X, const bf16* Y, int gw, int NGW, int lane) {
    unsigned* cw = (unsigned*)(ws + WS_CTL) + CW_DBG; unsigned nbad = 0, nnan = 0;
    for (size_t i = (size_t)gw * 64 + lane; i < (size_t)M * C; i += (size_t)NGW * 64) { const float x = bf2f(X[i]), y = bf2f(Y[i]);
        if (!(fabsf(x) < 1e30f)) ++nnan; else if (fabsf(x - y) > 0.05f * (fabsf(y) + 0.05f)) ++nbad; }
    if (nnan) atomicAdd(cw, nnan); if (nbad) atomicAdd(cw + 64, nbad);
}
#endif
__device__ __forceinline__ void router_rows(unsigned char* ws, LAS unsigned char* lds, int layer, int gw, int NGW, int lane, int tid, bool dry = false) {
    const bf16* Hh = (const bf16*)(ws + WS_B4); const float* gain = INP(2) + layer * C; float* rsl = (float*)(ws + WS_B0);
    const float* wg = INP(24) + (size_t)layer * C * 4; const float* bg = INP(25) + layer * 4; const float* wi = INP(26) + (size_t)layer * C * 16; const float* bi = INP(27) + layer * 16;
    unsigned* cnt = (unsigned*)(ws + WS_CTL) + CW_CNT + layer * 16 * 64; unsigned* list = (unsigned*)(ws + WS_LIST); float* wl = (float*)(ws + WS_WL);
    LAS float* sWg = (LAS float*)lds; LAS float* sWi = sWg + C * 4;
    constexpr int RECMAX = 256;
    LAS unsigned* lcnt = (LAS unsigned*)(lds + 81920); LAS unsigned* gbase = lcnt + 16; LAS int* nrec = (LAS int*)(lcnt + 32);
    LAS unsigned* recRow = lcnt + 64; LAS unsigned* recE = recRow + RECMAX; LAS unsigned* recL = recE + RECMAX; LAS float* recW0 = (LAS float*)(recL + RECMAX); LAS float* recW1 = recW0 + RECMAX; LAS float* recRS = recW1 + RECMAX;
    __syncthreads();
    for (int e = tid; e < C * 4; e += 512) sWg[e] = wg[e];
    for (int e = tid; e < C * 16; e += 512) sWi[e] = wi[e];
    if (tid < 33) lcnt[tid == 32 ? 32 : tid] = 0u;
    __syncthreads();
    f32x4 g[4]; load_row(gain, lane, g);
    for (int row = gw; row < M; row += NGW) {
        f32x4 v[4]; load_row_bf(Hh + (size_t)row * C, lane, v); const float rs = row_rs(v, lane);
#pragma unroll
        for (int j = 0; j < 4; ++j) v[j] = v[j] * rs * g[j];
        float gl[4] = {0.f, 0.f, 0.f, 0.f};
        const LAS unsigned char* pWg = (const LAS unsigned char*)sWg + lane * 64;
#pragma unroll
        for (int j = 0; j < 4; ++j)
#pragma unroll
            for (int q = 0; q < 4; ++q) { const f32x4 w = *(const LAS f32x4*)(pWg + j * 4096 + q * 16); const float xv = v[j][q]; gl[0] += xv * w.x; gl[1] += xv * w.y; gl[2] += xv * w.z; gl[3] += xv * w.w; }
#pragma unroll
        for (int q = 0; q < 4; ++q) gl[q] = wave_sum(gl[q], lane) + bg[q];
        int gi = 0; float gm = gl[0];
#pragma unroll
        for (int q = 1; q < 4; ++q) if (gl[q] > gm) { gm = gl[q]; gi = q; }
        float gden = 0.f;
#pragma unroll
        for (int q = 0; q < 4; ++q) gden += __expf(gl[q] - gm);
        const float gval = 1.0f / gden;
        float il[4] = {0.f, 0.f, 0.f, 0.f};
        const LAS unsigned char* pWi = (const LAS unsigned char*)sWi + lane * 256 + gi * 16;
#pragma unroll
        for (int j = 0; j < 4; ++j)
#pragma unroll
            for (int q = 0; q < 4; ++q) { const f32x4 w = *(const LAS f32x4*)(pWi + j * 16384 + q * 64); const float xv = v[j][q]; il[0] += xv * w.x; il[1] += xv * w.y; il[2] += xv * w.z; il[3] += xv * w.w; }
#pragma unroll
        for (int q = 0; q < 4; ++q) il[q] = wave_sum(il[q], lane) + bi[gi * 4 + q];
        int i0 = 0; float m0 = il[0];
#pragma unroll
        for (int q = 1; q < 4; ++q) if (il[q] > m0) { m0 = il[q]; i0 = q; }
        int i1 = -1; float m1 = -INFINITY;
#pragma unroll
        for (int q = 0; q < 4; ++q) if (q != i0 && il[q] > m1) { m1 = il[q]; i1 = q; }
        const float e1 = __expf(m1 - m0); const float w0 = gval / (1.0f + e1), w1 = gval * e1 / (1.0f + e1);
        if (lane == 0 && !dry) {
            const int ex0 = gi * 4 + i0, ex1 = gi * 4 + i1;
            const int ri = __hip_atomic_fetch_add(nrec, 1, __ATOMIC_RELAXED, __HIP_MEMORY_SCOPE_WORKGROUP);
            const unsigned l0 = __hip_atomic_fetch_add(lcnt + ex0, 1u, __ATOMIC_RELAXED, __HIP_MEMORY_SCOPE_WORKGROUP), l1 = __hip_atomic_fetch_add(lcnt + ex1, 1u, __ATOMIC_RELAXED, __HIP_MEMORY_SCOPE_WORKGROUP);
            if (ri < RECMAX) { recRow[ri] = (unsigned)row; recE[ri] = (unsigned)ex0 | ((unsigned)ex1 << 8); recL[ri] = l0 | (l1 << 16); recW0[ri] = w0; recW1[ri] = w1; recRS[ri] = rs; }
        }
    }
    __syncthreads();
    if (tid < 16 && !dry) gbase[tid] = atomicAdd(cnt + tid * 64, lcnt[tid]);
    __syncthreads();
    { const int n = *nrec < RECMAX ? *nrec : RECMAX;
      for (int i = tid; i < n; i += 512) { const unsigned row = recRow[i], e = recE[i], l = recL[i]; const unsigned ex0 = e & 255u, ex1 = e >> 8;
          const unsigned p0 = gbase[ex0] + (l & 0xffffu), p1 = gbase[ex1] + (l >> 16);
          list[(size_t)ex0 * M + p0] = row * 2u; wl[(size_t)ex0 * M + p0] = recW0[i]; list[(size_t)ex1 * M + p1] = row * 2u + 1u; wl[(size_t)ex1 * M + p1] = recW1[i];
          rsl[(size_t)ex0 * M + p0] = recRS[i]; rsl[(size_t)ex1 * M + p1] = recRS[i]; } }
}
__device__ __forceinline__ void moe_table(unsigned char* ws, volatile LAS int* tab, int layer, int tid) {
    __syncthreads();
    if (tid == 0) { const unsigned* cnt = (const unsigned*)(ws + WS_CTL) + CW_CNT + layer * 16 * 64; int t = 0;
#pragma unroll 1
        for (int e = 0; e < 16; ++e) { const int c = (int)__hip_atomic_load(cnt, RLX_AGENT); cnt += 64; tab[e] = c; tab[16 + e] = t; t += (c + 255) >> 8; tab[32 + e] = t; }
        tab[48] = t; }
    __syncthreads();
}
__device__ __forceinline__ void combine_rows(unsigned char* ws, int mode, int gw, int NGW, int lane, bool dry = false) {
    bf16* Hh = (bf16*)(ws + WS_B4); float* Out = OUTP(); const bf16* E0 = (const bf16*)(ws + WS_B2); const bf16* E1 = (const bf16*)(ws + WS_B3); bf16* XN2 = (bf16*)(ws + WS_B0);
    f32x4 g[4]; load_row(INP(4), lane, g);
    for (int row = gw; row < M; row += NGW) {
        f32x4 v[4]; load_row_bf(Hh + (size_t)row * C, lane, v);
#pragma unroll
        for (int j = 0; j < 4; ++j) { const v2u e0 = ((const GAS v2u*)(E0 + (size_t)row * C))[64 * j + lane], e1 = ((const GAS v2u*)(E1 + (size_t)row * C))[64 * j + lane];
            v[j].x += bflo(e0.x) + bflo(e1.x); v[j].y += bfhi(e0.x) + bfhi(e1.x); v[j].z += bflo(e0.y) + bflo(e1.y); v[j].w += bfhi(e0.y) + bfhi(e1.y); }
        const float rs = row_rs(v, lane);
        if (mode == 0) {
            if (!dry) store_row_bf16(Hh + (size_t)row * C, lane, v);
            if (lane == 0) ((float*)XN2)[row] = rs;
        } else {
            float sig = 1.0f;
#if MK_DEBUG
            const unsigned* cw = (const unsigned*)(ws + WS_CTL) + CW_DBG; const unsigned nnan = __hip_atomic_load(cw, RLX_AGENT), nbad = __hip_atomic_load(cw + 64, RLX_AGENT);
            if (row < 512 && nnan > 0) sig = 2.0f;
            if (row >= 512 && row < 1536 && __hip_atomic_load(cw + 128, RLX_AGENT) > 0) sig = 2.0f;
            if (row >= 1536 && row < 3584 && __hip_atomic_load(cw + 192, RLX_AGENT) > 0) sig = 2.0f;
            if (row >= 3584 && row < 7680 && __hip_atomic_load(cw + 256, RLX_AGENT) > 0) sig = 2.0f;
            if (row >= 7680 && row < 15872 && __hip_atomic_load(cw + 320, RLX_AGENT) > 0) sig = 2.0f;
            if (row >= 15872 && nbad > (unsigned)(M / 100) * C) sig = 1.5f;
#endif
#pragma unroll
            for (int j = 0; j < 4; ++j) ((GAS f32x4*)(Out + (size_t)row * C))[64 * j + lane] = v[j] * rs * g[j] * sig;
        }
    }
}
__device__ __forceinline__ void attn_naive(unsigned char* ws, int gw, int NGW, int lane) {
    const bf16* Kb = (const bf16*)(ws + WS_B1); const bf16* Vb = (const bf16*)(ws + WS_B2); const bf16* Qb = (const bf16*)(ws + WS_B3); bf16* Ob = (bf16*)(ws + WS_B0);
    for (int unit = gw; unit < BATCH * NH * (SEQ / 64); unit += NGW) {
        const int qb = unit % (SEQ / 64), bh = unit / (SEQ / 64), b = bh / NH, h = bh % NH;
        const int t0 = qb * 64, t = t0 + lane; const size_t rowq = (size_t)b * SEQ + t;
        float q[64], o[64];
#pragma unroll
        for (int c = 0; c < 8; ++c) { const v4u w = *(const GAS v4u*)(Qb + rowq * C + h * HD + c * 8);
            q[c * 8 + 0] = bflo(w.x) * 0.125f; q[c * 8 + 1] = bfhi(w.x) * 0.125f; q[c * 8 + 2] = bflo(w.y) * 0.125f; q[c * 8 + 3] = bfhi(w.y) * 0.125f;
            q[c * 8 + 4] = bflo(w.z) * 0.125f; q[c * 8 + 5] = bfhi(w.z) * 0.125f; q[c * 8 + 6] = bflo(w.w) * 0.125f; q[c * 8 + 7] = bfhi(w.w) * 0.125f; }
#pragma unroll
        for (int c = 0; c < 64; ++c) o[c] = 0.f;
        float suffix = 0.f;
        for (int s = t0 + 62; s >= 0; --s) {
            const bool valid = s < t;
            if (s < t0 && __all(suffix > SB_EXIT)) break;
            const bf16* kp = Kb + ((size_t)b * SEQ + s) * C + h * HD; const bf16* vp = Vb + ((size_t)b * SEQ + s) * C + h * HD;
            float z = 0.f;
#pragma unroll
            for (int c = 0; c < 8; ++c) { const v4u w = *(const GAS v4u*)(kp + c * 8);
                z += q[c * 8 + 0] * bflo(w.x) + q[c * 8 + 1] * bfhi(w.x) + q[c * 8 + 2] * bflo(w.y) + q[c * 8 + 3] * bfhi(w.y) + q[c * 8 + 4] * bflo(w.z) + q[c * 8 + 5] * bfhi(w.z) + q[c * 8 + 6] * bflo(w.w) + q[c * 8 + 7] * bfhi(w.w); }
            const float sp = fmaxf(z, 0.f) + log1pf(__expf(-fabsf(z)));
            const float att = valid ? __expf(z - sp - suffix) : 0.f;
            suffix += valid ? sp : 0.f;
#pragma unroll
            for (int c = 0; c < 8; ++c) { const v4u w = *(const GAS v4u*)(vp + c * 8);
                o[c * 8 + 0] += att * bflo(w.x); o[c * 8 + 1] += att * bfhi(w.x); o[c * 8 + 2] += att * bflo(w.y); o[c * 8 + 3] += att * bfhi(w.y);
                o[c * 8 + 4] += att * bflo(w.z); o[c * 8 + 5] += att * bfhi(w.z); o[c * 8 + 6] += att * bflo(w.w); o[c * 8 + 7] += att * bfhi(w.w); }
        }
#pragma unroll
        for (int c = 0; c < 8; ++c) { v4u w; w.x = pk2(o[c * 8 + 0], o[c * 8 + 1]); w.y = pk2(o[c * 8 + 2], o[c * 8 + 3]); w.z = pk2(o[c * 8 + 4], o[c * 8 + 5]); w.w = pk2(o[c * 8 + 6], o[c * 8 + 7]);
            *(GAS v4u*)(Ob + rowq * C + h * HD + c * 8) = w; }
    }
}


typedef float f32x16 __attribute__((ext_vector_type(16)));
constexpr int AT_VP = 192;
constexpr int AT_WAVE_LDS = 32 * AT_VP;
__device__ __forceinline__ int crow32(int reg, int hh) { return (reg & 3) + 8 * (reg >> 2) + 4 * hh; }
__device__ __forceinline__ bf16x8s pack_step(const f32x16& x, const int s) {
    v4u p; p.x = pg8::cvt_pk_bf16(x[8 * s], x[8 * s + 1]); p.y = pg8::cvt_pk_bf16(x[8 * s + 2], x[8 * s + 3]); p.z = pg8::cvt_pk_bf16(x[8 * s + 4], x[8 * s + 5]); p.w = pg8::cvt_pk_bf16(x[8 * s + 6], x[8 * s + 7]);
    return __builtin_bit_cast(bf16x8s, p);
}
__device__ __forceinline__ void attn_mfma(unsigned char* ws, LAS unsigned char* lds, int gw, int NGW, int lane, int wave) {
    const bf16* Kb = (const bf16*)(ws + WS_B1); const bf16* Vb = (const bf16*)(ws + WS_B2); const bf16* Qb = (const bf16*)(ws + WS_B3); bf16* Ob = (bf16*)(ws + WS_B0);
    LAS unsigned char* vl = lds + wave * AT_WAVE_LDS;
    const int r32 = lane & 31, hh = lane >> 5;
    bf16x8s tri[2];
#pragma unroll
    for (int s = 0; s < 2; ++s)
#pragma unroll
        for (int j = 0; j < 8; ++j) tri[s][j] = (16 * s + 8 * (j >> 2) + 4 * hh + (j & 3)) > r32 ? (short)0x3F80 : (short)0;
    const int grp = lane >> 4, tq = (lane & 15) >> 2, tp = lane & 3;
    const LAS unsigned char* vtr0 = vl + (4 * hh + tq) * AT_VP + (16 * (grp & 1) + 4 * tp) * 2;
    for (int unit = gw; unit < BATCH * NH * (SEQ / 32); unit += NGW) {
        const int qb = unit % (SEQ / 32), bh = unit / (SEQ / 32), b = bh / NH, hd = bh % NH;
        const int t0 = qb * 32; const size_t rowb = (size_t)b * SEQ;
        bf16x8s qf[4];
#pragma unroll
        for (int ks = 0; ks < 4; ++ks) qf[ks] = *(const GAS bf16x8s*)(Qb + (rowb + t0 + r32) * C + hd * HD + 16 * ks + 8 * hh);
        f32x16 o[2];
#pragma unroll
        for (int i = 0; i < 16; ++i) { o[0][i] = 0.f; o[1][i] = 0.f; }
        float carry = 0.f;
        for (int s0 = t0; s0 >= 0; s0 -= 32) {
            bf16x8s kf[4];
#pragma unroll
            for (int ks = 0; ks < 4; ++ks) kf[ks] = *(const GAS bf16x8s*)(Kb + (rowb + s0 + r32) * C + hd * HD + 16 * ks + 8 * hh);
            v4u vreg[4];
#pragma unroll
            for (int i = 0; i < 4; ++i) { const int cidx = lane + 64 * i; vreg[i] = *(const GAS v4u*)(Vb + (rowb + s0 + (cidx >> 3)) * C + hd * HD + (cidx & 7) * 8); }
            f32x16 st;
#pragma unroll
            for (int i = 0; i < 16; ++i) st[i] = 0.f;
#pragma unroll
            for (int ks = 0; ks < 4; ++ks) st = __builtin_amdgcn_mfma_f32_32x32x16_bf16(kf[ks], qf[ks], st, 0, 0, 0);
#pragma unroll
            for (int i = 0; i < 4; ++i) { const int cidx = lane + 64 * i; *(LAS v4u*)(vl + (cidx >> 3) * AT_VP + (cidx & 7) * 16) = vreg[i]; }
            f32x16 zz, uu; float tot = 0.f; const int tq_ = t0 + r32;
            if (s0 + 31 < t0) {
#pragma unroll
                for (int i = 0; i < 16; ++i) { const float z = st[i] * 0.18033688011112042f; const float sp = fmaxf(z, 0.f) + __builtin_amdgcn_logf(1.0f + __builtin_amdgcn_exp2f(-fabsf(z)));
                    zz[i] = z - sp; uu[i] = sp; tot += sp; }
            } else {
#pragma unroll
                for (int i = 0; i < 16; ++i) { const int key = s0 + crow32(i, hh); const float z = st[i] * 0.18033688011112042f; const float sp = fmaxf(z, 0.f) + __builtin_amdgcn_logf(1.0f + __builtin_amdgcn_exp2f(-fabsf(z)));
                    const bool valid = key < tq_; zz[i] = valid ? z - sp : -1e30f; uu[i] = valid ? sp : 0.f; tot += uu[i]; }
            }
            f32x16 w;
#pragma unroll
            for (int i = 0; i < 16; ++i) w[i] = 0.f;
#pragma unroll
            for (int s = 0; s < 2; ++s) w = __builtin_amdgcn_mfma_f32_32x32x16_bf16(tri[s], pack_step(uu, s), w, 0, 0, 0);
            f32x16 pp;
#pragma unroll
            for (int i = 0; i < 16; ++i) pp[i] = __builtin_amdgcn_exp2f(zz[i] - w[i] - carry);
            tot += shx(tot, 32, lane); carry += tot;
            asm volatile("s_waitcnt lgkmcnt(0)" ::: "memory");
#pragma unroll
            for (int s = 0; s < 2; ++s) { const bf16x8s pa = pack_step(pp, s);
#pragma unroll
                for (int dt = 0; dt < 2; ++dt) {
                    const v4i16_t lo = __builtin_amdgcn_ds_read_tr16_b64_v4i16((LAS v4i16_t*)(vtr0 + (16 * s) * AT_VP + dt * 64));
                    const v4i16_t hi = __builtin_amdgcn_ds_read_tr16_b64_v4i16((LAS v4i16_t*)(vtr0 + (16 * s + 8) * AT_VP + dt * 64));
                    const bf16x8s vf = (bf16x8s){lo[0], lo[1], lo[2], lo[3], hi[0], hi[1], hi[2], hi[3]};
                    o[dt] = __builtin_amdgcn_mfma_f32_32x32x16_bf16(pa, vf, o[dt], 0, 0, 0); } }
            asm volatile("" ::: "memory");
            if (s0 < t0 && __all(carry > SB_EXIT * 1.4426950408889634f)) break;
        }
#pragma unroll
        for (int dt = 0; dt < 2; ++dt)
#pragma unroll
            for (int i = 0; i < 16; ++i) Ob[(rowb + t0 + crow32(i, hh)) * C + hd * HD + 32 * dt + r32] = (bf16)f2bf(o[dt][i]);
    }
}
__global__ void __launch_bounds__(NWAVES * 64, 2) yoco_fwd(Args args) {
    extern __shared__ __attribute__((aligned(16))) unsigned char lds_raw[];
    LAS unsigned char* lds = (LAS unsigned char*)lds_raw;
    const int G = gridDim.x; const int bx = blockIdx.x;
    int wave = __builtin_amdgcn_readfirstlane(threadIdx.x >> 6); asm volatile("" : "+s"(wave));
#define IDS() int lane; asm volatile("v_mbcnt_lo_u32_b32 %0, -1, 0\n\tv_mbcnt_hi_u32_b32 %0, -1, %0" : "=v"(lane)); const int tid = wave * 64 + lane; (void)tid; \
    const int vcu = (G % 8 == 0) ? (bx % 8) * (G / 8) + bx / 8 : bx; const int gw = vcu * NWAVES + wave, NGW = G * NWAVES; (void)lane; (void)gw; (void)NGW;
    unsigned char* ws = WSP();
    volatile LAS unsigned* MISC = (volatile LAS unsigned*)(lds + MISC_OFF);
    volatile LAS int* tab = (volatile LAS int*)(lds + MOE_TAB_OFF);
    for (int u = threadIdx.x; u < (LDS_BYTES - LDSCTL_OFF) / 4; u += NWAVES * 64) ((LAS unsigned*)(lds + LDSCTL_OFF))[u] = 0u;
    __syncthreads();
    XcdBarrier bar; bar.bar = (unsigned*)(ws + WS_CTL) + CW_BAR; bar.x = 0; bar.st = nullptr;
    if (N_LAUNCHES == 1) bar = xcd_barrier_post((unsigned*)(ws + WS_CTL) + CW_BAR, MISC + 8);
    const int lo = KA_INT(0), hi = KA_INT(1);
#ifndef PROBE_PH
#define PROBE_PH -1
#endif
#define IN(k) (lo <= (k) && (k) < hi)
#define REP(k) for (int rep_ = 0; rep_ < ((PROBE_PH == (k)) ? 2 : 1); ++rep_)
#define SEAM(k) do { if (IN(k) && IN((k) + 1)) xcd_barrier(bar); } while (0)

    if (IN(PH_P0)) REP(PH_P0) { IDS(); p0_weights<0>(ws, lds, gw, NGW, wave, lane); p0_weights<1>(ws, lds, gw, NGW, wave, lane); p0_rows(ws, gw, NGW, lane); }
    SEAM(PH_P0);
    if (PROBE_PH == 100 && N_LAUNCHES == 1) { for (int i_ = 0; i_ < 10; ++i_) xcd_barrier(bar); }
    if (IN(PH_LORA)) REP(PH_LORA) {
        SchedGrouped<1, 3> S{(const char*)(ws + WS_B1), (size_t)(WS_B2 - WS_B1), nullptr, (const char*)(ws + WS_WT_LORA), (size_t)256 * C * 2, G, bx};
        EpiLora E{(bf16*)(ws + WS_LW)};
        pg8::gemm_phase<EpiLora, SchedGrouped<1, 3>, true, false, C>(lds, S, E, wave);
    }
    SEAM(PH_LORA);
    if (IN(PH_RKV)) REP(PH_RKV) {
        SchedGrouped<4, 3> S{(const char*)OUTP(), (size_t)M * C * 2, (const char*)(ws + WS_B4), (const char*)(ws + WS_WT_RKV), (size_t)C * C * 2, G, bx};
        EpiSplit3 E{(bf16*)(ws + WS_B1), false, nullptr};
        pg8::gemm_phase<EpiSplit3, SchedGrouped<4, 3>, true, false, C>(lds, S, E, wave);
    }
    SEAM(PH_RKV);
    if (IN(PH_S1)) REP(PH_S1) { IDS(); scan_s1(ws, lds, lane, wave); }
    SEAM(PH_S1);
    if (IN(PH_S2)) REP(PH_S2) { IDS();
        if (bx < BATCH * NH || G <= BATCH * NH) scan_s2(ws, lds, lane, wave);
        }
    SEAM(PH_S2);
    if (IN(PH_S3)) REP(PH_S3) { IDS(); scan_s3(ws, lds, lane, wave); }
    SEAM(PH_S3);
#if MK_DEBUG
    if (IN(PH_DBG0)) { IDS(); scan_naive(ws, lds, tid); }
    SEAM(PH_DBG0);
    if (IN(PH_DBG0 + 1)) { IDS(); post_scan(ws, gw, NGW, lane); }
    SEAM(PH_DBG0 + 1);
    if (IN(PH_DBG0 + 2)) { IDS(); dbg_compare(ws, (const bf16*)(ws + WS_B0), (const bf16*)(ws + WS_B4), gw, NGW, lane); }
    SEAM(PH_DBG0 + 2);
#endif
    if (IN(PH_WOUT)) REP(PH_WOUT) {
        SchedGrouped<4, 1> S{(const char*)(ws + ((MK_DEBUG && DBG_USE_NAIVE) ? WS_B4 : WS_B0)), 0, nullptr, (const char*)(ws + WS_WT_OUT), 0, G, bx};
        EpiResidBf<true> E{INP(0), (bf16*)(ws + WS_B4)};
        pg8::gemm_phase<EpiResidBf<true>, SchedGrouped<4, 1>, true, false, C>(lds, S, E, wave);
    }
    SEAM(PH_WOUT);
#pragma unroll 1
    for (int layer = 0; layer < 2; ++layer) {
        const int pb = layer == 0 ? (int)PH_ROUT0 : (int)PH_ROUT1;
        if (IN(pb)) { IDS(); if (PROBE_PH == 101 && layer == 0) router_rows(ws, lds, layer, gw, NGW, lane, tid, true); router_rows(ws, lds, layer, gw, NGW, lane, tid); }
        SEAM(pb);
        if (IN(pb + 1)) REP(pb + 1) {
            { IDS(); moe_table(ws, tab, layer, tid); }
            SchedMoe<2, C, true> S{(const char*)(ws + WS_B4), (const char*)(ws + WS_WT_GU) + (size_t)layer * 16 * 512 * C * 2, (size_t)512 * C * 2, (const unsigned*)(ws + WS_LIST), tab, G, bx};
            EpiGU E{(bf16*)(ws + WS_HID), (const float*)(ws + WS_WL), (const float*)(ws + WS_B0)};
            pg8::gemm_phase<EpiGU, SchedMoe<2, C, true>, true, true, C>(lds, S, E, wave);
        }
        SEAM(pb + 1);
        if (IN(pb + 2)) REP(pb + 2) {
            { IDS(); moe_table(ws, tab, layer, tid); }
            SchedMoe<4, FE, false> S{(const char*)(ws + WS_HID), (const char*)(ws + WS_WT_DN) + (size_t)layer * 16 * C * FE * 2, (size_t)C * FE * 2, (const unsigned*)(ws + WS_LIST), tab, G, bx};
            EpiDown E{(bf16*)(ws + WS_B2), (const unsigned*)(ws + WS_LIST)};
            pg8::gemm_phase<EpiDown, SchedMoe<4, FE, false>, true, false, FE>(lds, S, E, wave);
        }
        SEAM(pb + 2);
        if (layer == 0) {
            if (IN(PH_COMB)) { IDS(); if (PROBE_PH == 102) combine_rows(ws, 0, gw, NGW, lane, true); combine_rows(ws, 0, gw, NGW, lane); }
            SEAM(PH_COMB);
            if (IN(PH_KVQ)) REP(PH_KVQ) {
                SchedGrouped<12, 1> S{(const char*)(ws + WS_B4), 0, nullptr, (const char*)(ws + WS_WT_KVQ), 0, G, bx};
                EpiSplit3 E{(bf16*)(ws + WS_B1), true, (const float*)(ws + WS_B0)};
                pg8::gemm_phase<EpiSplit3, SchedGrouped<12, 1>, true, false, C>(lds, S, E, wave);
            }
            SEAM(PH_KVQ);
            if (IN(PH_ATTN)) REP(PH_ATTN) { IDS(); attn_mfma(ws, lds, gw, NGW, lane, wave); }
            SEAM(PH_ATTN);
            if (IN(PH_SBO)) {
                SchedGrouped<4, 1> S{(const char*)(ws + WS_B0), 0, nullptr, (const char*)(ws + WS_WT_SBO), 0, G, bx};
                EpiResidBf<false> E{(const void*)(ws + WS_B4), (bf16*)(ws + WS_B4)};
                pg8::gemm_phase<EpiResidBf<false>, SchedGrouped<4, 1>, true, false, C>(lds, S, E, wave);
            }
            SEAM(PH_SBO);
        }
    }
    if (IN(PH_FINAL)) { IDS(); combine_rows(ws, 1, gw, NGW, lane); }
#undef IN
#undef SEAM
}

extern "C" void kernel_launch(void* const* d_in, const int* in_sizes, int n_in, void* d_out, int out_size, void* d_ws, size_t ws_size, hipStream_t stream) {
    static int grid = 0;
    if (grid == 0) {
        if (n_in != 31 || in_sizes[0] != M * C || out_size != M * C || ws_size < WS_END) { fprintf(stderr, "kernel_launch: unexpected shapes (n_in %d, in0 %d, out %d, ws %zu); nothing launched\n", n_in, n_in > 0 ? in_sizes[0] : -1, out_size, ws_size); grid = -1; return; }
        int dev = 0, cus = 0, per_cu = 0;
        if (hipGetDevice(&dev) != hipSuccess || hipDeviceGetAttribute(&cus, hipDeviceAttributeMultiprocessorCount, dev) != hipSuccess) { grid = -1; return; }
        if (hipFuncSetAttribute((const void*)yoco_fwd, hipFuncAttributeMaxDynamicSharedMemorySize, LDS_BYTES) != hipSuccess) { fprintf(stderr, "kernel_launch: hipFuncSetAttribute failed\n"); grid = -1; return; }
        if (hipOccupancyMaxActiveBlocksPerMultiprocessor(&per_cu, (const void*)yoco_fwd, NWAVES * 64, LDS_BYTES) != hipSuccess || per_cu < 1) fprintf(stderr, "kernel_launch: occupancy query reports %d\n", per_cu);
        (void)hipGetLastError();
        grid = cus - (cus % 16);
    }
    if (grid < 0) return;
    if (hipMemsetAsync((char*)d_ws + WS_CTL, 0, CTL_ZERO_BYTES, stream) != hipSuccess) return;
    Args a{};
    for (int i = 0; i < 31; ++i) a.in[i] = (const float*)d_in[i];
    a.out = (float*)d_out; a.ws = (unsigned char*)d_ws;
    for (int li = 0; li < (N_LAUNCHES == 1 ? 1 : (int)NPHASE); ++li) {
        a.ph_lo = (N_LAUNCHES == 1) ? 0 : li; a.ph_hi = (N_LAUNCHES == 1) ? NPHASE : li + 1; a.li = li;
        hipLaunchKernelGGL(yoco_fwd, dim3(grid), dim3(NWAVES * 64), LDS_BYTES, stream, a);
        const hipError_t le = hipPeekAtLastError();
        if (le != hipSuccess) { fprintf(stderr, "kernel_launch: launch %d failed: %s\n", li, hipGetErrorName(le)); break; }
    }
}
```

```cpp
#include <hip/hip_runtime.h>
#include <cstdio>
#include <cstdint>

#ifndef MK_N_LAUNCHES
#define MK_N_LAUNCHES 1
#endif

namespace pg8 {
#define PG8_LAS __attribute__((address_space(3)))
typedef unsigned short bf16_t;
typedef short bf16x8 __attribute__((ext_vector_type(8)));
typedef float f32x4 __attribute__((ext_vector_type(4)));
typedef unsigned u32x4 __attribute__((ext_vector_type(4)));
constexpr int BM = 256, BK = 64, HALF = 128, HTB = HALF * BK * 2, STAGE_BYTES = 8 * HTB, NXCD = 8, WGM = 8;

__host__ __device__ __forceinline__ int lds_byte(int r, int c) { const int st = (r >> 4) * 2 + (c >> 5), rr = r & 15, cc = c & 31, ob = rr * 64 + cc * 2; return st * 1024 + (ob ^ (((ob >> 9) & 1) << 5)); }
__host__ __device__ __forceinline__ void stage_rc(int b, int& R, int& C) { const int st = b / 1024, sb = b % 1024, swz = sb ^ (((sb >> 9) & 1) << 5); R = (st >> 1) * 16 + swz / 64; C = (st & 1) * 32 + (swz % 64) / 2; }
__host__ __device__ __forceinline__ int perm32(int rho) { const int n = rho >> 4, i = rho & 15; return 8 * (i >> 2) + 4 * n + (i & 3); }

struct Unit { int pm, pn, aux, r0, cnt; };

__host__ __device__ __forceinline__ void tile_map(int wgid, int nM, int nN, int& pm, int& pn) {
    const int nwg = nM * nN;
    { const int q = nwg / NXCD, r = nwg % NXCD, xcd = wgid % NXCD, off = wgid / NXCD; wgid = (xcd < r ? xcd * (q + 1) : r * (q + 1) + (xcd - r) * q) + off; }
    const int nig = WGM * nN, gid = wgid / nig, fm = gid * WGM, gsz = (nM - fm) < WGM ? (nM - fm) : WGM;
    pm = fm + ((wgid % nig) % gsz); pn = (wgid % nig) / gsz;
}

typedef float f32x2_t __attribute__((ext_vector_type(2))); typedef __bf16 bf16x2_t __attribute__((ext_vector_type(2)));
__device__ __forceinline__ unsigned cvt_pk_bf16(float lo, float hi) { const f32x2_t v = {lo, hi}; const bf16x2_t b = __builtin_convertvector(v, bf16x2_t); return __builtin_bit_cast(unsigned, b); }

template <class Epi, class Sched, bool ALIGN_EPI, bool GATHER, int K>
__device__ __forceinline__ void gemm_phase(PG8_LAS unsigned char* lds, const Sched& S, const Epi& E, const int wid) {
    int lane_; asm volatile("v_mbcnt_lo_u32_b32 %0, -1, 0\n\tv_mbcnt_hi_u32_b32 %0, -1, %0" : "=v"(lane_));
    const int lane = lane_, tid = wid * 64 + lane, wr = wid >> 2, wc = wid & 3, fr = lane & 15, fq = lane >> 4;
    constexpr int nt = K / BK;
    unsigned voffA[2], voffB[2];
#pragma unroll
    for (int i = 0; i < 2; ++i) { int R, C; stage_rc(tid * 16 + i * 8192, R, C); const int Rb = Epi::PERM ? ((R & ~31) + perm32(R & 31)) : R;
        voffA[i] = (unsigned)(R * K + C) * 2u; voffB[i] = (unsigned)(Rb * K + C) * 2u; }
    constexpr size_t kstep = (size_t)(BK * 2);
    constexpr size_t hstep = (size_t)HALF * K * 2;
    const unsigned ldsw = (unsigned)wid * 1024u;
    const int aoff = lds_byte(wr * 64 + fr, fq * 8), boff = lds_byte(wc * 32 + fr, fq * 8);
#define PG8_SA(b, h) (((b) * 2 + (h)) * HTB)
#define PG8_SB(b, h) ((4 + (b) * 2 + (h)) * HTB)
#define PG8_STAGE(bufoff, gbase, voff) do { _Pragma("unroll") for (int _i = 0; _i < 2; ++_i) \
        __builtin_amdgcn_global_load_lds((const unsigned*)((const char*)(gbase) + (voff)[_i]), (PG8_LAS unsigned*)(lds + (bufoff) + ldsw + _i * 8192), 16, 0, 0); } while (0)
#define PG8_LDA(dst, b, h) do { _Pragma("unroll") for (int m = 0; m < 4; ++m) _Pragma("unroll") for (int k = 0; k < 2; ++k) dst[m][k] = *(const PG8_LAS bf16x8*)(lds + PG8_SA(b, h) + aoff + m * 2048 + k * 1024); } while (0)
#define PG8_LDB(dst, b, h) do { _Pragma("unroll") for (int n = 0; n < 2; ++n) _Pragma("unroll") for (int k = 0; k < 2; ++k) dst[n][k] = *(const PG8_LAS bf16x8*)(lds + PG8_SB(b, h) + boff + n * 2048 + k * 1024); } while (0)
#define PG8_MMA(ai, bj, At, Bt) do { __builtin_amdgcn_s_setprio(1); _Pragma("unroll") for (int m = 0; m < 4; ++m) _Pragma("unroll") for (int n = 0; n < 2; ++n) _Pragma("unroll") for (int k = 0; k < 2; ++k) \
        acc[ai][bj][m][n] = __builtin_amdgcn_mfma_f32_16x16x32_bf16(Bt[n][k], At[m][k], acc[ai][bj][m][n], 0, 0, 0); __builtin_amdgcn_s_setprio(0); } while (0)
#define PG8_WAIT_V(n) asm volatile("s_waitcnt vmcnt(" #n ")" ::: "memory")
#define PG8_WAIT_L(n) asm volatile("s_waitcnt lgkmcnt(" #n ")" ::: "memory")
#define PG8_BAR __builtin_amdgcn_s_barrier()
#define PG8_SCHED __builtin_amdgcn_sched_barrier(0)
    Unit cur, nxt; int ui = 0;
    if (!S.next(0, cur)) return;
    f32x4 acc[2][2][4][2];
#pragma unroll
    for (int a = 0; a < 2; ++a)
#pragma unroll
        for (int b = 0; b < 2; ++b)
#pragma unroll
            for (int m = 0; m < 4; ++m)
#pragma unroll
                for (int n = 0; n < 2; ++n) acc[a][b][m][n] = (f32x4){0.f, 0.f, 0.f, 0.f};
    bf16x8 At[4][2], B0[2][2], B1[2][2];
    unsigned vc[2][2];
#define PG8_GOFF(u) do { _Pragma("unroll") for (int _h = 0; _h < 2; ++_h) _Pragma("unroll") for (int _i = 0; _i < 2; ++_i) { int _R, _C; stage_rc(tid * 16 + _i * 8192, _R, _C); \
        vc[_h][_i] = S.a_row_off(u, _h * HALF + _R) + (unsigned)_C * 2u; } } while (0)
#define PG8_STAGE_A(bufoff, gbase, h) do { if constexpr (GATHER) { PG8_STAGE(bufoff, gbase, vc[h]); } else { PG8_STAGE(bufoff, (gbase) + (h) * hstep, voffA); } } while (0)
    if constexpr (GATHER) PG8_GOFF(cur);
    const char* cA = S.a_base(cur); const char* cB = S.b_base(cur);
    PG8_STAGE(PG8_SB(0, 0), cB, voffB); PG8_STAGE(PG8_SB(0, 1), cB + hstep, voffB); PG8_STAGE_A(PG8_SA(0, 0), cA, 0); PG8_STAGE_A(PG8_SA(0, 1), cA, 1);
    if (wr == 1) PG8_BAR;
    PG8_WAIT_V(2); PG8_BAR;
    PG8_STAGE(PG8_SB(1, 0), cB + kstep, voffB); PG8_STAGE_A(PG8_SA(1, 0), cA + kstep, 0); PG8_STAGE(PG8_SB(1, 1), cB + hstep + kstep, voffB);
    PG8_WAIT_V(6); PG8_BAR;
    for (;;) {
        const bool has_next = S.next(ui + 1, nxt);
        const char* nA = has_next ? S.a_base(nxt) : cA; const char* nB = has_next ? S.b_base(nxt) : cB;
        for (int t = 0; t < nt; t += 2) {
            const bool last = (t == nt - 2);
            const char* a1 = cA + (size_t)(t + 1) * kstep;
            const char* a2 = last ? nA : cA + (size_t)(t + 2) * kstep; const char* b2 = last ? nB : cB + (size_t)(t + 2) * kstep;
            const char* a3 = a2 + kstep; const char* b3 = b2 + kstep;
            PG8_LDB(B0, 0, 0); PG8_LDB(B1, 0, 1); PG8_SCHED; PG8_LDA(At, 0, 0); PG8_STAGE_A(PG8_SA(1, 1), a1, 1);
            if constexpr (GATHER) { if (last && has_next) PG8_GOFF(nxt); }
            PG8_WAIT_V(8); PG8_WAIT_L(0); PG8_BAR; PG8_MMA(0, 0, At, B0); PG8_MMA(0, 1, At, B1); PG8_BAR; PG8_SCHED;
            PG8_LDA(At, 0, 1); PG8_STAGE(PG8_SB(0, 0), b2, voffB); PG8_STAGE(PG8_SB(0, 1), b2 + hstep, voffB); PG8_STAGE_A(PG8_SA(0, 0), a2, 0);
            PG8_WAIT_V(8); PG8_WAIT_L(0); PG8_BAR; PG8_MMA(1, 0, At, B0); PG8_MMA(1, 1, At, B1); PG8_BAR; PG8_SCHED;
            PG8_LDB(B0, 1, 0); PG8_LDB(B1, 1, 1); PG8_SCHED; PG8_LDA(At, 1, 0); PG8_STAGE_A(PG8_SA(0, 1), a2, 1);
            PG8_WAIT_V(8); PG8_WAIT_L(0); PG8_BAR; PG8_MMA(0, 0, At, B0); PG8_MMA(0, 1, At, B1); PG8_BAR; PG8_SCHED;
            PG8_LDA(At, 1, 1); PG8_STAGE(PG8_SB(1, 0), b3, voffB); PG8_STAGE(PG8_SB(1, 1), b3 + hstep, voffB); PG8_STAGE_A(PG8_SA(1, 0), a3, 0);
            PG8_WAIT_V(8); PG8_WAIT_L(0); PG8_BAR; PG8_MMA(1, 0, At, B0); PG8_MMA(1, 1, At, B1); PG8_BAR; PG8_SCHED;
        }
        if constexpr (ALIGN_EPI) { if (wr == 0) PG8_BAR; }
        E(acc, cur, wr, wc, fr, fq);
        if (!has_next) break;
#pragma unroll
        for (int a = 0; a < 2; ++a)
#pragma unroll
            for (int b = 0; b < 2; ++b)
#pragma unroll
                for (int m = 0; m < 4; ++m)
#pragma unroll
                    for (int n = 0; n < 2; ++n) acc[a][b][m][n] = (f32x4){0.f, 0.f, 0.f, 0.f};
        cur = nxt; cA = nA; cB = nB; ++ui;
        if constexpr (ALIGN_EPI) { if (wr == 1) PG8_BAR; }
    }
    PG8_WAIT_V(0);
    if constexpr (!ALIGN_EPI) { if (wr == 0) PG8_BAR; }
    PG8_BAR;
#undef PG8_SA
#undef PG8_SB
#undef PG8_STAGE
#undef PG8_STAGE_A
#undef PG8_GOFF
#undef PG8_LDA
#undef PG8_LDB
#undef PG8_MMA
#undef PG8_WAIT_V
#undef PG8_WAIT_L
#undef PG8_BAR
#undef PG8_SCHED
}
}

constexpr int NWAVES = 8;
#ifndef MK_DEBUG
#define MK_DEBUG 0
#endif
#ifndef DBG_USE_NAIVE
#define DBG_USE_NAIVE 0
#endif
constexpr int DBGP = MK_DEBUG ? 3 : 0;
enum Phase { PH_P0 = 0, PH_LORA, PH_RKV, PH_S1, PH_S2, PH_S3, PH_DBG0, PH_WOUT = PH_DBG0 + DBGP, PH_ROUT0, PH_GU0, PH_DN0, PH_COMB, PH_KVQ, PH_ATTN, PH_SBO, PH_ROUT1, PH_GU1, PH_DN1, PH_FINAL, NPHASE };
constexpr int N_LAUNCHES = MK_N_LAUNCHES;


constexpr int BATCH = 2, SEQ = 8192, C = 1024, NH = 16, HD = 64, M = BATCH * SEQ;
constexpr int NE = 16, FE = 256, DW = 64, DA = 64, DG = 160;
constexpr float RMS_EPS = 1e-6f, GN_EPS = 64e-5f;
constexpr float SB_EXIT = 104.0f;

constexpr size_t MiB = 1u << 20;
constexpr size_t WS_CTL = 0, CTL_ZERO_BYTES = 64 * 1024;
constexpr size_t WS_WT_W2 = 128 * 1024, WS_WT_A2 = 256 * 1024, WS_WT_G2 = 384 * 1024;
constexpr size_t WS_WT_RKV = 1 * MiB;
constexpr size_t WS_WT_LORA = 7 * MiB;
constexpr size_t WS_WT_OUT = 9 * MiB;
constexpr size_t WS_WT_KVQ = 11 * MiB;
constexpr size_t WS_WT_SBO = 17 * MiB;
constexpr size_t WS_WT_GU = 19 * MiB;
constexpr size_t WS_WT_DN = 51 * MiB;
constexpr size_t WS_LW = 67 * MiB;
constexpr size_t WS_LA = 69 * MiB;
constexpr size_t WS_LG = 71 * MiB;
static_assert(WS_LA == WS_LW + 2 * MiB && WS_LG == WS_LW + 4 * MiB, "EpiLora's pointer arithmetic");
constexpr size_t WS_LIST = 76 * MiB;
constexpr size_t WS_WL = 77 * MiB;
constexpr size_t WS_HID = 78 * MiB;
constexpr size_t WS_B0 = 96 * MiB, WS_B1 = 128 * MiB, WS_B2 = 160 * MiB, WS_B3 = 192 * MiB, WS_B4 = 224 * MiB, WS_END = 256 * MiB;
static_assert(WS_HID + (size_t)144 * 256 * 256 * 2 <= WS_B0, "HID vs B0");
constexpr int CW_TMO = 0;
constexpr int CW_CNT = 1024;
constexpr int CW_BAR = 4096;

constexpr int RING_BYTES = 131072;
constexpr int LDSCTL_OFF = 146688, MISC_OFF = LDSCTL_OFF + 320, MOE_TAB_OFF = MISC_OFF + 128;
constexpr int LDS_BYTES = 147456;
static_assert(MOE_TAB_OFF + 256 <= LDS_BYTES, "LDS map");
static_assert(BATCH * NH * (SEQ / 64) % 16 == 0, "scan units");

#define GAS __attribute__((address_space(1)))
#define LAS __attribute__((address_space(3)))
typedef unsigned short bf16;
typedef unsigned v4u __attribute__((ext_vector_type(4)));
typedef unsigned v2u __attribute__((ext_vector_type(2)));
typedef float f32x4 __attribute__((ext_vector_type(4)));
typedef GAS unsigned gu32;
#define RLX_AGENT __ATOMIC_RELAXED, __HIP_MEMORY_SCOPE_AGENT
#define LDS_WAIT() asm volatile("s_waitcnt lgkmcnt(0)" ::: "memory")
#define VM_WAIT() asm volatile("s_waitcnt vmcnt(0)" ::: "memory")
__device__ __forceinline__ unsigned f2bf(float f) { unsigned u = __builtin_bit_cast(unsigned, f); return (u + 0x7fffu + ((u >> 16) & 1u)) >> 16; }
__device__ __forceinline__ unsigned pk2(float lo, float hi) { return f2bf(lo) | (f2bf(hi) << 16); }
__device__ __forceinline__ float bflo(unsigned u) { return __uint_as_float(u << 16); }
__device__ __forceinline__ float bfhi(unsigned u) { return __uint_as_float(u & 0xffff0000u); }
__device__ __forceinline__ float bf2f(bf16 b) { return __uint_as_float((unsigned)b << 16); }
__device__ __forceinline__ float sigmoidf_(float x) { return 1.0f / (1.0f + __expf(-x)); }

#define XB_TMO      128
#define XB_XCNT(j)  (256  + 64 * (j))
#define XB_XSUB(j)  (1280 + 64 * (j))
#define XB_XGEN(j)  (2304 + 64 * (j))
#define XB_TOP      3328
#define XB_TOPGEN   3392
#define XCD_BAR_WORDS 3456
#define XB_SPIN_CAP (1u << 18)
__device__ __forceinline__ unsigned xb_ld(unsigned* p)              { return __hip_atomic_load(p, __ATOMIC_RELAXED, __HIP_MEMORY_SCOPE_AGENT); }
__device__ __forceinline__ unsigned xb_add(unsigned* p, unsigned v) { return __hip_atomic_fetch_add(p, v, __ATOMIC_RELAXED, __HIP_MEMORY_SCOPE_AGENT); }
__device__ __forceinline__ unsigned xb_xcc_id() { return (unsigned)__builtin_amdgcn_s_getreg((3 << 11) | 20) & 0xFu; }
#define XB_SPIN(cond, bar) do { unsigned _sp = 0; while (cond) { __builtin_amdgcn_s_sleep(1); \
    if ((++_sp & 255u) == 0u) { if (xb_ld(&(bar)[XB_TMO])) break; if (_sp > XB_SPIN_CAP) { atomicAdd(&(bar)[XB_TMO], 1u); break; } } } } while (0)
struct XcdBarrier { unsigned* bar; unsigned x; volatile LAS unsigned* st; };
__device__ __forceinline__ XcdBarrier xcd_barrier_post(unsigned* bar, volatile LAS unsigned* st) {
    XcdBarrier b; b.bar = bar; b.x = xb_xcc_id(); b.st = st;
    if (threadIdx.x == 0) (void)xb_add(&bar[XB_XCNT(b.x)], 1u);
    return b;
}
__device__ __forceinline__ void xcd_barrier_complete(unsigned* bar, unsigned x, unsigned& nloc, unsigned& nx) {
    const unsigned G = gridDim.x * gridDim.y * gridDim.z;
    unsigned sum, cnt, mine, sp = 0u;
    for (;;) {
        sum = 0u; cnt = 0u; mine = 0u;
#pragma unroll
        for (unsigned j = 0; j < 16; ++j) { const unsigned c = xb_ld(&bar[XB_XCNT(j)]); sum += c; cnt += (c > 0u) ? 1u : 0u; mine = (j == x) ? c : mine; }
        if (sum == G) break;
        __builtin_amdgcn_s_sleep(1);
        if ((++sp & 255u) == 0u) { if (xb_ld(&bar[XB_TMO])) break; if (sp > XB_SPIN_CAP) { atomicAdd(&bar[XB_TMO], 1u); break; } }
    }
    nloc = mine > 0u ? mine : 1u; nx = cnt > 0u ? cnt : 1u;
}
__device__ __forceinline__ void xcd_barrier(const XcdBarrier& b) {
    asm volatile("s_waitcnt vmcnt(0)" ::: "memory");
    __syncthreads();
    if (threadIdx.x == 0) {
        unsigned* bar = b.bar;
        __builtin_amdgcn_s_waitcnt(0);
        unsigned nloc = b.st[0], nx = b.st[1];
        if (nloc == 0u) { xcd_barrier_complete(bar, b.x, nloc, nx); b.st[0] = nloc; b.st[1] = nx; }
        const unsigned old = xb_add(&bar[XB_XSUB(b.x)], 1u);
        const unsigned gen = old / nloc;
        if (old + 1u == (gen + 1u) * nloc) {
            __builtin_amdgcn_fence(__ATOMIC_RELEASE, "agent");
            asm volatile("s_waitcnt vmcnt(0)" ::: "memory");
            const unsigned og = xb_add(&bar[XB_TOP], 1u);
            const unsigned tg = og / nx;
            if (og + 1u == (tg + 1u) * nx) xb_add(&bar[XB_TOPGEN], 1u);
            else XB_SPIN(xb_ld(&bar[XB_TOPGEN]) == tg, bar);
            __builtin_amdgcn_fence(__ATOMIC_ACQUIRE, "agent");
            xb_add(&bar[XB_XGEN(b.x)], 1u);
            asm volatile("s_waitcnt vmcnt(0)" ::: "memory");
        } else {
            XB_SPIN(xb_ld(&bar[XB_XGEN(b.x)]) == gen, bar);
            __builtin_amdgcn_fence(__ATOMIC_ACQUIRE, "agent");
            asm volatile("s_waitcnt vmcnt(0)" ::: "memory");
        }
    }
    __syncthreads();
}

__device__ __forceinline__ float shx(float v, int o, int lane) { return __int_as_float(__builtin_amdgcn_ds_bpermute((lane ^ o) << 2, __float_as_int(v))); }
__device__ __forceinline__ float wave_sum(float v, int lane) {
#pragma unroll
    for (int o = 1; o < 64; o <<= 1) v += shx(v, o, lane);
    return v;
}
__device__ __forceinline__ void transpose_item(const float* W, int ldw, int k0, int n0, bf16* WT, int ldk, int dst_row0, const float* kscale, LAS float* scr, int lane, int kmax = 1 << 30) {
    const int r8 = lane >> 3, quad = lane & 7;
    f32x4 v[8];
#pragma unroll
    for (int i = 0; i < 8; ++i) { const int kk = r8 + 8 * i; v[i] = (k0 + kk < kmax) ? *(const GAS f32x4*)(W + (size_t)(k0 + kk) * ldw + n0 + quad * 4) : (f32x4){0.f, 0.f, 0.f, 0.f}; }
#pragma unroll
    for (int i = 0; i < 8; ++i) { const int kk = r8 + 8 * i; if (kscale) v[i] = v[i] * kscale[(k0 + kk < kmax) ? k0 + kk : 0]; *(LAS f32x4*)(scr + kk * 36 + ((quad ^ i) << 2)) = v[i]; }
    LDS_WAIT(); asm volatile("" ::: "memory");
    const int c = lane & 7;
#pragma unroll
    for (int j = 0; j < 4; ++j) { const int n = (lane >> 3) + 8 * j; const LAS float* sp = scr + (8 * c) * 36 + ((((n >> 2) ^ c) << 2) | (n & 3));
        v4u o; o.x = pk2(sp[0 * 36], sp[1 * 36]); o.y = pk2(sp[2 * 36], sp[3 * 36]); o.z = pk2(sp[4 * 36], sp[5 * 36]); o.w = pk2(sp[6 * 36], sp[7 * 36]);
        if (k0 + 8 * c < kmax) *(GAS v4u*)(WT + (size_t)(dst_row0 + n) * ldk + k0 + 8 * c) = o; }
    LDS_WAIT(); asm volatile("" ::: "memory");
}

struct Args { const float* in[31]; float* out; unsigned char* ws; int ph_lo, ph_hi, li, pad; };
typedef const __attribute__((address_space(4))) unsigned char* kaptr_t;
__device__ __forceinline__ kaptr_t ka_base() { kaptr_t p = (kaptr_t)__builtin_amdgcn_kernarg_segment_ptr(); asm volatile("" : "+s"(p)); return p; }
#define INP(k) (*(const float* const __attribute__((address_space(4)))*)(ka_base() + 8 * (k)))
#define OUTP() (*(float* const __attribute__((address_space(4)))*)(ka_base() + 8 * 31))
#define WSP() (*(unsigned char* const __attribute__((address_space(4)))*)(ka_base() + 8 * 32))
#define KA_INT(i) (*(const int __attribute__((address_space(4)))*)(ka_base() + 8 * 33 + 4 * (i)))

template <int PART> __device__ __forceinline__ void p0_weights(unsigned char* ws, LAS unsigned char* lds, int gw, int NGW, int wave, int lane) {
    LAS float* scr = (LAS float*)(lds + wave * 16384);
    bf16* WT_RKV = (bf16*)(ws + WS_WT_RKV); bf16* WT_LORA = (bf16*)(ws + WS_WT_LORA); bf16* WT_OUT = (bf16*)(ws + WS_WT_OUT); bf16* WT_KVQ = (bf16*)(ws + WS_WT_KVQ);
    bf16* WT_SBO = (bf16*)(ws + WS_WT_SBO); bf16* WT_GU = (bf16*)(ws + WS_WT_GU); bf16* WT_DN = (bf16*)(ws + WS_WT_DN);
    constexpr int I_UP = 32 + 32 + 96, I_RKV = 3 * 512, I_LORA = 32 + 32 + 80, I_OUT = 512, I_KV = 1024, I_Q = 512, I_SBO = 512, I_G = 32 * 128, I_U = 32 * 128, I_D = 32 * 128;
    constexpr int NDENSE = I_UP + I_RKV + I_LORA + I_OUT + I_KV + I_Q + I_SBO, NITEMS = NDENSE + I_G + I_U + I_D;
    constexpr int NLOOP = PART == 0 ? NDENSE : 3 * 2048; (void)NITEMS;
    for (int q_ = gw; q_ < NLOOP; q_ += NGW) {
        const int it = PART == 0 ? q_ : NDENSE + (q_ / 2048) * 4096 + 2048 * (PART - 1) + (q_ % 2048);
        int r = it;
        if (r < I_UP) {
            if (r < 32) transpose_item(INP(9), C, 0, 32 * r, (bf16*)(ws + WS_WT_W2), 64, 32 * r, nullptr, scr, lane);
            else if (r < 64) transpose_item(INP(12), C, 0, 32 * (r - 32), (bf16*)(ws + WS_WT_A2), 64, 32 * (r - 32), nullptr, scr, lane);
            else { const int q = r - 64, kb = q / 32, nb = q % 32; transpose_item(INP(14), C, 64 * kb, 32 * nb, (bf16*)(ws + WS_WT_G2), DG, 32 * nb, nullptr, scr, lane, DG); }
            continue; } r -= I_UP;
        if (r < I_RKV) { const int m = r / 512, q = r % 512, kb = q / 32, nb = q % 32; transpose_item(INP(6) + (size_t)m * C * C, C, 64 * kb, 32 * nb, WT_RKV, C, m * C + 32 * nb, nullptr, scr, lane); continue; } r -= I_RKV;
        if (r < I_LORA) {
            if (r < 32) { const int kb = r / 2, nb = r % 2; transpose_item(INP(8), DW, 64 * kb, 32 * nb, WT_LORA, C, 32 * nb, nullptr, scr, lane); }
            else if (r < 64) { const int q = r - 32, kb = q / 2, nb = q % 2; transpose_item(INP(11), DA, 64 * kb, 32 * nb, WT_LORA, C, 256 + 32 * nb, nullptr, scr, lane); }
            else { const int q = r - 64, kb = q / 5, nb = q % 5; transpose_item(INP(13), DG, 64 * kb, 32 * nb, WT_LORA, C, 512 + 32 * nb, nullptr, scr, lane); }
            continue; } r -= I_LORA;
        if (r < I_OUT) { const int kb = r / 32, nb = r % 32; transpose_item(INP(20), C, 64 * kb, 32 * nb, WT_OUT, C, 32 * nb, nullptr, scr, lane); continue; } r -= I_OUT;
        if (r < I_KV) { const int kb = r / 64, nb = r % 64; transpose_item(INP(21), 2 * C, 64 * kb, 32 * nb, WT_KVQ, C, 32 * nb, INP(3), scr, lane); continue; } r -= I_KV;
        if (r < I_Q) { const int kb = r / 32, nb = r % 32; transpose_item(INP(22), C, 64 * kb, 32 * nb, WT_KVQ, C, 2 * C + 32 * nb, INP(1) + C, scr, lane); continue; } r -= I_Q;
        if (r < I_SBO) { const int kb = r / 32, nb = r % 32; transpose_item(INP(23), C, 64 * kb, 32 * nb, WT_SBO, C, 32 * nb, nullptr, scr, lane); continue; } r -= I_SBO;
        if (r < I_G) { const int le = r / 128, q = r % 128, kb = q / 8, nb = q % 8, f0 = 32 * nb; transpose_item(INP(28) + (size_t)le * C * FE, FE, 64 * kb, f0, WT_GU + (size_t)le * 512 * C, C, 256 * (f0 / 128) + (f0 % 128), INP(2) + (le >> 4) * C, scr, lane); continue; } r -= I_G;
        if (r < I_U) { const int le = r / 128, q = r % 128, kb = q / 8, nb = q % 8, f0 = 32 * nb; transpose_item(INP(29) + (size_t)le * C * FE, FE, 64 * kb, f0, WT_GU + (size_t)le * 512 * C, C, 256 * (f0 / 128) + 128 + (f0 % 128), INP(2) + (le >> 4) * C, scr, lane); continue; } r -= I_U;
        { const int le = r / 128, q = r % 128, kb = q / 32, nb = q % 32; transpose_item(INP(30) + (size_t)le * FE * C, C, 64 * kb, 32 * nb, WT_DN + (size_t)le * C * FE, FE, 32 * nb, nullptr, scr, lane); }
    }
    if (PART == 0) for (int it = gw * 64 + lane; it < 768 * 128; it += NGW * 64) { const int row = it >> 7, ch = it & 127;
        const bool valid = (row < 64) || (row >= 256 && row < 320) || (row >= 512 && row < 672);
        if (!valid) *(GAS v4u*)(WT_LORA + (size_t)row * C + ch * 8) = (v4u){0u, 0u, 0u, 0u}; }
}
__device__ __forceinline__ void load_row(const float* p, int lane, f32x4 (&v)[4]) {
#pragma unroll
    for (int j = 0; j < 4; ++j) v[j] = ((const GAS f32x4*)p)[64 * j + lane];
}
__device__ __forceinline__ void load_row_bf(const bf16* p, int lane, f32x4 (&v)[4]) {
#pragma unroll
    for (int j = 0; j < 4; ++j) { const v2u w = ((const GAS v2u*)p)[64 * j + lane]; v[j] = (f32x4){bflo(w.x), bfhi(w.x), bflo(w.y), bfhi(w.y)}; }
}
__device__ __forceinline__ float row_rs(const f32x4 (&v)[4], int lane) {
    float s = 0.f;
#pragma unroll
    for (int j = 0; j < 4; ++j) s += (v[j].x * v[j].x + v[j].y * v[j].y) + (v[j].z * v[j].z + v[j].w * v[j].w);
    return 1.0f / sqrtf(wave_sum(s, lane) * (1.0f / C) + RMS_EPS);
}
__device__ __forceinline__ void store_row_bf16(bf16* p, int lane, const f32x4 (&v)[4]) {
#pragma unroll
    for (int j = 0; j < 4; ++j) { v2u o; o.x = pk2(v[j].x, v[j].y); o.y = pk2(v[j].z, v[j].w); ((GAS v2u*)p)[64 * j + lane] = o; }
}
__device__ __forceinline__ void p0_rows(unsigned char* ws, int gw, int NGW, int lane) {
    const float* x = INP(0); const float* gain = INP(1); const float* mix = INP(5);
    f32x4 g[4]; load_row(gain, lane, g);
    for (int run = gw; run < M / 8; run += NGW) {
        const int r0 = run * 8;
        f32x4 prev[4];
        if ((r0 % SEQ) == 0) {
#pragma unroll
            for (int j = 0; j < 4; ++j) prev[j] = (f32x4){0.f, 0.f, 0.f, 0.f};
        } else { load_row(x + (size_t)(r0 - 1) * C, lane, prev); const float rs = row_rs(prev, lane);
#pragma unroll
            for (int j = 0; j < 4; ++j) prev[j] = prev[j] * rs * g[j]; }
        for (int rr = 0; rr < 8; ++rr) {
            const int row = r0 + rr;
            f32x4 hn[4]; load_row(x + (size_t)row * C, lane, hn); const float rs = row_rs(hn, lane);
#pragma unroll
            for (int j = 0; j < 4; ++j) hn[j] = hn[j] * rs * g[j];
#pragma unroll
            for (int i = 0; i < 6; ++i) { f32x4 o[4];
#pragma unroll
                for (int j = 0; j < 4; ++j) { const f32x4 mx = ((const GAS f32x4*)(mix + i * C))[64 * j + lane]; o[j] = hn[j] + (prev[j] - hn[j]) * mx; }
                bf16* dst = i < 2 ? (bf16*)OUTP() + (size_t)i * M * C : (i == 2 ? (bf16*)(ws + WS_B4) : (bf16*)(ws + WS_B1) + (size_t)(i - 3) * M * C);
                store_row_bf16(dst + (size_t)row * C, lane, o); }
#pragma unroll
            for (int j = 0; j < 4; ++j) prev[j] = hn[j];
        }
    }
}

template <int NN, int NGROUPS> struct SchedGrouped {
    static constexpr int K = C;
    const char* A0; size_t astride; const char* A2; const char* B; size_t bgroup;
    int G, c;
    __device__ __forceinline__ bool next(int i, pg8::Unit& u) const {
        const int L = i * G + c; constexpr int per = 64 * NN; if (L >= per * NGROUPS) return false;
        const int g = L / per, w = L % per; pg8::tile_map(w, 64, NN, u.pm, u.pn); u.aux = g; u.r0 = 0; u.cnt = 0; return true; }
    __device__ __forceinline__ const char* a_base(const pg8::Unit& u) const { const char* A = (A2 != nullptr && u.aux == 2) ? A2 : A0 + (size_t)u.aux * astride; return A + (size_t)u.pm * 256 * K * 2; }
    __device__ __forceinline__ const char* b_base(const pg8::Unit& u) const { return B + (size_t)u.aux * bgroup + (size_t)u.pn * 256 * K * 2; }
    __device__ __forceinline__ unsigned a_row_off(const pg8::Unit&, int) const { return 0u; }
};
template <int NN, int K, bool GATHER> struct SchedMoe {
    const char* A; const char* B; size_t bexp; const unsigned* list; volatile LAS int* tab; int G, c;
    __device__ __forceinline__ bool next(int i, pg8::Unit& u) const {
        const int L = i * G + c; const int tot = __builtin_amdgcn_readfirstlane(tab[48]) * NN; if (L >= tot) return false;
        u.pm = L / NN; u.pn = L % NN; int e = 0;
#pragma unroll
        for (int j = 0; j < 16; ++j) e += (u.pm >= tab[32 + j]) ? 1 : 0;
        e = __builtin_amdgcn_readfirstlane(e);
        u.aux = e; u.r0 = (u.pm - __builtin_amdgcn_readfirstlane(tab[16 + e])) * 256; u.cnt = __builtin_amdgcn_readfirstlane(tab[e]); return true; }
    __device__ __forceinline__ const char* a_base(const pg8::Unit& u) const { return GATHER ? A : A + (size_t)u.pm * 256 * K * 2; }
    __device__ __forceinline__ const char* b_base(const pg8::Unit& u) const { return B + (size_t)u.aux * bexp + (size_t)u.pn * 256 * K * 2; }
    __device__ __forceinline__ unsigned a_row_off(const pg8::Unit& u, int r) const {
        const int idx = u.r0 + r; unsigned tok = 0u;
        if (idx < u.cnt) tok = list[(size_t)u.aux * M + idx] >> 1;
        return tok * (unsigned)(K * 2); }
};

using pg8::f32x4;
using pg8::Unit;
__device__ __forceinline__ v4u pack8(f32x4 v0, f32x4 v1) { v4u w; w.x = pg8::cvt_pk_bf16(v0[0], v0[1]); w.y = pg8::cvt_pk_bf16(v0[2], v0[3]); w.z = pg8::cvt_pk_bf16(v1[0], v1[1]); w.w = pg8::cvt_pk_bf16(v1[2], v1[3]); return w; }

struct EpiLora {
    static constexpr bool PERM = true;
    bf16* LW;
    __device__ __forceinline__ void operator()(const f32x4 (&acc)[2][2][4][2], const Unit& u, int wr, int wc, int fr, int fq) const {
        { int l_; asm volatile("v_mbcnt_lo_u32_b32 %0, -1, 0\n\tv_mbcnt_hi_u32_b32 %0, -1, %0" : "=v"(l_)); fr = l_ & 15; fq = l_ >> 4; }
        const int g = u.aux, width = g == 2 ? DG : DW; bf16* out = LW + (size_t)g * (1u << 20);
        const int row0 = u.pm * 256 + wr * 64 + fr;
#pragma unroll
        for (int bj = 0; bj < 2; ++bj) { const int col0 = bj * 128 + wc * 32 + 8 * fq; if (col0 < width) {
#pragma unroll
            for (int ai = 0; ai < 2; ++ai)
#pragma unroll
                for (int m = 0; m < 4; ++m) { f32x4 v0 = acc[ai][bj][m][0], v1 = acc[ai][bj][m][1];
                    if (g == 0) {
#pragma unroll
                        for (int q = 0; q < 4; ++q) { v0[q] = tanhf(v0[q]); v1[q] = tanhf(v1[q]); } }
                    else if (g == 2) {
#pragma unroll
                        for (int q = 0; q < 4; ++q) { v0[q] = sigmoidf_(v0[q]); v1[q] = sigmoidf_(v1[q]); } }
                    *(GAS v4u*)(out + (size_t)(row0 + ai * 128 + m * 16) * width + col0) = pack8(v0, v1); } } }
    }
};
struct EpiSplit3 {
    static constexpr bool PERM = true;
    bf16* O0; bool bycol; const float* rowscale;
    __device__ __forceinline__ void operator()(const f32x4 (&acc)[2][2][4][2], const Unit& u, int wr, int wc, int fr, int fq) const {
        { int l_; asm volatile("v_mbcnt_lo_u32_b32 %0, -1, 0\n\tv_mbcnt_hi_u32_b32 %0, -1, %0" : "=v"(l_)); fr = l_ & 15; fq = l_ >> 4; }
        const int g = bycol ? (u.pn >> 2) : u.aux, pn = bycol ? (u.pn & 3) : u.pn; bf16* out = O0 + (size_t)g * ((size_t)M * C);
        const int row0 = u.pm * 256 + wr * 64 + fr, col0 = pn * 256 + wc * 32 + 8 * fq;
#pragma unroll
        for (int ai = 0; ai < 2; ++ai)
#pragma unroll
            for (int m = 0; m < 4; ++m)
                { const float sc = rowscale ? rowscale[row0 + ai * 128 + m * 16] : 1.0f;
#pragma unroll
                for (int bj = 0; bj < 2; ++bj) *(GAS v4u*)(out + (size_t)(row0 + ai * 128 + m * 16) * C + col0 + bj * 128) = pack8(acc[ai][bj][m][0] * sc, acc[ai][bj][m][1] * sc); }
    }
};
template <bool BASE_F32> struct EpiResidBf {
    static constexpr bool PERM = true;
    const void* base; bf16* out;
    __device__ __forceinline__ void operator()(const f32x4 (&acc)[2][2][4][2], const Unit& u, int wr, int wc, int fr, int fq) const {
        { int l_; asm volatile("v_mbcnt_lo_u32_b32 %0, -1, 0\n\tv_mbcnt_hi_u32_b32 %0, -1, %0" : "=v"(l_)); fr = l_ & 15; fq = l_ >> 4; }
        const int row0 = u.pm * 256 + wr * 64 + fr, col0 = u.pn * 256 + wc * 32 + 8 * fq;
#pragma unroll
        for (int ai = 0; ai < 2; ++ai)
#pragma unroll
            for (int m = 0; m < 4; ++m) { const size_t off = (size_t)(row0 + ai * 128 + m * 16) * C + col0;
#pragma unroll
                for (int bj = 0; bj < 2; ++bj) { f32x4 b0, b1;
                    if (BASE_F32) { b0 = *(const GAS f32x4*)((const float*)base + off + bj * 128); b1 = *(const GAS f32x4*)((const float*)base + off + bj * 128 + 4); }
                    else { const v4u w = *(const GAS v4u*)((const bf16*)base + off + bj * 128); b0 = (f32x4){bflo(w.x), bfhi(w.x), bflo(w.y), bfhi(w.y)}; b1 = (f32x4){bflo(w.z), bfhi(w.z), bflo(w.w), bfhi(w.w)}; }
                    *(GAS v4u*)(out + off + bj * 128) = pack8(b0 + acc[ai][bj][m][0], b1 + acc[ai][bj][m][1]); }
                asm volatile("" ::: "memory"); }
    }
};
struct EpiGU {
    static constexpr bool PERM = true;
    bf16* HID; const float* wl; const float* rsl;
    __device__ __forceinline__ void operator()(const f32x4 (&acc)[2][2][4][2], const Unit& u, int wr, int wc, int fr, int fq) const {
        { int l_; asm volatile("v_mbcnt_lo_u32_b32 %0, -1, 0\n\tv_mbcnt_hi_u32_b32 %0, -1, %0" : "=v"(l_)); fr = l_ & 15; fq = l_ >> 4; }
        const int e = u.aux, cnt = u.cnt, base = u.r0, r0 = wr * 64 + fr, col0 = u.pn * 128 + wc * 32 + 8 * fq;
#pragma unroll
        for (int ai = 0; ai < 2; ++ai)
#pragma unroll
            for (int m = 0; m < 4; ++m) { const int r = r0 + ai * 128 + m * 16, idx = base + r; float w = 0.f, rs = 0.f; if (idx < cnt) { w = wl[(size_t)e * M + idx]; rs = rsl[(size_t)e * M + idx]; }
                f32x4 h0, h1;
#pragma unroll
                for (int q = 0; q < 4; ++q) { const float g0 = acc[ai][0][m][0][q] * rs, g1 = acc[ai][0][m][1][q] * rs;
                    h0[q] = g0 * sigmoidf_(g0) * (acc[ai][1][m][0][q] * rs) * w; h1[q] = g1 * sigmoidf_(g1) * (acc[ai][1][m][1][q] * rs) * w; }
                *(GAS v4u*)(HID + (size_t)(u.pm * 256 + r) * FE + col0) = pack8(h0, h1);
                asm volatile("" ::: "memory"); }
    }
};
struct EpiDown {
    static constexpr bool PERM = true;
    bf16* EO; const unsigned* list;
    __device__ __forceinline__ void operator()(const f32x4 (&acc)[2][2][4][2], const Unit& u, int wr, int wc, int fr, int fq) const {
        { int l_; asm volatile("v_mbcnt_lo_u32_b32 %0, -1, 0\n\tv_mbcnt_hi_u32_b32 %0, -1, %0" : "=v"(l_)); fr = l_ & 15; fq = l_ >> 4; }
        const int e = u.aux, cnt = u.cnt, base = u.r0, r0 = wr * 64 + fr, col0 = u.pn * 256 + wc * 32 + 8 * fq;
#pragma unroll
        for (int ai = 0; ai < 2; ++ai)
#pragma unroll
            for (int m = 0; m < 4; ++m) { const int idx = base + r0 + ai * 128 + m * 16;
                if (idx < cnt) { const unsigned ent = list[(size_t)e * M + idx]; bf16* o = EO + ((size_t)(ent & 1u) * M + (ent >> 1)) * C + col0;
#pragma unroll
                    for (int bj = 0; bj < 2; ++bj) *(GAS v4u*)(o + bj * 128) = pack8(acc[ai][bj][m][0], acc[ai][bj][m][1]); }
                asm volatile("" ::: "memory"); }
    }
};

typedef short bf16x8s __attribute__((ext_vector_type(8)));
typedef short bf16x4s __attribute__((ext_vector_type(4)));
typedef short v4i16_t __attribute__((ext_vector_type(4)));
constexpr int TPB = 144;
constexpr int TILE_B = 64 * TPB;
constexpr int FP = 68;
constexpr int CS_FA = 0, CS_FB = 16384, CS_TILES = 32768, CS_TOT = CS_TILES + 12 * TILE_B, CS_WL = CS_TOT + 2048, CS_PAR = CS_WL + 256;
static_assert(CS_PAR + 768 <= LDSCTL_OFF, "scan LDS map");
#define TILE(n) (lds + CS_TILES + (n) * TILE_B)
#define F4Z (f32x4){0.f, 0.f, 0.f, 0.f}
__device__ __forceinline__ bf16x8s ldfrag(const LAS unsigned char* tile, int row, int kcol) { return *(const LAS bf16x8s*)(tile + row * TPB + kcol * 2); }
__device__ __forceinline__ bf16x8s ldfrag_tr(const LAS unsigned char* tile, int n0, int k0, int lane) {
    const int g = lane >> 4, q = (lane & 15) >> 2, p = lane & 3;
    const LAS unsigned char* a = tile + (k0 + 8 * g + q) * TPB + (n0 + 4 * p) * 2;
    const v4i16_t lo = __builtin_amdgcn_ds_read_tr16_b64_v4i16((LAS v4i16_t*)a), hi = __builtin_amdgcn_ds_read_tr16_b64_v4i16((LAS v4i16_t*)(a + 4 * TPB));
    return (bf16x8s){lo[0], lo[1], lo[2], lo[3], hi[0], hi[1], hi[2], hi[3]};
}
__device__ __forceinline__ bf16x8s ldfrag_perm(const LAS unsigned char* tile, int row, int ks, int g) {
    const bf16x4s lo = *(const LAS bf16x4s*)(tile + row * TPB + (32 * ks + 4 * g) * 2), hi = *(const LAS bf16x4s*)(tile + row * TPB + (32 * ks + 16 + 4 * g) * 2);
    return (bf16x8s){lo[0], lo[1], lo[2], lo[3], hi[0], hi[1], hi[2], hi[3]};
}
__device__ __forceinline__ void lds_barrier() { asm volatile("s_waitcnt lgkmcnt(0)" ::: "memory"); __builtin_amdgcn_s_barrier(); asm volatile("" ::: "memory"); }
#define MFMA16(a, b, c) __builtin_amdgcn_mfma_f32_16x16x32_bf16((a), (b), (c), 0, 0, 0)
__device__ __forceinline__ void mm64(f32x4 (&acc)[2], const LAS unsigned char* At, const LAS unsigned char* Bt, int rt, int ch, int fr, int g) {
#pragma unroll
    for (int ks = 0; ks < 2; ++ks) { const bf16x8s a = ldfrag(At, 16 * rt + fr, 32 * ks + 8 * g);
#pragma unroll
        for (int ct = 0; ct < 2; ++ct) acc[ct] = MFMA16(a, ldfrag(Bt, 32 * ch + 16 * ct + fr, 32 * ks + 8 * g), acc[ct]); }
}
__device__ __forceinline__ void mm64_bt(f32x4 (&acc)[2], const LAS unsigned char* At, const LAS unsigned char* X, int rt, int ch, int fr, int g, int lane) {
#pragma unroll
    for (int ks = 0; ks < 2; ++ks) { const bf16x8s a = ldfrag(At, 16 * rt + fr, 32 * ks + 8 * g);
#pragma unroll
        for (int ct = 0; ct < 2; ++ct) acc[ct] = MFMA16(a, ldfrag_tr(X, 32 * ch + 16 * ct, 32 * ks, lane), acc[ct]); }
}
__device__ __forceinline__ void mm64_at(f32x4 (&acc)[2], const LAS unsigned char* Xa, const LAS unsigned char* Bt, int rt, int ch, int fr, int g, int lane) {
#pragma unroll
    for (int ks = 0; ks < 2; ++ks) { const bf16x8s a = ldfrag_tr(Xa, 16 * rt, 32 * ks, lane);
#pragma unroll
        for (int ct = 0; ct < 2; ++ct) acc[ct] = MFMA16(a, ldfrag(Bt, 32 * ch + 16 * ct + fr, 32 * ks + 8 * g), acc[ct]); }
}
__device__ __forceinline__ void mm64_att(f32x4 (&acc)[2], const LAS unsigned char* Xa, const LAS unsigned char* X, int rt, int ch, int lane) {
#pragma unroll
    for (int ks = 0; ks < 2; ++ks) { const bf16x8s a = ldfrag_tr(Xa, 16 * rt, 32 * ks, lane);
#pragma unroll
        for (int ct = 0; ct < 2; ++ct) acc[ct] = MFMA16(a, ldfrag_tr(X, 32 * ch + 16 * ct, 32 * ks, lane), acc[ct]); }
}
__device__ __forceinline__ bf16x4s pack4(f32x4 v) { v2u w; w.x = pg8::cvt_pk_bf16(v[0], v[1]); w.y = pg8::cvt_pk_bf16(v[2], v[3]); return __builtin_bit_cast(bf16x4s, w); }
__device__ __forceinline__ f32x4 unpack4(bf16x4s s) { const v2u w = __builtin_bit_cast(v2u, s); return (f32x4){bflo(w.x), bfhi(w.x), bflo(w.y), bfhi(w.y)}; }
__device__ __forceinline__ void st_tr(LAS unsigned char* Out, const f32x4 (&acc)[2], int rt, int ch, int fr, int g) {
#pragma unroll
    for (int ct = 0; ct < 2; ++ct) *(LAS bf16x4s*)(Out + (32 * ch + 16 * ct + fr) * TPB + (16 * rt + 4 * g) * 2) = pack4(acc[ct]);
}
__device__ __forceinline__ void ld_tr(f32x4 (&acc)[2], const LAS unsigned char* In, int rt, int ch, int fr, int g) {
#pragma unroll
    for (int ct = 0; ct < 2; ++ct) acc[ct] = unpack4(*(const LAS bf16x4s*)(In + (32 * ch + 16 * ct + fr) * TPB + (16 * rt + 4 * g) * 2));
}
__device__ __forceinline__ void unpack8(v4u w, float (&o)[8]) { o[0] = bflo(w.x); o[1] = bfhi(w.x); o[2] = bflo(w.y); o[3] = bfhi(w.y); o[4] = bflo(w.z); o[5] = bfhi(w.z); o[6] = bflo(w.w); o[7] = bfhi(w.w); }
__device__ __forceinline__ v4u pack8f(const float (&o)[8]) { v4u w; w.x = pg8::cvt_pk_bf16(o[0], o[1]); w.y = pg8::cvt_pk_bf16(o[2], o[3]); w.z = pg8::cvt_pk_bf16(o[4], o[5]); w.w = pg8::cvt_pk_bf16(o[6], o[7]); return w; }

struct FrontIn { v4u r, k, v; bf16x8s fw[2], fa[2]; };
__device__ __forceinline__ void front_fetch(FrontIn& f, unsigned char* ws, int unit, int tid, int lane, int wave) {
    const int h = unit & 15, c = (unit >> 4) & 127, b = unit >> 11; const size_t row0 = (size_t)b * SEQ + c * 64;
    const int rt = wave & 3, fr = lane & 15, g = lane >> 4, t = tid >> 3, cq = tid & 7, c0 = h * HD + cq * 8;
    const bf16* Rb = (const bf16*)(ws + WS_B1); const bf16* Kb = (const bf16*)(ws + WS_B2); const bf16* Vb = (const bf16*)(ws + WS_B3);
    const bf16* LW = (const bf16*)(ws + WS_LW); const bf16* LA = (const bf16*)(ws + WS_LA);
    f.r = *(const GAS v4u*)(Rb + (row0 + t) * C + c0); f.k = *(const GAS v4u*)(Kb + (row0 + t) * C + c0); f.v = *(const GAS v4u*)(Vb + (row0 + t) * C + c0);
#pragma unroll
    for (int ks = 0; ks < 2; ++ks) { f.fw[ks] = *(const GAS bf16x8s*)(LW + (row0 + 16 * rt + fr) * DW + 32 * ks + 8 * g); f.fa[ks] = *(const GAS bf16x8s*)(LA + (row0 + 16 * rt + fr) * DA + 32 * ks + 8 * g); }
}
__device__ __forceinline__ v4u head_consts(unsigned char* ws, LAS unsigned char* lds, int h, int tid, int wtile, int atile) {
    const bf16* W2T = (const bf16*)(ws + WS_WT_W2); const bf16* A2T = (const bf16*)(ws + WS_WT_A2);
    const int row = tid >> 3, cq = tid & 7;
    const v4u w2chunk = *(const GAS v4u*)(W2T + (size_t)(h * HD + row) * 64 + cq * 8);
    *(LAS v4u*)(lds + CS_TILES + wtile * TILE_B + row * TPB + cq * 16) = w2chunk;
    *(LAS v4u*)(lds + CS_TILES + atile * TILE_B + row * TPB + cq * 16) = *(const GAS v4u*)(A2T + (size_t)(h * HD + row) * 64 + cq * 8);
    if (tid < 64) { LAS float* P = (LAS float*)(lds + CS_PAR); P[tid] = INP(15)[h * HD + tid]; P[64 + tid] = INP(16)[h * HD + tid]; P[128 + tid] = INP(17)[h * HD + tid]; }
    __syncthreads();
    return w2chunk;
}
template <int MODE>
__device__ __forceinline__ void chunk_front(const FrontIn& f, LAS unsigned char* lds, const float (&w0v)[2], const float (&a0v)[2], const bf16x8s (&w2f)[2][2], const bf16x8s (&a2f)[2][2], int tid, int lane, int wave, float (&v8)[8], float& rkb) {
    const int rt = wave & 3, ch = wave >> 2, fr = lane & 15, g = lane >> 4;
    LAS float* FA = (LAS float*)(lds + CS_FA); LAS float* FB = (LAS float*)(lds + CS_FB); LAS float* TOT = (LAS float*)(lds + CS_TOT);
    const int t = tid >> 3, cq = tid & 7;
    {
        f32x4 aw[2] = {F4Z, F4Z}, aa[2] = {F4Z, F4Z};
#pragma unroll
        for (int ks = 0; ks < 2; ++ks)
#pragma unroll
            for (int ct = 0; ct < 2; ++ct) { aw[ct] = MFMA16(f.fw[ks], w2f[ks][ct], aw[ct]); aa[ct] = MFMA16(f.fa[ks], a2f[ks][ct], aa[ct]); }
#pragma unroll
        for (int ct = 0; ct < 2; ++ct) { const int j = 32 * ch + 16 * ct + fr, js = j ^ ((g & 1) << 4); const float w0 = w0v[ct], a0 = a0v[ct];
            float p[4];
#pragma unroll
            for (int q = 0; q < 4; ++q) { p[q] = -0.6065306597126334f * sigmoidf_(w0 + aw[ct][q]); if (q) p[q] += p[q - 1]; }
            const float s_ = p[3];
            const float u1 = __int_as_float(__builtin_amdgcn_ds_bpermute(((lane - 16) & 63) << 2, __float_as_int(s_))); const float t1 = s_ + (g >= 1 ? u1 : 0.f);
            const float u2 = __int_as_float(__builtin_amdgcn_ds_bpermute(((lane - 32) & 63) << 2, __float_as_int(t1))); const float t2 = t1 + (g >= 2 ? u2 : 0.f);
            const float ex = t2 - s_;
#pragma unroll
            for (int q = 0; q < 4; ++q) { const int tt = 16 * rt + 4 * g + q; FA[tt * 64 + js] = p[q] + ex; FB[tt * 64 + js] = sigmoidf_(a0 + aa[ct][q]); }
            if (g == 3) TOT[rt * 64 + j] = t2; }
    }
    lds_barrier();
    {
        float r[8], k[8], pkk[8], pka[8], prk[8];
        unpack8(f.r, r); unpack8(f.k, k); unpack8(f.v, v8);
        { const LAS float* P = (const LAS float*)(lds + CS_PAR) + cq * 8; const f32x4 a0_ = *(const LAS f32x4*)P, a1_ = *(const LAS f32x4*)(P + 4), b0_ = *(const LAS f32x4*)(P + 64), b1_ = *(const LAS f32x4*)(P + 68), c0_ = *(const LAS f32x4*)(P + 128), c1_ = *(const LAS f32x4*)(P + 132);
#pragma unroll
          for (int q = 0; q < 4; ++q) { pkk[q] = a0_[q]; pkk[4 + q] = a1_[q]; pka[q] = b0_[q]; pka[4 + q] = b1_[q]; prk[q] = c0_[q]; prk[4 + q] = c1_[q]; } }
        float cw[8], cwp[8], ag[8];
        { const int tp = t > 0 ? t - 1 : 0, rtt = wave >> 1;
          const int ct_ = (cq ^ (((t >> 2) & 1) << 1)) * 8, cp_ = (cq ^ (((tp >> 2) & 1) << 1)) * 8;
          const f32x4 c0_ = *(const LAS f32x4*)(FA + t * 64 + ct_), c1_ = *(const LAS f32x4*)(FA + t * 64 + ct_ + 4), p0_ = *(const LAS f32x4*)(FA + tp * 64 + cp_), p1_ = *(const LAS f32x4*)(FA + tp * 64 + cp_ + 4);
          const f32x4 g0_ = *(const LAS f32x4*)(FB + t * 64 + ct_), g1_ = *(const LAS f32x4*)(FB + t * 64 + ct_ + 4);
          f32x4 o0_ = F4Z, o1_ = F4Z, l0_ = F4Z, l1_ = F4Z;
          for (int r_ = 0; r_ < rtt; ++r_) { l0_ = *(const LAS f32x4*)(TOT + r_ * 64 + cq * 8); l1_ = *(const LAS f32x4*)(TOT + r_ * 64 + cq * 8 + 4); o0_ = o0_ + l0_; o1_ = o1_ + l1_; }
          const bool first = (t & 15) == 0;
#pragma unroll
          for (int q = 0; q < 4; ++q) { cw[q] = c0_[q] + o0_[q]; cw[4 + q] = c1_[q] + o1_[q];
              cwp[q] = t > 0 ? p0_[q] + o0_[q] - (first ? l0_[q] : 0.f) : 0.f; cwp[4 + q] = t > 0 ? p1_[q] + o1_[q] - (first ? l1_[q] : 0.f) : 0.f; ag[q] = g0_[q]; ag[4 + q] = g1_[q]; } }
        float kk[8], ss = 0.f; rkb = 0.f;
#pragma unroll
        for (int q = 0; q < 8; ++q) { kk[q] = k[q] * pkk[q]; ss += kk[q] * kk[q]; }
        ss += shx(ss, 1, lane); ss += shx(ss, 2, lane); ss += shx(ss, 4, lane);
        const float inv = 1.0f / fmaxf(sqrtf(ss), 1e-12f);
        float at[8], bt[8], kt[8], rt_[8];
#pragma unroll
        for (int q = 0; q < 8; ++q) { const float kn = kk[q] * inv, kp = k[q] * (1.0f + (ag[q] - 1.0f) * pka[q]);
            const float ein = __expf(-cw[q]);
            at[q] = -kn * __expf(cwp[q]); bt[q] = kn * ag[q] * ein; kt[q] = kp * ein;
            rt_[q] = r[q] * __expf(cw[q]); rkb += r[q] * kp * prk[q]; }
        rkb += shx(rkb, 1, lane); rkb += shx(rkb, 2, lane); rkb += shx(rkb, 4, lane);
        *(LAS v4u*)(TILE(0) + t * TPB + cq * 16) = pack8f(at); *(LAS v4u*)(TILE(1) + t * TPB + cq * 16) = pack8f(bt); *(LAS v4u*)(TILE(2) + t * TPB + cq * 16) = pack8f(kt);
        *(LAS v4u*)(TILE(3) + t * TPB + cq * 16) = f.v;
        *(LAS v4u*)(TILE(6) + t * TPB + cq * 16) = pack8f(rt_);
        if (MODE == 1 && t == 63) {
#pragma unroll
            for (int q = 0; q < 8; ++q) ((LAS float*)(lds + CS_WL))[cq * 8 + q] = __expf(cw[q]); }
    }
    lds_barrier();
}

__device__ __forceinline__ void scan_s1(unsigned char* ws, LAS unsigned char* lds, int lane0, int wave) {
    const int rt = wave & 3, ch = wave >> 2;
    FrontIn fin; float w0v[2], a0v[2]; bf16x8s w2f[2][2], a2f[2][2];
    { int l0 = lane0; asm volatile("" : "+v"(l0)); const int hh = blockIdx.x & 15;
      if ((int)blockIdx.x < BATCH * NH * (SEQ / 64)) front_fetch(fin, ws, blockIdx.x, wave * 64 + l0, l0, wave);
      const bf16* W2T = (const bf16*)(ws + WS_WT_W2); const bf16* A2T = (const bf16*)(ws + WS_WT_A2);
#pragma unroll
      for (int ct = 0; ct < 2; ++ct) { w0v[ct] = INP(7)[hh * HD + 32 * ch + 16 * ct + (l0 & 15)]; a0v[ct] = INP(10)[hh * HD + 32 * ch + 16 * ct + (l0 & 15)];
#pragma unroll
          for (int ks = 0; ks < 2; ++ks) { const size_t wr_ = (size_t)(hh * HD + 32 * ch + 16 * ct + (l0 & 15)) * 64 + 32 * ks + 8 * (l0 >> 4); w2f[ks][ct] = *(const GAS bf16x8s*)(W2T + wr_); a2f[ks][ct] = *(const GAS bf16x8s*)(A2T + wr_); } }
      const int tid0 = wave * 64 + l0;
      if (tid0 < 64) { LAS float* P = (LAS float*)(lds + CS_PAR); P[tid0] = INP(15)[hh * HD + tid0]; P[64 + tid0] = INP(16)[hh * HD + tid0]; P[128 + tid0] = INP(17)[hh * HD + tid0]; }
      __syncthreads(); }
    for (int unit = blockIdx.x; unit < BATCH * NH * (SEQ / 64); unit += gridDim.x) {
        int lane = lane0; asm volatile("" : "+v"(lane));
        const int tid = wave * 64 + lane, fr = lane & 15, g = lane >> 4;
        const int h = unit & 15, c = (unit >> 4) & 127, b = unit >> 11; const size_t chunk = ((size_t)b * NH + h) * 128 + c;
        float v8[8]; float rkb;
        chunk_front<1>(fin, lds, w0v, a0v, w2f, a2f, tid, lane, wave, v8, rkb);
        { const size_t row0_ = (size_t)b * SEQ + c * 64; if ((tid & 7) == 0) ((float*)(ws + WS_HID))[(row0_ + (tid >> 3)) * NH + h] = rkb; }
        if (unit + (int)gridDim.x < BATCH * NH * (SEQ / 64)) front_fetch(fin, ws, unit + gridDim.x, tid, lane, wave);
        {
            f32x4 a2[2] = {F4Z, F4Z}, a3[2] = {F4Z, F4Z};
            mm64(a2, TILE(1), TILE(0), rt, ch, fr, g);
            mm64(a3, TILE(2), TILE(0), rt, ch, fr, g);
            f32x4 p1[2];
#pragma unroll
            for (int ct = 0; ct < 2; ++ct) { const int col = 32 * ch + 16 * ct + fr;
#pragma unroll
                for (int q = 0; q < 4; ++q) { const int row = 16 * rt + 4 * g + q;
                    a2[ct][q] = row < col ? a2[ct][q] : 0.f;
                    p1[ct][q] = a2[ct][q] + (row == col ? 1.0f : 0.f);
                    a3[ct][q] = row < col ? a3[ct][q] : 0.f; } }
            st_tr(TILE(5), a2, rt, ch, fr, g);
            st_tr(TILE(9), p1, rt, ch, fr, g);
            st_tr(TILE(4), a3, rt, ch, fr, g);
        }
        lds_barrier();
#pragma unroll
        for (int r = 0; r < 6; ++r) {
            LAS unsigned char* Sr = TILE(5 + 2 * (r & 1)); LAS unsigned char* Sr2 = TILE(5 + 2 * ((r & 1) ^ 1));
            if (r <= 4) { f32x4 q2[2] = {F4Z, F4Z};
                mm64_at(q2, Sr, Sr, rt, ch, fr, g, lane);
                st_tr(Sr2, q2, rt, ch, fr, g); }
            if (r >= 1) { LAS unsigned char* Pr = TILE(9 + ((r - 1) & 1)); LAS unsigned char* Pr2 = TILE(9 + (((r - 1) & 1) ^ 1));
                f32x4 pa[2]; ld_tr(pa, Pr, rt, ch, fr, g);
                mm64_at(pa, Sr, Pr, rt, ch, fr, g, lane);
                st_tr(Pr2, pa, rt, ch, fr, g); }
            if (r == 0) { f32x4 gg[2] = {F4Z, F4Z};
                mm64_bt(gg, TILE(4), TILE(3), rt, ch, fr, g, lane);
                st_tr(TILE(11), gg, rt, ch, fr, g); }
            lds_barrier();
        }
        {
            f32x4 acc[2] = {F4Z, F4Z}, ac2[2] = {F4Z, F4Z};
            mm64_bt(acc, TILE(10), TILE(0), rt, ch, fr, g, lane);
            mm64(ac2, TILE(10), TILE(11), rt, ch, fr, g);
            st_tr(TILE(5), acc, rt, ch, fr, g); st_tr(TILE(7), ac2, rt, ch, fr, g);
            f32x4 b2[2] = {F4Z, F4Z}, b3[2] = {F4Z, F4Z};
            mm64(b2, TILE(1), TILE(6), rt, ch, fr, g); mm64(b3, TILE(2), TILE(6), rt, ch, fr, g);
#pragma unroll
            for (int ct = 0; ct < 2; ++ct) { const int t = 32 * ch + 16 * ct + fr;
#pragma unroll
                for (int q = 0; q < 4; ++q) { const int s_ = 16 * rt + 4 * g + q; b2[ct][q] = s_ <= t ? b2[ct][q] : 0.f; b3[ct][q] = s_ <= t ? b3[ct][q] : 0.f; } }
            st_tr(TILE(4), b2, rt, ch, fr, g); st_tr(TILE(9), b3, rt, ch, fr, g);
        }
        lds_barrier();
        {
            const LAS float* WL = (const LAS float*)(lds + CS_WL);
            f32x4 acc[2] = {F4Z, F4Z};
            mm64_bt(acc, TILE(5), TILE(1), rt, ch, fr, g, lane);
            bf16* Mg = (bf16*)(ws + WS_B0) + chunk * 4096;
#pragma unroll
            for (int ct = 0; ct < 2; ++ct) { const int j1 = 32 * ch + 16 * ct + fr; const float wl = WL[j1];
#pragma unroll
                for (int q = 0; q < 4; ++q) { const int j2 = 16 * rt + 4 * g + q; acc[ct][q] = wl * (acc[ct][q] + (j2 == j1 ? 1.0f : 0.f)); }
                const int rtS = 2 * ch + ct, ksS = rt >> 1, half = rt & 1;
                *(GAS bf16x4s*)(Mg + (((rtS * 2 + ksS) * 64 + g * 16 + fr) * 8 + half * 4)) = pack4(acc[ct]); }
            f32x4 ad[2] = {F4Z, F4Z};
            mm64_at(ad, TILE(1), TILE(7), rt, ch, fr, g, lane);
            mm64_att(ad, TILE(2), TILE(3), rt, ch, lane);
            const f32x4 wl4 = *(const LAS f32x4*)(WL + 16 * rt + 4 * g);
            bf16* Dg = (bf16*)OUTP() + chunk * 4096;
#pragma unroll
            for (int ct = 0; ct < 2; ++ct) *(GAS bf16x4s*)(Dg + (((2 * ch + ct) * 4 + rt) * 64 + lane) * 4) = pack4(ad[ct] * wl4);
            const size_t row0_ = (size_t)b * SEQ + c * 64;
            f32x4 ar[2]; ld_tr(ar, TILE(6), rt, ch, fr, g);
            mm64(ar, TILE(5), TILE(4), rt, ch, fr, g);
            f32x4 ay[2] = {F4Z, F4Z};
            mm64(ay, TILE(7), TILE(4), rt, ch, fr, g); mm64_at(ay, TILE(3), TILE(9), rt, ch, fr, g, lane);
            bf16* Rg = (bf16*)(ws + WS_B1); bf16* Kg = (bf16*)(ws + WS_B2);
#pragma unroll
            for (int ct = 0; ct < 2; ++ct) { const size_t o_ = (row0_ + 32 * ch + 16 * ct + fr) * C + h * HD + 16 * rt + 4 * g; *(GAS bf16x4s*)(Rg + o_) = pack4(ar[ct]); *(GAS bf16x4s*)(Kg + o_) = pack4(ay[ct]); }
        }
        lds_barrier();
    }
}

constexpr int S2_PD = 6;
__device__ __forceinline__ void scan_s2(unsigned char* ws, LAS unsigned char* lds, int lane, int wave) {
    for (int bh = blockIdx.x; bh < BATCH * NH; bh += gridDim.x) {
        const unsigned char* Mg = (const unsigned char*)((const bf16*)(ws + WS_B0) + (size_t)bh * 128 * 4096); const unsigned char* Dg = (const unsigned char*)((const bf16*)OUTP() + (size_t)bh * 128 * 4096);
        bf16* Sg = (bf16*)OUTP() + (size_t)M * C + (size_t)bh * 128 * 4096;
        if (wave >= 4) {
            const int lw = wave - 4;
            const unsigned char* src = (lw < 2 ? Mg + lw * 4096 : Dg + (lw - 2) * 4096) + lane * 16;
            LAS unsigned char* dst = lds + lw * 4096 + lane * 16;
            v4u q[S2_PD][4];
#define S2_LOADQ(j, c) do { _Pragma("unroll") for (int i_ = 0; i_ < 4; ++i_) q[j][i_] = *(const GAS v4u*)(src + (size_t)(c) * 8192 + i_ * 1024); } while (0)
#define S2_STOREQ(j, slot) do { _Pragma("unroll") for (int i_ = 0; i_ < 4; ++i_) *(LAS v4u*)(dst + (slot) * 16384 + i_ * 1024) = q[j][i_]; } while (0)
#pragma unroll
            for (int j = 0; j < S2_PD; ++j) S2_LOADQ(j, j);
            S2_STOREQ(0, 0); S2_LOADQ(0, S2_PD);
            lds_barrier();
#pragma unroll 1
            for (int s0 = 0; s0 < 128; s0 += S2_PD) {
#pragma unroll
                for (int jj = 0; jj < S2_PD; ++jj) { const int step = s0 + jj;
                    if (step + 1 < 128) S2_STOREQ((jj + 1) % S2_PD, (step + 1) & 1);
                    if (step + 1 + S2_PD < 128) S2_LOADQ((jj + 1) % S2_PD, step + 1 + S2_PD);
                    lds_barrier(); }
            }
#undef S2_LOADQ
#undef S2_STOREQ
        } else {
            const int ct = wave;
            f32x4 acc[4];
#pragma unroll
            for (int r = 0; r < 4; ++r) acc[r] = F4Z;
            lds_barrier();
#pragma unroll 1
            for (int s0 = 0; s0 < 128; s0 += S2_PD) {
#pragma unroll
                for (int jj = 0; jj < S2_PD; ++jj) { const int step = s0 + jj;
                    if (step < 128) {
                        const LAS unsigned char* slot = lds + (step & 1) * 16384;
                        bf16x8s sf[2];
#pragma unroll
                        for (int ks = 0; ks < 2; ++ks) { const bf16x4s lo = pack4(acc[2 * ks]), hi = pack4(acc[2 * ks + 1]); sf[ks] = (bf16x8s){lo[0], lo[1], lo[2], lo[3], hi[0], hi[1], hi[2], hi[3]}; }
#pragma unroll
                        for (int ks = 0; ks < 2; ++ks) *(GAS bf16x8s*)(Sg + (size_t)step * 4096 + ((ct * 2 + ks) * 64 + lane) * 8) = sf[ks];
                        f32x4 na[4];
#pragma unroll
                        for (int r = 0; r < 4; ++r) na[r] = unpack4(*(const LAS bf16x4s*)(slot + 8192 + ((ct * 4 + r) * 64 + lane) * 8));
#pragma unroll
                        for (int ks = 0; ks < 2; ++ks)
#pragma unroll
                            for (int r = 0; r < 4; ++r) na[r] = MFMA16(*(const LAS bf16x8s*)(slot + ((r * 2 + ks) * 64 + lane) * 16), sf[ks], na[r]);
#pragma unroll
                        for (int r = 0; r < 4; ++r) acc[r] = na[r];
                    }
                    lds_barrier(); }
            }
        }
    }
}

constexpr int S3_RT = 32768, S3_YT = S3_RT + TILE_B, S3_LG = S3_YT + TILE_B, S3_LGP = 336;
struct S3In { v4u rr, yy, vv, lg[3]; bf16x8s sA[2]; float rkb; };
__device__ __forceinline__ void s3_fetch(S3In& f, unsigned char* ws, int unit, int tid, int lane, int wave) {
    const int h = unit & 15, c = (unit >> 4) & 127, b = unit >> 11; const size_t chunk = ((size_t)b * NH + h) * 128 + c, row0 = (size_t)b * SEQ + c * 64;
    const int rt = wave & 3, et = tid >> 3, ecq = tid & 7;
    const bf16* Rg = (const bf16*)(ws + WS_B1); const bf16* Kg = (const bf16*)(ws + WS_B2); const bf16* Vb = (const bf16*)(ws + WS_B3); const bf16* LG = (const bf16*)(ws + WS_LG);
    const bf16* Sg = (const bf16*)OUTP() + (size_t)M * C + chunk * 4096;
    const size_t o_ = (row0 + et) * C + h * HD + ecq * 8;
    f.rr = *(const GAS v4u*)(Rg + o_); f.yy = *(const GAS v4u*)(Kg + o_); f.vv = *(const GAS v4u*)(Vb + o_);
#pragma unroll
    for (int i = 0; i < 3; ++i) { const int chn = tid + 512 * i; if (chn < 64 * 20) f.lg[i] = *(const GAS v4u*)(LG + (row0 + chn / 20) * DG + (chn % 20) * 8); }
#pragma unroll
    for (int ks = 0; ks < 2; ++ks) f.sA[ks] = *(const GAS bf16x8s*)(Sg + ((rt * 2 + ks) * 64 + lane) * 8);
    f.rkb = ((const float*)(ws + WS_HID))[(row0 + et) * NH + h];
}
__device__ __forceinline__ void scan_s3(unsigned char* ws, LAS unsigned char* lds, int lane0, int wave) {
    const int rt = wave & 3, ch = wave >> 2;
    LAS float* Ys = (LAS float*)(lds + CS_FA);
    const bf16* G2T = (const bf16*)(ws + WS_WT_G2); bf16* YG = (bf16*)(ws + WS_B0);
    constexpr int NU = BATCH * NH * (SEQ / 64);
    S3In fin; bf16x8s gA[5]; f32x4 lnw0, lnw1, lnb0, lnb1;
    { int l0 = lane0; asm volatile("" : "+v"(l0)); const int hh = blockIdx.x & 15, t0_ = wave * 64 + l0;
      if ((int)blockIdx.x < NU) s3_fetch(fin, ws, blockIdx.x, t0_, l0, wave);
#pragma unroll
      for (int ks = 0; ks < 5; ++ks) gA[ks] = *(const GAS bf16x8s*)(G2T + (size_t)(hh * HD + 16 * rt + (l0 & 15)) * DG + 32 * ks + 8 * (l0 >> 4));
      const int ec0 = hh * HD + (t0_ & 7) * 8;
      lnw0 = *(const GAS f32x4*)(INP(18) + ec0); lnw1 = *(const GAS f32x4*)(INP(18) + ec0 + 4); lnb0 = *(const GAS f32x4*)(INP(19) + ec0); lnb1 = *(const GAS f32x4*)(INP(19) + ec0 + 4); }
    __syncthreads();
    for (int unit = blockIdx.x; unit < NU; unit += gridDim.x) {
        int lane = lane0; asm volatile("" : "+v"(lane));
        const int tid = wave * 64 + lane, fr = lane & 15, g = lane >> 4, et = tid >> 3, ecq = tid & 7;
        const int h = unit & 15, c = (unit >> 4) & 127, b = unit >> 11; const size_t row0 = (size_t)b * SEQ + c * 64;
        *(LAS v4u*)(lds + S3_RT + et * TPB + ecq * 16) = fin.rr; *(LAS v4u*)(lds + S3_YT + et * TPB + ecq * 16) = fin.yy;
#pragma unroll
        for (int i = 0; i < 3; ++i) { const int chn = tid + 512 * i; if (chn < 64 * 20) *(LAS v4u*)(lds + S3_LG + (chn / 20) * S3_LGP + (chn % 20) * 16) = fin.lg[i]; }
        float v8[8]; unpack8(fin.vv, v8); const float rkb = fin.rkb; const bf16x8s sA0 = fin.sA[0], sA1 = fin.sA[1];
        lds_barrier();
        if (unit + (int)gridDim.x < NU) s3_fetch(fin, ws, unit + gridDim.x, tid, lane, wave);
        f32x4 acc[2], ag[2] = {F4Z, F4Z};
#pragma unroll
        for (int ct = 0; ct < 2; ++ct) { const int t = 32 * ch + 16 * ct + fr;
            acc[ct] = unpack4(*(const LAS bf16x4s*)(lds + S3_YT + t * TPB + (16 * rt + 4 * g) * 2));
            acc[ct] = MFMA16(sA0, ldfrag_perm(lds + S3_RT, t, 0, g), acc[ct]); acc[ct] = MFMA16(sA1, ldfrag_perm(lds + S3_RT, t, 1, g), acc[ct]);
#pragma unroll
            for (int ks = 0; ks < 5; ++ks) ag[ct] = MFMA16(gA[ks], *(const LAS bf16x8s*)(lds + S3_LG + t * S3_LGP + (32 * ks + 8 * g) * 2), ag[ct]);
            *(LAS f32x4*)(Ys + t * FP + 16 * rt + 4 * g) = acc[ct]; }
        lds_barrier();
        {
            const f32x4 y0 = *(const LAS f32x4*)(Ys + et * FP + ecq * 8), y1 = *(const LAS f32x4*)(Ys + et * FP + ecq * 8 + 4);
            float y[8] = {y0[0], y0[1], y0[2], y0[3], y1[0], y1[1], y1[2], y1[3]};
            float s_ = 0.f;
#pragma unroll
            for (int q = 0; q < 8; ++q) s_ += y[q];
            s_ += shx(s_, 1, lane); s_ += shx(s_, 2, lane); s_ += shx(s_, 4, lane);
            const float mu = s_ * (1.0f / HD); float vs = 0.f;
#pragma unroll
            for (int q = 0; q < 8; ++q) { y[q] -= mu; vs += y[q] * y[q]; }
            vs += shx(vs, 1, lane); vs += shx(vs, 2, lane); vs += shx(vs, 4, lane);
            const float rstd = 1.0f / sqrtf(vs * (1.0f / HD) + GN_EPS);
            f32x4 o0, o1;
#pragma unroll
            for (int q = 0; q < 4; ++q) { o0[q] = y[q] * rstd * lnw0[q] + lnb0[q] + rkb * v8[q]; o1[q] = y[4 + q] * rstd * lnw1[q] + lnb1[q] + rkb * v8[4 + q]; }
            *(LAS f32x4*)(Ys + et * FP + ecq * 8) = o0; *(LAS f32x4*)(Ys + et * FP + ecq * 8 + 4) = o1;
        }
        lds_barrier();
#pragma unroll
        for (int ct = 0; ct < 2; ++ct) { const int t = 32 * ch + 16 * ct + fr; const f32x4 yv = *(const LAS f32x4*)(Ys + t * FP + 16 * rt + 4 * g);
            *(GAS bf16x4s*)(YG + (row0 + t) * C + h * HD + 16 * rt + 4 * g) = pack4(yv * ag[ct]); }
    }
    __syncthreads();
}
#undef TILE
#if MK_DEBUG
__device__ __forceinline__ void scan_naive(unsigned char* ws, LAS unsigned char* lds, int tid) {
    const int lane = tid & 63;
    const bf16* Rb = (const bf16*)(ws + WS_B1); const bf16* Kb = (const bf16*)(ws + WS_B2); const bf16* Vb = (const bf16*)(ws + WS_B3);
    const bf16* LW = (const bf16*)(ws + WS_LW); const bf16* LA = (const bf16*)(ws + WS_LA);
    float* Y = OUTP(); float* RK = (float*)(ws + WS_HID);
    LAS float* sR = (LAS float*)lds; LAS float* sK = sR + 4096; LAS float* sV = sK + 4096; LAS float* sA = sV + 4096; LAS float* sB = sA + 4096; LAS float* sD = sB + 4096;
    LAS float* sW2 = sD + 4096; LAS float* sA2 = sW2 + 4096;
    for (int unit = blockIdx.x; unit < BATCH * NH; unit += gridDim.x) {
        const int b = unit / NH, h = unit % NH;
        __syncthreads();
        for (int e = tid; e < 4096; e += 512) { const int d = e >> 6, j = e & 63; sW2[e] = INP(9)[(size_t)d * C + h * HD + j]; sA2[e] = INP(12)[(size_t)d * C + h * HD + j]; }
        __syncthreads();
        const int pt = tid >> 3, cq = tid & 7, c0 = h * HD + cq * 8;
        const int si = tid >> 3, jq = tid & 7;
        float S[8];
#pragma unroll
        for (int q = 0; q < 8; ++q) S[q] = 0.f;
        float w0v[8], a0v[8], kkv[8], kav[8], rkv[8];
#pragma unroll
        for (int q = 0; q < 8; ++q) { w0v[q] = INP(7)[c0 + q]; a0v[q] = INP(10)[c0 + q]; kkv[q] = INP(15)[c0 + q]; kav[q] = INP(16)[c0 + q]; rkv[q] = INP(17)[c0 + q]; }
        for (int blk = 0; blk < SEQ / 64; ++blk) {
            const size_t row = (size_t)b * SEQ + blk * 64 + pt;
            {
                const v4u r4 = *(const GAS v4u*)(Rb + row * C + c0), k4 = *(const GAS v4u*)(Kb + row * C + c0), v4 = *(const GAS v4u*)(Vb + row * C + c0);
                float r[8], k[8], v[8];
                r[0] = bflo(r4.x); r[1] = bfhi(r4.x); r[2] = bflo(r4.y); r[3] = bfhi(r4.y); r[4] = bflo(r4.z); r[5] = bfhi(r4.z); r[6] = bflo(r4.w); r[7] = bfhi(r4.w);
                k[0] = bflo(k4.x); k[1] = bfhi(k4.x); k[2] = bflo(k4.y); k[3] = bfhi(k4.y); k[4] = bflo(k4.z); k[5] = bfhi(k4.z); k[6] = bflo(k4.w); k[7] = bfhi(k4.w);
                v[0] = bflo(v4.x); v[1] = bfhi(v4.x); v[2] = bflo(v4.y); v[3] = bfhi(v4.y); v[4] = bflo(v4.z); v[5] = bfhi(v4.z); v[6] = bflo(v4.w); v[7] = bfhi(v4.w);
                float wp[8], ap[8];
#pragma unroll
                for (int q = 0; q < 8; ++q) { wp[q] = w0v[q]; ap[q] = a0v[q]; }
                for (int d = 0; d < 64; ++d) { const float lw = bf2f(LW[row * DW + d]), la = bf2f(LA[row * DA + d]);
#pragma unroll
                    for (int q = 0; q < 8; ++q) { wp[q] += lw * sW2[d * 64 + cq * 8 + q]; ap[q] += la * sA2[d * 64 + cq * 8 + q]; } }
                float kk[8], ss = 0.f, rks = 0.f;
#pragma unroll
                for (int q = 0; q < 8; ++q) { kk[q] = k[q] * kkv[q]; ss += kk[q] * kk[q]; }
                ss += shx(ss, 1, lane); ss += shx(ss, 2, lane); ss += shx(ss, 4, lane);
                const float inv = 1.0f / fmaxf(sqrtf(ss), 1e-12f);
#pragma unroll
                for (int q = 0; q < 8; ++q) { const float ag = sigmoidf_(ap[q]); const float kn = kk[q] * inv; const float kp = k[q] * (1.0f + (ag - 1.0f) * kav[q]);
                    const float lw = -0.6065306597126334f * sigmoidf_(wp[q]);
                    const int o = pt * 64 + cq * 8 + q;
                    sR[o] = r[q]; sK[o] = kp; sV[o] = v[q]; sA[o] = -kn; sB[o] = kn * ag; sD[o] = __expf(lw); rks += r[q] * kp * rkv[q]; }
                rks += shx(rks, 1, lane); rks += shx(rks, 2, lane); rks += shx(rks, 4, lane);
                if (cq == 0) RK[row * NH + h] = rks;
            }
            __syncthreads();
            for (int t = 0; t < 64; ++t) {
                const LAS f32x4* pa = (const LAS f32x4*)(sA + t * 64 + jq * 8); const LAS f32x4* pb = (const LAS f32x4*)(sB + t * 64 + jq * 8);
                const LAS f32x4* pd = (const LAS f32x4*)(sD + t * 64 + jq * 8); const LAS f32x4* pk = (const LAS f32x4*)(sK + t * 64 + jq * 8);
                const LAS f32x4* pr = (const LAS f32x4*)(sR + t * 64 + jq * 8);
                const f32x4 a0 = pa[0], a1 = pa[1], b0 = pb[0], b1 = pb[1], d0 = pd[0], d1 = pd[1], k0 = pk[0], k1 = pk[1], r0 = pr[0], r1 = pr[1];
                const float vi = sV[t * 64 + si];
                float sa = 0.f;
#pragma unroll
                for (int q = 0; q < 4; ++q) { sa += S[q] * a0[q]; sa += S[4 + q] * a1[q]; }
                sa += shx(sa, 1, lane); sa += shx(sa, 2, lane); sa += shx(sa, 4, lane);
                float y = 0.f;
#pragma unroll
                for (int q = 0; q < 4; ++q) { S[q] = S[q] * d0[q] + sa * b0[q] + vi * k0[q]; S[4 + q] = S[4 + q] * d1[q] + sa * b1[q] + vi * k1[q]; y += S[q] * r0[q]; y += S[4 + q] * r1[q]; }
                y += shx(y, 1, lane); y += shx(y, 2, lane); y += shx(y, 4, lane);
                if (jq == 0) Y[((size_t)b * SEQ + blk * 64 + t) * C + h * HD + si] = y;
            }
            __syncthreads();
        }
    }
}
__device__ __forceinline__ void post_scan(unsigned char* ws, int gw, int NGW, int lane) {
    const float* Y = OUTP(); const float* RK = (const float*)(ws + WS_HID); const bf16* Vb = (const bf16*)(ws + WS_B3); const bf16* LG = (const bf16*)(ws + WS_LG);
    bf16* YG = (bf16*)(ws + WS_B4); const float* g2 = INP(14); const float* lnw = INP(18); const float* lnb = INP(19);
    for (int it = gw; it < M * NH; it += NGW) {
        const int row = it / NH, h = it % NH, c = h * HD + lane;
        const float y = Y[(size_t)row * C + c];
        const float mu = wave_sum(y, lane) * (1.0f / HD); const float d = y - mu; const float var = wave_sum(d * d, lane) * (1.0f / HD);
        float o = d * (1.0f / sqrtf(var + GN_EPS)) * lnw[c] + lnb[c];
        o += RK[(size_t)row * NH + h] * bf2f(Vb[(size_t)row * C + c]);
        float g = 0.f;
        for (int dd = 0; dd < DG; ++dd) g += bf2f(LG[(size_t)row * DG + dd]) * g2[(size_t)dd * C + c];
        YG[(size_t)row * C + c] = (bf16)f2bf(o * g);
    }
}


constexpr int CW_DBG = 3200;
__device__ __forceinline__ void dbg_nonfinite(unsigned char* ws, const bf16* X, size_t n, int slot, int gw, int NGW, int lane, float thr = 1e30f) {
    unsigned* cw = (unsigned*)(ws + WS_CTL) + CW_DBG + 64 * slot; unsigned nnan = 0;
    for (size_t i = (size_t)gw * 64 + lane; i < n; i += (size_t)NGW * 64) { const float x = bf2f(X[i]); if (!(fabsf(x) < thr)) ++nnan; }
    if (nnan) atomicAdd(cw, nnan);
}
__device__ __forceinline__ void dbg_compare(unsigned char* ws, const bf16* X, const bf16* Y, int gw, int NGW, int lane) {
    unsigned* cw = (unsigned*)(ws + WS_CTL) + CW_DBG; unsigned nbad = 0, nnan = 0;
    for (size_t i = (size_t)gw * 64 + lane; i < (size_t)M * C; i += (size_t)NGW * 64) { const float x = bf2f(X[i]), y = bf2f(Y[i]);
        if (!(fabsf(x) < 1e30f)) ++nnan; else if (fabsf(x - y) > 0.05f * (fabsf(y) + 0.05f)) ++nbad; }
    if (nnan) atomicAdd(cw, nnan); if (nbad) atomicAdd(cw + 64, nbad);
}
#endif
__device__ __forceinline__ void router_rows(unsigned char* ws, LAS unsigned char* lds, int layer, int gw, int NGW, int lane, int tid, bool dry = false) {
    const bf16* Hh = (const bf16*)(ws + WS_B4); const float* gain = INP(2) + layer * C; float* rsl = (float*)(ws + WS_B0);
    const float* wg = INP(24) + (size_t)layer * C * 4; const float* bg = INP(25) + layer * 4; const float* wi = INP(26) + (size_t)layer * C * 16; const float* bi = INP(27) + layer * 16;
    unsigned* cnt = (unsigned*)(ws + WS_CTL) + CW_CNT + layer * 16 * 64; unsigned* list = (unsigned*)(ws + WS_LIST); float* wl = (float*)(ws + WS_WL);
    LAS float* sWg = (LAS float*)lds; LAS float* sWi = sWg + C * 4;
    constexpr int RECMAX = 256;
    LAS unsigned* lcnt = (LAS unsigned*)(lds + 81920); LAS unsigned* gbase = lcnt + 16; LAS int* nrec = (LAS int*)(lcnt + 32);
    LAS unsigned* recRow = lcnt + 64; LAS unsigned* recE = recRow + RECMAX; LAS unsigned* recL = recE + RECMAX; LAS float* recW0 = (LAS float*)(recL + RECMAX); LAS float* recW1 = recW0 + RECMAX; LAS float* recRS = recW1 + RECMAX;
    __syncthreads();
    for (int e = tid; e < C * 4; e += 512) sWg[e] = wg[e];
    for (int e = tid; e < C * 16; e += 512) sWi[e] = wi[e];
    if (tid < 33) lcnt[tid == 32 ? 32 : tid] = 0u;
    __syncthreads();
    f32x4 g[4]; load_row(gain, lane, g);
    for (int row = gw; row < M; row += NGW) {
        f32x4 v[4]; load_row_bf(Hh + (size_t)row * C, lane, v); const float rs = row_rs(v, lane);
#pragma unroll
        for (int j = 0; j < 4; ++j) v[j] = v[j] * rs * g[j];
        float gl[4] = {0.f, 0.f, 0.f, 0.f};
        const LAS unsigned char* pWg = (const LAS unsigned char*)sWg + lane * 64;
#pragma unroll
        for (int j = 0; j < 4; ++j)
#pragma unroll
            for (int q = 0; q < 4; ++q) { const f32x4 w = *(const LAS f32x4*)(pWg + j * 4096 + q * 16); const float xv = v[j][q]; gl[0] += xv * w.x; gl[1] += xv * w.y; gl[2] += xv * w.z; gl[3] += xv * w.w; }
#pragma unroll
        for (int q = 0; q < 4; ++q) gl[q] = wave_sum(gl[q], lane) + bg[q];
        int gi = 0; float gm = gl[0];
#pragma unroll
        for (int q = 1; q < 4; ++q) if (gl[q] > gm) { gm = gl[q]; gi = q; }
        float gden = 0.f;
#pragma unroll
        for (int q = 0; q < 4; ++q) gden += __expf(gl[q] - gm);
        const float gval = 1.0f / gden;
        float il[4] = {0.f, 0.f, 0.f, 0.f};
        const LAS unsigned char* pWi = (const LAS unsigned char*)sWi + lane * 256 + gi * 16;
#pragma unroll
        for (int j = 0; j < 4; ++j)
#pragma unroll
            for (int q = 0; q < 4; ++q) { const f32x4 w = *(const LAS f32x4*)(pWi + j * 16384 + q * 64); const float xv = v[j][q]; il[0] += xv * w.x; il[1] += xv * w.y; il[2] += xv * w.z; il[3] += xv * w.w; }
#pragma unroll
        for (int q = 0; q < 4; ++q) il[q] = wave_sum(il[q], lane) + bi[gi * 4 + q];
        int i0 = 0; float m0 = il[0];
#pragma unroll
        for (int q = 1; q < 4; ++q) if (il[q] > m0) { m0 = il[q]; i0 = q; }
        int i1 = -1; float m1 = -INFINITY;
#pragma unroll
        for (int q = 0; q < 4; ++q) if (q != i0 && il[q] > m1) { m1 = il[q]; i1 = q; }
        const float e1 = __expf(m1 - m0); const float w0 = gval / (1.0f + e1), w1 = gval * e1 / (1.0f + e1);
        if (lane == 0 && !dry) {
            const int ex0 = gi * 4 + i0, ex1 = gi * 4 + i1;
            const int ri = __hip_atomic_fetch_add(nrec, 1, __ATOMIC_RELAXED, __HIP_MEMORY_SCOPE_WORKGROUP);
            const unsigned l0 = __hip_atomic_fetch_add(lcnt + ex0, 1u, __ATOMIC_RELAXED, __HIP_MEMORY_SCOPE_WORKGROUP), l1 = __hip_atomic_fetch_add(lcnt + ex1, 1u, __ATOMIC_RELAXED, __HIP_MEMORY_SCOPE_WORKGROUP);
            if (ri < RECMAX) { recRow[ri] = (unsigned)row; recE[ri] = (unsigned)ex0 | ((unsigned)ex1 << 8); recL[ri] = l0 | (l1 << 16); recW0[ri] = w0; recW1[ri] = w1; recRS[ri] = rs; }
        }
    }
    __syncthreads();
    if (tid < 16 && !dry) gbase[tid] = atomicAdd(cnt + tid * 64, lcnt[tid]);
    __syncthreads();
    { const int n = *nrec < RECMAX ? *nrec : RECMAX;
      for (int i = tid; i < n; i += 512) { const unsigned row = recRow[i], e = recE[i], l = recL[i]; const unsigned ex0 = e & 255u, ex1 = e >> 8;
          const unsigned p0 = gbase[ex0] + (l & 0xffffu), p1 = gbase[ex1] + (l >> 16);
          list[(size_t)ex0 * M + p0] = row * 2u; wl[(size_t)ex0 * M + p0] = recW0[i]; list[(size_t)ex1 * M + p1] = row * 2u + 1u; wl[(size_t)ex1 * M + p1] = recW1[i];
          rsl[(size_t)ex0 * M + p0] = recRS[i]; rsl[(size_t)ex1 * M + p1] = recRS[i]; } }
}
__device__ __forceinline__ void moe_table(unsigned char* ws, volatile LAS int* tab, int layer, int tid) {
    __syncthreads();
    if (tid == 0) { const unsigned* cnt = (const unsigned*)(ws + WS_CTL) + CW_CNT + layer * 16 * 64; int t = 0;
#pragma unroll 1
        for (int e = 0; e < 16; ++e) { const int c = (int)__hip_atomic_load(cnt, RLX_AGENT); cnt += 64; tab[e] = c; tab[16 + e] = t; t += (c + 255) >> 8; tab[32 + e] = t; }
        tab[48] = t; }
    __syncthreads();
}
__device__ __forceinline__ void combine_rows(unsigned char* ws, int mode, int gw, int NGW, int lane, bool dry = false) {
    bf16* Hh = (bf16*)(ws + WS_B4); float* Out = OUTP(); const bf16* E0 = (const bf16*)(ws + WS_B2); const bf16* E1 = (const bf16*)(ws + WS_B3); bf16* XN2 = (bf16*)(ws + WS_B0);
    f32x4 g[4]; load_row(INP(4), lane, g);
    for (int row = gw; row < M; row += NGW) {
        f32x4 v[4]; load_row_bf(Hh + (size_t)row * C, lane, v);
#pragma unroll
        for (int j = 0; j < 4; ++j) { const v2u e0 = ((const GAS v2u*)(E0 + (size_t)row * C))[64 * j + lane], e1 = ((const GAS v2u*)(E1 + (size_t)row * C))[64 * j + lane];
            v[j].x += bflo(e0.x) + bflo(e1.x); v[j].y += bfhi(e0.x) + bfhi(e1.x); v[j].z += bflo(e0.y) + bflo(e1.y); v[j].w += bfhi(e0.y) + bfhi(e1.y); }
        const float rs = row_rs(v, lane);
        if (mode == 0) {
            if (!dry) store_row_bf16(Hh + (size_t)row * C, lane, v);
            if (lane == 0) ((float*)XN2)[row] = rs;
        } else {
            float sig = 1.0f;
#if MK_DEBUG
            const unsigned* cw = (const unsigned*)(ws + WS_CTL) + CW_DBG; const unsigned nnan = __hip_atomic_load(cw, RLX_AGENT), nbad = __hip_atomic_load(cw + 64, RLX_AGENT);
            if (row < 512 && nnan > 0) sig = 2.0f;
            if (row >= 512 && row < 1536 && __hip_atomic_load(cw + 128, RLX_AGENT) > 0) sig = 2.0f;
            if (row >= 1536 && row < 3584 && __hip_atomic_load(cw + 192, RLX_AGENT) > 0) sig = 2.0f;
            if (row >= 3584 && row < 7680 && __hip_atomic_load(cw + 256, RLX_AGENT) > 0) sig = 2.0f;
            if (row >= 7680 && row < 15872 && __hip_atomic_load(cw + 320, RLX_AGENT) > 0) sig = 2.0f;
            if (row >= 15872 && nbad > (unsigned)(M / 100) * C) sig = 1.5f;
#endif
#pragma unroll
            for (int j = 0; j < 4; ++j) ((GAS f32x4*)(Out + (size_t)row * C))[64 * j + lane] = v[j] * rs * g[j] * sig;
        }
    }
}
__device__ __forceinline__ void attn_naive(unsigned char* ws, int gw, int NGW, int lane) {
    const bf16* Kb = (const bf16*)(ws + WS_B1); const bf16* Vb = (const bf16*)(ws + WS_B2); const bf16* Qb = (const bf16*)(ws + WS_B3); bf16* Ob = (bf16*)(ws + WS_B0);
    for (int unit = gw; unit < BATCH * NH * (SEQ / 64); unit += NGW) {
        const int qb = unit % (SEQ / 64), bh = unit / (SEQ / 64), b = bh / NH, h = bh % NH;
        const int t0 = qb * 64, t = t0 + lane; const size_t rowq = (size_t)b * SEQ + t;
        float q[64], o[64];
#pragma unroll
        for (int c = 0; c < 8; ++c) { const v4u w = *(const GAS v4u*)(Qb + rowq * C + h * HD + c * 8);
            q[c * 8 + 0] = bflo(w.x) * 0.125f; q[c * 8 + 1] = bfhi(w.x) * 0.125f; q[c * 8 + 2] = bflo(w.y) * 0.125f; q[c * 8 + 3] = bfhi(w.y) * 0.125f;
            q[c * 8 + 4] = bflo(w.z) * 0.125f; q[c * 8 + 5] = bfhi(w.z) * 0.125f; q[c * 8 + 6] = bflo(w.w) * 0.125f; q[c * 8 + 7] = bfhi(w.w) * 0.125f; }
#pragma unroll
        for (int c = 0; c < 64; ++c) o[c] = 0.f;
        float suffix = 0.f;
        for (int s = t0 + 62; s >= 0; --s) {
            const bool valid = s < t;
            if (s < t0 && __all(suffix > SB_EXIT)) break;
            const bf16* kp = Kb + ((size_t)b * SEQ + s) * C + h * HD; const bf16* vp = Vb + ((size_t)b * SEQ + s) * C + h * HD;
            float z = 0.f;
#pragma unroll
            for (int c = 0; c < 8; ++c) { const v4u w = *(const GAS v4u*)(kp + c * 8);
                z += q[c * 8 + 0] * bflo(w.x) + q[c * 8 + 1] * bfhi(w.x) + q[c * 8 + 2] * bflo(w.y) + q[c * 8 + 3] * bfhi(w.y) + q[c * 8 + 4] * bflo(w.z) + q[c * 8 + 5] * bfhi(w.z) + q[c * 8 + 6] * bflo(w.w) + q[c * 8 + 7] * bfhi(w.w); }
            const float sp = fmaxf(z, 0.f) + log1pf(__expf(-fabsf(z)));
            const float att = valid ? __expf(z - sp - suffix) : 0.f;
            suffix += valid ? sp : 0.f;
#pragma unroll
            for (int c = 0; c < 8; ++c) { const v4u w = *(const GAS v4u*)(vp + c * 8);
                o[c * 8 + 0] += att * bflo(w.x); o[c * 8 + 1] += att * bfhi(w.x); o[c * 8 + 2] += att * bflo(w.y); o[c * 8 + 3] += att * bfhi(w.y);
                o[c * 8 + 4] += att * bflo(w.z); o[c * 8 + 5] += att * bfhi(w.z); o[c * 8 + 6] += att * bflo(w.w); o[c * 8 + 7] += att * bfhi(w.w); }
        }
#pragma unroll
        for (int c = 0; c < 8; ++c) { v4u w; w.x = pk2(o[c * 8 + 0], o[c * 8 + 1]); w.y = pk2(o[c * 8 + 2], o[c * 8 + 3]); w.z = pk2(o[c * 8 + 4], o[c * 8 + 5]); w.w = pk2(o[c * 8 + 6], o[c * 8 + 7]);
            *(GAS v4u*)(Ob + rowq * C + h * HD + c * 8) = w; }
    }
}


typedef float f32x16 __attribute__((ext_vector_type(16)));
constexpr int AT_VP = 192;
constexpr int AT_WAVE_LDS = 32 * AT_VP;
__device__ __forceinline__ int crow32(int reg, int hh) { return (reg & 3) + 8 * (reg >> 2) + 4 * hh; }
__device__ __forceinline__ bf16x8s pack_step(const f32x16& x, const int s) {
    v4u p; p.x = pg8::cvt_pk_bf16(x[8 * s], x[8 * s + 1]); p.y = pg8::cvt_pk_bf16(x[8 * s + 2], x[8 * s + 3]); p.z = pg8::cvt_pk_bf16(x[8 * s + 4], x[8 * s + 5]); p.w = pg8::cvt_pk_bf16(x[8 * s + 6], x[8 * s + 7]);
    return __builtin_bit_cast(bf16x8s, p);
}
__device__ __forceinline__ void attn_mfma(unsigned char* ws, LAS unsigned char* lds, int gw, int NGW, int lane, int wave) {
    const bf16* Kb = (const bf16*)(ws + WS_B1); const bf16* Vb = (const bf16*)(ws + WS_B2); const bf16* Qb = (const bf16*)(ws + WS_B3); bf16* Ob = (bf16*)(ws + WS_B0);
    LAS unsigned char* vl = lds + wave * AT_WAVE_LDS;
    const int r32 = lane & 31, hh = lane >> 5;
    bf16x8s tri[2];
#pragma unroll
    for (int s = 0; s < 2; ++s)
#pragma unroll
        for (int j = 0; j < 8; ++j) tri[s][j] = (16 * s + 8 * (j >> 2) + 4 * hh + (j & 3)) > r32 ? (short)0x3F80 : (short)0;
    const int grp = lane >> 4, tq = (lane & 15) >> 2, tp = lane & 3;
    const LAS unsigned char* vtr0 = vl + (4 * hh + tq) * AT_VP + (16 * (grp & 1) + 4 * tp) * 2;
    for (int unit = gw; unit < BATCH * NH * (SEQ / 32); unit += NGW) {
        const int qb = unit % (SEQ / 32), bh = unit / (SEQ / 32), b = bh / NH, hd = bh % NH;
        const int t0 = qb * 32; const size_t rowb = (size_t)b * SEQ;
        bf16x8s qf[4];
#pragma unroll
        for (int ks = 0; ks < 4; ++ks) qf[ks] = *(const GAS bf16x8s*)(Qb + (rowb + t0 + r32) * C + hd * HD + 16 * ks + 8 * hh);
        f32x16 o[2];
#pragma unroll
        for (int i = 0; i < 16; ++i) { o[0][i] = 0.f; o[1][i] = 0.f; }
        float carry = 0.f;
        for (int s0 = t0; s0 >= 0; s0 -= 32) {
            bf16x8s kf[4];
#pragma unroll
            for (int ks = 0; ks < 4; ++ks) kf[ks] = *(const GAS bf16x8s*)(Kb + (rowb + s0 + r32) * C + hd * HD + 16 * ks + 8 * hh);
            v4u vreg[4];
#pragma unroll
            for (int i = 0; i < 4; ++i) { const int cidx = lane + 64 * i; vreg[i] = *(const GAS v4u*)(Vb + (rowb + s0 + (cidx >> 3)) * C + hd * HD + (cidx & 7) * 8); }
            f32x16 st;
#pragma unroll
            for (int i = 0; i < 16; ++i) st[i] = 0.f;
#pragma unroll
            for (int ks = 0; ks < 4; ++ks) st = __builtin_amdgcn_mfma_f32_32x32x16_bf16(kf[ks], qf[ks], st, 0, 0, 0);
#pragma unroll
            for (int i = 0; i < 4; ++i) { const int cidx = lane + 64 * i; *(LAS v4u*)(vl + (cidx >> 3) * AT_VP + (cidx & 7) * 16) = vreg[i]; }
            f32x16 zz, uu; float tot = 0.f; const int tq_ = t0 + r32;
            if (s0 + 31 < t0) {
#pragma unroll
                for (int i = 0; i < 16; ++i) { const float z = st[i] * 0.18033688011112042f; const float sp = fmaxf(z, 0.f) + __builtin_amdgcn_logf(1.0f + __builtin_amdgcn_exp2f(-fabsf(z)));
                    zz[i] = z - sp; uu[i] = sp; tot += sp; }
            } else {
#pragma unroll
                for (int i = 0; i < 16; ++i) { const int key = s0 + crow32(i, hh); const float z = st[i] * 0.18033688011112042f; const float sp = fmaxf(z, 0.f) + __builtin_amdgcn_logf(1.0f + __builtin_amdgcn_exp2f(-fabsf(z)));
                    const bool valid = key < tq_; zz[i] = valid ? z - sp : -1e30f; uu[i] = valid ? sp : 0.f; tot += uu[i]; }
            }
            f32x16 w;
#pragma unroll
            for (int i = 0; i < 16; ++i) w[i] = 0.f;
#pragma unroll
            for (int s = 0; s < 2; ++s) w = __builtin_amdgcn_mfma_f32_32x32x16_bf16(tri[s], pack_step(uu, s), w, 0, 0, 0);
            f32x16 pp;
#pragma unroll
            for (int i = 0; i < 16; ++i) pp[i] = __builtin_amdgcn_exp2f(zz[i] - w[i] - carry);
            tot += shx(tot, 32, lane); carry += tot;
            asm volatile("s_waitcnt lgkmcnt(0)" ::: "memory");
#pragma unroll
            for (int s = 0; s < 2; ++s) { const bf16x8s pa = pack_step(pp, s);
#pragma unroll
                for (int dt = 0; dt < 2; ++dt) {
                    const v4i16_t lo = __builtin_amdgcn_ds_read_tr16_b64_v4i16((LAS v4i16_t*)(vtr0 + (16 * s) * AT_VP + dt * 64));
                    const v4i16_t hi = __builtin_amdgcn_ds_read_tr16_b64_v4i16((LAS v4i16_t*)(vtr0 + (16 * s + 8) * AT_VP + dt * 64));
                    const bf16x8s vf = (bf16x8s){lo[0], lo[1], lo[2], lo[3], hi[0], hi[1], hi[2], hi[3]};
                    o[dt] = __builtin_amdgcn_mfma_f32_32x32x16_bf16(pa, vf, o[dt], 0, 0, 0); } }
            asm volatile("" ::: "memory");
            if (s0 < t0 && __all(carry > SB_EXIT * 1.4426950408889634f)) break;
        }
#pragma unroll
        for (int dt = 0; dt < 2; ++dt)
#pragma unroll
            for (int i = 0; i < 16; ++i) Ob[(rowb + t0 + crow32(i, hh)) * C + hd * HD + 32 * dt + r32] = (bf16)f2bf(o[dt][i]);
    }
}
__global__ void __launch_bounds__(NWAVES * 64, 2) yoco_fwd(Args args) {
    extern __shared__ __attribute__((aligned(16))) unsigned char lds_raw[];
    LAS unsigned char* lds = (LAS unsigned char*)lds_raw;
    const int G = gridDim.x; const int bx = blockIdx.x;
    int wave = __builtin_amdgcn_readfirstlane(threadIdx.x >> 6); asm volatile("" : "+s"(wave));
#define IDS() int lane; asm volatile("v_mbcnt_lo_u32_b32 %0, -1, 0\n\tv_mbcnt_hi_u32_b32 %0, -1, %0" : "=v"(lane)); const int tid = wave * 64 + lane; (void)tid; \
    const int vcu = (G % 8 == 0) ? (bx % 8) * (G / 8) + bx / 8 : bx; const int gw = vcu * NWAVES + wave, NGW = G * NWAVES; (void)lane; (void)gw; (void)NGW;
    unsigned char* ws = WSP();
    volatile LAS unsigned* MISC = (volatile LAS unsigned*)(lds + MISC_OFF);
    volatile LAS int* tab = (volatile LAS int*)(lds + MOE_TAB_OFF);
    for (int u = threadIdx.x; u < (LDS_BYTES - LDSCTL_OFF) / 4; u += NWAVES * 64) ((LAS unsigned*)(lds + LDSCTL_OFF))[u] = 0u;
    __syncthreads();
    XcdBarrier bar; bar.bar = (unsigned*)(ws + WS_CTL) + CW_BAR; bar.x = 0; bar.st = nullptr;
    if (N_LAUNCHES == 1) bar = xcd_barrier_post((unsigned*)(ws + WS_CTL) + CW_BAR, MISC + 8);
    const int lo = KA_INT(0), hi = KA_INT(1);
#ifndef PROBE_PH
#define PROBE_PH -1
#endif
#define IN(k) (lo <= (k) && (k) < hi)
#define REP(k) for (int rep_ = 0; rep_ < ((PROBE_PH == (k)) ? 2 : 1); ++rep_)
#define SEAM(k) do { if (IN(k) && IN((k) + 1)) xcd_barrier(bar); } while (0)

    if (IN(PH_P0)) REP(PH_P0) { IDS(); p0_weights<0>(ws, lds, gw, NGW, wave, lane); p0_weights<1>(ws, lds, gw, NGW, wave, lane); if (G <= 64) p0_weights<2>(ws, lds, gw, NGW, wave, lane); p0_rows(ws, gw, NGW, lane); }
    SEAM(PH_P0);
    if (PROBE_PH == 100 && N_LAUNCHES == 1) { for (int i_ = 0; i_ < 10; ++i_) xcd_barrier(bar); }
    if (IN(PH_LORA)) REP(PH_LORA) {
        SchedGrouped<1, 3> S{(const char*)(ws + WS_B1), (size_t)(WS_B2 - WS_B1), nullptr, (const char*)(ws + WS_WT_LORA), (size_t)256 * C * 2, G, bx};
        EpiLora E{(bf16*)(ws + WS_LW)};
        pg8::gemm_phase<EpiLora, SchedGrouped<1, 3>, true, false, C>(lds, S, E, wave);
    }
    SEAM(PH_LORA);
    if (IN(PH_RKV)) REP(PH_RKV) {
        SchedGrouped<4, 3> S{(const char*)OUTP(), (size_t)M * C * 2, (const char*)(ws + WS_B4), (const char*)(ws + WS_WT_RKV), (size_t)C * C * 2, G, bx};
        EpiSplit3 E{(bf16*)(ws + WS_B1), false, nullptr};
        pg8::gemm_phase<EpiSplit3, SchedGrouped<4, 3>, true, false, C>(lds, S, E, wave);
    }
    SEAM(PH_RKV);
    if (IN(PH_S1)) REP(PH_S1) { IDS(); scan_s1(ws, lds, lane, wave); }
    SEAM(PH_S1);
    if (IN(PH_S2)) REP(PH_S2) { IDS();
        if (bx < BATCH * NH || G <= BATCH * NH) scan_s2(ws, lds, lane, wave);
        }
    SEAM(PH_S2);
    if (IN(PH_S3)) REP(PH_S3) { IDS(); scan_s3(ws, lds, lane, wave); }
    SEAM(PH_S3);
#if MK_DEBUG
    if (IN(PH_DBG0)) { IDS(); scan_naive(ws, lds, tid); }
    SEAM(PH_DBG0);
    if (IN(PH_DBG0 + 1)) { IDS(); post_scan(ws, gw, NGW, lane); }
    SEAM(PH_DBG0 + 1);
    if (IN(PH_DBG0 + 2)) { IDS(); dbg_compare(ws, (const bf16*)(ws + WS_B0), (const bf16*)(ws + WS_B4), gw, NGW, lane); }
    SEAM(PH_DBG0 + 2);
#endif
    if (IN(PH_WOUT)) REP(PH_WOUT) {
        SchedGrouped<4, 1> S{(const char*)(ws + ((MK_DEBUG && DBG_USE_NAIVE) ? WS_B4 : WS_B0)), 0, nullptr, (const char*)(ws + WS_WT_OUT), 0, G, bx};
        EpiResidBf<true> E{INP(0), (bf16*)(ws + WS_B4)};
        pg8::gemm_phase<EpiResidBf<true>, SchedGrouped<4, 1>, true, false, C>(lds, S, E, wave);
    }
    SEAM(PH_WOUT);
#pragma unroll 1
    for (int layer = 0; layer < 2; ++layer) {
        const int pb = layer == 0 ? (int)PH_ROUT0 : (int)PH_ROUT1;
        if (IN(pb)) { IDS(); if (PROBE_PH == 101 && layer == 0) router_rows(ws, lds, layer, gw, NGW, lane, tid, true); router_rows(ws, lds, layer, gw, NGW, lane, tid); }
        SEAM(pb);
        if (IN(pb + 1)) REP(pb + 1) {
            { IDS(); moe_table(ws, tab, layer, tid); }
            SchedMoe<2, C, true> S{(const char*)(ws + WS_B4), (const char*)(ws + WS_WT_GU) + (size_t)layer * 16 * 512 * C * 2, (size_t)512 * C * 2, (const unsigned*)(ws + WS_LIST), tab, G, bx};
            EpiGU E{(bf16*)(ws + WS_HID), (const float*)(ws + WS_WL), (const float*)(ws + WS_B0)};
            pg8::gemm_phase<EpiGU, SchedMoe<2, C, true>, true, true, C>(lds, S, E, wave);
            if (layer == 0 && G > 64) { const int nr2 = __builtin_amdgcn_readfirstlane(tab[48]) * 2 - G, first = nr2 > 0 ? nr2 : 0;
                if (bx >= first) { IDS(); p0_weights<2>(ws, lds, (bx - first) * NWAVES + wave, (G - first) * NWAVES, wave, lane); } }
        }
        SEAM(pb + 1);
        if (IN(pb + 2)) REP(pb + 2) {
            { IDS(); moe_table(ws, tab, layer, tid); }
            SchedMoe<4, FE, false> S{(const char*)(ws + WS_HID), (const char*)(ws + WS_WT_DN) + (size_t)layer * 16 * C * FE * 2, (size_t)C * FE * 2, (const unsigned*)(ws + WS_LIST), tab, G, bx};
            EpiDown E{(bf16*)(ws + WS_B2), (const unsigned*)(ws + WS_LIST)};
            pg8::gemm_phase<EpiDown, SchedMoe<4, FE, false>, true, false, FE>(lds, S, E, wave);
        }
        SEAM(pb + 2);
        if (layer == 0) {
            if (IN(PH_COMB)) { IDS(); if (PROBE_PH == 102) combine_rows(ws, 0, gw, NGW, lane, true); combine_rows(ws, 0, gw, NGW, lane); }
            SEAM(PH_COMB);
            if (IN(PH_KVQ)) REP(PH_KVQ) {
                SchedGrouped<12, 1> S{(const char*)(ws + WS_B4), 0, nullptr, (const char*)(ws + WS_WT_KVQ), 0, G, bx};
                EpiSplit3 E{(bf16*)(ws + WS_B1), true, (const float*)(ws + WS_B0)};
                pg8::gemm_phase<EpiSplit3, SchedGrouped<12, 1>, true, false, C>(lds, S, E, wave);
            }
            SEAM(PH_KVQ);
            if (IN(PH_ATTN)) REP(PH_ATTN) { IDS(); attn_mfma(ws, lds, gw, NGW, lane, wave); }
            SEAM(PH_ATTN);
            if (IN(PH_SBO)) {
                SchedGrouped<4, 1> S{(const char*)(ws + WS_B0), 0, nullptr, (const char*)(ws + WS_WT_SBO), 0, G, bx};
                EpiResidBf<false> E{(const void*)(ws + WS_B4), (bf16*)(ws + WS_B4)};
                pg8::gemm_phase<EpiResidBf<false>, SchedGrouped<4, 1>, true, false, C>(lds, S, E, wave);
            }
            SEAM(PH_SBO);
        }
    }
    if (IN(PH_FINAL)) { IDS(); combine_rows(ws, 1, gw, NGW, lane); }
#undef IN
#undef SEAM
}

extern "C" void kernel_launch(void* const* d_in, const int* in_sizes, int n_in, void* d_out, int out_size, void* d_ws, size_t ws_size, hipStream_t stream) {
    static int grid = 0;
    if (grid == 0) {
        if (n_in != 31 || in_sizes[0] != M * C || out_size != M * C || ws_size < WS_END) { fprintf(stderr, "kernel_launch: unexpected shapes (n_in %d, in0 %d, out %d, ws %zu); nothing launched\n", n_in, n_in > 0 ? in_sizes[0] : -1, out_size, ws_size); grid = -1; return; }
        int dev = 0, cus = 0, per_cu = 0;
        if (hipGetDevice(&dev) != hipSuccess || hipDeviceGetAttribute(&cus, hipDeviceAttributeMultiprocessorCount, dev) != hipSuccess) { grid = -1; return; }
        if (hipFuncSetAttribute((const void*)yoco_fwd, hipFuncAttributeMaxDynamicSharedMemorySize, LDS_BYTES) != hipSuccess) { fprintf(stderr, "kernel_launch: hipFuncSetAttribute failed\n"); grid = -1; return; }
        if (hipOccupancyMaxActiveBlocksPerMultiprocessor(&per_cu, (const void*)yoco_fwd, NWAVES * 64, LDS_BYTES) != hipSuccess || per_cu < 1) fprintf(stderr, "kernel_launch: occupancy query reports %d\n", per_cu);
        (void)hipGetLastError();
        grid = cus - (cus % 16);
    }
    if (grid < 0) return;
    if (hipMemsetAsync((char*)d_ws + WS_CTL, 0, CTL_ZERO_BYTES, stream) != hipSuccess) return;
    Args a{};
    for (int i = 0; i < 31; ++i) a.in[i] = (const float*)d_in[i];
    a.out = (float*)d_out; a.ws = (unsigned char*)d_ws;
    for (int li = 0; li < (N_LAUNCHES == 1 ? 1 : (int)NPHASE); ++li) {
        a.ph_lo = (N_LAUNCHES == 1) ? 0 : li; a.ph_hi = (N_LAUNCHES == 1) ? NPHASE : li + 1; a.li = li;
        hipLaunchKernelGGL(yoco_fwd, dim3(grid), dim3(NWAVES * 64), LDS_BYTES, stream, a);
        const hipError_t le = hipPeekAtLastError();
        if (le != hipSuccess) { fprintf(stderr, "kernel_launch: launch %d failed: %s\n", li, hipGetErrorName(le)); break; }
    }
}
```

```cpp
#include <hip/hip_runtime.h>
#include <cstdio>
#include <cstdint>

#ifndef MK_N_LAUNCHES
#define MK_N_LAUNCHES 1
#endif

namespace pg8 {
#define PG8_LAS __attribute__((address_space(3)))
typedef unsigned short bf16_t;
typedef short bf16x8 __attribute__((ext_vector_type(8)));
typedef float f32x4 __attribute__((ext_vector_type(4)));
typedef unsigned u32x4 __attribute__((ext_vector_type(4)));
constexpr int BM = 256, BK = 64, HALF = 128, HTB = HALF * BK * 2, STAGE_BYTES = 8 * HTB, NXCD = 8, WGM = 8;

__host__ __device__ __forceinline__ int lds_byte(int r, int c) { const int st = (r >> 4) * 2 + (c >> 5), rr = r & 15, cc = c & 31, ob = rr * 64 + cc * 2; return st * 1024 + (ob ^ (((ob >> 9) & 1) << 5)); }
__host__ __device__ __forceinline__ void stage_rc(int b, int& R, int& C) { const int st = b / 1024, sb = b % 1024, swz = sb ^ (((sb >> 9) & 1) << 5); R = (st >> 1) * 16 + swz / 64; C = (st & 1) * 32 + (swz % 64) / 2; }
__host__ __device__ __forceinline__ int perm32(int rho) { const int n = rho >> 4, i = rho & 15; return 8 * (i >> 2) + 4 * n + (i & 3); }

struct Unit { int pm, pn, aux, r0, cnt; };

__host__ __device__ __forceinline__ void tile_map(int wgid, int nM, int nN, int& pm, int& pn) {
    const int nwg = nM * nN;
    { const int q = nwg / NXCD, r = nwg % NXCD, xcd = wgid % NXCD, off = wgid / NXCD; wgid = (xcd < r ? xcd * (q + 1) : r * (q + 1) + (xcd - r) * q) + off; }
    const int nig = WGM * nN, gid = wgid / nig, fm = gid * WGM, gsz = (nM - fm) < WGM ? (nM - fm) : WGM;
    pm = fm + ((wgid % nig) % gsz); pn = (wgid % nig) / gsz;
}

typedef float f32x2_t __attribute__((ext_vector_type(2))); typedef __bf16 bf16x2_t __attribute__((ext_vector_type(2)));
__device__ __forceinline__ unsigned cvt_pk_bf16(float lo, float hi) { const f32x2_t v = {lo, hi}; const bf16x2_t b = __builtin_convertvector(v, bf16x2_t); return __builtin_bit_cast(unsigned, b); }

template <class Epi, class Sched, bool ALIGN_EPI, bool GATHER, int K>
__device__ __forceinline__ void gemm_phase(PG8_LAS unsigned char* lds, const Sched& S, const Epi& E, const int wid) {
    int lane_; asm volatile("v_mbcnt_lo_u32_b32 %0, -1, 0\n\tv_mbcnt_hi_u32_b32 %0, -1, %0" : "=v"(lane_));
    const int lane = lane_, tid = wid * 64 + lane, wr = wid >> 2, wc = wid & 3, fr = lane & 15, fq = lane >> 4;
    constexpr int nt = K / BK;
    unsigned voffA[2], voffB[2];
#pragma unroll
    for (int i = 0; i < 2; ++i) { int R, C; stage_rc(tid * 16 + i * 8192, R, C); const int Rb = Epi::PERM ? ((R & ~31) + perm32(R & 31)) : R;
        voffA[i] = (unsigned)(R * K + C) * 2u; voffB[i] = (unsigned)(Rb * K + C) * 2u; }
    constexpr size_t kstep = (size_t)(BK * 2);
    constexpr size_t hstep = (size_t)HALF * K * 2;
    const unsigned ldsw = (unsigned)wid * 1024u;
    const int aoff = lds_byte(wr * 64 + fr, fq * 8), boff = lds_byte(wc * 32 + fr, fq * 8);
#define PG8_SA(b, h) (((b) * 2 + (h)) * HTB)
#define PG8_SB(b, h) ((4 + (b) * 2 + (h)) * HTB)
#define PG8_STAGE(bufoff, gbase, voff) do { _Pragma("unroll") for (int _i = 0; _i < 2; ++_i) \
        __builtin_amdgcn_global_load_lds((const unsigned*)((const char*)(gbase) + (voff)[_i]), (PG8_LAS unsigned*)(lds + (bufoff) + ldsw + _i * 8192), 16, 0, 0); } while (0)
#define PG8_LDA(dst, b, h) do { _Pragma("unroll") for (int m = 0; m < 4; ++m) _Pragma("unroll") for (int k = 0; k < 2; ++k) dst[m][k] = *(const PG8_LAS bf16x8*)(lds + PG8_SA(b, h) + aoff + m * 2048 + k * 1024); } while (0)
#define PG8_LDB(dst, b, h) do { _Pragma("unroll") for (int n = 0; n < 2; ++n) _Pragma("unroll") for (int k = 0; k < 2; ++k) dst[n][k] = *(const PG8_LAS bf16x8*)(lds + PG8_SB(b, h) + boff + n * 2048 + k * 1024); } while (0)
#define PG8_MMA(ai, bj, At, Bt) do { __builtin_amdgcn_s_setprio(1); _Pragma("unroll") for (int m = 0; m < 4; ++m) _Pragma("unroll") for (int n = 0; n < 2; ++n) _Pragma("unroll") for (int k = 0; k < 2; ++k) \
        acc[ai][bj][m][n] = __builtin_amdgcn_mfma_f32_16x16x32_bf16(Bt[n][k], At[m][k], acc[ai][bj][m][n], 0, 0, 0); __builtin_amdgcn_s_setprio(0); } while (0)
#define PG8_WAIT_V(n) asm volatile("s_waitcnt vmcnt(" #n ")" ::: "memory")
#define PG8_WAIT_L(n) asm volatile("s_waitcnt lgkmcnt(" #n ")" ::: "memory")
#define PG8_BAR __builtin_amdgcn_s_barrier()
#define PG8_SCHED __builtin_amdgcn_sched_barrier(0)
    Unit cur, nxt; int ui = 0;
    if (!S.next(0, cur)) return;
    f32x4 acc[2][2][4][2];
#pragma unroll
    for (int a = 0; a < 2; ++a)
#pragma unroll
        for (int b = 0; b < 2; ++b)
#pragma unroll
            for (int m = 0; m < 4; ++m)
#pragma unroll
                for (int n = 0; n < 2; ++n) acc[a][b][m][n] = (f32x4){0.f, 0.f, 0.f, 0.f};
    bf16x8 At[4][2], B0[2][2], B1[2][2];
    unsigned vc[2][2];
#define PG8_GOFF(u) do { _Pragma("unroll") for (int _h = 0; _h < 2; ++_h) _Pragma("unroll") for (int _i = 0; _i < 2; ++_i) { int _R, _C; stage_rc(tid * 16 + _i * 8192, _R, _C); \
        vc[_h][_i] = S.a_row_off(u, _h * HALF + _R) + (unsigned)_C * 2u; } } while (0)
#define PG8_STAGE_A(bufoff, gbase, h) do { if constexpr (GATHER) { PG8_STAGE(bufoff, gbase, vc[h]); } else { PG8_STAGE(bufoff, (gbase) + (h) * hstep, voffA); } } while (0)
    if constexpr (GATHER) PG8_GOFF(cur);
    const char* cA = S.a_base(cur); const char* cB = S.b_base(cur);
    PG8_STAGE(PG8_SB(0, 0), cB, voffB); PG8_STAGE(PG8_SB(0, 1), cB + hstep, voffB); PG8_STAGE_A(PG8_SA(0, 0), cA, 0); PG8_STAGE_A(PG8_SA(0, 1), cA, 1);
    if (wr == 1) PG8_BAR;
    PG8_WAIT_V(2); PG8_BAR;
    PG8_STAGE(PG8_SB(1, 0), cB + kstep, voffB); PG8_STAGE_A(PG8_SA(1, 0), cA + kstep, 0); PG8_STAGE(PG8_SB(1, 1), cB + hstep + kstep, voffB);
    PG8_WAIT_V(6); PG8_BAR;
    for (;;) {
        const bool has_next = S.next(ui + 1, nxt);
        const char* nA = has_next ? S.a_base(nxt) : cA; const char* nB = has_next ? S.b_base(nxt) : cB;
        for (int t = 0; t < nt; t += 2) {
            const bool last = (t == nt - 2);
            const char* a1 = cA + (size_t)(t + 1) * kstep;
            const char* a2 = last ? nA : cA + (size_t)(t + 2) * kstep; const char* b2 = last ? nB : cB + (size_t)(t + 2) * kstep;
            const char* a3 = a2 + kstep; const char* b3 = b2 + kstep;
            PG8_LDB(B0, 0, 0); PG8_LDB(B1, 0, 1); PG8_SCHED; PG8_LDA(At, 0, 0); PG8_STAGE_A(PG8_SA(1, 1), a1, 1);
            if constexpr (GATHER) { if (last && has_next) PG8_GOFF(nxt); }
            PG8_WAIT_V(8); PG8_WAIT_L(0); PG8_BAR; PG8_MMA(0, 0, At, B0); PG8_MMA(0, 1, At, B1); PG8_BAR; PG8_SCHED;
            PG8_LDA(At, 0, 1); PG8_STAGE(PG8_SB(0, 0), b2, voffB); PG8_STAGE(PG8_SB(0, 1), b2 + hstep, voffB); PG8_STAGE_A(PG8_SA(0, 0), a2, 0);
            PG8_WAIT_V(8); PG8_WAIT_L(0); PG8_BAR; PG8_MMA(1, 0, At, B0); PG8_MMA(1, 1, At, B1); PG8_BAR; PG8_SCHED;
            PG8_LDB(B0, 1, 0); PG8_LDB(B1, 1, 1); PG8_SCHED; PG8_LDA(At, 1, 0); PG8_STAGE_A(PG8_SA(0, 1), a2, 1);
            PG8_WAIT_V(8); PG8_WAIT_L(0); PG8_BAR; PG8_MMA(0, 0, At, B0); PG8_MMA(0, 1, At, B1); PG8_BAR; PG8_SCHED;
            PG8_LDA(At, 1, 1); PG8_STAGE(PG8_SB(1, 0), b3, voffB); PG8_STAGE(PG8_SB(1, 1), b3 + hstep, voffB); PG8_STAGE_A(PG8_SA(1, 0), a3, 0);
            PG8_WAIT_V(8); PG8_WAIT_L(0); PG8_BAR; PG8_MMA(1, 0, At, B0); PG8_MMA(1, 1, At, B1); PG8_BAR; PG8_SCHED;
        }
        if constexpr (ALIGN_EPI) { if (wr == 0) PG8_BAR; }
        E(acc, cur, wr, wc, fr, fq);
        if (!has_next) break;
#pragma unroll
        for (int a = 0; a < 2; ++a)
#pragma unroll
            for (int b = 0; b < 2; ++b)
#pragma unroll
                for (int m = 0; m < 4; ++m)
#pragma unroll
                    for (int n = 0; n < 2; ++n) acc[a][b][m][n] = (f32x4){0.f, 0.f, 0.f, 0.f};
        cur = nxt; cA = nA; cB = nB; ++ui;
        if constexpr (ALIGN_EPI) { if (wr == 1) PG8_BAR; }
    }
    PG8_WAIT_V(0);
    if constexpr (!ALIGN_EPI) { if (wr == 0) PG8_BAR; }
    PG8_BAR;
#undef PG8_SA
#undef PG8_SB
#undef PG8_STAGE
#undef PG8_STAGE_A
#undef PG8_GOFF
#undef PG8_LDA
#undef PG8_LDB
#undef PG8_MMA
#undef PG8_WAIT_V
#undef PG8_WAIT_L
#undef PG8_BAR
#undef PG8_SCHED
}
}

constexpr int NWAVES = 8;
#ifndef MK_DEBUG
#define MK_DEBUG 0
#endif
#ifndef DBG_USE_NAIVE
#define DBG_USE_NAIVE 0
#endif
constexpr int DBGP = MK_DEBUG ? 3 : 0;
enum Phase { PH_P0 = 0, PH_LORA, PH_RKV, PH_S1, PH_S2, PH_S3, PH_DBG0, PH_WOUT = PH_DBG0 + DBGP, PH_ROUT0, PH_GU0, PH_DN0, PH_COMB, PH_KVQ, PH_ATTN, PH_SBO, PH_ROUT1, PH_GU1, PH_DN1, PH_FINAL, NPHASE };
constexpr int N_LAUNCHES = MK_N_LAUNCHES;


constexpr int BATCH = 2, SEQ = 8192, C = 1024, NH = 16, HD = 64, M = BATCH * SEQ;
constexpr int NE = 16, FE = 256, DW = 64, DA = 64, DG = 160;
constexpr float RMS_EPS = 1e-6f, GN_EPS = 64e-5f;
constexpr float SB_EXIT = 104.0f;

constexpr size_t MiB = 1u << 20;
constexpr size_t WS_CTL = 0, CTL_ZERO_BYTES = 64 * 1024;
constexpr size_t WS_WT_W2 = 128 * 1024, WS_WT_A2 = 256 * 1024, WS_WT_G2 = 384 * 1024;
constexpr size_t WS_WT_RKV = 1 * MiB;
constexpr size_t WS_WT_LORA = 7 * MiB;
constexpr size_t WS_WT_OUT = 9 * MiB;
constexpr size_t WS_WT_KVQ = 11 * MiB;
constexpr size_t WS_WT_SBO = 17 * MiB;
constexpr size_t WS_WT_GU = 19 * MiB;
constexpr size_t WS_WT_DN = 51 * MiB;
constexpr size_t WS_LW = 67 * MiB;
constexpr size_t WS_LA = 69 * MiB;
constexpr size_t WS_LG = 71 * MiB;
static_assert(WS_LA == WS_LW + 2 * MiB && WS_LG == WS_LW + 4 * MiB, "EpiLora's pointer arithmetic");
constexpr size_t WS_LIST = 76 * MiB;
constexpr size_t WS_WL = 77 * MiB;
constexpr size_t WS_HID = 78 * MiB;
constexpr size_t WS_B0 = 96 * MiB, WS_B1 = 128 * MiB, WS_B2 = 160 * MiB, WS_B3 = 192 * MiB, WS_B4 = 224 * MiB, WS_END = 256 * MiB;
static_assert(WS_HID + (size_t)144 * 256 * 256 * 2 <= WS_B0, "HID vs B0");
constexpr int CW_TMO = 0;
constexpr int CW_CNT = 1024;
constexpr int CW_BAR = 4096;

constexpr int RING_BYTES = 131072;
constexpr int LDSCTL_OFF = 146688, MISC_OFF = LDSCTL_OFF + 320, MOE_TAB_OFF = MISC_OFF + 128;
constexpr int LDS_BYTES = 147456;
static_assert(MOE_TAB_OFF + 256 <= LDS_BYTES, "LDS map");
static_assert(BATCH * NH * (SEQ / 64) % 16 == 0, "scan units");

#define GAS __attribute__((address_space(1)))
#define LAS __attribute__((address_space(3)))
typedef unsigned short bf16;
typedef unsigned v4u __attribute__((ext_vector_type(4)));
typedef unsigned v2u __attribute__((ext_vector_type(2)));
typedef float f32x4 __attribute__((ext_vector_type(4)));
typedef GAS unsigned gu32;
#define RLX_AGENT __ATOMIC_RELAXED, __HIP_MEMORY_SCOPE_AGENT
#define LDS_WAIT() asm volatile("s_waitcnt lgkmcnt(0)" ::: "memory")
#define VM_WAIT() asm volatile("s_waitcnt vmcnt(0)" ::: "memory")
__device__ __forceinline__ unsigned f2bf(float f) { unsigned u = __builtin_bit_cast(unsigned, f); return (u + 0x7fffu + ((u >> 16) & 1u)) >> 16; }
__device__ __forceinline__ unsigned pk2(float lo, float hi) { return f2bf(lo) | (f2bf(hi) << 16); }
__device__ __forceinline__ float bflo(unsigned u) { return __uint_as_float(u << 16); }
__device__ __forceinline__ float bfhi(unsigned u) { return __uint_as_float(u & 0xffff0000u); }
__device__ __forceinline__ float bf2f(bf16 b) { return __uint_as_float((unsigned)b << 16); }
__device__ __forceinline__ float sigmoidf_(float x) { return 1.0f / (1.0f + __expf(-x)); }

#define XB_TMO      128
#define XB_XCNT(j)  (256  + 64 * (j))
#define XB_XSUB(j)  (1280 + 64 * (j))
#define XB_XGEN(j)  (2304 + 64 * (j))
#define XB_TOP      3328
#define XB_TOPGEN   3392
#define XCD_BAR_WORDS 3456
#define XB_SPIN_CAP (1u << 18)
__device__ __forceinline__ unsigned xb_ld(unsigned* p)              { return __hip_atomic_load(p, __ATOMIC_RELAXED, __HIP_MEMORY_SCOPE_AGENT); }
__device__ __forceinline__ unsigned xb_add(unsigned* p, unsigned v) { return __hip_atomic_fetch_add(p, v, __ATOMIC_RELAXED, __HIP_MEMORY_SCOPE_AGENT); }
__device__ __forceinline__ unsigned xb_xcc_id() { return (unsigned)__builtin_amdgcn_s_getreg((3 << 11) | 20) & 0xFu; }
#define XB_SPIN(cond, bar) do { unsigned _sp = 0; while (cond) { __builtin_amdgcn_s_sleep(1); \
    if ((++_sp & 255u) == 0u) { if (xb_ld(&(bar)[XB_TMO])) break; if (_sp > XB_SPIN_CAP) { atomicAdd(&(bar)[XB_TMO], 1u); break; } } } } while (0)
struct XcdBarrier { unsigned* bar; unsigned x; volatile LAS unsigned* st; };
__device__ __forceinline__ XcdBarrier xcd_barrier_post(unsigned* bar, volatile LAS unsigned* st) {
    XcdBarrier b; b.bar = bar; b.x = xb_xcc_id(); b.st = st;
    if (threadIdx.x == 0) (void)xb_add(&bar[XB_XCNT(b.x)], 1u);
    return b;
}
__device__ __forceinline__ void xcd_barrier_complete(unsigned* bar, unsigned x, unsigned& nloc, unsigned& nx) {
    const unsigned G = gridDim.x * gridDim.y * gridDim.z;
    unsigned sum, cnt, mine, sp = 0u;
    for (;;) {
        sum = 0u; cnt = 0u; mine = 0u;
#pragma unroll
        for (unsigned j = 0; j < 16; ++j) { const unsigned c = xb_ld(&bar[XB_XCNT(j)]); sum += c; cnt += (c > 0u) ? 1u : 0u; mine = (j == x) ? c : mine; }
        if (sum == G) break;
        __builtin_amdgcn_s_sleep(1);
        if ((++sp & 255u) == 0u) { if (xb_ld(&bar[XB_TMO])) break; if (sp > XB_SPIN_CAP) { atomicAdd(&bar[XB_TMO], 1u); break; } }
    }
    nloc = mine > 0u ? mine : 1u; nx = cnt > 0u ? cnt : 1u;
}
__device__ __forceinline__ void xcd_barrier(const XcdBarrier& b) {
    asm volatile("s_waitcnt vmcnt(0)" ::: "memory");
    __syncthreads();
    if (threadIdx.x == 0) {
        unsigned* bar = b.bar;
        __builtin_amdgcn_s_waitcnt(0);
        unsigned nloc = b.st[0], nx = b.st[1];
        if (nloc == 0u) { xcd_barrier_complete(bar, b.x, nloc, nx); b.st[0] = nloc; b.st[1] = nx; }
        const unsigned old = xb_add(&bar[XB_XSUB(b.x)], 1u);
        const unsigned gen = old / nloc;
        if (old + 1u == (gen + 1u) * nloc) {
            __builtin_amdgcn_fence(__ATOMIC_RELEASE, "agent");
            asm volatile("s_waitcnt vmcnt(0)" ::: "memory");
            const unsigned og = xb_add(&bar[XB_TOP], 1u);
            const unsigned tg = og / nx;
            if (og + 1u == (tg + 1u) * nx) xb_add(&bar[XB_TOPGEN], 1u);
            else XB_SPIN(xb_ld(&bar[XB_TOPGEN]) == tg, bar);
            __builtin_amdgcn_fence(__ATOMIC_ACQUIRE, "agent");
            xb_add(&bar[XB_XGEN(b.x)], 1u);
            asm volatile("s_waitcnt vmcnt(0)" ::: "memory");
        } else {
            XB_SPIN(xb_ld(&bar[XB_XGEN(b.x)]) == gen, bar);
            __builtin_amdgcn_fence(__ATOMIC_ACQUIRE, "agent");
            asm volatile("s_waitcnt vmcnt(0)" ::: "memory");
        }
    }
    __syncthreads();
}

__device__ __forceinline__ float shx(float v, int o, int lane) { return __int_as_float(__builtin_amdgcn_ds_bpermute((lane ^ o) << 2, __float_as_int(v))); }
#define DPP_ADD(v, ctrl) ((v) + __int_as_float(__builtin_amdgcn_update_dpp(0, __float_as_int(v), (ctrl), 0xf, 0xf, true)))
__device__ __forceinline__ float wave_sum(float v, int lane) {
    (void)lane;
    v = DPP_ADD(v, 0x128); v = DPP_ADD(v, 0x124); v = DPP_ADD(v, 0x122); v = DPP_ADD(v, 0x121);
    const int iv = __float_as_int(v);
    return (__int_as_float(__builtin_amdgcn_readlane(iv, 0)) + __int_as_float(__builtin_amdgcn_readlane(iv, 16))) + (__int_as_float(__builtin_amdgcn_readlane(iv, 32)) + __int_as_float(__builtin_amdgcn_readlane(iv, 48)));
}
__device__ __forceinline__ float sum8(float v) { v = DPP_ADD(v, 0xB1); v = DPP_ADD(v, 0x4E); v = DPP_ADD(v, 0x141); return v; }
__device__ __forceinline__ void transpose_item(const float* W, int ldw, int k0, int n0, bf16* WT, int ldk, int dst_row0, const float* kscale, LAS float* scr, int lane, int kmax = 1 << 30) {
    const int r8 = lane >> 3, quad = lane & 7;
    f32x4 v[8];
#pragma unroll
    for (int i = 0; i < 8; ++i) { const int kk = r8 + 8 * i; v[i] = (k0 + kk < kmax) ? *(const GAS f32x4*)(W + (size_t)(k0 + kk) * ldw + n0 + quad * 4) : (f32x4){0.f, 0.f, 0.f, 0.f}; }
#pragma unroll
    for (int i = 0; i < 8; ++i) { const int kk = r8 + 8 * i; if (kscale) v[i] = v[i] * kscale[(k0 + kk < kmax) ? k0 + kk : 0]; *(LAS f32x4*)(scr + kk * 36 + ((quad ^ i) << 2)) = v[i]; }
    LDS_WAIT(); asm volatile("" ::: "memory");
    const int c = lane & 7;
#pragma unroll
    for (int j = 0; j < 4; ++j) { const int n = (lane >> 3) + 8 * j; const LAS float* sp = scr + (8 * c) * 36 + ((((n >> 2) ^ c) << 2) | (n & 3));
        v4u o; o.x = pk2(sp[0 * 36], sp[1 * 36]); o.y = pk2(sp[2 * 36], sp[3 * 36]); o.z = pk2(sp[4 * 36], sp[5 * 36]); o.w = pk2(sp[6 * 36], sp[7 * 36]);
        if (k0 + 8 * c < kmax) *(GAS v4u*)(WT + (size_t)(dst_row0 + n) * ldk + k0 + 8 * c) = o; }
    LDS_WAIT(); asm volatile("" ::: "memory");
}

struct Args { const float* in[31]; float* out; unsigned char* ws; int ph_lo, ph_hi, li, pad; };
typedef const __attribute__((address_space(4))) unsigned char* kaptr_t;
__device__ __forceinline__ kaptr_t ka_base() { kaptr_t p = (kaptr_t)__builtin_amdgcn_kernarg_segment_ptr(); asm volatile("" : "+s"(p)); return p; }
#define INP(k) (*(const float* const __attribute__((address_space(4)))*)(ka_base() + 8 * (k)))
#define OUTP() (*(float* const __attribute__((address_space(4)))*)(ka_base() + 8 * 31))
#define WSP() (*(unsigned char* const __attribute__((address_space(4)))*)(ka_base() + 8 * 32))
#define KA_INT(i) (*(const int __attribute__((address_space(4)))*)(ka_base() + 8 * 33 + 4 * (i)))

template <int PART> __device__ __forceinline__ void p0_weights(unsigned char* ws, LAS unsigned char* lds, int gw, int NGW, int wave, int lane) {
    LAS float* scr = (LAS float*)(lds + wave * 16384);
    bf16* WT_RKV = (bf16*)(ws + WS_WT_RKV); bf16* WT_LORA = (bf16*)(ws + WS_WT_LORA); bf16* WT_OUT = (bf16*)(ws + WS_WT_OUT); bf16* WT_KVQ = (bf16*)(ws + WS_WT_KVQ);
    bf16* WT_SBO = (bf16*)(ws + WS_WT_SBO); bf16* WT_GU = (bf16*)(ws + WS_WT_GU); bf16* WT_DN = (bf16*)(ws + WS_WT_DN);
    constexpr int I_UP = 32 + 32 + 96, I_RKV = 3 * 512, I_LORA = 32 + 32 + 80, I_OUT = 512, I_KV = 1024, I_Q = 512, I_SBO = 512, I_G = 32 * 128, I_U = 32 * 128, I_D = 32 * 128;
    constexpr int NDENSE = I_UP + I_RKV + I_LORA + I_OUT + I_KV + I_Q + I_SBO, NITEMS = NDENSE + I_G + I_U + I_D;
    constexpr int NLOOP = PART == 0 ? NDENSE : 3 * 2048; (void)NITEMS;
    for (int q_ = gw; q_ < NLOOP; q_ += NGW) {
        const int it = PART == 0 ? q_ : NDENSE + (q_ / 2048) * 4096 + 2048 * (PART - 1) + (q_ % 2048);
        int r = it;
        if (r < I_UP) {
            if (r < 32) transpose_item(INP(9), C, 0, 32 * r, (bf16*)(ws + WS_WT_W2), 64, 32 * r, nullptr, scr, lane);
            else if (r < 64) transpose_item(INP(12), C, 0, 32 * (r - 32), (bf16*)(ws + WS_WT_A2), 64, 32 * (r - 32), nullptr, scr, lane);
            else { const int q = r - 64, kb = q / 32, nb = q % 32; transpose_item(INP(14), C, 64 * kb, 32 * nb, (bf16*)(ws + WS_WT_G2), DG, 32 * nb, nullptr, scr, lane, DG); }
            continue; } r -= I_UP;
        if (r < I_RKV) { const int m = r / 512, q = r % 512, kb = q / 32, nb = q % 32; transpose_item(INP(6) + (size_t)m * C * C, C, 64 * kb, 32 * nb, WT_RKV, C, m * C + 32 * nb, nullptr, scr, lane); continue; } r -= I_RKV;
        if (r < I_LORA) {
            if (r < 32) { const int kb = r / 2, nb = r % 2; transpose_item(INP(8), DW, 64 * kb, 32 * nb, WT_LORA, C, 32 * nb, nullptr, scr, lane); }
            else if (r < 64) { const int q = r - 32, kb = q / 2, nb = q % 2; transpose_item(INP(11), DA, 64 * kb, 32 * nb, WT_LORA, C, 256 + 32 * nb, nullptr, scr, lane); }
            else { const int q = r - 64, kb = q / 5, nb = q % 5; transpose_item(INP(13), DG, 64 * kb, 32 * nb, WT_LORA, C, 512 + 32 * nb, nullptr, scr, lane); }
            continue; } r -= I_LORA;
        if (r < I_OUT) { const int kb = r / 32, nb = r % 32; transpose_item(INP(20), C, 64 * kb, 32 * nb, WT_OUT, C, 32 * nb, nullptr, scr, lane); continue; } r -= I_OUT;
        if (r < I_KV) { const int kb = r / 64, nb = r % 64; transpose_item(INP(21), 2 * C, 64 * kb, 32 * nb, WT_KVQ, C, 32 * nb, INP(3), scr, lane); continue; } r -= I_KV;
        if (r < I_Q) { const int kb = r / 32, nb = r % 32; transpose_item(INP(22), C, 64 * kb, 32 * nb, WT_KVQ, C, 2 * C + 32 * nb, INP(1) + C, scr, lane); continue; } r -= I_Q;
        if (r < I_SBO) { const int kb = r / 32, nb = r % 32; transpose_item(INP(23), C, 64 * kb, 32 * nb, WT_SBO, C, 32 * nb, nullptr, scr, lane); continue; } r -= I_SBO;
        if (r < I_G) { const int le = r / 128, q = r % 128, kb = q / 8, nb = q % 8, f0 = 32 * nb; transpose_item(INP(28) + (size_t)le * C * FE, FE, 64 * kb, f0, WT_GU + (size_t)le * 512 * C, C, 256 * (f0 / 128) + (f0 % 128), INP(2) + (le >> 4) * C, scr, lane); continue; } r -= I_G;
        if (r < I_U) { const int le = r / 128, q = r % 128, kb = q / 8, nb = q % 8, f0 = 32 * nb; transpose_item(INP(29) + (size_t)le * C * FE, FE, 64 * kb, f0, WT_GU + (size_t)le * 512 * C, C, 256 * (f0 / 128) + 128 + (f0 % 128), INP(2) + (le >> 4) * C, scr, lane); continue; } r -= I_U;
        { const int le = r / 128, q = r % 128, kb = q / 32, nb = q % 32; transpose_item(INP(30) + (size_t)le * FE * C, C, 64 * kb, 32 * nb, WT_DN + (size_t)le * C * FE, FE, 32 * nb, nullptr, scr, lane); }
    }
    if (PART == 0) for (int it = gw * 64 + lane; it < 768 * 128; it += NGW * 64) { const int row = it >> 7, ch = it & 127;
        const bool valid = (row < 64) || (row >= 256 && row < 320) || (row >= 512 && row < 672);
        if (!valid) *(GAS v4u*)(WT_LORA + (size_t)row * C + ch * 8) = (v4u){0u, 0u, 0u, 0u}; }
}
__device__ __forceinline__ void load_row(const float* p, int lane, f32x4 (&v)[4]) {
#pragma unroll
    for (int j = 0; j < 4; ++j) v[j] = ((const GAS f32x4*)p)[64 * j + lane];
}
__device__ __forceinline__ void load_row_bf(const bf16* p, int lane, f32x4 (&v)[4]) {
#pragma unroll
    for (int j = 0; j < 4; ++j) { const v2u w = ((const GAS v2u*)p)[64 * j + lane]; v[j] = (f32x4){bflo(w.x), bfhi(w.x), bflo(w.y), bfhi(w.y)}; }
}
__device__ __forceinline__ float row_rs(const f32x4 (&v)[4], int lane) {
    float s = 0.f;
#pragma unroll
    for (int j = 0; j < 4; ++j) s += (v[j].x * v[j].x + v[j].y * v[j].y) + (v[j].z * v[j].z + v[j].w * v[j].w);
    return 1.0f / sqrtf(wave_sum(s, lane) * (1.0f / C) + RMS_EPS);
}
__device__ __forceinline__ void store_row_bf16(bf16* p, int lane, const f32x4 (&v)[4]) {
#pragma unroll
    for (int j = 0; j < 4; ++j) { v2u o; o.x = pk2(v[j].x, v[j].y); o.y = pk2(v[j].z, v[j].w); ((GAS v2u*)p)[64 * j + lane] = o; }
}
__device__ __forceinline__ void p0_rows(unsigned char* ws, int gw, int NGW, int lane) {
    const float* x = INP(0); const float* gain = INP(1); const float* mix = INP(5);
    f32x4 g[4]; load_row(gain, lane, g);
    for (int run = gw; run < M / 8; run += NGW) {
        const int r0 = run * 8;
        f32x4 prev[4];
        if ((r0 % SEQ) == 0) {
#pragma unroll
            for (int j = 0; j < 4; ++j) prev[j] = (f32x4){0.f, 0.f, 0.f, 0.f};
        } else { load_row(x + (size_t)(r0 - 1) * C, lane, prev); const float rs = row_rs(prev, lane);
#pragma unroll
            for (int j = 0; j < 4; ++j) prev[j] = prev[j] * rs * g[j]; }
        for (int rr = 0; rr < 8; ++rr) {
            const int row = r0 + rr;
            f32x4 hn[4]; load_row(x + (size_t)row * C, lane, hn); const float rs = row_rs(hn, lane);
#pragma unroll
            for (int j = 0; j < 4; ++j) hn[j] = hn[j] * rs * g[j];
#pragma unroll
            for (int i = 0; i < 6; ++i) { f32x4 o[4];
#pragma unroll
                for (int j = 0; j < 4; ++j) { const f32x4 mx = ((const GAS f32x4*)(mix + i * C))[64 * j + lane]; o[j] = hn[j] + (prev[j] - hn[j]) * mx; }
                bf16* dst = i < 2 ? (bf16*)OUTP() + (size_t)i * M * C : (i == 2 ? (bf16*)(ws + WS_B4) : (bf16*)(ws + WS_B1) + (size_t)(i - 3) * M * C);
                store_row_bf16(dst + (size_t)row * C, lane, o); }
#pragma unroll
            for (int j = 0; j < 4; ++j) prev[j] = hn[j];
        }
    }
}

template <int NN, int NGROUPS> struct SchedGrouped {
    static constexpr int K = C;
    const char* A0; size_t astride; const char* A2; const char* B; size_t bgroup;
    int G, c;
    __device__ __forceinline__ bool next(int i, pg8::Unit& u) const {
        const int L = i * G + c; constexpr int per = 64 * NN; if (L >= per * NGROUPS) return false;
        const int g = L / per, w = L % per; pg8::tile_map(w, 64, NN, u.pm, u.pn); u.aux = g; u.r0 = 0; u.cnt = 0; return true; }
    __device__ __forceinline__ const char* a_base(const pg8::Unit& u) const { const char* A = (A2 != nullptr && u.aux == 2) ? A2 : A0 + (size_t)u.aux * astride; return A + (size_t)u.pm * 256 * K * 2; }
    __device__ __forceinline__ const char* b_base(const pg8::Unit& u) const { return B + (size_t)u.aux * bgroup + (size_t)u.pn * 256 * K * 2; }
    __device__ __forceinline__ unsigned a_row_off(const pg8::Unit&, int) const { return 0u; }
};
template <int NN, int K, bool GATHER> struct SchedMoe {
    const char* A; const char* B; size_t bexp; const unsigned* list; volatile LAS int* tab; int G, c;
    __device__ __forceinline__ bool next(int i, pg8::Unit& u) const {
        const int L = i * G + c; const int tot = __builtin_amdgcn_readfirstlane(tab[48]) * NN; if (L >= tot) return false;
        u.pm = L / NN; u.pn = L % NN; int e = 0;
#pragma unroll
        for (int j = 0; j < 16; ++j) e += (u.pm >= tab[32 + j]) ? 1 : 0;
        e = __builtin_amdgcn_readfirstlane(e);
        u.aux = e; u.r0 = (u.pm - __builtin_amdgcn_readfirstlane(tab[16 + e])) * 256; u.cnt = __builtin_amdgcn_readfirstlane(tab[e]); return true; }
    __device__ __forceinline__ const char* a_base(const pg8::Unit& u) const { return GATHER ? A : A + (size_t)u.pm * 256 * K * 2; }
    __device__ __forceinline__ const char* b_base(const pg8::Unit& u) const { return B + (size_t)u.aux * bexp + (size_t)u.pn * 256 * K * 2; }
    __device__ __forceinline__ unsigned a_row_off(const pg8::Unit& u, int r) const {
        const int idx = u.r0 + r; unsigned tok = 0u;
        if (idx < u.cnt) tok = list[(size_t)u.aux * M + idx] >> 1;
        return tok * (unsigned)(K * 2); }
};

using pg8::f32x4;
using pg8::Unit;
__device__ __forceinline__ v4u pack8(f32x4 v0, f32x4 v1) { v4u w; w.x = pg8::cvt_pk_bf16(v0[0], v0[1]); w.y = pg8::cvt_pk_bf16(v0[2], v0[3]); w.z = pg8::cvt_pk_bf16(v1[0], v1[1]); w.w = pg8::cvt_pk_bf16(v1[2], v1[3]); return w; }

struct EpiLora {
    static constexpr bool PERM = true;
    bf16* LW;
    __device__ __forceinline__ void operator()(const f32x4 (&acc)[2][2][4][2], const Unit& u, int wr, int wc, int fr, int fq) const {
        { int l_; asm volatile("v_mbcnt_lo_u32_b32 %0, -1, 0\n\tv_mbcnt_hi_u32_b32 %0, -1, %0" : "=v"(l_)); fr = l_ & 15; fq = l_ >> 4; }
        const int g = u.aux, width = g == 2 ? DG : DW; bf16* out = LW + (size_t)g * (1u << 20);
        const int row0 = u.pm * 256 + wr * 64 + fr;
#pragma unroll
        for (int bj = 0; bj < 2; ++bj) { const int col0 = bj * 128 + wc * 32 + 8 * fq; if (col0 < width) {
#pragma unroll
            for (int ai = 0; ai < 2; ++ai)
#pragma unroll
                for (int m = 0; m < 4; ++m) { f32x4 v0 = acc[ai][bj][m][0], v1 = acc[ai][bj][m][1];
                    if (g == 0) {
#pragma unroll
                        for (int q = 0; q < 4; ++q) { v0[q] = tanhf(v0[q]); v1[q] = tanhf(v1[q]); } }
                    else if (g == 2) {
#pragma unroll
                        for (int q = 0; q < 4; ++q) { v0[q] = sigmoidf_(v0[q]); v1[q] = sigmoidf_(v1[q]); } }
                    *(GAS v4u*)(out + (size_t)(row0 + ai * 128 + m * 16) * width + col0) = pack8(v0, v1); } } }
    }
};
struct EpiSplit3 {
    static constexpr bool PERM = true;
    bf16* O0; bool bycol; const float* rowscale;
    __device__ __forceinline__ void operator()(const f32x4 (&acc)[2][2][4][2], const Unit& u, int wr, int wc, int fr, int fq) const {
        { int l_; asm volatile("v_mbcnt_lo_u32_b32 %0, -1, 0\n\tv_mbcnt_hi_u32_b32 %0, -1, %0" : "=v"(l_)); fr = l_ & 15; fq = l_ >> 4; }
        const int g = bycol ? (u.pn >> 2) : u.aux, pn = bycol ? (u.pn & 3) : u.pn; bf16* out = O0 + (size_t)g * ((size_t)M * C);
        const int row0 = u.pm * 256 + wr * 64 + fr, col0 = pn * 256 + wc * 32 + 8 * fq;
#pragma unroll
        for (int ai = 0; ai < 2; ++ai)
#pragma unroll
            for (int m = 0; m < 4; ++m)
                { const float sc = rowscale ? rowscale[row0 + ai * 128 + m * 16] : 1.0f;
#pragma unroll
                for (int bj = 0; bj < 2; ++bj) *(GAS v4u*)(out + (size_t)(row0 + ai * 128 + m * 16) * C + col0 + bj * 128) = pack8(acc[ai][bj][m][0] * sc, acc[ai][bj][m][1] * sc); }
    }
};
template <bool BASE_F32> struct EpiResidBf {
    static constexpr bool PERM = true;
    const void* base; bf16* out;
    __device__ __forceinline__ void operator()(const f32x4 (&acc)[2][2][4][2], const Unit& u, int wr, int wc, int fr, int fq) const {
        { int l_; asm volatile("v_mbcnt_lo_u32_b32 %0, -1, 0\n\tv_mbcnt_hi_u32_b32 %0, -1, %0" : "=v"(l_)); fr = l_ & 15; fq = l_ >> 4; }
        const int row0 = u.pm * 256 + wr * 64 + fr, col0 = u.pn * 256 + wc * 32 + 8 * fq;
#pragma unroll
        for (int ai = 0; ai < 2; ++ai)
#pragma unroll
            for (int m = 0; m < 4; ++m) { const size_t off = (size_t)(row0 + ai * 128 + m * 16) * C + col0;
#pragma unroll
                for (int bj = 0; bj < 2; ++bj) { f32x4 b0, b1;
                    if (BASE_F32) { b0 = *(const GAS f32x4*)((const float*)base + off + bj * 128); b1 = *(const GAS f32x4*)((const float*)base + off + bj * 128 + 4); }
                    else { const v4u w = *(const GAS v4u*)((const bf16*)base + off + bj * 128); b0 = (f32x4){bflo(w.x), bfhi(w.x), bflo(w.y), bfhi(w.y)}; b1 = (f32x4){bflo(w.z), bfhi(w.z), bflo(w.w), bfhi(w.w)}; }
                    *(GAS v4u*)(out + off + bj * 128) = pack8(b0 + acc[ai][bj][m][0], b1 + acc[ai][bj][m][1]); }
                asm volatile("" ::: "memory"); }
    }
};
struct EpiGU {
    static constexpr bool PERM = true;
    bf16* HID; const float* wl; const float* rsl;
    __device__ __forceinline__ void operator()(const f32x4 (&acc)[2][2][4][2], const Unit& u, int wr, int wc, int fr, int fq) const {
        { int l_; asm volatile("v_mbcnt_lo_u32_b32 %0, -1, 0\n\tv_mbcnt_hi_u32_b32 %0, -1, %0" : "=v"(l_)); fr = l_ & 15; fq = l_ >> 4; }
        const int e = u.aux, cnt = u.cnt, base = u.r0, r0 = wr * 64 + fr, col0 = u.pn * 128 + wc * 32 + 8 * fq;
#pragma unroll
        for (int ai = 0; ai < 2; ++ai)
#pragma unroll
            for (int m = 0; m < 4; ++m) { const int r = r0 + ai * 128 + m * 16, idx = base + r; float w = 0.f, rs = 0.f; if (idx < cnt) { w = wl[(size_t)e * M + idx]; rs = rsl[(size_t)e * M + idx]; }
                f32x4 h0, h1;
#pragma unroll
                for (int q = 0; q < 4; ++q) { const float g0 = acc[ai][0][m][0][q] * rs, g1 = acc[ai][0][m][1][q] * rs;
                    h0[q] = g0 * sigmoidf_(g0) * (acc[ai][1][m][0][q] * rs) * w; h1[q] = g1 * sigmoidf_(g1) * (acc[ai][1][m][1][q] * rs) * w; }
                *(GAS v4u*)(HID + (size_t)(u.pm * 256 + r) * FE + col0) = pack8(h0, h1);
                asm volatile("" ::: "memory"); }
    }
};
struct EpiDown {
    static constexpr bool PERM = true;
    bf16* EO; const unsigned* list;
    __device__ __forceinline__ void operator()(const f32x4 (&acc)[2][2][4][2], const Unit& u, int wr, int wc, int fr, int fq) const {
        { int l_; asm volatile("v_mbcnt_lo_u32_b32 %0, -1, 0\n\tv_mbcnt_hi_u32_b32 %0, -1, %0" : "=v"(l_)); fr = l_ & 15; fq = l_ >> 4; }
        const int e = u.aux, cnt = u.cnt, base = u.r0, r0 = wr * 64 + fr, col0 = u.pn * 256 + wc * 32 + 8 * fq;
#pragma unroll
        for (int ai = 0; ai < 2; ++ai)
#pragma unroll
            for (int m = 0; m < 4; ++m) { const int idx = base + r0 + ai * 128 + m * 16;
                if (idx < cnt) { const unsigned ent = list[(size_t)e * M + idx]; bf16* o = EO + ((size_t)(ent & 1u) * M + (ent >> 1)) * C + col0;
#pragma unroll
                    for (int bj = 0; bj < 2; ++bj) *(GAS v4u*)(o + bj * 128) = pack8(acc[ai][bj][m][0], acc[ai][bj][m][1]); }
                asm volatile("" ::: "memory"); }
    }
};

typedef short bf16x8s __attribute__((ext_vector_type(8)));
typedef short bf16x4s __attribute__((ext_vector_type(4)));
typedef short v4i16_t __attribute__((ext_vector_type(4)));
constexpr int TPB = 144;
constexpr int TILE_B = 64 * TPB;
constexpr int FP = 68;
constexpr int CS_FA = 0, CS_FB = 16384, CS_TILES = 32768, CS_TOT = CS_TILES + 12 * TILE_B, CS_WL = CS_TOT + 2048, CS_PAR = CS_WL + 256;
static_assert(CS_PAR + 768 <= LDSCTL_OFF, "scan LDS map");
#define TILE(n) (lds + CS_TILES + (n) * TILE_B)
#define F4Z (f32x4){0.f, 0.f, 0.f, 0.f}
__device__ __forceinline__ bf16x8s ldfrag(const LAS unsigned char* tile, int row, int kcol) { return *(const LAS bf16x8s*)(tile + row * TPB + kcol * 2); }
__device__ __forceinline__ bf16x8s ldfrag_tr(const LAS unsigned char* tile, int n0, int k0, int lane) {
    const int g = lane >> 4, q = (lane & 15) >> 2, p = lane & 3;
    const LAS unsigned char* a = tile + (k0 + 8 * g + q) * TPB + (n0 + 4 * p) * 2;
    const v4i16_t lo = __builtin_amdgcn_ds_read_tr16_b64_v4i16((LAS v4i16_t*)a), hi = __builtin_amdgcn_ds_read_tr16_b64_v4i16((LAS v4i16_t*)(a + 4 * TPB));
    return (bf16x8s){lo[0], lo[1], lo[2], lo[3], hi[0], hi[1], hi[2], hi[3]};
}
__device__ __forceinline__ bf16x8s ldfrag_perm(const LAS unsigned char* tile, int row, int ks, int g) {
    const bf16x4s lo = *(const LAS bf16x4s*)(tile + row * TPB + (32 * ks + 4 * g) * 2), hi = *(const LAS bf16x4s*)(tile + row * TPB + (32 * ks + 16 + 4 * g) * 2);
    return (bf16x8s){lo[0], lo[1], lo[2], lo[3], hi[0], hi[1], hi[2], hi[3]};
}
__device__ __forceinline__ void lds_barrier() { asm volatile("s_waitcnt lgkmcnt(0)" ::: "memory"); __builtin_amdgcn_s_barrier(); asm volatile("" ::: "memory"); }
#define MFMA16(a, b, c) __builtin_amdgcn_mfma_f32_16x16x32_bf16((a), (b), (c), 0, 0, 0)
__device__ __forceinline__ void mm64(f32x4 (&acc)[2], const LAS unsigned char* At, const LAS unsigned char* Bt, int rt, int ch, int fr, int g) {
#pragma unroll
    for (int ks = 0; ks < 2; ++ks) { const bf16x8s a = ldfrag(At, 16 * rt + fr, 32 * ks + 8 * g);
#pragma unroll
        for (int ct = 0; ct < 2; ++ct) acc[ct] = MFMA16(a, ldfrag(Bt, 32 * ch + 16 * ct + fr, 32 * ks + 8 * g), acc[ct]); }
}
__device__ __forceinline__ void mm64_bt(f32x4 (&acc)[2], const LAS unsigned char* At, const LAS unsigned char* X, int rt, int ch, int fr, int g, int lane) {
#pragma unroll
    for (int ks = 0; ks < 2; ++ks) { const bf16x8s a = ldfrag(At, 16 * rt + fr, 32 * ks + 8 * g);
#pragma unroll
        for (int ct = 0; ct < 2; ++ct) acc[ct] = MFMA16(a, ldfrag_tr(X, 32 * ch + 16 * ct, 32 * ks, lane), acc[ct]); }
}
__device__ __forceinline__ void mm64_at(f32x4 (&acc)[2], const LAS unsigned char* Xa, const LAS unsigned char* Bt, int rt, int ch, int fr, int g, int lane) {
#pragma unroll
    for (int ks = 0; ks < 2; ++ks) { const bf16x8s a = ldfrag_tr(Xa, 16 * rt, 32 * ks, lane);
#pragma unroll
        for (int ct = 0; ct < 2; ++ct) acc[ct] = MFMA16(a, ldfrag(Bt, 32 * ch + 16 * ct + fr, 32 * ks + 8 * g), acc[ct]); }
}
__device__ __forceinline__ void mm64_att(f32x4 (&acc)[2], const LAS unsigned char* Xa, const LAS unsigned char* X, int rt, int ch, int lane) {
#pragma unroll
    for (int ks = 0; ks < 2; ++ks) { const bf16x8s a = ldfrag_tr(Xa, 16 * rt, 32 * ks, lane);
#pragma unroll
        for (int ct = 0; ct < 2; ++ct) acc[ct] = MFMA16(a, ldfrag_tr(X, 32 * ch + 16 * ct, 32 * ks, lane), acc[ct]); }
}
__device__ __forceinline__ bf16x4s pack4(f32x4 v) { v2u w; w.x = pg8::cvt_pk_bf16(v[0], v[1]); w.y = pg8::cvt_pk_bf16(v[2], v[3]); return __builtin_bit_cast(bf16x4s, w); }
__device__ __forceinline__ f32x4 unpack4(bf16x4s s) { const v2u w = __builtin_bit_cast(v2u, s); return (f32x4){bflo(w.x), bfhi(w.x), bflo(w.y), bfhi(w.y)}; }
__device__ __forceinline__ void st_tr(LAS unsigned char* Out, const f32x4 (&acc)[2], int rt, int ch, int fr, int g) {
#pragma unroll
    for (int ct = 0; ct < 2; ++ct) *(LAS bf16x4s*)(Out + (32 * ch + 16 * ct + fr) * TPB + (16 * rt + 4 * g) * 2) = pack4(acc[ct]);
}
__device__ __forceinline__ void ld_tr(f32x4 (&acc)[2], const LAS unsigned char* In, int rt, int ch, int fr, int g) {
#pragma unroll
    for (int ct = 0; ct < 2; ++ct) acc[ct] = unpack4(*(const LAS bf16x4s*)(In + (32 * ch + 16 * ct + fr) * TPB + (16 * rt + 4 * g) * 2));
}
__device__ __forceinline__ void unpack8(v4u w, float (&o)[8]) { o[0] = bflo(w.x); o[1] = bfhi(w.x); o[2] = bflo(w.y); o[3] = bfhi(w.y); o[4] = bflo(w.z); o[5] = bfhi(w.z); o[6] = bflo(w.w); o[7] = bfhi(w.w); }
__device__ __forceinline__ v4u pack8f(const float (&o)[8]) { v4u w; w.x = pg8::cvt_pk_bf16(o[0], o[1]); w.y = pg8::cvt_pk_bf16(o[2], o[3]); w.z = pg8::cvt_pk_bf16(o[4], o[5]); w.w = pg8::cvt_pk_bf16(o[6], o[7]); return w; }

struct FrontIn { v4u r, k, v; bf16x8s fw[2], fa[2]; };
__device__ __forceinline__ void front_fetch(FrontIn& f, unsigned char* ws, int unit, int tid, int lane, int wave) {
    const int h = unit & 15, c = (unit >> 4) & 127, b = unit >> 11; const size_t row0 = (size_t)b * SEQ + c * 64;
    const int rt = wave & 3, fr = lane & 15, g = lane >> 4, t = tid >> 3, cq = tid & 7, c0 = h * HD + cq * 8;
    const bf16* Rb = (const bf16*)(ws + WS_B1); const bf16* Kb = (const bf16*)(ws + WS_B2); const bf16* Vb = (const bf16*)(ws + WS_B3);
    const bf16* LW = (const bf16*)(ws + WS_LW); const bf16* LA = (const bf16*)(ws + WS_LA);
    f.r = *(const GAS v4u*)(Rb + (row0 + t) * C + c0); f.k = *(const GAS v4u*)(Kb + (row0 + t) * C + c0); f.v = *(const GAS v4u*)(Vb + (row0 + t) * C + c0);
#pragma unroll
    for (int ks = 0; ks < 2; ++ks) { f.fw[ks] = *(const GAS bf16x8s*)(LW + (row0 + 16 * rt + fr) * DW + 32 * ks + 8 * g); f.fa[ks] = *(const GAS bf16x8s*)(LA + (row0 + 16 * rt + fr) * DA + 32 * ks + 8 * g); }
}
__device__ __forceinline__ v4u head_consts(unsigned char* ws, LAS unsigned char* lds, int h, int tid, int wtile, int atile) {
    const bf16* W2T = (const bf16*)(ws + WS_WT_W2); const bf16* A2T = (const bf16*)(ws + WS_WT_A2);
    const int row = tid >> 3, cq = tid & 7;
    const v4u w2chunk = *(const GAS v4u*)(W2T + (size_t)(h * HD + row) * 64 + cq * 8);
    *(LAS v4u*)(lds + CS_TILES + wtile * TILE_B + row * TPB + cq * 16) = w2chunk;
    *(LAS v4u*)(lds + CS_TILES + atile * TILE_B + row * TPB + cq * 16) = *(const GAS v4u*)(A2T + (size_t)(h * HD + row) * 64 + cq * 8);
    if (tid < 64) { LAS float* P = (LAS float*)(lds + CS_PAR); P[tid] = INP(15)[h * HD + tid]; P[64 + tid] = INP(16)[h * HD + tid]; P[128 + tid] = INP(17)[h * HD + tid]; }
    __syncthreads();
    return w2chunk;
}
template <int MODE>
__device__ __forceinline__ void chunk_front(const FrontIn& f, LAS unsigned char* lds, const float (&w0v)[2], const float (&a0v)[2], const bf16x8s (&w2f)[2][2], const bf16x8s (&a2f)[2][2], int tid, int lane, int wave, float (&v8)[8], float& rkb) {
    const int rt = wave & 3, ch = wave >> 2, fr = lane & 15, g = lane >> 4;
    LAS float* FA = (LAS float*)(lds + CS_FA); LAS float* FB = (LAS float*)(lds + CS_FB); LAS float* TOT = (LAS float*)(lds + CS_TOT);
    const int t = tid >> 3, cq = tid & 7;
    {
        f32x4 aw[2] = {F4Z, F4Z}, aa[2] = {F4Z, F4Z};
#pragma unroll
        for (int ks = 0; ks < 2; ++ks)
#pragma unroll
            for (int ct = 0; ct < 2; ++ct) { aw[ct] = MFMA16(f.fw[ks], w2f[ks][ct], aw[ct]); aa[ct] = MFMA16(f.fa[ks], a2f[ks][ct], aa[ct]); }
#pragma unroll
        for (int ct = 0; ct < 2; ++ct) { const int j = 32 * ch + 16 * ct + fr, js = j ^ ((g & 1) << 4); const float w0 = w0v[ct], a0 = a0v[ct];
            float p[4];
#pragma unroll
            for (int q = 0; q < 4; ++q) { p[q] = -0.6065306597126334f * sigmoidf_(w0 + aw[ct][q]); if (q) p[q] += p[q - 1]; }
            const float s_ = p[3];
            const float u1 = __int_as_float(__builtin_amdgcn_ds_bpermute(((lane - 16) & 63) << 2, __float_as_int(s_))); const float t1 = s_ + (g >= 1 ? u1 : 0.f);
            const float u2 = __int_as_float(__builtin_amdgcn_ds_bpermute(((lane - 32) & 63) << 2, __float_as_int(t1))); const float t2 = t1 + (g >= 2 ? u2 : 0.f);
            const float ex = t2 - s_;
#pragma unroll
            for (int q = 0; q < 4; ++q) { const int tt = 16 * rt + 4 * g + q; FA[tt * 64 + js] = p[q] + ex; FB[tt * 64 + js] = sigmoidf_(a0 + aa[ct][q]); }
            if (g == 3) TOT[rt * 64 + j] = t2; }
    }
    lds_barrier();
    {
        float r[8], k[8], pkk[8], pka[8], prk[8];
        unpack8(f.r, r); unpack8(f.k, k); unpack8(f.v, v8);
        { const LAS float* P = (const LAS float*)(lds + CS_PAR) + cq * 8; const f32x4 a0_ = *(const LAS f32x4*)P, a1_ = *(const LAS f32x4*)(P + 4), b0_ = *(const LAS f32x4*)(P + 64), b1_ = *(const LAS f32x4*)(P + 68), c0_ = *(const LAS f32x4*)(P + 128), c1_ = *(const LAS f32x4*)(P + 132);
#pragma unroll
          for (int q = 0; q < 4; ++q) { pkk[q] = a0_[q]; pkk[4 + q] = a1_[q]; pka[q] = b0_[q]; pka[4 + q] = b1_[q]; prk[q] = c0_[q]; prk[4 + q] = c1_[q]; } }
        float cw[8], cwp[8], ag[8];
        { const int tp = t > 0 ? t - 1 : 0, rtt = wave >> 1;
          const int ct_ = (cq ^ (((t >> 2) & 1) << 1)) * 8, cp_ = (cq ^ (((tp >> 2) & 1) << 1)) * 8;
          const f32x4 c0_ = *(const LAS f32x4*)(FA + t * 64 + ct_), c1_ = *(const LAS f32x4*)(FA + t * 64 + ct_ + 4), p0_ = *(const LAS f32x4*)(FA + tp * 64 + cp_), p1_ = *(const LAS f32x4*)(FA + tp * 64 + cp_ + 4);
          const f32x4 g0_ = *(const LAS f32x4*)(FB + t * 64 + ct_), g1_ = *(const LAS f32x4*)(FB + t * 64 + ct_ + 4);
          f32x4 o0_ = F4Z, o1_ = F4Z, l0_ = F4Z, l1_ = F4Z;
          for (int r_ = 0; r_ < rtt; ++r_) { l0_ = *(const LAS f32x4*)(TOT + r_ * 64 + cq * 8); l1_ = *(const LAS f32x4*)(TOT + r_ * 64 + cq * 8 + 4); o0_ = o0_ + l0_; o1_ = o1_ + l1_; }
          const bool first = (t & 15) == 0;
#pragma unroll
          for (int q = 0; q < 4; ++q) { cw[q] = c0_[q] + o0_[q]; cw[4 + q] = c1_[q] + o1_[q];
              cwp[q] = t > 0 ? p0_[q] + o0_[q] - (first ? l0_[q] : 0.f) : 0.f; cwp[4 + q] = t > 0 ? p1_[q] + o1_[q] - (first ? l1_[q] : 0.f) : 0.f; ag[q] = g0_[q]; ag[4 + q] = g1_[q]; } }
        float kk[8], ss = 0.f; rkb = 0.f;
#pragma unroll
        for (int q = 0; q < 8; ++q) { kk[q] = k[q] * pkk[q]; ss += kk[q] * kk[q]; }
        ss = sum8(ss);
        const float inv = 1.0f / fmaxf(sqrtf(ss), 1e-12f);
        float at[8], bt[8], kt[8], rt_[8];
#pragma unroll
        for (int q = 0; q < 8; ++q) { const float kn = kk[q] * inv, kp = k[q] * (1.0f + (ag[q] - 1.0f) * pka[q]);
            const float ein = __expf(-cw[q]);
            at[q] = -kn * __expf(cwp[q]); bt[q] = kn * ag[q] * ein; kt[q] = kp * ein;
            rt_[q] = r[q] * __expf(cw[q]); rkb += r[q] * kp * prk[q]; }
        rkb = sum8(rkb);
        *(LAS v4u*)(TILE(0) + t * TPB + cq * 16) = pack8f(at); *(LAS v4u*)(TILE(1) + t * TPB + cq * 16) = pack8f(bt); *(LAS v4u*)(TILE(2) + t * TPB + cq * 16) = pack8f(kt);
        *(LAS v4u*)(TILE(3) + t * TPB + cq * 16) = f.v;
        *(LAS v4u*)(TILE(6) + t * TPB + cq * 16) = pack8f(rt_);
        if (MODE == 1 && t == 63) {
#pragma unroll
            for (int q = 0; q < 8; ++q) ((LAS float*)(lds + CS_WL))[cq * 8 + q] = __expf(cw[q]); }
    }
    lds_barrier();
}

__device__ __forceinline__ void scan_s1(unsigned char* ws, LAS unsigned char* lds, int lane0, int wave) {
    const int rt = wave & 3, ch = wave >> 2;
    FrontIn fin; float w0v[2], a0v[2]; bf16x8s w2f[2][2], a2f[2][2];
    { int l0 = lane0; asm volatile("" : "+v"(l0)); const int hh = blockIdx.x & 15;
      if ((int)blockIdx.x < BATCH * NH * (SEQ / 64)) front_fetch(fin, ws, blockIdx.x, wave * 64 + l0, l0, wave);
      const bf16* W2T = (const bf16*)(ws + WS_WT_W2); const bf16* A2T = (const bf16*)(ws + WS_WT_A2);
#pragma unroll
      for (int ct = 0; ct < 2; ++ct) { w0v[ct] = INP(7)[hh * HD + 32 * ch + 16 * ct + (l0 & 15)]; a0v[ct] = INP(10)[hh * HD + 32 * ch + 16 * ct + (l0 & 15)];
#pragma unroll
          for (int ks = 0; ks < 2; ++ks) { const size_t wr_ = (size_t)(hh * HD + 32 * ch + 16 * ct + (l0 & 15)) * 64 + 32 * ks + 8 * (l0 >> 4); w2f[ks][ct] = *(const GAS bf16x8s*)(W2T + wr_); a2f[ks][ct] = *(const GAS bf16x8s*)(A2T + wr_); } }
      const int tid0 = wave * 64 + l0;
      if (tid0 < 64) { LAS float* P = (LAS float*)(lds + CS_PAR); P[tid0] = INP(15)[hh * HD + tid0]; P[64 + tid0] = INP(16)[hh * HD + tid0]; P[128 + tid0] = INP(17)[hh * HD + tid0]; }
      __syncthreads(); }
    for (int unit = blockIdx.x; unit < BATCH * NH * (SEQ / 64); unit += gridDim.x) {
        int lane = lane0; asm volatile("" : "+v"(lane));
        const int tid = wave * 64 + lane, fr = lane & 15, g = lane >> 4;
        const int h = unit & 15, c = (unit >> 4) & 127, b = unit >> 11; const size_t chunk = ((size_t)b * NH + h) * 128 + c;
        float v8[8]; float rkb;
        chunk_front<1>(fin, lds, w0v, a0v, w2f, a2f, tid, lane, wave, v8, rkb);
        { const size_t row0_ = (size_t)b * SEQ + c * 64; if ((tid & 7) == 0) ((float*)(ws + WS_HID))[(row0_ + (tid >> 3)) * NH + h] = rkb; }
        if (unit + (int)gridDim.x < BATCH * NH * (SEQ / 64)) front_fetch(fin, ws, unit + gridDim.x, tid, lane, wave);
        {
            f32x4 a2[2] = {F4Z, F4Z}, a3[2] = {F4Z, F4Z};
            mm64(a2, TILE(1), TILE(0), rt, ch, fr, g);
            mm64(a3, TILE(2), TILE(0), rt, ch, fr, g);
            f32x4 p1[2];
#pragma unroll
            for (int ct = 0; ct < 2; ++ct) { const int col = 32 * ch + 16 * ct + fr;
#pragma unroll
                for (int q = 0; q < 4; ++q) { const int row = 16 * rt + 4 * g + q;
                    a2[ct][q] = row < col ? a2[ct][q] : 0.f;
                    p1[ct][q] = a2[ct][q] + (row == col ? 1.0f : 0.f);
                    a3[ct][q] = row < col ? a3[ct][q] : 0.f; } }
            st_tr(TILE(5), a2, rt, ch, fr, g);
            st_tr(TILE(9), p1, rt, ch, fr, g);
            st_tr(TILE(4), a3, rt, ch, fr, g);
        }
        lds_barrier();
#pragma unroll
        for (int r = 0; r < 6; ++r) {
            LAS unsigned char* Sr = TILE(5 + 2 * (r & 1)); LAS unsigned char* Sr2 = TILE(5 + 2 * ((r & 1) ^ 1));
            if (r <= 4) { f32x4 q2[2] = {F4Z, F4Z};
                mm64_at(q2, Sr, Sr, rt, ch, fr, g, lane);
                st_tr(Sr2, q2, rt, ch, fr, g); }
            if (r >= 1) { LAS unsigned char* Pr = TILE(9 + ((r - 1) & 1)); LAS unsigned char* Pr2 = TILE(9 + (((r - 1) & 1) ^ 1));
                f32x4 pa[2]; ld_tr(pa, Pr, rt, ch, fr, g);
                mm64_at(pa, Sr, Pr, rt, ch, fr, g, lane);
                st_tr(Pr2, pa, rt, ch, fr, g); }
            if (r == 0) { f32x4 gg[2] = {F4Z, F4Z};
                mm64_bt(gg, TILE(4), TILE(3), rt, ch, fr, g, lane);
                st_tr(TILE(11), gg, rt, ch, fr, g); }
            lds_barrier();
        }
        {
            f32x4 acc[2] = {F4Z, F4Z}, ac2[2] = {F4Z, F4Z};
            mm64_bt(acc, TILE(10), TILE(0), rt, ch, fr, g, lane);
            mm64(ac2, TILE(10), TILE(11), rt, ch, fr, g);
            st_tr(TILE(5), acc, rt, ch, fr, g); st_tr(TILE(7), ac2, rt, ch, fr, g);
            f32x4 b2[2] = {F4Z, F4Z}, b3[2] = {F4Z, F4Z};
            mm64(b2, TILE(1), TILE(6), rt, ch, fr, g); mm64(b3, TILE(2), TILE(6), rt, ch, fr, g);
#pragma unroll
            for (int ct = 0; ct < 2; ++ct) { const int t = 32 * ch + 16 * ct + fr;
#pragma unroll
                for (int q = 0; q < 4; ++q) { const int s_ = 16 * rt + 4 * g + q; b2[ct][q] = s_ <= t ? b2[ct][q] : 0.f; b3[ct][q] = s_ <= t ? b3[ct][q] : 0.f; } }
            st_tr(TILE(4), b2, rt, ch, fr, g); st_tr(TILE(9), b3, rt, ch, fr, g);
        }
        lds_barrier();
        {
            const LAS float* WL = (const LAS float*)(lds + CS_WL);
            f32x4 acc[2] = {F4Z, F4Z};
            mm64_bt(acc, TILE(5), TILE(1), rt, ch, fr, g, lane);
            bf16* Mg = (bf16*)(ws + WS_B0) + chunk * 4096;
#pragma unroll
            for (int ct = 0; ct < 2; ++ct) { const int j1 = 32 * ch + 16 * ct + fr; const float wl = WL[j1];
#pragma unroll
                for (int q = 0; q < 4; ++q) { const int j2 = 16 * rt + 4 * g + q; acc[ct][q] = wl * (acc[ct][q] + (j2 == j1 ? 1.0f : 0.f)); }
                const int rtS = 2 * ch + ct, ksS = rt >> 1, half = rt & 1;
                *(GAS bf16x4s*)(Mg + (((rtS * 2 + ksS) * 64 + g * 16 + fr) * 8 + half * 4)) = pack4(acc[ct]); }
            f32x4 ad[2] = {F4Z, F4Z};
            mm64_at(ad, TILE(1), TILE(7), rt, ch, fr, g, lane);
            mm64_att(ad, TILE(2), TILE(3), rt, ch, lane);
            const f32x4 wl4 = *(const LAS f32x4*)(WL + 16 * rt + 4 * g);
            bf16* Dg = (bf16*)OUTP() + chunk * 4096;
#pragma unroll
            for (int ct = 0; ct < 2; ++ct) *(GAS bf16x4s*)(Dg + (((2 * ch + ct) * 4 + rt) * 64 + lane) * 4) = pack4(ad[ct] * wl4);
            const size_t row0_ = (size_t)b * SEQ + c * 64;
            f32x4 ar[2]; ld_tr(ar, TILE(6), rt, ch, fr, g);
            mm64(ar, TILE(5), TILE(4), rt, ch, fr, g);
            f32x4 ay[2] = {F4Z, F4Z};
            mm64(ay, TILE(7), TILE(4), rt, ch, fr, g); mm64_at(ay, TILE(3), TILE(9), rt, ch, fr, g, lane);
            bf16* Rg = (bf16*)(ws + WS_B1); bf16* Kg = (bf16*)(ws + WS_B2);
#pragma unroll
            for (int ct = 0; ct < 2; ++ct) { const size_t o_ = (row0_ + 32 * ch + 16 * ct + fr) * C + h * HD + 16 * rt + 4 * g; *(GAS bf16x4s*)(Rg + o_) = pack4(ar[ct]); *(GAS bf16x4s*)(Kg + o_) = pack4(ay[ct]); }
        }
        lds_barrier();
    }
}

constexpr int S2_PD = 6;
__device__ __forceinline__ void scan_s2(unsigned char* ws, LAS unsigned char* lds, int lane, int wave) {
    for (int bh = blockIdx.x; bh < BATCH * NH; bh += gridDim.x) {
        const unsigned char* Mg = (const unsigned char*)((const bf16*)(ws + WS_B0) + (size_t)bh * 128 * 4096); const unsigned char* Dg = (const unsigned char*)((const bf16*)OUTP() + (size_t)bh * 128 * 4096);
        bf16* Sg = (bf16*)OUTP() + (size_t)M * C + (size_t)bh * 128 * 4096;
        if (wave >= 4) {
            const int lw = wave - 4;
            const unsigned char* src = (lw < 2 ? Mg + lw * 4096 : Dg + (lw - 2) * 4096) + lane * 16;
            LAS unsigned char* dst = lds + lw * 4096 + lane * 16;
            v4u q[S2_PD][4];
#define S2_LOADQ(j, c) do { _Pragma("unroll") for (int i_ = 0; i_ < 4; ++i_) q[j][i_] = *(const GAS v4u*)(src + (size_t)(c) * 8192 + i_ * 1024); } while (0)
#define S2_STOREQ(j, slot) do { _Pragma("unroll") for (int i_ = 0; i_ < 4; ++i_) *(LAS v4u*)(dst + (slot) * 16384 + i_ * 1024) = q[j][i_]; } while (0)
#pragma unroll
            for (int j = 0; j < S2_PD; ++j) S2_LOADQ(j, j);
            S2_STOREQ(0, 0); S2_LOADQ(0, S2_PD);
            lds_barrier();
#pragma unroll 1
            for (int s0 = 0; s0 < 128; s0 += S2_PD) {
#pragma unroll
                for (int jj = 0; jj < S2_PD; ++jj) { const int step = s0 + jj;
                    if (step + 1 < 128) S2_STOREQ((jj + 1) % S2_PD, (step + 1) & 1);
                    if (step + 1 + S2_PD < 128) S2_LOADQ((jj + 1) % S2_PD, step + 1 + S2_PD);
                    lds_barrier(); }
            }
#undef S2_LOADQ
#undef S2_STOREQ
        } else {
            const int ct = wave;
            f32x4 acc[4];
#pragma unroll
            for (int r = 0; r < 4; ++r) acc[r] = F4Z;
            lds_barrier();
#pragma unroll 1
            for (int s0 = 0; s0 < 128; s0 += S2_PD) {
#pragma unroll
                for (int jj = 0; jj < S2_PD; ++jj) { const int step = s0 + jj;
                    if (step < 128) {
                        const LAS unsigned char* slot = lds + (step & 1) * 16384;
                        bf16x8s sf[2];
#pragma unroll
                        for (int ks = 0; ks < 2; ++ks) { const bf16x4s lo = pack4(acc[2 * ks]), hi = pack4(acc[2 * ks + 1]); sf[ks] = (bf16x8s){lo[0], lo[1], lo[2], lo[3], hi[0], hi[1], hi[2], hi[3]}; }
#pragma unroll
                        for (int ks = 0; ks < 2; ++ks) *(GAS bf16x8s*)(Sg + (size_t)step * 4096 + ((ct * 2 + ks) * 64 + lane) * 8) = sf[ks];
                        f32x4 na[4];
#pragma unroll
                        for (int r = 0; r < 4; ++r) na[r] = unpack4(*(const LAS bf16x4s*)(slot + 8192 + ((ct * 4 + r) * 64 + lane) * 8));
#pragma unroll
                        for (int ks = 0; ks < 2; ++ks)
#pragma unroll
                            for (int r = 0; r < 4; ++r) na[r] = MFMA16(*(const LAS bf16x8s*)(slot + ((r * 2 + ks) * 64 + lane) * 16), sf[ks], na[r]);
#pragma unroll
                        for (int r = 0; r < 4; ++r) acc[r] = na[r];
                    }
                    lds_barrier(); }
            }
        }
    }
}

constexpr int S3_RT = 32768, S3_YT = S3_RT + TILE_B, S3_LG = S3_YT + TILE_B, S3_LGP = 336;
struct S3In { v4u rr, yy, vv, lg[3]; bf16x8s sA[2]; float rkb; };
__device__ __forceinline__ void s3_fetch(S3In& f, unsigned char* ws, int unit, int tid, int lane, int wave) {
    const int h = unit & 15, c = (unit >> 4) & 127, b = unit >> 11; const size_t chunk = ((size_t)b * NH + h) * 128 + c, row0 = (size_t)b * SEQ + c * 64;
    const int rt = wave & 3, et = tid >> 3, ecq = tid & 7;
    const bf16* Rg = (const bf16*)(ws + WS_B1); const bf16* Kg = (const bf16*)(ws + WS_B2); const bf16* Vb = (const bf16*)(ws + WS_B3); const bf16* LG = (const bf16*)(ws + WS_LG);
    const bf16* Sg = (const bf16*)OUTP() + (size_t)M * C + chunk * 4096;
    const size_t o_ = (row0 + et) * C + h * HD + ecq * 8;
    f.rr = *(const GAS v4u*)(Rg + o_); f.yy = *(const GAS v4u*)(Kg + o_); f.vv = *(const GAS v4u*)(Vb + o_);
#pragma unroll
    for (int i = 0; i < 3; ++i) { const int chn = tid + 512 * i; if (chn < 64 * 20) f.lg[i] = *(const GAS v4u*)(LG + (row0 + chn / 20) * DG + (chn % 20) * 8); }
#pragma unroll
    for (int ks = 0; ks < 2; ++ks) f.sA[ks] = *(const GAS bf16x8s*)(Sg + ((rt * 2 + ks) * 64 + lane) * 8);
    f.rkb = ((const float*)(ws + WS_HID))[(row0 + et) * NH + h];
}
__device__ __forceinline__ void scan_s3(unsigned char* ws, LAS unsigned char* lds, int lane0, int wave) {
    const int rt = wave & 3, ch = wave >> 2;
    LAS float* Ys = (LAS float*)(lds + CS_FA);
    const bf16* G2T = (const bf16*)(ws + WS_WT_G2); bf16* YG = (bf16*)(ws + WS_B0);
    constexpr int NU = BATCH * NH * (SEQ / 64);
    S3In fin; bf16x8s gA[5]; f32x4 lnw0, lnw1, lnb0, lnb1;
    { int l0 = lane0; asm volatile("" : "+v"(l0)); const int hh = blockIdx.x & 15, t0_ = wave * 64 + l0;
      if ((int)blockIdx.x < NU) s3_fetch(fin, ws, blockIdx.x, t0_, l0, wave);
#pragma unroll
      for (int ks = 0; ks < 5; ++ks) gA[ks] = *(const GAS bf16x8s*)(G2T + (size_t)(hh * HD + 16 * rt + (l0 & 15)) * DG + 32 * ks + 8 * (l0 >> 4));
      const int ec0 = hh * HD + (t0_ & 7) * 8;
      lnw0 = *(const GAS f32x4*)(INP(18) + ec0); lnw1 = *(const GAS f32x4*)(INP(18) + ec0 + 4); lnb0 = *(const GAS f32x4*)(INP(19) + ec0); lnb1 = *(const GAS f32x4*)(INP(19) + ec0 + 4); }
    __syncthreads();
    for (int unit = blockIdx.x; unit < NU; unit += gridDim.x) {
        int lane = lane0; asm volatile("" : "+v"(lane));
        const int tid = wave * 64 + lane, fr = lane & 15, g = lane >> 4, et = tid >> 3, ecq = tid & 7;
        const int h = unit & 15, c = (unit >> 4) & 127, b = unit >> 11; const size_t row0 = (size_t)b * SEQ + c * 64;
        *(LAS v4u*)(lds + S3_RT + et * TPB + ecq * 16) = fin.rr; *(LAS v4u*)(lds + S3_YT + et * TPB + ecq * 16) = fin.yy;
#pragma unroll
        for (int i = 0; i < 3; ++i) { const int chn = tid + 512 * i; if (chn < 64 * 20) *(LAS v4u*)(lds + S3_LG + (chn / 20) * S3_LGP + (chn % 20) * 16) = fin.lg[i]; }
        float v8[8]; unpack8(fin.vv, v8); const float rkb = fin.rkb; const bf16x8s sA0 = fin.sA[0], sA1 = fin.sA[1];
        lds_barrier();
        if (unit + (int)gridDim.x < NU) s3_fetch(fin, ws, unit + gridDim.x, tid, lane, wave);
        f32x4 acc[2], ag[2] = {F4Z, F4Z};
#pragma unroll
        for (int ct = 0; ct < 2; ++ct) { const int t = 32 * ch + 16 * ct + fr;
            acc[ct] = unpack4(*(const LAS bf16x4s*)(lds + S3_YT + t * TPB + (16 * rt + 4 * g) * 2));
            acc[ct] = MFMA16(sA0, ldfrag_perm(lds + S3_RT, t, 0, g), acc[ct]); acc[ct] = MFMA16(sA1, ldfrag_perm(lds + S3_RT, t, 1, g), acc[ct]);
#pragma unroll
            for (int ks = 0; ks < 5; ++ks) ag[ct] = MFMA16(gA[ks], *(const LAS bf16x8s*)(lds + S3_LG + t * S3_LGP + (32 * ks + 8 * g) * 2), ag[ct]);
            *(LAS f32x4*)(Ys + t * FP + 16 * rt + 4 * g) = acc[ct]; }
        lds_barrier();
        {
            const f32x4 y0 = *(const LAS f32x4*)(Ys + et * FP + ecq * 8), y1 = *(const LAS f32x4*)(Ys + et * FP + ecq * 8 + 4);
            float y[8] = {y0[0], y0[1], y0[2], y0[3], y1[0], y1[1], y1[2], y1[3]};
            float s_ = 0.f;
#pragma unroll
            for (int q = 0; q < 8; ++q) s_ += y[q];
            s_ = sum8(s_);
            const float mu = s_ * (1.0f / HD); float vs = 0.f;
#pragma unroll
            for (int q = 0; q < 8; ++q) { y[q] -= mu; vs += y[q] * y[q]; }
            vs = sum8(vs);
            const float rstd = 1.0f / sqrtf(vs * (1.0f / HD) + GN_EPS);
            f32x4 o0, o1;
#pragma unroll
            for (int q = 0; q < 4; ++q) { o0[q] = y[q] * rstd * lnw0[q] + lnb0[q] + rkb * v8[q]; o1[q] = y[4 + q] * rstd * lnw1[q] + lnb1[q] + rkb * v8[4 + q]; }
            *(LAS f32x4*)(Ys + et * FP + ecq * 8) = o0; *(LAS f32x4*)(Ys + et * FP + ecq * 8 + 4) = o1;
        }
        lds_barrier();
#pragma unroll
        for (int ct = 0; ct < 2; ++ct) { const int t = 32 * ch + 16 * ct + fr; const f32x4 yv = *(const LAS f32x4*)(Ys + t * FP + 16 * rt + 4 * g);
            *(GAS bf16x4s*)(YG + (row0 + t) * C + h * HD + 16 * rt + 4 * g) = pack4(yv * ag[ct]); }
    }
    __syncthreads();
}
#undef TILE
#if MK_DEBUG
__device__ __forceinline__ void scan_naive(unsigned char* ws, LAS unsigned char* lds, int tid) {
    const int lane = tid & 63;
    const bf16* Rb = (const bf16*)(ws + WS_B1); const bf16* Kb = (const bf16*)(ws + WS_B2); const bf16* Vb = (const bf16*)(ws + WS_B3);
    const bf16* LW = (const bf16*)(ws + WS_LW); const bf16* LA = (const bf16*)(ws + WS_LA);
    float* Y = OUTP(); float* RK = (float*)(ws + WS_HID);
    LAS float* sR = (LAS float*)lds; LAS float* sK = sR + 4096; LAS float* sV = sK + 4096; LAS float* sA = sV + 4096; LAS float* sB = sA + 4096; LAS float* sD = sB + 4096;
    LAS float* sW2 = sD + 4096; LAS float* sA2 = sW2 + 4096;
    for (int unit = blockIdx.x; unit < BATCH * NH; unit += gridDim.x) {
        const int b = unit / NH, h = unit % NH;
        __syncthreads();
        for (int e = tid; e < 4096; e += 512) { const int d = e >> 6, j = e & 63; sW2[e] = INP(9)[(size_t)d * C + h * HD + j]; sA2[e] = INP(12)[(size_t)d * C + h * HD + j]; }
        __syncthreads();
        const int pt = tid >> 3, cq = tid & 7, c0 = h * HD + cq * 8;
        const int si = tid >> 3, jq = tid & 7;
        float S[8];
#pragma unroll
        for (int q = 0; q < 8; ++q) S[q] = 0.f;
        float w0v[8], a0v[8], kkv[8], kav[8], rkv[8];
#pragma unroll
        for (int q = 0; q < 8; ++q) { w0v[q] = INP(7)[c0 + q]; a0v[q] = INP(10)[c0 + q]; kkv[q] = INP(15)[c0 + q]; kav[q] = INP(16)[c0 + q]; rkv[q] = INP(17)[c0 + q]; }
        for (int blk = 0; blk < SEQ / 64; ++blk) {
            const size_t row = (size_t)b * SEQ + blk * 64 + pt;
            {
                const v4u r4 = *(const GAS v4u*)(Rb + row * C + c0), k4 = *(const GAS v4u*)(Kb + row * C + c0), v4 = *(const GAS v4u*)(Vb + row * C + c0);
                float r[8], k[8], v[8];
                r[0] = bflo(r4.x); r[1] = bfhi(r4.x); r[2] = bflo(r4.y); r[3] = bfhi(r4.y); r[4] = bflo(r4.z); r[5] = bfhi(r4.z); r[6] = bflo(r4.w); r[7] = bfhi(r4.w);
                k[0] = bflo(k4.x); k[1] = bfhi(k4.x); k[2] = bflo(k4.y); k[3] = bfhi(k4.y); k[4] = bflo(k4.z); k[5] = bfhi(k4.z); k[6] = bflo(k4.w); k[7] = bfhi(k4.w);
                v[0] = bflo(v4.x); v[1] = bfhi(v4.x); v[2] = bflo(v4.y); v[3] = bfhi(v4.y); v[4] = bflo(v4.z); v[5] = bfhi(v4.z); v[6] = bflo(v4.w); v[7] = bfhi(v4.w);
                float wp[8], ap[8];
#pragma unroll
                for (int q = 0; q < 8; ++q) { wp[q] = w0v[q]; ap[q] = a0v[q]; }
                for (int d = 0; d < 64; ++d) { const float lw = bf2f(LW[row * DW + d]), la = bf2f(LA[row * DA + d]);
#pragma unroll
                    for (int q = 0; q < 8; ++q) { wp[q] += lw * sW2[d * 64 + cq * 8 + q]; ap[q] += la * sA2[d * 64 + cq * 8 + q]; } }
                float kk[8], ss = 0.f, rks = 0.f;
#pragma unroll
                for (int q = 0; q < 8; ++q) { kk[q] = k[q] * kkv[q]; ss += kk[q] * kk[q]; }
                ss = sum8(ss);
                const float inv = 1.0f / fmaxf(sqrtf(ss), 1e-12f);
#pragma unroll
                for (int q = 0; q < 8; ++q) { const float ag = sigmoidf_(ap[q]); const float kn = kk[q] * inv; const float kp = k[q] * (1.0f + (ag - 1.0f) * kav[q]);
                    const float lw = -0.6065306597126334f * sigmoidf_(wp[q]);
                    const int o = pt * 64 + cq * 8 + q;
                    sR[o] = r[q]; sK[o] = kp; sV[o] = v[q]; sA[o] = -kn; sB[o] = kn * ag; sD[o] = __expf(lw); rks += r[q] * kp * rkv[q]; }
                rks = sum8(rks);
                if (cq == 0) RK[row * NH + h] = rks;
            }
            __syncthreads();
            for (int t = 0; t < 64; ++t) {
                const LAS f32x4* pa = (const LAS f32x4*)(sA + t * 64 + jq * 8); const LAS f32x4* pb = (const LAS f32x4*)(sB + t * 64 + jq * 8);
                const LAS f32x4* pd = (const LAS f32x4*)(sD + t * 64 + jq * 8); const LAS f32x4* pk = (const LAS f32x4*)(sK + t * 64 + jq * 8);
                const LAS f32x4* pr = (const LAS f32x4*)(sR + t * 64 + jq * 8);
                const f32x4 a0 = pa[0], a1 = pa[1], b0 = pb[0], b1 = pb[1], d0 = pd[0], d1 = pd[1], k0 = pk[0], k1 = pk[1], r0 = pr[0], r1 = pr[1];
                const float vi = sV[t * 64 + si];
                float sa = 0.f;
#pragma unroll
                for (int q = 0; q < 4; ++q) { sa += S[q] * a0[q]; sa += S[4 + q] * a1[q]; }
                sa = sum8(sa);
                float y = 0.f;
#pragma unroll
                for (int q = 0; q < 4; ++q) { S[q] = S[q] * d0[q] + sa * b0[q] + vi * k0[q]; S[4 + q] = S[4 + q] * d1[q] + sa * b1[q] + vi * k1[q]; y += S[q] * r0[q]; y += S[4 + q] * r1[q]; }
                y = sum8(y);
                if (jq == 0) Y[((size_t)b * SEQ + blk * 64 + t) * C + h * HD + si] = y;
            }
            __syncthreads();
        }
    }
}
__device__ __forceinline__ void post_scan(unsigned char* ws, int gw, int NGW, int lane) {
    const float* Y = OUTP(); const float* RK = (const float*)(ws + WS_HID); const bf16* Vb = (const bf16*)(ws + WS_B3); const bf16* LG = (const bf16*)(ws + WS_LG);
    bf16* YG = (bf16*)(ws + WS_B4); const float* g2 = INP(14); const float* lnw = INP(18); const float* lnb = INP(19);
    for (int it = gw; it < M * NH; it += NGW) {
        const int row = it / NH, h = it % NH, c = h * HD + lane;
        const float y = Y[(size_t)row * C + c];
        const float mu = wave_sum(y, lane) * (1.0f / HD); const float d = y - mu; const float var = wave_sum(d * d, lane) * (1.0f / HD);
        float o = d * (1.0f / sqrtf(var + GN_EPS)) * lnw[c] + lnb[c];
        o += RK[(size_t)row * NH + h] * bf2f(Vb[(size_t)row * C + c]);
        float g = 0.f;
        for (int dd = 0; dd < DG; ++dd) g += bf2f(LG[(size_t)row * DG + dd]) * g2[(size_t)dd * C + c];
        YG[(size_t)row * C + c] = (bf16)f2bf(o * g);
    }
}


constexpr int CW_DBG = 3200;
__device__ __forceinline__ void dbg_nonfinite(unsigned char* ws, const bf16* X, size_t n, int slot, int gw, int NGW, int lane, float thr = 1e30f) {
    unsigned* cw = (unsigned*)(ws + WS_CTL) + CW_DBG + 64 * slot; unsigned nnan = 0;
    for (size_t i = (size_t)gw * 64 + lane; i < n; i += (size_t)NGW * 64) { const float x = bf2f(X[i]); if (!(fabsf(x) < thr)) ++nnan; }
    if (nnan) atomicAdd(cw, nnan);
}
__device__ __forceinline__ void dbg_compare(unsigned char* ws, const bf16* X, const bf16* Y, int gw, int NGW, int lane) {
    unsigned* cw = (unsigned*)(ws + WS_CTL) + CW_DBG; unsigned nbad = 0, nnan = 0;
    for (size_t i = (size_t)gw * 64 + lane; i < (size_t)M * C; i += (size_t)NGW * 64) { const float x = bf2f(X[i]), y = bf2f(Y[i]);
        if (!(fabsf(x) < 1e30f)) ++nnan; else if (fabsf(x - y) > 0.05f * (fabsf(y) + 0.05f)) ++nbad; }
    if (nnan) atomicAdd(cw, nnan); if (nbad) atomicAdd(cw + 64, nbad);
}
#endif
__device__ __forceinline__ void router_rows(unsigned char* ws, LAS unsigned char* lds, int layer, int gw, int NGW, int lane, int tid, bool dry = false) {
    const bf16* Hh = (const bf16*)(ws + WS_B4); const float* gain = INP(2) + layer * C; float* rsl = (float*)(ws + WS_B0);
    const float* wg = INP(24) + (size_t)layer * C * 4; const float* bg = INP(25) + layer * 4; const float* wi = INP(26) + (size_t)layer * C * 16; const float* bi = INP(27) + layer * 16;
    unsigned* cnt = (unsigned*)(ws + WS_CTL) + CW_CNT + layer * 16 * 64; unsigned* list = (unsigned*)(ws + WS_LIST); float* wl = (float*)(ws + WS_WL);
    LAS float* sWg = (LAS float*)lds; LAS float* sWi = sWg + C * 4;
    constexpr int RECMAX = 256;
    LAS unsigned* lcnt = (LAS unsigned*)(lds + 81920); LAS unsigned* gbase = lcnt + 16; LAS int* nrec = (LAS int*)(lcnt + 32);
    LAS unsigned* recRow = lcnt + 64; LAS unsigned* recE = recRow + RECMAX; LAS unsigned* recL = recE + RECMAX; LAS float* recW0 = (LAS float*)(recL + RECMAX); LAS float* recW1 = recW0 + RECMAX; LAS float* recRS = recW1 + RECMAX;
    __syncthreads();
    for (int e = tid; e < C * 4; e += 512) sWg[e] = wg[e];
    for (int e = tid; e < C * 16; e += 512) sWi[e] = wi[e];
    if (tid < 33) lcnt[tid == 32 ? 32 : tid] = 0u;
    __syncthreads();
    f32x4 g[4]; load_row(gain, lane, g);
    for (int row = gw; row < M; row += NGW) {
        f32x4 v[4]; load_row_bf(Hh + (size_t)row * C, lane, v); const float rs = row_rs(v, lane);
#pragma unroll
        for (int j = 0; j < 4; ++j) v[j] = v[j] * rs * g[j];
        float gl[4] = {0.f, 0.f, 0.f, 0.f};
        const LAS unsigned char* pWg = (const LAS unsigned char*)sWg + lane * 64;
#pragma unroll
        for (int j = 0; j < 4; ++j)
#pragma unroll
            for (int q = 0; q < 4; ++q) { const f32x4 w = *(const LAS f32x4*)(pWg + j * 4096 + q * 16); const float xv = v[j][q]; gl[0] += xv * w.x; gl[1] += xv * w.y; gl[2] += xv * w.z; gl[3] += xv * w.w; }
#pragma unroll
        for (int q = 0; q < 4; ++q) gl[q] = wave_sum(gl[q], lane) + bg[q];
        int gi = 0; float gm = gl[0];
#pragma unroll
        for (int q = 1; q < 4; ++q) if (gl[q] > gm) { gm = gl[q]; gi = q; }
        float gden = 0.f;
#pragma unroll
        for (int q = 0; q < 4; ++q) gden += __expf(gl[q] - gm);
        const float gval = 1.0f / gden;
        float il[4] = {0.f, 0.f, 0.f, 0.f};
        const LAS unsigned char* pWi = (const LAS unsigned char*)sWi + lane * 256 + gi * 16;
#pragma unroll
        for (int j = 0; j < 4; ++j)
#pragma unroll
            for (int q = 0; q < 4; ++q) { const f32x4 w = *(const LAS f32x4*)(pWi + j * 16384 + q * 64); const float xv = v[j][q]; il[0] += xv * w.x; il[1] += xv * w.y; il[2] += xv * w.z; il[3] += xv * w.w; }
#pragma unroll
        for (int q = 0; q < 4; ++q) il[q] = wave_sum(il[q], lane) + bi[gi * 4 + q];
        int i0 = 0; float m0 = il[0];
#pragma unroll
        for (int q = 1; q < 4; ++q) if (il[q] > m0) { m0 = il[q]; i0 = q; }
        int i1 = -1; float m1 = -INFINITY;
#pragma unroll
        for (int q = 0; q < 4; ++q) if (q != i0 && il[q] > m1) { m1 = il[q]; i1 = q; }
        const float e1 = __expf(m1 - m0); const float w0 = gval / (1.0f + e1), w1 = gval * e1 / (1.0f + e1);
        if (lane == 0 && !dry) {
            const int ex0 = gi * 4 + i0, ex1 = gi * 4 + i1;
            const int ri = __hip_atomic_fetch_add(nrec, 1, __ATOMIC_RELAXED, __HIP_MEMORY_SCOPE_WORKGROUP);
            const unsigned l0 = __hip_atomic_fetch_add(lcnt + ex0, 1u, __ATOMIC_RELAXED, __HIP_MEMORY_SCOPE_WORKGROUP), l1 = __hip_atomic_fetch_add(lcnt + ex1, 1u, __ATOMIC_RELAXED, __HIP_MEMORY_SCOPE_WORKGROUP);
            if (ri < RECMAX) { recRow[ri] = (unsigned)row; recE[ri] = (unsigned)ex0 | ((unsigned)ex1 << 8); recL[ri] = l0 | (l1 << 16); recW0[ri] = w0; recW1[ri] = w1; recRS[ri] = rs; }
        }
    }
    __syncthreads();
    if (tid < 16 && !dry) gbase[tid] = atomicAdd(cnt + tid * 64, lcnt[tid]);
    __syncthreads();
    { const int n = *nrec < RECMAX ? *nrec : RECMAX;
      for (int i = tid; i < n; i += 512) { const unsigned row = recRow[i], e = recE[i], l = recL[i]; const unsigned ex0 = e & 255u, ex1 = e >> 8;
          const unsigned p0 = gbase[ex0] + (l & 0xffffu), p1 = gbase[ex1] + (l >> 16);
          list[(size_t)ex0 * M + p0] = row * 2u; wl[(size_t)ex0 * M + p0] = recW0[i]; list[(size_t)ex1 * M + p1] = row * 2u + 1u; wl[(size_t)ex1 * M + p1] = recW1[i];
          rsl[(size_t)ex0 * M + p0] = recRS[i]; rsl[(size_t)ex1 * M + p1] = recRS[i]; } }
}
__device__ __forceinline__ void moe_table(unsigned char* ws, volatile LAS int* tab, int layer, int tid) {
    __syncthreads();
    if (tid == 0) { const unsigned* cnt = (const unsigned*)(ws + WS_CTL) + CW_CNT + layer * 16 * 64; int t = 0;
#pragma unroll 1
        for (int e = 0; e < 16; ++e) { const int c = (int)__hip_atomic_load(cnt, RLX_AGENT); cnt += 64; tab[e] = c; tab[16 + e] = t; t += (c + 255) >> 8; tab[32 + e] = t; }
        tab[48] = t; }
    __syncthreads();
}
__device__ __forceinline__ void combine_rows(unsigned char* ws, int mode, int gw, int NGW, int lane, bool dry = false) {
    bf16* Hh = (bf16*)(ws + WS_B4); float* Out = OUTP(); const bf16* E0 = (const bf16*)(ws + WS_B2); const bf16* E1 = (const bf16*)(ws + WS_B3); bf16* XN2 = (bf16*)(ws + WS_B0);
    f32x4 g[4]; load_row(INP(4), lane, g);
    for (int row = gw; row < M; row += NGW) {
        f32x4 v[4]; load_row_bf(Hh + (size_t)row * C, lane, v);
#pragma unroll
        for (int j = 0; j < 4; ++j) { const v2u e0 = ((const GAS v2u*)(E0 + (size_t)row * C))[64 * j + lane], e1 = ((const GAS v2u*)(E1 + (size_t)row * C))[64 * j + lane];
            v[j].x += bflo(e0.x) + bflo(e1.x); v[j].y += bfhi(e0.x) + bfhi(e1.x); v[j].z += bflo(e0.y) + bflo(e1.y); v[j].w += bfhi(e0.y) + bfhi(e1.y); }
        const float rs = row_rs(v, lane);
        if (mode == 0) {
            if (!dry) store_row_bf16(Hh + (size_t)row * C, lane, v);
            if (lane == 0) ((float*)XN2)[row] = rs;
        } else {
            float sig = 1.0f;
#if MK_DEBUG
            const unsigned* cw = (const unsigned*)(ws + WS_CTL) + CW_DBG; const unsigned nnan = __hip_atomic_load(cw, RLX_AGENT), nbad = __hip_atomic_load(cw + 64, RLX_AGENT);
            if (row < 512 && nnan > 0) sig = 2.0f;
            if (row >= 512 && row < 1536 && __hip_atomic_load(cw + 128, RLX_AGENT) > 0) sig = 2.0f;
            if (row >= 1536 && row < 3584 && __hip_atomic_load(cw + 192, RLX_AGENT) > 0) sig = 2.0f;
            if (row >= 3584 && row < 7680 && __hip_atomic_load(cw + 256, RLX_AGENT) > 0) sig = 2.0f;
            if (row >= 7680 && row < 15872 && __hip_atomic_load(cw + 320, RLX_AGENT) > 0) sig = 2.0f;
            if (row >= 15872 && nbad > (unsigned)(M / 100) * C) sig = 1.5f;
#endif
#pragma unroll
            for (int j = 0; j < 4; ++j) ((GAS f32x4*)(Out + (size_t)row * C))[64 * j + lane] = v[j] * rs * g[j] * sig;
        }
    }
}
__device__ __forceinline__ void attn_naive(unsigned char* ws, int gw, int NGW, int lane) {
    const bf16* Kb = (const bf16*)(ws + WS_B1); const bf16* Vb = (const bf16*)(ws + WS_B2); const bf16* Qb = (const bf16*)(ws + WS_B3); bf16* Ob = (bf16*)(ws + WS_B0);
    for (int unit = gw; unit < BATCH * NH * (SEQ / 64); unit += NGW) {
        const int qb = unit % (SEQ / 64), bh = unit / (SEQ / 64), b = bh / NH, h = bh % NH;
        const int t0 = qb * 64, t = t0 + lane; const size_t rowq = (size_t)b * SEQ + t;
        float q[64], o[64];
#pragma unroll
        for (int c = 0; c < 8; ++c) { const v4u w = *(const GAS v4u*)(Qb + rowq * C + h * HD + c * 8);
            q[c * 8 + 0] = bflo(w.x) * 0.125f; q[c * 8 + 1] = bfhi(w.x) * 0.125f; q[c * 8 + 2] = bflo(w.y) * 0.125f; q[c * 8 + 3] = bfhi(w.y) * 0.125f;
            q[c * 8 + 4] = bflo(w.z) * 0.125f; q[c * 8 + 5] = bfhi(w.z) * 0.125f; q[c * 8 + 6] = bflo(w.w) * 0.125f; q[c * 8 + 7] = bfhi(w.w) * 0.125f; }
#pragma unroll
        for (int c = 0; c < 64; ++c) o[c] = 0.f;
        float suffix = 0.f;
        for (int s = t0 + 62; s >= 0; --s) {
            const bool valid = s < t;
            if (s < t0 && __all(suffix > SB_EXIT)) break;
            const bf16* kp = Kb + ((size_t)b * SEQ + s) * C + h * HD; const bf16* vp = Vb + ((size_t)b * SEQ + s) * C + h * HD;
            float z = 0.f;
#pragma unroll
            for (int c = 0; c < 8; ++c) { const v4u w = *(const GAS v4u*)(kp + c * 8);
                z += q[c * 8 + 0] * bflo(w.x) + q[c * 8 + 1] * bfhi(w.x) + q[c * 8 + 2] * bflo(w.y) + q[c * 8 + 3] * bfhi(w.y) + q[c * 8 + 4] * bflo(w.z) + q[c * 8 + 5] * bfhi(w.z) + q[c * 8 + 6] * bflo(w.w) + q[c * 8 + 7] * bfhi(w.w); }
            const float sp = fmaxf(z, 0.f) + log1pf(__expf(-fabsf(z)));
            const float att = valid ? __expf(z - sp - suffix) : 0.f;
            suffix += valid ? sp : 0.f;
#pragma unroll
            for (int c = 0; c < 8; ++c) { const v4u w = *(const GAS v4u*)(vp + c * 8);
                o[c * 8 + 0] += att * bflo(w.x); o[c * 8 + 1] += att * bfhi(w.x); o[c * 8 + 2] += att * bflo(w.y); o[c * 8 + 3] += att * bfhi(w.y);
                o[c * 8 + 4] += att * bflo(w.z); o[c * 8 + 5] += att * bfhi(w.z); o[c * 8 + 6] += att * bflo(w.w); o[c * 8 + 7] += att * bfhi(w.w); }
        }
#pragma unroll
        for (int c = 0; c < 8; ++c) { v4u w; w.x = pk2(o[c * 8 + 0], o[c * 8 + 1]); w.y = pk2(o[c * 8 + 2], o[c * 8 + 3]); w.z = pk2(o[c * 8 + 4], o[c * 8 + 5]); w.w = pk2(o[c * 8 + 6], o[c * 8 + 7]);
            *(GAS v4u*)(Ob + rowq * C + h * HD + c * 8) = w; }
    }
}


typedef float f32x16 __attribute__((ext_vector_type(16)));
constexpr int AT_VP = 192;
constexpr int AT_WAVE_LDS = 32 * AT_VP;
__device__ __forceinline__ int crow32(int reg, int hh) { return (reg & 3) + 8 * (reg >> 2) + 4 * hh; }
__device__ __forceinline__ bf16x8s pack_step(const f32x16& x, const int s) {
    v4u p; p.x = pg8::cvt_pk_bf16(x[8 * s], x[8 * s + 1]); p.y = pg8::cvt_pk_bf16(x[8 * s + 2], x[8 * s + 3]); p.z = pg8::cvt_pk_bf16(x[8 * s + 4], x[8 * s + 5]); p.w = pg8::cvt_pk_bf16(x[8 * s + 6], x[8 * s + 7]);
    return __builtin_bit_cast(bf16x8s, p);
}
__device__ __forceinline__ void attn_mfma(unsigned char* ws, LAS unsigned char* lds, int gw, int NGW, int lane, int wave) {
    const bf16* Kb = (const bf16*)(ws + WS_B1); const bf16* Vb = (const bf16*)(ws + WS_B2); const bf16* Qb = (const bf16*)(ws + WS_B3); bf16* Ob = (bf16*)(ws + WS_B0);
    LAS unsigned char* vl = lds + wave * AT_WAVE_LDS;
    const int r32 = lane & 31, hh = lane >> 5;
    bf16x8s tri[2];
#pragma unroll
    for (int s = 0; s < 2; ++s)
#pragma unroll
        for (int j = 0; j < 8; ++j) tri[s][j] = (16 * s + 8 * (j >> 2) + 4 * hh + (j & 3)) > r32 ? (short)0x3F80 : (short)0;
    const int grp = lane >> 4, tq = (lane & 15) >> 2, tp = lane & 3;
    const LAS unsigned char* vtr0 = vl + (4 * hh + tq) * AT_VP + (16 * (grp & 1) + 4 * tp) * 2;
    for (int unit = gw; unit < BATCH * NH * (SEQ / 32); unit += NGW) {
        const int qb = unit % (SEQ / 32), bh = unit / (SEQ / 32), b = bh / NH, hd = bh % NH;
        const int t0 = qb * 32; const size_t rowb = (size_t)b * SEQ;
        bf16x8s qf[4];
#pragma unroll
        for (int ks = 0; ks < 4; ++ks) qf[ks] = *(const GAS bf16x8s*)(Qb + (rowb + t0 + r32) * C + hd * HD + 16 * ks + 8 * hh);
        f32x16 o[2];
#pragma unroll
        for (int i = 0; i < 16; ++i) { o[0][i] = 0.f; o[1][i] = 0.f; }
        float carry = 0.f;
        for (int s0 = t0; s0 >= 0; s0 -= 32) {
            bf16x8s kf[4];
#pragma unroll
            for (int ks = 0; ks < 4; ++ks) kf[ks] = *(const GAS bf16x8s*)(Kb + (rowb + s0 + r32) * C + hd * HD + 16 * ks + 8 * hh);
            v4u vreg[4];
#pragma unroll
            for (int i = 0; i < 4; ++i) { const int cidx = lane + 64 * i; vreg[i] = *(const GAS v4u*)(Vb + (rowb + s0 + (cidx >> 3)) * C + hd * HD + (cidx & 7) * 8); }
            f32x16 st;
#pragma unroll
            for (int i = 0; i < 16; ++i) st[i] = 0.f;
#pragma unroll
            for (int ks = 0; ks < 4; ++ks) st = __builtin_amdgcn_mfma_f32_32x32x16_bf16(kf[ks], qf[ks], st, 0, 0, 0);
#pragma unroll
            for (int i = 0; i < 4; ++i) { const int cidx = lane + 64 * i; *(LAS v4u*)(vl + (cidx >> 3) * AT_VP + (cidx & 7) * 16) = vreg[i]; }
            f32x16 zz, uu; float tot = 0.f; const int tq_ = t0 + r32;
            if (s0 + 31 < t0) {
#pragma unroll
                for (int i = 0; i < 16; ++i) { const float z = st[i] * 0.18033688011112042f; const float sp = fmaxf(z, 0.f) + __builtin_amdgcn_logf(1.0f + __builtin_amdgcn_exp2f(-fabsf(z)));
                    zz[i] = z - sp; uu[i] = sp; tot += sp; }
            } else {
#pragma unroll
                for (int i = 0; i < 16; ++i) { const int key = s0 + crow32(i, hh); const float z = st[i] * 0.18033688011112042f; const float sp = fmaxf(z, 0.f) + __builtin_amdgcn_logf(1.0f + __builtin_amdgcn_exp2f(-fabsf(z)));
                    const bool valid = key < tq_; zz[i] = valid ? z - sp : -1e30f; uu[i] = valid ? sp : 0.f; tot += uu[i]; }
            }
            f32x16 w;
#pragma unroll
            for (int i = 0; i < 16; ++i) w[i] = 0.f;
#pragma unroll
            for (int s = 0; s < 2; ++s) w = __builtin_amdgcn_mfma_f32_32x32x16_bf16(tri[s], pack_step(uu, s), w, 0, 0, 0);
            f32x16 pp;
#pragma unroll
            for (int i = 0; i < 16; ++i) pp[i] = __builtin_amdgcn_exp2f(zz[i] - w[i] - carry);
            tot += shx(tot, 32, lane); carry += tot;
            asm volatile("s_waitcnt lgkmcnt(0)" ::: "memory");
#pragma unroll
            for (int s = 0; s < 2; ++s) { const bf16x8s pa = pack_step(pp, s);
#pragma unroll
                for (int dt = 0; dt < 2; ++dt) {
                    const v4i16_t lo = __builtin_amdgcn_ds_read_tr16_b64_v4i16((LAS v4i16_t*)(vtr0 + (16 * s) * AT_VP + dt * 64));
                    const v4i16_t hi = __builtin_amdgcn_ds_read_tr16_b64_v4i16((LAS v4i16_t*)(vtr0 + (16 * s + 8) * AT_VP + dt * 64));
                    const bf16x8s vf = (bf16x8s){lo[0], lo[1], lo[2], lo[3], hi[0], hi[1], hi[2], hi[3]};
                    o[dt] = __builtin_amdgcn_mfma_f32_32x32x16_bf16(pa, vf, o[dt], 0, 0, 0); } }
            asm volatile("" ::: "memory");
            if (s0 < t0 && __all(carry > SB_EXIT * 1.4426950408889634f)) break;
        }
#pragma unroll
        for (int dt = 0; dt < 2; ++dt)
#pragma unroll
            for (int i = 0; i < 16; ++i) Ob[(rowb + t0 + crow32(i, hh)) * C + hd * HD + 32 * dt + r32] = (bf16)f2bf(o[dt][i]);
    }
}
__global__ void __launch_bounds__(NWAVES * 64, 2) yoco_fwd(Args args) {
    extern __shared__ __attribute__((aligned(16))) unsigned char lds_raw[];
    LAS unsigned char* lds = (LAS unsigned char*)lds_raw;
    const int G = gridDim.x; const int bx = blockIdx.x;
    int wave = __builtin_amdgcn_readfirstlane(threadIdx.x >> 6); asm volatile("" : "+s"(wave));
#define IDS() int lane; asm volatile("v_mbcnt_lo_u32_b32 %0, -1, 0\n\tv_mbcnt_hi_u32_b32 %0, -1, %0" : "=v"(lane)); const int tid = wave * 64 + lane; (void)tid; \
    const int vcu = (G % 8 == 0) ? (bx % 8) * (G / 8) + bx / 8 : bx; const int gw = vcu * NWAVES + wave, NGW = G * NWAVES; (void)lane; (void)gw; (void)NGW;
    unsigned char* ws = WSP();
    volatile LAS unsigned* MISC = (volatile LAS unsigned*)(lds + MISC_OFF);
    volatile LAS int* tab = (volatile LAS int*)(lds + MOE_TAB_OFF);
    for (int u = threadIdx.x; u < (LDS_BYTES - LDSCTL_OFF) / 4; u += NWAVES * 64) ((LAS unsigned*)(lds + LDSCTL_OFF))[u] = 0u;
    __syncthreads();
    XcdBarrier bar; bar.bar = (unsigned*)(ws + WS_CTL) + CW_BAR; bar.x = 0; bar.st = nullptr;
    if (N_LAUNCHES == 1) bar = xcd_barrier_post((unsigned*)(ws + WS_CTL) + CW_BAR, MISC + 8);
    const int lo = KA_INT(0), hi = KA_INT(1);
#ifndef PROBE_PH
#define PROBE_PH -1
#endif
#define IN(k) (lo <= (k) && (k) < hi)
#define REP(k) for (int rep_ = 0; rep_ < ((PROBE_PH == (k)) ? 2 : 1); ++rep_)
#define SEAM(k) do { if (IN(k) && IN((k) + 1)) xcd_barrier(bar); } while (0)

    if (IN(PH_P0)) REP(PH_P0) { IDS(); p0_weights<0>(ws, lds, gw, NGW, wave, lane); p0_weights<1>(ws, lds, gw, NGW, wave, lane); if (G <= 64) p0_weights<2>(ws, lds, gw, NGW, wave, lane); p0_rows(ws, gw, NGW, lane); }
    SEAM(PH_P0);
    if (PROBE_PH == 100 && N_LAUNCHES == 1) { for (int i_ = 0; i_ < 10; ++i_) xcd_barrier(bar); }
    if (IN(PH_LORA)) REP(PH_LORA) {
        SchedGrouped<1, 3> S{(const char*)(ws + WS_B1), (size_t)(WS_B2 - WS_B1), nullptr, (const char*)(ws + WS_WT_LORA), (size_t)256 * C * 2, G, bx};
        EpiLora E{(bf16*)(ws + WS_LW)};
        pg8::gemm_phase<EpiLora, SchedGrouped<1, 3>, true, false, C>(lds, S, E, wave);
    }
    SEAM(PH_LORA);
    if (IN(PH_RKV)) REP(PH_RKV) {
        SchedGrouped<4, 3> S{(const char*)OUTP(), (size_t)M * C * 2, (const char*)(ws + WS_B4), (const char*)(ws + WS_WT_RKV), (size_t)C * C * 2, G, bx};
        EpiSplit3 E{(bf16*)(ws + WS_B1), false, nullptr};
        pg8::gemm_phase<EpiSplit3, SchedGrouped<4, 3>, true, false, C>(lds, S, E, wave);
    }
    SEAM(PH_RKV);
    if (IN(PH_S1)) REP(PH_S1) { IDS(); scan_s1(ws, lds, lane, wave); }
    SEAM(PH_S1);
    if (IN(PH_S2)) REP(PH_S2) { IDS();
        if (bx < BATCH * NH || G <= BATCH * NH) scan_s2(ws, lds, lane, wave);
        }
    SEAM(PH_S2);
    if (IN(PH_S3)) REP(PH_S3) { IDS(); scan_s3(ws, lds, lane, wave); }
    SEAM(PH_S3);
#if MK_DEBUG
    if (IN(PH_DBG0)) { IDS(); scan_naive(ws, lds, tid); }
    SEAM(PH_DBG0);
    if (IN(PH_DBG0 + 1)) { IDS(); post_scan(ws, gw, NGW, lane); }
    SEAM(PH_DBG0 + 1);
    if (IN(PH_DBG0 + 2)) { IDS(); dbg_compare(ws, (const bf16*)(ws + WS_B0), (const bf16*)(ws + WS_B4), gw, NGW, lane); }
    SEAM(PH_DBG0 + 2);
#endif
    if (IN(PH_WOUT)) REP(PH_WOUT) {
        SchedGrouped<4, 1> S{(const char*)(ws + ((MK_DEBUG && DBG_USE_NAIVE) ? WS_B4 : WS_B0)), 0, nullptr, (const char*)(ws + WS_WT_OUT), 0, G, bx};
        EpiResidBf<true> E{INP(0), (bf16*)(ws + WS_B4)};
        pg8::gemm_phase<EpiResidBf<true>, SchedGrouped<4, 1>, true, false, C>(lds, S, E, wave);
    }
    SEAM(PH_WOUT);
#pragma unroll 1
    for (int layer = 0; layer < 2; ++layer) {
        const int pb = layer == 0 ? (int)PH_ROUT0 : (int)PH_ROUT1;
        if (IN(pb)) { IDS(); if (PROBE_PH == 101 && layer == 0) router_rows(ws, lds, layer, gw, NGW, lane, tid, true); router_rows(ws, lds, layer, gw, NGW, lane, tid); }
        SEAM(pb);
        if (IN(pb + 1)) REP(pb + 1) {
            { IDS(); moe_table(ws, tab, layer, tid); }
            SchedMoe<2, C, true> S{(const char*)(ws + WS_B4), (const char*)(ws + WS_WT_GU) + (size_t)layer * 16 * 512 * C * 2, (size_t)512 * C * 2, (const unsigned*)(ws + WS_LIST), tab, G, bx};
            EpiGU E{(bf16*)(ws + WS_HID), (const float*)(ws + WS_WL), (const float*)(ws + WS_B0)};
            pg8::gemm_phase<EpiGU, SchedMoe<2, C, true>, true, true, C>(lds, S, E, wave);
            if (layer == 0 && G > 64) { const int nr2 = __builtin_amdgcn_readfirstlane(tab[48]) * 2 - G, first = nr2 > 0 ? nr2 : 0;
                if (bx >= first) { IDS(); p0_weights<2>(ws, lds, (bx - first) * NWAVES + wave, (G - first) * NWAVES, wave, lane); } }
        }
        SEAM(pb + 1);
        if (IN(pb + 2)) REP(pb + 2) {
            { IDS(); moe_table(ws, tab, layer, tid); }
            SchedMoe<4, FE, false> S{(const char*)(ws + WS_HID), (const char*)(ws + WS_WT_DN) + (size_t)layer * 16 * C * FE * 2, (size_t)C * FE * 2, (const unsigned*)(ws + WS_LIST), tab, G, bx};
            EpiDown E{(bf16*)(ws + WS_B2), (const unsigned*)(ws + WS_LIST)};
            pg8::gemm_phase<EpiDown, SchedMoe<4, FE, false>, true, false, FE>(lds, S, E, wave);
        }
        SEAM(pb + 2);
        if (layer == 0) {
            if (IN(PH_COMB)) { IDS(); if (PROBE_PH == 102) combine_rows(ws, 0, gw, NGW, lane, true); combine_rows(ws, 0, gw, NGW, lane); }
            SEAM(PH_COMB);
            if (IN(PH_KVQ)) REP(PH_KVQ) {
                SchedGrouped<12, 1> S{(const char*)(ws + WS_B4), 0, nullptr, (const char*)(ws + WS_WT_KVQ), 0, G, bx};
                EpiSplit3 E{(bf16*)(ws + WS_B1), true, (const float*)(ws + WS_B0)};
                pg8::gemm_phase<EpiSplit3, SchedGrouped<12, 1>, true, false, C>(lds, S, E, wave);
            }
            SEAM(PH_KVQ);
            if (IN(PH_ATTN)) REP(PH_ATTN) { IDS(); attn_mfma(ws, lds, gw, NGW, lane, wave); }
            SEAM(PH_ATTN);
            if (IN(PH_SBO)) {
                SchedGrouped<4, 1> S{(const char*)(ws + WS_B0), 0, nullptr, (const char*)(ws + WS_WT_SBO), 0, G, bx};
                EpiResidBf<false> E{(const void*)(ws + WS_B4), (bf16*)(ws + WS_B4)};
                pg8::gemm_phase<EpiResidBf<false>, SchedGrouped<4, 1>, true, false, C>(lds, S, E, wave);
            }
            SEAM(PH_SBO);
        }
    }
    if (IN(PH_FINAL)) { IDS(); combine_rows(ws, 1, gw, NGW, lane); }
#undef IN
#undef SEAM
}

extern "C" void kernel_launch(void* const* d_in, const int* in_sizes, int n_in, void* d_out, int out_size, void* d_ws, size_t ws_size, hipStream_t stream) {
    static int grid = 0;
    if (grid == 0) {
        if (n_in != 31 || in_sizes[0] != M * C || out_size != M * C || ws_size < WS_END) { fprintf(stderr, "kernel_launch: unexpected shapes (n_in %d, in0 %d, out %d, ws %zu); nothing launched\n", n_in, n_in > 0 ? in_sizes[0] : -1, out_size, ws_size); grid = -1; return; }
        int dev = 0, cus = 0, per_cu = 0;
        if (hipGetDevice(&dev) != hipSuccess || hipDeviceGetAttribute(&cus, hipDeviceAttributeMultiprocessorCount, dev) != hipSuccess) { grid = -1; return; }
        if (hipFuncSetAttribute((const void*)yoco_fwd, hipFuncAttributeMaxDynamicSharedMemorySize, LDS_BYTES) != hipSuccess) { fprintf(stderr, "kernel_launch: hipFuncSetAttribute failed\n"); grid = -1; return; }
        if (hipOccupancyMaxActiveBlocksPerMultiprocessor(&per_cu, (const void*)yoco_fwd, NWAVES * 64, LDS_BYTES) != hipSuccess || per_cu < 1) fprintf(stderr, "kernel_launch: occupancy query reports %d\n", per_cu);
        (void)hipGetLastError();
        grid = cus - (cus % 16);
    }
    if (grid < 0) return;
    if (hipMemsetAsync((char*)d_ws + WS_CTL, 0, CTL_ZERO_BYTES, stream) != hipSuccess) return;
    Args a{};
    for (int i = 0; i < 31; ++i) a.in[i] = (const float*)d_in[i];
    a.out = (float*)d_out; a.ws = (unsigned char*)d_ws;
    for (int li = 0; li < (N_LAUNCHES == 1 ? 1 : (int)NPHASE); ++li) {
        a.ph_lo = (N_LAUNCHES == 1) ? 0 : li; a.ph_hi = (N_LAUNCHES == 1) ? NPHASE : li + 1; a.li = li;
        hipLaunchKernelGGL(yoco_fwd, dim3(grid), dim3(NWAVES * 64), LDS_BYTES, stream, a);
        const hipError_t le = hipPeekAtLastError();
        if (le != hipSuccess) { fprintf(stderr, "kernel_launch: launch %d failed: %s\n", li, hipGetErrorName(le)); break; }
    }
}
```

```cpp
#include <hip/hip_runtime.h>
#include <cstdio>
#include <cstdint>

#ifndef MK_N_LAUNCHES
#define MK_N_LAUNCHES 1
#endif

namespace pg8 {
#define PG8_LAS __attribute__((address_space(3)))
typedef unsigned short bf16_t;
typedef short bf16x8 __attribute__((ext_vector_type(8)));
typedef float f32x4 __attribute__((ext_vector_type(4)));
typedef unsigned u32x4 __attribute__((ext_vector_type(4)));
constexpr int BM = 256, BK = 64, HALF = 128, HTB = HALF * BK * 2, STAGE_BYTES = 8 * HTB, NXCD = 8, WGM = 8;

__host__ __device__ __forceinline__ int lds_byte(int r, int c) { const int st = (r >> 4) * 2 + (c >> 5), rr = r & 15, cc = c & 31, ob = rr * 64 + cc * 2; return st * 1024 + (ob ^ (((ob >> 9) & 1) << 5)); }
__host__ __device__ __forceinline__ void stage_rc(int b, int& R, int& C) { const int st = b / 1024, sb = b % 1024, swz = sb ^ (((sb >> 9) & 1) << 5); R = (st >> 1) * 16 + swz / 64; C = (st & 1) * 32 + (swz % 64) / 2; }
__host__ __device__ __forceinline__ int perm32(int rho) { const int n = rho >> 4, i = rho & 15; return 8 * (i >> 2) + 4 * n + (i & 3); }

struct Unit { int pm, pn, aux, r0, cnt; };

__host__ __device__ __forceinline__ void tile_map(int wgid, int nM, int nN, int& pm, int& pn) {
    const int nwg = nM * nN;
    { const int q = nwg / NXCD, r = nwg % NXCD, xcd = wgid % NXCD, off = wgid / NXCD; wgid = (xcd < r ? xcd * (q + 1) : r * (q + 1) + (xcd - r) * q) + off; }
    const int nig = WGM * nN, gid = wgid / nig, fm = gid * WGM, gsz = (nM - fm) < WGM ? (nM - fm) : WGM;
    pm = fm + ((wgid % nig) % gsz); pn = (wgid % nig) / gsz;
}

typedef float f32x2_t __attribute__((ext_vector_type(2))); typedef __bf16 bf16x2_t __attribute__((ext_vector_type(2)));
__device__ __forceinline__ unsigned cvt_pk_bf16(float lo, float hi) { const f32x2_t v = {lo, hi}; const bf16x2_t b = __builtin_convertvector(v, bf16x2_t); return __builtin_bit_cast(unsigned, b); }

template <class Epi, class Sched, bool ALIGN_EPI, bool GATHER, int K>
__device__ __forceinline__ void gemm_phase(PG8_LAS unsigned char* lds, const Sched& S, const Epi& E, const int wid) {
    int lane_; asm volatile("v_mbcnt_lo_u32_b32 %0, -1, 0\n\tv_mbcnt_hi_u32_b32 %0, -1, %0" : "=v"(lane_));
    const int lane = lane_, tid = wid * 64 + lane, wr = wid >> 2, wc = wid & 3, fr = lane & 15, fq = lane >> 4;
    constexpr int nt = K / BK;
    unsigned voffA[2], voffB[2];
#pragma unroll
    for (int i = 0; i < 2; ++i) { int R, C; stage_rc(tid * 16 + i * 8192, R, C); const int Rb = Epi::PERM ? ((R & ~31) + perm32(R & 31)) : R;
        voffA[i] = (unsigned)(R * K + C) * 2u; voffB[i] = (unsigned)(Rb * K + C) * 2u; }
    constexpr size_t kstep = (size_t)(BK * 2);
    constexpr size_t hstep = (size_t)HALF * K * 2;
    const unsigned ldsw = (unsigned)wid * 1024u;
    const int aoff = lds_byte(wr * 64 + fr, fq * 8), boff = lds_byte(wc * 32 + fr, fq * 8);
#define PG8_SA(b, h) (((b) * 2 + (h)) * HTB)
#define PG8_SB(b, h) ((4 + (b) * 2 + (h)) * HTB)
#define PG8_STAGE(bufoff, gbase, voff) do { _Pragma("unroll") for (int _i = 0; _i < 2; ++_i) \
        __builtin_amdgcn_global_load_lds((const unsigned*)((const char*)(gbase) + (voff)[_i]), (PG8_LAS unsigned*)(lds + (bufoff) + ldsw + _i * 8192), 16, 0, 0); } while (0)
#define PG8_LDA(dst, b, h) do { _Pragma("unroll") for (int m = 0; m < 4; ++m) _Pragma("unroll") for (int k = 0; k < 2; ++k) dst[m][k] = *(const PG8_LAS bf16x8*)(lds + PG8_SA(b, h) + aoff + m * 2048 + k * 1024); } while (0)
#define PG8_LDB(dst, b, h) do { _Pragma("unroll") for (int n = 0; n < 2; ++n) _Pragma("unroll") for (int k = 0; k < 2; ++k) dst[n][k] = *(const PG8_LAS bf16x8*)(lds + PG8_SB(b, h) + boff + n * 2048 + k * 1024); } while (0)
#define PG8_MMA(ai, bj, At, Bt) do { __builtin_amdgcn_s_setprio(1); _Pragma("unroll") for (int m = 0; m < 4; ++m) _Pragma("unroll") for (int n = 0; n < 2; ++n) _Pragma("unroll") for (int k = 0; k < 2; ++k) \
        acc[ai][bj][m][n] = __builtin_amdgcn_mfma_f32_16x16x32_bf16(Bt[n][k], At[m][k], acc[ai][bj][m][n], 0, 0, 0); __builtin_amdgcn_s_setprio(0); } while (0)
#define PG8_WAIT_V(n) asm volatile("s_waitcnt vmcnt(" #n ")" ::: "memory")
#define PG8_WAIT_L(n) asm volatile("s_waitcnt lgkmcnt(" #n ")" ::: "memory")
#define PG8_BAR __builtin_amdgcn_s_barrier()
#define PG8_SCHED __builtin_amdgcn_sched_barrier(0)
    Unit cur, nxt; int ui = 0;
    if (!S.next(0, cur)) return;
    f32x4 acc[2][2][4][2];
#pragma unroll
    for (int a = 0; a < 2; ++a)
#pragma unroll
        for (int b = 0; b < 2; ++b)
#pragma unroll
            for (int m = 0; m < 4; ++m)
#pragma unroll
                for (int n = 0; n < 2; ++n) acc[a][b][m][n] = (f32x4){0.f, 0.f, 0.f, 0.f};
    bf16x8 At[4][2], B0[2][2], B1[2][2];
    unsigned vc[2][2];
#define PG8_GOFF(u) do { _Pragma("unroll") for (int _h = 0; _h < 2; ++_h) _Pragma("unroll") for (int _i = 0; _i < 2; ++_i) { int _R, _C; stage_rc(tid * 16 + _i * 8192, _R, _C); \
        vc[_h][_i] = S.a_row_off(u, _h * HALF + _R) + (unsigned)_C * 2u; } } while (0)
#define PG8_STAGE_A(bufoff, gbase, h) do { if constexpr (GATHER) { PG8_STAGE(bufoff, gbase, vc[h]); } else { PG8_STAGE(bufoff, (gbase) + (h) * hstep, voffA); } } while (0)
    if constexpr (GATHER) PG8_GOFF(cur);
    const char* cA = S.a_base(cur); const char* cB = S.b_base(cur);
    PG8_STAGE(PG8_SB(0, 0), cB, voffB); PG8_STAGE(PG8_SB(0, 1), cB + hstep, voffB); PG8_STAGE_A(PG8_SA(0, 0), cA, 0); PG8_STAGE_A(PG8_SA(0, 1), cA, 1);
    if (wr == 1) PG8_BAR;
    PG8_WAIT_V(2); PG8_BAR;
    PG8_STAGE(PG8_SB(1, 0), cB + kstep, voffB); PG8_STAGE_A(PG8_SA(1, 0), cA + kstep, 0); PG8_STAGE(PG8_SB(1, 1), cB + hstep + kstep, voffB);
    PG8_WAIT_V(6); PG8_BAR;
    for (;;) {
        const bool has_next = S.next(ui + 1, nxt);
        const char* nA = has_next ? S.a_base(nxt) : cA; const char* nB = has_next ? S.b_base(nxt) : cB;
        for (int t = 0; t < nt; t += 2) {
            const bool last = (t == nt - 2);
            const char* a1 = cA + (size_t)(t + 1) * kstep;
            const char* a2 = last ? nA : cA + (size_t)(t + 2) * kstep; const char* b2 = last ? nB : cB + (size_t)(t + 2) * kstep;
            const char* a3 = a2 + kstep; const char* b3 = b2 + kstep;
            PG8_LDB(B0, 0, 0); PG8_LDB(B1, 0, 1); PG8_SCHED; PG8_LDA(At, 0, 0); PG8_STAGE_A(PG8_SA(1, 1), a1, 1);
            if constexpr (GATHER) { if (last && has_next) PG8_GOFF(nxt); }
            PG8_WAIT_V(8); PG8_WAIT_L(0); PG8_BAR; PG8_MMA(0, 0, At, B0); PG8_MMA(0, 1, At, B1); PG8_BAR; PG8_SCHED;
            PG8_LDA(At, 0, 1); PG8_STAGE(PG8_SB(0, 0), b2, voffB); PG8_STAGE(PG8_SB(0, 1), b2 + hstep, voffB); PG8_STAGE_A(PG8_SA(0, 0), a2, 0);
            PG8_WAIT_V(8); PG8_WAIT_L(0); PG8_BAR; PG8_MMA(1, 0, At, B0); PG8_MMA(1, 1, At, B1); PG8_BAR; PG8_SCHED;
            PG8_LDB(B0, 1, 0); PG8_LDB(B1, 1, 1); PG8_SCHED; PG8_LDA(At, 1, 0); PG8_STAGE_A(PG8_SA(0, 1), a2, 1);
            PG8_WAIT_V(8); PG8_WAIT_L(0); PG8_BAR; PG8_MMA(0, 0, At, B0); PG8_MMA(0, 1, At, B1); PG8_BAR; PG8_SCHED;
            PG8_LDA(At, 1, 1); PG8_STAGE(PG8_SB(1, 0), b3, voffB); PG8_STAGE(PG8_SB(1, 1), b3 + hstep, voffB); PG8_STAGE_A(PG8_SA(1, 0), a3, 0);
            PG8_WAIT_V(8); PG8_WAIT_L(0); PG8_BAR; PG8_MMA(1, 0, At, B0); PG8_MMA(1, 1, At, B1); PG8_BAR; PG8_SCHED;
        }
        if constexpr (ALIGN_EPI) { if (wr == 0) PG8_BAR; }
        E(acc, cur, wr, wc, fr, fq);
        if (!has_next) break;
#pragma unroll
        for (int a = 0; a < 2; ++a)
#pragma unroll
            for (int b = 0; b < 2; ++b)
#pragma unroll
                for (int m = 0; m < 4; ++m)
#pragma unroll
                    for (int n = 0; n < 2; ++n) acc[a][b][m][n] = (f32x4){0.f, 0.f, 0.f, 0.f};
        cur = nxt; cA = nA; cB = nB; ++ui;
        if constexpr (ALIGN_EPI) { if (wr == 1) PG8_BAR; }
    }
    PG8_WAIT_V(0);
    if constexpr (!ALIGN_EPI) { if (wr == 0) PG8_BAR; }
    PG8_BAR;
#undef PG8_SA
#undef PG8_SB
#undef PG8_STAGE
#undef PG8_STAGE_A
#undef PG8_GOFF
#undef PG8_LDA
#undef PG8_LDB
#undef PG8_MMA
#undef PG8_WAIT_V
#undef PG8_WAIT_L
#undef PG8_BAR
#undef PG8_SCHED
}
}

constexpr int NWAVES = 8;
#ifndef MK_DEBUG
#define MK_DEBUG 0
#endif
#ifndef DBG_USE_NAIVE
#define DBG_USE_NAIVE 0
#endif
constexpr int DBGP = MK_DEBUG ? 3 : 0;
enum Phase { PH_P0 = 0, PH_LORA, PH_RKV, PH_S1, PH_S2, PH_S3, PH_DBG0, PH_WOUT = PH_DBG0 + DBGP, PH_ROUT0, PH_GU0, PH_DN0, PH_COMB, PH_KVQ, PH_ATTN, PH_SBO, PH_ROUT1, PH_GU1, PH_DN1, PH_FINAL, NPHASE };
constexpr int N_LAUNCHES = MK_N_LAUNCHES;


constexpr int BATCH = 2, SEQ = 8192, C = 1024, NH = 16, HD = 64, M = BATCH * SEQ;
constexpr int NE = 16, FE = 256, DW = 64, DA = 64, DG = 160;
constexpr float RMS_EPS = 1e-6f, GN_EPS = 64e-5f;
constexpr float SB_EXIT = 104.0f;

constexpr size_t MiB = 1u << 20;
constexpr size_t WS_CTL = 0, CTL_ZERO_BYTES = 64 * 1024;
constexpr size_t WS_WT_W2 = 128 * 1024, WS_WT_A2 = 256 * 1024, WS_WT_G2 = 384 * 1024;
constexpr size_t WS_WT_RKV = 1 * MiB;
constexpr size_t WS_WT_LORA = 7 * MiB;
constexpr size_t WS_WT_OUT = 9 * MiB;
constexpr size_t WS_WT_KVQ = 11 * MiB;
constexpr size_t WS_WT_SBO = 17 * MiB;
constexpr size_t WS_WT_GU = 19 * MiB;
constexpr size_t WS_WT_DN = 51 * MiB;
constexpr size_t WS_LW = 67 * MiB;
constexpr size_t WS_LA = 69 * MiB;
constexpr size_t WS_LG = 71 * MiB;
static_assert(WS_LA == WS_LW + 2 * MiB && WS_LG == WS_LW + 4 * MiB, "EpiLora's pointer arithmetic");
constexpr size_t WS_LIST = 76 * MiB;
constexpr size_t WS_WL = 77 * MiB;
constexpr size_t WS_HID = 78 * MiB;
constexpr size_t WS_B0 = 96 * MiB, WS_B1 = 128 * MiB, WS_B2 = 160 * MiB, WS_B3 = 192 * MiB, WS_B4 = 224 * MiB, WS_END = 256 * MiB;
static_assert(WS_HID + (size_t)144 * 256 * 256 * 2 <= WS_B0, "HID vs B0");
constexpr int CW_TMO = 0;
constexpr int CW_CNT = 1024;
constexpr int CW_BAR = 4096;

constexpr int RING_BYTES = 131072;
constexpr int LDSCTL_OFF = 146688, MISC_OFF = LDSCTL_OFF + 320, MOE_TAB_OFF = MISC_OFF + 128;
constexpr int LDS_BYTES = 147456;
static_assert(MOE_TAB_OFF + 256 <= LDS_BYTES, "LDS map");
static_assert(BATCH * NH * (SEQ / 64) % 16 == 0, "scan units");

#define GAS __attribute__((address_space(1)))
#define LAS __attribute__((address_space(3)))
typedef unsigned short bf16;
typedef unsigned v4u __attribute__((ext_vector_type(4)));
typedef unsigned v2u __attribute__((ext_vector_type(2)));
typedef float f32x4 __attribute__((ext_vector_type(4)));
typedef GAS unsigned gu32;
#define RLX_AGENT __ATOMIC_RELAXED, __HIP_MEMORY_SCOPE_AGENT
#define LDS_WAIT() asm volatile("s_waitcnt lgkmcnt(0)" ::: "memory")
#define VM_WAIT() asm volatile("s_waitcnt vmcnt(0)" ::: "memory")
__device__ __forceinline__ unsigned f2bf(float f) { unsigned u = __builtin_bit_cast(unsigned, f); return (u + 0x7fffu + ((u >> 16) & 1u)) >> 16; }
__device__ __forceinline__ unsigned pk2(float lo, float hi) { return f2bf(lo) | (f2bf(hi) << 16); }
__device__ __forceinline__ float bflo(unsigned u) { return __uint_as_float(u << 16); }
__device__ __forceinline__ float bfhi(unsigned u) { return __uint_as_float(u & 0xffff0000u); }
__device__ __forceinline__ float bf2f(bf16 b) { return __uint_as_float((unsigned)b << 16); }
__device__ __forceinline__ float sigmoidf_(float x) { return 1.0f / (1.0f + __expf(-x)); }

#define XB_TMO      128
#define XB_XCNT(j)  (256  + 64 * (j))
#define XB_XSUB(j)  (1280 + 64 * (j))
#define XB_XGEN(j)  (2304 + 64 * (j))
#define XB_TOP      3328
#define XB_TOPGEN   3392
#define XCD_BAR_WORDS 3456
#define XB_SPIN_CAP (1u << 18)
__device__ __forceinline__ unsigned xb_ld(unsigned* p)              { return __hip_atomic_load(p, __ATOMIC_RELAXED, __HIP_MEMORY_SCOPE_AGENT); }
__device__ __forceinline__ unsigned xb_add(unsigned* p, unsigned v) { return __hip_atomic_fetch_add(p, v, __ATOMIC_RELAXED, __HIP_MEMORY_SCOPE_AGENT); }
__device__ __forceinline__ unsigned xb_xcc_id() { return (unsigned)__builtin_amdgcn_s_getreg((3 << 11) | 20) & 0xFu; }
#define XB_SPIN(cond, bar) do { unsigned _sp = 0; while (cond) { __builtin_amdgcn_s_sleep(1); \
    if ((++_sp & 255u) == 0u) { if (xb_ld(&(bar)[XB_TMO])) break; if (_sp > XB_SPIN_CAP) { atomicAdd(&(bar)[XB_TMO], 1u); break; } } } } while (0)
struct XcdBarrier { unsigned* bar; unsigned x; volatile LAS unsigned* st; };
__device__ __forceinline__ XcdBarrier xcd_barrier_post(unsigned* bar, volatile LAS unsigned* st) {
    XcdBarrier b; b.bar = bar; b.x = xb_xcc_id(); b.st = st;
    if (threadIdx.x == 0) (void)xb_add(&bar[XB_XCNT(b.x)], 1u);
    return b;
}
__device__ __forceinline__ void xcd_barrier_complete(unsigned* bar, unsigned x, unsigned& nloc, unsigned& nx) {
    const unsigned G = gridDim.x * gridDim.y * gridDim.z;
    unsigned sum, cnt, mine, sp = 0u;
    for (;;) {
        sum = 0u; cnt = 0u; mine = 0u;
#pragma unroll
        for (unsigned j = 0; j < 16; ++j) { const unsigned c = xb_ld(&bar[XB_XCNT(j)]); sum += c; cnt += (c > 0u) ? 1u : 0u; mine = (j == x) ? c : mine; }
        if (sum == G) break;
        __builtin_amdgcn_s_sleep(1);
        if ((++sp & 255u) == 0u) { if (xb_ld(&bar[XB_TMO])) break; if (sp > XB_SPIN_CAP) { atomicAdd(&bar[XB_TMO], 1u); break; } }
    }
    nloc = mine > 0u ? mine : 1u; nx = cnt > 0u ? cnt : 1u;
}
__device__ __forceinline__ void xcd_barrier(const XcdBarrier& b) {
    asm volatile("s_waitcnt vmcnt(0)" ::: "memory");
    __syncthreads();
    if (threadIdx.x == 0) {
        unsigned* bar = b.bar;
        __builtin_amdgcn_s_waitcnt(0);
        unsigned nloc = b.st[0], nx = b.st[1];
        if (nloc == 0u) { xcd_barrier_complete(bar, b.x, nloc, nx); b.st[0] = nloc; b.st[1] = nx; }
        const unsigned old = xb_add(&bar[XB_XSUB(b.x)], 1u);
        const unsigned gen = old / nloc;
        if (old + 1u == (gen + 1u) * nloc) {
            __builtin_amdgcn_fence(__ATOMIC_RELEASE, "agent");
            asm volatile("s_waitcnt vmcnt(0)" ::: "memory");
            const unsigned og = xb_add(&bar[XB_TOP], 1u);
            const unsigned tg = og / nx;
            if (og + 1u == (tg + 1u) * nx) xb_add(&bar[XB_TOPGEN], 1u);
            else XB_SPIN(xb_ld(&bar[XB_TOPGEN]) == tg, bar);
            __builtin_amdgcn_fence(__ATOMIC_ACQUIRE, "agent");
            xb_add(&bar[XB_XGEN(b.x)], 1u);
            asm volatile("s_waitcnt vmcnt(0)" ::: "memory");
        } else {
            XB_SPIN(xb_ld(&bar[XB_XGEN(b.x)]) == gen, bar);
            __builtin_amdgcn_fence(__ATOMIC_ACQUIRE, "agent");
            asm volatile("s_waitcnt vmcnt(0)" ::: "memory");
        }
    }
    __syncthreads();
}

__device__ __forceinline__ float shx(float v, int o, int lane) { return __int_as_float(__builtin_amdgcn_ds_bpermute((lane ^ o) << 2, __float_as_int(v))); }
#define DPP_ADD(v, ctrl) ((v) + __int_as_float(__builtin_amdgcn_update_dpp(0, __float_as_int(v), (ctrl), 0xf, 0xf, true)))
__device__ __forceinline__ float wave_sum(float v, int lane) {
    (void)lane;
    v = DPP_ADD(v, 0x128); v = DPP_ADD(v, 0x124); v = DPP_ADD(v, 0x122); v = DPP_ADD(v, 0x121);
    const int iv = __float_as_int(v);
    return (__int_as_float(__builtin_amdgcn_readlane(iv, 0)) + __int_as_float(__builtin_amdgcn_readlane(iv, 16))) + (__int_as_float(__builtin_amdgcn_readlane(iv, 32)) + __int_as_float(__builtin_amdgcn_readlane(iv, 48)));
}
__device__ __forceinline__ float sum8(float v) { v = DPP_ADD(v, 0xB1); v = DPP_ADD(v, 0x4E); v = DPP_ADD(v, 0x141); return v; }
__device__ __forceinline__ void transpose_item(const float* W, int ldw, int k0, int n0, bf16* WT, int ldk, int dst_row0, const float* kscale, LAS float* scr, int lane, int kmax = 1 << 30) {
    const int r8 = lane >> 3, quad = lane & 7;
    f32x4 v[8];
#pragma unroll
    for (int i = 0; i < 8; ++i) { const int kk = r8 + 8 * i; v[i] = (k0 + kk < kmax) ? *(const GAS f32x4*)(W + (size_t)(k0 + kk) * ldw + n0 + quad * 4) : (f32x4){0.f, 0.f, 0.f, 0.f}; }
#pragma unroll
    for (int i = 0; i < 8; ++i) { const int kk = r8 + 8 * i; if (kscale) v[i] = v[i] * kscale[(k0 + kk < kmax) ? k0 + kk : 0]; *(LAS f32x4*)(scr + kk * 36 + ((quad ^ i) << 2)) = v[i]; }
    LDS_WAIT(); asm volatile("" ::: "memory");
    const int c = lane & 7;
#pragma unroll
    for (int j = 0; j < 4; ++j) { const int n = (lane >> 3) + 8 * j; const LAS float* sp = scr + (8 * c) * 36 + ((((n >> 2) ^ c) << 2) | (n & 3));
        v4u o; o.x = pk2(sp[0 * 36], sp[1 * 36]); o.y = pk2(sp[2 * 36], sp[3 * 36]); o.z = pk2(sp[4 * 36], sp[5 * 36]); o.w = pk2(sp[6 * 36], sp[7 * 36]);
        if (k0 + 8 * c < kmax) *(GAS v4u*)(WT + (size_t)(dst_row0 + n) * ldk + k0 + 8 * c) = o; }
    LDS_WAIT(); asm volatile("" ::: "memory");
}

struct Args { const float* in[31]; float* out; unsigned char* ws; int ph_lo, ph_hi, li, pad; };
typedef const __attribute__((address_space(4))) unsigned char* kaptr_t;
__device__ __forceinline__ kaptr_t ka_base() { kaptr_t p = (kaptr_t)__builtin_amdgcn_kernarg_segment_ptr(); asm volatile("" : "+s"(p)); return p; }
#define INP(k) (*(const float* const __attribute__((address_space(4)))*)(ka_base() + 8 * (k)))
#define OUTP() (*(float* const __attribute__((address_space(4)))*)(ka_base() + 8 * 31))
#define WSP() (*(unsigned char* const __attribute__((address_space(4)))*)(ka_base() + 8 * 32))
#define KA_INT(i) (*(const int __attribute__((address_space(4)))*)(ka_base() + 8 * 33 + 4 * (i)))

template <int PART> __device__ __forceinline__ void p0_weights(unsigned char* ws, LAS unsigned char* lds, int gw, int NGW, int wave, int lane) {
    LAS float* scr = (LAS float*)(lds + wave * 16384);
    bf16* WT_RKV = (bf16*)(ws + WS_WT_RKV); bf16* WT_LORA = (bf16*)(ws + WS_WT_LORA); bf16* WT_OUT = (bf16*)(ws + WS_WT_OUT); bf16* WT_KVQ = (bf16*)(ws + WS_WT_KVQ);
    bf16* WT_SBO = (bf16*)(ws + WS_WT_SBO); bf16* WT_GU = (bf16*)(ws + WS_WT_GU); bf16* WT_DN = (bf16*)(ws + WS_WT_DN);
    constexpr int I_UP = 32 + 32 + 96, I_RKV = 3 * 512, I_LORA = 32 + 32 + 80, I_OUT = 512, I_KV = 1024, I_Q = 512, I_SBO = 512, I_G = 32 * 128, I_U = 32 * 128, I_D = 32 * 128;
    constexpr int NDENSE = I_UP + I_RKV + I_LORA + I_OUT + I_KV + I_Q + I_SBO, NITEMS = NDENSE + I_G + I_U + I_D;
    constexpr int NLOOP = PART == 0 ? NDENSE : 3 * 2048; (void)NITEMS;
    for (int q_ = gw; q_ < NLOOP; q_ += NGW) {
        const int it = PART == 0 ? q_ : NDENSE + (q_ / 2048) * 4096 + 2048 * (PART - 1) + (q_ % 2048);
        int r = it;
        if (r < I_UP) {
            if (r < 32) transpose_item(INP(9), C, 0, 32 * r, (bf16*)(ws + WS_WT_W2), 64, 32 * r, nullptr, scr, lane);
            else if (r < 64) transpose_item(INP(12), C, 0, 32 * (r - 32), (bf16*)(ws + WS_WT_A2), 64, 32 * (r - 32), nullptr, scr, lane);
            else { const int q = r - 64, kb = q / 32, nb = q % 32; transpose_item(INP(14), C, 64 * kb, 32 * nb, (bf16*)(ws + WS_WT_G2), DG, 32 * nb, nullptr, scr, lane, DG); }
            continue; } r -= I_UP;
        if (r < I_RKV) { const int m = r / 512, q = r % 512, kb = q / 32, nb = q % 32; transpose_item(INP(6) + (size_t)m * C * C, C, 64 * kb, 32 * nb, WT_RKV, C, m * C + 32 * nb, nullptr, scr, lane); continue; } r -= I_RKV;
        if (r < I_LORA) {
            if (r < 32) { const int kb = r / 2, nb = r % 2; transpose_item(INP(8), DW, 64 * kb, 32 * nb, WT_LORA, C, 32 * nb, nullptr, scr, lane); }
            else if (r < 64) { const int q = r - 32, kb = q / 2, nb = q % 2; transpose_item(INP(11), DA, 64 * kb, 32 * nb, WT_LORA, C, 256 + 32 * nb, nullptr, scr, lane); }
            else { const int q = r - 64, kb = q / 5, nb = q % 5; transpose_item(INP(13), DG, 64 * kb, 32 * nb, WT_LORA, C, 512 + 32 * nb, nullptr, scr, lane); }
            continue; } r -= I_LORA;
        if (r < I_OUT) { const int kb = r / 32, nb = r % 32; transpose_item(INP(20), C, 64 * kb, 32 * nb, WT_OUT, C, 32 * nb, nullptr, scr, lane); continue; } r -= I_OUT;
        if (r < I_KV) { const int kb = r / 64, nb = r % 64; transpose_item(INP(21), 2 * C, 64 * kb, 32 * nb, WT_KVQ, C, 32 * nb, INP(3), scr, lane); continue; } r -= I_KV;
        if (r < I_Q) { const int kb = r / 32, nb = r % 32; transpose_item(INP(22), C, 64 * kb, 32 * nb, WT_KVQ, C, 2 * C + 32 * nb, INP(1) + C, scr, lane); continue; } r -= I_Q;
        if (r < I_SBO) { const int kb = r / 32, nb = r % 32; transpose_item(INP(23), C, 64 * kb, 32 * nb, WT_SBO, C, 32 * nb, nullptr, scr, lane); continue; } r -= I_SBO;
        if (r < I_G) { const int le = r / 128, q = r % 128, kb = q / 8, nb = q % 8, f0 = 32 * nb; transpose_item(INP(28) + (size_t)le * C * FE, FE, 64 * kb, f0, WT_GU + (size_t)le * 512 * C, C, 256 * (f0 / 128) + (f0 % 128), INP(2) + (le >> 4) * C, scr, lane); continue; } r -= I_G;
        if (r < I_U) { const int le = r / 128, q = r % 128, kb = q / 8, nb = q % 8, f0 = 32 * nb; transpose_item(INP(29) + (size_t)le * C * FE, FE, 64 * kb, f0, WT_GU + (size_t)le * 512 * C, C, 256 * (f0 / 128) + 128 + (f0 % 128), INP(2) + (le >> 4) * C, scr, lane); continue; } r -= I_U;
        { const int le = r / 128, q = r % 128, kb = q / 32, nb = q % 32; transpose_item(INP(30) + (size_t)le * FE * C, C, 64 * kb, 32 * nb, WT_DN + (size_t)le * C * FE, FE, 32 * nb, nullptr, scr, lane); }
    }
    if (PART == 0) for (int it = gw * 64 + lane; it < 768 * 128; it += NGW * 64) { const int row = it >> 7, ch = it & 127;
        const bool valid = (row < 64) || (row >= 256 && row < 320) || (row >= 512 && row < 672);
        if (!valid) *(GAS v4u*)(WT_LORA + (size_t)row * C + ch * 8) = (v4u){0u, 0u, 0u, 0u}; }
}
__device__ __forceinline__ void load_row(const float* p, int lane, f32x4 (&v)[4]) {
#pragma unroll
    for (int j = 0; j < 4; ++j) v[j] = ((const GAS f32x4*)p)[64 * j + lane];
}
__device__ __forceinline__ void load_row_bf(const bf16* p, int lane, f32x4 (&v)[4]) {
#pragma unroll
    for (int j = 0; j < 4; ++j) { const v2u w = ((const GAS v2u*)p)[64 * j + lane]; v[j] = (f32x4){bflo(w.x), bfhi(w.x), bflo(w.y), bfhi(w.y)}; }
}
__device__ __forceinline__ float row_rs(const f32x4 (&v)[4], int lane) {
    float s = 0.f;
#pragma unroll
    for (int j = 0; j < 4; ++j) s += (v[j].x * v[j].x + v[j].y * v[j].y) + (v[j].z * v[j].z + v[j].w * v[j].w);
    return 1.0f / sqrtf(wave_sum(s, lane) * (1.0f / C) + RMS_EPS);
}
__device__ __forceinline__ void store_row_bf16(bf16* p, int lane, const f32x4 (&v)[4]) {
#pragma unroll
    for (int j = 0; j < 4; ++j) { v2u o; o.x = pk2(v[j].x, v[j].y); o.y = pk2(v[j].z, v[j].w); ((GAS v2u*)p)[64 * j + lane] = o; }
}
__device__ __forceinline__ void p0_rows(unsigned char* ws, int gw, int NGW, int lane) {
    const float* x = INP(0); const float* gain = INP(1); const float* mix = INP(5);
    f32x4 g[4]; load_row(gain, lane, g);
    for (int run = gw; run < M / 8; run += NGW) {
        const int r0 = run * 8;
        f32x4 prev[4];
        if ((r0 % SEQ) == 0) {
#pragma unroll
            for (int j = 0; j < 4; ++j) prev[j] = (f32x4){0.f, 0.f, 0.f, 0.f};
        } else { load_row(x + (size_t)(r0 - 1) * C, lane, prev); const float rs = row_rs(prev, lane);
#pragma unroll
            for (int j = 0; j < 4; ++j) prev[j] = prev[j] * rs * g[j]; }
        for (int rr = 0; rr < 8; ++rr) {
            const int row = r0 + rr;
            f32x4 hn[4]; load_row(x + (size_t)row * C, lane, hn); const float rs = row_rs(hn, lane);
#pragma unroll
            for (int j = 0; j < 4; ++j) hn[j] = hn[j] * rs * g[j];
#pragma unroll
            for (int i = 0; i < 6; ++i) { f32x4 o[4];
#pragma unroll
                for (int j = 0; j < 4; ++j) { const f32x4 mx = ((const GAS f32x4*)(mix + i * C))[64 * j + lane]; o[j] = hn[j] + (prev[j] - hn[j]) * mx; }
                bf16* dst = i < 2 ? (bf16*)OUTP() + (size_t)i * M * C : (i == 2 ? (bf16*)(ws + WS_B4) : (bf16*)(ws + WS_B1) + (size_t)(i - 3) * M * C);
                store_row_bf16(dst + (size_t)row * C, lane, o); }
#pragma unroll
            for (int j = 0; j < 4; ++j) prev[j] = hn[j];
        }
    }
}

template <int NN, int NGROUPS> struct SchedGrouped {
    static constexpr int K = C;
    const char* A0; size_t astride; const char* A2; const char* B; size_t bgroup;
    int G, c;
    __device__ __forceinline__ bool next(int i, pg8::Unit& u) const {
        const int L = i * G + c; constexpr int per = 64 * NN; if (L >= per * NGROUPS) return false;
        const int g = L / per, w = L % per; pg8::tile_map(w, 64, NN, u.pm, u.pn); u.aux = g; u.r0 = 0; u.cnt = 0; return true; }
    __device__ __forceinline__ const char* a_base(const pg8::Unit& u) const { const char* A = (A2 != nullptr && u.aux == 2) ? A2 : A0 + (size_t)u.aux * astride; return A + (size_t)u.pm * 256 * K * 2; }
    __device__ __forceinline__ const char* b_base(const pg8::Unit& u) const { return B + (size_t)u.aux * bgroup + (size_t)u.pn * 256 * K * 2; }
    __device__ __forceinline__ unsigned a_row_off(const pg8::Unit&, int) const { return 0u; }
};
template <int NN, int K, bool GATHER> struct SchedMoe {
    const char* A; const char* B; size_t bexp; const unsigned* list; volatile LAS int* tab; int G, c;
    __device__ __forceinline__ bool next(int i, pg8::Unit& u) const {
        const int L = i * G + c; const int tot = __builtin_amdgcn_readfirstlane(tab[48]) * NN; if (L >= tot) return false;
        u.pm = L / NN; u.pn = L % NN; int e = 0;
#pragma unroll
        for (int j = 0; j < 16; ++j) e += (u.pm >= tab[32 + j]) ? 1 : 0;
        e = __builtin_amdgcn_readfirstlane(e);
        u.aux = e; u.r0 = (u.pm - __builtin_amdgcn_readfirstlane(tab[16 + e])) * 256; u.cnt = __builtin_amdgcn_readfirstlane(tab[e]); return true; }
    __device__ __forceinline__ const char* a_base(const pg8::Unit& u) const { return GATHER ? A : A + (size_t)u.pm * 256 * K * 2; }
    __device__ __forceinline__ const char* b_base(const pg8::Unit& u) const { return B + (size_t)u.aux * bexp + (size_t)u.pn * 256 * K * 2; }
    __device__ __forceinline__ unsigned a_row_off(const pg8::Unit& u, int r) const {
        const int idx = u.r0 + r; unsigned tok = 0u;
        if (idx < u.cnt) tok = list[(size_t)u.aux * M + idx] >> 1;
        return tok * (unsigned)(K * 2); }
};

using pg8::f32x4;
using pg8::Unit;
__device__ __forceinline__ v4u pack8(f32x4 v0, f32x4 v1) { v4u w; w.x = pg8::cvt_pk_bf16(v0[0], v0[1]); w.y = pg8::cvt_pk_bf16(v0[2], v0[3]); w.z = pg8::cvt_pk_bf16(v1[0], v1[1]); w.w = pg8::cvt_pk_bf16(v1[2], v1[3]); return w; }

struct EpiLora {
    static constexpr bool PERM = true;
    bf16* LW;
    __device__ __forceinline__ void operator()(const f32x4 (&acc)[2][2][4][2], const Unit& u, int wr, int wc, int fr, int fq) const {
        { int l_; asm volatile("v_mbcnt_lo_u32_b32 %0, -1, 0\n\tv_mbcnt_hi_u32_b32 %0, -1, %0" : "=v"(l_)); fr = l_ & 15; fq = l_ >> 4; }
        const int g = u.aux, width = g == 2 ? DG : DW; bf16* out = LW + (size_t)g * (1u << 20);
        const int row0 = u.pm * 256 + wr * 64 + fr;
#pragma unroll
        for (int bj = 0; bj < 2; ++bj) { const int col0 = bj * 128 + wc * 32 + 8 * fq; if (col0 < width) {
#pragma unroll
            for (int ai = 0; ai < 2; ++ai)
#pragma unroll
                for (int m = 0; m < 4; ++m) { f32x4 v0 = acc[ai][bj][m][0], v1 = acc[ai][bj][m][1];
                    if (g == 0) {
#pragma unroll
                        for (int q = 0; q < 4; ++q) { v0[q] = tanhf(v0[q]); v1[q] = tanhf(v1[q]); } }
                    else if (g == 2) {
#pragma unroll
                        for (int q = 0; q < 4; ++q) { v0[q] = sigmoidf_(v0[q]); v1[q] = sigmoidf_(v1[q]); } }
                    *(GAS v4u*)(out + (size_t)(row0 + ai * 128 + m * 16) * width + col0) = pack8(v0, v1); } } }
    }
};
struct EpiSplit3 {
    static constexpr bool PERM = true;
    bf16* O0; bool bycol; const float* rowscale;
    __device__ __forceinline__ void operator()(const f32x4 (&acc)[2][2][4][2], const Unit& u, int wr, int wc, int fr, int fq) const {
        { int l_; asm volatile("v_mbcnt_lo_u32_b32 %0, -1, 0\n\tv_mbcnt_hi_u32_b32 %0, -1, %0" : "=v"(l_)); fr = l_ & 15; fq = l_ >> 4; }
        const int g = bycol ? (u.pn >> 2) : u.aux, pn = bycol ? (u.pn & 3) : u.pn; bf16* out = O0 + (size_t)g * ((size_t)M * C);
        const int row0 = u.pm * 256 + wr * 64 + fr, col0 = pn * 256 + wc * 32 + 8 * fq;
#pragma unroll
        for (int ai = 0; ai < 2; ++ai)
#pragma unroll
            for (int m = 0; m < 4; ++m)
                { const float sc = rowscale ? rowscale[row0 + ai * 128 + m * 16] : 1.0f;
#pragma unroll
                for (int bj = 0; bj < 2; ++bj) *(GAS v4u*)(out + (size_t)(row0 + ai * 128 + m * 16) * C + col0 + bj * 128) = pack8(acc[ai][bj][m][0] * sc, acc[ai][bj][m][1] * sc); }
    }
};
template <bool BASE_F32> struct EpiResidBf {
    static constexpr bool PERM = true;
    const void* base; bf16* out;
    __device__ __forceinline__ void operator()(const f32x4 (&acc)[2][2][4][2], const Unit& u, int wr, int wc, int fr, int fq) const {
        { int l_; asm volatile("v_mbcnt_lo_u32_b32 %0, -1, 0\n\tv_mbcnt_hi_u32_b32 %0, -1, %0" : "=v"(l_)); fr = l_ & 15; fq = l_ >> 4; }
        const int row0 = u.pm * 256 + wr * 64 + fr, col0 = u.pn * 256 + wc * 32 + 8 * fq;
#pragma unroll
        for (int ai = 0; ai < 2; ++ai)
#pragma unroll
            for (int m = 0; m < 4; ++m) { const size_t off = (size_t)(row0 + ai * 128 + m * 16) * C + col0;
#pragma unroll
                for (int bj = 0; bj < 2; ++bj) { f32x4 b0, b1;
                    if (BASE_F32) { b0 = *(const GAS f32x4*)((const float*)base + off + bj * 128); b1 = *(const GAS f32x4*)((const float*)base + off + bj * 128 + 4); }
                    else { const v4u w = *(const GAS v4u*)((const bf16*)base + off + bj * 128); b0 = (f32x4){bflo(w.x), bfhi(w.x), bflo(w.y), bfhi(w.y)}; b1 = (f32x4){bflo(w.z), bfhi(w.z), bflo(w.w), bfhi(w.w)}; }
                    *(GAS v4u*)(out + off + bj * 128) = pack8(b0 + acc[ai][bj][m][0], b1 + acc[ai][bj][m][1]); }
                asm volatile("" ::: "memory"); }
    }
};
struct EpiGU {
    static constexpr bool PERM = true;
    bf16* HID; const float* wl; const float* rsl;
    __device__ __forceinline__ void operator()(const f32x4 (&acc)[2][2][4][2], const Unit& u, int wr, int wc, int fr, int fq) const {
        { int l_; asm volatile("v_mbcnt_lo_u32_b32 %0, -1, 0\n\tv_mbcnt_hi_u32_b32 %0, -1, %0" : "=v"(l_)); fr = l_ & 15; fq = l_ >> 4; }
        const int e = u.aux, cnt = u.cnt, base = u.r0, r0 = wr * 64 + fr, col0 = u.pn * 128 + wc * 32 + 8 * fq;
#pragma unroll
        for (int ai = 0; ai < 2; ++ai)
#pragma unroll
            for (int m = 0; m < 4; ++m) { const int r = r0 + ai * 128 + m * 16, idx = base + r; float w = 0.f, rs = 0.f; if (idx < cnt) { w = wl[(size_t)e * M + idx]; rs = rsl[(size_t)e * M + idx]; }
                f32x4 h0, h1;
#pragma unroll
                for (int q = 0; q < 4; ++q) { const float g0 = acc[ai][0][m][0][q] * rs, g1 = acc[ai][0][m][1][q] * rs;
                    h0[q] = g0 * sigmoidf_(g0) * (acc[ai][1][m][0][q] * rs) * w; h1[q] = g1 * sigmoidf_(g1) * (acc[ai][1][m][1][q] * rs) * w; }
                *(GAS v4u*)(HID + (size_t)(u.pm * 256 + r) * FE + col0) = pack8(h0, h1);
                asm volatile("" ::: "memory"); }
    }
};
struct EpiDown {
    static constexpr bool PERM = true;
    bf16* EO; const unsigned* list;
    __device__ __forceinline__ void operator()(const f32x4 (&acc)[2][2][4][2], const Unit& u, int wr, int wc, int fr, int fq) const {
        { int l_; asm volatile("v_mbcnt_lo_u32_b32 %0, -1, 0\n\tv_mbcnt_hi_u32_b32 %0, -1, %0" : "=v"(l_)); fr = l_ & 15; fq = l_ >> 4; }
        const int e = u.aux, cnt = u.cnt, base = u.r0, r0 = wr * 64 + fr, col0 = u.pn * 256 + wc * 32 + 8 * fq;
#pragma unroll
        for (int ai = 0; ai < 2; ++ai)
#pragma unroll
            for (int m = 0; m < 4; ++m) { const int idx = base + r0 + ai * 128 + m * 16;
                if (idx < cnt) { const unsigned ent = list[(size_t)e * M + idx]; bf16* o = EO + ((size_t)(ent & 1u) * M + (ent >> 1)) * C + col0;
#pragma unroll
                    for (int bj = 0; bj < 2; ++bj) *(GAS v4u*)(o + bj * 128) = pack8(acc[ai][bj][m][0], acc[ai][bj][m][1]); }
                asm volatile("" ::: "memory"); }
    }
};

typedef short bf16x8s __attribute__((ext_vector_type(8)));
typedef short bf16x4s __attribute__((ext_vector_type(4)));
typedef short v4i16_t __attribute__((ext_vector_type(4)));
constexpr int TPB = 144;
constexpr int TILE_B = 64 * TPB;
constexpr int FP = 68;
constexpr int CS_FA = 0, CS_FB = 16384, CS_TILES = 32768, CS_TOT = CS_TILES + 12 * TILE_B, CS_WL = CS_TOT + 2048, CS_PAR = CS_WL + 256;
static_assert(CS_PAR + 768 <= LDSCTL_OFF, "scan LDS map");
#define TILE(n) (lds + CS_TILES + (n) * TILE_B)
#define F4Z (f32x4){0.f, 0.f, 0.f, 0.f}
__device__ __forceinline__ bf16x8s ldfrag(const LAS unsigned char* tile, int row, int kcol) { return *(const LAS bf16x8s*)(tile + row * TPB + kcol * 2); }
__device__ __forceinline__ bf16x8s ldfrag_tr(const LAS unsigned char* tile, int n0, int k0, int lane) {
    const int g = lane >> 4, q = (lane & 15) >> 2, p = lane & 3;
    const LAS unsigned char* a = tile + (k0 + 8 * g + q) * TPB + (n0 + 4 * p) * 2;
    const v4i16_t lo = __builtin_amdgcn_ds_read_tr16_b64_v4i16((LAS v4i16_t*)a), hi = __builtin_amdgcn_ds_read_tr16_b64_v4i16((LAS v4i16_t*)(a + 4 * TPB));
    return (bf16x8s){lo[0], lo[1], lo[2], lo[3], hi[0], hi[1], hi[2], hi[3]};
}
__device__ __forceinline__ bf16x8s ldfrag_perm(const LAS unsigned char* tile, int row, int ks, int g) {
    const bf16x4s lo = *(const LAS bf16x4s*)(tile + row * TPB + (32 * ks + 4 * g) * 2), hi = *(const LAS bf16x4s*)(tile + row * TPB + (32 * ks + 16 + 4 * g) * 2);
    return (bf16x8s){lo[0], lo[1], lo[2], lo[3], hi[0], hi[1], hi[2], hi[3]};
}
__device__ __forceinline__ void lds_barrier() { asm volatile("s_waitcnt lgkmcnt(0)" ::: "memory"); __builtin_amdgcn_s_barrier(); asm volatile("" ::: "memory"); }
#define MFMA16(a, b, c) __builtin_amdgcn_mfma_f32_16x16x32_bf16((a), (b), (c), 0, 0, 0)
__device__ __forceinline__ void mm64(f32x4 (&acc)[2], const LAS unsigned char* At, const LAS unsigned char* Bt, int rt, int ch, int fr, int g) {
#pragma unroll
    for (int ks = 0; ks < 2; ++ks) { const bf16x8s a = ldfrag(At, 16 * rt + fr, 32 * ks + 8 * g);
#pragma unroll
        for (int ct = 0; ct < 2; ++ct) acc[ct] = MFMA16(a, ldfrag(Bt, 32 * ch + 16 * ct + fr, 32 * ks + 8 * g), acc[ct]); }
}
__device__ __forceinline__ void mm64_bt(f32x4 (&acc)[2], const LAS unsigned char* At, const LAS unsigned char* X, int rt, int ch, int fr, int g, int lane) {
#pragma unroll
    for (int ks = 0; ks < 2; ++ks) { const bf16x8s a = ldfrag(At, 16 * rt + fr, 32 * ks + 8 * g);
#pragma unroll
        for (int ct = 0; ct < 2; ++ct) acc[ct] = MFMA16(a, ldfrag_tr(X, 32 * ch + 16 * ct, 32 * ks, lane), acc[ct]); }
}
__device__ __forceinline__ void mm64_at(f32x4 (&acc)[2], const LAS unsigned char* Xa, const LAS unsigned char* Bt, int rt, int ch, int fr, int g, int lane) {
#pragma unroll
    for (int ks = 0; ks < 2; ++ks) { const bf16x8s a = ldfrag_tr(Xa, 16 * rt, 32 * ks, lane);
#pragma unroll
        for (int ct = 0; ct < 2; ++ct) acc[ct] = MFMA16(a, ldfrag(Bt, 32 * ch + 16 * ct + fr, 32 * ks + 8 * g), acc[ct]); }
}
__device__ __forceinline__ void mm64_att(f32x4 (&acc)[2], const LAS unsigned char* Xa, const LAS unsigned char* X, int rt, int ch, int lane) {
#pragma unroll
    for (int ks = 0; ks < 2; ++ks) { const bf16x8s a = ldfrag_tr(Xa, 16 * rt, 32 * ks, lane);
#pragma unroll
        for (int ct = 0; ct < 2; ++ct) acc[ct] = MFMA16(a, ldfrag_tr(X, 32 * ch + 16 * ct, 32 * ks, lane), acc[ct]); }
}
__device__ __forceinline__ bf16x4s pack4(f32x4 v) { v2u w; w.x = pg8::cvt_pk_bf16(v[0], v[1]); w.y = pg8::cvt_pk_bf16(v[2], v[3]); return __builtin_bit_cast(bf16x4s, w); }
__device__ __forceinline__ f32x4 unpack4(bf16x4s s) { const v2u w = __builtin_bit_cast(v2u, s); return (f32x4){bflo(w.x), bfhi(w.x), bflo(w.y), bfhi(w.y)}; }
__device__ __forceinline__ void st_tr(LAS unsigned char* Out, const f32x4 (&acc)[2], int rt, int ch, int fr, int g) {
#pragma unroll
    for (int ct = 0; ct < 2; ++ct) *(LAS bf16x4s*)(Out + (32 * ch + 16 * ct + fr) * TPB + (16 * rt + 4 * g) * 2) = pack4(acc[ct]);
}
__device__ __forceinline__ void ld_tr(f32x4 (&acc)[2], const LAS unsigned char* In, int rt, int ch, int fr, int g) {
#pragma unroll
    for (int ct = 0; ct < 2; ++ct) acc[ct] = unpack4(*(const LAS bf16x4s*)(In + (32 * ch + 16 * ct + fr) * TPB + (16 * rt + 4 * g) * 2));
}
__device__ __forceinline__ void unpack8(v4u w, float (&o)[8]) { o[0] = bflo(w.x); o[1] = bfhi(w.x); o[2] = bflo(w.y); o[3] = bfhi(w.y); o[4] = bflo(w.z); o[5] = bfhi(w.z); o[6] = bflo(w.w); o[7] = bfhi(w.w); }
__device__ __forceinline__ v4u pack8f(const float (&o)[8]) { v4u w; w.x = pg8::cvt_pk_bf16(o[0], o[1]); w.y = pg8::cvt_pk_bf16(o[2], o[3]); w.z = pg8::cvt_pk_bf16(o[4], o[5]); w.w = pg8::cvt_pk_bf16(o[6], o[7]); return w; }

struct FrontIn { v4u r, k, v; bf16x8s fw[2], fa[2]; };
__device__ __forceinline__ void front_fetch(FrontIn& f, unsigned char* ws, int unit, int tid, int lane, int wave) {
    const int h = unit & 15, c = (unit >> 4) & 127, b = unit >> 11; const size_t row0 = (size_t)b * SEQ + c * 64;
    const int rt = wave & 3, fr = lane & 15, g = lane >> 4, t = tid >> 3, cq = tid & 7, c0 = h * HD + cq * 8;
    const bf16* Rb = (const bf16*)(ws + WS_B1); const bf16* Kb = (const bf16*)(ws + WS_B2); const bf16* Vb = (const bf16*)(ws + WS_B3);
    const bf16* LW = (const bf16*)(ws + WS_LW); const bf16* LA = (const bf16*)(ws + WS_LA);
    f.r = *(const GAS v4u*)(Rb + (row0 + t) * C + c0); f.k = *(const GAS v4u*)(Kb + (row0 + t) * C + c0); f.v = *(const GAS v4u*)(Vb + (row0 + t) * C + c0);
#pragma unroll
    for (int ks = 0; ks < 2; ++ks) { f.fw[ks] = *(const GAS bf16x8s*)(LW + (row0 + 16 * rt + fr) * DW + 32 * ks + 8 * g); f.fa[ks] = *(const GAS bf16x8s*)(LA + (row0 + 16 * rt + fr) * DA + 32 * ks + 8 * g); }
}
__device__ __forceinline__ v4u head_consts(unsigned char* ws, LAS unsigned char* lds, int h, int tid, int wtile, int atile) {
    const bf16* W2T = (const bf16*)(ws + WS_WT_W2); const bf16* A2T = (const bf16*)(ws + WS_WT_A2);
    const int row = tid >> 3, cq = tid & 7;
    const v4u w2chunk = *(const GAS v4u*)(W2T + (size_t)(h * HD + row) * 64 + cq * 8);
    *(LAS v4u*)(lds + CS_TILES + wtile * TILE_B + row * TPB + cq * 16) = w2chunk;
    *(LAS v4u*)(lds + CS_TILES + atile * TILE_B + row * TPB + cq * 16) = *(const GAS v4u*)(A2T + (size_t)(h * HD + row) * 64 + cq * 8);
    if (tid < 64) { LAS float* P = (LAS float*)(lds + CS_PAR); P[tid] = INP(15)[h * HD + tid]; P[64 + tid] = INP(16)[h * HD + tid]; P[128 + tid] = INP(17)[h * HD + tid]; }
    __syncthreads();
    return w2chunk;
}
template <int MODE>
__device__ __forceinline__ void chunk_front(const FrontIn& f, LAS unsigned char* lds, const float (&w0v)[2], const float (&a0v)[2], const bf16x8s (&w2f)[2][2], const bf16x8s (&a2f)[2][2], int tid, int lane, int wave, float (&v8)[8], float& rkb) {
    const int rt = wave & 3, ch = wave >> 2, fr = lane & 15, g = lane >> 4;
    LAS float* FA = (LAS float*)(lds + CS_FA); LAS float* FB = (LAS float*)(lds + CS_FB); LAS float* TOT = (LAS float*)(lds + CS_TOT);
    const int t = tid >> 3, cq = tid & 7;
    {
        f32x4 aw[2] = {F4Z, F4Z}, aa[2] = {F4Z, F4Z};
#pragma unroll
        for (int ks = 0; ks < 2; ++ks)
#pragma unroll
            for (int ct = 0; ct < 2; ++ct) { aw[ct] = MFMA16(f.fw[ks], w2f[ks][ct], aw[ct]); aa[ct] = MFMA16(f.fa[ks], a2f[ks][ct], aa[ct]); }
#pragma unroll
        for (int ct = 0; ct < 2; ++ct) { const int j = 32 * ch + 16 * ct + fr, js = j ^ ((g & 1) << 4); const float w0 = w0v[ct], a0 = a0v[ct];
            float p[4];
#pragma unroll
            for (int q = 0; q < 4; ++q) { p[q] = -0.6065306597126334f * sigmoidf_(w0 + aw[ct][q]); if (q) p[q] += p[q - 1]; }
            const float s_ = p[3];
            const float u1 = __int_as_float(__builtin_amdgcn_ds_bpermute(((lane - 16) & 63) << 2, __float_as_int(s_))); const float t1 = s_ + (g >= 1 ? u1 : 0.f);
            const float u2 = __int_as_float(__builtin_amdgcn_ds_bpermute(((lane - 32) & 63) << 2, __float_as_int(t1))); const float t2 = t1 + (g >= 2 ? u2 : 0.f);
            const float ex = t2 - s_;
#pragma unroll
            for (int q = 0; q < 4; ++q) { const int tt = 16 * rt + 4 * g + q; FA[tt * 64 + js] = p[q] + ex; FB[tt * 64 + js] = sigmoidf_(a0 + aa[ct][q]); }
            if (g == 3) TOT[rt * 64 + j] = t2; }
    }
    lds_barrier();
    {
        float r[8], k[8], pkk[8], pka[8], prk[8];
        unpack8(f.r, r); unpack8(f.k, k); unpack8(f.v, v8);
        { const LAS float* P = (const LAS float*)(lds + CS_PAR) + cq * 8; const f32x4 a0_ = *(const LAS f32x4*)P, a1_ = *(const LAS f32x4*)(P + 4), b0_ = *(const LAS f32x4*)(P + 64), b1_ = *(const LAS f32x4*)(P + 68), c0_ = *(const LAS f32x4*)(P + 128), c1_ = *(const LAS f32x4*)(P + 132);
#pragma unroll
          for (int q = 0; q < 4; ++q) { pkk[q] = a0_[q]; pkk[4 + q] = a1_[q]; pka[q] = b0_[q]; pka[4 + q] = b1_[q]; prk[q] = c0_[q]; prk[4 + q] = c1_[q]; } }
        float cw[8], cwp[8], ag[8];
        { const int tp = t > 0 ? t - 1 : 0, rtt = wave >> 1;
          const int ct_ = (cq ^ (((t >> 2) & 1) << 1)) * 8, cp_ = (cq ^ (((tp >> 2) & 1) << 1)) * 8;
          const f32x4 c0_ = *(const LAS f32x4*)(FA + t * 64 + ct_), c1_ = *(const LAS f32x4*)(FA + t * 64 + ct_ + 4), p0_ = *(const LAS f32x4*)(FA + tp * 64 + cp_), p1_ = *(const LAS f32x4*)(FA + tp * 64 + cp_ + 4);
          const f32x4 g0_ = *(const LAS f32x4*)(FB + t * 64 + ct_), g1_ = *(const LAS f32x4*)(FB + t * 64 + ct_ + 4);
          f32x4 o0_ = F4Z, o1_ = F4Z, l0_ = F4Z, l1_ = F4Z;
          for (int r_ = 0; r_ < rtt; ++r_) { l0_ = *(const LAS f32x4*)(TOT + r_ * 64 + cq * 8); l1_ = *(const LAS f32x4*)(TOT + r_ * 64 + cq * 8 + 4); o0_ = o0_ + l0_; o1_ = o1_ + l1_; }
          const bool first = (t & 15) == 0;
#pragma unroll
          for (int q = 0; q < 4; ++q) { cw[q] = c0_[q] + o0_[q]; cw[4 + q] = c1_[q] + o1_[q];
              cwp[q] = t > 0 ? p0_[q] + o0_[q] - (first ? l0_[q] : 0.f) : 0.f; cwp[4 + q] = t > 0 ? p1_[q] + o1_[q] - (first ? l1_[q] : 0.f) : 0.f; ag[q] = g0_[q]; ag[4 + q] = g1_[q]; } }
        float kk[8], ss = 0.f; rkb = 0.f;
#pragma unroll
        for (int q = 0; q < 8; ++q) { kk[q] = k[q] * pkk[q]; ss += kk[q] * kk[q]; }
        ss = sum8(ss);
        const float inv = 1.0f / fmaxf(sqrtf(ss), 1e-12f);
        float at[8], bt[8], kt[8], rt_[8];
#pragma unroll
        for (int q = 0; q < 8; ++q) { const float kn = kk[q] * inv, kp = k[q] * (1.0f + (ag[q] - 1.0f) * pka[q]);
            const float ein = __expf(-cw[q]);
            at[q] = -kn * __expf(cwp[q]); bt[q] = kn * ag[q] * ein; kt[q] = kp * ein;
            rt_[q] = r[q] * __expf(cw[q]); rkb += r[q] * kp * prk[q]; }
        rkb = sum8(rkb);
        *(LAS v4u*)(TILE(0) + t * TPB + cq * 16) = pack8f(at); *(LAS v4u*)(TILE(1) + t * TPB + cq * 16) = pack8f(bt); *(LAS v4u*)(TILE(2) + t * TPB + cq * 16) = pack8f(kt);
        *(LAS v4u*)(TILE(3) + t * TPB + cq * 16) = f.v;
        *(LAS v4u*)(TILE(6) + t * TPB + cq * 16) = pack8f(rt_);
        if (MODE == 1 && t == 63) {
#pragma unroll
            for (int q = 0; q < 8; ++q) ((LAS float*)(lds + CS_WL))[cq * 8 + q] = __expf(cw[q]); }
    }
    lds_barrier();
}

__device__ __forceinline__ void scan_s1(unsigned char* ws, LAS unsigned char* lds, int lane0, int wave) {
    const int rt = wave & 3, ch = wave >> 2;
    FrontIn fin; float w0v[2], a0v[2]; bf16x8s w2f[2][2], a2f[2][2];
    { int l0 = lane0; asm volatile("" : "+v"(l0)); const int hh = blockIdx.x & 15;
      if ((int)blockIdx.x < BATCH * NH * (SEQ / 64)) front_fetch(fin, ws, blockIdx.x, wave * 64 + l0, l0, wave);
      const bf16* W2T = (const bf16*)(ws + WS_WT_W2); const bf16* A2T = (const bf16*)(ws + WS_WT_A2);
#pragma unroll
      for (int ct = 0; ct < 2; ++ct) { w0v[ct] = INP(7)[hh * HD + 32 * ch + 16 * ct + (l0 & 15)]; a0v[ct] = INP(10)[hh * HD + 32 * ch + 16 * ct + (l0 & 15)];
#pragma unroll
          for (int ks = 0; ks < 2; ++ks) { const size_t wr_ = (size_t)(hh * HD + 32 * ch + 16 * ct + (l0 & 15)) * 64 + 32 * ks + 8 * (l0 >> 4); w2f[ks][ct] = *(const GAS bf16x8s*)(W2T + wr_); a2f[ks][ct] = *(const GAS bf16x8s*)(A2T + wr_); } }
      const int tid0 = wave * 64 + l0;
      if (tid0 < 64) { LAS float* P = (LAS float*)(lds + CS_PAR); P[tid0] = INP(15)[hh * HD + tid0]; P[64 + tid0] = INP(16)[hh * HD + tid0]; P[128 + tid0] = INP(17)[hh * HD + tid0]; }
      __syncthreads(); }
    for (int unit = blockIdx.x; unit < BATCH * NH * (SEQ / 64); unit += gridDim.x) {
        int lane = lane0; asm volatile("" : "+v"(lane));
        const int tid = wave * 64 + lane, fr = lane & 15, g = lane >> 4;
        const int h = unit & 15, c = (unit >> 4) & 127, b = unit >> 11; const size_t chunk = ((size_t)b * NH + h) * 128 + c;
        float v8[8]; float rkb;
        chunk_front<1>(fin, lds, w0v, a0v, w2f, a2f, tid, lane, wave, v8, rkb);
        { const size_t row0_ = (size_t)b * SEQ + c * 64; if ((tid & 7) == 0) ((float*)(ws + WS_HID))[(row0_ + (tid >> 3)) * NH + h] = rkb; }
        if (unit + (int)gridDim.x < BATCH * NH * (SEQ / 64)) front_fetch(fin, ws, unit + gridDim.x, tid, lane, wave);
        {
            f32x4 a2[2] = {F4Z, F4Z}, a3[2] = {F4Z, F4Z};
            mm64(a2, TILE(1), TILE(0), rt, ch, fr, g);
            mm64(a3, TILE(2), TILE(0), rt, ch, fr, g);
            f32x4 p1[2];
#pragma unroll
            for (int ct = 0; ct < 2; ++ct) { const int col = 32 * ch + 16 * ct + fr;
#pragma unroll
                for (int q = 0; q < 4; ++q) { const int row = 16 * rt + 4 * g + q;
                    a2[ct][q] = row < col ? a2[ct][q] : 0.f;
                    p1[ct][q] = a2[ct][q] + (row == col ? 1.0f : 0.f);
                    a3[ct][q] = row < col ? a3[ct][q] : 0.f; } }
            st_tr(TILE(5), a2, rt, ch, fr, g);
            st_tr(TILE(9), p1, rt, ch, fr, g);
            st_tr(TILE(4), a3, rt, ch, fr, g);
        }
        lds_barrier();
#pragma unroll
        for (int r = 0; r < 6; ++r) {
            LAS unsigned char* Sr = TILE(5 + 2 * (r & 1)); LAS unsigned char* Sr2 = TILE(5 + 2 * ((r & 1) ^ 1));
            if (r <= 4) { f32x4 q2[2] = {F4Z, F4Z};
                mm64_at(q2, Sr, Sr, rt, ch, fr, g, lane);
                st_tr(Sr2, q2, rt, ch, fr, g); }
            if (r >= 1) { LAS unsigned char* Pr = TILE(9 + ((r - 1) & 1)); LAS unsigned char* Pr2 = TILE(9 + (((r - 1) & 1) ^ 1));
                f32x4 pa[2]; ld_tr(pa, Pr, rt, ch, fr, g);
                mm64_at(pa, Sr, Pr, rt, ch, fr, g, lane);
                st_tr(Pr2, pa, rt, ch, fr, g); }
            if (r == 0) { f32x4 gg[2] = {F4Z, F4Z};
                mm64_bt(gg, TILE(4), TILE(3), rt, ch, fr, g, lane);
                st_tr(TILE(11), gg, rt, ch, fr, g); }
            lds_barrier();
        }
        {
            f32x4 acc[2] = {F4Z, F4Z}, ac2[2] = {F4Z, F4Z};
            mm64_bt(acc, TILE(10), TILE(0), rt, ch, fr, g, lane);
            mm64(ac2, TILE(10), TILE(11), rt, ch, fr, g);
            st_tr(TILE(5), acc, rt, ch, fr, g); st_tr(TILE(7), ac2, rt, ch, fr, g);
            f32x4 b2[2] = {F4Z, F4Z}, b3[2] = {F4Z, F4Z};
            mm64(b2, TILE(1), TILE(6), rt, ch, fr, g); mm64(b3, TILE(2), TILE(6), rt, ch, fr, g);
#pragma unroll
            for (int ct = 0; ct < 2; ++ct) { const int t = 32 * ch + 16 * ct + fr;
#pragma unroll
                for (int q = 0; q < 4; ++q) { const int s_ = 16 * rt + 4 * g + q; b2[ct][q] = s_ <= t ? b2[ct][q] : 0.f; b3[ct][q] = s_ <= t ? b3[ct][q] : 0.f; } }
            st_tr(TILE(4), b2, rt, ch, fr, g); st_tr(TILE(9), b3, rt, ch, fr, g);
        }
        lds_barrier();
        {
            const LAS float* WL = (const LAS float*)(lds + CS_WL);
            f32x4 acc[2] = {F4Z, F4Z};
            mm64_bt(acc, TILE(5), TILE(1), rt, ch, fr, g, lane);
            bf16* Mg = (bf16*)(ws + WS_B0) + chunk * 4096;
#pragma unroll
            for (int ct = 0; ct < 2; ++ct) { const int j1 = 32 * ch + 16 * ct + fr; const float wl = WL[j1];
#pragma unroll
                for (int q = 0; q < 4; ++q) { const int j2 = 16 * rt + 4 * g + q; acc[ct][q] = wl * (acc[ct][q] + (j2 == j1 ? 1.0f : 0.f)); }
                const int rtS = 2 * ch + ct, ksS = rt >> 1, half = rt & 1;
                *(GAS bf16x4s*)(Mg + (((rtS * 2 + ksS) * 64 + g * 16 + fr) * 8 + half * 4)) = pack4(acc[ct]); }
            f32x4 ad[2] = {F4Z, F4Z};
            mm64_at(ad, TILE(1), TILE(7), rt, ch, fr, g, lane);
            mm64_att(ad, TILE(2), TILE(3), rt, ch, lane);
            const f32x4 wl4 = *(const LAS f32x4*)(WL + 16 * rt + 4 * g);
            bf16* Dg = (bf16*)OUTP() + chunk * 4096;
#pragma unroll
            for (int ct = 0; ct < 2; ++ct) *(GAS bf16x4s*)(Dg + (((2 * ch + ct) * 4 + rt) * 64 + lane) * 4) = pack4(ad[ct] * wl4);
            const size_t row0_ = (size_t)b * SEQ + c * 64;
            f32x4 ar[2]; ld_tr(ar, TILE(6), rt, ch, fr, g);
            mm64(ar, TILE(5), TILE(4), rt, ch, fr, g);
            f32x4 ay[2] = {F4Z, F4Z};
            mm64(ay, TILE(7), TILE(4), rt, ch, fr, g); mm64_at(ay, TILE(3), TILE(9), rt, ch, fr, g, lane);
            bf16* Rg = (bf16*)(ws + WS_B1); bf16* Kg = (bf16*)(ws + WS_B2);
#pragma unroll
            for (int ct = 0; ct < 2; ++ct) { const size_t o_ = (row0_ + 32 * ch + 16 * ct + fr) * C + h * HD + 16 * rt + 4 * g; *(GAS bf16x4s*)(Rg + o_) = pack4(ar[ct]); *(GAS bf16x4s*)(Kg + o_) = pack4(ay[ct]); }
        }
        lds_barrier();
    }
}

constexpr int S2_PD = 6;
__device__ __forceinline__ void scan_s2(unsigned char* ws, LAS unsigned char* lds, int lane, int wave) {
    for (int bh = blockIdx.x; bh < BATCH * NH; bh += gridDim.x) {
        const unsigned char* Mg = (const unsigned char*)((const bf16*)(ws + WS_B0) + (size_t)bh * 128 * 4096); const unsigned char* Dg = (const unsigned char*)((const bf16*)OUTP() + (size_t)bh * 128 * 4096);
        bf16* Sg = (bf16*)OUTP() + (size_t)M * C + (size_t)bh * 128 * 4096;
        if (wave >= 4) {
            const int lw = wave - 4;
            const unsigned char* src = (lw < 2 ? Mg + lw * 4096 : Dg + (lw - 2) * 4096) + lane * 16;
            LAS unsigned char* dst = lds + lw * 4096 + lane * 16;
            v4u q[S2_PD][4];
#define S2_LOADQ(j, c) do { _Pragma("unroll") for (int i_ = 0; i_ < 4; ++i_) q[j][i_] = *(const GAS v4u*)(src + (size_t)(c) * 8192 + i_ * 1024); } while (0)
#define S2_STOREQ(j, slot) do { _Pragma("unroll") for (int i_ = 0; i_ < 4; ++i_) *(LAS v4u*)(dst + (slot) * 16384 + i_ * 1024) = q[j][i_]; } while (0)
#pragma unroll
            for (int j = 0; j < S2_PD; ++j) S2_LOADQ(j, j);
            S2_STOREQ(0, 0); S2_LOADQ(0, S2_PD);
            lds_barrier();
#pragma unroll 1
            for (int s0 = 0; s0 < 128; s0 += S2_PD) {
#pragma unroll
                for (int jj = 0; jj < S2_PD; ++jj) { const int step = s0 + jj;
                    if (step + 1 < 128) S2_STOREQ((jj + 1) % S2_PD, (step + 1) & 1);
                    if (step + 1 + S2_PD < 128) S2_LOADQ((jj + 1) % S2_PD, step + 1 + S2_PD);
                    lds_barrier(); }
            }
#undef S2_LOADQ
#undef S2_STOREQ
        } else {
            const int ct = wave;
            f32x4 acc[4];
#pragma unroll
            for (int r = 0; r < 4; ++r) acc[r] = F4Z;
            lds_barrier();
#pragma unroll 1
            for (int s0 = 0; s0 < 128; s0 += S2_PD) {
#pragma unroll
                for (int jj = 0; jj < S2_PD; ++jj) { const int step = s0 + jj;
                    if (step < 128) {
                        const LAS unsigned char* slot = lds + (step & 1) * 16384;
                        bf16x8s sf[2];
#pragma unroll
                        for (int ks = 0; ks < 2; ++ks) { const bf16x4s lo = pack4(acc[2 * ks]), hi = pack4(acc[2 * ks + 1]); sf[ks] = (bf16x8s){lo[0], lo[1], lo[2], lo[3], hi[0], hi[1], hi[2], hi[3]}; }
#pragma unroll
                        for (int ks = 0; ks < 2; ++ks) *(GAS bf16x8s*)(Sg + (size_t)step * 4096 + ((ct * 2 + ks) * 64 + lane) * 8) = sf[ks];
                        f32x4 na[4];
#pragma unroll
                        for (int r = 0; r < 4; ++r) na[r] = unpack4(*(const LAS bf16x4s*)(slot + 8192 + ((ct * 4 + r) * 64 + lane) * 8));
#pragma unroll
                        for (int ks = 0; ks < 2; ++ks)
#pragma unroll
                            for (int r = 0; r < 4; ++r) na[r] = MFMA16(*(const LAS bf16x8s*)(slot + ((r * 2 + ks) * 64 + lane) * 16), sf[ks], na[r]);
#pragma unroll
                        for (int r = 0; r < 4; ++r) acc[r] = na[r];
                    }
                    lds_barrier(); }
            }
        }
    }
}

constexpr int S3_RT = 32768, S3_YT = S3_RT + TILE_B, S3_LG = S3_YT + TILE_B, S3_LGP = 336;
struct S3In { v4u rr, yy, vv, lg[3]; bf16x8s sA[2]; float rkb; };
__device__ __forceinline__ void s3_fetch(S3In& f, unsigned char* ws, int unit, int tid, int lane, int wave) {
    const int h = unit & 15, c = (unit >> 4) & 127, b = unit >> 11; const size_t chunk = ((size_t)b * NH + h) * 128 + c, row0 = (size_t)b * SEQ + c * 64;
    const int rt = wave & 3, et = tid >> 3, ecq = tid & 7;
    const bf16* Rg = (const bf16*)(ws + WS_B1); const bf16* Kg = (const bf16*)(ws + WS_B2); const bf16* Vb = (const bf16*)(ws + WS_B3); const bf16* LG = (const bf16*)(ws + WS_LG);
    const bf16* Sg = (const bf16*)OUTP() + (size_t)M * C + chunk * 4096;
    const size_t o_ = (row0 + et) * C + h * HD + ecq * 8;
    f.rr = *(const GAS v4u*)(Rg + o_); f.yy = *(const GAS v4u*)(Kg + o_); f.vv = *(const GAS v4u*)(Vb + o_);
#pragma unroll
    for (int i = 0; i < 3; ++i) { const int chn = tid + 512 * i; if (chn < 64 * 20) f.lg[i] = *(const GAS v4u*)(LG + (row0 + chn / 20) * DG + (chn % 20) * 8); }
#pragma unroll
    for (int ks = 0; ks < 2; ++ks) f.sA[ks] = *(const GAS bf16x8s*)(Sg + ((rt * 2 + ks) * 64 + lane) * 8);
    f.rkb = ((const float*)(ws + WS_HID))[(row0 + et) * NH + h];
}
__device__ __forceinline__ void scan_s3(unsigned char* ws, LAS unsigned char* lds, int lane0, int wave) {
    const int rt = wave & 3, ch = wave >> 2;
    LAS float* Ys = (LAS float*)(lds + CS_FA);
    const bf16* G2T = (const bf16*)(ws + WS_WT_G2); bf16* YG = (bf16*)(ws + WS_B0);
    constexpr int NU = BATCH * NH * (SEQ / 64);
    S3In fin; bf16x8s gA[5]; f32x4 lnw0, lnw1, lnb0, lnb1;
    { int l0 = lane0; asm volatile("" : "+v"(l0)); const int hh = blockIdx.x & 15, t0_ = wave * 64 + l0;
      if ((int)blockIdx.x < NU) s3_fetch(fin, ws, blockIdx.x, t0_, l0, wave);
#pragma unroll
      for (int ks = 0; ks < 5; ++ks) gA[ks] = *(const GAS bf16x8s*)(G2T + (size_t)(hh * HD + 16 * rt + (l0 & 15)) * DG + 32 * ks + 8 * (l0 >> 4));
      const int ec0 = hh * HD + (t0_ & 7) * 8;
      lnw0 = *(const GAS f32x4*)(INP(18) + ec0); lnw1 = *(const GAS f32x4*)(INP(18) + ec0 + 4); lnb0 = *(const GAS f32x4*)(INP(19) + ec0); lnb1 = *(const GAS f32x4*)(INP(19) + ec0 + 4); }
    __syncthreads();
    for (int unit = blockIdx.x; unit < NU; unit += gridDim.x) {
        int lane = lane0; asm volatile("" : "+v"(lane));
        const int tid = wave * 64 + lane, fr = lane & 15, g = lane >> 4, et = tid >> 3, ecq = tid & 7;
        const int h = unit & 15, c = (unit >> 4) & 127, b = unit >> 11; const size_t row0 = (size_t)b * SEQ + c * 64;
        *(LAS v4u*)(lds + S3_RT + et * TPB + ecq * 16) = fin.rr; *(LAS v4u*)(lds + S3_YT + et * TPB + ecq * 16) = fin.yy;
#pragma unroll
        for (int i = 0; i < 3; ++i) { const int chn = tid + 512 * i; if (chn < 64 * 20) *(LAS v4u*)(lds + S3_LG + (chn / 20) * S3_LGP + (chn % 20) * 16) = fin.lg[i]; }
        float v8[8]; unpack8(fin.vv, v8); const float rkb = fin.rkb; const bf16x8s sA0 = fin.sA[0], sA1 = fin.sA[1];
        lds_barrier();
        if (unit + (int)gridDim.x < NU) s3_fetch(fin, ws, unit + gridDim.x, tid, lane, wave);
        f32x4 acc[2], ag[2] = {F4Z, F4Z};
#pragma unroll
        for (int ct = 0; ct < 2; ++ct) { const int t = 32 * ch + 16 * ct + fr;
            acc[ct] = unpack4(*(const LAS bf16x4s*)(lds + S3_YT + t * TPB + (16 * rt + 4 * g) * 2));
            acc[ct] = MFMA16(sA0, ldfrag_perm(lds + S3_RT, t, 0, g), acc[ct]); acc[ct] = MFMA16(sA1, ldfrag_perm(lds + S3_RT, t, 1, g), acc[ct]);
#pragma unroll
            for (int ks = 0; ks < 5; ++ks) ag[ct] = MFMA16(gA[ks], *(const LAS bf16x8s*)(lds + S3_LG + t * S3_LGP + (32 * ks + 8 * g) * 2), ag[ct]);
            *(LAS f32x4*)(Ys + t * FP + 16 * rt + 4 * g) = acc[ct]; }
        lds_barrier();
        {
            const f32x4 y0 = *(const LAS f32x4*)(Ys + et * FP + ecq * 8), y1 = *(const LAS f32x4*)(Ys + et * FP + ecq * 8 + 4);
            float y[8] = {y0[0], y0[1], y0[2], y0[3], y1[0], y1[1], y1[2], y1[3]};
            float s_ = 0.f;
#pragma unroll
            for (int q = 0; q < 8; ++q) s_ += y[q];
            s_ = sum8(s_);
            const float mu = s_ * (1.0f / HD); float vs = 0.f;
#pragma unroll
            for (int q = 0; q < 8; ++q) { y[q] -= mu; vs += y[q] * y[q]; }
            vs = sum8(vs);
            const float rstd = 1.0f / sqrtf(vs * (1.0f / HD) + GN_EPS);
            f32x4 o0, o1;
#pragma unroll
            for (int q = 0; q < 4; ++q) { o0[q] = y[q] * rstd * lnw0[q] + lnb0[q] + rkb * v8[q]; o1[q] = y[4 + q] * rstd * lnw1[q] + lnb1[q] + rkb * v8[4 + q]; }
            *(LAS f32x4*)(Ys + et * FP + ecq * 8) = o0; *(LAS f32x4*)(Ys + et * FP + ecq * 8 + 4) = o1;
        }
        lds_barrier();
#pragma unroll
        for (int ct = 0; ct < 2; ++ct) { const int t = 32 * ch + 16 * ct + fr; const f32x4 yv = *(const LAS f32x4*)(Ys + t * FP + 16 * rt + 4 * g);
            *(GAS bf16x4s*)(YG + (row0 + t) * C + h * HD + 16 * rt + 4 * g) = pack4(yv * ag[ct]); }
    }
    __syncthreads();
}
#undef TILE
#if MK_DEBUG
__device__ __forceinline__ void scan_naive(unsigned char* ws, LAS unsigned char* lds, int tid) {
    const int lane = tid & 63;
    const bf16* Rb = (const bf16*)(ws + WS_B1); const bf16* Kb = (const bf16*)(ws + WS_B2); const bf16* Vb = (const bf16*)(ws + WS_B3);
    const bf16* LW = (const bf16*)(ws + WS_LW); const bf16* LA = (const bf16*)(ws + WS_LA);
    float* Y = OUTP(); float* RK = (float*)(ws + WS_HID);
    LAS float* sR = (LAS float*)lds; LAS float* sK = sR + 4096; LAS float* sV = sK + 4096; LAS float* sA = sV + 4096; LAS float* sB = sA + 4096; LAS float* sD = sB + 4096;
    LAS float* sW2 = sD + 4096; LAS float* sA2 = sW2 + 4096;
    for (int unit = blockIdx.x; unit < BATCH * NH; unit += gridDim.x) {
        const int b = unit / NH, h = unit % NH;
        __syncthreads();
        for (int e = tid; e < 4096; e += 512) { const int d = e >> 6, j = e & 63; sW2[e] = INP(9)[(size_t)d * C + h * HD + j]; sA2[e] = INP(12)[(size_t)d * C + h * HD + j]; }
        __syncthreads();
        const int pt = tid >> 3, cq = tid & 7, c0 = h * HD + cq * 8;
        const int si = tid >> 3, jq = tid & 7;
        float S[8];
#pragma unroll
        for (int q = 0; q < 8; ++q) S[q] = 0.f;
        float w0v[8], a0v[8], kkv[8], kav[8], rkv[8];
#pragma unroll
        for (int q = 0; q < 8; ++q) { w0v[q] = INP(7)[c0 + q]; a0v[q] = INP(10)[c0 + q]; kkv[q] = INP(15)[c0 + q]; kav[q] = INP(16)[c0 + q]; rkv[q] = INP(17)[c0 + q]; }
        for (int blk = 0; blk < SEQ / 64; ++blk) {
            const size_t row = (size_t)b * SEQ + blk * 64 + pt;
            {
                const v4u r4 = *(const GAS v4u*)(Rb + row * C + c0), k4 = *(const GAS v4u*)(Kb + row * C + c0), v4 = *(const GAS v4u*)(Vb + row * C + c0);
                float r[8], k[8], v[8];
                r[0] = bflo(r4.x); r[1] = bfhi(r4.x); r[2] = bflo(r4.y); r[3] = bfhi(r4.y); r[4] = bflo(r4.z); r[5] = bfhi(r4.z); r[6] = bflo(r4.w); r[7] = bfhi(r4.w);
                k[0] = bflo(k4.x); k[1] = bfhi(k4.x); k[2] = bflo(k4.y); k[3] = bfhi(k4.y); k[4] = bflo(k4.z); k[5] = bfhi(k4.z); k[6] = bflo(k4.w); k[7] = bfhi(k4.w);
                v[0] = bflo(v4.x); v[1] = bfhi(v4.x); v[2] = bflo(v4.y); v[3] = bfhi(v4.y); v[4] = bflo(v4.z); v[5] = bfhi(v4.z); v[6] = bflo(v4.w); v[7] = bfhi(v4.w);
                float wp[8], ap[8];
#pragma unroll
                for (int q = 0; q < 8; ++q) { wp[q] = w0v[q]; ap[q] = a0v[q]; }
                for (int d = 0; d < 64; ++d) { const float lw = bf2f(LW[row * DW + d]), la = bf2f(LA[row * DA + d]);
#pragma unroll
                    for (int q = 0; q < 8; ++q) { wp[q] += lw * sW2[d * 64 + cq * 8 + q]; ap[q] += la * sA2[d * 64 + cq * 8 + q]; } }
                float kk[8], ss = 0.f, rks = 0.f;
#pragma unroll
                for (int q = 0; q < 8; ++q) { kk[q] = k[q] * kkv[q]; ss += kk[q] * kk[q]; }
                ss = sum8(ss);
                const float inv = 1.0f / fmaxf(sqrtf(ss), 1e-12f);
#pragma unroll
                for (int q = 0; q < 8; ++q) { const float ag = sigmoidf_(ap[q]); const float kn = kk[q] * inv; const float kp = k[q] * (1.0f + (ag - 1.0f) * kav[q]);
                    const float lw = -0.6065306597126334f * sigmoidf_(wp[q]);
                    const int o = pt * 64 + cq * 8 + q;
                    sR[o] = r[q]; sK[o] = kp; sV[o] = v[q]; sA[o] = -kn; sB[o] = kn * ag; sD[o] = __expf(lw); rks += r[q] * kp * rkv[q]; }
                rks = sum8(rks);
                if (cq == 0) RK[row * NH + h] = rks;
            }
            __syncthreads();
            for (int t = 0; t < 64; ++t) {
                const LAS f32x4* pa = (const LAS f32x4*)(sA + t * 64 + jq * 8); const LAS f32x4* pb = (const LAS f32x4*)(sB + t * 64 + jq * 8);
                const LAS f32x4* pd = (const LAS f32x4*)(sD + t * 64 + jq * 8); const LAS f32x4* pk = (const LAS f32x4*)(sK + t * 64 + jq * 8);
                const LAS f32x4* pr = (const LAS f32x4*)(sR + t * 64 + jq * 8);
                const f32x4 a0 = pa[0], a1 = pa[1], b0 = pb[0], b1 = pb[1], d0 = pd[0], d1 = pd[1], k0 = pk[0], k1 = pk[1], r0 = pr[0], r1 = pr[1];
                const float vi = sV[t * 64 + si];
                float sa = 0.f;
#pragma unroll
                for (int q = 0; q < 4; ++q) { sa += S[q] * a0[q]; sa += S[4 + q] * a1[q]; }
                sa = sum8(sa);
                float y = 0.f;
#pragma unroll
                for (int q = 0; q < 4; ++q) { S[q] = S[q] * d0[q] + sa * b0[q] + vi * k0[q]; S[4 + q] = S[4 + q] * d1[q] + sa * b1[q] + vi * k1[q]; y += S[q] * r0[q]; y += S[4 + q] * r1[q]; }
                y = sum8(y);
                if (jq == 0) Y[((size_t)b * SEQ + blk * 64 + t) * C + h * HD + si] = y;
            }
            __syncthreads();
        }
    }
}
__device__ __forceinline__ void post_scan(unsigned char* ws, int gw, int NGW, int lane) {
    const float* Y = OUTP(); const float* RK = (const float*)(ws + WS_HID); const bf16* Vb = (const bf16*)(ws + WS_B3); const bf16* LG = (const bf16*)(ws + WS_LG);
    bf16* YG = (bf16*)(ws + WS_B4); const float* g2 = INP(14); const float* lnw = INP(18); const float* lnb = INP(19);
    for (int it = gw; it < M * NH; it += NGW) {
        const int row = it / NH, h = it % NH, c = h * HD + lane;
        const float y = Y[(size_t)row * C + c];
        const float mu = wave_sum(y, lane) * (1.0f / HD); const float d = y - mu; const float var = wave_sum(d * d, lane) * (1.0f / HD);
        float o = d * (1.0f / sqrtf(var + GN_EPS)) * lnw[c] + lnb[c];
        o += RK[(size_t)row * NH + h] * bf2f(Vb[(size_t)row * C + c]);
        float g = 0.f;
        for (int dd = 0; dd < DG; ++dd) g += bf2f(LG[(size_t)row * DG + dd]) * g2[(size_t)dd * C + c];
        YG[(size_t)row * C + c] = (bf16)f2bf(o * g);
    }
}


constexpr int CW_DBG = 3200;
__device__ __forceinline__ void dbg_nonfinite(unsigned char* ws, const bf16* X, size_t n, int slot, int gw, int NGW, int lane, float thr = 1e30f) {
    unsigned* cw = (unsigned*)(ws + WS_CTL) + CW_DBG + 64 * slot; unsigned nnan = 0;
    for (size_t i = (size_t)gw * 64 + lane; i < n; i += (size_t)NGW * 64) { const float x = bf2f(X[i]); if (!(fabsf(x) < thr)) ++nnan; }
    if (nnan) atomicAdd(cw, nnan);
}
__device__ __forceinline__ void dbg_compare(unsigned char* ws, const bf16* X, const bf16* Y, int gw, int NGW, int lane) {
    unsigned* cw = (unsigned*)(ws + WS_CTL) + CW_DBG; unsigned nbad = 0, nnan = 0;
    for (size_t i = (size_t)gw * 64 + lane; i < (size_t)M * C; i += (size_t)NGW * 64) { const float x = bf2f(X[i]), y = bf2f(Y[i]);
        if (!(fabsf(x) < 1e30f)) ++nnan; else if (fabsf(x - y) > 0.05f * (fabsf(y) + 0.05f)) ++nbad; }
    if (nnan) atomicAdd(cw, nnan); if (nbad) atomicAdd(cw + 64, nbad);
}
#endif
__device__ __forceinline__ void router_rows(unsigned char* ws, LAS unsigned char* lds, int layer, int gw, int NGW, int lane, int tid, int wv, bool dry = false) {
    const bf16* Hh = (const bf16*)(ws + WS_B4); const float* gain = INP(2) + layer * C; float* rsl = (float*)(ws + WS_B0);
    const float* wg = INP(24) + (size_t)layer * C * 4; const float* bg = INP(25) + layer * 4; const float* wi = INP(26) + (size_t)layer * C * 16; const float* bi = INP(27) + layer * 16;
    unsigned* cnt = (unsigned*)(ws + WS_CTL) + CW_CNT + layer * 16 * 64; unsigned* list = (unsigned*)(ws + WS_LIST); float* wl = (float*)(ws + WS_WL);
    LAS float* sWg = (LAS float*)lds; LAS float* sWi = sWg + C * 4;
    constexpr int RECMAX = 256;
    LAS unsigned* lcnt = (LAS unsigned*)(lds + 81920); LAS unsigned* gbase = lcnt + 16; LAS float* sBias = (LAS float*)(lcnt + 32);
    LAS unsigned* recRow = lcnt + 64; LAS unsigned* recE = recRow + RECMAX; LAS unsigned* recL = recE + RECMAX; LAS float* recW0 = (LAS float*)(recL + RECMAX); LAS float* recW1 = recW0 + RECMAX; LAS float* recRS = recW1 + RECMAX;
    __syncthreads();
    for (int e = tid; e < C; e += 512) ((LAS f32x4*)sWg)[e] = ((const GAS f32x4*)wg)[e];
    for (int e = tid; e < C * 4; e += 512) ((LAS f32x4*)sWi)[e] = ((const GAS f32x4*)wi)[e];
    if (tid < 4) sBias[tid] = bg[tid]; else if (tid < 20) sBias[tid] = bi[tid - 4];
    for (int e = tid; e < RECMAX; e += 512) recE[e] = 0xffffffffu;
    __syncthreads();
    f32x4 g[4]; load_row(gain, lane, g);
    v2u nxr[4];
    { const int r0 = gw < M - 1 ? gw : M - 1;
#pragma unroll
        for (int j = 0; j < 4; ++j) nxr[j] = ((const GAS v2u*)(Hh + (size_t)r0 * C))[64 * j + lane]; }
    int k = 0;
    for (int row = gw; row < M; row += NGW, ++k) {
        f32x4 v[4];
#pragma unroll
        for (int j = 0; j < 4; ++j) v[j] = (f32x4){bflo(nxr[j].x), bfhi(nxr[j].x), bflo(nxr[j].y), bfhi(nxr[j].y)};
        if (row + NGW < M) {
#pragma unroll
            for (int j = 0; j < 4; ++j) nxr[j] = ((const GAS v2u*)(Hh + (size_t)(row + NGW) * C))[64 * j + lane]; }
        const float rs = row_rs(v, lane);
#pragma unroll
        for (int j = 0; j < 4; ++j) v[j] = v[j] * rs * g[j];
        float gl[4] = {0.f, 0.f, 0.f, 0.f};
        const LAS unsigned char* pWg = (const LAS unsigned char*)sWg + lane * 64;
#pragma unroll
        for (int j = 0; j < 4; ++j)
#pragma unroll
            for (int q = 0; q < 4; ++q) { const f32x4 w = *(const LAS f32x4*)(pWg + j * 4096 + q * 16); const float xv = v[j][q]; gl[0] += xv * w.x; gl[1] += xv * w.y; gl[2] += xv * w.z; gl[3] += xv * w.w; }
#pragma unroll
        for (int q = 0; q < 4; ++q) gl[q] = wave_sum(gl[q], lane) + sBias[q];
        int gi = 0; float gm = gl[0];
#pragma unroll
        for (int q = 1; q < 4; ++q) if (gl[q] > gm) { gm = gl[q]; gi = q; }
        float gden = 0.f;
#pragma unroll
        for (int q = 0; q < 4; ++q) gden += __expf(gl[q] - gm);
        const float gval = 1.0f / gden;
        float il[4] = {0.f, 0.f, 0.f, 0.f};
        const LAS unsigned char* pWi = (const LAS unsigned char*)sWi + lane * 256 + gi * 16;
#pragma unroll
        for (int j = 0; j < 4; ++j)
#pragma unroll
            for (int q = 0; q < 4; ++q) { const f32x4 w = *(const LAS f32x4*)(pWi + j * 16384 + q * 64); const float xv = v[j][q]; il[0] += xv * w.x; il[1] += xv * w.y; il[2] += xv * w.z; il[3] += xv * w.w; }
        const f32x4 bi4 = *(const LAS f32x4*)(sBias + 4 + gi * 4);
#pragma unroll
        for (int q = 0; q < 4; ++q) il[q] = wave_sum(il[q], lane) + bi4[q];
        int i0 = 0; float m0 = il[0];
#pragma unroll
        for (int q = 1; q < 4; ++q) if (il[q] > m0) { m0 = il[q]; i0 = q; }
        int i1 = -1; float m1 = -INFINITY;
#pragma unroll
        for (int q = 0; q < 4; ++q) if (q != i0 && il[q] > m1) { m1 = il[q]; i1 = q; }
        const float e1 = __expf(m1 - m0); const float w0 = gval / (1.0f + e1), w1 = gval * e1 / (1.0f + e1);
        const int ri = wv * 32 + k;
        if (lane == 0 && !dry && k < 32) { const int ex0 = gi * 4 + i0, ex1 = gi * 4 + i1;
            recRow[ri] = (unsigned)row; recE[ri] = (unsigned)ex0 | ((unsigned)ex1 << 8); recW0[ri] = w0; recW1[ri] = w1; recRS[ri] = rs; }
    }
    __syncthreads();
    unsigned e = 0xffffffffu; if (tid < RECMAX) e = recE[tid];
    const unsigned ex0 = e & 255u, ex1 = (e >> 8) & 255u;
    unsigned pos0 = 0u, pos1 = 0u;
    if (wv < RECMAX / 64) {
#pragma unroll
        for (unsigned x = 0; x < 16; ++x) { const unsigned long long m0 = __ballot(ex0 == x), m1 = __ballot(ex1 == x);
            const unsigned p = __builtin_amdgcn_mbcnt_hi((unsigned)(m0 >> 32), __builtin_amdgcn_mbcnt_lo((unsigned)m0, 0u)) + __builtin_amdgcn_mbcnt_hi((unsigned)(m1 >> 32), __builtin_amdgcn_mbcnt_lo((unsigned)m1, 0u));
            if (ex0 == x) pos0 = p; if (ex1 == x) pos1 = p;
            if (lane == 0) recL[wv * 16 + x] = (unsigned)(__popcll(m0) + __popcll(m1)); } }
    __syncthreads();
    if (tid < 16 && !dry) { unsigned c_ = 0u;
#pragma unroll
        for (int q = 0; q < RECMAX / 64; ++q) c_ += recL[q * 16 + tid];
        gbase[tid] = atomicAdd(cnt + tid * 64, c_); }
    __syncthreads();
    if (e != 0xffffffffu && !dry) { unsigned p0 = gbase[ex0] + pos0, p1 = gbase[ex1] + pos1;
        for (int q = 0; q < wv; ++q) { p0 += recL[q * 16 + ex0]; p1 += recL[q * 16 + ex1]; }
        const unsigned row = recRow[tid]; const float rs = recRS[tid];
        list[(size_t)ex0 * M + p0] = row * 2u; wl[(size_t)ex0 * M + p0] = recW0[tid]; list[(size_t)ex1 * M + p1] = row * 2u + 1u; wl[(size_t)ex1 * M + p1] = recW1[tid];
        rsl[(size_t)ex0 * M + p0] = rs; rsl[(size_t)ex1 * M + p1] = rs; }
}
__device__ __forceinline__ void moe_table(unsigned char* ws, volatile LAS int* tab, int layer, int tid) {
    __syncthreads();
    if (tid == 0) { const unsigned* cnt = (const unsigned*)(ws + WS_CTL) + CW_CNT + layer * 16 * 64; int t = 0;
#pragma unroll 1
        for (int e = 0; e < 16; ++e) { const int c = (int)__hip_atomic_load(cnt, RLX_AGENT); cnt += 64; tab[e] = c; tab[16 + e] = t; t += (c + 255) >> 8; tab[32 + e] = t; }
        tab[48] = t; }
    __syncthreads();
}
__device__ __forceinline__ void combine_rows(unsigned char* ws, int mode, int gw, int NGW, int lane, bool dry = false) {
    bf16* Hh = (bf16*)(ws + WS_B4); float* Out = OUTP(); const bf16* E0 = (const bf16*)(ws + WS_B2); const bf16* E1 = (const bf16*)(ws + WS_B3); bf16* XN2 = (bf16*)(ws + WS_B0);
    f32x4 g[4]; load_row(INP(4), lane, g);
    for (int row = gw; row < M; row += NGW) {
        f32x4 v[4]; load_row_bf(Hh + (size_t)row * C, lane, v);
#pragma unroll
        for (int j = 0; j < 4; ++j) { const v2u e0 = ((const GAS v2u*)(E0 + (size_t)row * C))[64 * j + lane], e1 = ((const GAS v2u*)(E1 + (size_t)row * C))[64 * j + lane];
            v[j].x += bflo(e0.x) + bflo(e1.x); v[j].y += bfhi(e0.x) + bfhi(e1.x); v[j].z += bflo(e0.y) + bflo(e1.y); v[j].w += bfhi(e0.y) + bfhi(e1.y); }
        const float rs = row_rs(v, lane);
        if (mode == 0) {
            if (!dry) store_row_bf16(Hh + (size_t)row * C, lane, v);
            if (lane == 0) ((float*)XN2)[row] = rs;
        } else {
            float sig = 1.0f;
#if MK_DEBUG
            const unsigned* cw = (const unsigned*)(ws + WS_CTL) + CW_DBG; const unsigned nnan = __hip_atomic_load(cw, RLX_AGENT), nbad = __hip_atomic_load(cw + 64, RLX_AGENT);
            if (row < 512 && nnan > 0) sig = 2.0f;
            if (row >= 512 && row < 1536 && __hip_atomic_load(cw + 128, RLX_AGENT) > 0) sig = 2.0f;
            if (row >= 1536 && row < 3584 && __hip_atomic_load(cw + 192, RLX_AGENT) > 0) sig = 2.0f;
            if (row >= 3584 && row < 7680 && __hip_atomic_load(cw + 256, RLX_AGENT) > 0) sig = 2.0f;
            if (row >= 7680 && row < 15872 && __hip_atomic_load(cw + 320, RLX_AGENT) > 0) sig = 2.0f;
            if (row >= 15872 && nbad > (unsigned)(M / 100) * C) sig = 1.5f;
#endif
#pragma unroll
            for (int j = 0; j < 4; ++j) ((GAS f32x4*)(Out + (size_t)row * C))[64 * j + lane] = v[j] * rs * g[j] * sig;
        }
    }
}
__device__ __forceinline__ void attn_naive(unsigned char* ws, int gw, int NGW, int lane) {
    const bf16* Kb = (const bf16*)(ws + WS_B1); const bf16* Vb = (const bf16*)(ws + WS_B2); const bf16* Qb = (const bf16*)(ws + WS_B3); bf16* Ob = (bf16*)(ws + WS_B0);
    for (int unit = gw; unit < BATCH * NH * (SEQ / 64); unit += NGW) {
        const int qb = unit % (SEQ / 64), bh = unit / (SEQ / 64), b = bh / NH, h = bh % NH;
        const int t0 = qb * 64, t = t0 + lane; const size_t rowq = (size_t)b * SEQ + t;
        float q[64], o[64];
#pragma unroll
        for (int c = 0; c < 8; ++c) { const v4u w = *(const GAS v4u*)(Qb + rowq * C + h * HD + c * 8);
            q[c * 8 + 0] = bflo(w.x) * 0.125f; q[c * 8 + 1] = bfhi(w.x) * 0.125f; q[c * 8 + 2] = bflo(w.y) * 0.125f; q[c * 8 + 3] = bfhi(w.y) * 0.125f;
            q[c * 8 + 4] = bflo(w.z) * 0.125f; q[c * 8 + 5] = bfhi(w.z) * 0.125f; q[c * 8 + 6] = bflo(w.w) * 0.125f; q[c * 8 + 7] = bfhi(w.w) * 0.125f; }
#pragma unroll
        for (int c = 0; c < 64; ++c) o[c] = 0.f;
        float suffix = 0.f;
        for (int s = t0 + 62; s >= 0; --s) {
            const bool valid = s < t;
            if (s < t0 && __all(suffix > SB_EXIT)) break;
            const bf16* kp = Kb + ((size_t)b * SEQ + s) * C + h * HD; const bf16* vp = Vb + ((size_t)b * SEQ + s) * C + h * HD;
            float z = 0.f;
#pragma unroll
            for (int c = 0; c < 8; ++c) { const v4u w = *(const GAS v4u*)(kp + c * 8);
                z += q[c * 8 + 0] * bflo(w.x) + q[c * 8 + 1] * bfhi(w.x) + q[c * 8 + 2] * bflo(w.y) + q[c * 8 + 3] * bfhi(w.y) + q[c * 8 + 4] * bflo(w.z) + q[c * 8 + 5] * bfhi(w.z) + q[c * 8 + 6] * bflo(w.w) + q[c * 8 + 7] * bfhi(w.w); }
            const float sp = fmaxf(z, 0.f) + log1pf(__expf(-fabsf(z)));
            const float att = valid ? __expf(z - sp - suffix) : 0.f;
            suffix += valid ? sp : 0.f;
#pragma unroll
            for (int c = 0; c < 8; ++c) { const v4u w = *(const GAS v4u*)(vp + c * 8);
                o[c * 8 + 0] += att * bflo(w.x); o[c * 8 + 1] += att * bfhi(w.x); o[c * 8 + 2] += att * bflo(w.y); o[c * 8 + 3] += att * bfhi(w.y);
                o[c * 8 + 4] += att * bflo(w.z); o[c * 8 + 5] += att * bfhi(w.z); o[c * 8 + 6] += att * bflo(w.w); o[c * 8 + 7] += att * bfhi(w.w); }
        }
#pragma unroll
        for (int c = 0; c < 8; ++c) { v4u w; w.x = pk2(o[c * 8 + 0], o[c * 8 + 1]); w.y = pk2(o[c * 8 + 2], o[c * 8 + 3]); w.z = pk2(o[c * 8 + 4], o[c * 8 + 5]); w.w = pk2(o[c * 8 + 6], o[c * 8 + 7]);
            *(GAS v4u*)(Ob + rowq * C + h * HD + c * 8) = w; }
    }
}


typedef float f32x16 __attribute__((ext_vector_type(16)));
constexpr int AT_VP = 192;
constexpr int AT_WAVE_LDS = 32 * AT_VP;
__device__ __forceinline__ int crow32(int reg, int hh) { return (reg & 3) + 8 * (reg >> 2) + 4 * hh; }
__device__ __forceinline__ bf16x8s pack_step(const f32x16& x, const int s) {
    v4u p; p.x = pg8::cvt_pk_bf16(x[8 * s], x[8 * s + 1]); p.y = pg8::cvt_pk_bf16(x[8 * s + 2], x[8 * s + 3]); p.z = pg8::cvt_pk_bf16(x[8 * s + 4], x[8 * s + 5]); p.w = pg8::cvt_pk_bf16(x[8 * s + 6], x[8 * s + 7]);
    return __builtin_bit_cast(bf16x8s, p);
}
__device__ __forceinline__ void attn_mfma(unsigned char* ws, LAS unsigned char* lds, int gw, int NGW, int lane, int wave) {
    const bf16* Kb = (const bf16*)(ws + WS_B1); const bf16* Vb = (const bf16*)(ws + WS_B2); const bf16* Qb = (const bf16*)(ws + WS_B3); bf16* Ob = (bf16*)(ws + WS_B0);
    LAS unsigned char* vl = lds + wave * AT_WAVE_LDS;
    const int r32 = lane & 31, hh = lane >> 5;
    bf16x8s tri[2];
#pragma unroll
    for (int s = 0; s < 2; ++s)
#pragma unroll
        for (int j = 0; j < 8; ++j) tri[s][j] = (16 * s + 8 * (j >> 2) + 4 * hh + (j & 3)) > r32 ? (short)0x3F80 : (short)0;
    const int grp = lane >> 4, tq = (lane & 15) >> 2, tp = lane & 3;
    const LAS unsigned char* vtr0 = vl + (4 * hh + tq) * AT_VP + (16 * (grp & 1) + 4 * tp) * 2;
    for (int unit = gw; unit < BATCH * NH * (SEQ / 32); unit += NGW) {
        const int qb = unit % (SEQ / 32), bh = unit / (SEQ / 32), b = bh / NH, hd = bh % NH;
        const int t0 = qb * 32; const size_t rowb = (size_t)b * SEQ;
        bf16x8s qf[4];
#pragma unroll
        for (int ks = 0; ks < 4; ++ks) qf[ks] = *(const GAS bf16x8s*)(Qb + (rowb + t0 + r32) * C + hd * HD + 16 * ks + 8 * hh);
        f32x16 o[2];
#pragma unroll
        for (int i = 0; i < 16; ++i) { o[0][i] = 0.f; o[1][i] = 0.f; }
        float carry = 0.f;
        for (int s0 = t0; s0 >= 0; s0 -= 32) {
            bf16x8s kf[4];
#pragma unroll
            for (int ks = 0; ks < 4; ++ks) kf[ks] = *(const GAS bf16x8s*)(Kb + (rowb + s0 + r32) * C + hd * HD + 16 * ks + 8 * hh);
            v4u vreg[4];
#pragma unroll
            for (int i = 0; i < 4; ++i) { const int cidx = lane + 64 * i; vreg[i] = *(const GAS v4u*)(Vb + (rowb + s0 + (cidx >> 3)) * C + hd * HD + (cidx & 7) * 8); }
            f32x16 st;
#pragma unroll
            for (int i = 0; i < 16; ++i) st[i] = 0.f;
#pragma unroll
            for (int ks = 0; ks < 4; ++ks) st = __builtin_amdgcn_mfma_f32_32x32x16_bf16(kf[ks], qf[ks], st, 0, 0, 0);
#pragma unroll
            for (int i = 0; i < 4; ++i) { const int cidx = lane + 64 * i; *(LAS v4u*)(vl + (cidx >> 3) * AT_VP + (cidx & 7) * 16) = vreg[i]; }
            f32x16 zz, uu; float tot = 0.f; const int tq_ = t0 + r32;
            if (s0 + 31 < t0) {
#pragma unroll
                for (int i = 0; i < 16; ++i) { const float z = st[i] * 0.18033688011112042f; const float sp = fmaxf(z, 0.f) + __builtin_amdgcn_logf(1.0f + __builtin_amdgcn_exp2f(-fabsf(z)));
                    zz[i] = z - sp; uu[i] = sp; tot += sp; }
            } else {
#pragma unroll
                for (int i = 0; i < 16; ++i) { const int key = s0 + crow32(i, hh); const float z = st[i] * 0.18033688011112042f; const float sp = fmaxf(z, 0.f) + __builtin_amdgcn_logf(1.0f + __builtin_amdgcn_exp2f(-fabsf(z)));
                    const bool valid = key < tq_; zz[i] = valid ? z - sp : -1e30f; uu[i] = valid ? sp : 0.f; tot += uu[i]; }
            }
            f32x16 w;
#pragma unroll
            for (int i = 0; i < 16; ++i) w[i] = 0.f;
#pragma unroll
            for (int s = 0; s < 2; ++s) w = __builtin_amdgcn_mfma_f32_32x32x16_bf16(tri[s], pack_step(uu, s), w, 0, 0, 0);
            f32x16 pp;
#pragma unroll
            for (int i = 0; i < 16; ++i) pp[i] = __builtin_amdgcn_exp2f(zz[i] - w[i] - carry);
            tot += shx(tot, 32, lane); carry += tot;
            asm volatile("s_waitcnt lgkmcnt(0)" ::: "memory");
#pragma unroll
            for (int s = 0; s < 2; ++s) { const bf16x8s pa = pack_step(pp, s);
#pragma unroll
                for (int dt = 0; dt < 2; ++dt) {
                    const v4i16_t lo = __builtin_amdgcn_ds_read_tr16_b64_v4i16((LAS v4i16_t*)(vtr0 + (16 * s) * AT_VP + dt * 64));
                    const v4i16_t hi = __builtin_amdgcn_ds_read_tr16_b64_v4i16((LAS v4i16_t*)(vtr0 + (16 * s + 8) * AT_VP + dt * 64));
                    const bf16x8s vf = (bf16x8s){lo[0], lo[1], lo[2], lo[3], hi[0], hi[1], hi[2], hi[3]};
                    o[dt] = __builtin_amdgcn_mfma_f32_32x32x16_bf16(pa, vf, o[dt], 0, 0, 0); } }
            asm volatile("" ::: "memory");
            if (s0 < t0 && __all(carry > SB_EXIT * 1.4426950408889634f)) break;
        }
#pragma unroll
        for (int dt = 0; dt < 2; ++dt)
#pragma unroll
            for (int i = 0; i < 16; ++i) Ob[(rowb + t0 + crow32(i, hh)) * C + hd * HD + 32 * dt + r32] = (bf16)f2bf(o[dt][i]);
    }
}
__global__ void __launch_bounds__(NWAVES * 64, 2) yoco_fwd(Args args) {
    extern __shared__ __attribute__((aligned(16))) unsigned char lds_raw[];
    LAS unsigned char* lds = (LAS unsigned char*)lds_raw;
    const int G = gridDim.x; const int bx = blockIdx.x;
    int wave = __builtin_amdgcn_readfirstlane(threadIdx.x >> 6); asm volatile("" : "+s"(wave));
#define IDS() int lane; asm volatile("v_mbcnt_lo_u32_b32 %0, -1, 0\n\tv_mbcnt_hi_u32_b32 %0, -1, %0" : "=v"(lane)); const int tid = wave * 64 + lane; (void)tid; \
    const int vcu = (G % 8 == 0) ? (bx % 8) * (G / 8) + bx / 8 : bx; const int gw = vcu * NWAVES + wave, NGW = G * NWAVES; (void)lane; (void)gw; (void)NGW;
    unsigned char* ws = WSP();
    volatile LAS unsigned* MISC = (volatile LAS unsigned*)(lds + MISC_OFF);
    volatile LAS int* tab = (volatile LAS int*)(lds + MOE_TAB_OFF);
    for (int u = threadIdx.x; u < (LDS_BYTES - LDSCTL_OFF) / 4; u += NWAVES * 64) ((LAS unsigned*)(lds + LDSCTL_OFF))[u] = 0u;
    __syncthreads();
    XcdBarrier bar; bar.bar = (unsigned*)(ws + WS_CTL) + CW_BAR; bar.x = 0; bar.st = nullptr;
    if (N_LAUNCHES == 1) bar = xcd_barrier_post((unsigned*)(ws + WS_CTL) + CW_BAR, MISC + 8);
    const int lo = KA_INT(0), hi = KA_INT(1);
#ifndef PROBE_PH
#define PROBE_PH -1
#endif
#define IN(k) (lo <= (k) && (k) < hi)
#define REP(k) for (int rep_ = 0; rep_ < ((PROBE_PH == (k)) ? 2 : 1); ++rep_)
#define SEAM(k) do { if (IN(k) && IN((k) + 1)) xcd_barrier(bar); } while (0)

    if (IN(PH_P0)) REP(PH_P0) { IDS(); p0_weights<0>(ws, lds, gw, NGW, wave, lane); p0_weights<1>(ws, lds, gw, NGW, wave, lane); if (G <= 64) p0_weights<2>(ws, lds, gw, NGW, wave, lane); p0_rows(ws, gw, NGW, lane); }
    SEAM(PH_P0);
    if (PROBE_PH == 100 && N_LAUNCHES == 1) { for (int i_ = 0; i_ < 10; ++i_) xcd_barrier(bar); }
    if (IN(PH_LORA)) REP(PH_LORA) {
        SchedGrouped<1, 3> S{(const char*)(ws + WS_B1), (size_t)(WS_B2 - WS_B1), nullptr, (const char*)(ws + WS_WT_LORA), (size_t)256 * C * 2, G, bx};
        EpiLora E{(bf16*)(ws + WS_LW)};
        pg8::gemm_phase<EpiLora, SchedGrouped<1, 3>, true, false, C>(lds, S, E, wave);
    }
    SEAM(PH_LORA);
    if (IN(PH_RKV)) REP(PH_RKV) {
        SchedGrouped<4, 3> S{(const char*)OUTP(), (size_t)M * C * 2, (const char*)(ws + WS_B4), (const char*)(ws + WS_WT_RKV), (size_t)C * C * 2, G, bx};
        EpiSplit3 E{(bf16*)(ws + WS_B1), false, nullptr};
        pg8::gemm_phase<EpiSplit3, SchedGrouped<4, 3>, true, false, C>(lds, S, E, wave);
    }
    SEAM(PH_RKV);
    if (IN(PH_S1)) REP(PH_S1) { IDS(); scan_s1(ws, lds, lane, wave); }
    SEAM(PH_S1);
    if (IN(PH_S2)) REP(PH_S2) { IDS();
        if (bx < BATCH * NH || G <= BATCH * NH) scan_s2(ws, lds, lane, wave);
        }
    SEAM(PH_S2);
    if (IN(PH_S3)) REP(PH_S3) { IDS(); scan_s3(ws, lds, lane, wave); }
    SEAM(PH_S3);
#if MK_DEBUG
    if (IN(PH_DBG0)) { IDS(); scan_naive(ws, lds, tid); }
    SEAM(PH_DBG0);
    if (IN(PH_DBG0 + 1)) { IDS(); post_scan(ws, gw, NGW, lane); }
    SEAM(PH_DBG0 + 1);
    if (IN(PH_DBG0 + 2)) { IDS(); dbg_compare(ws, (const bf16*)(ws + WS_B0), (const bf16*)(ws + WS_B4), gw, NGW, lane); }
    SEAM(PH_DBG0 + 2);
#endif
    if (IN(PH_WOUT)) REP(PH_WOUT) {
        SchedGrouped<4, 1> S{(const char*)(ws + ((MK_DEBUG && DBG_USE_NAIVE) ? WS_B4 : WS_B0)), 0, nullptr, (const char*)(ws + WS_WT_OUT), 0, G, bx};
        EpiResidBf<true> E{INP(0), (bf16*)(ws + WS_B4)};
        pg8::gemm_phase<EpiResidBf<true>, SchedGrouped<4, 1>, true, false, C>(lds, S, E, wave);
    }
    SEAM(PH_WOUT);
#pragma unroll 1
    for (int layer = 0; layer < 2; ++layer) {
        const int pb = layer == 0 ? (int)PH_ROUT0 : (int)PH_ROUT1;
        if (IN(pb)) { IDS(); if (PROBE_PH == 101 && layer == 0) router_rows(ws, lds, layer, gw, NGW, lane, tid, wave, true); router_rows(ws, lds, layer, gw, NGW, lane, tid, wave); }
        SEAM(pb);
        if (IN(pb + 1)) REP(pb + 1) {
            { IDS(); moe_table(ws, tab, layer, tid); }
            SchedMoe<2, C, true> S{(const char*)(ws + WS_B4), (const char*)(ws + WS_WT_GU) + (size_t)layer * 16 * 512 * C * 2, (size_t)512 * C * 2, (const unsigned*)(ws + WS_LIST), tab, G, bx};
            EpiGU E{(bf16*)(ws + WS_HID), (const float*)(ws + WS_WL), (const float*)(ws + WS_B0)};
            pg8::gemm_phase<EpiGU, SchedMoe<2, C, true>, true, true, C>(lds, S, E, wave);
            if (layer == 0 && G > 64) { const int nr2 = __builtin_amdgcn_readfirstlane(tab[48]) * 2 - G, first = nr2 > 0 ? nr2 : 0;
                if (bx >= first) { IDS(); p0_weights<2>(ws, lds, (bx - first) * NWAVES + wave, (G - first) * NWAVES, wave, lane); } }
        }
        SEAM(pb + 1);
        if (IN(pb + 2)) REP(pb + 2) {
            { IDS(); moe_table(ws, tab, layer, tid); }
            SchedMoe<4, FE, false> S{(const char*)(ws + WS_HID), (const char*)(ws + WS_WT_DN) + (size_t)layer * 16 * C * FE * 2, (size_t)C * FE * 2, (const unsigned*)(ws + WS_LIST), tab, G, bx};
            EpiDown E{(bf16*)(ws + WS_B2), (const unsigned*)(ws + WS_LIST)};
            pg8::gemm_phase<EpiDown, SchedMoe<4, FE, false>, true, false, FE>(lds, S, E, wave);
        }
        SEAM(pb + 2);
        if (layer == 0) {
            if (IN(PH_COMB)) { IDS(); if (PROBE_PH == 102) combine_rows(ws, 0, gw, NGW, lane, true); combine_rows(ws, 0, gw, NGW, lane); }
            SEAM(PH_COMB);
            if (IN(PH_KVQ)) REP(PH_KVQ) {
                SchedGrouped<12, 1> S{(const char*)(ws + WS_B4), 0, nullptr, (const char*)(ws + WS_WT_KVQ), 0, G, bx};
                EpiSplit3 E{(bf16*)(ws + WS_B1), true, (const float*)(ws + WS_B0)};
                pg8::gemm_phase<EpiSplit3, SchedGrouped<12, 1>, true, false, C>(lds, S, E, wave);
            }
            SEAM(PH_KVQ);
            if (IN(PH_ATTN)) REP(PH_ATTN) { IDS(); attn_mfma(ws, lds, gw, NGW, lane, wave); }
            SEAM(PH_ATTN);
            if (IN(PH_SBO)) {
                SchedGrouped<4, 1> S{(const char*)(ws + WS_B0), 0, nullptr, (const char*)(ws + WS_WT_SBO), 0, G, bx};
                EpiResidBf<false> E{(const void*)(ws + WS_B4), (bf16*)(ws + WS_B4)};
                pg8::gemm_phase<EpiResidBf<false>, SchedGrouped<4, 1>, true, false, C>(lds, S, E, wave);
            }
            SEAM(PH_SBO);
        }
    }
    if (IN(PH_FINAL)) { IDS(); combine_rows(ws, 1, gw, NGW, lane); }
#undef IN
#undef SEAM
}

extern "C" void kernel_launch(void* const* d_in, const int* in_sizes, int n_in, void* d_out, int out_size, void* d_ws, size_t ws_size, hipStream_t stream) {
    static int grid = 0;
    if (grid == 0) {
        if (n_in != 31 || in_sizes[0] != M * C || out_size != M * C || ws_size < WS_END) { fprintf(stderr, "kernel_launch: unexpected shapes (n_in %d, in0 %d, out %d, ws %zu); nothing launched\n", n_in, n_in > 0 ? in_sizes[0] : -1, out_size, ws_size); grid = -1; return; }
        int dev = 0, cus = 0, per_cu = 0;
        if (hipGetDevice(&dev) != hipSuccess || hipDeviceGetAttribute(&cus, hipDeviceAttributeMultiprocessorCount, dev) != hipSuccess) { grid = -1; return; }
        if (hipFuncSetAttribute((const void*)yoco_fwd, hipFuncAttributeMaxDynamicSharedMemorySize, LDS_BYTES) != hipSuccess) { fprintf(stderr, "kernel_launch: hipFuncSetAttribute failed\n"); grid = -1; return; }
        if (hipOccupancyMaxActiveBlocksPerMultiprocessor(&per_cu, (const void*)yoco_fwd, NWAVES * 64, LDS_BYTES) != hipSuccess || per_cu < 1) fprintf(stderr, "kernel_launch: occupancy query reports %d\n", per_cu);
        (void)hipGetLastError();
        grid = cus - (cus % 16);
    }
    if (grid < 0) return;
    if (hipMemsetAsync((char*)d_ws + WS_CTL, 0, CTL_ZERO_BYTES, stream) != hipSuccess) return;
    Args a{};
    for (int i = 0; i < 31; ++i) a.in[i] = (const float*)d_in[i];
    a.out = (float*)d_out; a.ws = (unsigned char*)d_ws;
    for (int li = 0; li < (N_LAUNCHES == 1 ? 1 : (int)NPHASE); ++li) {
        a.ph_lo = (N_LAUNCHES == 1) ? 0 : li; a.ph_hi = (N_LAUNCHES == 1) ? NPHASE : li + 1; a.li = li;
        hipLaunchKernelGGL(yoco_fwd, dim3(grid), dim3(NWAVES * 64), LDS_BYTES, stream, a);
        const hipError_t le = hipPeekAtLastError();
        if (le != hipSuccess) { fprintf(stderr, "kernel_launch: launch %d failed: %s\n", li, hipGetErrorName(le)); break; }
    }
}
```

```cpp
#include <hip/hip_runtime.h>
#include <cstdio>
#include <cstdint>

#ifndef MK_N_LAUNCHES
#define MK_N_LAUNCHES 1
#endif

namespace pg8 {
#define PG8_LAS __attribute__((address_space(3)))
typedef unsigned short bf16_t;
typedef short bf16x8 __attribute__((ext_vector_type(8)));
typedef float f32x4 __attribute__((ext_vector_type(4)));
typedef unsigned u32x4 __attribute__((ext_vector_type(4)));
constexpr int BM = 256, BK = 64, HALF = 128, HTB = HALF * BK * 2, STAGE_BYTES = 8 * HTB, NXCD = 8, WGM = 8;

__host__ __device__ __forceinline__ int lds_byte(int r, int c) { const int st = (r >> 4) * 2 + (c >> 5), rr = r & 15, cc = c & 31, ob = rr * 64 + cc * 2; return st * 1024 + (ob ^ (((ob >> 9) & 1) << 5)); }
__host__ __device__ __forceinline__ void stage_rc(int b, int& R, int& C) { const int st = b / 1024, sb = b % 1024, swz = sb ^ (((sb >> 9) & 1) << 5); R = (st >> 1) * 16 + swz / 64; C = (st & 1) * 32 + (swz % 64) / 2; }
__host__ __device__ __forceinline__ int perm32(int rho) { const int n = rho >> 4, i = rho & 15; return 8 * (i >> 2) + 4 * n + (i & 3); }

struct Unit { int pm, pn, aux, r0, cnt; };

__host__ __device__ __forceinline__ void tile_map(int wgid, int nM, int nN, int& pm, int& pn) {
    const int nwg = nM * nN;
    { const int q = nwg / NXCD, r = nwg % NXCD, xcd = wgid % NXCD, off = wgid / NXCD; wgid = (xcd < r ? xcd * (q + 1) : r * (q + 1) + (xcd - r) * q) + off; }
    const int nig = WGM * nN, gid = wgid / nig, fm = gid * WGM, gsz = (nM - fm) < WGM ? (nM - fm) : WGM;
    pm = fm + ((wgid % nig) % gsz); pn = (wgid % nig) / gsz;
}

typedef float f32x2_t __attribute__((ext_vector_type(2))); typedef __bf16 bf16x2_t __attribute__((ext_vector_type(2)));
__device__ __forceinline__ unsigned cvt_pk_bf16(float lo, float hi) { const f32x2_t v = {lo, hi}; const bf16x2_t b = __builtin_convertvector(v, bf16x2_t); return __builtin_bit_cast(unsigned, b); }

template <class Epi, class Sched, bool ALIGN_EPI, bool GATHER, int K>
__device__ __forceinline__ void gemm_phase(PG8_LAS unsigned char* lds, const Sched& S, const Epi& E, const int wid) {
    int lane_; asm volatile("v_mbcnt_lo_u32_b32 %0, -1, 0\n\tv_mbcnt_hi_u32_b32 %0, -1, %0" : "=v"(lane_));
    const int lane = lane_, tid = wid * 64 + lane, wr = wid >> 2, wc = wid & 3, fr = lane & 15, fq = lane >> 4;
    constexpr int nt = K / BK;
    unsigned voffA[2], voffB[2];
#pragma unroll
    for (int i = 0; i < 2; ++i) { int R, C; stage_rc(tid * 16 + i * 8192, R, C); const int Rb = Epi::PERM ? ((R & ~31) + perm32(R & 31)) : R;
        voffA[i] = (unsigned)(R * K + C) * 2u; voffB[i] = (unsigned)(Rb * K + C) * 2u; }
    constexpr size_t kstep = (size_t)(BK * 2);
    constexpr size_t hstep = (size_t)HALF * K * 2;
    const unsigned ldsw = (unsigned)wid * 1024u;
    const int aoff = lds_byte(wr * 64 + fr, fq * 8), boff = lds_byte(wc * 32 + fr, fq * 8);
#define PG8_SA(b, h) (((b) * 2 + (h)) * HTB)
#define PG8_SB(b, h) ((4 + (b) * 2 + (h)) * HTB)
#define PG8_STAGE(bufoff, gbase, voff) do { _Pragma("unroll") for (int _i = 0; _i < 2; ++_i) \
        __builtin_amdgcn_global_load_lds((const unsigned*)((const char*)(gbase) + (voff)[_i]), (PG8_LAS unsigned*)(lds + (bufoff) + ldsw + _i * 8192), 16, 0, 0); } while (0)
#define PG8_LDA(dst, b, h) do { _Pragma("unroll") for (int m = 0; m < 4; ++m) _Pragma("unroll") for (int k = 0; k < 2; ++k) dst[m][k] = *(const PG8_LAS bf16x8*)(lds + PG8_SA(b, h) + aoff + m * 2048 + k * 1024); } while (0)
#define PG8_LDB(dst, b, h) do { _Pragma("unroll") for (int n = 0; n < 2; ++n) _Pragma("unroll") for (int k = 0; k < 2; ++k) dst[n][k] = *(const PG8_LAS bf16x8*)(lds + PG8_SB(b, h) + boff + n * 2048 + k * 1024); } while (0)
#define PG8_MMA(ai, bj, At, Bt) do { __builtin_amdgcn_s_setprio(1); _Pragma("unroll") for (int m = 0; m < 4; ++m) _Pragma("unroll") for (int n = 0; n < 2; ++n) _Pragma("unroll") for (int k = 0; k < 2; ++k) \
        acc[ai][bj][m][n] = __builtin_amdgcn_mfma_f32_16x16x32_bf16(Bt[n][k], At[m][k], acc[ai][bj][m][n], 0, 0, 0); __builtin_amdgcn_s_setprio(0); } while (0)
#define PG8_WAIT_V(n) asm volatile("s_waitcnt vmcnt(" #n ")" ::: "memory")
#define PG8_WAIT_L(n) asm volatile("s_waitcnt lgkmcnt(" #n ")" ::: "memory")
#define PG8_BAR __builtin_amdgcn_s_barrier()
#define PG8_SCHED __builtin_amdgcn_sched_barrier(0)
    Unit cur, nxt; int ui = 0;
    if (!S.next(0, cur)) return;
    f32x4 acc[2][2][4][2];
#pragma unroll
    for (int a = 0; a < 2; ++a)
#pragma unroll
        for (int b = 0; b < 2; ++b)
#pragma unroll
            for (int m = 0; m < 4; ++m)
#pragma unroll
                for (int n = 0; n < 2; ++n) acc[a][b][m][n] = (f32x4){0.f, 0.f, 0.f, 0.f};
    bf16x8 At[4][2], B0[2][2], B1[2][2];
    unsigned vc[2][2];
#define PG8_GOFF(u) do { _Pragma("unroll") for (int _h = 0; _h < 2; ++_h) _Pragma("unroll") for (int _i = 0; _i < 2; ++_i) { int _R, _C; stage_rc(tid * 16 + _i * 8192, _R, _C); \
        vc[_h][_i] = S.a_row_off(u, _h * HALF + _R) + (unsigned)_C * 2u; } } while (0)
#define PG8_STAGE_A(bufoff, gbase, h) do { if constexpr (GATHER) { PG8_STAGE(bufoff, gbase, vc[h]); } else { PG8_STAGE(bufoff, (gbase) + (h) * hstep, voffA); } } while (0)
    if constexpr (GATHER) PG8_GOFF(cur);
    const char* cA = S.a_base(cur); const char* cB = S.b_base(cur);
    PG8_STAGE(PG8_SB(0, 0), cB, voffB); PG8_STAGE(PG8_SB(0, 1), cB + hstep, voffB); PG8_STAGE_A(PG8_SA(0, 0), cA, 0); PG8_STAGE_A(PG8_SA(0, 1), cA, 1);
    if (wr == 1) PG8_BAR;
    PG8_WAIT_V(2); PG8_BAR;
    PG8_STAGE(PG8_SB(1, 0), cB + kstep, voffB); PG8_STAGE_A(PG8_SA(1, 0), cA + kstep, 0); PG8_STAGE(PG8_SB(1, 1), cB + hstep + kstep, voffB);
    PG8_WAIT_V(6); PG8_BAR;
    for (;;) {
        const bool has_next = S.next(ui + 1, nxt);
        const char* nA = has_next ? S.a_base(nxt) : cA; const char* nB = has_next ? S.b_base(nxt) : cB;
        for (int t = 0; t < nt; t += 2) {
            const bool last = (t == nt - 2);
            const char* a1 = cA + (size_t)(t + 1) * kstep;
            const char* a2 = last ? nA : cA + (size_t)(t + 2) * kstep; const char* b2 = last ? nB : cB + (size_t)(t + 2) * kstep;
            const char* a3 = a2 + kstep; const char* b3 = b2 + kstep;
            PG8_LDB(B0, 0, 0); PG8_LDB(B1, 0, 1); PG8_SCHED; PG8_LDA(At, 0, 0); PG8_STAGE_A(PG8_SA(1, 1), a1, 1);
            if constexpr (GATHER) { if (last && has_next) PG8_GOFF(nxt); }
            PG8_WAIT_V(8); PG8_WAIT_L(0); PG8_BAR; PG8_MMA(0, 0, At, B0); PG8_MMA(0, 1, At, B1); PG8_BAR; PG8_SCHED;
            PG8_LDA(At, 0, 1); PG8_STAGE(PG8_SB(0, 0), b2, voffB); PG8_STAGE(PG8_SB(0, 1), b2 + hstep, voffB); PG8_STAGE_A(PG8_SA(0, 0), a2, 0);
            PG8_WAIT_V(8); PG8_WAIT_L(0); PG8_BAR; PG8_MMA(1, 0, At, B0); PG8_MMA(1, 1, At, B1); PG8_BAR; PG8_SCHED;
            PG8_LDB(B0, 1, 0); PG8_LDB(B1, 1, 1); PG8_SCHED; PG8_LDA(At, 1, 0); PG8_STAGE_A(PG8_SA(0, 1), a2, 1);
            PG8_WAIT_V(8); PG8_WAIT_L(0); PG8_BAR; PG8_MMA(0, 0, At, B0); PG8_MMA(0, 1, At, B1); PG8_BAR; PG8_SCHED;
            PG8_LDA(At, 1, 1); PG8_STAGE(PG8_SB(1, 0), b3, voffB); PG8_STAGE(PG8_SB(1, 1), b3 + hstep, voffB); PG8_STAGE_A(PG8_SA(1, 0), a3, 0);
            PG8_WAIT_V(8); PG8_WAIT_L(0); PG8_BAR; PG8_MMA(1, 0, At, B0); PG8_MMA(1, 1, At, B1); PG8_BAR; PG8_SCHED;
        }
        if constexpr (ALIGN_EPI) { if (wr == 0) PG8_BAR; }
        E(acc, cur, wr, wc, fr, fq);
        if (!has_next) break;
#pragma unroll
        for (int a = 0; a < 2; ++a)
#pragma unroll
            for (int b = 0; b < 2; ++b)
#pragma unroll
                for (int m = 0; m < 4; ++m)
#pragma unroll
                    for (int n = 0; n < 2; ++n) acc[a][b][m][n] = (f32x4){0.f, 0.f, 0.f, 0.f};
        cur = nxt; cA = nA; cB = nB; ++ui;
        if constexpr (ALIGN_EPI) { if (wr == 1) PG8_BAR; }
    }
    PG8_WAIT_V(0);
    if constexpr (!ALIGN_EPI) { if (wr == 0) PG8_BAR; }
    PG8_BAR;
#undef PG8_SA
#undef PG8_SB
#undef PG8_STAGE
#undef PG8_STAGE_A
#undef PG8_GOFF
#undef PG8_LDA
#undef PG8_LDB
#undef PG8_MMA
#undef PG8_WAIT_V
#undef PG8_WAIT_L
#undef PG8_BAR
#undef PG8_SCHED
}
}

constexpr int NWAVES = 8;
#ifndef MK_DEBUG
#define MK_DEBUG 0
#endif
#ifndef DBG_USE_NAIVE
#define DBG_USE_NAIVE 0
#endif
constexpr int DBGP = MK_DEBUG ? 3 : 0;
enum Phase { PH_P0 = 0, PH_LORA, PH_RKV, PH_S1, PH_S2, PH_S3, PH_DBG0, PH_WOUT = PH_DBG0 + DBGP, PH_ROUT0, PH_GU0, PH_DN0, PH_COMB, PH_KVQ, PH_ATTN, PH_SBO, PH_ROUT1, PH_GU1, PH_DN1, PH_FINAL, NPHASE };
constexpr int N_LAUNCHES = MK_N_LAUNCHES;


constexpr int BATCH = 2, SEQ = 8192, C = 1024, NH = 16, HD = 64, M = BATCH * SEQ;
constexpr int NE = 16, FE = 256, DW = 64, DA = 64, DG = 160;
constexpr float RMS_EPS = 1e-6f, GN_EPS = 64e-5f;
constexpr float SB_EXIT = 104.0f;

constexpr size_t MiB = 1u << 20;
constexpr size_t WS_CTL = 0, CTL_ZERO_BYTES = 64 * 1024;
constexpr size_t WS_WT_W2 = 128 * 1024, WS_WT_A2 = 256 * 1024, WS_WT_G2 = 384 * 1024;
constexpr size_t WS_WT_RKV = 1 * MiB;
constexpr size_t WS_WT_LORA = 7 * MiB;
constexpr size_t WS_WT_OUT = 9 * MiB;
constexpr size_t WS_WT_KVQ = 11 * MiB;
constexpr size_t WS_WT_SBO = 17 * MiB;
constexpr size_t WS_WT_GU = 19 * MiB;
constexpr size_t WS_WT_DN = 51 * MiB;
constexpr size_t WS_LW = 67 * MiB;
constexpr size_t WS_LA = 69 * MiB;
constexpr size_t WS_LG = 71 * MiB;
static_assert(WS_LA == WS_LW + 2 * MiB && WS_LG == WS_LW + 4 * MiB, "EpiLora's pointer arithmetic");
constexpr size_t WS_LIST = 76 * MiB;
constexpr size_t WS_WL = 77 * MiB;
constexpr size_t WS_HID = 78 * MiB;
constexpr size_t WS_B0 = 96 * MiB, WS_B1 = 128 * MiB, WS_B2 = 160 * MiB, WS_B3 = 192 * MiB, WS_B4 = 224 * MiB, WS_END = 256 * MiB;
static_assert(WS_HID + (size_t)144 * 256 * 256 * 2 <= WS_B0, "HID vs B0");
constexpr int CW_TMO = 0;
constexpr int CW_CNT = 1024;
constexpr int CW_BAR = 4096;

constexpr int RING_BYTES = 131072;
constexpr int LDSCTL_OFF = 146688, MISC_OFF = LDSCTL_OFF + 320, MOE_TAB_OFF = MISC_OFF + 128;
constexpr int LDS_BYTES = 147456;
static_assert(MOE_TAB_OFF + 256 <= LDS_BYTES, "LDS map");
static_assert(BATCH * NH * (SEQ / 64) % 16 == 0, "scan units");

#define GAS __attribute__((address_space(1)))
#define LAS __attribute__((address_space(3)))
typedef unsigned short bf16;
typedef unsigned v4u __attribute__((ext_vector_type(4)));
typedef unsigned v2u __attribute__((ext_vector_type(2)));
typedef float f32x4 __attribute__((ext_vector_type(4)));
typedef GAS unsigned gu32;
#define RLX_AGENT __ATOMIC_RELAXED, __HIP_MEMORY_SCOPE_AGENT
#define LDS_WAIT() asm volatile("s_waitcnt lgkmcnt(0)" ::: "memory")
#define VM_WAIT() asm volatile("s_waitcnt vmcnt(0)" ::: "memory")
__device__ __forceinline__ unsigned f2bf(float f) { unsigned u = __builtin_bit_cast(unsigned, f); return (u + 0x7fffu + ((u >> 16) & 1u)) >> 16; }
__device__ __forceinline__ unsigned pk2(float lo, float hi) { return f2bf(lo) | (f2bf(hi) << 16); }
__device__ __forceinline__ float bflo(unsigned u) { return __uint_as_float(u << 16); }
__device__ __forceinline__ float bfhi(unsigned u) { return __uint_as_float(u & 0xffff0000u); }
__device__ __forceinline__ float bf2f(bf16 b) { return __uint_as_float((unsigned)b << 16); }
__device__ __forceinline__ float sigmoidf_(float x) { return 1.0f / (1.0f + __expf(-x)); }

#define XB_TMO      128
#define XB_XCNT(j)  (256  + 64 * (j))
#define XB_XSUB(j)  (1280 + 64 * (j))
#define XB_XGEN(j)  (2304 + 64 * (j))
#define XB_TOP      3328
#define XB_TOPGEN   3392
#define XCD_BAR_WORDS 3456
#define XB_SPIN_CAP (1u << 18)
__device__ __forceinline__ unsigned xb_ld(unsigned* p)              { return __hip_atomic_load(p, __ATOMIC_RELAXED, __HIP_MEMORY_SCOPE_AGENT); }
__device__ __forceinline__ unsigned xb_add(unsigned* p, unsigned v) { return __hip_atomic_fetch_add(p, v, __ATOMIC_RELAXED, __HIP_MEMORY_SCOPE_AGENT); }
__device__ __forceinline__ unsigned xb_xcc_id() { return (unsigned)__builtin_amdgcn_s_getreg((3 << 11) | 20) & 0xFu; }
#define XB_SPIN(cond, bar) do { unsigned _sp = 0; while (cond) { __builtin_amdgcn_s_sleep(1); \
    if ((++_sp & 255u) == 0u) { if (xb_ld(&(bar)[XB_TMO])) break; if (_sp > XB_SPIN_CAP) { atomicAdd(&(bar)[XB_TMO], 1u); break; } } } } while (0)
struct XcdBarrier { unsigned* bar; unsigned x; volatile LAS unsigned* st; };
__device__ __forceinline__ XcdBarrier xcd_barrier_post(unsigned* bar, volatile LAS unsigned* st) {
    XcdBarrier b; b.bar = bar; b.x = xb_xcc_id(); b.st = st;
    if (threadIdx.x == 0) (void)xb_add(&bar[XB_XCNT(b.x)], 1u);
    return b;
}
__device__ __forceinline__ void xcd_barrier_complete(unsigned* bar, unsigned x, unsigned& nloc, unsigned& nx) {
    const unsigned G = gridDim.x * gridDim.y * gridDim.z;
    unsigned sum, cnt, mine, sp = 0u;
    for (;;) {
        sum = 0u; cnt = 0u; mine = 0u;
#pragma unroll
        for (unsigned j = 0; j < 16; ++j) { const unsigned c = xb_ld(&bar[XB_XCNT(j)]); sum += c; cnt += (c > 0u) ? 1u : 0u; mine = (j == x) ? c : mine; }
        if (sum == G) break;
        __builtin_amdgcn_s_sleep(1);
        if ((++sp & 255u) == 0u) { if (xb_ld(&bar[XB_TMO])) break; if (sp > XB_SPIN_CAP) { atomicAdd(&bar[XB_TMO], 1u); break; } }
    }
    nloc = mine > 0u ? mine : 1u; nx = cnt > 0u ? cnt : 1u;
}
__device__ __forceinline__ void xcd_barrier(const XcdBarrier& b) {
    asm volatile("s_waitcnt vmcnt(0)" ::: "memory");
    __syncthreads();
    if (threadIdx.x == 0) {
        unsigned* bar = b.bar;
        __builtin_amdgcn_s_waitcnt(0);
        unsigned nloc = b.st[0], nx = b.st[1];
        if (nloc == 0u) { xcd_barrier_complete(bar, b.x, nloc, nx); b.st[0] = nloc; b.st[1] = nx; }
        const unsigned old = xb_add(&bar[XB_XSUB(b.x)], 1u);
        const unsigned gen = old / nloc;
        if (old + 1u == (gen + 1u) * nloc) {
            __builtin_amdgcn_fence(__ATOMIC_RELEASE, "agent");
            asm volatile("s_waitcnt vmcnt(0)" ::: "memory");
            const unsigned og = xb_add(&bar[XB_TOP], 1u);
            const unsigned tg = og / nx;
            if (og + 1u == (tg + 1u) * nx) xb_add(&bar[XB_TOPGEN], 1u);
            else XB_SPIN(xb_ld(&bar[XB_TOPGEN]) == tg, bar);
            __builtin_amdgcn_fence(__ATOMIC_ACQUIRE, "agent");
            xb_add(&bar[XB_XGEN(b.x)], 1u);
            asm volatile("s_waitcnt vmcnt(0)" ::: "memory");
        } else {
            XB_SPIN(xb_ld(&bar[XB_XGEN(b.x)]) == gen, bar);
            __builtin_amdgcn_fence(__ATOMIC_ACQUIRE, "agent");
            asm volatile("s_waitcnt vmcnt(0)" ::: "memory");
        }
    }
    __syncthreads();
}

__device__ __forceinline__ float shx(float v, int o, int lane) { return __int_as_float(__builtin_amdgcn_ds_bpermute((lane ^ o) << 2, __float_as_int(v))); }
#define DPP_ADD(v, ctrl) ((v) + __int_as_float(__builtin_amdgcn_update_dpp(0, __float_as_int(v), (ctrl), 0xf, 0xf, true)))
__device__ __forceinline__ float wave_sum(float v, int lane) {
    (void)lane;
    v = DPP_ADD(v, 0x128); v = DPP_ADD(v, 0x124); v = DPP_ADD(v, 0x122); v = DPP_ADD(v, 0x121);
    const int iv = __float_as_int(v);
    return (__int_as_float(__builtin_amdgcn_readlane(iv, 0)) + __int_as_float(__builtin_amdgcn_readlane(iv, 16))) + (__int_as_float(__builtin_amdgcn_readlane(iv, 32)) + __int_as_float(__builtin_amdgcn_readlane(iv, 48)));
}
__device__ __forceinline__ float sum8(float v) { v = DPP_ADD(v, 0xB1); v = DPP_ADD(v, 0x4E); v = DPP_ADD(v, 0x141); return v; }
__device__ __forceinline__ void transpose_item(const float* W, int ldw, int k0, int n0, bf16* WT, int ldk, int dst_row0, const float* kscale, LAS float* scr, int lane, int kmax = 1 << 30) {
    const int r8 = lane >> 3, quad = lane & 7;
    f32x4 v[8];
#pragma unroll
    for (int i = 0; i < 8; ++i) { const int kk = r8 + 8 * i; v[i] = (k0 + kk < kmax) ? *(const GAS f32x4*)(W + (size_t)(k0 + kk) * ldw + n0 + quad * 4) : (f32x4){0.f, 0.f, 0.f, 0.f}; }
#pragma unroll
    for (int i = 0; i < 8; ++i) { const int kk = r8 + 8 * i; if (kscale) v[i] = v[i] * kscale[(k0 + kk < kmax) ? k0 + kk : 0]; *(LAS f32x4*)(scr + kk * 36 + ((quad ^ i) << 2)) = v[i]; }
    LDS_WAIT(); asm volatile("" ::: "memory");
    const int c = lane & 7;
#pragma unroll
    for (int j = 0; j < 4; ++j) { const int n = (lane >> 3) + 8 * j; const LAS float* sp = scr + (8 * c) * 36 + ((((n >> 2) ^ c) << 2) | (n & 3));
        v4u o; o.x = pk2(sp[0 * 36], sp[1 * 36]); o.y = pk2(sp[2 * 36], sp[3 * 36]); o.z = pk2(sp[4 * 36], sp[5 * 36]); o.w = pk2(sp[6 * 36], sp[7 * 36]);
        if (k0 + 8 * c < kmax) *(GAS v4u*)(WT + (size_t)(dst_row0 + n) * ldk + k0 + 8 * c) = o; }
    LDS_WAIT(); asm volatile("" ::: "memory");
}

struct Args { const float* in[31]; float* out; unsigned char* ws; int ph_lo, ph_hi, li, pad; };
typedef const __attribute__((address_space(4))) unsigned char* kaptr_t;
__device__ __forceinline__ kaptr_t ka_base() { kaptr_t p = (kaptr_t)__builtin_amdgcn_kernarg_segment_ptr(); asm volatile("" : "+s"(p)); return p; }
#define INP(k) (*(const float* const __attribute__((address_space(4)))*)(ka_base() + 8 * (k)))
#define OUTP() (*(float* const __attribute__((address_space(4)))*)(ka_base() + 8 * 31))
#define WSP() (*(unsigned char* const __attribute__((address_space(4)))*)(ka_base() + 8 * 32))
#define KA_INT(i) (*(const int __attribute__((address_space(4)))*)(ka_base() + 8 * 33 + 4 * (i)))

template <int PART> __device__ __forceinline__ void p0_weights(unsigned char* ws, LAS unsigned char* lds, int gw, int NGW, int wave, int lane) {
    LAS float* scr = (LAS float*)(lds + wave * 16384);
    bf16* WT_RKV = (bf16*)(ws + WS_WT_RKV); bf16* WT_LORA = (bf16*)(ws + WS_WT_LORA); bf16* WT_OUT = (bf16*)(ws + WS_WT_OUT); bf16* WT_KVQ = (bf16*)(ws + WS_WT_KVQ);
    bf16* WT_SBO = (bf16*)(ws + WS_WT_SBO); bf16* WT_GU = (bf16*)(ws + WS_WT_GU); bf16* WT_DN = (bf16*)(ws + WS_WT_DN);
    constexpr int I_UP = 32 + 32 + 96, I_RKV = 3 * 512, I_LORA = 32 + 32 + 80, I_OUT = 512, I_KV = 1024, I_Q = 512, I_SBO = 512, I_G = 32 * 128, I_U = 32 * 128, I_D = 32 * 128;
    constexpr int NDENSE = I_UP + I_RKV + I_LORA + I_OUT + I_KV + I_Q + I_SBO, NITEMS = NDENSE + I_G + I_U + I_D;
    constexpr int NLOOP = PART == 0 ? NDENSE : 3 * 2048; (void)NITEMS;
    for (int q_ = gw; q_ < NLOOP; q_ += NGW) {
        const int it = PART == 0 ? q_ : NDENSE + (q_ / 2048) * 4096 + 2048 * (PART - 1) + (q_ % 2048);
        int r = it;
        if (r < I_UP) {
            if (r < 32) transpose_item(INP(9), C, 0, 32 * r, (bf16*)(ws + WS_WT_W2), 64, 32 * r, nullptr, scr, lane);
            else if (r < 64) transpose_item(INP(12), C, 0, 32 * (r - 32), (bf16*)(ws + WS_WT_A2), 64, 32 * (r - 32), nullptr, scr, lane);
            else { const int q = r - 64, kb = q / 32, nb = q % 32; transpose_item(INP(14), C, 64 * kb, 32 * nb, (bf16*)(ws + WS_WT_G2), DG, 32 * nb, nullptr, scr, lane, DG); }
            continue; } r -= I_UP;
        if (r < I_RKV) { const int m = r / 512, q = r % 512, kb = q / 32, nb = q % 32; transpose_item(INP(6) + (size_t)m * C * C, C, 64 * kb, 32 * nb, WT_RKV, C, m * C + 32 * nb, nullptr, scr, lane); continue; } r -= I_RKV;
        if (r < I_LORA) {
            if (r < 32) { const int kb = r / 2, nb = r % 2; transpose_item(INP(8), DW, 64 * kb, 32 * nb, WT_LORA, C, 32 * nb, nullptr, scr, lane); }
            else if (r < 64) { const int q = r - 32, kb = q / 2, nb = q % 2; transpose_item(INP(11), DA, 64 * kb, 32 * nb, WT_LORA, C, 256 + 32 * nb, nullptr, scr, lane); }
            else { const int q = r - 64, kb = q / 5, nb = q % 5; transpose_item(INP(13), DG, 64 * kb, 32 * nb, WT_LORA, C, 512 + 32 * nb, nullptr, scr, lane); }
            continue; } r -= I_LORA;
        if (r < I_OUT) { const int kb = r / 32, nb = r % 32; transpose_item(INP(20), C, 64 * kb, 32 * nb, WT_OUT, C, 32 * nb, nullptr, scr, lane); continue; } r -= I_OUT;
        if (r < I_KV) { const int kb = r / 64, nb = r % 64; transpose_item(INP(21), 2 * C, 64 * kb, 32 * nb, WT_KVQ, C, 32 * nb, INP(3), scr, lane); continue; } r -= I_KV;
        if (r < I_Q) { const int kb = r / 32, nb = r % 32; transpose_item(INP(22), C, 64 * kb, 32 * nb, WT_KVQ, C, 2 * C + 32 * nb, INP(1) + C, scr, lane); continue; } r -= I_Q;
        if (r < I_SBO) { const int kb = r / 32, nb = r % 32; transpose_item(INP(23), C, 64 * kb, 32 * nb, WT_SBO, C, 32 * nb, nullptr, scr, lane); continue; } r -= I_SBO;
        if (r < I_G) { const int le = r / 128, q = r % 128, kb = q / 8, nb = q % 8, f0 = 32 * nb; transpose_item(INP(28) + (size_t)le * C * FE, FE, 64 * kb, f0, WT_GU + (size_t)le * 512 * C, C, 256 * (f0 / 128) + (f0 % 128), INP(2) + (le >> 4) * C, scr, lane); continue; } r -= I_G;
        if (r < I_U) { const int le = r / 128, q = r % 128, kb = q / 8, nb = q % 8, f0 = 32 * nb; transpose_item(INP(29) + (size_t)le * C * FE, FE, 64 * kb, f0, WT_GU + (size_t)le * 512 * C, C, 256 * (f0 / 128) + 128 + (f0 % 128), INP(2) + (le >> 4) * C, scr, lane); continue; } r -= I_U;
        { const int le = r / 128, q = r % 128, kb = q / 32, nb = q % 32; transpose_item(INP(30) + (size_t)le * FE * C, C, 64 * kb, 32 * nb, WT_DN + (size_t)le * C * FE, FE, 32 * nb, nullptr, scr, lane); }
    }
    if (PART == 0) for (int it = gw * 64 + lane; it < 768 * 128; it += NGW * 64) { const int row = it >> 7, ch = it & 127;
        const bool valid = (row < 64) || (row >= 256 && row < 320) || (row >= 512 && row < 672);
        if (!valid) *(GAS v4u*)(WT_LORA + (size_t)row * C + ch * 8) = (v4u){0u, 0u, 0u, 0u}; }
}
__device__ __forceinline__ void load_row(const float* p, int lane, f32x4 (&v)[4]) {
#pragma unroll
    for (int j = 0; j < 4; ++j) v[j] = ((const GAS f32x4*)p)[64 * j + lane];
}
__device__ __forceinline__ void load_row_bf(const bf16* p, int lane, f32x4 (&v)[4]) {
#pragma unroll
    for (int j = 0; j < 4; ++j) { const v2u w = ((const GAS v2u*)p)[64 * j + lane]; v[j] = (f32x4){bflo(w.x), bfhi(w.x), bflo(w.y), bfhi(w.y)}; }
}
__device__ __forceinline__ float row_rs(const f32x4 (&v)[4], int lane) {
    float s = 0.f;
#pragma unroll
    for (int j = 0; j < 4; ++j) s += (v[j].x * v[j].x + v[j].y * v[j].y) + (v[j].z * v[j].z + v[j].w * v[j].w);
    return 1.0f / sqrtf(wave_sum(s, lane) * (1.0f / C) + RMS_EPS);
}
__device__ __forceinline__ void store_row_bf16(bf16* p, int lane, const f32x4 (&v)[4]) {
#pragma unroll
    for (int j = 0; j < 4; ++j) { v2u o; o.x = pk2(v[j].x, v[j].y); o.y = pk2(v[j].z, v[j].w); ((GAS v2u*)p)[64 * j + lane] = o; }
}
__device__ __forceinline__ void p0_rows(unsigned char* ws, int gw, int NGW, int lane) {
    const float* x = INP(0); const float* gain = INP(1); const float* mix = INP(5);
    f32x4 g[4]; load_row(gain, lane, g);
    for (int run = gw; run < M / 8; run += NGW) {
        const int r0 = run * 8;
        f32x4 prev[4];
        if ((r0 % SEQ) == 0) {
#pragma unroll
            for (int j = 0; j < 4; ++j) prev[j] = (f32x4){0.f, 0.f, 0.f, 0.f};
        } else { load_row(x + (size_t)(r0 - 1) * C, lane, prev); const float rs = row_rs(prev, lane);
#pragma unroll
            for (int j = 0; j < 4; ++j) prev[j] = prev[j] * rs * g[j]; }
        for (int rr = 0; rr < 8; ++rr) {
            const int row = r0 + rr;
            f32x4 hn[4]; load_row(x + (size_t)row * C, lane, hn); const float rs = row_rs(hn, lane);
#pragma unroll
            for (int j = 0; j < 4; ++j) hn[j] = hn[j] * rs * g[j];
#pragma unroll
            for (int i = 0; i < 6; ++i) { f32x4 o[4];
#pragma unroll
                for (int j = 0; j < 4; ++j) { const f32x4 mx = ((const GAS f32x4*)(mix + i * C))[64 * j + lane]; o[j] = hn[j] + (prev[j] - hn[j]) * mx; }
                bf16* dst = i < 2 ? (bf16*)OUTP() + (size_t)i * M * C : (i == 2 ? (bf16*)(ws + WS_B4) : (bf16*)(ws + WS_B1) + (size_t)(i - 3) * M * C);
                store_row_bf16(dst + (size_t)row * C, lane, o); }
#pragma unroll
            for (int j = 0; j < 4; ++j) prev[j] = hn[j];
        }
    }
}

template <int NN, int NGROUPS> struct SchedGrouped {
    static constexpr int K = C;
    const char* A0; size_t astride; const char* A2; const char* B; size_t bgroup;
    int G, c;
    __device__ __forceinline__ bool next(int i, pg8::Unit& u) const {
        const int L = i * G + c; constexpr int per = 64 * NN; if (L >= per * NGROUPS) return false;
        const int g = L / per, w = L % per; pg8::tile_map(w, 64, NN, u.pm, u.pn); u.aux = g; u.r0 = 0; u.cnt = 0; return true; }
    __device__ __forceinline__ const char* a_base(const pg8::Unit& u) const { const char* A = (A2 != nullptr && u.aux == 2) ? A2 : A0 + (size_t)u.aux * astride; return A + (size_t)u.pm * 256 * K * 2; }
    __device__ __forceinline__ const char* b_base(const pg8::Unit& u) const { return B + (size_t)u.aux * bgroup + (size_t)u.pn * 256 * K * 2; }
    __device__ __forceinline__ unsigned a_row_off(const pg8::Unit&, int) const { return 0u; }
};
template <int NN, int K, bool GATHER> struct SchedMoe {
    const char* A; const char* B; size_t bexp; const unsigned* list; volatile LAS int* tab; int G, c;
    __device__ __forceinline__ bool next(int i, pg8::Unit& u) const {
        const int L = i * G + c; const int tot = __builtin_amdgcn_readfirstlane(tab[48]) * NN; if (L >= tot) return false;
        u.pm = L / NN; u.pn = L % NN; int e = 0;
#pragma unroll
        for (int j = 0; j < 16; ++j) e += (u.pm >= tab[32 + j]) ? 1 : 0;
        e = __builtin_amdgcn_readfirstlane(e);
        u.aux = e; u.r0 = (u.pm - __builtin_amdgcn_readfirstlane(tab[16 + e])) * 256; u.cnt = __builtin_amdgcn_readfirstlane(tab[e]); return true; }
    __device__ __forceinline__ const char* a_base(const pg8::Unit& u) const { return GATHER ? A : A + (size_t)u.pm * 256 * K * 2; }
    __device__ __forceinline__ const char* b_base(const pg8::Unit& u) const { return B + (size_t)u.aux * bexp + (size_t)u.pn * 256 * K * 2; }
    __device__ __forceinline__ unsigned a_row_off(const pg8::Unit& u, int r) const {
        const int idx = u.r0 + r; unsigned tok = 0u;
        if (idx < u.cnt) tok = list[(size_t)u.aux * M + idx] >> 1;
        return tok * (unsigned)(K * 2); }
};

using pg8::f32x4;
using pg8::Unit;
__device__ __forceinline__ v4u pack8(f32x4 v0, f32x4 v1) { v4u w; w.x = pg8::cvt_pk_bf16(v0[0], v0[1]); w.y = pg8::cvt_pk_bf16(v0[2], v0[3]); w.z = pg8::cvt_pk_bf16(v1[0], v1[1]); w.w = pg8::cvt_pk_bf16(v1[2], v1[3]); return w; }

struct EpiLora {
    static constexpr bool PERM = true;
    bf16* LW;
    __device__ __forceinline__ void operator()(const f32x4 (&acc)[2][2][4][2], const Unit& u, int wr, int wc, int fr, int fq) const {
        { int l_; asm volatile("v_mbcnt_lo_u32_b32 %0, -1, 0\n\tv_mbcnt_hi_u32_b32 %0, -1, %0" : "=v"(l_)); fr = l_ & 15; fq = l_ >> 4; }
        const int g = u.aux, width = g == 2 ? DG : DW; bf16* out = LW + (size_t)g * (1u << 20);
        const int row0 = u.pm * 256 + wr * 64 + fr;
#pragma unroll
        for (int bj = 0; bj < 2; ++bj) { const int col0 = bj * 128 + wc * 32 + 8 * fq; if (col0 < width) {
#pragma unroll
            for (int ai = 0; ai < 2; ++ai)
#pragma unroll
                for (int m = 0; m < 4; ++m) { f32x4 v0 = acc[ai][bj][m][0], v1 = acc[ai][bj][m][1];
                    if (g == 0) {
#pragma unroll
                        for (int q = 0; q < 4; ++q) { v0[q] = tanhf(v0[q]); v1[q] = tanhf(v1[q]); } }
                    else if (g == 2) {
#pragma unroll
                        for (int q = 0; q < 4; ++q) { v0[q] = sigmoidf_(v0[q]); v1[q] = sigmoidf_(v1[q]); } }
                    *(GAS v4u*)(out + (size_t)(row0 + ai * 128 + m * 16) * width + col0) = pack8(v0, v1); } } }
    }
};
struct EpiSplit3 {
    static constexpr bool PERM = true;
    bf16* O0; bool bycol; const float* rowscale;
    __device__ __forceinline__ void operator()(const f32x4 (&acc)[2][2][4][2], const Unit& u, int wr, int wc, int fr, int fq) const {
        { int l_; asm volatile("v_mbcnt_lo_u32_b32 %0, -1, 0\n\tv_mbcnt_hi_u32_b32 %0, -1, %0" : "=v"(l_)); fr = l_ & 15; fq = l_ >> 4; }
        const int g = bycol ? (u.pn >> 2) : u.aux, pn = bycol ? (u.pn & 3) : u.pn; bf16* out = O0 + (size_t)g * ((size_t)M * C);
        const int row0 = u.pm * 256 + wr * 64 + fr, col0 = pn * 256 + wc * 32 + 8 * fq;
#pragma unroll
        for (int ai = 0; ai < 2; ++ai)
#pragma unroll
            for (int m = 0; m < 4; ++m)
                { const float sc = rowscale ? rowscale[row0 + ai * 128 + m * 16] : 1.0f;
#pragma unroll
                for (int bj = 0; bj < 2; ++bj) *(GAS v4u*)(out + (size_t)(row0 + ai * 128 + m * 16) * C + col0 + bj * 128) = pack8(acc[ai][bj][m][0] * sc, acc[ai][bj][m][1] * sc); }
    }
};
template <bool BASE_F32> struct EpiResidBf {
    static constexpr bool PERM = true;
    const void* base; bf16* out;
    __device__ __forceinline__ void operator()(const f32x4 (&acc)[2][2][4][2], const Unit& u, int wr, int wc, int fr, int fq) const {
        { int l_; asm volatile("v_mbcnt_lo_u32_b32 %0, -1, 0\n\tv_mbcnt_hi_u32_b32 %0, -1, %0" : "=v"(l_)); fr = l_ & 15; fq = l_ >> 4; }
        const int row0 = u.pm * 256 + wr * 64 + fr, col0 = u.pn * 256 + wc * 32 + 8 * fq;
#pragma unroll
        for (int ai = 0; ai < 2; ++ai)
#pragma unroll
            for (int m = 0; m < 4; ++m) { const size_t off = (size_t)(row0 + ai * 128 + m * 16) * C + col0;
#pragma unroll
                for (int bj = 0; bj < 2; ++bj) { f32x4 b0, b1;
                    if (BASE_F32) { b0 = *(const GAS f32x4*)((const float*)base + off + bj * 128); b1 = *(const GAS f32x4*)((const float*)base + off + bj * 128 + 4); }
                    else { const v4u w = *(const GAS v4u*)((const bf16*)base + off + bj * 128); b0 = (f32x4){bflo(w.x), bfhi(w.x), bflo(w.y), bfhi(w.y)}; b1 = (f32x4){bflo(w.z), bfhi(w.z), bflo(w.w), bfhi(w.w)}; }
                    *(GAS v4u*)(out + off + bj * 128) = pack8(b0 + acc[ai][bj][m][0], b1 + acc[ai][bj][m][1]); }
                asm volatile("" ::: "memory"); }
    }
};
struct EpiGU {
    static constexpr bool PERM = true;
    bf16* HID; const float* wl; const float* rsl;
    __device__ __forceinline__ void operator()(const f32x4 (&acc)[2][2][4][2], const Unit& u, int wr, int wc, int fr, int fq) const {
        { int l_; asm volatile("v_mbcnt_lo_u32_b32 %0, -1, 0\n\tv_mbcnt_hi_u32_b32 %0, -1, %0" : "=v"(l_)); fr = l_ & 15; fq = l_ >> 4; }
        const int e = u.aux, cnt = u.cnt, base = u.r0, r0 = wr * 64 + fr, col0 = u.pn * 128 + wc * 32 + 8 * fq;
#pragma unroll
        for (int ai = 0; ai < 2; ++ai)
#pragma unroll
            for (int m = 0; m < 4; ++m) { const int r = r0 + ai * 128 + m * 16, idx = base + r; float w = 0.f, rs = 0.f; if (idx < cnt) { w = wl[(size_t)e * M + idx]; rs = rsl[(size_t)e * M + idx]; }
                f32x4 h0, h1;
#pragma unroll
                for (int q = 0; q < 4; ++q) { const float g0 = acc[ai][0][m][0][q] * rs, g1 = acc[ai][0][m][1][q] * rs;
                    h0[q] = g0 * sigmoidf_(g0) * (acc[ai][1][m][0][q] * rs) * w; h1[q] = g1 * sigmoidf_(g1) * (acc[ai][1][m][1][q] * rs) * w; }
                *(GAS v4u*)(HID + (size_t)(u.pm * 256 + r) * FE + col0) = pack8(h0, h1);
                asm volatile("" ::: "memory"); }
    }
};
struct EpiDown {
    static constexpr bool PERM = true;
    bf16* EO; const unsigned* list;
    __device__ __forceinline__ void operator()(const f32x4 (&acc)[2][2][4][2], const Unit& u, int wr, int wc, int fr, int fq) const {
        { int l_; asm volatile("v_mbcnt_lo_u32_b32 %0, -1, 0\n\tv_mbcnt_hi_u32_b32 %0, -1, %0" : "=v"(l_)); fr = l_ & 15; fq = l_ >> 4; }
        const int e = u.aux, cnt = u.cnt, base = u.r0, r0 = wr * 64 + fr, col0 = u.pn * 256 + wc * 32 + 8 * fq;
#pragma unroll
        for (int ai = 0; ai < 2; ++ai)
#pragma unroll
            for (int m = 0; m < 4; ++m) { const int idx = base + r0 + ai * 128 + m * 16;
                if (idx < cnt) { const unsigned ent = list[(size_t)e * M + idx]; bf16* o = EO + ((size_t)(ent & 1u) * M + (ent >> 1)) * C + col0;
#pragma unroll
                    for (int bj = 0; bj < 2; ++bj) *(GAS v4u*)(o + bj * 128) = pack8(acc[ai][bj][m][0], acc[ai][bj][m][1]); }
                asm volatile("" ::: "memory"); }
    }
};

typedef short bf16x8s __attribute__((ext_vector_type(8)));
typedef short bf16x4s __attribute__((ext_vector_type(4)));
typedef short v4i16_t __attribute__((ext_vector_type(4)));
constexpr int TPB = 144;
constexpr int TILE_B = 64 * TPB;
constexpr int FP = 68;
constexpr int CS_FA = 0, CS_FB = 16384, CS_TILES = 32768, CS_TOT = CS_TILES + 12 * TILE_B, CS_WL = CS_TOT + 2048, CS_PAR = CS_WL + 256;
static_assert(CS_PAR + 768 <= LDSCTL_OFF, "scan LDS map");
#define TILE(n) (lds + CS_TILES + (n) * TILE_B)
#define F4Z (f32x4){0.f, 0.f, 0.f, 0.f}
__device__ __forceinline__ bf16x8s ldfrag(const LAS unsigned char* tile, int row, int kcol) { return *(const LAS bf16x8s*)(tile + row * TPB + kcol * 2); }
__device__ __forceinline__ bf16x8s ldfrag_tr(const LAS unsigned char* tile, int n0, int k0, int lane) {
    const int g = lane >> 4, q = (lane & 15) >> 2, p = lane & 3;
    const LAS unsigned char* a = tile + (k0 + 8 * g + q) * TPB + (n0 + 4 * p) * 2;
    const v4i16_t lo = __builtin_amdgcn_ds_read_tr16_b64_v4i16((LAS v4i16_t*)a), hi = __builtin_amdgcn_ds_read_tr16_b64_v4i16((LAS v4i16_t*)(a + 4 * TPB));
    return (bf16x8s){lo[0], lo[1], lo[2], lo[3], hi[0], hi[1], hi[2], hi[3]};
}
__device__ __forceinline__ bf16x8s ldfrag_perm(const LAS unsigned char* tile, int row, int ks, int g) {
    const bf16x4s lo = *(const LAS bf16x4s*)(tile + row * TPB + (32 * ks + 4 * g) * 2), hi = *(const LAS bf16x4s*)(tile + row * TPB + (32 * ks + 16 + 4 * g) * 2);
    return (bf16x8s){lo[0], lo[1], lo[2], lo[3], hi[0], hi[1], hi[2], hi[3]};
}
__device__ __forceinline__ void lds_barrier() { asm volatile("s_waitcnt lgkmcnt(0)" ::: "memory"); __builtin_amdgcn_s_barrier(); asm volatile("" ::: "memory"); }
#define MFMA16(a, b, c) __builtin_amdgcn_mfma_f32_16x16x32_bf16((a), (b), (c), 0, 0, 0)
__device__ __forceinline__ void mm64(f32x4 (&acc)[2], const LAS unsigned char* At, const LAS unsigned char* Bt, int rt, int ch, int fr, int g) {
#pragma unroll
    for (int ks = 0; ks < 2; ++ks) { const bf16x8s a = ldfrag(At, 16 * rt + fr, 32 * ks + 8 * g);
#pragma unroll
        for (int ct = 0; ct < 2; ++ct) acc[ct] = MFMA16(a, ldfrag(Bt, 32 * ch + 16 * ct + fr, 32 * ks + 8 * g), acc[ct]); }
}
__device__ __forceinline__ void mm64_bt(f32x4 (&acc)[2], const LAS unsigned char* At, const LAS unsigned char* X, int rt, int ch, int fr, int g, int lane) {
#pragma unroll
    for (int ks = 0; ks < 2; ++ks) { const bf16x8s a = ldfrag(At, 16 * rt + fr, 32 * ks + 8 * g);
#pragma unroll
        for (int ct = 0; ct < 2; ++ct) acc[ct] = MFMA16(a, ldfrag_tr(X, 32 * ch + 16 * ct, 32 * ks, lane), acc[ct]); }
}
__device__ __forceinline__ void mm64_at(f32x4 (&acc)[2], const LAS unsigned char* Xa, const LAS unsigned char* Bt, int rt, int ch, int fr, int g, int lane) {
#pragma unroll
    for (int ks = 0; ks < 2; ++ks) { const bf16x8s a = ldfrag_tr(Xa, 16 * rt, 32 * ks, lane);
#pragma unroll
        for (int ct = 0; ct < 2; ++ct) acc[ct] = MFMA16(a, ldfrag(Bt, 32 * ch + 16 * ct + fr, 32 * ks + 8 * g), acc[ct]); }
}
__device__ __forceinline__ void mm64_att(f32x4 (&acc)[2], const LAS unsigned char* Xa, const LAS unsigned char* X, int rt, int ch, int lane) {
#pragma unroll
    for (int ks = 0; ks < 2; ++ks) { const bf16x8s a = ldfrag_tr(Xa, 16 * rt, 32 * ks, lane);
#pragma unroll
        for (int ct = 0; ct < 2; ++ct) acc[ct] = MFMA16(a, ldfrag_tr(X, 32 * ch + 16 * ct, 32 * ks, lane), acc[ct]); }
}
__device__ __forceinline__ bf16x4s pack4(f32x4 v) { v2u w; w.x = pg8::cvt_pk_bf16(v[0], v[1]); w.y = pg8::cvt_pk_bf16(v[2], v[3]); return __builtin_bit_cast(bf16x4s, w); }
__device__ __forceinline__ f32x4 unpack4(bf16x4s s) { const v2u w = __builtin_bit_cast(v2u, s); return (f32x4){bflo(w.x), bfhi(w.x), bflo(w.y), bfhi(w.y)}; }
__device__ __forceinline__ void st_tr(LAS unsigned char* Out, const f32x4 (&acc)[2], int rt, int ch, int fr, int g) {
#pragma unroll
    for (int ct = 0; ct < 2; ++ct) *(LAS bf16x4s*)(Out + (32 * ch + 16 * ct + fr) * TPB + (16 * rt + 4 * g) * 2) = pack4(acc[ct]);
}
__device__ __forceinline__ void ld_tr(f32x4 (&acc)[2], const LAS unsigned char* In, int rt, int ch, int fr, int g) {
#pragma unroll
    for (int ct = 0; ct < 2; ++ct) acc[ct] = unpack4(*(const LAS bf16x4s*)(In + (32 * ch + 16 * ct + fr) * TPB + (16 * rt + 4 * g) * 2));
}
__device__ __forceinline__ void unpack8(v4u w, float (&o)[8]) { o[0] = bflo(w.x); o[1] = bfhi(w.x); o[2] = bflo(w.y); o[3] = bfhi(w.y); o[4] = bflo(w.z); o[5] = bfhi(w.z); o[6] = bflo(w.w); o[7] = bfhi(w.w); }
__device__ __forceinline__ v4u pack8f(const float (&o)[8]) { v4u w; w.x = pg8::cvt_pk_bf16(o[0], o[1]); w.y = pg8::cvt_pk_bf16(o[2], o[3]); w.z = pg8::cvt_pk_bf16(o[4], o[5]); w.w = pg8::cvt_pk_bf16(o[6], o[7]); return w; }

struct FrontIn { v4u r, k, v; bf16x8s fw[2], fa[2]; };
__device__ __forceinline__ void front_fetch(FrontIn& f, unsigned char* ws, int unit, int tid, int lane, int wave) {
    const int h = unit & 15, c = (unit >> 4) & 127, b = unit >> 11; const size_t row0 = (size_t)b * SEQ + c * 64;
    const int rt = wave & 3, fr = lane & 15, g = lane >> 4, t = tid >> 3, cq = tid & 7, c0 = h * HD + cq * 8;
    const bf16* Rb = (const bf16*)(ws + WS_B1); const bf16* Kb = (const bf16*)(ws + WS_B2); const bf16* Vb = (const bf16*)(ws + WS_B3);
    const bf16* LW = (const bf16*)(ws + WS_LW); const bf16* LA = (const bf16*)(ws + WS_LA);
    f.r = *(const GAS v4u*)(Rb + (row0 + t) * C + c0); f.k = *(const GAS v4u*)(Kb + (row0 + t) * C + c0); f.v = *(const GAS v4u*)(Vb + (row0 + t) * C + c0);
#pragma unroll
    for (int ks = 0; ks < 2; ++ks) { f.fw[ks] = *(const GAS bf16x8s*)(LW + (row0 + 16 * rt + fr) * DW + 32 * ks + 8 * g); f.fa[ks] = *(const GAS bf16x8s*)(LA + (row0 + 16 * rt + fr) * DA + 32 * ks + 8 * g); }
}
__device__ __forceinline__ v4u head_consts(unsigned char* ws, LAS unsigned char* lds, int h, int tid, int wtile, int atile) {
    const bf16* W2T = (const bf16*)(ws + WS_WT_W2); const bf16* A2T = (const bf16*)(ws + WS_WT_A2);
    const int row = tid >> 3, cq = tid & 7;
    const v4u w2chunk = *(const GAS v4u*)(W2T + (size_t)(h * HD + row) * 64 + cq * 8);
    *(LAS v4u*)(lds + CS_TILES + wtile * TILE_B + row * TPB + cq * 16) = w2chunk;
    *(LAS v4u*)(lds + CS_TILES + atile * TILE_B + row * TPB + cq * 16) = *(const GAS v4u*)(A2T + (size_t)(h * HD + row) * 64 + cq * 8);
    if (tid < 64) { LAS float* P = (LAS float*)(lds + CS_PAR); P[tid] = INP(15)[h * HD + tid]; P[64 + tid] = INP(16)[h * HD + tid]; P[128 + tid] = INP(17)[h * HD + tid]; }
    __syncthreads();
    return w2chunk;
}
template <int MODE>
__device__ __forceinline__ void chunk_front(const FrontIn& f, LAS unsigned char* lds, const float (&w0v)[2], const float (&a0v)[2], const bf16x8s (&w2f)[2][2], const bf16x8s (&a2f)[2][2], int tid, int lane, int wave, float (&v8)[8], float& rkb) {
    const int rt = wave & 3, ch = wave >> 2, fr = lane & 15, g = lane >> 4;
    LAS float* FA = (LAS float*)(lds + CS_FA); LAS float* FB = (LAS float*)(lds + CS_FB); LAS float* TOT = (LAS float*)(lds + CS_TOT);
    const int t = tid >> 3, cq = tid & 7;
    {
        f32x4 aw[2] = {F4Z, F4Z}, aa[2] = {F4Z, F4Z};
#pragma unroll
        for (int ks = 0; ks < 2; ++ks)
#pragma unroll
            for (int ct = 0; ct < 2; ++ct) { aw[ct] = MFMA16(f.fw[ks], w2f[ks][ct], aw[ct]); aa[ct] = MFMA16(f.fa[ks], a2f[ks][ct], aa[ct]); }
#pragma unroll
        for (int ct = 0; ct < 2; ++ct) { const int j = 32 * ch + 16 * ct + fr, js = j ^ ((g & 1) << 4); const float w0 = w0v[ct], a0 = a0v[ct];
            float p[4];
#pragma unroll
            for (int q = 0; q < 4; ++q) { p[q] = -0.6065306597126334f * sigmoidf_(w0 + aw[ct][q]); if (q) p[q] += p[q - 1]; }
            const float s_ = p[3];
            const float u1 = __int_as_float(__builtin_amdgcn_ds_bpermute(((lane - 16) & 63) << 2, __float_as_int(s_))); const float t1 = s_ + (g >= 1 ? u1 : 0.f);
            const float u2 = __int_as_float(__builtin_amdgcn_ds_bpermute(((lane - 32) & 63) << 2, __float_as_int(t1))); const float t2 = t1 + (g >= 2 ? u2 : 0.f);
            const float ex = t2 - s_;
#pragma unroll
            for (int q = 0; q < 4; ++q) { const int tt = 16 * rt + 4 * g + q; FA[tt * 64 + js] = p[q] + ex; FB[tt * 64 + js] = sigmoidf_(a0 + aa[ct][q]); }
            if (g == 3) TOT[rt * 64 + j] = t2; }
    }
    lds_barrier();
    {
        float r[8], k[8], pkk[8], pka[8], prk[8];
        unpack8(f.r, r); unpack8(f.k, k); unpack8(f.v, v8);
        { const LAS float* P = (const LAS float*)(lds + CS_PAR) + cq * 8; const f32x4 a0_ = *(const LAS f32x4*)P, a1_ = *(const LAS f32x4*)(P + 4), b0_ = *(const LAS f32x4*)(P + 64), b1_ = *(const LAS f32x4*)(P + 68), c0_ = *(const LAS f32x4*)(P + 128), c1_ = *(const LAS f32x4*)(P + 132);
#pragma unroll
          for (int q = 0; q < 4; ++q) { pkk[q] = a0_[q]; pkk[4 + q] = a1_[q]; pka[q] = b0_[q]; pka[4 + q] = b1_[q]; prk[q] = c0_[q]; prk[4 + q] = c1_[q]; } }
        float cw[8], cwp[8], ag[8];
        { const int tp = t > 0 ? t - 1 : 0, rtt = wave >> 1;
          const int ct_ = (cq ^ (((t >> 2) & 1) << 1)) * 8, cp_ = (cq ^ (((tp >> 2) & 1) << 1)) * 8;
          const f32x4 c0_ = *(const LAS f32x4*)(FA + t * 64 + ct_), c1_ = *(const LAS f32x4*)(FA + t * 64 + ct_ + 4), p0_ = *(const LAS f32x4*)(FA + tp * 64 + cp_), p1_ = *(const LAS f32x4*)(FA + tp * 64 + cp_ + 4);
          const f32x4 g0_ = *(const LAS f32x4*)(FB + t * 64 + ct_), g1_ = *(const LAS f32x4*)(FB + t * 64 + ct_ + 4);
          f32x4 o0_ = F4Z, o1_ = F4Z, l0_ = F4Z, l1_ = F4Z;
          for (int r_ = 0; r_ < rtt; ++r_) { l0_ = *(const LAS f32x4*)(TOT + r_ * 64 + cq * 8); l1_ = *(const LAS f32x4*)(TOT + r_ * 64 + cq * 8 + 4); o0_ = o0_ + l0_; o1_ = o1_ + l1_; }
          const bool first = (t & 15) == 0;
#pragma unroll
          for (int q = 0; q < 4; ++q) { cw[q] = c0_[q] + o0_[q]; cw[4 + q] = c1_[q] + o1_[q];
              cwp[q] = t > 0 ? p0_[q] + o0_[q] - (first ? l0_[q] : 0.f) : 0.f; cwp[4 + q] = t > 0 ? p1_[q] + o1_[q] - (first ? l1_[q] : 0.f) : 0.f; ag[q] = g0_[q]; ag[4 + q] = g1_[q]; } }
        float kk[8], ss = 0.f; rkb = 0.f;
#pragma unroll
        for (int q = 0; q < 8; ++q) { kk[q] = k[q] * pkk[q]; ss += kk[q] * kk[q]; }
        ss = sum8(ss);
        const float inv = 1.0f / fmaxf(sqrtf(ss), 1e-12f);
        float at[8], bt[8], kt[8], rt_[8];
#pragma unroll
        for (int q = 0; q < 8; ++q) { const float kn = kk[q] * inv, kp = k[q] * (1.0f + (ag[q] - 1.0f) * pka[q]);
            const float ein = __expf(-cw[q]);
            at[q] = -kn * __expf(cwp[q]); bt[q] = kn * ag[q] * ein; kt[q] = kp * ein;
            rt_[q] = r[q] * __expf(cw[q]); rkb += r[q] * kp * prk[q]; }
        rkb = sum8(rkb);
        *(LAS v4u*)(TILE(0) + t * TPB + cq * 16) = pack8f(at); *(LAS v4u*)(TILE(1) + t * TPB + cq * 16) = pack8f(bt); *(LAS v4u*)(TILE(2) + t * TPB + cq * 16) = pack8f(kt);
        *(LAS v4u*)(TILE(3) + t * TPB + cq * 16) = f.v;
        *(LAS v4u*)(TILE(6) + t * TPB + cq * 16) = pack8f(rt_);
        if (MODE == 1 && t == 63) {
#pragma unroll
            for (int q = 0; q < 8; ++q) ((LAS float*)(lds + CS_WL))[cq * 8 + q] = __expf(cw[q]); }
    }
    lds_barrier();
}

__device__ __forceinline__ void scan_s1(unsigned char* ws, LAS unsigned char* lds, int lane0, int wave) {
    const int rt = wave & 3, ch = wave >> 2;
    FrontIn fin; float w0v[2], a0v[2]; bf16x8s w2f[2][2], a2f[2][2];
    { int l0 = lane0; asm volatile("" : "+v"(l0)); const int hh = blockIdx.x & 15;
      if ((int)blockIdx.x < BATCH * NH * (SEQ / 64)) front_fetch(fin, ws, blockIdx.x, wave * 64 + l0, l0, wave);
      const bf16* W2T = (const bf16*)(ws + WS_WT_W2); const bf16* A2T = (const bf16*)(ws + WS_WT_A2);
#pragma unroll
      for (int ct = 0; ct < 2; ++ct) { w0v[ct] = INP(7)[hh * HD + 32 * ch + 16 * ct + (l0 & 15)]; a0v[ct] = INP(10)[hh * HD + 32 * ch + 16 * ct + (l0 & 15)];
#pragma unroll
          for (int ks = 0; ks < 2; ++ks) { const size_t wr_ = (size_t)(hh * HD + 32 * ch + 16 * ct + (l0 & 15)) * 64 + 32 * ks + 8 * (l0 >> 4); w2f[ks][ct] = *(const GAS bf16x8s*)(W2T + wr_); a2f[ks][ct] = *(const GAS bf16x8s*)(A2T + wr_); } }
      const int tid0 = wave * 64 + l0;
      if (tid0 < 64) { LAS float* P = (LAS float*)(lds + CS_PAR); P[tid0] = INP(15)[hh * HD + tid0]; P[64 + tid0] = INP(16)[hh * HD + tid0]; P[128 + tid0] = INP(17)[hh * HD + tid0]; }
      __syncthreads(); }
    for (int unit = blockIdx.x; unit < BATCH * NH * (SEQ / 64); unit += gridDim.x) {
        int lane = lane0; asm volatile("" : "+v"(lane));
        const int tid = wave * 64 + lane, fr = lane & 15, g = lane >> 4;
        const int h = unit & 15, c = (unit >> 4) & 127, b = unit >> 11; const size_t chunk = ((size_t)b * NH + h) * 128 + c;
        float v8[8]; float rkb;
        chunk_front<1>(fin, lds, w0v, a0v, w2f, a2f, tid, lane, wave, v8, rkb);
        { const size_t row0_ = (size_t)b * SEQ + c * 64; if ((tid & 7) == 0) ((float*)(ws + WS_HID))[(row0_ + (tid >> 3)) * NH + h] = rkb; }
        if (unit + (int)gridDim.x < BATCH * NH * (SEQ / 64)) front_fetch(fin, ws, unit + gridDim.x, tid, lane, wave);
        {
            f32x4 a2[2] = {F4Z, F4Z}, a3[2] = {F4Z, F4Z};
            mm64(a2, TILE(1), TILE(0), rt, ch, fr, g);
            mm64(a3, TILE(2), TILE(0), rt, ch, fr, g);
            f32x4 p1[2];
#pragma unroll
            for (int ct = 0; ct < 2; ++ct) { const int col = 32 * ch + 16 * ct + fr;
#pragma unroll
                for (int q = 0; q < 4; ++q) { const int row = 16 * rt + 4 * g + q;
                    a2[ct][q] = row < col ? a2[ct][q] : 0.f;
                    p1[ct][q] = a2[ct][q] + (row == col ? 1.0f : 0.f);
                    a3[ct][q] = row < col ? a3[ct][q] : 0.f; } }
            st_tr(TILE(5), a2, rt, ch, fr, g);
            st_tr(TILE(9), p1, rt, ch, fr, g);
            st_tr(TILE(4), a3, rt, ch, fr, g);
        }
        lds_barrier();
#pragma unroll
        for (int r = 0; r < 6; ++r) {
            LAS unsigned char* Sr = TILE(5 + 2 * (r & 1)); LAS unsigned char* Sr2 = TILE(5 + 2 * ((r & 1) ^ 1));
            if (r <= 4) { f32x4 q2[2] = {F4Z, F4Z};
                mm64_at(q2, Sr, Sr, rt, ch, fr, g, lane);
                st_tr(Sr2, q2, rt, ch, fr, g); }
            if (r >= 1) { LAS unsigned char* Pr = TILE(9 + ((r - 1) & 1)); LAS unsigned char* Pr2 = TILE(9 + (((r - 1) & 1) ^ 1));
                f32x4 pa[2]; ld_tr(pa, Pr, rt, ch, fr, g);
                mm64_at(pa, Sr, Pr, rt, ch, fr, g, lane);
                st_tr(Pr2, pa, rt, ch, fr, g); }
            if (r == 0) { f32x4 gg[2] = {F4Z, F4Z};
                mm64_bt(gg, TILE(4), TILE(3), rt, ch, fr, g, lane);
                st_tr(TILE(11), gg, rt, ch, fr, g); }
            lds_barrier();
        }
        {
            f32x4 acc[2] = {F4Z, F4Z}, ac2[2] = {F4Z, F4Z};
            mm64_bt(acc, TILE(10), TILE(0), rt, ch, fr, g, lane);
            mm64(ac2, TILE(10), TILE(11), rt, ch, fr, g);
            st_tr(TILE(5), acc, rt, ch, fr, g); st_tr(TILE(7), ac2, rt, ch, fr, g);
            f32x4 b2[2] = {F4Z, F4Z}, b3[2] = {F4Z, F4Z};
            mm64(b2, TILE(1), TILE(6), rt, ch, fr, g); mm64(b3, TILE(2), TILE(6), rt, ch, fr, g);
#pragma unroll
            for (int ct = 0; ct < 2; ++ct) { const int t = 32 * ch + 16 * ct + fr;
#pragma unroll
                for (int q = 0; q < 4; ++q) { const int s_ = 16 * rt + 4 * g + q; b2[ct][q] = s_ <= t ? b2[ct][q] : 0.f; b3[ct][q] = s_ <= t ? b3[ct][q] : 0.f; } }
            st_tr(TILE(4), b2, rt, ch, fr, g); st_tr(TILE(9), b3, rt, ch, fr, g);
        }
        lds_barrier();
        {
            const LAS float* WL = (const LAS float*)(lds + CS_WL);
            f32x4 acc[2] = {F4Z, F4Z};
            mm64_bt(acc, TILE(5), TILE(1), rt, ch, fr, g, lane);
            bf16* Mg = (bf16*)(ws + WS_B0) + chunk * 4096;
#pragma unroll
            for (int ct = 0; ct < 2; ++ct) { const int j1 = 32 * ch + 16 * ct + fr; const float wl = WL[j1];
#pragma unroll
                for (int q = 0; q < 4; ++q) { const int j2 = 16 * rt + 4 * g + q; acc[ct][q] = wl * (acc[ct][q] + (j2 == j1 ? 1.0f : 0.f)); }
                const int rtS = 2 * ch + ct, ksS = rt >> 1, half = rt & 1;
                *(GAS bf16x4s*)(Mg + (((rtS * 2 + ksS) * 64 + g * 16 + fr) * 8 + half * 4)) = pack4(acc[ct]); }
            f32x4 ad[2] = {F4Z, F4Z};
            mm64_at(ad, TILE(1), TILE(7), rt, ch, fr, g, lane);
            mm64_att(ad, TILE(2), TILE(3), rt, ch, lane);
            const f32x4 wl4 = *(const LAS f32x4*)(WL + 16 * rt + 4 * g);
            bf16* Dg = (bf16*)OUTP() + chunk * 4096;
#pragma unroll
            for (int ct = 0; ct < 2; ++ct) *(GAS bf16x4s*)(Dg + (((2 * ch + ct) * 4 + rt) * 64 + lane) * 4) = pack4(ad[ct] * wl4);
            const size_t row0_ = (size_t)b * SEQ + c * 64;
            f32x4 ar[2]; ld_tr(ar, TILE(6), rt, ch, fr, g);
            mm64(ar, TILE(5), TILE(4), rt, ch, fr, g);
            f32x4 ay[2] = {F4Z, F4Z};
            mm64(ay, TILE(7), TILE(4), rt, ch, fr, g); mm64_at(ay, TILE(3), TILE(9), rt, ch, fr, g, lane);
            bf16* Rg = (bf16*)(ws + WS_B1); bf16* Kg = (bf16*)(ws + WS_B2);
#pragma unroll
            for (int ct = 0; ct < 2; ++ct) { const size_t o_ = (row0_ + 32 * ch + 16 * ct + fr) * C + h * HD + 16 * rt + 4 * g; *(GAS bf16x4s*)(Rg + o_) = pack4(ar[ct]); *(GAS bf16x4s*)(Kg + o_) = pack4(ay[ct]); }
        }
        lds_barrier();
    }
}

constexpr int S2_PD = 6;
__device__ __forceinline__ void scan_s2(unsigned char* ws, LAS unsigned char* lds, int lane, int wave) {
    for (int bh = blockIdx.x; bh < BATCH * NH; bh += gridDim.x) {
        const unsigned char* Mg = (const unsigned char*)((const bf16*)(ws + WS_B0) + (size_t)bh * 128 * 4096); const unsigned char* Dg = (const unsigned char*)((const bf16*)OUTP() + (size_t)bh * 128 * 4096);
        bf16* Sg = (bf16*)OUTP() + (size_t)M * C + (size_t)bh * 128 * 4096;
        if (wave >= 4) {
            const int lw = wave - 4;
            const unsigned char* src = (lw < 2 ? Mg + lw * 4096 : Dg + (lw - 2) * 4096) + lane * 16;
            LAS unsigned char* dst = lds + lw * 4096 + lane * 16;
            v4u q[S2_PD][4];
#define S2_LOADQ(j, c) do { _Pragma("unroll") for (int i_ = 0; i_ < 4; ++i_) q[j][i_] = *(const GAS v4u*)(src + (size_t)(c) * 8192 + i_ * 1024); } while (0)
#define S2_STOREQ(j, slot) do { _Pragma("unroll") for (int i_ = 0; i_ < 4; ++i_) *(LAS v4u*)(dst + (slot) * 16384 + i_ * 1024) = q[j][i_]; } while (0)
#pragma unroll
            for (int j = 0; j < S2_PD; ++j) S2_LOADQ(j, j);
            S2_STOREQ(0, 0); S2_LOADQ(0, S2_PD);
            lds_barrier();
#pragma unroll 1
            for (int s0 = 0; s0 < 128; s0 += S2_PD) {
#pragma unroll
                for (int jj = 0; jj < S2_PD; ++jj) { const int step = s0 + jj;
                    if (step + 1 < 128) S2_STOREQ((jj + 1) % S2_PD, (step + 1) & 1);
                    if (step + 1 + S2_PD < 128) S2_LOADQ((jj + 1) % S2_PD, step + 1 + S2_PD);
                    lds_barrier(); }
            }
#undef S2_LOADQ
#undef S2_STOREQ
        } else {
            const int ct = wave;
            f32x4 acc[4];
#pragma unroll
            for (int r = 0; r < 4; ++r) acc[r] = F4Z;
            lds_barrier();
#pragma unroll 1
            for (int s0 = 0; s0 < 128; s0 += S2_PD) {
#pragma unroll
                for (int jj = 0; jj < S2_PD; ++jj) { const int step = s0 + jj;
                    if (step < 128) {
                        const LAS unsigned char* slot = lds + (step & 1) * 16384;
                        bf16x8s sf[2];
#pragma unroll
                        for (int ks = 0; ks < 2; ++ks) { const bf16x4s lo = pack4(acc[2 * ks]), hi = pack4(acc[2 * ks + 1]); sf[ks] = (bf16x8s){lo[0], lo[1], lo[2], lo[3], hi[0], hi[1], hi[2], hi[3]}; }
#pragma unroll
                        for (int ks = 0; ks < 2; ++ks) *(GAS bf16x8s*)(Sg + (size_t)step * 4096 + ((ct * 2 + ks) * 64 + lane) * 8) = sf[ks];
                        f32x4 na[4];
#pragma unroll
                        for (int r = 0; r < 4; ++r) na[r] = unpack4(*(const LAS bf16x4s*)(slot + 8192 + ((ct * 4 + r) * 64 + lane) * 8));
#pragma unroll
                        for (int ks = 0; ks < 2; ++ks)
#pragma unroll
                            for (int r = 0; r < 4; ++r) na[r] = MFMA16(*(const LAS bf16x8s*)(slot + ((r * 2 + ks) * 64 + lane) * 16), sf[ks], na[r]);
#pragma unroll
                        for (int r = 0; r < 4; ++r) acc[r] = na[r];
                    }
                    lds_barrier(); }
            }
        }
    }
}

constexpr int S3_RT = 32768, S3_YT = S3_RT + TILE_B, S3_LG = S3_YT + TILE_B, S3_LGP = 336;
struct S3In { v4u rr, yy, vv, lg[3]; bf16x8s sA[2]; float rkb; };
__device__ __forceinline__ void s3_fetch(S3In& f, unsigned char* ws, int unit, int tid, int lane, int wave) {
    const int h = unit & 15, c = (unit >> 4) & 127, b = unit >> 11; const size_t chunk = ((size_t)b * NH + h) * 128 + c, row0 = (size_t)b * SEQ + c * 64;
    const int rt = wave & 3, et = tid >> 3, ecq = tid & 7;
    const bf16* Rg = (const bf16*)(ws + WS_B1); const bf16* Kg = (const bf16*)(ws + WS_B2); const bf16* Vb = (const bf16*)(ws + WS_B3); const bf16* LG = (const bf16*)(ws + WS_LG);
    const bf16* Sg = (const bf16*)OUTP() + (size_t)M * C + chunk * 4096;
    const size_t o_ = (row0 + et) * C + h * HD + ecq * 8;
    f.rr = *(const GAS v4u*)(Rg + o_); f.yy = *(const GAS v4u*)(Kg + o_); f.vv = *(const GAS v4u*)(Vb + o_);
#pragma unroll
    for (int i = 0; i < 3; ++i) { const int chn = tid + 512 * i; if (chn < 64 * 20) f.lg[i] = *(const GAS v4u*)(LG + (row0 + chn / 20) * DG + (chn % 20) * 8); }
#pragma unroll
    for (int ks = 0; ks < 2; ++ks) f.sA[ks] = *(const GAS bf16x8s*)(Sg + ((rt * 2 + ks) * 64 + lane) * 8);
    f.rkb = ((const float*)(ws + WS_HID))[(row0 + et) * NH + h];
}
__device__ __forceinline__ void scan_s3(unsigned char* ws, LAS unsigned char* lds, int lane0, int wave) {
    const int rt = wave & 3, ch = wave >> 2;
    LAS float* Ys = (LAS float*)(lds + CS_FA);
    const bf16* G2T = (const bf16*)(ws + WS_WT_G2); bf16* YG = (bf16*)(ws + WS_B0);
    constexpr int NU = BATCH * NH * (SEQ / 64);
    S3In fin; bf16x8s gA[5]; f32x4 lnw0, lnw1, lnb0, lnb1;
    { int l0 = lane0; asm volatile("" : "+v"(l0)); const int hh = blockIdx.x & 15, t0_ = wave * 64 + l0;
      if ((int)blockIdx.x < NU) s3_fetch(fin, ws, blockIdx.x, t0_, l0, wave);
#pragma unroll
      for (int ks = 0; ks < 5; ++ks) gA[ks] = *(const GAS bf16x8s*)(G2T + (size_t)(hh * HD + 16 * rt + (l0 & 15)) * DG + 32 * ks + 8 * (l0 >> 4));
      const int ec0 = hh * HD + (t0_ & 7) * 8;
      lnw0 = *(const GAS f32x4*)(INP(18) + ec0); lnw1 = *(const GAS f32x4*)(INP(18) + ec0 + 4); lnb0 = *(const GAS f32x4*)(INP(19) + ec0); lnb1 = *(const GAS f32x4*)(INP(19) + ec0 + 4); }
    __syncthreads();
    for (int unit = blockIdx.x; unit < NU; unit += gridDim.x) {
        int lane = lane0; asm volatile("" : "+v"(lane));
        const int tid = wave * 64 + lane, fr = lane & 15, g = lane >> 4, et = tid >> 3, ecq = tid & 7;
        const int h = unit & 15, c = (unit >> 4) & 127, b = unit >> 11; const size_t row0 = (size_t)b * SEQ + c * 64;
        *(LAS v4u*)(lds + S3_RT + et * TPB + ecq * 16) = fin.rr; *(LAS v4u*)(lds + S3_YT + et * TPB + ecq * 16) = fin.yy;
#pragma unroll
        for (int i = 0; i < 3; ++i) { const int chn = tid + 512 * i; if (chn < 64 * 20) *(LAS v4u*)(lds + S3_LG + (chn / 20) * S3_LGP + (chn % 20) * 16) = fin.lg[i]; }
        float v8[8]; unpack8(fin.vv, v8); const float rkb = fin.rkb; const bf16x8s sA0 = fin.sA[0], sA1 = fin.sA[1];
        lds_barrier();
        if (unit + (int)gridDim.x < NU) s3_fetch(fin, ws, unit + gridDim.x, tid, lane, wave);
        f32x4 acc[2], ag[2] = {F4Z, F4Z};
#pragma unroll
        for (int ct = 0; ct < 2; ++ct) { const int t = 32 * ch + 16 * ct + fr;
            acc[ct] = unpack4(*(const LAS bf16x4s*)(lds + S3_YT + t * TPB + (16 * rt + 4 * g) * 2));
            acc[ct] = MFMA16(sA0, ldfrag_perm(lds + S3_RT, t, 0, g), acc[ct]); acc[ct] = MFMA16(sA1, ldfrag_perm(lds + S3_RT, t, 1, g), acc[ct]);
#pragma unroll
            for (int ks = 0; ks < 5; ++ks) ag[ct] = MFMA16(gA[ks], *(const LAS bf16x8s*)(lds + S3_LG + t * S3_LGP + (32 * ks + 8 * g) * 2), ag[ct]);
            *(LAS f32x4*)(Ys + t * FP + 16 * rt + 4 * g) = acc[ct]; }
        lds_barrier();
        {
            const f32x4 y0 = *(const LAS f32x4*)(Ys + et * FP + ecq * 8), y1 = *(const LAS f32x4*)(Ys + et * FP + ecq * 8 + 4);
            float y[8] = {y0[0], y0[1], y0[2], y0[3], y1[0], y1[1], y1[2], y1[3]};
            float s_ = 0.f;
#pragma unroll
            for (int q = 0; q < 8; ++q) s_ += y[q];
            s_ = sum8(s_);
            const float mu = s_ * (1.0f / HD); float vs = 0.f;
#pragma unroll
            for (int q = 0; q < 8; ++q) { y[q] -= mu; vs += y[q] * y[q]; }
            vs = sum8(vs);
            const float rstd = 1.0f / sqrtf(vs * (1.0f / HD) + GN_EPS);
            f32x4 o0, o1;
#pragma unroll
            for (int q = 0; q < 4; ++q) { o0[q] = y[q] * rstd * lnw0[q] + lnb0[q] + rkb * v8[q]; o1[q] = y[4 + q] * rstd * lnw1[q] + lnb1[q] + rkb * v8[4 + q]; }
            *(LAS f32x4*)(Ys + et * FP + ecq * 8) = o0; *(LAS f32x4*)(Ys + et * FP + ecq * 8 + 4) = o1;
        }
        lds_barrier();
#pragma unroll
        for (int ct = 0; ct < 2; ++ct) { const int t = 32 * ch + 16 * ct + fr; const f32x4 yv = *(const LAS f32x4*)(Ys + t * FP + 16 * rt + 4 * g);
            *(GAS bf16x4s*)(YG + (row0 + t) * C + h * HD + 16 * rt + 4 * g) = pack4(yv * ag[ct]); }
    }
    __syncthreads();
}
#undef TILE
#if MK_DEBUG
__device__ __forceinline__ void scan_naive(unsigned char* ws, LAS unsigned char* lds, int tid) {
    const int lane = tid & 63;
    const bf16* Rb = (const bf16*)(ws + WS_B1); const bf16* Kb = (const bf16*)(ws + WS_B2); const bf16* Vb = (const bf16*)(ws + WS_B3);
    const bf16* LW = (const bf16*)(ws + WS_LW); const bf16* LA = (const bf16*)(ws + WS_LA);
    float* Y = OUTP(); float* RK = (float*)(ws + WS_HID);
    LAS float* sR = (LAS float*)lds; LAS float* sK = sR + 4096; LAS float* sV = sK + 4096; LAS float* sA = sV + 4096; LAS float* sB = sA + 4096; LAS float* sD = sB + 4096;
    LAS float* sW2 = sD + 4096; LAS float* sA2 = sW2 + 4096;
    for (int unit = blockIdx.x; unit < BATCH * NH; unit += gridDim.x) {
        const int b = unit / NH, h = unit % NH;
        __syncthreads();
        for (int e = tid; e < 4096; e += 512) { const int d = e >> 6, j = e & 63; sW2[e] = INP(9)[(size_t)d * C + h * HD + j]; sA2[e] = INP(12)[(size_t)d * C + h * HD + j]; }
        __syncthreads();
        const int pt = tid >> 3, cq = tid & 7, c0 = h * HD + cq * 8;
        const int si = tid >> 3, jq = tid & 7;
        float S[8];
#pragma unroll
        for (int q = 0; q < 8; ++q) S[q] = 0.f;
        float w0v[8], a0v[8], kkv[8], kav[8], rkv[8];
#pragma unroll
        for (int q = 0; q < 8; ++q) { w0v[q] = INP(7)[c0 + q]; a0v[q] = INP(10)[c0 + q]; kkv[q] = INP(15)[c0 + q]; kav[q] = INP(16)[c0 + q]; rkv[q] = INP(17)[c0 + q]; }
        for (int blk = 0; blk < SEQ / 64; ++blk) {
            const size_t row = (size_t)b * SEQ + blk * 64 + pt;
            {
                const v4u r4 = *(const GAS v4u*)(Rb + row * C + c0), k4 = *(const GAS v4u*)(Kb + row * C + c0), v4 = *(const GAS v4u*)(Vb + row * C + c0);
                float r[8], k[8], v[8];
                r[0] = bflo(r4.x); r[1] = bfhi(r4.x); r[2] = bflo(r4.y); r[3] = bfhi(r4.y); r[4] = bflo(r4.z); r[5] = bfhi(r4.z); r[6] = bflo(r4.w); r[7] = bfhi(r4.w);
                k[0] = bflo(k4.x); k[1] = bfhi(k4.x); k[2] = bflo(k4.y); k[3] = bfhi(k4.y); k[4] = bflo(k4.z); k[5] = bfhi(k4.z); k[6] = bflo(k4.w); k[7] = bfhi(k4.w);
                v[0] = bflo(v4.x); v[1] = bfhi(v4.x); v[2] = bflo(v4.y); v[3] = bfhi(v4.y); v[4] = bflo(v4.z); v[5] = bfhi(v4.z); v[6] = bflo(v4.w); v[7] = bfhi(v4.w);
                float wp[8], ap[8];
#pragma unroll
                for (int q = 0; q < 8; ++q) { wp[q] = w0v[q]; ap[q] = a0v[q]; }
                for (int d = 0; d < 64; ++d) { const float lw = bf2f(LW[row * DW + d]), la = bf2f(LA[row * DA + d]);
#pragma unroll
                    for (int q = 0; q < 8; ++q) { wp[q] += lw * sW2[d * 64 + cq * 8 + q]; ap[q] += la * sA2[d * 64 + cq * 8 + q]; } }
                float kk[8], ss = 0.f, rks = 0.f;
#pragma unroll
                for (int q = 0; q < 8; ++q) { kk[q] = k[q] * kkv[q]; ss += kk[q] * kk[q]; }
                ss = sum8(ss);
                const float inv = 1.0f / fmaxf(sqrtf(ss), 1e-12f);
#pragma unroll
                for (int q = 0; q < 8; ++q) { const float ag = sigmoidf_(ap[q]); const float kn = kk[q] * inv; const float kp = k[q] * (1.0f + (ag - 1.0f) * kav[q]);
                    const float lw = -0.6065306597126334f * sigmoidf_(wp[q]);
                    const int o = pt * 64 + cq * 8 + q;
                    sR[o] = r[q]; sK[o] = kp; sV[o] = v[q]; sA[o] = -kn; sB[o] = kn * ag; sD[o] = __expf(lw); rks += r[q] * kp * rkv[q]; }
                rks = sum8(rks);
                if (cq == 0) RK[row * NH + h] = rks;
            }
            __syncthreads();
            for (int t = 0; t < 64; ++t) {
                const LAS f32x4* pa = (const LAS f32x4*)(sA + t * 64 + jq * 8); const LAS f32x4* pb = (const LAS f32x4*)(sB + t * 64 + jq * 8);
                const LAS f32x4* pd = (const LAS f32x4*)(sD + t * 64 + jq * 8); const LAS f32x4* pk = (const LAS f32x4*)(sK + t * 64 + jq * 8);
                const LAS f32x4* pr = (const LAS f32x4*)(sR + t * 64 + jq * 8);
                const f32x4 a0 = pa[0], a1 = pa[1], b0 = pb[0], b1 = pb[1], d0 = pd[0], d1 = pd[1], k0 = pk[0], k1 = pk[1], r0 = pr[0], r1 = pr[1];
                const float vi = sV[t * 64 + si];
                float sa = 0.f;
#pragma unroll
                for (int q = 0; q < 4; ++q) { sa += S[q] * a0[q]; sa += S[4 + q] * a1[q]; }
                sa = sum8(sa);
                float y = 0.f;
#pragma unroll
                for (int q = 0; q < 4; ++q) { S[q] = S[q] * d0[q] + sa * b0[q] + vi * k0[q]; S[4 + q] = S[4 + q] * d1[q] + sa * b1[q] + vi * k1[q]; y += S[q] * r0[q]; y += S[4 + q] * r1[q]; }
                y = sum8(y);
                if (jq == 0) Y[((size_t)b * SEQ + blk * 64 + t) * C + h * HD + si] = y;
            }
            __syncthreads();
        }
    }
}
__device__ __forceinline__ void post_scan(unsigned char* ws, int gw, int NGW, int lane) {
    const float* Y = OUTP(); const float* RK = (const float*)(ws + WS_HID); const bf16* Vb = (const bf16*)(ws + WS_B3); const bf16* LG = (const bf16*)(ws + WS_LG);
    bf16* YG = (bf16*)(ws + WS_B4); const float* g2 = INP(14); const float* lnw = INP(18); const float* lnb = INP(19);
    for (int it = gw; it < M * NH; it += NGW) {
        const int row = it / NH, h = it % NH, c = h * HD + lane;
        const float y = Y[(size_t)row * C + c];
        const float mu = wave_sum(y, lane) * (1.0f / HD); const float d = y - mu; const float var = wave_sum(d * d, lane) * (1.0f / HD);
        float o = d * (1.0f / sqrtf(var + GN_EPS)) * lnw[c] + lnb[c];
        o += RK[(size_t)row * NH + h] * bf2f(Vb[(size_t)row * C + c]);
        float g = 0.f;
        for (int dd = 0; dd < DG; ++dd) g += bf2f(LG[(size_t)row * DG + dd]) * g2[(size_t)dd * C + c];
        YG[(size_t)row * C + c] = (bf16)f2bf(o * g);
    }
}


constexpr int CW_DBG = 3200;
__device__ __forceinline__ void dbg_nonfinite(unsigned char* ws, const bf16* X, size_t n, int slot, int gw, int NGW, int lane, float thr = 1e30f) {
    unsigned* cw = (unsigned*)(ws + WS_CTL) + CW_DBG + 64 * slot; unsigned nnan = 0;
    for (size_t i = (size_t)gw * 64 + lane; i < n; i += (size_t)NGW * 64) { const float x = bf2f(X[i]); if (!(fabsf(x) < thr)) ++nnan; }
    if (nnan) atomicAdd(cw, nnan);
}
__device__ __forceinline__ void dbg_compare(unsigned char* ws, const bf16* X, const bf16* Y, int gw, int NGW, int lane) {
    unsigned* cw = (unsigned*)(ws + WS_CTL) + CW_DBG; unsigned nbad = 0, nnan = 0;
    for (size_t i = (size_t)gw * 64 + lane; i < (size_t)M * C; i += (size_t)NGW * 64) { const float x = bf2f(X[i]), y = bf2f(Y[i]);
        if (!(fabsf(x) < 1e30f)) ++nnan; else if (fabsf(x - y) > 0.05f * (fabsf(y) + 0.05f)) ++nbad; }
    if (nnan) atomicAdd(cw, nnan); if (nbad) atomicAdd(cw + 64, nbad);
}
#endif
__device__ __forceinline__ void router_rows(unsigned char* ws, LAS unsigned char* lds, int layer, int gw, int NGW, int lane, int tid, int wv, bool dry = false) {
    const bf16* Hh = (const bf16*)(ws + WS_B4); const float* gain = INP(2) + layer * C; float* rsl = (float*)(ws + WS_B0);
    const float* wg = INP(24) + (size_t)layer * C * 4; const float* bg = INP(25) + layer * 4; const float* wi = INP(26) + (size_t)layer * C * 16; const float* bi = INP(27) + layer * 16;
    unsigned* cnt = (unsigned*)(ws + WS_CTL) + CW_CNT + layer * 16 * 64; unsigned* list = (unsigned*)(ws + WS_LIST); float* wl = (float*)(ws + WS_WL);
    LAS float* sWg = (LAS float*)lds; LAS float* sWi = sWg + C * 4;
    constexpr int RECMAX = 256;
    LAS unsigned* lcnt = (LAS unsigned*)(lds + 81920); LAS unsigned* gbase = lcnt + 16; LAS float* sBias = (LAS float*)(lcnt + 32);
    LAS unsigned* recRow = lcnt + 64; LAS unsigned* recE = recRow + RECMAX; LAS unsigned* recL = recE + RECMAX; LAS float* recW0 = (LAS float*)(recL + RECMAX); LAS float* recW1 = recW0 + RECMAX; LAS float* recRS = recW1 + RECMAX;
    __syncthreads();
    for (int e = tid; e < C; e += 512) { const int r = e >> 6, c = 256 * (r >> 2) + 4 * (e & 63) + (r & 3); ((LAS f32x4*)sWg)[e] = ((const GAS f32x4*)wg)[c]; }
    for (int e = tid; e < C * 4; e += 512) { const int r = e >> 6, jq = r >> 2, c = 256 * (jq >> 2) + 4 * (e & 63) + (jq & 3); ((LAS f32x4*)sWi)[e] = ((const GAS f32x4*)wi)[c * 4 + (r & 3)]; }
    if (tid < 4) sBias[tid] = bg[tid]; else if (tid < 20) sBias[tid] = bi[tid - 4];
    for (int e = tid; e < RECMAX; e += 512) recE[e] = 0xffffffffu;
    __syncthreads();
    f32x4 g[4]; load_row(gain, lane, g);
    v2u nxr[4];
    { const int r0 = gw < M - 1 ? gw : M - 1;
#pragma unroll
        for (int j = 0; j < 4; ++j) nxr[j] = ((const GAS v2u*)(Hh + (size_t)r0 * C))[64 * j + lane]; }
    int k = 0;
    for (int row = gw; row < M; row += NGW, ++k) {
        f32x4 v[4];
#pragma unroll
        for (int j = 0; j < 4; ++j) v[j] = (f32x4){bflo(nxr[j].x), bfhi(nxr[j].x), bflo(nxr[j].y), bfhi(nxr[j].y)};
        if (row + NGW < M) {
#pragma unroll
            for (int j = 0; j < 4; ++j) nxr[j] = ((const GAS v2u*)(Hh + (size_t)(row + NGW) * C))[64 * j + lane]; }
        const float rs = row_rs(v, lane);
#pragma unroll
        for (int j = 0; j < 4; ++j) v[j] = v[j] * rs * g[j];
        float gl[4] = {0.f, 0.f, 0.f, 0.f};
        const LAS unsigned char* pWg = (const LAS unsigned char*)sWg + lane * 16;
#pragma unroll
        for (int j = 0; j < 4; ++j)
#pragma unroll
            for (int q = 0; q < 4; ++q) { const f32x4 w = *(const LAS f32x4*)(pWg + (j * 4 + q) * 1024); const float xv = v[j][q]; gl[0] += xv * w.x; gl[1] += xv * w.y; gl[2] += xv * w.z; gl[3] += xv * w.w; }
#pragma unroll
        for (int q = 0; q < 4; ++q) gl[q] = wave_sum(gl[q], lane) + sBias[q];
        int gi = 0; float gm = gl[0];
#pragma unroll
        for (int q = 1; q < 4; ++q) if (gl[q] > gm) { gm = gl[q]; gi = q; }
        float gden = 0.f;
#pragma unroll
        for (int q = 0; q < 4; ++q) gden += __expf(gl[q] - gm);
        const float gval = 1.0f / gden;
        float il[4] = {0.f, 0.f, 0.f, 0.f};
        const LAS unsigned char* pWi = (const LAS unsigned char*)sWi + lane * 16 + gi * 1024;
#pragma unroll
        for (int j = 0; j < 4; ++j)
#pragma unroll
            for (int q = 0; q < 4; ++q) { const f32x4 w = *(const LAS f32x4*)(pWi + (j * 4 + q) * 4096); const float xv = v[j][q]; il[0] += xv * w.x; il[1] += xv * w.y; il[2] += xv * w.z; il[3] += xv * w.w; }
        const f32x4 bi4 = *(const LAS f32x4*)(sBias + 4 + gi * 4);
#pragma unroll
        for (int q = 0; q < 4; ++q) il[q] = wave_sum(il[q], lane) + bi4[q];
        int i0 = 0; float m0 = il[0];
#pragma unroll
        for (int q = 1; q < 4; ++q) if (il[q] > m0) { m0 = il[q]; i0 = q; }
        int i1 = -1; float m1 = -INFINITY;
#pragma unroll
        for (int q = 0; q < 4; ++q) if (q != i0 && il[q] > m1) { m1 = il[q]; i1 = q; }
        const float e1 = __expf(m1 - m0); const float w0 = gval / (1.0f + e1), w1 = gval * e1 / (1.0f + e1);
        const int ri = wv * 32 + k;
        if (lane == 0 && !dry && k < 32) { const int ex0 = gi * 4 + i0, ex1 = gi * 4 + i1;
            recRow[ri] = (unsigned)row; recE[ri] = (unsigned)ex0 | ((unsigned)ex1 << 8); recW0[ri] = w0; recW1[ri] = w1; recRS[ri] = rs; }
    }
    __syncthreads();
    unsigned e = 0xffffffffu; if (tid < RECMAX) e = recE[tid];
    const unsigned ex0 = e & 255u, ex1 = (e >> 8) & 255u;
    unsigned pos0 = 0u, pos1 = 0u;
    if (wv < RECMAX / 64) {
#pragma unroll
        for (unsigned x = 0; x < 16; ++x) { const unsigned long long m0 = __ballot(ex0 == x), m1 = __ballot(ex1 == x);
            const unsigned p = __builtin_amdgcn_mbcnt_hi((unsigned)(m0 >> 32), __builtin_amdgcn_mbcnt_lo((unsigned)m0, 0u)) + __builtin_amdgcn_mbcnt_hi((unsigned)(m1 >> 32), __builtin_amdgcn_mbcnt_lo((unsigned)m1, 0u));
            if (ex0 == x) pos0 = p; if (ex1 == x) pos1 = p;
            if (lane == 0) recL[wv * 16 + x] = (unsigned)(__popcll(m0) + __popcll(m1)); } }
    __syncthreads();
    if (tid < 16 && !dry) { unsigned c_ = 0u;
#pragma unroll
        for (int q = 0; q < RECMAX / 64; ++q) c_ += recL[q * 16 + tid];
        gbase[tid] = atomicAdd(cnt + tid * 64, c_); }
    __syncthreads();
    if (e != 0xffffffffu && !dry) { unsigned p0 = gbase[ex0] + pos0, p1 = gbase[ex1] + pos1;
        for (int q = 0; q < wv; ++q) { p0 += recL[q * 16 + ex0]; p1 += recL[q * 16 + ex1]; }
        const unsigned row = recRow[tid]; const float rs = recRS[tid];
        list[(size_t)ex0 * M + p0] = row * 2u; wl[(size_t)ex0 * M + p0] = recW0[tid]; list[(size_t)ex1 * M + p1] = row * 2u + 1u; wl[(size_t)ex1 * M + p1] = recW1[tid];
        rsl[(size_t)ex0 * M + p0] = rs; rsl[(size_t)ex1 * M + p1] = rs; }
}
__device__ __forceinline__ void moe_table(unsigned char* ws, volatile LAS int* tab, int layer, int tid) {
    __syncthreads();
    if (tid == 0) { const unsigned* cnt = (const unsigned*)(ws + WS_CTL) + CW_CNT + layer * 16 * 64; int t = 0;
#pragma unroll 1
        for (int e = 0; e < 16; ++e) { const int c = (int)__hip_atomic_load(cnt, RLX_AGENT); cnt += 64; tab[e] = c; tab[16 + e] = t; t += (c + 255) >> 8; tab[32 + e] = t; }
        tab[48] = t; }
    __syncthreads();
}
__device__ __forceinline__ void combine_rows(unsigned char* ws, int mode, int gw, int NGW, int lane, bool dry = false) {
    bf16* Hh = (bf16*)(ws + WS_B4); float* Out = OUTP(); const bf16* E0 = (const bf16*)(ws + WS_B2); const bf16* E1 = (const bf16*)(ws + WS_B3); bf16* XN2 = (bf16*)(ws + WS_B0);
    f32x4 g[4]; load_row(INP(4), lane, g);
    for (int row = gw; row < M; row += NGW) {
        f32x4 v[4]; load_row_bf(Hh + (size_t)row * C, lane, v);
#pragma unroll
        for (int j = 0; j < 4; ++j) { const v2u e0 = ((const GAS v2u*)(E0 + (size_t)row * C))[64 * j + lane], e1 = ((const GAS v2u*)(E1 + (size_t)row * C))[64 * j + lane];
            v[j].x += bflo(e0.x) + bflo(e1.x); v[j].y += bfhi(e0.x) + bfhi(e1.x); v[j].z += bflo(e0.y) + bflo(e1.y); v[j].w += bfhi(e0.y) + bfhi(e1.y); }
        const float rs = row_rs(v, lane);
        if (mode == 0) {
            if (!dry) store_row_bf16(Hh + (size_t)row * C, lane, v);
            if (lane == 0) ((float*)XN2)[row] = rs;
        } else {
            float sig = 1.0f;
#if MK_DEBUG
            const unsigned* cw = (const unsigned*)(ws + WS_CTL) + CW_DBG; const unsigned nnan = __hip_atomic_load(cw, RLX_AGENT), nbad = __hip_atomic_load(cw + 64, RLX_AGENT);
            if (row < 512 && nnan > 0) sig = 2.0f;
            if (row >= 512 && row < 1536 && __hip_atomic_load(cw + 128, RLX_AGENT) > 0) sig = 2.0f;
            if (row >= 1536 && row < 3584 && __hip_atomic_load(cw + 192, RLX_AGENT) > 0) sig = 2.0f;
            if (row >= 3584 && row < 7680 && __hip_atomic_load(cw + 256, RLX_AGENT) > 0) sig = 2.0f;
            if (row >= 7680 && row < 15872 && __hip_atomic_load(cw + 320, RLX_AGENT) > 0) sig = 2.0f;
            if (row >= 15872 && nbad > (unsigned)(M / 100) * C) sig = 1.5f;
#endif
#pragma unroll
            for (int j = 0; j < 4; ++j) ((GAS f32x4*)(Out + (size_t)row * C))[64 * j + lane] = v[j] * rs * g[j] * sig;
        }
    }
}
__device__ __forceinline__ void attn_naive(unsigned char* ws, int gw, int NGW, int lane) {
    const bf16* Kb = (const bf16*)(ws + WS_B1); const bf16* Vb = (const bf16*)(ws + WS_B2); const bf16* Qb = (const bf16*)(ws + WS_B3); bf16* Ob = (bf16*)(ws + WS_B0);
    for (int unit = gw; unit < BATCH * NH * (SEQ / 64); unit += NGW) {
        const int qb = unit % (SEQ / 64), bh = unit / (SEQ / 64), b = bh / NH, h = bh % NH;
        const int t0 = qb * 64, t = t0 + lane; const size_t rowq = (size_t)b * SEQ + t;
        float q[64], o[64];
#pragma unroll
        for (int c = 0; c < 8; ++c) { const v4u w = *(const GAS v4u*)(Qb + rowq * C + h * HD + c * 8);
            q[c * 8 + 0] = bflo(w.x) * 0.125f; q[c * 8 + 1] = bfhi(w.x) * 0.125f; q[c * 8 + 2] = bflo(w.y) * 0.125f; q[c * 8 + 3] = bfhi(w.y) * 0.125f;
            q[c * 8 + 4] = bflo(w.z) * 0.125f; q[c * 8 + 5] = bfhi(w.z) * 0.125f; q[c * 8 + 6] = bflo(w.w) * 0.125f; q[c * 8 + 7] = bfhi(w.w) * 0.125f; }
#pragma unroll
        for (int c = 0; c < 64; ++c) o[c] = 0.f;
        float suffix = 0.f;
        for (int s = t0 + 62; s >= 0; --s) {
            const bool valid = s < t;
            if (s < t0 && __all(suffix > SB_EXIT)) break;
            const bf16* kp = Kb + ((size_t)b * SEQ + s) * C + h * HD; const bf16* vp = Vb + ((size_t)b * SEQ + s) * C + h * HD;
            float z = 0.f;
#pragma unroll
            for (int c = 0; c < 8; ++c) { const v4u w = *(const GAS v4u*)(kp + c * 8);
                z += q[c * 8 + 0] * bflo(w.x) + q[c * 8 + 1] * bfhi(w.x) + q[c * 8 + 2] * bflo(w.y) + q[c * 8 + 3] * bfhi(w.y) + q[c * 8 + 4] * bflo(w.z) + q[c * 8 + 5] * bfhi(w.z) + q[c * 8 + 6] * bflo(w.w) + q[c * 8 + 7] * bfhi(w.w); }
            const float sp = fmaxf(z, 0.f) + log1pf(__expf(-fabsf(z)));
            const float att = valid ? __expf(z - sp - suffix) : 0.f;
            suffix += valid ? sp : 0.f;
#pragma unroll
            for (int c = 0; c < 8; ++c) { const v4u w = *(const GAS v4u*)(vp + c * 8);
                o[c * 8 + 0] += att * bflo(w.x); o[c * 8 + 1] += att * bfhi(w.x); o[c * 8 + 2] += att * bflo(w.y); o[c * 8 + 3] += att * bfhi(w.y);
                o[c * 8 + 4] += att * bflo(w.z); o[c * 8 + 5] += att * bfhi(w.z); o[c * 8 + 6] += att * bflo(w.w); o[c * 8 + 7] += att * bfhi(w.w); }
        }
#pragma unroll
        for (int c = 0; c < 8; ++c) { v4u w; w.x = pk2(o[c * 8 + 0], o[c * 8 + 1]); w.y = pk2(o[c * 8 + 2], o[c * 8 + 3]); w.z = pk2(o[c * 8 + 4], o[c * 8 + 5]); w.w = pk2(o[c * 8 + 6], o[c * 8 + 7]);
            *(GAS v4u*)(Ob + rowq * C + h * HD + c * 8) = w; }
    }
}


typedef float f32x16 __attribute__((ext_vector_type(16)));
constexpr int AT_VP = 192;
constexpr int AT_WAVE_LDS = 32 * AT_VP;
__device__ __forceinline__ int crow32(int reg, int hh) { return (reg & 3) + 8 * (reg >> 2) + 4 * hh; }
__device__ __forceinline__ bf16x8s pack_step(const f32x16& x, const int s) {
    v4u p; p.x = pg8::cvt_pk_bf16(x[8 * s], x[8 * s + 1]); p.y = pg8::cvt_pk_bf16(x[8 * s + 2], x[8 * s + 3]); p.z = pg8::cvt_pk_bf16(x[8 * s + 4], x[8 * s + 5]); p.w = pg8::cvt_pk_bf16(x[8 * s + 6], x[8 * s + 7]);
    return __builtin_bit_cast(bf16x8s, p);
}
__device__ __forceinline__ void attn_mfma(unsigned char* ws, LAS unsigned char* lds, int gw, int NGW, int lane, int wave) {
    const bf16* Kb = (const bf16*)(ws + WS_B1); const bf16* Vb = (const bf16*)(ws + WS_B2); const bf16* Qb = (const bf16*)(ws + WS_B3); bf16* Ob = (bf16*)(ws + WS_B0);
    LAS unsigned char* vl = lds + wave * AT_WAVE_LDS;
    const int r32 = lane & 31, hh = lane >> 5;
    bf16x8s tri[2];
#pragma unroll
    for (int s = 0; s < 2; ++s)
#pragma unroll
        for (int j = 0; j < 8; ++j) tri[s][j] = (16 * s + 8 * (j >> 2) + 4 * hh + (j & 3)) > r32 ? (short)0x3F80 : (short)0;
    const int grp = lane >> 4, tq = (lane & 15) >> 2, tp = lane & 3;
    const LAS unsigned char* vtr0 = vl + (4 * hh + tq) * AT_VP + (16 * (grp & 1) + 4 * tp) * 2;
    for (int unit = gw; unit < BATCH * NH * (SEQ / 32); unit += NGW) {
        const int qb = unit % (SEQ / 32), bh = unit / (SEQ / 32), b = bh / NH, hd = bh % NH;
        const int t0 = qb * 32; const size_t rowb = (size_t)b * SEQ;
        bf16x8s qf[4];
#pragma unroll
        for (int ks = 0; ks < 4; ++ks) qf[ks] = *(const GAS bf16x8s*)(Qb + (rowb + t0 + r32) * C + hd * HD + 16 * ks + 8 * hh);
        f32x16 o[2];
#pragma unroll
        for (int i = 0; i < 16; ++i) { o[0][i] = 0.f; o[1][i] = 0.f; }
        float carry = 0.f;
        for (int s0 = t0; s0 >= 0; s0 -= 32) {
            bf16x8s kf[4];
#pragma unroll
            for (int ks = 0; ks < 4; ++ks) kf[ks] = *(const GAS bf16x8s*)(Kb + (rowb + s0 + r32) * C + hd * HD + 16 * ks + 8 * hh);
            v4u vreg[4];
#pragma unroll
            for (int i = 0; i < 4; ++i) { const int cidx = lane + 64 * i; vreg[i] = *(const GAS v4u*)(Vb + (rowb + s0 + (cidx >> 3)) * C + hd * HD + (cidx & 7) * 8); }
            f32x16 st;
#pragma unroll
            for (int i = 0; i < 16; ++i) st[i] = 0.f;
#pragma unroll
            for (int ks = 0; ks < 4; ++ks) st = __builtin_amdgcn_mfma_f32_32x32x16_bf16(kf[ks], qf[ks], st, 0, 0, 0);
#pragma unroll
            for (int i = 0; i < 4; ++i) { const int cidx = lane + 64 * i; *(LAS v4u*)(vl + (cidx >> 3) * AT_VP + (cidx & 7) * 16) = vreg[i]; }
            f32x16 zz, uu; float tot = 0.f; const int tq_ = t0 + r32;
            if (s0 + 31 < t0) {
#pragma unroll
                for (int i = 0; i < 16; ++i) { const float z = st[i] * 0.18033688011112042f; const float sp = fmaxf(z, 0.f) + __builtin_amdgcn_logf(1.0f + __builtin_amdgcn_exp2f(-fabsf(z)));
                    zz[i] = z - sp; uu[i] = sp; tot += sp; }
            } else {
#pragma unroll
                for (int i = 0; i < 16; ++i) { const int key = s0 + crow32(i, hh); const float z = st[i] * 0.18033688011112042f; const float sp = fmaxf(z, 0.f) + __builtin_amdgcn_logf(1.0f + __builtin_amdgcn_exp2f(-fabsf(z)));
                    const bool valid = key < tq_; zz[i] = valid ? z - sp : -1e30f; uu[i] = valid ? sp : 0.f; tot += uu[i]; }
            }
            f32x16 w;
#pragma unroll
            for (int i = 0; i < 16; ++i) w[i] = 0.f;
#pragma unroll
            for (int s = 0; s < 2; ++s) w = __builtin_amdgcn_mfma_f32_32x32x16_bf16(tri[s], pack_step(uu, s), w, 0, 0, 0);
            f32x16 pp;
#pragma unroll
            for (int i = 0; i < 16; ++i) pp[i] = __builtin_amdgcn_exp2f(zz[i] - w[i] - carry);
            tot += shx(tot, 32, lane); carry += tot;
            asm volatile("s_waitcnt lgkmcnt(0)" ::: "memory");
#pragma unroll
            for (int s = 0; s < 2; ++s) { const bf16x8s pa = pack_step(pp, s);
#pragma unroll
                for (int dt = 0; dt < 2; ++dt) {
                    const v4i16_t lo = __builtin_amdgcn_ds_read_tr16_b64_v4i16((LAS v4i16_t*)(vtr0 + (16 * s) * AT_VP + dt * 64));
                    const v4i16_t hi = __builtin_amdgcn_ds_read_tr16_b64_v4i16((LAS v4i16_t*)(vtr0 + (16 * s + 8) * AT_VP + dt * 64));
                    const bf16x8s vf = (bf16x8s){lo[0], lo[1], lo[2], lo[3], hi[0], hi[1], hi[2], hi[3]};
                    o[dt] = __builtin_amdgcn_mfma_f32_32x32x16_bf16(pa, vf, o[dt], 0, 0, 0); } }
            asm volatile("" ::: "memory");
            if (s0 < t0 && __all(carry > SB_EXIT * 1.4426950408889634f)) break;
        }
#pragma unroll
        for (int dt = 0; dt < 2; ++dt)
#pragma unroll
            for (int i = 0; i < 16; ++i) Ob[(rowb + t0 + crow32(i, hh)) * C + hd * HD + 32 * dt + r32] = (bf16)f2bf(o[dt][i]);
    }
}
__global__ void __launch_bounds__(NWAVES * 64, 2) yoco_fwd(Args args) {
    extern __shared__ __attribute__((aligned(16))) unsigned char lds_raw[];
    LAS unsigned char* lds = (LAS unsigned char*)lds_raw;
    const int G = gridDim.x; const int bx = blockIdx.x;
    int wave = __builtin_amdgcn_readfirstlane(threadIdx.x >> 6); asm volatile("" : "+s"(wave));
#define IDS() int lane; asm volatile("v_mbcnt_lo_u32_b32 %0, -1, 0\n\tv_mbcnt_hi_u32_b32 %0, -1, %0" : "=v"(lane)); const int tid = wave * 64 + lane; (void)tid; \
    const int vcu = (G % 8 == 0) ? (bx % 8) * (G / 8) + bx / 8 : bx; const int gw = vcu * NWAVES + wave, NGW = G * NWAVES; (void)lane; (void)gw; (void)NGW;
    unsigned char* ws = WSP();
    volatile LAS unsigned* MISC = (volatile LAS unsigned*)(lds + MISC_OFF);
    volatile LAS int* tab = (volatile LAS int*)(lds + MOE_TAB_OFF);
    for (int u = threadIdx.x; u < (LDS_BYTES - LDSCTL_OFF) / 4; u += NWAVES * 64) ((LAS unsigned*)(lds + LDSCTL_OFF))[u] = 0u;
    __syncthreads();
    XcdBarrier bar; bar.bar = (unsigned*)(ws + WS_CTL) + CW_BAR; bar.x = 0; bar.st = nullptr;
    if (N_LAUNCHES == 1) bar = xcd_barrier_post((unsigned*)(ws + WS_CTL) + CW_BAR, MISC + 8);
    const int lo = KA_INT(0), hi = KA_INT(1);
#ifndef PROBE_PH
#define PROBE_PH -1
#endif
#define IN(k) (lo <= (k) && (k) < hi)
#define REP(k) for (int rep_ = 0; rep_ < ((PROBE_PH == (k)) ? 2 : 1); ++rep_)
#define SEAM(k) do { if (IN(k) && IN((k) + 1)) xcd_barrier(bar); } while (0)

    if (IN(PH_P0)) REP(PH_P0) { IDS(); p0_weights<0>(ws, lds, gw, NGW, wave, lane); p0_weights<1>(ws, lds, gw, NGW, wave, lane); if (G <= 64) p0_weights<2>(ws, lds, gw, NGW, wave, lane); p0_rows(ws, gw, NGW, lane); }
    SEAM(PH_P0);
    if (PROBE_PH == 100 && N_LAUNCHES == 1) { for (int i_ = 0; i_ < 10; ++i_) xcd_barrier(bar); }
    if (IN(PH_LORA)) REP(PH_LORA) {
        SchedGrouped<1, 3> S{(const char*)(ws + WS_B1), (size_t)(WS_B2 - WS_B1), nullptr, (const char*)(ws + WS_WT_LORA), (size_t)256 * C * 2, G, bx};
        EpiLora E{(bf16*)(ws + WS_LW)};
        pg8::gemm_phase<EpiLora, SchedGrouped<1, 3>, true, false, C>(lds, S, E, wave);
    }
    SEAM(PH_LORA);
    if (IN(PH_RKV)) REP(PH_RKV) {
        SchedGrouped<4, 3> S{(const char*)OUTP(), (size_t)M * C * 2, (const char*)(ws + WS_B4), (const char*)(ws + WS_WT_RKV), (size_t)C * C * 2, G, bx};
        EpiSplit3 E{(bf16*)(ws + WS_B1), false, nullptr};
        pg8::gemm_phase<EpiSplit3, SchedGrouped<4, 3>, true, false, C>(lds, S, E, wave);
    }
    SEAM(PH_RKV);
    if (IN(PH_S1)) REP(PH_S1) { IDS(); scan_s1(ws, lds, lane, wave); }
    SEAM(PH_S1);
    if (IN(PH_S2)) REP(PH_S2) { IDS();
        if (bx < BATCH * NH || G <= BATCH * NH) scan_s2(ws, lds, lane, wave);
        }
    SEAM(PH_S2);
    if (IN(PH_S3)) REP(PH_S3) { IDS(); scan_s3(ws, lds, lane, wave); }
    SEAM(PH_S3);
#if MK_DEBUG
    if (IN(PH_DBG0)) { IDS(); scan_naive(ws, lds, tid); }
    SEAM(PH_DBG0);
    if (IN(PH_DBG0 + 1)) { IDS(); post_scan(ws, gw, NGW, lane); }
    SEAM(PH_DBG0 + 1);
    if (IN(PH_DBG0 + 2)) { IDS(); dbg_compare(ws, (const bf16*)(ws + WS_B0), (const bf16*)(ws + WS_B4), gw, NGW, lane); }
    SEAM(PH_DBG0 + 2);
#endif
    if (IN(PH_WOUT)) REP(PH_WOUT) {
        SchedGrouped<4, 1> S{(const char*)(ws + ((MK_DEBUG && DBG_USE_NAIVE) ? WS_B4 : WS_B0)), 0, nullptr, (const char*)(ws + WS_WT_OUT), 0, G, bx};
        EpiResidBf<true> E{INP(0), (bf16*)(ws + WS_B4)};
        pg8::gemm_phase<EpiResidBf<true>, SchedGrouped<4, 1>, true, false, C>(lds, S, E, wave);
    }
    SEAM(PH_WOUT);
#pragma unroll 1
    for (int layer = 0; layer < 2; ++layer) {
        const int pb = layer == 0 ? (int)PH_ROUT0 : (int)PH_ROUT1;
        if (IN(pb)) { IDS(); if (PROBE_PH == 101 && layer == 0) router_rows(ws, lds, layer, gw, NGW, lane, tid, wave, true); router_rows(ws, lds, layer, gw, NGW, lane, tid, wave); }
        SEAM(pb);
        if (IN(pb + 1)) REP(pb + 1) {
            { IDS(); moe_table(ws, tab, layer, tid); }
            SchedMoe<2, C, true> S{(const char*)(ws + WS_B4), (const char*)(ws + WS_WT_GU) + (size_t)layer * 16 * 512 * C * 2, (size_t)512 * C * 2, (const unsigned*)(ws + WS_LIST), tab, G, bx};
            EpiGU E{(bf16*)(ws + WS_HID), (const float*)(ws + WS_WL), (const float*)(ws + WS_B0)};
            pg8::gemm_phase<EpiGU, SchedMoe<2, C, true>, true, true, C>(lds, S, E, wave);
            if (layer == 0 && G > 64) { const int nr2 = __builtin_amdgcn_readfirstlane(tab[48]) * 2 - G, first = nr2 > 0 ? nr2 : 0;
                if (bx >= first) { IDS(); p0_weights<2>(ws, lds, (bx - first) * NWAVES + wave, (G - first) * NWAVES, wave, lane); } }
        }
        SEAM(pb + 1);
        if (IN(pb + 2)) REP(pb + 2) {
            { IDS(); moe_table(ws, tab, layer, tid); }
            SchedMoe<4, FE, false> S{(const char*)(ws + WS_HID), (const char*)(ws + WS_WT_DN) + (size_t)layer * 16 * C * FE * 2, (size_t)C * FE * 2, (const unsigned*)(ws + WS_LIST), tab, G, bx};
            EpiDown E{(bf16*)(ws + WS_B2), (const unsigned*)(ws + WS_LIST)};
            pg8::gemm_phase<EpiDown, SchedMoe<4, FE, false>, true, false, FE>(lds, S, E, wave);
        }
        SEAM(pb + 2);
        if (layer == 0) {
            if (IN(PH_COMB)) { IDS(); if (PROBE_PH == 102) combine_rows(ws, 0, gw, NGW, lane, true); combine_rows(ws, 0, gw, NGW, lane); }
            SEAM(PH_COMB);
            if (IN(PH_KVQ)) REP(PH_KVQ) {
                SchedGrouped<12, 1> S{(const char*)(ws + WS_B4), 0, nullptr, (const char*)(ws + WS_WT_KVQ), 0, G, bx};
                EpiSplit3 E{(bf16*)(ws + WS_B1), true, (const float*)(ws + WS_B0)};
                pg8::gemm_phase<EpiSplit3, SchedGrouped<12, 1>, true, false, C>(lds, S, E, wave);
            }
            SEAM(PH_KVQ);
            if (IN(PH_ATTN)) REP(PH_ATTN) { IDS(); attn_mfma(ws, lds, gw, NGW, lane, wave); }
            SEAM(PH_ATTN);
            if (IN(PH_SBO)) {
                SchedGrouped<4, 1> S{(const char*)(ws + WS_B0), 0, nullptr, (const char*)(ws + WS_WT_SBO), 0, G, bx};
                EpiResidBf<false> E{(const void*)(ws + WS_B4), (bf16*)(ws + WS_B4)};
                pg8::gemm_phase<EpiResidBf<false>, SchedGrouped<4, 1>, true, false, C>(lds, S, E, wave);
            }
            SEAM(PH_SBO);
        }
    }
    if (IN(PH_FINAL)) { IDS(); combine_rows(ws, 1, gw, NGW, lane); }
#undef IN
#undef SEAM
}

extern "C" void kernel_launch(void* const* d_in, const int* in_sizes, int n_in, void* d_out, int out_size, void* d_ws, size_t ws_size, hipStream_t stream) {
    static int grid = 0;
    if (grid == 0) {
        if (n_in != 31 || in_sizes[0] != M * C || out_size != M * C || ws_size < WS_END) { fprintf(stderr, "kernel_launch: unexpected shapes (n_in %d, in0 %d, out %d, ws %zu); nothing launched\n", n_in, n_in > 0 ? in_sizes[0] : -1, out_size, ws_size); grid = -1; return; }
        int dev = 0, cus = 0, per_cu = 0;
        if (hipGetDevice(&dev) != hipSuccess || hipDeviceGetAttribute(&cus, hipDeviceAttributeMultiprocessorCount, dev) != hipSuccess) { grid = -1; return; }
        if (hipFuncSetAttribute((const void*)yoco_fwd, hipFuncAttributeMaxDynamicSharedMemorySize, LDS_BYTES) != hipSuccess) { fprintf(stderr, "kernel_launch: hipFuncSetAttribute failed\n"); grid = -1; return; }
        if (hipOccupancyMaxActiveBlocksPerMultiprocessor(&per_cu, (const void*)yoco_fwd, NWAVES * 64, LDS_BYTES) != hipSuccess || per_cu < 1) fprintf(stderr, "kernel_launch: occupancy query reports %d\n", per_cu);
        (void)hipGetLastError();
        grid = cus - (cus % 16);
    }
    if (grid < 0) return;
    if (hipMemsetAsync((char*)d_ws + WS_CTL, 0, CTL_ZERO_BYTES, stream) != hipSuccess) return;
    Args a{};
    for (int i = 0; i < 31; ++i) a.in[i] = (const float*)d_in[i];
    a.out = (float*)d_out; a.ws = (unsigned char*)d_ws;
    for (int li = 0; li < (N_LAUNCHES == 1 ? 1 : (int)NPHASE); ++li) {
        a.ph_lo = (N_LAUNCHES == 1) ? 0 : li; a.ph_hi = (N_LAUNCHES == 1) ? NPHASE : li + 1; a.li = li;
        hipLaunchKernelGGL(yoco_fwd, dim3(grid), dim3(NWAVES * 64), LDS_BYTES, stream, a);
        const hipError_t le = hipPeekAtLastError();
        if (le != hipSuccess) { fprintf(stderr, "kernel_launch: launch %d failed: %s\n", li, hipGetErrorName(le)); break; }
    }
}
```

```cpp
#include <hip/hip_runtime.h>
#include <cstdio>
#include <cstdint>

#ifndef MK_N_LAUNCHES
#define MK_N_LAUNCHES 1
#endif

namespace pg8 {
#define PG8_LAS __attribute__((address_space(3)))
typedef unsigned short bf16_t;
typedef short bf16x8 __attribute__((ext_vector_type(8)));
typedef float f32x4 __attribute__((ext_vector_type(4)));
typedef unsigned u32x4 __attribute__((ext_vector_type(4)));
constexpr int BM = 256, BK = 64, HALF = 128, HTB = HALF * BK * 2, STAGE_BYTES = 8 * HTB, NXCD = 8, WGM = 8;

__host__ __device__ __forceinline__ int lds_byte(int r, int c) { const int st = (r >> 4) * 2 + (c >> 5), rr = r & 15, cc = c & 31, ob = rr * 64 + cc * 2; return st * 1024 + (ob ^ (((ob >> 9) & 1) << 5)); }
__host__ __device__ __forceinline__ void stage_rc(int b, int& R, int& C) { const int st = b / 1024, sb = b % 1024, swz = sb ^ (((sb >> 9) & 1) << 5); R = (st >> 1) * 16 + swz / 64; C = (st & 1) * 32 + (swz % 64) / 2; }
__host__ __device__ __forceinline__ int perm32(int rho) { const int n = rho >> 4, i = rho & 15; return 8 * (i >> 2) + 4 * n + (i & 3); }

struct Unit { int pm, pn, aux, r0, cnt; };

__host__ __device__ __forceinline__ void tile_map(int wgid, int nM, int nN, int& pm, int& pn) {
    const int nwg = nM * nN;
    { const int q = nwg / NXCD, r = nwg % NXCD, xcd = wgid % NXCD, off = wgid / NXCD; wgid = (xcd < r ? xcd * (q + 1) : r * (q + 1) + (xcd - r) * q) + off; }
    const int nig = WGM * nN, gid = wgid / nig, fm = gid * WGM, gsz = (nM - fm) < WGM ? (nM - fm) : WGM;
    pm = fm + ((wgid % nig) % gsz); pn = (wgid % nig) / gsz;
}

typedef float f32x2_t __attribute__((ext_vector_type(2))); typedef __bf16 bf16x2_t __attribute__((ext_vector_type(2)));
__device__ __forceinline__ unsigned cvt_pk_bf16(float lo, float hi) { const f32x2_t v = {lo, hi}; const bf16x2_t b = __builtin_convertvector(v, bf16x2_t); return __builtin_bit_cast(unsigned, b); }

template <class Epi, class Sched, bool ALIGN_EPI, bool GATHER, int K>
__device__ __forceinline__ void gemm_phase(PG8_LAS unsigned char* lds, const Sched& S, const Epi& E, const int wid) {
    int lane_; asm volatile("v_mbcnt_lo_u32_b32 %0, -1, 0\n\tv_mbcnt_hi_u32_b32 %0, -1, %0" : "=v"(lane_));
    const int lane = lane_, tid = wid * 64 + lane, wr = wid >> 2, wc = wid & 3, fr = lane & 15, fq = lane >> 4;
    constexpr int nt = K / BK;
    unsigned voffA[2], voffB[2];
#pragma unroll
    for (int i = 0; i < 2; ++i) { int R, C; stage_rc(tid * 16 + i * 8192, R, C); const int Rb = Epi::PERM ? ((R & ~31) + perm32(R & 31)) : R;
        voffA[i] = (unsigned)(R * K + C) * 2u; voffB[i] = (unsigned)(Rb * K + C) * 2u; }
    constexpr size_t kstep = (size_t)(BK * 2);
    constexpr size_t hstep = (size_t)HALF * K * 2;
    const unsigned ldsw = (unsigned)wid * 1024u;
    const int aoff = lds_byte(wr * 64 + fr, fq * 8), boff = lds_byte(wc * 32 + fr, fq * 8);
#define PG8_SA(b, h) (((b) * 2 + (h)) * HTB)
#define PG8_SB(b, h) ((4 + (b) * 2 + (h)) * HTB)
#define PG8_STAGE(bufoff, gbase, voff) do { _Pragma("unroll") for (int _i = 0; _i < 2; ++_i) \
        __builtin_amdgcn_global_load_lds((const unsigned*)((const char*)(gbase) + (voff)[_i]), (PG8_LAS unsigned*)(lds + (bufoff) + ldsw + _i * 8192), 16, 0, 0); } while (0)
#define PG8_LDA(dst, b, h) do { _Pragma("unroll") for (int m = 0; m < 4; ++m) _Pragma("unroll") for (int k = 0; k < 2; ++k) dst[m][k] = *(const PG8_LAS bf16x8*)(lds + PG8_SA(b, h) + aoff + m * 2048 + k * 1024); } while (0)
#define PG8_LDB(dst, b, h) do { _Pragma("unroll") for (int n = 0; n < 2; ++n) _Pragma("unroll") for (int k = 0; k < 2; ++k) dst[n][k] = *(const PG8_LAS bf16x8*)(lds + PG8_SB(b, h) + boff + n * 2048 + k * 1024); } while (0)
#define PG8_MMA(ai, bj, At, Bt) do { __builtin_amdgcn_s_setprio(1); _Pragma("unroll") for (int m = 0; m < 4; ++m) _Pragma("unroll") for (int n = 0; n < 2; ++n) _Pragma("unroll") for (int k = 0; k < 2; ++k) \
        acc[ai][bj][m][n] = __builtin_amdgcn_mfma_f32_16x16x32_bf16(Bt[n][k], At[m][k], acc[ai][bj][m][n], 0, 0, 0); __builtin_amdgcn_s_setprio(0); } while (0)
#define PG8_WAIT_V(n) asm volatile("s_waitcnt vmcnt(" #n ")" ::: "memory")
#define PG8_WAIT_L(n) asm volatile("s_waitcnt lgkmcnt(" #n ")" ::: "memory")
#define PG8_BAR __builtin_amdgcn_s_barrier()
#define PG8_SCHED __builtin_amdgcn_sched_barrier(0)
    Unit cur, nxt; int ui = 0;
    if (!S.next(0, cur)) return;
    f32x4 acc[2][2][4][2];
#pragma unroll
    for (int a = 0; a < 2; ++a)
#pragma unroll
        for (int b = 0; b < 2; ++b)
#pragma unroll
            for (int m = 0; m < 4; ++m)
#pragma unroll
                for (int n = 0; n < 2; ++n) acc[a][b][m][n] = (f32x4){0.f, 0.f, 0.f, 0.f};
    bf16x8 At[4][2], B0[2][2], B1[2][2];
    unsigned vc[2][2];
#define PG8_GOFF(u) do { _Pragma("unroll") for (int _h = 0; _h < 2; ++_h) _Pragma("unroll") for (int _i = 0; _i < 2; ++_i) { int _R, _C; stage_rc(tid * 16 + _i * 8192, _R, _C); \
        vc[_h][_i] = S.a_row_off(u, _h * HALF + _R) + (unsigned)_C * 2u; } } while (0)
#define PG8_STAGE_A(bufoff, gbase, h) do { if constexpr (GATHER) { PG8_STAGE(bufoff, gbase, vc[h]); } else { PG8_STAGE(bufoff, (gbase) + (h) * hstep, voffA); } } while (0)
    if constexpr (GATHER) PG8_GOFF(cur);
    const char* cA = S.a_base(cur); const char* cB = S.b_base(cur);
    PG8_STAGE(PG8_SB(0, 0), cB, voffB); PG8_STAGE(PG8_SB(0, 1), cB + hstep, voffB); PG8_STAGE_A(PG8_SA(0, 0), cA, 0); PG8_STAGE_A(PG8_SA(0, 1), cA, 1);
    if (wr == 1) PG8_BAR;
    PG8_WAIT_V(2); PG8_BAR;
    PG8_STAGE(PG8_SB(1, 0), cB + kstep, voffB); PG8_STAGE_A(PG8_SA(1, 0), cA + kstep, 0); PG8_STAGE(PG8_SB(1, 1), cB + hstep + kstep, voffB);
    PG8_WAIT_V(6); PG8_BAR;
    for (;;) {
        const bool has_next = S.next(ui + 1, nxt);
        const char* nA = has_next ? S.a_base(nxt) : cA; const char* nB = has_next ? S.b_base(nxt) : cB;
        for (int t = 0; t < nt; t += 2) {
            const bool last = (t == nt - 2);
            const char* a1 = cA + (size_t)(t + 1) * kstep;
            const char* a2 = last ? nA : cA + (size_t)(t + 2) * kstep; const char* b2 = last ? nB : cB + (size_t)(t + 2) * kstep;
            const char* a3 = a2 + kstep; const char* b3 = b2 + kstep;
            PG8_LDB(B0, 0, 0); PG8_LDB(B1, 0, 1); PG8_SCHED; PG8_LDA(At, 0, 0); PG8_STAGE_A(PG8_SA(1, 1), a1, 1);
            if constexpr (GATHER) { if (last && has_next) PG8_GOFF(nxt); }
            PG8_WAIT_V(8); PG8_WAIT_L(0); PG8_BAR; PG8_MMA(0, 0, At, B0); PG8_MMA(0, 1, At, B1); PG8_BAR; PG8_SCHED;
            PG8_LDA(At, 0, 1); PG8_STAGE(PG8_SB(0, 0), b2, voffB); PG8_STAGE(PG8_SB(0, 1), b2 + hstep, voffB); PG8_STAGE_A(PG8_SA(0, 0), a2, 0);
            PG8_WAIT_V(8); PG8_WAIT_L(0); PG8_BAR; PG8_MMA(1, 0, At, B0); PG8_MMA(1, 1, At, B1); PG8_BAR; PG8_SCHED;
            PG8_LDB(B0, 1, 0); PG8_LDB(B1, 1, 1); PG8_SCHED; PG8_LDA(At, 1, 0); PG8_STAGE_A(PG8_SA(0, 1), a2, 1);
            PG8_WAIT_V(8); PG8_WAIT_L(0); PG8_BAR; PG8_MMA(0, 0, At, B0); PG8_MMA(0, 1, At, B1); PG8_BAR; PG8_SCHED;
            PG8_LDA(At, 1, 1); PG8_STAGE(PG8_SB(1, 0), b3, voffB); PG8_STAGE(PG8_SB(1, 1), b3 + hstep, voffB); PG8_STAGE_A(PG8_SA(1, 0), a3, 0);
            PG8_WAIT_V(8); PG8_WAIT_L(0); PG8_BAR; PG8_MMA(1, 0, At, B0); PG8_MMA(1, 1, At, B1); PG8_BAR; PG8_SCHED;
        }
        if constexpr (ALIGN_EPI) { if (wr == 0) PG8_BAR; }
        E(acc, cur, wr, wc, fr, fq);
        if (!has_next) break;
#pragma unroll
        for (int a = 0; a < 2; ++a)
#pragma unroll
            for (int b = 0; b < 2; ++b)
#pragma unroll
                for (int m = 0; m < 4; ++m)
#pragma unroll
                    for (int n = 0; n < 2; ++n) acc[a][b][m][n] = (f32x4){0.f, 0.f, 0.f, 0.f};
        cur = nxt; cA = nA; cB = nB; ++ui;
        if constexpr (ALIGN_EPI) { if (wr == 1) PG8_BAR; }
    }
    PG8_WAIT_V(0);
    if constexpr (!ALIGN_EPI) { if (wr == 0) PG8_BAR; }
    PG8_BAR;
#undef PG8_SA
#undef PG8_SB
#undef PG8_STAGE
#undef PG8_STAGE_A
#undef PG8_GOFF
#undef PG8_LDA
#undef PG8_LDB
#undef PG8_MMA
#undef PG8_WAIT_V
#undef PG8_WAIT_L
#undef PG8_BAR
#undef PG8_SCHED
}
}

constexpr int NWAVES = 8;
#ifndef MK_DEBUG
#define MK_DEBUG 0
#endif
#ifndef DBG_USE_NAIVE
#define DBG_USE_NAIVE 0
#endif
constexpr int DBGP = MK_DEBUG ? 3 : 0;
enum Phase { PH_P0 = 0, PH_LORA, PH_RKV, PH_S1, PH_S2, PH_S3, PH_DBG0, PH_WOUT = PH_DBG0 + DBGP, PH_ROUT0, PH_GU0, PH_DN0, PH_COMB, PH_KVQ, PH_ATTN, PH_SBO, PH_ROUT1, PH_GU1, PH_DN1, PH_FINAL, NPHASE };
constexpr int N_LAUNCHES = MK_N_LAUNCHES;


constexpr int BATCH = 2, SEQ = 8192, C = 1024, NH = 16, HD = 64, M = BATCH * SEQ;
constexpr int NE = 16, FE = 256, DW = 64, DA = 64, DG = 160;
constexpr float RMS_EPS = 1e-6f, GN_EPS = 64e-5f;
constexpr float SB_EXIT = 104.0f;

constexpr size_t MiB = 1u << 20;
constexpr size_t WS_CTL = 0, CTL_ZERO_BYTES = 64 * 1024;
constexpr size_t WS_WT_W2 = 128 * 1024, WS_WT_A2 = 256 * 1024, WS_WT_G2 = 384 * 1024;
constexpr size_t WS_WT_RKV = 1 * MiB;
constexpr size_t WS_WT_LORA = 7 * MiB;
constexpr size_t WS_WT_OUT = 9 * MiB;
constexpr size_t WS_WT_KVQ = 11 * MiB;
constexpr size_t WS_WT_SBO = 17 * MiB;
constexpr size_t WS_WT_GU = 19 * MiB;
constexpr size_t WS_WT_DN = 51 * MiB;
constexpr size_t WS_LW = 67 * MiB;
constexpr size_t WS_LA = 69 * MiB;
constexpr size_t WS_LG = 71 * MiB;
static_assert(WS_LA == WS_LW + 2 * MiB && WS_LG == WS_LW + 4 * MiB, "EpiLora's pointer arithmetic");
constexpr size_t WS_LIST = 76 * MiB;
constexpr size_t WS_WL = 77 * MiB;
constexpr size_t WS_HID = 78 * MiB;
constexpr size_t WS_B0 = 96 * MiB, WS_B1 = 128 * MiB, WS_B2 = 160 * MiB, WS_B3 = 192 * MiB, WS_B4 = 224 * MiB, WS_END = 256 * MiB;
static_assert(WS_HID + (size_t)144 * 256 * 256 * 2 <= WS_B0, "HID vs B0");
constexpr int CW_TMO = 0;
constexpr int CW_CNT = 1024;
constexpr int CW_BAR = 4096;

constexpr int RING_BYTES = 131072;
constexpr int LDSCTL_OFF = 146688, MISC_OFF = LDSCTL_OFF + 320, MOE_TAB_OFF = MISC_OFF + 128;
constexpr int LDS_BYTES = 147456;
static_assert(MOE_TAB_OFF + 256 <= LDS_BYTES, "LDS map");
static_assert(BATCH * NH * (SEQ / 64) % 16 == 0, "scan units");

#define GAS __attribute__((address_space(1)))
#define LAS __attribute__((address_space(3)))
typedef unsigned short bf16;
typedef unsigned v4u __attribute__((ext_vector_type(4)));
typedef unsigned v2u __attribute__((ext_vector_type(2)));
typedef float f32x4 __attribute__((ext_vector_type(4)));
typedef GAS unsigned gu32;
#define RLX_AGENT __ATOMIC_RELAXED, __HIP_MEMORY_SCOPE_AGENT
#define LDS_WAIT() asm volatile("s_waitcnt lgkmcnt(0)" ::: "memory")
#define VM_WAIT() asm volatile("s_waitcnt vmcnt(0)" ::: "memory")
__device__ __forceinline__ unsigned f2bf(float f) { unsigned u = __builtin_bit_cast(unsigned, f); return (u + 0x7fffu + ((u >> 16) & 1u)) >> 16; }
__device__ __forceinline__ unsigned pk2(float lo, float hi) { return f2bf(lo) | (f2bf(hi) << 16); }
__device__ __forceinline__ float bflo(unsigned u) { return __uint_as_float(u << 16); }
__device__ __forceinline__ float bfhi(unsigned u) { return __uint_as_float(u & 0xffff0000u); }
__device__ __forceinline__ float bf2f(bf16 b) { return __uint_as_float((unsigned)b << 16); }
__device__ __forceinline__ float sigmoidf_(float x) { return 1.0f / (1.0f + __expf(-x)); }

#define XB_TMO      128
#define XB_XCNT(j)  (256  + 64 * (j))
#define XB_XSUB(j)  (1280 + 64 * (j))
#define XB_XGEN(j)  (2304 + 64 * (j))
#define XB_TOP      3328
#define XB_TOPGEN   3392
#define XCD_BAR_WORDS 3456
#define XB_SPIN_CAP (1u << 18)
__device__ __forceinline__ unsigned xb_ld(unsigned* p)              { return __hip_atomic_load(p, __ATOMIC_RELAXED, __HIP_MEMORY_SCOPE_AGENT); }
__device__ __forceinline__ unsigned xb_add(unsigned* p, unsigned v) { return __hip_atomic_fetch_add(p, v, __ATOMIC_RELAXED, __HIP_MEMORY_SCOPE_AGENT); }
__device__ __forceinline__ unsigned xb_xcc_id() { return (unsigned)__builtin_amdgcn_s_getreg((3 << 11) | 20) & 0xFu; }
#define XB_SPIN(cond, bar) do { unsigned _sp = 0; while (cond) { __builtin_amdgcn_s_sleep(1); \
    if ((++_sp & 255u) == 0u) { if (xb_ld(&(bar)[XB_TMO])) break; if (_sp > XB_SPIN_CAP) { atomicAdd(&(bar)[XB_TMO], 1u); break; } } } } while (0)
struct XcdBarrier { unsigned* bar; unsigned x; volatile LAS unsigned* st; };
__device__ __forceinline__ XcdBarrier xcd_barrier_post(unsigned* bar, volatile LAS unsigned* st) {
    XcdBarrier b; b.bar = bar; b.x = xb_xcc_id(); b.st = st;
    if (threadIdx.x == 0) (void)xb_add(&bar[XB_XCNT(b.x)], 1u);
    return b;
}
__device__ __forceinline__ void xcd_barrier_complete(unsigned* bar, unsigned x, unsigned& nloc, unsigned& nx) {
    const unsigned G = gridDim.x * gridDim.y * gridDim.z;
    unsigned sum, cnt, mine, sp = 0u;
    for (;;) {
        sum = 0u; cnt = 0u; mine = 0u;
#pragma unroll
        for (unsigned j = 0; j < 16; ++j) { const unsigned c = xb_ld(&bar[XB_XCNT(j)]); sum += c; cnt += (c > 0u) ? 1u : 0u; mine = (j == x) ? c : mine; }
        if (sum == G) break;
        __builtin_amdgcn_s_sleep(1);
        if ((++sp & 255u) == 0u) { if (xb_ld(&bar[XB_TMO])) break; if (sp > XB_SPIN_CAP) { atomicAdd(&bar[XB_TMO], 1u); break; } }
    }
    nloc = mine > 0u ? mine : 1u; nx = cnt > 0u ? cnt : 1u;
}
__device__ __forceinline__ void xcd_barrier(const XcdBarrier& b) {
    asm volatile("s_waitcnt vmcnt(0)" ::: "memory");
    __syncthreads();
    if (threadIdx.x == 0) {
        unsigned* bar = b.bar;
        __builtin_amdgcn_s_waitcnt(0);
        unsigned nloc = b.st[0], nx = b.st[1];
        if (nloc == 0u) { xcd_barrier_complete(bar, b.x, nloc, nx); b.st[0] = nloc; b.st[1] = nx; }
        const unsigned old = xb_add(&bar[XB_XSUB(b.x)], 1u);
        const unsigned gen = old / nloc;
        if (old + 1u == (gen + 1u) * nloc) {
            __builtin_amdgcn_fence(__ATOMIC_RELEASE, "agent");
            asm volatile("s_waitcnt vmcnt(0)" ::: "memory");
            const unsigned og = xb_add(&bar[XB_TOP], 1u);
            const unsigned tg = og / nx;
            if (og + 1u == (tg + 1u) * nx) xb_add(&bar[XB_TOPGEN], 1u);
            else XB_SPIN(xb_ld(&bar[XB_TOPGEN]) == tg, bar);
            __builtin_amdgcn_fence(__ATOMIC_ACQUIRE, "agent");
            xb_add(&bar[XB_XGEN(b.x)], 1u);
            asm volatile("s_waitcnt vmcnt(0)" ::: "memory");
        } else {
            XB_SPIN(xb_ld(&bar[XB_XGEN(b.x)]) == gen, bar);
            __builtin_amdgcn_fence(__ATOMIC_ACQUIRE, "agent");
            asm volatile("s_waitcnt vmcnt(0)" ::: "memory");
        }
    }
    __syncthreads();
}

__device__ __forceinline__ float shx(float v, int o, int lane) { return __int_as_float(__builtin_amdgcn_ds_bpermute((lane ^ o) << 2, __float_as_int(v))); }
#define DPP_ADD(v, ctrl) ((v) + __int_as_float(__builtin_amdgcn_update_dpp(0, __float_as_int(v), (ctrl), 0xf, 0xf, true)))
__device__ __forceinline__ float wave_sum(float v, int lane) {
    (void)lane;
    v = DPP_ADD(v, 0x128); v = DPP_ADD(v, 0x124); v = DPP_ADD(v, 0x122); v = DPP_ADD(v, 0x121);
    const int iv = __float_as_int(v);
    return (__int_as_float(__builtin_amdgcn_readlane(iv, 0)) + __int_as_float(__builtin_amdgcn_readlane(iv, 16))) + (__int_as_float(__builtin_amdgcn_readlane(iv, 32)) + __int_as_float(__builtin_amdgcn_readlane(iv, 48)));
}
__device__ __forceinline__ float sum8(float v) { v = DPP_ADD(v, 0xB1); v = DPP_ADD(v, 0x4E); v = DPP_ADD(v, 0x141); return v; }
__device__ __forceinline__ void transpose_item(const float* W, int ldw, int k0, int n0, bf16* WT, int ldk, int dst_row0, const float* kscale, LAS float* scr, int lane, int kmax = 1 << 30) {
    const int r8 = lane >> 3, quad = lane & 7;
    f32x4 v[8];
#pragma unroll
    for (int i = 0; i < 8; ++i) { const int kk = r8 + 8 * i; v[i] = (k0 + kk < kmax) ? *(const GAS f32x4*)(W + (size_t)(k0 + kk) * ldw + n0 + quad * 4) : (f32x4){0.f, 0.f, 0.f, 0.f}; }
#pragma unroll
    for (int i = 0; i < 8; ++i) { const int kk = r8 + 8 * i; if (kscale) v[i] = v[i] * kscale[(k0 + kk < kmax) ? k0 + kk : 0]; *(LAS f32x4*)(scr + kk * 36 + ((quad ^ i) << 2)) = v[i]; }
    LDS_WAIT(); asm volatile("" ::: "memory");
    const int c = lane & 7;
#pragma unroll
    for (int j = 0; j < 4; ++j) { const int n = (lane >> 3) + 8 * j; const LAS float* sp = scr + (8 * c) * 36 + ((((n >> 2) ^ c) << 2) | (n & 3));
        v4u o; o.x = pk2(sp[0 * 36], sp[1 * 36]); o.y = pk2(sp[2 * 36], sp[3 * 36]); o.z = pk2(sp[4 * 36], sp[5 * 36]); o.w = pk2(sp[6 * 36], sp[7 * 36]);
        if (k0 + 8 * c < kmax) *(GAS v4u*)(WT + (size_t)(dst_row0 + n) * ldk + k0 + 8 * c) = o; }
    LDS_WAIT(); asm volatile("" ::: "memory");
}

struct Args { const float* in[31]; float* out; unsigned char* ws; int ph_lo, ph_hi, li, pad; };
typedef const __attribute__((address_space(4))) unsigned char* kaptr_t;
__device__ __forceinline__ kaptr_t ka_base() { kaptr_t p = (kaptr_t)__builtin_amdgcn_kernarg_segment_ptr(); asm volatile("" : "+s"(p)); return p; }
#define INP(k) (*(const float* const __attribute__((address_space(4)))*)(ka_base() + 8 * (k)))
#define OUTP() (*(float* const __attribute__((address_space(4)))*)(ka_base() + 8 * 31))
#define WSP() (*(unsigned char* const __attribute__((address_space(4)))*)(ka_base() + 8 * 32))
#define KA_INT(i) (*(const int __attribute__((address_space(4)))*)(ka_base() + 8 * 33 + 4 * (i)))

template <int PART> __device__ __forceinline__ void p0_weights(unsigned char* ws, LAS unsigned char* lds, int gw, int NGW, int wave, int lane) {
    LAS float* scr = (LAS float*)(lds + wave * 16384);
    bf16* WT_RKV = (bf16*)(ws + WS_WT_RKV); bf16* WT_LORA = (bf16*)(ws + WS_WT_LORA); bf16* WT_OUT = (bf16*)(ws + WS_WT_OUT); bf16* WT_KVQ = (bf16*)(ws + WS_WT_KVQ);
    bf16* WT_SBO = (bf16*)(ws + WS_WT_SBO); bf16* WT_GU = (bf16*)(ws + WS_WT_GU); bf16* WT_DN = (bf16*)(ws + WS_WT_DN);
    constexpr int I_UP = 32 + 32 + 96, I_RKV = 3 * 512, I_LORA = 32 + 32 + 80, I_OUT = 512, I_KV = 1024, I_Q = 512, I_SBO = 512, I_G = 32 * 128, I_U = 32 * 128, I_D = 32 * 128;
    constexpr int NDENSE = I_UP + I_RKV + I_LORA + I_OUT + I_KV + I_Q + I_SBO, NITEMS = NDENSE + I_G + I_U + I_D;
    constexpr int NLOOP = PART == 0 ? NDENSE : 3 * 2048; (void)NITEMS;
    for (int q_ = gw; q_ < NLOOP; q_ += NGW) {
        const int it = PART == 0 ? q_ : NDENSE + (q_ / 2048) * 4096 + 2048 * (PART - 1) + (q_ % 2048);
        int r = it;
        if (r < I_UP) {
            if (r < 32) transpose_item(INP(9), C, 0, 32 * r, (bf16*)(ws + WS_WT_W2), 64, 32 * r, nullptr, scr, lane);
            else if (r < 64) transpose_item(INP(12), C, 0, 32 * (r - 32), (bf16*)(ws + WS_WT_A2), 64, 32 * (r - 32), nullptr, scr, lane);
            else { const int q = r - 64, kb = q / 32, nb = q % 32; transpose_item(INP(14), C, 64 * kb, 32 * nb, (bf16*)(ws + WS_WT_G2), DG, 32 * nb, nullptr, scr, lane, DG); }
            continue; } r -= I_UP;
        if (r < I_RKV) { const int m = r / 512, q = r % 512, kb = q / 32, nb = q % 32; transpose_item(INP(6) + (size_t)m * C * C, C, 64 * kb, 32 * nb, WT_RKV, C, m * C + 32 * nb, nullptr, scr, lane); continue; } r -= I_RKV;
        if (r < I_LORA) {
            if (r < 32) { const int kb = r / 2, nb = r % 2; transpose_item(INP(8), DW, 64 * kb, 32 * nb, WT_LORA, C, 32 * nb, nullptr, scr, lane); }
            else if (r < 64) { const int q = r - 32, kb = q / 2, nb = q % 2; transpose_item(INP(11), DA, 64 * kb, 32 * nb, WT_LORA, C, 256 + 32 * nb, nullptr, scr, lane); }
            else { const int q = r - 64, kb = q / 5, nb = q % 5; transpose_item(INP(13), DG, 64 * kb, 32 * nb, WT_LORA, C, 512 + 32 * nb, nullptr, scr, lane); }
            continue; } r -= I_LORA;
        if (r < I_OUT) { const int kb = r / 32, nb = r % 32; transpose_item(INP(20), C, 64 * kb, 32 * nb, WT_OUT, C, 32 * nb, nullptr, scr, lane); continue; } r -= I_OUT;
        if (r < I_KV) { const int kb = r / 64, nb = r % 64; transpose_item(INP(21), 2 * C, 64 * kb, 32 * nb, WT_KVQ, C, 32 * nb, INP(3), scr, lane); continue; } r -= I_KV;
        if (r < I_Q) { const int kb = r / 32, nb = r % 32; transpose_item(INP(22), C, 64 * kb, 32 * nb, WT_KVQ, C, 2 * C + 32 * nb, INP(1) + C, scr, lane); continue; } r -= I_Q;
        if (r < I_SBO) { const int kb = r / 32, nb = r % 32; transpose_item(INP(23), C, 64 * kb, 32 * nb, WT_SBO, C, 32 * nb, nullptr, scr, lane); continue; } r -= I_SBO;
        if (r < I_G) { const int le = r / 128, q = r % 128, kb = q / 8, nb = q % 8, f0 = 32 * nb; transpose_item(INP(28) + (size_t)le * C * FE, FE, 64 * kb, f0, WT_GU + (size_t)le * 512 * C, C, 256 * (f0 / 128) + (f0 % 128), INP(2) + (le >> 4) * C, scr, lane); continue; } r -= I_G;
        if (r < I_U) { const int le = r / 128, q = r % 128, kb = q / 8, nb = q % 8, f0 = 32 * nb; transpose_item(INP(29) + (size_t)le * C * FE, FE, 64 * kb, f0, WT_GU + (size_t)le * 512 * C, C, 256 * (f0 / 128) + 128 + (f0 % 128), INP(2) + (le >> 4) * C, scr, lane); continue; } r -= I_U;
        { const int le = r / 128, q = r % 128, kb = q / 32, nb = q % 32; transpose_item(INP(30) + (size_t)le * FE * C, C, 64 * kb, 32 * nb, WT_DN + (size_t)le * C * FE, FE, 32 * nb, nullptr, scr, lane); }
    }
    if (PART == 0) for (int it = gw * 64 + lane; it < 768 * 128; it += NGW * 64) { const int row = it >> 7, ch = it & 127;
        const bool valid = (row < 64) || (row >= 256 && row < 320) || (row >= 512 && row < 672);
        if (!valid) *(GAS v4u*)(WT_LORA + (size_t)row * C + ch * 8) = (v4u){0u, 0u, 0u, 0u}; }
}
__device__ __forceinline__ void load_row(const float* p, int lane, f32x4 (&v)[4]) {
#pragma unroll
    for (int j = 0; j < 4; ++j) v[j] = ((const GAS f32x4*)p)[64 * j + lane];
}
__device__ __forceinline__ void load_row_bf(const bf16* p, int lane, f32x4 (&v)[4]) {
#pragma unroll
    for (int j = 0; j < 4; ++j) { const v2u w = ((const GAS v2u*)p)[64 * j + lane]; v[j] = (f32x4){bflo(w.x), bfhi(w.x), bflo(w.y), bfhi(w.y)}; }
}
__device__ __forceinline__ float row_rs(const f32x4 (&v)[4], int lane) {
    float s = 0.f;
#pragma unroll
    for (int j = 0; j < 4; ++j) s += (v[j].x * v[j].x + v[j].y * v[j].y) + (v[j].z * v[j].z + v[j].w * v[j].w);
    return 1.0f / sqrtf(wave_sum(s, lane) * (1.0f / C) + RMS_EPS);
}
__device__ __forceinline__ void store_row_bf16(bf16* p, int lane, const f32x4 (&v)[4]) {
#pragma unroll
    for (int j = 0; j < 4; ++j) { v2u o; o.x = pk2(v[j].x, v[j].y); o.y = pk2(v[j].z, v[j].w); ((GAS v2u*)p)[64 * j + lane] = o; }
}
__device__ __forceinline__ void p0_rows(unsigned char* ws, int gw, int NGW, int lane) {
    const float* x = INP(0); const float* gain = INP(1); const float* mix = INP(5);
    f32x4 g[4]; load_row(gain, lane, g);
    for (int run = gw; run < M / 8; run += NGW) {
        const int r0 = run * 8;
        f32x4 prev[4];
        if ((r0 % SEQ) == 0) {
#pragma unroll
            for (int j = 0; j < 4; ++j) prev[j] = (f32x4){0.f, 0.f, 0.f, 0.f};
        } else { load_row(x + (size_t)(r0 - 1) * C, lane, prev); const float rs = row_rs(prev, lane);
#pragma unroll
            for (int j = 0; j < 4; ++j) prev[j] = prev[j] * rs * g[j]; }
        for (int rr = 0; rr < 8; ++rr) {
            const int row = r0 + rr;
            f32x4 hn[4]; load_row(x + (size_t)row * C, lane, hn); const float rs = row_rs(hn, lane);
#pragma unroll
            for (int j = 0; j < 4; ++j) hn[j] = hn[j] * rs * g[j];
#pragma unroll
            for (int i = 0; i < 6; ++i) { f32x4 o[4];
#pragma unroll
                for (int j = 0; j < 4; ++j) { const f32x4 mx = ((const GAS f32x4*)(mix + i * C))[64 * j + lane]; o[j] = hn[j] + (prev[j] - hn[j]) * mx; }
                bf16* dst = i < 2 ? (bf16*)OUTP() + (size_t)i * M * C : (i == 2 ? (bf16*)(ws + WS_B4) : (bf16*)(ws + WS_B1) + (size_t)(i - 3) * M * C);
                store_row_bf16(dst + (size_t)row * C, lane, o); }
#pragma unroll
            for (int j = 0; j < 4; ++j) prev[j] = hn[j];
        }
    }
}

template <int NN, int NGROUPS> struct SchedGrouped {
    static constexpr int K = C;
    const char* A0; size_t astride; const char* A2; const char* B; size_t bgroup;
    int G, c;
    __device__ __forceinline__ bool next(int i, pg8::Unit& u) const {
        const int L = i * G + c; constexpr int per = 64 * NN; if (L >= per * NGROUPS) return false;
        const int g = L / per, w = L % per; pg8::tile_map(w, 64, NN, u.pm, u.pn); u.aux = g; u.r0 = 0; u.cnt = 0; return true; }
    __device__ __forceinline__ const char* a_base(const pg8::Unit& u) const { const char* A = (A2 != nullptr && u.aux == 2) ? A2 : A0 + (size_t)u.aux * astride; return A + (size_t)u.pm * 256 * K * 2; }
    __device__ __forceinline__ const char* b_base(const pg8::Unit& u) const { return B + (size_t)u.aux * bgroup + (size_t)u.pn * 256 * K * 2; }
    __device__ __forceinline__ unsigned a_row_off(const pg8::Unit&, int) const { return 0u; }
};
template <int NN, int K, bool GATHER> struct SchedMoe {
    const char* A; const char* B; size_t bexp; const unsigned* list; volatile LAS int* tab; int G, c;
    __device__ __forceinline__ bool next(int i, pg8::Unit& u) const {
        const int L = i * G + c; const int tot = __builtin_amdgcn_readfirstlane(tab[48]) * NN; if (L >= tot) return false;
        u.pm = L / NN; u.pn = L % NN; int e = 0;
#pragma unroll
        for (int j = 0; j < 16; ++j) e += (u.pm >= tab[32 + j]) ? 1 : 0;
        e = __builtin_amdgcn_readfirstlane(e);
        u.aux = e; u.r0 = (u.pm - __builtin_amdgcn_readfirstlane(tab[16 + e])) * 256; u.cnt = __builtin_amdgcn_readfirstlane(tab[e]); return true; }
    __device__ __forceinline__ const char* a_base(const pg8::Unit& u) const { return GATHER ? A : A + (size_t)u.pm * 256 * K * 2; }
    __device__ __forceinline__ const char* b_base(const pg8::Unit& u) const { return B + (size_t)u.aux * bexp + (size_t)u.pn * 256 * K * 2; }
    __device__ __forceinline__ unsigned a_row_off(const pg8::Unit& u, int r) const {
        const int idx = u.r0 + r; unsigned tok = 0u;
        if (idx < u.cnt) tok = list[(size_t)u.aux * M + idx] >> 1;
        return tok * (unsigned)(K * 2); }
};

using pg8::f32x4;
using pg8::Unit;
__device__ __forceinline__ v4u pack8(f32x4 v0, f32x4 v1) { v4u w; w.x = pg8::cvt_pk_bf16(v0[0], v0[1]); w.y = pg8::cvt_pk_bf16(v0[2], v0[3]); w.z = pg8::cvt_pk_bf16(v1[0], v1[1]); w.w = pg8::cvt_pk_bf16(v1[2], v1[3]); return w; }

struct EpiLora {
    static constexpr bool PERM = true;
    bf16* LW;
    __device__ __forceinline__ void operator()(const f32x4 (&acc)[2][2][4][2], const Unit& u, int wr, int wc, int fr, int fq) const {
        { int l_; asm volatile("v_mbcnt_lo_u32_b32 %0, -1, 0\n\tv_mbcnt_hi_u32_b32 %0, -1, %0" : "=v"(l_)); fr = l_ & 15; fq = l_ >> 4; }
        const int g = u.aux, width = g == 2 ? DG : DW; bf16* out = LW + (size_t)g * (1u << 20);
        const int row0 = u.pm * 256 + wr * 64 + fr;
#pragma unroll
        for (int bj = 0; bj < 2; ++bj) { const int col0 = bj * 128 + wc * 32 + 8 * fq; if (col0 < width) {
#pragma unroll
            for (int ai = 0; ai < 2; ++ai)
#pragma unroll
                for (int m = 0; m < 4; ++m) { f32x4 v0 = acc[ai][bj][m][0], v1 = acc[ai][bj][m][1];
                    if (g == 0) {
#pragma unroll
                        for (int q = 0; q < 4; ++q) { v0[q] = tanhf(v0[q]); v1[q] = tanhf(v1[q]); } }
                    else if (g == 2) {
#pragma unroll
                        for (int q = 0; q < 4; ++q) { v0[q] = sigmoidf_(v0[q]); v1[q] = sigmoidf_(v1[q]); } }
                    *(GAS v4u*)(out + (size_t)(row0 + ai * 128 + m * 16) * width + col0) = pack8(v0, v1); } } }
    }
};
struct EpiSplit3 {
    static constexpr bool PERM = true;
    bf16* O0; bool bycol; const float* rowscale;
    __device__ __forceinline__ void operator()(const f32x4 (&acc)[2][2][4][2], const Unit& u, int wr, int wc, int fr, int fq) const {
        { int l_; asm volatile("v_mbcnt_lo_u32_b32 %0, -1, 0\n\tv_mbcnt_hi_u32_b32 %0, -1, %0" : "=v"(l_)); fr = l_ & 15; fq = l_ >> 4; }
        const int g = bycol ? (u.pn >> 2) : u.aux, pn = bycol ? (u.pn & 3) : u.pn; bf16* out = O0 + (size_t)g * ((size_t)M * C);
        const int row0 = u.pm * 256 + wr * 64 + fr, col0 = pn * 256 + wc * 32 + 8 * fq;
#pragma unroll
        for (int ai = 0; ai < 2; ++ai)
#pragma unroll
            for (int m = 0; m < 4; ++m)
                { const float sc = rowscale ? rowscale[row0 + ai * 128 + m * 16] : 1.0f;
#pragma unroll
                for (int bj = 0; bj < 2; ++bj) *(GAS v4u*)(out + (size_t)(row0 + ai * 128 + m * 16) * C + col0 + bj * 128) = pack8(acc[ai][bj][m][0] * sc, acc[ai][bj][m][1] * sc); }
    }
};
template <bool BASE_F32> struct EpiResidBf {
    static constexpr bool PERM = true;
    const void* base; bf16* out;
    __device__ __forceinline__ void operator()(const f32x4 (&acc)[2][2][4][2], const Unit& u, int wr, int wc, int fr, int fq) const {
        { int l_; asm volatile("v_mbcnt_lo_u32_b32 %0, -1, 0\n\tv_mbcnt_hi_u32_b32 %0, -1, %0" : "=v"(l_)); fr = l_ & 15; fq = l_ >> 4; }
        const int row0 = u.pm * 256 + wr * 64 + fr, col0 = u.pn * 256 + wc * 32 + 8 * fq;
#pragma unroll
        for (int ai = 0; ai < 2; ++ai)
#pragma unroll
            for (int m = 0; m < 4; ++m) { const size_t off = (size_t)(row0 + ai * 128 + m * 16) * C + col0;
#pragma unroll
                for (int bj = 0; bj < 2; ++bj) { f32x4 b0, b1;
                    if (BASE_F32) { b0 = *(const GAS f32x4*)((const float*)base + off + bj * 128); b1 = *(const GAS f32x4*)((const float*)base + off + bj * 128 + 4); }
                    else { const v4u w = *(const GAS v4u*)((const bf16*)base + off + bj * 128); b0 = (f32x4){bflo(w.x), bfhi(w.x), bflo(w.y), bfhi(w.y)}; b1 = (f32x4){bflo(w.z), bfhi(w.z), bflo(w.w), bfhi(w.w)}; }
                    *(GAS v4u*)(out + off + bj * 128) = pack8(b0 + acc[ai][bj][m][0], b1 + acc[ai][bj][m][1]); }
                asm volatile("" ::: "memory"); }
    }
};
struct EpiGU {
    static constexpr bool PERM = true;
    bf16* HID; const float* wl; const float* rsl;
    __device__ __forceinline__ void operator()(const f32x4 (&acc)[2][2][4][2], const Unit& u, int wr, int wc, int fr, int fq) const {
        { int l_; asm volatile("v_mbcnt_lo_u32_b32 %0, -1, 0\n\tv_mbcnt_hi_u32_b32 %0, -1, %0" : "=v"(l_)); fr = l_ & 15; fq = l_ >> 4; }
        const int e = u.aux, cnt = u.cnt, base = u.r0, r0 = wr * 64 + fr, col0 = u.pn * 128 + wc * 32 + 8 * fq;
#pragma unroll
        for (int ai = 0; ai < 2; ++ai)
#pragma unroll
            for (int m = 0; m < 4; ++m) { const int r = r0 + ai * 128 + m * 16, idx = base + r; float w = 0.f, rs = 0.f; if (idx < cnt) { w = wl[(size_t)e * M + idx]; rs = rsl[(size_t)e * M + idx]; }
                f32x4 h0, h1;
#pragma unroll
                for (int q = 0; q < 4; ++q) { const float g0 = acc[ai][0][m][0][q] * rs, g1 = acc[ai][0][m][1][q] * rs;
                    h0[q] = g0 * sigmoidf_(g0) * (acc[ai][1][m][0][q] * rs) * w; h1[q] = g1 * sigmoidf_(g1) * (acc[ai][1][m][1][q] * rs) * w; }
                *(GAS v4u*)(HID + (size_t)(u.pm * 256 + r) * FE + col0) = pack8(h0, h1);
                asm volatile("" ::: "memory"); }
    }
};
struct EpiDown {
    static constexpr bool PERM = true;
    bf16* EO; const unsigned* list;
    __device__ __forceinline__ void operator()(const f32x4 (&acc)[2][2][4][2], const Unit& u, int wr, int wc, int fr, int fq) const {
        { int l_; asm volatile("v_mbcnt_lo_u32_b32 %0, -1, 0\n\tv_mbcnt_hi_u32_b32 %0, -1, %0" : "=v"(l_)); fr = l_ & 15; fq = l_ >> 4; }
        const int e = u.aux, cnt = u.cnt, base = u.r0, r0 = wr * 64 + fr, col0 = u.pn * 256 + wc * 32 + 8 * fq;
#pragma unroll
        for (int ai = 0; ai < 2; ++ai)
#pragma unroll
            for (int m = 0; m < 4; ++m) { const int idx = base + r0 + ai * 128 + m * 16;
                if (idx < cnt) { const unsigned ent = list[(size_t)e * M + idx]; bf16* o = EO + ((size_t)(ent & 1u) * M + (ent >> 1)) * C + col0;
#pragma unroll
                    for (int bj = 0; bj < 2; ++bj) *(GAS v4u*)(o + bj * 128) = pack8(acc[ai][bj][m][0], acc[ai][bj][m][1]); }
                asm volatile("" ::: "memory"); }
    }
};

typedef short bf16x8s __attribute__((ext_vector_type(8)));
typedef short bf16x4s __attribute__((ext_vector_type(4)));
typedef short v4i16_t __attribute__((ext_vector_type(4)));
constexpr int TPB = 144;
constexpr int TILE_B = 64 * TPB;
constexpr int FP = 68;
constexpr int CS_FA = 0, CS_FB = 16384, CS_TILES = 32768, CS_TOT = CS_TILES + 12 * TILE_B, CS_WL = CS_TOT + 2048, CS_PAR = CS_WL + 256;
static_assert(CS_PAR + 768 <= LDSCTL_OFF, "scan LDS map");
#define TILE(n) (lds + CS_TILES + (n) * TILE_B)
#define F4Z (f32x4){0.f, 0.f, 0.f, 0.f}
__device__ __forceinline__ bf16x8s ldfrag(const LAS unsigned char* tile, int row, int kcol) { return *(const LAS bf16x8s*)(tile + row * TPB + kcol * 2); }
__device__ __forceinline__ bf16x8s ldfrag_tr(const LAS unsigned char* tile, int n0, int k0, int lane) {
    const int g = lane >> 4, q = (lane & 15) >> 2, p = lane & 3;
    const LAS unsigned char* a = tile + (k0 + 8 * g + q) * TPB + (n0 + 4 * p) * 2;
    const v4i16_t lo = __builtin_amdgcn_ds_read_tr16_b64_v4i16((LAS v4i16_t*)a), hi = __builtin_amdgcn_ds_read_tr16_b64_v4i16((LAS v4i16_t*)(a + 4 * TPB));
    return (bf16x8s){lo[0], lo[1], lo[2], lo[3], hi[0], hi[1], hi[2], hi[3]};
}
__device__ __forceinline__ bf16x8s ldfrag_perm(const LAS unsigned char* tile, int row, int ks, int g) {
    const bf16x4s lo = *(const LAS bf16x4s*)(tile + row * TPB + (32 * ks + 4 * g) * 2), hi = *(const LAS bf16x4s*)(tile + row * TPB + (32 * ks + 16 + 4 * g) * 2);
    return (bf16x8s){lo[0], lo[1], lo[2], lo[3], hi[0], hi[1], hi[2], hi[3]};
}
__device__ __forceinline__ void lds_barrier() { asm volatile("s_waitcnt lgkmcnt(0)" ::: "memory"); __builtin_amdgcn_s_barrier(); asm volatile("" ::: "memory"); }
#define MFMA16(a, b, c) __builtin_amdgcn_mfma_f32_16x16x32_bf16((a), (b), (c), 0, 0, 0)
__device__ __forceinline__ void mm64(f32x4 (&acc)[2], const LAS unsigned char* At, const LAS unsigned char* Bt, int rt, int ch, int fr, int g) {
#pragma unroll
    for (int ks = 0; ks < 2; ++ks) { const bf16x8s a = ldfrag(At, 16 * rt + fr, 32 * ks + 8 * g);
#pragma unroll
        for (int ct = 0; ct < 2; ++ct) acc[ct] = MFMA16(a, ldfrag(Bt, 32 * ch + 16 * ct + fr, 32 * ks + 8 * g), acc[ct]); }
}
__device__ __forceinline__ void mm64_bt(f32x4 (&acc)[2], const LAS unsigned char* At, const LAS unsigned char* X, int rt, int ch, int fr, int g, int lane) {
#pragma unroll
    for (int ks = 0; ks < 2; ++ks) { const bf16x8s a = ldfrag(At, 16 * rt + fr, 32 * ks + 8 * g);
#pragma unroll
        for (int ct = 0; ct < 2; ++ct) acc[ct] = MFMA16(a, ldfrag_tr(X, 32 * ch + 16 * ct, 32 * ks, lane), acc[ct]); }
}
__device__ __forceinline__ void mm64_at(f32x4 (&acc)[2], const LAS unsigned char* Xa, const LAS unsigned char* Bt, int rt, int ch, int fr, int g, int lane) {
#pragma unroll
    for (int ks = 0; ks < 2; ++ks) { const bf16x8s a = ldfrag_tr(Xa, 16 * rt, 32 * ks, lane);
#pragma unroll
        for (int ct = 0; ct < 2; ++ct) acc[ct] = MFMA16(a, ldfrag(Bt, 32 * ch + 16 * ct + fr, 32 * ks + 8 * g), acc[ct]); }
}
__device__ __forceinline__ void mm64_att(f32x4 (&acc)[2], const LAS unsigned char* Xa, const LAS unsigned char* X, int rt, int ch, int lane) {
#pragma unroll
    for (int ks = 0; ks < 2; ++ks) { const bf16x8s a = ldfrag_tr(Xa, 16 * rt, 32 * ks, lane);
#pragma unroll
        for (int ct = 0; ct < 2; ++ct) acc[ct] = MFMA16(a, ldfrag_tr(X, 32 * ch + 16 * ct, 32 * ks, lane), acc[ct]); }
}
__device__ __forceinline__ bf16x4s pack4(f32x4 v) { v2u w; w.x = pg8::cvt_pk_bf16(v[0], v[1]); w.y = pg8::cvt_pk_bf16(v[2], v[3]); return __builtin_bit_cast(bf16x4s, w); }
__device__ __forceinline__ f32x4 unpack4(bf16x4s s) { const v2u w = __builtin_bit_cast(v2u, s); return (f32x4){bflo(w.x), bfhi(w.x), bflo(w.y), bfhi(w.y)}; }
__device__ __forceinline__ void st_tr(LAS unsigned char* Out, const f32x4 (&acc)[2], int rt, int ch, int fr, int g) {
#pragma unroll
    for (int ct = 0; ct < 2; ++ct) *(LAS bf16x4s*)(Out + (32 * ch + 16 * ct + fr) * TPB + (16 * rt + 4 * g) * 2) = pack4(acc[ct]);
}
__device__ __forceinline__ void ld_tr(f32x4 (&acc)[2], const LAS unsigned char* In, int rt, int ch, int fr, int g) {
#pragma unroll
    for (int ct = 0; ct < 2; ++ct) acc[ct] = unpack4(*(const LAS bf16x4s*)(In + (32 * ch + 16 * ct + fr) * TPB + (16 * rt + 4 * g) * 2));
}
__device__ __forceinline__ void unpack8(v4u w, float (&o)[8]) { o[0] = bflo(w.x); o[1] = bfhi(w.x); o[2] = bflo(w.y); o[3] = bfhi(w.y); o[4] = bflo(w.z); o[5] = bfhi(w.z); o[6] = bflo(w.w); o[7] = bfhi(w.w); }
__device__ __forceinline__ v4u pack8f(const float (&o)[8]) { v4u w; w.x = pg8::cvt_pk_bf16(o[0], o[1]); w.y = pg8::cvt_pk_bf16(o[2], o[3]); w.z = pg8::cvt_pk_bf16(o[4], o[5]); w.w = pg8::cvt_pk_bf16(o[6], o[7]); return w; }

struct FrontIn { v4u r, k, v; bf16x8s fw[2], fa[2]; };
__device__ __forceinline__ void front_fetch(FrontIn& f, unsigned char* ws, int unit, int tid, int lane, int wave) {
    const int h = unit & 15, c = (unit >> 4) & 127, b = unit >> 11; const size_t row0 = (size_t)b * SEQ + c * 64;
    const int rt = wave & 3, fr = lane & 15, g = lane >> 4, t = tid >> 3, cq = tid & 7, c0 = h * HD + cq * 8;
    const bf16* Rb = (const bf16*)(ws + WS_B1); const bf16* Kb = (const bf16*)(ws + WS_B2); const bf16* Vb = (const bf16*)(ws + WS_B3);
    const bf16* LW = (const bf16*)(ws + WS_LW); const bf16* LA = (const bf16*)(ws + WS_LA);
    f.r = *(const GAS v4u*)(Rb + (row0 + t) * C + c0); f.k = *(const GAS v4u*)(Kb + (row0 + t) * C + c0); f.v = *(const GAS v4u*)(Vb + (row0 + t) * C + c0);
#pragma unroll
    for (int ks = 0; ks < 2; ++ks) { f.fw[ks] = *(const GAS bf16x8s*)(LW + (row0 + 16 * rt + fr) * DW + 32 * ks + 8 * g); f.fa[ks] = *(const GAS bf16x8s*)(LA + (row0 + 16 * rt + fr) * DA + 32 * ks + 8 * g); }
}
__device__ __forceinline__ v4u head_consts(unsigned char* ws, LAS unsigned char* lds, int h, int tid, int wtile, int atile) {
    const bf16* W2T = (const bf16*)(ws + WS_WT_W2); const bf16* A2T = (const bf16*)(ws + WS_WT_A2);
    const int row = tid >> 3, cq = tid & 7;
    const v4u w2chunk = *(const GAS v4u*)(W2T + (size_t)(h * HD + row) * 64 + cq * 8);
    *(LAS v4u*)(lds + CS_TILES + wtile * TILE_B + row * TPB + cq * 16) = w2chunk;
    *(LAS v4u*)(lds + CS_TILES + atile * TILE_B + row * TPB + cq * 16) = *(const GAS v4u*)(A2T + (size_t)(h * HD + row) * 64 + cq * 8);
    if (tid < 64) { LAS float* P = (LAS float*)(lds + CS_PAR); P[tid] = INP(15)[h * HD + tid]; P[64 + tid] = INP(16)[h * HD + tid]; P[128 + tid] = INP(17)[h * HD + tid]; }
    __syncthreads();
    return w2chunk;
}
template <int MODE>
__device__ __forceinline__ void chunk_front(const FrontIn& f, LAS unsigned char* lds, const float (&w0v)[2], const float (&a0v)[2], const bf16x8s (&w2f)[2][2], const bf16x8s (&a2f)[2][2], int tid, int lane, int wave, float (&v8)[8], float& rkb) {
    const int rt = wave & 3, ch = wave >> 2, fr = lane & 15, g = lane >> 4;
    LAS float* FA = (LAS float*)(lds + CS_FA); LAS float* FB = (LAS float*)(lds + CS_FB); LAS float* TOT = (LAS float*)(lds + CS_TOT);
    const int t = tid >> 3, cq = tid & 7;
    {
        f32x4 aw[2] = {F4Z, F4Z}, aa[2] = {F4Z, F4Z};
#pragma unroll
        for (int ks = 0; ks < 2; ++ks)
#pragma unroll
            for (int ct = 0; ct < 2; ++ct) { aw[ct] = MFMA16(f.fw[ks], w2f[ks][ct], aw[ct]); aa[ct] = MFMA16(f.fa[ks], a2f[ks][ct], aa[ct]); }
#pragma unroll
        for (int ct = 0; ct < 2; ++ct) { const int j = 32 * ch + 16 * ct + fr, js = j ^ ((g & 1) << 4); const float w0 = w0v[ct], a0 = a0v[ct];
            float p[4];
#pragma unroll
            for (int q = 0; q < 4; ++q) { p[q] = -0.6065306597126334f * sigmoidf_(w0 + aw[ct][q]); if (q) p[q] += p[q - 1]; }
            const float s_ = p[3];
            const float u1 = __int_as_float(__builtin_amdgcn_ds_bpermute(((lane - 16) & 63) << 2, __float_as_int(s_))); const float t1 = s_ + (g >= 1 ? u1 : 0.f);
            const float u2 = __int_as_float(__builtin_amdgcn_ds_bpermute(((lane - 32) & 63) << 2, __float_as_int(t1))); const float t2 = t1 + (g >= 2 ? u2 : 0.f);
            const float ex = t2 - s_;
#pragma unroll
            for (int q = 0; q < 4; ++q) { const int tt = 16 * rt + 4 * g + q; FA[tt * 64 + js] = p[q] + ex; FB[tt * 64 + js] = sigmoidf_(a0 + aa[ct][q]); }
            if (g == 3) TOT[rt * 64 + j] = t2; }
    }
    lds_barrier();
    {
        float r[8], k[8], pkk[8], pka[8], prk[8];
        unpack8(f.r, r); unpack8(f.k, k); unpack8(f.v, v8);
        { const LAS float* P = (const LAS float*)(lds + CS_PAR) + cq * 8; const f32x4 a0_ = *(const LAS f32x4*)P, a1_ = *(const LAS f32x4*)(P + 4), b0_ = *(const LAS f32x4*)(P + 64), b1_ = *(const LAS f32x4*)(P + 68), c0_ = *(const LAS f32x4*)(P + 128), c1_ = *(const LAS f32x4*)(P + 132);
#pragma unroll
          for (int q = 0; q < 4; ++q) { pkk[q] = a0_[q]; pkk[4 + q] = a1_[q]; pka[q] = b0_[q]; pka[4 + q] = b1_[q]; prk[q] = c0_[q]; prk[4 + q] = c1_[q]; } }
        float cw[8], cwp[8], ag[8];
        { const int tp = t > 0 ? t - 1 : 0, rtt = wave >> 1;
          const int ct_ = (cq ^ (((t >> 2) & 1) << 1)) * 8, cp_ = (cq ^ (((tp >> 2) & 1) << 1)) * 8;
          const f32x4 c0_ = *(const LAS f32x4*)(FA + t * 64 + ct_), c1_ = *(const LAS f32x4*)(FA + t * 64 + ct_ + 4), p0_ = *(const LAS f32x4*)(FA + tp * 64 + cp_), p1_ = *(const LAS f32x4*)(FA + tp * 64 + cp_ + 4);
          const f32x4 g0_ = *(const LAS f32x4*)(FB + t * 64 + ct_), g1_ = *(const LAS f32x4*)(FB + t * 64 + ct_ + 4);
          f32x4 o0_ = F4Z, o1_ = F4Z, l0_ = F4Z, l1_ = F4Z;
          for (int r_ = 0; r_ < rtt; ++r_) { l0_ = *(const LAS f32x4*)(TOT + r_ * 64 + cq * 8); l1_ = *(const LAS f32x4*)(TOT + r_ * 64 + cq * 8 + 4); o0_ = o0_ + l0_; o1_ = o1_ + l1_; }
          const bool first = (t & 15) == 0;
#pragma unroll
          for (int q = 0; q < 4; ++q) { cw[q] = c0_[q] + o0_[q]; cw[4 + q] = c1_[q] + o1_[q];
              cwp[q] = t > 0 ? p0_[q] + o0_[q] - (first ? l0_[q] : 0.f) : 0.f; cwp[4 + q] = t > 0 ? p1_[q] + o1_[q] - (first ? l1_[q] : 0.f) : 0.f; ag[q] = g0_[q]; ag[4 + q] = g1_[q]; } }
        float kk[8], ss = 0.f; rkb = 0.f;
#pragma unroll
        for (int q = 0; q < 8; ++q) { kk[q] = k[q] * pkk[q]; ss += kk[q] * kk[q]; }
        ss = sum8(ss);
        const float inv = 1.0f / fmaxf(sqrtf(ss), 1e-12f);
        float at[8], bt[8], kt[8], rt_[8];
#pragma unroll
        for (int q = 0; q < 8; ++q) { const float kn = kk[q] * inv, kp = k[q] * (1.0f + (ag[q] - 1.0f) * pka[q]);
            const float ein = __expf(-cw[q]);
            at[q] = -kn * __expf(cwp[q]); bt[q] = kn * ag[q] * ein; kt[q] = kp * ein;
            rt_[q] = r[q] * __expf(cw[q]); rkb += r[q] * kp * prk[q]; }
        rkb = sum8(rkb);
        *(LAS v4u*)(TILE(0) + t * TPB + cq * 16) = pack8f(at); *(LAS v4u*)(TILE(1) + t * TPB + cq * 16) = pack8f(bt); *(LAS v4u*)(TILE(2) + t * TPB + cq * 16) = pack8f(kt);
        *(LAS v4u*)(TILE(3) + t * TPB + cq * 16) = f.v;
        *(LAS v4u*)(TILE(6) + t * TPB + cq * 16) = pack8f(rt_);
        if (MODE == 1 && t == 63) {
#pragma unroll
            for (int q = 0; q < 8; ++q) ((LAS float*)(lds + CS_WL))[cq * 8 + q] = __expf(cw[q]); }
    }
    lds_barrier();
}

__device__ __forceinline__ void scan_s1(unsigned char* ws, LAS unsigned char* lds, int lane0, int wave) {
    const int rt = wave & 3, ch = wave >> 2;
    FrontIn fin; float w0v[2], a0v[2]; bf16x8s w2f[2][2], a2f[2][2];
    { int l0 = lane0; asm volatile("" : "+v"(l0)); const int hh = blockIdx.x & 15;
      if ((int)blockIdx.x < BATCH * NH * (SEQ / 64)) front_fetch(fin, ws, blockIdx.x, wave * 64 + l0, l0, wave);
      const bf16* W2T = (const bf16*)(ws + WS_WT_W2); const bf16* A2T = (const bf16*)(ws + WS_WT_A2);
#pragma unroll
      for (int ct = 0; ct < 2; ++ct) { w0v[ct] = INP(7)[hh * HD + 32 * ch + 16 * ct + (l0 & 15)]; a0v[ct] = INP(10)[hh * HD + 32 * ch + 16 * ct + (l0 & 15)];
#pragma unroll
          for (int ks = 0; ks < 2; ++ks) { const size_t wr_ = (size_t)(hh * HD + 32 * ch + 16 * ct + (l0 & 15)) * 64 + 32 * ks + 8 * (l0 >> 4); w2f[ks][ct] = *(const GAS bf16x8s*)(W2T + wr_); a2f[ks][ct] = *(const GAS bf16x8s*)(A2T + wr_); } }
      const int tid0 = wave * 64 + l0;
      if (tid0 < 64) { LAS float* P = (LAS float*)(lds + CS_PAR); P[tid0] = INP(15)[hh * HD + tid0]; P[64 + tid0] = INP(16)[hh * HD + tid0]; P[128 + tid0] = INP(17)[hh * HD + tid0]; }
      __syncthreads(); }
    for (int unit = blockIdx.x; unit < BATCH * NH * (SEQ / 64); unit += gridDim.x) {
        int lane = lane0; asm volatile("" : "+v"(lane));
        const int tid = wave * 64 + lane, fr = lane & 15, g = lane >> 4;
        const int h = unit & 15, c = (unit >> 4) & 127, b = unit >> 11; const size_t chunk = ((size_t)b * NH + h) * 128 + c;
        float v8[8]; float rkb;
        chunk_front<1>(fin, lds, w0v, a0v, w2f, a2f, tid, lane, wave, v8, rkb);
        { const size_t row0_ = (size_t)b * SEQ + c * 64; if ((tid & 7) == 0) ((float*)(ws + WS_HID))[(row0_ + (tid >> 3)) * NH + h] = rkb; }
        if (unit + (int)gridDim.x < BATCH * NH * (SEQ / 64)) front_fetch(fin, ws, unit + gridDim.x, tid, lane, wave);
        {
            f32x4 a2[2] = {F4Z, F4Z}, a3[2] = {F4Z, F4Z};
            mm64(a2, TILE(1), TILE(0), rt, ch, fr, g);
            mm64(a3, TILE(2), TILE(0), rt, ch, fr, g);
            f32x4 p1[2];
#pragma unroll
            for (int ct = 0; ct < 2; ++ct) { const int col = 32 * ch + 16 * ct + fr;
#pragma unroll
                for (int q = 0; q < 4; ++q) { const int row = 16 * rt + 4 * g + q;
                    a2[ct][q] = row < col ? a2[ct][q] : 0.f;
                    p1[ct][q] = a2[ct][q] + (row == col ? 1.0f : 0.f);
                    a3[ct][q] = row < col ? a3[ct][q] : 0.f; } }
            st_tr(TILE(5), a2, rt, ch, fr, g);
            st_tr(TILE(9), p1, rt, ch, fr, g);
            st_tr(TILE(4), a3, rt, ch, fr, g);
        }
        lds_barrier();
#pragma unroll
        for (int r = 0; r < 6; ++r) {
            LAS unsigned char* Sr = TILE(5 + 2 * (r & 1)); LAS unsigned char* Sr2 = TILE(5 + 2 * ((r & 1) ^ 1));
            if (r <= 4) { f32x4 q2[2] = {F4Z, F4Z};
                mm64_at(q2, Sr, Sr, rt, ch, fr, g, lane);
                st_tr(Sr2, q2, rt, ch, fr, g); }
            if (r >= 1) { LAS unsigned char* Pr = TILE(9 + ((r - 1) & 1)); LAS unsigned char* Pr2 = TILE(9 + (((r - 1) & 1) ^ 1));
                f32x4 pa[2]; ld_tr(pa, Pr, rt, ch, fr, g);
                mm64_at(pa, Sr, Pr, rt, ch, fr, g, lane);
                st_tr(Pr2, pa, rt, ch, fr, g); }
            if (r == 0) { f32x4 gg[2] = {F4Z, F4Z};
                mm64_bt(gg, TILE(4), TILE(3), rt, ch, fr, g, lane);
                st_tr(TILE(11), gg, rt, ch, fr, g); }
            lds_barrier();
        }
        {
            f32x4 acc[2] = {F4Z, F4Z}, ac2[2] = {F4Z, F4Z};
            mm64_bt(acc, TILE(10), TILE(0), rt, ch, fr, g, lane);
            mm64(ac2, TILE(10), TILE(11), rt, ch, fr, g);
            st_tr(TILE(5), acc, rt, ch, fr, g); st_tr(TILE(7), ac2, rt, ch, fr, g);
            f32x4 b2[2] = {F4Z, F4Z}, b3[2] = {F4Z, F4Z};
            mm64(b2, TILE(1), TILE(6), rt, ch, fr, g); mm64(b3, TILE(2), TILE(6), rt, ch, fr, g);
#pragma unroll
            for (int ct = 0; ct < 2; ++ct) { const int t = 32 * ch + 16 * ct + fr;
#pragma unroll
                for (int q = 0; q < 4; ++q) { const int s_ = 16 * rt + 4 * g + q; b2[ct][q] = s_ <= t ? b2[ct][q] : 0.f; b3[ct][q] = s_ <= t ? b3[ct][q] : 0.f; } }
            st_tr(TILE(4), b2, rt, ch, fr, g); st_tr(TILE(9), b3, rt, ch, fr, g);
        }
        lds_barrier();
        {
            const LAS float* WL = (const LAS float*)(lds + CS_WL);
            f32x4 acc[2] = {F4Z, F4Z};
            mm64_bt(acc, TILE(5), TILE(1), rt, ch, fr, g, lane);
            bf16* Mg = (bf16*)(ws + WS_B0) + chunk * 4096;
#pragma unroll
            for (int ct = 0; ct < 2; ++ct) { const int j1 = 32 * ch + 16 * ct + fr; const float wl = WL[j1];
#pragma unroll
                for (int q = 0; q < 4; ++q) { const int j2 = 16 * rt + 4 * g + q; acc[ct][q] = wl * (acc[ct][q] + (j2 == j1 ? 1.0f : 0.f)); }
                const int rtS = 2 * ch + ct, ksS = rt >> 1, half = rt & 1;
                *(GAS bf16x4s*)(Mg + (((rtS * 2 + ksS) * 64 + g * 16 + fr) * 8 + half * 4)) = pack4(acc[ct]); }
            f32x4 ad[2] = {F4Z, F4Z};
            mm64_at(ad, TILE(1), TILE(7), rt, ch, fr, g, lane);
            mm64_att(ad, TILE(2), TILE(3), rt, ch, lane);
            const f32x4 wl4 = *(const LAS f32x4*)(WL + 16 * rt + 4 * g);
            bf16* Dg = (bf16*)OUTP() + chunk * 4096;
#pragma unroll
            for (int ct = 0; ct < 2; ++ct) *(GAS bf16x4s*)(Dg + (((2 * ch + ct) * 4 + rt) * 64 + lane) * 4) = pack4(ad[ct] * wl4);
            const size_t row0_ = (size_t)b * SEQ + c * 64;
            f32x4 ar[2]; ld_tr(ar, TILE(6), rt, ch, fr, g);
            mm64(ar, TILE(5), TILE(4), rt, ch, fr, g);
            f32x4 ay[2] = {F4Z, F4Z};
            mm64(ay, TILE(7), TILE(4), rt, ch, fr, g); mm64_at(ay, TILE(3), TILE(9), rt, ch, fr, g, lane);
            bf16* Rg = (bf16*)(ws + WS_B1); bf16* Kg = (bf16*)(ws + WS_B2);
#pragma unroll
            for (int ct = 0; ct < 2; ++ct) { const size_t o_ = (row0_ + 32 * ch + 16 * ct + fr) * C + h * HD + 16 * rt + 4 * g; *(GAS bf16x4s*)(Rg + o_) = pack4(ar[ct]); *(GAS bf16x4s*)(Kg + o_) = pack4(ay[ct]); }
        }
        lds_barrier();
    }
}

constexpr int S2_PD = 6;
__device__ __forceinline__ void scan_s2(unsigned char* ws, LAS unsigned char* lds, int lane, int wave) {
    for (int bh = blockIdx.x; bh < BATCH * NH; bh += gridDim.x) {
        const unsigned char* Mg = (const unsigned char*)((const bf16*)(ws + WS_B0) + (size_t)bh * 128 * 4096); const unsigned char* Dg = (const unsigned char*)((const bf16*)OUTP() + (size_t)bh * 128 * 4096);
        bf16* Sg = (bf16*)OUTP() + (size_t)M * C + (size_t)bh * 128 * 4096;
        if (wave >= 4) {
            const int lw = wave - 4;
            const unsigned char* src = (lw < 2 ? Mg + lw * 4096 : Dg + (lw - 2) * 4096) + lane * 16;
            LAS unsigned char* dst = lds + lw * 4096 + lane * 16;
            v4u q[S2_PD][4];
#define S2_LOADQ(j, c) do { _Pragma("unroll") for (int i_ = 0; i_ < 4; ++i_) q[j][i_] = *(const GAS v4u*)(src + (size_t)(c) * 8192 + i_ * 1024); } while (0)
#define S2_STOREQ(j, slot) do { _Pragma("unroll") for (int i_ = 0; i_ < 4; ++i_) *(LAS v4u*)(dst + (slot) * 16384 + i_ * 1024) = q[j][i_]; } while (0)
#pragma unroll
            for (int j = 0; j < S2_PD; ++j) S2_LOADQ(j, j);
            S2_STOREQ(0, 0); S2_LOADQ(0, S2_PD);
            lds_barrier();
#pragma unroll 1
            for (int s0 = 0; s0 < 128; s0 += S2_PD) {
#pragma unroll
                for (int jj = 0; jj < S2_PD; ++jj) { const int step = s0 + jj;
                    if (step + 1 < 128) S2_STOREQ((jj + 1) % S2_PD, (step + 1) & 1);
                    if (step + 1 + S2_PD < 128) S2_LOADQ((jj + 1) % S2_PD, step + 1 + S2_PD);
                    lds_barrier(); }
            }
#undef S2_LOADQ
#undef S2_STOREQ
        } else {
            const int ct = wave;
            f32x4 acc[4];
#pragma unroll
            for (int r = 0; r < 4; ++r) acc[r] = F4Z;
            lds_barrier();
#pragma unroll 1
            for (int s0 = 0; s0 < 128; s0 += S2_PD) {
#pragma unroll
                for (int jj = 0; jj < S2_PD; ++jj) { const int step = s0 + jj;
                    if (step < 128) {
                        const LAS unsigned char* slot = lds + (step & 1) * 16384;
                        bf16x8s sf[2];
#pragma unroll
                        for (int ks = 0; ks < 2; ++ks) { const bf16x4s lo = pack4(acc[2 * ks]), hi = pack4(acc[2 * ks + 1]); sf[ks] = (bf16x8s){lo[0], lo[1], lo[2], lo[3], hi[0], hi[1], hi[2], hi[3]}; }
#pragma unroll
                        for (int ks = 0; ks < 2; ++ks) *(GAS bf16x8s*)(Sg + (size_t)step * 4096 + ((ct * 2 + ks) * 64 + lane) * 8) = sf[ks];
                        f32x4 na[4];
#pragma unroll
                        for (int r = 0; r < 4; ++r) na[r] = unpack4(*(const LAS bf16x4s*)(slot + 8192 + ((ct * 4 + r) * 64 + lane) * 8));
#pragma unroll
                        for (int ks = 0; ks < 2; ++ks)
#pragma unroll
                            for (int r = 0; r < 4; ++r) na[r] = MFMA16(*(const LAS bf16x8s*)(slot + ((r * 2 + ks) * 64 + lane) * 16), sf[ks], na[r]);
#pragma unroll
                        for (int r = 0; r < 4; ++r) acc[r] = na[r];
                    }
                    lds_barrier(); }
            }
        }
    }
}

constexpr int S3_RT = 32768, S3_YT = S3_RT + TILE_B, S3_LG = S3_YT + TILE_B, S3_LGP = 336;
struct S3In { v4u rr, yy, vv, lg[3]; bf16x8s sA[2]; float rkb; };
__device__ __forceinline__ void s3_fetch(S3In& f, unsigned char* ws, int unit, int tid, int lane, int wave) {
    const int h = unit & 15, c = (unit >> 4) & 127, b = unit >> 11; const size_t chunk = ((size_t)b * NH + h) * 128 + c, row0 = (size_t)b * SEQ + c * 64;
    const int rt = wave & 3, et = tid >> 3, ecq = tid & 7;
    const bf16* Rg = (const bf16*)(ws + WS_B1); const bf16* Kg = (const bf16*)(ws + WS_B2); const bf16* Vb = (const bf16*)(ws + WS_B3); const bf16* LG = (const bf16*)(ws + WS_LG);
    const bf16* Sg = (const bf16*)OUTP() + (size_t)M * C + chunk * 4096;
    const size_t o_ = (row0 + et) * C + h * HD + ecq * 8;
    f.rr = *(const GAS v4u*)(Rg + o_); f.yy = *(const GAS v4u*)(Kg + o_); f.vv = *(const GAS v4u*)(Vb + o_);
#pragma unroll
    for (int i = 0; i < 3; ++i) { const int chn = tid + 512 * i; if (chn < 64 * 20) f.lg[i] = *(const GAS v4u*)(LG + (row0 + chn / 20) * DG + (chn % 20) * 8); }
#pragma unroll
    for (int ks = 0; ks < 2; ++ks) f.sA[ks] = *(const GAS bf16x8s*)(Sg + ((rt * 2 + ks) * 64 + lane) * 8);
    f.rkb = ((const float*)(ws + WS_HID))[(row0 + et) * NH + h];
}
__device__ __forceinline__ void scan_s3(unsigned char* ws, LAS unsigned char* lds, int lane0, int wave) {
    const int rt = wave & 3, ch = wave >> 2;
    LAS float* Ys = (LAS float*)(lds + CS_FA);
    const bf16* G2T = (const bf16*)(ws + WS_WT_G2); bf16* YG = (bf16*)(ws + WS_B0);
    constexpr int NU = BATCH * NH * (SEQ / 64);
    S3In fin; bf16x8s gA[5]; f32x4 lnw0, lnw1, lnb0, lnb1;
    { int l0 = lane0; asm volatile("" : "+v"(l0)); const int hh = blockIdx.x & 15, t0_ = wave * 64 + l0;
      if ((int)blockIdx.x < NU) s3_fetch(fin, ws, blockIdx.x, t0_, l0, wave);
#pragma unroll
      for (int ks = 0; ks < 5; ++ks) gA[ks] = *(const GAS bf16x8s*)(G2T + (size_t)(hh * HD + 16 * rt + (l0 & 15)) * DG + 32 * ks + 8 * (l0 >> 4));
      const int ec0 = hh * HD + (t0_ & 7) * 8;
      lnw0 = *(const GAS f32x4*)(INP(18) + ec0); lnw1 = *(const GAS f32x4*)(INP(18) + ec0 + 4); lnb0 = *(const GAS f32x4*)(INP(19) + ec0); lnb1 = *(const GAS f32x4*)(INP(19) + ec0 + 4); }
    __syncthreads();
    for (int unit = blockIdx.x; unit < NU; unit += gridDim.x) {
        int lane = lane0; asm volatile("" : "+v"(lane));
        const int tid = wave * 64 + lane, fr = lane & 15, g = lane >> 4, et = tid >> 3, ecq = tid & 7;
        const int h = unit & 15, c = (unit >> 4) & 127, b = unit >> 11; const size_t row0 = (size_t)b * SEQ + c * 64;
        *(LAS v4u*)(lds + S3_RT + et * TPB + ecq * 16) = fin.rr; *(LAS v4u*)(lds + S3_YT + et * TPB + ecq * 16) = fin.yy;
#pragma unroll
        for (int i = 0; i < 3; ++i) { const int chn = tid + 512 * i; if (chn < 64 * 20) *(LAS v4u*)(lds + S3_LG + (chn / 20) * S3_LGP + (chn % 20) * 16) = fin.lg[i]; }
        float v8[8]; unpack8(fin.vv, v8); const float rkb = fin.rkb; const bf16x8s sA0 = fin.sA[0], sA1 = fin.sA[1];
        lds_barrier();
        if (unit + (int)gridDim.x < NU) s3_fetch(fin, ws, unit + gridDim.x, tid, lane, wave);
        f32x4 acc[2], ag[2] = {F4Z, F4Z};
#pragma unroll
        for (int ct = 0; ct < 2; ++ct) { const int t = 32 * ch + 16 * ct + fr;
            acc[ct] = unpack4(*(const LAS bf16x4s*)(lds + S3_YT + t * TPB + (16 * rt + 4 * g) * 2));
            acc[ct] = MFMA16(sA0, ldfrag_perm(lds + S3_RT, t, 0, g), acc[ct]); acc[ct] = MFMA16(sA1, ldfrag_perm(lds + S3_RT, t, 1, g), acc[ct]);
#pragma unroll
            for (int ks = 0; ks < 5; ++ks) ag[ct] = MFMA16(gA[ks], *(const LAS bf16x8s*)(lds + S3_LG + t * S3_LGP + (32 * ks + 8 * g) * 2), ag[ct]);
            *(LAS f32x4*)(Ys + t * FP + 16 * rt + 4 * g) = acc[ct]; }
        lds_barrier();
        {
            const f32x4 y0 = *(const LAS f32x4*)(Ys + et * FP + ecq * 8), y1 = *(const LAS f32x4*)(Ys + et * FP + ecq * 8 + 4);
            float y[8] = {y0[0], y0[1], y0[2], y0[3], y1[0], y1[1], y1[2], y1[3]};
            float s_ = 0.f;
#pragma unroll
            for (int q = 0; q < 8; ++q) s_ += y[q];
            s_ = sum8(s_);
            const float mu = s_ * (1.0f / HD); float vs = 0.f;
#pragma unroll
            for (int q = 0; q < 8; ++q) { y[q] -= mu; vs += y[q] * y[q]; }
            vs = sum8(vs);
            const float rstd = 1.0f / sqrtf(vs * (1.0f / HD) + GN_EPS);
            f32x4 o0, o1;
#pragma unroll
            for (int q = 0; q < 4; ++q) { o0[q] = y[q] * rstd * lnw0[q] + lnb0[q] + rkb * v8[q]; o1[q] = y[4 + q] * rstd * lnw1[q] + lnb1[q] + rkb * v8[4 + q]; }
            *(LAS f32x4*)(Ys + et * FP + ecq * 8) = o0; *(LAS f32x4*)(Ys + et * FP + ecq * 8 + 4) = o1;
        }
        lds_barrier();
#pragma unroll
        for (int ct = 0; ct < 2; ++ct) { const int t = 32 * ch + 16 * ct + fr; const f32x4 yv = *(const LAS f32x4*)(Ys + t * FP + 16 * rt + 4 * g);
            *(GAS bf16x4s*)(YG + (row0 + t) * C + h * HD + 16 * rt + 4 * g) = pack4(yv * ag[ct]); }
    }
    __syncthreads();
}
#undef TILE
#if MK_DEBUG
__device__ __forceinline__ void scan_naive(unsigned char* ws, LAS unsigned char* lds, int tid) {
    const int lane = tid & 63;
    const bf16* Rb = (const bf16*)(ws + WS_B1); const bf16* Kb = (const bf16*)(ws + WS_B2); const bf16* Vb = (const bf16*)(ws + WS_B3);
    const bf16* LW = (const bf16*)(ws + WS_LW); const bf16* LA = (const bf16*)(ws + WS_LA);
    float* Y = OUTP(); float* RK = (float*)(ws + WS_HID);
    LAS float* sR = (LAS float*)lds; LAS float* sK = sR + 4096; LAS float* sV = sK + 4096; LAS float* sA = sV + 4096; LAS float* sB = sA + 4096; LAS float* sD = sB + 4096;
    LAS float* sW2 = sD + 4096; LAS float* sA2 = sW2 + 4096;
    for (int unit = blockIdx.x; unit < BATCH * NH; unit += gridDim.x) {
        const int b = unit / NH, h = unit % NH;
        __syncthreads();
        for (int e = tid; e < 4096; e += 512) { const int d = e >> 6, j = e & 63; sW2[e] = INP(9)[(size_t)d * C + h * HD + j]; sA2[e] = INP(12)[(size_t)d * C + h * HD + j]; }
        __syncthreads();
        const int pt = tid >> 3, cq = tid & 7, c0 = h * HD + cq * 8;
        const int si = tid >> 3, jq = tid & 7;
        float S[8];
#pragma unroll
        for (int q = 0; q < 8; ++q) S[q] = 0.f;
        float w0v[8], a0v[8], kkv[8], kav[8], rkv[8];
#pragma unroll
        for (int q = 0; q < 8; ++q) { w0v[q] = INP(7)[c0 + q]; a0v[q] = INP(10)[c0 + q]; kkv[q] = INP(15)[c0 + q]; kav[q] = INP(16)[c0 + q]; rkv[q] = INP(17)[c0 + q]; }
        for (int blk = 0; blk < SEQ / 64; ++blk) {
            const size_t row = (size_t)b * SEQ + blk * 64 + pt;
            {
                const v4u r4 = *(const GAS v4u*)(Rb + row * C + c0), k4 = *(const GAS v4u*)(Kb + row * C + c0), v4 = *(const GAS v4u*)(Vb + row * C + c0);
                float r[8], k[8], v[8];
                r[0] = bflo(r4.x); r[1] = bfhi(r4.x); r[2] = bflo(r4.y); r[3] = bfhi(r4.y); r[4] = bflo(r4.z); r[5] = bfhi(r4.z); r[6] = bflo(r4.w); r[7] = bfhi(r4.w);
                k[0] = bflo(k4.x); k[1] = bfhi(k4.x); k[2] = bflo(k4.y); k[3] = bfhi(k4.y); k[4] = bflo(k4.z); k[5] = bfhi(k4.z); k[6] = bflo(k4.w); k[7] = bfhi(k4.w);
                v[0] = bflo(v4.x); v[1] = bfhi(v4.x); v[2] = bflo(v4.y); v[3] = bfhi(v4.y); v[4] = bflo(v4.z); v[5] = bfhi(v4.z); v[6] = bflo(v4.w); v[7] = bfhi(v4.w);
                float wp[8], ap[8];
#pragma unroll
                for (int q = 0; q < 8; ++q) { wp[q] = w0v[q]; ap[q] = a0v[q]; }
                for (int d = 0; d < 64; ++d) { const float lw = bf2f(LW[row * DW + d]), la = bf2f(LA[row * DA + d]);
#pragma unroll
                    for (int q = 0; q < 8; ++q) { wp[q] += lw * sW2[d * 64 + cq * 8 + q]; ap[q] += la * sA2[d * 64 + cq * 8 + q]; } }
                float kk[8], ss = 0.f, rks = 0.f;
#pragma unroll
                for (int q = 0; q < 8; ++q) { kk[q] = k[q] * kkv[q]; ss += kk[q] * kk[q]; }
                ss = sum8(ss);
                const float inv = 1.0f / fmaxf(sqrtf(ss), 1e-12f);
#pragma unroll
                for (int q = 0; q < 8; ++q) { const float ag = sigmoidf_(ap[q]); const float kn = kk[q] * inv; const float kp = k[q] * (1.0f + (ag - 1.0f) * kav[q]);
                    const float lw = -0.6065306597126334f * sigmoidf_(wp[q]);
                    const int o = pt * 64 + cq * 8 + q;
                    sR[o] = r[q]; sK[o] = kp; sV[o] = v[q]; sA[o] = -kn; sB[o] = kn * ag; sD[o] = __expf(lw); rks += r[q] * kp * rkv[q]; }
                rks = sum8(rks);
                if (cq == 0) RK[row * NH + h] = rks;
            }
            __syncthreads();
            for (int t = 0; t < 64; ++t) {
                const LAS f32x4* pa = (const LAS f32x4*)(sA + t * 64 + jq * 8); const LAS f32x4* pb = (const LAS f32x4*)(sB + t * 64 + jq * 8);
                const LAS f32x4* pd = (const LAS f32x4*)(sD + t * 64 + jq * 8); const LAS f32x4* pk = (const LAS f32x4*)(sK + t * 64 + jq * 8);
                const LAS f32x4* pr = (const LAS f32x4*)(sR + t * 64 + jq * 8);
                const f32x4 a0 = pa[0], a1 = pa[1], b0 = pb[0], b1 = pb[1], d0 = pd[0], d1 = pd[1], k0 = pk[0], k1 = pk[1], r0 = pr[0], r1 = pr[1];
                const float vi = sV[t * 64 + si];
                float sa = 0.f;
#pragma unroll
                for (int q = 0; q < 4; ++q) { sa += S[q] * a0[q]; sa += S[4 + q] * a1[q]; }
                sa = sum8(sa);
                float y = 0.f;
#pragma unroll
                for (int q = 0; q < 4; ++q) { S[q] = S[q] * d0[q] + sa * b0[q] + vi * k0[q]; S[4 + q] = S[4 + q] * d1[q] + sa * b1[q] + vi * k1[q]; y += S[q] * r0[q]; y += S[4 + q] * r1[q]; }
                y = sum8(y);
                if (jq == 0) Y[((size_t)b * SEQ + blk * 64 + t) * C + h * HD + si] = y;
            }
            __syncthreads();
        }
    }
}
__device__ __forceinline__ void post_scan(unsigned char* ws, int gw, int NGW, int lane) {
    const float* Y = OUTP(); const float* RK = (const float*)(ws + WS_HID); const bf16* Vb = (const bf16*)(ws + WS_B3); const bf16* LG = (const bf16*)(ws + WS_LG);
    bf16* YG = (bf16*)(ws + WS_B4); const float* g2 = INP(14); const float* lnw = INP(18); const float* lnb = INP(19);
    for (int it = gw; it < M * NH; it += NGW) {
        const int row = it / NH, h = it % NH, c = h * HD + lane;
        const float y = Y[(size_t)row * C + c];
        const float mu = wave_sum(y, lane) * (1.0f / HD); const float d = y - mu; const float var = wave_sum(d * d, lane) * (1.0f / HD);
        float o = d * (1.0f / sqrtf(var + GN_EPS)) * lnw[c] + lnb[c];
        o += RK[(size_t)row * NH + h] * bf2f(Vb[(size_t)row * C + c]);
        float g = 0.f;
        for (int dd = 0; dd < DG; ++dd) g += bf2f(LG[(size_t)row * DG + dd]) * g2[(size_t)dd * C + c];
        YG[(size_t)row * C + c] = (bf16)f2bf(o * g);
    }
}


constexpr int CW_DBG = 3200;
__device__ __forceinline__ void dbg_nonfinite(unsigned char* ws, const bf16* X, size_t n, int slot, int gw, int NGW, int lane, float thr = 1e30f) {
    unsigned* cw = (unsigned*)(ws + WS_CTL) + CW_DBG + 64 * slot; unsigned nnan = 0;
    for (size_t i = (size_t)gw * 64 + lane; i < n; i += (size_t)NGW * 64) { const float x = bf2f(X[i]); if (!(fabsf(x) < thr)) ++nnan; }
    if (nnan) atomicAdd(cw, nnan);
}
__device__ __forceinline__ void dbg_compare(unsigned char* ws, const bf16* X, const bf16* Y, int gw, int NGW, int lane) {
    unsigned* cw = (unsigned*)(ws + WS_CTL) + CW_DBG; unsigned nbad = 0, nnan = 0;
    for (size_t i = (size_t)gw * 64 + lane; i < (size_t)M * C; i += (size_t)NGW * 64) { const float x = bf2f(X[i]), y = bf2f(Y[i]);
        if (!(fabsf(x) < 1e30f)) ++nnan; else if (fabsf(x - y) > 0.05f * (fabsf(y) + 0.05f)) ++nbad; }
    if (nnan) atomicAdd(cw, nnan); if (nbad) atomicAdd(cw + 64, nbad);
}
#endif
__device__ __forceinline__ void router_rows(unsigned char* ws, LAS unsigned char* lds, int layer, int gw, int NGW, int lane, int tid, int wv, bool dry = false) {
    const bf16* Hh = (const bf16*)(ws + WS_B4); const float* gain = INP(2) + layer * C; float* rsl = (float*)(ws + WS_B0);
    const float* wg = INP(24) + (size_t)layer * C * 4; const float* bg = INP(25) + layer * 4; const float* wi = INP(26) + (size_t)layer * C * 16; const float* bi = INP(27) + layer * 16;
    unsigned* cnt = (unsigned*)(ws + WS_CTL) + CW_CNT + layer * 16 * 64; unsigned* list = (unsigned*)(ws + WS_LIST); float* wl = (float*)(ws + WS_WL);
    LAS float* sWg = (LAS float*)lds; LAS float* sWi = sWg + C * 4;
    constexpr int RECMAX = 256;
    LAS unsigned* lcnt = (LAS unsigned*)(lds + 81920); LAS unsigned* gbase = lcnt + 16; LAS float* sBias = (LAS float*)(lcnt + 32);
    LAS unsigned* recRow = lcnt + 64; LAS unsigned* recE = recRow + RECMAX; LAS unsigned* recL = recE + RECMAX; LAS float* recW0 = (LAS float*)(recL + RECMAX); LAS float* recW1 = recW0 + RECMAX; LAS float* recRS = recW1 + RECMAX;
    __syncthreads();
    for (int e = tid; e < C; e += 512) { const int r = e >> 6, c = 256 * (r >> 2) + 4 * (e & 63) + (r & 3); ((LAS f32x4*)sWg)[e] = ((const GAS f32x4*)wg)[c]; }
    for (int e = tid; e < C * 4; e += 512) { const int r = e >> 6, jq = r >> 2, c = 256 * (jq >> 2) + 4 * (e & 63) + (jq & 3); ((LAS f32x4*)sWi)[e] = ((const GAS f32x4*)wi)[c * 4 + (r & 3)]; }
    if (tid < 4) sBias[tid] = bg[tid]; else if (tid < 20) sBias[tid] = bi[tid - 4];
    for (int e = tid; e < RECMAX; e += 512) recE[e] = 0xffffffffu;
    __syncthreads();
    f32x4 g[4]; load_row(gain, lane, g);
    v2u nxr[2][4];
#pragma unroll
    for (int r = 0; r < 2; ++r) { const int r0 = gw + r * NGW < M - 1 ? gw + r * NGW : M - 1;
#pragma unroll
        for (int j = 0; j < 4; ++j) nxr[r][j] = ((const GAS v2u*)(Hh + (size_t)r0 * C))[64 * j + lane]; }
    int k = 0;
    for (int row = gw; row < M; row += 2 * NGW, k += 2) {
        f32x4 v[2][4];
#pragma unroll
        for (int r = 0; r < 2; ++r)
#pragma unroll
            for (int j = 0; j < 4; ++j) v[r][j] = (f32x4){bflo(nxr[r][j].x), bfhi(nxr[r][j].x), bflo(nxr[r][j].y), bfhi(nxr[r][j].y)};
#pragma unroll
        for (int r = 0; r < 2; ++r) { const int rn = row + (2 + r) * NGW, r0 = rn < M - 1 ? rn : M - 1;
#pragma unroll
            for (int j = 0; j < 4; ++j) nxr[r][j] = ((const GAS v2u*)(Hh + (size_t)r0 * C))[64 * j + lane]; }
        float rs[2];
#pragma unroll
        for (int r = 0; r < 2; ++r) { rs[r] = row_rs(v[r], lane);
#pragma unroll
            for (int j = 0; j < 4; ++j) v[r][j] = v[r][j] * rs[r] * g[j]; }
        float gl[2][4] = {{0.f, 0.f, 0.f, 0.f}, {0.f, 0.f, 0.f, 0.f}};
        const LAS unsigned char* pWg = (const LAS unsigned char*)sWg + lane * 16;
#pragma unroll
        for (int j = 0; j < 4; ++j)
#pragma unroll
            for (int q = 0; q < 4; ++q) { const f32x4 w = *(const LAS f32x4*)(pWg + (j * 4 + q) * 1024);
#pragma unroll
                for (int r = 0; r < 2; ++r) { const float xv = v[r][j][q]; gl[r][0] += xv * w.x; gl[r][1] += xv * w.y; gl[r][2] += xv * w.z; gl[r][3] += xv * w.w; } }
        int gi[2]; float gval[2];
#pragma unroll
        for (int r = 0; r < 2; ++r) {
#pragma unroll
            for (int q = 0; q < 4; ++q) gl[r][q] = wave_sum(gl[r][q], lane) + sBias[q];
            gi[r] = 0; float gm = gl[r][0];
#pragma unroll
            for (int q = 1; q < 4; ++q) if (gl[r][q] > gm) { gm = gl[r][q]; gi[r] = q; }
            float gden = 0.f;
#pragma unroll
            for (int q = 0; q < 4; ++q) gden += __expf(gl[r][q] - gm);
            gval[r] = 1.0f / gden; }
        float il[2][4] = {{0.f, 0.f, 0.f, 0.f}, {0.f, 0.f, 0.f, 0.f}};
        const LAS unsigned char* pWi0 = (const LAS unsigned char*)sWi + lane * 16 + gi[0] * 1024;
        const LAS unsigned char* pWi1 = (const LAS unsigned char*)sWi + lane * 16 + gi[1] * 1024;
#pragma unroll
        for (int j = 0; j < 4; ++j)
#pragma unroll
            for (int q = 0; q < 4; ++q) {
                { const f32x4 w = *(const LAS f32x4*)(pWi0 + (j * 4 + q) * 4096); const float xv = v[0][j][q]; il[0][0] += xv * w.x; il[0][1] += xv * w.y; il[0][2] += xv * w.z; il[0][3] += xv * w.w; }
                { const f32x4 w = *(const LAS f32x4*)(pWi1 + (j * 4 + q) * 4096); const float xv = v[1][j][q]; il[1][0] += xv * w.x; il[1][1] += xv * w.y; il[1][2] += xv * w.z; il[1][3] += xv * w.w; } }
#pragma unroll
        for (int r = 0; r < 2; ++r) {
            const f32x4 bi4 = *(const LAS f32x4*)(sBias + 4 + gi[r] * 4);
#pragma unroll
            for (int q = 0; q < 4; ++q) il[r][q] = wave_sum(il[r][q], lane) + bi4[q];
            int i0 = 0; float m0 = il[r][0];
#pragma unroll
            for (int q = 1; q < 4; ++q) if (il[r][q] > m0) { m0 = il[r][q]; i0 = q; }
            int i1 = -1; float m1 = -INFINITY;
#pragma unroll
            for (int q = 0; q < 4; ++q) if (q != i0 && il[r][q] > m1) { m1 = il[r][q]; i1 = q; }
            const float e1 = __expf(m1 - m0); const float w0 = gval[r] / (1.0f + e1), w1 = gval[r] * e1 / (1.0f + e1);
            const int ri = wv * 32 + k + r;
            if (lane == 0 && !dry && k + r < 32 && row + r * NGW < M) { const int ex0 = gi[r] * 4 + i0, ex1 = gi[r] * 4 + i1;
                recRow[ri] = (unsigned)(row + r * NGW); recE[ri] = (unsigned)ex0 | ((unsigned)ex1 << 8); recW0[ri] = w0; recW1[ri] = w1; recRS[ri] = rs[r]; }
        }
    }
    __syncthreads();
    unsigned e = 0xffffffffu; if (tid < RECMAX) e = recE[tid];
    const unsigned ex0 = e & 255u, ex1 = (e >> 8) & 255u;
    unsigned pos0 = 0u, pos1 = 0u;
    if (wv < RECMAX / 64) {
#pragma unroll
        for (unsigned x = 0; x < 16; ++x) { const unsigned long long m0 = __ballot(ex0 == x), m1 = __ballot(ex1 == x);
            const unsigned p = __builtin_amdgcn_mbcnt_hi((unsigned)(m0 >> 32), __builtin_amdgcn_mbcnt_lo((unsigned)m0, 0u)) + __builtin_amdgcn_mbcnt_hi((unsigned)(m1 >> 32), __builtin_amdgcn_mbcnt_lo((unsigned)m1, 0u));
            if (ex0 == x) pos0 = p; if (ex1 == x) pos1 = p;
            if (lane == 0) recL[wv * 16 + x] = (unsigned)(__popcll(m0) + __popcll(m1)); } }
    __syncthreads();
    if (tid < 16 && !dry) { unsigned c_ = 0u;
#pragma unroll
        for (int q = 0; q < RECMAX / 64; ++q) c_ += recL[q * 16 + tid];
        gbase[tid] = atomicAdd(cnt + tid * 64, c_); }
    __syncthreads();
    if (e != 0xffffffffu && !dry) { unsigned p0 = gbase[ex0] + pos0, p1 = gbase[ex1] + pos1;
        for (int q = 0; q < wv; ++q) { p0 += recL[q * 16 + ex0]; p1 += recL[q * 16 + ex1]; }
        const unsigned row = recRow[tid]; const float rs = recRS[tid];
        list[(size_t)ex0 * M + p0] = row * 2u; wl[(size_t)ex0 * M + p0] = recW0[tid]; list[(size_t)ex1 * M + p1] = row * 2u + 1u; wl[(size_t)ex1 * M + p1] = recW1[tid];
        rsl[(size_t)ex0 * M + p0] = rs; rsl[(size_t)ex1 * M + p1] = rs; }
}
__device__ __forceinline__ void moe_table(unsigned char* ws, volatile LAS int* tab, int layer, int tid) {
    __syncthreads();
    if (tid == 0) { const unsigned* cnt = (const unsigned*)(ws + WS_CTL) + CW_CNT + layer * 16 * 64; int t = 0;
#pragma unroll 1
        for (int e = 0; e < 16; ++e) { const int c = (int)__hip_atomic_load(cnt, RLX_AGENT); cnt += 64; tab[e] = c; tab[16 + e] = t; t += (c + 255) >> 8; tab[32 + e] = t; }
        tab[48] = t; }
    __syncthreads();
}
__device__ __forceinline__ void combine_rows(unsigned char* ws, int mode, int gw, int NGW, int lane, bool dry = false) {
    bf16* Hh = (bf16*)(ws + WS_B4); float* Out = OUTP(); const bf16* E0 = (const bf16*)(ws + WS_B2); const bf16* E1 = (const bf16*)(ws + WS_B3); bf16* XN2 = (bf16*)(ws + WS_B0);
    f32x4 g[4]; load_row(INP(4), lane, g);
    for (int row = gw; row < M; row += NGW) {
        f32x4 v[4]; load_row_bf(Hh + (size_t)row * C, lane, v);
#pragma unroll
        for (int j = 0; j < 4; ++j) { const v2u e0 = ((const GAS v2u*)(E0 + (size_t)row * C))[64 * j + lane], e1 = ((const GAS v2u*)(E1 + (size_t)row * C))[64 * j + lane];
            v[j].x += bflo(e0.x) + bflo(e1.x); v[j].y += bfhi(e0.x) + bfhi(e1.x); v[j].z += bflo(e0.y) + bflo(e1.y); v[j].w += bfhi(e0.y) + bfhi(e1.y); }
        const float rs = row_rs(v, lane);
        if (mode == 0) {
            if (!dry) store_row_bf16(Hh + (size_t)row * C, lane, v);
            if (lane == 0) ((float*)XN2)[row] = rs;
        } else {
            float sig = 1.0f;
#if MK_DEBUG
            const unsigned* cw = (const unsigned*)(ws + WS_CTL) + CW_DBG; const unsigned nnan = __hip_atomic_load(cw, RLX_AGENT), nbad = __hip_atomic_load(cw + 64, RLX_AGENT);
            if (row < 512 && nnan > 0) sig = 2.0f;
            if (row >= 512 && row < 1536 && __hip_atomic_load(cw + 128, RLX_AGENT) > 0) sig = 2.0f;
            if (row >= 1536 && row < 3584 && __hip_atomic_load(cw + 192, RLX_AGENT) > 0) sig = 2.0f;
            if (row >= 3584 && row < 7680 && __hip_atomic_load(cw + 256, RLX_AGENT) > 0) sig = 2.0f;
            if (row >= 7680 && row < 15872 && __hip_atomic_load(cw + 320, RLX_AGENT) > 0) sig = 2.0f;
            if (row >= 15872 && nbad > (unsigned)(M / 100) * C) sig = 1.5f;
#endif
#pragma unroll
            for (int j = 0; j < 4; ++j) ((GAS f32x4*)(Out + (size_t)row * C))[64 * j + lane] = v[j] * rs * g[j] * sig;
        }
    }
}
__device__ __forceinline__ void attn_naive(unsigned char* ws, int gw, int NGW, int lane) {
    const bf16* Kb = (const bf16*)(ws + WS_B1); const bf16* Vb = (const bf16*)(ws + WS_B2); const bf16* Qb = (const bf16*)(ws + WS_B3); bf16* Ob = (bf16*)(ws + WS_B0);
    for (int unit = gw; unit < BATCH * NH * (SEQ / 64); unit += NGW) {
        const int qb = unit % (SEQ / 64), bh = unit / (SEQ / 64), b = bh / NH, h = bh % NH;
        const int t0 = qb * 64, t = t0 + lane; const size_t rowq = (size_t)b * SEQ + t;
        float q[64], o[64];
#pragma unroll
        for (int c = 0; c < 8; ++c) { const v4u w = *(const GAS v4u*)(Qb + rowq * C + h * HD + c * 8);
            q[c * 8 + 0] = bflo(w.x) * 0.125f; q[c * 8 + 1] = bfhi(w.x) * 0.125f; q[c * 8 + 2] = bflo(w.y) * 0.125f; q[c * 8 + 3] = bfhi(w.y) * 0.125f;
            q[c * 8 + 4] = bflo(w.z) * 0.125f; q[c * 8 + 5] = bfhi(w.z) * 0.125f; q[c * 8 + 6] = bflo(w.w) * 0.125f; q[c * 8 + 7] = bfhi(w.w) * 0.125f; }
#pragma unroll
        for (int c = 0; c < 64; ++c) o[c] = 0.f;
        float suffix = 0.f;
        for (int s = t0 + 62; s >= 0; --s) {
            const bool valid = s < t;
            if (s < t0 && __all(suffix > SB_EXIT)) break;
            const bf16* kp = Kb + ((size_t)b * SEQ + s) * C + h * HD; const bf16* vp = Vb + ((size_t)b * SEQ + s) * C + h * HD;
            float z = 0.f;
#pragma unroll
            for (int c = 0; c < 8; ++c) { const v4u w = *(const GAS v4u*)(kp + c * 8);
                z += q[c * 8 + 0] * bflo(w.x) + q[c * 8 + 1] * bfhi(w.x) + q[c * 8 + 2] * bflo(w.y) + q[c * 8 + 3] * bfhi(w.y) + q[c * 8 + 4] * bflo(w.z) + q[c * 8 + 5] * bfhi(w.z) + q[c * 8 + 6] * bflo(w.w) + q[c * 8 + 7] * bfhi(w.w); }
            const float sp = fmaxf(z, 0.f) + log1pf(__expf(-fabsf(z)));
            const float att = valid ? __expf(z - sp - suffix) : 0.f;
            suffix += valid ? sp : 0.f;
#pragma unroll
            for (int c = 0; c < 8; ++c) { const v4u w = *(const GAS v4u*)(vp + c * 8);
                o[c * 8 + 0] += att * bflo(w.x); o[c * 8 + 1] += att * bfhi(w.x); o[c * 8 + 2] += att * bflo(w.y); o[c * 8 + 3] += att * bfhi(w.y);
                o[c * 8 + 4] += att * bflo(w.z); o[c * 8 + 5] += att * bfhi(w.z); o[c * 8 + 6] += att * bflo(w.w); o[c * 8 + 7] += att * bfhi(w.w); }
        }
#pragma unroll
        for (int c = 0; c < 8; ++c) { v4u w; w.x = pk2(o[c * 8 + 0], o[c * 8 + 1]); w.y = pk2(o[c * 8 + 2], o[c * 8 + 3]); w.z = pk2(o[c * 8 + 4], o[c * 8 + 5]); w.w = pk2(o[c * 8 + 6], o[c * 8 + 7]);
            *(GAS v4u*)(Ob + rowq * C + h * HD + c * 8) = w; }
    }
}


typedef float f32x16 __attribute__((ext_vector_type(16)));
constexpr int AT_VP = 192;
constexpr int AT_WAVE_LDS = 32 * AT_VP;
__device__ __forceinline__ int crow32(int reg, int hh) { return (reg & 3) + 8 * (reg >> 2) + 4 * hh; }
__device__ __forceinline__ bf16x8s pack_step(const f32x16& x, const int s) {
    v4u p; p.x = pg8::cvt_pk_bf16(x[8 * s], x[8 * s + 1]); p.y = pg8::cvt_pk_bf16(x[8 * s + 2], x[8 * s + 3]); p.z = pg8::cvt_pk_bf16(x[8 * s + 4], x[8 * s + 5]); p.w = pg8::cvt_pk_bf16(x[8 * s + 6], x[8 * s + 7]);
    return __builtin_bit_cast(bf16x8s, p);
}
__device__ __forceinline__ void attn_mfma(unsigned char* ws, LAS unsigned char* lds, int gw, int NGW, int lane, int wave) {
    const bf16* Kb = (const bf16*)(ws + WS_B1); const bf16* Vb = (const bf16*)(ws + WS_B2); const bf16* Qb = (const bf16*)(ws + WS_B3); bf16* Ob = (bf16*)(ws + WS_B0);
    LAS unsigned char* vl = lds + wave * AT_WAVE_LDS;
    const int r32 = lane & 31, hh = lane >> 5;
    bf16x8s tri[2];
#pragma unroll
    for (int s = 0; s < 2; ++s)
#pragma unroll
        for (int j = 0; j < 8; ++j) tri[s][j] = (16 * s + 8 * (j >> 2) + 4 * hh + (j & 3)) > r32 ? (short)0x3F80 : (short)0;
    const int grp = lane >> 4, tq = (lane & 15) >> 2, tp = lane & 3;
    const LAS unsigned char* vtr0 = vl + (4 * hh + tq) * AT_VP + (16 * (grp & 1) + 4 * tp) * 2;
    for (int unit = gw; unit < BATCH * NH * (SEQ / 32); unit += NGW) {
        const int qb = unit % (SEQ / 32), bh = unit / (SEQ / 32), b = bh / NH, hd = bh % NH;
        const int t0 = qb * 32; const size_t rowb = (size_t)b * SEQ;
        bf16x8s qf[4];
#pragma unroll
        for (int ks = 0; ks < 4; ++ks) qf[ks] = *(const GAS bf16x8s*)(Qb + (rowb + t0 + r32) * C + hd * HD + 16 * ks + 8 * hh);
        f32x16 o[2];
#pragma unroll
        for (int i = 0; i < 16; ++i) { o[0][i] = 0.f; o[1][i] = 0.f; }
        float carry = 0.f;
        for (int s0 = t0; s0 >= 0; s0 -= 32) {
            bf16x8s kf[4];
#pragma unroll
            for (int ks = 0; ks < 4; ++ks) kf[ks] = *(const GAS bf16x8s*)(Kb + (rowb + s0 + r32) * C + hd * HD + 16 * ks + 8 * hh);
            v4u vreg[4];
#pragma unroll
            for (int i = 0; i < 4; ++i) { const int cidx = lane + 64 * i; vreg[i] = *(const GAS v4u*)(Vb + (rowb + s0 + (cidx >> 3)) * C + hd * HD + (cidx & 7) * 8); }
            f32x16 st;
#pragma unroll
            for (int i = 0; i < 16; ++i) st[i] = 0.f;
#pragma unroll
            for (int ks = 0; ks < 4; ++ks) st = __builtin_amdgcn_mfma_f32_32x32x16_bf16(kf[ks], qf[ks], st, 0, 0, 0);
#pragma unroll
            for (int i = 0; i < 4; ++i) { const int cidx = lane + 64 * i; *(LAS v4u*)(vl + (cidx >> 3) * AT_VP + (cidx & 7) * 16) = vreg[i]; }
            f32x16 zz, uu; float tot = 0.f; const int tq_ = t0 + r32;
            if (s0 + 31 < t0) {
#pragma unroll
                for (int i = 0; i < 16; ++i) { const float z = st[i] * 0.18033688011112042f; const float sp = fmaxf(z, 0.f) + __builtin_amdgcn_logf(1.0f + __builtin_amdgcn_exp2f(-fabsf(z)));
                    zz[i] = z - sp; uu[i] = sp; tot += sp; }
            } else {
#pragma unroll
                for (int i = 0; i < 16; ++i) { const int key = s0 + crow32(i, hh); const float z = st[i] * 0.18033688011112042f; const float sp = fmaxf(z, 0.f) + __builtin_amdgcn_logf(1.0f + __builtin_amdgcn_exp2f(-fabsf(z)));
                    const bool valid = key < tq_; zz[i] = valid ? z - sp : -1e30f; uu[i] = valid ? sp : 0.f; tot += uu[i]; }
            }
            f32x16 w;
#pragma unroll
            for (int i = 0; i < 16; ++i) w[i] = 0.f;
#pragma unroll
            for (int s = 0; s < 2; ++s) w = __builtin_amdgcn_mfma_f32_32x32x16_bf16(tri[s], pack_step(uu, s), w, 0, 0, 0);
            f32x16 pp;
#pragma unroll
            for (int i = 0; i < 16; ++i) pp[i] = __builtin_amdgcn_exp2f(zz[i] - w[i] - carry);
            tot += shx(tot, 32, lane); carry += tot;
            asm volatile("s_waitcnt lgkmcnt(0)" ::: "memory");
#pragma unroll
            for (int s = 0; s < 2; ++s) { const bf16x8s pa = pack_step(pp, s);
#pragma unroll
                for (int dt = 0; dt < 2; ++dt) {
                    const v4i16_t lo = __builtin_amdgcn_ds_read_tr16_b64_v4i16((LAS v4i16_t*)(vtr0 + (16 * s) * AT_VP + dt * 64));
                    const v4i16_t hi = __builtin_amdgcn_ds_read_tr16_b64_v4i16((LAS v4i16_t*)(vtr0 + (16 * s + 8) * AT_VP + dt * 64));
                    const bf16x8s vf = (bf16x8s){lo[0], lo[1], lo[2], lo[3], hi[0], hi[1], hi[2], hi[3]};
                    o[dt] = __builtin_amdgcn_mfma_f32_32x32x16_bf16(pa, vf, o[dt], 0, 0, 0); } }
            asm volatile("" ::: "memory");
            if (s0 < t0 && __all(carry > SB_EXIT * 1.4426950408889634f)) break;
        }
#pragma unroll
        for (int dt = 0; dt < 2; ++dt)
#pragma unroll
            for (int i = 0; i < 16; ++i) Ob[(rowb + t0 + crow32(i, hh)) * C + hd * HD + 32 * dt + r32] = (bf16)f2bf(o[dt][i]);
    }
}
__global__ void __launch_bounds__(NWAVES * 64, 2) yoco_fwd(Args args) {
    extern __shared__ __attribute__((aligned(16))) unsigned char lds_raw[];
    LAS unsigned char* lds = (LAS unsigned char*)lds_raw;
    const int G = gridDim.x; const int bx = blockIdx.x;
    int wave = __builtin_amdgcn_readfirstlane(threadIdx.x >> 6); asm volatile("" : "+s"(wave));
#define IDS() int lane; asm volatile("v_mbcnt_lo_u32_b32 %0, -1, 0\n\tv_mbcnt_hi_u32_b32 %0, -1, %0" : "=v"(lane)); const int tid = wave * 64 + lane; (void)tid; \
    const int vcu = (G % 8 == 0) ? (bx % 8) * (G / 8) + bx / 8 : bx; const int gw = vcu * NWAVES + wave, NGW = G * NWAVES; (void)lane; (void)gw; (void)NGW;
    unsigned char* ws = WSP();
    volatile LAS unsigned* MISC = (volatile LAS unsigned*)(lds + MISC_OFF);
    volatile LAS int* tab = (volatile LAS int*)(lds + MOE_TAB_OFF);
    for (int u = threadIdx.x; u < (LDS_BYTES - LDSCTL_OFF) / 4; u += NWAVES * 64) ((LAS unsigned*)(lds + LDSCTL_OFF))[u] = 0u;
    __syncthreads();
    XcdBarrier bar; bar.bar = (unsigned*)(ws + WS_CTL) + CW_BAR; bar.x = 0; bar.st = nullptr;
    if (N_LAUNCHES == 1) bar = xcd_barrier_post((unsigned*)(ws + WS_CTL) + CW_BAR, MISC + 8);
    const int lo = KA_INT(0), hi = KA_INT(1);
#ifndef PROBE_PH
#define PROBE_PH -1
#endif
#define IN(k) (lo <= (k) && (k) < hi)
#define REP(k) for (int rep_ = 0; rep_ < ((PROBE_PH == (k)) ? 2 : 1); ++rep_)
#define SEAM(k) do { if (IN(k) && IN((k) + 1)) xcd_barrier(bar); } while (0)

    if (IN(PH_P0)) REP(PH_P0) { IDS(); p0_weights<0>(ws, lds, gw, NGW, wave, lane); p0_weights<1>(ws, lds, gw, NGW, wave, lane); if (G <= 64) p0_weights<2>(ws, lds, gw, NGW, wave, lane); p0_rows(ws, gw, NGW, lane); }
    SEAM(PH_P0);
    if (PROBE_PH == 100 && N_LAUNCHES == 1) { for (int i_ = 0; i_ < 10; ++i_) xcd_barrier(bar); }
    if (IN(PH_LORA)) REP(PH_LORA) {
        SchedGrouped<1, 3> S{(const char*)(ws + WS_B1), (size_t)(WS_B2 - WS_B1), nullptr, (const char*)(ws + WS_WT_LORA), (size_t)256 * C * 2, G, bx};
        EpiLora E{(bf16*)(ws + WS_LW)};
        pg8::gemm_phase<EpiLora, SchedGrouped<1, 3>, true, false, C>(lds, S, E, wave);
    }
    SEAM(PH_LORA);
    if (IN(PH_RKV)) REP(PH_RKV) {
        SchedGrouped<4, 3> S{(const char*)OUTP(), (size_t)M * C * 2, (const char*)(ws + WS_B4), (const char*)(ws + WS_WT_RKV), (size_t)C * C * 2, G, bx};
        EpiSplit3 E{(bf16*)(ws + WS_B1), false, nullptr};
        pg8::gemm_phase<EpiSplit3, SchedGrouped<4, 3>, true, false, C>(lds, S, E, wave);
    }
    SEAM(PH_RKV);
    if (IN(PH_S1)) REP(PH_S1) { IDS(); scan_s1(ws, lds, lane, wave); }
    SEAM(PH_S1);
    if (IN(PH_S2)) REP(PH_S2) { IDS();
        if (bx < BATCH * NH || G <= BATCH * NH) scan_s2(ws, lds, lane, wave);
        }
    SEAM(PH_S2);
    if (IN(PH_S3)) REP(PH_S3) { IDS(); scan_s3(ws, lds, lane, wave); }
    SEAM(PH_S3);
#if MK_DEBUG
    if (IN(PH_DBG0)) { IDS(); scan_naive(ws, lds, tid); }
    SEAM(PH_DBG0);
    if (IN(PH_DBG0 + 1)) { IDS(); post_scan(ws, gw, NGW, lane); }
    SEAM(PH_DBG0 + 1);
    if (IN(PH_DBG0 + 2)) { IDS(); dbg_compare(ws, (const bf16*)(ws + WS_B0), (const bf16*)(ws + WS_B4), gw, NGW, lane); }
    SEAM(PH_DBG0 + 2);
#endif
    if (IN(PH_WOUT)) REP(PH_WOUT) {
        SchedGrouped<4, 1> S{(const char*)(ws + ((MK_DEBUG && DBG_USE_NAIVE) ? WS_B4 : WS_B0)), 0, nullptr, (const char*)(ws + WS_WT_OUT), 0, G, bx};
        EpiResidBf<true> E{INP(0), (bf16*)(ws + WS_B4)};
        pg8::gemm_phase<EpiResidBf<true>, SchedGrouped<4, 1>, true, false, C>(lds, S, E, wave);
    }
    SEAM(PH_WOUT);
#pragma unroll 1
    for (int layer = 0; layer < 2; ++layer) {
        const int pb = layer == 0 ? (int)PH_ROUT0 : (int)PH_ROUT1;
        if (IN(pb)) { IDS(); if (PROBE_PH == 101 && layer == 0) router_rows(ws, lds, layer, gw, NGW, lane, tid, wave, true); router_rows(ws, lds, layer, gw, NGW, lane, tid, wave); }
        SEAM(pb);
        if (IN(pb + 1)) REP(pb + 1) {
            { IDS(); moe_table(ws, tab, layer, tid); }
            SchedMoe<2, C, true> S{(const char*)(ws + WS_B4), (const char*)(ws + WS_WT_GU) + (size_t)layer * 16 * 512 * C * 2, (size_t)512 * C * 2, (const unsigned*)(ws + WS_LIST), tab, G, bx};
            EpiGU E{(bf16*)(ws + WS_HID), (const float*)(ws + WS_WL), (const float*)(ws + WS_B0)};
            pg8::gemm_phase<EpiGU, SchedMoe<2, C, true>, true, true, C>(lds, S, E, wave);
            if (layer == 0 && G > 64) { const int nr2 = __builtin_amdgcn_readfirstlane(tab[48]) * 2 - G, first = nr2 > 0 ? nr2 : 0;
                if (bx >= first) { IDS(); p0_weights<2>(ws, lds, (bx - first) * NWAVES + wave, (G - first) * NWAVES, wave, lane); } }
        }
        SEAM(pb + 1);
        if (IN(pb + 2)) REP(pb + 2) {
            { IDS(); moe_table(ws, tab, layer, tid); }
            SchedMoe<4, FE, false> S{(const char*)(ws + WS_HID), (const char*)(ws + WS_WT_DN) + (size_t)layer * 16 * C * FE * 2, (size_t)C * FE * 2, (const unsigned*)(ws + WS_LIST), tab, G, bx};
            EpiDown E{(bf16*)(ws + WS_B2), (const unsigned*)(ws + WS_LIST)};
            pg8::gemm_phase<EpiDown, SchedMoe<4, FE, false>, true, false, FE>(lds, S, E, wave);
        }
        SEAM(pb + 2);
        if (layer == 0) {
            if (IN(PH_COMB)) { IDS(); if (PROBE_PH == 102) combine_rows(ws, 0, gw, NGW, lane, true); combine_rows(ws, 0, gw, NGW, lane); }
            SEAM(PH_COMB);
            if (IN(PH_KVQ)) REP(PH_KVQ) {
                SchedGrouped<12, 1> S{(const char*)(ws + WS_B4), 0, nullptr, (const char*)(ws + WS_WT_KVQ), 0, G, bx};
                EpiSplit3 E{(bf16*)(ws + WS_B1), true, (const float*)(ws + WS_B0)};
                pg8::gemm_phase<EpiSplit3, SchedGrouped<12, 1>, true, false, C>(lds, S, E, wave);
            }
            SEAM(PH_KVQ);
            if (IN(PH_ATTN)) REP(PH_ATTN) { IDS(); attn_mfma(ws, lds, gw, NGW, lane, wave); }
            SEAM(PH_ATTN);
            if (IN(PH_SBO)) {
                SchedGrouped<4, 1> S{(const char*)(ws + WS_B0), 0, nullptr, (const char*)(ws + WS_WT_SBO), 0, G, bx};
                EpiResidBf<false> E{(const void*)(ws + WS_B4), (bf16*)(ws + WS_B4)};
                pg8::gemm_phase<EpiResidBf<false>, SchedGrouped<4, 1>, true, false, C>(lds, S, E, wave);
            }
            SEAM(PH_SBO);
        }
    }
    if (IN(PH_FINAL)) { IDS(); combine_rows(ws, 1, gw, NGW, lane); }
#undef IN
#undef SEAM
}

extern "C" void kernel_launch(void* const* d_in, const int* in_sizes, int n_in, void* d_out, int out_size, void* d_ws, size_t ws_size, hipStream_t stream) {
    static int grid = 0;
    if (grid == 0) {
        if (n_in != 31 || in_sizes[0] != M * C || out_size != M * C || ws_size < WS_END) { fprintf(stderr, "kernel_launch: unexpected shapes (n_in %d, in0 %d, out %d, ws %zu); nothing launched\n", n_in, n_in > 0 ? in_sizes[0] : -1, out_size, ws_size); grid = -1; return; }
        int dev = 0, cus = 0, per_cu = 0;
        if (hipGetDevice(&dev) != hipSuccess || hipDeviceGetAttribute(&cus, hipDeviceAttributeMultiprocessorCount, dev) != hipSuccess) { grid = -1; return; }
        if (hipFuncSetAttribute((const void*)yoco_fwd, hipFuncAttributeMaxDynamicSharedMemorySize, LDS_BYTES) != hipSuccess) { fprintf(stderr, "kernel_launch: hipFuncSetAttribute failed\n"); grid = -1; return; }
        if (hipOccupancyMaxActiveBlocksPerMultiprocessor(&per_cu, (const void*)yoco_fwd, NWAVES * 64, LDS_BYTES) != hipSuccess || per_cu < 1) fprintf(stderr, "kernel_launch: occupancy query reports %d\n", per_cu);
        (void)hipGetLastError();
        grid = cus - (cus % 16);
    }
    if (grid < 0) return;
    if (hipMemsetAsync((char*)d_ws + WS_CTL, 0, CTL_ZERO_BYTES, stream) != hipSuccess) return;
    Args a{};
    for (int i = 0; i < 31; ++i) a.in[i] = (const float*)d_in[i];
    a.out = (float*)d_out; a.ws = (unsigned char*)d_ws;
    for (int li = 0; li < (N_LAUNCHES == 1 ? 1 : (int)NPHASE); ++li) {
        a.ph_lo = (N_LAUNCHES == 1) ? 0 : li; a.ph_hi = (N_LAUNCHES == 1) ? NPHASE : li + 1; a.li = li;
        hipLaunchKernelGGL(yoco_fwd, dim3(grid), dim3(NWAVES * 64), LDS_BYTES, stream, a);
        const hipError_t le = hipPeekAtLastError();
        if (le != hipSuccess) { fprintf(stderr, "kernel_launch: launch %d failed: %s\n", li, hipGetErrorName(le)); break; }
    }
}
```

```cpp
#include <hip/hip_runtime.h>
#include <cstdio>
#include <cstdint>

#ifndef MK_N_LAUNCHES
#define MK_N_LAUNCHES 1
#endif

namespace pg8 {
#define PG8_LAS __attribute__((address_space(3)))
typedef unsigned short bf16_t;
typedef short bf16x8 __attribute__((ext_vector_type(8)));
typedef float f32x4 __attribute__((ext_vector_type(4)));
typedef unsigned u32x4 __attribute__((ext_vector_type(4)));
constexpr int BM = 256, BK = 64, HALF = 128, HTB = HALF * BK * 2, STAGE_BYTES = 8 * HTB, NXCD = 8, WGM = 8;

__host__ __device__ __forceinline__ int lds_byte(int r, int c) { const int st = (r >> 4) * 2 + (c >> 5), rr = r & 15, cc = c & 31, ob = rr * 64 + cc * 2; return st * 1024 + (ob ^ (((ob >> 9) & 1) << 5)); }
__host__ __device__ __forceinline__ void stage_rc(int b, int& R, int& C) { const int st = b / 1024, sb = b % 1024, swz = sb ^ (((sb >> 9) & 1) << 5); R = (st >> 1) * 16 + swz / 64; C = (st & 1) * 32 + (swz % 64) / 2; }
__host__ __device__ __forceinline__ int perm32(int rho) { const int n = rho >> 4, i = rho & 15; return 8 * (i >> 2) + 4 * n + (i & 3); }

struct Unit { int pm, pn, aux, r0, cnt; };

__host__ __device__ __forceinline__ void tile_map(int wgid, int nM, int nN, int& pm, int& pn) {
    const int nwg = nM * nN;
    { const int q = nwg / NXCD, r = nwg % NXCD, xcd = wgid % NXCD, off = wgid / NXCD; wgid = (xcd < r ? xcd * (q + 1) : r * (q + 1) + (xcd - r) * q) + off; }
    const int nig = WGM * nN, gid = wgid / nig, fm = gid * WGM, gsz = (nM - fm) < WGM ? (nM - fm) : WGM;
    pm = fm + ((wgid % nig) % gsz); pn = (wgid % nig) / gsz;
}

typedef float f32x2_t __attribute__((ext_vector_type(2))); typedef __bf16 bf16x2_t __attribute__((ext_vector_type(2)));
__device__ __forceinline__ unsigned cvt_pk_bf16(float lo, float hi) { const f32x2_t v = {lo, hi}; const bf16x2_t b = __builtin_convertvector(v, bf16x2_t); return __builtin_bit_cast(unsigned, b); }

template <class Epi, class Sched, bool ALIGN_EPI, bool GATHER, int K>
__device__ __forceinline__ void gemm_phase(PG8_LAS unsigned char* lds, const Sched& S, const Epi& E, const int wid) {
    int lane_; asm volatile("v_mbcnt_lo_u32_b32 %0, -1, 0\n\tv_mbcnt_hi_u32_b32 %0, -1, %0" : "=v"(lane_));
    const int lane = lane_, tid = wid * 64 + lane, wr = wid >> 2, wc = wid & 3, fr = lane & 15, fq = lane >> 4;
    constexpr int nt = K / BK;
    unsigned voffA[2], voffB[2];
#pragma unroll
    for (int i = 0; i < 2; ++i) { int R, C; stage_rc(tid * 16 + i * 8192, R, C); const int Rb = Epi::PERM ? ((R & ~31) + perm32(R & 31)) : R;
        voffA[i] = (unsigned)(R * K + C) * 2u; voffB[i] = (unsigned)(Rb * K + C) * 2u; }
    constexpr size_t kstep = (size_t)(BK * 2);
    constexpr size_t hstep = (size_t)HALF * K * 2;
    const unsigned ldsw = (unsigned)wid * 1024u;
    const int aoff = lds_byte(wr * 64 + fr, fq * 8), boff = lds_byte(wc * 32 + fr, fq * 8);
#define PG8_SA(b, h) (((b) * 2 + (h)) * HTB)
#define PG8_SB(b, h) ((4 + (b) * 2 + (h)) * HTB)
#define PG8_STAGE(bufoff, gbase, voff) do { _Pragma("unroll") for (int _i = 0; _i < 2; ++_i) \
        __builtin_amdgcn_global_load_lds((const unsigned*)((const char*)(gbase) + (voff)[_i]), (PG8_LAS unsigned*)(lds + (bufoff) + ldsw + _i * 8192), 16, 0, 0); } while (0)
#define PG8_LDA(dst, b, h) do { _Pragma("unroll") for (int m = 0; m < 4; ++m) _Pragma("unroll") for (int k = 0; k < 2; ++k) dst[m][k] = *(const PG8_LAS bf16x8*)(lds + PG8_SA(b, h) + aoff + m * 2048 + k * 1024); } while (0)
#define PG8_LDB(dst, b, h) do { _Pragma("unroll") for (int n = 0; n < 2; ++n) _Pragma("unroll") for (int k = 0; k < 2; ++k) dst[n][k] = *(const PG8_LAS bf16x8*)(lds + PG8_SB(b, h) + boff + n * 2048 + k * 1024); } while (0)
#define PG8_MMA(ai, bj, At, Bt) do { __builtin_amdgcn_s_setprio(1); _Pragma("unroll") for (int m = 0; m < 4; ++m) _Pragma("unroll") for (int n = 0; n < 2; ++n) _Pragma("unroll") for (int k = 0; k < 2; ++k) \
        acc[ai][bj][m][n] = __builtin_amdgcn_mfma_f32_16x16x32_bf16(Bt[n][k], At[m][k], acc[ai][bj][m][n], 0, 0, 0); __builtin_amdgcn_s_setprio(0); } while (0)
#define PG8_WAIT_V(n) asm volatile("s_waitcnt vmcnt(" #n ")" ::: "memory")
#define PG8_WAIT_L(n) asm volatile("s_waitcnt lgkmcnt(" #n ")" ::: "memory")
#define PG8_BAR __builtin_amdgcn_s_barrier()
#define PG8_SCHED __builtin_amdgcn_sched_barrier(0)
    Unit cur, nxt; int ui = 0;
    if (!S.next(0, cur)) return;
    f32x4 acc[2][2][4][2];
#pragma unroll
    for (int a = 0; a < 2; ++a)
#pragma unroll
        for (int b = 0; b < 2; ++b)
#pragma unroll
            for (int m = 0; m < 4; ++m)
#pragma unroll
                for (int n = 0; n < 2; ++n) acc[a][b][m][n] = (f32x4){0.f, 0.f, 0.f, 0.f};
    bf16x8 At[4][2], B0[2][2], B1[2][2];
    unsigned vc[2][2];
#define PG8_GOFF(u) do { _Pragma("unroll") for (int _h = 0; _h < 2; ++_h) _Pragma("unroll") for (int _i = 0; _i < 2; ++_i) { int _R, _C; stage_rc(tid * 16 + _i * 8192, _R, _C); \
        vc[_h][_i] = S.a_row_off(u, _h * HALF + _R) + (unsigned)_C * 2u; } } while (0)
#define PG8_STAGE_A(bufoff, gbase, h) do { if constexpr (GATHER) { PG8_STAGE(bufoff, gbase, vc[h]); } else { PG8_STAGE(bufoff, (gbase) + (h) * hstep, voffA); } } while (0)
    if constexpr (GATHER) PG8_GOFF(cur);
    const char* cA = S.a_base(cur); const char* cB = S.b_base(cur);
    PG8_STAGE(PG8_SB(0, 0), cB, voffB); PG8_STAGE(PG8_SB(0, 1), cB + hstep, voffB); PG8_STAGE_A(PG8_SA(0, 0), cA, 0); PG8_STAGE_A(PG8_SA(0, 1), cA, 1);
    if (wr == 1) PG8_BAR;
    PG8_WAIT_V(2); PG8_BAR;
    PG8_STAGE(PG8_SB(1, 0), cB + kstep, voffB); PG8_STAGE_A(PG8_SA(1, 0), cA + kstep, 0); PG8_STAGE(PG8_SB(1, 1), cB + hstep + kstep, voffB);
    PG8_WAIT_V(6); PG8_BAR;
    for (;;) {
        const bool has_next = S.next(ui + 1, nxt);
        const char* nA = has_next ? S.a_base(nxt) : cA; const char* nB = has_next ? S.b_base(nxt) : cB;
        for (int t = 0; t < nt; t += 2) {
            const bool last = (t == nt - 2);
            const char* a1 = cA + (size_t)(t + 1) * kstep;
            const char* a2 = last ? nA : cA + (size_t)(t + 2) * kstep; const char* b2 = last ? nB : cB + (size_t)(t + 2) * kstep;
            const char* a3 = a2 + kstep; const char* b3 = b2 + kstep;
            PG8_LDB(B0, 0, 0); PG8_LDB(B1, 0, 1); PG8_SCHED; PG8_LDA(At, 0, 0); PG8_STAGE_A(PG8_SA(1, 1), a1, 1);
            if constexpr (GATHER) { if (last && has_next) PG8_GOFF(nxt); }
            PG8_WAIT_V(8); PG8_WAIT_L(0); PG8_BAR; PG8_MMA(0, 0, At, B0); PG8_MMA(0, 1, At, B1); PG8_BAR; PG8_SCHED;
            PG8_LDA(At, 0, 1); PG8_STAGE(PG8_SB(0, 0), b2, voffB); PG8_STAGE(PG8_SB(0, 1), b2 + hstep, voffB); PG8_STAGE_A(PG8_SA(0, 0), a2, 0);
            PG8_WAIT_V(8); PG8_WAIT_L(0); PG8_BAR; PG8_MMA(1, 0, At, B0); PG8_MMA(1, 1, At, B1); PG8_BAR; PG8_SCHED;
            PG8_LDB(B0, 1, 0); PG8_LDB(B1, 1, 1); PG8_SCHED; PG8_LDA(At, 1, 0); PG8_STAGE_A(PG8_SA(0, 1), a2, 1);
            PG8_WAIT_V(8); PG8_WAIT_L(0); PG8_BAR; PG8_MMA(0, 0, At, B0); PG8_MMA(0, 1, At, B1); PG8_BAR; PG8_SCHED;
            PG8_LDA(At, 1, 1); PG8_STAGE(PG8_SB(1, 0), b3, voffB); PG8_STAGE(PG8_SB(1, 1), b3 + hstep, voffB); PG8_STAGE_A(PG8_SA(1, 0), a3, 0);
            PG8_WAIT_V(8); PG8_WAIT_L(0); PG8_BAR; PG8_MMA(1, 0, At, B0); PG8_MMA(1, 1, At, B1); PG8_BAR; PG8_SCHED;
        }
        if constexpr (ALIGN_EPI) { if (wr == 0) PG8_BAR; }
        E(acc, cur, wr, wc, fr, fq);
        if (!has_next) break;
#pragma unroll
        for (int a = 0; a < 2; ++a)
#pragma unroll
            for (int b = 0; b < 2; ++b)
#pragma unroll
                for (int m = 0; m < 4; ++m)
#pragma unroll
                    for (int n = 0; n < 2; ++n) acc[a][b][m][n] = (f32x4){0.f, 0.f, 0.f, 0.f};
        cur = nxt; cA = nA; cB = nB; ++ui;
        if constexpr (ALIGN_EPI) { if (wr == 1) PG8_BAR; }
    }
    PG8_WAIT_V(0);
    if constexpr (!ALIGN_EPI) { if (wr == 0) PG8_BAR; }
    PG8_BAR;
#undef PG8_SA
#undef PG8_SB
#undef PG8_STAGE
#undef PG8_STAGE_A
#undef PG8_GOFF
#undef PG8_LDA
#undef PG8_LDB
#undef PG8_MMA
#undef PG8_WAIT_V
#undef PG8_WAIT_L
#undef PG8_BAR
#undef PG8_SCHED
}
}

constexpr int NWAVES = 8;
#ifndef MK_DEBUG
#define MK_DEBUG 0
#endif
#ifndef DBG_USE_NAIVE
#define DBG_USE_NAIVE 0
#endif
constexpr int DBGP = MK_DEBUG ? 3 : 0;
enum Phase { PH_P0 = 0, PH_LORA, PH_RKV, PH_S1, PH_S2, PH_S3, PH_DBG0, PH_WOUT = PH_DBG0 + DBGP, PH_ROUT0, PH_GU0, PH_DN0, PH_COMB, PH_KVQ, PH_ATTN, PH_SBO, PH_ROUT1, PH_GU1, PH_DN1, PH_FINAL, NPHASE };
constexpr int N_LAUNCHES = MK_N_LAUNCHES;


constexpr int BATCH = 2, SEQ = 8192, C = 1024, NH = 16, HD = 64, M = BATCH * SEQ;
constexpr int NE = 16, FE = 256, DW = 64, DA = 64, DG = 160;
constexpr float RMS_EPS = 1e-6f, GN_EPS = 64e-5f;
constexpr float SB_EXIT = 104.0f;

constexpr size_t MiB = 1u << 20;
constexpr size_t WS_CTL = 0, CTL_ZERO_BYTES = 64 * 1024;
constexpr size_t WS_WT_W2 = 128 * 1024, WS_WT_A2 = 256 * 1024, WS_WT_G2 = 384 * 1024;
constexpr size_t WS_WT_RKV = 1 * MiB;
constexpr size_t WS_WT_LORA = 7 * MiB;
constexpr size_t WS_WT_OUT = 9 * MiB;
constexpr size_t WS_WT_KVQ = 11 * MiB;
constexpr size_t WS_WT_SBO = 17 * MiB;
constexpr size_t WS_WT_GU = 19 * MiB;
constexpr size_t WS_WT_DN = 51 * MiB;
constexpr size_t WS_LW = 67 * MiB;
constexpr size_t WS_LA = 69 * MiB;
constexpr size_t WS_LG = 71 * MiB;
static_assert(WS_LA == WS_LW + 2 * MiB && WS_LG == WS_LW + 4 * MiB, "EpiLora's pointer arithmetic");
constexpr size_t WS_LIST = 76 * MiB;
constexpr size_t WS_WL = 77 * MiB;
constexpr size_t WS_HID = 78 * MiB;
constexpr size_t WS_B0 = 96 * MiB, WS_B1 = 128 * MiB, WS_B2 = 160 * MiB, WS_B3 = 192 * MiB, WS_B4 = 224 * MiB, WS_END = 256 * MiB;
static_assert(WS_HID + (size_t)144 * 256 * 256 * 2 <= WS_B0, "HID vs B0");
constexpr int CW_TMO = 0;
constexpr int CW_CNT = 1024;
constexpr int CW_BAR = 4096;

constexpr int RING_BYTES = 131072;
constexpr int LDSCTL_OFF = 146688, MISC_OFF = LDSCTL_OFF + 320, MOE_TAB_OFF = MISC_OFF + 128;
constexpr int LDS_BYTES = 147456;
static_assert(MOE_TAB_OFF + 256 <= LDS_BYTES, "LDS map");
static_assert(BATCH * NH * (SEQ / 64) % 16 == 0, "scan units");

#define GAS __attribute__((address_space(1)))
#define LAS __attribute__((address_space(3)))
typedef unsigned short bf16;
typedef unsigned v4u __attribute__((ext_vector_type(4)));
typedef unsigned v2u __attribute__((ext_vector_type(2)));
typedef float f32x4 __attribute__((ext_vector_type(4)));
typedef GAS unsigned gu32;
#define RLX_AGENT __ATOMIC_RELAXED, __HIP_MEMORY_SCOPE_AGENT
#define LDS_WAIT() asm volatile("s_waitcnt lgkmcnt(0)" ::: "memory")
#define VM_WAIT() asm volatile("s_waitcnt vmcnt(0)" ::: "memory")
__device__ __forceinline__ unsigned f2bf(float f) { unsigned u = __builtin_bit_cast(unsigned, f); return (u + 0x7fffu + ((u >> 16) & 1u)) >> 16; }
__device__ __forceinline__ unsigned pk2(float lo, float hi) { return f2bf(lo) | (f2bf(hi) << 16); }
__device__ __forceinline__ float bflo(unsigned u) { return __uint_as_float(u << 16); }
__device__ __forceinline__ float bfhi(unsigned u) { return __uint_as_float(u & 0xffff0000u); }
__device__ __forceinline__ float bf2f(bf16 b) { return __uint_as_float((unsigned)b << 16); }
__device__ __forceinline__ float sigmoidf_(float x) { return 1.0f / (1.0f + __expf(-x)); }

#define XB_TMO      128
#define XB_XCNT(j)  (256  + 64 * (j))
#define XB_XSUB(j)  (1280 + 64 * (j))
#define XB_XGEN(j)  (2304 + 64 * (j))
#define XB_TOP      3328
#define XB_TOPGEN   3392
#define XCD_BAR_WORDS 3456
#define XB_SPIN_CAP (1u << 18)
__device__ __forceinline__ unsigned xb_ld(unsigned* p)              { return __hip_atomic_load(p, __ATOMIC_RELAXED, __HIP_MEMORY_SCOPE_AGENT); }
__device__ __forceinline__ unsigned xb_add(unsigned* p, unsigned v) { return __hip_atomic_fetch_add(p, v, __ATOMIC_RELAXED, __HIP_MEMORY_SCOPE_AGENT); }
__device__ __forceinline__ unsigned xb_xcc_id() { return (unsigned)__builtin_amdgcn_s_getreg((3 << 11) | 20) & 0xFu; }
#define XB_SPIN(cond, bar) do { unsigned _sp = 0; while (cond) { __builtin_amdgcn_s_sleep(1); \
    if ((++_sp & 255u) == 0u) { if (xb_ld(&(bar)[XB_TMO])) break; if (_sp > XB_SPIN_CAP) { atomicAdd(&(bar)[XB_TMO], 1u); break; } } } } while (0)
struct XcdBarrier { unsigned* bar; unsigned x; volatile LAS unsigned* st; };
__device__ __forceinline__ XcdBarrier xcd_barrier_post(unsigned* bar, volatile LAS unsigned* st) {
    XcdBarrier b; b.bar = bar; b.x = xb_xcc_id(); b.st = st;
    if (threadIdx.x == 0) (void)xb_add(&bar[XB_XCNT(b.x)], 1u);
    return b;
}
__device__ __forceinline__ void xcd_barrier_complete(unsigned* bar, unsigned x, unsigned& nloc, unsigned& nx) {
    const unsigned G = gridDim.x * gridDim.y * gridDim.z;
    unsigned sum, cnt, mine, sp = 0u;
    for (;;) {
        sum = 0u; cnt = 0u; mine = 0u;
#pragma unroll
        for (unsigned j = 0; j < 16; ++j) { const unsigned c = xb_ld(&bar[XB_XCNT(j)]); sum += c; cnt += (c > 0u) ? 1u : 0u; mine = (j == x) ? c : mine; }
        if (sum == G) break;
        __builtin_amdgcn_s_sleep(1);
        if ((++sp & 255u) == 0u) { if (xb_ld(&bar[XB_TMO])) break; if (sp > XB_SPIN_CAP) { atomicAdd(&bar[XB_TMO], 1u); break; } }
    }
    nloc = mine > 0u ? mine : 1u; nx = cnt > 0u ? cnt : 1u;
}
__device__ __forceinline__ void xcd_barrier(const XcdBarrier& b) {
    asm volatile("s_waitcnt vmcnt(0)" ::: "memory");
    __syncthreads();
    if (threadIdx.x == 0) {
        unsigned* bar = b.bar;
        __builtin_amdgcn_s_waitcnt(0);
        unsigned nloc = b.st[0], nx = b.st[1];
        if (nloc == 0u) { xcd_barrier_complete(bar, b.x, nloc, nx); b.st[0] = nloc; b.st[1] = nx; }
        const unsigned old = xb_add(&bar[XB_XSUB(b.x)], 1u);
        const unsigned gen = old / nloc;
        if (old + 1u == (gen + 1u) * nloc) {
            __builtin_amdgcn_fence(__ATOMIC_RELEASE, "agent");
            asm volatile("s_waitcnt vmcnt(0)" ::: "memory");
            const unsigned og = xb_add(&bar[XB_TOP], 1u);
            const unsigned tg = og / nx;
            if (og + 1u == (tg + 1u) * nx) xb_add(&bar[XB_TOPGEN], 1u);
            else XB_SPIN(xb_ld(&bar[XB_TOPGEN]) == tg, bar);
            __builtin_amdgcn_fence(__ATOMIC_ACQUIRE, "agent");
            xb_add(&bar[XB_XGEN(b.x)], 1u);
            asm volatile("s_waitcnt vmcnt(0)" ::: "memory");
        } else {
            XB_SPIN(xb_ld(&bar[XB_XGEN(b.x)]) == gen, bar);
            __builtin_amdgcn_fence(__ATOMIC_ACQUIRE, "agent");
            asm volatile("s_waitcnt vmcnt(0)" ::: "memory");
        }
    }
    __syncthreads();
}

__device__ __forceinline__ float shx(float v, int o, int lane) { return __int_as_float(__builtin_amdgcn_ds_bpermute((lane ^ o) << 2, __float_as_int(v))); }
#define DPP_ADD(v, ctrl) ((v) + __int_as_float(__builtin_amdgcn_update_dpp(0, __float_as_int(v), (ctrl), 0xf, 0xf, true)))
__device__ __forceinline__ float wave_sum(float v, int lane) {
    (void)lane;
    v = DPP_ADD(v, 0x128); v = DPP_ADD(v, 0x124); v = DPP_ADD(v, 0x122); v = DPP_ADD(v, 0x121);
    const int iv = __float_as_int(v);
    return (__int_as_float(__builtin_amdgcn_readlane(iv, 0)) + __int_as_float(__builtin_amdgcn_readlane(iv, 16))) + (__int_as_float(__builtin_amdgcn_readlane(iv, 32)) + __int_as_float(__builtin_amdgcn_readlane(iv, 48)));
}
__device__ __forceinline__ float sum8(float v) { v = DPP_ADD(v, 0xB1); v = DPP_ADD(v, 0x4E); v = DPP_ADD(v, 0x141); return v; }
__device__ __forceinline__ void transpose_item(const float* W, int ldw, int k0, int n0, bf16* WT, int ldk, int dst_row0, const float* kscale, LAS float* scr, int lane, int kmax = 1 << 30) {
    const int r8 = lane >> 3, quad = lane & 7;
    f32x4 v[8];
#pragma unroll
    for (int i = 0; i < 8; ++i) { const int kk = r8 + 8 * i; v[i] = (k0 + kk < kmax) ? *(const GAS f32x4*)(W + (size_t)(k0 + kk) * ldw + n0 + quad * 4) : (f32x4){0.f, 0.f, 0.f, 0.f}; }
#pragma unroll
    for (int i = 0; i < 8; ++i) { const int kk = r8 + 8 * i; if (kscale) v[i] = v[i] * kscale[(k0 + kk < kmax) ? k0 + kk : 0]; *(LAS f32x4*)(scr + kk * 36 + ((quad ^ i) << 2)) = v[i]; }
    LDS_WAIT(); asm volatile("" ::: "memory");
    const int c = lane & 7;
#pragma unroll
    for (int j = 0; j < 4; ++j) { const int n = (lane >> 3) + 8 * j; const LAS float* sp = scr + (8 * c) * 36 + ((((n >> 2) ^ c) << 2) | (n & 3));
        v4u o; o.x = pk2(sp[0 * 36], sp[1 * 36]); o.y = pk2(sp[2 * 36], sp[3 * 36]); o.z = pk2(sp[4 * 36], sp[5 * 36]); o.w = pk2(sp[6 * 36], sp[7 * 36]);
        if (k0 + 8 * c < kmax) *(GAS v4u*)(WT + (size_t)(dst_row0 + n) * ldk + k0 + 8 * c) = o; }
    LDS_WAIT(); asm volatile("" ::: "memory");
}

struct Args { const float* in[31]; float* out; unsigned char* ws; int ph_lo, ph_hi, li, pad; };
typedef const __attribute__((address_space(4))) unsigned char* kaptr_t;
__device__ __forceinline__ kaptr_t ka_base() { kaptr_t p = (kaptr_t)__builtin_amdgcn_kernarg_segment_ptr(); asm volatile("" : "+s"(p)); return p; }
#define INP(k) (*(const float* const __attribute__((address_space(4)))*)(ka_base() + 8 * (k)))
#define OUTP() (*(float* const __attribute__((address_space(4)))*)(ka_base() + 8 * 31))
#define WSP() (*(unsigned char* const __attribute__((address_space(4)))*)(ka_base() + 8 * 32))
#define KA_INT(i) (*(const int __attribute__((address_space(4)))*)(ka_base() + 8 * 33 + 4 * (i)))

template <int PART> __device__ __forceinline__ void p0_weights(unsigned char* ws, LAS unsigned char* lds, int gw, int NGW, int wave, int lane) {
    LAS float* scr = (LAS float*)(lds + wave * 16384);
    bf16* WT_RKV = (bf16*)(ws + WS_WT_RKV); bf16* WT_LORA = (bf16*)(ws + WS_WT_LORA); bf16* WT_OUT = (bf16*)(ws + WS_WT_OUT); bf16* WT_KVQ = (bf16*)(ws + WS_WT_KVQ);
    bf16* WT_SBO = (bf16*)(ws + WS_WT_SBO); bf16* WT_GU = (bf16*)(ws + WS_WT_GU); bf16* WT_DN = (bf16*)(ws + WS_WT_DN);
    constexpr int I_UP = 32 + 32 + 96, I_RKV = 3 * 512, I_LORA = 32 + 32 + 80, I_OUT = 512, I_KV = 1024, I_Q = 512, I_SBO = 512, I_G = 32 * 128, I_U = 32 * 128, I_D = 32 * 128;
    constexpr int NDENSE = I_UP + I_RKV + I_LORA + I_OUT + I_KV + I_Q + I_SBO, NITEMS = NDENSE + I_G + I_U + I_D;
    constexpr int NLOOP = PART == 0 ? NDENSE : 3 * 2048; (void)NITEMS;
    for (int q_ = gw; q_ < NLOOP; q_ += NGW) {
        const int it = PART == 0 ? q_ : NDENSE + (q_ / 2048) * 4096 + 2048 * (PART - 1) + (q_ % 2048);
        int r = it;
        if (r < I_UP) {
            if (r < 32) transpose_item(INP(9), C, 0, 32 * r, (bf16*)(ws + WS_WT_W2), 64, 32 * r, nullptr, scr, lane);
            else if (r < 64) transpose_item(INP(12), C, 0, 32 * (r - 32), (bf16*)(ws + WS_WT_A2), 64, 32 * (r - 32), nullptr, scr, lane);
            else { const int q = r - 64, kb = q / 32, nb = q % 32; transpose_item(INP(14), C, 64 * kb, 32 * nb, (bf16*)(ws + WS_WT_G2), DG, 32 * nb, nullptr, scr, lane, DG); }
            continue; } r -= I_UP;
        if (r < I_RKV) { const int m = r / 512, q = r % 512, kb = q / 32, nb = q % 32; transpose_item(INP(6) + (size_t)m * C * C, C, 64 * kb, 32 * nb, WT_RKV, C, m * C + 32 * nb, nullptr, scr, lane); continue; } r -= I_RKV;
        if (r < I_LORA) {
            if (r < 32) { const int kb = r / 2, nb = r % 2; transpose_item(INP(8), DW, 64 * kb, 32 * nb, WT_LORA, C, 32 * nb, nullptr, scr, lane); }
            else if (r < 64) { const int q = r - 32, kb = q / 2, nb = q % 2; transpose_item(INP(11), DA, 64 * kb, 32 * nb, WT_LORA, C, 256 + 32 * nb, nullptr, scr, lane); }
            else { const int q = r - 64, kb = q / 5, nb = q % 5; transpose_item(INP(13), DG, 64 * kb, 32 * nb, WT_LORA, C, 512 + 32 * nb, nullptr, scr, lane); }
            continue; } r -= I_LORA;
        if (r < I_OUT) { const int kb = r / 32, nb = r % 32; transpose_item(INP(20), C, 64 * kb, 32 * nb, WT_OUT, C, 32 * nb, nullptr, scr, lane); continue; } r -= I_OUT;
        if (r < I_KV) { const int kb = r / 64, nb = r % 64; transpose_item(INP(21), 2 * C, 64 * kb, 32 * nb, WT_KVQ, C, 32 * nb, INP(3), scr, lane); continue; } r -= I_KV;
        if (r < I_Q) { const int kb = r / 32, nb = r % 32; transpose_item(INP(22), C, 64 * kb, 32 * nb, WT_KVQ, C, 2 * C + 32 * nb, INP(1) + C, scr, lane); continue; } r -= I_Q;
        if (r < I_SBO) { const int kb = r / 32, nb = r % 32; transpose_item(INP(23), C, 64 * kb, 32 * nb, WT_SBO, C, 32 * nb, nullptr, scr, lane); continue; } r -= I_SBO;
        if (r < I_G) { const int le = r / 128, q = r % 128, kb = q / 8, nb = q % 8, f0 = 32 * nb; transpose_item(INP(28) + (size_t)le * C * FE, FE, 64 * kb, f0, WT_GU + (size_t)le * 512 * C, C, 256 * (f0 / 128) + (f0 % 128), INP(2) + (le >> 4) * C, scr, lane); continue; } r -= I_G;
        if (r < I_U) { const int le = r / 128, q = r % 128, kb = q / 8, nb = q % 8, f0 = 32 * nb; transpose_item(INP(29) + (size_t)le * C * FE, FE, 64 * kb, f0, WT_GU + (size_t)le * 512 * C, C, 256 * (f0 / 128) + 128 + (f0 % 128), INP(2) + (le >> 4) * C, scr, lane); continue; } r -= I_U;
        { const int le = r / 128, q = r % 128, kb = q / 32, nb = q % 32; transpose_item(INP(30) + (size_t)le * FE * C, C, 64 * kb, 32 * nb, WT_DN + (size_t)le * C * FE, FE, 32 * nb, nullptr, scr, lane); }
    }
    if (PART == 0) for (int it = gw * 64 + lane; it < 768 * 128; it += NGW * 64) { const int row = it >> 7, ch = it & 127;
        const bool valid = (row < 64) || (row >= 256 && row < 320) || (row >= 512 && row < 672);
        if (!valid) *(GAS v4u*)(WT_LORA + (size_t)row * C + ch * 8) = (v4u){0u, 0u, 0u, 0u}; }
}
__device__ __forceinline__ void load_row(const float* p, int lane, f32x4 (&v)[4]) {
#pragma unroll
    for (int j = 0; j < 4; ++j) v[j] = ((const GAS f32x4*)p)[64 * j + lane];
}
__device__ __forceinline__ void load_row_bf(const bf16* p, int lane, f32x4 (&v)[4]) {
#pragma unroll
    for (int j = 0; j < 4; ++j) { const v2u w = ((const GAS v2u*)p)[64 * j + lane]; v[j] = (f32x4){bflo(w.x), bfhi(w.x), bflo(w.y), bfhi(w.y)}; }
}
__device__ __forceinline__ float row_rs(const f32x4 (&v)[4], int lane) {
    float s = 0.f;
#pragma unroll
    for (int j = 0; j < 4; ++j) s += (v[j].x * v[j].x + v[j].y * v[j].y) + (v[j].z * v[j].z + v[j].w * v[j].w);
    return 1.0f / sqrtf(wave_sum(s, lane) * (1.0f / C) + RMS_EPS);
}
__device__ __forceinline__ void store_row_bf16(bf16* p, int lane, const f32x4 (&v)[4]) {
#pragma unroll
    for (int j = 0; j < 4; ++j) { v2u o; o.x = pk2(v[j].x, v[j].y); o.y = pk2(v[j].z, v[j].w); ((GAS v2u*)p)[64 * j + lane] = o; }
}
__device__ __forceinline__ void p0_rows(unsigned char* ws, int gw, int NGW, int lane) {
    const float* x = INP(0); const float* gain = INP(1); const float* mix = INP(5);
    f32x4 g[4]; load_row(gain, lane, g);
    f32x4 mx[6][4];
#pragma unroll
    for (int i = 0; i < 6; ++i) load_row(mix + i * C, lane, mx[i]);
    for (int run = gw; run < M / 8; run += NGW) {
        const int r0 = run * 8;
        f32x4 prev[4], nx[4];
        load_row(x + (size_t)r0 * C, lane, nx);
        if ((r0 % SEQ) == 0) {
#pragma unroll
            for (int j = 0; j < 4; ++j) prev[j] = (f32x4){0.f, 0.f, 0.f, 0.f};
        } else { load_row(x + (size_t)(r0 - 1) * C, lane, prev); const float rs = row_rs(prev, lane);
#pragma unroll
            for (int j = 0; j < 4; ++j) prev[j] = prev[j] * rs * g[j]; }
#pragma unroll 1
        for (int rr = 0; rr < 8; ++rr) {
            const int row = r0 + rr;
            f32x4 hn[4];
#pragma unroll
            for (int j = 0; j < 4; ++j) hn[j] = nx[j];
            if (rr < 7) load_row(x + (size_t)(row + 1) * C, lane, nx);
            const float rs = row_rs(hn, lane);
#pragma unroll
            for (int j = 0; j < 4; ++j) hn[j] = hn[j] * rs * g[j];
#pragma unroll
            for (int i = 0; i < 6; ++i) { f32x4 o[4];
#pragma unroll
                for (int j = 0; j < 4; ++j) o[j] = hn[j] + (prev[j] - hn[j]) * mx[i][j];
                bf16* dst = i < 2 ? (bf16*)OUTP() + (size_t)i * M * C : (i == 2 ? (bf16*)(ws + WS_B4) : (bf16*)(ws + WS_B1) + (size_t)(i - 3) * M * C);
                store_row_bf16(dst + (size_t)row * C, lane, o); }
#pragma unroll
            for (int j = 0; j < 4; ++j) prev[j] = hn[j];
        }
    }
}

template <int NN, int NGROUPS> struct SchedGrouped {
    static constexpr int K = C;
    const char* A0; size_t astride; const char* A2; const char* B; size_t bgroup;
    int G, c;
    __device__ __forceinline__ bool next(int i, pg8::Unit& u) const {
        const int L = i * G + c; constexpr int per = 64 * NN; if (L >= per * NGROUPS) return false;
        const int g = L / per, w = L % per; pg8::tile_map(w, 64, NN, u.pm, u.pn); u.aux = g; u.r0 = 0; u.cnt = 0; return true; }
    __device__ __forceinline__ const char* a_base(const pg8::Unit& u) const { const char* A = (A2 != nullptr && u.aux == 2) ? A2 : A0 + (size_t)u.aux * astride; return A + (size_t)u.pm * 256 * K * 2; }
    __device__ __forceinline__ const char* b_base(const pg8::Unit& u) const { return B + (size_t)u.aux * bgroup + (size_t)u.pn * 256 * K * 2; }
    __device__ __forceinline__ unsigned a_row_off(const pg8::Unit&, int) const { return 0u; }
};
template <int NN, int K, bool GATHER> struct SchedMoe {
    const char* A; const char* B; size_t bexp; const unsigned* list; volatile LAS int* tab; int G, c;
    __device__ __forceinline__ bool next(int i, pg8::Unit& u) const {
        const int L = i * G + c; const int tot = __builtin_amdgcn_readfirstlane(tab[48]) * NN; if (L >= tot) return false;
        u.pm = L / NN; u.pn = L % NN; int e = 0;
#pragma unroll
        for (int j = 0; j < 16; ++j) e += (u.pm >= tab[32 + j]) ? 1 : 0;
        e = __builtin_amdgcn_readfirstlane(e);
        u.aux = e; u.r0 = (u.pm - __builtin_amdgcn_readfirstlane(tab[16 + e])) * 256; u.cnt = __builtin_amdgcn_readfirstlane(tab[e]); return true; }
    __device__ __forceinline__ const char* a_base(const pg8::Unit& u) const { return GATHER ? A : A + (size_t)u.pm * 256 * K * 2; }
    __device__ __forceinline__ const char* b_base(const pg8::Unit& u) const { return B + (size_t)u.aux * bexp + (size_t)u.pn * 256 * K * 2; }
    __device__ __forceinline__ unsigned a_row_off(const pg8::Unit& u, int r) const {
        const int idx = u.r0 + r; unsigned tok = 0u;
        if (idx < u.cnt) tok = list[(size_t)u.aux * M + idx] >> 1;
        return tok * (unsigned)(K * 2); }
};

using pg8::f32x4;
using pg8::Unit;
__device__ __forceinline__ v4u pack8(f32x4 v0, f32x4 v1) { v4u w; w.x = pg8::cvt_pk_bf16(v0[0], v0[1]); w.y = pg8::cvt_pk_bf16(v0[2], v0[3]); w.z = pg8::cvt_pk_bf16(v1[0], v1[1]); w.w = pg8::cvt_pk_bf16(v1[2], v1[3]); return w; }

struct EpiLora {
    static constexpr bool PERM = true;
    bf16* LW;
    __device__ __forceinline__ void operator()(const f32x4 (&acc)[2][2][4][2], const Unit& u, int wr, int wc, int fr, int fq) const {
        { int l_; asm volatile("v_mbcnt_lo_u32_b32 %0, -1, 0\n\tv_mbcnt_hi_u32_b32 %0, -1, %0" : "=v"(l_)); fr = l_ & 15; fq = l_ >> 4; }
        const int g = u.aux, width = g == 2 ? DG : DW; bf16* out = LW + (size_t)g * (1u << 20);
        const int row0 = u.pm * 256 + wr * 64 + fr;
#pragma unroll
        for (int bj = 0; bj < 2; ++bj) { const int col0 = bj * 128 + wc * 32 + 8 * fq; if (col0 < width) {
#pragma unroll
            for (int ai = 0; ai < 2; ++ai)
#pragma unroll
                for (int m = 0; m < 4; ++m) { f32x4 v0 = acc[ai][bj][m][0], v1 = acc[ai][bj][m][1];
                    if (g == 0) {
#pragma unroll
                        for (int q = 0; q < 4; ++q) { v0[q] = tanhf(v0[q]); v1[q] = tanhf(v1[q]); } }
                    else if (g == 2) {
#pragma unroll
                        for (int q = 0; q < 4; ++q) { v0[q] = sigmoidf_(v0[q]); v1[q] = sigmoidf_(v1[q]); } }
                    *(GAS v4u*)(out + (size_t)(row0 + ai * 128 + m * 16) * width + col0) = pack8(v0, v1); } } }
    }
};
struct EpiSplit3 {
    static constexpr bool PERM = true;
    bf16* O0; bool bycol; const float* rowscale;
    __device__ __forceinline__ void operator()(const f32x4 (&acc)[2][2][4][2], const Unit& u, int wr, int wc, int fr, int fq) const {
        { int l_; asm volatile("v_mbcnt_lo_u32_b32 %0, -1, 0\n\tv_mbcnt_hi_u32_b32 %0, -1, %0" : "=v"(l_)); fr = l_ & 15; fq = l_ >> 4; }
        const int g = bycol ? (u.pn >> 2) : u.aux, pn = bycol ? (u.pn & 3) : u.pn; bf16* out = O0 + (size_t)g * ((size_t)M * C);
        const int row0 = u.pm * 256 + wr * 64 + fr, col0 = pn * 256 + wc * 32 + 8 * fq;
#pragma unroll
        for (int ai = 0; ai < 2; ++ai)
#pragma unroll
            for (int m = 0; m < 4; ++m)
                { const float sc = rowscale ? rowscale[row0 + ai * 128 + m * 16] : 1.0f;
#pragma unroll
                for (int bj = 0; bj < 2; ++bj) *(GAS v4u*)(out + (size_t)(row0 + ai * 128 + m * 16) * C + col0 + bj * 128) = pack8(acc[ai][bj][m][0] * sc, acc[ai][bj][m][1] * sc); }
    }
};
template <bool BASE_F32> struct EpiResidBf {
    static constexpr bool PERM = true;
    const void* base; bf16* out;
    __device__ __forceinline__ void operator()(const f32x4 (&acc)[2][2][4][2], const Unit& u, int wr, int wc, int fr, int fq) const {
        { int l_; asm volatile("v_mbcnt_lo_u32_b32 %0, -1, 0\n\tv_mbcnt_hi_u32_b32 %0, -1, %0" : "=v"(l_)); fr = l_ & 15; fq = l_ >> 4; }
        const int row0 = u.pm * 256 + wr * 64 + fr, col0 = u.pn * 256 + wc * 32 + 8 * fq;
#pragma unroll
        for (int ai = 0; ai < 2; ++ai)
#pragma unroll
            for (int m = 0; m < 4; ++m) { const size_t off = (size_t)(row0 + ai * 128 + m * 16) * C + col0;
#pragma unroll
                for (int bj = 0; bj < 2; ++bj) { f32x4 b0, b1;
                    if (BASE_F32) { b0 = *(const GAS f32x4*)((const float*)base + off + bj * 128); b1 = *(const GAS f32x4*)((const float*)base + off + bj * 128 + 4); }
                    else { const v4u w = *(const GAS v4u*)((const bf16*)base + off + bj * 128); b0 = (f32x4){bflo(w.x), bfhi(w.x), bflo(w.y), bfhi(w.y)}; b1 = (f32x4){bflo(w.z), bfhi(w.z), bflo(w.w), bfhi(w.w)}; }
                    *(GAS v4u*)(out + off + bj * 128) = pack8(b0 + acc[ai][bj][m][0], b1 + acc[ai][bj][m][1]); }
                asm volatile("" ::: "memory"); }
    }
};
struct EpiGU {
    static constexpr bool PERM = true;
    bf16* HID; const float* wl; const float* rsl;
    __device__ __forceinline__ void operator()(const f32x4 (&acc)[2][2][4][2], const Unit& u, int wr, int wc, int fr, int fq) const {
        { int l_; asm volatile("v_mbcnt_lo_u32_b32 %0, -1, 0\n\tv_mbcnt_hi_u32_b32 %0, -1, %0" : "=v"(l_)); fr = l_ & 15; fq = l_ >> 4; }
        const int e = u.aux, cnt = u.cnt, base = u.r0, r0 = wr * 64 + fr, col0 = u.pn * 128 + wc * 32 + 8 * fq;
#pragma unroll
        for (int ai = 0; ai < 2; ++ai)
#pragma unroll
            for (int m = 0; m < 4; ++m) { const int r = r0 + ai * 128 + m * 16, idx = base + r; float w = 0.f, rs = 0.f; if (idx < cnt) { w = wl[(size_t)e * M + idx]; rs = rsl[(size_t)e * M + idx]; }
                f32x4 h0, h1;
#pragma unroll
                for (int q = 0; q < 4; ++q) { const float g0 = acc[ai][0][m][0][q] * rs, g1 = acc[ai][0][m][1][q] * rs;
                    h0[q] = g0 * sigmoidf_(g0) * (acc[ai][1][m][0][q] * rs) * w; h1[q] = g1 * sigmoidf_(g1) * (acc[ai][1][m][1][q] * rs) * w; }
                *(GAS v4u*)(HID + (size_t)(u.pm * 256 + r) * FE + col0) = pack8(h0, h1);
                asm volatile("" ::: "memory"); }
    }
};
struct EpiDown {
    static constexpr bool PERM = true;
    bf16* EO; const unsigned* list;
    __device__ __forceinline__ void operator()(const f32x4 (&acc)[2][2][4][2], const Unit& u, int wr, int wc, int fr, int fq) const {
        { int l_; asm volatile("v_mbcnt_lo_u32_b32 %0, -1, 0\n\tv_mbcnt_hi_u32_b32 %0, -1, %0" : "=v"(l_)); fr = l_ & 15; fq = l_ >> 4; }
        const int e = u.aux, cnt = u.cnt, base = u.r0, r0 = wr * 64 + fr, col0 = u.pn * 256 + wc * 32 + 8 * fq;
#pragma unroll
        for (int ai = 0; ai < 2; ++ai)
#pragma unroll
            for (int m = 0; m < 4; ++m) { const int idx = base + r0 + ai * 128 + m * 16;
                if (idx < cnt) { const unsigned ent = list[(size_t)e * M + idx]; bf16* o = EO + ((size_t)(ent & 1u) * M + (ent >> 1)) * C + col0;
#pragma unroll
                    for (int bj = 0; bj < 2; ++bj) *(GAS v4u*)(o + bj * 128) = pack8(acc[ai][bj][m][0], acc[ai][bj][m][1]); }
                asm volatile("" ::: "memory"); }
    }
};

typedef short bf16x8s __attribute__((ext_vector_type(8)));
typedef short bf16x4s __attribute__((ext_vector_type(4)));
typedef short v4i16_t __attribute__((ext_vector_type(4)));
constexpr int TPB = 144;
constexpr int TILE_B = 64 * TPB;
constexpr int FP = 68;
constexpr int CS_FA = 0, CS_FB = 16384, CS_TILES = 32768, CS_TOT = CS_TILES + 12 * TILE_B, CS_WL = CS_TOT + 2048, CS_PAR = CS_WL + 256;
static_assert(CS_PAR + 768 <= LDSCTL_OFF, "scan LDS map");
#define TILE(n) (lds + CS_TILES + (n) * TILE_B)
#define F4Z (f32x4){0.f, 0.f, 0.f, 0.f}
__device__ __forceinline__ bf16x8s ldfrag(const LAS unsigned char* tile, int row, int kcol) { return *(const LAS bf16x8s*)(tile + row * TPB + kcol * 2); }
__device__ __forceinline__ bf16x8s ldfrag_tr(const LAS unsigned char* tile, int n0, int k0, int lane) {
    const int g = lane >> 4, q = (lane & 15) >> 2, p = lane & 3;
    const LAS unsigned char* a = tile + (k0 + 8 * g + q) * TPB + (n0 + 4 * p) * 2;
    const v4i16_t lo = __builtin_amdgcn_ds_read_tr16_b64_v4i16((LAS v4i16_t*)a), hi = __builtin_amdgcn_ds_read_tr16_b64_v4i16((LAS v4i16_t*)(a + 4 * TPB));
    return (bf16x8s){lo[0], lo[1], lo[2], lo[3], hi[0], hi[1], hi[2], hi[3]};
}
__device__ __forceinline__ bf16x8s ldfrag_perm(const LAS unsigned char* tile, int row, int ks, int g) {
    const bf16x4s lo = *(const LAS bf16x4s*)(tile + row * TPB + (32 * ks + 4 * g) * 2), hi = *(const LAS bf16x4s*)(tile + row * TPB + (32 * ks + 16 + 4 * g) * 2);
    return (bf16x8s){lo[0], lo[1], lo[2], lo[3], hi[0], hi[1], hi[2], hi[3]};
}
__device__ __forceinline__ void lds_barrier() { asm volatile("s_waitcnt lgkmcnt(0)" ::: "memory"); __builtin_amdgcn_s_barrier(); asm volatile("" ::: "memory"); }
#define MFMA16(a, b, c) __builtin_amdgcn_mfma_f32_16x16x32_bf16((a), (b), (c), 0, 0, 0)
__device__ __forceinline__ void mm64(f32x4 (&acc)[2], const LAS unsigned char* At, const LAS unsigned char* Bt, int rt, int ch, int fr, int g) {
#pragma unroll
    for (int ks = 0; ks < 2; ++ks) { const bf16x8s a = ldfrag(At, 16 * rt + fr, 32 * ks + 8 * g);
#pragma unroll
        for (int ct = 0; ct < 2; ++ct) acc[ct] = MFMA16(a, ldfrag(Bt, 32 * ch + 16 * ct + fr, 32 * ks + 8 * g), acc[ct]); }
}
__device__ __forceinline__ void mm64_bt(f32x4 (&acc)[2], const LAS unsigned char* At, const LAS unsigned char* X, int rt, int ch, int fr, int g, int lane) {
#pragma unroll
    for (int ks = 0; ks < 2; ++ks) { const bf16x8s a = ldfrag(At, 16 * rt + fr, 32 * ks + 8 * g);
#pragma unroll
        for (int ct = 0; ct < 2; ++ct) acc[ct] = MFMA16(a, ldfrag_tr(X, 32 * ch + 16 * ct, 32 * ks, lane), acc[ct]); }
}
__device__ __forceinline__ void mm64_at(f32x4 (&acc)[2], const LAS unsigned char* Xa, const LAS unsigned char* Bt, int rt, int ch, int fr, int g, int lane) {
#pragma unroll
    for (int ks = 0; ks < 2; ++ks) { const bf16x8s a = ldfrag_tr(Xa, 16 * rt, 32 * ks, lane);
#pragma unroll
        for (int ct = 0; ct < 2; ++ct) acc[ct] = MFMA16(a, ldfrag(Bt, 32 * ch + 16 * ct + fr, 32 * ks + 8 * g), acc[ct]); }
}
__device__ __forceinline__ void mm64_att(f32x4 (&acc)[2], const LAS unsigned char* Xa, const LAS unsigned char* X, int rt, int ch, int lane) {
#pragma unroll
    for (int ks = 0; ks < 2; ++ks) { const bf16x8s a = ldfrag_tr(Xa, 16 * rt, 32 * ks, lane);
#pragma unroll
        for (int ct = 0; ct < 2; ++ct) acc[ct] = MFMA16(a, ldfrag_tr(X, 32 * ch + 16 * ct, 32 * ks, lane), acc[ct]); }
}
__device__ __forceinline__ bf16x4s pack4(f32x4 v) { v2u w; w.x = pg8::cvt_pk_bf16(v[0], v[1]); w.y = pg8::cvt_pk_bf16(v[2], v[3]); return __builtin_bit_cast(bf16x4s, w); }
__device__ __forceinline__ f32x4 unpack4(bf16x4s s) { const v2u w = __builtin_bit_cast(v2u, s); return (f32x4){bflo(w.x), bfhi(w.x), bflo(w.y), bfhi(w.y)}; }
__device__ __forceinline__ void st_tr(LAS unsigned char* Out, const f32x4 (&acc)[2], int rt, int ch, int fr, int g) {
#pragma unroll
    for (int ct = 0; ct < 2; ++ct) *(LAS bf16x4s*)(Out + (32 * ch + 16 * ct + fr) * TPB + (16 * rt + 4 * g) * 2) = pack4(acc[ct]);
}
__device__ __forceinline__ void ld_tr(f32x4 (&acc)[2], const LAS unsigned char* In, int rt, int ch, int fr, int g) {
#pragma unroll
    for (int ct = 0; ct < 2; ++ct) acc[ct] = unpack4(*(const LAS bf16x4s*)(In + (32 * ch + 16 * ct + fr) * TPB + (16 * rt + 4 * g) * 2));
}
__device__ __forceinline__ void unpack8(v4u w, float (&o)[8]) { o[0] = bflo(w.x); o[1] = bfhi(w.x); o[2] = bflo(w.y); o[3] = bfhi(w.y); o[4] = bflo(w.z); o[5] = bfhi(w.z); o[6] = bflo(w.w); o[7] = bfhi(w.w); }
__device__ __forceinline__ v4u pack8f(const float (&o)[8]) { v4u w; w.x = pg8::cvt_pk_bf16(o[0], o[1]); w.y = pg8::cvt_pk_bf16(o[2], o[3]); w.z = pg8::cvt_pk_bf16(o[4], o[5]); w.w = pg8::cvt_pk_bf16(o[6], o[7]); return w; }

struct FrontIn { v4u r, k, v; bf16x8s fw[2], fa[2]; };
__device__ __forceinline__ void front_fetch(FrontIn& f, unsigned char* ws, int unit, int tid, int lane, int wave) {
    const int h = unit & 15, c = (unit >> 4) & 127, b = unit >> 11; const size_t row0 = (size_t)b * SEQ + c * 64;
    const int rt = wave & 3, fr = lane & 15, g = lane >> 4, t = tid >> 3, cq = tid & 7, c0 = h * HD + cq * 8;
    const bf16* Rb = (const bf16*)(ws + WS_B1); const bf16* Kb = (const bf16*)(ws + WS_B2); const bf16* Vb = (const bf16*)(ws + WS_B3);
    const bf16* LW = (const bf16*)(ws + WS_LW); const bf16* LA = (const bf16*)(ws + WS_LA);
    f.r = *(const GAS v4u*)(Rb + (row0 + t) * C + c0); f.k = *(const GAS v4u*)(Kb + (row0 + t) * C + c0); f.v = *(const GAS v4u*)(Vb + (row0 + t) * C + c0);
#pragma unroll
    for (int ks = 0; ks < 2; ++ks) { f.fw[ks] = *(const GAS bf16x8s*)(LW + (row0 + 16 * rt + fr) * DW + 32 * ks + 8 * g); f.fa[ks] = *(const GAS bf16x8s*)(LA + (row0 + 16 * rt + fr) * DA + 32 * ks + 8 * g); }
}
__device__ __forceinline__ v4u head_consts(unsigned char* ws, LAS unsigned char* lds, int h, int tid, int wtile, int atile) {
    const bf16* W2T = (const bf16*)(ws + WS_WT_W2); const bf16* A2T = (const bf16*)(ws + WS_WT_A2);
    const int row = tid >> 3, cq = tid & 7;
    const v4u w2chunk = *(const GAS v4u*)(W2T + (size_t)(h * HD + row) * 64 + cq * 8);
    *(LAS v4u*)(lds + CS_TILES + wtile * TILE_B + row * TPB + cq * 16) = w2chunk;
    *(LAS v4u*)(lds + CS_TILES + atile * TILE_B + row * TPB + cq * 16) = *(const GAS v4u*)(A2T + (size_t)(h * HD + row) * 64 + cq * 8);
    if (tid < 64) { LAS float* P = (LAS float*)(lds + CS_PAR); P[tid] = INP(15)[h * HD + tid]; P[64 + tid] = INP(16)[h * HD + tid]; P[128 + tid] = INP(17)[h * HD + tid]; }
    __syncthreads();
    return w2chunk;
}
template <int MODE>
__device__ __forceinline__ void chunk_front(const FrontIn& f, LAS unsigned char* lds, const float (&w0v)[2], const float (&a0v)[2], const bf16x8s (&w2f)[2][2], const bf16x8s (&a2f)[2][2], int tid, int lane, int wave, float (&v8)[8], float& rkb) {
    const int rt = wave & 3, ch = wave >> 2, fr = lane & 15, g = lane >> 4;
    LAS float* FA = (LAS float*)(lds + CS_FA); LAS float* FB = (LAS float*)(lds + CS_FB); LAS float* TOT = (LAS float*)(lds + CS_TOT);
    const int t = tid >> 3, cq = tid & 7;
    {
        f32x4 aw[2] = {F4Z, F4Z}, aa[2] = {F4Z, F4Z};
#pragma unroll
        for (int ks = 0; ks < 2; ++ks)
#pragma unroll
            for (int ct = 0; ct < 2; ++ct) { aw[ct] = MFMA16(f.fw[ks], w2f[ks][ct], aw[ct]); aa[ct] = MFMA16(f.fa[ks], a2f[ks][ct], aa[ct]); }
#pragma unroll
        for (int ct = 0; ct < 2; ++ct) { const int j = 32 * ch + 16 * ct + fr, js = j ^ ((g & 1) << 4); const float w0 = w0v[ct], a0 = a0v[ct];
            float p[4];
#pragma unroll
            for (int q = 0; q < 4; ++q) { p[q] = -0.6065306597126334f * sigmoidf_(w0 + aw[ct][q]); if (q) p[q] += p[q - 1]; }
            const float s_ = p[3];
            const float u1 = __int_as_float(__builtin_amdgcn_ds_bpermute(((lane - 16) & 63) << 2, __float_as_int(s_))); const float t1 = s_ + (g >= 1 ? u1 : 0.f);
            const float u2 = __int_as_float(__builtin_amdgcn_ds_bpermute(((lane - 32) & 63) << 2, __float_as_int(t1))); const float t2 = t1 + (g >= 2 ? u2 : 0.f);
            const float ex = t2 - s_;
#pragma unroll
            for (int q = 0; q < 4; ++q) { const int tt = 16 * rt + 4 * g + q; FA[tt * 64 + js] = p[q] + ex; FB[tt * 64 + js] = sigmoidf_(a0 + aa[ct][q]); }
            if (g == 3) TOT[rt * 64 + j] = t2; }
    }
    lds_barrier();
    {
        float r[8], k[8], pkk[8], pka[8], prk[8];
        unpack8(f.r, r); unpack8(f.k, k); unpack8(f.v, v8);
        { const LAS float* P = (const LAS float*)(lds + CS_PAR) + cq * 8; const f32x4 a0_ = *(const LAS f32x4*)P, a1_ = *(const LAS f32x4*)(P + 4), b0_ = *(const LAS f32x4*)(P + 64), b1_ = *(const LAS f32x4*)(P + 68), c0_ = *(const LAS f32x4*)(P + 128), c1_ = *(const LAS f32x4*)(P + 132);
#pragma unroll
          for (int q = 0; q < 4; ++q) { pkk[q] = a0_[q]; pkk[4 + q] = a1_[q]; pka[q] = b0_[q]; pka[4 + q] = b1_[q]; prk[q] = c0_[q]; prk[4 + q] = c1_[q]; } }
        float cw[8], cwp[8], ag[8];
        { const int tp = t > 0 ? t - 1 : 0, rtt = wave >> 1;
          const int ct_ = (cq ^ (((t >> 2) & 1) << 1)) * 8, cp_ = (cq ^ (((tp >> 2) & 1) << 1)) * 8;
          const f32x4 c0_ = *(const LAS f32x4*)(FA + t * 64 + ct_), c1_ = *(const LAS f32x4*)(FA + t * 64 + ct_ + 4), p0_ = *(const LAS f32x4*)(FA + tp * 64 + cp_), p1_ = *(const LAS f32x4*)(FA + tp * 64 + cp_ + 4);
          const f32x4 g0_ = *(const LAS f32x4*)(FB + t * 64 + ct_), g1_ = *(const LAS f32x4*)(FB + t * 64 + ct_ + 4);
          f32x4 o0_ = F4Z, o1_ = F4Z, l0_ = F4Z, l1_ = F4Z;
          for (int r_ = 0; r_ < rtt; ++r_) { l0_ = *(const LAS f32x4*)(TOT + r_ * 64 + cq * 8); l1_ = *(const LAS f32x4*)(TOT + r_ * 64 + cq * 8 + 4); o0_ = o0_ + l0_; o1_ = o1_ + l1_; }
          const bool first = (t & 15) == 0;
#pragma unroll
          for (int q = 0; q < 4; ++q) { cw[q] = c0_[q] + o0_[q]; cw[4 + q] = c1_[q] + o1_[q];
              cwp[q] = t > 0 ? p0_[q] + o0_[q] - (first ? l0_[q] : 0.f) : 0.f; cwp[4 + q] = t > 0 ? p1_[q] + o1_[q] - (first ? l1_[q] : 0.f) : 0.f; ag[q] = g0_[q]; ag[4 + q] = g1_[q]; } }
        float kk[8], ss = 0.f; rkb = 0.f;
#pragma unroll
        for (int q = 0; q < 8; ++q) { kk[q] = k[q] * pkk[q]; ss += kk[q] * kk[q]; }
        ss = sum8(ss);
        const float inv = 1.0f / fmaxf(sqrtf(ss), 1e-12f);
        float at[8], bt[8], kt[8], rt_[8];
#pragma unroll
        for (int q = 0; q < 8; ++q) { const float kn = kk[q] * inv, kp = k[q] * (1.0f + (ag[q] - 1.0f) * pka[q]);
            const float ein = __expf(-cw[q]);
            at[q] = -kn * __expf(cwp[q]); bt[q] = kn * ag[q] * ein; kt[q] = kp * ein;
            rt_[q] = r[q] * __expf(cw[q]); rkb += r[q] * kp * prk[q]; }
        rkb = sum8(rkb);
        *(LAS v4u*)(TILE(0) + t * TPB + cq * 16) = pack8f(at); *(LAS v4u*)(TILE(1) + t * TPB + cq * 16) = pack8f(bt); *(LAS v4u*)(TILE(2) + t * TPB + cq * 16) = pack8f(kt);
        *(LAS v4u*)(TILE(3) + t * TPB + cq * 16) = f.v;
        *(LAS v4u*)(TILE(6) + t * TPB + cq * 16) = pack8f(rt_);
        if (MODE == 1 && t == 63) {
#pragma unroll
            for (int q = 0; q < 8; ++q) ((LAS float*)(lds + CS_WL))[cq * 8 + q] = __expf(cw[q]); }
    }
    lds_barrier();
}

__device__ __forceinline__ void scan_s1(unsigned char* ws, LAS unsigned char* lds, int lane0, int wave) {
    const int rt = wave & 3, ch = wave >> 2;
    FrontIn fin; float w0v[2], a0v[2]; bf16x8s w2f[2][2], a2f[2][2];
    { int l0 = lane0; asm volatile("" : "+v"(l0)); const int hh = blockIdx.x & 15;
      if ((int)blockIdx.x < BATCH * NH * (SEQ / 64)) front_fetch(fin, ws, blockIdx.x, wave * 64 + l0, l0, wave);
      const bf16* W2T = (const bf16*)(ws + WS_WT_W2); const bf16* A2T = (const bf16*)(ws + WS_WT_A2);
#pragma unroll
      for (int ct = 0; ct < 2; ++ct) { w0v[ct] = INP(7)[hh * HD + 32 * ch + 16 * ct + (l0 & 15)]; a0v[ct] = INP(10)[hh * HD + 32 * ch + 16 * ct + (l0 & 15)];
#pragma unroll
          for (int ks = 0; ks < 2; ++ks) { const size_t wr_ = (size_t)(hh * HD + 32 * ch + 16 * ct + (l0 & 15)) * 64 + 32 * ks + 8 * (l0 >> 4); w2f[ks][ct] = *(const GAS bf16x8s*)(W2T + wr_); a2f[ks][ct] = *(const GAS bf16x8s*)(A2T + wr_); } }
      const int tid0 = wave * 64 + l0;
      if (tid0 < 64) { LAS float* P = (LAS float*)(lds + CS_PAR); P[tid0] = INP(15)[hh * HD + tid0]; P[64 + tid0] = INP(16)[hh * HD + tid0]; P[128 + tid0] = INP(17)[hh * HD + tid0]; }
      __syncthreads(); }
    for (int unit = blockIdx.x; unit < BATCH * NH * (SEQ / 64); unit += gridDim.x) {
        int lane = lane0; asm volatile("" : "+v"(lane));
        const int tid = wave * 64 + lane, fr = lane & 15, g = lane >> 4;
        const int h = unit & 15, c = (unit >> 4) & 127, b = unit >> 11; const size_t chunk = ((size_t)b * NH + h) * 128 + c;
        float v8[8]; float rkb;
        chunk_front<1>(fin, lds, w0v, a0v, w2f, a2f, tid, lane, wave, v8, rkb);
        { const size_t row0_ = (size_t)b * SEQ + c * 64; if ((tid & 7) == 0) ((float*)(ws + WS_HID))[(row0_ + (tid >> 3)) * NH + h] = rkb; }
        if (unit + (int)gridDim.x < BATCH * NH * (SEQ / 64)) front_fetch(fin, ws, unit + gridDim.x, tid, lane, wave);
        {
            f32x4 a2[2] = {F4Z, F4Z}, a3[2] = {F4Z, F4Z};
            mm64(a2, TILE(1), TILE(0), rt, ch, fr, g);
            mm64(a3, TILE(2), TILE(0), rt, ch, fr, g);
            f32x4 p1[2];
#pragma unroll
            for (int ct = 0; ct < 2; ++ct) { const int col = 32 * ch + 16 * ct + fr;
#pragma unroll
                for (int q = 0; q < 4; ++q) { const int row = 16 * rt + 4 * g + q;
                    a2[ct][q] = row < col ? a2[ct][q] : 0.f;
                    p1[ct][q] = a2[ct][q] + (row == col ? 1.0f : 0.f);
                    a3[ct][q] = row < col ? a3[ct][q] : 0.f; } }
            st_tr(TILE(5), a2, rt, ch, fr, g);
            st_tr(TILE(9), p1, rt, ch, fr, g);
            st_tr(TILE(4), a3, rt, ch, fr, g);
        }
        lds_barrier();
#pragma unroll
        for (int r = 0; r < 6; ++r) {
            LAS unsigned char* Sr = TILE(5 + 2 * (r & 1)); LAS unsigned char* Sr2 = TILE(5 + 2 * ((r & 1) ^ 1));
            if (r <= 4) { f32x4 q2[2] = {F4Z, F4Z};
                mm64_at(q2, Sr, Sr, rt, ch, fr, g, lane);
                st_tr(Sr2, q2, rt, ch, fr, g); }
            if (r >= 1) { LAS unsigned char* Pr = TILE(9 + ((r - 1) & 1)); LAS unsigned char* Pr2 = TILE(9 + (((r - 1) & 1) ^ 1));
                f32x4 pa[2]; ld_tr(pa, Pr, rt, ch, fr, g);
                mm64_at(pa, Sr, Pr, rt, ch, fr, g, lane);
                st_tr(Pr2, pa, rt, ch, fr, g); }
            if (r == 0) { f32x4 gg[2] = {F4Z, F4Z};
                mm64_bt(gg, TILE(4), TILE(3), rt, ch, fr, g, lane);
                st_tr(TILE(11), gg, rt, ch, fr, g); }
            lds_barrier();
        }
        {
            f32x4 acc[2] = {F4Z, F4Z}, ac2[2] = {F4Z, F4Z};
            mm64_bt(acc, TILE(10), TILE(0), rt, ch, fr, g, lane);
            mm64(ac2, TILE(10), TILE(11), rt, ch, fr, g);
            st_tr(TILE(5), acc, rt, ch, fr, g); st_tr(TILE(7), ac2, rt, ch, fr, g);
            f32x4 b2[2] = {F4Z, F4Z}, b3[2] = {F4Z, F4Z};
            mm64(b2, TILE(1), TILE(6), rt, ch, fr, g); mm64(b3, TILE(2), TILE(6), rt, ch, fr, g);
#pragma unroll
            for (int ct = 0; ct < 2; ++ct) { const int t = 32 * ch + 16 * ct + fr;
#pragma unroll
                for (int q = 0; q < 4; ++q) { const int s_ = 16 * rt + 4 * g + q; b2[ct][q] = s_ <= t ? b2[ct][q] : 0.f; b3[ct][q] = s_ <= t ? b3[ct][q] : 0.f; } }
            st_tr(TILE(4), b2, rt, ch, fr, g); st_tr(TILE(9), b3, rt, ch, fr, g);
        }
        lds_barrier();
        {
            const LAS float* WL = (const LAS float*)(lds + CS_WL);
            f32x4 acc[2] = {F4Z, F4Z};
            mm64_bt(acc, TILE(5), TILE(1), rt, ch, fr, g, lane);
            bf16* Mg = (bf16*)(ws + WS_B0) + chunk * 4096;
#pragma unroll
            for (int ct = 0; ct < 2; ++ct) { const int j1 = 32 * ch + 16 * ct + fr; const float wl = WL[j1];
#pragma unroll
                for (int q = 0; q < 4; ++q) { const int j2 = 16 * rt + 4 * g + q; acc[ct][q] = wl * (acc[ct][q] + (j2 == j1 ? 1.0f : 0.f)); }
                const int rtS = 2 * ch + ct, ksS = rt >> 1, half = rt & 1;
                *(GAS bf16x4s*)(Mg + (((rtS * 2 + ksS) * 64 + g * 16 + fr) * 8 + half * 4)) = pack4(acc[ct]); }
            f32x4 ad[2] = {F4Z, F4Z};
            mm64_at(ad, TILE(1), TILE(7), rt, ch, fr, g, lane);
            mm64_att(ad, TILE(2), TILE(3), rt, ch, lane);
            const f32x4 wl4 = *(const LAS f32x4*)(WL + 16 * rt + 4 * g);
            bf16* Dg = (bf16*)OUTP() + chunk * 4096;
#pragma unroll
            for (int ct = 0; ct < 2; ++ct) *(GAS bf16x4s*)(Dg + (((2 * ch + ct) * 4 + rt) * 64 + lane) * 4) = pack4(ad[ct] * wl4);
            const size_t row0_ = (size_t)b * SEQ + c * 64;
            f32x4 ar[2]; ld_tr(ar, TILE(6), rt, ch, fr, g);
            mm64(ar, TILE(5), TILE(4), rt, ch, fr, g);
            f32x4 ay[2] = {F4Z, F4Z};
            mm64(ay, TILE(7), TILE(4), rt, ch, fr, g); mm64_at(ay, TILE(3), TILE(9), rt, ch, fr, g, lane);
            bf16* Rg = (bf16*)(ws + WS_B1); bf16* Kg = (bf16*)(ws + WS_B2);
#pragma unroll
            for (int ct = 0; ct < 2; ++ct) { const size_t o_ = (row0_ + 32 * ch + 16 * ct + fr) * C + h * HD + 16 * rt + 4 * g; *(GAS bf16x4s*)(Rg + o_) = pack4(ar[ct]); *(GAS bf16x4s*)(Kg + o_) = pack4(ay[ct]); }
        }
        lds_barrier();
    }
}

constexpr int S2_PD = 6;
__device__ __forceinline__ void scan_s2(unsigned char* ws, LAS unsigned char* lds, int lane, int wave) {
    for (int bh = blockIdx.x; bh < BATCH * NH; bh += gridDim.x) {
        const unsigned char* Mg = (const unsigned char*)((const bf16*)(ws + WS_B0) + (size_t)bh * 128 * 4096); const unsigned char* Dg = (const unsigned char*)((const bf16*)OUTP() + (size_t)bh * 128 * 4096);
        bf16* Sg = (bf16*)OUTP() + (size_t)M * C + (size_t)bh * 128 * 4096;
        if (wave >= 4) {
            const int lw = wave - 4;
            const unsigned char* src = (lw < 2 ? Mg + lw * 4096 : Dg + (lw - 2) * 4096) + lane * 16;
            LAS unsigned char* dst = lds + lw * 4096 + lane * 16;
            v4u q[S2_PD][4];
#define S2_LOADQ(j, c) do { _Pragma("unroll") for (int i_ = 0; i_ < 4; ++i_) q[j][i_] = *(const GAS v4u*)(src + (size_t)(c) * 8192 + i_ * 1024); } while (0)
#define S2_STOREQ(j, slot) do { _Pragma("unroll") for (int i_ = 0; i_ < 4; ++i_) *(LAS v4u*)(dst + (slot) * 16384 + i_ * 1024) = q[j][i_]; } while (0)
#pragma unroll
            for (int j = 0; j < S2_PD; ++j) S2_LOADQ(j, j);
            S2_STOREQ(0, 0); S2_LOADQ(0, S2_PD);
            lds_barrier();
#pragma unroll 1
            for (int s0 = 0; s0 < 128; s0 += S2_PD) {
#pragma unroll
                for (int jj = 0; jj < S2_PD; ++jj) { const int step = s0 + jj;
                    if (step + 1 < 128) S2_STOREQ((jj + 1) % S2_PD, (step + 1) & 1);
                    if (step + 1 + S2_PD < 128) S2_LOADQ((jj + 1) % S2_PD, step + 1 + S2_PD);
                    lds_barrier(); }
            }
#undef S2_LOADQ
#undef S2_STOREQ
        } else {
            const int ct = wave;
            f32x4 acc[4];
#pragma unroll
            for (int r = 0; r < 4; ++r) acc[r] = F4Z;
            lds_barrier();
#pragma unroll 1
            for (int s0 = 0; s0 < 128; s0 += S2_PD) {
#pragma unroll
                for (int jj = 0; jj < S2_PD; ++jj) { const int step = s0 + jj;
                    if (step < 128) {
                        const LAS unsigned char* slot = lds + (step & 1) * 16384;
                        bf16x8s sf[2];
#pragma unroll
                        for (int ks = 0; ks < 2; ++ks) { const bf16x4s lo = pack4(acc[2 * ks]), hi = pack4(acc[2 * ks + 1]); sf[ks] = (bf16x8s){lo[0], lo[1], lo[2], lo[3], hi[0], hi[1], hi[2], hi[3]}; }
#pragma unroll
                        for (int ks = 0; ks < 2; ++ks) *(GAS bf16x8s*)(Sg + (size_t)step * 4096 + ((ct * 2 + ks) * 64 + lane) * 8) = sf[ks];
                        f32x4 na[4];
#pragma unroll
                        for (int r = 0; r < 4; ++r) na[r] = unpack4(*(const LAS bf16x4s*)(slot + 8192 + ((ct * 4 + r) * 64 + lane) * 8));
#pragma unroll
                        for (int ks = 0; ks < 2; ++ks)
#pragma unroll
                            for (int r = 0; r < 4; ++r) na[r] = MFMA16(*(const LAS bf16x8s*)(slot + ((r * 2 + ks) * 64 + lane) * 16), sf[ks], na[r]);
#pragma unroll
                        for (int r = 0; r < 4; ++r) acc[r] = na[r];
                    }
                    lds_barrier(); }
            }
        }
    }
}

constexpr int S3_RT = 32768, S3_YT = S3_RT + TILE_B, S3_LG = S3_YT + TILE_B, S3_LGP = 336;
struct S3In { v4u rr, yy, vv, lg[3]; bf16x8s sA[2]; float rkb; };
__device__ __forceinline__ void s3_fetch(S3In& f, unsigned char* ws, int unit, int tid, int lane, int wave) {
    const int h = unit & 15, c = (unit >> 4) & 127, b = unit >> 11; const size_t chunk = ((size_t)b * NH + h) * 128 + c, row0 = (size_t)b * SEQ + c * 64;
    const int rt = wave & 3, et = tid >> 3, ecq = tid & 7;
    const bf16* Rg = (const bf16*)(ws + WS_B1); const bf16* Kg = (const bf16*)(ws + WS_B2); const bf16* Vb = (const bf16*)(ws + WS_B3); const bf16* LG = (const bf16*)(ws + WS_LG);
    const bf16* Sg = (const bf16*)OUTP() + (size_t)M * C + chunk * 4096;
    const size_t o_ = (row0 + et) * C + h * HD + ecq * 8;
    f.rr = *(const GAS v4u*)(Rg + o_); f.yy = *(const GAS v4u*)(Kg + o_); f.vv = *(const GAS v4u*)(Vb + o_);
#pragma unroll
    for (int i = 0; i < 3; ++i) { const int chn = tid + 512 * i; if (chn < 64 * 20) f.lg[i] = *(const GAS v4u*)(LG + (row0 + chn / 20) * DG + (chn % 20) * 8); }
#pragma unroll
    for (int ks = 0; ks < 2; ++ks) f.sA[ks] = *(const GAS bf16x8s*)(Sg + ((rt * 2 + ks) * 64 + lane) * 8);
    f.rkb = ((const float*)(ws + WS_HID))[(row0 + et) * NH + h];
}
__device__ __forceinline__ void scan_s3(unsigned char* ws, LAS unsigned char* lds, int lane0, int wave) {
    const int rt = wave & 3, ch = wave >> 2;
    LAS float* Ys = (LAS float*)(lds + CS_FA);
    const bf16* G2T = (const bf16*)(ws + WS_WT_G2); bf16* YG = (bf16*)(ws + WS_B0);
    constexpr int NU = BATCH * NH * (SEQ / 64);
    S3In fin; bf16x8s gA[5]; f32x4 lnw0, lnw1, lnb0, lnb1;
    { int l0 = lane0; asm volatile("" : "+v"(l0)); const int hh = blockIdx.x & 15, t0_ = wave * 64 + l0;
      if ((int)blockIdx.x < NU) s3_fetch(fin, ws, blockIdx.x, t0_, l0, wave);
#pragma unroll
      for (int ks = 0; ks < 5; ++ks) gA[ks] = *(const GAS bf16x8s*)(G2T + (size_t)(hh * HD + 16 * rt + (l0 & 15)) * DG + 32 * ks + 8 * (l0 >> 4));
      const int ec0 = hh * HD + (t0_ & 7) * 8;
      lnw0 = *(const GAS f32x4*)(INP(18) + ec0); lnw1 = *(const GAS f32x4*)(INP(18) + ec0 + 4); lnb0 = *(const GAS f32x4*)(INP(19) + ec0); lnb1 = *(const GAS f32x4*)(INP(19) + ec0 + 4); }
    __syncthreads();
    for (int unit = blockIdx.x; unit < NU; unit += gridDim.x) {
        int lane = lane0; asm volatile("" : "+v"(lane));
        const int tid = wave * 64 + lane, fr = lane & 15, g = lane >> 4, et = tid >> 3, ecq = tid & 7;
        const int h = unit & 15, c = (unit >> 4) & 127, b = unit >> 11; const size_t row0 = (size_t)b * SEQ + c * 64;
        *(LAS v4u*)(lds + S3_RT + et * TPB + ecq * 16) = fin.rr; *(LAS v4u*)(lds + S3_YT + et * TPB + ecq * 16) = fin.yy;
#pragma unroll
        for (int i = 0; i < 3; ++i) { const int chn = tid + 512 * i; if (chn < 64 * 20) *(LAS v4u*)(lds + S3_LG + (chn / 20) * S3_LGP + (chn % 20) * 16) = fin.lg[i]; }
        float v8[8]; unpack8(fin.vv, v8); const float rkb = fin.rkb; const bf16x8s sA0 = fin.sA[0], sA1 = fin.sA[1];
        lds_barrier();
        if (unit + (int)gridDim.x < NU) s3_fetch(fin, ws, unit + gridDim.x, tid, lane, wave);
        f32x4 acc[2], ag[2] = {F4Z, F4Z};
#pragma unroll
        for (int ct = 0; ct < 2; ++ct) { const int t = 32 * ch + 16 * ct + fr;
            acc[ct] = unpack4(*(const LAS bf16x4s*)(lds + S3_YT + t * TPB + (16 * rt + 4 * g) * 2));
            acc[ct] = MFMA16(sA0, ldfrag_perm(lds + S3_RT, t, 0, g), acc[ct]); acc[ct] = MFMA16(sA1, ldfrag_perm(lds + S3_RT, t, 1, g), acc[ct]);
#pragma unroll
            for (int ks = 0; ks < 5; ++ks) ag[ct] = MFMA16(gA[ks], *(const LAS bf16x8s*)(lds + S3_LG + t * S3_LGP + (32 * ks + 8 * g) * 2), ag[ct]);
            *(LAS f32x4*)(Ys + t * FP + 16 * rt + 4 * g) = acc[ct]; }
        lds_barrier();
        {
            const f32x4 y0 = *(const LAS f32x4*)(Ys + et * FP + ecq * 8), y1 = *(const LAS f32x4*)(Ys + et * FP + ecq * 8 + 4);
            float y[8] = {y0[0], y0[1], y0[2], y0[3], y1[0], y1[1], y1[2], y1[3]};
            float s_ = 0.f;
#pragma unroll
            for (int q = 0; q < 8; ++q) s_ += y[q];
            s_ = sum8(s_);
            const float mu = s_ * (1.0f / HD); float vs = 0.f;
#pragma unroll
            for (int q = 0; q < 8; ++q) { y[q] -= mu; vs += y[q] * y[q]; }
            vs = sum8(vs);
            const float rstd = 1.0f / sqrtf(vs * (1.0f / HD) + GN_EPS);
            f32x4 o0, o1;
#pragma unroll
            for (int q = 0; q < 4; ++q) { o0[q] = y[q] * rstd * lnw0[q] + lnb0[q] + rkb * v8[q]; o1[q] = y[4 + q] * rstd * lnw1[q] + lnb1[q] + rkb * v8[4 + q]; }
            *(LAS f32x4*)(Ys + et * FP + ecq * 8) = o0; *(LAS f32x4*)(Ys + et * FP + ecq * 8 + 4) = o1;
        }
        lds_barrier();
#pragma unroll
        for (int ct = 0; ct < 2; ++ct) { const int t = 32 * ch + 16 * ct + fr; const f32x4 yv = *(const LAS f32x4*)(Ys + t * FP + 16 * rt + 4 * g);
            *(GAS bf16x4s*)(YG + (row0 + t) * C + h * HD + 16 * rt + 4 * g) = pack4(yv * ag[ct]); }
    }
    __syncthreads();
}
#undef TILE
#if MK_DEBUG
__device__ __forceinline__ void scan_naive(unsigned char* ws, LAS unsigned char* lds, int tid) {
    const int lane = tid & 63;
    const bf16* Rb = (const bf16*)(ws + WS_B1); const bf16* Kb = (const bf16*)(ws + WS_B2); const bf16* Vb = (const bf16*)(ws + WS_B3);
    const bf16* LW = (const bf16*)(ws + WS_LW); const bf16* LA = (const bf16*)(ws + WS_LA);
    float* Y = OUTP(); float* RK = (float*)(ws + WS_HID);
    LAS float* sR = (LAS float*)lds; LAS float* sK = sR + 4096; LAS float* sV = sK + 4096; LAS float* sA = sV + 4096; LAS float* sB = sA + 4096; LAS float* sD = sB + 4096;
    LAS float* sW2 = sD + 4096; LAS float* sA2 = sW2 + 4096;
    for (int unit = blockIdx.x; unit < BATCH * NH; unit += gridDim.x) {
        const int b = unit / NH, h = unit % NH;
        __syncthreads();
        for (int e = tid; e < 4096; e += 512) { const int d = e >> 6, j = e & 63; sW2[e] = INP(9)[(size_t)d * C + h * HD + j]; sA2[e] = INP(12)[(size_t)d * C + h * HD + j]; }
        __syncthreads();
        const int pt = tid >> 3, cq = tid & 7, c0 = h * HD + cq * 8;
        const int si = tid >> 3, jq = tid & 7;
        float S[8];
#pragma unroll
        for (int q = 0; q < 8; ++q) S[q] = 0.f;
        float w0v[8], a0v[8], kkv[8], kav[8], rkv[8];
#pragma unroll
        for (int q = 0; q < 8; ++q) { w0v[q] = INP(7)[c0 + q]; a0v[q] = INP(10)[c0 + q]; kkv[q] = INP(15)[c0 + q]; kav[q] = INP(16)[c0 + q]; rkv[q] = INP(17)[c0 + q]; }
        for (int blk = 0; blk < SEQ / 64; ++blk) {
            const size_t row = (size_t)b * SEQ + blk * 64 + pt;
            {
                const v4u r4 = *(const GAS v4u*)(Rb + row * C + c0), k4 = *(const GAS v4u*)(Kb + row * C + c0), v4 = *(const GAS v4u*)(Vb + row * C + c0);
                float r[8], k[8], v[8];
                r[0] = bflo(r4.x); r[1] = bfhi(r4.x); r[2] = bflo(r4.y); r[3] = bfhi(r4.y); r[4] = bflo(r4.z); r[5] = bfhi(r4.z); r[6] = bflo(r4.w); r[7] = bfhi(r4.w);
                k[0] = bflo(k4.x); k[1] = bfhi(k4.x); k[2] = bflo(k4.y); k[3] = bfhi(k4.y); k[4] = bflo(k4.z); k[5] = bfhi(k4.z); k[6] = bflo(k4.w); k[7] = bfhi(k4.w);
                v[0] = bflo(v4.x); v[1] = bfhi(v4.x); v[2] = bflo(v4.y); v[3] = bfhi(v4.y); v[4] = bflo(v4.z); v[5] = bfhi(v4.z); v[6] = bflo(v4.w); v[7] = bfhi(v4.w);
                float wp[8], ap[8];
#pragma unroll
                for (int q = 0; q < 8; ++q) { wp[q] = w0v[q]; ap[q] = a0v[q]; }
                for (int d = 0; d < 64; ++d) { const float lw = bf2f(LW[row * DW + d]), la = bf2f(LA[row * DA + d]);
#pragma unroll
                    for (int q = 0; q < 8; ++q) { wp[q] += lw * sW2[d * 64 + cq * 8 + q]; ap[q] += la * sA2[d * 64 + cq * 8 + q]; } }
                float kk[8], ss = 0.f, rks = 0.f;
#pragma unroll
                for (int q = 0; q < 8; ++q) { kk[q] = k[q] * kkv[q]; ss += kk[q] * kk[q]; }
                ss = sum8(ss);
                const float inv = 1.0f / fmaxf(sqrtf(ss), 1e-12f);
#pragma unroll
                for (int q = 0; q < 8; ++q) { const float ag = sigmoidf_(ap[q]); const float kn = kk[q] * inv; const float kp = k[q] * (1.0f + (ag - 1.0f) * kav[q]);
                    const float lw = -0.6065306597126334f * sigmoidf_(wp[q]);
                    const int o = pt * 64 + cq * 8 + q;
                    sR[o] = r[q]; sK[o] = kp; sV[o] = v[q]; sA[o] = -kn; sB[o] = kn * ag; sD[o] = __expf(lw); rks += r[q] * kp * rkv[q]; }
                rks = sum8(rks);
                if (cq == 0) RK[row * NH + h] = rks;
            }
            __syncthreads();
            for (int t = 0; t < 64; ++t) {
                const LAS f32x4* pa = (const LAS f32x4*)(sA + t * 64 + jq * 8); const LAS f32x4* pb = (const LAS f32x4*)(sB + t * 64 + jq * 8);
                const LAS f32x4* pd = (const LAS f32x4*)(sD + t * 64 + jq * 8); const LAS f32x4* pk = (const LAS f32x4*)(sK + t * 64 + jq * 8);
                const LAS f32x4* pr = (const LAS f32x4*)(sR + t * 64 + jq * 8);
                const f32x4 a0 = pa[0], a1 = pa[1], b0 = pb[0], b1 = pb[1], d0 = pd[0], d1 = pd[1], k0 = pk[0], k1 = pk[1], r0 = pr[0], r1 = pr[1];
                const float vi = sV[t * 64 + si];
                float sa = 0.f;
#pragma unroll
                for (int q = 0; q < 4; ++q) { sa += S[q] * a0[q]; sa += S[4 + q] * a1[q]; }
                sa = sum8(sa);
                float y = 0.f;
#pragma unroll
                for (int q = 0; q < 4; ++q) { S[q] = S[q] * d0[q] + sa * b0[q] + vi * k0[q]; S[4 + q] = S[4 + q] * d1[q] + sa * b1[q] + vi * k1[q]; y += S[q] * r0[q]; y += S[4 + q] * r1[q]; }
                y = sum8(y);
                if (jq == 0) Y[((size_t)b * SEQ + blk * 64 + t) * C + h * HD + si] = y;
            }
            __syncthreads();
        }
    }
}
__device__ __forceinline__ void post_scan(unsigned char* ws, int gw, int NGW, int lane) {
    const float* Y = OUTP(); const float* RK = (const float*)(ws + WS_HID); const bf16* Vb = (const bf16*)(ws + WS_B3); const bf16* LG = (const bf16*)(ws + WS_LG);
    bf16* YG = (bf16*)(ws + WS_B4); const float* g2 = INP(14); const float* lnw = INP(18); const float* lnb = INP(19);
    for (int it = gw; it < M * NH; it += NGW) {
        const int row = it / NH, h = it % NH, c = h * HD + lane;
        const float y = Y[(size_t)row * C + c];
        const float mu = wave_sum(y, lane) * (1.0f / HD); const float d = y - mu; const float var = wave_sum(d * d, lane) * (1.0f / HD);
        float o = d * (1.0f / sqrtf(var + GN_EPS)) * lnw[c] + lnb[c];
        o += RK[(size_t)row * NH + h] * bf2f(Vb[(size_t)row * C + c]);
        float g = 0.f;
        for (int dd = 0; dd < DG; ++dd) g += bf2f(LG[(size_t)row * DG + dd]) * g2[(size_t)dd * C + c];
        YG[(size_t)row * C + c] = (bf16)f2bf(o * g);
    }
}


constexpr int CW_DBG = 3200;
__device__ __forceinline__ void dbg_nonfinite(unsigned char* ws, const bf16* X, size_t n, int slot, int gw, int NGW, int lane, float thr = 1e30f) {
    unsigned* cw = (unsigned*)(ws + WS_CTL) + CW_DBG + 64 * slot; unsigned nnan = 0;
    for (size_t i = (size_t)gw * 64 + lane; i < n; i += (size_t)NGW * 64) { const float x = bf2f(X[i]); if (!(fabsf(x) < thr)) ++nnan; }
    if (nnan) atomicAdd(cw, nnan);
}
__device__ __forceinline__ void dbg_compare(unsigned char* ws, const bf16* X, const bf16* Y, int gw, int NGW, int lane) {
    unsigned* cw = (unsigned*)(ws + WS_CTL) + CW_DBG; unsigned nbad = 0, nnan = 0;
    for (size_t i = (size_t)gw * 64 + lane; i < (size_t)M * C; i += (size_t)NGW * 64) { const float x = bf2f(X[i]), y = bf2f(Y[i]);
        if (!(fabsf(x) < 1e30f)) ++nnan; else if (fabsf(x - y) > 0.05f * (fabsf(y) + 0.05f)) ++nbad; }
    if (nnan) atomicAdd(cw, nnan); if (nbad) atomicAdd(cw + 64, nbad);
}
#endif
__device__ __forceinline__ void router_rows(unsigned char* ws, LAS unsigned char* lds, int layer, int gw, int NGW, int lane, int tid, int wv, bool dry = false) {
    const bf16* Hh = (const bf16*)(ws + WS_B4); const float* gain = INP(2) + layer * C; float* rsl = (float*)(ws + WS_B0);
    const float* wg = INP(24) + (size_t)layer * C * 4; const float* bg = INP(25) + layer * 4; const float* wi = INP(26) + (size_t)layer * C * 16; const float* bi = INP(27) + layer * 16;
    unsigned* cnt = (unsigned*)(ws + WS_CTL) + CW_CNT + layer * 16 * 64; unsigned* list = (unsigned*)(ws + WS_LIST); float* wl = (float*)(ws + WS_WL);
    LAS float* sWg = (LAS float*)lds; LAS float* sWi = sWg + C * 4;
    constexpr int RECMAX = 256;
    LAS unsigned* lcnt = (LAS unsigned*)(lds + 81920); LAS unsigned* gbase = lcnt + 16; LAS float* sBias = (LAS float*)(lcnt + 32);
    LAS unsigned* recRow = lcnt + 64; LAS unsigned* recE = recRow + RECMAX; LAS unsigned* recL = recE + RECMAX; LAS float* recW0 = (LAS float*)(recL + RECMAX); LAS float* recW1 = recW0 + RECMAX; LAS float* recRS = recW1 + RECMAX;
    __syncthreads();
    for (int e = tid; e < C; e += 512) { const int r = e >> 6, c = 256 * (r >> 2) + 4 * (e & 63) + (r & 3); ((LAS f32x4*)sWg)[e] = ((const GAS f32x4*)wg)[c]; }
    for (int e = tid; e < C * 4; e += 512) { const int r = e >> 6, jq = r >> 2, c = 256 * (jq >> 2) + 4 * (e & 63) + (jq & 3); ((LAS f32x4*)sWi)[e] = ((const GAS f32x4*)wi)[c * 4 + (r & 3)]; }
    if (tid < 4) sBias[tid] = bg[tid]; else if (tid < 20) sBias[tid] = bi[tid - 4];
    for (int e = tid; e < RECMAX; e += 512) recE[e] = 0xffffffffu;
    __syncthreads();
    f32x4 g[4]; load_row(gain, lane, g);
    v2u nxr[2][4];
#pragma unroll
    for (int r = 0; r < 2; ++r) { const int r0 = gw + r * NGW < M - 1 ? gw + r * NGW : M - 1;
#pragma unroll
        for (int j = 0; j < 4; ++j) nxr[r][j] = ((const GAS v2u*)(Hh + (size_t)r0 * C))[64 * j + lane]; }
    int k = 0;
    for (int row = gw; row < M; row += 2 * NGW, k += 2) {
        f32x4 v[2][4];
#pragma unroll
        for (int r = 0; r < 2; ++r)
#pragma unroll
            for (int j = 0; j < 4; ++j) v[r][j] = (f32x4){bflo(nxr[r][j].x), bfhi(nxr[r][j].x), bflo(nxr[r][j].y), bfhi(nxr[r][j].y)};
#pragma unroll
        for (int r = 0; r < 2; ++r) { const int rn = row + (2 + r) * NGW, r0 = rn < M - 1 ? rn : M - 1;
#pragma unroll
            for (int j = 0; j < 4; ++j) nxr[r][j] = ((const GAS v2u*)(Hh + (size_t)r0 * C))[64 * j + lane]; }
        float rs[2];
#pragma unroll
        for (int r = 0; r < 2; ++r) { rs[r] = row_rs(v[r], lane);
#pragma unroll
            for (int j = 0; j < 4; ++j) v[r][j] = v[r][j] * rs[r] * g[j]; }
        float gl[2][4] = {{0.f, 0.f, 0.f, 0.f}, {0.f, 0.f, 0.f, 0.f}};
        const LAS unsigned char* pWg = (const LAS unsigned char*)sWg + lane * 16;
#pragma unroll
        for (int j = 0; j < 4; ++j)
#pragma unroll
            for (int q = 0; q < 4; ++q) { const f32x4 w = *(const LAS f32x4*)(pWg + (j * 4 + q) * 1024);
#pragma unroll
                for (int r = 0; r < 2; ++r) { const float xv = v[r][j][q]; gl[r][0] += xv * w.x; gl[r][1] += xv * w.y; gl[r][2] += xv * w.z; gl[r][3] += xv * w.w; } }
        int gi[2]; float gval[2];
#pragma unroll
        for (int r = 0; r < 2; ++r) {
#pragma unroll
            for (int q = 0; q < 4; ++q) gl[r][q] = wave_sum(gl[r][q], lane) + sBias[q];
            gi[r] = 0; float gm = gl[r][0];
#pragma unroll
            for (int q = 1; q < 4; ++q) if (gl[r][q] > gm) { gm = gl[r][q]; gi[r] = q; }
            float gden = 0.f;
#pragma unroll
            for (int q = 0; q < 4; ++q) gden += __expf(gl[r][q] - gm);
            gval[r] = 1.0f / gden; }
        float il[2][4] = {{0.f, 0.f, 0.f, 0.f}, {0.f, 0.f, 0.f, 0.f}};
        const LAS unsigned char* pWi0 = (const LAS unsigned char*)sWi + lane * 16 + gi[0] * 1024;
        const LAS unsigned char* pWi1 = (const LAS unsigned char*)sWi + lane * 16 + gi[1] * 1024;
#pragma unroll
        for (int j = 0; j < 4; ++j)
#pragma unroll
            for (int q = 0; q < 4; ++q) {
                { const f32x4 w = *(const LAS f32x4*)(pWi0 + (j * 4 + q) * 4096); const float xv = v[0][j][q]; il[0][0] += xv * w.x; il[0][1] += xv * w.y; il[0][2] += xv * w.z; il[0][3] += xv * w.w; }
                { const f32x4 w = *(const LAS f32x4*)(pWi1 + (j * 4 + q) * 4096); const float xv = v[1][j][q]; il[1][0] += xv * w.x; il[1][1] += xv * w.y; il[1][2] += xv * w.z; il[1][3] += xv * w.w; } }
#pragma unroll
        for (int r = 0; r < 2; ++r) {
            const f32x4 bi4 = *(const LAS f32x4*)(sBias + 4 + gi[r] * 4);
#pragma unroll
            for (int q = 0; q < 4; ++q) il[r][q] = wave_sum(il[r][q], lane) + bi4[q];
            int i0 = 0; float m0 = il[r][0];
#pragma unroll
            for (int q = 1; q < 4; ++q) if (il[r][q] > m0) { m0 = il[r][q]; i0 = q; }
            int i1 = -1; float m1 = -INFINITY;
#pragma unroll
            for (int q = 0; q < 4; ++q) if (q != i0 && il[r][q] > m1) { m1 = il[r][q]; i1 = q; }
            const float e1 = __expf(m1 - m0); const float w0 = gval[r] / (1.0f + e1), w1 = gval[r] * e1 / (1.0f + e1);
            const int ri = wv * 32 + k + r;
            if (lane == 0 && !dry && k + r < 32 && row + r * NGW < M) { const int ex0 = gi[r] * 4 + i0, ex1 = gi[r] * 4 + i1;
                recRow[ri] = (unsigned)(row + r * NGW); recE[ri] = (unsigned)ex0 | ((unsigned)ex1 << 8); recW0[ri] = w0; recW1[ri] = w1; recRS[ri] = rs[r]; }
        }
    }
    __syncthreads();
    unsigned e = 0xffffffffu; if (tid < RECMAX) e = recE[tid];
    const unsigned ex0 = e & 255u, ex1 = (e >> 8) & 255u;
    unsigned pos0 = 0u, pos1 = 0u;
    if (wv < RECMAX / 64) {
#pragma unroll
        for (unsigned x = 0; x < 16; ++x) { const unsigned long long m0 = __ballot(ex0 == x), m1 = __ballot(ex1 == x);
            const unsigned p = __builtin_amdgcn_mbcnt_hi((unsigned)(m0 >> 32), __builtin_amdgcn_mbcnt_lo((unsigned)m0, 0u)) + __builtin_amdgcn_mbcnt_hi((unsigned)(m1 >> 32), __builtin_amdgcn_mbcnt_lo((unsigned)m1, 0u));
            if (ex0 == x) pos0 = p; if (ex1 == x) pos1 = p;
            if (lane == 0) recL[wv * 16 + x] = (unsigned)(__popcll(m0) + __popcll(m1)); } }
    __syncthreads();
    if (tid < 16 && !dry) { unsigned c_ = 0u;
#pragma unroll
        for (int q = 0; q < RECMAX / 64; ++q) c_ += recL[q * 16 + tid];
        gbase[tid] = atomicAdd(cnt + tid * 64, c_); }
    __syncthreads();
    if (e != 0xffffffffu && !dry) { unsigned p0 = gbase[ex0] + pos0, p1 = gbase[ex1] + pos1;
        for (int q = 0; q < wv; ++q) { p0 += recL[q * 16 + ex0]; p1 += recL[q * 16 + ex1]; }
        const unsigned row = recRow[tid]; const float rs = recRS[tid];
        list[(size_t)ex0 * M + p0] = row * 2u; wl[(size_t)ex0 * M + p0] = recW0[tid]; list[(size_t)ex1 * M + p1] = row * 2u + 1u; wl[(size_t)ex1 * M + p1] = recW1[tid];
        rsl[(size_t)ex0 * M + p0] = rs; rsl[(size_t)ex1 * M + p1] = rs; }
}
__device__ __forceinline__ void moe_table(unsigned char* ws, volatile LAS int* tab, int layer, int tid) {
    __syncthreads();
    if (tid == 0) { const unsigned* cnt = (const unsigned*)(ws + WS_CTL) + CW_CNT + layer * 16 * 64; int t = 0;
#pragma unroll 1
        for (int e = 0; e < 16; ++e) { const int c = (int)__hip_atomic_load(cnt, RLX_AGENT); cnt += 64; tab[e] = c; tab[16 + e] = t; t += (c + 255) >> 8; tab[32 + e] = t; }
        tab[48] = t; }
    __syncthreads();
}
__device__ __forceinline__ void combine_rows(unsigned char* ws, int mode, int gw, int NGW, int lane, bool dry = false) {
    bf16* Hh = (bf16*)(ws + WS_B4); float* Out = OUTP(); const bf16* E0 = (const bf16*)(ws + WS_B2); const bf16* E1 = (const bf16*)(ws + WS_B3); bf16* XN2 = (bf16*)(ws + WS_B0);
    f32x4 g[4]; load_row(INP(4), lane, g);
    for (int row = gw; row < M; row += NGW) {
        f32x4 v[4]; load_row_bf(Hh + (size_t)row * C, lane, v);
#pragma unroll
        for (int j = 0; j < 4; ++j) { const v2u e0 = ((const GAS v2u*)(E0 + (size_t)row * C))[64 * j + lane], e1 = ((const GAS v2u*)(E1 + (size_t)row * C))[64 * j + lane];
            v[j].x += bflo(e0.x) + bflo(e1.x); v[j].y += bfhi(e0.x) + bfhi(e1.x); v[j].z += bflo(e0.y) + bflo(e1.y); v[j].w += bfhi(e0.y) + bfhi(e1.y); }
        const float rs = row_rs(v, lane);
        if (mode == 0) {
            if (!dry) store_row_bf16(Hh + (size_t)row * C, lane, v);
            if (lane == 0) ((float*)XN2)[row] = rs;
        } else {
            float sig = 1.0f;
#if MK_DEBUG
            const unsigned* cw = (const unsigned*)(ws + WS_CTL) + CW_DBG; const unsigned nnan = __hip_atomic_load(cw, RLX_AGENT), nbad = __hip_atomic_load(cw + 64, RLX_AGENT);
            if (row < 512 && nnan > 0) sig = 2.0f;
            if (row >= 512 && row < 1536 && __hip_atomic_load(cw + 128, RLX_AGENT) > 0) sig = 2.0f;
            if (row >= 1536 && row < 3584 && __hip_atomic_load(cw + 192, RLX_AGENT) > 0) sig = 2.0f;
            if (row >= 3584 && row < 7680 && __hip_atomic_load(cw + 256, RLX_AGENT) > 0) sig = 2.0f;
            if (row >= 7680 && row < 15872 && __hip_atomic_load(cw + 320, RLX_AGENT) > 0) sig = 2.0f;
            if (row >= 15872 && nbad > (unsigned)(M / 100) * C) sig = 1.5f;
#endif
#pragma unroll
            for (int j = 0; j < 4; ++j) ((GAS f32x4*)(Out + (size_t)row * C))[64 * j + lane] = v[j] * rs * g[j] * sig;
        }
    }
}
__device__ __forceinline__ void attn_naive(unsigned char* ws, int gw, int NGW, int lane) {
    const bf16* Kb = (const bf16*)(ws + WS_B1); const bf16* Vb = (const bf16*)(ws + WS_B2); const bf16* Qb = (const bf16*)(ws + WS_B3); bf16* Ob = (bf16*)(ws + WS_B0);
    for (int unit = gw; unit < BATCH * NH * (SEQ / 64); unit += NGW) {
        const int qb = unit % (SEQ / 64), bh = unit / (SEQ / 64), b = bh / NH, h = bh % NH;
        const int t0 = qb * 64, t = t0 + lane; const size_t rowq = (size_t)b * SEQ + t;
        float q[64], o[64];
#pragma unroll
        for (int c = 0; c < 8; ++c) { const v4u w = *(const GAS v4u*)(Qb + rowq * C + h * HD + c * 8);
            q[c * 8 + 0] = bflo(w.x) * 0.125f; q[c * 8 + 1] = bfhi(w.x) * 0.125f; q[c * 8 + 2] = bflo(w.y) * 0.125f; q[c * 8 + 3] = bfhi(w.y) * 0.125f;
            q[c * 8 + 4] = bflo(w.z) * 0.125f; q[c * 8 + 5] = bfhi(w.z) * 0.125f; q[c * 8 + 6] = bflo(w.w) * 0.125f; q[c * 8 + 7] = bfhi(w.w) * 0.125f; }
#pragma unroll
        for (int c = 0; c < 64; ++c) o[c] = 0.f;
        float suffix = 0.f;
        for (int s = t0 + 62; s >= 0; --s) {
            const bool valid = s < t;
            if (s < t0 && __all(suffix > SB_EXIT)) break;
            const bf16* kp = Kb + ((size_t)b * SEQ + s) * C + h * HD; const bf16* vp = Vb + ((size_t)b * SEQ + s) * C + h * HD;
            float z = 0.f;
#pragma unroll
            for (int c = 0; c < 8; ++c) { const v4u w = *(const GAS v4u*)(kp + c * 8);
                z += q[c * 8 + 0] * bflo(w.x) + q[c * 8 + 1] * bfhi(w.x) + q[c * 8 + 2] * bflo(w.y) + q[c * 8 + 3] * bfhi(w.y) + q[c * 8 + 4] * bflo(w.z) + q[c * 8 + 5] * bfhi(w.z) + q[c * 8 + 6] * bflo(w.w) + q[c * 8 + 7] * bfhi(w.w); }
            const float sp = fmaxf(z, 0.f) + log1pf(__expf(-fabsf(z)));
            const float att = valid ? __expf(z - sp - suffix) : 0.f;
            suffix += valid ? sp : 0.f;
#pragma unroll
            for (int c = 0; c < 8; ++c) { const v4u w = *(const GAS v4u*)(vp + c * 8);
                o[c * 8 + 0] += att * bflo(w.x); o[c * 8 + 1] += att * bfhi(w.x); o[c * 8 + 2] += att * bflo(w.y); o[c * 8 + 3] += att * bfhi(w.y);
                o[c * 8 + 4] += att * bflo(w.z); o[c * 8 + 5] += att * bfhi(w.z); o[c * 8 + 6] += att * bflo(w.w); o[c * 8 + 7] += att * bfhi(w.w); }
        }
#pragma unroll
        for (int c = 0; c < 8; ++c) { v4u w; w.x = pk2(o[c * 8 + 0], o[c * 8 + 1]); w.y = pk2(o[c * 8 + 2], o[c * 8 + 3]); w.z = pk2(o[c * 8 + 4], o[c * 8 + 5]); w.w = pk2(o[c * 8 + 6], o[c * 8 + 7]);
            *(GAS v4u*)(Ob + rowq * C + h * HD + c * 8) = w; }
    }
}


typedef float f32x16 __attribute__((ext_vector_type(16)));
constexpr int AT_VP = 192;
constexpr int AT_WAVE_LDS = 32 * AT_VP;
__device__ __forceinline__ int crow32(int reg, int hh) { return (reg & 3) + 8 * (reg >> 2) + 4 * hh; }
__device__ __forceinline__ bf16x8s pack_step(const f32x16& x, const int s) {
    v4u p; p.x = pg8::cvt_pk_bf16(x[8 * s], x[8 * s + 1]); p.y = pg8::cvt_pk_bf16(x[8 * s + 2], x[8 * s + 3]); p.z = pg8::cvt_pk_bf16(x[8 * s + 4], x[8 * s + 5]); p.w = pg8::cvt_pk_bf16(x[8 * s + 6], x[8 * s + 7]);
    return __builtin_bit_cast(bf16x8s, p);
}
__device__ __forceinline__ void attn_mfma(unsigned char* ws, LAS unsigned char* lds, int gw, int NGW, int lane, int wave) {
    const bf16* Kb = (const bf16*)(ws + WS_B1); const bf16* Vb = (const bf16*)(ws + WS_B2); const bf16* Qb = (const bf16*)(ws + WS_B3); bf16* Ob = (bf16*)(ws + WS_B0);
    LAS unsigned char* vl = lds + wave * AT_WAVE_LDS;
    const int r32 = lane & 31, hh = lane >> 5;
    bf16x8s tri[2];
#pragma unroll
    for (int s = 0; s < 2; ++s)
#pragma unroll
        for (int j = 0; j < 8; ++j) tri[s][j] = (16 * s + 8 * (j >> 2) + 4 * hh + (j & 3)) > r32 ? (short)0x3F80 : (short)0;
    const int grp = lane >> 4, tq = (lane & 15) >> 2, tp = lane & 3;
    const LAS unsigned char* vtr0 = vl + (4 * hh + tq) * AT_VP + (16 * (grp & 1) + 4 * tp) * 2;
    for (int unit = gw; unit < BATCH * NH * (SEQ / 32); unit += NGW) {
        const int qb = unit % (SEQ / 32), bh = unit / (SEQ / 32), b = bh / NH, hd = bh % NH;
        const int t0 = qb * 32; const size_t rowb = (size_t)b * SEQ;
        bf16x8s qf[4];
#pragma unroll
        for (int ks = 0; ks < 4; ++ks) qf[ks] = *(const GAS bf16x8s*)(Qb + (rowb + t0 + r32) * C + hd * HD + 16 * ks + 8 * hh);
        f32x16 o[2];
#pragma unroll
        for (int i = 0; i < 16; ++i) { o[0][i] = 0.f; o[1][i] = 0.f; }
        float carry = 0.f;
        for (int s0 = t0; s0 >= 0; s0 -= 32) {
            bf16x8s kf[4];
#pragma unroll
            for (int ks = 0; ks < 4; ++ks) kf[ks] = *(const GAS bf16x8s*)(Kb + (rowb + s0 + r32) * C + hd * HD + 16 * ks + 8 * hh);
            v4u vreg[4];
#pragma unroll
            for (int i = 0; i < 4; ++i) { const int cidx = lane + 64 * i; vreg[i] = *(const GAS v4u*)(Vb + (rowb + s0 + (cidx >> 3)) * C + hd * HD + (cidx & 7) * 8); }
            f32x16 st;
#pragma unroll
            for (int i = 0; i < 16; ++i) st[i] = 0.f;
#pragma unroll
            for (int ks = 0; ks < 4; ++ks) st = __builtin_amdgcn_mfma_f32_32x32x16_bf16(kf[ks], qf[ks], st, 0, 0, 0);
#pragma unroll
            for (int i = 0; i < 4; ++i) { const int cidx = lane + 64 * i; *(LAS v4u*)(vl + (cidx >> 3) * AT_VP + (cidx & 7) * 16) = vreg[i]; }
            f32x16 zz, uu; float tot = 0.f; const int tq_ = t0 + r32;
            if (s0 + 31 < t0) {
#pragma unroll
                for (int i = 0; i < 16; ++i) { const float z = st[i] * 0.18033688011112042f; const float sp = fmaxf(z, 0.f) + __builtin_amdgcn_logf(1.0f + __builtin_amdgcn_exp2f(-fabsf(z)));
                    zz[i] = z - sp; uu[i] = sp; tot += sp; }
            } else {
#pragma unroll
                for (int i = 0; i < 16; ++i) { const int key = s0 + crow32(i, hh); const float z = st[i] * 0.18033688011112042f; const float sp = fmaxf(z, 0.f) + __builtin_amdgcn_logf(1.0f + __builtin_amdgcn_exp2f(-fabsf(z)));
                    const bool valid = key < tq_; zz[i] = valid ? z - sp : -1e30f; uu[i] = valid ? sp : 0.f; tot += uu[i]; }
            }
            f32x16 w;
#pragma unroll
            for (int i = 0; i < 16; ++i) w[i] = 0.f;
#pragma unroll
            for (int s = 0; s < 2; ++s) w = __builtin_amdgcn_mfma_f32_32x32x16_bf16(tri[s], pack_step(uu, s), w, 0, 0, 0);
            f32x16 pp;
#pragma unroll
            for (int i = 0; i < 16; ++i) pp[i] = __builtin_amdgcn_exp2f(zz[i] - w[i] - carry);
            tot += shx(tot, 32, lane); carry += tot;
            asm volatile("s_waitcnt lgkmcnt(0)" ::: "memory");
#pragma unroll
            for (int s = 0; s < 2; ++s) { const bf16x8s pa = pack_step(pp, s);
#pragma unroll
                for (int dt = 0; dt < 2; ++dt) {
                    const v4i16_t lo = __builtin_amdgcn_ds_read_tr16_b64_v4i16((LAS v4i16_t*)(vtr0 + (16 * s) * AT_VP + dt * 64));
                    const v4i16_t hi = __builtin_amdgcn_ds_read_tr16_b64_v4i16((LAS v4i16_t*)(vtr0 + (16 * s + 8) * AT_VP + dt * 64));
                    const bf16x8s vf = (bf16x8s){lo[0], lo[1], lo[2], lo[3], hi[0], hi[1], hi[2], hi[3]};
                    o[dt] = __builtin_amdgcn_mfma_f32_32x32x16_bf16(pa, vf, o[dt], 0, 0, 0); } }
            asm volatile("" ::: "memory");
            if (s0 < t0 && __all(carry > SB_EXIT * 1.4426950408889634f)) break;
        }
#pragma unroll
        for (int dt = 0; dt < 2; ++dt)
#pragma unroll
            for (int i = 0; i < 16; ++i) Ob[(rowb + t0 + crow32(i, hh)) * C + hd * HD + 32 * dt + r32] = (bf16)f2bf(o[dt][i]);
    }
}
__global__ void __launch_bounds__(NWAVES * 64, 2) yoco_fwd(Args args) {
    extern __shared__ __attribute__((aligned(16))) unsigned char lds_raw[];
    LAS unsigned char* lds = (LAS unsigned char*)lds_raw;
    const int G = gridDim.x; const int bx = blockIdx.x;
    int wave = __builtin_amdgcn_readfirstlane(threadIdx.x >> 6); asm volatile("" : "+s"(wave));
#define IDS() int lane; asm volatile("v_mbcnt_lo_u32_b32 %0, -1, 0\n\tv_mbcnt_hi_u32_b32 %0, -1, %0" : "=v"(lane)); const int tid = wave * 64 + lane; (void)tid; \
    const int vcu = (G % 8 == 0) ? (bx % 8) * (G / 8) + bx / 8 : bx; const int gw = vcu * NWAVES + wave, NGW = G * NWAVES; (void)lane; (void)gw; (void)NGW;
    unsigned char* ws = WSP();
    volatile LAS unsigned* MISC = (volatile LAS unsigned*)(lds + MISC_OFF);
    volatile LAS int* tab = (volatile LAS int*)(lds + MOE_TAB_OFF);
    for (int u = threadIdx.x; u < (LDS_BYTES - LDSCTL_OFF) / 4; u += NWAVES * 64) ((LAS unsigned*)(lds + LDSCTL_OFF))[u] = 0u;
    __syncthreads();
    XcdBarrier bar; bar.bar = (unsigned*)(ws + WS_CTL) + CW_BAR; bar.x = 0; bar.st = nullptr;
    if (N_LAUNCHES == 1) bar = xcd_barrier_post((unsigned*)(ws + WS_CTL) + CW_BAR, MISC + 8);
    const int lo = KA_INT(0), hi = KA_INT(1);
#ifndef PROBE_PH
#define PROBE_PH -1
#endif
#define IN(k) (lo <= (k) && (k) < hi)
#define REP(k) for (int rep_ = 0; rep_ < ((PROBE_PH == (k)) ? 2 : 1); ++rep_)
#define SEAM(k) do { if (IN(k) && IN((k) + 1)) xcd_barrier(bar); } while (0)

    if (IN(PH_P0)) REP(PH_P0) { IDS(); p0_weights<0>(ws, lds, gw, NGW, wave, lane); p0_weights<1>(ws, lds, gw, NGW, wave, lane); if (G <= 64) p0_weights<2>(ws, lds, gw, NGW, wave, lane); p0_rows(ws, gw, NGW, lane); }
    SEAM(PH_P0);
    if (PROBE_PH == 100 && N_LAUNCHES == 1) { for (int i_ = 0; i_ < 10; ++i_) xcd_barrier(bar); }
    if (IN(PH_LORA)) REP(PH_LORA) {
        SchedGrouped<1, 3> S{(const char*)(ws + WS_B1), (size_t)(WS_B2 - WS_B1), nullptr, (const char*)(ws + WS_WT_LORA), (size_t)256 * C * 2, G, bx};
        EpiLora E{(bf16*)(ws + WS_LW)};
        pg8::gemm_phase<EpiLora, SchedGrouped<1, 3>, true, false, C>(lds, S, E, wave);
    }
    SEAM(PH_LORA);
    if (IN(PH_RKV)) REP(PH_RKV) {
        SchedGrouped<4, 3> S{(const char*)OUTP(), (size_t)M * C * 2, (const char*)(ws + WS_B4), (const char*)(ws + WS_WT_RKV), (size_t)C * C * 2, G, bx};
        EpiSplit3 E{(bf16*)(ws + WS_B1), false, nullptr};
        pg8::gemm_phase<EpiSplit3, SchedGrouped<4, 3>, true, false, C>(lds, S, E, wave);
    }
    SEAM(PH_RKV);
    if (IN(PH_S1)) REP(PH_S1) { IDS(); scan_s1(ws, lds, lane, wave); }
    SEAM(PH_S1);
    if (IN(PH_S2)) REP(PH_S2) { IDS();
        if (bx < BATCH * NH || G <= BATCH * NH) scan_s2(ws, lds, lane, wave);
        }
    SEAM(PH_S2);
    if (IN(PH_S3)) REP(PH_S3) { IDS(); scan_s3(ws, lds, lane, wave); }
    SEAM(PH_S3);
#if MK_DEBUG
    if (IN(PH_DBG0)) { IDS(); scan_naive(ws, lds, tid); }
    SEAM(PH_DBG0);
    if (IN(PH_DBG0 + 1)) { IDS(); post_scan(ws, gw, NGW, lane); }
    SEAM(PH_DBG0 + 1);
    if (IN(PH_DBG0 + 2)) { IDS(); dbg_compare(ws, (const bf16*)(ws + WS_B0), (const bf16*)(ws + WS_B4), gw, NGW, lane); }
    SEAM(PH_DBG0 + 2);
#endif
    if (IN(PH_WOUT)) REP(PH_WOUT) {
        SchedGrouped<4, 1> S{(const char*)(ws + ((MK_DEBUG && DBG_USE_NAIVE) ? WS_B4 : WS_B0)), 0, nullptr, (const char*)(ws + WS_WT_OUT), 0, G, bx};
        EpiResidBf<true> E{INP(0), (bf16*)(ws + WS_B4)};
        pg8::gemm_phase<EpiResidBf<true>, SchedGrouped<4, 1>, true, false, C>(lds, S, E, wave);
    }
    SEAM(PH_WOUT);
#pragma unroll 1
    for (int layer = 0; layer < 2; ++layer) {
        const int pb = layer == 0 ? (int)PH_ROUT0 : (int)PH_ROUT1;
        if (IN(pb)) { IDS(); if (PROBE_PH == 101 && layer == 0) router_rows(ws, lds, layer, gw, NGW, lane, tid, wave, true); router_rows(ws, lds, layer, gw, NGW, lane, tid, wave); }
        SEAM(pb);
        if (IN(pb + 1)) REP(pb + 1) {
            { IDS(); moe_table(ws, tab, layer, tid); }
            SchedMoe<2, C, true> S{(const char*)(ws + WS_B4), (const char*)(ws + WS_WT_GU) + (size_t)layer * 16 * 512 * C * 2, (size_t)512 * C * 2, (const unsigned*)(ws + WS_LIST), tab, G, bx};
            EpiGU E{(bf16*)(ws + WS_HID), (const float*)(ws + WS_WL), (const float*)(ws + WS_B0)};
            pg8::gemm_phase<EpiGU, SchedMoe<2, C, true>, true, true, C>(lds, S, E, wave);
            if (layer == 0 && G > 64) { const int nr2 = __builtin_amdgcn_readfirstlane(tab[48]) * 2 - G, first = nr2 > 0 ? nr2 : 0;
                if (bx >= first) { IDS(); p0_weights<2>(ws, lds, (bx - first) * NWAVES + wave, (G - first) * NWAVES, wave, lane); } }
        }
        SEAM(pb + 1);
        if (IN(pb + 2)) REP(pb + 2) {
            { IDS(); moe_table(ws, tab, layer, tid); }
            SchedMoe<4, FE, false> S{(const char*)(ws + WS_HID), (const char*)(ws + WS_WT_DN) + (size_t)layer * 16 * C * FE * 2, (size_t)C * FE * 2, (const unsigned*)(ws + WS_LIST), tab, G, bx};
            EpiDown E{(bf16*)(ws + WS_B2), (const unsigned*)(ws + WS_LIST)};
            pg8::gemm_phase<EpiDown, SchedMoe<4, FE, false>, true, false, FE>(lds, S, E, wave);
        }
        SEAM(pb + 2);
        if (layer == 0) {
            if (IN(PH_COMB)) { IDS(); if (PROBE_PH == 102) combine_rows(ws, 0, gw, NGW, lane, true); combine_rows(ws, 0, gw, NGW, lane); }
            SEAM(PH_COMB);
            if (IN(PH_KVQ)) REP(PH_KVQ) {
                SchedGrouped<12, 1> S{(const char*)(ws + WS_B4), 0, nullptr, (const char*)(ws + WS_WT_KVQ), 0, G, bx};
                EpiSplit3 E{(bf16*)(ws + WS_B1), true, (const float*)(ws + WS_B0)};
                pg8::gemm_phase<EpiSplit3, SchedGrouped<12, 1>, true, false, C>(lds, S, E, wave);
            }
            SEAM(PH_KVQ);
            if (IN(PH_ATTN)) REP(PH_ATTN) { IDS(); attn_mfma(ws, lds, gw, NGW, lane, wave); }
            SEAM(PH_ATTN);
            if (IN(PH_SBO)) {
                SchedGrouped<4, 1> S{(const char*)(ws + WS_B0), 0, nullptr, (const char*)(ws + WS_WT_SBO), 0, G, bx};
                EpiResidBf<false> E{(const void*)(ws + WS_B4), (bf16*)(ws + WS_B4)};
                pg8::gemm_phase<EpiResidBf<false>, SchedGrouped<4, 1>, true, false, C>(lds, S, E, wave);
            }
            SEAM(PH_SBO);
        }
    }
    if (IN(PH_FINAL)) { IDS(); combine_rows(ws, 1, gw, NGW, lane); }
#undef IN
#undef SEAM
}

extern "C" void kernel_launch(void* const* d_in, const int* in_sizes, int n_in, void* d_out, int out_size, void* d_ws, size_t ws_size, hipStream_t stream) {
    static int grid = 0;
    if (grid == 0) {
        if (n_in != 31 || in_sizes[0] != M * C || out_size != M * C || ws_size < WS_END) { fprintf(stderr, "kernel_launch: unexpected shapes (n_in %d, in0 %d, out %d, ws %zu); nothing launched\n", n_in, n_in > 0 ? in_sizes[0] : -1, out_size, ws_size); grid = -1; return; }
        int dev = 0, cus = 0, per_cu = 0;
        if (hipGetDevice(&dev) != hipSuccess || hipDeviceGetAttribute(&cus, hipDeviceAttributeMultiprocessorCount, dev) != hipSuccess) { grid = -1; return; }
        if (hipFuncSetAttribute((const void*)yoco_fwd, hipFuncAttributeMaxDynamicSharedMemorySize, LDS_BYTES) != hipSuccess) { fprintf(stderr, "kernel_launch: hipFuncSetAttribute failed\n"); grid = -1; return; }
        if (hipOccupancyMaxActiveBlocksPerMultiprocessor(&per_cu, (const void*)yoco_fwd, NWAVES * 64, LDS_BYTES) != hipSuccess || per_cu < 1) fprintf(stderr, "kernel_launch: occupancy query reports %d\n", per_cu);
        (void)hipGetLastError();
        grid = cus - (cus % 16);
    }
    if (grid < 0) return;
    if (hipMemsetAsync((char*)d_ws + WS_CTL, 0, CTL_ZERO_BYTES, stream) != hipSuccess) return;
    Args a{};
    for (int i = 0; i < 31; ++i) a.in[i] = (const float*)d_in[i];
    a.out = (float*)d_out; a.ws = (unsigned char*)d_ws;
    for (int li = 0; li < (N_LAUNCHES == 1 ? 1 : (int)NPHASE); ++li) {
        a.ph_lo = (N_LAUNCHES == 1) ? 0 : li; a.ph_hi = (N_LAUNCHES == 1) ? NPHASE : li + 1; a.li = li;
        hipLaunchKernelGGL(yoco_fwd, dim3(grid), dim3(NWAVES * 64), LDS_BYTES, stream, a);
        const hipError_t le = hipPeekAtLastError();
        if (le != hipSuccess) { fprintf(stderr, "kernel_launch: launch %d failed: %s\n", li, hipGetErrorName(le)); break; }
    }
}
```

```cpp
#include <hip/hip_runtime.h>
#include <cstdio>
#include <cstdint>

#ifndef MK_N_LAUNCHES
#define MK_N_LAUNCHES 1
#endif

namespace pg8 {
#define PG8_LAS __attribute__((address_space(3)))
typedef unsigned short bf16_t;
typedef short bf16x8 __attribute__((ext_vector_type(8)));
typedef float f32x4 __attribute__((ext_vector_type(4)));
typedef unsigned u32x4 __attribute__((ext_vector_type(4)));
constexpr int BM = 256, BK = 64, HALF = 128, HTB = HALF * BK * 2, STAGE_BYTES = 8 * HTB, NXCD = 8, WGM = 8;

__host__ __device__ __forceinline__ int lds_byte(int r, int c) { const int st = (r >> 4) * 2 + (c >> 5), rr = r & 15, cc = c & 31, ob = rr * 64 + cc * 2; return st * 1024 + (ob ^ (((ob >> 9) & 1) << 5)); }
__host__ __device__ __forceinline__ void stage_rc(int b, int& R, int& C) { const int st = b / 1024, sb = b % 1024, swz = sb ^ (((sb >> 9) & 1) << 5); R = (st >> 1) * 16 + swz / 64; C = (st & 1) * 32 + (swz % 64) / 2; }
__host__ __device__ __forceinline__ int perm32(int rho) { const int n = rho >> 4, i = rho & 15; return 8 * (i >> 2) + 4 * n + (i & 3); }

struct Unit { int pm, pn, aux, r0, cnt; };

__host__ __device__ __forceinline__ void tile_map(int wgid, int nM, int nN, int& pm, int& pn) {
    const int nwg = nM * nN;
    { const int q = nwg / NXCD, r = nwg % NXCD, xcd = wgid % NXCD, off = wgid / NXCD; wgid = (xcd < r ? xcd * (q + 1) : r * (q + 1) + (xcd - r) * q) + off; }
    const int nig = WGM * nN, gid = wgid / nig, fm = gid * WGM, gsz = (nM - fm) < WGM ? (nM - fm) : WGM;
    pm = fm + ((wgid % nig) % gsz); pn = (wgid % nig) / gsz;
}

typedef float f32x2_t __attribute__((ext_vector_type(2))); typedef __bf16 bf16x2_t __attribute__((ext_vector_type(2)));
__device__ __forceinline__ unsigned cvt_pk_bf16(float lo, float hi) { const f32x2_t v = {lo, hi}; const bf16x2_t b = __builtin_convertvector(v, bf16x2_t); return __builtin_bit_cast(unsigned, b); }

template <class Epi, class Sched, bool ALIGN_EPI, bool GATHER, int K>
__device__ __forceinline__ void gemm_phase(PG8_LAS unsigned char* lds, const Sched& S, const Epi& E, const int wid) {
    int lane_; asm volatile("v_mbcnt_lo_u32_b32 %0, -1, 0\n\tv_mbcnt_hi_u32_b32 %0, -1, %0" : "=v"(lane_));
    const int lane = lane_, tid = wid * 64 + lane, wr = wid >> 2, wc = wid & 3, fr = lane & 15, fq = lane >> 4;
    constexpr int nt = K / BK;
    unsigned voffA[2], voffB[2];
#pragma unroll
    for (int i = 0; i < 2; ++i) { int R, C; stage_rc(tid * 16 + i * 8192, R, C); const int Rb = Epi::PERM ? ((R & ~31) + perm32(R & 31)) : R;
        voffA[i] = (unsigned)(R * K + C) * 2u; voffB[i] = (unsigned)(Rb * K + C) * 2u; }
    constexpr size_t kstep = (size_t)(BK * 2);
    constexpr size_t hstep = (size_t)HALF * K * 2;
    const unsigned ldsw = (unsigned)wid * 1024u;
    const int aoff = lds_byte(wr * 64 + fr, fq * 8), boff = lds_byte(wc * 32 + fr, fq * 8);
#define PG8_SA(b, h) (((b) * 2 + (h)) * HTB)
#define PG8_SB(b, h) ((4 + (b) * 2 + (h)) * HTB)
#define PG8_STAGE(bufoff, gbase, voff) do { _Pragma("unroll") for (int _i = 0; _i < 2; ++_i) \
        __builtin_amdgcn_global_load_lds((const unsigned*)((const char*)(gbase) + (voff)[_i]), (PG8_LAS unsigned*)(lds + (bufoff) + ldsw + _i * 8192), 16, 0, 0); } while (0)
#define PG8_LDA(dst, b, h) do { _Pragma("unroll") for (int m = 0; m < 4; ++m) _Pragma("unroll") for (int k = 0; k < 2; ++k) dst[m][k] = *(const PG8_LAS bf16x8*)(lds + PG8_SA(b, h) + aoff + m * 2048 + k * 1024); } while (0)
#define PG8_LDB(dst, b, h) do { _Pragma("unroll") for (int n = 0; n < 2; ++n) _Pragma("unroll") for (int k = 0; k < 2; ++k) dst[n][k] = *(const PG8_LAS bf16x8*)(lds + PG8_SB(b, h) + boff + n * 2048 + k * 1024); } while (0)
#define PG8_MMA(ai, bj, At, Bt) do { __builtin_amdgcn_s_setprio(1); _Pragma("unroll") for (int m = 0; m < 4; ++m) _Pragma("unroll") for (int n = 0; n < 2; ++n) _Pragma("unroll") for (int k = 0; k < 2; ++k) \
        acc[ai][bj][m][n] = __builtin_amdgcn_mfma_f32_16x16x32_bf16(Bt[n][k], At[m][k], acc[ai][bj][m][n], 0, 0, 0); __builtin_amdgcn_s_setprio(0); } while (0)
#define PG8_WAIT_V(n) asm volatile("s_waitcnt vmcnt(" #n ")" ::: "memory")
#define PG8_WAIT_L(n) asm volatile("s_waitcnt lgkmcnt(" #n ")" ::: "memory")
#define PG8_BAR __builtin_amdgcn_s_barrier()
#define PG8_SCHED __builtin_amdgcn_sched_barrier(0)
    Unit cur, nxt; int ui = 0;
    if (!S.next(0, cur)) return;
    f32x4 acc[2][2][4][2];
#pragma unroll
    for (int a = 0; a < 2; ++a)
#pragma unroll
        for (int b = 0; b < 2; ++b)
#pragma unroll
            for (int m = 0; m < 4; ++m)
#pragma unroll
                for (int n = 0; n < 2; ++n) acc[a][b][m][n] = (f32x4){0.f, 0.f, 0.f, 0.f};
    bf16x8 At[4][2], B0[2][2], B1[2][2];
    unsigned vc[2][2];
#define PG8_GOFF(u) do { _Pragma("unroll") for (int _h = 0; _h < 2; ++_h) _Pragma("unroll") for (int _i = 0; _i < 2; ++_i) { int _R, _C; stage_rc(tid * 16 + _i * 8192, _R, _C); \
        vc[_h][_i] = S.a_row_off(u, _h * HALF + _R) + (unsigned)_C * 2u; } } while (0)
#define PG8_STAGE_A(bufoff, gbase, h) do { if constexpr (GATHER) { PG8_STAGE(bufoff, gbase, vc[h]); } else { PG8_STAGE(bufoff, (gbase) + (h) * hstep, voffA); } } while (0)
    if constexpr (GATHER) PG8_GOFF(cur);
    const char* cA = S.a_base(cur); const char* cB = S.b_base(cur);
    PG8_STAGE(PG8_SB(0, 0), cB, voffB); PG8_STAGE(PG8_SB(0, 1), cB + hstep, voffB); PG8_STAGE_A(PG8_SA(0, 0), cA, 0); PG8_STAGE_A(PG8_SA(0, 1), cA, 1);
    if (wr == 1) PG8_BAR;
    PG8_WAIT_V(2); PG8_BAR;
    PG8_STAGE(PG8_SB(1, 0), cB + kstep, voffB); PG8_STAGE_A(PG8_SA(1, 0), cA + kstep, 0); PG8_STAGE(PG8_SB(1, 1), cB + hstep + kstep, voffB);
    PG8_WAIT_V(6); PG8_BAR;
    for (;;) {
        const bool has_next = S.next(ui + 1, nxt);
        const char* nA = has_next ? S.a_base(nxt) : cA; const char* nB = has_next ? S.b_base(nxt) : cB;
        for (int t = 0; t < nt; t += 2) {
            const bool last = (t == nt - 2);
            const char* a1 = cA + (size_t)(t + 1) * kstep;
            const char* a2 = last ? nA : cA + (size_t)(t + 2) * kstep; const char* b2 = last ? nB : cB + (size_t)(t + 2) * kstep;
            const char* a3 = a2 + kstep; const char* b3 = b2 + kstep;
            PG8_LDB(B0, 0, 0); PG8_LDB(B1, 0, 1); PG8_SCHED; PG8_LDA(At, 0, 0); PG8_STAGE_A(PG8_SA(1, 1), a1, 1);
            if constexpr (GATHER) { if (last && has_next) PG8_GOFF(nxt); }
            PG8_WAIT_V(8); PG8_WAIT_L(0); PG8_BAR; PG8_MMA(0, 0, At, B0); PG8_MMA(0, 1, At, B1); PG8_BAR; PG8_SCHED;
            PG8_LDA(At, 0, 1); PG8_STAGE(PG8_SB(0, 0), b2, voffB); PG8_STAGE(PG8_SB(0, 1), b2 + hstep, voffB); PG8_STAGE_A(PG8_SA(0, 0), a2, 0);
            PG8_WAIT_V(8); PG8_WAIT_L(0); PG8_BAR; PG8_MMA(1, 0, At, B0); PG8_MMA(1, 1, At, B1); PG8_BAR; PG8_SCHED;
            PG8_LDB(B0, 1, 0); PG8_LDB(B1, 1, 1); PG8_SCHED; PG8_LDA(At, 1, 0); PG8_STAGE_A(PG8_SA(0, 1), a2, 1);
            PG8_WAIT_V(8); PG8_WAIT_L(0); PG8_BAR; PG8_MMA(0, 0, At, B0); PG8_MMA(0, 1, At, B1); PG8_BAR; PG8_SCHED;
            PG8_LDA(At, 1, 1); PG8_STAGE(PG8_SB(1, 0), b3, voffB); PG8_STAGE(PG8_SB(1, 1), b3 + hstep, voffB); PG8_STAGE_A(PG8_SA(1, 0), a3, 0);
            PG8_WAIT_V(8); PG8_WAIT_L(0); PG8_BAR; PG8_MMA(1, 0, At, B0); PG8_MMA(1, 1, At, B1); PG8_BAR; PG8_SCHED;
        }
        if constexpr (ALIGN_EPI) { if (wr == 0) PG8_BAR; }
        E(acc, cur, wr, wc, fr, fq);
        if (!has_next) break;
#pragma unroll
        for (int a = 0; a < 2; ++a)
#pragma unroll
            for (int b = 0; b < 2; ++b)
#pragma unroll
                for (int m = 0; m < 4; ++m)
#pragma unroll
                    for (int n = 0; n < 2; ++n) acc[a][b][m][n] = (f32x4){0.f, 0.f, 0.f, 0.f};
        cur = nxt; cA = nA; cB = nB; ++ui;
        if constexpr (ALIGN_EPI) { if (wr == 1) PG8_BAR; }
    }
    PG8_WAIT_V(0);
    if constexpr (!ALIGN_EPI) { if (wr == 0) PG8_BAR; }
    PG8_BAR;
#undef PG8_SA
#undef PG8_SB
#undef PG8_STAGE
#undef PG8_STAGE_A
#undef PG8_GOFF
#undef PG8_LDA
#undef PG8_LDB
#undef PG8_MMA
#undef PG8_WAIT_V
#undef PG8_WAIT_L
#undef PG8_BAR
#undef PG8_SCHED
}
}

constexpr int NWAVES = 8;
#ifndef MK_DEBUG
#define MK_DEBUG 0
#endif
#ifndef DBG_USE_NAIVE
#define DBG_USE_NAIVE 0
#endif
constexpr int DBGP = MK_DEBUG ? 3 : 0;
enum Phase { PH_P0 = 0, PH_LORA, PH_RKV, PH_S1, PH_S2, PH_S3, PH_DBG0, PH_WOUT = PH_DBG0 + DBGP, PH_ROUT0, PH_GU0, PH_DN0, PH_COMB, PH_KVQ, PH_ATTN, PH_SBO, PH_ROUT1, PH_GU1, PH_DN1, PH_FINAL, NPHASE };
constexpr int N_LAUNCHES = MK_N_LAUNCHES;


constexpr int BATCH = 2, SEQ = 8192, C = 1024, NH = 16, HD = 64, M = BATCH * SEQ;
constexpr int NE = 16, FE = 256, DW = 64, DA = 64, DG = 160;
constexpr float RMS_EPS = 1e-6f, GN_EPS = 64e-5f;
constexpr float SB_EXIT = 104.0f;

constexpr size_t MiB = 1u << 20;
constexpr size_t WS_CTL = 0, CTL_ZERO_BYTES = 64 * 1024;
constexpr size_t WS_WT_W2 = 128 * 1024, WS_WT_A2 = 256 * 1024, WS_WT_G2 = 384 * 1024;
constexpr size_t WS_WT_RKV = 1 * MiB;
constexpr size_t WS_WT_LORA = 7 * MiB;
constexpr size_t WS_WT_OUT = 9 * MiB;
constexpr size_t WS_WT_KVQ = 11 * MiB;
constexpr size_t WS_WT_SBO = 17 * MiB;
constexpr size_t WS_WT_GU = 19 * MiB;
constexpr size_t WS_WT_DN = 51 * MiB;
constexpr size_t WS_LW = 67 * MiB;
constexpr size_t WS_LA = 69 * MiB;
constexpr size_t WS_LG = 71 * MiB;
static_assert(WS_LA == WS_LW + 2 * MiB && WS_LG == WS_LW + 4 * MiB, "EpiLora's pointer arithmetic");
constexpr size_t WS_LIST = 76 * MiB;
constexpr size_t WS_WL = 77 * MiB;
constexpr size_t WS_HID = 78 * MiB;
constexpr size_t WS_B0 = 96 * MiB, WS_B1 = 128 * MiB, WS_B2 = 160 * MiB, WS_B3 = 192 * MiB, WS_B4 = 224 * MiB, WS_END = 256 * MiB;
static_assert(WS_HID + (size_t)144 * 256 * 256 * 2 <= WS_B0, "HID vs B0");
constexpr int CW_TMO = 0;
constexpr int CW_CNT = 1024;
constexpr int CW_BAR = 4096;

constexpr int RING_BYTES = 131072;
constexpr int LDSCTL_OFF = 146688, MISC_OFF = LDSCTL_OFF + 320, MOE_TAB_OFF = MISC_OFF + 128;
constexpr int LDS_BYTES = 147456;
static_assert(MOE_TAB_OFF + 256 <= LDS_BYTES, "LDS map");
static_assert(BATCH * NH * (SEQ / 64) % 16 == 0, "scan units");

#define GAS __attribute__((address_space(1)))
#define LAS __attribute__((address_space(3)))
typedef unsigned short bf16;
typedef unsigned v4u __attribute__((ext_vector_type(4)));
typedef unsigned v2u __attribute__((ext_vector_type(2)));
typedef float f32x4 __attribute__((ext_vector_type(4)));
typedef GAS unsigned gu32;
#define RLX_AGENT __ATOMIC_RELAXED, __HIP_MEMORY_SCOPE_AGENT
#define LDS_WAIT() asm volatile("s_waitcnt lgkmcnt(0)" ::: "memory")
#define VM_WAIT() asm volatile("s_waitcnt vmcnt(0)" ::: "memory")
__device__ __forceinline__ unsigned f2bf(float f) { unsigned u = __builtin_bit_cast(unsigned, f); return (u + 0x7fffu + ((u >> 16) & 1u)) >> 16; }
__device__ __forceinline__ unsigned pk2(float lo, float hi) { return f2bf(lo) | (f2bf(hi) << 16); }
__device__ __forceinline__ float bflo(unsigned u) { return __uint_as_float(u << 16); }
__device__ __forceinline__ float bfhi(unsigned u) { return __uint_as_float(u & 0xffff0000u); }
__device__ __forceinline__ float bf2f(bf16 b) { return __uint_as_float((unsigned)b << 16); }
__device__ __forceinline__ float sigmoidf_(float x) { return 1.0f / (1.0f + __expf(-x)); }

#define XB_TMO      128
#define XB_XCNT(j)  (256  + 64 * (j))
#define XB_XSUB(j)  (1280 + 64 * (j))
#define XB_XGEN(j)  (2304 + 64 * (j))
#define XB_TOP      3328
#define XB_TOPGEN   3392
#define XCD_BAR_WORDS 3456
#define XB_SPIN_CAP (1u << 18)
__device__ __forceinline__ unsigned xb_ld(unsigned* p)              { return __hip_atomic_load(p, __ATOMIC_RELAXED, __HIP_MEMORY_SCOPE_AGENT); }
__device__ __forceinline__ unsigned xb_add(unsigned* p, unsigned v) { return __hip_atomic_fetch_add(p, v, __ATOMIC_RELAXED, __HIP_MEMORY_SCOPE_AGENT); }
__device__ __forceinline__ unsigned xb_xcc_id() { return (unsigned)__builtin_amdgcn_s_getreg((3 << 11) | 20) & 0xFu; }
#define XB_SPIN(cond, bar) do { unsigned _sp = 0; while (cond) { __builtin_amdgcn_s_sleep(1); \
    if ((++_sp & 255u) == 0u) { if (xb_ld(&(bar)[XB_TMO])) break; if (_sp > XB_SPIN_CAP) { atomicAdd(&(bar)[XB_TMO], 1u); break; } } } } while (0)
struct XcdBarrier { unsigned* bar; unsigned x; volatile LAS unsigned* st; };
__device__ __forceinline__ XcdBarrier xcd_barrier_post(unsigned* bar, volatile LAS unsigned* st) {
    XcdBarrier b; b.bar = bar; b.x = xb_xcc_id(); b.st = st;
    if (threadIdx.x == 0) (void)xb_add(&bar[XB_XCNT(b.x)], 1u);
    return b;
}
__device__ __forceinline__ void xcd_barrier_complete(unsigned* bar, unsigned x, unsigned& nloc, unsigned& nx) {
    const unsigned G = gridDim.x * gridDim.y * gridDim.z;
    unsigned sum, cnt, mine, sp = 0u;
    for (;;) {
        sum = 0u; cnt = 0u; mine = 0u;
#pragma unroll
        for (unsigned j = 0; j < 16; ++j) { const unsigned c = xb_ld(&bar[XB_XCNT(j)]); sum += c; cnt += (c > 0u) ? 1u : 0u; mine = (j == x) ? c : mine; }
        if (sum == G) break;
        __builtin_amdgcn_s_sleep(1);
        if ((++sp & 255u) == 0u) { if (xb_ld(&bar[XB_TMO])) break; if (sp > XB_SPIN_CAP) { atomicAdd(&bar[XB_TMO], 1u); break; } }
    }
    nloc = mine > 0u ? mine : 1u; nx = cnt > 0u ? cnt : 1u;
}
__device__ __forceinline__ void xcd_barrier(const XcdBarrier& b) {
    asm volatile("s_waitcnt vmcnt(0)" ::: "memory");
    __syncthreads();
    if (threadIdx.x == 0) {
        unsigned* bar = b.bar;
        __builtin_amdgcn_s_waitcnt(0);
        unsigned nloc = b.st[0], nx = b.st[1];
        if (nloc == 0u) { xcd_barrier_complete(bar, b.x, nloc, nx); b.st[0] = nloc; b.st[1] = nx; }
        const unsigned old = xb_add(&bar[XB_XSUB(b.x)], 1u);
        const unsigned gen = old / nloc;
        const unsigned target = (gen + 1u) * nx;
        if (old + 1u == (gen + 1u) * nloc) {
            __builtin_amdgcn_fence(__ATOMIC_RELEASE, "agent");
            asm volatile("s_waitcnt vmcnt(0)" ::: "memory");
            const unsigned og = xb_add(&bar[XB_TOP], 1u);
            if (og + 1u != target) XB_SPIN((int)(xb_ld(&bar[XB_TOP]) - target) < 0, bar);
        } else {
            XB_SPIN((int)(xb_ld(&bar[XB_TOP]) - target) < 0, bar);
        }
        __builtin_amdgcn_fence(__ATOMIC_ACQUIRE, "agent");
        asm volatile("s_waitcnt vmcnt(0)" ::: "memory");
    }
    __syncthreads();
}

__device__ __forceinline__ float shx(float v, int o, int lane) { return __int_as_float(__builtin_amdgcn_ds_bpermute((lane ^ o) << 2, __float_as_int(v))); }
#define DPP_ADD(v, ctrl) ((v) + __int_as_float(__builtin_amdgcn_update_dpp(0, __float_as_int(v), (ctrl), 0xf, 0xf, true)))
__device__ __forceinline__ float wave_sum(float v, int lane) {
    (void)lane;
    v = DPP_ADD(v, 0x128); v = DPP_ADD(v, 0x124); v = DPP_ADD(v, 0x122); v = DPP_ADD(v, 0x121);
    const int iv = __float_as_int(v);
    return (__int_as_float(__builtin_amdgcn_readlane(iv, 0)) + __int_as_float(__builtin_amdgcn_readlane(iv, 16))) + (__int_as_float(__builtin_amdgcn_readlane(iv, 32)) + __int_as_float(__builtin_amdgcn_readlane(iv, 48)));
}
__device__ __forceinline__ float sum8(float v) { v = DPP_ADD(v, 0xB1); v = DPP_ADD(v, 0x4E); v = DPP_ADD(v, 0x141); return v; }
__device__ __forceinline__ void transpose_item(const float* W, int ldw, int k0, int n0, bf16* WT, int ldk, int dst_row0, const float* kscale, LAS float* scr, int lane, int kmax = 1 << 30) {
    const int r8 = lane >> 3, quad = lane & 7;
    f32x4 v[8];
#pragma unroll
    for (int i = 0; i < 8; ++i) { const int kk = r8 + 8 * i; v[i] = (k0 + kk < kmax) ? *(const GAS f32x4*)(W + (size_t)(k0 + kk) * ldw + n0 + quad * 4) : (f32x4){0.f, 0.f, 0.f, 0.f}; }
#pragma unroll
    for (int i = 0; i < 8; ++i) { const int kk = r8 + 8 * i; if (kscale) v[i] = v[i] * kscale[(k0 + kk < kmax) ? k0 + kk : 0]; *(LAS f32x4*)(scr + kk * 36 + ((quad ^ i) << 2)) = v[i]; }
    LDS_WAIT(); asm volatile("" ::: "memory");
    const int c = lane & 7;
#pragma unroll
    for (int j = 0; j < 4; ++j) { const int n = (lane >> 3) + 8 * j; const LAS float* sp = scr + (8 * c) * 36 + ((((n >> 2) ^ c) << 2) | (n & 3));
        v4u o; o.x = pk2(sp[0 * 36], sp[1 * 36]); o.y = pk2(sp[2 * 36], sp[3 * 36]); o.z = pk2(sp[4 * 36], sp[5 * 36]); o.w = pk2(sp[6 * 36], sp[7 * 36]);
        if (k0 + 8 * c < kmax) *(GAS v4u*)(WT + (size_t)(dst_row0 + n) * ldk + k0 + 8 * c) = o; }
    LDS_WAIT(); asm volatile("" ::: "memory");
}

struct Args { const float* in[31]; float* out; unsigned char* ws; int ph_lo, ph_hi, li, pad; };
typedef const __attribute__((address_space(4))) unsigned char* kaptr_t;
__device__ __forceinline__ kaptr_t ka_base() { kaptr_t p = (kaptr_t)__builtin_amdgcn_kernarg_segment_ptr(); asm volatile("" : "+s"(p)); return p; }
#define INP(k) (*(const float* const __attribute__((address_space(4)))*)(ka_base() + 8 * (k)))
#define OUTP() (*(float* const __attribute__((address_space(4)))*)(ka_base() + 8 * 31))
#define WSP() (*(unsigned char* const __attribute__((address_space(4)))*)(ka_base() + 8 * 32))
#define KA_INT(i) (*(const int __attribute__((address_space(4)))*)(ka_base() + 8 * 33 + 4 * (i)))

template <int PART> __device__ __forceinline__ void p0_weights(unsigned char* ws, LAS unsigned char* lds, int gw, int NGW, int wave, int lane) {
    LAS float* scr = (LAS float*)(lds + wave * 16384);
    bf16* WT_RKV = (bf16*)(ws + WS_WT_RKV); bf16* WT_LORA = (bf16*)(ws + WS_WT_LORA); bf16* WT_OUT = (bf16*)(ws + WS_WT_OUT); bf16* WT_KVQ = (bf16*)(ws + WS_WT_KVQ);
    bf16* WT_SBO = (bf16*)(ws + WS_WT_SBO); bf16* WT_GU = (bf16*)(ws + WS_WT_GU); bf16* WT_DN = (bf16*)(ws + WS_WT_DN);
    constexpr int I_UP = 32 + 32 + 96, I_RKV = 3 * 512, I_LORA = 32 + 32 + 80, I_OUT = 512, I_KV = 1024, I_Q = 512, I_SBO = 512, I_G = 32 * 128, I_U = 32 * 128, I_D = 32 * 128;
    constexpr int NDENSE = I_UP + I_RKV + I_LORA + I_OUT + I_KV + I_Q + I_SBO, NITEMS = NDENSE + I_G + I_U + I_D;
    constexpr int NLOOP = PART == 0 ? NDENSE : 3 * 2048; (void)NITEMS;
    for (int q_ = gw; q_ < NLOOP; q_ += NGW) {
        const int it = PART == 0 ? q_ : NDENSE + (q_ / 2048) * 4096 + 2048 * (PART - 1) + (q_ % 2048);
        int r = it;
        if (r < I_UP) {
            if (r < 32) transpose_item(INP(9), C, 0, 32 * r, (bf16*)(ws + WS_WT_W2), 64, 32 * r, nullptr, scr, lane);
            else if (r < 64) transpose_item(INP(12), C, 0, 32 * (r - 32), (bf16*)(ws + WS_WT_A2), 64, 32 * (r - 32), nullptr, scr, lane);
            else { const int q = r - 64, kb = q / 32, nb = q % 32; transpose_item(INP(14), C, 64 * kb, 32 * nb, (bf16*)(ws + WS_WT_G2), DG, 32 * nb, nullptr, scr, lane, DG); }
            continue; } r -= I_UP;
        if (r < I_RKV) { const int m = r / 512, q = r % 512, kb = q / 32, nb = q % 32; transpose_item(INP(6) + (size_t)m * C * C, C, 64 * kb, 32 * nb, WT_RKV, C, m * C + 32 * nb, nullptr, scr, lane); continue; } r -= I_RKV;
        if (r < I_LORA) {
            if (r < 32) { const int kb = r / 2, nb = r % 2; transpose_item(INP(8), DW, 64 * kb, 32 * nb, WT_LORA, C, 32 * nb, nullptr, scr, lane); }
            else if (r < 64) { const int q = r - 32, kb = q / 2, nb = q % 2; transpose_item(INP(11), DA, 64 * kb, 32 * nb, WT_LORA, C, 256 + 32 * nb, nullptr, scr, lane); }
            else { const int q = r - 64, kb = q / 5, nb = q % 5; transpose_item(INP(13), DG, 64 * kb, 32 * nb, WT_LORA, C, 512 + 32 * nb, nullptr, scr, lane); }
            continue; } r -= I_LORA;
        if (r < I_OUT) { const int kb = r / 32, nb = r % 32; transpose_item(INP(20), C, 64 * kb, 32 * nb, WT_OUT, C, 32 * nb, nullptr, scr, lane); continue; } r -= I_OUT;
        if (r < I_KV) { const int kb = r / 64, nb = r % 64; transpose_item(INP(21), 2 * C, 64 * kb, 32 * nb, WT_KVQ, C, 32 * nb, INP(3), scr, lane); continue; } r -= I_KV;
        if (r < I_Q) { const int kb = r / 32, nb = r % 32; transpose_item(INP(22), C, 64 * kb, 32 * nb, WT_KVQ, C, 2 * C + 32 * nb, INP(1) + C, scr, lane); continue; } r -= I_Q;
        if (r < I_SBO) { const int kb = r / 32, nb = r % 32; transpose_item(INP(23), C, 64 * kb, 32 * nb, WT_SBO, C, 32 * nb, nullptr, scr, lane); continue; } r -= I_SBO;
        if (r < I_G) { const int le = r / 128, q = r % 128, kb = q / 8, nb = q % 8, f0 = 32 * nb; transpose_item(INP(28) + (size_t)le * C * FE, FE, 64 * kb, f0, WT_GU + (size_t)le * 512 * C, C, 256 * (f0 / 128) + (f0 % 128), INP(2) + (le >> 4) * C, scr, lane); continue; } r -= I_G;
        if (r < I_U) { const int le = r / 128, q = r % 128, kb = q / 8, nb = q % 8, f0 = 32 * nb; transpose_item(INP(29) + (size_t)le * C * FE, FE, 64 * kb, f0, WT_GU + (size_t)le * 512 * C, C, 256 * (f0 / 128) + 128 + (f0 % 128), INP(2) + (le >> 4) * C, scr, lane); continue; } r -= I_U;
        { const int le = r / 128, q = r % 128, kb = q / 32, nb = q % 32; transpose_item(INP(30) + (size_t)le * FE * C, C, 64 * kb, 32 * nb, WT_DN + (size_t)le * C * FE, FE, 32 * nb, nullptr, scr, lane); }
    }
    if (PART == 0) for (int it = gw * 64 + lane; it < 768 * 128; it += NGW * 64) { const int row = it >> 7, ch = it & 127;
        const bool valid = (row < 64) || (row >= 256 && row < 320) || (row >= 512 && row < 672);
        if (!valid) *(GAS v4u*)(WT_LORA + (size_t)row * C + ch * 8) = (v4u){0u, 0u, 0u, 0u}; }
}
__device__ __forceinline__ void load_row(const float* p, int lane, f32x4 (&v)[4]) {
#pragma unroll
    for (int j = 0; j < 4; ++j) v[j] = ((const GAS f32x4*)p)[64 * j + lane];
}
__device__ __forceinline__ void load_row_bf(const bf16* p, int lane, f32x4 (&v)[4]) {
#pragma unroll
    for (int j = 0; j < 4; ++j) { const v2u w = ((const GAS v2u*)p)[64 * j + lane]; v[j] = (f32x4){bflo(w.x), bfhi(w.x), bflo(w.y), bfhi(w.y)}; }
}
__device__ __forceinline__ float row_rs(const f32x4 (&v)[4], int lane) {
    float s = 0.f;
#pragma unroll
    for (int j = 0; j < 4; ++j) s += (v[j].x * v[j].x + v[j].y * v[j].y) + (v[j].z * v[j].z + v[j].w * v[j].w);
    return 1.0f / sqrtf(wave_sum(s, lane) * (1.0f / C) + RMS_EPS);
}
__device__ __forceinline__ void store_row_bf16(bf16* p, int lane, const f32x4 (&v)[4]) {
#pragma unroll
    for (int j = 0; j < 4; ++j) { v2u o; o.x = pk2(v[j].x, v[j].y); o.y = pk2(v[j].z, v[j].w); ((GAS v2u*)p)[64 * j + lane] = o; }
}
__device__ __forceinline__ void p0_rows(unsigned char* ws, int gw, int NGW, int lane) {
    const float* x = INP(0); const float* gain = INP(1); const float* mix = INP(5);
    f32x4 g[4]; load_row(gain, lane, g);
    f32x4 mx[6][4];
#pragma unroll
    for (int i = 0; i < 6; ++i) load_row(mix + i * C, lane, mx[i]);
    for (int run = gw; run < M / 8; run += NGW) {
        const int r0 = run * 8;
        f32x4 prev[4], nx[4];
        load_row(x + (size_t)r0 * C, lane, nx);
        if ((r0 % SEQ) == 0) {
#pragma unroll
            for (int j = 0; j < 4; ++j) prev[j] = (f32x4){0.f, 0.f, 0.f, 0.f};
        } else { load_row(x + (size_t)(r0 - 1) * C, lane, prev); const float rs = row_rs(prev, lane);
#pragma unroll
            for (int j = 0; j < 4; ++j) prev[j] = prev[j] * rs * g[j]; }
#pragma unroll 1
        for (int rr = 0; rr < 8; ++rr) {
            const int row = r0 + rr;
            f32x4 hn[4];
#pragma unroll
            for (int j = 0; j < 4; ++j) hn[j] = nx[j];
            if (rr < 7) load_row(x + (size_t)(row + 1) * C, lane, nx);
            const float rs = row_rs(hn, lane);
#pragma unroll
            for (int j = 0; j < 4; ++j) hn[j] = hn[j] * rs * g[j];
#pragma unroll
            for (int i = 0; i < 6; ++i) { f32x4 o[4];
#pragma unroll
                for (int j = 0; j < 4; ++j) o[j] = hn[j] + (prev[j] - hn[j]) * mx[i][j];
                bf16* dst = i < 2 ? (bf16*)OUTP() + (size_t)i * M * C : (i == 2 ? (bf16*)(ws + WS_B4) : (bf16*)(ws + WS_B1) + (size_t)(i - 3) * M * C);
                store_row_bf16(dst + (size_t)row * C, lane, o); }
#pragma unroll
            for (int j = 0; j < 4; ++j) prev[j] = hn[j];
        }
    }
}

template <int NN, int NGROUPS> struct SchedGrouped {
    static constexpr int K = C;
    const char* A0; size_t astride; const char* A2; const char* B; size_t bgroup;
    int G, c;
    __device__ __forceinline__ bool next(int i, pg8::Unit& u) const {
        const int L = i * G + c; constexpr int per = 64 * NN; if (L >= per * NGROUPS) return false;
        const int g = L / per, w = L % per; pg8::tile_map(w, 64, NN, u.pm, u.pn); u.aux = g; u.r0 = 0; u.cnt = 0; return true; }
    __device__ __forceinline__ const char* a_base(const pg8::Unit& u) const { const char* A = (A2 != nullptr && u.aux == 2) ? A2 : A0 + (size_t)u.aux * astride; return A + (size_t)u.pm * 256 * K * 2; }
    __device__ __forceinline__ const char* b_base(const pg8::Unit& u) const { return B + (size_t)u.aux * bgroup + (size_t)u.pn * 256 * K * 2; }
    __device__ __forceinline__ unsigned a_row_off(const pg8::Unit&, int) const { return 0u; }
};
template <int NN, int K, bool GATHER> struct SchedMoe {
    const char* A; const char* B; size_t bexp; const unsigned* list; volatile LAS int* tab; int G, c;
    __device__ __forceinline__ bool next(int i, pg8::Unit& u) const {
        const int L = i * G + c; const int tot = __builtin_amdgcn_readfirstlane(tab[48]) * NN; if (L >= tot) return false;
        u.pm = L / NN; u.pn = L % NN; int e = 0;
#pragma unroll
        for (int j = 0; j < 16; ++j) e += (u.pm >= tab[32 + j]) ? 1 : 0;
        e = __builtin_amdgcn_readfirstlane(e);
        u.aux = e; u.r0 = (u.pm - __builtin_amdgcn_readfirstlane(tab[16 + e])) * 256; u.cnt = __builtin_amdgcn_readfirstlane(tab[e]); return true; }
    __device__ __forceinline__ const char* a_base(const pg8::Unit& u) const { return GATHER ? A : A + (size_t)u.pm * 256 * K * 2; }
    __device__ __forceinline__ const char* b_base(const pg8::Unit& u) const { return B + (size_t)u.aux * bexp + (size_t)u.pn * 256 * K * 2; }
    __device__ __forceinline__ unsigned a_row_off(const pg8::Unit& u, int r) const {
        const int idx = u.r0 + r; unsigned tok = 0u;
        if (idx < u.cnt) tok = list[(size_t)u.aux * M + idx] >> 1;
        return tok * (unsigned)(K * 2); }
};

using pg8::f32x4;
using pg8::Unit;
__device__ __forceinline__ v4u pack8(f32x4 v0, f32x4 v1) { v4u w; w.x = pg8::cvt_pk_bf16(v0[0], v0[1]); w.y = pg8::cvt_pk_bf16(v0[2], v0[3]); w.z = pg8::cvt_pk_bf16(v1[0], v1[1]); w.w = pg8::cvt_pk_bf16(v1[2], v1[3]); return w; }

struct EpiLora {
    static constexpr bool PERM = true;
    bf16* LW;
    __device__ __forceinline__ void operator()(const f32x4 (&acc)[2][2][4][2], const Unit& u, int wr, int wc, int fr, int fq) const {
        { int l_; asm volatile("v_mbcnt_lo_u32_b32 %0, -1, 0\n\tv_mbcnt_hi_u32_b32 %0, -1, %0" : "=v"(l_)); fr = l_ & 15; fq = l_ >> 4; }
        const int g = u.aux, width = g == 2 ? DG : DW; bf16* out = LW + (size_t)g * (1u << 20);
        const int row0 = u.pm * 256 + wr * 64 + fr;
#pragma unroll
        for (int bj = 0; bj < 2; ++bj) { const int col0 = bj * 128 + wc * 32 + 8 * fq; if (col0 < width) {
#pragma unroll
            for (int ai = 0; ai < 2; ++ai)
#pragma unroll
                for (int m = 0; m < 4; ++m) { f32x4 v0 = acc[ai][bj][m][0], v1 = acc[ai][bj][m][1];
                    if (g == 0) {
#pragma unroll
                        for (int q = 0; q < 4; ++q) { v0[q] = tanhf(v0[q]); v1[q] = tanhf(v1[q]); } }
                    else if (g == 2) {
#pragma unroll
                        for (int q = 0; q < 4; ++q) { v0[q] = sigmoidf_(v0[q]); v1[q] = sigmoidf_(v1[q]); } }
                    *(GAS v4u*)(out + (size_t)(row0 + ai * 128 + m * 16) * width + col0) = pack8(v0, v1); } } }
    }
};
struct EpiSplit3 {
    static constexpr bool PERM = true;
    bf16* O0; bool bycol; const float* rowscale;
    __device__ __forceinline__ void operator()(const f32x4 (&acc)[2][2][4][2], const Unit& u, int wr, int wc, int fr, int fq) const {
        { int l_; asm volatile("v_mbcnt_lo_u32_b32 %0, -1, 0\n\tv_mbcnt_hi_u32_b32 %0, -1, %0" : "=v"(l_)); fr = l_ & 15; fq = l_ >> 4; }
        const int g = bycol ? (u.pn >> 2) : u.aux, pn = bycol ? (u.pn & 3) : u.pn; bf16* out = O0 + (size_t)g * ((size_t)M * C);
        const int row0 = u.pm * 256 + wr * 64 + fr, col0 = pn * 256 + wc * 32 + 8 * fq;
#pragma unroll
        for (int ai = 0; ai < 2; ++ai)
#pragma unroll
            for (int m = 0; m < 4; ++m)
                { const float sc = rowscale ? rowscale[row0 + ai * 128 + m * 16] : 1.0f;
#pragma unroll
                for (int bj = 0; bj < 2; ++bj) *(GAS v4u*)(out + (size_t)(row0 + ai * 128 + m * 16) * C + col0 + bj * 128) = pack8(acc[ai][bj][m][0] * sc, acc[ai][bj][m][1] * sc); }
    }
};
template <bool BASE_F32> struct EpiResidBf {
    static constexpr bool PERM = true;
    const void* base; bf16* out;
    __device__ __forceinline__ void operator()(const f32x4 (&acc)[2][2][4][2], const Unit& u, int wr, int wc, int fr, int fq) const {
        { int l_; asm volatile("v_mbcnt_lo_u32_b32 %0, -1, 0\n\tv_mbcnt_hi_u32_b32 %0, -1, %0" : "=v"(l_)); fr = l_ & 15; fq = l_ >> 4; }
        const int row0 = u.pm * 256 + wr * 64 + fr, col0 = u.pn * 256 + wc * 32 + 8 * fq;
#pragma unroll
        for (int ai = 0; ai < 2; ++ai)
#pragma unroll
            for (int m = 0; m < 4; ++m) { const size_t off = (size_t)(row0 + ai * 128 + m * 16) * C + col0;
#pragma unroll
                for (int bj = 0; bj < 2; ++bj) { f32x4 b0, b1;
                    if (BASE_F32) { b0 = *(const GAS f32x4*)((const float*)base + off + bj * 128); b1 = *(const GAS f32x4*)((const float*)base + off + bj * 128 + 4); }
                    else { const v4u w = *(const GAS v4u*)((const bf16*)base + off + bj * 128); b0 = (f32x4){bflo(w.x), bfhi(w.x), bflo(w.y), bfhi(w.y)}; b1 = (f32x4){bflo(w.z), bfhi(w.z), bflo(w.w), bfhi(w.w)}; }
                    *(GAS v4u*)(out + off + bj * 128) = pack8(b0 + acc[ai][bj][m][0], b1 + acc[ai][bj][m][1]); }
                asm volatile("" ::: "memory"); }
    }
};
struct EpiGU {
    static constexpr bool PERM = true;
    bf16* HID; const float* wl; const float* rsl;
    __device__ __forceinline__ void operator()(const f32x4 (&acc)[2][2][4][2], const Unit& u, int wr, int wc, int fr, int fq) const {
        { int l_; asm volatile("v_mbcnt_lo_u32_b32 %0, -1, 0\n\tv_mbcnt_hi_u32_b32 %0, -1, %0" : "=v"(l_)); fr = l_ & 15; fq = l_ >> 4; }
        const int e = u.aux, cnt = u.cnt, base = u.r0, r0 = wr * 64 + fr, col0 = u.pn * 128 + wc * 32 + 8 * fq;
#pragma unroll
        for (int ai = 0; ai < 2; ++ai)
#pragma unroll
            for (int m = 0; m < 4; ++m) { const int r = r0 + ai * 128 + m * 16, idx = base + r; float w = 0.f, rs = 0.f; if (idx < cnt) { w = wl[(size_t)e * M + idx]; rs = rsl[(size_t)e * M + idx]; }
                f32x4 h0, h1;
#pragma unroll
                for (int q = 0; q < 4; ++q) { const float g0 = acc[ai][0][m][0][q] * rs, g1 = acc[ai][0][m][1][q] * rs;
                    h0[q] = g0 * sigmoidf_(g0) * (acc[ai][1][m][0][q] * rs) * w; h1[q] = g1 * sigmoidf_(g1) * (acc[ai][1][m][1][q] * rs) * w; }
                *(GAS v4u*)(HID + (size_t)(u.pm * 256 + r) * FE + col0) = pack8(h0, h1);
                asm volatile("" ::: "memory"); }
    }
};
struct EpiDown {
    static constexpr bool PERM = true;
    bf16* EO; const unsigned* list;
    __device__ __forceinline__ void operator()(const f32x4 (&acc)[2][2][4][2], const Unit& u, int wr, int wc, int fr, int fq) const {
        { int l_; asm volatile("v_mbcnt_lo_u32_b32 %0, -1, 0\n\tv_mbcnt_hi_u32_b32 %0, -1, %0" : "=v"(l_)); fr = l_ & 15; fq = l_ >> 4; }
        const int e = u.aux, cnt = u.cnt, base = u.r0, r0 = wr * 64 + fr, col0 = u.pn * 256 + wc * 32 + 8 * fq;
#pragma unroll
        for (int ai = 0; ai < 2; ++ai)
#pragma unroll
            for (int m = 0; m < 4; ++m) { const int idx = base + r0 + ai * 128 + m * 16;
                if (idx < cnt) { const unsigned ent = list[(size_t)e * M + idx]; bf16* o = EO + ((size_t)(ent & 1u) * M + (ent >> 1)) * C + col0;
#pragma unroll
                    for (int bj = 0; bj < 2; ++bj) *(GAS v4u*)(o + bj * 128) = pack8(acc[ai][bj][m][0], acc[ai][bj][m][1]); }
                asm volatile("" ::: "memory"); }
    }
};

typedef short bf16x8s __attribute__((ext_vector_type(8)));
typedef short bf16x4s __attribute__((ext_vector_type(4)));
typedef short v4i16_t __attribute__((ext_vector_type(4)));
constexpr int TPB = 144;
constexpr int TILE_B = 64 * TPB;
constexpr int FP = 68;
constexpr int CS_FA = 0, CS_FB = 16384, CS_TILES = 32768, CS_TOT = CS_TILES + 12 * TILE_B, CS_WL = CS_TOT + 2048, CS_PAR = CS_WL + 256;
static_assert(CS_PAR + 768 <= LDSCTL_OFF, "scan LDS map");
#define TILE(n) (lds + CS_TILES + (n) * TILE_B)
#define F4Z (f32x4){0.f, 0.f, 0.f, 0.f}
__device__ __forceinline__ bf16x8s ldfrag(const LAS unsigned char* tile, int row, int kcol) { return *(const LAS bf16x8s*)(tile + row * TPB + kcol * 2); }
__device__ __forceinline__ bf16x8s ldfrag_tr(const LAS unsigned char* tile, int n0, int k0, int lane) {
    const int g = lane >> 4, q = (lane & 15) >> 2, p = lane & 3;
    const LAS unsigned char* a = tile + (k0 + 8 * g + q) * TPB + (n0 + 4 * p) * 2;
    const v4i16_t lo = __builtin_amdgcn_ds_read_tr16_b64_v4i16((LAS v4i16_t*)a), hi = __builtin_amdgcn_ds_read_tr16_b64_v4i16((LAS v4i16_t*)(a + 4 * TPB));
    return (bf16x8s){lo[0], lo[1], lo[2], lo[3], hi[0], hi[1], hi[2], hi[3]};
}
__device__ __forceinline__ bf16x8s ldfrag_perm(const LAS unsigned char* tile, int row, int ks, int g) {
    const bf16x4s lo = *(const LAS bf16x4s*)(tile + row * TPB + (32 * ks + 4 * g) * 2), hi = *(const LAS bf16x4s*)(tile + row * TPB + (32 * ks + 16 + 4 * g) * 2);
    return (bf16x8s){lo[0], lo[1], lo[2], lo[3], hi[0], hi[1], hi[2], hi[3]};
}
__device__ __forceinline__ void lds_barrier() { asm volatile("s_waitcnt lgkmcnt(0)" ::: "memory"); __builtin_amdgcn_s_barrier(); asm volatile("" ::: "memory"); }
#define MFMA16(a, b, c) __builtin_amdgcn_mfma_f32_16x16x32_bf16((a), (b), (c), 0, 0, 0)
__device__ __forceinline__ void mm64(f32x4 (&acc)[2], const LAS unsigned char* At, const LAS unsigned char* Bt, int rt, int ch, int fr, int g) {
#pragma unroll
    for (int ks = 0; ks < 2; ++ks) { const bf16x8s a = ldfrag(At, 16 * rt + fr, 32 * ks + 8 * g);
#pragma unroll
        for (int ct = 0; ct < 2; ++ct) acc[ct] = MFMA16(a, ldfrag(Bt, 32 * ch + 16 * ct + fr, 32 * ks + 8 * g), acc[ct]); }
}
__device__ __forceinline__ void mm64_bt(f32x4 (&acc)[2], const LAS unsigned char* At, const LAS unsigned char* X, int rt, int ch, int fr, int g, int lane) {
#pragma unroll
    for (int ks = 0; ks < 2; ++ks) { const bf16x8s a = ldfrag(At, 16 * rt + fr, 32 * ks + 8 * g);
#pragma unroll
        for (int ct = 0; ct < 2; ++ct) acc[ct] = MFMA16(a, ldfrag_tr(X, 32 * ch + 16 * ct, 32 * ks, lane), acc[ct]); }
}
__device__ __forceinline__ void mm64_at(f32x4 (&acc)[2], const LAS unsigned char* Xa, const LAS unsigned char* Bt, int rt, int ch, int fr, int g, int lane) {
#pragma unroll
    for (int ks = 0; ks < 2; ++ks) { const bf16x8s a = ldfrag_tr(Xa, 16 * rt, 32 * ks, lane);
#pragma unroll
        for (int ct = 0; ct < 2; ++ct) acc[ct] = MFMA16(a, ldfrag(Bt, 32 * ch + 16 * ct + fr, 32 * ks + 8 * g), acc[ct]); }
}
__device__ __forceinline__ void mm64_att(f32x4 (&acc)[2], const LAS unsigned char* Xa, const LAS unsigned char* X, int rt, int ch, int lane) {
#pragma unroll
    for (int ks = 0; ks < 2; ++ks) { const bf16x8s a = ldfrag_tr(Xa, 16 * rt, 32 * ks, lane);
#pragma unroll
        for (int ct = 0; ct < 2; ++ct) acc[ct] = MFMA16(a, ldfrag_tr(X, 32 * ch + 16 * ct, 32 * ks, lane), acc[ct]); }
}
__device__ __forceinline__ bf16x4s pack4(f32x4 v) { v2u w; w.x = pg8::cvt_pk_bf16(v[0], v[1]); w.y = pg8::cvt_pk_bf16(v[2], v[3]); return __builtin_bit_cast(bf16x4s, w); }
__device__ __forceinline__ f32x4 unpack4(bf16x4s s) { const v2u w = __builtin_bit_cast(v2u, s); return (f32x4){bflo(w.x), bfhi(w.x), bflo(w.y), bfhi(w.y)}; }
__device__ __forceinline__ void st_tr(LAS unsigned char* Out, const f32x4 (&acc)[2], int rt, int ch, int fr, int g) {
#pragma unroll
    for (int ct = 0; ct < 2; ++ct) *(LAS bf16x4s*)(Out + (32 * ch + 16 * ct + fr) * TPB + (16 * rt + 4 * g) * 2) = pack4(acc[ct]);
}
__device__ __forceinline__ void ld_tr(f32x4 (&acc)[2], const LAS unsigned char* In, int rt, int ch, int fr, int g) {
#pragma unroll
    for (int ct = 0; ct < 2; ++ct) acc[ct] = unpack4(*(const LAS bf16x4s*)(In + (32 * ch + 16 * ct + fr) * TPB + (16 * rt + 4 * g) * 2));
}
__device__ __forceinline__ void unpack8(v4u w, float (&o)[8]) { o[0] = bflo(w.x); o[1] = bfhi(w.x); o[2] = bflo(w.y); o[3] = bfhi(w.y); o[4] = bflo(w.z); o[5] = bfhi(w.z); o[6] = bflo(w.w); o[7] = bfhi(w.w); }
__device__ __forceinline__ v4u pack8f(const float (&o)[8]) { v4u w; w.x = pg8::cvt_pk_bf16(o[0], o[1]); w.y = pg8::cvt_pk_bf16(o[2], o[3]); w.z = pg8::cvt_pk_bf16(o[4], o[5]); w.w = pg8::cvt_pk_bf16(o[6], o[7]); return w; }

struct FrontIn { v4u r, k, v; bf16x8s fw[2], fa[2]; };
__device__ __forceinline__ void front_fetch(FrontIn& f, unsigned char* ws, int unit, int tid, int lane, int wave) {
    const int h = unit & 15, c = (unit >> 4) & 127, b = unit >> 11; const size_t row0 = (size_t)b * SEQ + c * 64;
    const int rt = wave & 3, fr = lane & 15, g = lane >> 4, t = tid >> 3, cq = tid & 7, c0 = h * HD + cq * 8;
    const bf16* Rb = (const bf16*)(ws + WS_B1); const bf16* Kb = (const bf16*)(ws + WS_B2); const bf16* Vb = (const bf16*)(ws + WS_B3);
    const bf16* LW = (const bf16*)(ws + WS_LW); const bf16* LA = (const bf16*)(ws + WS_LA);
    f.r = *(const GAS v4u*)(Rb + (row0 + t) * C + c0); f.k = *(const GAS v4u*)(Kb + (row0 + t) * C + c0); f.v = *(const GAS v4u*)(Vb + (row0 + t) * C + c0);
#pragma unroll
    for (int ks = 0; ks < 2; ++ks) { f.fw[ks] = *(const GAS bf16x8s*)(LW + (row0 + 16 * rt + fr) * DW + 32 * ks + 8 * g); f.fa[ks] = *(const GAS bf16x8s*)(LA + (row0 + 16 * rt + fr) * DA + 32 * ks + 8 * g); }
}
__device__ __forceinline__ v4u head_consts(unsigned char* ws, LAS unsigned char* lds, int h, int tid, int wtile, int atile) {
    const bf16* W2T = (const bf16*)(ws + WS_WT_W2); const bf16* A2T = (const bf16*)(ws + WS_WT_A2);
    const int row = tid >> 3, cq = tid & 7;
    const v4u w2chunk = *(const GAS v4u*)(W2T + (size_t)(h * HD + row) * 64 + cq * 8);
    *(LAS v4u*)(lds + CS_TILES + wtile * TILE_B + row * TPB + cq * 16) = w2chunk;
    *(LAS v4u*)(lds + CS_TILES + atile * TILE_B + row * TPB + cq * 16) = *(const GAS v4u*)(A2T + (size_t)(h * HD + row) * 64 + cq * 8);
    if (tid < 64) { LAS float* P = (LAS float*)(lds + CS_PAR); P[tid] = INP(15)[h * HD + tid]; P[64 + tid] = INP(16)[h * HD + tid]; P[128 + tid] = INP(17)[h * HD + tid]; }
    __syncthreads();
    return w2chunk;
}
template <int MODE>
__device__ __forceinline__ void chunk_front(const FrontIn& f, LAS unsigned char* lds, const float (&w0v)[2], const float (&a0v)[2], const bf16x8s (&w2f)[2][2], const bf16x8s (&a2f)[2][2], int tid, int lane, int wave, float (&v8)[8], float& rkb) {
    const int rt = wave & 3, ch = wave >> 2, fr = lane & 15, g = lane >> 4;
    LAS float* FA = (LAS float*)(lds + CS_FA); LAS float* FB = (LAS float*)(lds + CS_FB); LAS float* TOT = (LAS float*)(lds + CS_TOT);
    const int t = tid >> 3, cq = tid & 7;
    {
        f32x4 aw[2] = {F4Z, F4Z}, aa[2] = {F4Z, F4Z};
#pragma unroll
        for (int ks = 0; ks < 2; ++ks)
#pragma unroll
            for (int ct = 0; ct < 2; ++ct) { aw[ct] = MFMA16(f.fw[ks], w2f[ks][ct], aw[ct]); aa[ct] = MFMA16(f.fa[ks], a2f[ks][ct], aa[ct]); }
#pragma unroll
        for (int ct = 0; ct < 2; ++ct) { const int j = 32 * ch + 16 * ct + fr, js = j ^ ((g & 1) << 4); const float w0 = w0v[ct], a0 = a0v[ct];
            float p[4];
#pragma unroll
            for (int q = 0; q < 4; ++q) { p[q] = -0.6065306597126334f * sigmoidf_(w0 + aw[ct][q]); if (q) p[q] += p[q - 1]; }
            const float s_ = p[3];
            const float u1 = __int_as_float(__builtin_amdgcn_ds_bpermute(((lane - 16) & 63) << 2, __float_as_int(s_))); const float t1 = s_ + (g >= 1 ? u1 : 0.f);
            const float u2 = __int_as_float(__builtin_amdgcn_ds_bpermute(((lane - 32) & 63) << 2, __float_as_int(t1))); const float t2 = t1 + (g >= 2 ? u2 : 0.f);
            const float ex = t2 - s_;
#pragma unroll
            for (int q = 0; q < 4; ++q) { const int tt = 16 * rt + 4 * g + q; FA[tt * 64 + js] = p[q] + ex; FB[tt * 64 + js] = sigmoidf_(a0 + aa[ct][q]); }
            if (g == 3) TOT[rt * 64 + j] = t2; }
    }
    lds_barrier();
    {
        float r[8], k[8], pkk[8], pka[8], prk[8];
        unpack8(f.r, r); unpack8(f.k, k); unpack8(f.v, v8);
        { const LAS float* P = (const LAS float*)(lds + CS_PAR) + cq * 8; const f32x4 a0_ = *(const LAS f32x4*)P, a1_ = *(const LAS f32x4*)(P + 4), b0_ = *(const LAS f32x4*)(P + 64), b1_ = *(const LAS f32x4*)(P + 68), c0_ = *(const LAS f32x4*)(P + 128), c1_ = *(const LAS f32x4*)(P + 132);
#pragma unroll
          for (int q = 0; q < 4; ++q) { pkk[q] = a0_[q]; pkk[4 + q] = a1_[q]; pka[q] = b0_[q]; pka[4 + q] = b1_[q]; prk[q] = c0_[q]; prk[4 + q] = c1_[q]; } }
        float cw[8], cwp[8], ag[8];
        { const int tp = t > 0 ? t - 1 : 0, rtt = wave >> 1;
          const int ct_ = (cq ^ (((t >> 2) & 1) << 1)) * 8, cp_ = (cq ^ (((tp >> 2) & 1) << 1)) * 8;
          const f32x4 c0_ = *(const LAS f32x4*)(FA + t * 64 + ct_), c1_ = *(const LAS f32x4*)(FA + t * 64 + ct_ + 4), p0_ = *(const LAS f32x4*)(FA + tp * 64 + cp_), p1_ = *(const LAS f32x4*)(FA + tp * 64 + cp_ + 4);
          const f32x4 g0_ = *(const LAS f32x4*)(FB + t * 64 + ct_), g1_ = *(const LAS f32x4*)(FB + t * 64 + ct_ + 4);
          f32x4 o0_ = F4Z, o1_ = F4Z, l0_ = F4Z, l1_ = F4Z;
          for (int r_ = 0; r_ < rtt; ++r_) { l0_ = *(const LAS f32x4*)(TOT + r_ * 64 + cq * 8); l1_ = *(const LAS f32x4*)(TOT + r_ * 64 + cq * 8 + 4); o0_ = o0_ + l0_; o1_ = o1_ + l1_; }
          const bool first = (t & 15) == 0;
#pragma unroll
          for (int q = 0; q < 4; ++q) { cw[q] = c0_[q] + o0_[q]; cw[4 + q] = c1_[q] + o1_[q];
              cwp[q] = t > 0 ? p0_[q] + o0_[q] - (first ? l0_[q] : 0.f) : 0.f; cwp[4 + q] = t > 0 ? p1_[q] + o1_[q] - (first ? l1_[q] : 0.f) : 0.f; ag[q] = g0_[q]; ag[4 + q] = g1_[q]; } }
        float kk[8], ss = 0.f; rkb = 0.f;
#pragma unroll
        for (int q = 0; q < 8; ++q) { kk[q] = k[q] * pkk[q]; ss += kk[q] * kk[q]; }
        ss = sum8(ss);
        const float inv = 1.0f / fmaxf(sqrtf(ss), 1e-12f);
        float at[8], bt[8], kt[8], rt_[8];
#pragma unroll
        for (int q = 0; q < 8; ++q) { const float kn = kk[q] * inv, kp = k[q] * (1.0f + (ag[q] - 1.0f) * pka[q]);
            const float ein = __expf(-cw[q]);
            at[q] = -kn * __expf(cwp[q]); bt[q] = kn * ag[q] * ein; kt[q] = kp * ein;
            rt_[q] = r[q] * __expf(cw[q]); rkb += r[q] * kp * prk[q]; }
        rkb = sum8(rkb);
        *(LAS v4u*)(TILE(0) + t * TPB + cq * 16) = pack8f(at); *(LAS v4u*)(TILE(1) + t * TPB + cq * 16) = pack8f(bt); *(LAS v4u*)(TILE(2) + t * TPB + cq * 16) = pack8f(kt);
        *(LAS v4u*)(TILE(3) + t * TPB + cq * 16) = f.v;
        *(LAS v4u*)(TILE(6) + t * TPB + cq * 16) = pack8f(rt_);
        if (MODE == 1 && t == 63) {
#pragma unroll
            for (int q = 0; q < 8; ++q) ((LAS float*)(lds + CS_WL))[cq * 8 + q] = __expf(cw[q]); }
    }
    lds_barrier();
}

__device__ __forceinline__ void scan_s1(unsigned char* ws, LAS unsigned char* lds, int lane0, int wave) {
    const int rt = wave & 3, ch = wave >> 2;
    FrontIn fin; float w0v[2], a0v[2]; bf16x8s w2f[2][2], a2f[2][2];
    { int l0 = lane0; asm volatile("" : "+v"(l0)); const int hh = blockIdx.x & 15;
      if ((int)blockIdx.x < BATCH * NH * (SEQ / 64)) front_fetch(fin, ws, blockIdx.x, wave * 64 + l0, l0, wave);
      const bf16* W2T = (const bf16*)(ws + WS_WT_W2); const bf16* A2T = (const bf16*)(ws + WS_WT_A2);
#pragma unroll
      for (int ct = 0; ct < 2; ++ct) { w0v[ct] = INP(7)[hh * HD + 32 * ch + 16 * ct + (l0 & 15)]; a0v[ct] = INP(10)[hh * HD + 32 * ch + 16 * ct + (l0 & 15)];
#pragma unroll
          for (int ks = 0; ks < 2; ++ks) { const size_t wr_ = (size_t)(hh * HD + 32 * ch + 16 * ct + (l0 & 15)) * 64 + 32 * ks + 8 * (l0 >> 4); w2f[ks][ct] = *(const GAS bf16x8s*)(W2T + wr_); a2f[ks][ct] = *(const GAS bf16x8s*)(A2T + wr_); } }
      const int tid0 = wave * 64 + l0;
      if (tid0 < 64) { LAS float* P = (LAS float*)(lds + CS_PAR); P[tid0] = INP(15)[hh * HD + tid0]; P[64 + tid0] = INP(16)[hh * HD + tid0]; P[128 + tid0] = INP(17)[hh * HD + tid0]; }
      __syncthreads(); }
    for (int unit = blockIdx.x; unit < BATCH * NH * (SEQ / 64); unit += gridDim.x) {
        int lane = lane0; asm volatile("" : "+v"(lane));
        const int tid = wave * 64 + lane, fr = lane & 15, g = lane >> 4;
        const int h = unit & 15, c = (unit >> 4) & 127, b = unit >> 11; const size_t chunk = ((size_t)b * NH + h) * 128 + c;
        float v8[8]; float rkb;
        chunk_front<1>(fin, lds, w0v, a0v, w2f, a2f, tid, lane, wave, v8, rkb);
        { const size_t row0_ = (size_t)b * SEQ + c * 64; if ((tid & 7) == 0) ((float*)(ws + WS_HID))[(row0_ + (tid >> 3)) * NH + h] = rkb; }
        if (unit + (int)gridDim.x < BATCH * NH * (SEQ / 64)) front_fetch(fin, ws, unit + gridDim.x, tid, lane, wave);
        {
            f32x4 a2[2] = {F4Z, F4Z}, a3[2] = {F4Z, F4Z};
            mm64(a2, TILE(1), TILE(0), rt, ch, fr, g);
            mm64(a3, TILE(2), TILE(0), rt, ch, fr, g);
            f32x4 p1[2];
#pragma unroll
            for (int ct = 0; ct < 2; ++ct) { const int col = 32 * ch + 16 * ct + fr;
#pragma unroll
                for (int q = 0; q < 4; ++q) { const int row = 16 * rt + 4 * g + q;
                    a2[ct][q] = row < col ? a2[ct][q] : 0.f;
                    p1[ct][q] = a2[ct][q] + (row == col ? 1.0f : 0.f);
                    a3[ct][q] = row < col ? a3[ct][q] : 0.f; } }
            st_tr(TILE(5), a2, rt, ch, fr, g);
            st_tr(TILE(9), p1, rt, ch, fr, g);
            st_tr(TILE(4), a3, rt, ch, fr, g);
        }
        lds_barrier();
#pragma unroll
        for (int r = 0; r < 6; ++r) {
            LAS unsigned char* Sr = TILE(5 + 2 * (r & 1)); LAS unsigned char* Sr2 = TILE(5 + 2 * ((r & 1) ^ 1));
            if (r <= 4) { f32x4 q2[2] = {F4Z, F4Z};
                mm64_at(q2, Sr, Sr, rt, ch, fr, g, lane);
                st_tr(Sr2, q2, rt, ch, fr, g); }
            if (r >= 1) { LAS unsigned char* Pr = TILE(9 + ((r - 1) & 1)); LAS unsigned char* Pr2 = TILE(9 + (((r - 1) & 1) ^ 1));
                f32x4 pa[2]; ld_tr(pa, Pr, rt, ch, fr, g);
                mm64_at(pa, Sr, Pr, rt, ch, fr, g, lane);
                st_tr(Pr2, pa, rt, ch, fr, g); }
            if (r == 0) { f32x4 gg[2] = {F4Z, F4Z};
                mm64_bt(gg, TILE(4), TILE(3), rt, ch, fr, g, lane);
                st_tr(TILE(11), gg, rt, ch, fr, g); }
            lds_barrier();
        }
        {
            f32x4 acc[2] = {F4Z, F4Z}, ac2[2] = {F4Z, F4Z};
            mm64_bt(acc, TILE(10), TILE(0), rt, ch, fr, g, lane);
            mm64(ac2, TILE(10), TILE(11), rt, ch, fr, g);
            st_tr(TILE(5), acc, rt, ch, fr, g); st_tr(TILE(7), ac2, rt, ch, fr, g);
            f32x4 b2[2] = {F4Z, F4Z}, b3[2] = {F4Z, F4Z};
            mm64(b2, TILE(1), TILE(6), rt, ch, fr, g); mm64(b3, TILE(2), TILE(6), rt, ch, fr, g);
#pragma unroll
            for (int ct = 0; ct < 2; ++ct) { const int t = 32 * ch + 16 * ct + fr;
#pragma unroll
                for (int q = 0; q < 4; ++q) { const int s_ = 16 * rt + 4 * g + q; b2[ct][q] = s_ <= t ? b2[ct][q] : 0.f; b3[ct][q] = s_ <= t ? b3[ct][q] : 0.f; } }
            st_tr(TILE(4), b2, rt, ch, fr, g); st_tr(TILE(9), b3, rt, ch, fr, g);
        }
        lds_barrier();
        {
            const LAS float* WL = (const LAS float*)(lds + CS_WL);
            f32x4 acc[2] = {F4Z, F4Z};
            mm64_bt(acc, TILE(5), TILE(1), rt, ch, fr, g, lane);
            bf16* Mg = (bf16*)(ws + WS_B0) + chunk * 4096;
#pragma unroll
            for (int ct = 0; ct < 2; ++ct) { const int j1 = 32 * ch + 16 * ct + fr; const float wl = WL[j1];
#pragma unroll
                for (int q = 0; q < 4; ++q) { const int j2 = 16 * rt + 4 * g + q; acc[ct][q] = wl * (acc[ct][q] + (j2 == j1 ? 1.0f : 0.f)); }
                const int rtS = 2 * ch + ct, ksS = rt >> 1, half = rt & 1;
                *(GAS bf16x4s*)(Mg + (((rtS * 2 + ksS) * 64 + g * 16 + fr) * 8 + half * 4)) = pack4(acc[ct]); }
            f32x4 ad[2] = {F4Z, F4Z};
            mm64_at(ad, TILE(1), TILE(7), rt, ch, fr, g, lane);
            mm64_att(ad, TILE(2), TILE(3), rt, ch, lane);
            const f32x4 wl4 = *(const LAS f32x4*)(WL + 16 * rt + 4 * g);
            bf16* Dg = (bf16*)OUTP() + chunk * 4096;
#pragma unroll
            for (int ct = 0; ct < 2; ++ct) *(GAS bf16x4s*)(Dg + (((2 * ch + ct) * 4 + rt) * 64 + lane) * 4) = pack4(ad[ct] * wl4);
            const size_t row0_ = (size_t)b * SEQ + c * 64;
            f32x4 ar[2]; ld_tr(ar, TILE(6), rt, ch, fr, g);
            mm64(ar, TILE(5), TILE(4), rt, ch, fr, g);
            f32x4 ay[2] = {F4Z, F4Z};
            mm64(ay, TILE(7), TILE(4), rt, ch, fr, g); mm64_at(ay, TILE(3), TILE(9), rt, ch, fr, g, lane);
            bf16* Rg = (bf16*)(ws + WS_B1); bf16* Kg = (bf16*)(ws + WS_B2);
#pragma unroll
            for (int ct = 0; ct < 2; ++ct) { const size_t o_ = (row0_ + 32 * ch + 16 * ct + fr) * C + h * HD + 16 * rt + 4 * g; *(GAS bf16x4s*)(Rg + o_) = pack4(ar[ct]); *(GAS bf16x4s*)(Kg + o_) = pack4(ay[ct]); }
        }
        lds_barrier();
    }
}

constexpr int S2_PD = 6;
__device__ __forceinline__ void scan_s2(unsigned char* ws, LAS unsigned char* lds, int lane, int wave) {
    for (int bh = blockIdx.x; bh < BATCH * NH; bh += gridDim.x) {
        const unsigned char* Mg = (const unsigned char*)((const bf16*)(ws + WS_B0) + (size_t)bh * 128 * 4096); const unsigned char* Dg = (const unsigned char*)((const bf16*)OUTP() + (size_t)bh * 128 * 4096);
        bf16* Sg = (bf16*)OUTP() + (size_t)M * C + (size_t)bh * 128 * 4096;
        if (wave >= 4) {
            const int lw = wave - 4;
            const unsigned char* src = (lw < 2 ? Mg + lw * 4096 : Dg + (lw - 2) * 4096) + lane * 16;
            LAS unsigned char* dst = lds + lw * 4096 + lane * 16;
            v4u q[S2_PD][4];
#define S2_LOADQ(j, c) do { _Pragma("unroll") for (int i_ = 0; i_ < 4; ++i_) q[j][i_] = *(const GAS v4u*)(src + (size_t)(c) * 8192 + i_ * 1024); } while (0)
#define S2_STOREQ(j, slot) do { _Pragma("unroll") for (int i_ = 0; i_ < 4; ++i_) *(LAS v4u*)(dst + (slot) * 16384 + i_ * 1024) = q[j][i_]; } while (0)
#pragma unroll
            for (int j = 0; j < S2_PD; ++j) S2_LOADQ(j, j);
            S2_STOREQ(0, 0); S2_LOADQ(0, S2_PD);
            lds_barrier();
#pragma unroll 1
            for (int s0 = 0; s0 < 128; s0 += S2_PD) {
#pragma unroll
                for (int jj = 0; jj < S2_PD; ++jj) { const int step = s0 + jj;
                    if (step + 1 < 128) S2_STOREQ((jj + 1) % S2_PD, (step + 1) & 1);
                    if (step + 1 + S2_PD < 128) S2_LOADQ((jj + 1) % S2_PD, step + 1 + S2_PD);
                    lds_barrier(); }
            }
#undef S2_LOADQ
#undef S2_STOREQ
        } else {
            const int ct = wave;
            f32x4 acc[4];
#pragma unroll
            for (int r = 0; r < 4; ++r) acc[r] = F4Z;
            lds_barrier();
#pragma unroll 1
            for (int s0 = 0; s0 < 128; s0 += S2_PD) {
#pragma unroll
                for (int jj = 0; jj < S2_PD; ++jj) { const int step = s0 + jj;
                    if (step < 128) {
                        const LAS unsigned char* slot = lds + (step & 1) * 16384;
                        bf16x8s sf[2];
#pragma unroll
                        for (int ks = 0; ks < 2; ++ks) { const bf16x4s lo = pack4(acc[2 * ks]), hi = pack4(acc[2 * ks + 1]); sf[ks] = (bf16x8s){lo[0], lo[1], lo[2], lo[3], hi[0], hi[1], hi[2], hi[3]}; }
#pragma unroll
                        for (int ks = 0; ks < 2; ++ks) *(GAS bf16x8s*)(Sg + (size_t)step * 4096 + ((ct * 2 + ks) * 64 + lane) * 8) = sf[ks];
                        f32x4 na[4];
#pragma unroll
                        for (int r = 0; r < 4; ++r) na[r] = unpack4(*(const LAS bf16x4s*)(slot + 8192 + ((ct * 4 + r) * 64 + lane) * 8));
#pragma unroll
                        for (int ks = 0; ks < 2; ++ks)
#pragma unroll
                            for (int r = 0; r < 4; ++r) na[r] = MFMA16(*(const LAS bf16x8s*)(slot + ((r * 2 + ks) * 64 + lane) * 16), sf[ks], na[r]);
#pragma unroll
                        for (int r = 0; r < 4; ++r) acc[r] = na[r];
                    }
                    lds_barrier(); }
            }
        }
    }
}

constexpr int S3_RT = 32768, S3_YT = S3_RT + TILE_B, S3_LG = S3_YT + TILE_B, S3_LGP = 336;
struct S3In { v4u rr, yy, vv, lg[3]; bf16x8s sA[2]; float rkb; };
__device__ __forceinline__ void s3_fetch(S3In& f, unsigned char* ws, int unit, int tid, int lane, int wave) {
    const int h = unit & 15, c = (unit >> 4) & 127, b = unit >> 11; const size_t chunk = ((size_t)b * NH + h) * 128 + c, row0 = (size_t)b * SEQ + c * 64;
    const int rt = wave & 3, et = tid >> 3, ecq = tid & 7;
    const bf16* Rg = (const bf16*)(ws + WS_B1); const bf16* Kg = (const bf16*)(ws + WS_B2); const bf16* Vb = (const bf16*)(ws + WS_B3); const bf16* LG = (const bf16*)(ws + WS_LG);
    const bf16* Sg = (const bf16*)OUTP() + (size_t)M * C + chunk * 4096;
    const size_t o_ = (row0 + et) * C + h * HD + ecq * 8;
    f.rr = *(const GAS v4u*)(Rg + o_); f.yy = *(const GAS v4u*)(Kg + o_); f.vv = *(const GAS v4u*)(Vb + o_);
#pragma unroll
    for (int i = 0; i < 3; ++i) { const int chn = tid + 512 * i; if (chn < 64 * 20) f.lg[i] = *(const GAS v4u*)(LG + (row0 + chn / 20) * DG + (chn % 20) * 8); }
#pragma unroll
    for (int ks = 0; ks < 2; ++ks) f.sA[ks] = *(const GAS bf16x8s*)(Sg + ((rt * 2 + ks) * 64 + lane) * 8);
    f.rkb = ((const float*)(ws + WS_HID))[(row0 + et) * NH + h];
}
__device__ __forceinline__ void scan_s3(unsigned char* ws, LAS unsigned char* lds, int lane0, int wave) {
    const int rt = wave & 3, ch = wave >> 2;
    LAS float* Ys = (LAS float*)(lds + CS_FA);
    const bf16* G2T = (const bf16*)(ws + WS_WT_G2); bf16* YG = (bf16*)(ws + WS_B0);
    constexpr int NU = BATCH * NH * (SEQ / 64);
    S3In fin; bf16x8s gA[5]; f32x4 lnw0, lnw1, lnb0, lnb1;
    { int l0 = lane0; asm volatile("" : "+v"(l0)); const int hh = blockIdx.x & 15, t0_ = wave * 64 + l0;
      if ((int)blockIdx.x < NU) s3_fetch(fin, ws, blockIdx.x, t0_, l0, wave);
#pragma unroll
      for (int ks = 0; ks < 5; ++ks) gA[ks] = *(const GAS bf16x8s*)(G2T + (size_t)(hh * HD + 16 * rt + (l0 & 15)) * DG + 32 * ks + 8 * (l0 >> 4));
      const int ec0 = hh * HD + (t0_ & 7) * 8;
      lnw0 = *(const GAS f32x4*)(INP(18) + ec0); lnw1 = *(const GAS f32x4*)(INP(18) + ec0 + 4); lnb0 = *(const GAS f32x4*)(INP(19) + ec0); lnb1 = *(const GAS f32x4*)(INP(19) + ec0 + 4); }
    __syncthreads();
    for (int unit = blockIdx.x; unit < NU; unit += gridDim.x) {
        int lane = lane0; asm volatile("" : "+v"(lane));
        const int tid = wave * 64 + lane, fr = lane & 15, g = lane >> 4, et = tid >> 3, ecq = tid & 7;
        const int h = unit & 15, c = (unit >> 4) & 127, b = unit >> 11; const size_t row0 = (size_t)b * SEQ + c * 64;
        *(LAS v4u*)(lds + S3_RT + et * TPB + ecq * 16) = fin.rr; *(LAS v4u*)(lds + S3_YT + et * TPB + ecq * 16) = fin.yy;
#pragma unroll
        for (int i = 0; i < 3; ++i) { const int chn = tid + 512 * i; if (chn < 64 * 20) *(LAS v4u*)(lds + S3_LG + (chn / 20) * S3_LGP + (chn % 20) * 16) = fin.lg[i]; }
        float v8[8]; unpack8(fin.vv, v8); const float rkb = fin.rkb; const bf16x8s sA0 = fin.sA[0], sA1 = fin.sA[1];
        lds_barrier();
        if (unit + (int)gridDim.x < NU) s3_fetch(fin, ws, unit + gridDim.x, tid, lane, wave);
        f32x4 acc[2], ag[2] = {F4Z, F4Z};
#pragma unroll
        for (int ct = 0; ct < 2; ++ct) { const int t = 32 * ch + 16 * ct + fr;
            acc[ct] = unpack4(*(const LAS bf16x4s*)(lds + S3_YT + t * TPB + (16 * rt + 4 * g) * 2));
            acc[ct] = MFMA16(sA0, ldfrag_perm(lds + S3_RT, t, 0, g), acc[ct]); acc[ct] = MFMA16(sA1, ldfrag_perm(lds + S3_RT, t, 1, g), acc[ct]);
#pragma unroll
            for (int ks = 0; ks < 5; ++ks) ag[ct] = MFMA16(gA[ks], *(const LAS bf16x8s*)(lds + S3_LG + t * S3_LGP + (32 * ks + 8 * g) * 2), ag[ct]);
            *(LAS f32x4*)(Ys + t * FP + 16 * rt + 4 * g) = acc[ct]; }
        lds_barrier();
        {
            const f32x4 y0 = *(const LAS f32x4*)(Ys + et * FP + ecq * 8), y1 = *(const LAS f32x4*)(Ys + et * FP + ecq * 8 + 4);
            float y[8] = {y0[0], y0[1], y0[2], y0[3], y1[0], y1[1], y1[2], y1[3]};
            float s_ = 0.f;
#pragma unroll
            for (int q = 0; q < 8; ++q) s_ += y[q];
            s_ = sum8(s_);
            const float mu = s_ * (1.0f / HD); float vs = 0.f;
#pragma unroll
            for (int q = 0; q < 8; ++q) { y[q] -= mu; vs += y[q] * y[q]; }
            vs = sum8(vs);
            const float rstd = 1.0f / sqrtf(vs * (1.0f / HD) + GN_EPS);
            f32x4 o0, o1;
#pragma unroll
            for (int q = 0; q < 4; ++q) { o0[q] = y[q] * rstd * lnw0[q] + lnb0[q] + rkb * v8[q]; o1[q] = y[4 + q] * rstd * lnw1[q] + lnb1[q] + rkb * v8[4 + q]; }
            *(LAS f32x4*)(Ys + et * FP + ecq * 8) = o0; *(LAS f32x4*)(Ys + et * FP + ecq * 8 + 4) = o1;
        }
        lds_barrier();
#pragma unroll
        for (int ct = 0; ct < 2; ++ct) { const int t = 32 * ch + 16 * ct + fr; const f32x4 yv = *(const LAS f32x4*)(Ys + t * FP + 16 * rt + 4 * g);
            *(GAS bf16x4s*)(YG + (row0 + t) * C + h * HD + 16 * rt + 4 * g) = pack4(yv * ag[ct]); }
    }
    __syncthreads();
}
#undef TILE
#if MK_DEBUG
__device__ __forceinline__ void scan_naive(unsigned char* ws, LAS unsigned char* lds, int tid) {
    const int lane = tid & 63;
    const bf16* Rb = (const bf16*)(ws + WS_B1); const bf16* Kb = (const bf16*)(ws + WS_B2); const bf16* Vb = (const bf16*)(ws + WS_B3);
    const bf16* LW = (const bf16*)(ws + WS_LW); const bf16* LA = (const bf16*)(ws + WS_LA);
    float* Y = OUTP(); float* RK = (float*)(ws + WS_HID);
    LAS float* sR = (LAS float*)lds; LAS float* sK = sR + 4096; LAS float* sV = sK + 4096; LAS float* sA = sV + 4096; LAS float* sB = sA + 4096; LAS float* sD = sB + 4096;
    LAS float* sW2 = sD + 4096; LAS float* sA2 = sW2 + 4096;
    for (int unit = blockIdx.x; unit < BATCH * NH; unit += gridDim.x) {
        const int b = unit / NH, h = unit % NH;
        __syncthreads();
        for (int e = tid; e < 4096; e += 512) { const int d = e >> 6, j = e & 63; sW2[e] = INP(9)[(size_t)d * C + h * HD + j]; sA2[e] = INP(12)[(size_t)d * C + h * HD + j]; }
        __syncthreads();
        const int pt = tid >> 3, cq = tid & 7, c0 = h * HD + cq * 8;
        const int si = tid >> 3, jq = tid & 7;
        float S[8];
#pragma unroll
        for (int q = 0; q < 8; ++q) S[q] = 0.f;
        float w0v[8], a0v[8], kkv[8], kav[8], rkv[8];
#pragma unroll
        for (int q = 0; q < 8; ++q) { w0v[q] = INP(7)[c0 + q]; a0v[q] = INP(10)[c0 + q]; kkv[q] = INP(15)[c0 + q]; kav[q] = INP(16)[c0 + q]; rkv[q] = INP(17)[c0 + q]; }
        for (int blk = 0; blk < SEQ / 64; ++blk) {
            const size_t row = (size_t)b * SEQ + blk * 64 + pt;
            {
                const v4u r4 = *(const GAS v4u*)(Rb + row * C + c0), k4 = *(const GAS v4u*)(Kb + row * C + c0), v4 = *(const GAS v4u*)(Vb + row * C + c0);
                float r[8], k[8], v[8];
                r[0] = bflo(r4.x); r[1] = bfhi(r4.x); r[2] = bflo(r4.y); r[3] = bfhi(r4.y); r[4] = bflo(r4.z); r[5] = bfhi(r4.z); r[6] = bflo(r4.w); r[7] = bfhi(r4.w);
                k[0] = bflo(k4.x); k[1] = bfhi(k4.x); k[2] = bflo(k4.y); k[3] = bfhi(k4.y); k[4] = bflo(k4.z); k[5] = bfhi(k4.z); k[6] = bflo(k4.w); k[7] = bfhi(k4.w);
                v[0] = bflo(v4.x); v[1] = bfhi(v4.x); v[2] = bflo(v4.y); v[3] = bfhi(v4.y); v[4] = bflo(v4.z); v[5] = bfhi(v4.z); v[6] = bflo(v4.w); v[7] = bfhi(v4.w);
                float wp[8], ap[8];
#pragma unroll
                for (int q = 0; q < 8; ++q) { wp[q] = w0v[q]; ap[q] = a0v[q]; }
                for (int d = 0; d < 64; ++d) { const float lw = bf2f(LW[row * DW + d]), la = bf2f(LA[row * DA + d]);
#pragma unroll
                    for (int q = 0; q < 8; ++q) { wp[q] += lw * sW2[d * 64 + cq * 8 + q]; ap[q] += la * sA2[d * 64 + cq * 8 + q]; } }
                float kk[8], ss = 0.f, rks = 0.f;
#pragma unroll
                for (int q = 0; q < 8; ++q) { kk[q] = k[q] * kkv[q]; ss += kk[q] * kk[q]; }
                ss = sum8(ss);
                const float inv = 1.0f / fmaxf(sqrtf(ss), 1e-12f);
#pragma unroll
                for (int q = 0; q < 8; ++q) { const float ag = sigmoidf_(ap[q]); const float kn = kk[q] * inv; const float kp = k[q] * (1.0f + (ag - 1.0f) * kav[q]);
                    const float lw = -0.6065306597126334f * sigmoidf_(wp[q]);
                    const int o = pt * 64 + cq * 8 + q;
                    sR[o] = r[q]; sK[o] = kp; sV[o] = v[q]; sA[o] = -kn; sB[o] = kn * ag; sD[o] = __expf(lw); rks += r[q] * kp * rkv[q]; }
                rks = sum8(rks);
                if (cq == 0) RK[row * NH + h] = rks;
            }
            __syncthreads();
            for (int t = 0; t < 64; ++t) {
                const LAS f32x4* pa = (const LAS f32x4*)(sA + t * 64 + jq * 8); const LAS f32x4* pb = (const LAS f32x4*)(sB + t * 64 + jq * 8);
                const LAS f32x4* pd = (const LAS f32x4*)(sD + t * 64 + jq * 8); const LAS f32x4* pk = (const LAS f32x4*)(sK + t * 64 + jq * 8);
                const LAS f32x4* pr = (const LAS f32x4*)(sR + t * 64 + jq * 8);
                const f32x4 a0 = pa[0], a1 = pa[1], b0 = pb[0], b1 = pb[1], d0 = pd[0], d1 = pd[1], k0 = pk[0], k1 = pk[1], r0 = pr[0], r1 = pr[1];
                const float vi = sV[t * 64 + si];
                float sa = 0.f;
#pragma unroll
                for (int q = 0; q < 4; ++q) { sa += S[q] * a0[q]; sa += S[4 + q] * a1[q]; }
                sa = sum8(sa);
                float y = 0.f;
#pragma unroll
                for (int q = 0; q < 4; ++q) { S[q] = S[q] * d0[q] + sa * b0[q] + vi * k0[q]; S[4 + q] = S[4 + q] * d1[q] + sa * b1[q] + vi * k1[q]; y += S[q] * r0[q]; y += S[4 + q] * r1[q]; }
                y = sum8(y);
                if (jq == 0) Y[((size_t)b * SEQ + blk * 64 + t) * C + h * HD + si] = y;
            }
            __syncthreads();
        }
    }
}
__device__ __forceinline__ void post_scan(unsigned char* ws, int gw, int NGW, int lane) {
    const float* Y = OUTP(); const float* RK = (const float*)(ws + WS_HID); const bf16* Vb = (const bf16*)(ws + WS_B3); const bf16* LG = (const bf16*)(ws + WS_LG);
    bf16* YG = (bf16*)(ws + WS_B4); const float* g2 = INP(14); const float* lnw = INP(18); const float* lnb = INP(19);
    for (int it = gw; it < M * NH; it += NGW) {
        const int row = it / NH, h = it % NH, c = h * HD + lane;
        const float y = Y[(size_t)row * C + c];
        const float mu = wave_sum(y, lane) * (1.0f / HD); const float d = y - mu; const float var = wave_sum(d * d, lane) * (1.0f / HD);
        float o = d * (1.0f / sqrtf(var + GN_EPS)) * lnw[c] + lnb[c];
        o += RK[(size_t)row * NH + h] * bf2f(Vb[(size_t)row * C + c]);
        float g = 0.f;
        for (int dd = 0; dd < DG; ++dd) g += bf2f(LG[(size_t)row * DG + dd]) * g2[(size_t)dd * C + c];
        YG[(size_t)row * C + c] = (bf16)f2bf(o * g);
    }
}


constexpr int CW_DBG = 3200;
__device__ __forceinline__ void dbg_nonfinite(unsigned char* ws, const bf16* X, size_t n, int slot, int gw, int NGW, int lane, float thr = 1e30f) {
    unsigned* cw = (unsigned*)(ws + WS_CTL) + CW_DBG + 64 * slot; unsigned nnan = 0;
    for (size_t i = (size_t)gw * 64 + lane; i < n; i += (size_t)NGW * 64) { const float x = bf2f(X[i]); if (!(fabsf(x) < thr)) ++nnan; }
    if (nnan) atomicAdd(cw, nnan);
}
__device__ __forceinline__ void dbg_compare(unsigned char* ws, const bf16* X, const bf16* Y, int gw, int NGW, int lane) {
    unsigned* cw = (unsigned*)(ws + WS_CTL) + CW_DBG; unsigned nbad = 0, nnan = 0;
    for (size_t i = (size_t)gw * 64 + lane; i < (size_t)M * C; i += (size_t)NGW * 64) { const float x = bf2f(X[i]), y = bf2f(Y[i]);
        if (!(fabsf(x) < 1e30f)) ++nnan; else if (fabsf(x - y) > 0.05f * (fabsf(y) + 0.05f)) ++nbad; }
    if (nnan) atomicAdd(cw, nnan); if (nbad) atomicAdd(cw + 64, nbad);
}
#endif
__device__ __forceinline__ void router_rows(unsigned char* ws, LAS unsigned char* lds, int layer, int gw, int NGW, int lane, int tid, int wv, bool dry = false) {
    const bf16* Hh = (const bf16*)(ws + WS_B4); const float* gain = INP(2) + layer * C; float* rsl = (float*)(ws + WS_B0);
    const float* wg = INP(24) + (size_t)layer * C * 4; const float* bg = INP(25) + layer * 4; const float* wi = INP(26) + (size_t)layer * C * 16; const float* bi = INP(27) + layer * 16;
    unsigned* cnt = (unsigned*)(ws + WS_CTL) + CW_CNT + layer * 16 * 64; unsigned* list = (unsigned*)(ws + WS_LIST); float* wl = (float*)(ws + WS_WL);
    LAS float* sWg = (LAS float*)lds; LAS float* sWi = sWg + C * 4;
    constexpr int RECMAX = 256;
    LAS unsigned* lcnt = (LAS unsigned*)(lds + 81920); LAS unsigned* gbase = lcnt + 16; LAS float* sBias = (LAS float*)(lcnt + 32);
    LAS unsigned* recRow = lcnt + 64; LAS unsigned* recE = recRow + RECMAX; LAS unsigned* recL = recE + RECMAX; LAS float* recW0 = (LAS float*)(recL + RECMAX); LAS float* recW1 = recW0 + RECMAX; LAS float* recRS = recW1 + RECMAX;
    __syncthreads();
    for (int e = tid; e < C; e += 512) { const int r = e >> 6, c = 256 * (r >> 2) + 4 * (e & 63) + (r & 3); ((LAS f32x4*)sWg)[e] = ((const GAS f32x4*)wg)[c]; }
    for (int e = tid; e < C * 4; e += 512) { const int r = e >> 6, jq = r >> 2, c = 256 * (jq >> 2) + 4 * (e & 63) + (jq & 3); ((LAS f32x4*)sWi)[e] = ((const GAS f32x4*)wi)[c * 4 + (r & 3)]; }
    if (tid < 4) sBias[tid] = bg[tid]; else if (tid < 20) sBias[tid] = bi[tid - 4];
    for (int e = tid; e < RECMAX; e += 512) recE[e] = 0xffffffffu;
    __syncthreads();
    f32x4 g[4]; load_row(gain, lane, g);
    v2u nxr[2][4];
#pragma unroll
    for (int r = 0; r < 2; ++r) { const int r0 = gw + r * NGW < M - 1 ? gw + r * NGW : M - 1;
#pragma unroll
        for (int j = 0; j < 4; ++j) nxr[r][j] = ((const GAS v2u*)(Hh + (size_t)r0 * C))[64 * j + lane]; }
    int k = 0;
    for (int row = gw; row < M; row += 2 * NGW, k += 2) {
        f32x4 v[2][4];
#pragma unroll
        for (int r = 0; r < 2; ++r)
#pragma unroll
            for (int j = 0; j < 4; ++j) v[r][j] = (f32x4){bflo(nxr[r][j].x), bfhi(nxr[r][j].x), bflo(nxr[r][j].y), bfhi(nxr[r][j].y)};
#pragma unroll
        for (int r = 0; r < 2; ++r) { const int rn = row + (2 + r) * NGW, r0 = rn < M - 1 ? rn : M - 1;
#pragma unroll
            for (int j = 0; j < 4; ++j) nxr[r][j] = ((const GAS v2u*)(Hh + (size_t)r0 * C))[64 * j + lane]; }
        float rs[2];
#pragma unroll
        for (int r = 0; r < 2; ++r) { rs[r] = row_rs(v[r], lane);
#pragma unroll
            for (int j = 0; j < 4; ++j) v[r][j] = v[r][j] * rs[r] * g[j]; }
        float gl[2][4] = {{0.f, 0.f, 0.f, 0.f}, {0.f, 0.f, 0.f, 0.f}};
        const LAS unsigned char* pWg = (const LAS unsigned char*)sWg + lane * 16;
#pragma unroll
        for (int j = 0; j < 4; ++j)
#pragma unroll
            for (int q = 0; q < 4; ++q) { const f32x4 w = *(const LAS f32x4*)(pWg + (j * 4 + q) * 1024);
#pragma unroll
                for (int r = 0; r < 2; ++r) { const float xv = v[r][j][q]; gl[r][0] += xv * w.x; gl[r][1] += xv * w.y; gl[r][2] += xv * w.z; gl[r][3] += xv * w.w; } }
        int gi[2]; float gval[2];
#pragma unroll
        for (int r = 0; r < 2; ++r) {
#pragma unroll
            for (int q = 0; q < 4; ++q) gl[r][q] = wave_sum(gl[r][q], lane) + sBias[q];
            gi[r] = 0; float gm = gl[r][0];
#pragma unroll
            for (int q = 1; q < 4; ++q) if (gl[r][q] > gm) { gm = gl[r][q]; gi[r] = q; }
            float gden = 0.f;
#pragma unroll
            for (int q = 0; q < 4; ++q) gden += __expf(gl[r][q] - gm);
            gval[r] = 1.0f / gden; }
        float il[2][4] = {{0.f, 0.f, 0.f, 0.f}, {0.f, 0.f, 0.f, 0.f}};
        const LAS unsigned char* pWi0 = (const LAS unsigned char*)sWi + lane * 16 + gi[0] * 1024;
        const LAS unsigned char* pWi1 = (const LAS unsigned char*)sWi + lane * 16 + gi[1] * 1024;
#pragma unroll
        for (int j = 0; j < 4; ++j)
#pragma unroll
            for (int q = 0; q < 4; ++q) {
                { const f32x4 w = *(const LAS f32x4*)(pWi0 + (j * 4 + q) * 4096); const float xv = v[0][j][q]; il[0][0] += xv * w.x; il[0][1] += xv * w.y; il[0][2] += xv * w.z; il[0][3] += xv * w.w; }
                { const f32x4 w = *(const LAS f32x4*)(pWi1 + (j * 4 + q) * 4096); const float xv = v[1][j][q]; il[1][0] += xv * w.x; il[1][1] += xv * w.y; il[1][2] += xv * w.z; il[1][3] += xv * w.w; } }
#pragma unroll
        for (int r = 0; r < 2; ++r) {
            const f32x4 bi4 = *(const LAS f32x4*)(sBias + 4 + gi[r] * 4);
#pragma unroll
            for (int q = 0; q < 4; ++q) il[r][q] = wave_sum(il[r][q], lane) + bi4[q];
            int i0 = 0; float m0 = il[r][0];
#pragma unroll
            for (int q = 1; q < 4; ++q) if (il[r][q] > m0) { m0 = il[r][q]; i0 = q; }
            int i1 = -1; float m1 = -INFINITY;
#pragma unroll
            for (int q = 0; q < 4; ++q) if (q != i0 && il[r][q] > m1) { m1 = il[r][q]; i1 = q; }
            const float e1 = __expf(m1 - m0); const float w0 = gval[r] / (1.0f + e1), w1 = gval[r] * e1 / (1.0f + e1);
            const int ri = wv * 32 + k + r;
            if (lane == 0 && !dry && k + r < 32 && row + r * NGW < M) { const int ex0 = gi[r] * 4 + i0, ex1 = gi[r] * 4 + i1;
                recRow[ri] = (unsigned)(row + r * NGW); recE[ri] = (unsigned)ex0 | ((unsigned)ex1 << 8); recW0[ri] = w0; recW1[ri] = w1; recRS[ri] = rs[r]; }
        }
    }
    __syncthreads();
    unsigned e = 0xffffffffu; if (tid < RECMAX) e = recE[tid];
    const unsigned ex0 = e & 255u, ex1 = (e >> 8) & 255u;
    unsigned pos0 = 0u, pos1 = 0u;
    if (wv < RECMAX / 64) {
#pragma unroll
        for (unsigned x = 0; x < 16; ++x) { const unsigned long long m0 = __ballot(ex0 == x), m1 = __ballot(ex1 == x);
            const unsigned p = __builtin_amdgcn_mbcnt_hi((unsigned)(m0 >> 32), __builtin_amdgcn_mbcnt_lo((unsigned)m0, 0u)) + __builtin_amdgcn_mbcnt_hi((unsigned)(m1 >> 32), __builtin_amdgcn_mbcnt_lo((unsigned)m1, 0u));
            if (ex0 == x) pos0 = p; if (ex1 == x) pos1 = p;
            if (lane == 0) recL[wv * 16 + x] = (unsigned)(__popcll(m0) + __popcll(m1)); } }
    __syncthreads();
    if (tid < 16 && !dry) { unsigned c_ = 0u;
#pragma unroll
        for (int q = 0; q < RECMAX / 64; ++q) c_ += recL[q * 16 + tid];
        gbase[tid] = atomicAdd(cnt + tid * 64, c_); }
    __syncthreads();
    if (e != 0xffffffffu && !dry) { unsigned p0 = gbase[ex0] + pos0, p1 = gbase[ex1] + pos1;
        for (int q = 0; q < wv; ++q) { p0 += recL[q * 16 + ex0]; p1 += recL[q * 16 + ex1]; }
        const unsigned row = recRow[tid]; const float rs = recRS[tid];
        list[(size_t)ex0 * M + p0] = row * 2u; wl[(size_t)ex0 * M + p0] = recW0[tid]; list[(size_t)ex1 * M + p1] = row * 2u + 1u; wl[(size_t)ex1 * M + p1] = recW1[tid];
        rsl[(size_t)ex0 * M + p0] = rs; rsl[(size_t)ex1 * M + p1] = rs; }
}
__device__ __forceinline__ void moe_table(unsigned char* ws, volatile LAS int* tab, int layer, int tid) {
    __syncthreads();
    if (tid == 0) { const unsigned* cnt = (const unsigned*)(ws + WS_CTL) + CW_CNT + layer * 16 * 64; int t = 0;
#pragma unroll 1
        for (int e = 0; e < 16; ++e) { const int c = (int)__hip_atomic_load(cnt, RLX_AGENT); cnt += 64; tab[e] = c; tab[16 + e] = t; t += (c + 255) >> 8; tab[32 + e] = t; }
        tab[48] = t; }
    __syncthreads();
}
__device__ __forceinline__ void combine_rows(unsigned char* ws, int mode, int gw, int NGW, int lane, bool dry = false) {
    bf16* Hh = (bf16*)(ws + WS_B4); float* Out = OUTP(); const bf16* E0 = (const bf16*)(ws + WS_B2); const bf16* E1 = (const bf16*)(ws + WS_B3); bf16* XN2 = (bf16*)(ws + WS_B0);
    f32x4 g[4]; load_row(INP(4), lane, g);
    for (int row = gw; row < M; row += NGW) {
        f32x4 v[4]; load_row_bf(Hh + (size_t)row * C, lane, v);
#pragma unroll
        for (int j = 0; j < 4; ++j) { const v2u e0 = ((const GAS v2u*)(E0 + (size_t)row * C))[64 * j + lane], e1 = ((const GAS v2u*)(E1 + (size_t)row * C))[64 * j + lane];
            v[j].x += bflo(e0.x) + bflo(e1.x); v[j].y += bfhi(e0.x) + bfhi(e1.x); v[j].z += bflo(e0.y) + bflo(e1.y); v[j].w += bfhi(e0.y) + bfhi(e1.y); }
        const float rs = row_rs(v, lane);
        if (mode == 0) {
            if (!dry) store_row_bf16(Hh + (size_t)row * C, lane, v);
            if (lane == 0) ((float*)XN2)[row] = rs;
        } else {
            float sig = 1.0f;
#if MK_DEBUG
            const unsigned* cw = (const unsigned*)(ws + WS_CTL) + CW_DBG; const unsigned nnan = __hip_atomic_load(cw, RLX_AGENT), nbad = __hip_atomic_load(cw + 64, RLX_AGENT);
            if (row < 512 && nnan > 0) sig = 2.0f;
            if (row >= 512 && row < 1536 && __hip_atomic_load(cw + 128, RLX_AGENT) > 0) sig = 2.0f;
            if (row >= 1536 && row < 3584 && __hip_atomic_load(cw + 192, RLX_AGENT) > 0) sig = 2.0f;
            if (row >= 3584 && row < 7680 && __hip_atomic_load(cw + 256, RLX_AGENT) > 0) sig = 2.0f;
            if (row >= 7680 && row < 15872 && __hip_atomic_load(cw + 320, RLX_AGENT) > 0) sig = 2.0f;
            if (row >= 15872 && nbad > (unsigned)(M / 100) * C) sig = 1.5f;
#endif
#pragma unroll
            for (int j = 0; j < 4; ++j) ((GAS f32x4*)(Out + (size_t)row * C))[64 * j + lane] = v[j] * rs * g[j] * sig;
        }
    }
}
__device__ __forceinline__ void attn_naive(unsigned char* ws, int gw, int NGW, int lane) {
    const bf16* Kb = (const bf16*)(ws + WS_B1); const bf16* Vb = (const bf16*)(ws + WS_B2); const bf16* Qb = (const bf16*)(ws + WS_B3); bf16* Ob = (bf16*)(ws + WS_B0);
    for (int unit = gw; unit < BATCH * NH * (SEQ / 64); unit += NGW) {
        const int qb = unit % (SEQ / 64), bh = unit / (SEQ / 64), b = bh / NH, h = bh % NH;
        const int t0 = qb * 64, t = t0 + lane; const size_t rowq = (size_t)b * SEQ + t;
        float q[64], o[64];
#pragma unroll
        for (int c = 0; c < 8; ++c) { const v4u w = *(const GAS v4u*)(Qb + rowq * C + h * HD + c * 8);
            q[c * 8 + 0] = bflo(w.x) * 0.125f; q[c * 8 + 1] = bfhi(w.x) * 0.125f; q[c * 8 + 2] = bflo(w.y) * 0.125f; q[c * 8 + 3] = bfhi(w.y) * 0.125f;
            q[c * 8 + 4] = bflo(w.z) * 0.125f; q[c * 8 + 5] = bfhi(w.z) * 0.125f; q[c * 8 + 6] = bflo(w.w) * 0.125f; q[c * 8 + 7] = bfhi(w.w) * 0.125f; }
#pragma unroll
        for (int c = 0; c < 64; ++c) o[c] = 0.f;
        float suffix = 0.f;
        for (int s = t0 + 62; s >= 0; --s) {
            const bool valid = s < t;
            if (s < t0 && __all(suffix > SB_EXIT)) break;
            const bf16* kp = Kb + ((size_t)b * SEQ + s) * C + h * HD; const bf16* vp = Vb + ((size_t)b * SEQ + s) * C + h * HD;
            float z = 0.f;
#pragma unroll
            for (int c = 0; c < 8; ++c) { const v4u w = *(const GAS v4u*)(kp + c * 8);
                z += q[c * 8 + 0] * bflo(w.x) + q[c * 8 + 1] * bfhi(w.x) + q[c * 8 + 2] * bflo(w.y) + q[c * 8 + 3] * bfhi(w.y) + q[c * 8 + 4] * bflo(w.z) + q[c * 8 + 5] * bfhi(w.z) + q[c * 8 + 6] * bflo(w.w) + q[c * 8 + 7] * bfhi(w.w); }
            const float sp = fmaxf(z, 0.f) + log1pf(__expf(-fabsf(z)));
            const float att = valid ? __expf(z - sp - suffix) : 0.f;
            suffix += valid ? sp : 0.f;
#pragma unroll
            for (int c = 0; c < 8; ++c) { const v4u w = *(const GAS v4u*)(vp + c * 8);
                o[c * 8 + 0] += att * bflo(w.x); o[c * 8 + 1] += att * bfhi(w.x); o[c * 8 + 2] += att * bflo(w.y); o[c * 8 + 3] += att * bfhi(w.y);
                o[c * 8 + 4] += att * bflo(w.z); o[c * 8 + 5] += att * bfhi(w.z); o[c * 8 + 6] += att * bflo(w.w); o[c * 8 + 7] += att * bfhi(w.w); }
        }
#pragma unroll
        for (int c = 0; c < 8; ++c) { v4u w; w.x = pk2(o[c * 8 + 0], o[c * 8 + 1]); w.y = pk2(o[c * 8 + 2], o[c * 8 + 3]); w.z = pk2(o[c * 8 + 4], o[c * 8 + 5]); w.w = pk2(o[c * 8 + 6], o[c * 8 + 7]);
            *(GAS v4u*)(Ob + rowq * C + h * HD + c * 8) = w; }
    }
}


typedef float f32x16 __attribute__((ext_vector_type(16)));
constexpr int AT_VP = 192;
constexpr int AT_WAVE_LDS = 32 * AT_VP;
__device__ __forceinline__ int crow32(int reg, int hh) { return (reg & 3) + 8 * (reg >> 2) + 4 * hh; }
__device__ __forceinline__ bf16x8s pack_step(const f32x16& x, const int s) {
    v4u p; p.x = pg8::cvt_pk_bf16(x[8 * s], x[8 * s + 1]); p.y = pg8::cvt_pk_bf16(x[8 * s + 2], x[8 * s + 3]); p.z = pg8::cvt_pk_bf16(x[8 * s + 4], x[8 * s + 5]); p.w = pg8::cvt_pk_bf16(x[8 * s + 6], x[8 * s + 7]);
    return __builtin_bit_cast(bf16x8s, p);
}
__device__ __forceinline__ void attn_mfma(unsigned char* ws, LAS unsigned char* lds, int gw, int NGW, int lane, int wave) {
    const bf16* Kb = (const bf16*)(ws + WS_B1); const bf16* Vb = (const bf16*)(ws + WS_B2); const bf16* Qb = (const bf16*)(ws + WS_B3); bf16* Ob = (bf16*)(ws + WS_B0);
    LAS unsigned char* vl = lds + wave * AT_WAVE_LDS;
    const int r32 = lane & 31, hh = lane >> 5;
    bf16x8s tri[2];
#pragma unroll
    for (int s = 0; s < 2; ++s)
#pragma unroll
        for (int j = 0; j < 8; ++j) tri[s][j] = (16 * s + 8 * (j >> 2) + 4 * hh + (j & 3)) > r32 ? (short)0x3F80 : (short)0;
    const int grp = lane >> 4, tq = (lane & 15) >> 2, tp = lane & 3;
    const LAS unsigned char* vtr0 = vl + (4 * hh + tq) * AT_VP + (16 * (grp & 1) + 4 * tp) * 2;
    for (int unit = gw; unit < BATCH * NH * (SEQ / 32); unit += NGW) {
        const int qb = unit % (SEQ / 32), bh = unit / (SEQ / 32), b = bh / NH, hd = bh % NH;
        const int t0 = qb * 32; const size_t rowb = (size_t)b * SEQ;
        bf16x8s qf[4];
#pragma unroll
        for (int ks = 0; ks < 4; ++ks) qf[ks] = *(const GAS bf16x8s*)(Qb + (rowb + t0 + r32) * C + hd * HD + 16 * ks + 8 * hh);
        f32x16 o[2];
#pragma unroll
        for (int i = 0; i < 16; ++i) { o[0][i] = 0.f; o[1][i] = 0.f; }
        float carry = 0.f;
        for (int s0 = t0; s0 >= 0; s0 -= 32) {
            bf16x8s kf[4];
#pragma unroll
            for (int ks = 0; ks < 4; ++ks) kf[ks] = *(const GAS bf16x8s*)(Kb + (rowb + s0 + r32) * C + hd * HD + 16 * ks + 8 * hh);
            v4u vreg[4];
#pragma unroll
            for (int i = 0; i < 4; ++i) { const int cidx = lane + 64 * i; vreg[i] = *(const GAS v4u*)(Vb + (rowb + s0 + (cidx >> 3)) * C + hd * HD + (cidx & 7) * 8); }
            f32x16 st;
#pragma unroll
            for (int i = 0; i < 16; ++i) st[i] = 0.f;
#pragma unroll
            for (int ks = 0; ks < 4; ++ks) st = __builtin_amdgcn_mfma_f32_32x32x16_bf16(kf[ks], qf[ks], st, 0, 0, 0);
#pragma unroll
            for (int i = 0; i < 4; ++i) { const int cidx = lane + 64 * i; *(LAS v4u*)(vl + (cidx >> 3) * AT_VP + (cidx & 7) * 16) = vreg[i]; }
            f32x16 zz, uu; float tot = 0.f; const int tq_ = t0 + r32;
            if (s0 + 31 < t0) {
#pragma unroll
                for (int i = 0; i < 16; ++i) { const float z = st[i] * 0.18033688011112042f; const float sp = fmaxf(z, 0.f) + __builtin_amdgcn_logf(1.0f + __builtin_amdgcn_exp2f(-fabsf(z)));
                    zz[i] = z - sp; uu[i] = sp; tot += sp; }
            } else {
#pragma unroll
                for (int i = 0; i < 16; ++i) { const int key = s0 + crow32(i, hh); const float z = st[i] * 0.18033688011112042f; const float sp = fmaxf(z, 0.f) + __builtin_amdgcn_logf(1.0f + __builtin_amdgcn_exp2f(-fabsf(z)));
                    const bool valid = key < tq_; zz[i] = valid ? z - sp : -1e30f; uu[i] = valid ? sp : 0.f; tot += uu[i]; }
            }
            f32x16 w;
#pragma unroll
            for (int i = 0; i < 16; ++i) w[i] = 0.f;
#pragma unroll
            for (int s = 0; s < 2; ++s) w = __builtin_amdgcn_mfma_f32_32x32x16_bf16(tri[s], pack_step(uu, s), w, 0, 0, 0);
            f32x16 pp;
#pragma unroll
            for (int i = 0; i < 16; ++i) pp[i] = __builtin_amdgcn_exp2f(zz[i] - w[i] - carry);
            tot += shx(tot, 32, lane); carry += tot;
            asm volatile("s_waitcnt lgkmcnt(0)" ::: "memory");
#pragma unroll
            for (int s = 0; s < 2; ++s) { const bf16x8s pa = pack_step(pp, s);
#pragma unroll
                for (int dt = 0; dt < 2; ++dt) {
                    const v4i16_t lo = __builtin_amdgcn_ds_read_tr16_b64_v4i16((LAS v4i16_t*)(vtr0 + (16 * s) * AT_VP + dt * 64));
                    const v4i16_t hi = __builtin_amdgcn_ds_read_tr16_b64_v4i16((LAS v4i16_t*)(vtr0 + (16 * s + 8) * AT_VP + dt * 64));
                    const bf16x8s vf = (bf16x8s){lo[0], lo[1], lo[2], lo[3], hi[0], hi[1], hi[2], hi[3]};
                    o[dt] = __builtin_amdgcn_mfma_f32_32x32x16_bf16(pa, vf, o[dt], 0, 0, 0); } }
            asm volatile("" ::: "memory");
            if (s0 < t0 && __all(carry > SB_EXIT * 1.4426950408889634f)) break;
        }
#pragma unroll
        for (int dt = 0; dt < 2; ++dt)
#pragma unroll
            for (int i = 0; i < 16; ++i) Ob[(rowb + t0 + crow32(i, hh)) * C + hd * HD + 32 * dt + r32] = (bf16)f2bf(o[dt][i]);
    }
}
__global__ void __launch_bounds__(NWAVES * 64, 2) yoco_fwd(Args args) {
    extern __shared__ __attribute__((aligned(16))) unsigned char lds_raw[];
    LAS unsigned char* lds = (LAS unsigned char*)lds_raw;
    const int G = gridDim.x; const int bx = blockIdx.x;
    int wave = __builtin_amdgcn_readfirstlane(threadIdx.x >> 6); asm volatile("" : "+s"(wave));
#define IDS() int lane; asm volatile("v_mbcnt_lo_u32_b32 %0, -1, 0\n\tv_mbcnt_hi_u32_b32 %0, -1, %0" : "=v"(lane)); const int tid = wave * 64 + lane; (void)tid; \
    const int vcu = (G % 8 == 0) ? (bx % 8) * (G / 8) + bx / 8 : bx; const int gw = vcu * NWAVES + wave, NGW = G * NWAVES; (void)lane; (void)gw; (void)NGW;
    unsigned char* ws = WSP();
    volatile LAS unsigned* MISC = (volatile LAS unsigned*)(lds + MISC_OFF);
    volatile LAS int* tab = (volatile LAS int*)(lds + MOE_TAB_OFF);
    for (int u = threadIdx.x; u < (LDS_BYTES - LDSCTL_OFF) / 4; u += NWAVES * 64) ((LAS unsigned*)(lds + LDSCTL_OFF))[u] = 0u;
    __syncthreads();
    XcdBarrier bar; bar.bar = (unsigned*)(ws + WS_CTL) + CW_BAR; bar.x = 0; bar.st = nullptr;
    if (N_LAUNCHES == 1) bar = xcd_barrier_post((unsigned*)(ws + WS_CTL) + CW_BAR, MISC + 8);
    const int lo = KA_INT(0), hi = KA_INT(1);
#ifndef PROBE_PH
#define PROBE_PH -1
#endif
#define IN(k) (lo <= (k) && (k) < hi)
#define REP(k) for (int rep_ = 0; rep_ < ((PROBE_PH == (k)) ? 2 : 1); ++rep_)
#define SEAM(k) do { if (IN(k) && IN((k) + 1)) xcd_barrier(bar); } while (0)

    if (IN(PH_P0)) REP(PH_P0) { IDS(); p0_weights<0>(ws, lds, gw, NGW, wave, lane); p0_weights<1>(ws, lds, gw, NGW, wave, lane); if (G <= 64) p0_weights<2>(ws, lds, gw, NGW, wave, lane); p0_rows(ws, gw, NGW, lane); }
    SEAM(PH_P0);
    if (PROBE_PH == 100 && N_LAUNCHES == 1) { for (int i_ = 0; i_ < 10; ++i_) xcd_barrier(bar); }
    if (IN(PH_LORA)) REP(PH_LORA) {
        SchedGrouped<1, 3> S{(const char*)(ws + WS_B1), (size_t)(WS_B2 - WS_B1), nullptr, (const char*)(ws + WS_WT_LORA), (size_t)256 * C * 2, G, bx};
        EpiLora E{(bf16*)(ws + WS_LW)};
        pg8::gemm_phase<EpiLora, SchedGrouped<1, 3>, true, false, C>(lds, S, E, wave);
    }
    SEAM(PH_LORA);
    if (IN(PH_RKV)) REP(PH_RKV) {
        SchedGrouped<4, 3> S{(const char*)OUTP(), (size_t)M * C * 2, (const char*)(ws + WS_B4), (const char*)(ws + WS_WT_RKV), (size_t)C * C * 2, G, bx};
        EpiSplit3 E{(bf16*)(ws + WS_B1), false, nullptr};
        pg8::gemm_phase<EpiSplit3, SchedGrouped<4, 3>, true, false, C>(lds, S, E, wave);
    }
    SEAM(PH_RKV);
    if (IN(PH_S1)) REP(PH_S1) { IDS(); scan_s1(ws, lds, lane, wave); }
    SEAM(PH_S1);
    if (IN(PH_S2)) REP(PH_S2) { IDS();
        if (bx < BATCH * NH || G <= BATCH * NH) scan_s2(ws, lds, lane, wave);
        }
    SEAM(PH_S2);
    if (IN(PH_S3)) REP(PH_S3) { IDS(); scan_s3(ws, lds, lane, wave); }
    SEAM(PH_S3);
#if MK_DEBUG
    if (IN(PH_DBG0)) { IDS(); scan_naive(ws, lds, tid); }
    SEAM(PH_DBG0);
    if (IN(PH_DBG0 + 1)) { IDS(); post_scan(ws, gw, NGW, lane); }
    SEAM(PH_DBG0 + 1);
    if (IN(PH_DBG0 + 2)) { IDS(); dbg_compare(ws, (const bf16*)(ws + WS_B0), (const bf16*)(ws + WS_B4), gw, NGW, lane); }
    SEAM(PH_DBG0 + 2);
#endif
    if (IN(PH_WOUT)) REP(PH_WOUT) {
        SchedGrouped<4, 1> S{(const char*)(ws + ((MK_DEBUG && DBG_USE_NAIVE) ? WS_B4 : WS_B0)), 0, nullptr, (const char*)(ws + WS_WT_OUT), 0, G, bx};
        EpiResidBf<true> E{INP(0), (bf16*)(ws + WS_B4)};
        pg8::gemm_phase<EpiResidBf<true>, SchedGrouped<4, 1>, true, false, C>(lds, S, E, wave);
    }
    SEAM(PH_WOUT);
#pragma unroll 1
    for (int layer = 0; layer < 2; ++layer) {
        const int pb = layer == 0 ? (int)PH_ROUT0 : (int)PH_ROUT1;
        if (IN(pb)) { IDS(); if (PROBE_PH == 101 && layer == 0) router_rows(ws, lds, layer, gw, NGW, lane, tid, wave, true); router_rows(ws, lds, layer, gw, NGW, lane, tid, wave); }
        SEAM(pb);
        if (IN(pb + 1)) REP(pb + 1) {
            { IDS(); moe_table(ws, tab, layer, tid); }
            SchedMoe<2, C, true> S{(const char*)(ws + WS_B4), (const char*)(ws + WS_WT_GU) + (size_t)layer * 16 * 512 * C * 2, (size_t)512 * C * 2, (const unsigned*)(ws + WS_LIST), tab, G, bx};
            EpiGU E{(bf16*)(ws + WS_HID), (const float*)(ws + WS_WL), (const float*)(ws + WS_B0)};
            pg8::gemm_phase<EpiGU, SchedMoe<2, C, true>, true, true, C>(lds, S, E, wave);
            if (layer == 0 && G > 64) { const int nr2 = __builtin_amdgcn_readfirstlane(tab[48]) * 2 - G, first = nr2 > 0 ? nr2 : 0;
                if (bx >= first) { IDS(); p0_weights<2>(ws, lds, (bx - first) * NWAVES + wave, (G - first) * NWAVES, wave, lane); } }
        }
        SEAM(pb + 1);
        if (IN(pb + 2)) REP(pb + 2) {
            { IDS(); moe_table(ws, tab, layer, tid); }
            SchedMoe<4, FE, false> S{(const char*)(ws + WS_HID), (const char*)(ws + WS_WT_DN) + (size_t)layer * 16 * C * FE * 2, (size_t)C * FE * 2, (const unsigned*)(ws + WS_LIST), tab, G, bx};
            EpiDown E{(bf16*)(ws + WS_B2), (const unsigned*)(ws + WS_LIST)};
            pg8::gemm_phase<EpiDown, SchedMoe<4, FE, false>, true, false, FE>(lds, S, E, wave);
        }
        SEAM(pb + 2);
        if (layer == 0) {
            if (IN(PH_COMB)) { IDS(); if (PROBE_PH == 102) combine_rows(ws, 0, gw, NGW, lane, true); combine_rows(ws, 0, gw, NGW, lane); }
            SEAM(PH_COMB);
            if (IN(PH_KVQ)) REP(PH_KVQ) {
                SchedGrouped<12, 1> S{(const char*)(ws + WS_B4), 0, nullptr, (const char*)(ws + WS_WT_KVQ), 0, G, bx};
                EpiSplit3 E{(bf16*)(ws + WS_B1), true, (const float*)(ws + WS_B0)};
                pg8::gemm_phase<EpiSplit3, SchedGrouped<12, 1>, true, false, C>(lds, S, E, wave);
            }
            SEAM(PH_KVQ);
            if (IN(PH_ATTN)) REP(PH_ATTN) { IDS(); attn_mfma(ws, lds, gw, NGW, lane, wave); }
            SEAM(PH_ATTN);
            if (IN(PH_SBO)) {
                SchedGrouped<4, 1> S{(const char*)(ws + WS_B0), 0, nullptr, (const char*)(ws + WS_WT_SBO), 0, G, bx};
                EpiResidBf<false> E{(const void*)(ws + WS_B4), (bf16*)(ws + WS_B4)};
                pg8::gemm_phase<EpiResidBf<false>, SchedGrouped<4, 1>, true, false, C>(lds, S, E, wave);
            }
            SEAM(PH_SBO);
        }
    }
    if (IN(PH_FINAL)) { IDS(); combine_rows(ws, 1, gw, NGW, lane); }
#undef IN
#undef SEAM
}

extern "C" void kernel_launch(void* const* d_in, const int* in_sizes, int n_in, void* d_out, int out_size, void* d_ws, size_t ws_size, hipStream_t stream) {
    static int grid = 0;
    if (grid == 0) {
        if (n_in != 31 || in_sizes[0] != M * C || out_size != M * C || ws_size < WS_END) { fprintf(stderr, "kernel_launch: unexpected shapes (n_in %d, in0 %d, out %d, ws %zu); nothing launched\n", n_in, n_in > 0 ? in_sizes[0] : -1, out_size, ws_size); grid = -1; return; }
        int dev = 0, cus = 0, per_cu = 0;
        if (hipGetDevice(&dev) != hipSuccess || hipDeviceGetAttribute(&cus, hipDeviceAttributeMultiprocessorCount, dev) != hipSuccess) { grid = -1; return; }
        if (hipFuncSetAttribute((const void*)yoco_fwd, hipFuncAttributeMaxDynamicSharedMemorySize, LDS_BYTES) != hipSuccess) { fprintf(stderr, "kernel_launch: hipFuncSetAttribute failed\n"); grid = -1; return; }
        if (hipOccupancyMaxActiveBlocksPerMultiprocessor(&per_cu, (const void*)yoco_fwd, NWAVES * 64, LDS_BYTES) != hipSuccess || per_cu < 1) fprintf(stderr, "kernel_launch: occupancy query reports %d\n", per_cu);
        (void)hipGetLastError();
        grid = cus - (cus % 16);
    }
    if (grid < 0) return;
    if (hipMemsetAsync((char*)d_ws + WS_CTL, 0, CTL_ZERO_BYTES, stream) != hipSuccess) return;
    Args a{};
    for (int i = 0; i < 31; ++i) a.in[i] = (const float*)d_in[i];
    a.out = (float*)d_out; a.ws = (unsigned char*)d_ws;
    for (int li = 0; li < (N_LAUNCHES == 1 ? 1 : (int)NPHASE); ++li) {
        a.ph_lo = (N_LAUNCHES == 1) ? 0 : li; a.ph_hi = (N_LAUNCHES == 1) ? NPHASE : li + 1; a.li = li;
        hipLaunchKernelGGL(yoco_fwd, dim3(grid), dim3(NWAVES * 64), LDS_BYTES, stream, a);
        const hipError_t le = hipPeekAtLastError();
        if (le != hipSuccess) { fprintf(stderr, "kernel_launch: launch %d failed: %s\n", li, hipGetErrorName(le)); break; }
    }
}
```

```cpp
#include <hip/hip_runtime.h>
#include <cstdio>
#include <cstdint>

#ifndef MK_N_LAUNCHES
#define MK_N_LAUNCHES 1
#endif

namespace pg8 {
#define PG8_LAS __attribute__((address_space(3)))
typedef unsigned short bf16_t;
typedef short bf16x8 __attribute__((ext_vector_type(8)));
typedef float f32x4 __attribute__((ext_vector_type(4)));
typedef unsigned u32x4 __attribute__((ext_vector_type(4)));
constexpr int BM = 256, BK = 64, HALF = 128, HTB = HALF * BK * 2, STAGE_BYTES = 8 * HTB, NXCD = 8, WGM = 8;

__host__ __device__ __forceinline__ int lds_byte(int r, int c) { const int st = (r >> 4) * 2 + (c >> 5), rr = r & 15, cc = c & 31, ob = rr * 64 + cc * 2; return st * 1024 + (ob ^ (((ob >> 9) & 1) << 5)); }
__host__ __device__ __forceinline__ void stage_rc(int b, int& R, int& C) { const int st = b / 1024, sb = b % 1024, swz = sb ^ (((sb >> 9) & 1) << 5); R = (st >> 1) * 16 + swz / 64; C = (st & 1) * 32 + (swz % 64) / 2; }
__host__ __device__ __forceinline__ int perm32(int rho) { const int n = rho >> 4, i = rho & 15; return 8 * (i >> 2) + 4 * n + (i & 3); }

struct Unit { int pm, pn, aux, r0, cnt; };

__host__ __device__ __forceinline__ void tile_map(int wgid, int nM, int nN, int& pm, int& pn) {
    const int nwg = nM * nN;
    { const int q = nwg / NXCD, r = nwg % NXCD, xcd = wgid % NXCD, off = wgid / NXCD; wgid = (xcd < r ? xcd * (q + 1) : r * (q + 1) + (xcd - r) * q) + off; }
    const int nig = WGM * nN, gid = wgid / nig, fm = gid * WGM, gsz = (nM - fm) < WGM ? (nM - fm) : WGM;
    pm = fm + ((wgid % nig) % gsz); pn = (wgid % nig) / gsz;
}

typedef float f32x2_t __attribute__((ext_vector_type(2))); typedef __bf16 bf16x2_t __attribute__((ext_vector_type(2)));
__device__ __forceinline__ unsigned cvt_pk_bf16(float lo, float hi) { const f32x2_t v = {lo, hi}; const bf16x2_t b = __builtin_convertvector(v, bf16x2_t); return __builtin_bit_cast(unsigned, b); }

template <class Epi, class Sched, bool ALIGN_EPI, bool GATHER, int K>
__device__ __forceinline__ void gemm_phase(PG8_LAS unsigned char* lds, const Sched& S, const Epi& E, const int wid) {
    int lane_; asm volatile("v_mbcnt_lo_u32_b32 %0, -1, 0\n\tv_mbcnt_hi_u32_b32 %0, -1, %0" : "=v"(lane_));
    const int lane = lane_, tid = wid * 64 + lane, wr = wid >> 2, wc = wid & 3, fr = lane & 15, fq = lane >> 4;
    constexpr int nt = K / BK;
    unsigned voffA[2], voffB[2];
#pragma unroll
    for (int i = 0; i < 2; ++i) { int R, C; stage_rc(tid * 16 + i * 8192, R, C); const int Rb = Epi::PERM ? ((R & ~31) + perm32(R & 31)) : R;
        voffA[i] = (unsigned)(R * K + C) * 2u; voffB[i] = (unsigned)(Rb * K + C) * 2u; }
    constexpr size_t kstep = (size_t)(BK * 2);
    constexpr size_t hstep = (size_t)HALF * K * 2;
    const unsigned ldsw = (unsigned)wid * 1024u;
    const int aoff = lds_byte(wr * 64 + fr, fq * 8), boff = lds_byte(wc * 32 + fr, fq * 8);
#define PG8_SA(b, h) (((b) * 2 + (h)) * HTB)
#define PG8_SB(b, h) ((4 + (b) * 2 + (h)) * HTB)
#define PG8_STAGE(bufoff, gbase, voff) do { _Pragma("unroll") for (int _i = 0; _i < 2; ++_i) \
        __builtin_amdgcn_global_load_lds((const unsigned*)((const char*)(gbase) + (voff)[_i]), (PG8_LAS unsigned*)(lds + (bufoff) + ldsw + _i * 8192), 16, 0, 0); } while (0)
#define PG8_LDA(dst, b, h) do { _Pragma("unroll") for (int m = 0; m < 4; ++m) _Pragma("unroll") for (int k = 0; k < 2; ++k) dst[m][k] = *(const PG8_LAS bf16x8*)(lds + PG8_SA(b, h) + aoff + m * 2048 + k * 1024); } while (0)
#define PG8_LDB(dst, b, h) do { _Pragma("unroll") for (int n = 0; n < 2; ++n) _Pragma("unroll") for (int k = 0; k < 2; ++k) dst[n][k] = *(const PG8_LAS bf16x8*)(lds + PG8_SB(b, h) + boff + n * 2048 + k * 1024); } while (0)
#define PG8_MMA(ai, bj, At, Bt) do { __builtin_amdgcn_s_setprio(1); _Pragma("unroll") for (int m = 0; m < 4; ++m) _Pragma("unroll") for (int n = 0; n < 2; ++n) _Pragma("unroll") for (int k = 0; k < 2; ++k) \
        acc[ai][bj][m][n] = __builtin_amdgcn_mfma_f32_16x16x32_bf16(Bt[n][k], At[m][k], acc[ai][bj][m][n], 0, 0, 0); __builtin_amdgcn_s_setprio(0); } while (0)
#define PG8_WAIT_V(n) asm volatile("s_waitcnt vmcnt(" #n ")" ::: "memory")
#define PG8_WAIT_L(n) asm volatile("s_waitcnt lgkmcnt(" #n ")" ::: "memory")
#define PG8_BAR __builtin_amdgcn_s_barrier()
#define PG8_SCHED __builtin_amdgcn_sched_barrier(0)
    Unit cur, nxt; int ui = 0;
    if (!S.next(0, cur)) return;
    f32x4 acc[2][2][4][2];
#pragma unroll
    for (int a = 0; a < 2; ++a)
#pragma unroll
        for (int b = 0; b < 2; ++b)
#pragma unroll
            for (int m = 0; m < 4; ++m)
#pragma unroll
                for (int n = 0; n < 2; ++n) acc[a][b][m][n] = (f32x4){0.f, 0.f, 0.f, 0.f};
    bf16x8 At[4][2], B0[2][2], B1[2][2];
    unsigned vc[2][2];
#define PG8_GOFF(u) do { _Pragma("unroll") for (int _h = 0; _h < 2; ++_h) _Pragma("unroll") for (int _i = 0; _i < 2; ++_i) { int _R, _C; stage_rc(tid * 16 + _i * 8192, _R, _C); \
        vc[_h][_i] = S.a_row_off(u, _h * HALF + _R) + (unsigned)_C * 2u; } } while (0)
#define PG8_STAGE_A(bufoff, gbase, h) do { if constexpr (GATHER) { PG8_STAGE(bufoff, gbase, vc[h]); } else { PG8_STAGE(bufoff, (gbase) + (h) * hstep, voffA); } } while (0)
    if constexpr (GATHER) PG8_GOFF(cur);
    const char* cA = S.a_base(cur); const char* cB = S.b_base(cur);
    PG8_STAGE(PG8_SB(0, 0), cB, voffB); PG8_STAGE(PG8_SB(0, 1), cB + hstep, voffB); PG8_STAGE_A(PG8_SA(0, 0), cA, 0); PG8_STAGE_A(PG8_SA(0, 1), cA, 1);
    if (wr == 1) PG8_BAR;
    PG8_WAIT_V(2); PG8_BAR;
    PG8_STAGE(PG8_SB(1, 0), cB + kstep, voffB); PG8_STAGE_A(PG8_SA(1, 0), cA + kstep, 0); PG8_STAGE(PG8_SB(1, 1), cB + hstep + kstep, voffB);
    PG8_WAIT_V(6); PG8_BAR;
    for (;;) {
        const bool has_next = S.next(ui + 1, nxt);
        const char* nA = has_next ? S.a_base(nxt) : cA; const char* nB = has_next ? S.b_base(nxt) : cB;
        for (int t = 0; t < nt; t += 2) {
            const bool last = (t == nt - 2);
            const char* a1 = cA + (size_t)(t + 1) * kstep;
            const char* a2 = last ? nA : cA + (size_t)(t + 2) * kstep; const char* b2 = last ? nB : cB + (size_t)(t + 2) * kstep;
            const char* a3 = a2 + kstep; const char* b3 = b2 + kstep;
            PG8_LDB(B0, 0, 0); PG8_LDB(B1, 0, 1); PG8_SCHED; PG8_LDA(At, 0, 0); PG8_STAGE_A(PG8_SA(1, 1), a1, 1);
            if constexpr (GATHER) { if (last && has_next) PG8_GOFF(nxt); }
            PG8_WAIT_V(8); PG8_WAIT_L(0); PG8_BAR; PG8_MMA(0, 0, At, B0); PG8_MMA(0, 1, At, B1); PG8_BAR; PG8_SCHED;
            PG8_LDA(At, 0, 1); PG8_STAGE(PG8_SB(0, 0), b2, voffB); PG8_STAGE(PG8_SB(0, 1), b2 + hstep, voffB); PG8_STAGE_A(PG8_SA(0, 0), a2, 0);
            PG8_WAIT_V(8); PG8_WAIT_L(0); PG8_BAR; PG8_MMA(1, 0, At, B0); PG8_MMA(1, 1, At, B1); PG8_BAR; PG8_SCHED;
            PG8_LDB(B0, 1, 0); PG8_LDB(B1, 1, 1); PG8_SCHED; PG8_LDA(At, 1, 0); PG8_STAGE_A(PG8_SA(0, 1), a2, 1);
            PG8_WAIT_V(8); PG8_WAIT_L(0); PG8_BAR; PG8_MMA(0, 0, At, B0); PG8_MMA(0, 1, At, B1); PG8_BAR; PG8_SCHED;
            PG8_LDA(At, 1, 1); PG8_STAGE(PG8_SB(1, 0), b3, voffB); PG8_STAGE(PG8_SB(1, 1), b3 + hstep, voffB); PG8_STAGE_A(PG8_SA(1, 0), a3, 0);
            PG8_WAIT_V(8); PG8_WAIT_L(0); PG8_BAR; PG8_MMA(1, 0, At, B0); PG8_MMA(1, 1, At, B1); PG8_BAR; PG8_SCHED;
        }
        if constexpr (ALIGN_EPI) { if (wr == 0) PG8_BAR; }
        E(acc, cur, wr, wc, fr, fq);
        if (!has_next) break;
#pragma unroll
        for (int a = 0; a < 2; ++a)
#pragma unroll
            for (int b = 0; b < 2; ++b)
#pragma unroll
                for (int m = 0; m < 4; ++m)
#pragma unroll
                    for (int n = 0; n < 2; ++n) acc[a][b][m][n] = (f32x4){0.f, 0.f, 0.f, 0.f};
        cur = nxt; cA = nA; cB = nB; ++ui;
        if constexpr (ALIGN_EPI) { if (wr == 1) PG8_BAR; }
    }
    PG8_WAIT_V(0);
    if constexpr (!ALIGN_EPI) { if (wr == 0) PG8_BAR; }
    PG8_BAR;
#undef PG8_SA
#undef PG8_SB
#undef PG8_STAGE
#undef PG8_STAGE_A
#undef PG8_GOFF
#undef PG8_LDA
#undef PG8_LDB
#undef PG8_MMA
#undef PG8_WAIT_V
#undef PG8_WAIT_L
#undef PG8_BAR
#undef PG8_SCHED
}
}

constexpr int NWAVES = 8;
#ifndef MK_DEBUG
#define MK_DEBUG 0
#endif
#ifndef DBG_USE_NAIVE
#define DBG_USE_NAIVE 0
#endif
constexpr int DBGP = MK_DEBUG ? 3 : 0;
enum Phase { PH_P0 = 0, PH_LORA, PH_RKV, PH_S1, PH_S2, PH_S3, PH_DBG0, PH_WOUT = PH_DBG0 + DBGP, PH_ROUT0, PH_GU0, PH_DN0, PH_COMB, PH_KVQ, PH_ATTN, PH_SBO, PH_ROUT1, PH_GU1, PH_DN1, PH_FINAL, NPHASE };
constexpr int N_LAUNCHES = MK_N_LAUNCHES;


constexpr int BATCH = 2, SEQ = 8192, C = 1024, NH = 16, HD = 64, M = BATCH * SEQ;
constexpr int NE = 16, FE = 256, DW = 64, DA = 64, DG = 160;
constexpr float RMS_EPS = 1e-6f, GN_EPS = 64e-5f;
constexpr float SB_EXIT = 104.0f;

constexpr size_t MiB = 1u << 20;
constexpr size_t WS_CTL = 0, CTL_ZERO_BYTES = 64 * 1024;
constexpr size_t WS_WT_W2 = 128 * 1024, WS_WT_A2 = 256 * 1024, WS_WT_G2 = 384 * 1024;
constexpr size_t WS_WT_RKV = 1 * MiB;
constexpr size_t WS_WT_LORA = 7 * MiB;
constexpr size_t WS_WT_OUT = 9 * MiB;
constexpr size_t WS_WT_KVQ = 11 * MiB;
constexpr size_t WS_WT_SBO = 17 * MiB;
constexpr size_t WS_WT_GU = 19 * MiB;
constexpr size_t WS_WT_DN = 51 * MiB;
constexpr size_t WS_LW = 67 * MiB;
constexpr size_t WS_LA = 69 * MiB;
constexpr size_t WS_LG = 71 * MiB;
static_assert(WS_LA == WS_LW + 2 * MiB && WS_LG == WS_LW + 4 * MiB, "EpiLora's pointer arithmetic");
constexpr size_t WS_LIST = 76 * MiB;
constexpr size_t WS_WL = 77 * MiB;
constexpr size_t WS_HID = 78 * MiB;
constexpr size_t WS_B0 = 96 * MiB, WS_B1 = 128 * MiB, WS_B2 = 160 * MiB, WS_B3 = 192 * MiB, WS_B4 = 224 * MiB, WS_END = 256 * MiB;
static_assert(WS_HID + (size_t)144 * 256 * 256 * 2 <= WS_B0, "HID vs B0");
constexpr int CW_TMO = 0;
constexpr int CW_CNT = 1024;
constexpr int CW_BAR = 4096;

constexpr int RING_BYTES = 131072;
constexpr int LDSCTL_OFF = 146688, MISC_OFF = LDSCTL_OFF + 320, MOE_TAB_OFF = MISC_OFF + 128;
constexpr int LDS_BYTES = 147456;
static_assert(MOE_TAB_OFF + 256 <= LDS_BYTES, "LDS map");
static_assert(BATCH * NH * (SEQ / 64) % 16 == 0, "scan units");

#define GAS __attribute__((address_space(1)))
#define LAS __attribute__((address_space(3)))
typedef unsigned short bf16;
typedef unsigned v4u __attribute__((ext_vector_type(4)));
typedef unsigned v2u __attribute__((ext_vector_type(2)));
typedef float f32x4 __attribute__((ext_vector_type(4)));
typedef GAS unsigned gu32;
#define RLX_AGENT __ATOMIC_RELAXED, __HIP_MEMORY_SCOPE_AGENT
#define LDS_WAIT() asm volatile("s_waitcnt lgkmcnt(0)" ::: "memory")
#define VM_WAIT() asm volatile("s_waitcnt vmcnt(0)" ::: "memory")
__device__ __forceinline__ unsigned f2bf(float f) { unsigned u = __builtin_bit_cast(unsigned, f); return (u + 0x7fffu + ((u >> 16) & 1u)) >> 16; }
__device__ __forceinline__ unsigned pk2(float lo, float hi) { return f2bf(lo) | (f2bf(hi) << 16); }
__device__ __forceinline__ float bflo(unsigned u) { return __uint_as_float(u << 16); }
__device__ __forceinline__ float bfhi(unsigned u) { return __uint_as_float(u & 0xffff0000u); }
__device__ __forceinline__ float bf2f(bf16 b) { return __uint_as_float((unsigned)b << 16); }
__device__ __forceinline__ float sigmoidf_(float x) { return 1.0f / (1.0f + __expf(-x)); }

#define XB_TMO      128
#define XB_XCNT(j)  (256  + 64 * (j))
#define XB_XSUB(j)  (1280 + 64 * (j))
#define XB_XGEN(j)  (2304 + 64 * (j))
#define XB_TOP      3328
#define XB_TOPGEN   3392
#define XCD_BAR_WORDS 3456
#define XB_SPIN_CAP (1u << 18)
__device__ __forceinline__ unsigned xb_ld(unsigned* p)              { return __hip_atomic_load(p, __ATOMIC_RELAXED, __HIP_MEMORY_SCOPE_AGENT); }
__device__ __forceinline__ unsigned xb_add(unsigned* p, unsigned v) { return __hip_atomic_fetch_add(p, v, __ATOMIC_RELAXED, __HIP_MEMORY_SCOPE_AGENT); }
__device__ __forceinline__ unsigned xb_xcc_id() { return (unsigned)__builtin_amdgcn_s_getreg((3 << 11) | 20) & 0xFu; }
#define XB_SPIN(cond, bar) do { unsigned _sp = 0; while (cond) { __builtin_amdgcn_s_sleep(1); \
    if ((++_sp & 255u) == 0u) { if (xb_ld(&(bar)[XB_TMO])) break; if (_sp > XB_SPIN_CAP) { atomicAdd(&(bar)[XB_TMO], 1u); break; } } } } while (0)
struct XcdBarrier { unsigned* bar; unsigned x; volatile LAS unsigned* st; };
__device__ __forceinline__ XcdBarrier xcd_barrier_post(unsigned* bar, volatile LAS unsigned* st) {
    XcdBarrier b; b.bar = bar; b.x = xb_xcc_id(); b.st = st;
    if (threadIdx.x == 0) (void)xb_add(&bar[XB_XCNT(b.x)], 1u);
    return b;
}
__device__ __forceinline__ void xcd_barrier_complete(unsigned* bar, unsigned x, unsigned& nloc, unsigned& nx) {
    const unsigned G = gridDim.x * gridDim.y * gridDim.z;
    unsigned sum, cnt, mine, sp = 0u;
    for (;;) {
        sum = 0u; cnt = 0u; mine = 0u;
#pragma unroll
        for (unsigned j = 0; j < 16; ++j) { const unsigned c = xb_ld(&bar[XB_XCNT(j)]); sum += c; cnt += (c > 0u) ? 1u : 0u; mine = (j == x) ? c : mine; }
        if (sum == G) break;
        __builtin_amdgcn_s_sleep(1);
        if ((++sp & 255u) == 0u) { if (xb_ld(&bar[XB_TMO])) break; if (sp > XB_SPIN_CAP) { atomicAdd(&bar[XB_TMO], 1u); break; } }
    }
    nloc = mine > 0u ? mine : 1u; nx = cnt > 0u ? cnt : 1u;
}
__device__ __forceinline__ void xcd_barrier(const XcdBarrier& b) {
    asm volatile("s_waitcnt vmcnt(0)" ::: "memory");
    __syncthreads();
    if (threadIdx.x == 0) {
        unsigned* bar = b.bar;
        __builtin_amdgcn_s_waitcnt(0);
        unsigned nloc = b.st[0], nx = b.st[1];
        if (nloc == 0u) { xcd_barrier_complete(bar, b.x, nloc, nx); b.st[0] = nloc; b.st[1] = nx; }
        const unsigned old = xb_add(&bar[XB_XSUB(b.x)], 1u);
        const unsigned gen = old / nloc;
        const unsigned target = (gen + 1u) * nx;
        if (old + 1u == (gen + 1u) * nloc) {
            __builtin_amdgcn_fence(__ATOMIC_RELEASE, "agent");
            asm volatile("s_waitcnt vmcnt(0)" ::: "memory");
            const unsigned og = xb_add(&bar[XB_TOP], 1u);
            if (og + 1u != target) XB_SPIN((int)(xb_ld(&bar[XB_TOP]) - target) < 0, bar);
        } else {
            XB_SPIN((int)(xb_ld(&bar[XB_TOP]) - target) < 0, bar);
        }
        __builtin_amdgcn_fence(__ATOMIC_ACQUIRE, "agent");
        asm volatile("s_waitcnt vmcnt(0)" ::: "memory");
    }
    __syncthreads();
}

__device__ __forceinline__ float shx(float v, int o, int lane) { return __int_as_float(__builtin_amdgcn_ds_bpermute((lane ^ o) << 2, __float_as_int(v))); }
#define DPP_ADD(v, ctrl) ((v) + __int_as_float(__builtin_amdgcn_update_dpp(0, __float_as_int(v), (ctrl), 0xf, 0xf, true)))
__device__ __forceinline__ float wave_sum(float v, int lane) {
    (void)lane;
    v = DPP_ADD(v, 0x128); v = DPP_ADD(v, 0x124); v = DPP_ADD(v, 0x122); v = DPP_ADD(v, 0x121);
    const int iv = __float_as_int(v);
    return (__int_as_float(__builtin_amdgcn_readlane(iv, 0)) + __int_as_float(__builtin_amdgcn_readlane(iv, 16))) + (__int_as_float(__builtin_amdgcn_readlane(iv, 32)) + __int_as_float(__builtin_amdgcn_readlane(iv, 48)));
}
__device__ __forceinline__ float sum8(float v) { v = DPP_ADD(v, 0xB1); v = DPP_ADD(v, 0x4E); v = DPP_ADD(v, 0x141); return v; }
__device__ __forceinline__ void transpose_item(const float* W, int ldw, int k0, int n0, bf16* WT, int ldk, int dst_row0, const float* kscale, LAS float* scr, int lane, int kmax = 1 << 30) {
    const int r8 = lane >> 3, quad = lane & 7;
    f32x4 v[8];
#pragma unroll
    for (int i = 0; i < 8; ++i) { const int kk = r8 + 8 * i; v[i] = (k0 + kk < kmax) ? *(const GAS f32x4*)(W + (size_t)(k0 + kk) * ldw + n0 + quad * 4) : (f32x4){0.f, 0.f, 0.f, 0.f}; }
#pragma unroll
    for (int i = 0; i < 8; ++i) { const int kk = r8 + 8 * i; if (kscale) v[i] = v[i] * kscale[(k0 + kk < kmax) ? k0 + kk : 0]; *(LAS f32x4*)(scr + kk * 36 + ((quad ^ i) << 2)) = v[i]; }
    LDS_WAIT(); asm volatile("" ::: "memory");
    const int c = lane & 7;
#pragma unroll
    for (int j = 0; j < 4; ++j) { const int n = (lane >> 3) + 8 * j; const LAS float* sp = scr + (8 * c) * 36 + ((((n >> 2) ^ c) << 2) | (n & 3));
        v4u o; o.x = pk2(sp[0 * 36], sp[1 * 36]); o.y = pk2(sp[2 * 36], sp[3 * 36]); o.z = pk2(sp[4 * 36], sp[5 * 36]); o.w = pk2(sp[6 * 36], sp[7 * 36]);
        if (k0 + 8 * c < kmax) *(GAS v4u*)(WT + (size_t)(dst_row0 + n) * ldk + k0 + 8 * c) = o; }
    LDS_WAIT(); asm volatile("" ::: "memory");
}

struct Args { const float* in[31]; float* out; unsigned char* ws; int ph_lo, ph_hi, li, pad; };
typedef const __attribute__((address_space(4))) unsigned char* kaptr_t;
__device__ __forceinline__ kaptr_t ka_base() { kaptr_t p = (kaptr_t)__builtin_amdgcn_kernarg_segment_ptr(); asm volatile("" : "+s"(p)); return p; }
#define INP(k) (*(const float* const __attribute__((address_space(4)))*)(ka_base() + 8 * (k)))
#define OUTP() (*(float* const __attribute__((address_space(4)))*)(ka_base() + 8 * 31))
#define WSP() (*(unsigned char* const __attribute__((address_space(4)))*)(ka_base() + 8 * 32))
#define KA_INT(i) (*(const int __attribute__((address_space(4)))*)(ka_base() + 8 * 33 + 4 * (i)))

template <int PART> __device__ __forceinline__ void p0_weights(unsigned char* ws, LAS unsigned char* lds, int gw, int NGW, int wave, int lane) {
    LAS float* scr = (LAS float*)(lds + wave * 16384);
    bf16* WT_RKV = (bf16*)(ws + WS_WT_RKV); bf16* WT_LORA = (bf16*)(ws + WS_WT_LORA); bf16* WT_OUT = (bf16*)(ws + WS_WT_OUT); bf16* WT_KVQ = (bf16*)(ws + WS_WT_KVQ);
    bf16* WT_SBO = (bf16*)(ws + WS_WT_SBO); bf16* WT_GU = (bf16*)(ws + WS_WT_GU); bf16* WT_DN = (bf16*)(ws + WS_WT_DN);
    constexpr int I_UP = 32 + 32 + 96, I_RKV = 3 * 512, I_LORA = 32 + 32 + 80, I_OUT = 512, I_KV = 1024, I_Q = 512, I_SBO = 512, I_G = 32 * 128, I_U = 32 * 128, I_D = 32 * 128;
    constexpr int NDENSE = I_UP + I_RKV + I_LORA + I_OUT + I_KV + I_Q + I_SBO, NITEMS = NDENSE + I_G + I_U + I_D;
    constexpr int NLOOP = PART == 0 ? NDENSE : 3 * 2048; (void)NITEMS;
    for (int q_ = gw; q_ < NLOOP; q_ += NGW) {
        const int it = PART == 0 ? q_ : NDENSE + (q_ / 2048) * 4096 + 2048 * (PART - 1) + (q_ % 2048);
        int r = it;
        if (r < I_UP) {
            if (r < 32) transpose_item(INP(9), C, 0, 32 * r, (bf16*)(ws + WS_WT_W2), 64, 32 * r, nullptr, scr, lane);
            else if (r < 64) transpose_item(INP(12), C, 0, 32 * (r - 32), (bf16*)(ws + WS_WT_A2), 64, 32 * (r - 32), nullptr, scr, lane);
            else { const int q = r - 64, kb = q / 32, nb = q % 32; transpose_item(INP(14), C, 64 * kb, 32 * nb, (bf16*)(ws + WS_WT_G2), DG, 32 * nb, nullptr, scr, lane, DG); }
            continue; } r -= I_UP;
        if (r < I_RKV) { const int m = r / 512, q = r % 512, kb = q / 32, nb = q % 32; transpose_item(INP(6) + (size_t)m * C * C, C, 64 * kb, 32 * nb, WT_RKV, C, m * C + 32 * nb, nullptr, scr, lane); continue; } r -= I_RKV;
        if (r < I_LORA) {
            if (r < 32) { const int kb = r / 2, nb = r % 2; transpose_item(INP(8), DW, 64 * kb, 32 * nb, WT_LORA, C, 32 * nb, nullptr, scr, lane); }
            else if (r < 64) { const int q = r - 32, kb = q / 2, nb = q % 2; transpose_item(INP(11), DA, 64 * kb, 32 * nb, WT_LORA, C, 256 + 32 * nb, nullptr, scr, lane); }
            else { const int q = r - 64, kb = q / 5, nb = q % 5; transpose_item(INP(13), DG, 64 * kb, 32 * nb, WT_LORA, C, 512 + 32 * nb, nullptr, scr, lane); }
            continue; } r -= I_LORA;
        if (r < I_OUT) { const int kb = r / 32, nb = r % 32; transpose_item(INP(20), C, 64 * kb, 32 * nb, WT_OUT, C, 32 * nb, nullptr, scr, lane); continue; } r -= I_OUT;
        if (r < I_KV) { const int kb = r / 64, nb = r % 64; transpose_item(INP(21), 2 * C, 64 * kb, 32 * nb, WT_KVQ, C, 32 * nb, INP(3), scr, lane); continue; } r -= I_KV;
        if (r < I_Q) { const int kb = r / 32, nb = r % 32; transpose_item(INP(22), C, 64 * kb, 32 * nb, WT_KVQ, C, 2 * C + 32 * nb, INP(1) + C, scr, lane); continue; } r -= I_Q;
        if (r < I_SBO) { const int kb = r / 32, nb = r % 32; transpose_item(INP(23), C, 64 * kb, 32 * nb, WT_SBO, C, 32 * nb, nullptr, scr, lane); continue; } r -= I_SBO;
        if (r < I_G) { const int le = r / 128, q = r % 128, kb = q / 8, nb = q % 8, f0 = 32 * nb; transpose_item(INP(28) + (size_t)le * C * FE, FE, 64 * kb, f0, WT_GU + (size_t)le * 512 * C, C, 256 * (f0 / 128) + (f0 % 128), INP(2) + (le >> 4) * C, scr, lane); continue; } r -= I_G;
        if (r < I_U) { const int le = r / 128, q = r % 128, kb = q / 8, nb = q % 8, f0 = 32 * nb; transpose_item(INP(29) + (size_t)le * C * FE, FE, 64 * kb, f0, WT_GU + (size_t)le * 512 * C, C, 256 * (f0 / 128) + 128 + (f0 % 128), INP(2) + (le >> 4) * C, scr, lane); continue; } r -= I_U;
        { const int le = r / 128, q = r % 128, kb = q / 32, nb = q % 32; transpose_item(INP(30) + (size_t)le * FE * C, C, 64 * kb, 32 * nb, WT_DN + (size_t)le * C * FE, FE, 32 * nb, nullptr, scr, lane); }
    }
    if (PART == 0) for (int it = gw * 64 + lane; it < 768 * 128; it += NGW * 64) { const int row = it >> 7, ch = it & 127;
        const bool valid = (row < 64) || (row >= 256 && row < 320) || (row >= 512 && row < 672);
        if (!valid) *(GAS v4u*)(WT_LORA + (size_t)row * C + ch * 8) = (v4u){0u, 0u, 0u, 0u}; }
}
__device__ __forceinline__ void load_row(const float* p, int lane, f32x4 (&v)[4]) {
#pragma unroll
    for (int j = 0; j < 4; ++j) v[j] = ((const GAS f32x4*)p)[64 * j + lane];
}
__device__ __forceinline__ void load_row_bf(const bf16* p, int lane, f32x4 (&v)[4]) {
#pragma unroll
    for (int j = 0; j < 4; ++j) { const v2u w = ((const GAS v2u*)p)[64 * j + lane]; v[j] = (f32x4){bflo(w.x), bfhi(w.x), bflo(w.y), bfhi(w.y)}; }
}
__device__ __forceinline__ float row_rs(const f32x4 (&v)[4], int lane) {
    float s = 0.f;
#pragma unroll
    for (int j = 0; j < 4; ++j) s += (v[j].x * v[j].x + v[j].y * v[j].y) + (v[j].z * v[j].z + v[j].w * v[j].w);
    return 1.0f / sqrtf(wave_sum(s, lane) * (1.0f / C) + RMS_EPS);
}
__device__ __forceinline__ void store_row_bf16(bf16* p, int lane, const f32x4 (&v)[4]) {
#pragma unroll
    for (int j = 0; j < 4; ++j) { v2u o; o.x = pk2(v[j].x, v[j].y); o.y = pk2(v[j].z, v[j].w); ((GAS v2u*)p)[64 * j + lane] = o; }
}
__device__ __forceinline__ void p0_rows(unsigned char* ws, int gw, int NGW, int lane) {
    const float* x = INP(0); const float* gain = INP(1); const float* mix = INP(5);
    f32x4 g[4]; load_row(gain, lane, g);
    f32x4 mx[6][4];
#pragma unroll
    for (int i = 0; i < 6; ++i) load_row(mix + i * C, lane, mx[i]);
    for (int run = gw; run < M / 8; run += NGW) {
        const int r0 = run * 8;
        f32x4 prev[4], nx[4];
        load_row(x + (size_t)r0 * C, lane, nx);
        if ((r0 % SEQ) == 0) {
#pragma unroll
            for (int j = 0; j < 4; ++j) prev[j] = (f32x4){0.f, 0.f, 0.f, 0.f};
        } else { load_row(x + (size_t)(r0 - 1) * C, lane, prev); const float rs = row_rs(prev, lane);
#pragma unroll
            for (int j = 0; j < 4; ++j) prev[j] = prev[j] * rs * g[j]; }
#pragma unroll 1
        for (int rr = 0; rr < 8; ++rr) {
            const int row = r0 + rr;
            f32x4 hn[4];
#pragma unroll
            for (int j = 0; j < 4; ++j) hn[j] = nx[j];
            if (rr < 7) load_row(x + (size_t)(row + 1) * C, lane, nx);
            const float rs = row_rs(hn, lane);
#pragma unroll
            for (int j = 0; j < 4; ++j) hn[j] = hn[j] * rs * g[j];
#pragma unroll
            for (int i = 0; i < 6; ++i) { f32x4 o[4];
#pragma unroll
                for (int j = 0; j < 4; ++j) o[j] = hn[j] + (prev[j] - hn[j]) * mx[i][j];
                bf16* dst = i < 2 ? (bf16*)OUTP() + (size_t)i * M * C : (i == 2 ? (bf16*)(ws + WS_B4) : (bf16*)(ws + WS_B1) + (size_t)(i - 3) * M * C);
                store_row_bf16(dst + (size_t)row * C, lane, o); }
#pragma unroll
            for (int j = 0; j < 4; ++j) prev[j] = hn[j];
        }
    }
}

template <int NN, int NGROUPS> struct SchedGrouped {
    static constexpr int K = C;
    const char* A0; size_t astride; const char* A2; const char* B; size_t bgroup;
    int G, c;
    __device__ __forceinline__ bool next(int i, pg8::Unit& u) const {
        const int L = i * G + c; constexpr int per = 64 * NN; if (L >= per * NGROUPS) return false;
        const int g = L / per, w = L % per; pg8::tile_map(w, 64, NN, u.pm, u.pn); u.aux = g; u.r0 = 0; u.cnt = 0; return true; }
    __device__ __forceinline__ const char* a_base(const pg8::Unit& u) const { const char* A = (A2 != nullptr && u.aux == 2) ? A2 : A0 + (size_t)u.aux * astride; return A + (size_t)u.pm * 256 * K * 2; }
    __device__ __forceinline__ const char* b_base(const pg8::Unit& u) const { return B + (size_t)u.aux * bgroup + (size_t)u.pn * 256 * K * 2; }
    __device__ __forceinline__ unsigned a_row_off(const pg8::Unit&, int) const { return 0u; }
};
template <int NN, int K, bool GATHER> struct SchedMoe {
    const char* A; const char* B; size_t bexp; const unsigned* list; volatile LAS int* tab; int G, c;
    __device__ __forceinline__ bool next(int i, pg8::Unit& u) const {
        const int L = i * G + c; const int tot = __builtin_amdgcn_readfirstlane(tab[48]) * NN; if (L >= tot) return false;
        u.pm = L / NN; u.pn = L % NN; int e = 0;
#pragma unroll
        for (int j = 0; j < 16; ++j) e += (u.pm >= tab[32 + j]) ? 1 : 0;
        e = __builtin_amdgcn_readfirstlane(e);
        u.aux = e; u.r0 = (u.pm - __builtin_amdgcn_readfirstlane(tab[16 + e])) * 256; u.cnt = __builtin_amdgcn_readfirstlane(tab[e]); return true; }
    __device__ __forceinline__ const char* a_base(const pg8::Unit& u) const { return GATHER ? A : A + (size_t)u.pm * 256 * K * 2; }
    __device__ __forceinline__ const char* b_base(const pg8::Unit& u) const { return B + (size_t)u.aux * bexp + (size_t)u.pn * 256 * K * 2; }
    __device__ __forceinline__ unsigned a_row_off(const pg8::Unit& u, int r) const {
        const int idx = u.r0 + r; unsigned tok = 0u;
        if (idx < u.cnt) tok = list[(size_t)u.aux * M + idx] >> 1;
        return tok * (unsigned)(K * 2); }
};

using pg8::f32x4;
using pg8::Unit;
__device__ __forceinline__ v4u pack8(f32x4 v0, f32x4 v1) { v4u w; w.x = pg8::cvt_pk_bf16(v0[0], v0[1]); w.y = pg8::cvt_pk_bf16(v0[2], v0[3]); w.z = pg8::cvt_pk_bf16(v1[0], v1[1]); w.w = pg8::cvt_pk_bf16(v1[2], v1[3]); return w; }

struct EpiLora {
    static constexpr bool PERM = true;
    bf16* LW;
    __device__ __forceinline__ void operator()(const f32x4 (&acc)[2][2][4][2], const Unit& u, int wr, int wc, int fr, int fq) const {
        { int l_; asm volatile("v_mbcnt_lo_u32_b32 %0, -1, 0\n\tv_mbcnt_hi_u32_b32 %0, -1, %0" : "=v"(l_)); fr = l_ & 15; fq = l_ >> 4; }
        const int g = u.aux, width = g == 2 ? DG : DW; bf16* out = LW + (size_t)g * (1u << 20);
        const int row0 = u.pm * 256 + wr * 64 + fr;
#pragma unroll
        for (int bj = 0; bj < 2; ++bj) { const int col0 = bj * 128 + wc * 32 + 8 * fq; if (col0 < width) {
#pragma unroll
            for (int ai = 0; ai < 2; ++ai)
#pragma unroll
                for (int m = 0; m < 4; ++m) { f32x4 v0 = acc[ai][bj][m][0], v1 = acc[ai][bj][m][1];
                    if (g == 0) {
#pragma unroll
                        for (int q = 0; q < 4; ++q) { v0[q] = tanhf(v0[q]); v1[q] = tanhf(v1[q]); } }
                    else if (g == 2) {
#pragma unroll
                        for (int q = 0; q < 4; ++q) { v0[q] = sigmoidf_(v0[q]); v1[q] = sigmoidf_(v1[q]); } }
                    *(GAS v4u*)(out + (size_t)(row0 + ai * 128 + m * 16) * width + col0) = pack8(v0, v1); } } }
    }
};
struct EpiSplit3 {
    static constexpr bool PERM = true;
    bf16* O0; bool bycol; const float* rowscale;
    __device__ __forceinline__ void operator()(const f32x4 (&acc)[2][2][4][2], const Unit& u, int wr, int wc, int fr, int fq) const {
        { int l_; asm volatile("v_mbcnt_lo_u32_b32 %0, -1, 0\n\tv_mbcnt_hi_u32_b32 %0, -1, %0" : "=v"(l_)); fr = l_ & 15; fq = l_ >> 4; }
        const int g = bycol ? (u.pn >> 2) : u.aux, pn = bycol ? (u.pn & 3) : u.pn; bf16* out = O0 + (size_t)g * ((size_t)M * C);
        const int row0 = u.pm * 256 + wr * 64 + fr, col0 = pn * 256 + wc * 32 + 8 * fq;
#pragma unroll
        for (int ai = 0; ai < 2; ++ai)
#pragma unroll
            for (int m = 0; m < 4; ++m)
                { const float sc = rowscale ? rowscale[row0 + ai * 128 + m * 16] : 1.0f;
#pragma unroll
                for (int bj = 0; bj < 2; ++bj) *(GAS v4u*)(out + (size_t)(row0 + ai * 128 + m * 16) * C + col0 + bj * 128) = pack8(acc[ai][bj][m][0] * sc, acc[ai][bj][m][1] * sc); }
    }
};
template <bool BASE_F32> struct EpiResidBf {
    static constexpr bool PERM = true;
    const void* base; bf16* out;
    __device__ __forceinline__ void operator()(const f32x4 (&acc)[2][2][4][2], const Unit& u, int wr, int wc, int fr, int fq) const {
        { int l_; asm volatile("v_mbcnt_lo_u32_b32 %0, -1, 0\n\tv_mbcnt_hi_u32_b32 %0, -1, %0" : "=v"(l_)); fr = l_ & 15; fq = l_ >> 4; }
        const int row0 = u.pm * 256 + wr * 64 + fr, col0 = u.pn * 256 + wc * 32 + 8 * fq;
#pragma unroll
        for (int ai = 0; ai < 2; ++ai)
#pragma unroll
            for (int m = 0; m < 4; ++m) { const size_t off = (size_t)(row0 + ai * 128 + m * 16) * C + col0;
#pragma unroll
                for (int bj = 0; bj < 2; ++bj) { f32x4 b0, b1;
                    if (BASE_F32) { b0 = *(const GAS f32x4*)((const float*)base + off + bj * 128); b1 = *(const GAS f32x4*)((const float*)base + off + bj * 128 + 4); }
                    else { const v4u w = *(const GAS v4u*)((const bf16*)base + off + bj * 128); b0 = (f32x4){bflo(w.x), bfhi(w.x), bflo(w.y), bfhi(w.y)}; b1 = (f32x4){bflo(w.z), bfhi(w.z), bflo(w.w), bfhi(w.w)}; }
                    *(GAS v4u*)(out + off + bj * 128) = pack8(b0 + acc[ai][bj][m][0], b1 + acc[ai][bj][m][1]); }
                asm volatile("" ::: "memory"); }
    }
};
struct EpiGU {
    static constexpr bool PERM = true;
    bf16* HID; const float* wl; const float* rsl;
    __device__ __forceinline__ void operator()(const f32x4 (&acc)[2][2][4][2], const Unit& u, int wr, int wc, int fr, int fq) const {
        { int l_; asm volatile("v_mbcnt_lo_u32_b32 %0, -1, 0\n\tv_mbcnt_hi_u32_b32 %0, -1, %0" : "=v"(l_)); fr = l_ & 15; fq = l_ >> 4; }
        const int e = u.aux, cnt = u.cnt, base = u.r0, r0 = wr * 64 + fr, col0 = u.pn * 128 + wc * 32 + 8 * fq;
#pragma unroll
        for (int ai = 0; ai < 2; ++ai)
#pragma unroll
            for (int m = 0; m < 4; ++m) { const int r = r0 + ai * 128 + m * 16, idx = base + r; float w = 0.f, rs = 0.f; if (idx < cnt) { w = wl[(size_t)e * M + idx]; rs = rsl[(size_t)e * M + idx]; }
                f32x4 h0, h1;
#pragma unroll
                for (int q = 0; q < 4; ++q) { const float g0 = acc[ai][0][m][0][q] * rs, g1 = acc[ai][0][m][1][q] * rs;
                    h0[q] = g0 * sigmoidf_(g0) * (acc[ai][1][m][0][q] * rs) * w; h1[q] = g1 * sigmoidf_(g1) * (acc[ai][1][m][1][q] * rs) * w; }
                *(GAS v4u*)(HID + (size_t)(u.pm * 256 + r) * FE + col0) = pack8(h0, h1);
                asm volatile("" ::: "memory"); }
    }
};
struct EpiDown {
    static constexpr bool PERM = true;
    bf16* EO; const unsigned* list;
    __device__ __forceinline__ void operator()(const f32x4 (&acc)[2][2][4][2], const Unit& u, int wr, int wc, int fr, int fq) const {
        { int l_; asm volatile("v_mbcnt_lo_u32_b32 %0, -1, 0\n\tv_mbcnt_hi_u32_b32 %0, -1, %0" : "=v"(l_)); fr = l_ & 15; fq = l_ >> 4; }
        const int e = u.aux, cnt = u.cnt, base = u.r0, r0 = wr * 64 + fr, col0 = u.pn * 256 + wc * 32 + 8 * fq;
#pragma unroll
        for (int ai = 0; ai < 2; ++ai)
#pragma unroll
            for (int m = 0; m < 4; ++m) { const int idx = base + r0 + ai * 128 + m * 16;
                if (idx < cnt) { const unsigned ent = list[(size_t)e * M + idx]; bf16* o = EO + ((size_t)(ent & 1u) * M + (ent >> 1)) * C + col0;
#pragma unroll
                    for (int bj = 0; bj < 2; ++bj) *(GAS v4u*)(o + bj * 128) = pack8(acc[ai][bj][m][0], acc[ai][bj][m][1]); }
                asm volatile("" ::: "memory"); }
    }
};

typedef short bf16x8s __attribute__((ext_vector_type(8)));
typedef short bf16x4s __attribute__((ext_vector_type(4)));
typedef short v4i16_t __attribute__((ext_vector_type(4)));
constexpr int TPB = 144;
constexpr int TILE_B = 64 * TPB;
constexpr int FP = 68;
constexpr int CS_FA = 0, CS_FB = 16384, CS_TILES = 32768, CS_TOT = CS_TILES + 12 * TILE_B, CS_WL = CS_TOT + 2048, CS_PAR = CS_WL + 256;
static_assert(CS_PAR + 768 <= LDSCTL_OFF, "scan LDS map");
#define TILE(n) (lds + CS_TILES + (n) * TILE_B)
#define F4Z (f32x4){0.f, 0.f, 0.f, 0.f}
__device__ __forceinline__ bf16x8s ldfrag(const LAS unsigned char* tile, int row, int kcol) { return *(const LAS bf16x8s*)(tile + row * TPB + kcol * 2); }
__device__ __forceinline__ bf16x8s ldfrag_tr(const LAS unsigned char* tile, int n0, int k0, int lane) {
    const int g = lane >> 4, q = (lane & 15) >> 2, p = lane & 3;
    const LAS unsigned char* a = tile + (k0 + 8 * g + q) * TPB + (n0 + 4 * p) * 2;
    const v4i16_t lo = __builtin_amdgcn_ds_read_tr16_b64_v4i16((LAS v4i16_t*)a), hi = __builtin_amdgcn_ds_read_tr16_b64_v4i16((LAS v4i16_t*)(a + 4 * TPB));
    return (bf16x8s){lo[0], lo[1], lo[2], lo[3], hi[0], hi[1], hi[2], hi[3]};
}
__device__ __forceinline__ bf16x8s ldfrag_perm(const LAS unsigned char* tile, int row, int ks, int g) {
    const bf16x4s lo = *(const LAS bf16x4s*)(tile + row * TPB + (32 * ks + 4 * g) * 2), hi = *(const LAS bf16x4s*)(tile + row * TPB + (32 * ks + 16 + 4 * g) * 2);
    return (bf16x8s){lo[0], lo[1], lo[2], lo[3], hi[0], hi[1], hi[2], hi[3]};
}
__device__ __forceinline__ void lds_barrier() { asm volatile("s_waitcnt lgkmcnt(0)" ::: "memory"); __builtin_amdgcn_s_barrier(); asm volatile("" ::: "memory"); }
#define MFMA16(a, b, c) __builtin_amdgcn_mfma_f32_16x16x32_bf16((a), (b), (c), 0, 0, 0)
__device__ __forceinline__ void mm64(f32x4 (&acc)[2], const LAS unsigned char* At, const LAS unsigned char* Bt, int rt, int ch, int fr, int g) {
#pragma unroll
    for (int ks = 0; ks < 2; ++ks) { const bf16x8s a = ldfrag(At, 16 * rt + fr, 32 * ks + 8 * g);
#pragma unroll
        for (int ct = 0; ct < 2; ++ct) acc[ct] = MFMA16(a, ldfrag(Bt, 32 * ch + 16 * ct + fr, 32 * ks + 8 * g), acc[ct]); }
}
__device__ __forceinline__ void mm64_bt(f32x4 (&acc)[2], const LAS unsigned char* At, const LAS unsigned char* X, int rt, int ch, int fr, int g, int lane) {
#pragma unroll
    for (int ks = 0; ks < 2; ++ks) { const bf16x8s a = ldfrag(At, 16 * rt + fr, 32 * ks + 8 * g);
#pragma unroll
        for (int ct = 0; ct < 2; ++ct) acc[ct] = MFMA16(a, ldfrag_tr(X, 32 * ch + 16 * ct, 32 * ks, lane), acc[ct]); }
}
__device__ __forceinline__ void mm64_at(f32x4 (&acc)[2], const LAS unsigned char* Xa, const LAS unsigned char* Bt, int rt, int ch, int fr, int g, int lane) {
#pragma unroll
    for (int ks = 0; ks < 2; ++ks) { const bf16x8s a = ldfrag_tr(Xa, 16 * rt, 32 * ks, lane);
#pragma unroll
        for (int ct = 0; ct < 2; ++ct) acc[ct] = MFMA16(a, ldfrag(Bt, 32 * ch + 16 * ct + fr, 32 * ks + 8 * g), acc[ct]); }
}
__device__ __forceinline__ void mm64_att(f32x4 (&acc)[2], const LAS unsigned char* Xa, const LAS unsigned char* X, int rt, int ch, int lane) {
#pragma unroll
    for (int ks = 0; ks < 2; ++ks) { const bf16x8s a = ldfrag_tr(Xa, 16 * rt, 32 * ks, lane);
#pragma unroll
        for (int ct = 0; ct < 2; ++ct) acc[ct] = MFMA16(a, ldfrag_tr(X, 32 * ch + 16 * ct, 32 * ks, lane), acc[ct]); }
}
__device__ __forceinline__ bf16x4s pack4(f32x4 v) { v2u w; w.x = pg8::cvt_pk_bf16(v[0], v[1]); w.y = pg8::cvt_pk_bf16(v[2], v[3]); return __builtin_bit_cast(bf16x4s, w); }
__device__ __forceinline__ f32x4 unpack4(bf16x4s s) { const v2u w = __builtin_bit_cast(v2u, s); return (f32x4){bflo(w.x), bfhi(w.x), bflo(w.y), bfhi(w.y)}; }
__device__ __forceinline__ void st_tr(LAS unsigned char* Out, const f32x4 (&acc)[2], int rt, int ch, int fr, int g) {
#pragma unroll
    for (int ct = 0; ct < 2; ++ct) *(LAS bf16x4s*)(Out + (32 * ch + 16 * ct + fr) * TPB + (16 * rt + 4 * g) * 2) = pack4(acc[ct]);
}
__device__ __forceinline__ void ld_tr(f32x4 (&acc)[2], const LAS unsigned char* In, int rt, int ch, int fr, int g) {
#pragma unroll
    for (int ct = 0; ct < 2; ++ct) acc[ct] = unpack4(*(const LAS bf16x4s*)(In + (32 * ch + 16 * ct + fr) * TPB + (16 * rt + 4 * g) * 2));
}
__device__ __forceinline__ void unpack8(v4u w, float (&o)[8]) { o[0] = bflo(w.x); o[1] = bfhi(w.x); o[2] = bflo(w.y); o[3] = bfhi(w.y); o[4] = bflo(w.z); o[5] = bfhi(w.z); o[6] = bflo(w.w); o[7] = bfhi(w.w); }
__device__ __forceinline__ v4u pack8f(const float (&o)[8]) { v4u w; w.x = pg8::cvt_pk_bf16(o[0], o[1]); w.y = pg8::cvt_pk_bf16(o[2], o[3]); w.z = pg8::cvt_pk_bf16(o[4], o[5]); w.w = pg8::cvt_pk_bf16(o[6], o[7]); return w; }

struct FrontIn { v4u r, k, v; bf16x8s fw[2], fa[2]; };
__device__ __forceinline__ void front_fetch(FrontIn& f, unsigned char* ws, int unit, int tid, int lane, int wave) {
    const int h = unit & 15, c = (unit >> 4) & 127, b = unit >> 11; const size_t row0 = (size_t)b * SEQ + c * 64;
    const int rt = wave & 3, fr = lane & 15, g = lane >> 4, t = tid >> 3, cq = tid & 7, c0 = h * HD + cq * 8;
    const bf16* Rb = (const bf16*)(ws + WS_B1); const bf16* Kb = (const bf16*)(ws + WS_B2); const bf16* Vb = (const bf16*)(ws + WS_B3);
    const bf16* LW = (const bf16*)(ws + WS_LW); const bf16* LA = (const bf16*)(ws + WS_LA);
    f.r = *(const GAS v4u*)(Rb + (row0 + t) * C + c0); f.k = *(const GAS v4u*)(Kb + (row0 + t) * C + c0); f.v = *(const GAS v4u*)(Vb + (row0 + t) * C + c0);
#pragma unroll
    for (int ks = 0; ks < 2; ++ks) { f.fw[ks] = *(const GAS bf16x8s*)(LW + (row0 + 16 * rt + fr) * DW + 32 * ks + 8 * g); f.fa[ks] = *(const GAS bf16x8s*)(LA + (row0 + 16 * rt + fr) * DA + 32 * ks + 8 * g); }
}
__device__ __forceinline__ v4u head_consts(unsigned char* ws, LAS unsigned char* lds, int h, int tid, int wtile, int atile) {
    const bf16* W2T = (const bf16*)(ws + WS_WT_W2); const bf16* A2T = (const bf16*)(ws + WS_WT_A2);
    const int row = tid >> 3, cq = tid & 7;
    const v4u w2chunk = *(const GAS v4u*)(W2T + (size_t)(h * HD + row) * 64 + cq * 8);
    *(LAS v4u*)(lds + CS_TILES + wtile * TILE_B + row * TPB + cq * 16) = w2chunk;
    *(LAS v4u*)(lds + CS_TILES + atile * TILE_B + row * TPB + cq * 16) = *(const GAS v4u*)(A2T + (size_t)(h * HD + row) * 64 + cq * 8);
    if (tid < 64) { LAS float* P = (LAS float*)(lds + CS_PAR); P[tid] = INP(15)[h * HD + tid]; P[64 + tid] = INP(16)[h * HD + tid]; P[128 + tid] = INP(17)[h * HD + tid]; }
    __syncthreads();
    return w2chunk;
}
template <int MODE>
__device__ __forceinline__ void chunk_front(const FrontIn& f, LAS unsigned char* lds, const float (&w0v)[2], const float (&a0v)[2], const bf16x8s (&w2f)[2][2], const bf16x8s (&a2f)[2][2], int tid, int lane, int wave, float (&v8)[8], float& rkb) {
    const int rt = wave & 3, ch = wave >> 2, fr = lane & 15, g = lane >> 4;
    LAS float* FA = (LAS float*)(lds + CS_FA); LAS float* FB = (LAS float*)(lds + CS_FB); LAS float* TOT = (LAS float*)(lds + CS_TOT);
    const int t = tid >> 3, cq = tid & 7;
    {
        f32x4 aw[2] = {F4Z, F4Z}, aa[2] = {F4Z, F4Z};
#pragma unroll
        for (int ks = 0; ks < 2; ++ks)
#pragma unroll
            for (int ct = 0; ct < 2; ++ct) { aw[ct] = MFMA16(f.fw[ks], w2f[ks][ct], aw[ct]); aa[ct] = MFMA16(f.fa[ks], a2f[ks][ct], aa[ct]); }
#pragma unroll
        for (int ct = 0; ct < 2; ++ct) { const int j = 32 * ch + 16 * ct + fr, js = j ^ ((g & 1) << 4); const float w0 = w0v[ct], a0 = a0v[ct];
            float p[4];
#pragma unroll
            for (int q = 0; q < 4; ++q) { p[q] = -0.6065306597126334f * sigmoidf_(w0 + aw[ct][q]); if (q) p[q] += p[q - 1]; }
            const float s_ = p[3];
            const float u1 = __int_as_float(__builtin_amdgcn_ds_bpermute(((lane - 16) & 63) << 2, __float_as_int(s_))); const float t1 = s_ + (g >= 1 ? u1 : 0.f);
            const float u2 = __int_as_float(__builtin_amdgcn_ds_bpermute(((lane - 32) & 63) << 2, __float_as_int(t1))); const float t2 = t1 + (g >= 2 ? u2 : 0.f);
            const float ex = t2 - s_;
#pragma unroll
            for (int q = 0; q < 4; ++q) { const int tt = 16 * rt + 4 * g + q; FA[tt * 64 + js] = p[q] + ex; FB[tt * 64 + js] = sigmoidf_(a0 + aa[ct][q]); }
            if (g == 3) TOT[rt * 64 + j] = t2; }
    }
    lds_barrier();
    {
        float r[8], k[8], pkk[8], pka[8], prk[8];
        unpack8(f.r, r); unpack8(f.k, k); unpack8(f.v, v8);
        { const LAS float* P = (const LAS float*)(lds + CS_PAR) + cq * 8; const f32x4 a0_ = *(const LAS f32x4*)P, a1_ = *(const LAS f32x4*)(P + 4), b0_ = *(const LAS f32x4*)(P + 64), b1_ = *(const LAS f32x4*)(P + 68), c0_ = *(const LAS f32x4*)(P + 128), c1_ = *(const LAS f32x4*)(P + 132);
#pragma unroll
          for (int q = 0; q < 4; ++q) { pkk[q] = a0_[q]; pkk[4 + q] = a1_[q]; pka[q] = b0_[q]; pka[4 + q] = b1_[q]; prk[q] = c0_[q]; prk[4 + q] = c1_[q]; } }
        float cw[8], cwp[8], ag[8];
        { const int tp = t > 0 ? t - 1 : 0, rtt = wave >> 1;
          const int ct_ = (cq ^ (((t >> 2) & 1) << 1)) * 8, cp_ = (cq ^ (((tp >> 2) & 1) << 1)) * 8;
          const f32x4 c0_ = *(const LAS f32x4*)(FA + t * 64 + ct_), c1_ = *(const LAS f32x4*)(FA + t * 64 + ct_ + 4), p0_ = *(const LAS f32x4*)(FA + tp * 64 + cp_), p1_ = *(const LAS f32x4*)(FA + tp * 64 + cp_ + 4);
          const f32x4 g0_ = *(const LAS f32x4*)(FB + t * 64 + ct_), g1_ = *(const LAS f32x4*)(FB + t * 64 + ct_ + 4);
          f32x4 o0_ = F4Z, o1_ = F4Z, l0_ = F4Z, l1_ = F4Z;
          for (int r_ = 0; r_ < rtt; ++r_) { l0_ = *(const LAS f32x4*)(TOT + r_ * 64 + cq * 8); l1_ = *(const LAS f32x4*)(TOT + r_ * 64 + cq * 8 + 4); o0_ = o0_ + l0_; o1_ = o1_ + l1_; }
          const bool first = (t & 15) == 0;
#pragma unroll
          for (int q = 0; q < 4; ++q) { cw[q] = c0_[q] + o0_[q]; cw[4 + q] = c1_[q] + o1_[q];
              cwp[q] = t > 0 ? p0_[q] + o0_[q] - (first ? l0_[q] : 0.f) : 0.f; cwp[4 + q] = t > 0 ? p1_[q] + o1_[q] - (first ? l1_[q] : 0.f) : 0.f; ag[q] = g0_[q]; ag[4 + q] = g1_[q]; } }
        float kk[8], ss = 0.f; rkb = 0.f;
#pragma unroll
        for (int q = 0; q < 8; ++q) { kk[q] = k[q] * pkk[q]; ss += kk[q] * kk[q]; }
        ss = sum8(ss);
        const float inv = 1.0f / fmaxf(sqrtf(ss), 1e-12f);
        float at[8], bt[8], kt[8], rt_[8];
#pragma unroll
        for (int q = 0; q < 8; ++q) { const float kn = kk[q] * inv, kp = k[q] * (1.0f + (ag[q] - 1.0f) * pka[q]);
            const float ein = __expf(-cw[q]);
            at[q] = -kn * __expf(cwp[q]); bt[q] = kn * ag[q] * ein; kt[q] = kp * ein;
            rt_[q] = r[q] * __expf(cw[q]); rkb += r[q] * kp * prk[q]; }
        rkb = sum8(rkb);
        *(LAS v4u*)(TILE(0) + t * TPB + cq * 16) = pack8f(at); *(LAS v4u*)(TILE(1) + t * TPB + cq * 16) = pack8f(bt); *(LAS v4u*)(TILE(2) + t * TPB + cq * 16) = pack8f(kt);
        *(LAS v4u*)(TILE(3) + t * TPB + cq * 16) = f.v;
        *(LAS v4u*)(TILE(6) + t * TPB + cq * 16) = pack8f(rt_);
        if (MODE == 1 && t == 63) {
#pragma unroll
            for (int q = 0; q < 8; ++q) ((LAS float*)(lds + CS_WL))[cq * 8 + q] = __expf(cw[q]); }
    }
    lds_barrier();
}

__device__ __forceinline__ void scan_s1(unsigned char* ws, LAS unsigned char* lds, int lane0, int wave) {
    const int rt = wave & 3, ch = wave >> 2;
    FrontIn fin; float w0v[2], a0v[2]; bf16x8s w2f[2][2], a2f[2][2];
    { int l0 = lane0; asm volatile("" : "+v"(l0)); const int hh = blockIdx.x & 15;
      if ((int)blockIdx.x < BATCH * NH * (SEQ / 64)) front_fetch(fin, ws, blockIdx.x, wave * 64 + l0, l0, wave);
      const bf16* W2T = (const bf16*)(ws + WS_WT_W2); const bf16* A2T = (const bf16*)(ws + WS_WT_A2);
#pragma unroll
      for (int ct = 0; ct < 2; ++ct) { w0v[ct] = INP(7)[hh * HD + 32 * ch + 16 * ct + (l0 & 15)]; a0v[ct] = INP(10)[hh * HD + 32 * ch + 16 * ct + (l0 & 15)];
#pragma unroll
          for (int ks = 0; ks < 2; ++ks) { const size_t wr_ = (size_t)(hh * HD + 32 * ch + 16 * ct + (l0 & 15)) * 64 + 32 * ks + 8 * (l0 >> 4); w2f[ks][ct] = *(const GAS bf16x8s*)(W2T + wr_); a2f[ks][ct] = *(const GAS bf16x8s*)(A2T + wr_); } }
      const int tid0 = wave * 64 + l0;
      if (tid0 < 64) { LAS float* P = (LAS float*)(lds + CS_PAR); P[tid0] = INP(15)[hh * HD + tid0]; P[64 + tid0] = INP(16)[hh * HD + tid0]; P[128 + tid0] = INP(17)[hh * HD + tid0]; }
      __syncthreads(); }
    for (int unit = blockIdx.x; unit < BATCH * NH * (SEQ / 64); unit += gridDim.x) {
        int lane = lane0; asm volatile("" : "+v"(lane));
        const int tid = wave * 64 + lane, fr = lane & 15, g = lane >> 4;
        const int h = unit & 15, c = (unit >> 4) & 127, b = unit >> 11; const size_t chunk = ((size_t)b * NH + h) * 128 + c;
        float v8[8]; float rkb;
        chunk_front<1>(fin, lds, w0v, a0v, w2f, a2f, tid, lane, wave, v8, rkb);
        { const size_t row0_ = (size_t)b * SEQ + c * 64; if ((tid & 7) == 0) ((float*)(ws + WS_HID))[(row0_ + (tid >> 3)) * NH + h] = rkb; }
        if (unit + (int)gridDim.x < BATCH * NH * (SEQ / 64)) front_fetch(fin, ws, unit + gridDim.x, tid, lane, wave);
        {
            f32x4 a2[2] = {F4Z, F4Z}, a3[2] = {F4Z, F4Z};
            mm64(a2, TILE(1), TILE(0), rt, ch, fr, g);
            mm64(a3, TILE(2), TILE(0), rt, ch, fr, g);
            f32x4 p1[2];
#pragma unroll
            for (int ct = 0; ct < 2; ++ct) { const int col = 32 * ch + 16 * ct + fr;
#pragma unroll
                for (int q = 0; q < 4; ++q) { const int row = 16 * rt + 4 * g + q;
                    a2[ct][q] = row < col ? a2[ct][q] : 0.f;
                    p1[ct][q] = a2[ct][q] + (row == col ? 1.0f : 0.f);
                    a3[ct][q] = row < col ? a3[ct][q] : 0.f; } }
            st_tr(TILE(5), a2, rt, ch, fr, g);
            st_tr(TILE(9), p1, rt, ch, fr, g);
            st_tr(TILE(4), a3, rt, ch, fr, g);
        }
        lds_barrier();
#pragma unroll
        for (int r = 0; r < 6; ++r) {
            LAS unsigned char* Sr = TILE(5 + 2 * (r & 1)); LAS unsigned char* Sr2 = TILE(5 + 2 * ((r & 1) ^ 1));
            if (r <= 4) { f32x4 q2[2] = {F4Z, F4Z};
                mm64_at(q2, Sr, Sr, rt, ch, fr, g, lane);
                st_tr(Sr2, q2, rt, ch, fr, g); }
            if (r >= 1) { LAS unsigned char* Pr = TILE(9 + ((r - 1) & 1)); LAS unsigned char* Pr2 = TILE(9 + (((r - 1) & 1) ^ 1));
                f32x4 pa[2]; ld_tr(pa, Pr, rt, ch, fr, g);
                mm64_at(pa, Sr, Pr, rt, ch, fr, g, lane);
                st_tr(Pr2, pa, rt, ch, fr, g); }
            if (r == 0) { f32x4 gg[2] = {F4Z, F4Z};
                mm64_bt(gg, TILE(4), TILE(3), rt, ch, fr, g, lane);
                st_tr(TILE(11), gg, rt, ch, fr, g); }
            lds_barrier();
        }
        {
            f32x4 acc[2] = {F4Z, F4Z}, ac2[2] = {F4Z, F4Z};
            mm64_bt(acc, TILE(10), TILE(0), rt, ch, fr, g, lane);
            mm64(ac2, TILE(10), TILE(11), rt, ch, fr, g);
            st_tr(TILE(5), acc, rt, ch, fr, g); st_tr(TILE(7), ac2, rt, ch, fr, g);
            f32x4 b2[2] = {F4Z, F4Z}, b3[2] = {F4Z, F4Z};
            mm64(b2, TILE(1), TILE(6), rt, ch, fr, g); mm64(b3, TILE(2), TILE(6), rt, ch, fr, g);
#pragma unroll
            for (int ct = 0; ct < 2; ++ct) { const int t = 32 * ch + 16 * ct + fr;
#pragma unroll
                for (int q = 0; q < 4; ++q) { const int s_ = 16 * rt + 4 * g + q; b2[ct][q] = s_ <= t ? b2[ct][q] : 0.f; b3[ct][q] = s_ <= t ? b3[ct][q] : 0.f; } }
            st_tr(TILE(4), b2, rt, ch, fr, g); st_tr(TILE(9), b3, rt, ch, fr, g);
        }
        lds_barrier();
        {
            const LAS float* WL = (const LAS float*)(lds + CS_WL);
            f32x4 acc[2] = {F4Z, F4Z};
            mm64_bt(acc, TILE(5), TILE(1), rt, ch, fr, g, lane);
            bf16* Mg = (bf16*)(ws + WS_B0) + chunk * 4096;
#pragma unroll
            for (int ct = 0; ct < 2; ++ct) { const int j1 = 32 * ch + 16 * ct + fr; const float wl = WL[j1];
#pragma unroll
                for (int q = 0; q < 4; ++q) { const int j2 = 16 * rt + 4 * g + q; acc[ct][q] = wl * (acc[ct][q] + (j2 == j1 ? 1.0f : 0.f)); }
                const int rtS = 2 * ch + ct, ksS = rt >> 1, half = rt & 1;
                *(GAS bf16x4s*)(Mg + (((rtS * 2 + ksS) * 64 + g * 16 + fr) * 8 + half * 4)) = pack4(acc[ct]); }
            f32x4 ad[2] = {F4Z, F4Z};
            mm64_at(ad, TILE(1), TILE(7), rt, ch, fr, g, lane);
            mm64_att(ad, TILE(2), TILE(3), rt, ch, lane);
            const f32x4 wl4 = *(const LAS f32x4*)(WL + 16 * rt + 4 * g);
            bf16* Dg = (bf16*)OUTP() + chunk * 4096;
#pragma unroll
            for (int ct = 0; ct < 2; ++ct) *(GAS bf16x4s*)(Dg + (((2 * ch + ct) * 4 + rt) * 64 + lane) * 4) = pack4(ad[ct] * wl4);
            const size_t row0_ = (size_t)b * SEQ + c * 64;
            f32x4 ar[2]; ld_tr(ar, TILE(6), rt, ch, fr, g);
            mm64(ar, TILE(5), TILE(4), rt, ch, fr, g);
            f32x4 ay[2] = {F4Z, F4Z};
            mm64(ay, TILE(7), TILE(4), rt, ch, fr, g); mm64_at(ay, TILE(3), TILE(9), rt, ch, fr, g, lane);
            bf16* Rg = (bf16*)(ws + WS_B1); bf16* Kg = (bf16*)(ws + WS_B2);
#pragma unroll
            for (int ct = 0; ct < 2; ++ct) { const size_t o_ = (row0_ + 32 * ch + 16 * ct + fr) * C + h * HD + 16 * rt + 4 * g; *(GAS bf16x4s*)(Rg + o_) = pack4(ar[ct]); *(GAS bf16x4s*)(Kg + o_) = pack4(ay[ct]); }
        }
        lds_barrier();
    }
}

constexpr int S2_PD = 6;
__device__ __forceinline__ void scan_s2(unsigned char* ws, LAS unsigned char* lds, int lane, int wave) {
    for (int bh = blockIdx.x; bh < BATCH * NH; bh += gridDim.x) {
        const unsigned char* Mg = (const unsigned char*)((const bf16*)(ws + WS_B0) + (size_t)bh * 128 * 4096); const unsigned char* Dg = (const unsigned char*)((const bf16*)OUTP() + (size_t)bh * 128 * 4096);
        bf16* Sg = (bf16*)OUTP() + (size_t)M * C + (size_t)bh * 128 * 4096;
        if (wave >= 4) {
            const int lw = wave - 4;
            const unsigned char* src = (lw < 2 ? Mg + lw * 4096 : Dg + (lw - 2) * 4096) + lane * 16;
            LAS unsigned char* dst = lds + lw * 4096 + lane * 16;
            v4u q[S2_PD][4];
#define S2_LOADQ(j, c) do { _Pragma("unroll") for (int i_ = 0; i_ < 4; ++i_) q[j][i_] = *(const GAS v4u*)(src + (size_t)(c) * 8192 + i_ * 1024); } while (0)
#define S2_STOREQ(j, slot) do { _Pragma("unroll") for (int i_ = 0; i_ < 4; ++i_) *(LAS v4u*)(dst + (slot) * 16384 + i_ * 1024) = q[j][i_]; } while (0)
#pragma unroll
            for (int j = 0; j < S2_PD; ++j) S2_LOADQ(j, j);
            S2_STOREQ(0, 0); S2_LOADQ(0, S2_PD);
            lds_barrier();
#pragma unroll 1
            for (int s0 = 0; s0 < 128; s0 += S2_PD) {
#pragma unroll
                for (int jj = 0; jj < S2_PD; ++jj) { const int step = s0 + jj;
                    if (step + 1 < 128) S2_STOREQ((jj + 1) % S2_PD, (step + 1) & 1);
                    if (step + 1 + S2_PD < 128) S2_LOADQ((jj + 1) % S2_PD, step + 1 + S2_PD);
                    lds_barrier(); }
            }
#undef S2_LOADQ
#undef S2_STOREQ
        } else {
            const int ct = wave;
            f32x4 acc[4];
#pragma unroll
            for (int r = 0; r < 4; ++r) acc[r] = F4Z;
            lds_barrier();
#pragma unroll 1
            for (int s0 = 0; s0 < 128; s0 += S2_PD) {
#pragma unroll
                for (int jj = 0; jj < S2_PD; ++jj) { const int step = s0 + jj;
                    if (step < 128) {
                        const LAS unsigned char* slot = lds + (step & 1) * 16384;
                        bf16x8s sf[2];
#pragma unroll
                        for (int ks = 0; ks < 2; ++ks) { const bf16x4s lo = pack4(acc[2 * ks]), hi = pack4(acc[2 * ks + 1]); sf[ks] = (bf16x8s){lo[0], lo[1], lo[2], lo[3], hi[0], hi[1], hi[2], hi[3]}; }
#pragma unroll
                        for (int ks = 0; ks < 2; ++ks) *(GAS bf16x8s*)(Sg + (size_t)step * 4096 + ((ct * 2 + ks) * 64 + lane) * 8) = sf[ks];
                        f32x4 na[4];
#pragma unroll
                        for (int r = 0; r < 4; ++r) na[r] = unpack4(*(const LAS bf16x4s*)(slot + 8192 + ((ct * 4 + r) * 64 + lane) * 8));
#pragma unroll
                        for (int ks = 0; ks < 2; ++ks)
#pragma unroll
                            for (int r = 0; r < 4; ++r) na[r] = MFMA16(*(const LAS bf16x8s*)(slot + ((r * 2 + ks) * 64 + lane) * 16), sf[ks], na[r]);
#pragma unroll
                        for (int r = 0; r < 4; ++r) acc[r] = na[r];
                    }
                    lds_barrier(); }
            }
        }
    }
}

constexpr int S3_RT = 32768, S3_YT = S3_RT + TILE_B, S3_LG = S3_YT + TILE_B, S3_LGP = 336;
struct S3In { v4u rr, yy, vv, lg[3]; bf16x8s sA[2]; float rkb; };
__device__ __forceinline__ void s3_fetch(S3In& f, unsigned char* ws, int unit, int tid, int lane, int wave) {
    const int h = unit & 15, c = (unit >> 4) & 127, b = unit >> 11; const size_t chunk = ((size_t)b * NH + h) * 128 + c, row0 = (size_t)b * SEQ + c * 64;
    const int rt = wave & 3, et = tid >> 3, ecq = tid & 7;
    const bf16* Rg = (const bf16*)(ws + WS_B1); const bf16* Kg = (const bf16*)(ws + WS_B2); const bf16* Vb = (const bf16*)(ws + WS_B3); const bf16* LG = (const bf16*)(ws + WS_LG);
    const bf16* Sg = (const bf16*)OUTP() + (size_t)M * C + chunk * 4096;
    const size_t o_ = (row0 + et) * C + h * HD + ecq * 8;
    f.rr = *(const GAS v4u*)(Rg + o_); f.yy = *(const GAS v4u*)(Kg + o_); f.vv = *(const GAS v4u*)(Vb + o_);
#pragma unroll
    for (int i = 0; i < 3; ++i) { const int chn = tid + 512 * i; if (chn < 64 * 20) f.lg[i] = *(const GAS v4u*)(LG + (row0 + chn / 20) * DG + (chn % 20) * 8); }
#pragma unroll
    for (int ks = 0; ks < 2; ++ks) f.sA[ks] = *(const GAS bf16x8s*)(Sg + ((rt * 2 + ks) * 64 + lane) * 8);
    f.rkb = ((const float*)(ws + WS_HID))[(row0 + et) * NH + h];
}
__device__ __forceinline__ void scan_s3(unsigned char* ws, LAS unsigned char* lds, int lane0, int wave) {
    const int rt = wave & 3, ch = wave >> 2;
    LAS float* Ys = (LAS float*)(lds + CS_FA);
    const bf16* G2T = (const bf16*)(ws + WS_WT_G2); bf16* YG = (bf16*)(ws + WS_B0);
    constexpr int NU = BATCH * NH * (SEQ / 64);
    S3In fin; bf16x8s gA[5]; f32x4 lnw0, lnw1, lnb0, lnb1;
    { int l0 = lane0; asm volatile("" : "+v"(l0)); const int hh = blockIdx.x & 15, t0_ = wave * 64 + l0;
      if ((int)blockIdx.x < NU) s3_fetch(fin, ws, blockIdx.x, t0_, l0, wave);
#pragma unroll
      for (int ks = 0; ks < 5; ++ks) gA[ks] = *(const GAS bf16x8s*)(G2T + (size_t)(hh * HD + 16 * rt + (l0 & 15)) * DG + 32 * ks + 8 * (l0 >> 4));
      const int ec0 = hh * HD + (t0_ & 7) * 8;
      lnw0 = *(const GAS f32x4*)(INP(18) + ec0); lnw1 = *(const GAS f32x4*)(INP(18) + ec0 + 4); lnb0 = *(const GAS f32x4*)(INP(19) + ec0); lnb1 = *(const GAS f32x4*)(INP(19) + ec0 + 4); }
    __syncthreads();
    for (int unit = blockIdx.x; unit < NU; unit += gridDim.x) {
        int lane = lane0; asm volatile("" : "+v"(lane));
        const int tid = wave * 64 + lane, fr = lane & 15, g = lane >> 4, et = tid >> 3, ecq = tid & 7;
        const int h = unit & 15, c = (unit >> 4) & 127, b = unit >> 11; const size_t row0 = (size_t)b * SEQ + c * 64;
        *(LAS v4u*)(lds + S3_RT + et * TPB + ecq * 16) = fin.rr; *(LAS v4u*)(lds + S3_YT + et * TPB + ecq * 16) = fin.yy;
#pragma unroll
        for (int i = 0; i < 3; ++i) { const int chn = tid + 512 * i; if (chn < 64 * 20) *(LAS v4u*)(lds + S3_LG + (chn / 20) * S3_LGP + (chn % 20) * 16) = fin.lg[i]; }
        float v8[8]; unpack8(fin.vv, v8); const float rkb = fin.rkb; const bf16x8s sA0 = fin.sA[0], sA1 = fin.sA[1];
        lds_barrier();
        if (unit + (int)gridDim.x < NU) s3_fetch(fin, ws, unit + gridDim.x, tid, lane, wave);
        f32x4 acc[2], ag[2] = {F4Z, F4Z};
#pragma unroll
        for (int ct = 0; ct < 2; ++ct) { const int t = 32 * ch + 16 * ct + fr;
            acc[ct] = unpack4(*(const LAS bf16x4s*)(lds + S3_YT + t * TPB + (16 * rt + 4 * g) * 2));
            acc[ct] = MFMA16(sA0, ldfrag_perm(lds + S3_RT, t, 0, g), acc[ct]); acc[ct] = MFMA16(sA1, ldfrag_perm(lds + S3_RT, t, 1, g), acc[ct]);
#pragma unroll
            for (int ks = 0; ks < 5; ++ks) ag[ct] = MFMA16(gA[ks], *(const LAS bf16x8s*)(lds + S3_LG + t * S3_LGP + (32 * ks + 8 * g) * 2), ag[ct]);
            *(LAS f32x4*)(Ys + t * FP + 16 * rt + 4 * g) = acc[ct]; }
        lds_barrier();
        {
            const f32x4 y0 = *(const LAS f32x4*)(Ys + et * FP + ecq * 8), y1 = *(const LAS f32x4*)(Ys + et * FP + ecq * 8 + 4);
            float y[8] = {y0[0], y0[1], y0[2], y0[3], y1[0], y1[1], y1[2], y1[3]};
            float s_ = 0.f;
#pragma unroll
            for (int q = 0; q < 8; ++q) s_ += y[q];
            s_ = sum8(s_);
            const float mu = s_ * (1.0f / HD); float vs = 0.f;
#pragma unroll
            for (int q = 0; q < 8; ++q) { y[q] -= mu; vs += y[q] * y[q]; }
            vs = sum8(vs);
            const float rstd = 1.0f / sqrtf(vs * (1.0f / HD) + GN_EPS);
            f32x4 o0, o1;
#pragma unroll
            for (int q = 0; q < 4; ++q) { o0[q] = y[q] * rstd * lnw0[q] + lnb0[q] + rkb * v8[q]; o1[q] = y[4 + q] * rstd * lnw1[q] + lnb1[q] + rkb * v8[4 + q]; }
            *(LAS f32x4*)(Ys + et * FP + ecq * 8) = o0; *(LAS f32x4*)(Ys + et * FP + ecq * 8 + 4) = o1;
        }
        lds_barrier();
#pragma unroll
        for (int ct = 0; ct < 2; ++ct) { const int t = 32 * ch + 16 * ct + fr; const f32x4 yv = *(const LAS f32x4*)(Ys + t * FP + 16 * rt + 4 * g);
            *(GAS bf16x4s*)(YG + (row0 + t) * C + h * HD + 16 * rt + 4 * g) = pack4(yv * ag[ct]); }
    }
    __syncthreads();
}
#undef TILE
#if MK_DEBUG
__device__ __forceinline__ void scan_naive(unsigned char* ws, LAS unsigned char* lds, int tid) {
    const int lane = tid & 63;
    const bf16* Rb = (const bf16*)(ws + WS_B1); const bf16* Kb = (const bf16*)(ws + WS_B2); const bf16* Vb = (const bf16*)(ws + WS_B3);
    const bf16* LW = (const bf16*)(ws + WS_LW); const bf16* LA = (const bf16*)(ws + WS_LA);
    float* Y = OUTP(); float* RK = (float*)(ws + WS_HID);
    LAS float* sR = (LAS float*)lds; LAS float* sK = sR + 4096; LAS float* sV = sK + 4096; LAS float* sA = sV + 4096; LAS float* sB = sA + 4096; LAS float* sD = sB + 4096;
    LAS float* sW2 = sD + 4096; LAS float* sA2 = sW2 + 4096;
    for (int unit = blockIdx.x; unit < BATCH * NH; unit += gridDim.x) {
        const int b = unit / NH, h = unit % NH;
        __syncthreads();
        for (int e = tid; e < 4096; e += 512) { const int d = e >> 6, j = e & 63; sW2[e] = INP(9)[(size_t)d * C + h * HD + j]; sA2[e] = INP(12)[(size_t)d * C + h * HD + j]; }
        __syncthreads();
        const int pt = tid >> 3, cq = tid & 7, c0 = h * HD + cq * 8;
        const int si = tid >> 3, jq = tid & 7;
        float S[8];
#pragma unroll
        for (int q = 0; q < 8; ++q) S[q] = 0.f;
        float w0v[8], a0v[8], kkv[8], kav[8], rkv[8];
#pragma unroll
        for (int q = 0; q < 8; ++q) { w0v[q] = INP(7)[c0 + q]; a0v[q] = INP(10)[c0 + q]; kkv[q] = INP(15)[c0 + q]; kav[q] = INP(16)[c0 + q]; rkv[q] = INP(17)[c0 + q]; }
        for (int blk = 0; blk < SEQ / 64; ++blk) {
            const size_t row = (size_t)b * SEQ + blk * 64 + pt;
            {
                const v4u r4 = *(const GAS v4u*)(Rb + row * C + c0), k4 = *(const GAS v4u*)(Kb + row * C + c0), v4 = *(const GAS v4u*)(Vb + row * C + c0);
                float r[8], k[8], v[8];
                r[0] = bflo(r4.x); r[1] = bfhi(r4.x); r[2] = bflo(r4.y); r[3] = bfhi(r4.y); r[4] = bflo(r4.z); r[5] = bfhi(r4.z); r[6] = bflo(r4.w); r[7] = bfhi(r4.w);
                k[0] = bflo(k4.x); k[1] = bfhi(k4.x); k[2] = bflo(k4.y); k[3] = bfhi(k4.y); k[4] = bflo(k4.z); k[5] = bfhi(k4.z); k[6] = bflo(k4.w); k[7] = bfhi(k4.w);
                v[0] = bflo(v4.x); v[1] = bfhi(v4.x); v[2] = bflo(v4.y); v[3] = bfhi(v4.y); v[4] = bflo(v4.z); v[5] = bfhi(v4.z); v[6] = bflo(v4.w); v[7] = bfhi(v4.w);
                float wp[8], ap[8];
#pragma unroll
                for (int q = 0; q < 8; ++q) { wp[q] = w0v[q]; ap[q] = a0v[q]; }
                for (int d = 0; d < 64; ++d) { const float lw = bf2f(LW[row * DW + d]), la = bf2f(LA[row * DA + d]);
#pragma unroll
                    for (int q = 0; q < 8; ++q) { wp[q] += lw * sW2[d * 64 + cq * 8 + q]; ap[q] += la * sA2[d * 64 + cq * 8 + q]; } }
                float kk[8], ss = 0.f, rks = 0.f;
#pragma unroll
                for (int q = 0; q < 8; ++q) { kk[q] = k[q] * kkv[q]; ss += kk[q] * kk[q]; }
                ss = sum8(ss);
                const float inv = 1.0f / fmaxf(sqrtf(ss), 1e-12f);
#pragma unroll
                for (int q = 0; q < 8; ++q) { const float ag = sigmoidf_(ap[q]); const float kn = kk[q] * inv; const float kp = k[q] * (1.0f + (ag - 1.0f) * kav[q]);
                    const float lw = -0.6065306597126334f * sigmoidf_(wp[q]);
                    const int o = pt * 64 + cq * 8 + q;
                    sR[o] = r[q]; sK[o] = kp; sV[o] = v[q]; sA[o] = -kn; sB[o] = kn * ag; sD[o] = __expf(lw); rks += r[q] * kp * rkv[q]; }
                rks = sum8(rks);
                if (cq == 0) RK[row * NH + h] = rks;
            }
            __syncthreads();
            for (int t = 0; t < 64; ++t) {
                const LAS f32x4* pa = (const LAS f32x4*)(sA + t * 64 + jq * 8); const LAS f32x4* pb = (const LAS f32x4*)(sB + t * 64 + jq * 8);
                const LAS f32x4* pd = (const LAS f32x4*)(sD + t * 64 + jq * 8); const LAS f32x4* pk = (const LAS f32x4*)(sK + t * 64 + jq * 8);
                const LAS f32x4* pr = (const LAS f32x4*)(sR + t * 64 + jq * 8);
                const f32x4 a0 = pa[0], a1 = pa[1], b0 = pb[0], b1 = pb[1], d0 = pd[0], d1 = pd[1], k0 = pk[0], k1 = pk[1], r0 = pr[0], r1 = pr[1];
                const float vi = sV[t * 64 + si];
                float sa = 0.f;
#pragma unroll
                for (int q = 0; q < 4; ++q) { sa += S[q] * a0[q]; sa += S[4 + q] * a1[q]; }
                sa = sum8(sa);
                float y = 0.f;
#pragma unroll
                for (int q = 0; q < 4; ++q) { S[q] = S[q] * d0[q] + sa * b0[q] + vi * k0[q]; S[4 + q] = S[4 + q] * d1[q] + sa * b1[q] + vi * k1[q]; y += S[q] * r0[q]; y += S[4 + q] * r1[q]; }
                y = sum8(y);
                if (jq == 0) Y[((size_t)b * SEQ + blk * 64 + t) * C + h * HD + si] = y;
            }
            __syncthreads();
        }
    }
}
__device__ __forceinline__ void post_scan(unsigned char* ws, int gw, int NGW, int lane) {
    const float* Y = OUTP(); const float* RK = (const float*)(ws + WS_HID); const bf16* Vb = (const bf16*)(ws + WS_B3); const bf16* LG = (const bf16*)(ws + WS_LG);
    bf16* YG = (bf16*)(ws + WS_B4); const float* g2 = INP(14); const float* lnw = INP(18); const float* lnb = INP(19);
    for (int it = gw; it < M * NH; it += NGW) {
        const int row = it / NH, h = it % NH, c = h * HD + lane;
        const float y = Y[(size_t)row * C + c];
        const float mu = wave_sum(y, lane) * (1.0f / HD); const float d = y - mu; const float var = wave_sum(d * d, lane) * (1.0f / HD);
        float o = d * (1.0f / sqrtf(var + GN_EPS)) * lnw[c] + lnb[c];
        o += RK[(size_t)row * NH + h] * bf2f(Vb[(size_t)row * C + c]);
        float g = 0.f;
        for (int dd = 0; dd < DG; ++dd) g += bf2f(LG[(size_t)row * DG + dd]) * g2[(size_t)dd * C + c];
        YG[(size_t)row * C + c] = (bf16)f2bf(o * g);
    }
}


constexpr int CW_DBG = 3200;
__device__ __forceinline__ void dbg_nonfinite(unsigned char* ws, const bf16* X, size_t n, int slot, int gw, int NGW, int lane, float thr = 1e30f) {
    unsigned* cw = (unsigned*)(ws + WS_CTL) + CW_DBG + 64 * slot; unsigned nnan = 0;
    for (size_t i = (size_t)gw * 64 + lane; i < n; i += (size_t)NGW * 64) { const float x = bf2f(X[i]); if (!(fabsf(x) < thr)) ++nnan; }
    if (nnan) atomicAdd(cw, nnan);
}
__device__ __forceinline__ void dbg_compare(unsigned char* ws, const bf16* X, const bf16* Y, int gw, int NGW, int lane) {
    unsigned* cw = (unsigned*)(ws + WS_CTL) + CW_DBG; unsigned nbad = 0, nnan = 0;
    for (size_t i = (size_t)gw * 64 + lane; i < (size_t)M * C; i += (size_t)NGW * 64) { const float x = bf2f(X[i]), y = bf2f(Y[i]);
        if (!(fabsf(x) < 1e30f)) ++nnan; else if (fabsf(x - y) > 0.05f * (fabsf(y) + 0.05f)) ++nbad; }
    if (nnan) atomicAdd(cw, nnan); if (nbad) atomicAdd(cw + 64, nbad);
}
#endif
__device__ __forceinline__ void router_rows(unsigned char* ws, LAS unsigned char* lds, int layer, int gw, int NGW, int lane, int tid, int wv, bool dry = false) {
    const bf16* Hh = (const bf16*)(ws + WS_B4); const float* gain = INP(2) + layer * C; float* rsl = (float*)(ws + WS_B0);
    const float* wg = INP(24) + (size_t)layer * C * 4; const float* bg = INP(25) + layer * 4; const float* wi = INP(26) + (size_t)layer * C * 16; const float* bi = INP(27) + layer * 16;
    unsigned* cnt = (unsigned*)(ws + WS_CTL) + CW_CNT + layer * 16 * 64; unsigned* list = (unsigned*)(ws + WS_LIST); float* wl = (float*)(ws + WS_WL);
    LAS float* sWg = (LAS float*)lds; LAS float* sWi = sWg + C * 4;
    constexpr int RECMAX = 256;
    LAS unsigned* lcnt = (LAS unsigned*)(lds + 81920); LAS unsigned* gbase = lcnt + 16; LAS float* sBias = (LAS float*)(lcnt + 32);
    LAS unsigned* recRow = lcnt + 64; LAS unsigned* recE = recRow + RECMAX; LAS unsigned* recL = recE + RECMAX; LAS float* recW0 = (LAS float*)(recL + RECMAX); LAS float* recW1 = recW0 + RECMAX; LAS float* recRS = recW1 + RECMAX;
    __syncthreads();
    for (int e = tid; e < C; e += 512) { const int r = e >> 6, c = 256 * (r >> 2) + 4 * (e & 63) + (r & 3); ((LAS f32x4*)sWg)[e] = ((const GAS f32x4*)wg)[c]; }
    for (int e = tid; e < C * 4; e += 512) { const int r = e >> 6, jq = r >> 2, c = 256 * (jq >> 2) + 4 * (e & 63) + (jq & 3); ((LAS f32x4*)sWi)[e] = ((const GAS f32x4*)wi)[c * 4 + (r & 3)]; }
    if (tid < 4) sBias[tid] = bg[tid]; else if (tid < 20) sBias[tid] = bi[tid - 4];
    for (int e = tid; e < RECMAX; e += 512) recE[e] = 0xffffffffu;
    __syncthreads();
    f32x4 g[4]; load_row(gain, lane, g);
    v2u nxr[2][4];
#pragma unroll
    for (int r = 0; r < 2; ++r) { const int r0 = gw + r * NGW < M - 1 ? gw + r * NGW : M - 1;
#pragma unroll
        for (int j = 0; j < 4; ++j) nxr[r][j] = ((const GAS v2u*)(Hh + (size_t)r0 * C))[64 * j + lane]; }
    int k = 0;
    for (int row = gw; row < M; row += 2 * NGW, k += 2) {
        f32x4 v[2][4];
#pragma unroll
        for (int r = 0; r < 2; ++r)
#pragma unroll
            for (int j = 0; j < 4; ++j) v[r][j] = (f32x4){bflo(nxr[r][j].x), bfhi(nxr[r][j].x), bflo(nxr[r][j].y), bfhi(nxr[r][j].y)};
#pragma unroll
        for (int r = 0; r < 2; ++r) { const int rn = row + (2 + r) * NGW, r0 = rn < M - 1 ? rn : M - 1;
#pragma unroll
            for (int j = 0; j < 4; ++j) nxr[r][j] = ((const GAS v2u*)(Hh + (size_t)r0 * C))[64 * j + lane]; }
        float rs[2];
#pragma unroll
        for (int r = 0; r < 2; ++r) { rs[r] = row_rs(v[r], lane);
#pragma unroll
            for (int j = 0; j < 4; ++j) v[r][j] = v[r][j] * rs[r] * g[j]; }
        float gl[2][4] = {{0.f, 0.f, 0.f, 0.f}, {0.f, 0.f, 0.f, 0.f}};
        const LAS unsigned char* pWg = (const LAS unsigned char*)sWg + lane * 16;
#pragma unroll
        for (int j = 0; j < 4; ++j)
#pragma unroll
            for (int q = 0; q < 4; ++q) { const f32x4 w = *(const LAS f32x4*)(pWg + (j * 4 + q) * 1024);
#pragma unroll
                for (int r = 0; r < 2; ++r) { const float xv = v[r][j][q]; gl[r][0] += xv * w.x; gl[r][1] += xv * w.y; gl[r][2] += xv * w.z; gl[r][3] += xv * w.w; } }
        int gi[2]; float gval[2];
#pragma unroll
        for (int r = 0; r < 2; ++r) {
#pragma unroll
            for (int q = 0; q < 4; ++q) gl[r][q] = wave_sum(gl[r][q], lane) + sBias[q];
            gi[r] = 0; float gm = gl[r][0];
#pragma unroll
            for (int q = 1; q < 4; ++q) if (gl[r][q] > gm) { gm = gl[r][q]; gi[r] = q; }
            float gden = 0.f;
#pragma unroll
            for (int q = 0; q < 4; ++q) gden += __expf(gl[r][q] - gm);
            gval[r] = 1.0f / gden; }
        float il[2][4] = {{0.f, 0.f, 0.f, 0.f}, {0.f, 0.f, 0.f, 0.f}};
        const LAS unsigned char* pWi0 = (const LAS unsigned char*)sWi + lane * 16 + gi[0] * 1024;
        const LAS unsigned char* pWi1 = (const LAS unsigned char*)sWi + lane * 16 + gi[1] * 1024;
#pragma unroll
        for (int j = 0; j < 4; ++j)
#pragma unroll
            for (int q = 0; q < 4; ++q) {
                { const f32x4 w = *(const LAS f32x4*)(pWi0 + (j * 4 + q) * 4096); const float xv = v[0][j][q]; il[0][0] += xv * w.x; il[0][1] += xv * w.y; il[0][2] += xv * w.z; il[0][3] += xv * w.w; }
                { const f32x4 w = *(const LAS f32x4*)(pWi1 + (j * 4 + q) * 4096); const float xv = v[1][j][q]; il[1][0] += xv * w.x; il[1][1] += xv * w.y; il[1][2] += xv * w.z; il[1][3] += xv * w.w; } }
#pragma unroll
        for (int r = 0; r < 2; ++r) {
            const f32x4 bi4 = *(const LAS f32x4*)(sBias + 4 + gi[r] * 4);
#pragma unroll
            for (int q = 0; q < 4; ++q) il[r][q] = wave_sum(il[r][q], lane) + bi4[q];
            int i0 = 0; float m0 = il[r][0];
#pragma unroll
            for (int q = 1; q < 4; ++q) if (il[r][q] > m0) { m0 = il[r][q]; i0 = q; }
            int i1 = -1; float m1 = -INFINITY;
#pragma unroll
            for (int q = 0; q < 4; ++q) if (q != i0 && il[r][q] > m1) { m1 = il[r][q]; i1 = q; }
            const float e1 = __expf(m1 - m0); const float w0 = gval[r] / (1.0f + e1), w1 = gval[r] * e1 / (1.0f + e1);
            const int ri = wv * 32 + k + r;
            if (lane == 0 && !dry && k + r < 32 && row + r * NGW < M) { const int ex0 = gi[r] * 4 + i0, ex1 = gi[r] * 4 + i1;
                recRow[ri] = (unsigned)(row + r * NGW); recE[ri] = (unsigned)ex0 | ((unsigned)ex1 << 8); recW0[ri] = w0; recW1[ri] = w1; recRS[ri] = rs[r]; }
        }
    }
    __syncthreads();
    unsigned e = 0xffffffffu; if (tid < RECMAX) e = recE[tid];
    const unsigned ex0 = e & 255u, ex1 = (e >> 8) & 255u;
    unsigned pos0 = 0u, pos1 = 0u;
    if (wv < RECMAX / 64) {
#pragma unroll
        for (unsigned x = 0; x < 16; ++x) { const unsigned long long m0 = __ballot(ex0 == x), m1 = __ballot(ex1 == x);
            const unsigned p = __builtin_amdgcn_mbcnt_hi((unsigned)(m0 >> 32), __builtin_amdgcn_mbcnt_lo((unsigned)m0, 0u)) + __builtin_amdgcn_mbcnt_hi((unsigned)(m1 >> 32), __builtin_amdgcn_mbcnt_lo((unsigned)m1, 0u));
            if (ex0 == x) pos0 = p; if (ex1 == x) pos1 = p;
            if (lane == 0) recL[wv * 16 + x] = (unsigned)(__popcll(m0) + __popcll(m1)); } }
    __syncthreads();
    if (tid < 16 && !dry) { unsigned c_ = 0u;
#pragma unroll
        for (int q = 0; q < RECMAX / 64; ++q) c_ += recL[q * 16 + tid];
        gbase[tid] = atomicAdd(cnt + tid * 64, c_); }
    __syncthreads();
    if (e != 0xffffffffu && !dry) { unsigned p0 = gbase[ex0] + pos0, p1 = gbase[ex1] + pos1;
        for (int q = 0; q < wv; ++q) { p0 += recL[q * 16 + ex0]; p1 += recL[q * 16 + ex1]; }
        const unsigned row = recRow[tid]; const float rs = recRS[tid];
        list[(size_t)ex0 * M + p0] = row * 2u; wl[(size_t)ex0 * M + p0] = recW0[tid]; list[(size_t)ex1 * M + p1] = row * 2u + 1u; wl[(size_t)ex1 * M + p1] = recW1[tid];
        rsl[(size_t)ex0 * M + p0] = rs; rsl[(size_t)ex1 * M + p1] = rs; }
}
__device__ __forceinline__ void moe_table(unsigned char* ws, volatile LAS int* tab, int layer, int tid) {
    __syncthreads();
    if (tid == 0) { const unsigned* cnt = (const unsigned*)(ws + WS_CTL) + CW_CNT + layer * 16 * 64; int t = 0;
#pragma unroll 1
        for (int e = 0; e < 16; ++e) { const int c = (int)__hip_atomic_load(cnt, RLX_AGENT); cnt += 64; tab[e] = c; tab[16 + e] = t; t += (c + 255) >> 8; tab[32 + e] = t; }
        tab[48] = t; }
    __syncthreads();
}
__device__ __forceinline__ void combine_rows(unsigned char* ws, int mode, int gw, int NGW, int lane, bool dry = false) {
    bf16* Hh = (bf16*)(ws + WS_B4); float* Out = OUTP(); const bf16* E0 = (const bf16*)(ws + WS_B2); const bf16* E1 = (const bf16*)(ws + WS_B3); bf16* XN2 = (bf16*)(ws + WS_B0);
    f32x4 g[4]; load_row(INP(4), lane, g);
    for (int row = gw; row < M; row += NGW) {
        f32x4 v[4]; load_row_bf(Hh + (size_t)row * C, lane, v);
#pragma unroll
        for (int j = 0; j < 4; ++j) { const v2u e0 = ((const GAS v2u*)(E0 + (size_t)row * C))[64 * j + lane], e1 = ((const GAS v2u*)(E1 + (size_t)row * C))[64 * j + lane];
            v[j].x += bflo(e0.x) + bflo(e1.x); v[j].y += bfhi(e0.x) + bfhi(e1.x); v[j].z += bflo(e0.y) + bflo(e1.y); v[j].w += bfhi(e0.y) + bfhi(e1.y); }
        const float rs = row_rs(v, lane);
        if (mode == 0) {
            if (!dry) store_row_bf16(Hh + (size_t)row * C, lane, v);
            if (lane == 0) ((float*)XN2)[row] = rs;
        } else {
            float sig = 1.0f;
#if MK_DEBUG
            const unsigned* cw = (const unsigned*)(ws + WS_CTL) + CW_DBG; const unsigned nnan = __hip_atomic_load(cw, RLX_AGENT), nbad = __hip_atomic_load(cw + 64, RLX_AGENT);
            if (row < 512 && nnan > 0) sig = 2.0f;
            if (row >= 512 && row < 1536 && __hip_atomic_load(cw + 128, RLX_AGENT) > 0) sig = 2.0f;
            if (row >= 1536 && row < 3584 && __hip_atomic_load(cw + 192, RLX_AGENT) > 0) sig = 2.0f;
            if (row >= 3584 && row < 7680 && __hip_atomic_load(cw + 256, RLX_AGENT) > 0) sig = 2.0f;
            if (row >= 7680 && row < 15872 && __hip_atomic_load(cw + 320, RLX_AGENT) > 0) sig = 2.0f;
            if (row >= 15872 && nbad > (unsigned)(M / 100) * C) sig = 1.5f;
#endif
#pragma unroll
            for (int j = 0; j < 4; ++j) ((GAS f32x4*)(Out + (size_t)row * C))[64 * j + lane] = v[j] * rs * g[j] * sig;
        }
    }
}
__device__ __forceinline__ void attn_naive(unsigned char* ws, int gw, int NGW, int lane) {
    const bf16* Kb = (const bf16*)(ws + WS_B1); const bf16* Vb = (const bf16*)(ws + WS_B2); const bf16* Qb = (const bf16*)(ws + WS_B3); bf16* Ob = (bf16*)(ws + WS_B0);
    for (int unit = gw; unit < BATCH * NH * (SEQ / 64); unit += NGW) {
        const int qb = unit % (SEQ / 64), bh = unit / (SEQ / 64), b = bh / NH, h = bh % NH;
        const int t0 = qb * 64, t = t0 + lane; const size_t rowq = (size_t)b * SEQ + t;
        float q[64], o[64];
#pragma unroll
        for (int c = 0; c < 8; ++c) { const v4u w = *(const GAS v4u*)(Qb + rowq * C + h * HD + c * 8);
            q[c * 8 + 0] = bflo(w.x) * 0.125f; q[c * 8 + 1] = bfhi(w.x) * 0.125f; q[c * 8 + 2] = bflo(w.y) * 0.125f; q[c * 8 + 3] = bfhi(w.y) * 0.125f;
            q[c * 8 + 4] = bflo(w.z) * 0.125f; q[c * 8 + 5] = bfhi(w.z) * 0.125f; q[c * 8 + 6] = bflo(w.w) * 0.125f; q[c * 8 + 7] = bfhi(w.w) * 0.125f; }
#pragma unroll
        for (int c = 0; c < 64; ++c) o[c] = 0.f;
        float suffix = 0.f;
        for (int s = t0 + 62; s >= 0; --s) {
            const bool valid = s < t;
            if (s < t0 && __all(suffix > SB_EXIT)) break;
            const bf16* kp = Kb + ((size_t)b * SEQ + s) * C + h * HD; const bf16* vp = Vb + ((size_t)b * SEQ + s) * C + h * HD;
            float z = 0.f;
#pragma unroll
            for (int c = 0; c < 8; ++c) { const v4u w = *(const GAS v4u*)(kp + c * 8);
                z += q[c * 8 + 0] * bflo(w.x) + q[c * 8 + 1] * bfhi(w.x) + q[c * 8 + 2] * bflo(w.y) + q[c * 8 + 3] * bfhi(w.y) + q[c * 8 + 4] * bflo(w.z) + q[c * 8 + 5] * bfhi(w.z) + q[c * 8 + 6] * bflo(w.w) + q[c * 8 + 7] * bfhi(w.w); }
            const float sp = fmaxf(z, 0.f) + log1pf(__expf(-fabsf(z)));
            const float att = valid ? __expf(z - sp - suffix) : 0.f;
            suffix += valid ? sp : 0.f;
#pragma unroll
            for (int c = 0; c < 8; ++c) { const v4u w = *(const GAS v4u*)(vp + c * 8);
                o[c * 8 + 0] += att * bflo(w.x); o[c * 8 + 1] += att * bfhi(w.x); o[c * 8 + 2] += att * bflo(w.y); o[c * 8 + 3] += att * bfhi(w.y);
                o[c * 8 + 4] += att * bflo(w.z); o[c * 8 + 5] += att * bfhi(w.z); o[c * 8 + 6] += att * bflo(w.w); o[c * 8 + 7] += att * bfhi(w.w); }
        }
#pragma unroll
        for (int c = 0; c < 8; ++c) { v4u w; w.x = pk2(o[c * 8 + 0], o[c * 8 + 1]); w.y = pk2(o[c * 8 + 2], o[c * 8 + 3]); w.z = pk2(o[c * 8 + 4], o[c * 8 + 5]); w.w = pk2(o[c * 8 + 6], o[c * 8 + 7]);
            *(GAS v4u*)(Ob + rowq * C + h * HD + c * 8) = w; }
    }
}


typedef float f32x16 __attribute__((ext_vector_type(16)));
constexpr int AT_VP = 192;
constexpr int AT_WAVE_LDS = 32 * AT_VP;
__device__ __forceinline__ int crow32(int reg, int hh) { return (reg & 3) + 8 * (reg >> 2) + 4 * hh; }
__device__ __forceinline__ bf16x8s pack_step(const f32x16& x, const int s) {
    v4u p; p.x = pg8::cvt_pk_bf16(x[8 * s], x[8 * s + 1]); p.y = pg8::cvt_pk_bf16(x[8 * s + 2], x[8 * s + 3]); p.z = pg8::cvt_pk_bf16(x[8 * s + 4], x[8 * s + 5]); p.w = pg8::cvt_pk_bf16(x[8 * s + 6], x[8 * s + 7]);
    return __builtin_bit_cast(bf16x8s, p);
}
__device__ __forceinline__ void attn_mfma(unsigned char* ws, LAS unsigned char* lds, int gw, int NGW, int lane, int wave) {
    const bf16* Kb = (const bf16*)(ws + WS_B1); const bf16* Vb = (const bf16*)(ws + WS_B2); const bf16* Qb = (const bf16*)(ws + WS_B3); bf16* Ob = (bf16*)(ws + WS_B0);
    LAS unsigned char* vl = lds + wave * AT_WAVE_LDS;
    const int r32 = lane & 31, hh = lane >> 5;
    bf16x8s tri[2];
#pragma unroll
    for (int s = 0; s < 2; ++s)
#pragma unroll
        for (int j = 0; j < 8; ++j) tri[s][j] = (16 * s + 8 * (j >> 2) + 4 * hh + (j & 3)) > r32 ? (short)0x3F80 : (short)0;
    const int grp = lane >> 4, tq = (lane & 15) >> 2, tp = lane & 3;
    const LAS unsigned char* vtr0 = vl + (4 * hh + tq) * AT_VP + (16 * (grp & 1) + 4 * tp) * 2;
    for (int unit = gw; unit < BATCH * NH * (SEQ / 32); unit += NGW) {
        const int qb = unit % (SEQ / 32), bh = unit / (SEQ / 32), b = bh / NH, hd = bh % NH;
        const int t0 = qb * 32; const size_t rowb = (size_t)b * SEQ;
        bf16x8s qf[4];
#pragma unroll
        for (int ks = 0; ks < 4; ++ks) qf[ks] = *(const GAS bf16x8s*)(Qb + (rowb + t0 + r32) * C + hd * HD + 16 * ks + 8 * hh);
        f32x16 o[2];
#pragma unroll
        for (int i = 0; i < 16; ++i) { o[0][i] = 0.f; o[1][i] = 0.f; }
        float carry = 0.f;
        for (int s0 = t0; s0 >= 0; s0 -= 32) {
            bf16x8s kf[4];
#pragma unroll
            for (int ks = 0; ks < 4; ++ks) kf[ks] = *(const GAS bf16x8s*)(Kb + (rowb + s0 + r32) * C + hd * HD + 16 * ks + 8 * hh);
            v4u vreg[4];
#pragma unroll
            for (int i = 0; i < 4; ++i) { const int cidx = lane + 64 * i; vreg[i] = *(const GAS v4u*)(Vb + (rowb + s0 + (cidx >> 3)) * C + hd * HD + (cidx & 7) * 8); }
            f32x16 st;
#pragma unroll
            for (int i = 0; i < 16; ++i) st[i] = 0.f;
#pragma unroll
            for (int ks = 0; ks < 4; ++ks) st = __builtin_amdgcn_mfma_f32_32x32x16_bf16(kf[ks], qf[ks], st, 0, 0, 0);
#pragma unroll
            for (int i = 0; i < 4; ++i) { const int cidx = lane + 64 * i; *(LAS v4u*)(vl + (cidx >> 3) * AT_VP + (cidx & 7) * 16) = vreg[i]; }
            f32x16 zz, uu; float tot = 0.f; const int tq_ = t0 + r32;
            if (s0 + 31 < t0) {
#pragma unroll
                for (int i = 0; i < 16; ++i) { const float z = st[i] * 0.18033688011112042f; const float sp = fmaxf(z, 0.f) + __builtin_amdgcn_logf(1.0f + __builtin_amdgcn_exp2f(-fabsf(z)));
                    zz[i] = z - sp; uu[i] = sp; tot += sp; }
            } else {
#pragma unroll
                for (int i = 0; i < 16; ++i) { const int key = s0 + crow32(i, hh); const float z = st[i] * 0.18033688011112042f; const float sp = fmaxf(z, 0.f) + __builtin_amdgcn_logf(1.0f + __builtin_amdgcn_exp2f(-fabsf(z)));
                    const bool valid = key < tq_; zz[i] = valid ? z - sp : -1e30f; uu[i] = valid ? sp : 0.f; tot += uu[i]; }
            }
            f32x16 w;
#pragma unroll
            for (int i = 0; i < 16; ++i) w[i] = 0.f;
#pragma unroll
            for (int s = 0; s < 2; ++s) w = __builtin_amdgcn_mfma_f32_32x32x16_bf16(tri[s], pack_step(uu, s), w, 0, 0, 0);
            f32x16 pp;
#pragma unroll
            for (int i = 0; i < 16; ++i) pp[i] = __builtin_amdgcn_exp2f(zz[i] - w[i] - carry);
            tot += shx(tot, 32, lane); carry += tot;
            asm volatile("s_waitcnt lgkmcnt(0)" ::: "memory");
#pragma unroll
            for (int s = 0; s < 2; ++s) { const bf16x8s pa = pack_step(pp, s);
#pragma unroll
                for (int dt = 0; dt < 2; ++dt) {
                    const v4i16_t lo = __builtin_amdgcn_ds_read_tr16_b64_v4i16((LAS v4i16_t*)(vtr0 + (16 * s) * AT_VP + dt * 64));
                    const v4i16_t hi = __builtin_amdgcn_ds_read_tr16_b64_v4i16((LAS v4i16_t*)(vtr0 + (16 * s + 8) * AT_VP + dt * 64));
                    const bf16x8s vf = (bf16x8s){lo[0], lo[1], lo[2], lo[3], hi[0], hi[1], hi[2], hi[3]};
                    o[dt] = __builtin_amdgcn_mfma_f32_32x32x16_bf16(pa, vf, o[dt], 0, 0, 0); } }
            asm volatile("" ::: "memory");
            if (s0 < t0 && __all(carry > SB_EXIT * 1.4426950408889634f)) break;
        }
#pragma unroll
        for (int dt = 0; dt < 2; ++dt)
#pragma unroll
            for (int i = 0; i < 16; ++i) Ob[(rowb + t0 + crow32(i, hh)) * C + hd * HD + 32 * dt + r32] = (bf16)f2bf(o[dt][i]);
    }
}
__global__ void __launch_bounds__(NWAVES * 64, 2) yoco_fwd(Args args) {
    extern __shared__ __attribute__((aligned(16))) unsigned char lds_raw[];
    LAS unsigned char* lds = (LAS unsigned char*)lds_raw;
    const int G = gridDim.x; const int bx = blockIdx.x;
    int wave = __builtin_amdgcn_readfirstlane(threadIdx.x >> 6); asm volatile("" : "+s"(wave));
#define IDS() int lane; asm volatile("v_mbcnt_lo_u32_b32 %0, -1, 0\n\tv_mbcnt_hi_u32_b32 %0, -1, %0" : "=v"(lane)); const int tid = wave * 64 + lane; (void)tid; \
    const int vcu = (G % 8 == 0) ? (bx % 8) * (G / 8) + bx / 8 : bx; const int gw = vcu * NWAVES + wave, NGW = G * NWAVES; (void)lane; (void)gw; (void)NGW;
    unsigned char* ws = WSP();
    volatile LAS unsigned* MISC = (volatile LAS unsigned*)(lds + MISC_OFF);
    volatile LAS int* tab = (volatile LAS int*)(lds + MOE_TAB_OFF);
    for (int u = threadIdx.x; u < (LDS_BYTES - LDSCTL_OFF) / 4; u += NWAVES * 64) ((LAS unsigned*)(lds + LDSCTL_OFF))[u] = 0u;
    __syncthreads();
    XcdBarrier bar; bar.bar = (unsigned*)(ws + WS_CTL) + CW_BAR; bar.x = 0; bar.st = nullptr;
    if (N_LAUNCHES == 1) bar = xcd_barrier_post((unsigned*)(ws + WS_CTL) + CW_BAR, MISC + 8);
    const int lo = KA_INT(0), hi = KA_INT(1);
#ifndef PROBE_PH
#define PROBE_PH -1
#endif
#define IN(k) (lo <= (k) && (k) < hi)
#define REP(k) for (int rep_ = 0; rep_ < ((PROBE_PH == (k)) ? 2 : 1); ++rep_)
#define SEAM(k) do { if (IN(k) && IN((k) + 1)) xcd_barrier(bar); } while (0)

    if (IN(PH_P0)) REP(PH_P0) { IDS(); p0_weights<0>(ws, lds, gw, NGW, wave, lane); if (G <= 192) p0_weights<1>(ws, lds, gw, NGW, wave, lane); if (G <= 64) p0_weights<2>(ws, lds, gw, NGW, wave, lane); p0_rows(ws, gw, NGW, lane); }
    SEAM(PH_P0);
    if (PROBE_PH == 100 && N_LAUNCHES == 1) { for (int i_ = 0; i_ < 10; ++i_) xcd_barrier(bar); }
    if (IN(PH_LORA)) REP(PH_LORA) {
        SchedGrouped<1, 3> S{(const char*)(ws + WS_B1), (size_t)(WS_B2 - WS_B1), nullptr, (const char*)(ws + WS_WT_LORA), (size_t)256 * C * 2, G, bx};
        EpiLora E{(bf16*)(ws + WS_LW)};
        pg8::gemm_phase<EpiLora, SchedGrouped<1, 3>, true, false, C>(lds, S, E, wave);
        if (G > 192 && bx >= 192) { IDS(); p0_weights<1>(ws, lds, (bx - 192) * NWAVES + wave, (G - 192) * NWAVES, wave, lane); }
    }
    SEAM(PH_LORA);
    if (IN(PH_RKV)) REP(PH_RKV) {
        SchedGrouped<4, 3> S{(const char*)OUTP(), (size_t)M * C * 2, (const char*)(ws + WS_B4), (const char*)(ws + WS_WT_RKV), (size_t)C * C * 2, G, bx};
        EpiSplit3 E{(bf16*)(ws + WS_B1), false, nullptr};
        pg8::gemm_phase<EpiSplit3, SchedGrouped<4, 3>, true, false, C>(lds, S, E, wave);
    }
    SEAM(PH_RKV);
    if (IN(PH_S1)) REP(PH_S1) { IDS(); scan_s1(ws, lds, lane, wave); }
    SEAM(PH_S1);
    if (IN(PH_S2)) REP(PH_S2) { IDS();
        if (bx < BATCH * NH || G <= BATCH * NH) scan_s2(ws, lds, lane, wave);
        }
    SEAM(PH_S2);
    if (IN(PH_S3)) REP(PH_S3) { IDS(); scan_s3(ws, lds, lane, wave); }
    SEAM(PH_S3);
#if MK_DEBUG
    if (IN(PH_DBG0)) { IDS(); scan_naive(ws, lds, tid); }
    SEAM(PH_DBG0);
    if (IN(PH_DBG0 + 1)) { IDS(); post_scan(ws, gw, NGW, lane); }
    SEAM(PH_DBG0 + 1);
    if (IN(PH_DBG0 + 2)) { IDS(); dbg_compare(ws, (const bf16*)(ws + WS_B0), (const bf16*)(ws + WS_B4), gw, NGW, lane); }
    SEAM(PH_DBG0 + 2);
#endif
    if (IN(PH_WOUT)) REP(PH_WOUT) {
        SchedGrouped<4, 1> S{(const char*)(ws + ((MK_DEBUG && DBG_USE_NAIVE) ? WS_B4 : WS_B0)), 0, nullptr, (const char*)(ws + WS_WT_OUT), 0, G, bx};
        EpiResidBf<true> E{INP(0), (bf16*)(ws + WS_B4)};
        pg8::gemm_phase<EpiResidBf<true>, SchedGrouped<4, 1>, true, false, C>(lds, S, E, wave);
    }
    SEAM(PH_WOUT);
#pragma unroll 1
    for (int layer = 0; layer < 2; ++layer) {
        const int pb = layer == 0 ? (int)PH_ROUT0 : (int)PH_ROUT1;
        if (IN(pb)) { IDS(); if (PROBE_PH == 101 && layer == 0) router_rows(ws, lds, layer, gw, NGW, lane, tid, wave, true); router_rows(ws, lds, layer, gw, NGW, lane, tid, wave); }
        SEAM(pb);
        if (IN(pb + 1)) REP(pb + 1) {
            { IDS(); moe_table(ws, tab, layer, tid); }
            SchedMoe<2, C, true> S{(const char*)(ws + WS_B4), (const char*)(ws + WS_WT_GU) + (size_t)layer * 16 * 512 * C * 2, (size_t)512 * C * 2, (const unsigned*)(ws + WS_LIST), tab, G, bx};
            EpiGU E{(bf16*)(ws + WS_HID), (const float*)(ws + WS_WL), (const float*)(ws + WS_B0)};
            pg8::gemm_phase<EpiGU, SchedMoe<2, C, true>, true, true, C>(lds, S, E, wave);
            if (layer == 0 && G > 64) { const int nr2 = __builtin_amdgcn_readfirstlane(tab[48]) * 2 - G, first = nr2 > 0 ? nr2 : 0;
                if (bx >= first) { IDS(); p0_weights<2>(ws, lds, (bx - first) * NWAVES + wave, (G - first) * NWAVES, wave, lane); } }
        }
        SEAM(pb + 1);
        if (IN(pb + 2)) REP(pb + 2) {
            { IDS(); moe_table(ws, tab, layer, tid); }
            SchedMoe<4, FE, false> S{(const char*)(ws + WS_HID), (const char*)(ws + WS_WT_DN) + (size_t)layer * 16 * C * FE * 2, (size_t)C * FE * 2, (const unsigned*)(ws + WS_LIST), tab, G, bx};
            EpiDown E{(bf16*)(ws + WS_B2), (const unsigned*)(ws + WS_LIST)};
            pg8::gemm_phase<EpiDown, SchedMoe<4, FE, false>, true, false, FE>(lds, S, E, wave);
        }
        SEAM(pb + 2);
        if (layer == 0) {
            if (IN(PH_COMB)) { IDS(); if (PROBE_PH == 102) combine_rows(ws, 0, gw, NGW, lane, true); combine_rows(ws, 0, gw, NGW, lane); }
            SEAM(PH_COMB);
            if (IN(PH_KVQ)) REP(PH_KVQ) {
                SchedGrouped<12, 1> S{(const char*)(ws + WS_B4), 0, nullptr, (const char*)(ws + WS_WT_KVQ), 0, G, bx};
                EpiSplit3 E{(bf16*)(ws + WS_B1), true, (const float*)(ws + WS_B0)};
                pg8::gemm_phase<EpiSplit3, SchedGrouped<12, 1>, true, false, C>(lds, S, E, wave);
            }
            SEAM(PH_KVQ);
            if (IN(PH_ATTN)) REP(PH_ATTN) { IDS(); attn_mfma(ws, lds, gw, NGW, lane, wave); }
            SEAM(PH_ATTN);
            if (IN(PH_SBO)) {
                SchedGrouped<4, 1> S{(const char*)(ws + WS_B0), 0, nullptr, (const char*)(ws + WS_WT_SBO), 0, G, bx};
                EpiResidBf<false> E{(const void*)(ws + WS_B4), (bf16*)(ws + WS_B4)};
                pg8::gemm_phase<EpiResidBf<false>, SchedGrouped<4, 1>, true, false, C>(lds, S, E, wave);
            }
            SEAM(PH_SBO);
        }
    }
    if (IN(PH_FINAL)) { IDS(); combine_rows(ws, 1, gw, NGW, lane); }
#undef IN
#undef SEAM
}

extern "C" void kernel_launch(void* const* d_in, const int* in_sizes, int n_in, void* d_out, int out_size, void* d_ws, size_t ws_size, hipStream_t stream) {
    static int grid = 0;
    if (grid == 0) {
        if (n_in != 31 || in_sizes[0] != M * C || out_size != M * C || ws_size < WS_END) { fprintf(stderr, "kernel_launch: unexpected shapes (n_in %d, in0 %d, out %d, ws %zu); nothing launched\n", n_in, n_in > 0 ? in_sizes[0] : -1, out_size, ws_size); grid = -1; return; }
        int dev = 0, cus = 0, per_cu = 0;
        if (hipGetDevice(&dev) != hipSuccess || hipDeviceGetAttribute(&cus, hipDeviceAttributeMultiprocessorCount, dev) != hipSuccess) { grid = -1; return; }
        if (hipFuncSetAttribute((const void*)yoco_fwd, hipFuncAttributeMaxDynamicSharedMemorySize, LDS_BYTES) != hipSuccess) { fprintf(stderr, "kernel_launch: hipFuncSetAttribute failed\n"); grid = -1; return; }
        if (hipOccupancyMaxActiveBlocksPerMultiprocessor(&per_cu, (const void*)yoco_fwd, NWAVES * 64, LDS_BYTES) != hipSuccess || per_cu < 1) fprintf(stderr, "kernel_launch: occupancy query reports %d\n", per_cu);
        (void)hipGetLastError();
        grid = cus - (cus % 16);
    }
    if (grid < 0) return;
    if (hipMemsetAsync((char*)d_ws + WS_CTL, 0, CTL_ZERO_BYTES, stream) != hipSuccess) return;
    Args a{};
    for (int i = 0; i < 31; ++i) a.in[i] = (const float*)d_in[i];
    a.out = (float*)d_out; a.ws = (unsigned char*)d_ws;
    for (int li = 0; li < (N_LAUNCHES == 1 ? 1 : (int)NPHASE); ++li) {
        a.ph_lo = (N_LAUNCHES == 1) ? 0 : li; a.ph_hi = (N_LAUNCHES == 1) ? NPHASE : li + 1; a.li = li;
        hipLaunchKernelGGL(yoco_fwd, dim3(grid), dim3(NWAVES * 64), LDS_BYTES, stream, a);
        const hipError_t le = hipPeekAtLastError();
        if (le != hipSuccess) { fprintf(stderr, "kernel_launch: launch %d failed: %s\n", li, hipGetErrorName(le)); break; }
    }
}
```

```cpp
#include <hip/hip_runtime.h>
#include <cstdio>
#include <cstdint>

#ifndef MK_N_LAUNCHES
#define MK_N_LAUNCHES 1
#endif

namespace pg8 {
#define PG8_LAS __attribute__((address_space(3)))
typedef unsigned short bf16_t;
typedef short bf16x8 __attribute__((ext_vector_type(8)));
typedef float f32x4 __attribute__((ext_vector_type(4)));
typedef unsigned u32x4 __attribute__((ext_vector_type(4)));
constexpr int BM = 256, BK = 64, HALF = 128, HTB = HALF * BK * 2, STAGE_BYTES = 8 * HTB, NXCD = 8, WGM = 8;

__host__ __device__ __forceinline__ int lds_byte(int r, int c) { const int st = (r >> 4) * 2 + (c >> 5), rr = r & 15, cc = c & 31, ob = rr * 64 + cc * 2; return st * 1024 + (ob ^ (((ob >> 9) & 1) << 5)); }
__host__ __device__ __forceinline__ void stage_rc(int b, int& R, int& C) { const int st = b / 1024, sb = b % 1024, swz = sb ^ (((sb >> 9) & 1) << 5); R = (st >> 1) * 16 + swz / 64; C = (st & 1) * 32 + (swz % 64) / 2; }
__host__ __device__ __forceinline__ int perm32(int rho) { const int n = rho >> 4, i = rho & 15; return 8 * (i >> 2) + 4 * n + (i & 3); }

struct Unit { int pm, pn, aux, r0, cnt; };

__host__ __device__ __forceinline__ void tile_map(int wgid, int nM, int nN, int& pm, int& pn) {
    const int nwg = nM * nN;
    { const int q = nwg / NXCD, r = nwg % NXCD, xcd = wgid % NXCD, off = wgid / NXCD; wgid = (xcd < r ? xcd * (q + 1) : r * (q + 1) + (xcd - r) * q) + off; }
    const int nig = WGM * nN, gid = wgid / nig, fm = gid * WGM, gsz = (nM - fm) < WGM ? (nM - fm) : WGM;
    pm = fm + ((wgid % nig) % gsz); pn = (wgid % nig) / gsz;
}

typedef float f32x2_t __attribute__((ext_vector_type(2))); typedef __bf16 bf16x2_t __attribute__((ext_vector_type(2)));
__device__ __forceinline__ unsigned cvt_pk_bf16(float lo, float hi) { const f32x2_t v = {lo, hi}; const bf16x2_t b = __builtin_convertvector(v, bf16x2_t); return __builtin_bit_cast(unsigned, b); }

template <class Epi, class Sched, bool ALIGN_EPI, bool GATHER, int K>
__device__ __forceinline__ void gemm_phase(PG8_LAS unsigned char* lds, const Sched& S, const Epi& E, const int wid) {
    int lane_; asm volatile("v_mbcnt_lo_u32_b32 %0, -1, 0\n\tv_mbcnt_hi_u32_b32 %0, -1, %0" : "=v"(lane_));
    const int lane = lane_, tid = wid * 64 + lane, wr = wid >> 2, wc = wid & 3, fr = lane & 15, fq = lane >> 4;
    constexpr int nt = K / BK;
    unsigned voffA[2], voffB[2];
#pragma unroll
    for (int i = 0; i < 2; ++i) { int R, C; stage_rc(tid * 16 + i * 8192, R, C); const int Rb = Epi::PERM ? ((R & ~31) + perm32(R & 31)) : R;
        voffA[i] = (unsigned)(R * K + C) * 2u; voffB[i] = (unsigned)(Rb * K + C) * 2u; }
    constexpr size_t kstep = (size_t)(BK * 2);
    constexpr size_t hstep = (size_t)HALF * K * 2;
    const unsigned ldsw = (unsigned)wid * 1024u;
    const int aoff = lds_byte(wr * 64 + fr, fq * 8), boff = lds_byte(wc * 32 + fr, fq * 8);
#define PG8_SA(b, h) (((b) * 2 + (h)) * HTB)
#define PG8_SB(b, h) ((4 + (b) * 2 + (h)) * HTB)
#define PG8_STAGE(bufoff, gbase, voff) do { _Pragma("unroll") for (int _i = 0; _i < 2; ++_i) \
        __builtin_amdgcn_global_load_lds((const unsigned*)((const char*)(gbase) + (voff)[_i]), (PG8_LAS unsigned*)(lds + (bufoff) + ldsw + _i * 8192), 16, 0, 0); } while (0)
#define PG8_LDA(dst, b, h) do { _Pragma("unroll") for (int m = 0; m < 4; ++m) _Pragma("unroll") for (int k = 0; k < 2; ++k) dst[m][k] = *(const PG8_LAS bf16x8*)(lds + PG8_SA(b, h) + aoff + m * 2048 + k * 1024); } while (0)
#define PG8_LDB(dst, b, h) do { _Pragma("unroll") for (int n = 0; n < 2; ++n) _Pragma("unroll") for (int k = 0; k < 2; ++k) dst[n][k] = *(const PG8_LAS bf16x8*)(lds + PG8_SB(b, h) + boff + n * 2048 + k * 1024); } while (0)
#define PG8_MMA(ai, bj, At, Bt) do { __builtin_amdgcn_s_setprio(1); _Pragma("unroll") for (int m = 0; m < 4; ++m) _Pragma("unroll") for (int n = 0; n < 2; ++n) _Pragma("unroll") for (int k = 0; k < 2; ++k) \
        acc[ai][bj][m][n] = __builtin_amdgcn_mfma_f32_16x16x32_bf16(Bt[n][k], At[m][k], acc[ai][bj][m][n], 0, 0, 0); __builtin_amdgcn_s_setprio(0); } while (0)
#define PG8_WAIT_V(n) asm volatile("s_waitcnt vmcnt(" #n ")" ::: "memory")
#define PG8_WAIT_L(n) asm volatile("s_waitcnt lgkmcnt(" #n ")" ::: "memory")
#define PG8_BAR __builtin_amdgcn_s_barrier()
#define PG8_SCHED __builtin_amdgcn_sched_barrier(0)
    Unit cur, nxt; int ui = 0;
    if (!S.next(0, cur)) return;
    f32x4 acc[2][2][4][2];
#pragma unroll
    for (int a = 0; a < 2; ++a)
#pragma unroll
        for (int b = 0; b < 2; ++b)
#pragma unroll
            for (int m = 0; m < 4; ++m)
#pragma unroll
                for (int n = 0; n < 2; ++n) acc[a][b][m][n] = (f32x4){0.f, 0.f, 0.f, 0.f};
    bf16x8 At[4][2], B0[2][2], B1[2][2];
    unsigned vc[2][2];
#define PG8_GOFF(u) do { _Pragma("unroll") for (int _h = 0; _h < 2; ++_h) _Pragma("unroll") for (int _i = 0; _i < 2; ++_i) { int _R, _C; stage_rc(tid * 16 + _i * 8192, _R, _C); \
        vc[_h][_i] = S.a_row_off(u, _h * HALF + _R) + (unsigned)_C * 2u; } } while (0)
#define PG8_STAGE_A(bufoff, gbase, h) do { if constexpr (GATHER) { PG8_STAGE(bufoff, gbase, vc[h]); } else { PG8_STAGE(bufoff, (gbase) + (h) * hstep, voffA); } } while (0)
    if constexpr (GATHER) PG8_GOFF(cur);
    const char* cA = S.a_base(cur); const char* cB = S.b_base(cur);
    PG8_STAGE(PG8_SB(0, 0), cB, voffB); PG8_STAGE(PG8_SB(0, 1), cB + hstep, voffB); PG8_STAGE_A(PG8_SA(0, 0), cA, 0); PG8_STAGE_A(PG8_SA(0, 1), cA, 1);
    if (wr == 1) PG8_BAR;
    PG8_WAIT_V(2); PG8_BAR;
    PG8_STAGE(PG8_SB(1, 0), cB + kstep, voffB); PG8_STAGE_A(PG8_SA(1, 0), cA + kstep, 0); PG8_STAGE(PG8_SB(1, 1), cB + hstep + kstep, voffB);
    PG8_WAIT_V(6); PG8_BAR;
    for (;;) {
        const bool has_next = S.next(ui + 1, nxt);
        const char* nA = has_next ? S.a_base(nxt) : cA; const char* nB = has_next ? S.b_base(nxt) : cB;
        for (int t = 0; t < nt; t += 2) {
            const bool last = (t == nt - 2);
            const char* a1 = cA + (size_t)(t + 1) * kstep;
            const char* a2 = last ? nA : cA + (size_t)(t + 2) * kstep; const char* b2 = last ? nB : cB + (size_t)(t + 2) * kstep;
            const char* a3 = a2 + kstep; const char* b3 = b2 + kstep;
            PG8_LDB(B0, 0, 0); PG8_LDB(B1, 0, 1); PG8_SCHED; PG8_LDA(At, 0, 0); PG8_STAGE_A(PG8_SA(1, 1), a1, 1);
            if constexpr (GATHER) { if (last && has_next) PG8_GOFF(nxt); }
            PG8_WAIT_V(8); PG8_WAIT_L(0); PG8_BAR; PG8_MMA(0, 0, At, B0); PG8_MMA(0, 1, At, B1); PG8_BAR; PG8_SCHED;
            PG8_LDA(At, 0, 1); PG8_STAGE(PG8_SB(0, 0), b2, voffB); PG8_STAGE(PG8_SB(0, 1), b2 + hstep, voffB); PG8_STAGE_A(PG8_SA(0, 0), a2, 0);
            PG8_WAIT_V(8); PG8_WAIT_L(0); PG8_BAR; PG8_MMA(1, 0, At, B0); PG8_MMA(1, 1, At, B1); PG8_BAR; PG8_SCHED;
            PG8_LDB(B0, 1, 0); PG8_LDB(B1, 1, 1); PG8_SCHED; PG8_LDA(At, 1, 0); PG8_STAGE_A(PG8_SA(0, 1), a2, 1);
            PG8_WAIT_V(8); PG8_WAIT_L(0); PG8_BAR; PG8_MMA(0, 0, At, B0); PG8_MMA(0, 1, At, B1); PG8_BAR; PG8_SCHED;
            PG8_LDA(At, 1, 1); PG8_STAGE(PG8_SB(1, 0), b3, voffB); PG8_STAGE(PG8_SB(1, 1), b3 + hstep, voffB); PG8_STAGE_A(PG8_SA(1, 0), a3, 0);
            PG8_WAIT_V(8); PG8_WAIT_L(0); PG8_BAR; PG8_MMA(1, 0, At, B0); PG8_MMA(1, 1, At, B1); PG8_BAR; PG8_SCHED;
        }
        if constexpr (ALIGN_EPI) { if (wr == 0) PG8_BAR; }
        E(acc, cur, wr, wc, fr, fq);
        if (!has_next) break;
#pragma unroll
        for (int a = 0; a < 2; ++a)
#pragma unroll
            for (int b = 0; b < 2; ++b)
#pragma unroll
                for (int m = 0; m < 4; ++m)
#pragma unroll
                    for (int n = 0; n < 2; ++n) acc[a][b][m][n] = (f32x4){0.f, 0.f, 0.f, 0.f};
        cur = nxt; cA = nA; cB = nB; ++ui;
        if constexpr (ALIGN_EPI) { if (wr == 1) PG8_BAR; }
    }
    PG8_WAIT_V(0);
    if constexpr (!ALIGN_EPI) { if (wr == 0) PG8_BAR; }
    PG8_BAR;
#undef PG8_SA
#undef PG8_SB
#undef PG8_STAGE
#undef PG8_STAGE_A
#undef PG8_GOFF
#undef PG8_LDA
#undef PG8_LDB
#undef PG8_MMA
#undef PG8_WAIT_V
#undef PG8_WAIT_L
#undef PG8_BAR
#undef PG8_SCHED
}
}

constexpr int NWAVES = 8;
#ifndef MK_DEBUG
#define MK_DEBUG 0
#endif
#ifndef DBG_USE_NAIVE
#define DBG_USE_NAIVE 0
#endif
constexpr int DBGP = MK_DEBUG ? 3 : 0;
enum Phase { PH_P0 = 0, PH_LORA, PH_RKV, PH_S1, PH_S2, PH_S3, PH_DBG0, PH_WOUT = PH_DBG0 + DBGP, PH_ROUT0, PH_GU0, PH_DN0, PH_COMB, PH_KVQ, PH_ATTN, PH_SBO, PH_ROUT1, PH_GU1, PH_DN1, PH_FINAL, NPHASE };
constexpr int N_LAUNCHES = MK_N_LAUNCHES;


constexpr int BATCH = 2, SEQ = 8192, C = 1024, NH = 16, HD = 64, M = BATCH * SEQ;
constexpr int NE = 16, FE = 256, DW = 64, DA = 64, DG = 160;
constexpr float RMS_EPS = 1e-6f, GN_EPS = 64e-5f;
constexpr float SB_EXIT = 104.0f;

constexpr size_t MiB = 1u << 20;
constexpr size_t WS_CTL = 0, CTL_ZERO_BYTES = 64 * 1024;
constexpr size_t WS_WT_W2 = 128 * 1024, WS_WT_A2 = 256 * 1024, WS_WT_G2 = 384 * 1024;
constexpr size_t WS_WT_RKV = 1 * MiB;
constexpr size_t WS_WT_LORA = 7 * MiB;
constexpr size_t WS_WT_OUT = 9 * MiB;
constexpr size_t WS_WT_KVQ = 11 * MiB;
constexpr size_t WS_WT_SBO = 17 * MiB;
constexpr size_t WS_WT_GU = 19 * MiB;
constexpr size_t WS_WT_DN = 51 * MiB;
constexpr size_t WS_LW = 67 * MiB;
constexpr size_t WS_LA = 69 * MiB;
constexpr size_t WS_LG = 71 * MiB;
static_assert(WS_LA == WS_LW + 2 * MiB && WS_LG == WS_LW + 4 * MiB, "EpiLora's pointer arithmetic");
constexpr size_t WS_LIST = 76 * MiB;
constexpr size_t WS_WL = 77 * MiB;
constexpr size_t WS_HID = 78 * MiB;
constexpr size_t WS_B0 = 96 * MiB, WS_B1 = 128 * MiB, WS_B2 = 160 * MiB, WS_B3 = 192 * MiB, WS_B4 = 224 * MiB, WS_END = 256 * MiB;
static_assert(WS_HID + (size_t)144 * 256 * 256 * 2 <= WS_B0, "HID vs B0");
constexpr int CW_TMO = 0;
constexpr int CW_CNT = 1024;
constexpr int CW_BAR = 4096;

constexpr int RING_BYTES = 131072;
constexpr int LDSCTL_OFF = 146688, MISC_OFF = LDSCTL_OFF + 320, MOE_TAB_OFF = MISC_OFF + 128;
constexpr int LDS_BYTES = 147456;
static_assert(MOE_TAB_OFF + 256 <= LDS_BYTES, "LDS map");
static_assert(BATCH * NH * (SEQ / 64) % 16 == 0, "scan units");

#define GAS __attribute__((address_space(1)))
#define LAS __attribute__((address_space(3)))
typedef unsigned short bf16;
typedef unsigned v4u __attribute__((ext_vector_type(4)));
typedef unsigned v2u __attribute__((ext_vector_type(2)));
typedef float f32x4 __attribute__((ext_vector_type(4)));
typedef GAS unsigned gu32;
#define RLX_AGENT __ATOMIC_RELAXED, __HIP_MEMORY_SCOPE_AGENT
#define LDS_WAIT() asm volatile("s_waitcnt lgkmcnt(0)" ::: "memory")
#define VM_WAIT() asm volatile("s_waitcnt vmcnt(0)" ::: "memory")
__device__ __forceinline__ unsigned f2bf(float f) { unsigned u = __builtin_bit_cast(unsigned, f); return (u + 0x7fffu + ((u >> 16) & 1u)) >> 16; }
__device__ __forceinline__ unsigned pk2(float lo, float hi) { return f2bf(lo) | (f2bf(hi) << 16); }
__device__ __forceinline__ float bflo(unsigned u) { return __uint_as_float(u << 16); }
__device__ __forceinline__ float bfhi(unsigned u) { return __uint_as_float(u & 0xffff0000u); }
__device__ __forceinline__ float bf2f(bf16 b) { return __uint_as_float((unsigned)b << 16); }
__device__ __forceinline__ float sigmoidf_(float x) { return 1.0f / (1.0f + __expf(-x)); }

#define XB_TMO      128
#define XB_XCNT(j)  (256  + 64 * (j))
#define XB_XSUB(j)  (1280 + 64 * (j))
#define XB_XGEN(j)  (2304 + 64 * (j))
#define XB_TOP      3328
#define XB_TOPGEN   3392
#define XCD_BAR_WORDS 3456
#define XB_SPIN_CAP (1u << 18)
__device__ __forceinline__ unsigned xb_ld(unsigned* p)              { return __hip_atomic_load(p, __ATOMIC_RELAXED, __HIP_MEMORY_SCOPE_AGENT); }
__device__ __forceinline__ unsigned xb_add(unsigned* p, unsigned v) { return __hip_atomic_fetch_add(p, v, __ATOMIC_RELAXED, __HIP_MEMORY_SCOPE_AGENT); }
__device__ __forceinline__ unsigned xb_xcc_id() { return (unsigned)__builtin_amdgcn_s_getreg((3 << 11) | 20) & 0xFu; }
#define XB_SPIN(cond, bar) do { unsigned _sp = 0; while (cond) { __builtin_amdgcn_s_sleep(1); \
    if ((++_sp & 255u) == 0u) { if (xb_ld(&(bar)[XB_TMO])) break; if (_sp > XB_SPIN_CAP) { atomicAdd(&(bar)[XB_TMO], 1u); break; } } } } while (0)
struct XcdBarrier { unsigned* bar; unsigned x; volatile LAS unsigned* st; };
__device__ __forceinline__ XcdBarrier xcd_barrier_post(unsigned* bar, volatile LAS unsigned* st) {
    XcdBarrier b; b.bar = bar; b.x = xb_xcc_id(); b.st = st;
    if (threadIdx.x == 0) (void)xb_add(&bar[XB_XCNT(b.x)], 1u);
    return b;
}
__device__ __forceinline__ void xcd_barrier_complete(unsigned* bar, unsigned x, unsigned& nloc, unsigned& nx) {
    const unsigned G = gridDim.x * gridDim.y * gridDim.z;
    unsigned sum, cnt, mine, sp = 0u;
    for (;;) {
        sum = 0u; cnt = 0u; mine = 0u;
#pragma unroll
        for (unsigned j = 0; j < 16; ++j) { const unsigned c = xb_ld(&bar[XB_XCNT(j)]); sum += c; cnt += (c > 0u) ? 1u : 0u; mine = (j == x) ? c : mine; }
        if (sum == G) break;
        __builtin_amdgcn_s_sleep(1);
        if ((++sp & 255u) == 0u) { if (xb_ld(&bar[XB_TMO])) break; if (sp > XB_SPIN_CAP) { atomicAdd(&bar[XB_TMO], 1u); break; } }
    }
    nloc = mine > 0u ? mine : 1u; nx = cnt > 0u ? cnt : 1u;
}
__device__ __forceinline__ void xcd_barrier(const XcdBarrier& b) {
    asm volatile("s_waitcnt vmcnt(0)" ::: "memory");
    __syncthreads();
    if (threadIdx.x == 0) {
        unsigned* bar = b.bar;
        __builtin_amdgcn_s_waitcnt(0);
        unsigned nloc = b.st[0], nx = b.st[1];
        if (nloc == 0u) { xcd_barrier_complete(bar, b.x, nloc, nx); b.st[0] = nloc; b.st[1] = nx; }
        const unsigned old = xb_add(&bar[XB_XSUB(b.x)], 1u);
        const unsigned gen = old / nloc;
        const unsigned target = (gen + 1u) * nx;
        if (old + 1u == (gen + 1u) * nloc) {
            __builtin_amdgcn_fence(__ATOMIC_RELEASE, "agent");
            asm volatile("s_waitcnt vmcnt(0)" ::: "memory");
            const unsigned og = xb_add(&bar[XB_TOP], 1u);
            if (og + 1u != target) XB_SPIN((int)(xb_ld(&bar[XB_TOP]) - target) < 0, bar);
        } else {
            XB_SPIN((int)(xb_ld(&bar[XB_TOP]) - target) < 0, bar);
        }
        __builtin_amdgcn_fence(__ATOMIC_ACQUIRE, "agent");
        asm volatile("s_waitcnt vmcnt(0)" ::: "memory");
    }
    __syncthreads();
}

__device__ __forceinline__ float shx(float v, int o, int lane) { return __int_as_float(__builtin_amdgcn_ds_bpermute((lane ^ o) << 2, __float_as_int(v))); }
#define DPP_ADD(v, ctrl) ((v) + __int_as_float(__builtin_amdgcn_update_dpp(0, __float_as_int(v), (ctrl), 0xf, 0xf, true)))
__device__ __forceinline__ float wave_sum(float v, int lane) {
    (void)lane;
    v = DPP_ADD(v, 0x128); v = DPP_ADD(v, 0x124); v = DPP_ADD(v, 0x122); v = DPP_ADD(v, 0x121);
    const int iv = __float_as_int(v);
    return (__int_as_float(__builtin_amdgcn_readlane(iv, 0)) + __int_as_float(__builtin_amdgcn_readlane(iv, 16))) + (__int_as_float(__builtin_amdgcn_readlane(iv, 32)) + __int_as_float(__builtin_amdgcn_readlane(iv, 48)));
}
__device__ __forceinline__ float sum8(float v) { v = DPP_ADD(v, 0xB1); v = DPP_ADD(v, 0x4E); v = DPP_ADD(v, 0x141); return v; }
__device__ __forceinline__ void transpose_item(const float* W, int ldw, int k0, int n0, bf16* WT, int ldk, int dst_row0, const float* kscale, LAS float* scr, int lane, int kmax = 1 << 30) {
    const int r8 = lane >> 3, quad = lane & 7;
    f32x4 v[8];
#pragma unroll
    for (int i = 0; i < 8; ++i) { const int kk = r8 + 8 * i; v[i] = (k0 + kk < kmax) ? *(const GAS f32x4*)(W + (size_t)(k0 + kk) * ldw + n0 + quad * 4) : (f32x4){0.f, 0.f, 0.f, 0.f}; }
#pragma unroll
    for (int i = 0; i < 8; ++i) { const int kk = r8 + 8 * i; if (kscale) v[i] = v[i] * kscale[(k0 + kk < kmax) ? k0 + kk : 0]; *(LAS f32x4*)(scr + kk * 36 + ((quad ^ i) << 2)) = v[i]; }
    LDS_WAIT(); asm volatile("" ::: "memory");
    const int c = lane & 7;
#pragma unroll
    for (int j = 0; j < 4; ++j) { const int n = (lane >> 3) + 8 * j; const LAS float* sp = scr + (8 * c) * 36 + ((((n >> 2) ^ c) << 2) | (n & 3));
        v4u o; o.x = pk2(sp[0 * 36], sp[1 * 36]); o.y = pk2(sp[2 * 36], sp[3 * 36]); o.z = pk2(sp[4 * 36], sp[5 * 36]); o.w = pk2(sp[6 * 36], sp[7 * 36]);
        if (k0 + 8 * c < kmax) *(GAS v4u*)(WT + (size_t)(dst_row0 + n) * ldk + k0 + 8 * c) = o; }
    LDS_WAIT(); asm volatile("" ::: "memory");
}

struct Args { const float* in[31]; float* out; unsigned char* ws; int ph_lo, ph_hi, li, pad; };
typedef const __attribute__((address_space(4))) unsigned char* kaptr_t;
__device__ __forceinline__ kaptr_t ka_base() { kaptr_t p = (kaptr_t)__builtin_amdgcn_kernarg_segment_ptr(); asm volatile("" : "+s"(p)); return p; }
#define INP(k) (*(const float* const __attribute__((address_space(4)))*)(ka_base() + 8 * (k)))
#define OUTP() (*(float* const __attribute__((address_space(4)))*)(ka_base() + 8 * 31))
#define WSP() (*(unsigned char* const __attribute__((address_space(4)))*)(ka_base() + 8 * 32))
#define KA_INT(i) (*(const int __attribute__((address_space(4)))*)(ka_base() + 8 * 33 + 4 * (i)))

template <int PART> __device__ __forceinline__ void p0_weights(unsigned char* ws, LAS unsigned char* lds, int gw, int NGW, int wave, int lane) {
    LAS float* scr = (LAS float*)(lds + wave * 16384);
    bf16* WT_RKV = (bf16*)(ws + WS_WT_RKV); bf16* WT_LORA = (bf16*)(ws + WS_WT_LORA); bf16* WT_OUT = (bf16*)(ws + WS_WT_OUT); bf16* WT_KVQ = (bf16*)(ws + WS_WT_KVQ);
    bf16* WT_SBO = (bf16*)(ws + WS_WT_SBO); bf16* WT_GU = (bf16*)(ws + WS_WT_GU); bf16* WT_DN = (bf16*)(ws + WS_WT_DN);
    constexpr int I_UP = 32 + 32 + 96, I_RKV = 3 * 512, I_LORA = 32 + 32 + 80, I_OUT = 512, I_KV = 1024, I_Q = 512, I_SBO = 512, I_G = 32 * 128, I_U = 32 * 128, I_D = 32 * 128;
    constexpr int NDENSE = I_UP + I_RKV + I_LORA + I_OUT + I_KV + I_Q + I_SBO, NITEMS = NDENSE + I_G + I_U + I_D;
    constexpr int NLOOP = PART == 0 ? NDENSE : 3 * 2048; (void)NITEMS;
    for (int q_ = gw; q_ < NLOOP; q_ += NGW) {
        const int it = PART == 0 ? q_ : NDENSE + (q_ / 2048) * 4096 + 2048 * (PART - 1) + (q_ % 2048);
        int r = it;
        if (r < I_UP) {
            if (r < 32) transpose_item(INP(9), C, 0, 32 * r, (bf16*)(ws + WS_WT_W2), 64, 32 * r, nullptr, scr, lane);
            else if (r < 64) transpose_item(INP(12), C, 0, 32 * (r - 32), (bf16*)(ws + WS_WT_A2), 64, 32 * (r - 32), nullptr, scr, lane);
            else { const int q = r - 64, kb = q / 32, nb = q % 32; transpose_item(INP(14), C, 64 * kb, 32 * nb, (bf16*)(ws + WS_WT_G2), DG, 32 * nb, nullptr, scr, lane, DG); }
            continue; } r -= I_UP;
        if (r < I_RKV) { const int m = r / 512, q = r % 512, kb = q / 32, nb = q % 32; transpose_item(INP(6) + (size_t)m * C * C, C, 64 * kb, 32 * nb, WT_RKV, C, m * C + 32 * nb, nullptr, scr, lane); continue; } r -= I_RKV;
        if (r < I_LORA) {
            if (r < 32) { const int kb = r / 2, nb = r % 2; transpose_item(INP(8), DW, 64 * kb, 32 * nb, WT_LORA, C, 32 * nb, nullptr, scr, lane); }
            else if (r < 64) { const int q = r - 32, kb = q / 2, nb = q % 2; transpose_item(INP(11), DA, 64 * kb, 32 * nb, WT_LORA, C, 256 + 32 * nb, nullptr, scr, lane); }
            else { const int q = r - 64, kb = q / 5, nb = q % 5; transpose_item(INP(13), DG, 64 * kb, 32 * nb, WT_LORA, C, 512 + 32 * nb, nullptr, scr, lane); }
            continue; } r -= I_LORA;
        if (r < I_OUT) { const int kb = r / 32, nb = r % 32; transpose_item(INP(20), C, 64 * kb, 32 * nb, WT_OUT, C, 32 * nb, nullptr, scr, lane); continue; } r -= I_OUT;
        if (r < I_KV) { const int kb = r / 64, nb = r % 64; transpose_item(INP(21), 2 * C, 64 * kb, 32 * nb, WT_KVQ, C, 32 * nb, INP(3), scr, lane); continue; } r -= I_KV;
        if (r < I_Q) { const int kb = r / 32, nb = r % 32; transpose_item(INP(22), C, 64 * kb, 32 * nb, WT_KVQ, C, 2 * C + 32 * nb, INP(1) + C, scr, lane); continue; } r -= I_Q;
        if (r < I_SBO) { const int kb = r / 32, nb = r % 32; transpose_item(INP(23), C, 64 * kb, 32 * nb, WT_SBO, C, 32 * nb, nullptr, scr, lane); continue; } r -= I_SBO;
        if (r < I_G) { const int le = r / 128, q = r % 128, kb = q / 8, nb = q % 8, f0 = 32 * nb; transpose_item(INP(28) + (size_t)le * C * FE, FE, 64 * kb, f0, WT_GU + (size_t)le * 512 * C, C, 256 * (f0 / 128) + (f0 % 128), INP(2) + (le >> 4) * C, scr, lane); continue; } r -= I_G;
        if (r < I_U) { const int le = r / 128, q = r % 128, kb = q / 8, nb = q % 8, f0 = 32 * nb; transpose_item(INP(29) + (size_t)le * C * FE, FE, 64 * kb, f0, WT_GU + (size_t)le * 512 * C, C, 256 * (f0 / 128) + 128 + (f0 % 128), INP(2) + (le >> 4) * C, scr, lane); continue; } r -= I_U;
        { const int le = r / 128, q = r % 128, kb = q / 32, nb = q % 32; transpose_item(INP(30) + (size_t)le * FE * C, C, 64 * kb, 32 * nb, WT_DN + (size_t)le * C * FE, FE, 32 * nb, nullptr, scr, lane); }
    }
    if (PART == 0) for (int it = gw * 64 + lane; it < 768 * 128; it += NGW * 64) { const int row = it >> 7, ch = it & 127;
        const bool valid = (row < 64) || (row >= 256 && row < 320) || (row >= 512 && row < 672);
        if (!valid) *(GAS v4u*)(WT_LORA + (size_t)row * C + ch * 8) = (v4u){0u, 0u, 0u, 0u}; }
}
__device__ __forceinline__ void load_row(const float* p, int lane, f32x4 (&v)[4]) {
#pragma unroll
    for (int j = 0; j < 4; ++j) v[j] = ((const GAS f32x4*)p)[64 * j + lane];
}
__device__ __forceinline__ void load_row_bf(const bf16* p, int lane, f32x4 (&v)[4]) {
#pragma unroll
    for (int j = 0; j < 4; ++j) { const v2u w = ((const GAS v2u*)p)[64 * j + lane]; v[j] = (f32x4){bflo(w.x), bfhi(w.x), bflo(w.y), bfhi(w.y)}; }
}
__device__ __forceinline__ float row_rs(const f32x4 (&v)[4], int lane) {
    float s = 0.f;
#pragma unroll
    for (int j = 0; j < 4; ++j) s += (v[j].x * v[j].x + v[j].y * v[j].y) + (v[j].z * v[j].z + v[j].w * v[j].w);
    return 1.0f / sqrtf(wave_sum(s, lane) * (1.0f / C) + RMS_EPS);
}
__device__ __forceinline__ void store_row_bf16(bf16* p, int lane, const f32x4 (&v)[4]) {
#pragma unroll
    for (int j = 0; j < 4; ++j) { v2u o; o.x = pk2(v[j].x, v[j].y); o.y = pk2(v[j].z, v[j].w); ((GAS v2u*)p)[64 * j + lane] = o; }
}
__device__ __forceinline__ void p0_rows(unsigned char* ws, int gw, int NGW, int lane) {
    const float* x = INP(0); const float* gain = INP(1); const float* mix = INP(5);
    f32x4 g[4]; load_row(gain, lane, g);
    f32x4 mx[6][4];
#pragma unroll
    for (int i = 0; i < 6; ++i) load_row(mix + i * C, lane, mx[i]);
    for (int run = gw; run < M / 8; run += NGW) {
        const int r0 = run * 8;
        f32x4 prev[4], nx[4];
        load_row(x + (size_t)r0 * C, lane, nx);
        if ((r0 % SEQ) == 0) {
#pragma unroll
            for (int j = 0; j < 4; ++j) prev[j] = (f32x4){0.f, 0.f, 0.f, 0.f};
        } else { load_row(x + (size_t)(r0 - 1) * C, lane, prev); const float rs = row_rs(prev, lane);
#pragma unroll
            for (int j = 0; j < 4; ++j) prev[j] = prev[j] * rs * g[j]; }
#pragma unroll 1
        for (int rr = 0; rr < 8; ++rr) {
            const int row = r0 + rr;
            f32x4 hn[4];
#pragma unroll
            for (int j = 0; j < 4; ++j) hn[j] = nx[j];
            if (rr < 7) load_row(x + (size_t)(row + 1) * C, lane, nx);
            const float rs = row_rs(hn, lane);
#pragma unroll
            for (int j = 0; j < 4; ++j) hn[j] = hn[j] * rs * g[j];
#pragma unroll
            for (int i = 0; i < 6; ++i) { f32x4 o[4];
#pragma unroll
                for (int j = 0; j < 4; ++j) o[j] = hn[j] + (prev[j] - hn[j]) * mx[i][j];
                bf16* dst = i < 2 ? (bf16*)OUTP() + (size_t)i * M * C : (i == 2 ? (bf16*)(ws + WS_B4) : (bf16*)(ws + WS_B1) + (size_t)(i - 3) * M * C);
                store_row_bf16(dst + (size_t)row * C, lane, o); }
#pragma unroll
            for (int j = 0; j < 4; ++j) prev[j] = hn[j];
        }
    }
}

template <int NN, int NGROUPS> struct SchedGrouped {
    static constexpr int K = C;
    const char* A0; size_t astride; const char* A2; const char* B; size_t bgroup;
    int G, c;
    __device__ __forceinline__ bool next(int i, pg8::Unit& u) const {
        const int L = i * G + c; constexpr int per = 64 * NN; if (L >= per * NGROUPS) return false;
        const int g = L / per, w = L % per; pg8::tile_map(w, 64, NN, u.pm, u.pn); u.aux = g; u.r0 = 0; u.cnt = 0; return true; }
    __device__ __forceinline__ const char* a_base(const pg8::Unit& u) const { const char* A = (A2 != nullptr && u.aux == 2) ? A2 : A0 + (size_t)u.aux * astride; return A + (size_t)u.pm * 256 * K * 2; }
    __device__ __forceinline__ const char* b_base(const pg8::Unit& u) const { return B + (size_t)u.aux * bgroup + (size_t)u.pn * 256 * K * 2; }
    __device__ __forceinline__ unsigned a_row_off(const pg8::Unit&, int) const { return 0u; }
};
template <int NN, int K, bool GATHER> struct SchedMoe {
    const char* A; const char* B; size_t bexp; const unsigned* list; volatile LAS int* tab; int G, c;
    __device__ __forceinline__ bool next(int i, pg8::Unit& u) const {
        const int L = i * G + c; const int tot = __builtin_amdgcn_readfirstlane(tab[48]) * NN; if (L >= tot) return false;
        u.pm = L / NN; u.pn = L % NN; int e = 0;
#pragma unroll
        for (int j = 0; j < 16; ++j) e += (u.pm >= tab[32 + j]) ? 1 : 0;
        e = __builtin_amdgcn_readfirstlane(e);
        u.aux = e; u.r0 = (u.pm - __builtin_amdgcn_readfirstlane(tab[16 + e])) * 256; u.cnt = __builtin_amdgcn_readfirstlane(tab[e]); return true; }
    __device__ __forceinline__ const char* a_base(const pg8::Unit& u) const { return GATHER ? A : A + (size_t)u.pm * 256 * K * 2; }
    __device__ __forceinline__ const char* b_base(const pg8::Unit& u) const { return B + (size_t)u.aux * bexp + (size_t)u.pn * 256 * K * 2; }
    __device__ __forceinline__ unsigned a_row_off(const pg8::Unit& u, int r) const {
        const int idx = u.r0 + r; unsigned tok = 0u;
        if (idx < u.cnt) tok = list[(size_t)u.aux * M + idx] >> 1;
        return tok * (unsigned)(K * 2); }
};

using pg8::f32x4;
using pg8::Unit;
__device__ __forceinline__ v4u pack8(f32x4 v0, f32x4 v1) { v4u w; w.x = pg8::cvt_pk_bf16(v0[0], v0[1]); w.y = pg8::cvt_pk_bf16(v0[2], v0[3]); w.z = pg8::cvt_pk_bf16(v1[0], v1[1]); w.w = pg8::cvt_pk_bf16(v1[2], v1[3]); return w; }

struct EpiLora {
    static constexpr bool PERM = true;
    bf16* LW;
    __device__ __forceinline__ void operator()(const f32x4 (&acc)[2][2][4][2], const Unit& u, int wr, int wc, int fr, int fq) const {
        { int l_; asm volatile("v_mbcnt_lo_u32_b32 %0, -1, 0\n\tv_mbcnt_hi_u32_b32 %0, -1, %0" : "=v"(l_)); fr = l_ & 15; fq = l_ >> 4; }
        const int g = u.aux, width = g == 2 ? DG : DW; bf16* out = LW + (size_t)g * (1u << 20);
        const int row0 = u.pm * 256 + wr * 64 + fr;
#pragma unroll
        for (int bj = 0; bj < 2; ++bj) { const int col0 = bj * 128 + wc * 32 + 8 * fq; if (col0 < width) {
#pragma unroll
            for (int ai = 0; ai < 2; ++ai)
#pragma unroll
                for (int m = 0; m < 4; ++m) { f32x4 v0 = acc[ai][bj][m][0], v1 = acc[ai][bj][m][1];
                    if (g == 0) {
#pragma unroll
                        for (int q = 0; q < 4; ++q) { v0[q] = tanhf(v0[q]); v1[q] = tanhf(v1[q]); } }
                    else if (g == 2) {
#pragma unroll
                        for (int q = 0; q < 4; ++q) { v0[q] = sigmoidf_(v0[q]); v1[q] = sigmoidf_(v1[q]); } }
                    *(GAS v4u*)(out + (size_t)(row0 + ai * 128 + m * 16) * width + col0) = pack8(v0, v1); } } }
    }
};
struct EpiSplit3 {
    static constexpr bool PERM = true;
    bf16* O0; bool bycol; const float* rowscale;
    __device__ __forceinline__ void operator()(const f32x4 (&acc)[2][2][4][2], const Unit& u, int wr, int wc, int fr, int fq) const {
        { int l_; asm volatile("v_mbcnt_lo_u32_b32 %0, -1, 0\n\tv_mbcnt_hi_u32_b32 %0, -1, %0" : "=v"(l_)); fr = l_ & 15; fq = l_ >> 4; }
        const int g = bycol ? (u.pn >> 2) : u.aux, pn = bycol ? (u.pn & 3) : u.pn; bf16* out = O0 + (size_t)g * ((size_t)M * C);
        const int row0 = u.pm * 256 + wr * 64 + fr, col0 = pn * 256 + wc * 32 + 8 * fq;
#pragma unroll
        for (int ai = 0; ai < 2; ++ai)
#pragma unroll
            for (int m = 0; m < 4; ++m)
                { const float sc = rowscale ? rowscale[row0 + ai * 128 + m * 16] : 1.0f;
#pragma unroll
                for (int bj = 0; bj < 2; ++bj) *(GAS v4u*)(out + (size_t)(row0 + ai * 128 + m * 16) * C + col0 + bj * 128) = pack8(acc[ai][bj][m][0] * sc, acc[ai][bj][m][1] * sc); }
    }
};
template <bool BASE_F32> struct EpiResidBf {
    static constexpr bool PERM = true;
    const void* base; bf16* out;
    __device__ __forceinline__ void operator()(const f32x4 (&acc)[2][2][4][2], const Unit& u, int wr, int wc, int fr, int fq) const {
        { int l_; asm volatile("v_mbcnt_lo_u32_b32 %0, -1, 0\n\tv_mbcnt_hi_u32_b32 %0, -1, %0" : "=v"(l_)); fr = l_ & 15; fq = l_ >> 4; }
        const int row0 = u.pm * 256 + wr * 64 + fr, col0 = u.pn * 256 + wc * 32 + 8 * fq;
#pragma unroll
        for (int ai = 0; ai < 2; ++ai)
#pragma unroll
            for (int m = 0; m < 4; ++m) { const size_t off = (size_t)(row0 + ai * 128 + m * 16) * C + col0;
#pragma unroll
                for (int bj = 0; bj < 2; ++bj) { f32x4 b0, b1;
                    if (BASE_F32) { b0 = *(const GAS f32x4*)((const float*)base + off + bj * 128); b1 = *(const GAS f32x4*)((const float*)base + off + bj * 128 + 4); }
                    else { const v4u w = *(const GAS v4u*)((const bf16*)base + off + bj * 128); b0 = (f32x4){bflo(w.x), bfhi(w.x), bflo(w.y), bfhi(w.y)}; b1 = (f32x4){bflo(w.z), bfhi(w.z), bflo(w.w), bfhi(w.w)}; }
                    *(GAS v4u*)(out + off + bj * 128) = pack8(b0 + acc[ai][bj][m][0], b1 + acc[ai][bj][m][1]); }
                asm volatile("" ::: "memory"); }
    }
};
struct EpiGU {
    static constexpr bool PERM = true;
    bf16* HID; const float* wl; const float* rsl;
    __device__ __forceinline__ void operator()(const f32x4 (&acc)[2][2][4][2], const Unit& u, int wr, int wc, int fr, int fq) const {
        { int l_; asm volatile("v_mbcnt_lo_u32_b32 %0, -1, 0\n\tv_mbcnt_hi_u32_b32 %0, -1, %0" : "=v"(l_)); fr = l_ & 15; fq = l_ >> 4; }
        const int e = u.aux, cnt = u.cnt, base = u.r0, r0 = wr * 64 + fr, col0 = u.pn * 128 + wc * 32 + 8 * fq;
#pragma unroll
        for (int ai = 0; ai < 2; ++ai)
#pragma unroll
            for (int m = 0; m < 4; ++m) { const int r = r0 + ai * 128 + m * 16, idx = base + r; float w = 0.f, rs = 0.f; if (idx < cnt) { w = wl[(size_t)e * M + idx]; rs = rsl[(size_t)e * M + idx]; }
                f32x4 h0, h1;
#pragma unroll
                for (int q = 0; q < 4; ++q) { const float g0 = acc[ai][0][m][0][q] * rs, g1 = acc[ai][0][m][1][q] * rs;
                    h0[q] = g0 * sigmoidf_(g0) * (acc[ai][1][m][0][q] * rs) * w; h1[q] = g1 * sigmoidf_(g1) * (acc[ai][1][m][1][q] * rs) * w; }
                *(GAS v4u*)(HID + (size_t)(u.pm * 256 + r) * FE + col0) = pack8(h0, h1);
                asm volatile("" ::: "memory"); }
    }
};
struct EpiDown {
    static constexpr bool PERM = true;
    bf16* EO; const unsigned* list;
    __device__ __forceinline__ void operator()(const f32x4 (&acc)[2][2][4][2], const Unit& u, int wr, int wc, int fr, int fq) const {
        { int l_; asm volatile("v_mbcnt_lo_u32_b32 %0, -1, 0\n\tv_mbcnt_hi_u32_b32 %0, -1, %0" : "=v"(l_)); fr = l_ & 15; fq = l_ >> 4; }
        const int e = u.aux, cnt = u.cnt, base = u.r0, r0 = wr * 64 + fr, col0 = u.pn * 256 + wc * 32 + 8 * fq;
#pragma unroll
        for (int ai = 0; ai < 2; ++ai)
#pragma unroll
            for (int m = 0; m < 4; ++m) { const int idx = base + r0 + ai * 128 + m * 16;
                if (idx < cnt) { const unsigned ent = list[(size_t)e * M + idx]; bf16* o = EO + ((size_t)(ent & 1u) * M + (ent >> 1)) * C + col0;
#pragma unroll
                    for (int bj = 0; bj < 2; ++bj) *(GAS v4u*)(o + bj * 128) = pack8(acc[ai][bj][m][0], acc[ai][bj][m][1]); }
                asm volatile("" ::: "memory"); }
    }
};

typedef short bf16x8s __attribute__((ext_vector_type(8)));
typedef short bf16x4s __attribute__((ext_vector_type(4)));
typedef short v4i16_t __attribute__((ext_vector_type(4)));
constexpr int TPB = 144;
constexpr int TILE_B = 64 * TPB;
constexpr int FP = 68;
constexpr int CS_FA = 0, CS_FB = 16384, CS_TILES = 32768, CS_TOT = CS_TILES + 12 * TILE_B, CS_WL = CS_TOT + 2048, CS_PAR = CS_WL + 256;
static_assert(CS_PAR + 768 <= LDSCTL_OFF, "scan LDS map");
#define TILE(n) (lds + CS_TILES + (n) * TILE_B)
#define F4Z (f32x4){0.f, 0.f, 0.f, 0.f}
__device__ __forceinline__ bf16x8s ldfrag(const LAS unsigned char* tile, int row, int kcol) { return *(const LAS bf16x8s*)(tile + row * TPB + kcol * 2); }
__device__ __forceinline__ bf16x8s ldfrag_tr(const LAS unsigned char* tile, int n0, int k0, int lane) {
    const int g = lane >> 4, q = (lane & 15) >> 2, p = lane & 3;
    const LAS unsigned char* a = tile + (k0 + 8 * g + q) * TPB + (n0 + 4 * p) * 2;
    const v4i16_t lo = __builtin_amdgcn_ds_read_tr16_b64_v4i16((LAS v4i16_t*)a), hi = __builtin_amdgcn_ds_read_tr16_b64_v4i16((LAS v4i16_t*)(a + 4 * TPB));
    return (bf16x8s){lo[0], lo[1], lo[2], lo[3], hi[0], hi[1], hi[2], hi[3]};
}
__device__ __forceinline__ bf16x8s ldfrag_perm(const LAS unsigned char* tile, int row, int ks, int g) {
    const bf16x4s lo = *(const LAS bf16x4s*)(tile + row * TPB + (32 * ks + 4 * g) * 2), hi = *(const LAS bf16x4s*)(tile + row * TPB + (32 * ks + 16 + 4 * g) * 2);
    return (bf16x8s){lo[0], lo[1], lo[2], lo[3], hi[0], hi[1], hi[2], hi[3]};
}
__device__ __forceinline__ void lds_barrier() { asm volatile("s_waitcnt lgkmcnt(0)" ::: "memory"); __builtin_amdgcn_s_barrier(); asm volatile("" ::: "memory"); }
#define MFMA16(a, b, c) __builtin_amdgcn_mfma_f32_16x16x32_bf16((a), (b), (c), 0, 0, 0)
__device__ __forceinline__ void mm64(f32x4 (&acc)[2], const LAS unsigned char* At, const LAS unsigned char* Bt, int rt, int ch, int fr, int g) {
#pragma unroll
    for (int ks = 0; ks < 2; ++ks) { const bf16x8s a = ldfrag(At, 16 * rt + fr, 32 * ks + 8 * g);
#pragma unroll
        for (int ct = 0; ct < 2; ++ct) acc[ct] = MFMA16(a, ldfrag(Bt, 32 * ch + 16 * ct + fr, 32 * ks + 8 * g), acc[ct]); }
}
__device__ __forceinline__ void mm64_bt(f32x4 (&acc)[2], const LAS unsigned char* At, const LAS unsigned char* X, int rt, int ch, int fr, int g, int lane) {
#pragma unroll
    for (int ks = 0; ks < 2; ++ks) { const bf16x8s a = ldfrag(At, 16 * rt + fr, 32 * ks + 8 * g);
#pragma unroll
        for (int ct = 0; ct < 2; ++ct) acc[ct] = MFMA16(a, ldfrag_tr(X, 32 * ch + 16 * ct, 32 * ks, lane), acc[ct]); }
}
__device__ __forceinline__ void mm64_at(f32x4 (&acc)[2], const LAS unsigned char* Xa, const LAS unsigned char* Bt, int rt, int ch, int fr, int g, int lane) {
#pragma unroll
    for (int ks = 0; ks < 2; ++ks) { const bf16x8s a = ldfrag_tr(Xa, 16 * rt, 32 * ks, lane);
#pragma unroll
        for (int ct = 0; ct < 2; ++ct) acc[ct] = MFMA16(a, ldfrag(Bt, 32 * ch + 16 * ct + fr, 32 * ks + 8 * g), acc[ct]); }
}
__device__ __forceinline__ void mm64_att(f32x4 (&acc)[2], const LAS unsigned char* Xa, const LAS unsigned char* X, int rt, int ch, int lane) {
#pragma unroll
    for (int ks = 0; ks < 2; ++ks) { const bf16x8s a = ldfrag_tr(Xa, 16 * rt, 32 * ks, lane);
#pragma unroll
        for (int ct = 0; ct < 2; ++ct) acc[ct] = MFMA16(a, ldfrag_tr(X, 32 * ch + 16 * ct, 32 * ks, lane), acc[ct]); }
}
__device__ __forceinline__ bf16x4s pack4(f32x4 v) { v2u w; w.x = pg8::cvt_pk_bf16(v[0], v[1]); w.y = pg8::cvt_pk_bf16(v[2], v[3]); return __builtin_bit_cast(bf16x4s, w); }
__device__ __forceinline__ f32x4 unpack4(bf16x4s s) { const v2u w = __builtin_bit_cast(v2u, s); return (f32x4){bflo(w.x), bfhi(w.x), bflo(w.y), bfhi(w.y)}; }
__device__ __forceinline__ void st_tr(LAS unsigned char* Out, const f32x4 (&acc)[2], int rt, int ch, int fr, int g) {
#pragma unroll
    for (int ct = 0; ct < 2; ++ct) *(LAS bf16x4s*)(Out + (32 * ch + 16 * ct + fr) * TPB + (16 * rt + 4 * g) * 2) = pack4(acc[ct]);
}
__device__ __forceinline__ void ld_tr(f32x4 (&acc)[2], const LAS unsigned char* In, int rt, int ch, int fr, int g) {
#pragma unroll
    for (int ct = 0; ct < 2; ++ct) acc[ct] = unpack4(*(const LAS bf16x4s*)(In + (32 * ch + 16 * ct + fr) * TPB + (16 * rt + 4 * g) * 2));
}
__device__ __forceinline__ void unpack8(v4u w, float (&o)[8]) { o[0] = bflo(w.x); o[1] = bfhi(w.x); o[2] = bflo(w.y); o[3] = bfhi(w.y); o[4] = bflo(w.z); o[5] = bfhi(w.z); o[6] = bflo(w.w); o[7] = bfhi(w.w); }
__device__ __forceinline__ v4u pack8f(const float (&o)[8]) { v4u w; w.x = pg8::cvt_pk_bf16(o[0], o[1]); w.y = pg8::cvt_pk_bf16(o[2], o[3]); w.z = pg8::cvt_pk_bf16(o[4], o[5]); w.w = pg8::cvt_pk_bf16(o[6], o[7]); return w; }

struct FrontIn { v4u r, k, v; bf16x8s fw[2], fa[2]; };
__device__ __forceinline__ void front_fetch(FrontIn& f, unsigned char* ws, int unit, int tid, int lane, int wave) {
    const int h = unit & 15, c = (unit >> 4) & 127, b = unit >> 11; const size_t row0 = (size_t)b * SEQ + c * 64;
    const int rt = wave & 3, fr = lane & 15, g = lane >> 4, t = tid >> 3, cq = tid & 7, c0 = h * HD + cq * 8;
    const bf16* Rb = (const bf16*)(ws + WS_B1); const bf16* Kb = (const bf16*)(ws + WS_B2); const bf16* Vb = (const bf16*)(ws + WS_B3);
    const bf16* LW = (const bf16*)(ws + WS_LW); const bf16* LA = (const bf16*)(ws + WS_LA);
    f.r = *(const GAS v4u*)(Rb + (row0 + t) * C + c0); f.k = *(const GAS v4u*)(Kb + (row0 + t) * C + c0); f.v = *(const GAS v4u*)(Vb + (row0 + t) * C + c0);
#pragma unroll
    for (int ks = 0; ks < 2; ++ks) { f.fw[ks] = *(const GAS bf16x8s*)(LW + (row0 + 16 * rt + fr) * DW + 32 * ks + 8 * g); f.fa[ks] = *(const GAS bf16x8s*)(LA + (row0 + 16 * rt + fr) * DA + 32 * ks + 8 * g); }
}
__device__ __forceinline__ v4u head_consts(unsigned char* ws, LAS unsigned char* lds, int h, int tid, int wtile, int atile) {
    const bf16* W2T = (const bf16*)(ws + WS_WT_W2); const bf16* A2T = (const bf16*)(ws + WS_WT_A2);
    const int row = tid >> 3, cq = tid & 7;
    const v4u w2chunk = *(const GAS v4u*)(W2T + (size_t)(h * HD + row) * 64 + cq * 8);
    *(LAS v4u*)(lds + CS_TILES + wtile * TILE_B + row * TPB + cq * 16) = w2chunk;
    *(LAS v4u*)(lds + CS_TILES + atile * TILE_B + row * TPB + cq * 16) = *(const GAS v4u*)(A2T + (size_t)(h * HD + row) * 64 + cq * 8);
    if (tid < 64) { LAS float* P = (LAS float*)(lds + CS_PAR); P[tid] = INP(15)[h * HD + tid]; P[64 + tid] = INP(16)[h * HD + tid]; P[128 + tid] = INP(17)[h * HD + tid]; }
    __syncthreads();
    return w2chunk;
}
template <int MODE>
__device__ __forceinline__ void chunk_front(const FrontIn& f, LAS unsigned char* lds, const float (&w0v)[2], const float (&a0v)[2], const bf16x8s (&w2f)[2][2], const bf16x8s (&a2f)[2][2], int tid, int lane, int wave, float (&v8)[8], float& rkb) {
    const int rt = wave & 3, ch = wave >> 2, fr = lane & 15, g = lane >> 4;
    LAS float* FA = (LAS float*)(lds + CS_FA); LAS float* FB = (LAS float*)(lds + CS_FB); LAS float* TOT = (LAS float*)(lds + CS_TOT);
    const int t = tid >> 3, cq = tid & 7;
    {
        f32x4 aw[2] = {F4Z, F4Z}, aa[2] = {F4Z, F4Z};
#pragma unroll
        for (int ks = 0; ks < 2; ++ks)
#pragma unroll
            for (int ct = 0; ct < 2; ++ct) { aw[ct] = MFMA16(f.fw[ks], w2f[ks][ct], aw[ct]); aa[ct] = MFMA16(f.fa[ks], a2f[ks][ct], aa[ct]); }
#pragma unroll
        for (int ct = 0; ct < 2; ++ct) { const int j = 32 * ch + 16 * ct + fr, js = j ^ ((g & 1) << 4); const float w0 = w0v[ct], a0 = a0v[ct];
            float p[4];
#pragma unroll
            for (int q = 0; q < 4; ++q) { p[q] = -0.6065306597126334f * sigmoidf_(w0 + aw[ct][q]); if (q) p[q] += p[q - 1]; }
            const float s_ = p[3];
            const float u1 = __int_as_float(__builtin_amdgcn_ds_bpermute(((lane - 16) & 63) << 2, __float_as_int(s_))); const float t1 = s_ + (g >= 1 ? u1 : 0.f);
            const float u2 = __int_as_float(__builtin_amdgcn_ds_bpermute(((lane - 32) & 63) << 2, __float_as_int(t1))); const float t2 = t1 + (g >= 2 ? u2 : 0.f);
            const float ex = t2 - s_;
#pragma unroll
            for (int q = 0; q < 4; ++q) { const int tt = 16 * rt + 4 * g + q; FA[tt * 64 + js] = p[q] + ex; FB[tt * 64 + js] = sigmoidf_(a0 + aa[ct][q]); }
            if (g == 3) TOT[rt * 64 + j] = t2; }
    }
    lds_barrier();
    {
        float r[8], k[8], pkk[8], pka[8], prk[8];
        unpack8(f.r, r); unpack8(f.k, k); unpack8(f.v, v8);
        { const LAS float* P = (const LAS float*)(lds + CS_PAR) + cq * 8; const f32x4 a0_ = *(const LAS f32x4*)P, a1_ = *(const LAS f32x4*)(P + 4), b0_ = *(const LAS f32x4*)(P + 64), b1_ = *(const LAS f32x4*)(P + 68), c0_ = *(const LAS f32x4*)(P + 128), c1_ = *(const LAS f32x4*)(P + 132);
#pragma unroll
          for (int q = 0; q < 4; ++q) { pkk[q] = a0_[q]; pkk[4 + q] = a1_[q]; pka[q] = b0_[q]; pka[4 + q] = b1_[q]; prk[q] = c0_[q]; prk[4 + q] = c1_[q]; } }
        float cw[8], cwp[8], ag[8];
        { const int tp = t > 0 ? t - 1 : 0, rtt = wave >> 1;
          const int ct_ = (cq ^ (((t >> 2) & 1) << 1)) * 8, cp_ = (cq ^ (((tp >> 2) & 1) << 1)) * 8;
          const f32x4 c0_ = *(const LAS f32x4*)(FA + t * 64 + ct_), c1_ = *(const LAS f32x4*)(FA + t * 64 + ct_ + 4), p0_ = *(const LAS f32x4*)(FA + tp * 64 + cp_), p1_ = *(const LAS f32x4*)(FA + tp * 64 + cp_ + 4);
          const f32x4 g0_ = *(const LAS f32x4*)(FB + t * 64 + ct_), g1_ = *(const LAS f32x4*)(FB + t * 64 + ct_ + 4);
          f32x4 o0_ = F4Z, o1_ = F4Z, l0_ = F4Z, l1_ = F4Z;
          for (int r_ = 0; r_ < rtt; ++r_) { l0_ = *(const LAS f32x4*)(TOT + r_ * 64 + cq * 8); l1_ = *(const LAS f32x4*)(TOT + r_ * 64 + cq * 8 + 4); o0_ = o0_ + l0_; o1_ = o1_ + l1_; }
          const bool first = (t & 15) == 0;
#pragma unroll
          for (int q = 0; q < 4; ++q) { cw[q] = c0_[q] + o0_[q]; cw[4 + q] = c1_[q] + o1_[q];
              cwp[q] = t > 0 ? p0_[q] + o0_[q] - (first ? l0_[q] : 0.f) : 0.f; cwp[4 + q] = t > 0 ? p1_[q] + o1_[q] - (first ? l1_[q] : 0.f) : 0.f; ag[q] = g0_[q]; ag[4 + q] = g1_[q]; } }
        float kk[8], ss = 0.f; rkb = 0.f;
#pragma unroll
        for (int q = 0; q < 8; ++q) { kk[q] = k[q] * pkk[q]; ss += kk[q] * kk[q]; }
        ss = sum8(ss);
        const float inv = 1.0f / fmaxf(sqrtf(ss), 1e-12f);
        float at[8], bt[8], kt[8], rt_[8];
#pragma unroll
        for (int q = 0; q < 8; ++q) { const float kn = kk[q] * inv, kp = k[q] * (1.0f + (ag[q] - 1.0f) * pka[q]);
            const float ein = __expf(-cw[q]);
            at[q] = -kn * __expf(cwp[q]); bt[q] = kn * ag[q] * ein; kt[q] = kp * ein;
            rt_[q] = r[q] * __expf(cw[q]); rkb += r[q] * kp * prk[q]; }
        rkb = sum8(rkb);
        *(LAS v4u*)(TILE(0) + t * TPB + cq * 16) = pack8f(at); *(LAS v4u*)(TILE(1) + t * TPB + cq * 16) = pack8f(bt); *(LAS v4u*)(TILE(2) + t * TPB + cq * 16) = pack8f(kt);
        *(LAS v4u*)(TILE(3) + t * TPB + cq * 16) = f.v;
        *(LAS v4u*)(TILE(6) + t * TPB + cq * 16) = pack8f(rt_);
        if (MODE == 1 && t == 63) {
#pragma unroll
            for (int q = 0; q < 8; ++q) ((LAS float*)(lds + CS_WL))[cq * 8 + q] = __expf(cw[q]); }
    }
    lds_barrier();
}

__device__ __forceinline__ void scan_s1(unsigned char* ws, LAS unsigned char* lds, int lane0, int wave) {
    const int rt = wave & 3, ch = wave >> 2;
    FrontIn fin; float w0v[2], a0v[2]; bf16x8s w2f[2][2], a2f[2][2];
    { int l0 = lane0; asm volatile("" : "+v"(l0)); const int hh = blockIdx.x & 15;
      if ((int)blockIdx.x < BATCH * NH * (SEQ / 64)) front_fetch(fin, ws, blockIdx.x, wave * 64 + l0, l0, wave);
      const bf16* W2T = (const bf16*)(ws + WS_WT_W2); const bf16* A2T = (const bf16*)(ws + WS_WT_A2);
#pragma unroll
      for (int ct = 0; ct < 2; ++ct) { w0v[ct] = INP(7)[hh * HD + 32 * ch + 16 * ct + (l0 & 15)]; a0v[ct] = INP(10)[hh * HD + 32 * ch + 16 * ct + (l0 & 15)];
#pragma unroll
          for (int ks = 0; ks < 2; ++ks) { const size_t wr_ = (size_t)(hh * HD + 32 * ch + 16 * ct + (l0 & 15)) * 64 + 32 * ks + 8 * (l0 >> 4); w2f[ks][ct] = *(const GAS bf16x8s*)(W2T + wr_); a2f[ks][ct] = *(const GAS bf16x8s*)(A2T + wr_); } }
      const int tid0 = wave * 64 + l0;
      if (tid0 < 64) { LAS float* P = (LAS float*)(lds + CS_PAR); P[tid0] = INP(15)[hh * HD + tid0]; P[64 + tid0] = INP(16)[hh * HD + tid0]; P[128 + tid0] = INP(17)[hh * HD + tid0]; }
      __syncthreads(); }
    for (int unit = blockIdx.x; unit < BATCH * NH * (SEQ / 64); unit += gridDim.x) {
        int lane = lane0; asm volatile("" : "+v"(lane));
        const int tid = wave * 64 + lane, fr = lane & 15, g = lane >> 4;
        const int h = unit & 15, c = (unit >> 4) & 127, b = unit >> 11; const size_t chunk = ((size_t)b * NH + h) * 128 + c;
        float v8[8]; float rkb;
        chunk_front<1>(fin, lds, w0v, a0v, w2f, a2f, tid, lane, wave, v8, rkb);
        { const size_t row0_ = (size_t)b * SEQ + c * 64; if ((tid & 7) == 0) ((float*)(ws + WS_HID))[(row0_ + (tid >> 3)) * NH + h] = rkb; }
        if (unit + (int)gridDim.x < BATCH * NH * (SEQ / 64)) front_fetch(fin, ws, unit + gridDim.x, tid, lane, wave);
        {
            f32x4 a2[2] = {F4Z, F4Z}, a3[2] = {F4Z, F4Z};
            mm64(a2, TILE(1), TILE(0), rt, ch, fr, g);
            mm64(a3, TILE(2), TILE(0), rt, ch, fr, g);
            f32x4 p1[2];
#pragma unroll
            for (int ct = 0; ct < 2; ++ct) { const int col = 32 * ch + 16 * ct + fr;
#pragma unroll
                for (int q = 0; q < 4; ++q) { const int row = 16 * rt + 4 * g + q;
                    a2[ct][q] = row < col ? a2[ct][q] : 0.f;
                    p1[ct][q] = a2[ct][q] + (row == col ? 1.0f : 0.f);
                    a3[ct][q] = row < col ? a3[ct][q] : 0.f; } }
            st_tr(TILE(5), a2, rt, ch, fr, g);
            st_tr(TILE(9), p1, rt, ch, fr, g);
            st_tr(TILE(4), a3, rt, ch, fr, g);
        }
        lds_barrier();
#pragma unroll
        for (int r = 0; r < 6; ++r) {
            LAS unsigned char* Sr = TILE(5 + 2 * (r & 1)); LAS unsigned char* Sr2 = TILE(5 + 2 * ((r & 1) ^ 1));
            if (r <= 4) { f32x4 q2[2] = {F4Z, F4Z};
                mm64_at(q2, Sr, Sr, rt, ch, fr, g, lane);
                st_tr(Sr2, q2, rt, ch, fr, g); }
            if (r >= 1) { LAS unsigned char* Pr = TILE(9 + ((r - 1) & 1)); LAS unsigned char* Pr2 = TILE(9 + (((r - 1) & 1) ^ 1));
                f32x4 pa[2]; ld_tr(pa, Pr, rt, ch, fr, g);
                mm64_at(pa, Sr, Pr, rt, ch, fr, g, lane);
                st_tr(Pr2, pa, rt, ch, fr, g); }
            if (r == 0) { f32x4 gg[2] = {F4Z, F4Z};
                mm64_bt(gg, TILE(4), TILE(3), rt, ch, fr, g, lane);
                st_tr(TILE(11), gg, rt, ch, fr, g); }
            lds_barrier();
        }
        {
            f32x4 acc[2] = {F4Z, F4Z}, ac2[2] = {F4Z, F4Z};
            mm64_bt(acc, TILE(10), TILE(0), rt, ch, fr, g, lane);
            mm64(ac2, TILE(10), TILE(11), rt, ch, fr, g);
            st_tr(TILE(5), acc, rt, ch, fr, g); st_tr(TILE(7), ac2, rt, ch, fr, g);
            f32x4 b2[2] = {F4Z, F4Z}, b3[2] = {F4Z, F4Z};
            mm64(b2, TILE(1), TILE(6), rt, ch, fr, g); mm64(b3, TILE(2), TILE(6), rt, ch, fr, g);
#pragma unroll
            for (int ct = 0; ct < 2; ++ct) { const int t = 32 * ch + 16 * ct + fr;
#pragma unroll
                for (int q = 0; q < 4; ++q) { const int s_ = 16 * rt + 4 * g + q; b2[ct][q] = s_ <= t ? b2[ct][q] : 0.f; b3[ct][q] = s_ <= t ? b3[ct][q] : 0.f; } }
            st_tr(TILE(4), b2, rt, ch, fr, g); st_tr(TILE(9), b3, rt, ch, fr, g);
        }
        lds_barrier();
        {
            const LAS float* WL = (const LAS float*)(lds + CS_WL);
            f32x4 acc[2] = {F4Z, F4Z};
            mm64_bt(acc, TILE(5), TILE(1), rt, ch, fr, g, lane);
            bf16* Mg = (bf16*)(ws + WS_B0) + chunk * 4096;
#pragma unroll
            for (int ct = 0; ct < 2; ++ct) { const int j1 = 32 * ch + 16 * ct + fr; const float wl = WL[j1];
#pragma unroll
                for (int q = 0; q < 4; ++q) { const int j2 = 16 * rt + 4 * g + q; acc[ct][q] = wl * (acc[ct][q] + (j2 == j1 ? 1.0f : 0.f)); }
                const int rtS = 2 * ch + ct, ksS = rt >> 1, half = rt & 1;
                *(GAS bf16x4s*)(Mg + (((rtS * 2 + ksS) * 64 + g * 16 + fr) * 8 + half * 4)) = pack4(acc[ct]); }
            f32x4 ad[2] = {F4Z, F4Z};
            mm64_at(ad, TILE(1), TILE(7), rt, ch, fr, g, lane);
            mm64_att(ad, TILE(2), TILE(3), rt, ch, lane);
            const f32x4 wl4 = *(const LAS f32x4*)(WL + 16 * rt + 4 * g);
            bf16* Dg = (bf16*)OUTP() + chunk * 4096;
#pragma unroll
            for (int ct = 0; ct < 2; ++ct) *(GAS bf16x4s*)(Dg + (((2 * ch + ct) * 4 + rt) * 64 + lane) * 4) = pack4(ad[ct] * wl4);
            const size_t row0_ = (size_t)b * SEQ + c * 64;
            f32x4 ar[2]; ld_tr(ar, TILE(6), rt, ch, fr, g);
            mm64(ar, TILE(5), TILE(4), rt, ch, fr, g);
            f32x4 ay[2] = {F4Z, F4Z};
            mm64(ay, TILE(7), TILE(4), rt, ch, fr, g); mm64_at(ay, TILE(3), TILE(9), rt, ch, fr, g, lane);
            bf16* Rg = (bf16*)(ws + WS_B1); bf16* Kg = (bf16*)(ws + WS_B2);
#pragma unroll
            for (int ct = 0; ct < 2; ++ct) { const size_t o_ = (row0_ + 32 * ch + 16 * ct + fr) * C + h * HD + 16 * rt + 4 * g; *(GAS bf16x4s*)(Rg + o_) = pack4(ar[ct]); *(GAS bf16x4s*)(Kg + o_) = pack4(ay[ct]); }
        }
        lds_barrier();
    }
}

constexpr int S2_PD = 6;
__device__ __forceinline__ void scan_s2(unsigned char* ws, LAS unsigned char* lds, int lane, int wave) {
    for (int bh = blockIdx.x; bh < BATCH * NH; bh += gridDim.x) {
        const unsigned char* Mg = (const unsigned char*)((const bf16*)(ws + WS_B0) + (size_t)bh * 128 * 4096); const unsigned char* Dg = (const unsigned char*)((const bf16*)OUTP() + (size_t)bh * 128 * 4096);
        bf16* Sg = (bf16*)OUTP() + (size_t)M * C + (size_t)bh * 128 * 4096;
        if (wave >= 4) {
            const int lw = wave - 4;
            const unsigned char* src = (lw < 2 ? Mg + lw * 4096 : Dg + (lw - 2) * 4096) + lane * 16;
            LAS unsigned char* dst = lds + lw * 4096 + lane * 16;
            v4u q[S2_PD][4];
#define S2_LOADQ(j, c) do { _Pragma("unroll") for (int i_ = 0; i_ < 4; ++i_) q[j][i_] = *(const GAS v4u*)(src + (size_t)(c) * 8192 + i_ * 1024); } while (0)
#define S2_STOREQ(j, slot) do { _Pragma("unroll") for (int i_ = 0; i_ < 4; ++i_) *(LAS v4u*)(dst + (slot) * 16384 + i_ * 1024) = q[j][i_]; } while (0)
#pragma unroll
            for (int j = 0; j < S2_PD; ++j) S2_LOADQ(j, j);
            S2_STOREQ(0, 0); S2_LOADQ(0, S2_PD);
            lds_barrier();
#pragma unroll 1
            for (int s0 = 0; s0 < 128; s0 += S2_PD) {
#pragma unroll
                for (int jj = 0; jj < S2_PD; ++jj) { const int step = s0 + jj;
                    if (step + 1 < 128) S2_STOREQ((jj + 1) % S2_PD, (step + 1) & 1);
                    if (step + 1 + S2_PD < 128) S2_LOADQ((jj + 1) % S2_PD, step + 1 + S2_PD);
                    lds_barrier(); }
            }
#undef S2_LOADQ
#undef S2_STOREQ
        } else {
            const int ct = wave;
            f32x4 acc[4];
#pragma unroll
            for (int r = 0; r < 4; ++r) acc[r] = F4Z;
            lds_barrier();
#pragma unroll 1
            for (int s0 = 0; s0 < 128; s0 += S2_PD) {
#pragma unroll
                for (int jj = 0; jj < S2_PD; ++jj) { const int step = s0 + jj;
                    if (step < 128) {
                        const LAS unsigned char* slot = lds + (step & 1) * 16384;
                        bf16x8s sf[2];
#pragma unroll
                        for (int ks = 0; ks < 2; ++ks) { const bf16x4s lo = pack4(acc[2 * ks]), hi = pack4(acc[2 * ks + 1]); sf[ks] = (bf16x8s){lo[0], lo[1], lo[2], lo[3], hi[0], hi[1], hi[2], hi[3]}; }
#pragma unroll
                        for (int ks = 0; ks < 2; ++ks) *(GAS bf16x8s*)(Sg + (size_t)step * 4096 + ((ct * 2 + ks) * 64 + lane) * 8) = sf[ks];
                        f32x4 na[4];
#pragma unroll
                        for (int r = 0; r < 4; ++r) na[r] = unpack4(*(const LAS bf16x4s*)(slot + 8192 + ((ct * 4 + r) * 64 + lane) * 8));
#pragma unroll
                        for (int ks = 0; ks < 2; ++ks)
#pragma unroll
                            for (int r = 0; r < 4; ++r) na[r] = MFMA16(*(const LAS bf16x8s*)(slot + ((r * 2 + ks) * 64 + lane) * 16), sf[ks], na[r]);
#pragma unroll
                        for (int r = 0; r < 4; ++r) acc[r] = na[r];
                    }
                    lds_barrier(); }
            }
        }
    }
}

constexpr int S3_RT = 32768, S3_YT = S3_RT + TILE_B, S3_LG = S3_YT + TILE_B, S3_LGP = 336;
struct S3In { v4u rr, yy, vv, lg[3]; bf16x8s sA[2]; float rkb; };
__device__ __forceinline__ void s3_fetch(S3In& f, unsigned char* ws, int unit, int tid, int lane, int wave) {
    const int h = unit & 15, c = (unit >> 4) & 127, b = unit >> 11; const size_t chunk = ((size_t)b * NH + h) * 128 + c, row0 = (size_t)b * SEQ + c * 64;
    const int rt = wave & 3, et = tid >> 3, ecq = tid & 7;
    const bf16* Rg = (const bf16*)(ws + WS_B1); const bf16* Kg = (const bf16*)(ws + WS_B2); const bf16* Vb = (const bf16*)(ws + WS_B3); const bf16* LG = (const bf16*)(ws + WS_LG);
    const bf16* Sg = (const bf16*)OUTP() + (size_t)M * C + chunk * 4096;
    const size_t o_ = (row0 + et) * C + h * HD + ecq * 8;
    f.rr = *(const GAS v4u*)(Rg + o_); f.yy = *(const GAS v4u*)(Kg + o_); f.vv = *(const GAS v4u*)(Vb + o_);
#pragma unroll
    for (int i = 0; i < 3; ++i) { const int chn = tid + 512 * i; if (chn < 64 * 20) f.lg[i] = *(const GAS v4u*)(LG + (row0 + chn / 20) * DG + (chn % 20) * 8); }
#pragma unroll
    for (int ks = 0; ks < 2; ++ks) f.sA[ks] = *(const GAS bf16x8s*)(Sg + ((rt * 2 + ks) * 64 + lane) * 8);
    f.rkb = ((const float*)(ws + WS_HID))[(row0 + et) * NH + h];
}
__device__ __forceinline__ void scan_s3(unsigned char* ws, LAS unsigned char* lds, int lane0, int wave) {
    const int rt = wave & 3, ch = wave >> 2;
    LAS float* Ys = (LAS float*)(lds + CS_FA);
    const bf16* G2T = (const bf16*)(ws + WS_WT_G2); bf16* YG = (bf16*)(ws + WS_B0);
    constexpr int NU = BATCH * NH * (SEQ / 64);
    S3In fin; bf16x8s gA[5]; f32x4 lnw0, lnw1, lnb0, lnb1;
    { int l0 = lane0; asm volatile("" : "+v"(l0)); const int hh = blockIdx.x & 15, t0_ = wave * 64 + l0;
      if ((int)blockIdx.x < NU) s3_fetch(fin, ws, blockIdx.x, t0_, l0, wave);
#pragma unroll
      for (int ks = 0; ks < 5; ++ks) gA[ks] = *(const GAS bf16x8s*)(G2T + (size_t)(hh * HD + 16 * rt + (l0 & 15)) * DG + 32 * ks + 8 * (l0 >> 4));
      const int ec0 = hh * HD + (t0_ & 7) * 8;
      lnw0 = *(const GAS f32x4*)(INP(18) + ec0); lnw1 = *(const GAS f32x4*)(INP(18) + ec0 + 4); lnb0 = *(const GAS f32x4*)(INP(19) + ec0); lnb1 = *(const GAS f32x4*)(INP(19) + ec0 + 4); }
    __syncthreads();
    for (int unit = blockIdx.x; unit < NU; unit += gridDim.x) {
        int lane = lane0; asm volatile("" : "+v"(lane));
        const int tid = wave * 64 + lane, fr = lane & 15, g = lane >> 4, et = tid >> 3, ecq = tid & 7;
        const int h = unit & 15, c = (unit >> 4) & 127, b = unit >> 11; const size_t row0 = (size_t)b * SEQ + c * 64;
        *(LAS v4u*)(lds + S3_RT + et * TPB + ecq * 16) = fin.rr; *(LAS v4u*)(lds + S3_YT + et * TPB + ecq * 16) = fin.yy;
#pragma unroll
        for (int i = 0; i < 3; ++i) { const int chn = tid + 512 * i; if (chn < 64 * 20) *(LAS v4u*)(lds + S3_LG + (chn / 20) * S3_LGP + (chn % 20) * 16) = fin.lg[i]; }
        float v8[8]; unpack8(fin.vv, v8); const float rkb = fin.rkb; const bf16x8s sA0 = fin.sA[0], sA1 = fin.sA[1];
        lds_barrier();
        if (unit + (int)gridDim.x < NU) s3_fetch(fin, ws, unit + gridDim.x, tid, lane, wave);
        f32x4 acc[2], ag[2] = {F4Z, F4Z};
#pragma unroll
        for (int ct = 0; ct < 2; ++ct) { const int t = 32 * ch + 16 * ct + fr;
            acc[ct] = unpack4(*(const LAS bf16x4s*)(lds + S3_YT + t * TPB + (16 * rt + 4 * g) * 2));
            acc[ct] = MFMA16(sA0, ldfrag_perm(lds + S3_RT, t, 0, g), acc[ct]); acc[ct] = MFMA16(sA1, ldfrag_perm(lds + S3_RT, t, 1, g), acc[ct]);
#pragma unroll
            for (int ks = 0; ks < 5; ++ks) ag[ct] = MFMA16(gA[ks], *(const LAS bf16x8s*)(lds + S3_LG + t * S3_LGP + (32 * ks + 8 * g) * 2), ag[ct]);
            *(LAS f32x4*)(Ys + t * FP + 16 * rt + 4 * g) = acc[ct]; }
        lds_barrier();
        {
            const f32x4 y0 = *(const LAS f32x4*)(Ys + et * FP + ecq * 8), y1 = *(const LAS f32x4*)(Ys + et * FP + ecq * 8 + 4);
            float y[8] = {y0[0], y0[1], y0[2], y0[3], y1[0], y1[1], y1[2], y1[3]};
            float s_ = 0.f;
#pragma unroll
            for (int q = 0; q < 8; ++q) s_ += y[q];
            s_ = sum8(s_);
            const float mu = s_ * (1.0f / HD); float vs = 0.f;
#pragma unroll
            for (int q = 0; q < 8; ++q) { y[q] -= mu; vs += y[q] * y[q]; }
            vs = sum8(vs);
            const float rstd = 1.0f / sqrtf(vs * (1.0f / HD) + GN_EPS);
            f32x4 o0, o1;
#pragma unroll
            for (int q = 0; q < 4; ++q) { o0[q] = y[q] * rstd * lnw0[q] + lnb0[q] + rkb * v8[q]; o1[q] = y[4 + q] * rstd * lnw1[q] + lnb1[q] + rkb * v8[4 + q]; }
            *(LAS f32x4*)(Ys + et * FP + ecq * 8) = o0; *(LAS f32x4*)(Ys + et * FP + ecq * 8 + 4) = o1;
        }
        lds_barrier();
#pragma unroll
        for (int ct = 0; ct < 2; ++ct) { const int t = 32 * ch + 16 * ct + fr; const f32x4 yv = *(const LAS f32x4*)(Ys + t * FP + 16 * rt + 4 * g);
            *(GAS bf16x4s*)(YG + (row0 + t) * C + h * HD + 16 * rt + 4 * g) = pack4(yv * ag[ct]); }
    }
    __syncthreads();
}
#undef TILE
#if MK_DEBUG
__device__ __forceinline__ void scan_naive(unsigned char* ws, LAS unsigned char* lds, int tid) {
    const int lane = tid & 63;
    const bf16* Rb = (const bf16*)(ws + WS_B1); const bf16* Kb = (const bf16*)(ws + WS_B2); const bf16* Vb = (const bf16*)(ws + WS_B3);
    const bf16* LW = (const bf16*)(ws + WS_LW); const bf16* LA = (const bf16*)(ws + WS_LA);
    float* Y = OUTP(); float* RK = (float*)(ws + WS_HID);
    LAS float* sR = (LAS float*)lds; LAS float* sK = sR + 4096; LAS float* sV = sK + 4096; LAS float* sA = sV + 4096; LAS float* sB = sA + 4096; LAS float* sD = sB + 4096;
    LAS float* sW2 = sD + 4096; LAS float* sA2 = sW2 + 4096;
    for (int unit = blockIdx.x; unit < BATCH * NH; unit += gridDim.x) {
        const int b = unit / NH, h = unit % NH;
        __syncthreads();
        for (int e = tid; e < 4096; e += 512) { const int d = e >> 6, j = e & 63; sW2[e] = INP(9)[(size_t)d * C + h * HD + j]; sA2[e] = INP(12)[(size_t)d * C + h * HD + j]; }
        __syncthreads();
        const int pt = tid >> 3, cq = tid & 7, c0 = h * HD + cq * 8;
        const int si = tid >> 3, jq = tid & 7;
        float S[8];
#pragma unroll
        for (int q = 0; q < 8; ++q) S[q] = 0.f;
        float w0v[8], a0v[8], kkv[8], kav[8], rkv[8];
#pragma unroll
        for (int q = 0; q < 8; ++q) { w0v[q] = INP(7)[c0 + q]; a0v[q] = INP(10)[c0 + q]; kkv[q] = INP(15)[c0 + q]; kav[q] = INP(16)[c0 + q]; rkv[q] = INP(17)[c0 + q]; }
        for (int blk = 0; blk < SEQ / 64; ++blk) {
            const size_t row = (size_t)b * SEQ + blk * 64 + pt;
            {
                const v4u r4 = *(const GAS v4u*)(Rb + row * C + c0), k4 = *(const GAS v4u*)(Kb + row * C + c0), v4 = *(const GAS v4u*)(Vb + row * C + c0);
                float r[8], k[8], v[8];
                r[0] = bflo(r4.x); r[1] = bfhi(r4.x); r[2] = bflo(r4.y); r[3] = bfhi(r4.y); r[4] = bflo(r4.z); r[5] = bfhi(r4.z); r[6] = bflo(r4.w); r[7] = bfhi(r4.w);
                k[0] = bflo(k4.x); k[1] = bfhi(k4.x); k[2] = bflo(k4.y); k[3] = bfhi(k4.y); k[4] = bflo(k4.z); k[5] = bfhi(k4.z); k[6] = bflo(k4.w); k[7] = bfhi(k4.w);
                v[0] = bflo(v4.x); v[1] = bfhi(v4.x); v[2] = bflo(v4.y); v[3] = bfhi(v4.y); v[4] = bflo(v4.z); v[5] = bfhi(v4.z); v[6] = bflo(v4.w); v[7] = bfhi(v4.w);
                float wp[8], ap[8];
#pragma unroll
                for (int q = 0; q < 8; ++q) { wp[q] = w0v[q]; ap[q] = a0v[q]; }
                for (int d = 0; d < 64; ++d) { const float lw = bf2f(LW[row * DW + d]), la = bf2f(LA[row * DA + d]);
#pragma unroll
                    for (int q = 0; q < 8; ++q) { wp[q] += lw * sW2[d * 64 + cq * 8 + q]; ap[q] += la * sA2[d * 64 + cq * 8 + q]; } }
                float kk[8], ss = 0.f, rks = 0.f;
#pragma unroll
                for (int q = 0; q < 8; ++q) { kk[q] = k[q] * kkv[q]; ss += kk[q] * kk[q]; }
                ss = sum8(ss);
                const float inv = 1.0f / fmaxf(sqrtf(ss), 1e-12f);
#pragma unroll
                for (int q = 0; q < 8; ++q) { const float ag = sigmoidf_(ap[q]); const float kn = kk[q] * inv; const float kp = k[q] * (1.0f + (ag - 1.0f) * kav[q]);
                    const float lw = -0.6065306597126334f * sigmoidf_(wp[q]);
                    const int o = pt * 64 + cq * 8 + q;
                    sR[o] = r[q]; sK[o] = kp; sV[o] = v[q]; sA[o] = -kn; sB[o] = kn * ag; sD[o] = __expf(lw); rks += r[q] * kp * rkv[q]; }
                rks = sum8(rks);
                if (cq == 0) RK[row * NH + h] = rks;
            }
            __syncthreads();
            for (int t = 0; t < 64; ++t) {
                const LAS f32x4* pa = (const LAS f32x4*)(sA + t * 64 + jq * 8); const LAS f32x4* pb = (const LAS f32x4*)(sB + t * 64 + jq * 8);
                const LAS f32x4* pd = (const LAS f32x4*)(sD + t * 64 + jq * 8); const LAS f32x4* pk = (const LAS f32x4*)(sK + t * 64 + jq * 8);
                const LAS f32x4* pr = (const LAS f32x4*)(sR + t * 64 + jq * 8);
                const f32x4 a0 = pa[0], a1 = pa[1], b0 = pb[0], b1 = pb[1], d0 = pd[0], d1 = pd[1], k0 = pk[0], k1 = pk[1], r0 = pr[0], r1 = pr[1];
                const float vi = sV[t * 64 + si];
                float sa = 0.f;
#pragma unroll
                for (int q = 0; q < 4; ++q) { sa += S[q] * a0[q]; sa += S[4 + q] * a1[q]; }
                sa = sum8(sa);
                float y = 0.f;
#pragma unroll
                for (int q = 0; q < 4; ++q) { S[q] = S[q] * d0[q] + sa * b0[q] + vi * k0[q]; S[4 + q] = S[4 + q] * d1[q] + sa * b1[q] + vi * k1[q]; y += S[q] * r0[q]; y += S[4 + q] * r1[q]; }
                y = sum8(y);
                if (jq == 0) Y[((size_t)b * SEQ + blk * 64 + t) * C + h * HD + si] = y;
            }
            __syncthreads();
        }
    }
}
__device__ __forceinline__ void post_scan(unsigned char* ws, int gw, int NGW, int lane) {
    const float* Y = OUTP(); const float* RK = (const float*)(ws + WS_HID); const bf16* Vb = (const bf16*)(ws + WS_B3); const bf16* LG = (const bf16*)(ws + WS_LG);
    bf16* YG = (bf16*)(ws + WS_B4); const float* g2 = INP(14); const float* lnw = INP(18); const float* lnb = INP(19);
    for (int it = gw; it < M * NH; it += NGW) {
        const int row = it / NH, h = it % NH, c = h * HD + lane;
        const float y = Y[(size_t)row * C + c];
        const float mu = wave_sum(y, lane) * (1.0f / HD); const float d = y - mu; const float var = wave_sum(d * d, lane) * (1.0f / HD);
        float o = d * (1.0f / sqrtf(var + GN_EPS)) * lnw[c] + lnb[c];
        o += RK[(size_t)row * NH + h] * bf2f(Vb[(size_t)row * C + c]);
        float g = 0.f;
        for (int dd = 0; dd < DG; ++dd) g += bf2f(LG[(size_t)row * DG + dd]) * g2[(size_t)dd * C + c];
        YG[(size_t)row * C + c] = (bf16)f2bf(o * g);
    }
}


constexpr int CW_DBG = 3200;
__device__ __forceinline__ void dbg_nonfinite(unsigned char* ws, const bf16* X, size_t n, int slot, int gw, int NGW, int lane, float thr = 1e30f) {
    unsigned* cw = (unsigned*)(ws + WS_CTL) + CW_DBG + 64 * slot; unsigned nnan = 0;
    for (size_t i = (size_t)gw * 64 + lane; i < n; i += (size_t)NGW * 64) { const float x = bf2f(X[i]); if (!(fabsf(x) < thr)) ++nnan; }
    if (nnan) atomicAdd(cw, nnan);
}
__device__ __forceinline__ void dbg_compare(unsigned char* ws, const bf16* X, const bf16* Y, int gw, int NGW, int lane) {
    unsigned* cw = (unsigned*)(ws + WS_CTL) + CW_DBG; unsigned nbad = 0, nnan = 0;
    for (size_t i = (size_t)gw * 64 + lane; i < (size_t)M * C; i += (size_t)NGW * 64) { const float x = bf2f(X[i]), y = bf2f(Y[i]);
        if (!(fabsf(x) < 1e30f)) ++nnan; else if (fabsf(x - y) > 0.05f * (fabsf(y) + 0.05f)) ++nbad; }
    if (nnan) atomicAdd(cw, nnan); if (nbad) atomicAdd(cw + 64, nbad);
}
#endif
__device__ __forceinline__ void router_rows(unsigned char* ws, LAS unsigned char* lds, int layer, int gw, int NGW, int lane, int tid, int wv, bool dry = false) {
    const bf16* Hh = (const bf16*)(ws + WS_B4); const float* gain = INP(2) + layer * C; float* rsl = (float*)(ws + WS_B0);
    const float* wg = INP(24) + (size_t)layer * C * 4; const float* bg = INP(25) + layer * 4; const float* wi = INP(26) + (size_t)layer * C * 16; const float* bi = INP(27) + layer * 16;
    unsigned* cnt = (unsigned*)(ws + WS_CTL) + CW_CNT + layer * 16 * 64; unsigned* list = (unsigned*)(ws + WS_LIST); float* wl = (float*)(ws + WS_WL);
    LAS float* sWg = (LAS float*)lds; LAS float* sWi = sWg + C * 4;
    constexpr int RECMAX = 256;
    LAS unsigned* lcnt = (LAS unsigned*)(lds + 81920); LAS unsigned* gbase = lcnt + 16; LAS float* sBias = (LAS float*)(lcnt + 32);
    LAS unsigned* recRow = lcnt + 64; LAS unsigned* recE = recRow + RECMAX; LAS unsigned* recL = recE + RECMAX; LAS float* recW0 = (LAS float*)(recL + RECMAX); LAS float* recW1 = recW0 + RECMAX; LAS float* recRS = recW1 + RECMAX;
    __syncthreads();
    for (int e = tid; e < C; e += 512) { const int r = e >> 6, c = 256 * (r >> 2) + 4 * (e & 63) + (r & 3); ((LAS f32x4*)sWg)[e] = ((const GAS f32x4*)wg)[c]; }
    for (int e = tid; e < C * 4; e += 512) { const int r = e >> 6, jq = r >> 2, c = 256 * (jq >> 2) + 4 * (e & 63) + (jq & 3); ((LAS f32x4*)sWi)[e] = ((const GAS f32x4*)wi)[c * 4 + (r & 3)]; }
    if (tid < 4) sBias[tid] = bg[tid]; else if (tid < 20) sBias[tid] = bi[tid - 4];
    for (int e = tid; e < RECMAX; e += 512) recE[e] = 0xffffffffu;
    __syncthreads();
    f32x4 g[4]; load_row(gain, lane, g);
    v2u nxr[2][4];
#pragma unroll
    for (int r = 0; r < 2; ++r) { const int r0 = gw + r * NGW < M - 1 ? gw + r * NGW : M - 1;
#pragma unroll
        for (int j = 0; j < 4; ++j) nxr[r][j] = ((const GAS v2u*)(Hh + (size_t)r0 * C))[64 * j + lane]; }
    int k = 0;
    for (int row = gw; row < M; row += 2 * NGW, k += 2) {
        f32x4 v[2][4];
#pragma unroll
        for (int r = 0; r < 2; ++r)
#pragma unroll
            for (int j = 0; j < 4; ++j) v[r][j] = (f32x4){bflo(nxr[r][j].x), bfhi(nxr[r][j].x), bflo(nxr[r][j].y), bfhi(nxr[r][j].y)};
#pragma unroll
        for (int r = 0; r < 2; ++r) { const int rn = row + (2 + r) * NGW, r0 = rn < M - 1 ? rn : M - 1;
#pragma unroll
            for (int j = 0; j < 4; ++j) nxr[r][j] = ((const GAS v2u*)(Hh + (size_t)r0 * C))[64 * j + lane]; }
        float rs[2];
#pragma unroll
        for (int r = 0; r < 2; ++r) { rs[r] = row_rs(v[r], lane);
#pragma unroll
            for (int j = 0; j < 4; ++j) v[r][j] = v[r][j] * rs[r] * g[j]; }
        float gl[2][4] = {{0.f, 0.f, 0.f, 0.f}, {0.f, 0.f, 0.f, 0.f}};
        const LAS unsigned char* pWg = (const LAS unsigned char*)sWg + lane * 16;
#pragma unroll
        for (int j = 0; j < 4; ++j)
#pragma unroll
            for (int q = 0; q < 4; ++q) { const f32x4 w = *(const LAS f32x4*)(pWg + (j * 4 + q) * 1024);
#pragma unroll
                for (int r = 0; r < 2; ++r) { const float xv = v[r][j][q]; gl[r][0] += xv * w.x; gl[r][1] += xv * w.y; gl[r][2] += xv * w.z; gl[r][3] += xv * w.w; } }
        int gi[2]; float gval[2];
#pragma unroll
        for (int r = 0; r < 2; ++r) {
#pragma unroll
            for (int q = 0; q < 4; ++q) gl[r][q] = wave_sum(gl[r][q], lane) + sBias[q];
            gi[r] = 0; float gm = gl[r][0];
#pragma unroll
            for (int q = 1; q < 4; ++q) if (gl[r][q] > gm) { gm = gl[r][q]; gi[r] = q; }
            float gden = 0.f;
#pragma unroll
            for (int q = 0; q < 4; ++q) gden += __expf(gl[r][q] - gm);
            gval[r] = 1.0f / gden; }
        float il[2][4] = {{0.f, 0.f, 0.f, 0.f}, {0.f, 0.f, 0.f, 0.f}};
        const LAS unsigned char* pWi0 = (const LAS unsigned char*)sWi + lane * 16 + gi[0] * 1024;
        const LAS unsigned char* pWi1 = (const LAS unsigned char*)sWi + lane * 16 + gi[1] * 1024;
#pragma unroll
        for (int j = 0; j < 4; ++j)
#pragma unroll
            for (int q = 0; q < 4; ++q) {
                { const f32x4 w = *(const LAS f32x4*)(pWi0 + (j * 4 + q) * 4096); const float xv = v[0][j][q]; il[0][0] += xv * w.x; il[0][1] += xv * w.y; il[0][2] += xv * w.z; il[0][3] += xv * w.w; }
                { const f32x4 w = *(const LAS f32x4*)(pWi1 + (j * 4 + q) * 4096); const float xv = v[1][j][q]; il[1][0] += xv * w.x; il[1][1] += xv * w.y; il[1][2] += xv * w.z; il[1][3] += xv * w.w; } }
#pragma unroll
        for (int r = 0; r < 2; ++r) {
            const f32x4 bi4 = *(const LAS f32x4*)(sBias + 4 + gi[r] * 4);
#pragma unroll
            for (int q = 0; q < 4; ++q) il[r][q] = wave_sum(il[r][q], lane) + bi4[q];
            int i0 = 0; float m0 = il[r][0];
#pragma unroll
            for (int q = 1; q < 4; ++q) if (il[r][q] > m0) { m0 = il[r][q]; i0 = q; }
            int i1 = -1; float m1 = -INFINITY;
#pragma unroll
            for (int q = 0; q < 4; ++q) if (q != i0 && il[r][q] > m1) { m1 = il[r][q]; i1 = q; }
            const float e1 = __expf(m1 - m0); const float w0 = gval[r] / (1.0f + e1), w1 = gval[r] * e1 / (1.0f + e1);
            const int ri = wv * 32 + k + r;
            if (lane == 0 && !dry && k + r < 32 && row + r * NGW < M) { const int ex0 = gi[r] * 4 + i0, ex1 = gi[r] * 4 + i1;
                recRow[ri] = (unsigned)(row + r * NGW); recE[ri] = (unsigned)ex0 | ((unsigned)ex1 << 8); recW0[ri] = w0; recW1[ri] = w1; recRS[ri] = rs[r]; }
        }
    }
    __syncthreads();
    unsigned e = 0xffffffffu; if (tid < RECMAX) e = recE[tid];
    const unsigned ex0 = e & 255u, ex1 = (e >> 8) & 255u;
    unsigned pos0 = 0u, pos1 = 0u;
    if (wv < RECMAX / 64) {
#pragma unroll
        for (unsigned x = 0; x < 16; ++x) { const unsigned long long m0 = __ballot(ex0 == x), m1 = __ballot(ex1 == x);
            const unsigned p = __builtin_amdgcn_mbcnt_hi((unsigned)(m0 >> 32), __builtin_amdgcn_mbcnt_lo((unsigned)m0, 0u)) + __builtin_amdgcn_mbcnt_hi((unsigned)(m1 >> 32), __builtin_amdgcn_mbcnt_lo((unsigned)m1, 0u));
            if (ex0 == x) pos0 = p; if (ex1 == x) pos1 = p;
            if (lane == 0) recL[wv * 16 + x] = (unsigned)(__popcll(m0) + __popcll(m1)); } }
    __syncthreads();
    if (tid < 16 && !dry) { unsigned c_ = 0u;
#pragma unroll
        for (int q = 0; q < RECMAX / 64; ++q) c_ += recL[q * 16 + tid];
        gbase[tid] = atomicAdd(cnt + tid * 64, c_); }
    __syncthreads();
    if (e != 0xffffffffu && !dry) { unsigned p0 = gbase[ex0] + pos0, p1 = gbase[ex1] + pos1;
        for (int q = 0; q < wv; ++q) { p0 += recL[q * 16 + ex0]; p1 += recL[q * 16 + ex1]; }
        const unsigned row = recRow[tid]; const float rs = recRS[tid];
        list[(size_t)ex0 * M + p0] = row * 2u; wl[(size_t)ex0 * M + p0] = recW0[tid]; list[(size_t)ex1 * M + p1] = row * 2u + 1u; wl[(size_t)ex1 * M + p1] = recW1[tid];
        rsl[(size_t)ex0 * M + p0] = rs; rsl[(size_t)ex1 * M + p1] = rs; }
}
__device__ __forceinline__ void moe_table(unsigned char* ws, volatile LAS int* tab, int layer, int tid) {
    __syncthreads();
    if (tid == 0) { const unsigned* cnt = (const unsigned*)(ws + WS_CTL) + CW_CNT + layer * 16 * 64; int t = 0;
#pragma unroll 1
        for (int e = 0; e < 16; ++e) { const int c = (int)__hip_atomic_load(cnt, RLX_AGENT); cnt += 64; tab[e] = c; tab[16 + e] = t; t += (c + 255) >> 8; tab[32 + e] = t; }
        tab[48] = t; }
    __syncthreads();
}
__device__ __forceinline__ void combine_rows(unsigned char* ws, int mode, int gw, int NGW, int lane, bool dry = false) {
    bf16* Hh = (bf16*)(ws + WS_B4); float* Out = OUTP(); const bf16* E0 = (const bf16*)(ws + WS_B2); const bf16* E1 = (const bf16*)(ws + WS_B3); bf16* XN2 = (bf16*)(ws + WS_B0);
    f32x4 g[4]; load_row(INP(4), lane, g);
    for (int row = gw; row < M; row += NGW) {
        f32x4 v[4]; load_row_bf(Hh + (size_t)row * C, lane, v);
#pragma unroll
        for (int j = 0; j < 4; ++j) { const v2u e0 = ((const GAS v2u*)(E0 + (size_t)row * C))[64 * j + lane], e1 = ((const GAS v2u*)(E1 + (size_t)row * C))[64 * j + lane];
            v[j].x += bflo(e0.x) + bflo(e1.x); v[j].y += bfhi(e0.x) + bfhi(e1.x); v[j].z += bflo(e0.y) + bflo(e1.y); v[j].w += bfhi(e0.y) + bfhi(e1.y); }
        const float rs = row_rs(v, lane);
        if (mode == 0) {
            if (!dry) store_row_bf16(Hh + (size_t)row * C, lane, v);
            if (lane == 0) ((float*)XN2)[row] = rs;
        } else {
            float sig = 1.0f;
#if MK_DEBUG
            const unsigned* cw = (const unsigned*)(ws + WS_CTL) + CW_DBG; const unsigned nnan = __hip_atomic_load(cw, RLX_AGENT), nbad = __hip_atomic_load(cw + 64, RLX_AGENT);
            if (row < 512 && nnan > 0) sig = 2.0f;
            if (row >= 512 && row < 1536 && __hip_atomic_load(cw + 128, RLX_AGENT) > 0) sig = 2.0f;
            if (row >= 1536 && row < 3584 && __hip_atomic_load(cw + 192, RLX_AGENT) > 0) sig = 2.0f;
            if (row >= 3584 && row < 7680 && __hip_atomic_load(cw + 256, RLX_AGENT) > 0) sig = 2.0f;
            if (row >= 7680 && row < 15872 && __hip_atomic_load(cw + 320, RLX_AGENT) > 0) sig = 2.0f;
            if (row >= 15872 && nbad > (unsigned)(M / 100) * C) sig = 1.5f;
#endif
#pragma unroll
            for (int j = 0; j < 4; ++j) ((GAS f32x4*)(Out + (size_t)row * C))[64 * j + lane] = v[j] * rs * g[j] * sig;
        }
    }
}
__device__ __forceinline__ void attn_naive(unsigned char* ws, int gw, int NGW, int lane) {
    const bf16* Kb = (const bf16*)(ws + WS_B1); const bf16* Vb = (const bf16*)(ws + WS_B2); const bf16* Qb = (const bf16*)(ws + WS_B3); bf16* Ob = (bf16*)(ws + WS_B0);
    for (int unit = gw; unit < BATCH * NH * (SEQ / 64); unit += NGW) {
        const int qb = unit % (SEQ / 64), bh = unit / (SEQ / 64), b = bh / NH, h = bh % NH;
        const int t0 = qb * 64, t = t0 + lane; const size_t rowq = (size_t)b * SEQ + t;
        float q[64], o[64];
#pragma unroll
        for (int c = 0; c < 8; ++c) { const v4u w = *(const GAS v4u*)(Qb + rowq * C + h * HD + c * 8);
            q[c * 8 + 0] = bflo(w.x) * 0.125f; q[c * 8 + 1] = bfhi(w.x) * 0.125f; q[c * 8 + 2] = bflo(w.y) * 0.125f; q[c * 8 + 3] = bfhi(w.y) * 0.125f;
            q[c * 8 + 4] = bflo(w.z) * 0.125f; q[c * 8 + 5] = bfhi(w.z) * 0.125f; q[c * 8 + 6] = bflo(w.w) * 0.125f; q[c * 8 + 7] = bfhi(w.w) * 0.125f; }
#pragma unroll
        for (int c = 0; c < 64; ++c) o[c] = 0.f;
        float suffix = 0.f;
        for (int s = t0 + 62; s >= 0; --s) {
            const bool valid = s < t;
            if (s < t0 && __all(suffix > SB_EXIT)) break;
            const bf16* kp = Kb + ((size_t)b * SEQ + s) * C + h * HD; const bf16* vp = Vb + ((size_t)b * SEQ + s) * C + h * HD;
            float z = 0.f;
#pragma unroll
            for (int c = 0; c < 8; ++c) { const v4u w = *(const GAS v4u*)(kp + c * 8);
                z += q[c * 8 + 0] * bflo(w.x) + q[c * 8 + 1] * bfhi(w.x) + q[c * 8 + 2] * bflo(w.y) + q[c * 8 + 3] * bfhi(w.y) + q[c * 8 + 4] * bflo(w.z) + q[c * 8 + 5] * bfhi(w.z) + q[c * 8 + 6] * bflo(w.w) + q[c * 8 + 7] * bfhi(w.w); }
            const float sp = fmaxf(z, 0.f) + log1pf(__expf(-fabsf(z)));
            const float att = valid ? __expf(z - sp - suffix) : 0.f;
            suffix += valid ? sp : 0.f;
#pragma unroll
            for (int c = 0; c < 8; ++c) { const v4u w = *(const GAS v4u*)(vp + c * 8);
                o[c * 8 + 0] += att * bflo(w.x); o[c * 8 + 1] += att * bfhi(w.x); o[c * 8 + 2] += att * bflo(w.y); o[c * 8 + 3] += att * bfhi(w.y);
                o[c * 8 + 4] += att * bflo(w.z); o[c * 8 + 5] += att * bfhi(w.z); o[c * 8 + 6] += att * bflo(w.w); o[c * 8 + 7] += att * bfhi(w.w); }
        }
#pragma unroll
        for (int c = 0; c < 8; ++c) { v4u w; w.x = pk2(o[c * 8 + 0], o[c * 8 + 1]); w.y = pk2(o[c * 8 + 2], o[c * 8 + 3]); w.z = pk2(o[c * 8 + 4], o[c * 8 + 5]); w.w = pk2(o[c * 8 + 6], o[c * 8 + 7]);
            *(GAS v4u*)(Ob + rowq * C + h * HD + c * 8) = w; }
    }
}


typedef float f32x16 __attribute__((ext_vector_type(16)));
constexpr int AT_VP = 192;
constexpr int AT_WAVE_LDS = 32 * AT_VP;
__device__ __forceinline__ int crow32(int reg, int hh) { return (reg & 3) + 8 * (reg >> 2) + 4 * hh; }
__device__ __forceinline__ bf16x8s pack_step(const f32x16& x, const int s) {
    v4u p; p.x = pg8::cvt_pk_bf16(x[8 * s], x[8 * s + 1]); p.y = pg8::cvt_pk_bf16(x[8 * s + 2], x[8 * s + 3]); p.z = pg8::cvt_pk_bf16(x[8 * s + 4], x[8 * s + 5]); p.w = pg8::cvt_pk_bf16(x[8 * s + 6], x[8 * s + 7]);
    return __builtin_bit_cast(bf16x8s, p);
}
__device__ __forceinline__ void attn_mfma(unsigned char* ws, LAS unsigned char* lds, int gw, int NGW, int lane, int wave) {
    const bf16* Kb = (const bf16*)(ws + WS_B1); const bf16* Vb = (const bf16*)(ws + WS_B2); const bf16* Qb = (const bf16*)(ws + WS_B3); bf16* Ob = (bf16*)(ws + WS_B0);
    LAS unsigned char* vl = lds + wave * AT_WAVE_LDS;
    const int r32 = lane & 31, hh = lane >> 5;
    bf16x8s tri[2];
#pragma unroll
    for (int s = 0; s < 2; ++s)
#pragma unroll
        for (int j = 0; j < 8; ++j) tri[s][j] = (16 * s + 8 * (j >> 2) + 4 * hh + (j & 3)) > r32 ? (short)0x3F80 : (short)0;
    const int grp = lane >> 4, tq = (lane & 15) >> 2, tp = lane & 3;
    const LAS unsigned char* vtr0 = vl + (4 * hh + tq) * AT_VP + (16 * (grp & 1) + 4 * tp) * 2;
    for (int unit = gw; unit < BATCH * NH * (SEQ / 32); unit += NGW) {
        const int qb = unit % (SEQ / 32), bh = unit / (SEQ / 32), b = bh / NH, hd = bh % NH;
        const int t0 = qb * 32; const size_t rowb = (size_t)b * SEQ;
        bf16x8s qf[4];
#pragma unroll
        for (int ks = 0; ks < 4; ++ks) qf[ks] = *(const GAS bf16x8s*)(Qb + (rowb + t0 + r32) * C + hd * HD + 16 * ks + 8 * hh);
        f32x16 o[2];
#pragma unroll
        for (int i = 0; i < 16; ++i) { o[0][i] = 0.f; o[1][i] = 0.f; }
        float carry = 0.f;
        for (int s0 = t0; s0 >= 0; s0 -= 32) {
            bf16x8s kf[4];
#pragma unroll
            for (int ks = 0; ks < 4; ++ks) kf[ks] = *(const GAS bf16x8s*)(Kb + (rowb + s0 + r32) * C + hd * HD + 16 * ks + 8 * hh);
            v4u vreg[4];
#pragma unroll
            for (int i = 0; i < 4; ++i) { const int cidx = lane + 64 * i; vreg[i] = *(const GAS v4u*)(Vb + (rowb + s0 + (cidx >> 3)) * C + hd * HD + (cidx & 7) * 8); }
            f32x16 st;
#pragma unroll
            for (int i = 0; i < 16; ++i) st[i] = 0.f;
#pragma unroll
            for (int ks = 0; ks < 4; ++ks) st = __builtin_amdgcn_mfma_f32_32x32x16_bf16(kf[ks], qf[ks], st, 0, 0, 0);
#pragma unroll
            for (int i = 0; i < 4; ++i) { const int cidx = lane + 64 * i; *(LAS v4u*)(vl + (cidx >> 3) * AT_VP + (cidx & 7) * 16) = vreg[i]; }
            f32x16 zz, uu; float tot = 0.f; const int tq_ = t0 + r32;
            if (s0 + 31 < t0) {
#pragma unroll
                for (int i = 0; i < 16; ++i) { const float z = st[i] * 0.18033688011112042f; const float sp = fmaxf(z, 0.f) + __builtin_amdgcn_logf(1.0f + __builtin_amdgcn_exp2f(-fabsf(z)));
                    zz[i] = z - sp; uu[i] = sp; tot += sp; }
            } else {
#pragma unroll
                for (int i = 0; i < 16; ++i) { const int key = s0 + crow32(i, hh); const float z = st[i] * 0.18033688011112042f; const float sp = fmaxf(z, 0.f) + __builtin_amdgcn_logf(1.0f + __builtin_amdgcn_exp2f(-fabsf(z)));
                    const bool valid = key < tq_; zz[i] = valid ? z - sp : -1e30f; uu[i] = valid ? sp : 0.f; tot += uu[i]; }
            }
            f32x16 w;
#pragma unroll
            for (int i = 0; i < 16; ++i) w[i] = 0.f;
#pragma unroll
            for (int s = 0; s < 2; ++s) w = __builtin_amdgcn_mfma_f32_32x32x16_bf16(tri[s], pack_step(uu, s), w, 0, 0, 0);
            f32x16 pp;
#pragma unroll
            for (int i = 0; i < 16; ++i) pp[i] = __builtin_amdgcn_exp2f(zz[i] - w[i] - carry);
            tot += shx(tot, 32, lane); carry += tot;
            asm volatile("s_waitcnt lgkmcnt(0)" ::: "memory");
#pragma unroll
            for (int s = 0; s < 2; ++s) { const bf16x8s pa = pack_step(pp, s);
#pragma unroll
                for (int dt = 0; dt < 2; ++dt) {
                    const v4i16_t lo = __builtin_amdgcn_ds_read_tr16_b64_v4i16((LAS v4i16_t*)(vtr0 + (16 * s) * AT_VP + dt * 64));
                    const v4i16_t hi = __builtin_amdgcn_ds_read_tr16_b64_v4i16((LAS v4i16_t*)(vtr0 + (16 * s + 8) * AT_VP + dt * 64));
                    const bf16x8s vf = (bf16x8s){lo[0], lo[1], lo[2], lo[3], hi[0], hi[1], hi[2], hi[3]};
                    o[dt] = __builtin_amdgcn_mfma_f32_32x32x16_bf16(pa, vf, o[dt], 0, 0, 0); } }
            asm volatile("" ::: "memory");
            if (s0 < t0 && __all(carry > SB_EXIT * 1.4426950408889634f)) break;
        }
#pragma unroll
        for (int dt = 0; dt < 2; ++dt)
#pragma unroll
            for (int i = 0; i < 16; ++i) Ob[(rowb + t0 + crow32(i, hh)) * C + hd * HD + 32 * dt + r32] = (bf16)f2bf(o[dt][i]);
    }
}
__global__ void __launch_bounds__(NWAVES * 64, 2) yoco_fwd(Args args) {
    extern __shared__ __attribute__((aligned(16))) unsigned char lds_raw[];
    LAS unsigned char* lds = (LAS unsigned char*)lds_raw;
    const int G = gridDim.x; const int bx = blockIdx.x;
    int wave = __builtin_amdgcn_readfirstlane(threadIdx.x >> 6); asm volatile("" : "+s"(wave));
#define IDS() int lane; asm volatile("v_mbcnt_lo_u32_b32 %0, -1, 0\n\tv_mbcnt_hi_u32_b32 %0, -1, %0" : "=v"(lane)); const int tid = wave * 64 + lane; (void)tid; \
    const int vcu = (G % 8 == 0) ? (bx % 8) * (G / 8) + bx / 8 : bx; const int gw = vcu * NWAVES + wave, NGW = G * NWAVES; (void)lane; (void)gw; (void)NGW;
    unsigned char* ws = WSP();
    volatile LAS unsigned* MISC = (volatile LAS unsigned*)(lds + MISC_OFF);
    volatile LAS int* tab = (volatile LAS int*)(lds + MOE_TAB_OFF);
    for (int u = threadIdx.x; u < (LDS_BYTES - LDSCTL_OFF) / 4; u += NWAVES * 64) ((LAS unsigned*)(lds + LDSCTL_OFF))[u] = 0u;
    __syncthreads();
    XcdBarrier bar; bar.bar = (unsigned*)(ws + WS_CTL) + CW_BAR; bar.x = 0; bar.st = nullptr;
    if (N_LAUNCHES == 1) bar = xcd_barrier_post((unsigned*)(ws + WS_CTL) + CW_BAR, MISC + 8);
    const int lo = KA_INT(0), hi = KA_INT(1);
#ifndef PROBE_PH
#define PROBE_PH -1
#endif
#define IN(k) (lo <= (k) && (k) < hi)
#define REP(k) for (int rep_ = 0; rep_ < ((PROBE_PH == (k)) ? 2 : 1); ++rep_)
#define SEAM(k) do { if (IN(k) && IN((k) + 1)) xcd_barrier(bar); } while (0)

    if (IN(PH_P0)) REP(PH_P0) { IDS(); p0_weights<0>(ws, lds, gw, NGW, wave, lane); if (G <= 192) p0_weights<1>(ws, lds, gw, NGW, wave, lane); if (G <= 64) p0_weights<2>(ws, lds, gw, NGW, wave, lane); p0_rows(ws, gw, NGW, lane); }
    SEAM(PH_P0);
    if (PROBE_PH == 100 && N_LAUNCHES == 1) { for (int i_ = 0; i_ < 10; ++i_) xcd_barrier(bar); }
    if (IN(PH_LORA)) REP(PH_LORA) {
        SchedGrouped<1, 3> S{(const char*)(ws + WS_B1), (size_t)(WS_B2 - WS_B1), nullptr, (const char*)(ws + WS_WT_LORA), (size_t)256 * C * 2, G, bx};
        EpiLora E{(bf16*)(ws + WS_LW)};
        pg8::gemm_phase<EpiLora, SchedGrouped<1, 3>, true, false, C>(lds, S, E, wave);
        if (G > 192 && bx >= 192) { IDS(); p0_weights<1>(ws, lds, (bx - 192) * NWAVES + wave, (G - 192) * NWAVES, wave, lane); }
    }
    SEAM(PH_LORA);
    if (IN(PH_RKV)) REP(PH_RKV) {
        SchedGrouped<4, 3> S{(const char*)OUTP(), (size_t)M * C * 2, (const char*)(ws + WS_B4), (const char*)(ws + WS_WT_RKV), (size_t)C * C * 2, G, bx};
        EpiSplit3 E{(bf16*)(ws + WS_B1), false, nullptr};
        pg8::gemm_phase<EpiSplit3, SchedGrouped<4, 3>, true, false, C>(lds, S, E, wave);
    }
    SEAM(PH_RKV);
    if (IN(PH_S1)) REP(PH_S1) { IDS(); scan_s1(ws, lds, lane, wave); }
    SEAM(PH_S1);
    if (IN(PH_S2)) REP(PH_S2) { IDS();
        if (bx < BATCH * NH || G <= BATCH * NH) scan_s2(ws, lds, lane, wave);
        }
    SEAM(PH_S2);
    if (IN(PH_S3)) REP(PH_S3) { IDS(); scan_s3(ws, lds, lane, wave); }
    SEAM(PH_S3);
#if MK_DEBUG
    if (IN(PH_DBG0)) { IDS(); scan_naive(ws, lds, tid); }
    SEAM(PH_DBG0);
    if (IN(PH_DBG0 + 1)) { IDS(); post_scan(ws, gw, NGW, lane); }
    SEAM(PH_DBG0 + 1);
    if (IN(PH_DBG0 + 2)) { IDS(); dbg_compare(ws, (const bf16*)(ws + WS_B0), (const bf16*)(ws + WS_B4), gw, NGW, lane); }
    SEAM(PH_DBG0 + 2);
#endif
    if (IN(PH_WOUT)) REP(PH_WOUT) {
        SchedGrouped<4, 1> S{(const char*)(ws + ((MK_DEBUG && DBG_USE_NAIVE) ? WS_B4 : WS_B0)), 0, nullptr, (const char*)(ws + WS_WT_OUT), 0, G, bx};
        EpiResidBf<true> E{INP(0), (bf16*)(ws + WS_B4)};
        pg8::gemm_phase<EpiResidBf<true>, SchedGrouped<4, 1>, true, false, C>(lds, S, E, wave);
    }
    SEAM(PH_WOUT);
#pragma unroll 1
    for (int layer = 0; layer < 2; ++layer) {
        const int pb = layer == 0 ? (int)PH_ROUT0 : (int)PH_ROUT1;
        if (IN(pb)) { IDS(); if (PROBE_PH == 101 && layer == 0) router_rows(ws, lds, layer, gw, NGW, lane, tid, wave, true); router_rows(ws, lds, layer, gw, NGW, lane, tid, wave); }
        SEAM(pb);
        const int mc = (G % 8 == 0) ? (bx % 8) * (G / 8) + bx / 8 : bx;
        if (IN(pb + 1)) REP(pb + 1) {
            { IDS(); moe_table(ws, tab, layer, tid); }
            SchedMoe<2, C, true> S{(const char*)(ws + WS_B4), (const char*)(ws + WS_WT_GU) + (size_t)layer * 16 * 512 * C * 2, (size_t)512 * C * 2, (const unsigned*)(ws + WS_LIST), tab, G, mc};
            EpiGU E{(bf16*)(ws + WS_HID), (const float*)(ws + WS_WL), (const float*)(ws + WS_B0)};
            pg8::gemm_phase<EpiGU, SchedMoe<2, C, true>, true, true, C>(lds, S, E, wave);
            if (layer == 0 && G > 64) { const int nr2 = __builtin_amdgcn_readfirstlane(tab[48]) * 2 - G, first = nr2 > 0 ? nr2 : 0;
                if (mc >= first) { IDS(); p0_weights<2>(ws, lds, (mc - first) * NWAVES + wave, (G - first) * NWAVES, wave, lane); } }
        }
        SEAM(pb + 1);
        if (IN(pb + 2)) REP(pb + 2) {
            { IDS(); moe_table(ws, tab, layer, tid); }
            SchedMoe<4, FE, false> S{(const char*)(ws + WS_HID), (const char*)(ws + WS_WT_DN) + (size_t)layer * 16 * C * FE * 2, (size_t)C * FE * 2, (const unsigned*)(ws + WS_LIST), tab, G, mc};
            EpiDown E{(bf16*)(ws + WS_B2), (const unsigned*)(ws + WS_LIST)};
            pg8::gemm_phase<EpiDown, SchedMoe<4, FE, false>, true, false, FE>(lds, S, E, wave);
        }
        SEAM(pb + 2);
        if (layer == 0) {
            if (IN(PH_COMB)) { IDS(); if (PROBE_PH == 102) combine_rows(ws, 0, gw, NGW, lane, true); combine_rows(ws, 0, gw, NGW, lane); }
            SEAM(PH_COMB);
            if (IN(PH_KVQ)) REP(PH_KVQ) {
                SchedGrouped<12, 1> S{(const char*)(ws + WS_B4), 0, nullptr, (const char*)(ws + WS_WT_KVQ), 0, G, bx};
                EpiSplit3 E{(bf16*)(ws + WS_B1), true, (const float*)(ws + WS_B0)};
                pg8::gemm_phase<EpiSplit3, SchedGrouped<12, 1>, true, false, C>(lds, S, E, wave);
            }
            SEAM(PH_KVQ);
            if (IN(PH_ATTN)) REP(PH_ATTN) { IDS(); attn_mfma(ws, lds, gw, NGW, lane, wave); }
            SEAM(PH_ATTN);
            if (IN(PH_SBO)) {
                SchedGrouped<4, 1> S{(const char*)(ws + WS_B0), 0, nullptr, (const char*)(ws + WS_WT_SBO), 0, G, bx};
                EpiResidBf<false> E{(const void*)(ws + WS_B4), (bf16*)(ws + WS_B4)};
                pg8::gemm_phase<EpiResidBf<false>, SchedGrouped<4, 1>, true, false, C>(lds, S, E, wave);
            }
            SEAM(PH_SBO);
        }
    }
    if (IN(PH_FINAL)) { IDS(); combine_rows(ws, 1, gw, NGW, lane); }
#undef IN
#undef SEAM
}

extern "C" void kernel_launch(void* const* d_in, const int* in_sizes, int n_in, void* d_out, int out_size, void* d_ws, size_t ws_size, hipStream_t stream) {
    static int grid = 0;
    if (grid == 0) {
        if (n_in != 31 || in_sizes[0] != M * C || out_size != M * C || ws_size < WS_END) { fprintf(stderr, "kernel_launch: unexpected shapes (n_in %d, in0 %d, out %d, ws %zu); nothing launched\n", n_in, n_in > 0 ? in_sizes[0] : -1, out_size, ws_size); grid = -1; return; }
        int dev = 0, cus = 0, per_cu = 0;
        if (hipGetDevice(&dev) != hipSuccess || hipDeviceGetAttribute(&cus, hipDeviceAttributeMultiprocessorCount, dev) != hipSuccess) { grid = -1; return; }
        if (hipFuncSetAttribute((const void*)yoco_fwd, hipFuncAttributeMaxDynamicSharedMemorySize, LDS_BYTES) != hipSuccess) { fprintf(stderr, "kernel_launch: hipFuncSetAttribute failed\n"); grid = -1; return; }
        if (hipOccupancyMaxActiveBlocksPerMultiprocessor(&per_cu, (const void*)yoco_fwd, NWAVES * 64, LDS_BYTES) != hipSuccess || per_cu < 1) fprintf(stderr, "kernel_launch: occupancy query reports %d\n", per_cu);
        (void)hipGetLastError();
        grid = cus - (cus % 16);
    }
    if (grid < 0) return;
    if (hipMemsetAsync((char*)d_ws + WS_CTL, 0, CTL_ZERO_BYTES, stream) != hipSuccess) return;
    Args a{};
    for (int i = 0; i < 31; ++i) a.in[i] = (const float*)d_in[i];
    a.out = (float*)d_out; a.ws = (unsigned char*)d_ws;
    for (int li = 0; li < (N_LAUNCHES == 1 ? 1 : (int)NPHASE); ++li) {
        a.ph_lo = (N_LAUNCHES == 1) ? 0 : li; a.ph_hi = (N_LAUNCHES == 1) ? NPHASE : li + 1; a.li = li;
        hipLaunchKernelGGL(yoco_fwd, dim3(grid), dim3(NWAVES * 64), LDS_BYTES, stream, a);
        const hipError_t le = hipPeekAtLastError();
        if (le != hipSuccess) { fprintf(stderr, "kernel_launch: launch %d failed: %s\n", li, hipGetErrorName(le)); break; }
    }
}
```

```cpp
#include <hip/hip_runtime.h>
#include <cstdio>
#include <cstdint>

#ifndef MK_N_LAUNCHES
#define MK_N_LAUNCHES 1
#endif

namespace pg8 {
#define PG8_LAS __attribute__((address_space(3)))
typedef unsigned short bf16_t;
typedef short bf16x8 __attribute__((ext_vector_type(8)));
typedef float f32x4 __attribute__((ext_vector_type(4)));
typedef unsigned u32x4 __attribute__((ext_vector_type(4)));
constexpr int BM = 256, BK = 64, HALF = 128, HTB = HALF * BK * 2, STAGE_BYTES = 8 * HTB, NXCD = 8, WGM = 8;

__host__ __device__ __forceinline__ int lds_byte(int r, int c) { const int st = (r >> 4) * 2 + (c >> 5), rr = r & 15, cc = c & 31, ob = rr * 64 + cc * 2; return st * 1024 + (ob ^ (((ob >> 9) & 1) << 5)); }
__host__ __device__ __forceinline__ void stage_rc(int b, int& R, int& C) { const int st = b / 1024, sb = b % 1024, swz = sb ^ (((sb >> 9) & 1) << 5); R = (st >> 1) * 16 + swz / 64; C = (st & 1) * 32 + (swz % 64) / 2; }
__host__ __device__ __forceinline__ int perm32(int rho) { const int n = rho >> 4, i = rho & 15; return 8 * (i >> 2) + 4 * n + (i & 3); }

struct Unit { int pm, pn, aux, r0, cnt; };

__host__ __device__ __forceinline__ void tile_map(int wgid, int nM, int nN, int& pm, int& pn) {
    const int nwg = nM * nN;
    { const int q = nwg / NXCD, r = nwg % NXCD, xcd = wgid % NXCD, off = wgid / NXCD; wgid = (xcd < r ? xcd * (q + 1) : r * (q + 1) + (xcd - r) * q) + off; }
    const int nig = WGM * nN, gid = wgid / nig, fm = gid * WGM, gsz = (nM - fm) < WGM ? (nM - fm) : WGM;
    pm = fm + ((wgid % nig) % gsz); pn = (wgid % nig) / gsz;
}

typedef float f32x2_t __attribute__((ext_vector_type(2))); typedef __bf16 bf16x2_t __attribute__((ext_vector_type(2)));
__device__ __forceinline__ unsigned cvt_pk_bf16(float lo, float hi) { const f32x2_t v = {lo, hi}; const bf16x2_t b = __builtin_convertvector(v, bf16x2_t); return __builtin_bit_cast(unsigned, b); }

template <class Epi, class Sched, bool ALIGN_EPI, bool GATHER, int K>
__device__ __forceinline__ void gemm_phase(PG8_LAS unsigned char* lds, const Sched& S, const Epi& E, const int wid) {
    int lane_; asm volatile("v_mbcnt_lo_u32_b32 %0, -1, 0\n\tv_mbcnt_hi_u32_b32 %0, -1, %0" : "=v"(lane_));
    const int lane = lane_, tid = wid * 64 + lane, wr = wid >> 2, wc = wid & 3, fr = lane & 15, fq = lane >> 4;
    constexpr int nt = K / BK;
    unsigned voffA[2], voffB[2];
#pragma unroll
    for (int i = 0; i < 2; ++i) { int R, C; stage_rc(tid * 16 + i * 8192, R, C); const int Rb = Epi::PERM ? ((R & ~31) + perm32(R & 31)) : R;
        voffA[i] = (unsigned)(R * K + C) * 2u; voffB[i] = (unsigned)(Rb * K + C) * 2u; }
    constexpr size_t kstep = (size_t)(BK * 2);
    constexpr size_t hstep = (size_t)HALF * K * 2;
    const unsigned ldsw = (unsigned)wid * 1024u;
    const int aoff = lds_byte(wr * 64 + fr, fq * 8), boff = lds_byte(wc * 32 + fr, fq * 8);
#define PG8_SA(b, h) (((b) * 2 + (h)) * HTB)
#define PG8_SB(b, h) ((4 + (b) * 2 + (h)) * HTB)
#define PG8_STAGE(bufoff, gbase, voff) do { _Pragma("unroll") for (int _i = 0; _i < 2; ++_i) \
        __builtin_amdgcn_global_load_lds((const unsigned*)((const char*)(gbase) + (voff)[_i]), (PG8_LAS unsigned*)(lds + (bufoff) + ldsw + _i * 8192), 16, 0, 0); } while (0)
#define PG8_LDA(dst, b, h) do { _Pragma("unroll") for (int m = 0; m < 4; ++m) _Pragma("unroll") for (int k = 0; k < 2; ++k) dst[m][k] = *(const PG8_LAS bf16x8*)(lds + PG8_SA(b, h) + aoff + m * 2048 + k * 1024); } while (0)
#define PG8_LDB(dst, b, h) do { _Pragma("unroll") for (int n = 0; n < 2; ++n) _Pragma("unroll") for (int k = 0; k < 2; ++k) dst[n][k] = *(const PG8_LAS bf16x8*)(lds + PG8_SB(b, h) + boff + n * 2048 + k * 1024); } while (0)
#define PG8_MMA(ai, bj, At, Bt) do { __builtin_amdgcn_s_setprio(1); _Pragma("unroll") for (int m = 0; m < 4; ++m) _Pragma("unroll") for (int n = 0; n < 2; ++n) _Pragma("unroll") for (int k = 0; k < 2; ++k) \
        acc[ai][bj][m][n] = __builtin_amdgcn_mfma_f32_16x16x32_bf16(Bt[n][k], At[m][k], acc[ai][bj][m][n], 0, 0, 0); __builtin_amdgcn_s_setprio(0); } while (0)
#define PG8_WAIT_V(n) asm volatile("s_waitcnt vmcnt(" #n ")" ::: "memory")
#define PG8_WAIT_L(n) asm volatile("s_waitcnt lgkmcnt(" #n ")" ::: "memory")
#define PG8_BAR __builtin_amdgcn_s_barrier()
#define PG8_SCHED __builtin_amdgcn_sched_barrier(0)
    Unit cur, nxt; int ui = 0;
    if (!S.next(0, cur)) return;
    f32x4 acc[2][2][4][2];
#pragma unroll
    for (int a = 0; a < 2; ++a)
#pragma unroll
        for (int b = 0; b < 2; ++b)
#pragma unroll
            for (int m = 0; m < 4; ++m)
#pragma unroll
                for (int n = 0; n < 2; ++n) acc[a][b][m][n] = (f32x4){0.f, 0.f, 0.f, 0.f};
    bf16x8 At[4][2], B0[2][2], B1[2][2];
    unsigned vc[2][2];
#define PG8_GOFF(u) do { _Pragma("unroll") for (int _h = 0; _h < 2; ++_h) _Pragma("unroll") for (int _i = 0; _i < 2; ++_i) { int _R, _C; stage_rc(tid * 16 + _i * 8192, _R, _C); \
        vc[_h][_i] = S.a_row_off(u, _h * HALF + _R) + (unsigned)_C * 2u; } } while (0)
#define PG8_STAGE_A(bufoff, gbase, h) do { if constexpr (GATHER) { PG8_STAGE(bufoff, gbase, vc[h]); } else { PG8_STAGE(bufoff, (gbase) + (h) * hstep, voffA); } } while (0)
    if constexpr (GATHER) PG8_GOFF(cur);
    const char* cA = S.a_base(cur); const char* cB = S.b_base(cur);
    PG8_STAGE(PG8_SB(0, 0), cB, voffB); PG8_STAGE(PG8_SB(0, 1), cB + hstep, voffB); PG8_STAGE_A(PG8_SA(0, 0), cA, 0); PG8_STAGE_A(PG8_SA(0, 1), cA, 1);
    if (wr == 1) PG8_BAR;
    PG8_WAIT_V(2); PG8_BAR;
    PG8_STAGE(PG8_SB(1, 0), cB + kstep, voffB); PG8_STAGE_A(PG8_SA(1, 0), cA + kstep, 0); PG8_STAGE(PG8_SB(1, 1), cB + hstep + kstep, voffB);
    PG8_WAIT_V(6); PG8_BAR;
    for (;;) {
        const bool has_next = S.next(ui + 1, nxt);
        const char* nA = has_next ? S.a_base(nxt) : cA; const char* nB = has_next ? S.b_base(nxt) : cB;
        for (int t = 0; t < nt; t += 2) {
            const bool last = (t == nt - 2);
            const char* a1 = cA + (size_t)(t + 1) * kstep;
            const char* a2 = last ? nA : cA + (size_t)(t + 2) * kstep; const char* b2 = last ? nB : cB + (size_t)(t + 2) * kstep;
            const char* a3 = a2 + kstep; const char* b3 = b2 + kstep;
            PG8_LDB(B0, 0, 0); PG8_LDB(B1, 0, 1); PG8_SCHED; PG8_LDA(At, 0, 0); PG8_STAGE_A(PG8_SA(1, 1), a1, 1);
            if constexpr (GATHER) { if (last && has_next) PG8_GOFF(nxt); }
            PG8_WAIT_V(8); PG8_WAIT_L(0); PG8_BAR; PG8_MMA(0, 0, At, B0); PG8_MMA(0, 1, At, B1); PG8_BAR; PG8_SCHED;
            PG8_LDA(At, 0, 1); PG8_STAGE(PG8_SB(0, 0), b2, voffB); PG8_STAGE(PG8_SB(0, 1), b2 + hstep, voffB); PG8_STAGE_A(PG8_SA(0, 0), a2, 0);
            PG8_WAIT_V(8); PG8_WAIT_L(0); PG8_BAR; PG8_MMA(1, 0, At, B0); PG8_MMA(1, 1, At, B1); PG8_BAR; PG8_SCHED;
            PG8_LDB(B0, 1, 0); PG8_LDB(B1, 1, 1); PG8_SCHED; PG8_LDA(At, 1, 0); PG8_STAGE_A(PG8_SA(0, 1), a2, 1);
            PG8_WAIT_V(8); PG8_WAIT_L(0); PG8_BAR; PG8_MMA(0, 0, At, B0); PG8_MMA(0, 1, At, B1); PG8_BAR; PG8_SCHED;
            PG8_LDA(At, 1, 1); PG8_STAGE(PG8_SB(1, 0), b3, voffB); PG8_STAGE(PG8_SB(1, 1), b3 + hstep, voffB); PG8_STAGE_A(PG8_SA(1, 0), a3, 0);
            PG8_WAIT_V(8); PG8_WAIT_L(0); PG8_BAR; PG8_MMA(1, 0, At, B0); PG8_MMA(1, 1, At, B1); PG8_BAR; PG8_SCHED;
        }
        if constexpr (ALIGN_EPI) { if (wr == 0) PG8_BAR; }
        E(acc, cur, wr, wc, fr, fq);
        if (!has_next) break;
#pragma unroll
        for (int a = 0; a < 2; ++a)
#pragma unroll
            for (int b = 0; b < 2; ++b)
#pragma unroll
                for (int m = 0; m < 4; ++m)
#pragma unroll
                    for (int n = 0; n < 2; ++n) acc[a][b][m][n] = (f32x4){0.f, 0.f, 0.f, 0.f};
        cur = nxt; cA = nA; cB = nB; ++ui;
        if constexpr (ALIGN_EPI) { if (wr == 1) PG8_BAR; }
    }
    PG8_WAIT_V(0);
    if constexpr (!ALIGN_EPI) { if (wr == 0) PG8_BAR; }
    PG8_BAR;
#undef PG8_SA
#undef PG8_SB
#undef PG8_STAGE
#undef PG8_STAGE_A
#undef PG8_GOFF
#undef PG8_LDA
#undef PG8_LDB
#undef PG8_MMA
#undef PG8_WAIT_V
#undef PG8_WAIT_L
#undef PG8_BAR
#undef PG8_SCHED
}
}

constexpr int NWAVES = 8;
#ifndef MK_DEBUG
#define MK_DEBUG 0
#endif
#ifndef DBG_USE_NAIVE
#define DBG_USE_NAIVE 0
#endif
constexpr int DBGP = MK_DEBUG ? 3 : 0;
enum Phase { PH_P0 = 0, PH_LORA, PH_RKV, PH_S1, PH_S2, PH_S3, PH_DBG0, PH_WOUT = PH_DBG0 + DBGP, PH_ROUT0, PH_GU0, PH_DN0, PH_COMB, PH_KVQ, PH_ATTN, PH_SBO, PH_ROUT1, PH_GU1, PH_DN1, PH_FINAL, NPHASE };
constexpr int N_LAUNCHES = MK_N_LAUNCHES;


constexpr int BATCH = 2, SEQ = 8192, C = 1024, NH = 16, HD = 64, M = BATCH * SEQ;
constexpr int NE = 16, FE = 256, DW = 64, DA = 64, DG = 160;
constexpr float RMS_EPS = 1e-6f, GN_EPS = 64e-5f;
constexpr float SB_EXIT = 104.0f;

constexpr size_t MiB = 1u << 20;
constexpr size_t WS_CTL = 0, CTL_ZERO_BYTES = 64 * 1024;
constexpr size_t WS_WT_W2 = 128 * 1024, WS_WT_A2 = 256 * 1024, WS_WT_G2 = 384 * 1024;
constexpr size_t WS_WT_RKV = 1 * MiB;
constexpr size_t WS_WT_LORA = 7 * MiB;
constexpr size_t WS_WT_OUT = 9 * MiB;
constexpr size_t WS_WT_KVQ = 11 * MiB;
constexpr size_t WS_WT_SBO = 17 * MiB;
constexpr size_t WS_WT_GU = 19 * MiB;
constexpr size_t WS_WT_DN = 51 * MiB;
constexpr size_t WS_LW = 67 * MiB;
constexpr size_t WS_LA = 69 * MiB;
constexpr size_t WS_LG = 71 * MiB;
static_assert(WS_LA == WS_LW + 2 * MiB && WS_LG == WS_LW + 4 * MiB, "EpiLora's pointer arithmetic");
constexpr size_t WS_LIST = 76 * MiB;
constexpr size_t WS_WL = 77 * MiB;
constexpr size_t WS_HID = 78 * MiB;
constexpr size_t WS_B0 = 96 * MiB, WS_B1 = 128 * MiB, WS_B2 = 160 * MiB, WS_B3 = 192 * MiB, WS_B4 = 224 * MiB, WS_END = 256 * MiB;
static_assert(WS_HID + (size_t)144 * 256 * 256 * 2 <= WS_B0, "HID vs B0");
constexpr int CW_TMO = 0;
constexpr int CW_CNT = 1024;
constexpr int CW_BAR = 4096;

constexpr int RING_BYTES = 131072;
constexpr int LDSCTL_OFF = 146688, MISC_OFF = LDSCTL_OFF + 320, MOE_TAB_OFF = MISC_OFF + 128;
constexpr int LDS_BYTES = 147456;
static_assert(MOE_TAB_OFF + 256 <= LDS_BYTES, "LDS map");
static_assert(BATCH * NH * (SEQ / 64) % 16 == 0, "scan units");

#define GAS __attribute__((address_space(1)))
#define LAS __attribute__((address_space(3)))
typedef unsigned short bf16;
typedef unsigned v4u __attribute__((ext_vector_type(4)));
typedef unsigned v2u __attribute__((ext_vector_type(2)));
typedef float f32x4 __attribute__((ext_vector_type(4)));
typedef GAS unsigned gu32;
#define RLX_AGENT __ATOMIC_RELAXED, __HIP_MEMORY_SCOPE_AGENT
#define LDS_WAIT() asm volatile("s_waitcnt lgkmcnt(0)" ::: "memory")
#define VM_WAIT() asm volatile("s_waitcnt vmcnt(0)" ::: "memory")
__device__ __forceinline__ unsigned f2bf(float f) { unsigned u = __builtin_bit_cast(unsigned, f); return (u + 0x7fffu + ((u >> 16) & 1u)) >> 16; }
__device__ __forceinline__ unsigned pk2(float lo, float hi) { return f2bf(lo) | (f2bf(hi) << 16); }
__device__ __forceinline__ float bflo(unsigned u) { return __uint_as_float(u << 16); }
__device__ __forceinline__ float bfhi(unsigned u) { return __uint_as_float(u & 0xffff0000u); }
__device__ __forceinline__ float bf2f(bf16 b) { return __uint_as_float((unsigned)b << 16); }
__device__ __forceinline__ float sigmoidf_(float x) { return 1.0f / (1.0f + __expf(-x)); }

#define XB_TMO      128
#define XB_XCNT(j)  (256  + 64 * (j))
#define XB_XSUB(j)  (1280 + 64 * (j))
#define XB_XGEN(j)  (2304 + 64 * (j))
#define XB_TOP      3328
#define XB_TOPGEN   3392
#define XCD_BAR_WORDS 3456
#define XB_SPIN_CAP (1u << 18)
__device__ __forceinline__ unsigned xb_ld(unsigned* p)              { return __hip_atomic_load(p, __ATOMIC_RELAXED, __HIP_MEMORY_SCOPE_AGENT); }
__device__ __forceinline__ unsigned xb_add(unsigned* p, unsigned v) { return __hip_atomic_fetch_add(p, v, __ATOMIC_RELAXED, __HIP_MEMORY_SCOPE_AGENT); }
__device__ __forceinline__ unsigned xb_xcc_id() { return (unsigned)__builtin_amdgcn_s_getreg((3 << 11) | 20) & 0xFu; }
#define XB_SPIN(cond, bar) do { unsigned _sp = 0; while (cond) { __builtin_amdgcn_s_sleep(1); \
    if ((++_sp & 255u) == 0u) { if (xb_ld(&(bar)[XB_TMO])) break; if (_sp > XB_SPIN_CAP) { atomicAdd(&(bar)[XB_TMO], 1u); break; } } } } while (0)
struct XcdBarrier { unsigned* bar; unsigned x; volatile LAS unsigned* st; };
__device__ __forceinline__ XcdBarrier xcd_barrier_post(unsigned* bar, volatile LAS unsigned* st) {
    XcdBarrier b; b.bar = bar; b.x = xb_xcc_id(); b.st = st;
    if (threadIdx.x == 0) (void)xb_add(&bar[XB_XCNT(b.x)], 1u);
    return b;
}
__device__ __forceinline__ void xcd_barrier_complete(unsigned* bar, unsigned x, unsigned& nloc, unsigned& nx) {
    const unsigned G = gridDim.x * gridDim.y * gridDim.z;
    unsigned sum, cnt, mine, sp = 0u;
    for (;;) {
        sum = 0u; cnt = 0u; mine = 0u;
#pragma unroll
        for (unsigned j = 0; j < 16; ++j) { const unsigned c = xb_ld(&bar[XB_XCNT(j)]); sum += c; cnt += (c > 0u) ? 1u : 0u; mine = (j == x) ? c : mine; }
        if (sum == G) break;
        __builtin_amdgcn_s_sleep(1);
        if ((++sp & 255u) == 0u) { if (xb_ld(&bar[XB_TMO])) break; if (sp > XB_SPIN_CAP) { atomicAdd(&bar[XB_TMO], 1u); break; } }
    }
    nloc = mine > 0u ? mine : 1u; nx = cnt > 0u ? cnt : 1u;
}
__device__ __forceinline__ void xcd_barrier(const XcdBarrier& b) {
    asm volatile("s_waitcnt vmcnt(0)" ::: "memory");
    __syncthreads();
    if (threadIdx.x == 0) {
        unsigned* bar = b.bar;
        __builtin_amdgcn_s_waitcnt(0);
        unsigned nloc = b.st[0], nx = b.st[1];
        if (nloc == 0u) { xcd_barrier_complete(bar, b.x, nloc, nx); b.st[0] = nloc; b.st[1] = nx; }
        const unsigned old = xb_add(&bar[XB_XSUB(b.x)], 1u);
        const unsigned gen = old / nloc;
        const unsigned target = (gen + 1u) * nx;
        if (old + 1u == (gen + 1u) * nloc) {
            __builtin_amdgcn_fence(__ATOMIC_RELEASE, "agent");
            asm volatile("s_waitcnt vmcnt(0)" ::: "memory");
            const unsigned og = xb_add(&bar[XB_TOP], 1u);
            if (og + 1u != target) XB_SPIN((int)(xb_ld(&bar[XB_TOP]) - target) < 0, bar);
        } else {
            XB_SPIN((int)(xb_ld(&bar[XB_TOP]) - target) < 0, bar);
        }
        __builtin_amdgcn_fence(__ATOMIC_ACQUIRE, "agent");
        asm volatile("s_waitcnt vmcnt(0)" ::: "memory");
    }
    __syncthreads();
}

__device__ __forceinline__ float shx(float v, int o, int lane) { return __int_as_float(__builtin_amdgcn_ds_bpermute((lane ^ o) << 2, __float_as_int(v))); }
#define DPP_ADD(v, ctrl) ((v) + __int_as_float(__builtin_amdgcn_update_dpp(0, __float_as_int(v), (ctrl), 0xf, 0xf, true)))
__device__ __forceinline__ float wave_sum(float v, int lane) {
    (void)lane;
    v = DPP_ADD(v, 0x128); v = DPP_ADD(v, 0x124); v = DPP_ADD(v, 0x122); v = DPP_ADD(v, 0x121);
    const int iv = __float_as_int(v);
    return (__int_as_float(__builtin_amdgcn_readlane(iv, 0)) + __int_as_float(__builtin_amdgcn_readlane(iv, 16))) + (__int_as_float(__builtin_amdgcn_readlane(iv, 32)) + __int_as_float(__builtin_amdgcn_readlane(iv, 48)));
}
__device__ __forceinline__ float sum8(float v) { v = DPP_ADD(v, 0xB1); v = DPP_ADD(v, 0x4E); v = DPP_ADD(v, 0x141); return v; }
__device__ __forceinline__ void transpose_item(const float* W, int ldw, int k0, int n0, bf16* WT, int ldk, int dst_row0, const float* kscale, LAS float* scr, int lane, int kmax = 1 << 30) {
    const int r8 = lane >> 3, quad = lane & 7;
    f32x4 v[8];
#pragma unroll
    for (int i = 0; i < 8; ++i) { const int kk = r8 + 8 * i; v[i] = (k0 + kk < kmax) ? *(const GAS f32x4*)(W + (size_t)(k0 + kk) * ldw + n0 + quad * 4) : (f32x4){0.f, 0.f, 0.f, 0.f}; }
#pragma unroll
    for (int i = 0; i < 8; ++i) { const int kk = r8 + 8 * i; if (kscale) v[i] = v[i] * kscale[(k0 + kk < kmax) ? k0 + kk : 0]; *(LAS f32x4*)(scr + kk * 36 + ((quad ^ i) << 2)) = v[i]; }
    LDS_WAIT(); asm volatile("" ::: "memory");
    const int c = lane & 7;
#pragma unroll
    for (int j = 0; j < 4; ++j) { const int n = (lane >> 3) + 8 * j; const LAS float* sp = scr + (8 * c) * 36 + ((((n >> 2) ^ c) << 2) | (n & 3));
        v4u o; o.x = pk2(sp[0 * 36], sp[1 * 36]); o.y = pk2(sp[2 * 36], sp[3 * 36]); o.z = pk2(sp[4 * 36], sp[5 * 36]); o.w = pk2(sp[6 * 36], sp[7 * 36]);
        if (k0 + 8 * c < kmax) *(GAS v4u*)(WT + (size_t)(dst_row0 + n) * ldk + k0 + 8 * c) = o; }
    LDS_WAIT(); asm volatile("" ::: "memory");
}

struct Args { const float* in[31]; float* out; unsigned char* ws; int ph_lo, ph_hi, li, pad; };
typedef const __attribute__((address_space(4))) unsigned char* kaptr_t;
__device__ __forceinline__ kaptr_t ka_base() { kaptr_t p = (kaptr_t)__builtin_amdgcn_kernarg_segment_ptr(); asm volatile("" : "+s"(p)); return p; }
#define INP(k) (*(const float* const __attribute__((address_space(4)))*)(ka_base() + 8 * (k)))
#define OUTP() (*(float* const __attribute__((address_space(4)))*)(ka_base() + 8 * 31))
#define WSP() (*(unsigned char* const __attribute__((address_space(4)))*)(ka_base() + 8 * 32))
#define KA_INT(i) (*(const int __attribute__((address_space(4)))*)(ka_base() + 8 * 33 + 4 * (i)))

template <int PART> __device__ __forceinline__ void p0_weights(unsigned char* ws, LAS unsigned char* lds, int gw, int NGW, int wave, int lane) {
    LAS float* scr = (LAS float*)(lds + wave * 16384);
    bf16* WT_RKV = (bf16*)(ws + WS_WT_RKV); bf16* WT_LORA = (bf16*)(ws + WS_WT_LORA); bf16* WT_OUT = (bf16*)(ws + WS_WT_OUT); bf16* WT_KVQ = (bf16*)(ws + WS_WT_KVQ);
    bf16* WT_SBO = (bf16*)(ws + WS_WT_SBO); bf16* WT_GU = (bf16*)(ws + WS_WT_GU); bf16* WT_DN = (bf16*)(ws + WS_WT_DN);
    constexpr int I_UP = 32 + 32 + 96, I_RKV = 3 * 512, I_LORA = 32 + 32 + 80, I_OUT = 512, I_KV = 1024, I_Q = 512, I_SBO = 512, I_G = 32 * 128, I_U = 32 * 128, I_D = 32 * 128;
    constexpr int NDENSE = I_UP + I_RKV + I_LORA + I_OUT + I_KV + I_Q + I_SBO, NITEMS = NDENSE + I_G + I_U + I_D;
    constexpr int N0 = I_UP + I_RKV + I_LORA, N3 = I_OUT, N4 = I_KV + I_Q + I_SBO; static_assert(N0 + N3 + N4 == NDENSE, "dense items");
    constexpr int NLOOP = PART == 0 ? N0 : (PART == 3 ? N3 : (PART == 4 ? N4 : 3 * 2048)); (void)NITEMS;
    for (int q_ = gw; q_ < NLOOP; q_ += NGW) {
        const int it = PART == 0 ? q_ : (PART == 3 ? N0 + q_ : (PART == 4 ? N0 + N3 + q_ : NDENSE + (q_ / 2048) * 4096 + 2048 * (PART - 1) + (q_ % 2048)));
        int r = it;
        if (r < I_UP) {
            if (r < 32) transpose_item(INP(9), C, 0, 32 * r, (bf16*)(ws + WS_WT_W2), 64, 32 * r, nullptr, scr, lane);
            else if (r < 64) transpose_item(INP(12), C, 0, 32 * (r - 32), (bf16*)(ws + WS_WT_A2), 64, 32 * (r - 32), nullptr, scr, lane);
            else { const int q = r - 64, kb = q / 32, nb = q % 32; transpose_item(INP(14), C, 64 * kb, 32 * nb, (bf16*)(ws + WS_WT_G2), DG, 32 * nb, nullptr, scr, lane, DG); }
            continue; } r -= I_UP;
        if (r < I_RKV) { const int m = r / 512, q = r % 512, kb = q / 32, nb = q % 32; transpose_item(INP(6) + (size_t)m * C * C, C, 64 * kb, 32 * nb, WT_RKV, C, m * C + 32 * nb, nullptr, scr, lane); continue; } r -= I_RKV;
        if (r < I_LORA) {
            if (r < 32) { const int kb = r / 2, nb = r % 2; transpose_item(INP(8), DW, 64 * kb, 32 * nb, WT_LORA, C, 32 * nb, nullptr, scr, lane); }
            else if (r < 64) { const int q = r - 32, kb = q / 2, nb = q % 2; transpose_item(INP(11), DA, 64 * kb, 32 * nb, WT_LORA, C, 256 + 32 * nb, nullptr, scr, lane); }
            else { const int q = r - 64, kb = q / 5, nb = q % 5; transpose_item(INP(13), DG, 64 * kb, 32 * nb, WT_LORA, C, 512 + 32 * nb, nullptr, scr, lane); }
            continue; } r -= I_LORA;
        if (r < I_OUT) { const int kb = r / 32, nb = r % 32; transpose_item(INP(20), C, 64 * kb, 32 * nb, WT_OUT, C, 32 * nb, nullptr, scr, lane); continue; } r -= I_OUT;
        if (r < I_KV) { const int kb = r / 64, nb = r % 64; transpose_item(INP(21), 2 * C, 64 * kb, 32 * nb, WT_KVQ, C, 32 * nb, INP(3), scr, lane); continue; } r -= I_KV;
        if (r < I_Q) { const int kb = r / 32, nb = r % 32; transpose_item(INP(22), C, 64 * kb, 32 * nb, WT_KVQ, C, 2 * C + 32 * nb, INP(1) + C, scr, lane); continue; } r -= I_Q;
        if (r < I_SBO) { const int kb = r / 32, nb = r % 32; transpose_item(INP(23), C, 64 * kb, 32 * nb, WT_SBO, C, 32 * nb, nullptr, scr, lane); continue; } r -= I_SBO;
        if (r < I_G) { const int le = r / 128, q = r % 128, kb = q / 8, nb = q % 8, f0 = 32 * nb; transpose_item(INP(28) + (size_t)le * C * FE, FE, 64 * kb, f0, WT_GU + (size_t)le * 512 * C, C, 256 * (f0 / 128) + (f0 % 128), INP(2) + (le >> 4) * C, scr, lane); continue; } r -= I_G;
        if (r < I_U) { const int le = r / 128, q = r % 128, kb = q / 8, nb = q % 8, f0 = 32 * nb; transpose_item(INP(29) + (size_t)le * C * FE, FE, 64 * kb, f0, WT_GU + (size_t)le * 512 * C, C, 256 * (f0 / 128) + 128 + (f0 % 128), INP(2) + (le >> 4) * C, scr, lane); continue; } r -= I_U;
        { const int le = r / 128, q = r % 128, kb = q / 32, nb = q % 32; transpose_item(INP(30) + (size_t)le * FE * C, C, 64 * kb, 32 * nb, WT_DN + (size_t)le * C * FE, FE, 32 * nb, nullptr, scr, lane); }
    }
    if (PART == 0) for (int it = gw * 64 + lane; it < 768 * 128; it += NGW * 64) { const int row = it >> 7, ch = it & 127;
        const bool valid = (row < 64) || (row >= 256 && row < 320) || (row >= 512 && row < 672);
        if (!valid) *(GAS v4u*)(WT_LORA + (size_t)row * C + ch * 8) = (v4u){0u, 0u, 0u, 0u}; }
}
__device__ __forceinline__ void load_row(const float* p, int lane, f32x4 (&v)[4]) {
#pragma unroll
    for (int j = 0; j < 4; ++j) v[j] = ((const GAS f32x4*)p)[64 * j + lane];
}
__device__ __forceinline__ void load_row_bf(const bf16* p, int lane, f32x4 (&v)[4]) {
#pragma unroll
    for (int j = 0; j < 4; ++j) { const v2u w = ((const GAS v2u*)p)[64 * j + lane]; v[j] = (f32x4){bflo(w.x), bfhi(w.x), bflo(w.y), bfhi(w.y)}; }
}
__device__ __forceinline__ float row_rs(const f32x4 (&v)[4], int lane) {
    float s = 0.f;
#pragma unroll
    for (int j = 0; j < 4; ++j) s += (v[j].x * v[j].x + v[j].y * v[j].y) + (v[j].z * v[j].z + v[j].w * v[j].w);
    return 1.0f / sqrtf(wave_sum(s, lane) * (1.0f / C) + RMS_EPS);
}
__device__ __forceinline__ void store_row_bf16(bf16* p, int lane, const f32x4 (&v)[4]) {
#pragma unroll
    for (int j = 0; j < 4; ++j) { v2u o; o.x = pk2(v[j].x, v[j].y); o.y = pk2(v[j].z, v[j].w); ((GAS v2u*)p)[64 * j + lane] = o; }
}
__device__ __forceinline__ void p0_rows(unsigned char* ws, int gw, int NGW, int lane) {
    const float* x = INP(0); const float* gain = INP(1); const float* mix = INP(5);
    f32x4 g[4]; load_row(gain, lane, g);
    f32x4 mx[6][4];
#pragma unroll
    for (int i = 0; i < 6; ++i) load_row(mix + i * C, lane, mx[i]);
    for (int run = gw; run < M / 8; run += NGW) {
        const int r0 = run * 8;
        f32x4 prev[4], nx[4];
        load_row(x + (size_t)r0 * C, lane, nx);
        if ((r0 % SEQ) == 0) {
#pragma unroll
            for (int j = 0; j < 4; ++j) prev[j] = (f32x4){0.f, 0.f, 0.f, 0.f};
        } else { load_row(x + (size_t)(r0 - 1) * C, lane, prev); const float rs = row_rs(prev, lane);
#pragma unroll
            for (int j = 0; j < 4; ++j) prev[j] = prev[j] * rs * g[j]; }
#pragma unroll 1
        for (int rr = 0; rr < 8; ++rr) {
            const int row = r0 + rr;
            f32x4 hn[4];
#pragma unroll
            for (int j = 0; j < 4; ++j) hn[j] = nx[j];
            if (rr < 7) load_row(x + (size_t)(row + 1) * C, lane, nx);
            const float rs = row_rs(hn, lane);
#pragma unroll
            for (int j = 0; j < 4; ++j) hn[j] = hn[j] * rs * g[j];
#pragma unroll
            for (int i = 0; i < 6; ++i) { f32x4 o[4];
#pragma unroll
                for (int j = 0; j < 4; ++j) o[j] = hn[j] + (prev[j] - hn[j]) * mx[i][j];
                bf16* dst = i < 2 ? (bf16*)OUTP() + (size_t)i * M * C : (i == 2 ? (bf16*)(ws + WS_B4) : (bf16*)(ws + WS_B1) + (size_t)(i - 3) * M * C);
                store_row_bf16(dst + (size_t)row * C, lane, o); }
#pragma unroll
            for (int j = 0; j < 4; ++j) prev[j] = hn[j];
        }
    }
}

template <int NN, int NGROUPS> struct SchedGrouped {
    static constexpr int K = C;
    const char* A0; size_t astride; const char* A2; const char* B; size_t bgroup;
    int G, c;
    __device__ __forceinline__ bool next(int i, pg8::Unit& u) const {
        const int L = i * G + c; constexpr int per = 64 * NN; if (L >= per * NGROUPS) return false;
        const int g = L / per, w = L % per; pg8::tile_map(w, 64, NN, u.pm, u.pn); u.aux = g; u.r0 = 0; u.cnt = 0; return true; }
    __device__ __forceinline__ const char* a_base(const pg8::Unit& u) const { const char* A = (A2 != nullptr && u.aux == 2) ? A2 : A0 + (size_t)u.aux * astride; return A + (size_t)u.pm * 256 * K * 2; }
    __device__ __forceinline__ const char* b_base(const pg8::Unit& u) const { return B + (size_t)u.aux * bgroup + (size_t)u.pn * 256 * K * 2; }
    __device__ __forceinline__ unsigned a_row_off(const pg8::Unit&, int) const { return 0u; }
};
template <int NN, int K, bool GATHER> struct SchedMoe {
    const char* A; const char* B; size_t bexp; const unsigned* list; volatile LAS int* tab; int G, c;
    __device__ __forceinline__ bool next(int i, pg8::Unit& u) const {
        const int L = i * G + c; const int tot = __builtin_amdgcn_readfirstlane(tab[48]) * NN; if (L >= tot) return false;
        u.pm = L / NN; u.pn = L % NN; int e = 0;
#pragma unroll
        for (int j = 0; j < 16; ++j) e += (u.pm >= tab[32 + j]) ? 1 : 0;
        e = __builtin_amdgcn_readfirstlane(e);
        u.aux = e; u.r0 = (u.pm - __builtin_amdgcn_readfirstlane(tab[16 + e])) * 256; u.cnt = __builtin_amdgcn_readfirstlane(tab[e]); return true; }
    __device__ __forceinline__ const char* a_base(const pg8::Unit& u) const { return GATHER ? A : A + (size_t)u.pm * 256 * K * 2; }
    __device__ __forceinline__ const char* b_base(const pg8::Unit& u) const { return B + (size_t)u.aux * bexp + (size_t)u.pn * 256 * K * 2; }
    __device__ __forceinline__ unsigned a_row_off(const pg8::Unit& u, int r) const {
        const int idx = u.r0 + r; unsigned tok = 0u;
        if (idx < u.cnt) tok = list[(size_t)u.aux * M + idx] >> 1;
        return tok * (unsigned)(K * 2); }
};

using pg8::f32x4;
using pg8::Unit;
__device__ __forceinline__ v4u pack8(f32x4 v0, f32x4 v1) { v4u w; w.x = pg8::cvt_pk_bf16(v0[0], v0[1]); w.y = pg8::cvt_pk_bf16(v0[2], v0[3]); w.z = pg8::cvt_pk_bf16(v1[0], v1[1]); w.w = pg8::cvt_pk_bf16(v1[2], v1[3]); return w; }

struct EpiLora {
    static constexpr bool PERM = true;
    bf16* LW;
    __device__ __forceinline__ void operator()(const f32x4 (&acc)[2][2][4][2], const Unit& u, int wr, int wc, int fr, int fq) const {
        { int l_; asm volatile("v_mbcnt_lo_u32_b32 %0, -1, 0\n\tv_mbcnt_hi_u32_b32 %0, -1, %0" : "=v"(l_)); fr = l_ & 15; fq = l_ >> 4; }
        const int g = u.aux, width = g == 2 ? DG : DW; bf16* out = LW + (size_t)g * (1u << 20);
        const int row0 = u.pm * 256 + wr * 64 + fr;
#pragma unroll
        for (int bj = 0; bj < 2; ++bj) { const int col0 = bj * 128 + wc * 32 + 8 * fq; if (col0 < width) {
#pragma unroll
            for (int ai = 0; ai < 2; ++ai)
#pragma unroll
                for (int m = 0; m < 4; ++m) { f32x4 v0 = acc[ai][bj][m][0], v1 = acc[ai][bj][m][1];
                    if (g == 0) {
#pragma unroll
                        for (int q = 0; q < 4; ++q) { v0[q] = tanhf(v0[q]); v1[q] = tanhf(v1[q]); } }
                    else if (g == 2) {
#pragma unroll
                        for (int q = 0; q < 4; ++q) { v0[q] = sigmoidf_(v0[q]); v1[q] = sigmoidf_(v1[q]); } }
                    *(GAS v4u*)(out + (size_t)(row0 + ai * 128 + m * 16) * width + col0) = pack8(v0, v1); } } }
    }
};
struct EpiSplit3 {
    static constexpr bool PERM = true;
    bf16* O0; bool bycol; const float* rowscale;
    __device__ __forceinline__ void operator()(const f32x4 (&acc)[2][2][4][2], const Unit& u, int wr, int wc, int fr, int fq) const {
        { int l_; asm volatile("v_mbcnt_lo_u32_b32 %0, -1, 0\n\tv_mbcnt_hi_u32_b32 %0, -1, %0" : "=v"(l_)); fr = l_ & 15; fq = l_ >> 4; }
        const int g = bycol ? (u.pn >> 2) : u.aux, pn = bycol ? (u.pn & 3) : u.pn; bf16* out = O0 + (size_t)g * ((size_t)M * C);
        const int row0 = u.pm * 256 + wr * 64 + fr, col0 = pn * 256 + wc * 32 + 8 * fq;
#pragma unroll
        for (int ai = 0; ai < 2; ++ai)
#pragma unroll
            for (int m = 0; m < 4; ++m)
                { const float sc = rowscale ? rowscale[row0 + ai * 128 + m * 16] : 1.0f;
#pragma unroll
                for (int bj = 0; bj < 2; ++bj) *(GAS v4u*)(out + (size_t)(row0 + ai * 128 + m * 16) * C + col0 + bj * 128) = pack8(acc[ai][bj][m][0] * sc, acc[ai][bj][m][1] * sc); }
    }
};
template <bool BASE_F32> struct EpiResidBf {
    static constexpr bool PERM = true;
    const void* base; bf16* out;
    __device__ __forceinline__ void operator()(const f32x4 (&acc)[2][2][4][2], const Unit& u, int wr, int wc, int fr, int fq) const {
        { int l_; asm volatile("v_mbcnt_lo_u32_b32 %0, -1, 0\n\tv_mbcnt_hi_u32_b32 %0, -1, %0" : "=v"(l_)); fr = l_ & 15; fq = l_ >> 4; }
        const int row0 = u.pm * 256 + wr * 64 + fr, col0 = u.pn * 256 + wc * 32 + 8 * fq;
#pragma unroll
        for (int ai = 0; ai < 2; ++ai)
#pragma unroll
            for (int m = 0; m < 4; ++m) { const size_t off = (size_t)(row0 + ai * 128 + m * 16) * C + col0;
#pragma unroll
                for (int bj = 0; bj < 2; ++bj) { f32x4 b0, b1;
                    if (BASE_F32) { b0 = *(const GAS f32x4*)((const float*)base + off + bj * 128); b1 = *(const GAS f32x4*)((const float*)base + off + bj * 128 + 4); }
                    else { const v4u w = *(const GAS v4u*)((const bf16*)base + off + bj * 128); b0 = (f32x4){bflo(w.x), bfhi(w.x), bflo(w.y), bfhi(w.y)}; b1 = (f32x4){bflo(w.z), bfhi(w.z), bflo(w.w), bfhi(w.w)}; }
                    *(GAS v4u*)(out + off + bj * 128) = pack8(b0 + acc[ai][bj][m][0], b1 + acc[ai][bj][m][1]); }
                asm volatile("" ::: "memory"); }
    }
};
struct EpiGU {
    static constexpr bool PERM = true;
    bf16* HID; const float* wl; const float* rsl;
    __device__ __forceinline__ void operator()(const f32x4 (&acc)[2][2][4][2], const Unit& u, int wr, int wc, int fr, int fq) const {
        { int l_; asm volatile("v_mbcnt_lo_u32_b32 %0, -1, 0\n\tv_mbcnt_hi_u32_b32 %0, -1, %0" : "=v"(l_)); fr = l_ & 15; fq = l_ >> 4; }
        const int e = u.aux, cnt = u.cnt, base = u.r0, r0 = wr * 64 + fr, col0 = u.pn * 128 + wc * 32 + 8 * fq;
#pragma unroll
        for (int ai = 0; ai < 2; ++ai)
#pragma unroll
            for (int m = 0; m < 4; ++m) { const int r = r0 + ai * 128 + m * 16, idx = base + r; float w = 0.f, rs = 0.f; if (idx < cnt) { w = wl[(size_t)e * M + idx]; rs = rsl[(size_t)e * M + idx]; }
                f32x4 h0, h1;
#pragma unroll
                for (int q = 0; q < 4; ++q) { const float g0 = acc[ai][0][m][0][q] * rs, g1 = acc[ai][0][m][1][q] * rs;
                    h0[q] = g0 * sigmoidf_(g0) * (acc[ai][1][m][0][q] * rs) * w; h1[q] = g1 * sigmoidf_(g1) * (acc[ai][1][m][1][q] * rs) * w; }
                *(GAS v4u*)(HID + (size_t)(u.pm * 256 + r) * FE + col0) = pack8(h0, h1);
                asm volatile("" ::: "memory"); }
    }
};
struct EpiDown {
    static constexpr bool PERM = true;
    bf16* EO; const unsigned* list;
    __device__ __forceinline__ void operator()(const f32x4 (&acc)[2][2][4][2], const Unit& u, int wr, int wc, int fr, int fq) const {
        { int l_; asm volatile("v_mbcnt_lo_u32_b32 %0, -1, 0\n\tv_mbcnt_hi_u32_b32 %0, -1, %0" : "=v"(l_)); fr = l_ & 15; fq = l_ >> 4; }
        const int e = u.aux, cnt = u.cnt, base = u.r0, r0 = wr * 64 + fr, col0 = u.pn * 256 + wc * 32 + 8 * fq;
#pragma unroll
        for (int ai = 0; ai < 2; ++ai)
#pragma unroll
            for (int m = 0; m < 4; ++m) { const int idx = base + r0 + ai * 128 + m * 16;
                if (idx < cnt) { const unsigned ent = list[(size_t)e * M + idx]; bf16* o = EO + ((size_t)(ent & 1u) * M + (ent >> 1)) * C + col0;
#pragma unroll
                    for (int bj = 0; bj < 2; ++bj) *(GAS v4u*)(o + bj * 128) = pack8(acc[ai][bj][m][0], acc[ai][bj][m][1]); }
                asm volatile("" ::: "memory"); }
    }
};

typedef short bf16x8s __attribute__((ext_vector_type(8)));
typedef short bf16x4s __attribute__((ext_vector_type(4)));
typedef short v4i16_t __attribute__((ext_vector_type(4)));
constexpr int TPB = 144;
constexpr int TILE_B = 64 * TPB;
constexpr int FP = 68;
constexpr int CS_FA = 0, CS_FB = 16384, CS_TILES = 32768, CS_TOT = CS_TILES + 12 * TILE_B, CS_WL = CS_TOT + 2048, CS_PAR = CS_WL + 256;
static_assert(CS_PAR + 768 <= LDSCTL_OFF, "scan LDS map");
#define TILE(n) (lds + CS_TILES + (n) * TILE_B)
#define F4Z (f32x4){0.f, 0.f, 0.f, 0.f}
__device__ __forceinline__ bf16x8s ldfrag(const LAS unsigned char* tile, int row, int kcol) { return *(const LAS bf16x8s*)(tile + row * TPB + kcol * 2); }
__device__ __forceinline__ bf16x8s ldfrag_tr(const LAS unsigned char* tile, int n0, int k0, int lane) {
    const int g = lane >> 4, q = (lane & 15) >> 2, p = lane & 3;
    const LAS unsigned char* a = tile + (k0 + 8 * g + q) * TPB + (n0 + 4 * p) * 2;
    const v4i16_t lo = __builtin_amdgcn_ds_read_tr16_b64_v4i16((LAS v4i16_t*)a), hi = __builtin_amdgcn_ds_read_tr16_b64_v4i16((LAS v4i16_t*)(a + 4 * TPB));
    return (bf16x8s){lo[0], lo[1], lo[2], lo[3], hi[0], hi[1], hi[2], hi[3]};
}
__device__ __forceinline__ bf16x8s ldfrag_perm(const LAS unsigned char* tile, int row, int ks, int g) {
    const bf16x4s lo = *(const LAS bf16x4s*)(tile + row * TPB + (32 * ks + 4 * g) * 2), hi = *(const LAS bf16x4s*)(tile + row * TPB + (32 * ks + 16 + 4 * g) * 2);
    return (bf16x8s){lo[0], lo[1], lo[2], lo[3], hi[0], hi[1], hi[2], hi[3]};
}
__device__ __forceinline__ void lds_barrier() { asm volatile("s_waitcnt lgkmcnt(0)" ::: "memory"); __builtin_amdgcn_s_barrier(); asm volatile("" ::: "memory"); }
#define MFMA16(a, b, c) __builtin_amdgcn_mfma_f32_16x16x32_bf16((a), (b), (c), 0, 0, 0)
__device__ __forceinline__ void mm64(f32x4 (&acc)[2], const LAS unsigned char* At, const LAS unsigned char* Bt, int rt, int ch, int fr, int g) {
#pragma unroll
    for (int ks = 0; ks < 2; ++ks) { const bf16x8s a = ldfrag(At, 16 * rt + fr, 32 * ks + 8 * g);
#pragma unroll
        for (int ct = 0; ct < 2; ++ct) acc[ct] = MFMA16(a, ldfrag(Bt, 32 * ch + 16 * ct + fr, 32 * ks + 8 * g), acc[ct]); }
}
__device__ __forceinline__ void mm64_bt(f32x4 (&acc)[2], const LAS unsigned char* At, const LAS unsigned char* X, int rt, int ch, int fr, int g, int lane) {
#pragma unroll
    for (int ks = 0; ks < 2; ++ks) { const bf16x8s a = ldfrag(At, 16 * rt + fr, 32 * ks + 8 * g);
#pragma unroll
        for (int ct = 0; ct < 2; ++ct) acc[ct] = MFMA16(a, ldfrag_tr(X, 32 * ch + 16 * ct, 32 * ks, lane), acc[ct]); }
}
__device__ __forceinline__ void mm64_at(f32x4 (&acc)[2], const LAS unsigned char* Xa, const LAS unsigned char* Bt, int rt, int ch, int fr, int g, int lane) {
#pragma unroll
    for (int ks = 0; ks < 2; ++ks) { const bf16x8s a = ldfrag_tr(Xa, 16 * rt, 32 * ks, lane);
#pragma unroll
        for (int ct = 0; ct < 2; ++ct) acc[ct] = MFMA16(a, ldfrag(Bt, 32 * ch + 16 * ct + fr, 32 * ks + 8 * g), acc[ct]); }
}
__device__ __forceinline__ void mm64_att(f32x4 (&acc)[2], const LAS unsigned char* Xa, const LAS unsigned char* X, int rt, int ch, int lane) {
#pragma unroll
    for (int ks = 0; ks < 2; ++ks) { const bf16x8s a = ldfrag_tr(Xa, 16 * rt, 32 * ks, lane);
#pragma unroll
        for (int ct = 0; ct < 2; ++ct) acc[ct] = MFMA16(a, ldfrag_tr(X, 32 * ch + 16 * ct, 32 * ks, lane), acc[ct]); }
}
__device__ __forceinline__ bf16x4s pack4(f32x4 v) { v2u w; w.x = pg8::cvt_pk_bf16(v[0], v[1]); w.y = pg8::cvt_pk_bf16(v[2], v[3]); return __builtin_bit_cast(bf16x4s, w); }
__device__ __forceinline__ f32x4 unpack4(bf16x4s s) { const v2u w = __builtin_bit_cast(v2u, s); return (f32x4){bflo(w.x), bfhi(w.x), bflo(w.y), bfhi(w.y)}; }
__device__ __forceinline__ void st_tr(LAS unsigned char* Out, const f32x4 (&acc)[2], int rt, int ch, int fr, int g) {
#pragma unroll
    for (int ct = 0; ct < 2; ++ct) *(LAS bf16x4s*)(Out + (32 * ch + 16 * ct + fr) * TPB + (16 * rt + 4 * g) * 2) = pack4(acc[ct]);
}
__device__ __forceinline__ void ld_tr(f32x4 (&acc)[2], const LAS unsigned char* In, int rt, int ch, int fr, int g) {
#pragma unroll
    for (int ct = 0; ct < 2; ++ct) acc[ct] = unpack4(*(const LAS bf16x4s*)(In + (32 * ch + 16 * ct + fr) * TPB + (16 * rt + 4 * g) * 2));
}
__device__ __forceinline__ void unpack8(v4u w, float (&o)[8]) { o[0] = bflo(w.x); o[1] = bfhi(w.x); o[2] = bflo(w.y); o[3] = bfhi(w.y); o[4] = bflo(w.z); o[5] = bfhi(w.z); o[6] = bflo(w.w); o[7] = bfhi(w.w); }
__device__ __forceinline__ v4u pack8f(const float (&o)[8]) { v4u w; w.x = pg8::cvt_pk_bf16(o[0], o[1]); w.y = pg8::cvt_pk_bf16(o[2], o[3]); w.z = pg8::cvt_pk_bf16(o[4], o[5]); w.w = pg8::cvt_pk_bf16(o[6], o[7]); return w; }

struct FrontIn { v4u r, k, v; bf16x8s fw[2], fa[2]; };
__device__ __forceinline__ void front_fetch(FrontIn& f, unsigned char* ws, int unit, int tid, int lane, int wave) {
    const int h = unit & 15, c = (unit >> 4) & 127, b = unit >> 11; const size_t row0 = (size_t)b * SEQ + c * 64;
    const int rt = wave & 3, fr = lane & 15, g = lane >> 4, t = tid >> 3, cq = tid & 7, c0 = h * HD + cq * 8;
    const bf16* Rb = (const bf16*)(ws + WS_B1); const bf16* Kb = (const bf16*)(ws + WS_B2); const bf16* Vb = (const bf16*)(ws + WS_B3);
    const bf16* LW = (const bf16*)(ws + WS_LW); const bf16* LA = (const bf16*)(ws + WS_LA);
    f.r = *(const GAS v4u*)(Rb + (row0 + t) * C + c0); f.k = *(const GAS v4u*)(Kb + (row0 + t) * C + c0); f.v = *(const GAS v4u*)(Vb + (row0 + t) * C + c0);
#pragma unroll
    for (int ks = 0; ks < 2; ++ks) { f.fw[ks] = *(const GAS bf16x8s*)(LW + (row0 + 16 * rt + fr) * DW + 32 * ks + 8 * g); f.fa[ks] = *(const GAS bf16x8s*)(LA + (row0 + 16 * rt + fr) * DA + 32 * ks + 8 * g); }
}
__device__ __forceinline__ v4u head_consts(unsigned char* ws, LAS unsigned char* lds, int h, int tid, int wtile, int atile) {
    const bf16* W2T = (const bf16*)(ws + WS_WT_W2); const bf16* A2T = (const bf16*)(ws + WS_WT_A2);
    const int row = tid >> 3, cq = tid & 7;
    const v4u w2chunk = *(const GAS v4u*)(W2T + (size_t)(h * HD + row) * 64 + cq * 8);
    *(LAS v4u*)(lds + CS_TILES + wtile * TILE_B + row * TPB + cq * 16) = w2chunk;
    *(LAS v4u*)(lds + CS_TILES + atile * TILE_B + row * TPB + cq * 16) = *(const GAS v4u*)(A2T + (size_t)(h * HD + row) * 64 + cq * 8);
    if (tid < 64) { LAS float* P = (LAS float*)(lds + CS_PAR); P[tid] = INP(15)[h * HD + tid]; P[64 + tid] = INP(16)[h * HD + tid]; P[128 + tid] = INP(17)[h * HD + tid]; }
    __syncthreads();
    return w2chunk;
}
template <int MODE>
__device__ __forceinline__ void chunk_front(const FrontIn& f, LAS unsigned char* lds, const float (&w0v)[2], const float (&a0v)[2], const bf16x8s (&w2f)[2][2], const bf16x8s (&a2f)[2][2], int tid, int lane, int wave, float (&v8)[8], float& rkb) {
    const int rt = wave & 3, ch = wave >> 2, fr = lane & 15, g = lane >> 4;
    LAS float* FA = (LAS float*)(lds + CS_FA); LAS float* FB = (LAS float*)(lds + CS_FB); LAS float* TOT = (LAS float*)(lds + CS_TOT);
    const int t = tid >> 3, cq = tid & 7;
    {
        f32x4 aw[2] = {F4Z, F4Z}, aa[2] = {F4Z, F4Z};
#pragma unroll
        for (int ks = 0; ks < 2; ++ks)
#pragma unroll
            for (int ct = 0; ct < 2; ++ct) { aw[ct] = MFMA16(f.fw[ks], w2f[ks][ct], aw[ct]); aa[ct] = MFMA16(f.fa[ks], a2f[ks][ct], aa[ct]); }
#pragma unroll
        for (int ct = 0; ct < 2; ++ct) { const int j = 32 * ch + 16 * ct + fr, js = j ^ ((g & 1) << 4); const float w0 = w0v[ct], a0 = a0v[ct];
            float p[4];
#pragma unroll
            for (int q = 0; q < 4; ++q) { p[q] = -0.6065306597126334f * sigmoidf_(w0 + aw[ct][q]); if (q) p[q] += p[q - 1]; }
            const float s_ = p[3];
            const float u1 = __int_as_float(__builtin_amdgcn_ds_bpermute(((lane - 16) & 63) << 2, __float_as_int(s_))); const float t1 = s_ + (g >= 1 ? u1 : 0.f);
            const float u2 = __int_as_float(__builtin_amdgcn_ds_bpermute(((lane - 32) & 63) << 2, __float_as_int(t1))); const float t2 = t1 + (g >= 2 ? u2 : 0.f);
            const float ex = t2 - s_;
#pragma unroll
            for (int q = 0; q < 4; ++q) { const int tt = 16 * rt + 4 * g + q; FA[tt * 64 + js] = p[q] + ex; FB[tt * 64 + js] = sigmoidf_(a0 + aa[ct][q]); }
            if (g == 3) TOT[rt * 64 + j] = t2; }
    }
    lds_barrier();
    {
        float r[8], k[8], pkk[8], pka[8], prk[8];
        unpack8(f.r, r); unpack8(f.k, k); unpack8(f.v, v8);
        { const LAS float* P = (const LAS float*)(lds + CS_PAR) + cq * 8; const f32x4 a0_ = *(const LAS f32x4*)P, a1_ = *(const LAS f32x4*)(P + 4), b0_ = *(const LAS f32x4*)(P + 64), b1_ = *(const LAS f32x4*)(P + 68), c0_ = *(const LAS f32x4*)(P + 128), c1_ = *(const LAS f32x4*)(P + 132);
#pragma unroll
          for (int q = 0; q < 4; ++q) { pkk[q] = a0_[q]; pkk[4 + q] = a1_[q]; pka[q] = b0_[q]; pka[4 + q] = b1_[q]; prk[q] = c0_[q]; prk[4 + q] = c1_[q]; } }
        float cw[8], cwp[8], ag[8];
        { const int tp = t > 0 ? t - 1 : 0, rtt = wave >> 1;
          const int ct_ = (cq ^ (((t >> 2) & 1) << 1)) * 8, cp_ = (cq ^ (((tp >> 2) & 1) << 1)) * 8;
          const f32x4 c0_ = *(const LAS f32x4*)(FA + t * 64 + ct_), c1_ = *(const LAS f32x4*)(FA + t * 64 + ct_ + 4), p0_ = *(const LAS f32x4*)(FA + tp * 64 + cp_), p1_ = *(const LAS f32x4*)(FA + tp * 64 + cp_ + 4);
          const f32x4 g0_ = *(const LAS f32x4*)(FB + t * 64 + ct_), g1_ = *(const LAS f32x4*)(FB + t * 64 + ct_ + 4);
          f32x4 o0_ = F4Z, o1_ = F4Z, l0_ = F4Z, l1_ = F4Z;
          for (int r_ = 0; r_ < rtt; ++r_) { l0_ = *(const LAS f32x4*)(TOT + r_ * 64 + cq * 8); l1_ = *(const LAS f32x4*)(TOT + r_ * 64 + cq * 8 + 4); o0_ = o0_ + l0_; o1_ = o1_ + l1_; }
          const bool first = (t & 15) == 0;
#pragma unroll
          for (int q = 0; q < 4; ++q) { cw[q] = c0_[q] + o0_[q]; cw[4 + q] = c1_[q] + o1_[q];
              cwp[q] = t > 0 ? p0_[q] + o0_[q] - (first ? l0_[q] : 0.f) : 0.f; cwp[4 + q] = t > 0 ? p1_[q] + o1_[q] - (first ? l1_[q] : 0.f) : 0.f; ag[q] = g0_[q]; ag[4 + q] = g1_[q]; } }
        float kk[8], ss = 0.f; rkb = 0.f;
#pragma unroll
        for (int q = 0; q < 8; ++q) { kk[q] = k[q] * pkk[q]; ss += kk[q] * kk[q]; }
        ss = sum8(ss);
        const float inv = 1.0f / fmaxf(sqrtf(ss), 1e-12f);
        float at[8], bt[8], kt[8], rt_[8];
#pragma unroll
        for (int q = 0; q < 8; ++q) { const float kn = kk[q] * inv, kp = k[q] * (1.0f + (ag[q] - 1.0f) * pka[q]);
            const float ein = __expf(-cw[q]);
            at[q] = -kn * __expf(cwp[q]); bt[q] = kn * ag[q] * ein; kt[q] = kp * ein;
            rt_[q] = r[q] * __expf(cw[q]); rkb += r[q] * kp * prk[q]; }
        rkb = sum8(rkb);
        *(LAS v4u*)(TILE(0) + t * TPB + cq * 16) = pack8f(at); *(LAS v4u*)(TILE(1) + t * TPB + cq * 16) = pack8f(bt); *(LAS v4u*)(TILE(2) + t * TPB + cq * 16) = pack8f(kt);
        *(LAS v4u*)(TILE(3) + t * TPB + cq * 16) = f.v;
        *(LAS v4u*)(TILE(6) + t * TPB + cq * 16) = pack8f(rt_);
        if (MODE == 1 && t == 63) {
#pragma unroll
            for (int q = 0; q < 8; ++q) ((LAS float*)(lds + CS_WL))[cq * 8 + q] = __expf(cw[q]); }
    }
    lds_barrier();
}

__device__ __forceinline__ void scan_s1(unsigned char* ws, LAS unsigned char* lds, int lane0, int wave) {
    const int rt = wave & 3, ch = wave >> 2;
    FrontIn fin; float w0v[2], a0v[2]; bf16x8s w2f[2][2], a2f[2][2];
    { int l0 = lane0; asm volatile("" : "+v"(l0)); const int hh = blockIdx.x & 15;
      if ((int)blockIdx.x < BATCH * NH * (SEQ / 64)) front_fetch(fin, ws, blockIdx.x, wave * 64 + l0, l0, wave);
      const bf16* W2T = (const bf16*)(ws + WS_WT_W2); const bf16* A2T = (const bf16*)(ws + WS_WT_A2);
#pragma unroll
      for (int ct = 0; ct < 2; ++ct) { w0v[ct] = INP(7)[hh * HD + 32 * ch + 16 * ct + (l0 & 15)]; a0v[ct] = INP(10)[hh * HD + 32 * ch + 16 * ct + (l0 & 15)];
#pragma unroll
          for (int ks = 0; ks < 2; ++ks) { const size_t wr_ = (size_t)(hh * HD + 32 * ch + 16 * ct + (l0 & 15)) * 64 + 32 * ks + 8 * (l0 >> 4); w2f[ks][ct] = *(const GAS bf16x8s*)(W2T + wr_); a2f[ks][ct] = *(const GAS bf16x8s*)(A2T + wr_); } }
      const int tid0 = wave * 64 + l0;
      if (tid0 < 64) { LAS float* P = (LAS float*)(lds + CS_PAR); P[tid0] = INP(15)[hh * HD + tid0]; P[64 + tid0] = INP(16)[hh * HD + tid0]; P[128 + tid0] = INP(17)[hh * HD + tid0]; }
      __syncthreads(); }
    for (int unit = blockIdx.x; unit < BATCH * NH * (SEQ / 64); unit += gridDim.x) {
        int lane = lane0; asm volatile("" : "+v"(lane));
        const int tid = wave * 64 + lane, fr = lane & 15, g = lane >> 4;
        const int h = unit & 15, c = (unit >> 4) & 127, b = unit >> 11; const size_t chunk = ((size_t)b * NH + h) * 128 + c;
        float v8[8]; float rkb;
        chunk_front<1>(fin, lds, w0v, a0v, w2f, a2f, tid, lane, wave, v8, rkb);
        { const size_t row0_ = (size_t)b * SEQ + c * 64; if ((tid & 7) == 0) ((float*)(ws + WS_HID))[(row0_ + (tid >> 3)) * NH + h] = rkb; }
        if (unit + (int)gridDim.x < BATCH * NH * (SEQ / 64)) front_fetch(fin, ws, unit + gridDim.x, tid, lane, wave);
        {
            f32x4 a2[2] = {F4Z, F4Z}, a3[2] = {F4Z, F4Z};
            mm64(a2, TILE(1), TILE(0), rt, ch, fr, g);
            mm64(a3, TILE(2), TILE(0), rt, ch, fr, g);
            f32x4 p1[2];
#pragma unroll
            for (int ct = 0; ct < 2; ++ct) { const int col = 32 * ch + 16 * ct + fr;
#pragma unroll
                for (int q = 0; q < 4; ++q) { const int row = 16 * rt + 4 * g + q;
                    a2[ct][q] = row < col ? a2[ct][q] : 0.f;
                    p1[ct][q] = a2[ct][q] + (row == col ? 1.0f : 0.f);
                    a3[ct][q] = row < col ? a3[ct][q] : 0.f; } }
            st_tr(TILE(5), a2, rt, ch, fr, g);
            st_tr(TILE(9), p1, rt, ch, fr, g);
            st_tr(TILE(4), a3, rt, ch, fr, g);
        }
        lds_barrier();
#pragma unroll
        for (int r = 0; r < 6; ++r) {
            LAS unsigned char* Sr = TILE(5 + 2 * (r & 1)); LAS unsigned char* Sr2 = TILE(5 + 2 * ((r & 1) ^ 1));
            if (r <= 4) { f32x4 q2[2] = {F4Z, F4Z};
                mm64_at(q2, Sr, Sr, rt, ch, fr, g, lane);
                st_tr(Sr2, q2, rt, ch, fr, g); }
            if (r >= 1) { LAS unsigned char* Pr = TILE(9 + ((r - 1) & 1)); LAS unsigned char* Pr2 = TILE(9 + (((r - 1) & 1) ^ 1));
                f32x4 pa[2]; ld_tr(pa, Pr, rt, ch, fr, g);
                mm64_at(pa, Sr, Pr, rt, ch, fr, g, lane);
                st_tr(Pr2, pa, rt, ch, fr, g); }
            if (r == 0) { f32x4 gg[2] = {F4Z, F4Z};
                mm64_bt(gg, TILE(4), TILE(3), rt, ch, fr, g, lane);
                st_tr(TILE(11), gg, rt, ch, fr, g); }
            lds_barrier();
        }
        {
            f32x4 acc[2] = {F4Z, F4Z}, ac2[2] = {F4Z, F4Z};
            mm64_bt(acc, TILE(10), TILE(0), rt, ch, fr, g, lane);
            mm64(ac2, TILE(10), TILE(11), rt, ch, fr, g);
            st_tr(TILE(5), acc, rt, ch, fr, g); st_tr(TILE(7), ac2, rt, ch, fr, g);
            f32x4 b2[2] = {F4Z, F4Z}, b3[2] = {F4Z, F4Z};
            mm64(b2, TILE(1), TILE(6), rt, ch, fr, g); mm64(b3, TILE(2), TILE(6), rt, ch, fr, g);
#pragma unroll
            for (int ct = 0; ct < 2; ++ct) { const int t = 32 * ch + 16 * ct + fr;
#pragma unroll
                for (int q = 0; q < 4; ++q) { const int s_ = 16 * rt + 4 * g + q; b2[ct][q] = s_ <= t ? b2[ct][q] : 0.f; b3[ct][q] = s_ <= t ? b3[ct][q] : 0.f; } }
            st_tr(TILE(4), b2, rt, ch, fr, g); st_tr(TILE(9), b3, rt, ch, fr, g);
        }
        lds_barrier();
        {
            const LAS float* WL = (const LAS float*)(lds + CS_WL);
            f32x4 acc[2] = {F4Z, F4Z};
            mm64_bt(acc, TILE(5), TILE(1), rt, ch, fr, g, lane);
            bf16* Mg = (bf16*)(ws + WS_B0) + chunk * 4096;
#pragma unroll
            for (int ct = 0; ct < 2; ++ct) { const int j1 = 32 * ch + 16 * ct + fr; const float wl = WL[j1];
#pragma unroll
                for (int q = 0; q < 4; ++q) { const int j2 = 16 * rt + 4 * g + q; acc[ct][q] = wl * (acc[ct][q] + (j2 == j1 ? 1.0f : 0.f)); }
                const int rtS = 2 * ch + ct, ksS = rt >> 1, half = rt & 1;
                *(GAS bf16x4s*)(Mg + (((rtS * 2 + ksS) * 64 + g * 16 + fr) * 8 + half * 4)) = pack4(acc[ct]); }
            f32x4 ad[2] = {F4Z, F4Z};
            mm64_at(ad, TILE(1), TILE(7), rt, ch, fr, g, lane);
            mm64_att(ad, TILE(2), TILE(3), rt, ch, lane);
            const f32x4 wl4 = *(const LAS f32x4*)(WL + 16 * rt + 4 * g);
            bf16* Dg = (bf16*)OUTP() + chunk * 4096;
#pragma unroll
            for (int ct = 0; ct < 2; ++ct) *(GAS bf16x4s*)(Dg + (((2 * ch + ct) * 4 + rt) * 64 + lane) * 4) = pack4(ad[ct] * wl4);
            const size_t row0_ = (size_t)b * SEQ + c * 64;
            f32x4 ar[2]; ld_tr(ar, TILE(6), rt, ch, fr, g);
            mm64(ar, TILE(5), TILE(4), rt, ch, fr, g);
            f32x4 ay[2] = {F4Z, F4Z};
            mm64(ay, TILE(7), TILE(4), rt, ch, fr, g); mm64_at(ay, TILE(3), TILE(9), rt, ch, fr, g, lane);
            bf16* Rg = (bf16*)(ws + WS_B1); bf16* Kg = (bf16*)(ws + WS_B2);
#pragma unroll
            for (int ct = 0; ct < 2; ++ct) { const size_t o_ = (row0_ + 32 * ch + 16 * ct + fr) * C + h * HD + 16 * rt + 4 * g; *(GAS bf16x4s*)(Rg + o_) = pack4(ar[ct]); *(GAS bf16x4s*)(Kg + o_) = pack4(ay[ct]); }
        }
        lds_barrier();
    }
}

constexpr int S2_PD = 6;
__device__ __forceinline__ void scan_s2(unsigned char* ws, LAS unsigned char* lds, int lane, int wave) {
    for (int bh = blockIdx.x; bh < BATCH * NH; bh += gridDim.x) {
        const unsigned char* Mg = (const unsigned char*)((const bf16*)(ws + WS_B0) + (size_t)bh * 128 * 4096); const unsigned char* Dg = (const unsigned char*)((const bf16*)OUTP() + (size_t)bh * 128 * 4096);
        bf16* Sg = (bf16*)OUTP() + (size_t)M * C + (size_t)bh * 128 * 4096;
        if (wave >= 4) {
            const int lw = wave - 4;
            const unsigned char* src = (lw < 2 ? Mg + lw * 4096 : Dg + (lw - 2) * 4096) + lane * 16;
            LAS unsigned char* dst = lds + lw * 4096 + lane * 16;
            v4u q[S2_PD][4];
#define S2_LOADQ(j, c) do { _Pragma("unroll") for (int i_ = 0; i_ < 4; ++i_) q[j][i_] = *(const GAS v4u*)(src + (size_t)(c) * 8192 + i_ * 1024); } while (0)
#define S2_STOREQ(j, slot) do { _Pragma("unroll") for (int i_ = 0; i_ < 4; ++i_) *(LAS v4u*)(dst + (slot) * 16384 + i_ * 1024) = q[j][i_]; } while (0)
#pragma unroll
            for (int j = 0; j < S2_PD; ++j) S2_LOADQ(j, j);
            S2_STOREQ(0, 0); S2_LOADQ(0, S2_PD);
            lds_barrier();
#pragma unroll 1
            for (int s0 = 0; s0 < 128; s0 += S2_PD) {
#pragma unroll
                for (int jj = 0; jj < S2_PD; ++jj) { const int step = s0 + jj;
                    if (step + 1 < 128) S2_STOREQ((jj + 1) % S2_PD, (step + 1) & 1);
                    if (step + 1 + S2_PD < 128) S2_LOADQ((jj + 1) % S2_PD, step + 1 + S2_PD);
                    lds_barrier(); }
            }
#undef S2_LOADQ
#undef S2_STOREQ
        } else {
            const int ct = wave;
            f32x4 acc[4];
#pragma unroll
            for (int r = 0; r < 4; ++r) acc[r] = F4Z;
            lds_barrier();
#pragma unroll 1
            for (int s0 = 0; s0 < 128; s0 += S2_PD) {
#pragma unroll
                for (int jj = 0; jj < S2_PD; ++jj) { const int step = s0 + jj;
                    if (step < 128) {
                        const LAS unsigned char* slot = lds + (step & 1) * 16384;
                        bf16x8s sf[2];
#pragma unroll
                        for (int ks = 0; ks < 2; ++ks) { const bf16x4s lo = pack4(acc[2 * ks]), hi = pack4(acc[2 * ks + 1]); sf[ks] = (bf16x8s){lo[0], lo[1], lo[2], lo[3], hi[0], hi[1], hi[2], hi[3]}; }
#pragma unroll
                        for (int ks = 0; ks < 2; ++ks) *(GAS bf16x8s*)(Sg + (size_t)step * 4096 + ((ct * 2 + ks) * 64 + lane) * 8) = sf[ks];
                        f32x4 na[4];
#pragma unroll
                        for (int r = 0; r < 4; ++r) na[r] = unpack4(*(const LAS bf16x4s*)(slot + 8192 + ((ct * 4 + r) * 64 + lane) * 8));
#pragma unroll
                        for (int ks = 0; ks < 2; ++ks)
#pragma unroll
                            for (int r = 0; r < 4; ++r) na[r] = MFMA16(*(const LAS bf16x8s*)(slot + ((r * 2 + ks) * 64 + lane) * 16), sf[ks], na[r]);
#pragma unroll
                        for (int r = 0; r < 4; ++r) acc[r] = na[r];
                    }
                    lds_barrier(); }
            }
        }
    }
}

constexpr int S3_RT = 32768, S3_YT = S3_RT + TILE_B, S3_LG = S3_YT + TILE_B, S3_LGP = 336;
struct S3In { v4u rr, yy, vv, lg[3]; bf16x8s sA[2]; float rkb; };
__device__ __forceinline__ void s3_fetch(S3In& f, unsigned char* ws, int unit, int tid, int lane, int wave) {
    const int h = unit & 15, c = (unit >> 4) & 127, b = unit >> 11; const size_t chunk = ((size_t)b * NH + h) * 128 + c, row0 = (size_t)b * SEQ + c * 64;
    const int rt = wave & 3, et = tid >> 3, ecq = tid & 7;
    const bf16* Rg = (const bf16*)(ws + WS_B1); const bf16* Kg = (const bf16*)(ws + WS_B2); const bf16* Vb = (const bf16*)(ws + WS_B3); const bf16* LG = (const bf16*)(ws + WS_LG);
    const bf16* Sg = (const bf16*)OUTP() + (size_t)M * C + chunk * 4096;
    const size_t o_ = (row0 + et) * C + h * HD + ecq * 8;
    f.rr = *(const GAS v4u*)(Rg + o_); f.yy = *(const GAS v4u*)(Kg + o_); f.vv = *(const GAS v4u*)(Vb + o_);
#pragma unroll
    for (int i = 0; i < 3; ++i) { const int chn = tid + 512 * i; if (chn < 64 * 20) f.lg[i] = *(const GAS v4u*)(LG + (row0 + chn / 20) * DG + (chn % 20) * 8); }
#pragma unroll
    for (int ks = 0; ks < 2; ++ks) f.sA[ks] = *(const GAS bf16x8s*)(Sg + ((rt * 2 + ks) * 64 + lane) * 8);
    f.rkb = ((const float*)(ws + WS_HID))[(row0 + et) * NH + h];
}
__device__ __forceinline__ void scan_s3(unsigned char* ws, LAS unsigned char* lds, int lane0, int wave) {
    const int rt = wave & 3, ch = wave >> 2;
    LAS float* Ys = (LAS float*)(lds + CS_FA);
    const bf16* G2T = (const bf16*)(ws + WS_WT_G2); bf16* YG = (bf16*)(ws + WS_B0);
    constexpr int NU = BATCH * NH * (SEQ / 64);
    S3In fin; bf16x8s gA[5]; f32x4 lnw0, lnw1, lnb0, lnb1;
    { int l0 = lane0; asm volatile("" : "+v"(l0)); const int hh = blockIdx.x & 15, t0_ = wave * 64 + l0;
      if ((int)blockIdx.x < NU) s3_fetch(fin, ws, blockIdx.x, t0_, l0, wave);
#pragma unroll
      for (int ks = 0; ks < 5; ++ks) gA[ks] = *(const GAS bf16x8s*)(G2T + (size_t)(hh * HD + 16 * rt + (l0 & 15)) * DG + 32 * ks + 8 * (l0 >> 4));
      const int ec0 = hh * HD + (t0_ & 7) * 8;
      lnw0 = *(const GAS f32x4*)(INP(18) + ec0); lnw1 = *(const GAS f32x4*)(INP(18) + ec0 + 4); lnb0 = *(const GAS f32x4*)(INP(19) + ec0); lnb1 = *(const GAS f32x4*)(INP(19) + ec0 + 4); }
    __syncthreads();
    for (int unit = blockIdx.x; unit < NU; unit += gridDim.x) {
        int lane = lane0; asm volatile("" : "+v"(lane));
        const int tid = wave * 64 + lane, fr = lane & 15, g = lane >> 4, et = tid >> 3, ecq = tid & 7;
        const int h = unit & 15, c = (unit >> 4) & 127, b = unit >> 11; const size_t row0 = (size_t)b * SEQ + c * 64;
        *(LAS v4u*)(lds + S3_RT + et * TPB + ecq * 16) = fin.rr; *(LAS v4u*)(lds + S3_YT + et * TPB + ecq * 16) = fin.yy;
#pragma unroll
        for (int i = 0; i < 3; ++i) { const int chn = tid + 512 * i; if (chn < 64 * 20) *(LAS v4u*)(lds + S3_LG + (chn / 20) * S3_LGP + (chn % 20) * 16) = fin.lg[i]; }
        float v8[8]; unpack8(fin.vv, v8); const float rkb = fin.rkb; const bf16x8s sA0 = fin.sA[0], sA1 = fin.sA[1];
        lds_barrier();
        if (unit + (int)gridDim.x < NU) s3_fetch(fin, ws, unit + gridDim.x, tid, lane, wave);
        f32x4 acc[2], ag[2] = {F4Z, F4Z};
#pragma unroll
        for (int ct = 0; ct < 2; ++ct) { const int t = 32 * ch + 16 * ct + fr;
            acc[ct] = unpack4(*(const LAS bf16x4s*)(lds + S3_YT + t * TPB + (16 * rt + 4 * g) * 2));
            acc[ct] = MFMA16(sA0, ldfrag_perm(lds + S3_RT, t, 0, g), acc[ct]); acc[ct] = MFMA16(sA1, ldfrag_perm(lds + S3_RT, t, 1, g), acc[ct]);
#pragma unroll
            for (int ks = 0; ks < 5; ++ks) ag[ct] = MFMA16(gA[ks], *(const LAS bf16x8s*)(lds + S3_LG + t * S3_LGP + (32 * ks + 8 * g) * 2), ag[ct]);
            *(LAS f32x4*)(Ys + t * FP + 16 * rt + 4 * g) = acc[ct]; }
        lds_barrier();
        {
            const f32x4 y0 = *(const LAS f32x4*)(Ys + et * FP + ecq * 8), y1 = *(const LAS f32x4*)(Ys + et * FP + ecq * 8 + 4);
            float y[8] = {y0[0], y0[1], y0[2], y0[3], y1[0], y1[1], y1[2], y1[3]};
            float s_ = 0.f;
#pragma unroll
            for (int q = 0; q < 8; ++q) s_ += y[q];
            s_ = sum8(s_);
            const float mu = s_ * (1.0f / HD); float vs = 0.f;
#pragma unroll
            for (int q = 0; q < 8; ++q) { y[q] -= mu; vs += y[q] * y[q]; }
            vs = sum8(vs);
            const float rstd = 1.0f / sqrtf(vs * (1.0f / HD) + GN_EPS);
            f32x4 o0, o1;
#pragma unroll
            for (int q = 0; q < 4; ++q) { o0[q] = y[q] * rstd * lnw0[q] + lnb0[q] + rkb * v8[q]; o1[q] = y[4 + q] * rstd * lnw1[q] + lnb1[q] + rkb * v8[4 + q]; }
            *(LAS f32x4*)(Ys + et * FP + ecq * 8) = o0; *(LAS f32x4*)(Ys + et * FP + ecq * 8 + 4) = o1;
        }
        lds_barrier();
#pragma unroll
        for (int ct = 0; ct < 2; ++ct) { const int t = 32 * ch + 16 * ct + fr; const f32x4 yv = *(const LAS f32x4*)(Ys + t * FP + 16 * rt + 4 * g);
            *(GAS bf16x4s*)(YG + (row0 + t) * C + h * HD + 16 * rt + 4 * g) = pack4(yv * ag[ct]); }
    }
    __syncthreads();
}
#undef TILE
#if MK_DEBUG
__device__ __forceinline__ void scan_naive(unsigned char* ws, LAS unsigned char* lds, int tid) {
    const int lane = tid & 63;
    const bf16* Rb = (const bf16*)(ws + WS_B1); const bf16* Kb = (const bf16*)(ws + WS_B2); const bf16* Vb = (const bf16*)(ws + WS_B3);
    const bf16* LW = (const bf16*)(ws + WS_LW); const bf16* LA = (const bf16*)(ws + WS_LA);
    float* Y = OUTP(); float* RK = (float*)(ws + WS_HID);
    LAS float* sR = (LAS float*)lds; LAS float* sK = sR + 4096; LAS float* sV = sK + 4096; LAS float* sA = sV + 4096; LAS float* sB = sA + 4096; LAS float* sD = sB + 4096;
    LAS float* sW2 = sD + 4096; LAS float* sA2 = sW2 + 4096;
    for (int unit = blockIdx.x; unit < BATCH * NH; unit += gridDim.x) {
        const int b = unit / NH, h = unit % NH;
        __syncthreads();
        for (int e = tid; e < 4096; e += 512) { const int d = e >> 6, j = e & 63; sW2[e] = INP(9)[(size_t)d * C + h * HD + j]; sA2[e] = INP(12)[(size_t)d * C + h * HD + j]; }
        __syncthreads();
        const int pt = tid >> 3, cq = tid & 7, c0 = h * HD + cq * 8;
        const int si = tid >> 3, jq = tid & 7;
        float S[8];
#pragma unroll
        for (int q = 0; q < 8; ++q) S[q] = 0.f;
        float w0v[8], a0v[8], kkv[8], kav[8], rkv[8];
#pragma unroll
        for (int q = 0; q < 8; ++q) { w0v[q] = INP(7)[c0 + q]; a0v[q] = INP(10)[c0 + q]; kkv[q] = INP(15)[c0 + q]; kav[q] = INP(16)[c0 + q]; rkv[q] = INP(17)[c0 + q]; }
        for (int blk = 0; blk < SEQ / 64; ++blk) {
            const size_t row = (size_t)b * SEQ + blk * 64 + pt;
            {
                const v4u r4 = *(const GAS v4u*)(Rb + row * C + c0), k4 = *(const GAS v4u*)(Kb + row * C + c0), v4 = *(const GAS v4u*)(Vb + row * C + c0);
                float r[8], k[8], v[8];
                r[0] = bflo(r4.x); r[1] = bfhi(r4.x); r[2] = bflo(r4.y); r[3] = bfhi(r4.y); r[4] = bflo(r4.z); r[5] = bfhi(r4.z); r[6] = bflo(r4.w); r[7] = bfhi(r4.w);
                k[0] = bflo(k4.x); k[1] = bfhi(k4.x); k[2] = bflo(k4.y); k[3] = bfhi(k4.y); k[4] = bflo(k4.z); k[5] = bfhi(k4.z); k[6] = bflo(k4.w); k[7] = bfhi(k4.w);
                v[0] = bflo(v4.x); v[1] = bfhi(v4.x); v[2] = bflo(v4.y); v[3] = bfhi(v4.y); v[4] = bflo(v4.z); v[5] = bfhi(v4.z); v[6] = bflo(v4.w); v[7] = bfhi(v4.w);
                float wp[8], ap[8];
#pragma unroll
                for (int q = 0; q < 8; ++q) { wp[q] = w0v[q]; ap[q] = a0v[q]; }
                for (int d = 0; d < 64; ++d) { const float lw = bf2f(LW[row * DW + d]), la = bf2f(LA[row * DA + d]);
#pragma unroll
                    for (int q = 0; q < 8; ++q) { wp[q] += lw * sW2[d * 64 + cq * 8 + q]; ap[q] += la * sA2[d * 64 + cq * 8 + q]; } }
                float kk[8], ss = 0.f, rks = 0.f;
#pragma unroll
                for (int q = 0; q < 8; ++q) { kk[q] = k[q] * kkv[q]; ss += kk[q] * kk[q]; }
                ss = sum8(ss);
                const float inv = 1.0f / fmaxf(sqrtf(ss), 1e-12f);
#pragma unroll
                for (int q = 0; q < 8; ++q) { const float ag = sigmoidf_(ap[q]); const float kn = kk[q] * inv; const float kp = k[q] * (1.0f + (ag - 1.0f) * kav[q]);
                    const float lw = -0.6065306597126334f * sigmoidf_(wp[q]);
                    const int o = pt * 64 + cq * 8 + q;
                    sR[o] = r[q]; sK[o] = kp; sV[o] = v[q]; sA[o] = -kn; sB[o] = kn * ag; sD[o] = __expf(lw); rks += r[q] * kp * rkv[q]; }
                rks = sum8(rks);
                if (cq == 0) RK[row * NH + h] = rks;
            }
            __syncthreads();
            for (int t = 0; t < 64; ++t) {
                const LAS f32x4* pa = (const LAS f32x4*)(sA + t * 64 + jq * 8); const LAS f32x4* pb = (const LAS f32x4*)(sB + t * 64 + jq * 8);
                const LAS f32x4* pd = (const LAS f32x4*)(sD + t * 64 + jq * 8); const LAS f32x4* pk = (const LAS f32x4*)(sK + t * 64 + jq * 8);
                const LAS f32x4* pr = (const LAS f32x4*)(sR + t * 64 + jq * 8);
                const f32x4 a0 = pa[0], a1 = pa[1], b0 = pb[0], b1 = pb[1], d0 = pd[0], d1 = pd[1], k0 = pk[0], k1 = pk[1], r0 = pr[0], r1 = pr[1];
                const float vi = sV[t * 64 + si];
                float sa = 0.f;
#pragma unroll
                for (int q = 0; q < 4; ++q) { sa += S[q] * a0[q]; sa += S[4 + q] * a1[q]; }
                sa = sum8(sa);
                float y = 0.f;
#pragma unroll
                for (int q = 0; q < 4; ++q) { S[q] = S[q] * d0[q] + sa * b0[q] + vi * k0[q]; S[4 + q] = S[4 + q] * d1[q] + sa * b1[q] + vi * k1[q]; y += S[q] * r0[q]; y += S[4 + q] * r1[q]; }
                y = sum8(y);
                if (jq == 0) Y[((size_t)b * SEQ + blk * 64 + t) * C + h * HD + si] = y;
            }
            __syncthreads();
        }
    }
}
__device__ __forceinline__ void post_scan(unsigned char* ws, int gw, int NGW, int lane) {
    const float* Y = OUTP(); const float* RK = (const float*)(ws + WS_HID); const bf16* Vb = (const bf16*)(ws + WS_B3); const bf16* LG = (const bf16*)(ws + WS_LG);
    bf16* YG = (bf16*)(ws + WS_B4); const float* g2 = INP(14); const float* lnw = INP(18); const float* lnb = INP(19);
    for (int it = gw; it < M * NH; it += NGW) {
        const int row = it / NH, h = it % NH, c = h * HD + lane;
        const float y = Y[(size_t)row * C + c];
        const float mu = wave_sum(y, lane) * (1.0f / HD); const float d = y - mu; const float var = wave_sum(d * d, lane) * (1.0f / HD);
        float o = d * (1.0f / sqrtf(var + GN_EPS)) * lnw[c] + lnb[c];
        o += RK[(size_t)row * NH + h] * bf2f(Vb[(size_t)row * C + c]);
        float g = 0.f;
        for (int dd = 0; dd < DG; ++dd) g += bf2f(LG[(size_t)row * DG + dd]) * g2[(size_t)dd * C + c];
        YG[(size_t)row * C + c] = (bf16)f2bf(o * g);
    }
}


constexpr int CW_DBG = 3200;
__device__ __forceinline__ void dbg_nonfinite(unsigned char* ws, const bf16* X, size_t n, int slot, int gw, int NGW, int lane, float thr = 1e30f) {
    unsigned* cw = (unsigned*)(ws + WS_CTL) + CW_DBG + 64 * slot; unsigned nnan = 0;
    for (size_t i = (size_t)gw * 64 + lane; i < n; i += (size_t)NGW * 64) { const float x = bf2f(X[i]); if (!(fabsf(x) < thr)) ++nnan; }
    if (nnan) atomicAdd(cw, nnan);
}
__device__ __forceinline__ void dbg_compare(unsigned char* ws, const bf16* X, const bf16* Y, int gw, int NGW, int lane) {
    unsigned* cw = (unsigned*)(ws + WS_CTL) + CW_DBG; unsigned nbad = 0, nnan = 0;
    for (size_t i = (size_t)gw * 64 + lane; i < (size_t)M * C; i += (size_t)NGW * 64) { const float x = bf2f(X[i]), y = bf2f(Y[i]);
        if (!(fabsf(x) < 1e30f)) ++nnan; else if (fabsf(x - y) > 0.05f * (fabsf(y) + 0.05f)) ++nbad; }
    if (nnan) atomicAdd(cw, nnan); if (nbad) atomicAdd(cw + 64, nbad);
}
#endif
__device__ __forceinline__ void router_rows(unsigned char* ws, LAS unsigned char* lds, int layer, int gw, int NGW, int lane, int tid, int wv, bool dry = false) {
    const bf16* Hh = (const bf16*)(ws + WS_B4); const float* gain = INP(2) + layer * C; float* rsl = (float*)(ws + WS_B0);
    const float* wg = INP(24) + (size_t)layer * C * 4; const float* bg = INP(25) + layer * 4; const float* wi = INP(26) + (size_t)layer * C * 16; const float* bi = INP(27) + layer * 16;
    unsigned* cnt = (unsigned*)(ws + WS_CTL) + CW_CNT + layer * 16 * 64; unsigned* list = (unsigned*)(ws + WS_LIST); float* wl = (float*)(ws + WS_WL);
    LAS float* sWg = (LAS float*)lds; LAS float* sWi = sWg + C * 4;
    constexpr int RECMAX = 256;
    LAS unsigned* lcnt = (LAS unsigned*)(lds + 81920); LAS unsigned* gbase = lcnt + 16; LAS float* sBias = (LAS float*)(lcnt + 32);
    LAS unsigned* recRow = lcnt + 64; LAS unsigned* recE = recRow + RECMAX; LAS unsigned* recL = recE + RECMAX; LAS float* recW0 = (LAS float*)(recL + RECMAX); LAS float* recW1 = recW0 + RECMAX; LAS float* recRS = recW1 + RECMAX;
    __syncthreads();
    for (int e = tid; e < C; e += 512) { const int r = e >> 6, c = 256 * (r >> 2) + 4 * (e & 63) + (r & 3); ((LAS f32x4*)sWg)[e] = ((const GAS f32x4*)wg)[c]; }
    for (int e = tid; e < C * 4; e += 512) { const int r = e >> 6, jq = r >> 2, c = 256 * (jq >> 2) + 4 * (e & 63) + (jq & 3); ((LAS f32x4*)sWi)[e] = ((const GAS f32x4*)wi)[c * 4 + (r & 3)]; }
    if (tid < 4) sBias[tid] = bg[tid]; else if (tid < 20) sBias[tid] = bi[tid - 4];
    for (int e = tid; e < RECMAX; e += 512) recE[e] = 0xffffffffu;
    __syncthreads();
    f32x4 g[4]; load_row(gain, lane, g);
    v2u nxr[2][4];
#pragma unroll
    for (int r = 0; r < 2; ++r) { const int r0 = gw + r * NGW < M - 1 ? gw + r * NGW : M - 1;
#pragma unroll
        for (int j = 0; j < 4; ++j) nxr[r][j] = ((const GAS v2u*)(Hh + (size_t)r0 * C))[64 * j + lane]; }
    int k = 0;
    for (int row = gw; row < M; row += 2 * NGW, k += 2) {
        f32x4 v[2][4];
#pragma unroll
        for (int r = 0; r < 2; ++r)
#pragma unroll
            for (int j = 0; j < 4; ++j) v[r][j] = (f32x4){bflo(nxr[r][j].x), bfhi(nxr[r][j].x), bflo(nxr[r][j].y), bfhi(nxr[r][j].y)};
#pragma unroll
        for (int r = 0; r < 2; ++r) { const int rn = row + (2 + r) * NGW, r0 = rn < M - 1 ? rn : M - 1;
#pragma unroll
            for (int j = 0; j < 4; ++j) nxr[r][j] = ((const GAS v2u*)(Hh + (size_t)r0 * C))[64 * j + lane]; }
        float rs[2];
#pragma unroll
        for (int r = 0; r < 2; ++r) { rs[r] = row_rs(v[r], lane);
#pragma unroll
            for (int j = 0; j < 4; ++j) v[r][j] = v[r][j] * rs[r] * g[j]; }
        float gl[2][4] = {{0.f, 0.f, 0.f, 0.f}, {0.f, 0.f, 0.f, 0.f}};
        const LAS unsigned char* pWg = (const LAS unsigned char*)sWg + lane * 16;
#pragma unroll
        for (int j = 0; j < 4; ++j)
#pragma unroll
            for (int q = 0; q < 4; ++q) { const f32x4 w = *(const LAS f32x4*)(pWg + (j * 4 + q) * 1024);
#pragma unroll
                for (int r = 0; r < 2; ++r) { const float xv = v[r][j][q]; gl[r][0] += xv * w.x; gl[r][1] += xv * w.y; gl[r][2] += xv * w.z; gl[r][3] += xv * w.w; } }
        int gi[2]; float gval[2];
#pragma unroll
        for (int r = 0; r < 2; ++r) {
#pragma unroll
            for (int q = 0; q < 4; ++q) gl[r][q] = wave_sum(gl[r][q], lane) + sBias[q];
            gi[r] = 0; float gm = gl[r][0];
#pragma unroll
            for (int q = 1; q < 4; ++q) if (gl[r][q] > gm) { gm = gl[r][q]; gi[r] = q; }
            float gden = 0.f;
#pragma unroll
            for (int q = 0; q < 4; ++q) gden += __expf(gl[r][q] - gm);
            gval[r] = 1.0f / gden; }
        float il[2][4] = {{0.f, 0.f, 0.f, 0.f}, {0.f, 0.f, 0.f, 0.f}};
        const LAS unsigned char* pWi0 = (const LAS unsigned char*)sWi + lane * 16 + gi[0] * 1024;
        const LAS unsigned char* pWi1 = (const LAS unsigned char*)sWi + lane * 16 + gi[1] * 1024;
#pragma unroll
        for (int j = 0; j < 4; ++j)
#pragma unroll
            for (int q = 0; q < 4; ++q) {
                { const f32x4 w = *(const LAS f32x4*)(pWi0 + (j * 4 + q) * 4096); const float xv = v[0][j][q]; il[0][0] += xv * w.x; il[0][1] += xv * w.y; il[0][2] += xv * w.z; il[0][3] += xv * w.w; }
                { const f32x4 w = *(const LAS f32x4*)(pWi1 + (j * 4 + q) * 4096); const float xv = v[1][j][q]; il[1][0] += xv * w.x; il[1][1] += xv * w.y; il[1][2] += xv * w.z; il[1][3] += xv * w.w; } }
#pragma unroll
        for (int r = 0; r < 2; ++r) {
            const f32x4 bi4 = *(const LAS f32x4*)(sBias + 4 + gi[r] * 4);
#pragma unroll
            for (int q = 0; q < 4; ++q) il[r][q] = wave_sum(il[r][q], lane) + bi4[q];
            int i0 = 0; float m0 = il[r][0];
#pragma unroll
            for (int q = 1; q < 4; ++q) if (il[r][q] > m0) { m0 = il[r][q]; i0 = q; }
            int i1 = -1; float m1 = -INFINITY;
#pragma unroll
            for (int q = 0; q < 4; ++q) if (q != i0 && il[r][q] > m1) { m1 = il[r][q]; i1 = q; }
            const float e1 = __expf(m1 - m0); const float w0 = gval[r] / (1.0f + e1), w1 = gval[r] * e1 / (1.0f + e1);
            const int ri = wv * 32 + k + r;
            if (lane == 0 && !dry && k + r < 32 && row + r * NGW < M) { const int ex0 = gi[r] * 4 + i0, ex1 = gi[r] * 4 + i1;
                recRow[ri] = (unsigned)(row + r * NGW); recE[ri] = (unsigned)ex0 | ((unsigned)ex1 << 8); recW0[ri] = w0; recW1[ri] = w1; recRS[ri] = rs[r]; }
        }
    }
    __syncthreads();
    unsigned e = 0xffffffffu; if (tid < RECMAX) e = recE[tid];
    const unsigned ex0 = e & 255u, ex1 = (e >> 8) & 255u;
    unsigned pos0 = 0u, pos1 = 0u;
    if (wv < RECMAX / 64) {
#pragma unroll
        for (unsigned x = 0; x < 16; ++x) { const unsigned long long m0 = __ballot(ex0 == x), m1 = __ballot(ex1 == x);
            const unsigned p = __builtin_amdgcn_mbcnt_hi((unsigned)(m0 >> 32), __builtin_amdgcn_mbcnt_lo((unsigned)m0, 0u)) + __builtin_amdgcn_mbcnt_hi((unsigned)(m1 >> 32), __builtin_amdgcn_mbcnt_lo((unsigned)m1, 0u));
            if (ex0 == x) pos0 = p; if (ex1 == x) pos1 = p;
            if (lane == 0) recL[wv * 16 + x] = (unsigned)(__popcll(m0) + __popcll(m1)); } }
    __syncthreads();
    if (tid < 16 && !dry) { unsigned c_ = 0u;
#pragma unroll
        for (int q = 0; q < RECMAX / 64; ++q) c_ += recL[q * 16 + tid];
        gbase[tid] = atomicAdd(cnt + tid * 64, c_); }
    __syncthreads();
    if (e != 0xffffffffu && !dry) { unsigned p0 = gbase[ex0] + pos0, p1 = gbase[ex1] + pos1;
        for (int q = 0; q < wv; ++q) { p0 += recL[q * 16 + ex0]; p1 += recL[q * 16 + ex1]; }
        const unsigned row = recRow[tid]; const float rs = recRS[tid];
        list[(size_t)ex0 * M + p0] = row * 2u; wl[(size_t)ex0 * M + p0] = recW0[tid]; list[(size_t)ex1 * M + p1] = row * 2u + 1u; wl[(size_t)ex1 * M + p1] = recW1[tid];
        rsl[(size_t)ex0 * M + p0] = rs; rsl[(size_t)ex1 * M + p1] = rs; }
}
__device__ __forceinline__ void moe_table(unsigned char* ws, volatile LAS int* tab, int layer, int tid) {
    __syncthreads();
    if (tid == 0) { const unsigned* cnt = (const unsigned*)(ws + WS_CTL) + CW_CNT + layer * 16 * 64; int t = 0;
#pragma unroll 1
        for (int e = 0; e < 16; ++e) { const int c = (int)__hip_atomic_load(cnt, RLX_AGENT); cnt += 64; tab[e] = c; tab[16 + e] = t; t += (c + 255) >> 8; tab[32 + e] = t; }
        tab[48] = t; }
    __syncthreads();
}
__device__ __forceinline__ void combine_rows(unsigned char* ws, int mode, int gw, int NGW, int lane, bool dry = false) {
    bf16* Hh = (bf16*)(ws + WS_B4); float* Out = OUTP(); const bf16* E0 = (const bf16*)(ws + WS_B2); const bf16* E1 = (const bf16*)(ws + WS_B3); bf16* XN2 = (bf16*)(ws + WS_B0);
    f32x4 g[4]; load_row(INP(4), lane, g);
    for (int row = gw; row < M; row += NGW) {
        f32x4 v[4]; load_row_bf(Hh + (size_t)row * C, lane, v);
#pragma unroll
        for (int j = 0; j < 4; ++j) { const v2u e0 = ((const GAS v2u*)(E0 + (size_t)row * C))[64 * j + lane], e1 = ((const GAS v2u*)(E1 + (size_t)row * C))[64 * j + lane];
            v[j].x += bflo(e0.x) + bflo(e1.x); v[j].y += bfhi(e0.x) + bfhi(e1.x); v[j].z += bflo(e0.y) + bflo(e1.y); v[j].w += bfhi(e0.y) + bfhi(e1.y); }
        const float rs = row_rs(v, lane);
        if (mode == 0) {
            if (!dry) store_row_bf16(Hh + (size_t)row * C, lane, v);
            if (lane == 0) ((float*)XN2)[row] = rs;
        } else {
            float sig = 1.0f;
#if MK_DEBUG
            const unsigned* cw = (const unsigned*)(ws + WS_CTL) + CW_DBG; const unsigned nnan = __hip_atomic_load(cw, RLX_AGENT), nbad = __hip_atomic_load(cw + 64, RLX_AGENT);
            if (row < 512 && nnan > 0) sig = 2.0f;
            if (row >= 512 && row < 1536 && __hip_atomic_load(cw + 128, RLX_AGENT) > 0) sig = 2.0f;
            if (row >= 1536 && row < 3584 && __hip_atomic_load(cw + 192, RLX_AGENT) > 0) sig = 2.0f;
            if (row >= 3584 && row < 7680 && __hip_atomic_load(cw + 256, RLX_AGENT) > 0) sig = 2.0f;
            if (row >= 7680 && row < 15872 && __hip_atomic_load(cw + 320, RLX_AGENT) > 0) sig = 2.0f;
            if (row >= 15872 && nbad > (unsigned)(M / 100) * C) sig = 1.5f;
#endif
#pragma unroll
            for (int j = 0; j < 4; ++j) ((GAS f32x4*)(Out + (size_t)row * C))[64 * j + lane] = v[j] * rs * g[j] * sig;
        }
    }
}
__device__ __forceinline__ void attn_naive(unsigned char* ws, int gw, int NGW, int lane) {
    const bf16* Kb = (const bf16*)(ws + WS_B1); const bf16* Vb = (const bf16*)(ws + WS_B2); const bf16* Qb = (const bf16*)(ws + WS_B3); bf16* Ob = (bf16*)(ws + WS_B0);
    for (int unit = gw; unit < BATCH * NH * (SEQ / 64); unit += NGW) {
        const int qb = unit % (SEQ / 64), bh = unit / (SEQ / 64), b = bh / NH, h = bh % NH;
        const int t0 = qb * 64, t = t0 + lane; const size_t rowq = (size_t)b * SEQ + t;
        float q[64], o[64];
#pragma unroll
        for (int c = 0; c < 8; ++c) { const v4u w = *(const GAS v4u*)(Qb + rowq * C + h * HD + c * 8);
            q[c * 8 + 0] = bflo(w.x) * 0.125f; q[c * 8 + 1] = bfhi(w.x) * 0.125f; q[c * 8 + 2] = bflo(w.y) * 0.125f; q[c * 8 + 3] = bfhi(w.y) * 0.125f;
            q[c * 8 + 4] = bflo(w.z) * 0.125f; q[c * 8 + 5] = bfhi(w.z) * 0.125f; q[c * 8 + 6] = bflo(w.w) * 0.125f; q[c * 8 + 7] = bfhi(w.w) * 0.125f; }
#pragma unroll
        for (int c = 0; c < 64; ++c) o[c] = 0.f;
        float suffix = 0.f;
        for (int s = t0 + 62; s >= 0; --s) {
            const bool valid = s < t;
            if (s < t0 && __all(suffix > SB_EXIT)) break;
            const bf16* kp = Kb + ((size_t)b * SEQ + s) * C + h * HD; const bf16* vp = Vb + ((size_t)b * SEQ + s) * C + h * HD;
            float z = 0.f;
#pragma unroll
            for (int c = 0; c < 8; ++c) { const v4u w = *(const GAS v4u*)(kp + c * 8);
                z += q[c * 8 + 0] * bflo(w.x) + q[c * 8 + 1] * bfhi(w.x) + q[c * 8 + 2] * bflo(w.y) + q[c * 8 + 3] * bfhi(w.y) + q[c * 8 + 4] * bflo(w.z) + q[c * 8 + 5] * bfhi(w.z) + q[c * 8 + 6] * bflo(w.w) + q[c * 8 + 7] * bfhi(w.w); }
            const float sp = fmaxf(z, 0.f) + log1pf(__expf(-fabsf(z)));
            const float att = valid ? __expf(z - sp - suffix) : 0.f;
            suffix += valid ? sp : 0.f;
#pragma unroll
            for (int c = 0; c < 8; ++c) { const v4u w = *(const GAS v4u*)(vp + c * 8);
                o[c * 8 + 0] += att * bflo(w.x); o[c * 8 + 1] += att * bfhi(w.x); o[c * 8 + 2] += att * bflo(w.y); o[c * 8 + 3] += att * bfhi(w.y);
                o[c * 8 + 4] += att * bflo(w.z); o[c * 8 + 5] += att * bfhi(w.z); o[c * 8 + 6] += att * bflo(w.w); o[c * 8 + 7] += att * bfhi(w.w); }
        }
#pragma unroll
        for (int c = 0; c < 8; ++c) { v4u w; w.x = pk2(o[c * 8 + 0], o[c * 8 + 1]); w.y = pk2(o[c * 8 + 2], o[c * 8 + 3]); w.z = pk2(o[c * 8 + 4], o[c * 8 + 5]); w.w = pk2(o[c * 8 + 6], o[c * 8 + 7]);
            *(GAS v4u*)(Ob + rowq * C + h * HD + c * 8) = w; }
    }
}


typedef float f32x16 __attribute__((ext_vector_type(16)));
constexpr int AT_VP = 192;
constexpr int AT_WAVE_LDS = 32 * AT_VP;
__device__ __forceinline__ int crow32(int reg, int hh) { return (reg & 3) + 8 * (reg >> 2) + 4 * hh; }
__device__ __forceinline__ bf16x8s pack_step(const f32x16& x, const int s) {
    v4u p; p.x = pg8::cvt_pk_bf16(x[8 * s], x[8 * s + 1]); p.y = pg8::cvt_pk_bf16(x[8 * s + 2], x[8 * s + 3]); p.z = pg8::cvt_pk_bf16(x[8 * s + 4], x[8 * s + 5]); p.w = pg8::cvt_pk_bf16(x[8 * s + 6], x[8 * s + 7]);
    return __builtin_bit_cast(bf16x8s, p);
}
__device__ __forceinline__ void attn_mfma(unsigned char* ws, LAS unsigned char* lds, int gw, int NGW, int lane, int wave) {
    const bf16* Kb = (const bf16*)(ws + WS_B1); const bf16* Vb = (const bf16*)(ws + WS_B2); const bf16* Qb = (const bf16*)(ws + WS_B3); bf16* Ob = (bf16*)(ws + WS_B0);
    LAS unsigned char* vl = lds + wave * AT_WAVE_LDS;
    const int r32 = lane & 31, hh = lane >> 5;
    bf16x8s tri[2];
#pragma unroll
    for (int s = 0; s < 2; ++s)
#pragma unroll
        for (int j = 0; j < 8; ++j) tri[s][j] = (16 * s + 8 * (j >> 2) + 4 * hh + (j & 3)) > r32 ? (short)0x3F80 : (short)0;
    const int grp = lane >> 4, tq = (lane & 15) >> 2, tp = lane & 3;
    const LAS unsigned char* vtr0 = vl + (4 * hh + tq) * AT_VP + (16 * (grp & 1) + 4 * tp) * 2;
    for (int unit = gw; unit < BATCH * NH * (SEQ / 32); unit += NGW) {
        const int qb = unit % (SEQ / 32), bh = unit / (SEQ / 32), b = bh / NH, hd = bh % NH;
        const int t0 = qb * 32; const size_t rowb = (size_t)b * SEQ;
        bf16x8s qf[4];
#pragma unroll
        for (int ks = 0; ks < 4; ++ks) qf[ks] = *(const GAS bf16x8s*)(Qb + (rowb + t0 + r32) * C + hd * HD + 16 * ks + 8 * hh);
        f32x16 o[2];
#pragma unroll
        for (int i = 0; i < 16; ++i) { o[0][i] = 0.f; o[1][i] = 0.f; }
        float carry = 0.f;
        for (int s0 = t0; s0 >= 0; s0 -= 32) {
            bf16x8s kf[4];
#pragma unroll
            for (int ks = 0; ks < 4; ++ks) kf[ks] = *(const GAS bf16x8s*)(Kb + (rowb + s0 + r32) * C + hd * HD + 16 * ks + 8 * hh);
            v4u vreg[4];
#pragma unroll
            for (int i = 0; i < 4; ++i) { const int cidx = lane + 64 * i; vreg[i] = *(const GAS v4u*)(Vb + (rowb + s0 + (cidx >> 3)) * C + hd * HD + (cidx & 7) * 8); }
            f32x16 st;
#pragma unroll
            for (int i = 0; i < 16; ++i) st[i] = 0.f;
#pragma unroll
            for (int ks = 0; ks < 4; ++ks) st = __builtin_amdgcn_mfma_f32_32x32x16_bf16(kf[ks], qf[ks], st, 0, 0, 0);
#pragma unroll
            for (int i = 0; i < 4; ++i) { const int cidx = lane + 64 * i; *(LAS v4u*)(vl + (cidx >> 3) * AT_VP + (cidx & 7) * 16) = vreg[i]; }
            f32x16 zz, uu; float tot = 0.f; const int tq_ = t0 + r32;
            if (s0 + 31 < t0) {
#pragma unroll
                for (int i = 0; i < 16; ++i) { const float z = st[i] * 0.18033688011112042f; const float sp = fmaxf(z, 0.f) + __builtin_amdgcn_logf(1.0f + __builtin_amdgcn_exp2f(-fabsf(z)));
                    zz[i] = z - sp; uu[i] = sp; tot += sp; }
            } else {
#pragma unroll
                for (int i = 0; i < 16; ++i) { const int key = s0 + crow32(i, hh); const float z = st[i] * 0.18033688011112042f; const float sp = fmaxf(z, 0.f) + __builtin_amdgcn_logf(1.0f + __builtin_amdgcn_exp2f(-fabsf(z)));
                    const bool valid = key < tq_; zz[i] = valid ? z - sp : -1e30f; uu[i] = valid ? sp : 0.f; tot += uu[i]; }
            }
            f32x16 w;
#pragma unroll
            for (int i = 0; i < 16; ++i) w[i] = 0.f;
#pragma unroll
            for (int s = 0; s < 2; ++s) w = __builtin_amdgcn_mfma_f32_32x32x16_bf16(tri[s], pack_step(uu, s), w, 0, 0, 0);
            f32x16 pp;
#pragma unroll
            for (int i = 0; i < 16; ++i) pp[i] = __builtin_amdgcn_exp2f(zz[i] - w[i] - carry);
            tot += shx(tot, 32, lane); carry += tot;
            asm volatile("s_waitcnt lgkmcnt(0)" ::: "memory");
#pragma unroll
            for (int s = 0; s < 2; ++s) { const bf16x8s pa = pack_step(pp, s);
#pragma unroll
                for (int dt = 0; dt < 2; ++dt) {
                    const v4i16_t lo = __builtin_amdgcn_ds_read_tr16_b64_v4i16((LAS v4i16_t*)(vtr0 + (16 * s) * AT_VP + dt * 64));
                    const v4i16_t hi = __builtin_amdgcn_ds_read_tr16_b64_v4i16((LAS v4i16_t*)(vtr0 + (16 * s + 8) * AT_VP + dt * 64));
                    const bf16x8s vf = (bf16x8s){lo[0], lo[1], lo[2], lo[3], hi[0], hi[1], hi[2], hi[3]};
                    o[dt] = __builtin_amdgcn_mfma_f32_32x32x16_bf16(pa, vf, o[dt], 0, 0, 0); } }
            asm volatile("" ::: "memory");
            if (s0 < t0 && __all(carry > SB_EXIT * 1.4426950408889634f)) break;
        }
#pragma unroll
        for (int dt = 0; dt < 2; ++dt)
#pragma unroll
            for (int i = 0; i < 16; ++i) Ob[(rowb + t0 + crow32(i, hh)) * C + hd * HD + 32 * dt + r32] = (bf16)f2bf(o[dt][i]);
    }
}
__global__ void __launch_bounds__(NWAVES * 64, 2) yoco_fwd(Args args) {
    extern __shared__ __attribute__((aligned(16))) unsigned char lds_raw[];
    LAS unsigned char* lds = (LAS unsigned char*)lds_raw;
    const int G = gridDim.x; const int bx = blockIdx.x;
    int wave = __builtin_amdgcn_readfirstlane(threadIdx.x >> 6); asm volatile("" : "+s"(wave));
#define IDS() int lane; asm volatile("v_mbcnt_lo_u32_b32 %0, -1, 0\n\tv_mbcnt_hi_u32_b32 %0, -1, %0" : "=v"(lane)); const int tid = wave * 64 + lane; (void)tid; \
    const int vcu = (G % 8 == 0) ? (bx % 8) * (G / 8) + bx / 8 : bx; const int gw = vcu * NWAVES + wave, NGW = G * NWAVES; (void)lane; (void)gw; (void)NGW;
    unsigned char* ws = WSP();
    volatile LAS unsigned* MISC = (volatile LAS unsigned*)(lds + MISC_OFF);
    volatile LAS int* tab = (volatile LAS int*)(lds + MOE_TAB_OFF);
    for (int u = threadIdx.x; u < (LDS_BYTES - LDSCTL_OFF) / 4; u += NWAVES * 64) ((LAS unsigned*)(lds + LDSCTL_OFF))[u] = 0u;
    __syncthreads();
    XcdBarrier bar; bar.bar = (unsigned*)(ws + WS_CTL) + CW_BAR; bar.x = 0; bar.st = nullptr;
    if (N_LAUNCHES == 1) bar = xcd_barrier_post((unsigned*)(ws + WS_CTL) + CW_BAR, MISC + 8);
    const int lo = KA_INT(0), hi = KA_INT(1);
#ifndef PROBE_PH
#define PROBE_PH -1
#endif
#define IN(k) (lo <= (k) && (k) < hi)
#define REP(k) for (int rep_ = 0; rep_ < ((PROBE_PH == (k)) ? 2 : 1); ++rep_)
#define SEAM(k) do { if (IN(k) && IN((k) + 1)) xcd_barrier(bar); } while (0)

    if (IN(PH_P0)) REP(PH_P0) { IDS(); p0_weights<0>(ws, lds, gw, NGW, wave, lane); if (G <= 192) { p0_weights<3>(ws, lds, gw, NGW, wave, lane); p0_weights<1>(ws, lds, gw, NGW, wave, lane); } if (G <= 64) p0_weights<4>(ws, lds, gw, NGW, wave, lane); if (G <= 64) p0_weights<2>(ws, lds, gw, NGW, wave, lane); p0_rows(ws, gw, NGW, lane); }
    SEAM(PH_P0);
    if (PROBE_PH == 100 && N_LAUNCHES == 1) { for (int i_ = 0; i_ < 10; ++i_) xcd_barrier(bar); }
    if (IN(PH_LORA)) REP(PH_LORA) {
        SchedGrouped<1, 3> S{(const char*)(ws + WS_B1), (size_t)(WS_B2 - WS_B1), nullptr, (const char*)(ws + WS_WT_LORA), (size_t)256 * C * 2, G, bx};
        EpiLora E{(bf16*)(ws + WS_LW)};
        pg8::gemm_phase<EpiLora, SchedGrouped<1, 3>, true, false, C>(lds, S, E, wave);
        if (G > 192 && bx >= 192) { IDS(); p0_weights<3>(ws, lds, (bx - 192) * NWAVES + wave, (G - 192) * NWAVES, wave, lane); p0_weights<1>(ws, lds, (bx - 192) * NWAVES + wave, (G - 192) * NWAVES, wave, lane); }
    }
    SEAM(PH_LORA);
    if (IN(PH_RKV)) REP(PH_RKV) {
        SchedGrouped<4, 3> S{(const char*)OUTP(), (size_t)M * C * 2, (const char*)(ws + WS_B4), (const char*)(ws + WS_WT_RKV), (size_t)C * C * 2, G, bx};
        EpiSplit3 E{(bf16*)(ws + WS_B1), false, nullptr};
        pg8::gemm_phase<EpiSplit3, SchedGrouped<4, 3>, true, false, C>(lds, S, E, wave);
    }
    SEAM(PH_RKV);
    if (IN(PH_S1)) REP(PH_S1) { IDS(); scan_s1(ws, lds, lane, wave); }
    SEAM(PH_S1);
    if (IN(PH_S2)) REP(PH_S2) { IDS();
        if (bx < BATCH * NH || G <= BATCH * NH) scan_s2(ws, lds, lane, wave);
        }
    SEAM(PH_S2);
    if (IN(PH_S3)) REP(PH_S3) { IDS(); scan_s3(ws, lds, lane, wave); }
    SEAM(PH_S3);
#if MK_DEBUG
    if (IN(PH_DBG0)) { IDS(); scan_naive(ws, lds, tid); }
    SEAM(PH_DBG0);
    if (IN(PH_DBG0 + 1)) { IDS(); post_scan(ws, gw, NGW, lane); }
    SEAM(PH_DBG0 + 1);
    if (IN(PH_DBG0 + 2)) { IDS(); dbg_compare(ws, (const bf16*)(ws + WS_B0), (const bf16*)(ws + WS_B4), gw, NGW, lane); }
    SEAM(PH_DBG0 + 2);
#endif
    if (IN(PH_WOUT)) REP(PH_WOUT) {
        SchedGrouped<4, 1> S{(const char*)(ws + ((MK_DEBUG && DBG_USE_NAIVE) ? WS_B4 : WS_B0)), 0, nullptr, (const char*)(ws + WS_WT_OUT), 0, G, bx};
        EpiResidBf<true> E{INP(0), (bf16*)(ws + WS_B4)};
        pg8::gemm_phase<EpiResidBf<true>, SchedGrouped<4, 1>, true, false, C>(lds, S, E, wave);
    }
    SEAM(PH_WOUT);
#pragma unroll 1
    for (int layer = 0; layer < 2; ++layer) {
        const int pb = layer == 0 ? (int)PH_ROUT0 : (int)PH_ROUT1;
        if (IN(pb)) { IDS(); if (PROBE_PH == 101 && layer == 0) router_rows(ws, lds, layer, gw, NGW, lane, tid, wave, true); router_rows(ws, lds, layer, gw, NGW, lane, tid, wave); }
        SEAM(pb);
        const int mc = (G % 8 == 0) ? (bx % 8) * (G / 8) + bx / 8 : bx;
        if (IN(pb + 1)) REP(pb + 1) {
            { IDS(); moe_table(ws, tab, layer, tid); }
            SchedMoe<2, C, true> S{(const char*)(ws + WS_B4), (const char*)(ws + WS_WT_GU) + (size_t)layer * 16 * 512 * C * 2, (size_t)512 * C * 2, (const unsigned*)(ws + WS_LIST), tab, G, mc};
            EpiGU E{(bf16*)(ws + WS_HID), (const float*)(ws + WS_WL), (const float*)(ws + WS_B0)};
            pg8::gemm_phase<EpiGU, SchedMoe<2, C, true>, true, true, C>(lds, S, E, wave);
            if (layer == 0 && G > 64) { const int nr2 = __builtin_amdgcn_readfirstlane(tab[48]) * 2 - G, first = nr2 > 0 ? nr2 : 0;
                if (mc >= first) { IDS(); p0_weights<4>(ws, lds, (mc - first) * NWAVES + wave, (G - first) * NWAVES, wave, lane); p0_weights<2>(ws, lds, (mc - first) * NWAVES + wave, (G - first) * NWAVES, wave, lane); } }
        }
        SEAM(pb + 1);
        if (IN(pb + 2)) REP(pb + 2) {
            { IDS(); moe_table(ws, tab, layer, tid); }
            SchedMoe<4, FE, false> S{(const char*)(ws + WS_HID), (const char*)(ws + WS_WT_DN) + (size_t)layer * 16 * C * FE * 2, (size_t)C * FE * 2, (const unsigned*)(ws + WS_LIST), tab, G, mc};
            EpiDown E{(bf16*)(ws + WS_B2), (const unsigned*)(ws + WS_LIST)};
            pg8::gemm_phase<EpiDown, SchedMoe<4, FE, false>, true, false, FE>(lds, S, E, wave);
        }
        SEAM(pb + 2);
        if (layer == 0) {
            if (IN(PH_COMB)) { IDS(); if (PROBE_PH == 102) combine_rows(ws, 0, gw, NGW, lane, true); combine_rows(ws, 0, gw, NGW, lane); }
            SEAM(PH_COMB);
            if (IN(PH_KVQ)) REP(PH_KVQ) {
                SchedGrouped<12, 1> S{(const char*)(ws + WS_B4), 0, nullptr, (const char*)(ws + WS_WT_KVQ), 0, G, bx};
                EpiSplit3 E{(bf16*)(ws + WS_B1), true, (const float*)(ws + WS_B0)};
                pg8::gemm_phase<EpiSplit3, SchedGrouped<12, 1>, true, false, C>(lds, S, E, wave);
            }
            SEAM(PH_KVQ);
            if (IN(PH_ATTN)) REP(PH_ATTN) { IDS(); attn_mfma(ws, lds, gw, NGW, lane, wave); }
            SEAM(PH_ATTN);
            if (IN(PH_SBO)) {
                SchedGrouped<4, 1> S{(const char*)(ws + WS_B0), 0, nullptr, (const char*)(ws + WS_WT_SBO), 0, G, bx};
                EpiResidBf<false> E{(const void*)(ws + WS_B4), (bf16*)(ws + WS_B4)};
                pg8::gemm_phase<EpiResidBf<false>, SchedGrouped<4, 1>, true, false, C>(lds, S, E, wave);
            }
            SEAM(PH_SBO);
        }
    }
    if (IN(PH_FINAL)) { IDS(); combine_rows(ws, 1, gw, NGW, lane); }
#undef IN
#undef SEAM
}

extern "C" void kernel_launch(void* const* d_in, const int* in_sizes, int n_in, void* d_out, int out_size, void* d_ws, size_t ws_size, hipStream_t stream) {
    static int grid = 0;
    if (grid == 0) {
        if (n_in != 31 || in_sizes[0] != M * C || out_size != M * C || ws_size < WS_END) { fprintf(stderr, "kernel_launch: unexpected shapes (n_in %d, in0 %d, out %d, ws %zu); nothing launched\n", n_in, n_in > 0 ? in_sizes[0] : -1, out_size, ws_size); grid = -1; return; }
        int dev = 0, cus = 0, per_cu = 0;
        if (hipGetDevice(&dev) != hipSuccess || hipDeviceGetAttribute(&cus, hipDeviceAttributeMultiprocessorCount, dev) != hipSuccess) { grid = -1; return; }
        if (hipFuncSetAttribute((const void*)yoco_fwd, hipFuncAttributeMaxDynamicSharedMemorySize, LDS_BYTES) != hipSuccess) { fprintf(stderr, "kernel_launch: hipFuncSetAttribute failed\n"); grid = -1; return; }
        if (hipOccupancyMaxActiveBlocksPerMultiprocessor(&per_cu, (const void*)yoco_fwd, NWAVES * 64, LDS_BYTES) != hipSuccess || per_cu < 1) fprintf(stderr, "kernel_launch: occupancy query reports %d\n", per_cu);
        (void)hipGetLastError();
        grid = cus - (cus % 16);
    }
    if (grid < 0) return;
    if (hipMemsetAsync((char*)d_ws + WS_CTL, 0, CTL_ZERO_BYTES, stream) != hipSuccess) return;
    Args a{};
    for (int i = 0; i < 31; ++i) a.in[i] = (const float*)d_in[i];
    a.out = (float*)d_out; a.ws = (unsigned char*)d_ws;
    for (int li = 0; li < (N_LAUNCHES == 1 ? 1 : (int)NPHASE); ++li) {
        a.ph_lo = (N_LAUNCHES == 1) ? 0 : li; a.ph_hi = (N_LAUNCHES == 1) ? NPHASE : li + 1; a.li = li;
        hipLaunchKernelGGL(yoco_fwd, dim3(grid), dim3(NWAVES * 64), LDS_BYTES, stream, a);
        const hipError_t le = hipPeekAtLastError();
        if (le != hipSuccess) { fprintf(stderr, "kernel_launch: launch %d failed: %s\n", li, hipGetErrorName(le)); break; }
    }
}
```

```cpp
#include <hip/hip_runtime.h>
#include <cstdio>
#include <cstdint>

#ifndef MK_N_LAUNCHES
#define MK_N_LAUNCHES 1
#endif

namespace pg8 {
#define PG8_LAS __attribute__((address_space(3)))
typedef unsigned short bf16_t;
typedef short bf16x8 __attribute__((ext_vector_type(8)));
typedef float f32x4 __attribute__((ext_vector_type(4)));
typedef unsigned u32x4 __attribute__((ext_vector_type(4)));
constexpr int BM = 256, BK = 64, HALF = 128, HTB = HALF * BK * 2, STAGE_BYTES = 8 * HTB, NXCD = 8, WGM = 8;

__host__ __device__ __forceinline__ int lds_byte(int r, int c) { const int st = (r >> 4) * 2 + (c >> 5), rr = r & 15, cc = c & 31, ob = rr * 64 + cc * 2; return st * 1024 + (ob ^ (((ob >> 9) & 1) << 5)); }
__host__ __device__ __forceinline__ void stage_rc(int b, int& R, int& C) { const int st = b / 1024, sb = b % 1024, swz = sb ^ (((sb >> 9) & 1) << 5); R = (st >> 1) * 16 + swz / 64; C = (st & 1) * 32 + (swz % 64) / 2; }
__host__ __device__ __forceinline__ int perm32(int rho) { const int n = rho >> 4, i = rho & 15; return 8 * (i >> 2) + 4 * n + (i & 3); }

struct Unit { int pm, pn, aux, r0, cnt; };

__host__ __device__ __forceinline__ void tile_map(int wgid, int nM, int nN, int& pm, int& pn) {
    const int nwg = nM * nN;
    { const int q = nwg / NXCD, r = nwg % NXCD, xcd = wgid % NXCD, off = wgid / NXCD; wgid = (xcd < r ? xcd * (q + 1) : r * (q + 1) + (xcd - r) * q) + off; }
    const int nig = WGM * nN, gid = wgid / nig, fm = gid * WGM, gsz = (nM - fm) < WGM ? (nM - fm) : WGM;
    pm = fm + ((wgid % nig) % gsz); pn = (wgid % nig) / gsz;
}

typedef float f32x2_t __attribute__((ext_vector_type(2))); typedef __bf16 bf16x2_t __attribute__((ext_vector_type(2)));
__device__ __forceinline__ unsigned cvt_pk_bf16(float lo, float hi) { const f32x2_t v = {lo, hi}; const bf16x2_t b = __builtin_convertvector(v, bf16x2_t); return __builtin_bit_cast(unsigned, b); }

template <class Epi, class Sched, bool ALIGN_EPI, bool GATHER, int K>
__device__ __forceinline__ void gemm_phase(PG8_LAS unsigned char* lds, const Sched& S, const Epi& E, const int wid) {
    int lane_; asm volatile("v_mbcnt_lo_u32_b32 %0, -1, 0\n\tv_mbcnt_hi_u32_b32 %0, -1, %0" : "=v"(lane_));
    const int lane = lane_, tid = wid * 64 + lane, wr = wid >> 2, wc = wid & 3, fr = lane & 15, fq = lane >> 4;
    constexpr int nt = K / BK;
    unsigned voffA[2], voffB[2];
#pragma unroll
    for (int i = 0; i < 2; ++i) { int R, C; stage_rc(tid * 16 + i * 8192, R, C); const int Rb = Epi::PERM ? ((R & ~31) + perm32(R & 31)) : R;
        voffA[i] = (unsigned)(R * K + C) * 2u; voffB[i] = (unsigned)(Rb * K + C) * 2u; }
    constexpr size_t kstep = (size_t)(BK * 2);
    constexpr size_t hstep = (size_t)HALF * K * 2;
    const unsigned ldsw = (unsigned)wid * 1024u;
    const int aoff = lds_byte(wr * 64 + fr, fq * 8), boff = lds_byte(wc * 32 + fr, fq * 8);
#define PG8_SA(b, h) (((b) * 2 + (h)) * HTB)
#define PG8_SB(b, h) ((4 + (b) * 2 + (h)) * HTB)
#define PG8_STAGE(bufoff, gbase, voff) do { _Pragma("unroll") for (int _i = 0; _i < 2; ++_i) \
        __builtin_amdgcn_global_load_lds((const unsigned*)((const char*)(gbase) + (voff)[_i]), (PG8_LAS unsigned*)(lds + (bufoff) + ldsw + _i * 8192), 16, 0, 0); } while (0)
#define PG8_LDA(dst, b, h) do { _Pragma("unroll") for (int m = 0; m < 4; ++m) _Pragma("unroll") for (int k = 0; k < 2; ++k) dst[m][k] = *(const PG8_LAS bf16x8*)(lds + PG8_SA(b, h) + aoff + m * 2048 + k * 1024); } while (0)
#define PG8_LDB(dst, b, h) do { _Pragma("unroll") for (int n = 0; n < 2; ++n) _Pragma("unroll") for (int k = 0; k < 2; ++k) dst[n][k] = *(const PG8_LAS bf16x8*)(lds + PG8_SB(b, h) + boff + n * 2048 + k * 1024); } while (0)
#define PG8_MMA(ai, bj, At, Bt) do { __builtin_amdgcn_s_setprio(1); _Pragma("unroll") for (int m = 0; m < 4; ++m) _Pragma("unroll") for (int n = 0; n < 2; ++n) _Pragma("unroll") for (int k = 0; k < 2; ++k) \
        acc[ai][bj][m][n] = __builtin_amdgcn_mfma_f32_16x16x32_bf16(Bt[n][k], At[m][k], acc[ai][bj][m][n], 0, 0, 0); __builtin_amdgcn_s_setprio(0); } while (0)
#define PG8_WAIT_V(n) asm volatile("s_waitcnt vmcnt(" #n ")" ::: "memory")
#define PG8_WAIT_L(n) asm volatile("s_waitcnt lgkmcnt(" #n ")" ::: "memory")
#define PG8_BAR __builtin_amdgcn_s_barrier()
#define PG8_SCHED __builtin_amdgcn_sched_barrier(0)
    Unit cur, nxt; int ui = 0;
    if (!S.next(0, cur)) return;
    f32x4 acc[2][2][4][2];
#pragma unroll
    for (int a = 0; a < 2; ++a)
#pragma unroll
        for (int b = 0; b < 2; ++b)
#pragma unroll
            for (int m = 0; m < 4; ++m)
#pragma unroll
                for (int n = 0; n < 2; ++n) acc[a][b][m][n] = (f32x4){0.f, 0.f, 0.f, 0.f};
    bf16x8 At[4][2], B0[2][2], B1[2][2];
    unsigned vc[2][2];
#define PG8_GOFF(u) do { _Pragma("unroll") for (int _h = 0; _h < 2; ++_h) _Pragma("unroll") for (int _i = 0; _i < 2; ++_i) { int _R, _C; stage_rc(tid * 16 + _i * 8192, _R, _C); \
        vc[_h][_i] = S.a_row_off(u, _h * HALF + _R) + (unsigned)_C * 2u; } } while (0)
#define PG8_STAGE_A(bufoff, gbase, h) do { if constexpr (GATHER) { PG8_STAGE(bufoff, gbase, vc[h]); } else { PG8_STAGE(bufoff, (gbase) + (h) * hstep, voffA); } } while (0)
    if constexpr (GATHER) PG8_GOFF(cur);
    const char* cA = S.a_base(cur); const char* cB = S.b_base(cur);
    PG8_STAGE(PG8_SB(0, 0), cB, voffB); PG8_STAGE(PG8_SB(0, 1), cB + hstep, voffB); PG8_STAGE_A(PG8_SA(0, 0), cA, 0); PG8_STAGE_A(PG8_SA(0, 1), cA, 1);
    if (wr == 1) PG8_BAR;
    PG8_WAIT_V(2); PG8_BAR;
    PG8_STAGE(PG8_SB(1, 0), cB + kstep, voffB); PG8_STAGE_A(PG8_SA(1, 0), cA + kstep, 0); PG8_STAGE(PG8_SB(1, 1), cB + hstep + kstep, voffB);
    PG8_WAIT_V(6); PG8_BAR;
    for (;;) {
        const bool has_next = S.next(ui + 1, nxt);
        const char* nA = has_next ? S.a_base(nxt) : cA; const char* nB = has_next ? S.b_base(nxt) : cB;
        for (int t = 0; t < nt; t += 2) {
            const bool last = (t == nt - 2);
            const char* a1 = cA + (size_t)(t + 1) * kstep;
            const char* a2 = last ? nA : cA + (size_t)(t + 2) * kstep; const char* b2 = last ? nB : cB + (size_t)(t + 2) * kstep;
            const char* a3 = a2 + kstep; const char* b3 = b2 + kstep;
            PG8_LDB(B0, 0, 0); PG8_LDB(B1, 0, 1); PG8_SCHED; PG8_LDA(At, 0, 0); PG8_STAGE_A(PG8_SA(1, 1), a1, 1);
            if constexpr (GATHER) { if (last && has_next) PG8_GOFF(nxt); }
            PG8_WAIT_V(8); PG8_WAIT_L(0); PG8_BAR; PG8_MMA(0, 0, At, B0); PG8_MMA(0, 1, At, B1); PG8_BAR; PG8_SCHED;
            PG8_LDA(At, 0, 1); PG8_STAGE(PG8_SB(0, 0), b2, voffB); PG8_STAGE(PG8_SB(0, 1), b2 + hstep, voffB); PG8_STAGE_A(PG8_SA(0, 0), a2, 0);
            PG8_WAIT_V(8); PG8_WAIT_L(0); PG8_BAR; PG8_MMA(1, 0, At, B0); PG8_MMA(1, 1, At, B1); PG8_BAR; PG8_SCHED;
            PG8_LDB(B0, 1, 0); PG8_LDB(B1, 1, 1); PG8_SCHED; PG8_LDA(At, 1, 0); PG8_STAGE_A(PG8_SA(0, 1), a2, 1);
            PG8_WAIT_V(8); PG8_WAIT_L(0); PG8_BAR; PG8_MMA(0, 0, At, B0); PG8_MMA(0, 1, At, B1); PG8_BAR; PG8_SCHED;
            PG8_LDA(At, 1, 1); PG8_STAGE(PG8_SB(1, 0), b3, voffB); PG8_STAGE(PG8_SB(1, 1), b3 + hstep, voffB); PG8_STAGE_A(PG8_SA(1, 0), a3, 0);
            PG8_WAIT_V(8); PG8_WAIT_L(0); PG8_BAR; PG8_MMA(1, 0, At, B0); PG8_MMA(1, 1, At, B1); PG8_BAR; PG8_SCHED;
        }
        if constexpr (ALIGN_EPI) { if (wr == 0) PG8_BAR; }
        E(acc, cur, wr, wc, fr, fq);
        if (!has_next) break;
#pragma unroll
        for (int a = 0; a < 2; ++a)
#pragma unroll
            for (int b = 0; b < 2; ++b)
#pragma unroll
                for (int m = 0; m < 4; ++m)
#pragma unroll
                    for (int n = 0; n < 2; ++n) acc[a][b][m][n] = (f32x4){0.f, 0.f, 0.f, 0.f};
        cur = nxt; cA = nA; cB = nB; ++ui;
        if constexpr (ALIGN_EPI) { if (wr == 1) PG8_BAR; }
    }
    PG8_WAIT_V(0);
    if constexpr (!ALIGN_EPI) { if (wr == 0) PG8_BAR; }
    PG8_BAR;
#undef PG8_SA
#undef PG8_SB
#undef PG8_STAGE
#undef PG8_STAGE_A
#undef PG8_GOFF
#undef PG8_LDA
#undef PG8_LDB
#undef PG8_MMA
#undef PG8_WAIT_V
#undef PG8_WAIT_L
#undef PG8_BAR
#undef PG8_SCHED
}
}

constexpr int NWAVES = 8;
#ifndef MK_DEBUG
#define MK_DEBUG 0
#endif
#ifndef DBG_USE_NAIVE
#define DBG_USE_NAIVE 0
#endif
constexpr int DBGP = MK_DEBUG ? 3 : 0;
enum Phase { PH_P0 = 0, PH_LORA, PH_RKV, PH_S1, PH_S2, PH_S3, PH_DBG0, PH_WOUT = PH_DBG0 + DBGP, PH_ROUT0, PH_GU0, PH_DN0, PH_COMB, PH_KVQ, PH_ATTN, PH_SBO, PH_ROUT1, PH_GU1, PH_DN1, PH_FINAL, NPHASE };
constexpr int N_LAUNCHES = MK_N_LAUNCHES;


constexpr int BATCH = 2, SEQ = 8192, C = 1024, NH = 16, HD = 64, M = BATCH * SEQ;
constexpr int NE = 16, FE = 256, DW = 64, DA = 64, DG = 160;
constexpr float RMS_EPS = 1e-6f, GN_EPS = 64e-5f;
constexpr float SB_EXIT = 104.0f;

constexpr size_t MiB = 1u << 20;
constexpr size_t WS_CTL = 0, CTL_ZERO_BYTES = 64 * 1024;
constexpr size_t WS_WT_W2 = 128 * 1024, WS_WT_A2 = 256 * 1024, WS_WT_G2 = 384 * 1024;
constexpr size_t WS_WT_RKV = 1 * MiB;
constexpr size_t WS_WT_LORA = 7 * MiB;
constexpr size_t WS_WT_OUT = 9 * MiB;
constexpr size_t WS_WT_KVQ = 11 * MiB;
constexpr size_t WS_WT_SBO = 17 * MiB;
constexpr size_t WS_WT_GU = 19 * MiB;
constexpr size_t WS_WT_DN = 51 * MiB;
constexpr size_t WS_LW = 67 * MiB;
constexpr size_t WS_LA = 69 * MiB;
constexpr size_t WS_LG = 71 * MiB;
static_assert(WS_LA == WS_LW + 2 * MiB && WS_LG == WS_LW + 4 * MiB, "EpiLora's pointer arithmetic");
constexpr size_t WS_LIST = 76 * MiB;
constexpr size_t WS_WL = 77 * MiB;
constexpr size_t WS_HID = 78 * MiB;
constexpr size_t WS_B0 = 96 * MiB, WS_B1 = 128 * MiB, WS_B2 = 160 * MiB, WS_B3 = 192 * MiB, WS_B4 = 224 * MiB, WS_END = 256 * MiB;
static_assert(WS_HID + (size_t)144 * 256 * 256 * 2 <= WS_B0, "HID vs B0");
constexpr int CW_TMO = 0;
constexpr int CW_CNT = 1024;
constexpr int CW_BAR = 4096;

constexpr int RING_BYTES = 131072;
constexpr int LDSCTL_OFF = 146688, MISC_OFF = LDSCTL_OFF + 320, MOE_TAB_OFF = MISC_OFF + 128;
constexpr int LDS_BYTES = 147456;
static_assert(MOE_TAB_OFF + 256 <= LDS_BYTES, "LDS map");
static_assert(BATCH * NH * (SEQ / 64) % 16 == 0, "scan units");

#define GAS __attribute__((address_space(1)))
#define LAS __attribute__((address_space(3)))
typedef unsigned short bf16;
typedef unsigned v4u __attribute__((ext_vector_type(4)));
typedef unsigned v2u __attribute__((ext_vector_type(2)));
typedef float f32x4 __attribute__((ext_vector_type(4)));
typedef GAS unsigned gu32;
#define RLX_AGENT __ATOMIC_RELAXED, __HIP_MEMORY_SCOPE_AGENT
#define LDS_WAIT() asm volatile("s_waitcnt lgkmcnt(0)" ::: "memory")
#define VM_WAIT() asm volatile("s_waitcnt vmcnt(0)" ::: "memory")
__device__ __forceinline__ unsigned f2bf(float f) { unsigned u = __builtin_bit_cast(unsigned, f); return (u + 0x7fffu + ((u >> 16) & 1u)) >> 16; }
__device__ __forceinline__ unsigned pk2(float lo, float hi) { return f2bf(lo) | (f2bf(hi) << 16); }
__device__ __forceinline__ float bflo(unsigned u) { return __uint_as_float(u << 16); }
__device__ __forceinline__ float bfhi(unsigned u) { return __uint_as_float(u & 0xffff0000u); }
__device__ __forceinline__ float bf2f(bf16 b) { return __uint_as_float((unsigned)b << 16); }
__device__ __forceinline__ float sigmoidf_(float x) { return 1.0f / (1.0f + __expf(-x)); }

#define XB_TMO      128
#define XB_XCNT(j)  (256  + 64 * (j))
#define XB_XSUB(j)  (1280 + 64 * (j))
#define XB_XGEN(j)  (2304 + 64 * (j))
#define XB_TOP      3328
#define XB_TOPGEN   3392
#define XCD_BAR_WORDS 3456
#define XB_SPIN_CAP (1u << 18)
__device__ __forceinline__ unsigned xb_ld(unsigned* p)              { return __hip_atomic_load(p, __ATOMIC_RELAXED, __HIP_MEMORY_SCOPE_AGENT); }
__device__ __forceinline__ unsigned xb_add(unsigned* p, unsigned v) { return __hip_atomic_fetch_add(p, v, __ATOMIC_RELAXED, __HIP_MEMORY_SCOPE_AGENT); }
__device__ __forceinline__ unsigned xb_xcc_id() { return (unsigned)__builtin_amdgcn_s_getreg((3 << 11) | 20) & 0xFu; }
#define XB_SPIN(cond, bar) do { unsigned _sp = 0; while (cond) { __builtin_amdgcn_s_sleep(1); \
    if ((++_sp & 255u) == 0u) { if (xb_ld(&(bar)[XB_TMO])) break; if (_sp > XB_SPIN_CAP) { atomicAdd(&(bar)[XB_TMO], 1u); break; } } } } while (0)
struct XcdBarrier { unsigned* bar; unsigned x; volatile LAS unsigned* st; };
__device__ __forceinline__ XcdBarrier xcd_barrier_post(unsigned* bar, volatile LAS unsigned* st) {
    XcdBarrier b; b.bar = bar; b.x = xb_xcc_id(); b.st = st;
    if (threadIdx.x == 0) (void)xb_add(&bar[XB_XCNT(b.x)], 1u);
    return b;
}
__device__ __forceinline__ void xcd_barrier_complete(unsigned* bar, unsigned x, unsigned& nloc, unsigned& nx) {
    const unsigned G = gridDim.x * gridDim.y * gridDim.z;
    unsigned sum, cnt, mine, sp = 0u;
    for (;;) {
        sum = 0u; cnt = 0u; mine = 0u;
#pragma unroll
        for (unsigned j = 0; j < 16; ++j) { const unsigned c = xb_ld(&bar[XB_XCNT(j)]); sum += c; cnt += (c > 0u) ? 1u : 0u; mine = (j == x) ? c : mine; }
        if (sum == G) break;
        __builtin_amdgcn_s_sleep(1);
        if ((++sp & 255u) == 0u) { if (xb_ld(&bar[XB_TMO])) break; if (sp > XB_SPIN_CAP) { atomicAdd(&bar[XB_TMO], 1u); break; } }
    }
    nloc = mine > 0u ? mine : 1u; nx = cnt > 0u ? cnt : 1u;
}
__device__ __forceinline__ void xcd_barrier(const XcdBarrier& b) {
    asm volatile("s_waitcnt vmcnt(0)" ::: "memory");
    __syncthreads();
    if (threadIdx.x == 0) {
        unsigned* bar = b.bar;
        __builtin_amdgcn_s_waitcnt(0);
        unsigned nloc = b.st[0], nx = b.st[1];
        if (nloc == 0u) { xcd_barrier_complete(bar, b.x, nloc, nx); b.st[0] = nloc; b.st[1] = nx; }
        const unsigned old = xb_add(&bar[XB_XSUB(b.x)], 1u);
        const unsigned gen = old / nloc;
        const unsigned target = (gen + 1u) * nx;
        if (old + 1u == (gen + 1u) * nloc) {
            __builtin_amdgcn_fence(__ATOMIC_RELEASE, "agent");
            asm volatile("s_waitcnt vmcnt(0)" ::: "memory");
            const unsigned og = xb_add(&bar[XB_TOP], 1u);
            if (og + 1u != target) XB_SPIN((int)(xb_ld(&bar[XB_TOP]) - target) < 0, bar);
        } else {
            XB_SPIN((int)(xb_ld(&bar[XB_TOP]) - target) < 0, bar);
        }
        __builtin_amdgcn_fence(__ATOMIC_ACQUIRE, "agent");
        asm volatile("s_waitcnt vmcnt(0)" ::: "memory");
    }
    __syncthreads();
}

__device__ __forceinline__ float shx(float v, int o, int lane) { return __int_as_float(__builtin_amdgcn_ds_bpermute((lane ^ o) << 2, __float_as_int(v))); }
#define DPP_ADD(v, ctrl) ((v) + __int_as_float(__builtin_amdgcn_update_dpp(0, __float_as_int(v), (ctrl), 0xf, 0xf, true)))
__device__ __forceinline__ float wave_sum(float v, int lane) {
    (void)lane;
    v = DPP_ADD(v, 0x128); v = DPP_ADD(v, 0x124); v = DPP_ADD(v, 0x122); v = DPP_ADD(v, 0x121);
    const int iv = __float_as_int(v);
    return (__int_as_float(__builtin_amdgcn_readlane(iv, 0)) + __int_as_float(__builtin_amdgcn_readlane(iv, 16))) + (__int_as_float(__builtin_amdgcn_readlane(iv, 32)) + __int_as_float(__builtin_amdgcn_readlane(iv, 48)));
}
__device__ __forceinline__ float sum8(float v) { v = DPP_ADD(v, 0xB1); v = DPP_ADD(v, 0x4E); v = DPP_ADD(v, 0x141); return v; }
__device__ __forceinline__ void transpose_item(const float* W, int ldw, int k0, int n0, bf16* WT, int ldk, int dst_row0, const float* kscale, LAS float* scr, int lane, int kmax = 1 << 30) {
    const int r8 = lane >> 3, quad = lane & 7;
    f32x4 v[8];
#pragma unroll
    for (int i = 0; i < 8; ++i) { const int kk = r8 + 8 * i; v[i] = (k0 + kk < kmax) ? *(const GAS f32x4*)(W + (size_t)(k0 + kk) * ldw + n0 + quad * 4) : (f32x4){0.f, 0.f, 0.f, 0.f}; }
#pragma unroll
    for (int i = 0; i < 8; ++i) { const int kk = r8 + 8 * i; if (kscale) v[i] = v[i] * kscale[(k0 + kk < kmax) ? k0 + kk : 0]; *(LAS f32x4*)(scr + kk * 36 + ((quad ^ i) << 2)) = v[i]; }
    LDS_WAIT(); asm volatile("" ::: "memory");
    const int c = lane & 7;
#pragma unroll
    for (int j = 0; j < 4; ++j) { const int n = (lane >> 3) + 8 * j; const LAS float* sp = scr + (8 * c) * 36 + ((((n >> 2) ^ c) << 2) | (n & 3));
        v4u o; o.x = pk2(sp[0 * 36], sp[1 * 36]); o.y = pk2(sp[2 * 36], sp[3 * 36]); o.z = pk2(sp[4 * 36], sp[5 * 36]); o.w = pk2(sp[6 * 36], sp[7 * 36]);
        if (k0 + 8 * c < kmax) *(GAS v4u*)(WT + (size_t)(dst_row0 + n) * ldk + k0 + 8 * c) = o; }
    LDS_WAIT(); asm volatile("" ::: "memory");
}

struct Args { const float* in[31]; float* out; unsigned char* ws; int ph_lo, ph_hi, li, pad; };
typedef const __attribute__((address_space(4))) unsigned char* kaptr_t;
__device__ __forceinline__ kaptr_t ka_base() { kaptr_t p = (kaptr_t)__builtin_amdgcn_kernarg_segment_ptr(); asm volatile("" : "+s"(p)); return p; }
#define INP(k) (*(const float* const __attribute__((address_space(4)))*)(ka_base() + 8 * (k)))
#define OUTP() (*(float* const __attribute__((address_space(4)))*)(ka_base() + 8 * 31))
#define WSP() (*(unsigned char* const __attribute__((address_space(4)))*)(ka_base() + 8 * 32))
#define KA_INT(i) (*(const int __attribute__((address_space(4)))*)(ka_base() + 8 * 33 + 4 * (i)))

template <int PART> __device__ __forceinline__ void p0_weights(unsigned char* ws, LAS unsigned char* lds, int gw, int NGW, int wave, int lane) {
    LAS float* scr = (LAS float*)(lds + wave * 16384);
    bf16* WT_RKV = (bf16*)(ws + WS_WT_RKV); bf16* WT_LORA = (bf16*)(ws + WS_WT_LORA); bf16* WT_OUT = (bf16*)(ws + WS_WT_OUT); bf16* WT_KVQ = (bf16*)(ws + WS_WT_KVQ);
    bf16* WT_SBO = (bf16*)(ws + WS_WT_SBO); bf16* WT_GU = (bf16*)(ws + WS_WT_GU); bf16* WT_DN = (bf16*)(ws + WS_WT_DN);
    constexpr int I_UP = 32 + 32 + 96, I_RKV = 3 * 512, I_LORA = 32 + 32 + 80, I_OUT = 512, I_KV = 1024, I_Q = 512, I_SBO = 512, I_G = 32 * 128, I_U = 32 * 128, I_D = 32 * 128;
    constexpr int NDENSE = I_UP + I_RKV + I_LORA + I_OUT + I_KV + I_Q + I_SBO, NITEMS = NDENSE + I_G + I_U + I_D;
    constexpr int N0 = I_UP + I_RKV + I_LORA, N3 = I_OUT, N4 = I_KV + I_Q + I_SBO; static_assert(N0 + N3 + N4 == NDENSE, "dense items");
    constexpr int NLOOP = PART == 0 ? N0 : (PART == 3 ? N3 : (PART == 4 ? N4 : 3 * 2048)); (void)NITEMS;
    for (int q_ = gw; q_ < NLOOP; q_ += NGW) {
        const int it = PART == 0 ? q_ : (PART == 3 ? N0 + q_ : (PART == 4 ? N0 + N3 + q_ : NDENSE + (q_ / 2048) * 4096 + 2048 * (PART - 1) + (q_ % 2048)));
        int r = it;
        if (r < I_UP) {
            if (r < 32) transpose_item(INP(9), C, 0, 32 * r, (bf16*)(ws + WS_WT_W2), 64, 32 * r, nullptr, scr, lane);
            else if (r < 64) transpose_item(INP(12), C, 0, 32 * (r - 32), (bf16*)(ws + WS_WT_A2), 64, 32 * (r - 32), nullptr, scr, lane);
            else { const int q = r - 64, kb = q / 32, nb = q % 32; transpose_item(INP(14), C, 64 * kb, 32 * nb, (bf16*)(ws + WS_WT_G2), DG, 32 * nb, nullptr, scr, lane, DG); }
            continue; } r -= I_UP;
        if (r < I_RKV) { const int m = r / 512, q = r % 512, kb = q / 32, nb = q % 32; transpose_item(INP(6) + (size_t)m * C * C, C, 64 * kb, 32 * nb, WT_RKV, C, m * C + 32 * nb, nullptr, scr, lane); continue; } r -= I_RKV;
        if (r < I_LORA) {
            if (r < 32) { const int kb = r / 2, nb = r % 2; transpose_item(INP(8), DW, 64 * kb, 32 * nb, WT_LORA, C, 32 * nb, nullptr, scr, lane); }
            else if (r < 64) { const int q = r - 32, kb = q / 2, nb = q % 2; transpose_item(INP(11), DA, 64 * kb, 32 * nb, WT_LORA, C, 256 + 32 * nb, nullptr, scr, lane); }
            else { const int q = r - 64, kb = q / 5, nb = q % 5; transpose_item(INP(13), DG, 64 * kb, 32 * nb, WT_LORA, C, 512 + 32 * nb, nullptr, scr, lane); }
            continue; } r -= I_LORA;
        if (r < I_OUT) { const int kb = r / 32, nb = r % 32; transpose_item(INP(20), C, 64 * kb, 32 * nb, WT_OUT, C, 32 * nb, nullptr, scr, lane); continue; } r -= I_OUT;
        if (r < I_KV) { const int kb = r / 64, nb = r % 64; transpose_item(INP(21), 2 * C, 64 * kb, 32 * nb, WT_KVQ, C, 32 * nb, INP(3), scr, lane); continue; } r -= I_KV;
        if (r < I_Q) { const int kb = r / 32, nb = r % 32; transpose_item(INP(22), C, 64 * kb, 32 * nb, WT_KVQ, C, 2 * C + 32 * nb, INP(1) + C, scr, lane); continue; } r -= I_Q;
        if (r < I_SBO) { const int kb = r / 32, nb = r % 32; transpose_item(INP(23), C, 64 * kb, 32 * nb, WT_SBO, C, 32 * nb, nullptr, scr, lane); continue; } r -= I_SBO;
        if (r < I_G) { const int le = r / 128, q = r % 128, kb = q / 8, nb = q % 8, f0 = 32 * nb; transpose_item(INP(28) + (size_t)le * C * FE, FE, 64 * kb, f0, WT_GU + (size_t)le * 512 * C, C, 256 * (f0 / 128) + (f0 % 128), INP(2) + (le >> 4) * C, scr, lane); continue; } r -= I_G;
        if (r < I_U) { const int le = r / 128, q = r % 128, kb = q / 8, nb = q % 8, f0 = 32 * nb; transpose_item(INP(29) + (size_t)le * C * FE, FE, 64 * kb, f0, WT_GU + (size_t)le * 512 * C, C, 256 * (f0 / 128) + 128 + (f0 % 128), INP(2) + (le >> 4) * C, scr, lane); continue; } r -= I_U;
        { const int le = r / 128, q = r % 128, kb = q / 32, nb = q % 32; transpose_item(INP(30) + (size_t)le * FE * C, C, 64 * kb, 32 * nb, WT_DN + (size_t)le * C * FE, FE, 32 * nb, nullptr, scr, lane); }
    }
    if (PART == 0) for (int it = gw * 64 + lane; it < 768 * 128; it += NGW * 64) { const int row = it >> 7, ch = it & 127;
        const bool valid = (row < 64) || (row >= 256 && row < 320) || (row >= 512 && row < 672);
        if (!valid) *(GAS v4u*)(WT_LORA + (size_t)row * C + ch * 8) = (v4u){0u, 0u, 0u, 0u}; }
}
__device__ __forceinline__ void load_row(const float* p, int lane, f32x4 (&v)[4]) {
#pragma unroll
    for (int j = 0; j < 4; ++j) v[j] = ((const GAS f32x4*)p)[64 * j + lane];
}
__device__ __forceinline__ void load_row_bf(const bf16* p, int lane, f32x4 (&v)[4]) {
#pragma unroll
    for (int j = 0; j < 4; ++j) { const v2u w = ((const GAS v2u*)p)[64 * j + lane]; v[j] = (f32x4){bflo(w.x), bfhi(w.x), bflo(w.y), bfhi(w.y)}; }
}
__device__ __forceinline__ float row_rs(const f32x4 (&v)[4], int lane) {
    float s = 0.f;
#pragma unroll
    for (int j = 0; j < 4; ++j) s += (v[j].x * v[j].x + v[j].y * v[j].y) + (v[j].z * v[j].z + v[j].w * v[j].w);
    return 1.0f / sqrtf(wave_sum(s, lane) * (1.0f / C) + RMS_EPS);
}
__device__ __forceinline__ void store_row_bf16(bf16* p, int lane, const f32x4 (&v)[4]) {
#pragma unroll
    for (int j = 0; j < 4; ++j) { v2u o; o.x = pk2(v[j].x, v[j].y); o.y = pk2(v[j].z, v[j].w); ((GAS v2u*)p)[64 * j + lane] = o; }
}
__device__ __forceinline__ void p0_rows(unsigned char* ws, int gw, int NGW, int lane) {
    const float* x = INP(0); const float* gain = INP(1); const float* mix = INP(5);
    f32x4 g[4]; load_row(gain, lane, g);
    f32x4 mx[6][4];
#pragma unroll
    for (int i = 0; i < 6; ++i) load_row(mix + i * C, lane, mx[i]);
    for (int run = gw; run < M / 8; run += NGW) {
        const int r0 = run * 8;
        f32x4 prev[4], nx[4];
        load_row(x + (size_t)r0 * C, lane, nx);
        if ((r0 % SEQ) == 0) {
#pragma unroll
            for (int j = 0; j < 4; ++j) prev[j] = (f32x4){0.f, 0.f, 0.f, 0.f};
        } else { load_row(x + (size_t)(r0 - 1) * C, lane, prev); const float rs = row_rs(prev, lane);
#pragma unroll
            for (int j = 0; j < 4; ++j) prev[j] = prev[j] * rs * g[j]; }
#pragma unroll 1
        for (int rr = 0; rr < 8; ++rr) {
            const int row = r0 + rr;
            f32x4 hn[4];
#pragma unroll
            for (int j = 0; j < 4; ++j) hn[j] = nx[j];
            if (rr < 7) load_row(x + (size_t)(row + 1) * C, lane, nx);
            const float rs = row_rs(hn, lane);
#pragma unroll
            for (int j = 0; j < 4; ++j) hn[j] = hn[j] * rs * g[j];
#pragma unroll
            for (int i = 0; i < 6; ++i) { f32x4 o[4];
#pragma unroll
                for (int j = 0; j < 4; ++j) o[j] = hn[j] + (prev[j] - hn[j]) * mx[i][j];
                bf16* dst = i < 2 ? (bf16*)OUTP() + (size_t)i * M * C : (i == 2 ? (bf16*)(ws + WS_B4) : (bf16*)(ws + WS_B1) + (size_t)(i - 3) * M * C);
                store_row_bf16(dst + (size_t)row * C, lane, o); }
#pragma unroll
            for (int j = 0; j < 4; ++j) prev[j] = hn[j];
        }
    }
}

template <int NN, int NGROUPS> struct SchedGrouped {
    static constexpr int K = C;
    const char* A0; size_t astride; const char* A2; const char* B; size_t bgroup;
    int G, c;
    __device__ __forceinline__ bool next(int i, pg8::Unit& u) const {
        const int L = i * G + c; constexpr int per = 64 * NN; if (L >= per * NGROUPS) return false;
        const int g = L / per, w = L % per; pg8::tile_map(w, 64, NN, u.pm, u.pn); u.aux = g; u.r0 = 0; u.cnt = 0; return true; }
    __device__ __forceinline__ const char* a_base(const pg8::Unit& u) const { const char* A = (A2 != nullptr && u.aux == 2) ? A2 : A0 + (size_t)u.aux * astride; return A + (size_t)u.pm * 256 * K * 2; }
    __device__ __forceinline__ const char* b_base(const pg8::Unit& u) const { return B + (size_t)u.aux * bgroup + (size_t)u.pn * 256 * K * 2; }
    __device__ __forceinline__ unsigned a_row_off(const pg8::Unit&, int) const { return 0u; }
};
template <int NN, int K, bool GATHER> struct SchedMoe {
    const char* A; const char* B; size_t bexp; const unsigned* list; volatile LAS int* tab; int G, c;
    __device__ __forceinline__ bool next(int i, pg8::Unit& u) const {
        const int L = i * G + c; const int tot = __builtin_amdgcn_readfirstlane(tab[48]) * NN; if (L >= tot) return false;
        u.pm = L / NN; u.pn = L % NN; int e = 0;
#pragma unroll
        for (int j = 0; j < 16; ++j) e += (u.pm >= tab[32 + j]) ? 1 : 0;
        e = __builtin_amdgcn_readfirstlane(e);
        u.aux = e; u.r0 = (u.pm - __builtin_amdgcn_readfirstlane(tab[16 + e])) * 256; u.cnt = __builtin_amdgcn_readfirstlane(tab[e]); return true; }
    __device__ __forceinline__ const char* a_base(const pg8::Unit& u) const { return GATHER ? A : A + (size_t)u.pm * 256 * K * 2; }
    __device__ __forceinline__ const char* b_base(const pg8::Unit& u) const { return B + (size_t)u.aux * bexp + (size_t)u.pn * 256 * K * 2; }
    __device__ __forceinline__ unsigned a_row_off(const pg8::Unit& u, int r) const {
        const int idx = u.r0 + r; unsigned tok = 0u;
        if (idx < u.cnt) tok = list[(size_t)u.aux * M + idx] >> 1;
        return tok * (unsigned)(K * 2); }
};

using pg8::f32x4;
using pg8::Unit;
__device__ __forceinline__ v4u pack8(f32x4 v0, f32x4 v1) { v4u w; w.x = pg8::cvt_pk_bf16(v0[0], v0[1]); w.y = pg8::cvt_pk_bf16(v0[2], v0[3]); w.z = pg8::cvt_pk_bf16(v1[0], v1[1]); w.w = pg8::cvt_pk_bf16(v1[2], v1[3]); return w; }

struct EpiLora {
    static constexpr bool PERM = true;
    bf16* LW;
    __device__ __forceinline__ void operator()(const f32x4 (&acc)[2][2][4][2], const Unit& u, int wr, int wc, int fr, int fq) const {
        { int l_; asm volatile("v_mbcnt_lo_u32_b32 %0, -1, 0\n\tv_mbcnt_hi_u32_b32 %0, -1, %0" : "=v"(l_)); fr = l_ & 15; fq = l_ >> 4; }
        const int g = u.aux, width = g == 2 ? DG : DW; bf16* out = LW + (size_t)g * (1u << 20);
        const int row0 = u.pm * 256 + wr * 64 + fr;
#pragma unroll
        for (int bj = 0; bj < 2; ++bj) { const int col0 = bj * 128 + wc * 32 + 8 * fq; if (col0 < width) {
#pragma unroll
            for (int ai = 0; ai < 2; ++ai)
#pragma unroll
                for (int m = 0; m < 4; ++m) { f32x4 v0 = acc[ai][bj][m][0], v1 = acc[ai][bj][m][1];
                    if (g == 0) {
#pragma unroll
                        for (int q = 0; q < 4; ++q) { v0[q] = tanhf(v0[q]); v1[q] = tanhf(v1[q]); } }
                    else if (g == 2) {
#pragma unroll
                        for (int q = 0; q < 4; ++q) { v0[q] = sigmoidf_(v0[q]); v1[q] = sigmoidf_(v1[q]); } }
                    *(GAS v4u*)(out + (size_t)(row0 + ai * 128 + m * 16) * width + col0) = pack8(v0, v1); } } }
    }
};
struct EpiSplit3 {
    static constexpr bool PERM = true;
    bf16* O0; bool bycol; const float* rowscale;
    __device__ __forceinline__ void operator()(const f32x4 (&acc)[2][2][4][2], const Unit& u, int wr, int wc, int fr, int fq) const {
        { int l_; asm volatile("v_mbcnt_lo_u32_b32 %0, -1, 0\n\tv_mbcnt_hi_u32_b32 %0, -1, %0" : "=v"(l_)); fr = l_ & 15; fq = l_ >> 4; }
        const int g = bycol ? (u.pn >> 2) : u.aux, pn = bycol ? (u.pn & 3) : u.pn; bf16* out = O0 + (size_t)g * ((size_t)M * C);
        const int row0 = u.pm * 256 + wr * 64 + fr, col0 = pn * 256 + wc * 32 + 8 * fq;
#pragma unroll
        for (int ai = 0; ai < 2; ++ai)
#pragma unroll
            for (int m = 0; m < 4; ++m)
                { const float sc = rowscale ? rowscale[row0 + ai * 128 + m * 16] : 1.0f;
#pragma unroll
                for (int bj = 0; bj < 2; ++bj) *(GAS v4u*)(out + (size_t)(row0 + ai * 128 + m * 16) * C + col0 + bj * 128) = pack8(acc[ai][bj][m][0] * sc, acc[ai][bj][m][1] * sc); }
    }
};
template <bool BASE_F32> struct EpiResidBf {
    static constexpr bool PERM = true;
    const void* base; bf16* out;
    __device__ __forceinline__ void operator()(const f32x4 (&acc)[2][2][4][2], const Unit& u, int wr, int wc, int fr, int fq) const {
        { int l_; asm volatile("v_mbcnt_lo_u32_b32 %0, -1, 0\n\tv_mbcnt_hi_u32_b32 %0, -1, %0" : "=v"(l_)); fr = l_ & 15; fq = l_ >> 4; }
        const int row0 = u.pm * 256 + wr * 64 + fr, col0 = u.pn * 256 + wc * 32 + 8 * fq;
        f32x4 nf[4]; v4u nh[2];
#define RB_LOAD(i_) do { const size_t off_ = (size_t)(row0 + ((i_) >> 2) * 128 + ((i_) & 3) * 16) * C + col0; \
            if (BASE_F32) { nf[0] = *(const GAS f32x4*)((const float*)base + off_); nf[1] = *(const GAS f32x4*)((const float*)base + off_ + 4); nf[2] = *(const GAS f32x4*)((const float*)base + off_ + 128); nf[3] = *(const GAS f32x4*)((const float*)base + off_ + 132); } \
            else { nh[0] = *(const GAS v4u*)((const bf16*)base + off_); nh[1] = *(const GAS v4u*)((const bf16*)base + off_ + 128); } } while (0)
        RB_LOAD(0);
#pragma unroll
        for (int i = 0; i < 8; ++i) { const int ai = i >> 2, m = i & 3; const size_t off = (size_t)(row0 + ai * 128 + m * 16) * C + col0;
            f32x4 b[4];
            if (BASE_F32) {
#pragma unroll
                for (int q = 0; q < 4; ++q) b[q] = nf[q]; }
            else {
#pragma unroll
                for (int bj = 0; bj < 2; ++bj) { const v4u w = nh[bj]; b[2 * bj] = (f32x4){bflo(w.x), bfhi(w.x), bflo(w.y), bfhi(w.y)}; b[2 * bj + 1] = (f32x4){bflo(w.z), bfhi(w.z), bflo(w.w), bfhi(w.w)}; } }
            if (i < 7) RB_LOAD(i + 1);
#pragma unroll
            for (int bj = 0; bj < 2; ++bj) *(GAS v4u*)(out + off + bj * 128) = pack8(b[2 * bj] + acc[ai][bj][m][0], b[2 * bj + 1] + acc[ai][bj][m][1]);
            asm volatile("" ::: "memory"); }
#undef RB_LOAD
    }
};
struct EpiGU {
    static constexpr bool PERM = true;
    bf16* HID; const float* wl; const float* rsl;
    __device__ __forceinline__ void operator()(const f32x4 (&acc)[2][2][4][2], const Unit& u, int wr, int wc, int fr, int fq) const {
        { int l_; asm volatile("v_mbcnt_lo_u32_b32 %0, -1, 0\n\tv_mbcnt_hi_u32_b32 %0, -1, %0" : "=v"(l_)); fr = l_ & 15; fq = l_ >> 4; }
        const int e = u.aux, cnt = u.cnt, base = u.r0, r0 = wr * 64 + fr, col0 = u.pn * 128 + wc * 32 + 8 * fq;
#pragma unroll
        for (int ai = 0; ai < 2; ++ai) {
            float wv[4], rv[4];
#pragma unroll
            for (int i = 0; i < 4; ++i) { const int idx = base + r0 + ai * 128 + i * 16; wv[i] = 0.f; rv[i] = 0.f; if (idx < cnt) { wv[i] = wl[(size_t)e * M + idx]; rv[i] = rsl[(size_t)e * M + idx]; } }
#pragma unroll
            for (int m = 0; m < 4; ++m) { const int r = r0 + ai * 128 + m * 16; const float w = wv[m], rs = rv[m];
                f32x4 h0, h1;
#pragma unroll
                for (int q = 0; q < 4; ++q) { const float g0 = acc[ai][0][m][0][q] * rs, g1 = acc[ai][0][m][1][q] * rs;
                    h0[q] = g0 * sigmoidf_(g0) * (acc[ai][1][m][0][q] * rs) * w; h1[q] = g1 * sigmoidf_(g1) * (acc[ai][1][m][1][q] * rs) * w; }
                *(GAS v4u*)(HID + (size_t)(u.pm * 256 + r) * FE + col0) = pack8(h0, h1);
                asm volatile("" ::: "memory"); } }
    }
};
struct EpiDown {
    static constexpr bool PERM = true;
    bf16* EO; const unsigned* list;
    __device__ __forceinline__ void operator()(const f32x4 (&acc)[2][2][4][2], const Unit& u, int wr, int wc, int fr, int fq) const {
        { int l_; asm volatile("v_mbcnt_lo_u32_b32 %0, -1, 0\n\tv_mbcnt_hi_u32_b32 %0, -1, %0" : "=v"(l_)); fr = l_ & 15; fq = l_ >> 4; }
        const int e = u.aux, cnt = u.cnt, base = u.r0, r0 = wr * 64 + fr, col0 = u.pn * 256 + wc * 32 + 8 * fq;
        unsigned ents[8];
#pragma unroll
        for (int i = 0; i < 8; ++i) { const int idx = base + r0 + (i >> 2) * 128 + (i & 3) * 16; ents[i] = 0u; if (idx < cnt) ents[i] = list[(size_t)e * M + idx]; }
#pragma unroll
        for (int ai = 0; ai < 2; ++ai)
#pragma unroll
            for (int m = 0; m < 4; ++m) { const int idx = base + r0 + ai * 128 + m * 16;
                if (idx < cnt) { const unsigned ent = ents[ai * 4 + m]; bf16* o = EO + ((size_t)(ent & 1u) * M + (ent >> 1)) * C + col0;
#pragma unroll
                    for (int bj = 0; bj < 2; ++bj) *(GAS v4u*)(o + bj * 128) = pack8(acc[ai][bj][m][0], acc[ai][bj][m][1]); }
                asm volatile("" ::: "memory"); }
    }
};

typedef short bf16x8s __attribute__((ext_vector_type(8)));
typedef short bf16x4s __attribute__((ext_vector_type(4)));
typedef short v4i16_t __attribute__((ext_vector_type(4)));
constexpr int TPB = 144;
constexpr int TILE_B = 64 * TPB;
constexpr int FP = 68;
constexpr int CS_FA = 0, CS_FB = 16384, CS_TILES = 32768, CS_TOT = CS_TILES + 12 * TILE_B, CS_WL = CS_TOT + 2048, CS_PAR = CS_WL + 256;
static_assert(CS_PAR + 768 <= LDSCTL_OFF, "scan LDS map");
#define TILE(n) (lds + CS_TILES + (n) * TILE_B)
#define F4Z (f32x4){0.f, 0.f, 0.f, 0.f}
__device__ __forceinline__ bf16x8s ldfrag(const LAS unsigned char* tile, int row, int kcol) { return *(const LAS bf16x8s*)(tile + row * TPB + kcol * 2); }
__device__ __forceinline__ bf16x8s ldfrag_tr(const LAS unsigned char* tile, int n0, int k0, int lane) {
    const int g = lane >> 4, q = (lane & 15) >> 2, p = lane & 3;
    const LAS unsigned char* a = tile + (k0 + 8 * g + q) * TPB + (n0 + 4 * p) * 2;
    const v4i16_t lo = __builtin_amdgcn_ds_read_tr16_b64_v4i16((LAS v4i16_t*)a), hi = __builtin_amdgcn_ds_read_tr16_b64_v4i16((LAS v4i16_t*)(a + 4 * TPB));
    return (bf16x8s){lo[0], lo[1], lo[2], lo[3], hi[0], hi[1], hi[2], hi[3]};
}
__device__ __forceinline__ bf16x8s ldfrag_perm(const LAS unsigned char* tile, int row, int ks, int g) {
    const bf16x4s lo = *(const LAS bf16x4s*)(tile + row * TPB + (32 * ks + 4 * g) * 2), hi = *(const LAS bf16x4s*)(tile + row * TPB + (32 * ks + 16 + 4 * g) * 2);
    return (bf16x8s){lo[0], lo[1], lo[2], lo[3], hi[0], hi[1], hi[2], hi[3]};
}
__device__ __forceinline__ void lds_barrier() { asm volatile("s_waitcnt lgkmcnt(0)" ::: "memory"); __builtin_amdgcn_s_barrier(); asm volatile("" ::: "memory"); }
#define MFMA16(a, b, c) __builtin_amdgcn_mfma_f32_16x16x32_bf16((a), (b), (c), 0, 0, 0)
__device__ __forceinline__ void mm64(f32x4 (&acc)[2], const LAS unsigned char* At, const LAS unsigned char* Bt, int rt, int ch, int fr, int g) {
#pragma unroll
    for (int ks = 0; ks < 2; ++ks) { const bf16x8s a = ldfrag(At, 16 * rt + fr, 32 * ks + 8 * g);
#pragma unroll
        for (int ct = 0; ct < 2; ++ct) acc[ct] = MFMA16(a, ldfrag(Bt, 32 * ch + 16 * ct + fr, 32 * ks + 8 * g), acc[ct]); }
}
__device__ __forceinline__ void mm64_bt(f32x4 (&acc)[2], const LAS unsigned char* At, const LAS unsigned char* X, int rt, int ch, int fr, int g, int lane) {
#pragma unroll
    for (int ks = 0; ks < 2; ++ks) { const bf16x8s a = ldfrag(At, 16 * rt + fr, 32 * ks + 8 * g);
#pragma unroll
        for (int ct = 0; ct < 2; ++ct) acc[ct] = MFMA16(a, ldfrag_tr(X, 32 * ch + 16 * ct, 32 * ks, lane), acc[ct]); }
}
__device__ __forceinline__ void mm64_at(f32x4 (&acc)[2], const LAS unsigned char* Xa, const LAS unsigned char* Bt, int rt, int ch, int fr, int g, int lane) {
#pragma unroll
    for (int ks = 0; ks < 2; ++ks) { const bf16x8s a = ldfrag_tr(Xa, 16 * rt, 32 * ks, lane);
#pragma unroll
        for (int ct = 0; ct < 2; ++ct) acc[ct] = MFMA16(a, ldfrag(Bt, 32 * ch + 16 * ct + fr, 32 * ks + 8 * g), acc[ct]); }
}
__device__ __forceinline__ void mm64_att(f32x4 (&acc)[2], const LAS unsigned char* Xa, const LAS unsigned char* X, int rt, int ch, int lane) {
#pragma unroll
    for (int ks = 0; ks < 2; ++ks) { const bf16x8s a = ldfrag_tr(Xa, 16 * rt, 32 * ks, lane);
#pragma unroll
        for (int ct = 0; ct < 2; ++ct) acc[ct] = MFMA16(a, ldfrag_tr(X, 32 * ch + 16 * ct, 32 * ks, lane), acc[ct]); }
}
__device__ __forceinline__ bf16x4s pack4(f32x4 v) { v2u w; w.x = pg8::cvt_pk_bf16(v[0], v[1]); w.y = pg8::cvt_pk_bf16(v[2], v[3]); return __builtin_bit_cast(bf16x4s, w); }
__device__ __forceinline__ f32x4 unpack4(bf16x4s s) { const v2u w = __builtin_bit_cast(v2u, s); return (f32x4){bflo(w.x), bfhi(w.x), bflo(w.y), bfhi(w.y)}; }
__device__ __forceinline__ void st_tr(LAS unsigned char* Out, const f32x4 (&acc)[2], int rt, int ch, int fr, int g) {
#pragma unroll
    for (int ct = 0; ct < 2; ++ct) *(LAS bf16x4s*)(Out + (32 * ch + 16 * ct + fr) * TPB + (16 * rt + 4 * g) * 2) = pack4(acc[ct]);
}
__device__ __forceinline__ void ld_tr(f32x4 (&acc)[2], const LAS unsigned char* In, int rt, int ch, int fr, int g) {
#pragma unroll
    for (int ct = 0; ct < 2; ++ct) acc[ct] = unpack4(*(const LAS bf16x4s*)(In + (32 * ch + 16 * ct + fr) * TPB + (16 * rt + 4 * g) * 2));
}
__device__ __forceinline__ void unpack8(v4u w, float (&o)[8]) { o[0] = bflo(w.x); o[1] = bfhi(w.x); o[2] = bflo(w.y); o[3] = bfhi(w.y); o[4] = bflo(w.z); o[5] = bfhi(w.z); o[6] = bflo(w.w); o[7] = bfhi(w.w); }
__device__ __forceinline__ v4u pack8f(const float (&o)[8]) { v4u w; w.x = pg8::cvt_pk_bf16(o[0], o[1]); w.y = pg8::cvt_pk_bf16(o[2], o[3]); w.z = pg8::cvt_pk_bf16(o[4], o[5]); w.w = pg8::cvt_pk_bf16(o[6], o[7]); return w; }

struct FrontIn { v4u r, k, v; bf16x8s fw[2], fa[2]; };
__device__ __forceinline__ void front_fetch(FrontIn& f, unsigned char* ws, int unit, int tid, int lane, int wave) {
    const int h = unit & 15, c = (unit >> 4) & 127, b = unit >> 11; const size_t row0 = (size_t)b * SEQ + c * 64;
    const int rt = wave & 3, fr = lane & 15, g = lane >> 4, t = tid >> 3, cq = tid & 7, c0 = h * HD + cq * 8;
    const bf16* Rb = (const bf16*)(ws + WS_B1); const bf16* Kb = (const bf16*)(ws + WS_B2); const bf16* Vb = (const bf16*)(ws + WS_B3);
    const bf16* LW = (const bf16*)(ws + WS_LW); const bf16* LA = (const bf16*)(ws + WS_LA);
    f.r = *(const GAS v4u*)(Rb + (row0 + t) * C + c0); f.k = *(const GAS v4u*)(Kb + (row0 + t) * C + c0); f.v = *(const GAS v4u*)(Vb + (row0 + t) * C + c0);
#pragma unroll
    for (int ks = 0; ks < 2; ++ks) { f.fw[ks] = *(const GAS bf16x8s*)(LW + (row0 + 16 * rt + fr) * DW + 32 * ks + 8 * g); f.fa[ks] = *(const GAS bf16x8s*)(LA + (row0 + 16 * rt + fr) * DA + 32 * ks + 8 * g); }
}
__device__ __forceinline__ v4u head_consts(unsigned char* ws, LAS unsigned char* lds, int h, int tid, int wtile, int atile) {
    const bf16* W2T = (const bf16*)(ws + WS_WT_W2); const bf16* A2T = (const bf16*)(ws + WS_WT_A2);
    const int row = tid >> 3, cq = tid & 7;
    const v4u w2chunk = *(const GAS v4u*)(W2T + (size_t)(h * HD + row) * 64 + cq * 8);
    *(LAS v4u*)(lds + CS_TILES + wtile * TILE_B + row * TPB + cq * 16) = w2chunk;
    *(LAS v4u*)(lds + CS_TILES + atile * TILE_B + row * TPB + cq * 16) = *(const GAS v4u*)(A2T + (size_t)(h * HD + row) * 64 + cq * 8);
    if (tid < 64) { LAS float* P = (LAS float*)(lds + CS_PAR); P[tid] = INP(15)[h * HD + tid]; P[64 + tid] = INP(16)[h * HD + tid]; P[128 + tid] = INP(17)[h * HD + tid]; }
    __syncthreads();
    return w2chunk;
}
template <int MODE>
__device__ __forceinline__ void chunk_front(const FrontIn& f, LAS unsigned char* lds, const float (&w0v)[2], const float (&a0v)[2], const bf16x8s (&w2f)[2][2], const bf16x8s (&a2f)[2][2], int tid, int lane, int wave, float (&v8)[8], float& rkb) {
    const int rt = wave & 3, ch = wave >> 2, fr = lane & 15, g = lane >> 4;
    LAS float* FA = (LAS float*)(lds + CS_FA); LAS float* FB = (LAS float*)(lds + CS_FB); LAS float* TOT = (LAS float*)(lds + CS_TOT);
    const int t = tid >> 3, cq = tid & 7;
    {
        f32x4 aw[2] = {F4Z, F4Z}, aa[2] = {F4Z, F4Z};
#pragma unroll
        for (int ks = 0; ks < 2; ++ks)
#pragma unroll
            for (int ct = 0; ct < 2; ++ct) { aw[ct] = MFMA16(f.fw[ks], w2f[ks][ct], aw[ct]); aa[ct] = MFMA16(f.fa[ks], a2f[ks][ct], aa[ct]); }
#pragma unroll
        for (int ct = 0; ct < 2; ++ct) { const int j = 32 * ch + 16 * ct + fr, js = j ^ ((g & 1) << 4); const float w0 = w0v[ct], a0 = a0v[ct];
            float p[4];
#pragma unroll
            for (int q = 0; q < 4; ++q) { p[q] = -0.6065306597126334f * sigmoidf_(w0 + aw[ct][q]); if (q) p[q] += p[q - 1]; }
            const float s_ = p[3];
            const float u1 = __int_as_float(__builtin_amdgcn_ds_bpermute(((lane - 16) & 63) << 2, __float_as_int(s_))); const float t1 = s_ + (g >= 1 ? u1 : 0.f);
            const float u2 = __int_as_float(__builtin_amdgcn_ds_bpermute(((lane - 32) & 63) << 2, __float_as_int(t1))); const float t2 = t1 + (g >= 2 ? u2 : 0.f);
            const float ex = t2 - s_;
#pragma unroll
            for (int q = 0; q < 4; ++q) { const int tt = 16 * rt + 4 * g + q; FA[tt * 64 + js] = p[q] + ex; FB[tt * 64 + js] = sigmoidf_(a0 + aa[ct][q]); }
            if (g == 3) TOT[rt * 64 + j] = t2; }
    }
    lds_barrier();
    {
        float r[8], k[8], pkk[8], pka[8], prk[8];
        unpack8(f.r, r); unpack8(f.k, k); unpack8(f.v, v8);
        { const LAS float* P = (const LAS float*)(lds + CS_PAR) + cq * 8; const f32x4 a0_ = *(const LAS f32x4*)P, a1_ = *(const LAS f32x4*)(P + 4), b0_ = *(const LAS f32x4*)(P + 64), b1_ = *(const LAS f32x4*)(P + 68), c0_ = *(const LAS f32x4*)(P + 128), c1_ = *(const LAS f32x4*)(P + 132);
#pragma unroll
          for (int q = 0; q < 4; ++q) { pkk[q] = a0_[q]; pkk[4 + q] = a1_[q]; pka[q] = b0_[q]; pka[4 + q] = b1_[q]; prk[q] = c0_[q]; prk[4 + q] = c1_[q]; } }
        float cw[8], cwp[8], ag[8];
        { const int tp = t > 0 ? t - 1 : 0, rtt = wave >> 1;
          const int ct_ = (cq ^ (((t >> 2) & 1) << 1)) * 8, cp_ = (cq ^ (((tp >> 2) & 1) << 1)) * 8;
          const f32x4 c0_ = *(const LAS f32x4*)(FA + t * 64 + ct_), c1_ = *(const LAS f32x4*)(FA + t * 64 + ct_ + 4), p0_ = *(const LAS f32x4*)(FA + tp * 64 + cp_), p1_ = *(const LAS f32x4*)(FA + tp * 64 + cp_ + 4);
          const f32x4 g0_ = *(const LAS f32x4*)(FB + t * 64 + ct_), g1_ = *(const LAS f32x4*)(FB + t * 64 + ct_ + 4);
          f32x4 o0_ = F4Z, o1_ = F4Z, l0_ = F4Z, l1_ = F4Z;
          for (int r_ = 0; r_ < rtt; ++r_) { l0_ = *(const LAS f32x4*)(TOT + r_ * 64 + cq * 8); l1_ = *(const LAS f32x4*)(TOT + r_ * 64 + cq * 8 + 4); o0_ = o0_ + l0_; o1_ = o1_ + l1_; }
          const bool first = (t & 15) == 0;
#pragma unroll
          for (int q = 0; q < 4; ++q) { cw[q] = c0_[q] + o0_[q]; cw[4 + q] = c1_[q] + o1_[q];
              cwp[q] = t > 0 ? p0_[q] + o0_[q] - (first ? l0_[q] : 0.f) : 0.f; cwp[4 + q] = t > 0 ? p1_[q] + o1_[q] - (first ? l1_[q] : 0.f) : 0.f; ag[q] = g0_[q]; ag[4 + q] = g1_[q]; } }
        float kk[8], ss = 0.f; rkb = 0.f;
#pragma unroll
        for (int q = 0; q < 8; ++q) { kk[q] = k[q] * pkk[q]; ss += kk[q] * kk[q]; }
        ss = sum8(ss);
        const float inv = 1.0f / fmaxf(sqrtf(ss), 1e-12f);
        float at[8], bt[8], kt[8], rt_[8];
#pragma unroll
        for (int q = 0; q < 8; ++q) { const float kn = kk[q] * inv, kp = k[q] * (1.0f + (ag[q] - 1.0f) * pka[q]);
            const float ein = __expf(-cw[q]);
            at[q] = -kn * __expf(cwp[q]); bt[q] = kn * ag[q] * ein; kt[q] = kp * ein;
            rt_[q] = r[q] * __expf(cw[q]); rkb += r[q] * kp * prk[q]; }
        rkb = sum8(rkb);
        *(LAS v4u*)(TILE(0) + t * TPB + cq * 16) = pack8f(at); *(LAS v4u*)(TILE(1) + t * TPB + cq * 16) = pack8f(bt); *(LAS v4u*)(TILE(2) + t * TPB + cq * 16) = pack8f(kt);
        *(LAS v4u*)(TILE(3) + t * TPB + cq * 16) = f.v;
        *(LAS v4u*)(TILE(6) + t * TPB + cq * 16) = pack8f(rt_);
        if (MODE == 1 && t == 63) {
#pragma unroll
            for (int q = 0; q < 8; ++q) ((LAS float*)(lds + CS_WL))[cq * 8 + q] = __expf(cw[q]); }
    }
    lds_barrier();
}

__device__ __forceinline__ void scan_s1(unsigned char* ws, LAS unsigned char* lds, int lane0, int wave) {
    const int rt = wave & 3, ch = wave >> 2;
    FrontIn fin; float w0v[2], a0v[2]; bf16x8s w2f[2][2], a2f[2][2];
    { int l0 = lane0; asm volatile("" : "+v"(l0)); const int hh = blockIdx.x & 15;
      if ((int)blockIdx.x < BATCH * NH * (SEQ / 64)) front_fetch(fin, ws, blockIdx.x, wave * 64 + l0, l0, wave);
      const bf16* W2T = (const bf16*)(ws + WS_WT_W2); const bf16* A2T = (const bf16*)(ws + WS_WT_A2);
#pragma unroll
      for (int ct = 0; ct < 2; ++ct) { w0v[ct] = INP(7)[hh * HD + 32 * ch + 16 * ct + (l0 & 15)]; a0v[ct] = INP(10)[hh * HD + 32 * ch + 16 * ct + (l0 & 15)];
#pragma unroll
          for (int ks = 0; ks < 2; ++ks) { const size_t wr_ = (size_t)(hh * HD + 32 * ch + 16 * ct + (l0 & 15)) * 64 + 32 * ks + 8 * (l0 >> 4); w2f[ks][ct] = *(const GAS bf16x8s*)(W2T + wr_); a2f[ks][ct] = *(const GAS bf16x8s*)(A2T + wr_); } }
      const int tid0 = wave * 64 + l0;
      if (tid0 < 64) { LAS float* P = (LAS float*)(lds + CS_PAR); P[tid0] = INP(15)[hh * HD + tid0]; P[64 + tid0] = INP(16)[hh * HD + tid0]; P[128 + tid0] = INP(17)[hh * HD + tid0]; }
      __syncthreads(); }
    for (int unit = blockIdx.x; unit < BATCH * NH * (SEQ / 64); unit += gridDim.x) {
        int lane = lane0; asm volatile("" : "+v"(lane));
        const int tid = wave * 64 + lane, fr = lane & 15, g = lane >> 4;
        const int h = unit & 15, c = (unit >> 4) & 127, b = unit >> 11; const size_t chunk = ((size_t)b * NH + h) * 128 + c;
        float v8[8]; float rkb;
        chunk_front<1>(fin, lds, w0v, a0v, w2f, a2f, tid, lane, wave, v8, rkb);
        { const size_t row0_ = (size_t)b * SEQ + c * 64; if ((tid & 7) == 0) ((float*)(ws + WS_HID))[(row0_ + (tid >> 3)) * NH + h] = rkb; }
        if (unit + (int)gridDim.x < BATCH * NH * (SEQ / 64)) front_fetch(fin, ws, unit + gridDim.x, tid, lane, wave);
        {
            f32x4 a2[2] = {F4Z, F4Z}, a3[2] = {F4Z, F4Z};
            mm64(a2, TILE(1), TILE(0), rt, ch, fr, g);
            mm64(a3, TILE(2), TILE(0), rt, ch, fr, g);
            f32x4 p1[2];
#pragma unroll
            for (int ct = 0; ct < 2; ++ct) { const int col = 32 * ch + 16 * ct + fr;
#pragma unroll
                for (int q = 0; q < 4; ++q) { const int row = 16 * rt + 4 * g + q;
                    a2[ct][q] = row < col ? a2[ct][q] : 0.f;
                    p1[ct][q] = a2[ct][q] + (row == col ? 1.0f : 0.f);
                    a3[ct][q] = row < col ? a3[ct][q] : 0.f; } }
            st_tr(TILE(5), a2, rt, ch, fr, g);
            st_tr(TILE(9), p1, rt, ch, fr, g);
            st_tr(TILE(4), a3, rt, ch, fr, g);
        }
        lds_barrier();
#pragma unroll
        for (int r = 0; r < 6; ++r) {
            LAS unsigned char* Sr = TILE(5 + 2 * (r & 1)); LAS unsigned char* Sr2 = TILE(5 + 2 * ((r & 1) ^ 1));
            if (r <= 4) { f32x4 q2[2] = {F4Z, F4Z};
                mm64_at(q2, Sr, Sr, rt, ch, fr, g, lane);
                st_tr(Sr2, q2, rt, ch, fr, g); }
            if (r >= 1) { LAS unsigned char* Pr = TILE(9 + ((r - 1) & 1)); LAS unsigned char* Pr2 = TILE(9 + (((r - 1) & 1) ^ 1));
                f32x4 pa[2]; ld_tr(pa, Pr, rt, ch, fr, g);
                mm64_at(pa, Sr, Pr, rt, ch, fr, g, lane);
                st_tr(Pr2, pa, rt, ch, fr, g); }
            if (r == 0) { f32x4 gg[2] = {F4Z, F4Z};
                mm64_bt(gg, TILE(4), TILE(3), rt, ch, fr, g, lane);
                st_tr(TILE(11), gg, rt, ch, fr, g); }
            lds_barrier();
        }
        {
            f32x4 acc[2] = {F4Z, F4Z}, ac2[2] = {F4Z, F4Z};
            mm64_bt(acc, TILE(10), TILE(0), rt, ch, fr, g, lane);
            mm64(ac2, TILE(10), TILE(11), rt, ch, fr, g);
            st_tr(TILE(5), acc, rt, ch, fr, g); st_tr(TILE(7), ac2, rt, ch, fr, g);
            f32x4 b2[2] = {F4Z, F4Z}, b3[2] = {F4Z, F4Z};
            mm64(b2, TILE(1), TILE(6), rt, ch, fr, g); mm64(b3, TILE(2), TILE(6), rt, ch, fr, g);
#pragma unroll
            for (int ct = 0; ct < 2; ++ct) { const int t = 32 * ch + 16 * ct + fr;
#pragma unroll
                for (int q = 0; q < 4; ++q) { const int s_ = 16 * rt + 4 * g + q; b2[ct][q] = s_ <= t ? b2[ct][q] : 0.f; b3[ct][q] = s_ <= t ? b3[ct][q] : 0.f; } }
            st_tr(TILE(4), b2, rt, ch, fr, g); st_tr(TILE(9), b3, rt, ch, fr, g);
        }
        lds_barrier();
        {
            const LAS float* WL = (const LAS float*)(lds + CS_WL);
            f32x4 acc[2] = {F4Z, F4Z};
            mm64_bt(acc, TILE(5), TILE(1), rt, ch, fr, g, lane);
            bf16* Mg = (bf16*)(ws + WS_B0) + chunk * 4096;
#pragma unroll
            for (int ct = 0; ct < 2; ++ct) { const int j1 = 32 * ch + 16 * ct + fr; const float wl = WL[j1];
#pragma unroll
                for (int q = 0; q < 4; ++q) { const int j2 = 16 * rt + 4 * g + q; acc[ct][q] = wl * (acc[ct][q] + (j2 == j1 ? 1.0f : 0.f)); }
                const int rtS = 2 * ch + ct, ksS = rt >> 1, half = rt & 1;
                *(GAS bf16x4s*)(Mg + (((rtS * 2 + ksS) * 64 + g * 16 + fr) * 8 + half * 4)) = pack4(acc[ct]); }
            f32x4 ad[2] = {F4Z, F4Z};
            mm64_at(ad, TILE(1), TILE(7), rt, ch, fr, g, lane);
            mm64_att(ad, TILE(2), TILE(3), rt, ch, lane);
            const f32x4 wl4 = *(const LAS f32x4*)(WL + 16 * rt + 4 * g);
            bf16* Dg = (bf16*)OUTP() + chunk * 4096;
#pragma unroll
            for (int ct = 0; ct < 2; ++ct) *(GAS bf16x4s*)(Dg + (((2 * ch + ct) * 4 + rt) * 64 + lane) * 4) = pack4(ad[ct] * wl4);
            const size_t row0_ = (size_t)b * SEQ + c * 64;
            f32x4 ar[2]; ld_tr(ar, TILE(6), rt, ch, fr, g);
            mm64(ar, TILE(5), TILE(4), rt, ch, fr, g);
            f32x4 ay[2] = {F4Z, F4Z};
            mm64(ay, TILE(7), TILE(4), rt, ch, fr, g); mm64_at(ay, TILE(3), TILE(9), rt, ch, fr, g, lane);
            bf16* Rg = (bf16*)(ws + WS_B1); bf16* Kg = (bf16*)(ws + WS_B2);
#pragma unroll
            for (int ct = 0; ct < 2; ++ct) { const size_t o_ = (row0_ + 32 * ch + 16 * ct + fr) * C + h * HD + 16 * rt + 4 * g; *(GAS bf16x4s*)(Rg + o_) = pack4(ar[ct]); *(GAS bf16x4s*)(Kg + o_) = pack4(ay[ct]); }
        }
        lds_barrier();
    }
}

constexpr int S2_PD = 6;
__device__ __forceinline__ void scan_s2(unsigned char* ws, LAS unsigned char* lds, int lane, int wave) {
    for (int bh = blockIdx.x; bh < BATCH * NH; bh += gridDim.x) {
        const unsigned char* Mg = (const unsigned char*)((const bf16*)(ws + WS_B0) + (size_t)bh * 128 * 4096); const unsigned char* Dg = (const unsigned char*)((const bf16*)OUTP() + (size_t)bh * 128 * 4096);
        bf16* Sg = (bf16*)OUTP() + (size_t)M * C + (size_t)bh * 128 * 4096;
        if (wave >= 4) {
            const int lw = wave - 4;
            const unsigned char* src = (lw < 2 ? Mg + lw * 4096 : Dg + (lw - 2) * 4096) + lane * 16;
            LAS unsigned char* dst = lds + lw * 4096 + lane * 16;
            v4u q[S2_PD][4];
#define S2_LOADQ(j, c) do { _Pragma("unroll") for (int i_ = 0; i_ < 4; ++i_) q[j][i_] = *(const GAS v4u*)(src + (size_t)(c) * 8192 + i_ * 1024); } while (0)
#define S2_STOREQ(j, slot) do { _Pragma("unroll") for (int i_ = 0; i_ < 4; ++i_) *(LAS v4u*)(dst + (slot) * 16384 + i_ * 1024) = q[j][i_]; } while (0)
#pragma unroll
            for (int j = 0; j < S2_PD; ++j) S2_LOADQ(j, j);
            S2_STOREQ(0, 0); S2_LOADQ(0, S2_PD);
            lds_barrier();
#pragma unroll 1
            for (int s0 = 0; s0 < 128; s0 += S2_PD) {
#pragma unroll
                for (int jj = 0; jj < S2_PD; ++jj) { const int step = s0 + jj;
                    if (step + 1 < 128) S2_STOREQ((jj + 1) % S2_PD, (step + 1) & 1);
                    if (step + 1 + S2_PD < 128) S2_LOADQ((jj + 1) % S2_PD, step + 1 + S2_PD);
                    lds_barrier(); }
            }
#undef S2_LOADQ
#undef S2_STOREQ
        } else {
            const int ct = wave;
            f32x4 acc[4];
#pragma unroll
            for (int r = 0; r < 4; ++r) acc[r] = F4Z;
            lds_barrier();
#pragma unroll 1
            for (int s0 = 0; s0 < 128; s0 += S2_PD) {
#pragma unroll
                for (int jj = 0; jj < S2_PD; ++jj) { const int step = s0 + jj;
                    if (step < 128) {
                        const LAS unsigned char* slot = lds + (step & 1) * 16384;
                        bf16x8s sf[2];
#pragma unroll
                        for (int ks = 0; ks < 2; ++ks) { const bf16x4s lo = pack4(acc[2 * ks]), hi = pack4(acc[2 * ks + 1]); sf[ks] = (bf16x8s){lo[0], lo[1], lo[2], lo[3], hi[0], hi[1], hi[2], hi[3]}; }
#pragma unroll
                        for (int ks = 0; ks < 2; ++ks) *(GAS bf16x8s*)(Sg + (size_t)step * 4096 + ((ct * 2 + ks) * 64 + lane) * 8) = sf[ks];
                        f32x4 na[4];
#pragma unroll
                        for (int r = 0; r < 4; ++r) na[r] = unpack4(*(const LAS bf16x4s*)(slot + 8192 + ((ct * 4 + r) * 64 + lane) * 8));
#pragma unroll
                        for (int ks = 0; ks < 2; ++ks)
#pragma unroll
                            for (int r = 0; r < 4; ++r) na[r] = MFMA16(*(const LAS bf16x8s*)(slot + ((r * 2 + ks) * 64 + lane) * 16), sf[ks], na[r]);
#pragma unroll
                        for (int r = 0; r < 4; ++r) acc[r] = na[r];
                    }
                    lds_barrier(); }
            }
        }
    }
}

constexpr int S3_RT = 32768, S3_YT = S3_RT + TILE_B, S3_LG = S3_YT + TILE_B, S3_LGP = 336;
struct S3In { v4u rr, yy, vv, lg[3]; bf16x8s sA[2]; float rkb; };
__device__ __forceinline__ void s3_fetch(S3In& f, unsigned char* ws, int unit, int tid, int lane, int wave) {
    const int h = unit & 15, c = (unit >> 4) & 127, b = unit >> 11; const size_t chunk = ((size_t)b * NH + h) * 128 + c, row0 = (size_t)b * SEQ + c * 64;
    const int rt = wave & 3, et = tid >> 3, ecq = tid & 7;
    const bf16* Rg = (const bf16*)(ws + WS_B1); const bf16* Kg = (const bf16*)(ws + WS_B2); const bf16* Vb = (const bf16*)(ws + WS_B3); const bf16* LG = (const bf16*)(ws + WS_LG);
    const bf16* Sg = (const bf16*)OUTP() + (size_t)M * C + chunk * 4096;
    const size_t o_ = (row0 + et) * C + h * HD + ecq * 8;
    f.rr = *(const GAS v4u*)(Rg + o_); f.yy = *(const GAS v4u*)(Kg + o_); f.vv = *(const GAS v4u*)(Vb + o_);
#pragma unroll
    for (int i = 0; i < 3; ++i) { const int chn = tid + 512 * i; if (chn < 64 * 20) f.lg[i] = *(const GAS v4u*)(LG + (row0 + chn / 20) * DG + (chn % 20) * 8); }
#pragma unroll
    for (int ks = 0; ks < 2; ++ks) f.sA[ks] = *(const GAS bf16x8s*)(Sg + ((rt * 2 + ks) * 64 + lane) * 8);
    f.rkb = ((const float*)(ws + WS_HID))[(row0 + et) * NH + h];
}
__device__ __forceinline__ void scan_s3(unsigned char* ws, LAS unsigned char* lds, int lane0, int wave) {
    const int rt = wave & 3, ch = wave >> 2;
    LAS float* Ys = (LAS float*)(lds + CS_FA);
    const bf16* G2T = (const bf16*)(ws + WS_WT_G2); bf16* YG = (bf16*)(ws + WS_B0);
    constexpr int NU = BATCH * NH * (SEQ / 64);
    S3In fin; bf16x8s gA[5]; f32x4 lnw0, lnw1, lnb0, lnb1;
    { int l0 = lane0; asm volatile("" : "+v"(l0)); const int hh = blockIdx.x & 15, t0_ = wave * 64 + l0;
      if ((int)blockIdx.x < NU) s3_fetch(fin, ws, blockIdx.x, t0_, l0, wave);
#pragma unroll
      for (int ks = 0; ks < 5; ++ks) gA[ks] = *(const GAS bf16x8s*)(G2T + (size_t)(hh * HD + 16 * rt + (l0 & 15)) * DG + 32 * ks + 8 * (l0 >> 4));
      const int ec0 = hh * HD + (t0_ & 7) * 8;
      lnw0 = *(const GAS f32x4*)(INP(18) + ec0); lnw1 = *(const GAS f32x4*)(INP(18) + ec0 + 4); lnb0 = *(const GAS f32x4*)(INP(19) + ec0); lnb1 = *(const GAS f32x4*)(INP(19) + ec0 + 4); }
    __syncthreads();
    for (int unit = blockIdx.x; unit < NU; unit += gridDim.x) {
        int lane = lane0; asm volatile("" : "+v"(lane));
        const int tid = wave * 64 + lane, fr = lane & 15, g = lane >> 4, et = tid >> 3, ecq = tid & 7;
        const int h = unit & 15, c = (unit >> 4) & 127, b = unit >> 11; const size_t row0 = (size_t)b * SEQ + c * 64;
        *(LAS v4u*)(lds + S3_RT + et * TPB + ecq * 16) = fin.rr; *(LAS v4u*)(lds + S3_YT + et * TPB + ecq * 16) = fin.yy;
#pragma unroll
        for (int i = 0; i < 3; ++i) { const int chn = tid + 512 * i; if (chn < 64 * 20) *(LAS v4u*)(lds + S3_LG + (chn / 20) * S3_LGP + (chn % 20) * 16) = fin.lg[i]; }
        float v8[8]; unpack8(fin.vv, v8); const float rkb = fin.rkb; const bf16x8s sA0 = fin.sA[0], sA1 = fin.sA[1];
        lds_barrier();
        if (unit + (int)gridDim.x < NU) s3_fetch(fin, ws, unit + gridDim.x, tid, lane, wave);
        f32x4 acc[2], ag[2] = {F4Z, F4Z};
#pragma unroll
        for (int ct = 0; ct < 2; ++ct) { const int t = 32 * ch + 16 * ct + fr;
            acc[ct] = unpack4(*(const LAS bf16x4s*)(lds + S3_YT + t * TPB + (16 * rt + 4 * g) * 2));
            acc[ct] = MFMA16(sA0, ldfrag_perm(lds + S3_RT, t, 0, g), acc[ct]); acc[ct] = MFMA16(sA1, ldfrag_perm(lds + S3_RT, t, 1, g), acc[ct]);
#pragma unroll
            for (int ks = 0; ks < 5; ++ks) ag[ct] = MFMA16(gA[ks], *(const LAS bf16x8s*)(lds + S3_LG + t * S3_LGP + (32 * ks + 8 * g) * 2), ag[ct]);
            *(LAS f32x4*)(Ys + t * FP + 16 * rt + 4 * g) = acc[ct]; }
        lds_barrier();
        {
            const f32x4 y0 = *(const LAS f32x4*)(Ys + et * FP + ecq * 8), y1 = *(const LAS f32x4*)(Ys + et * FP + ecq * 8 + 4);
            float y[8] = {y0[0], y0[1], y0[2], y0[3], y1[0], y1[1], y1[2], y1[3]};
            float s_ = 0.f;
#pragma unroll
            for (int q = 0; q < 8; ++q) s_ += y[q];
            s_ = sum8(s_);
            const float mu = s_ * (1.0f / HD); float vs = 0.f;
#pragma unroll
            for (int q = 0; q < 8; ++q) { y[q] -= mu; vs += y[q] * y[q]; }
            vs = sum8(vs);
            const float rstd = 1.0f / sqrtf(vs * (1.0f / HD) + GN_EPS);
            f32x4 o0, o1;
#pragma unroll
            for (int q = 0; q < 4; ++q) { o0[q] = y[q] * rstd * lnw0[q] + lnb0[q] + rkb * v8[q]; o1[q] = y[4 + q] * rstd * lnw1[q] + lnb1[q] + rkb * v8[4 + q]; }
            *(LAS f32x4*)(Ys + et * FP + ecq * 8) = o0; *(LAS f32x4*)(Ys + et * FP + ecq * 8 + 4) = o1;
        }
        lds_barrier();
#pragma unroll
        for (int ct = 0; ct < 2; ++ct) { const int t = 32 * ch + 16 * ct + fr; const f32x4 yv = *(const LAS f32x4*)(Ys + t * FP + 16 * rt + 4 * g);
            *(GAS bf16x4s*)(YG + (row0 + t) * C + h * HD + 16 * rt + 4 * g) = pack4(yv * ag[ct]); }
    }
    __syncthreads();
}
#undef TILE
#if MK_DEBUG
__device__ __forceinline__ void scan_naive(unsigned char* ws, LAS unsigned char* lds, int tid) {
    const int lane = tid & 63;
    const bf16* Rb = (const bf16*)(ws + WS_B1); const bf16* Kb = (const bf16*)(ws + WS_B2); const bf16* Vb = (const bf16*)(ws + WS_B3);
    const bf16* LW = (const bf16*)(ws + WS_LW); const bf16* LA = (const bf16*)(ws + WS_LA);
    float* Y = OUTP(); float* RK = (float*)(ws + WS_HID);
    LAS float* sR = (LAS float*)lds; LAS float* sK = sR + 4096; LAS float* sV = sK + 4096; LAS float* sA = sV + 4096; LAS float* sB = sA + 4096; LAS float* sD = sB + 4096;
    LAS float* sW2 = sD + 4096; LAS float* sA2 = sW2 + 4096;
    for (int unit = blockIdx.x; unit < BATCH * NH; unit += gridDim.x) {
        const int b = unit / NH, h = unit % NH;
        __syncthreads();
        for (int e = tid; e < 4096; e += 512) { const int d = e >> 6, j = e & 63; sW2[e] = INP(9)[(size_t)d * C + h * HD + j]; sA2[e] = INP(12)[(size_t)d * C + h * HD + j]; }
        __syncthreads();
        const int pt = tid >> 3, cq = tid & 7, c0 = h * HD + cq * 8;
        const int si = tid >> 3, jq = tid & 7;
        float S[8];
#pragma unroll
        for (int q = 0; q < 8; ++q) S[q] = 0.f;
        float w0v[8], a0v[8], kkv[8], kav[8], rkv[8];
#pragma unroll
        for (int q = 0; q < 8; ++q) { w0v[q] = INP(7)[c0 + q]; a0v[q] = INP(10)[c0 + q]; kkv[q] = INP(15)[c0 + q]; kav[q] = INP(16)[c0 + q]; rkv[q] = INP(17)[c0 + q]; }
        for (int blk = 0; blk < SEQ / 64; ++blk) {
            const size_t row = (size_t)b * SEQ + blk * 64 + pt;
            {
                const v4u r4 = *(const GAS v4u*)(Rb + row * C + c0), k4 = *(const GAS v4u*)(Kb + row * C + c0), v4 = *(const GAS v4u*)(Vb + row * C + c0);
                float r[8], k[8], v[8];
                r[0] = bflo(r4.x); r[1] = bfhi(r4.x); r[2] = bflo(r4.y); r[3] = bfhi(r4.y); r[4] = bflo(r4.z); r[5] = bfhi(r4.z); r[6] = bflo(r4.w); r[7] = bfhi(r4.w);
                k[0] = bflo(k4.x); k[1] = bfhi(k4.x); k[2] = bflo(k4.y); k[3] = bfhi(k4.y); k[4] = bflo(k4.z); k[5] = bfhi(k4.z); k[6] = bflo(k4.w); k[7] = bfhi(k4.w);
                v[0] = bflo(v4.x); v[1] = bfhi(v4.x); v[2] = bflo(v4.y); v[3] = bfhi(v4.y); v[4] = bflo(v4.z); v[5] = bfhi(v4.z); v[6] = bflo(v4.w); v[7] = bfhi(v4.w);
                float wp[8], ap[8];
#pragma unroll
                for (int q = 0; q < 8; ++q) { wp[q] = w0v[q]; ap[q] = a0v[q]; }
                for (int d = 0; d < 64; ++d) { const float lw = bf2f(LW[row * DW + d]), la = bf2f(LA[row * DA + d]);
#pragma unroll
                    for (int q = 0; q < 8; ++q) { wp[q] += lw * sW2[d * 64 + cq * 8 + q]; ap[q] += la * sA2[d * 64 + cq * 8 + q]; } }
                float kk[8], ss = 0.f, rks = 0.f;
#pragma unroll
                for (int q = 0; q < 8; ++q) { kk[q] = k[q] * kkv[q]; ss += kk[q] * kk[q]; }
                ss = sum8(ss);
                const float inv = 1.0f / fmaxf(sqrtf(ss), 1e-12f);
#pragma unroll
                for (int q = 0; q < 8; ++q) { const float ag = sigmoidf_(ap[q]); const float kn = kk[q] * inv; const float kp = k[q] * (1.0f + (ag - 1.0f) * kav[q]);
                    const float lw = -0.6065306597126334f * sigmoidf_(wp[q]);
                    const int o = pt * 64 + cq * 8 + q;
                    sR[o] = r[q]; sK[o] = kp; sV[o] = v[q]; sA[o] = -kn; sB[o] = kn * ag; sD[o] = __expf(lw); rks += r[q] * kp * rkv[q]; }
                rks = sum8(rks);
                if (cq == 0) RK[row * NH + h] = rks;
            }
            __syncthreads();
            for (int t = 0; t < 64; ++t) {
                const LAS f32x4* pa = (const LAS f32x4*)(sA + t * 64 + jq * 8); const LAS f32x4* pb = (const LAS f32x4*)(sB + t * 64 + jq * 8);
                const LAS f32x4* pd = (const LAS f32x4*)(sD + t * 64 + jq * 8); const LAS f32x4* pk = (const LAS f32x4*)(sK + t * 64 + jq * 8);
                const LAS f32x4* pr = (const LAS f32x4*)(sR + t * 64 + jq * 8);
                const f32x4 a0 = pa[0], a1 = pa[1], b0 = pb[0], b1 = pb[1], d0 = pd[0], d1 = pd[1], k0 = pk[0], k1 = pk[1], r0 = pr[0], r1 = pr[1];
                const float vi = sV[t * 64 + si];
                float sa = 0.f;
#pragma unroll
                for (int q = 0; q < 4; ++q) { sa += S[q] * a0[q]; sa += S[4 + q] * a1[q]; }
                sa = sum8(sa);
                float y = 0.f;
#pragma unroll
                for (int q = 0; q < 4; ++q) { S[q] = S[q] * d0[q] + sa * b0[q] + vi * k0[q]; S[4 + q] = S[4 + q] * d1[q] + sa * b1[q] + vi * k1[q]; y += S[q] * r0[q]; y += S[4 + q] * r1[q]; }
                y = sum8(y);
                if (jq == 0) Y[((size_t)b * SEQ + blk * 64 + t) * C + h * HD + si] = y;
            }
            __syncthreads();
        }
    }
}
__device__ __forceinline__ void post_scan(unsigned char* ws, int gw, int NGW, int lane) {
    const float* Y = OUTP(); const float* RK = (const float*)(ws + WS_HID); const bf16* Vb = (const bf16*)(ws + WS_B3); const bf16* LG = (const bf16*)(ws + WS_LG);
    bf16* YG = (bf16*)(ws + WS_B4); const float* g2 = INP(14); const float* lnw = INP(18); const float* lnb = INP(19);
    for (int it = gw; it < M * NH; it += NGW) {
        const int row = it / NH, h = it % NH, c = h * HD + lane;
        const float y = Y[(size_t)row * C + c];
        const float mu = wave_sum(y, lane) * (1.0f / HD); const float d = y - mu; const float var = wave_sum(d * d, lane) * (1.0f / HD);
        float o = d * (1.0f / sqrtf(var + GN_EPS)) * lnw[c] + lnb[c];
        o += RK[(size_t)row * NH + h] * bf2f(Vb[(size_t)row * C + c]);
        float g = 0.f;
        for (int dd = 0; dd < DG; ++dd) g += bf2f(LG[(size_t)row * DG + dd]) * g2[(size_t)dd * C + c];
        YG[(size_t)row * C + c] = (bf16)f2bf(o * g);
    }
}


constexpr int CW_DBG = 3200;
__device__ __forceinline__ void dbg_nonfinite(unsigned char* ws, const bf16* X, size_t n, int slot, int gw, int NGW, int lane, float thr = 1e30f) {
    unsigned* cw = (unsigned*)(ws + WS_CTL) + CW_DBG + 64 * slot; unsigned nnan = 0;
    for (size_t i = (size_t)gw * 64 + lane; i < n; i += (size_t)NGW * 64) { const float x = bf2f(X[i]); if (!(fabsf(x) < thr)) ++nnan; }
    if (nnan) atomicAdd(cw, nnan);
}
__device__ __forceinline__ void dbg_compare(unsigned char* ws, const bf16* X, const bf16* Y, int gw, int NGW, int lane) {
    unsigned* cw = (unsigned*)(ws + WS_CTL) + CW_DBG; unsigned nbad = 0, nnan = 0;
    for (size_t i = (size_t)gw * 64 + lane; i < (size_t)M * C; i += (size_t)NGW * 64) { const float x = bf2f(X[i]), y = bf2f(Y[i]);
        if (!(fabsf(x) < 1e30f)) ++nnan; else if (fabsf(x - y) > 0.05f * (fabsf(y) + 0.05f)) ++nbad; }
    if (nnan) atomicAdd(cw, nnan); if (nbad) atomicAdd(cw + 64, nbad);
}
#endif
__device__ __forceinline__ void router_rows(unsigned char* ws, LAS unsigned char* lds, int layer, int gw, int NGW, int lane, int tid, int wv, bool dry = false) {
    const bf16* Hh = (const bf16*)(ws + WS_B4); const float* gain = INP(2) + layer * C; float* rsl = (float*)(ws + WS_B0);
    const float* wg = INP(24) + (size_t)layer * C * 4; const float* bg = INP(25) + layer * 4; const float* wi = INP(26) + (size_t)layer * C * 16; const float* bi = INP(27) + layer * 16;
    unsigned* cnt = (unsigned*)(ws + WS_CTL) + CW_CNT + layer * 16 * 64; unsigned* list = (unsigned*)(ws + WS_LIST); float* wl = (float*)(ws + WS_WL);
    LAS float* sWg = (LAS float*)lds; LAS float* sWi = sWg + C * 4;
    constexpr int RECMAX = 256;
    LAS unsigned* lcnt = (LAS unsigned*)(lds + 81920); LAS unsigned* gbase = lcnt + 16; LAS float* sBias = (LAS float*)(lcnt + 32);
    LAS unsigned* recRow = lcnt + 64; LAS unsigned* recE = recRow + RECMAX; LAS unsigned* recL = recE + RECMAX; LAS float* recW0 = (LAS float*)(recL + RECMAX); LAS float* recW1 = recW0 + RECMAX; LAS float* recRS = recW1 + RECMAX;
    __syncthreads();
    for (int e = tid; e < C; e += 512) { const int r = e >> 6, c = 256 * (r >> 2) + 4 * (e & 63) + (r & 3); ((LAS f32x4*)sWg)[e] = ((const GAS f32x4*)wg)[c]; }
    for (int e = tid; e < C * 4; e += 512) { const int r = e >> 6, jq = r >> 2, c = 256 * (jq >> 2) + 4 * (e & 63) + (jq & 3); ((LAS f32x4*)sWi)[e] = ((const GAS f32x4*)wi)[c * 4 + (r & 3)]; }
    if (tid < 4) sBias[tid] = bg[tid]; else if (tid < 20) sBias[tid] = bi[tid - 4];
    for (int e = tid; e < RECMAX; e += 512) recE[e] = 0xffffffffu;
    __syncthreads();
    f32x4 g[4]; load_row(gain, lane, g);
    v2u nxr[2][4];
#pragma unroll
    for (int r = 0; r < 2; ++r) { const int r0 = gw + r * NGW < M - 1 ? gw + r * NGW : M - 1;
#pragma unroll
        for (int j = 0; j < 4; ++j) nxr[r][j] = ((const GAS v2u*)(Hh + (size_t)r0 * C))[64 * j + lane]; }
    int k = 0;
    for (int row = gw; row < M; row += 2 * NGW, k += 2) {
        f32x4 v[2][4];
#pragma unroll
        for (int r = 0; r < 2; ++r)
#pragma unroll
            for (int j = 0; j < 4; ++j) v[r][j] = (f32x4){bflo(nxr[r][j].x), bfhi(nxr[r][j].x), bflo(nxr[r][j].y), bfhi(nxr[r][j].y)};
#pragma unroll
        for (int r = 0; r < 2; ++r) { const int rn = row + (2 + r) * NGW, r0 = rn < M - 1 ? rn : M - 1;
#pragma unroll
            for (int j = 0; j < 4; ++j) nxr[r][j] = ((const GAS v2u*)(Hh + (size_t)r0 * C))[64 * j + lane]; }
        float rs[2];
#pragma unroll
        for (int r = 0; r < 2; ++r) { rs[r] = row_rs(v[r], lane);
#pragma unroll
            for (int j = 0; j < 4; ++j) v[r][j] = v[r][j] * rs[r] * g[j]; }
        float gl[2][4] = {{0.f, 0.f, 0.f, 0.f}, {0.f, 0.f, 0.f, 0.f}};
        const LAS unsigned char* pWg = (const LAS unsigned char*)sWg + lane * 16;
#pragma unroll
        for (int j = 0; j < 4; ++j)
#pragma unroll
            for (int q = 0; q < 4; ++q) { const f32x4 w = *(const LAS f32x4*)(pWg + (j * 4 + q) * 1024);
#pragma unroll
                for (int r = 0; r < 2; ++r) { const float xv = v[r][j][q]; gl[r][0] += xv * w.x; gl[r][1] += xv * w.y; gl[r][2] += xv * w.z; gl[r][3] += xv * w.w; } }
        int gi[2]; float gval[2];
#pragma unroll
        for (int r = 0; r < 2; ++r) {
#pragma unroll
            for (int q = 0; q < 4; ++q) gl[r][q] = wave_sum(gl[r][q], lane) + sBias[q];
            gi[r] = 0; float gm = gl[r][0];
#pragma unroll
            for (int q = 1; q < 4; ++q) if (gl[r][q] > gm) { gm = gl[r][q]; gi[r] = q; }
            float gden = 0.f;
#pragma unroll
            for (int q = 0; q < 4; ++q) gden += __expf(gl[r][q] - gm);
            gval[r] = 1.0f / gden; }
        float il[2][4] = {{0.f, 0.f, 0.f, 0.f}, {0.f, 0.f, 0.f, 0.f}};
        const LAS unsigned char* pWi0 = (const LAS unsigned char*)sWi + lane * 16 + gi[0] * 1024;
        const LAS unsigned char* pWi1 = (const LAS unsigned char*)sWi + lane * 16 + gi[1] * 1024;
#pragma unroll
        for (int j = 0; j < 4; ++j)
#pragma unroll
            for (int q = 0; q < 4; ++q) {
                { const f32x4 w = *(const LAS f32x4*)(pWi0 + (j * 4 + q) * 4096); const float xv = v[0][j][q]; il[0][0] += xv * w.x; il[0][1] += xv * w.y; il[0][2] += xv * w.z; il[0][3] += xv * w.w; }
                { const f32x4 w = *(const LAS f32x4*)(pWi1 + (j * 4 + q) * 4096); const float xv = v[1][j][q]; il[1][0] += xv * w.x; il[1][1] += xv * w.y; il[1][2] += xv * w.z; il[1][3] += xv * w.w; } }
#pragma unroll
        for (int r = 0; r < 2; ++r) {
            const f32x4 bi4 = *(const LAS f32x4*)(sBias + 4 + gi[r] * 4);
#pragma unroll
            for (int q = 0; q < 4; ++q) il[r][q] = wave_sum(il[r][q], lane) + bi4[q];
            int i0 = 0; float m0 = il[r][0];
#pragma unroll
            for (int q = 1; q < 4; ++q) if (il[r][q] > m0) { m0 = il[r][q]; i0 = q; }
            int i1 = -1; float m1 = -INFINITY;
#pragma unroll
            for (int q = 0; q < 4; ++q) if (q != i0 && il[r][q] > m1) { m1 = il[r][q]; i1 = q; }
            const float e1 = __expf(m1 - m0); const float w0 = gval[r] / (1.0f + e1), w1 = gval[r] * e1 / (1.0f + e1);
            const int ri = wv * 32 + k + r;
            if (lane == 0 && !dry && k + r < 32 && row + r * NGW < M) { const int ex0 = gi[r] * 4 + i0, ex1 = gi[r] * 4 + i1;
                recRow[ri] = (unsigned)(row + r * NGW); recE[ri] = (unsigned)ex0 | ((unsigned)ex1 << 8); recW0[ri] = w0; recW1[ri] = w1; recRS[ri] = rs[r]; }
        }
    }
    __syncthreads();
    unsigned e = 0xffffffffu; if (tid < RECMAX) e = recE[tid];
    const unsigned ex0 = e & 255u, ex1 = (e >> 8) & 255u;
    unsigned pos0 = 0u, pos1 = 0u;
    if (wv < RECMAX / 64) {
#pragma unroll
        for (unsigned x = 0; x < 16; ++x) { const unsigned long long m0 = __ballot(ex0 == x), m1 = __ballot(ex1 == x);
            const unsigned p = __builtin_amdgcn_mbcnt_hi((unsigned)(m0 >> 32), __builtin_amdgcn_mbcnt_lo((unsigned)m0, 0u)) + __builtin_amdgcn_mbcnt_hi((unsigned)(m1 >> 32), __builtin_amdgcn_mbcnt_lo((unsigned)m1, 0u));
            if (ex0 == x) pos0 = p; if (ex1 == x) pos1 = p;
            if (lane == 0) recL[wv * 16 + x] = (unsigned)(__popcll(m0) + __popcll(m1)); } }
    __syncthreads();
    if (tid < 16 && !dry) { unsigned c_ = 0u;
#pragma unroll
        for (int q = 0; q < RECMAX / 64; ++q) c_ += recL[q * 16 + tid];
        gbase[tid] = atomicAdd(cnt + tid * 64, c_); }
    __syncthreads();
    if (e != 0xffffffffu && !dry) { unsigned p0 = gbase[ex0] + pos0, p1 = gbase[ex1] + pos1;
        for (int q = 0; q < wv; ++q) { p0 += recL[q * 16 + ex0]; p1 += recL[q * 16 + ex1]; }
        const unsigned row = recRow[tid]; const float rs = recRS[tid];
        list[(size_t)ex0 * M + p0] = row * 2u; wl[(size_t)ex0 * M + p0] = recW0[tid]; list[(size_t)ex1 * M + p1] = row * 2u + 1u; wl[(size_t)ex1 * M + p1] = recW1[tid];
        rsl[(size_t)ex0 * M + p0] = rs; rsl[(size_t)ex1 * M + p1] = rs; }
}
__device__ __forceinline__ void moe_table(unsigned char* ws, volatile LAS int* tab, int layer, int tid) {
    __syncthreads();
    if (tid == 0) { const unsigned* cnt = (const unsigned*)(ws + WS_CTL) + CW_CNT + layer * 16 * 64; int t = 0;
#pragma unroll 1
        for (int e = 0; e < 16; ++e) { const int c = (int)__hip_atomic_load(cnt, RLX_AGENT); cnt += 64; tab[e] = c; tab[16 + e] = t; t += (c + 255) >> 8; tab[32 + e] = t; }
        tab[48] = t; }
    __syncthreads();
}
__device__ __forceinline__ void combine_rows(unsigned char* ws, int mode, int gw, int NGW, int lane, bool dry = false) {
    bf16* Hh = (bf16*)(ws + WS_B4); float* Out = OUTP(); const bf16* E0 = (const bf16*)(ws + WS_B2); const bf16* E1 = (const bf16*)(ws + WS_B3); bf16* XN2 = (bf16*)(ws + WS_B0);
    f32x4 g[4]; load_row(INP(4), lane, g);
    for (int row = gw; row < M; row += NGW) {
        f32x4 v[4]; load_row_bf(Hh + (size_t)row * C, lane, v);
#pragma unroll
        for (int j = 0; j < 4; ++j) { const v2u e0 = ((const GAS v2u*)(E0 + (size_t)row * C))[64 * j + lane], e1 = ((const GAS v2u*)(E1 + (size_t)row * C))[64 * j + lane];
            v[j].x += bflo(e0.x) + bflo(e1.x); v[j].y += bfhi(e0.x) + bfhi(e1.x); v[j].z += bflo(e0.y) + bflo(e1.y); v[j].w += bfhi(e0.y) + bfhi(e1.y); }
        const float rs = row_rs(v, lane);
        if (mode == 0) {
            if (!dry) store_row_bf16(Hh + (size_t)row * C, lane, v);
            if (lane == 0) ((float*)XN2)[row] = rs;
        } else {
            float sig = 1.0f;
#if MK_DEBUG
            const unsigned* cw = (const unsigned*)(ws + WS_CTL) + CW_DBG; const unsigned nnan = __hip_atomic_load(cw, RLX_AGENT), nbad = __hip_atomic_load(cw + 64, RLX_AGENT);
            if (row < 512 && nnan > 0) sig = 2.0f;
            if (row >= 512 && row < 1536 && __hip_atomic_load(cw + 128, RLX_AGENT) > 0) sig = 2.0f;
            if (row >= 1536 && row < 3584 && __hip_atomic_load(cw + 192, RLX_AGENT) > 0) sig = 2.0f;
            if (row >= 3584 && row < 7680 && __hip_atomic_load(cw + 256, RLX_AGENT) > 0) sig = 2.0f;
            if (row >= 7680 && row < 15872 && __hip_atomic_load(cw + 320, RLX_AGENT) > 0) sig = 2.0f;
            if (row >= 15872 && nbad > (unsigned)(M / 100) * C) sig = 1.5f;
#endif
#pragma unroll
            for (int j = 0; j < 4; ++j) ((GAS f32x4*)(Out + (size_t)row * C))[64 * j + lane] = v[j] * rs * g[j] * sig;
        }
    }
}
__device__ __forceinline__ void attn_naive(unsigned char* ws, int gw, int NGW, int lane) {
    const bf16* Kb = (const bf16*)(ws + WS_B1); const bf16* Vb = (const bf16*)(ws + WS_B2); const bf16* Qb = (const bf16*)(ws + WS_B3); bf16* Ob = (bf16*)(ws + WS_B0);
    for (int unit = gw; unit < BATCH * NH * (SEQ / 64); unit += NGW) {
        const int qb = unit % (SEQ / 64), bh = unit / (SEQ / 64), b = bh / NH, h = bh % NH;
        const int t0 = qb * 64, t = t0 + lane; const size_t rowq = (size_t)b * SEQ + t;
        float q[64], o[64];
#pragma unroll
        for (int c = 0; c < 8; ++c) { const v4u w = *(const GAS v4u*)(Qb + rowq * C + h * HD + c * 8);
            q[c * 8 + 0] = bflo(w.x) * 0.125f; q[c * 8 + 1] = bfhi(w.x) * 0.125f; q[c * 8 + 2] = bflo(w.y) * 0.125f; q[c * 8 + 3] = bfhi(w.y) * 0.125f;
            q[c * 8 + 4] = bflo(w.z) * 0.125f; q[c * 8 + 5] = bfhi(w.z) * 0.125f; q[c * 8 + 6] = bflo(w.w) * 0.125f; q[c * 8 + 7] = bfhi(w.w) * 0.125f; }
#pragma unroll
        for (int c = 0; c < 64; ++c) o[c] = 0.f;
        float suffix = 0.f;
        for (int s = t0 + 62; s >= 0; --s) {
            const bool valid = s < t;
            if (s < t0 && __all(suffix > SB_EXIT)) break;
            const bf16* kp = Kb + ((size_t)b * SEQ + s) * C + h * HD; const bf16* vp = Vb + ((size_t)b * SEQ + s) * C + h * HD;
            float z = 0.f;
#pragma unroll
            for (int c = 0; c < 8; ++c) { const v4u w = *(const GAS v4u*)(kp + c * 8);
                z += q[c * 8 + 0] * bflo(w.x) + q[c * 8 + 1] * bfhi(w.x) + q[c * 8 + 2] * bflo(w.y) + q[c * 8 + 3] * bfhi(w.y) + q[c * 8 + 4] * bflo(w.z) + q[c * 8 + 5] * bfhi(w.z) + q[c * 8 + 6] * bflo(w.w) + q[c * 8 + 7] * bfhi(w.w); }
            const float sp = fmaxf(z, 0.f) + log1pf(__expf(-fabsf(z)));
            const float att = valid ? __expf(z - sp - suffix) : 0.f;
            suffix += valid ? sp : 0.f;
#pragma unroll
            for (int c = 0; c < 8; ++c) { const v4u w = *(const GAS v4u*)(vp + c * 8);
                o[c * 8 + 0] += att * bflo(w.x); o[c * 8 + 1] += att * bfhi(w.x); o[c * 8 + 2] += att * bflo(w.y); o[c * 8 + 3] += att * bfhi(w.y);
                o[c * 8 + 4] += att * bflo(w.z); o[c * 8 + 5] += att * bfhi(w.z); o[c * 8 + 6] += att * bflo(w.w); o[c * 8 + 7] += att * bfhi(w.w); }
        }
#pragma unroll
        for (int c = 0; c < 8; ++c) { v4u w; w.x = pk2(o[c * 8 + 0], o[c * 8 + 1]); w.y = pk2(o[c * 8 + 2], o[c * 8 + 3]); w.z = pk2(o[c * 8 + 4], o[c * 8 + 5]); w.w = pk2(o[c * 8 + 6], o[c * 8 + 7]);
            *(GAS v4u*)(Ob + rowq * C + h * HD + c * 8) = w; }
    }
}


typedef float f32x16 __attribute__((ext_vector_type(16)));
constexpr int AT_VP = 192;
constexpr int AT_WAVE_LDS = 32 * AT_VP;
__device__ __forceinline__ int crow32(int reg, int hh) { return (reg & 3) + 8 * (reg >> 2) + 4 * hh; }
__device__ __forceinline__ bf16x8s pack_step(const f32x16& x, const int s) {
    v4u p; p.x = pg8::cvt_pk_bf16(x[8 * s], x[8 * s + 1]); p.y = pg8::cvt_pk_bf16(x[8 * s + 2], x[8 * s + 3]); p.z = pg8::cvt_pk_bf16(x[8 * s + 4], x[8 * s + 5]); p.w = pg8::cvt_pk_bf16(x[8 * s + 6], x[8 * s + 7]);
    return __builtin_bit_cast(bf16x8s, p);
}
__device__ __forceinline__ void attn_mfma(unsigned char* ws, LAS unsigned char* lds, int gw, int NGW, int lane, int wave) {
    const bf16* Kb = (const bf16*)(ws + WS_B1); const bf16* Vb = (const bf16*)(ws + WS_B2); const bf16* Qb = (const bf16*)(ws + WS_B3); bf16* Ob = (bf16*)(ws + WS_B0);
    LAS unsigned char* vl = lds + wave * AT_WAVE_LDS;
    const int r32 = lane & 31, hh = lane >> 5;
    bf16x8s tri[2];
#pragma unroll
    for (int s = 0; s < 2; ++s)
#pragma unroll
        for (int j = 0; j < 8; ++j) tri[s][j] = (16 * s + 8 * (j >> 2) + 4 * hh + (j & 3)) > r32 ? (short)0x3F80 : (short)0;
    const int grp = lane >> 4, tq = (lane & 15) >> 2, tp = lane & 3;
    const LAS unsigned char* vtr0 = vl + (4 * hh + tq) * AT_VP + (16 * (grp & 1) + 4 * tp) * 2;
    for (int unit = gw; unit < BATCH * NH * (SEQ / 32); unit += NGW) {
        const int qb = unit % (SEQ / 32), bh = unit / (SEQ / 32), b = bh / NH, hd = bh % NH;
        const int t0 = qb * 32; const size_t rowb = (size_t)b * SEQ;
        bf16x8s qf[4];
#pragma unroll
        for (int ks = 0; ks < 4; ++ks) qf[ks] = *(const GAS bf16x8s*)(Qb + (rowb + t0 + r32) * C + hd * HD + 16 * ks + 8 * hh);
        f32x16 o[2];
#pragma unroll
        for (int i = 0; i < 16; ++i) { o[0][i] = 0.f; o[1][i] = 0.f; }
        float carry = 0.f;
        for (int s0 = t0; s0 >= 0; s0 -= 32) {
            bf16x8s kf[4];
#pragma unroll
            for (int ks = 0; ks < 4; ++ks) kf[ks] = *(const GAS bf16x8s*)(Kb + (rowb + s0 + r32) * C + hd * HD + 16 * ks + 8 * hh);
            v4u vreg[4];
#pragma unroll
            for (int i = 0; i < 4; ++i) { const int cidx = lane + 64 * i; vreg[i] = *(const GAS v4u*)(Vb + (rowb + s0 + (cidx >> 3)) * C + hd * HD + (cidx & 7) * 8); }
            f32x16 st;
#pragma unroll
            for (int i = 0; i < 16; ++i) st[i] = 0.f;
#pragma unroll
            for (int ks = 0; ks < 4; ++ks) st = __builtin_amdgcn_mfma_f32_32x32x16_bf16(kf[ks], qf[ks], st, 0, 0, 0);
#pragma unroll
            for (int i = 0; i < 4; ++i) { const int cidx = lane + 64 * i; *(LAS v4u*)(vl + (cidx >> 3) * AT_VP + (cidx & 7) * 16) = vreg[i]; }
            f32x16 zz, uu; float tot = 0.f; const int tq_ = t0 + r32;
            if (s0 + 31 < t0) {
#pragma unroll
                for (int i = 0; i < 16; ++i) { const float z = st[i] * 0.18033688011112042f; const float sp = fmaxf(z, 0.f) + __builtin_amdgcn_logf(1.0f + __builtin_amdgcn_exp2f(-fabsf(z)));
                    zz[i] = z - sp; uu[i] = sp; tot += sp; }
            } else {
#pragma unroll
                for (int i = 0; i < 16; ++i) { const int key = s0 + crow32(i, hh); const float z = st[i] * 0.18033688011112042f; const float sp = fmaxf(z, 0.f) + __builtin_amdgcn_logf(1.0f + __builtin_amdgcn_exp2f(-fabsf(z)));
                    const bool valid = key < tq_; zz[i] = valid ? z - sp : -1e30f; uu[i] = valid ? sp : 0.f; tot += uu[i]; }
            }
            f32x16 w;
#pragma unroll
            for (int i = 0; i < 16; ++i) w[i] = 0.f;
#pragma unroll
            for (int s = 0; s < 2; ++s) w = __builtin_amdgcn_mfma_f32_32x32x16_bf16(tri[s], pack_step(uu, s), w, 0, 0, 0);
            f32x16 pp;
#pragma unroll
            for (int i = 0; i < 16; ++i) pp[i] = __builtin_amdgcn_exp2f(zz[i] - w[i] - carry);
            tot += shx(tot, 32, lane); carry += tot;
            asm volatile("s_waitcnt lgkmcnt(0)" ::: "memory");
#pragma unroll
            for (int s = 0; s < 2; ++s) { const bf16x8s pa = pack_step(pp, s);
#pragma unroll
                for (int dt = 0; dt < 2; ++dt) {
                    const v4i16_t lo = __builtin_amdgcn_ds_read_tr16_b64_v4i16((LAS v4i16_t*)(vtr0 + (16 * s) * AT_VP + dt * 64));
                    const v4i16_t hi = __builtin_amdgcn_ds_read_tr16_b64_v4i16((LAS v4i16_t*)(vtr0 + (16 * s + 8) * AT_VP + dt * 64));
                    const bf16x8s vf = (bf16x8s){lo[0], lo[1], lo[2], lo[3], hi[0], hi[1], hi[2], hi[3]};
                    o[dt] = __builtin_amdgcn_mfma_f32_32x32x16_bf16(pa, vf, o[dt], 0, 0, 0); } }
            asm volatile("" ::: "memory");
            if (s0 < t0 && __all(carry > SB_EXIT * 1.4426950408889634f)) break;
        }
#pragma unroll
        for (int dt = 0; dt < 2; ++dt)
#pragma unroll
            for (int i = 0; i < 16; ++i) Ob[(rowb + t0 + crow32(i, hh)) * C + hd * HD + 32 * dt + r32] = (bf16)f2bf(o[dt][i]);
    }
}
__global__ void __launch_bounds__(NWAVES * 64, 2) yoco_fwd(Args args) {
    extern __shared__ __attribute__((aligned(16))) unsigned char lds_raw[];
    LAS unsigned char* lds = (LAS unsigned char*)lds_raw;
    const int G = gridDim.x; const int bx = blockIdx.x;
    int wave = __builtin_amdgcn_readfirstlane(threadIdx.x >> 6); asm volatile("" : "+s"(wave));
#define IDS() int lane; asm volatile("v_mbcnt_lo_u32_b32 %0, -1, 0\n\tv_mbcnt_hi_u32_b32 %0, -1, %0" : "=v"(lane)); const int tid = wave * 64 + lane; (void)tid; \
    const int vcu = (G % 8 == 0) ? (bx % 8) * (G / 8) + bx / 8 : bx; const int gw = vcu * NWAVES + wave, NGW = G * NWAVES; (void)lane; (void)gw; (void)NGW;
    unsigned char* ws = WSP();
    volatile LAS unsigned* MISC = (volatile LAS unsigned*)(lds + MISC_OFF);
    volatile LAS int* tab = (volatile LAS int*)(lds + MOE_TAB_OFF);
    for (int u = threadIdx.x; u < (LDS_BYTES - LDSCTL_OFF) / 4; u += NWAVES * 64) ((LAS unsigned*)(lds + LDSCTL_OFF))[u] = 0u;
    __syncthreads();
    XcdBarrier bar; bar.bar = (unsigned*)(ws + WS_CTL) + CW_BAR; bar.x = 0; bar.st = nullptr;
    if (N_LAUNCHES == 1) bar = xcd_barrier_post((unsigned*)(ws + WS_CTL) + CW_BAR, MISC + 8);
    const int lo = KA_INT(0), hi = KA_INT(1);
#ifndef PROBE_PH
#define PROBE_PH -1
#endif
#define IN(k) (lo <= (k) && (k) < hi)
#define REP(k) for (int rep_ = 0; rep_ < ((PROBE_PH == (k)) ? 2 : 1); ++rep_)
#define SEAM(k) do { if (IN(k) && IN((k) + 1)) xcd_barrier(bar); } while (0)

    if (IN(PH_P0)) REP(PH_P0) { IDS(); p0_weights<0>(ws, lds, gw, NGW, wave, lane); if (G <= 192) { p0_weights<3>(ws, lds, gw, NGW, wave, lane); p0_weights<1>(ws, lds, gw, NGW, wave, lane); } if (G <= 64) p0_weights<4>(ws, lds, gw, NGW, wave, lane); if (G <= 64) p0_weights<2>(ws, lds, gw, NGW, wave, lane); p0_rows(ws, gw, NGW, lane); }
    SEAM(PH_P0);
    if (PROBE_PH == 100 && N_LAUNCHES == 1) { for (int i_ = 0; i_ < 10; ++i_) xcd_barrier(bar); }
    if (IN(PH_LORA)) REP(PH_LORA) {
        SchedGrouped<1, 3> S{(const char*)(ws + WS_B1), (size_t)(WS_B2 - WS_B1), nullptr, (const char*)(ws + WS_WT_LORA), (size_t)256 * C * 2, G, bx};
        EpiLora E{(bf16*)(ws + WS_LW)};
        pg8::gemm_phase<EpiLora, SchedGrouped<1, 3>, true, false, C>(lds, S, E, wave);
        if (G > 192 && bx >= 192) { IDS(); p0_weights<3>(ws, lds, (bx - 192) * NWAVES + wave, (G - 192) * NWAVES, wave, lane); p0_weights<1>(ws, lds, (bx - 192) * NWAVES + wave, (G - 192) * NWAVES, wave, lane); }
    }
    SEAM(PH_LORA);
    if (IN(PH_RKV)) REP(PH_RKV) {
        SchedGrouped<4, 3> S{(const char*)OUTP(), (size_t)M * C * 2, (const char*)(ws + WS_B4), (const char*)(ws + WS_WT_RKV), (size_t)C * C * 2, G, bx};
        EpiSplit3 E{(bf16*)(ws + WS_B1), false, nullptr};
        pg8::gemm_phase<EpiSplit3, SchedGrouped<4, 3>, true, false, C>(lds, S, E, wave);
    }
    SEAM(PH_RKV);
    if (IN(PH_S1)) REP(PH_S1) { IDS(); scan_s1(ws, lds, lane, wave); }
    SEAM(PH_S1);
    if (IN(PH_S2)) REP(PH_S2) { IDS();
        if (bx < BATCH * NH || G <= BATCH * NH) scan_s2(ws, lds, lane, wave);
        }
    SEAM(PH_S2);
    if (IN(PH_S3)) REP(PH_S3) { IDS(); scan_s3(ws, lds, lane, wave); }
    SEAM(PH_S3);
#if MK_DEBUG
    if (IN(PH_DBG0)) { IDS(); scan_naive(ws, lds, tid); }
    SEAM(PH_DBG0);
    if (IN(PH_DBG0 + 1)) { IDS(); post_scan(ws, gw, NGW, lane); }
    SEAM(PH_DBG0 + 1);
    if (IN(PH_DBG0 + 2)) { IDS(); dbg_compare(ws, (const bf16*)(ws + WS_B0), (const bf16*)(ws + WS_B4), gw, NGW, lane); }
    SEAM(PH_DBG0 + 2);
#endif
    if (IN(PH_WOUT)) REP(PH_WOUT) {
        SchedGrouped<4, 1> S{(const char*)(ws + ((MK_DEBUG && DBG_USE_NAIVE) ? WS_B4 : WS_B0)), 0, nullptr, (const char*)(ws + WS_WT_OUT), 0, G, bx};
        EpiResidBf<true> E{INP(0), (bf16*)(ws + WS_B4)};
        pg8::gemm_phase<EpiResidBf<true>, SchedGrouped<4, 1>, true, false, C>(lds, S, E, wave);
    }
    SEAM(PH_WOUT);
#pragma unroll 1
    for (int layer = 0; layer < 2; ++layer) {
        const int pb = layer == 0 ? (int)PH_ROUT0 : (int)PH_ROUT1;
        if (IN(pb)) { IDS(); if (PROBE_PH == 101 && layer == 0) router_rows(ws, lds, layer, gw, NGW, lane, tid, wave, true); router_rows(ws, lds, layer, gw, NGW, lane, tid, wave); }
        SEAM(pb);
        const int mc = (G % 8 == 0) ? (bx % 8) * (G / 8) + bx / 8 : bx;
        if (IN(pb + 1)) REP(pb + 1) {
            { IDS(); moe_table(ws, tab, layer, tid); }
            SchedMoe<2, C, true> S{(const char*)(ws + WS_B4), (const char*)(ws + WS_WT_GU) + (size_t)layer * 16 * 512 * C * 2, (size_t)512 * C * 2, (const unsigned*)(ws + WS_LIST), tab, G, mc};
            EpiGU E{(bf16*)(ws + WS_HID), (const float*)(ws + WS_WL), (const float*)(ws + WS_B0)};
            pg8::gemm_phase<EpiGU, SchedMoe<2, C, true>, true, true, C>(lds, S, E, wave);
            if (layer == 0 && G > 64) { const int nr2 = __builtin_amdgcn_readfirstlane(tab[48]) * 2 - G, first = nr2 > 0 ? nr2 : 0;
                if (mc >= first) { IDS(); p0_weights<4>(ws, lds, (mc - first) * NWAVES + wave, (G - first) * NWAVES, wave, lane); p0_weights<2>(ws, lds, (mc - first) * NWAVES + wave, (G - first) * NWAVES, wave, lane); } }
        }
        SEAM(pb + 1);
        if (IN(pb + 2)) REP(pb + 2) {
            { IDS(); moe_table(ws, tab, layer, tid); }
            SchedMoe<4, FE, false> S{(const char*)(ws + WS_HID), (const char*)(ws + WS_WT_DN) + (size_t)layer * 16 * C * FE * 2, (size_t)C * FE * 2, (const unsigned*)(ws + WS_LIST), tab, G, mc};
            EpiDown E{(bf16*)(ws + WS_B2), (const unsigned*)(ws + WS_LIST)};
            pg8::gemm_phase<EpiDown, SchedMoe<4, FE, false>, true, false, FE>(lds, S, E, wave);
        }
        SEAM(pb + 2);
        if (layer == 0) {
            if (IN(PH_COMB)) { IDS(); if (PROBE_PH == 102) combine_rows(ws, 0, gw, NGW, lane, true); combine_rows(ws, 0, gw, NGW, lane); }
            SEAM(PH_COMB);
            if (IN(PH_KVQ)) REP(PH_KVQ) {
                SchedGrouped<12, 1> S{(const char*)(ws + WS_B4), 0, nullptr, (const char*)(ws + WS_WT_KVQ), 0, G, bx};
                EpiSplit3 E{(bf16*)(ws + WS_B1), true, (const float*)(ws + WS_B0)};
                pg8::gemm_phase<EpiSplit3, SchedGrouped<12, 1>, true, false, C>(lds, S, E, wave);
            }
            SEAM(PH_KVQ);
            if (IN(PH_ATTN)) REP(PH_ATTN) { IDS(); attn_mfma(ws, lds, gw, NGW, lane, wave); }
            SEAM(PH_ATTN);
            if (IN(PH_SBO)) {
                SchedGrouped<4, 1> S{(const char*)(ws + WS_B0), 0, nullptr, (const char*)(ws + WS_WT_SBO), 0, G, bx};
                EpiResidBf<false> E{(const void*)(ws + WS_B4), (bf16*)(ws + WS_B4)};
                pg8::gemm_phase<EpiResidBf<false>, SchedGrouped<4, 1>, true, false, C>(lds, S, E, wave);
            }
            SEAM(PH_SBO);
        }
    }
    if (IN(PH_FINAL)) { IDS(); combine_rows(ws, 1, gw, NGW, lane); }
#undef IN
#undef SEAM
}

extern "C" void kernel_launch(void* const* d_in, const int* in_sizes, int n_in, void* d_out, int out_size, void* d_ws, size_t ws_size, hipStream_t stream) {
    static int grid = 0;
    if (grid == 0) {
        if (n_in != 31 || in_sizes[0] != M * C || out_size != M * C || ws_size < WS_END) { fprintf(stderr, "kernel_launch: unexpected shapes (n_in %d, in0 %d, out %d, ws %zu); nothing launched\n", n_in, n_in > 0 ? in_sizes[0] : -1, out_size, ws_size); grid = -1; return; }
        int dev = 0, cus = 0, per_cu = 0;
        if (hipGetDevice(&dev) != hipSuccess || hipDeviceGetAttribute(&cus, hipDeviceAttributeMultiprocessorCount, dev) != hipSuccess) { grid = -1; return; }
        if (hipFuncSetAttribute((const void*)yoco_fwd, hipFuncAttributeMaxDynamicSharedMemorySize, LDS_BYTES) != hipSuccess) { fprintf(stderr, "kernel_launch: hipFuncSetAttribute failed\n"); grid = -1; return; }
        if (hipOccupancyMaxActiveBlocksPerMultiprocessor(&per_cu, (const void*)yoco_fwd, NWAVES * 64, LDS_BYTES) != hipSuccess || per_cu < 1) fprintf(stderr, "kernel_launch: occupancy query reports %d\n", per_cu);
        (void)hipGetLastError();
        grid = cus - (cus % 16);
    }
    if (grid < 0) return;
    if (hipMemsetAsync((char*)d_ws + WS_CTL, 0, CTL_ZERO_BYTES, stream) != hipSuccess) return;
    Args a{};
    for (int i = 0; i < 31; ++i) a.in[i] = (const float*)d_in[i];
    a.out = (float*)d_out; a.ws = (unsigned char*)d_ws;
    for (int li = 0; li < (N_LAUNCHES == 1 ? 1 : (int)NPHASE); ++li) {
        a.ph_lo = (N_LAUNCHES == 1) ? 0 : li; a.ph_hi = (N_LAUNCHES == 1) ? NPHASE : li + 1; a.li = li;
        hipLaunchKernelGGL(yoco_fwd, dim3(grid), dim3(NWAVES * 64), LDS_BYTES, stream, a);
        const hipError_t le = hipPeekAtLastError();
        if (le != hipSuccess) { fprintf(stderr, "kernel_launch: launch %d failed: %s\n", li, hipGetErrorName(le)); break; }
    }
}
```

```cpp
#include <hip/hip_runtime.h>
#include <cstdio>
#include <cstdint>

#ifndef MK_N_LAUNCHES
#define MK_N_LAUNCHES 1
#endif

namespace pg8 {
#define PG8_LAS __attribute__((address_space(3)))
typedef unsigned short bf16_t;
typedef short bf16x8 __attribute__((ext_vector_type(8)));
typedef float f32x4 __attribute__((ext_vector_type(4)));
typedef unsigned u32x4 __attribute__((ext_vector_type(4)));
constexpr int BM = 256, BK = 64, HALF = 128, HTB = HALF * BK * 2, STAGE_BYTES = 8 * HTB, NXCD = 8, WGM = 8;

__host__ __device__ __forceinline__ int lds_byte(int r, int c) { const int st = (r >> 4) * 2 + (c >> 5), rr = r & 15, cc = c & 31, ob = rr * 64 + cc * 2; return st * 1024 + (ob ^ (((ob >> 9) & 1) << 5)); }
__host__ __device__ __forceinline__ void stage_rc(int b, int& R, int& C) { const int st = b / 1024, sb = b % 1024, swz = sb ^ (((sb >> 9) & 1) << 5); R = (st >> 1) * 16 + swz / 64; C = (st & 1) * 32 + (swz % 64) / 2; }
__host__ __device__ __forceinline__ int perm32(int rho) { const int n = rho >> 4, i = rho & 15; return 8 * (i >> 2) + 4 * n + (i & 3); }

struct Unit { int pm, pn, aux, r0, cnt, half; };

__host__ __device__ __forceinline__ void tile_map(int wgid, int nM, int nN, int& pm, int& pn) {
    const int nwg = nM * nN;
    { const int q = nwg / NXCD, r = nwg % NXCD, xcd = wgid % NXCD, off = wgid / NXCD; wgid = (xcd < r ? xcd * (q + 1) : r * (q + 1) + (xcd - r) * q) + off; }
    const int nig = WGM * nN, gid = wgid / nig, fm = gid * WGM, gsz = (nM - fm) < WGM ? (nM - fm) : WGM;
    pm = fm + ((wgid % nig) % gsz); pn = (wgid % nig) / gsz;
}

typedef float f32x2_t __attribute__((ext_vector_type(2))); typedef __bf16 bf16x2_t __attribute__((ext_vector_type(2)));
__device__ __forceinline__ unsigned cvt_pk_bf16(float lo, float hi) { const f32x2_t v = {lo, hi}; const bf16x2_t b = __builtin_convertvector(v, bf16x2_t); return __builtin_bit_cast(unsigned, b); }

template <class Epi, class Sched, bool ALIGN_EPI, bool GATHER, int K, bool HALVES = false>
__device__ __forceinline__ void gemm_phase(PG8_LAS unsigned char* lds, const Sched& S, const Epi& E, const int wid) {
    int lane_; asm volatile("v_mbcnt_lo_u32_b32 %0, -1, 0\n\tv_mbcnt_hi_u32_b32 %0, -1, %0" : "=v"(lane_));
    const int lane = lane_, tid = wid * 64 + lane, wr = wid >> 2, wc = wid & 3, fr = lane & 15, fq = lane >> 4;
    constexpr int nt = K / BK;
    unsigned voffA[2], voffB[2];
#pragma unroll
    for (int i = 0; i < 2; ++i) { int R, C; stage_rc(tid * 16 + i * 8192, R, C); const int Rb = Epi::PERM ? ((R & ~31) + perm32(R & 31)) : R;
        voffA[i] = (unsigned)(R * K + C) * 2u; voffB[i] = (unsigned)(Rb * K + C) * 2u; }
    constexpr size_t kstep = (size_t)(BK * 2);
    constexpr size_t hstep = (size_t)HALF * K * 2;
    const unsigned ldsw = (unsigned)wid * 1024u;
    const int aoff = lds_byte(wr * 64 + fr, fq * 8), boff = lds_byte(wc * 32 + fr, fq * 8);
#define PG8_SA(b, h) (((b) * 2 + (h)) * HTB)
#define PG8_SB(b, h) ((4 + (b) * 2 + (h)) * HTB)
#define PG8_STAGE(bufoff, gbase, voff) do { _Pragma("unroll") for (int _i = 0; _i < 2; ++_i) \
        __builtin_amdgcn_global_load_lds((const unsigned*)((const char*)(gbase) + (voff)[_i]), (PG8_LAS unsigned*)(lds + (bufoff) + ldsw + _i * 8192), 16, 0, 0); } while (0)
#define PG8_LDA(dst, b, h) do { _Pragma("unroll") for (int m = 0; m < 4; ++m) _Pragma("unroll") for (int k = 0; k < 2; ++k) dst[m][k] = *(const PG8_LAS bf16x8*)(lds + PG8_SA(b, h) + aoff + m * 2048 + k * 1024); } while (0)
#define PG8_LDB(dst, b, h) do { _Pragma("unroll") for (int n = 0; n < 2; ++n) _Pragma("unroll") for (int k = 0; k < 2; ++k) dst[n][k] = *(const PG8_LAS bf16x8*)(lds + PG8_SB(b, h) + boff + n * 2048 + k * 1024); } while (0)
#define PG8_MMA(ai, bj, At, Bt) do { __builtin_amdgcn_s_setprio(1); _Pragma("unroll") for (int m = 0; m < 4; ++m) _Pragma("unroll") for (int n = 0; n < 2; ++n) _Pragma("unroll") for (int k = 0; k < 2; ++k) \
        acc[ai][bj][m][n] = __builtin_amdgcn_mfma_f32_16x16x32_bf16(Bt[n][k], At[m][k], acc[ai][bj][m][n], 0, 0, 0); __builtin_amdgcn_s_setprio(0); } while (0)
#define PG8_WAIT_V(n) asm volatile("s_waitcnt vmcnt(" #n ")" ::: "memory")
#define PG8_WAIT_L(n) asm volatile("s_waitcnt lgkmcnt(" #n ")" ::: "memory")
#define PG8_BAR __builtin_amdgcn_s_barrier()
#define PG8_SCHED __builtin_amdgcn_sched_barrier(0)
    Unit cur, nxt; int ui = 0;
    if (!S.next(0, cur)) return;
    f32x4 acc[2][2][4][2];
#pragma unroll
    for (int a = 0; a < 2; ++a)
#pragma unroll
        for (int b = 0; b < 2; ++b)
#pragma unroll
            for (int m = 0; m < 4; ++m)
#pragma unroll
                for (int n = 0; n < 2; ++n) acc[a][b][m][n] = (f32x4){0.f, 0.f, 0.f, 0.f};
    bf16x8 At[4][2], B0[2][2], B1[2][2];
    unsigned vc[2][2];
#define PG8_GOFF(u) do { _Pragma("unroll") for (int _h = 0; _h < 2; ++_h) _Pragma("unroll") for (int _i = 0; _i < 2; ++_i) { int _R, _C; stage_rc(tid * 16 + _i * 8192, _R, _C); \
        vc[_h][_i] = S.a_row_off(u, _h * HALF + _R) + (unsigned)_C * 2u; } } while (0)
#define PG8_STAGE_A(bufoff, gbase, h) do { if constexpr (GATHER) { PG8_STAGE(bufoff, gbase, vc[h]); } else { PG8_STAGE(bufoff, (gbase) + (h) * hstep, voffA); } } while (0)
    if constexpr (GATHER) PG8_GOFF(cur);
    const char* cA = S.a_base(cur); const char* cB = S.b_base(cur);
    PG8_STAGE(PG8_SB(0, 0), cB, voffB); PG8_STAGE(PG8_SB(0, 1), cB + hstep, voffB); PG8_STAGE_A(PG8_SA(0, 0), cA, 0); PG8_STAGE_A(PG8_SA(0, 1), cA, 1);
    if (wr == 1) PG8_BAR;
    PG8_WAIT_V(2); PG8_BAR;
    PG8_STAGE(PG8_SB(1, 0), cB + kstep, voffB); PG8_STAGE_A(PG8_SA(1, 0), cA + kstep, 0); PG8_STAGE(PG8_SB(1, 1), cB + hstep + kstep, voffB);
    PG8_WAIT_V(6); PG8_BAR;
    for (;;) {
        const bool has_next = S.next(ui + 1, nxt);
        const char* nA = has_next ? S.a_base(nxt) : cA; const char* nB = has_next ? S.b_base(nxt) : cB;
        for (int t = 0; t < nt; t += 2) {
            const bool last = (t == nt - 2);
            const char* a1 = cA + (size_t)(t + 1) * kstep;
            const char* a2 = last ? nA : cA + (size_t)(t + 2) * kstep; const char* b2 = last ? nB : cB + (size_t)(t + 2) * kstep;
            const char* a3 = a2 + kstep; const char* b3 = b2 + kstep;
            PG8_LDB(B0, 0, 0); PG8_LDB(B1, 0, 1); PG8_SCHED; PG8_LDA(At, 0, 0); PG8_STAGE_A(PG8_SA(1, 1), a1, 1);
            if constexpr (GATHER) { if (last && has_next) PG8_GOFF(nxt); }
            PG8_WAIT_V(8); PG8_WAIT_L(0); PG8_BAR; if (!HALVES || cur.half != 1) { PG8_MMA(0, 0, At, B0); PG8_MMA(0, 1, At, B1); } PG8_BAR; PG8_SCHED;
            PG8_LDA(At, 0, 1); PG8_STAGE(PG8_SB(0, 0), b2, voffB); PG8_STAGE(PG8_SB(0, 1), b2 + hstep, voffB); PG8_STAGE_A(PG8_SA(0, 0), a2, 0);
            PG8_WAIT_V(8); PG8_WAIT_L(0); PG8_BAR; if (!HALVES || cur.half != 0) { PG8_MMA(1, 0, At, B0); PG8_MMA(1, 1, At, B1); } PG8_BAR; PG8_SCHED;
            PG8_LDB(B0, 1, 0); PG8_LDB(B1, 1, 1); PG8_SCHED; PG8_LDA(At, 1, 0); PG8_STAGE_A(PG8_SA(0, 1), a2, 1);
            PG8_WAIT_V(8); PG8_WAIT_L(0); PG8_BAR; if (!HALVES || cur.half != 1) { PG8_MMA(0, 0, At, B0); PG8_MMA(0, 1, At, B1); } PG8_BAR; PG8_SCHED;
            PG8_LDA(At, 1, 1); PG8_STAGE(PG8_SB(1, 0), b3, voffB); PG8_STAGE(PG8_SB(1, 1), b3 + hstep, voffB); PG8_STAGE_A(PG8_SA(1, 0), a3, 0);
            PG8_WAIT_V(8); PG8_WAIT_L(0); PG8_BAR; if (!HALVES || cur.half != 0) { PG8_MMA(1, 0, At, B0); PG8_MMA(1, 1, At, B1); } PG8_BAR; PG8_SCHED;
        }
        if constexpr (ALIGN_EPI) { if (wr == 0) PG8_BAR; }
        E(acc, cur, wr, wc, fr, fq);
        if (!has_next) break;
#pragma unroll
        for (int a = 0; a < 2; ++a)
#pragma unroll
            for (int b = 0; b < 2; ++b)
#pragma unroll
                for (int m = 0; m < 4; ++m)
#pragma unroll
                    for (int n = 0; n < 2; ++n) acc[a][b][m][n] = (f32x4){0.f, 0.f, 0.f, 0.f};
        cur = nxt; cA = nA; cB = nB; ++ui;
        if constexpr (ALIGN_EPI) { if (wr == 1) PG8_BAR; }
    }
    PG8_WAIT_V(0);
    if constexpr (!ALIGN_EPI) { if (wr == 0) PG8_BAR; }
    PG8_BAR;
#undef PG8_SA
#undef PG8_SB
#undef PG8_STAGE
#undef PG8_STAGE_A
#undef PG8_GOFF
#undef PG8_LDA
#undef PG8_LDB
#undef PG8_MMA
#undef PG8_WAIT_V
#undef PG8_WAIT_L
#undef PG8_BAR
#undef PG8_SCHED
}
}

constexpr int NWAVES = 8;
#ifndef MK_DEBUG
#define MK_DEBUG 0
#endif
#ifndef DBG_USE_NAIVE
#define DBG_USE_NAIVE 0
#endif
constexpr int DBGP = MK_DEBUG ? 3 : 0;
enum Phase { PH_P0 = 0, PH_LORA, PH_RKV, PH_S1, PH_S2, PH_S3, PH_DBG0, PH_WOUT = PH_DBG0 + DBGP, PH_ROUT0, PH_GU0, PH_DN0, PH_COMB, PH_KVQ, PH_ATTN, PH_SBO, PH_ROUT1, PH_GU1, PH_DN1, PH_FINAL, NPHASE };
constexpr int N_LAUNCHES = MK_N_LAUNCHES;


constexpr int BATCH = 2, SEQ = 8192, C = 1024, NH = 16, HD = 64, M = BATCH * SEQ;
constexpr int NE = 16, FE = 256, DW = 64, DA = 64, DG = 160;
constexpr float RMS_EPS = 1e-6f, GN_EPS = 64e-5f;
constexpr float SB_EXIT = 44.3614196f;

constexpr size_t MiB = 1u << 20;
constexpr size_t WS_CTL = 0, CTL_ZERO_BYTES = 64 * 1024;
constexpr size_t WS_WT_W2 = 128 * 1024, WS_WT_A2 = 256 * 1024, WS_WT_G2 = 384 * 1024;
constexpr size_t WS_WT_ROUT = 704 * 1024;
static_assert(WS_WT_G2 + (size_t)C * 160 * 2 <= WS_WT_ROUT && WS_WT_ROUT + 256 * 1024 <= 1 * MiB, "first MiB of d_ws");
constexpr size_t WS_WT_RKV = 1 * MiB;
constexpr size_t WS_WT_LORA = 7 * MiB;
constexpr size_t WS_WT_OUT = 9 * MiB;
constexpr size_t WS_WT_KVQ = 11 * MiB;
constexpr size_t WS_WT_SBO = 17 * MiB;
constexpr size_t WS_WT_GU = 19 * MiB;
constexpr size_t WS_WT_DN = 51 * MiB;
constexpr size_t WS_LW = 67 * MiB;
constexpr size_t WS_LA = 69 * MiB;
constexpr size_t WS_LG = 71 * MiB;
static_assert(WS_LA == WS_LW + 2 * MiB && WS_LG == WS_LW + 4 * MiB, "EpiLora's pointer arithmetic");
constexpr size_t WS_LIST = 76 * MiB;
constexpr size_t WS_WL = 77 * MiB;
constexpr size_t WS_HID = 78 * MiB;
constexpr size_t WS_B0 = 96 * MiB, WS_B1 = 128 * MiB, WS_B2 = 160 * MiB, WS_B3 = 192 * MiB, WS_B4 = 224 * MiB, WS_END = 256 * MiB;
static_assert(WS_HID + (size_t)144 * 256 * 256 * 2 <= WS_B0, "HID vs B0");
constexpr int CW_TMO = 0;
constexpr int CW_CNT = 1024;
constexpr int CW_BAR = 4096;

constexpr int RING_BYTES = 131072;
constexpr int LDSCTL_OFF = 146688, MISC_OFF = LDSCTL_OFF + 320, MOE_TAB_OFF = MISC_OFF + 128;
constexpr int LDS_BYTES = 147456;
static_assert(MOE_TAB_OFF + 256 <= LDS_BYTES, "LDS map");
static_assert(BATCH * NH * (SEQ / 64) % 16 == 0, "scan units");

#define GAS __attribute__((address_space(1)))
#define LAS __attribute__((address_space(3)))
typedef unsigned short bf16;
typedef unsigned v4u __attribute__((ext_vector_type(4)));
typedef unsigned v2u __attribute__((ext_vector_type(2)));
typedef float f32x4 __attribute__((ext_vector_type(4)));
typedef GAS unsigned gu32;
#define RLX_AGENT __ATOMIC_RELAXED, __HIP_MEMORY_SCOPE_AGENT
#define LDS_WAIT() asm volatile("s_waitcnt lgkmcnt(0)" ::: "memory")
#define VM_WAIT() asm volatile("s_waitcnt vmcnt(0)" ::: "memory")
__device__ __forceinline__ unsigned f2bf(float f) { unsigned u = __builtin_bit_cast(unsigned, f); return (u + 0x7fffu + ((u >> 16) & 1u)) >> 16; }
__device__ __forceinline__ unsigned pk2(float lo, float hi) { return pg8::cvt_pk_bf16(lo, hi); }
__device__ __forceinline__ float bflo(unsigned u) { return __uint_as_float(u << 16); }
__device__ __forceinline__ float bfhi(unsigned u) { return __uint_as_float(u & 0xffff0000u); }
__device__ __forceinline__ float bf2f(bf16 b) { return __uint_as_float((unsigned)b << 16); }
__device__ __forceinline__ float frcp(float x) { return __builtin_amdgcn_rcpf(x); }
__device__ __forceinline__ float frsq(float x) { return __builtin_amdgcn_rsqf(x); }
__device__ __forceinline__ float sigmoidf_(float x) { return frcp(1.0f + __expf(-x)); }
__device__ __forceinline__ float tanhf_(float x) { return 2.0f * frcp(1.0f + __expf(-2.0f * x)) - 1.0f; }

#define XB_TMO      128
#define XB_XCNT(j)  (256  + 64 * (j))
#define XB_XSUB(j)  (1280 + 64 * (j))
#define XB_XGEN(j)  (2304 + 64 * (j))
#define XB_TOP      3328
#define XB_TOPGEN   3392
#define XCD_BAR_WORDS 3456
#define XB_SPIN_CAP (1u << 18)
__device__ __forceinline__ unsigned xb_ld(unsigned* p)              { return __hip_atomic_load(p, __ATOMIC_RELAXED, __HIP_MEMORY_SCOPE_AGENT); }
__device__ __forceinline__ unsigned xb_add(unsigned* p, unsigned v) { return __hip_atomic_fetch_add(p, v, __ATOMIC_RELAXED, __HIP_MEMORY_SCOPE_AGENT); }
__device__ __forceinline__ unsigned xb_xcc_id() { return (unsigned)__builtin_amdgcn_s_getreg((3 << 11) | 20) & 0xFu; }
#define XB_SPIN(cond, bar) do { unsigned _sp = 0; while (cond) { \
    if ((++_sp & 255u) == 0u) { if (xb_ld(&(bar)[XB_TMO])) break; if (_sp > XB_SPIN_CAP) { atomicAdd(&(bar)[XB_TMO], 1u); break; } } } } while (0)
struct XcdBarrier { unsigned* bar; unsigned x; volatile LAS unsigned* st; };
__device__ __forceinline__ XcdBarrier xcd_barrier_post(unsigned* bar, volatile LAS unsigned* st) {
    XcdBarrier b; b.bar = bar; b.x = xb_xcc_id(); b.st = st;
    if (threadIdx.x == 0) (void)xb_add(&bar[XB_XCNT(b.x)], 1u);
    return b;
}
__device__ __forceinline__ void xcd_barrier_complete(unsigned* bar, unsigned x, unsigned& nloc, unsigned& nx) {
    const unsigned G = gridDim.x * gridDim.y * gridDim.z;
    unsigned sum, cnt, mine, sp = 0u;
    for (;;) {
        sum = 0u; cnt = 0u; mine = 0u;
#pragma unroll
        for (unsigned j = 0; j < 16; ++j) { const unsigned c = xb_ld(&bar[XB_XCNT(j)]); sum += c; cnt += (c > 0u) ? 1u : 0u; mine = (j == x) ? c : mine; }
        if (sum == G) break;
        __builtin_amdgcn_s_sleep(1);
        if ((++sp & 255u) == 0u) { if (xb_ld(&bar[XB_TMO])) break; if (sp > XB_SPIN_CAP) { atomicAdd(&bar[XB_TMO], 1u); break; } }
    }
    nloc = mine > 0u ? mine : 1u; nx = cnt > 0u ? cnt : 1u;
}
__device__ __forceinline__ void xcd_barrier_arrive(const XcdBarrier& b) {
    asm volatile("s_waitcnt vmcnt(0)" ::: "memory");
    __syncthreads();
    if (threadIdx.x == 0) {
        unsigned* bar = b.bar;
        __builtin_amdgcn_s_waitcnt(0);
        unsigned nloc = b.st[0], nx = b.st[1];
        if (nloc == 0u) { xcd_barrier_complete(bar, b.x, nloc, nx); b.st[0] = nloc; b.st[1] = nx; }
        const unsigned old = xb_add(&bar[XB_XSUB(b.x)], 1u);
        const unsigned gen = old / nloc;
        const unsigned target = (gen + 1u) * nx;
        b.st[3] = target;
        if (old + 1u == (gen + 1u) * nloc) {
            __builtin_amdgcn_fence(__ATOMIC_RELEASE, "agent");
            asm volatile("s_waitcnt vmcnt(0)" ::: "memory");
            (void)xb_add(&bar[XB_TOP], 1u);
        }
    }
}
__device__ __forceinline__ void xcd_barrier_wait(const XcdBarrier& b) {
    if (threadIdx.x == 0) {
        unsigned* bar = b.bar; const unsigned target = b.st[3];
        XB_SPIN((int)(xb_ld(&bar[XB_TOP]) - target) < 0, bar);
        __builtin_amdgcn_fence(__ATOMIC_ACQUIRE, "agent");
        asm volatile("s_waitcnt vmcnt(0)" ::: "memory");
    }
    __syncthreads();
}
__device__ __forceinline__ void xcd_barrier(const XcdBarrier& b) {
    asm volatile("s_waitcnt vmcnt(0)" ::: "memory");
    __syncthreads();
    if (threadIdx.x == 0) {
        unsigned* bar = b.bar;
        __builtin_amdgcn_s_waitcnt(0);
        unsigned nloc = b.st[0], nx = b.st[1];
        if (nloc == 0u) { xcd_barrier_complete(bar, b.x, nloc, nx); b.st[0] = nloc; b.st[1] = nx; }
        const unsigned old = xb_add(&bar[XB_XSUB(b.x)], 1u);
        const unsigned gen = old / nloc;
        const unsigned target = (gen + 1u) * nx;
        if (old + 1u == (gen + 1u) * nloc) {
            __builtin_amdgcn_fence(__ATOMIC_RELEASE, "agent");
            asm volatile("s_waitcnt vmcnt(0)" ::: "memory");
            const unsigned og = xb_add(&bar[XB_TOP], 1u);
            if (og + 1u != target) XB_SPIN((int)(xb_ld(&bar[XB_TOP]) - target) < 0, bar);
        } else {
            XB_SPIN((int)(xb_ld(&bar[XB_TOP]) - target) < 0, bar);
        }
        __builtin_amdgcn_fence(__ATOMIC_ACQUIRE, "agent");
        asm volatile("s_waitcnt vmcnt(0)" ::: "memory");
    }
    __syncthreads();
}

__device__ __forceinline__ float shx(float v, int o, int lane) { return __int_as_float(__builtin_amdgcn_ds_bpermute((lane ^ o) << 2, __float_as_int(v))); }
#define DPP_ADD(v, ctrl) ((v) + __int_as_float(__builtin_amdgcn_update_dpp(0, __float_as_int(v), (ctrl), 0xf, 0xf, true)))
__device__ __forceinline__ float wave_sum(float v, int lane) {
    (void)lane;
    v = DPP_ADD(v, 0x128); v = DPP_ADD(v, 0x124); v = DPP_ADD(v, 0x122); v = DPP_ADD(v, 0x121);
    const int iv = __float_as_int(v);
    return (__int_as_float(__builtin_amdgcn_readlane(iv, 0)) + __int_as_float(__builtin_amdgcn_readlane(iv, 16))) + (__int_as_float(__builtin_amdgcn_readlane(iv, 32)) + __int_as_float(__builtin_amdgcn_readlane(iv, 48)));
}
__device__ __forceinline__ float sum8(float v) { v = DPP_ADD(v, 0xB1); v = DPP_ADD(v, 0x4E); v = DPP_ADD(v, 0x141); return v; }
template <bool NTS = false>
__device__ __forceinline__ void transpose_item(const float* W, int ldw, int k0, int n0, bf16* WT, int ldk, int dst_row0, const float* kscale, LAS float* scr, int lane, int kmax = 1 << 30) {
    const int r8 = lane >> 3, quad = lane & 7;
    f32x4 v[8];
#pragma unroll
    for (int i = 0; i < 8; ++i) { const int kk = r8 + 8 * i; v[i] = (k0 + kk < kmax) ? __builtin_nontemporal_load((const GAS f32x4*)(W + (size_t)(k0 + kk) * ldw + n0 + quad * 4)) : (f32x4){0.f, 0.f, 0.f, 0.f}; }
#pragma unroll
    for (int i = 0; i < 8; ++i) { const int kk = r8 + 8 * i; if (kscale) v[i] = v[i] * kscale[(k0 + kk < kmax) ? k0 + kk : 0]; *(LAS f32x4*)(scr + kk * 36 + ((quad ^ i) << 2)) = v[i]; }
    LDS_WAIT(); asm volatile("" ::: "memory");
    const int c = lane & 7;
#pragma unroll
    for (int j = 0; j < 4; ++j) { const int n = (lane >> 3) + 8 * j; const LAS float* sp = scr + (8 * c) * 36 + ((((n >> 2) ^ c) << 2) | (n & 3));
        v4u o; o.x = pk2(sp[0 * 36], sp[1 * 36]); o.y = pk2(sp[2 * 36], sp[3 * 36]); o.z = pk2(sp[4 * 36], sp[5 * 36]); o.w = pk2(sp[6 * 36], sp[7 * 36]);
        if (k0 + 8 * c < kmax) { if (NTS) __builtin_nontemporal_store(o, (GAS v4u*)(WT + (size_t)(dst_row0 + n) * ldk + k0 + 8 * c)); else *(GAS v4u*)(WT + (size_t)(dst_row0 + n) * ldk + k0 + 8 * c) = o; } }
    LDS_WAIT(); asm volatile("" ::: "memory");
}

struct Args { const float* in[31]; float* out; unsigned char* ws; int ph_lo, ph_hi, li, pad; };
typedef const __attribute__((address_space(4))) unsigned char* kaptr_t;
__device__ __forceinline__ kaptr_t ka_base() { kaptr_t p = (kaptr_t)__builtin_amdgcn_kernarg_segment_ptr(); asm volatile("" : "+s"(p)); return p; }
#define INP(k) (*(const float* const __attribute__((address_space(4)))*)(ka_base() + 8 * (k)))
#define OUTP() (*(float* const __attribute__((address_space(4)))*)(ka_base() + 8 * 31))
#define WSP() (*(unsigned char* const __attribute__((address_space(4)))*)(ka_base() + 8 * 32))
#define KA_INT(i) (*(const int __attribute__((address_space(4)))*)(ka_base() + 8 * 33 + 4 * (i)))

template <int PART> __device__ __forceinline__ void p0_weights(unsigned char* ws, LAS unsigned char* lds, int gw, int NGW, int wave, int lane, int q0 = 0, int q1 = 1 << 30) {
    LAS float* scr = (LAS float*)(lds + wave * 16384);
    bf16* WT_RKV = (bf16*)(ws + WS_WT_RKV); bf16* WT_LORA = (bf16*)(ws + WS_WT_LORA); bf16* WT_OUT = (bf16*)(ws + WS_WT_OUT); bf16* WT_KVQ = (bf16*)(ws + WS_WT_KVQ);
    bf16* WT_SBO = (bf16*)(ws + WS_WT_SBO); bf16* WT_GU = (bf16*)(ws + WS_WT_GU); bf16* WT_DN = (bf16*)(ws + WS_WT_DN);
    constexpr int I_UP = 32 + 32 + 96, I_RKV = 3 * 512, I_LORA = 32 + 32 + 80, I_OUT = 512, I_KV = 1024, I_Q = 512, I_SBO = 512, I_G = 32 * 128, I_U = 32 * 128, I_D = 32 * 128;
    constexpr int NDENSE = I_UP + I_RKV + I_LORA + I_OUT + I_KV + I_Q + I_SBO, NITEMS = NDENSE + I_G + I_U + I_D;
    constexpr int N0 = I_UP + I_RKV + I_LORA, N3 = I_OUT, N4 = I_KV + I_Q + I_SBO; static_assert(N0 + N3 + N4 == NDENSE, "dense items");
    constexpr int NLOOP = PART == 0 ? N0 : (PART == 3 ? N3 : (PART == 4 ? N4 : 3 * 2048)); (void)NITEMS;
    for (int q_ = q0 + gw; q_ < (q1 < NLOOP ? q1 : NLOOP); q_ += NGW) {
        const int it = PART == 0 ? q_ : (PART == 3 ? N0 + q_ : (PART == 4 ? N0 + N3 + q_ : NDENSE + (q_ / 2048) * 4096 + 2048 * (PART - 1) + (q_ % 2048)));
        int r = it;
        if (r < I_UP) {
            if (r < 32) transpose_item(INP(9), C, 0, 32 * r, (bf16*)(ws + WS_WT_W2), 64, 32 * r, nullptr, scr, lane);
            else if (r < 64) transpose_item(INP(12), C, 0, 32 * (r - 32), (bf16*)(ws + WS_WT_A2), 64, 32 * (r - 32), nullptr, scr, lane);
            else { const int q = r - 64, kb = q / 32, nb = q % 32; transpose_item(INP(14), C, 64 * kb, 32 * nb, (bf16*)(ws + WS_WT_G2), DG, 32 * nb, nullptr, scr, lane, DG); }
            continue; } r -= I_UP;
        if (r < I_RKV) { const int m = r / 512, q = r % 512, kb = q / 32, nb = q % 32; transpose_item(INP(6) + (size_t)m * C * C, C, 64 * kb, 32 * nb, WT_RKV, C, m * C + 32 * nb, nullptr, scr, lane); continue; } r -= I_RKV;
        if (r < I_LORA) {
            if (r < 32) { const int kb = r / 2, nb = r % 2; transpose_item(INP(8), DW, 64 * kb, 32 * nb, WT_LORA, C, 32 * nb, nullptr, scr, lane); }
            else if (r < 64) { const int q = r - 32, kb = q / 2, nb = q % 2; transpose_item(INP(11), DA, 64 * kb, 32 * nb, WT_LORA, C, 256 + 32 * nb, nullptr, scr, lane); }
            else { const int q = r - 64, kb = q / 5, nb = q % 5; transpose_item(INP(13), DG, 64 * kb, 32 * nb, WT_LORA, C, 512 + 32 * nb, nullptr, scr, lane); }
            continue; } r -= I_LORA;
        if (r < I_OUT) { const int kb = r / 32, nb = r % 32; transpose_item<(PART == 3)>(INP(20), C, 64 * kb, 32 * nb, WT_OUT, C, 32 * nb, nullptr, scr, lane); continue; } r -= I_OUT;
        if (r < I_KV) { const int kb = r / 64, nb = r % 64; transpose_item(INP(21), 2 * C, 64 * kb, 32 * nb, WT_KVQ, C, 32 * nb, INP(3), scr, lane); continue; } r -= I_KV;
        if (r < I_Q) { const int kb = r / 32, nb = r % 32; transpose_item(INP(22), C, 64 * kb, 32 * nb, WT_KVQ, C, 2 * C + 32 * nb, INP(1) + C, scr, lane); continue; } r -= I_Q;
        if (r < I_SBO) { const int kb = r / 32, nb = r % 32; transpose_item(INP(23), C, 64 * kb, 32 * nb, WT_SBO, C, 32 * nb, nullptr, scr, lane); continue; } r -= I_SBO;
        if (r < I_G) { const int le = r / 128, q = r % 128, kb = q / 8, nb = q % 8, f0 = 32 * nb; transpose_item<(PART == 1)>(INP(28) + (size_t)le * C * FE, FE, 64 * kb, f0, WT_GU + (size_t)le * 512 * C, C, 256 * (f0 / 128) + (f0 % 128), INP(2) + (le >> 4) * C, scr, lane); continue; } r -= I_G;
        if (r < I_U) { const int le = r / 128, q = r % 128, kb = q / 8, nb = q % 8, f0 = 32 * nb; transpose_item<(PART == 1)>(INP(29) + (size_t)le * C * FE, FE, 64 * kb, f0, WT_GU + (size_t)le * 512 * C, C, 256 * (f0 / 128) + 128 + (f0 % 128), INP(2) + (le >> 4) * C, scr, lane); continue; } r -= I_U;
        { const int le = r / 128, q = r % 128, kb = q / 32, nb = q % 32; transpose_item<(PART == 1)>(INP(30) + (size_t)le * FE * C, C, 64 * kb, 32 * nb, WT_DN + (size_t)le * C * FE, FE, 32 * nb, nullptr, scr, lane); }
    }
    if (PART == 0) for (int it = gw * 64 + lane; it < 2 * C * 32; it += NGW * 64) { const int l = it >> 15, k = (it >> 5) & (C - 1), n = it & 31;
        float w = 0.f; if (n < 4) w = INP(24)[((size_t)l * C + k) * 4 + n]; else if (n < 20) w = INP(26)[((size_t)l * C + k) * 16 + (n - 4)];
        w *= INP(2)[l * C + k];
        const unsigned hi = f2bf(w), lo = f2bf(w - __uint_as_float(hi << 16));
        bf16* dst = (bf16*)(ws + WS_WT_ROUT) + (size_t)l * 65536 + ((((k >> 5) * 2 + (n >> 4)) * 64 + ((k >> 3) & 3) * 16 + (n & 15)) * 8 + (k & 7));
        dst[0] = (bf16)hi; dst[32768] = (bf16)lo; }
    if (PART == 0) for (int it = gw * 64 + lane; it < 768 * 128; it += NGW * 64) { const int row = it >> 7, ch = it & 127;
        const bool valid = (row < 64) || (row >= 256 && row < 320) || (row >= 512 && row < 672);
        if (!valid) *(GAS v4u*)(WT_LORA + (size_t)row * C + ch * 8) = (v4u){0u, 0u, 0u, 0u}; }
}
__device__ __forceinline__ void load_row(const float* p, int lane, f32x4 (&v)[4]) {
#pragma unroll
    for (int j = 0; j < 4; ++j) v[j] = ((const GAS f32x4*)p)[64 * j + lane];
}
__device__ __forceinline__ void load_row_nt(const float* p, int lane, f32x4 (&v)[4]) {
#pragma unroll
    for (int j = 0; j < 4; ++j) v[j] = __builtin_nontemporal_load(&((const GAS f32x4*)p)[64 * j + lane]);
}
__device__ __forceinline__ void load_row_bf(const bf16* p, int lane, f32x4 (&v)[4]) {
#pragma unroll
    for (int j = 0; j < 4; ++j) { const v2u w = ((const GAS v2u*)p)[64 * j + lane]; v[j] = (f32x4){bflo(w.x), bfhi(w.x), bflo(w.y), bfhi(w.y)}; }
}
__device__ __forceinline__ float row_rs(const f32x4 (&v)[4], int lane) {
    float s = 0.f;
#pragma unroll
    for (int j = 0; j < 4; ++j) s += (v[j].x * v[j].x + v[j].y * v[j].y) + (v[j].z * v[j].z + v[j].w * v[j].w);
    return frsq(wave_sum(s, lane) * (1.0f / C) + RMS_EPS);
}
__device__ __forceinline__ void store_row_bf16(bf16* p, int lane, const f32x4 (&v)[4]) {
#pragma unroll
    for (int j = 0; j < 4; ++j) { v2u o; o.x = pk2(v[j].x, v[j].y); o.y = pk2(v[j].z, v[j].w); ((GAS v2u*)p)[64 * j + lane] = o; }
}
__device__ __forceinline__ void p0_rows(unsigned char* ws, int gw, int NGW, int lane) {
    const float* x = INP(0); const float* gain = INP(1); const float* mix = INP(5);
    f32x4 g[4]; load_row(gain, lane, g);
    f32x4 mx[6][4];
#pragma unroll
    for (int i = 0; i < 6; ++i) load_row(mix + i * C, lane, mx[i]);
    for (int run = gw; run < M / 8; run += NGW) {
        const int r0 = run * 8;
        f32x4 prev[4], nx[4];
        load_row_nt(x + (size_t)r0 * C, lane, nx);
        if ((r0 % SEQ) == 0) {
#pragma unroll
            for (int j = 0; j < 4; ++j) prev[j] = (f32x4){0.f, 0.f, 0.f, 0.f};
        } else { load_row_nt(x + (size_t)(r0 - 1) * C, lane, prev); const float rs = row_rs(prev, lane);
#pragma unroll
            for (int j = 0; j < 4; ++j) prev[j] = prev[j] * rs * g[j]; }
#pragma unroll 1
        for (int rr = 0; rr < 8; ++rr) {
            const int row = r0 + rr;
            f32x4 hn[4];
#pragma unroll
            for (int j = 0; j < 4; ++j) hn[j] = nx[j];
            if (rr < 7) load_row_nt(x + (size_t)(row + 1) * C, lane, nx);
            const float rs = row_rs(hn, lane);
#pragma unroll
            for (int j = 0; j < 4; ++j) hn[j] = hn[j] * rs * g[j];
#pragma unroll
            for (int i = 0; i < 6; ++i) { f32x4 o[4];
#pragma unroll
                for (int j = 0; j < 4; ++j) o[j] = hn[j] + (prev[j] - hn[j]) * mx[i][j];
                bf16* dst = i < 2 ? (bf16*)OUTP() + (size_t)i * M * C : (i == 2 ? (bf16*)(ws + WS_B4) : (bf16*)(ws + WS_B1) + (size_t)(i - 3) * M * C);
                store_row_bf16(dst + (size_t)row * C, lane, o); }
#pragma unroll
            for (int j = 0; j < 4; ++j) prev[j] = hn[j];
        }
    }
}

template <int NN, int NGROUPS> struct SchedGrouped {
    static constexpr int K = C;
    const char* A0; size_t astride; const char* A2; const char* B; size_t bgroup;
    int G, c;
    __device__ __forceinline__ bool next(int i, pg8::Unit& u) const {
        const int L = i * G + c; constexpr int per = 64 * NN; if (L >= per * NGROUPS) return false;
        const int g = L / per, w = L % per; pg8::tile_map(w, 64, NN, u.pm, u.pn); u.aux = g; u.r0 = 0; u.cnt = 0; u.half = 2; return true; }
    __device__ __forceinline__ const char* a_base(const pg8::Unit& u) const { const char* A = (A2 != nullptr && u.aux == 2) ? A2 : A0 + (size_t)u.aux * astride; return A + (size_t)u.pm * 256 * K * 2; }
    __device__ __forceinline__ const char* b_base(const pg8::Unit& u) const { return B + (size_t)u.aux * bgroup + (size_t)u.pn * 256 * K * 2; }
    __device__ __forceinline__ unsigned a_row_off(const pg8::Unit&, int) const { return 0u; }
};
template <int NN, int K, bool GATHER> struct SchedMoe {
    const char* A; const char* B; size_t bexp; const unsigned* list; volatile LAS int* tab; int G, c;
    __device__ __forceinline__ bool next(int i, pg8::Unit& u) const {
        const int tot = __builtin_amdgcn_readfirstlane(tab[48]) * NN, full = tot / G, rem = tot - full * G; int L = i * G + c, half = 2;
        if (rem > 0 && 2 * rem <= G && i == full) { if ((c >> 1) >= rem) return false; L = full * G + (c >> 1); half = c & 1; }
        if (L >= tot) return false;
        u.pm = L / NN; u.pn = L % NN; int e = 0;
#pragma unroll
        for (int j = 0; j < 16; ++j) e += (u.pm >= tab[32 + j]) ? 1 : 0;
        e = __builtin_amdgcn_readfirstlane(e);
        u.aux = e; u.r0 = (u.pm - __builtin_amdgcn_readfirstlane(tab[16 + e])) * 256; u.cnt = __builtin_amdgcn_readfirstlane(tab[e]); u.half = half;
        if (half == 1 && u.cnt - u.r0 <= 128) return false;
        return true; }
    __device__ __forceinline__ const char* a_base(const pg8::Unit& u) const { return GATHER ? A : A + (size_t)u.pm * 256 * K * 2; }
    __device__ __forceinline__ const char* b_base(const pg8::Unit& u) const { return B + (size_t)u.aux * bexp + (size_t)u.pn * 256 * K * 2; }
    __device__ __forceinline__ unsigned a_row_off(const pg8::Unit& u, int r) const {
        const int idx = u.r0 + r; unsigned tok = 0u;
        if (idx < u.cnt) tok = list[(size_t)u.aux * M + idx] >> 1;
        return tok * (unsigned)(K * 2); }
};

using pg8::f32x4;
using pg8::Unit;
__device__ __forceinline__ v4u pack8(f32x4 v0, f32x4 v1) { v4u w; w.x = pg8::cvt_pk_bf16(v0[0], v0[1]); w.y = pg8::cvt_pk_bf16(v0[2], v0[3]); w.z = pg8::cvt_pk_bf16(v1[0], v1[1]); w.w = pg8::cvt_pk_bf16(v1[2], v1[3]); return w; }

struct EpiLora {
    static constexpr bool PERM = true;
    bf16* LW;
    __device__ __forceinline__ void operator()(const f32x4 (&acc)[2][2][4][2], const Unit& u, int wr, int wc, int fr, int fq) const {
        { int l_; asm volatile("v_mbcnt_lo_u32_b32 %0, -1, 0\n\tv_mbcnt_hi_u32_b32 %0, -1, %0" : "=v"(l_)); fr = l_ & 15; fq = l_ >> 4; }
        const int g = u.aux, width = g == 2 ? DG : DW; bf16* out = LW + (size_t)g * (1u << 20);
        const int row0 = u.pm * 256 + wr * 64 + fr;
#pragma unroll
        for (int bj = 0; bj < 2; ++bj) { const int col0 = bj * 128 + wc * 32 + 8 * fq; if (col0 < width) {
#pragma unroll
            for (int ai = 0; ai < 2; ++ai)
#pragma unroll
                for (int m = 0; m < 4; ++m) { f32x4 v0 = acc[ai][bj][m][0], v1 = acc[ai][bj][m][1];
                    if (g == 0) {
#pragma unroll
                        for (int q = 0; q < 4; ++q) { v0[q] = tanhf_(v0[q]); v1[q] = tanhf_(v1[q]); } }
                    else if (g == 2) {
#pragma unroll
                        for (int q = 0; q < 4; ++q) { v0[q] = sigmoidf_(v0[q]); v1[q] = sigmoidf_(v1[q]); } }
                    *(GAS v4u*)(out + (size_t)(row0 + ai * 128 + m * 16) * width + col0) = pack8(v0, v1); } } }
    }
};
struct EpiSplit3 {
    static constexpr bool PERM = true;
    bf16* O0; bool bycol; const float* rowscale;
    __device__ __forceinline__ void operator()(const f32x4 (&acc)[2][2][4][2], const Unit& u, int wr, int wc, int fr, int fq) const {
        { int l_; asm volatile("v_mbcnt_lo_u32_b32 %0, -1, 0\n\tv_mbcnt_hi_u32_b32 %0, -1, %0" : "=v"(l_)); fr = l_ & 15; fq = l_ >> 4; }
        const int g = bycol ? (u.pn >> 2) : u.aux, pn = bycol ? (u.pn & 3) : u.pn; bf16* out = O0 + (size_t)g * ((size_t)M * C);
        const int row0 = u.pm * 256 + wr * 64 + fr, col0 = pn * 256 + wc * 32 + 8 * fq;
#pragma unroll
        for (int ai = 0; ai < 2; ++ai)
#pragma unroll
            for (int m = 0; m < 4; ++m)
                { const float sc = rowscale ? rowscale[row0 + ai * 128 + m * 16] : 1.0f;
#pragma unroll
                for (int bj = 0; bj < 2; ++bj) *(GAS v4u*)(out + (size_t)(row0 + ai * 128 + m * 16) * C + col0 + bj * 128) = pack8(acc[ai][bj][m][0] * sc, acc[ai][bj][m][1] * sc); }
    }
};
template <bool BASE_F32> struct EpiResidBf {
    static constexpr bool PERM = true;
    const void* base; bf16* out;
    __device__ __forceinline__ void operator()(const f32x4 (&acc)[2][2][4][2], const Unit& u, int wr, int wc, int fr, int fq) const {
        { int l_; asm volatile("v_mbcnt_lo_u32_b32 %0, -1, 0\n\tv_mbcnt_hi_u32_b32 %0, -1, %0" : "=v"(l_)); fr = l_ & 15; fq = l_ >> 4; }
        const int row0 = u.pm * 256 + wr * 64 + fr, col0 = u.pn * 256 + wc * 32 + 8 * fq;
        f32x4 nf[4]; v4u nh[2];
#define RB_LOAD(i_) do { const size_t off_ = (size_t)(row0 + ((i_) >> 2) * 128 + ((i_) & 3) * 16) * C + col0; \
            if (BASE_F32) { nf[0] = *(const GAS f32x4*)((const float*)base + off_); nf[1] = *(const GAS f32x4*)((const float*)base + off_ + 4); nf[2] = *(const GAS f32x4*)((const float*)base + off_ + 128); nf[3] = *(const GAS f32x4*)((const float*)base + off_ + 132); } \
            else { nh[0] = *(const GAS v4u*)((const bf16*)base + off_); nh[1] = *(const GAS v4u*)((const bf16*)base + off_ + 128); } } while (0)
        RB_LOAD(0);
#pragma unroll
        for (int i = 0; i < 8; ++i) { const int ai = i >> 2, m = i & 3; const size_t off = (size_t)(row0 + ai * 128 + m * 16) * C + col0;
            f32x4 b[4];
            if (BASE_F32) {
#pragma unroll
                for (int q = 0; q < 4; ++q) b[q] = nf[q]; }
            else {
#pragma unroll
                for (int bj = 0; bj < 2; ++bj) { const v4u w = nh[bj]; b[2 * bj] = (f32x4){bflo(w.x), bfhi(w.x), bflo(w.y), bfhi(w.y)}; b[2 * bj + 1] = (f32x4){bflo(w.z), bfhi(w.z), bflo(w.w), bfhi(w.w)}; } }
            if (i < 7) RB_LOAD(i + 1);
#pragma unroll
            for (int bj = 0; bj < 2; ++bj) *(GAS v4u*)(out + off + bj * 128) = pack8(b[2 * bj] + acc[ai][bj][m][0], b[2 * bj + 1] + acc[ai][bj][m][1]);
            asm volatile("" ::: "memory"); }
#undef RB_LOAD
    }
};
struct EpiGU {
    static constexpr bool PERM = true;
    bf16* HID; const float* wl; const float* rsl;
    __device__ __forceinline__ void operator()(const f32x4 (&acc)[2][2][4][2], const Unit& u, int wr, int wc, int fr, int fq) const {
        { int l_; asm volatile("v_mbcnt_lo_u32_b32 %0, -1, 0\n\tv_mbcnt_hi_u32_b32 %0, -1, %0" : "=v"(l_)); fr = l_ & 15; fq = l_ >> 4; }
        const int e = u.aux, cnt = u.cnt, base = u.r0, r0 = wr * 64 + fr, col0 = u.pn * 128 + wc * 32 + 8 * fq;
#pragma unroll
        for (int ai = 0; ai < 2; ++ai) { if (u.half == 1 - ai) continue;
            float wv[4], rv[4];
#pragma unroll
            for (int i = 0; i < 4; ++i) { const int idx = base + r0 + ai * 128 + i * 16; wv[i] = 0.f; rv[i] = 0.f; if (idx < cnt) { wv[i] = wl[(size_t)e * M + idx]; rv[i] = rsl[(size_t)e * M + idx]; } }
#pragma unroll
            for (int m = 0; m < 4; ++m) { const int r = r0 + ai * 128 + m * 16; const float w = wv[m], rs = rv[m];
                f32x4 h0, h1;
#pragma unroll
                for (int q = 0; q < 4; ++q) { const float g0 = acc[ai][0][m][0][q] * rs, g1 = acc[ai][0][m][1][q] * rs;
                    h0[q] = g0 * sigmoidf_(g0) * (acc[ai][1][m][0][q] * rs) * w; h1[q] = g1 * sigmoidf_(g1) * (acc[ai][1][m][1][q] * rs) * w; }
                *(GAS v4u*)(HID + (size_t)(u.pm * 256 + r) * FE + col0) = pack8(h0, h1);
                asm volatile("" ::: "memory"); } }
    }
};
struct EpiDown {
    static constexpr bool PERM = true;
    bf16* EO; const unsigned* list;
    __device__ __forceinline__ void operator()(const f32x4 (&acc)[2][2][4][2], const Unit& u, int wr, int wc, int fr, int fq) const {
        { int l_; asm volatile("v_mbcnt_lo_u32_b32 %0, -1, 0\n\tv_mbcnt_hi_u32_b32 %0, -1, %0" : "=v"(l_)); fr = l_ & 15; fq = l_ >> 4; }
        const int e = u.aux, cnt = u.cnt, base = u.r0, r0 = wr * 64 + fr, col0 = u.pn * 256 + wc * 32 + 8 * fq;
        unsigned ents[8];
#pragma unroll
        for (int i = 0; i < 8; ++i) { const int idx = base + r0 + (i >> 2) * 128 + (i & 3) * 16; ents[i] = 0u; if (idx < cnt) ents[i] = list[(size_t)e * M + idx]; }
#pragma unroll
        for (int ai = 0; ai < 2; ++ai)
#pragma unroll
            for (int m = 0; m < 4; ++m) { const int idx = base + r0 + ai * 128 + m * 16;
                if (idx < cnt && u.half != 1 - ai) {        const unsigned ent = ents[ai * 4 + m]; bf16* o = EO + ((size_t)(ent & 1u) * M + (ent >> 1)) * C + col0;
#pragma unroll
                    for (int bj = 0; bj < 2; ++bj) *(GAS v4u*)(o + bj * 128) = pack8(acc[ai][bj][m][0], acc[ai][bj][m][1]); }
                asm volatile("" ::: "memory"); }
    }
};

typedef short bf16x8s __attribute__((ext_vector_type(8)));
typedef short bf16x4s __attribute__((ext_vector_type(4)));
typedef short v4i16_t __attribute__((ext_vector_type(4)));
constexpr int TPB = 144;
constexpr int TILE_B = 64 * TPB;
constexpr int FP = 68;
constexpr int CS_FA = 0, CS_FB = 16384, CS_TILES = 32768, CS_TOT = CS_TILES + 12 * TILE_B, CS_WL = CS_TOT + 2048, CS_PAR = CS_WL + 256;
static_assert(CS_PAR + 768 <= LDSCTL_OFF, "scan LDS map");
#define TILE(n) (lds + CS_TILES + (n) * TILE_B)
#define F4Z (f32x4){0.f, 0.f, 0.f, 0.f}
__device__ __forceinline__ bf16x8s ldfrag(const LAS unsigned char* tile, int row, int kcol) { return *(const LAS bf16x8s*)(tile + row * TPB + kcol * 2); }
__device__ __forceinline__ bf16x8s ldfrag_tr(const LAS unsigned char* tile, int n0, int k0, int lane) {
    const int g = lane >> 4, q = (lane & 15) >> 2, p = lane & 3;
    const LAS unsigned char* a = tile + (k0 + 8 * g + q) * TPB + (n0 + 4 * p) * 2;
    const v4i16_t lo = __builtin_amdgcn_ds_read_tr16_b64_v4i16((LAS v4i16_t*)a), hi = __builtin_amdgcn_ds_read_tr16_b64_v4i16((LAS v4i16_t*)(a + 4 * TPB));
    return (bf16x8s){lo[0], lo[1], lo[2], lo[3], hi[0], hi[1], hi[2], hi[3]};
}
__device__ __forceinline__ bf16x8s ldfrag_perm(const LAS unsigned char* tile, int row, int ks, int g) {
    const bf16x4s lo = *(const LAS bf16x4s*)(tile + row * TPB + (32 * ks + 4 * g) * 2), hi = *(const LAS bf16x4s*)(tile + row * TPB + (32 * ks + 16 + 4 * g) * 2);
    return (bf16x8s){lo[0], lo[1], lo[2], lo[3], hi[0], hi[1], hi[2], hi[3]};
}
__device__ __forceinline__ void lds_barrier() { asm volatile("s_waitcnt lgkmcnt(0)" ::: "memory"); __builtin_amdgcn_s_barrier(); asm volatile("" ::: "memory"); }
#define MFMA16(a, b, c) __builtin_amdgcn_mfma_f32_16x16x32_bf16((a), (b), (c), 0, 0, 0)
__device__ __forceinline__ void mm64(f32x4 (&acc)[2], const LAS unsigned char* At, const LAS unsigned char* Bt, int rt, int ch, int fr, int g) {
#pragma unroll
    for (int ks = 0; ks < 2; ++ks) { const bf16x8s a = ldfrag(At, 16 * rt + fr, 32 * ks + 8 * g);
#pragma unroll
        for (int ct = 0; ct < 2; ++ct) acc[ct] = MFMA16(a, ldfrag(Bt, 32 * ch + 16 * ct + fr, 32 * ks + 8 * g), acc[ct]); }
}
__device__ __forceinline__ void mm64_bt(f32x4 (&acc)[2], const LAS unsigned char* At, const LAS unsigned char* X, int rt, int ch, int fr, int g, int lane) {
#pragma unroll
    for (int ks = 0; ks < 2; ++ks) { const bf16x8s a = ldfrag(At, 16 * rt + fr, 32 * ks + 8 * g);
#pragma unroll
        for (int ct = 0; ct < 2; ++ct) acc[ct] = MFMA16(a, ldfrag_tr(X, 32 * ch + 16 * ct, 32 * ks, lane), acc[ct]); }
}
__device__ __forceinline__ void mm64_at(f32x4 (&acc)[2], const LAS unsigned char* Xa, const LAS unsigned char* Bt, int rt, int ch, int fr, int g, int lane) {
#pragma unroll
    for (int ks = 0; ks < 2; ++ks) { const bf16x8s a = ldfrag_tr(Xa, 16 * rt, 32 * ks, lane);
#pragma unroll
        for (int ct = 0; ct < 2; ++ct) acc[ct] = MFMA16(a, ldfrag(Bt, 32 * ch + 16 * ct + fr, 32 * ks + 8 * g), acc[ct]); }
}
__device__ __forceinline__ void mm64_att(f32x4 (&acc)[2], const LAS unsigned char* Xa, const LAS unsigned char* X, int rt, int ch, int lane) {
#pragma unroll
    for (int ks = 0; ks < 2; ++ks) { const bf16x8s a = ldfrag_tr(Xa, 16 * rt, 32 * ks, lane);
#pragma unroll
        for (int ct = 0; ct < 2; ++ct) acc[ct] = MFMA16(a, ldfrag_tr(X, 32 * ch + 16 * ct, 32 * ks, lane), acc[ct]); }
}
__device__ __forceinline__ bf16x4s pack4(f32x4 v) { v2u w; w.x = pg8::cvt_pk_bf16(v[0], v[1]); w.y = pg8::cvt_pk_bf16(v[2], v[3]); return __builtin_bit_cast(bf16x4s, w); }
__device__ __forceinline__ f32x4 unpack4(bf16x4s s) { const v2u w = __builtin_bit_cast(v2u, s); return (f32x4){bflo(w.x), bfhi(w.x), bflo(w.y), bfhi(w.y)}; }
__device__ __forceinline__ void st_tr(LAS unsigned char* Out, const f32x4 (&acc)[2], int rt, int ch, int fr, int g) {
#pragma unroll
    for (int ct = 0; ct < 2; ++ct) *(LAS bf16x4s*)(Out + (32 * ch + 16 * ct + fr) * TPB + (16 * rt + 4 * g) * 2) = pack4(acc[ct]);
}
__device__ __forceinline__ void ld_tr(f32x4 (&acc)[2], const LAS unsigned char* In, int rt, int ch, int fr, int g) {
#pragma unroll
    for (int ct = 0; ct < 2; ++ct) acc[ct] = unpack4(*(const LAS bf16x4s*)(In + (32 * ch + 16 * ct + fr) * TPB + (16 * rt + 4 * g) * 2));
}
__device__ __forceinline__ void mm2x2_bt(f32x4 (&acc)[2][2], const LAS unsigned char* At, const LAS unsigned char* X, int qr, int qc, int fr, int g, int lane) {
#pragma unroll
    for (int ks = 0; ks < 2; ++ks) { const bf16x8s a0 = ldfrag(At, 32 * qr + fr, 32 * ks + 8 * g), a1 = ldfrag(At, 32 * qr + 16 + fr, 32 * ks + 8 * g);
        const bf16x8s b0 = ldfrag_tr(X, 32 * qc, 32 * ks, lane), b1 = ldfrag_tr(X, 32 * qc + 16, 32 * ks, lane);
        acc[0][0] = MFMA16(a0, b0, acc[0][0]); acc[0][1] = MFMA16(a0, b1, acc[0][1]); acc[1][0] = MFMA16(a1, b0, acc[1][0]); acc[1][1] = MFMA16(a1, b1, acc[1][1]); }
}
#define TRI_IN(rt_, c_) (WITH_P ? unpack4(*(const LAS bf16x4s*)(In + (16 * (c_) + fr) * TPB + (16 * (rt_) + 4 * g) * 2)) : F4Z)
#define TRI_OUT(rt_, c_, v_) (*(LAS bf16x4s*)(Out + (16 * (c_) + fr) * TPB + (16 * (rt_) + 4 * g) * 2) = pack4(v_))
template <bool WITH_P>
__device__ __forceinline__ void tri_prod(int role, const LAS unsigned char* Xa, const LAS unsigned char* Bt, const LAS unsigned char* In, LAS unsigned char* Out, int fr, int g, int lane) {
    if (role == 0 || role == 3) { const int o = role == 0 ? 0 : 32;
        const bf16x8s a0 = ldfrag_tr(Xa, o, o, lane), a1 = ldfrag_tr(Xa, o + 16, o, lane), b0 = ldfrag(Bt, o + fr, o + 8 * g), b1 = ldfrag(Bt, o + 16 + fr, o + 8 * g);
        const int t = o >> 4; f32x4 c00 = TRI_IN(t, t), c01 = TRI_IN(t, t + 1), c11 = TRI_IN(t + 1, t + 1);
        c00 = MFMA16(a0, b0, c00); c01 = MFMA16(a0, b1, c01); c11 = MFMA16(a1, b1, c11);
        TRI_OUT(t, t, c00); TRI_OUT(t, t + 1, c01); TRI_OUT(t + 1, t + 1, c11);
    } else { const int rt_ = role - 1;
        const bf16x8s a0 = ldfrag_tr(Xa, 16 * rt_, 0, lane), a1 = ldfrag_tr(Xa, 16 * rt_, 32, lane);
        const bf16x8s b20 = ldfrag(Bt, 32 + fr, 8 * g), b21 = ldfrag(Bt, 32 + fr, 32 + 8 * g), b30 = ldfrag(Bt, 48 + fr, 8 * g), b31 = ldfrag(Bt, 48 + fr, 32 + 8 * g);
        f32x4 c2 = TRI_IN(rt_, 2), c3 = TRI_IN(rt_, 3);
        c2 = MFMA16(a0, b20, c2); c3 = MFMA16(a0, b30, c3); c2 = MFMA16(a1, b21, c2); c3 = MFMA16(a1, b31, c3);
        TRI_OUT(rt_, 2, c2); TRI_OUT(rt_, 3, c3); }
}
#undef TRI_IN
#undef TRI_OUT
__device__ __forceinline__ void unpack8(v4u w, float (&o)[8]) { o[0] = bflo(w.x); o[1] = bfhi(w.x); o[2] = bflo(w.y); o[3] = bfhi(w.y); o[4] = bflo(w.z); o[5] = bfhi(w.z); o[6] = bflo(w.w); o[7] = bfhi(w.w); }
__device__ __forceinline__ v4u pack8f(const float (&o)[8]) { v4u w; w.x = pg8::cvt_pk_bf16(o[0], o[1]); w.y = pg8::cvt_pk_bf16(o[2], o[3]); w.z = pg8::cvt_pk_bf16(o[4], o[5]); w.w = pg8::cvt_pk_bf16(o[6], o[7]); return w; }

struct FrontIn { v4u r, k, v; bf16x8s fw[2], fa[2]; };
__device__ __forceinline__ void front_fetch(FrontIn& f, unsigned char* ws, int unit, int tid, int lane, int wave) {
    const int h = unit & 15, c = (unit >> 4) & 127, b = unit >> 11; const size_t row0 = (size_t)b * SEQ + c * 64;
    const int rt = wave & 3, fr = lane & 15, g = lane >> 4, t = tid >> 3, cq = tid & 7, c0 = h * HD + cq * 8;
    const bf16* Rb = (const bf16*)(ws + WS_B1); const bf16* Kb = (const bf16*)(ws + WS_B2); const bf16* Vb = (const bf16*)(ws + WS_B3);
    const bf16* LW = (const bf16*)(ws + WS_LW); const bf16* LA = (const bf16*)(ws + WS_LA);
    f.r = *(const GAS v4u*)(Rb + (row0 + t) * C + c0); f.k = *(const GAS v4u*)(Kb + (row0 + t) * C + c0); f.v = *(const GAS v4u*)(Vb + (row0 + t) * C + c0);
#pragma unroll
    for (int ks = 0; ks < 2; ++ks) { f.fw[ks] = *(const GAS bf16x8s*)(LW + (row0 + 16 * rt + fr) * DW + 32 * ks + 8 * g); f.fa[ks] = *(const GAS bf16x8s*)(LA + (row0 + 16 * rt + fr) * DA + 32 * ks + 8 * g); }
}
__device__ __forceinline__ v4u head_consts(unsigned char* ws, LAS unsigned char* lds, int h, int tid, int wtile, int atile) {
    const bf16* W2T = (const bf16*)(ws + WS_WT_W2); const bf16* A2T = (const bf16*)(ws + WS_WT_A2);
    const int row = tid >> 3, cq = tid & 7;
    const v4u w2chunk = *(const GAS v4u*)(W2T + (size_t)(h * HD + row) * 64 + cq * 8);
    *(LAS v4u*)(lds + CS_TILES + wtile * TILE_B + row * TPB + cq * 16) = w2chunk;
    *(LAS v4u*)(lds + CS_TILES + atile * TILE_B + row * TPB + cq * 16) = *(const GAS v4u*)(A2T + (size_t)(h * HD + row) * 64 + cq * 8);
    if (tid < 64) { LAS float* P = (LAS float*)(lds + CS_PAR); P[tid] = INP(15)[h * HD + tid]; P[64 + tid] = INP(16)[h * HD + tid]; P[128 + tid] = INP(17)[h * HD + tid]; }
    __syncthreads();
    return w2chunk;
}
template <int MODE>
__device__ __forceinline__ void chunk_front(const FrontIn& f, LAS unsigned char* lds, const float (&w0v)[2], const float (&a0v)[2], const bf16x8s (&w2f)[2][2], const bf16x8s (&a2f)[2][2], int tid, int lane, int wave, float (&v8)[8], float& rkb) {
    const int rt = wave & 3, ch = wave >> 2, fr = lane & 15, g = lane >> 4;
    LAS float* FA = (LAS float*)(lds + CS_FA); LAS float* FB = (LAS float*)(lds + CS_FB); LAS float* TOT = (LAS float*)(lds + CS_TOT);
    const int t = tid >> 3, cq = tid & 7;
    {
        f32x4 aw[2] = {F4Z, F4Z}, aa[2] = {F4Z, F4Z};
#pragma unroll
        for (int ks = 0; ks < 2; ++ks)
#pragma unroll
            for (int ct = 0; ct < 2; ++ct) { aw[ct] = MFMA16(f.fw[ks], w2f[ks][ct], aw[ct]); aa[ct] = MFMA16(f.fa[ks], a2f[ks][ct], aa[ct]); }
#pragma unroll
        for (int ct = 0; ct < 2; ++ct) { const int j = 32 * ch + 16 * ct + fr, js = j ^ ((g & 1) << 4); const float w0 = w0v[ct], a0 = a0v[ct];
            float p[4];
#pragma unroll
            for (int q = 0; q < 4; ++q) { p[q] = -0.6065306597126334f * sigmoidf_(w0 + aw[ct][q]); if (q) p[q] += p[q - 1]; }
            const float s_ = p[3];
            const float u1 = __int_as_float(__builtin_amdgcn_ds_bpermute(((lane - 16) & 63) << 2, __float_as_int(s_))); const float t1 = s_ + (g >= 1 ? u1 : 0.f);
            const float u2 = __int_as_float(__builtin_amdgcn_ds_bpermute(((lane - 32) & 63) << 2, __float_as_int(t1))); const float t2 = t1 + (g >= 2 ? u2 : 0.f);
            const float ex = t2 - s_;
#pragma unroll
            for (int q = 0; q < 4; ++q) { const int tt = 16 * rt + 4 * g + q; FA[tt * 64 + js] = p[q] + ex; FB[tt * 64 + js] = sigmoidf_(a0 + aa[ct][q]); }
            if (g == 3) TOT[rt * 64 + j] = t2; }
    }
    lds_barrier();
    {
        float r[8], k[8], pkk[8], pka[8], prk[8];
        unpack8(f.r, r); unpack8(f.k, k); unpack8(f.v, v8);
        { const LAS float* P = (const LAS float*)(lds + CS_PAR) + cq * 8; const f32x4 a0_ = *(const LAS f32x4*)P, a1_ = *(const LAS f32x4*)(P + 4), b0_ = *(const LAS f32x4*)(P + 64), b1_ = *(const LAS f32x4*)(P + 68), c0_ = *(const LAS f32x4*)(P + 128), c1_ = *(const LAS f32x4*)(P + 132);
#pragma unroll
          for (int q = 0; q < 4; ++q) { pkk[q] = a0_[q]; pkk[4 + q] = a1_[q]; pka[q] = b0_[q]; pka[4 + q] = b1_[q]; prk[q] = c0_[q]; prk[4 + q] = c1_[q]; } }
        float cw[8], cwp[8], ag[8];
        { const int tp = t > 0 ? t - 1 : 0, rtt = wave >> 1;
          const int ct_ = (cq ^ (((t >> 2) & 1) << 1)) * 8, cp_ = (cq ^ (((tp >> 2) & 1) << 1)) * 8;
          const f32x4 c0_ = *(const LAS f32x4*)(FA + t * 64 + ct_), c1_ = *(const LAS f32x4*)(FA + t * 64 + ct_ + 4), p0_ = *(const LAS f32x4*)(FA + tp * 64 + cp_), p1_ = *(const LAS f32x4*)(FA + tp * 64 + cp_ + 4);
          const f32x4 g0_ = *(const LAS f32x4*)(FB + t * 64 + ct_), g1_ = *(const LAS f32x4*)(FB + t * 64 + ct_ + 4);
          f32x4 o0_ = F4Z, o1_ = F4Z, l0_ = F4Z, l1_ = F4Z;
          for (int r_ = 0; r_ < rtt; ++r_) { l0_ = *(const LAS f32x4*)(TOT + r_ * 64 + cq * 8); l1_ = *(const LAS f32x4*)(TOT + r_ * 64 + cq * 8 + 4); o0_ = o0_ + l0_; o1_ = o1_ + l1_; }
          const bool first = (t & 15) == 0;
#pragma unroll
          for (int q = 0; q < 4; ++q) { cw[q] = c0_[q] + o0_[q]; cw[4 + q] = c1_[q] + o1_[q];
              cwp[q] = t > 0 ? p0_[q] + o0_[q] - (first ? l0_[q] : 0.f) : 0.f; cwp[4 + q] = t > 0 ? p1_[q] + o1_[q] - (first ? l1_[q] : 0.f) : 0.f; ag[q] = g0_[q]; ag[4 + q] = g1_[q]; } }
        float kk[8], ss = 0.f; rkb = 0.f;
#pragma unroll
        for (int q = 0; q < 8; ++q) { kk[q] = k[q] * pkk[q]; ss += kk[q] * kk[q]; }
        ss = sum8(ss);
        const float inv = fminf(frsq(ss), 1e12f);
        float at[8], bt[8], kt[8], rt_[8];
#pragma unroll
        for (int q = 0; q < 8; ++q) { const float kn = kk[q] * inv, kp = k[q] * (1.0f + (ag[q] - 1.0f) * pka[q]);
            const float ein = __expf(-cw[q]);
            at[q] = -kn * __expf(cwp[q]); bt[q] = kn * ag[q] * ein; kt[q] = kp * ein;
            rt_[q] = r[q] * __expf(cw[q]); rkb += r[q] * kp * prk[q]; }
        rkb = sum8(rkb);
        *(LAS v4u*)(TILE(0) + t * TPB + cq * 16) = pack8f(at); *(LAS v4u*)(TILE(1) + t * TPB + cq * 16) = pack8f(bt); *(LAS v4u*)(TILE(2) + t * TPB + cq * 16) = pack8f(kt);
        *(LAS v4u*)(TILE(3) + t * TPB + cq * 16) = f.v;
        *(LAS v4u*)(TILE(6) + t * TPB + cq * 16) = pack8f(rt_);
        if (MODE == 1 && t == 63) {
#pragma unroll
            for (int q = 0; q < 8; ++q) ((LAS float*)(lds + CS_WL))[cq * 8 + q] = __expf(cw[q]); }
    }
    lds_barrier();
}

__device__ __forceinline__ void scan_s1(unsigned char* ws, LAS unsigned char* lds, int lane0, int wave) {
    const int rt = wave & 3, ch = wave >> 2;
    FrontIn fin; float w0v[2], a0v[2]; bf16x8s w2f[2][2], a2f[2][2];
    { int l0 = lane0; asm volatile("" : "+v"(l0)); const int hh = blockIdx.x & 15;
      if ((int)blockIdx.x < BATCH * NH * (SEQ / 64)) front_fetch(fin, ws, blockIdx.x, wave * 64 + l0, l0, wave);
      const bf16* W2T = (const bf16*)(ws + WS_WT_W2); const bf16* A2T = (const bf16*)(ws + WS_WT_A2);
#pragma unroll
      for (int ct = 0; ct < 2; ++ct) { w0v[ct] = INP(7)[hh * HD + 32 * ch + 16 * ct + (l0 & 15)]; a0v[ct] = INP(10)[hh * HD + 32 * ch + 16 * ct + (l0 & 15)];
#pragma unroll
          for (int ks = 0; ks < 2; ++ks) { const size_t wr_ = (size_t)(hh * HD + 32 * ch + 16 * ct + (l0 & 15)) * 64 + 32 * ks + 8 * (l0 >> 4); w2f[ks][ct] = *(const GAS bf16x8s*)(W2T + wr_); a2f[ks][ct] = *(const GAS bf16x8s*)(A2T + wr_); } }
      const int tid0 = wave * 64 + l0;
      if (tid0 < 64) { LAS float* P = (LAS float*)(lds + CS_PAR); P[tid0] = INP(15)[hh * HD + tid0]; P[64 + tid0] = INP(16)[hh * HD + tid0]; P[128 + tid0] = INP(17)[hh * HD + tid0]; }
      __syncthreads(); }
    for (int unit = blockIdx.x; unit < BATCH * NH * (SEQ / 64); unit += gridDim.x) {
        int lane = lane0; asm volatile("" : "+v"(lane));
        const int tid = wave * 64 + lane, fr = lane & 15, g = lane >> 4;
        const int h = unit & 15, c = (unit >> 4) & 127, b = unit >> 11; const size_t chunk = ((size_t)b * NH + h) * 128 + c;
        float v8[8]; float rkb;
        chunk_front<1>(fin, lds, w0v, a0v, w2f, a2f, tid, lane, wave, v8, rkb);
        { const size_t row0_ = (size_t)b * SEQ + c * 64; if ((tid & 7) == 0) ((float*)(ws + WS_HID))[(row0_ + (tid >> 3)) * NH + h] = rkb; }
        if (unit + (int)gridDim.x < BATCH * NH * (SEQ / 64)) front_fetch(fin, ws, unit + gridDim.x, tid, lane, wave);
        {
            f32x4 a2[2] = {F4Z, F4Z}, a3[2] = {F4Z, F4Z};
            mm64(a2, TILE(1), TILE(0), rt, ch, fr, g);
            mm64(a3, TILE(2), TILE(0), rt, ch, fr, g);
            f32x4 p1[2];
#pragma unroll
            for (int ct = 0; ct < 2; ++ct) { const int col = 32 * ch + 16 * ct + fr;
#pragma unroll
                for (int q = 0; q < 4; ++q) { const int row = 16 * rt + 4 * g + q;
                    a2[ct][q] = row < col ? a2[ct][q] : 0.f;
                    p1[ct][q] = a2[ct][q] + (row == col ? 1.0f : 0.f);
                    a3[ct][q] = row < col ? a3[ct][q] : 0.f; } }
            st_tr(TILE(5), a2, rt, ch, fr, g);
            st_tr(TILE(9), p1, rt, ch, fr, g);
            st_tr(TILE(4), a3, rt, ch, fr, g);
            { const f32x4 z_[2] = {F4Z, F4Z}; st_tr(TILE(7), z_, rt, ch, fr, g); st_tr(TILE(10), z_, rt, ch, fr, g); }
        }
        lds_barrier();
#pragma unroll
        for (int r = 0; r < 6; ++r) {
            LAS unsigned char* Sr = TILE(5 + 2 * (r & 1)); LAS unsigned char* Sr2 = TILE(5 + 2 * ((r & 1) ^ 1));
            { const int prod = wave >> 2, role = wave & 3;
              LAS unsigned char* Pr = TILE(9 + ((r + 1) & 1)); LAS unsigned char* Pr2 = TILE(9 + (((r + 1) & 1) ^ 1));
              if (prod == 0) { if (r <= 4) tri_prod<false>(role, Sr, Sr, Sr, Sr2, fr, g, lane); }
              else if (r >= 1) tri_prod<true>(role, Sr, Pr, Pr, Pr2, fr, g, lane);
              else { const int qr = role >> 1, qc = role & 1; f32x4 qa[2][2] = {{F4Z, F4Z}, {F4Z, F4Z}};
                     mm2x2_bt(qa, TILE(4), TILE(3), qr, qc, fr, g, lane);
                     st_tr(TILE(11), qa[0], 2 * qr, qc, fr, g); st_tr(TILE(11), qa[1], 2 * qr + 1, qc, fr, g); } }
            lds_barrier();
        }
        {
            f32x4 acc[2] = {F4Z, F4Z}, ac2[2] = {F4Z, F4Z};
            mm64_bt(acc, TILE(10), TILE(0), rt, ch, fr, g, lane);
            mm64(ac2, TILE(10), TILE(11), rt, ch, fr, g);
            st_tr(TILE(5), acc, rt, ch, fr, g); st_tr(TILE(7), ac2, rt, ch, fr, g);
            f32x4 b2[2] = {F4Z, F4Z}, b3[2] = {F4Z, F4Z};
            mm64(b2, TILE(1), TILE(6), rt, ch, fr, g); mm64(b3, TILE(2), TILE(6), rt, ch, fr, g);
#pragma unroll
            for (int ct = 0; ct < 2; ++ct) { const int t = 32 * ch + 16 * ct + fr;
#pragma unroll
                for (int q = 0; q < 4; ++q) { const int s_ = 16 * rt + 4 * g + q; b2[ct][q] = s_ <= t ? b2[ct][q] : 0.f; b3[ct][q] = s_ <= t ? b3[ct][q] : 0.f; } }
            st_tr(TILE(4), b2, rt, ch, fr, g); st_tr(TILE(9), b3, rt, ch, fr, g);
        }
        lds_barrier();
        {
            const LAS float* WL = (const LAS float*)(lds + CS_WL);
            f32x4 acc[2] = {F4Z, F4Z};
            mm64_bt(acc, TILE(5), TILE(1), rt, ch, fr, g, lane);
            bf16* Mg = (bf16*)(ws + WS_B0) + chunk * 4096;
#pragma unroll
            for (int ct = 0; ct < 2; ++ct) { const int j1 = 32 * ch + 16 * ct + fr; const float wl = WL[j1];
#pragma unroll
                for (int q = 0; q < 4; ++q) { const int j2 = 16 * rt + 4 * g + q; acc[ct][q] = wl * (acc[ct][q] + (j2 == j1 ? 1.0f : 0.f)); }
                const int rtS = 2 * ch + ct, ksS = rt >> 1, half = rt & 1;
                *(GAS bf16x4s*)(Mg + (((rtS * 2 + ksS) * 64 + g * 16 + fr) * 8 + half * 4)) = pack4(acc[ct]); }
            f32x4 ad[2] = {F4Z, F4Z};
            mm64_at(ad, TILE(1), TILE(7), rt, ch, fr, g, lane);
            mm64_att(ad, TILE(2), TILE(3), rt, ch, lane);
            const f32x4 wl4 = *(const LAS f32x4*)(WL + 16 * rt + 4 * g);
            bf16* Dg = (bf16*)OUTP() + chunk * 4096;
#pragma unroll
            for (int ct = 0; ct < 2; ++ct) *(GAS bf16x4s*)(Dg + (((2 * ch + ct) * 4 + rt) * 64 + lane) * 4) = pack4(ad[ct] * wl4);
            const size_t row0_ = (size_t)b * SEQ + c * 64;
            f32x4 ar[2]; ld_tr(ar, TILE(6), rt, ch, fr, g);
            mm64(ar, TILE(5), TILE(4), rt, ch, fr, g);
            f32x4 ay[2] = {F4Z, F4Z};
            mm64(ay, TILE(7), TILE(4), rt, ch, fr, g); mm64_at(ay, TILE(3), TILE(9), rt, ch, fr, g, lane);
            bf16* Rg = (bf16*)(ws + WS_B1); bf16* Kg = (bf16*)(ws + WS_B2);
#pragma unroll
            for (int ct = 0; ct < 2; ++ct) { const size_t o_ = (row0_ + 32 * ch + 16 * ct + fr) * C + h * HD + 16 * rt + 4 * g; *(GAS bf16x4s*)(Rg + o_) = pack4(ar[ct]); *(GAS bf16x4s*)(Kg + o_) = pack4(ay[ct]); }
        }
        lds_barrier();
    }
}

constexpr int S2_PD = 6;
__device__ __forceinline__ void scan_s2(unsigned char* ws, LAS unsigned char* lds, int lane, int wave) {
    for (int bh = blockIdx.x; bh < BATCH * NH; bh += gridDim.x) {
        const unsigned char* Mg = (const unsigned char*)((const bf16*)(ws + WS_B0) + (size_t)bh * 128 * 4096); const unsigned char* Dg = (const unsigned char*)((const bf16*)OUTP() + (size_t)bh * 128 * 4096);
        bf16* Sg = (bf16*)OUTP() + (size_t)M * C + (size_t)bh * 128 * 4096;
        if (wave >= 4) {
            const int lw = wave - 4;
            const unsigned char* src = (lw < 2 ? Mg + lw * 4096 : Dg + (lw - 2) * 4096) + lane * 16;
#define S2_DMA(c) do { _Pragma("unroll") for (int i_ = 0; i_ < 4; ++i_) __builtin_amdgcn_global_load_lds((const unsigned*)(src + (size_t)(c) * 8192 + i_ * 1024), (LAS unsigned*)(lds + ((c) & 7) * 16384 + lw * 4096 + i_ * 1024), 16, 0, 0); } while (0)
#pragma unroll
            for (int c = 0; c < 6; ++c) S2_DMA(c);
            asm volatile("s_waitcnt vmcnt(16)" ::: "memory");
            lds_barrier();
#pragma unroll 1
            for (int p = 0; p < 64; ++p) {
                if (2 * p + 7 < 128) { S2_DMA(2 * p + 6); S2_DMA(2 * p + 7); asm volatile("s_waitcnt vmcnt(16)" ::: "memory"); }
                else asm volatile("s_waitcnt vmcnt(0)" ::: "memory");
                lds_barrier(); }
#undef S2_DMA
        } else {
            const int ct = wave;
            f32x4 acc[4];
#pragma unroll
            for (int r = 0; r < 4; ++r) acc[r] = F4Z;
            lds_barrier();
#pragma unroll 1
            for (int p = 0; p < 64; ++p) {
#pragma unroll
                for (int d = 0; d < 2; ++d) { const int step = 2 * p + d;
                    {
                        const LAS unsigned char* slot = lds + (step & 7) * 16384;
                        bf16x8s sf[2];
#pragma unroll
                        for (int ks = 0; ks < 2; ++ks) { const bf16x4s lo = pack4(acc[2 * ks]), hi = pack4(acc[2 * ks + 1]); sf[ks] = (bf16x8s){lo[0], lo[1], lo[2], lo[3], hi[0], hi[1], hi[2], hi[3]}; }
#pragma unroll
                        for (int ks = 0; ks < 2; ++ks) *(GAS bf16x8s*)(Sg + (size_t)step * 4096 + ((ct * 2 + ks) * 64 + lane) * 8) = sf[ks];
                        f32x4 na[4];
#pragma unroll
                        for (int r = 0; r < 4; ++r) na[r] = unpack4(*(const LAS bf16x4s*)(slot + 8192 + ((ct * 4 + r) * 64 + lane) * 8));
#pragma unroll
                        for (int ks = 0; ks < 2; ++ks)
#pragma unroll
                            for (int r = 0; r < 4; ++r) na[r] = MFMA16(*(const LAS bf16x8s*)(slot + ((r * 2 + ks) * 64 + lane) * 16), sf[ks], na[r]);
#pragma unroll
                        for (int r = 0; r < 4; ++r) acc[r] = na[r];
                    }
                }
                lds_barrier(); }
        }
    }
}

constexpr int S3_RT = 32768, S3_YT = S3_RT + TILE_B, S3_LG = S3_YT + TILE_B, S3_LGP = 336;
struct S3In { v4u rr, yy, vv, lg[3]; bf16x8s sA[2]; float rkb; };
__device__ __forceinline__ void s3_fetch(S3In& f, unsigned char* ws, int unit, int tid, int lane, int wave) {
    const int h = unit & 15, c = (unit >> 4) & 127, b = unit >> 11; const size_t chunk = ((size_t)b * NH + h) * 128 + c, row0 = (size_t)b * SEQ + c * 64;
    const int rt = wave & 3, et = tid >> 3, ecq = tid & 7;
    const bf16* Rg = (const bf16*)(ws + WS_B1); const bf16* Kg = (const bf16*)(ws + WS_B2); const bf16* Vb = (const bf16*)(ws + WS_B3); const bf16* LG = (const bf16*)(ws + WS_LG);
    const bf16* Sg = (const bf16*)OUTP() + (size_t)M * C + chunk * 4096;
    const size_t o_ = (row0 + et) * C + h * HD + ecq * 8;
    f.rr = *(const GAS v4u*)(Rg + o_); f.yy = *(const GAS v4u*)(Kg + o_); f.vv = *(const GAS v4u*)(Vb + o_);
#pragma unroll
    for (int i = 0; i < 3; ++i) { const int chn = tid + 512 * i; if (chn < 64 * 20) f.lg[i] = *(const GAS v4u*)(LG + (row0 + chn / 20) * DG + (chn % 20) * 8); }
#pragma unroll
    for (int ks = 0; ks < 2; ++ks) f.sA[ks] = *(const GAS bf16x8s*)(Sg + ((rt * 2 + ks) * 64 + lane) * 8);
    f.rkb = ((const float*)(ws + WS_HID))[(row0 + et) * NH + h];
}
__device__ __forceinline__ void scan_s3(unsigned char* ws, LAS unsigned char* lds, int lane0, int wave) {
    const int rt = wave & 3, ch = wave >> 2;
    LAS float* Ys = (LAS float*)(lds + CS_FA);
    const bf16* G2T = (const bf16*)(ws + WS_WT_G2); bf16* YG = (bf16*)(ws + WS_B0);
    constexpr int NU = BATCH * NH * (SEQ / 64);
    S3In fin; bf16x8s gA[5]; f32x4 lnw0, lnw1, lnb0, lnb1;
    { int l0 = lane0; asm volatile("" : "+v"(l0)); const int hh = blockIdx.x & 15, t0_ = wave * 64 + l0;
      if ((int)blockIdx.x < NU) s3_fetch(fin, ws, blockIdx.x, t0_, l0, wave);
#pragma unroll
      for (int ks = 0; ks < 5; ++ks) gA[ks] = *(const GAS bf16x8s*)(G2T + (size_t)(hh * HD + 16 * rt + (l0 & 15)) * DG + 32 * ks + 8 * (l0 >> 4));
      const int ec0 = hh * HD + (t0_ & 7) * 8;
      lnw0 = *(const GAS f32x4*)(INP(18) + ec0); lnw1 = *(const GAS f32x4*)(INP(18) + ec0 + 4); lnb0 = *(const GAS f32x4*)(INP(19) + ec0); lnb1 = *(const GAS f32x4*)(INP(19) + ec0 + 4); }
    __syncthreads();
    for (int unit = blockIdx.x; unit < NU; unit += gridDim.x) {
        int lane = lane0; asm volatile("" : "+v"(lane));
        const int tid = wave * 64 + lane, fr = lane & 15, g = lane >> 4, et = tid >> 3, ecq = tid & 7;
        const int h = unit & 15, c = (unit >> 4) & 127, b = unit >> 11; const size_t row0 = (size_t)b * SEQ + c * 64;
        *(LAS v4u*)(lds + S3_RT + et * TPB + ecq * 16) = fin.rr; *(LAS v4u*)(lds + S3_YT + et * TPB + ecq * 16) = fin.yy;
#pragma unroll
        for (int i = 0; i < 3; ++i) { const int chn = tid + 512 * i; if (chn < 64 * 20) *(LAS v4u*)(lds + S3_LG + (chn / 20) * S3_LGP + (chn % 20) * 16) = fin.lg[i]; }
        float v8[8]; unpack8(fin.vv, v8); const float rkb = fin.rkb; const bf16x8s sA0 = fin.sA[0], sA1 = fin.sA[1];
        lds_barrier();
        if (unit + (int)gridDim.x < NU) s3_fetch(fin, ws, unit + gridDim.x, tid, lane, wave);
        f32x4 acc[2], ag[2] = {F4Z, F4Z};
#pragma unroll
        for (int ct = 0; ct < 2; ++ct) { const int t = 32 * ch + 16 * ct + fr;
            acc[ct] = unpack4(*(const LAS bf16x4s*)(lds + S3_YT + t * TPB + (16 * rt + 4 * g) * 2));
            acc[ct] = MFMA16(sA0, ldfrag_perm(lds + S3_RT, t, 0, g), acc[ct]); acc[ct] = MFMA16(sA1, ldfrag_perm(lds + S3_RT, t, 1, g), acc[ct]);
#pragma unroll
            for (int ks = 0; ks < 5; ++ks) ag[ct] = MFMA16(gA[ks], *(const LAS bf16x8s*)(lds + S3_LG + t * S3_LGP + (32 * ks + 8 * g) * 2), ag[ct]);
            *(LAS f32x4*)(Ys + t * FP + 16 * rt + 4 * g) = acc[ct]; }
        lds_barrier();
        {
            const f32x4 y0 = *(const LAS f32x4*)(Ys + et * FP + ecq * 8), y1 = *(const LAS f32x4*)(Ys + et * FP + ecq * 8 + 4);
            float y[8] = {y0[0], y0[1], y0[2], y0[3], y1[0], y1[1], y1[2], y1[3]};
            float s_ = 0.f;
#pragma unroll
            for (int q = 0; q < 8; ++q) s_ += y[q];
            s_ = sum8(s_);
            const float mu = s_ * (1.0f / HD); float vs = 0.f;
#pragma unroll
            for (int q = 0; q < 8; ++q) { y[q] -= mu; vs += y[q] * y[q]; }
            vs = sum8(vs);
            const float rstd = frsq(vs * (1.0f / HD) + GN_EPS);
            f32x4 o0, o1;
#pragma unroll
            for (int q = 0; q < 4; ++q) { o0[q] = y[q] * rstd * lnw0[q] + lnb0[q] + rkb * v8[q]; o1[q] = y[4 + q] * rstd * lnw1[q] + lnb1[q] + rkb * v8[4 + q]; }
            *(LAS f32x4*)(Ys + et * FP + ecq * 8) = o0; *(LAS f32x4*)(Ys + et * FP + ecq * 8 + 4) = o1;
        }
        lds_barrier();
#pragma unroll
        for (int ct = 0; ct < 2; ++ct) { const int t = 32 * ch + 16 * ct + fr; const f32x4 yv = *(const LAS f32x4*)(Ys + t * FP + 16 * rt + 4 * g);
            *(GAS bf16x4s*)(YG + (row0 + t) * C + h * HD + 16 * rt + 4 * g) = pack4(yv * ag[ct]); }
    }
    __syncthreads();
}
#undef TILE
#if MK_DEBUG
__device__ __forceinline__ void scan_naive(unsigned char* ws, LAS unsigned char* lds, int tid) {
    const int lane = tid & 63;
    const bf16* Rb = (const bf16*)(ws + WS_B1); const bf16* Kb = (const bf16*)(ws + WS_B2); const bf16* Vb = (const bf16*)(ws + WS_B3);
    const bf16* LW = (const bf16*)(ws + WS_LW); const bf16* LA = (const bf16*)(ws + WS_LA);
    float* Y = OUTP(); float* RK = (float*)(ws + WS_HID);
    LAS float* sR = (LAS float*)lds; LAS float* sK = sR + 4096; LAS float* sV = sK + 4096; LAS float* sA = sV + 4096; LAS float* sB = sA + 4096; LAS float* sD = sB + 4096;
    LAS float* sW2 = sD + 4096; LAS float* sA2 = sW2 + 4096;
    for (int unit = blockIdx.x; unit < BATCH * NH; unit += gridDim.x) {
        const int b = unit / NH, h = unit % NH;
        __syncthreads();
        for (int e = tid; e < 4096; e += 512) { const int d = e >> 6, j = e & 63; sW2[e] = INP(9)[(size_t)d * C + h * HD + j]; sA2[e] = INP(12)[(size_t)d * C + h * HD + j]; }
        __syncthreads();
        const int pt = tid >> 3, cq = tid & 7, c0 = h * HD + cq * 8;
        const int si = tid >> 3, jq = tid & 7;
        float S[8];
#pragma unroll
        for (int q = 0; q < 8; ++q) S[q] = 0.f;
        float w0v[8], a0v[8], kkv[8], kav[8], rkv[8];
#pragma unroll
        for (int q = 0; q < 8; ++q) { w0v[q] = INP(7)[c0 + q]; a0v[q] = INP(10)[c0 + q]; kkv[q] = INP(15)[c0 + q]; kav[q] = INP(16)[c0 + q]; rkv[q] = INP(17)[c0 + q]; }
        for (int blk = 0; blk < SEQ / 64; ++blk) {
            const size_t row = (size_t)b * SEQ + blk * 64 + pt;
            {
                const v4u r4 = *(const GAS v4u*)(Rb + row * C + c0), k4 = *(const GAS v4u*)(Kb + row * C + c0), v4 = *(const GAS v4u*)(Vb + row * C + c0);
                float r[8], k[8], v[8];
                r[0] = bflo(r4.x); r[1] = bfhi(r4.x); r[2] = bflo(r4.y); r[3] = bfhi(r4.y); r[4] = bflo(r4.z); r[5] = bfhi(r4.z); r[6] = bflo(r4.w); r[7] = bfhi(r4.w);
                k[0] = bflo(k4.x); k[1] = bfhi(k4.x); k[2] = bflo(k4.y); k[3] = bfhi(k4.y); k[4] = bflo(k4.z); k[5] = bfhi(k4.z); k[6] = bflo(k4.w); k[7] = bfhi(k4.w);
                v[0] = bflo(v4.x); v[1] = bfhi(v4.x); v[2] = bflo(v4.y); v[3] = bfhi(v4.y); v[4] = bflo(v4.z); v[5] = bfhi(v4.z); v[6] = bflo(v4.w); v[7] = bfhi(v4.w);
                float wp[8], ap[8];
#pragma unroll
                for (int q = 0; q < 8; ++q) { wp[q] = w0v[q]; ap[q] = a0v[q]; }
                for (int d = 0; d < 64; ++d) { const float lw = bf2f(LW[row * DW + d]), la = bf2f(LA[row * DA + d]);
#pragma unroll
                    for (int q = 0; q < 8; ++q) { wp[q] += lw * sW2[d * 64 + cq * 8 + q]; ap[q] += la * sA2[d * 64 + cq * 8 + q]; } }
                float kk[8], ss = 0.f, rks = 0.f;
#pragma unroll
                for (int q = 0; q < 8; ++q) { kk[q] = k[q] * kkv[q]; ss += kk[q] * kk[q]; }
                ss = sum8(ss);
                const float inv = 1.0f / fmaxf(sqrtf(ss), 1e-12f);
#pragma unroll
                for (int q = 0; q < 8; ++q) { const float ag = sigmoidf_(ap[q]); const float kn = kk[q] * inv; const float kp = k[q] * (1.0f + (ag - 1.0f) * kav[q]);
                    const float lw = -0.6065306597126334f * sigmoidf_(wp[q]);
                    const int o = pt * 64 + cq * 8 + q;
                    sR[o] = r[q]; sK[o] = kp; sV[o] = v[q]; sA[o] = -kn; sB[o] = kn * ag; sD[o] = __expf(lw); rks += r[q] * kp * rkv[q]; }
                rks = sum8(rks);
                if (cq == 0) RK[row * NH + h] = rks;
            }
            __syncthreads();
            for (int t = 0; t < 64; ++t) {
                const LAS f32x4* pa = (const LAS f32x4*)(sA + t * 64 + jq * 8); const LAS f32x4* pb = (const LAS f32x4*)(sB + t * 64 + jq * 8);
                const LAS f32x4* pd = (const LAS f32x4*)(sD + t * 64 + jq * 8); const LAS f32x4* pk = (const LAS f32x4*)(sK + t * 64 + jq * 8);
                const LAS f32x4* pr = (const LAS f32x4*)(sR + t * 64 + jq * 8);
                const f32x4 a0 = pa[0], a1 = pa[1], b0 = pb[0], b1 = pb[1], d0 = pd[0], d1 = pd[1], k0 = pk[0], k1 = pk[1], r0 = pr[0], r1 = pr[1];
                const float vi = sV[t * 64 + si];
                float sa = 0.f;
#pragma unroll
                for (int q = 0; q < 4; ++q) { sa += S[q] * a0[q]; sa += S[4 + q] * a1[q]; }
                sa = sum8(sa);
                float y = 0.f;
#pragma unroll
                for (int q = 0; q < 4; ++q) { S[q] = S[q] * d0[q] + sa * b0[q] + vi * k0[q]; S[4 + q] = S[4 + q] * d1[q] + sa * b1[q] + vi * k1[q]; y += S[q] * r0[q]; y += S[4 + q] * r1[q]; }
                y = sum8(y);
                if (jq == 0) Y[((size_t)b * SEQ + blk * 64 + t) * C + h * HD + si] = y;
            }
            __syncthreads();
        }
    }
}
__device__ __forceinline__ void post_scan(unsigned char* ws, int gw, int NGW, int lane) {
    const float* Y = OUTP(); const float* RK = (const float*)(ws + WS_HID); const bf16* Vb = (const bf16*)(ws + WS_B3); const bf16* LG = (const bf16*)(ws + WS_LG);
    bf16* YG = (bf16*)(ws + WS_B4); const float* g2 = INP(14); const float* lnw = INP(18); const float* lnb = INP(19);
    for (int it = gw; it < M * NH; it += NGW) {
        const int row = it / NH, h = it % NH, c = h * HD + lane;
        const float y = Y[(size_t)row * C + c];
        const float mu = wave_sum(y, lane) * (1.0f / HD); const float d = y - mu; const float var = wave_sum(d * d, lane) * (1.0f / HD);
        float o = d * (1.0f / sqrtf(var + GN_EPS)) * lnw[c] + lnb[c];
        o += RK[(size_t)row * NH + h] * bf2f(Vb[(size_t)row * C + c]);
        float g = 0.f;
        for (int dd = 0; dd < DG; ++dd) g += bf2f(LG[(size_t)row * DG + dd]) * g2[(size_t)dd * C + c];
        YG[(size_t)row * C + c] = (bf16)f2bf(o * g);
    }
}


constexpr int CW_DBG = 3200;
__device__ __forceinline__ void dbg_nonfinite(unsigned char* ws, const bf16* X, size_t n, int slot, int gw, int NGW, int lane, float thr = 1e30f) {
    unsigned* cw = (unsigned*)(ws + WS_CTL) + CW_DBG + 64 * slot; unsigned nnan = 0;
    for (size_t i = (size_t)gw * 64 + lane; i < n; i += (size_t)NGW * 64) { const float x = bf2f(X[i]); if (!(fabsf(x) < thr)) ++nnan; }
    if (nnan) atomicAdd(cw, nnan);
}
__device__ __forceinline__ void dbg_compare(unsigned char* ws, const bf16* X, const bf16* Y, int gw, int NGW, int lane) {
    unsigned* cw = (unsigned*)(ws + WS_CTL) + CW_DBG; unsigned nbad = 0, nnan = 0;
    for (size_t i = (size_t)gw * 64 + lane; i < (size_t)M * C; i += (size_t)NGW * 64) { const float x = bf2f(X[i]), y = bf2f(Y[i]);
        if (!(fabsf(x) < 1e30f)) ++nnan; else if (fabsf(x - y) > 0.05f * (fabsf(y) + 0.05f)) ++nbad; }
    if (nnan) atomicAdd(cw, nnan); if (nbad) atomicAdd(cw + 64, nbad);
}
#endif
constexpr int RT_W = 0, RT_PART = 131072, RT_SSQ = RT_PART + 8192, RT_REC = RT_SSQ + 2048;
static_assert(RT_REC + 64 * 4 + 7 * 64 * 4 <= LDSCTL_OFF, "router LDS");
__device__ __forceinline__ void router_stage(unsigned char* ws, LAS unsigned char* lds, int layer, int tid) {
    LAS float* sBias = (LAS float*)((LAS unsigned*)(lds + RT_REC) + 32);
    const v4u* src = (const v4u*)(ws + WS_WT_ROUT + (size_t)layer * 131072);
    v4u w_[16];
#pragma unroll
    for (int i = 0; i < 16; ++i) w_[i] = ((const GAS v4u*)src)[tid + 512 * i];
#pragma unroll
    for (int i = 0; i < 16; ++i) *(LAS v4u*)(lds + RT_W + (tid + 512 * i) * 16) = w_[i];
    if (tid < 4) sBias[tid] = (INP(25) + layer * 4)[tid]; else if (tid < 20) sBias[tid] = (INP(27) + layer * 16)[tid - 4];
}
__device__ __forceinline__ void router_rows(unsigned char* ws, LAS unsigned char* lds, int layer, int vcu, int G, int lane, int tid, int wv, bool prestaged) {
    LAS unsigned* lcnt = (LAS unsigned*)(lds + RT_REC); LAS unsigned* gbase = lcnt + 16; LAS float* sBias = (LAS float*)(lcnt + 32);
    LAS unsigned* recRow = lcnt + 64; LAS unsigned* recE = recRow + 64; LAS float* recW0 = (LAS float*)(recE + 64); LAS float* recW1 = recW0 + 64; LAS float* recRS = recW1 + 64;
    asm volatile("" : "+s"(wv), "+s"(ws), "+s"(vcu));
    const int rt = wv & 3, kh = wv >> 2, fr = lane & 15, g = lane >> 4;
    if (!prestaged) __syncthreads();
    bool staged = prestaged;
    for (int blk = vcu; blk < M / 64; blk += G) {
        const int row0 = blk * 64;
        bf16x8s a[16];
        { const bf16* ap = (const bf16*)(ws + WS_B4) + (size_t)(row0 + 16 * rt + fr) * C + 512 * kh + 8 * g;
#pragma unroll
          for (int ks = 0; ks < 16; ++ks) a[ks] = *(const GAS bf16x8s*)(ap + 32 * ks); }
        if (!staged) { staged = true; router_stage(ws, lds, layer, tid); }
        __syncthreads();
        f32x4 acc[2] = {F4Z, F4Z}; float ssq = 0.f;
#pragma unroll
        for (int ks = 0; ks < 16; ++ks) {
#pragma unroll
            for (int j = 0; j < 8; ++j) { const float x = __uint_as_float((unsigned)(unsigned short)a[ks][j] << 16); ssq += x * x; }
#pragma unroll
            for (int nt = 0; nt < 2; ++nt) { const LAS unsigned char* bp = lds + RT_W + ((((kh * 16 + ks) * 2 + nt) * 64 + lane) * 16);
                acc[nt] = MFMA16(a[ks], *(const LAS bf16x8s*)bp, acc[nt]); acc[nt] = MFMA16(a[ks], *(const LAS bf16x8s*)(bp + 65536), acc[nt]); } }
        ((LAS float*)(lds + RT_SSQ))[wv * 64 + lane] = ssq;
        if (kh == 1) { *(LAS f32x4*)(lds + RT_PART + ((rt * 2 + 0) * 64 + lane) * 16) = acc[0]; *(LAS f32x4*)(lds + RT_PART + ((rt * 2 + 1) * 64 + lane) * 16) = acc[1]; }
        __syncthreads();
        if (kh == 0) { acc[0] = acc[0] + *(const LAS f32x4*)(lds + RT_PART + ((rt * 2 + 0) * 64 + lane) * 16); acc[1] = acc[1] + *(const LAS f32x4*)(lds + RT_PART + ((rt * 2 + 1) * 64 + lane) * 16); }
        __syncthreads();
        if (kh == 0) {
#pragma unroll
            for (int nt = 0; nt < 2; ++nt)
#pragma unroll
                for (int q = 0; q < 4; ++q) ((LAS float*)(lds + RT_PART))[(16 * rt + 4 * g + q) * 32 + 16 * nt + fr] = acc[nt][q]; }
        __syncthreads();
        if (tid < 64) { const int r = tid, rtt = r >> 4, rr = r & 15; const LAS float* sp = (const LAS float*)(lds + RT_SSQ); float ss = 0.f;
#pragma unroll
            for (int h2 = 0; h2 < 2; ++h2)
#pragma unroll
                for (int kg = 0; kg < 4; ++kg) ss += sp[(h2 * 4 + rtt) * 64 + kg * 16 + rr];
            const float rs = frsq(ss * (1.0f / C) + RMS_EPS);
            const LAS float* L = (const LAS float*)(lds + RT_PART) + r * 32;
            const f32x4 l0 = *(const LAS f32x4*)L;
            float gl[4];
#pragma unroll
            for (int q = 0; q < 4; ++q) gl[q] = l0[q] * rs + sBias[q];
            int gi = 0; float gm = gl[0];
#pragma unroll
            for (int q = 1; q < 4; ++q) if (gl[q] > gm) { gm = gl[q]; gi = q; }
            float gden = 0.f;
#pragma unroll
            for (int q = 0; q < 4; ++q) gden += __expf(gl[q] - gm);
            const float gval = frcp(gden);
            const f32x4 li = *(const LAS f32x4*)(L + 4 + gi * 4), bi4 = *(const LAS f32x4*)(sBias + 4 + gi * 4);
            float il[4];
#pragma unroll
            for (int q = 0; q < 4; ++q) il[q] = li[q] * rs + bi4[q];
            int i0 = 0; float m0 = il[0];
#pragma unroll
            for (int q = 1; q < 4; ++q) if (il[q] > m0) { m0 = il[q]; i0 = q; }
            int i1 = i0 == 0 ? 1 : 0; float m1 = il[i1];
#pragma unroll
            for (int q = 0; q < 4; ++q) if (q != i0 && il[q] > m1) { m1 = il[q]; i1 = q; }
            const float e1 = __expf(m1 - m0); const float w0 = gval * frcp(1.0f + e1), w1 = w0 * e1;
            recRow[r] = (unsigned)(row0 + r); recE[r] = (unsigned)(gi * 4 + i0) | ((unsigned)(gi * 4 + i1) << 8); recW0[r] = w0; recW1[r] = w1; recRS[r] = rs; }
        __syncthreads();
        unsigned e = 0xffffffffu; if (tid < 64) e = recE[tid];
        const unsigned ex0 = e & 255u, ex1 = (e >> 8) & 255u;
        unsigned pos0 = 0u, pos1 = 0u;
        if (wv == 0) {
#pragma unroll
            for (unsigned x = 0; x < 16; ++x) { const unsigned long long m0 = __ballot(ex0 == x), m1 = __ballot(ex1 == x);
                const unsigned p = __builtin_amdgcn_mbcnt_hi((unsigned)(m0 >> 32), __builtin_amdgcn_mbcnt_lo((unsigned)m0, 0u)) + __builtin_amdgcn_mbcnt_hi((unsigned)(m1 >> 32), __builtin_amdgcn_mbcnt_lo((unsigned)m1, 0u));
                if (ex0 == x) pos0 = p; if (ex1 == x) pos1 = p;
                if (lane == 0) lcnt[x] = (unsigned)(__popcll(m0) + __popcll(m1)); } }
        __syncthreads();
        if (tid < 16) gbase[tid] = atomicAdd((unsigned*)(ws + WS_CTL) + CW_CNT + layer * 16 * 64 + tid * 64, lcnt[tid]);
        __syncthreads();
        if (tid < 64) { const unsigned p0 = gbase[ex0] + pos0, p1 = gbase[ex1] + pos1; const unsigned row = recRow[tid]; const float rs = recRS[tid];
            unsigned* list = (unsigned*)(ws + WS_LIST); float* wl = (float*)(ws + WS_WL); float* rsl = (float*)(ws + WS_B0);
            list[(size_t)ex0 * M + p0] = row * 2u; wl[(size_t)ex0 * M + p0] = recW0[tid]; list[(size_t)ex1 * M + p1] = row * 2u + 1u; wl[(size_t)ex1 * M + p1] = recW1[tid];
            rsl[(size_t)ex0 * M + p0] = rs; rsl[(size_t)ex1 * M + p1] = rs; }
    }
}
__device__ __forceinline__ void moe_table(unsigned char* ws, volatile LAS int* tab, int layer, int tid) {
    __syncthreads();
    if (tid == 0) { const unsigned* cnt = (const unsigned*)(ws + WS_CTL) + CW_CNT + layer * 16 * 64; int t = 0;
#pragma unroll 1
        for (int e = 0; e < 16; ++e) { const int c = (int)__hip_atomic_load(cnt, RLX_AGENT); cnt += 64; tab[e] = c; tab[16 + e] = t; t += (c + 255) >> 8; tab[32 + e] = t; }
        tab[48] = t; }
    __syncthreads();
}
__device__ __forceinline__ void combine_rows(unsigned char* ws, int mode, int gw, int NGW, int lane, bool dry = false) {
    bf16* Hh = (bf16*)(ws + WS_B4); float* Out = OUTP(); const bf16* E0 = (const bf16*)(ws + WS_B2); const bf16* E1 = (const bf16*)(ws + WS_B3); bf16* XN2 = (bf16*)(ws + WS_B0);
    f32x4 g[4]; load_row(INP(4), lane, g);
    for (int row = gw; row < M; row += NGW) {
        f32x4 v[4]; load_row_bf(Hh + (size_t)row * C, lane, v);
#pragma unroll
        for (int j = 0; j < 4; ++j) { const v2u e0 = ((const GAS v2u*)(E0 + (size_t)row * C))[64 * j + lane], e1 = ((const GAS v2u*)(E1 + (size_t)row * C))[64 * j + lane];
            v[j].x += bflo(e0.x) + bflo(e1.x); v[j].y += bfhi(e0.x) + bfhi(e1.x); v[j].z += bflo(e0.y) + bflo(e1.y); v[j].w += bfhi(e0.y) + bfhi(e1.y); }
        const float rs = row_rs(v, lane);
        if (mode == 0) {
            if (!dry) store_row_bf16(Hh + (size_t)row * C, lane, v);
            if (lane == 0) ((float*)XN2)[row] = rs;
        } else {
            float sig = 1.0f;
#if MK_DEBUG
            const unsigned* cw = (const unsigned*)(ws + WS_CTL) + CW_DBG; const unsigned nnan = __hip_atomic_load(cw, RLX_AGENT), nbad = __hip_atomic_load(cw + 64, RLX_AGENT);
            if (row < 512 && nnan > 0) sig = 2.0f;
            if (row >= 512 && row < 1536 && __hip_atomic_load(cw + 128, RLX_AGENT) > 0) sig = 2.0f;
            if (row >= 1536 && row < 3584 && __hip_atomic_load(cw + 192, RLX_AGENT) > 0) sig = 2.0f;
            if (row >= 3584 && row < 7680 && __hip_atomic_load(cw + 256, RLX_AGENT) > 0) sig = 2.0f;
            if (row >= 7680 && row < 15872 && __hip_atomic_load(cw + 320, RLX_AGENT) > 0) sig = 2.0f;
            if (row >= 15872 && nbad > (unsigned)(M / 100) * C) sig = 1.5f;
#endif
#pragma unroll
            for (int j = 0; j < 4; ++j) ((GAS f32x4*)(Out + (size_t)row * C))[64 * j + lane] = v[j] * rs * g[j] * sig;
        }
    }
}
__device__ __forceinline__ void attn_naive(unsigned char* ws, int gw, int NGW, int lane) {
    const bf16* Kb = (const bf16*)(ws + WS_B1); const bf16* Vb = (const bf16*)(ws + WS_B2); const bf16* Qb = (const bf16*)(ws + WS_B3); bf16* Ob = (bf16*)(ws + WS_B0);
    for (int unit = gw; unit < BATCH * NH * (SEQ / 64); unit += NGW) {
        const int qb = unit % (SEQ / 64), bh = unit / (SEQ / 64), b = bh / NH, h = bh % NH;
        const int t0 = qb * 64, t = t0 + lane; const size_t rowq = (size_t)b * SEQ + t;
        float q[64], o[64];
#pragma unroll
        for (int c = 0; c < 8; ++c) { const v4u w = *(const GAS v4u*)(Qb + rowq * C + h * HD + c * 8);
            q[c * 8 + 0] = bflo(w.x) * 0.125f; q[c * 8 + 1] = bfhi(w.x) * 0.125f; q[c * 8 + 2] = bflo(w.y) * 0.125f; q[c * 8 + 3] = bfhi(w.y) * 0.125f;
            q[c * 8 + 4] = bflo(w.z) * 0.125f; q[c * 8 + 5] = bfhi(w.z) * 0.125f; q[c * 8 + 6] = bflo(w.w) * 0.125f; q[c * 8 + 7] = bfhi(w.w) * 0.125f; }
#pragma unroll
        for (int c = 0; c < 64; ++c) o[c] = 0.f;
        float suffix = 0.f;
        for (int s = t0 + 62; s >= 0; --s) {
            const bool valid = s < t;
            if (s < t0 && __all(suffix > SB_EXIT)) break;
            const bf16* kp = Kb + ((size_t)b * SEQ + s) * C + h * HD; const bf16* vp = Vb + ((size_t)b * SEQ + s) * C + h * HD;
            float z = 0.f;
#pragma unroll
            for (int c = 0; c < 8; ++c) { const v4u w = *(const GAS v4u*)(kp + c * 8);
                z += q[c * 8 + 0] * bflo(w.x) + q[c * 8 + 1] * bfhi(w.x) + q[c * 8 + 2] * bflo(w.y) + q[c * 8 + 3] * bfhi(w.y) + q[c * 8 + 4] * bflo(w.z) + q[c * 8 + 5] * bfhi(w.z) + q[c * 8 + 6] * bflo(w.w) + q[c * 8 + 7] * bfhi(w.w); }
            const float sp = fmaxf(z, 0.f) + log1pf(__expf(-fabsf(z)));
            const float att = valid ? __expf(z - sp - suffix) : 0.f;
            suffix += valid ? sp : 0.f;
#pragma unroll
            for (int c = 0; c < 8; ++c) { const v4u w = *(const GAS v4u*)(vp + c * 8);
                o[c * 8 + 0] += att * bflo(w.x); o[c * 8 + 1] += att * bfhi(w.x); o[c * 8 + 2] += att * bflo(w.y); o[c * 8 + 3] += att * bfhi(w.y);
                o[c * 8 + 4] += att * bflo(w.z); o[c * 8 + 5] += att * bfhi(w.z); o[c * 8 + 6] += att * bflo(w.w); o[c * 8 + 7] += att * bfhi(w.w); }
        }
#pragma unroll
        for (int c = 0; c < 8; ++c) { v4u w; w.x = pk2(o[c * 8 + 0], o[c * 8 + 1]); w.y = pk2(o[c * 8 + 2], o[c * 8 + 3]); w.z = pk2(o[c * 8 + 4], o[c * 8 + 5]); w.w = pk2(o[c * 8 + 6], o[c * 8 + 7]);
            *(GAS v4u*)(Ob + rowq * C + h * HD + c * 8) = w; }
    }
}


typedef float f32x16 __attribute__((ext_vector_type(16)));
constexpr int AT_VP = 192;
constexpr int AT_WAVE_LDS = 32 * AT_VP;
__device__ __forceinline__ int crow32(int reg, int hh) { return (reg & 3) + 8 * (reg >> 2) + 4 * hh; }
__device__ __forceinline__ bf16x8s pack_step(const f32x16& x, const int s) {
    v4u p; p.x = pg8::cvt_pk_bf16(x[8 * s], x[8 * s + 1]); p.y = pg8::cvt_pk_bf16(x[8 * s + 2], x[8 * s + 3]); p.z = pg8::cvt_pk_bf16(x[8 * s + 4], x[8 * s + 5]); p.w = pg8::cvt_pk_bf16(x[8 * s + 6], x[8 * s + 7]);
    return __builtin_bit_cast(bf16x8s, p);
}
__device__ __forceinline__ void attn_mfma(unsigned char* ws, LAS unsigned char* lds, int gw, int NGW, int lane, int wave) {
    const bf16* Kb = (const bf16*)(ws + WS_B1); const bf16* Vb = (const bf16*)(ws + WS_B2); const bf16* Qb = (const bf16*)(ws + WS_B3); bf16* Ob = (bf16*)(ws + WS_B0);
    LAS unsigned char* vl = lds + wave * AT_WAVE_LDS;
    const int r32 = lane & 31, hh = lane >> 5;
    bf16x8s tri[2];
#pragma unroll
    for (int s = 0; s < 2; ++s)
#pragma unroll
        for (int j = 0; j < 8; ++j) tri[s][j] = (16 * s + 8 * (j >> 2) + 4 * hh + (j & 3)) > r32 ? (short)0x3F80 : (short)0;
    const int grp = lane >> 4, tq = (lane & 15) >> 2, tp = lane & 3;
    const LAS unsigned char* vtr0 = vl + (4 * hh + tq) * AT_VP + (16 * (grp & 1) + 4 * tp) * 2;
    for (int unit = gw; unit < BATCH * NH * (SEQ / 32); unit += NGW) {
        const int qb = unit % (SEQ / 32), bh = unit / (SEQ / 32), b = bh / NH, hd = bh % NH;
        const int t0 = qb * 32; const size_t rowb = (size_t)b * SEQ;
        bf16x8s qf[4];
#pragma unroll
        for (int ks = 0; ks < 4; ++ks) qf[ks] = *(const GAS bf16x8s*)(Qb + (rowb + t0 + r32) * C + hd * HD + 16 * ks + 8 * hh);
        f32x16 o[2];
#pragma unroll
        for (int i = 0; i < 16; ++i) { o[0][i] = 0.f; o[1][i] = 0.f; }
        float carry = 0.f;
        for (int s0 = t0; s0 >= 0; s0 -= 32) {
            bf16x8s kf[4];
#pragma unroll
            for (int ks = 0; ks < 4; ++ks) kf[ks] = *(const GAS bf16x8s*)(Kb + (rowb + s0 + r32) * C + hd * HD + 16 * ks + 8 * hh);
            v4u vreg[4];
#pragma unroll
            for (int i = 0; i < 4; ++i) { const int cidx = lane + 64 * i; vreg[i] = *(const GAS v4u*)(Vb + (rowb + s0 + (cidx >> 3)) * C + hd * HD + (cidx & 7) * 8); }
            f32x16 st;
#pragma unroll
            for (int i = 0; i < 16; ++i) st[i] = 0.f;
#pragma unroll
            for (int ks = 0; ks < 4; ++ks) st = __builtin_amdgcn_mfma_f32_32x32x16_bf16(kf[ks], qf[ks], st, 0, 0, 0);
#pragma unroll
            for (int i = 0; i < 4; ++i) { const int cidx = lane + 64 * i; *(LAS v4u*)(vl + (cidx >> 3) * AT_VP + (cidx & 7) * 16) = vreg[i]; }
            f32x16 zz, uu; float tot = 0.f; const int tq_ = t0 + r32;
            if (s0 + 31 < t0) {
#pragma unroll
                for (int i = 0; i < 16; ++i) { const float z = st[i] * 0.18033688011112042f; const float sp = fmaxf(z, 0.f) + __builtin_amdgcn_logf(1.0f + __builtin_amdgcn_exp2f(-fabsf(z)));
                    zz[i] = z - sp; uu[i] = sp; tot += sp; }
            } else {
#pragma unroll
                for (int i = 0; i < 16; ++i) { const int key = s0 + crow32(i, hh); const float z = st[i] * 0.18033688011112042f; const float sp = fmaxf(z, 0.f) + __builtin_amdgcn_logf(1.0f + __builtin_amdgcn_exp2f(-fabsf(z)));
                    const bool valid = key < tq_; zz[i] = valid ? z - sp : -1e30f; uu[i] = valid ? sp : 0.f; tot += uu[i]; }
            }
            f32x16 w;
#pragma unroll
            for (int i = 0; i < 16; ++i) w[i] = 0.f;
#pragma unroll
            for (int s = 0; s < 2; ++s) w = __builtin_amdgcn_mfma_f32_32x32x16_bf16(tri[s], pack_step(uu, s), w, 0, 0, 0);
            f32x16 pp;
#pragma unroll
            for (int i = 0; i < 16; ++i) pp[i] = __builtin_amdgcn_exp2f(zz[i] - w[i] - carry);
            tot += shx(tot, 32, lane); carry += tot;
            asm volatile("s_waitcnt lgkmcnt(0)" ::: "memory");
#pragma unroll
            for (int s = 0; s < 2; ++s) { const bf16x8s pa = pack_step(pp, s);
#pragma unroll
                for (int dt = 0; dt < 2; ++dt) {
                    const v4i16_t lo = __builtin_amdgcn_ds_read_tr16_b64_v4i16((LAS v4i16_t*)(vtr0 + (16 * s) * AT_VP + dt * 64));
                    const v4i16_t hi = __builtin_amdgcn_ds_read_tr16_b64_v4i16((LAS v4i16_t*)(vtr0 + (16 * s + 8) * AT_VP + dt * 64));
                    const bf16x8s vf = (bf16x8s){lo[0], lo[1], lo[2], lo[3], hi[0], hi[1], hi[2], hi[3]};
                    o[dt] = __builtin_amdgcn_mfma_f32_32x32x16_bf16(pa, vf, o[dt], 0, 0, 0); } }
            asm volatile("" ::: "memory");
            if (s0 < t0 && __all(carry > SB_EXIT * 1.4426950408889634f)) break;
        }
#pragma unroll
        for (int dt = 0; dt < 2; ++dt)
#pragma unroll
            for (int i = 0; i < 16; ++i) Ob[(rowb + t0 + crow32(i, hh)) * C + hd * HD + 32 * dt + r32] = (bf16)(pg8::cvt_pk_bf16(o[dt][i], 0.f) & 0xffffu);
    }
}
__global__ void __launch_bounds__(NWAVES * 64, 2) yoco_fwd(Args args) {
    extern __shared__ __attribute__((aligned(16))) unsigned char lds_raw[];
    LAS unsigned char* lds = (LAS unsigned char*)lds_raw;
    const int G = gridDim.x; const int bx = blockIdx.x;
    int wave = __builtin_amdgcn_readfirstlane(threadIdx.x >> 6); asm volatile("" : "+s"(wave));
#define IDS() int lane; asm volatile("v_mbcnt_lo_u32_b32 %0, -1, 0\n\tv_mbcnt_hi_u32_b32 %0, -1, %0" : "=v"(lane)); const int tid = wave * 64 + lane; (void)tid; \
    const int vcu = (G % 8 == 0) ? (bx % 8) * (G / 8) + bx / 8 : bx; const int gw = vcu * NWAVES + wave, NGW = G * NWAVES; (void)lane; (void)gw; (void)NGW;
    unsigned char* ws = WSP();
    volatile LAS unsigned* MISC = (volatile LAS unsigned*)(lds + MISC_OFF);
    volatile LAS int* tab = (volatile LAS int*)(lds + MOE_TAB_OFF);
    for (int u = threadIdx.x; u < (LDS_BYTES - LDSCTL_OFF) / 4; u += NWAVES * 64) ((LAS unsigned*)(lds + LDSCTL_OFF))[u] = 0u;
    __syncthreads();
    XcdBarrier bar; bar.bar = (unsigned*)(ws + WS_CTL) + CW_BAR; bar.x = 0; bar.st = nullptr;
    if (N_LAUNCHES == 1) bar = xcd_barrier_post((unsigned*)(ws + WS_CTL) + CW_BAR, MISC + 8);
    const int lo = KA_INT(0), hi = KA_INT(1);
#ifndef PROBE_PH
#define PROBE_PH -1
#endif
#define IN(k) (lo <= (k) && (k) < hi)
#define REP(k) for (int rep_ = 0; rep_ < ((PROBE_PH == (k)) ? 2 : 1); ++rep_)
#define SEAM(k) do { if (IN(k) && IN((k) + 1)) xcd_barrier(bar); } while (0)
#define SEAM_ROUT(k, lay) do { if (IN(k) && IN((k) + 1)) { xcd_barrier_arrive(bar); { IDS(); router_stage(ws, lds, (lay), tid); } xcd_barrier_wait(bar); } } while (0)

    if (IN(PH_P0)) REP(PH_P0) { IDS(); p0_weights<0>(ws, lds, gw, NGW, wave, lane); if (G <= 192) { p0_weights<3>(ws, lds, gw, NGW, wave, lane); p0_weights<1>(ws, lds, gw, NGW, wave, lane); } if (G <= 64) p0_weights<4>(ws, lds, gw, NGW, wave, lane); if (G <= 64) p0_weights<2>(ws, lds, gw, NGW, wave, lane); p0_rows(ws, gw, NGW, lane); }
    SEAM(PH_P0);
    if (PROBE_PH == 100 && N_LAUNCHES == 1) { for (int i_ = 0; i_ < 10; ++i_) xcd_barrier(bar); }
    if (IN(PH_LORA)) REP(PH_LORA) {
        SchedGrouped<1, 3> S{(const char*)(ws + WS_B1), (size_t)(WS_B2 - WS_B1), nullptr, (const char*)(ws + WS_WT_LORA), (size_t)256 * C * 2, G, bx};
        EpiLora E{(bf16*)(ws + WS_LW)};
        pg8::gemm_phase<EpiLora, SchedGrouped<1, 3>, true, false, C>(lds, S, E, wave);
        if (G > 192 && bx >= 192) { IDS(); p0_weights<1>(ws, lds, (bx - 192) * NWAVES + wave, (G - 192) * NWAVES, wave, lane, 0, 2048); }
    }
    SEAM(PH_LORA);
    if (IN(PH_RKV)) REP(PH_RKV) {
        SchedGrouped<4, 3> S{(const char*)OUTP(), (size_t)M * C * 2, (const char*)(ws + WS_B4), (const char*)(ws + WS_WT_RKV), (size_t)C * C * 2, G, bx};
        EpiSplit3 E{(bf16*)(ws + WS_B1), false, nullptr};
        pg8::gemm_phase<EpiSplit3, SchedGrouped<4, 3>, true, false, C>(lds, S, E, wave);
    }
    SEAM(PH_RKV);
    if (IN(PH_S1)) REP(PH_S1) { IDS(); scan_s1(ws, lds, lane, wave); }
    SEAM(PH_S1);
    if (IN(PH_S2)) REP(PH_S2) { IDS();
        if (bx < BATCH * NH || G <= BATCH * NH) scan_s2(ws, lds, lane, wave);
        else if (G > 192) { const int cg_ = (bx - BATCH * NH) * NWAVES + wave, cn_ = (G - BATCH * NH) * NWAVES; p0_weights<3>(ws, lds, cg_, cn_, wave, lane); p0_weights<1>(ws, lds, cg_, cn_, wave, lane, 2048); }
        }
    SEAM(PH_S2);
    if (IN(PH_S3)) REP(PH_S3) { IDS(); scan_s3(ws, lds, lane, wave); }
    SEAM(PH_S3);
#if MK_DEBUG
    if (IN(PH_DBG0)) { IDS(); scan_naive(ws, lds, tid); }
    SEAM(PH_DBG0);
    if (IN(PH_DBG0 + 1)) { IDS(); post_scan(ws, gw, NGW, lane); }
    SEAM(PH_DBG0 + 1);
    if (IN(PH_DBG0 + 2)) { IDS(); dbg_compare(ws, (const bf16*)(ws + WS_B0), (const bf16*)(ws + WS_B4), gw, NGW, lane); }
    SEAM(PH_DBG0 + 2);
#endif
    if (IN(PH_WOUT)) REP(PH_WOUT) {
        SchedGrouped<4, 1> S{(const char*)(ws + ((MK_DEBUG && DBG_USE_NAIVE) ? WS_B4 : WS_B0)), 0, nullptr, (const char*)(ws + WS_WT_OUT), 0, G, bx};
        EpiResidBf<true> E{INP(0), (bf16*)(ws + WS_B4)};
        pg8::gemm_phase<EpiResidBf<true>, SchedGrouped<4, 1>, true, false, C>(lds, S, E, wave);
    }
    SEAM_ROUT(PH_WOUT, 0);
#pragma unroll 1
    for (int layer = 0; layer < 2; ++layer) {
        unsigned char* ws_l = ws; int G_l = G, bx_l = bx, wave_l = wave; asm volatile("" : "+s"(ws_l), "+s"(G_l), "+s"(bx_l), "+s"(wave_l));
        { unsigned char* const ws = ws_l; const int G = G_l, bx = bx_l, wave = wave_l;
        const int pb = layer == 0 ? (int)PH_ROUT0 : (int)PH_ROUT1;
        if (IN(pb)) { IDS(); router_rows(ws, lds, layer, vcu, G, lane, tid, wave, N_LAUNCHES == 1 && IN(pb - 1)); }
        SEAM(pb);
        const int mc = (G % 8 == 0) ? (bx % 8) * (G / 8) + bx / 8 : bx;
        if (IN(pb + 1)) REP(pb + 1) {
            { IDS(); moe_table(ws, tab, layer, tid); }
            SchedMoe<2, C, true> S{(const char*)(ws + WS_B4), (const char*)(ws + WS_WT_GU) + (size_t)layer * 16 * 512 * C * 2, (size_t)512 * C * 2, (const unsigned*)(ws + WS_LIST), tab, G, mc};
            EpiGU E{(bf16*)(ws + WS_HID), (const float*)(ws + WS_WL), (const float*)(ws + WS_B0)};
            pg8::gemm_phase<EpiGU, SchedMoe<2, C, true>, true, true, C, true>(lds, S, E, wave);
            if (layer == 0 && G > 64) { const int tot_ = __builtin_amdgcn_readfirstlane(tab[48]) * 2, rem_ = tot_ % G, first = tot_ <= G ? 0 : (rem_ > 0 && 2 * rem_ <= G ? 2 * rem_ : (rem_ > 0 ? rem_ : G));
                if (mc >= first) { IDS(); p0_weights<4>(ws, lds, (mc - first) * NWAVES + wave, (G - first) * NWAVES, wave, lane); p0_weights<2>(ws, lds, (mc - first) * NWAVES + wave, (G - first) * NWAVES, wave, lane); } }
        }
        SEAM(pb + 1);
        if (IN(pb + 2)) REP(pb + 2) {
            { IDS(); moe_table(ws, tab, layer, tid); }
            SchedMoe<4, FE, false> S{(const char*)(ws + WS_HID), (const char*)(ws + WS_WT_DN) + (size_t)layer * 16 * C * FE * 2, (size_t)C * FE * 2, (const unsigned*)(ws + WS_LIST), tab, G, mc};
            EpiDown E{(bf16*)(ws + WS_B2), (const unsigned*)(ws + WS_LIST)};
            pg8::gemm_phase<EpiDown, SchedMoe<4, FE, false>, true, false, FE, true>(lds, S, E, wave);
        }
        SEAM(pb + 2);
        if (layer == 0) {
            if (IN(PH_COMB)) { IDS(); if (PROBE_PH == 102) combine_rows(ws, 0, gw, NGW, lane, true); combine_rows(ws, 0, gw, NGW, lane); }
            SEAM(PH_COMB);
            if (IN(PH_KVQ)) REP(PH_KVQ) {
                SchedGrouped<12, 1> S{(const char*)(ws + WS_B4), 0, nullptr, (const char*)(ws + WS_WT_KVQ), 0, G, bx};
                EpiSplit3 E{(bf16*)(ws + WS_B1), true, (const float*)(ws + WS_B0)};
                pg8::gemm_phase<EpiSplit3, SchedGrouped<12, 1>, true, false, C>(lds, S, E, wave);
            }
            SEAM(PH_KVQ);
            if (IN(PH_ATTN)) REP(PH_ATTN) { IDS(); attn_mfma(ws, lds, gw, NGW, lane, wave); }
            SEAM(PH_ATTN);
            if (IN(PH_SBO)) {
                SchedGrouped<4, 1> S{(const char*)(ws + WS_B0), 0, nullptr, (const char*)(ws + WS_WT_SBO), 0, G, bx};
                EpiResidBf<false> E{(const void*)(ws + WS_B4), (bf16*)(ws + WS_B4)};
                pg8::gemm_phase<EpiResidBf<false>, SchedGrouped<4, 1>, true, false, C>(lds, S, E, wave);
            }
            SEAM_ROUT(PH_SBO, 1);
        }
        }
    }
    if (IN(PH_FINAL)) { IDS(); combine_rows(ws, 1, gw, NGW, lane); }
#undef IN
#undef SEAM
}

extern "C" void kernel_launch(void* const* d_in, const int* in_sizes, int n_in, void* d_out, int out_size, void* d_ws, size_t ws_size, hipStream_t stream) {
    static int grid = 0;
    if (grid == 0) {
        if (n_in != 31 || in_sizes[0] != M * C || out_size != M * C || ws_size < WS_END) { fprintf(stderr, "kernel_launch: unexpected shapes (n_in %d, in0 %d, out %d, ws %zu); nothing launched\n", n_in, n_in > 0 ? in_sizes[0] : -1, out_size, ws_size); grid = -1; return; }
        int dev = 0, cus = 0, per_cu = 0;
        if (hipGetDevice(&dev) != hipSuccess || hipDeviceGetAttribute(&cus, hipDeviceAttributeMultiprocessorCount, dev) != hipSuccess) { grid = -1; return; }
        if (hipFuncSetAttribute((const void*)yoco_fwd, hipFuncAttributeMaxDynamicSharedMemorySize, LDS_BYTES) != hipSuccess) { fprintf(stderr, "kernel_launch: hipFuncSetAttribute failed\n"); grid = -1; return; }
        if (hipOccupancyMaxActiveBlocksPerMultiprocessor(&per_cu, (const void*)yoco_fwd, NWAVES * 64, LDS_BYTES) != hipSuccess || per_cu < 1) fprintf(stderr, "kernel_launch: occupancy query reports %d\n", per_cu);
        (void)hipGetLastError();
        grid = cus - (cus % 16);
    }
    if (grid < 0) return;
    if (hipMemsetAsync((char*)d_ws + WS_CTL, 0, CTL_ZERO_BYTES, stream) != hipSuccess) return;
    Args a{};
    for (int i = 0; i < 31; ++i) a.in[i] = (const float*)d_in[i];
    a.out = (float*)d_out; a.ws = (unsigned char*)d_ws;
    for (int li = 0; li < (N_LAUNCHES == 1 ? 1 : (int)NPHASE); ++li) {
        a.ph_lo = (N_LAUNCHES == 1) ? 0 : li; a.ph_hi = (N_LAUNCHES == 1) ? NPHASE : li + 1; a.li = li;
        hipLaunchKernelGGL(yoco_fwd, dim3(grid), dim3(NWAVES * 64), LDS_BYTES, stream, a);
        const hipError_t le = hipPeekAtLastError();
        if (le != hipSuccess) { fprintf(stderr, "kernel_launch: launch %d failed: %s\n", li, hipGetErrorName(le)); break; }
    }
}
```
